# Optimizing an MI355X kernel written in HIP

```python
import jax, jax.numpy as jnp
from jax import lax
import numpy as np

D_MODEL = 2048
BATCH = 1
SEQ = 8192
DEPTH = 4

CHUNK = 64
N_BRANCH = 4
BRANCH_W = 512
RMS_EPS = 1e-6
GN_EPS = 1e-5
ROPE_THETA = 10000.0

RET_HEADS = 4
RET_DK = 128
RET_DV = 128
SSM_HEADS = 8
SSM_HEADDIM = 64
SSM_GROUPS = 2
SSM_STATE = 128
SSM_CONV = 4
SSM_HPG = SSM_HEADS // SSM_GROUPS
SSM_XBC = SSM_HEADS * SSM_HEADDIM + 2 * SSM_GROUPS * SSM_STATE
MLA_HEADS = 4
MLA_Q_RANK = 512
MLA_KV_RANK = 256
MLA_NOPE = 128
MLA_ROPE = 64
MLA_V = 128
MLA_QK = MLA_NOPE + MLA_ROPE
Q_BLOCK = 128
RWKV_HEADS = 8
RWKV_HEAD = 64
RWKV_W = RWKV_HEADS * RWKV_HEAD
RWKV_W_LORA = 64
RWKV_A_LORA = 64
RWKV_V_LORA = 32
RWKV_G_LORA = 128
RWKV_GN_EPS = 64e-5
RWKV_COLS = 3 * RWKV_W + RWKV_W_LORA + RWKV_A_LORA + RWKV_G_LORA
D_FF = -(-8 * D_MODEL // (3 * 256)) * 256

IN_SIZES = (
    RET_HEADS * RET_DK, RET_HEADS * RET_DK, RET_HEADS * RET_DV, RET_HEADS * RET_DV,
    SSM_HEADS * SSM_HEADDIM, SSM_XBC, SSM_HEADS,
    MLA_Q_RANK, MLA_KV_RANK, MLA_ROPE,
    RWKV_COLS,
    N_BRANCH * D_MODEL,
)
N_IN = sum(IN_SIZES)

kernel_name = "hybrid_ret_ssd_mla_rwkv7_gated_trunk"


def _split(x, sizes):
    idx = np.cumsum(np.array(sizes))[:-1].tolist()
    return jnp.split(x, idx, axis=-1)


def rms_norm(x, w, eps=RMS_EPS):
    xf = x.astype(jnp.float32)
    y = xf * lax.rsqrt(jnp.mean(xf * xf, axis=-1, keepdims=True) + eps)
    return (y * w.astype(jnp.float32)).astype(x.dtype)


def head_layer_norm(x, eps):
    xf = x.astype(jnp.float32)
    xc = xf - jnp.mean(xf, axis=-1, keepdims=True)
    return xc * lax.rsqrt(jnp.mean(xc * xc, axis=-1, keepdims=True) + eps)


def rope_tables(positions, dim):
    inv = 1.0 / (ROPE_THETA ** (jnp.arange(0, dim, 2, dtype=jnp.float32) / dim))
    ang = positions.astype(jnp.float32)[..., None] * inv
    return jnp.cos(ang), jnp.sin(ang)


def apply_rope(x, cos, sin):
    half = x.shape[-1] // 2
    x1 = x[..., :half].astype(jnp.float32)
    x2 = x[..., half:].astype(jnp.float32)
    c = cos[:, :, None, :]
    s = sin[:, :, None, :]
    return jnp.concatenate([x1 * c - x2 * s, x2 * c + x1 * s], axis=-1).astype(x.dtype)


def retention_mixer(q, k, v, g, cos, sin, gn_w):
    B, S, _ = q.shape
    NC = S // CHUNK
    H, DK, DV = RET_HEADS, RET_DK, RET_DV
    f32 = jnp.float32
    q = apply_rope(q.reshape(B, S, H, DK), cos, sin).astype(f32)
    k = apply_rope(k.reshape(B, S, H, DK), cos, sin).astype(f32) * (DK ** -0.5)
    v = v.reshape(B, S, H, DV).astype(f32)
    log_gamma = jnp.log1p(-jnp.exp2(-5.0 - jnp.arange(H, dtype=f32)))
    pos = jnp.arange(CHUNK, dtype=f32)
    intra_decay = jnp.exp(log_gamma[:, None, None] * jnp.abs(pos[:, None] - pos[None, :]))
    q_decay = jnp.exp(log_gamma[:, None] * (pos + 1.0))
    k_decay = jnp.exp(log_gamma[:, None] * (CHUNK - 1.0 - pos))
    chunk_decay = jnp.exp(log_gamma * CHUNK)[None, :, None, None]
    qc = q.reshape(B, NC, CHUNK, H, DK)
    kc = k.reshape(B, NC, CHUNK, H, DK)
    vc = v.reshape(B, NC, CHUNK, H, DV)
    scores = jnp.einsum('bclhd,bcmhd->bchlm', qc, kc) * intra_decay
    intra = jnp.einsum('bchlm,bcmhe->bclhe', scores, vc)
    kv = jnp.einsum('bcmhd,hm,bcmhe->bchde', kc, k_decay, vc)

    def step(state, kv_c):
        return chunk_decay * state + kv_c, state

    _, s_prev = lax.scan(step, jnp.zeros((B, H, DK, DV), f32), jnp.moveaxis(kv, 1, 0))
    s_prev = jnp.moveaxis(s_prev, 0, 1)
    inter = jnp.einsum('bclhd,bchde,hl->bclhe', qc, s_prev, q_decay)
    o = head_layer_norm((intra + inter).reshape(B, S, H, DV), GN_EPS) * gn_w.astype(f32).reshape(H, DV)
    return (jax.nn.silu(g.astype(f32)) * o.reshape(B, S, H * DV)).astype(g.dtype)


def causal_depthwise_conv(x, w, b):
    K, C = w.shape
    y = lax.conv_general_dilated(x, w.astype(x.dtype)[:, None, :], window_strides=(1,),
                                 padding=[(K - 1, 0)], dimension_numbers=('NWC', 'WIO', 'NWC'),
                                 feature_group_count=C)
    return y + b.astype(x.dtype)


def ssd_chunked(x, a_dt, bm, cm):
    B, S, G, HG, P = x.shape
    N = bm.shape[-1]
    NC = S // CHUNK
    f32 = jnp.float32
    xc = x.reshape(B, NC, CHUNK, G, HG, P)
    ac = a_dt.reshape(B, NC, CHUNK, G, HG)
    bc = bm.reshape(B, NC, CHUNK, G, N)
    cc = cm.reshape(B, NC, CHUNK, G, N)
    a_cs = jnp.cumsum(ac, axis=2)
    causal = jnp.tril(jnp.ones((CHUNK, CHUNK), dtype=bool))[:, :, None, None]
    seg = a_cs[:, :, :, None] - a_cs[:, :, None, :]
    decay_lm = jnp.exp(jnp.where(causal, seg, -jnp.inf))
    cb = jnp.einsum('bclgn,bcmgn->bclmg', cc, bc)
    y_diag = jnp.einsum('bclmgh,bcmghp->bclghp', cb[..., None] * decay_lm, xc)
    decay_to_end = jnp.exp(a_cs[:, :, -1:] - a_cs)
    states = jnp.einsum('bclgn,bclgh,bclghp->bcghpn', bc, decay_to_end, xc)
    chunk_decay = jnp.exp(a_cs[:, :, -1])[..., None, None]

    def step(state, inp):
        dec, st = inp
        return state * dec + st, state

    _, s_prev = lax.scan(step, jnp.zeros((B, G, HG, P, N), f32),
                         (jnp.moveaxis(chunk_decay, 1, 0).astype(f32), jnp.moveaxis(states, 1, 0).astype(f32)))
    s_prev = jnp.moveaxis(s_prev, 0, 1)
    y_off = jnp.einsum('bclgn,bcghpn,bclgh->bclghp', cc, s_prev, jnp.exp(a_cs))
    return (y_diag + y_off).reshape(B, S, G, HG, P)


def mamba2_mixer(z, xbc, dt, conv_w, conv_b, dt_bias, a_log, d_skip, norm_w):
    B, S, _ = z.shape
    G, HG, P, N = SSM_GROUPS, SSM_HPG, SSM_HEADDIM, SSM_STATE
    f32 = jnp.float32
    xbc = jax.nn.silu(causal_depthwise_conv(xbc, conv_w, conv_b))
    xs, bm, cm = _split(xbc, (SSM_HEADS * P, G * N, G * N))
    x = xs.reshape(B, S, G, HG, P).astype(f32)
    bm = bm.reshape(B, S, G, N).astype(f32)
    cm = cm.reshape(B, S, G, N).astype(f32)
    dt = jax.nn.softplus(dt.astype(f32) + dt_bias.astype(f32)).reshape(B, S, G, HG)
    a = -jnp.exp(a_log.astype(f32)).reshape(G, HG)
    y = ssd_chunked(x * dt[..., None], dt * a, bm, cm)
    y = y + x * d_skip.astype(f32).reshape(G, HG, 1)
    y = y.reshape(B, S, G, HG * P) * jax.nn.silu(z.astype(f32)).reshape(B, S, G, HG * P)
    y = rms_norm(y, norm_w.reshape(G, HG * P))
    return y.reshape(B, S, G * HG * P).astype(z.dtype)


def block_causal_attention(q, k, v):
    B, S, H, D = q.shape
    Dv = v.shape[-1]
    NB = S // Q_BLOCK
    scale = D ** -0.5
    qb = q.reshape(B, NB, Q_BLOCK, H, D).transpose(1, 0, 3, 2, 4)
    kt = k.transpose(0, 2, 1, 3)
    vt = v.transpose(0, 2, 1, 3)
    key_chunk = jnp.arange(S) // CHUNK

    def one_block(args):
        q_blk, blk = args
        q_chunk = (blk * Q_BLOCK + jnp.arange(Q_BLOCK)) // CHUNK
        s = jnp.einsum('bhqd,bhkd->bhqk', q_blk, kt).astype(jnp.float32) * scale
        s = jnp.where(key_chunk[None, :] <= q_chunk[:, None], s, -jnp.inf)
        p = jax.nn.softmax(s, axis=-1).astype(vt.dtype)
        return jnp.einsum('bhqk,bhkd->bhqd', p, vt)

    o = lax.map(one_block, (qb, jnp.arange(NB)))
    return o.transpose(1, 0, 3, 2, 4).reshape(B, S, H * Dv)


def mla_mixer(cq, ckv, k_rope, cos, sin, q_a_norm_w, w_qb, kv_a_norm_w, w_kvb, q_norm_w, k_norm_w):
    B, S, _ = cq.shape
    H = MLA_HEADS
    q = (rms_norm(cq, q_a_norm_w) @ w_qb).reshape(B, S, H, MLA_QK)
    kv = (rms_norm(ckv, kv_a_norm_w) @ w_kvb).reshape(B, S, H, MLA_NOPE + MLA_V)
    k_nope, v = kv[..., :MLA_NOPE], kv[..., MLA_NOPE:]
    k = jnp.concatenate([k_nope, jnp.broadcast_to(k_rope[:, :, None, :], (B, S, H, MLA_ROPE)).astype(k_nope.dtype)], axis=-1)
    q = rms_norm(q, q_norm_w)
    k = rms_norm(k, k_norm_w)
    q = jnp.concatenate([q[..., :MLA_NOPE], apply_rope(q[..., MLA_NOPE:], cos, sin)], axis=-1)
    k = jnp.concatenate([k[..., :MLA_NOPE], apply_rope(k[..., MLA_NOPE:], cos, sin)], axis=-1)
    return block_causal_attention(q, k, v)


def rwkv7_mixer(p, mu, w0, w2, a0, a2, g2, k_k, k_a, r_k, ln_w, ln_b, v_first, v_res):
    B, S, _ = p.shape
    H, N = RWKV_HEADS, RWKV_HEAD
    f32 = jnp.float32
    p = p.astype(f32)
    p_prev = jnp.pad(p[:, :-1], ((0, 0), (1, 0), (0, 0)))
    pm = p + (p_prev - p) * mu.astype(f32)
    r, k, v, wl, al, gl = _split(pm, (RWKV_W, RWKV_W, RWKV_W, RWKV_W_LORA, RWKV_A_LORA, RWKV_G_LORA))
    w = -jax.nn.softplus(-(w0.astype(f32) + jnp.tanh(wl) @ w2.astype(f32))) - 0.5
    decay = jnp.exp(-jnp.exp(w))
    a = jax.nn.sigmoid(a0.astype(f32) + al @ a2.astype(f32))
    g = jax.nn.sigmoid(gl) @ g2.astype(f32)
    if v_res is None:
        v_first = v
    else:
        v0, v1, v2 = v_res
        v = v + (v_first - v) * jax.nn.sigmoid(v0.astype(f32) + (v @ v1.astype(f32)) @ v2.astype(f32))
    rh = r.reshape(B, S, H, N)
    kh = k.reshape(B, S, H, N)
    vh = v.reshape(B, S, H, N)
    ah = a.reshape(B, S, H, N)
    dh = decay.reshape(B, S, H, N)
    kk = kh * k_k.astype(f32).reshape(H, N)
    kk = kk / jnp.maximum(jnp.sqrt(jnp.sum(kk * kk, axis=-1, keepdims=True)), 1e-12)
    kh = kh * (1.0 + (ah - 1.0) * k_a.astype(f32).reshape(H, N))

    def step(state, inp):
        r_t, w_t, k_t, v_t, a_t, b_t = inp
        sa = jnp.einsum('bhij,bhj->bhi', state, a_t)
        state = state * w_t[:, :, None, :] + sa[..., None] * b_t[:, :, None, :] + v_t[..., None] * k_t[:, :, None, :]
        return state, jnp.einsum('bhij,bhj->bhi', state, r_t)

    xs = (jnp.moveaxis(rh, 1, 0), jnp.moveaxis(dh, 1, 0), jnp.moveaxis(kh, 1, 0),
          jnp.moveaxis(vh, 1, 0), jnp.moveaxis(-kk, 1, 0), jnp.moveaxis(kk * ah, 1, 0))
    _, ys = lax.scan(step, jnp.zeros((B, H, N, N), f32), xs)
    y = jnp.moveaxis(ys, 0, 1)
    y = head_layer_norm(y, RWKV_GN_EPS) * ln_w.astype(f32).reshape(H, N) + ln_b.astype(f32).reshape(H, N)
    y = y + jnp.sum(rh * kh * r_k.astype(f32), axis=-1, keepdims=True) * vh
    return y.reshape(B, S, H * N) * g, v_first


def setup_inputs(seed: int = 0) -> dict:
    key = jax.random.key(seed)
    k = jax.random.split(key, 40)
    f32 = jnp.float32

    def nrm(i, shape, scale):
        return jax.random.normal(k[i], shape, f32) * scale

    def gain(i, shape):
        return 1.0 + nrm(i, shape, 0.02)

    x = jax.random.normal(k[0], (BATCH, SEQ, D_MODEL), f32)
    offset = jax.random.randint(k[1], (BATCH, 1), 0, 4096, dtype=jnp.int32)
    positions = (offset + jnp.arange(SEQ, dtype=jnp.int32)[None, :]).astype(jnp.int32)
    u = jax.random.uniform(k[6], (DEPTH, SSM_HEADS), f32)
    dt0 = jnp.exp(u * (jnp.log(0.1) - jnp.log(0.001)) + jnp.log(0.001))
    return {
        "x": x,
        "positions": positions,
        "norm1_w": gain(2, (DEPTH, D_MODEL)),
        "w_in": nrm(3, (DEPTH, D_MODEL, N_IN), D_MODEL ** -0.5),
        "ret_gn_w": gain(4, (DEPTH, RET_HEADS * RET_DV)),
        "ssm_conv_w": nrm(5, (DEPTH, SSM_CONV, SSM_XBC), SSM_CONV ** -0.5),
        "ssm_conv_b": nrm(7, (DEPTH, SSM_XBC), 0.02),
        "ssm_dt_bias": dt0 + jnp.log(-jnp.expm1(-dt0)),
        "ssm_a_log": jnp.log(jax.random.uniform(k[8], (DEPTH, SSM_HEADS), f32, 1.0, 16.0)),
        "ssm_d": 1.0 + nrm(9, (DEPTH, SSM_HEADS), 0.1),
        "ssm_norm_w": gain(10, (DEPTH, SSM_HEADS * SSM_HEADDIM)),
        "mla_q_a_norm_w": gain(11, (DEPTH, MLA_Q_RANK)),
        "mla_w_qb": nrm(12, (DEPTH, MLA_Q_RANK, MLA_HEADS * MLA_QK), MLA_Q_RANK ** -0.5),
        "mla_kv_a_norm_w": gain(13, (DEPTH, MLA_KV_RANK)),
        "mla_w_kvb": nrm(14, (DEPTH, MLA_KV_RANK, MLA_HEADS * (MLA_NOPE + MLA_V)), MLA_KV_RANK ** -0.5),
        "mla_q_norm_w": gain(15, (DEPTH, MLA_QK)),
        "mla_k_norm_w": gain(16, (DEPTH, MLA_QK)),
        "rwkv_mu": jax.random.uniform(k[17], (DEPTH, RWKV_COLS), f32),
        "rwkv_w0": jax.random.uniform(k[18], (DEPTH, RWKV_W), f32, -6.0, -1.0),
        "rwkv_w2": nrm(19, (DEPTH, RWKV_W_LORA, RWKV_W), 0.1),
        "rwkv_a0": nrm(20, (DEPTH, RWKV_W), 0.1),
        "rwkv_a2": nrm(21, (DEPTH, RWKV_A_LORA, RWKV_W), RWKV_A_LORA ** -0.5),
        "rwkv_g2": nrm(22, (DEPTH, RWKV_G_LORA, RWKV_W), RWKV_G_LORA ** -0.5),
        "rwkv_v0": nrm(23, (DEPTH - 1, RWKV_W), 0.1),
        "rwkv_v1": nrm(24, (DEPTH - 1, RWKV_W, RWKV_V_LORA), RWKV_W ** -0.5),
        "rwkv_v2": nrm(25, (DEPTH - 1, RWKV_V_LORA, RWKV_W), 0.1),
        "rwkv_k_k": 0.85 + nrm(26, (DEPTH, RWKV_W), 0.02),
        "rwkv_k_a": gain(27, (DEPTH, RWKV_W)),
        "rwkv_r_k": nrm(28, (DEPTH, RWKV_HEADS, RWKV_HEAD), 0.1),
        "rwkv_ln_w": gain(29, (DEPTH, RWKV_W)),
        "rwkv_ln_b": nrm(30, (DEPTH, RWKV_W), 0.02),
        "w_branch": nrm(31, (DEPTH, N_BRANCH, BRANCH_W, D_MODEL), BRANCH_W ** -0.5),
        "w_out": nrm(32, (DEPTH, D_MODEL, D_MODEL), D_MODEL ** -0.5),
        "norm2_w": gain(33, (DEPTH, D_MODEL)),
        "ffn_w_gu": nrm(34, (DEPTH, D_MODEL, 2 * D_FF), D_MODEL ** -0.5),
        "ffn_w_down": nrm(35, (DEPTH, D_FF, D_MODEL), D_FF ** -0.5),
    }


def reference(x, positions, norm1_w, w_in, ret_gn_w, ssm_conv_w, ssm_conv_b, ssm_dt_bias, ssm_a_log, ssm_d,
              ssm_norm_w, mla_q_a_norm_w, mla_w_qb, mla_kv_a_norm_w, mla_w_kvb, mla_q_norm_w, mla_k_norm_w,
              rwkv_mu, rwkv_w0, rwkv_w2, rwkv_a0, rwkv_a2, rwkv_g2, rwkv_v0, rwkv_v1, rwkv_v2, rwkv_k_k, rwkv_k_a,
              rwkv_r_k, rwkv_ln_w, rwkv_ln_b, w_branch, w_out, norm2_w, ffn_w_gu, ffn_w_down):
    B, S, D = x.shape
    cos_ret, sin_ret = rope_tables(positions, RET_DK)
    cos_mla, sin_mla = rope_tables(positions, MLA_ROPE)
    v_first = None
    for l in range(DEPTH):
        h = rms_norm(x, norm1_w[l])
        pin = h @ w_in[l]
        (rq, rk, rv, rg, sz, sxbc, sdt, cq, ckv, krope, rw, gate_pre) = _split(pin, IN_SIZES)
        o_a = retention_mixer(rq, rk, rv, rg, cos_ret, sin_ret, ret_gn_w[l])
        o_b = mamba2_mixer(sz, sxbc, sdt, ssm_conv_w[l], ssm_conv_b[l], ssm_dt_bias[l], ssm_a_log[l],
                           ssm_d[l], ssm_norm_w[l])
        o_c = mla_mixer(cq, ckv, krope, cos_mla, sin_mla, mla_q_a_norm_w[l], mla_w_qb[l], mla_kv_a_norm_w[l],
                        mla_w_kvb[l], mla_q_norm_w[l], mla_k_norm_w[l])
        v_res = None if l == 0 else (rwkv_v0[l - 1], rwkv_v1[l - 1], rwkv_v2[l - 1])
        o_d, v_first = rwkv7_mixer(rw, rwkv_mu[l], rwkv_w0[l], rwkv_w2[l], rwkv_a0[l], rwkv_a2[l], rwkv_g2[l],
                                   rwkv_k_k[l], rwkv_k_a[l], rwkv_r_k[l], rwkv_ln_w[l], rwkv_ln_b[l], v_first, v_res)
        o = jnp.stack([o_a.astype(x.dtype), o_b.astype(x.dtype), o_c.astype(x.dtype), o_d.astype(x.dtype)], axis=2)
        br = jnp.einsum('bsnc,ncd->bsnd', o, w_branch[l])
        gates = jax.nn.sigmoid(gate_pre.reshape(B, S, N_BRANCH, D))
        merged = jnp.sum(gates * br, axis=2)
        x = x + (merged @ w_out[l]).astype(x.dtype)
        h2 = rms_norm(x, norm2_w[l])
        gt, up = jnp.split(h2 @ ffn_w_gu[l], 2, axis=-1)
        x = x + ((jax.nn.silu(gt) * up) @ ffn_w_down[l]).astype(x.dtype)
    return x
```

```cpp
#include <hip/hip_runtime.h>
#include <cstdio>
#include <cstdint>

#define GAS __attribute__((address_space(1)))
#define LAS __attribute__((address_space(3)))
typedef unsigned short bf16;
typedef short bf16x8 __attribute__((ext_vector_type(8)));
typedef short s16x4 __attribute__((ext_vector_type(4)));
typedef float f32x4 __attribute__((ext_vector_type(4)));
typedef float f32x2 __attribute__((ext_vector_type(2)));
typedef unsigned u32x4 __attribute__((ext_vector_type(4)));
typedef unsigned u32x2 __attribute__((ext_vector_type(2)));
typedef GAS unsigned gu32;
#define RLX_AGENT __ATOMIC_RELAXED, __HIP_MEMORY_SCOPE_AGENT
#define DI __device__ __forceinline__

constexpr int S = 8192, D = 2048, DEPTH = 4, NIN = 14408, NINP = 14592, DFF = 5632;
constexpr int NCH = 128;
constexpr float LOG2E = 1.4426950408889634f;

DI float bf2f(unsigned v) { return __uint_as_float(v << 16); }
DI unsigned f2bf(float f) { unsigned u = __float_as_uint(f); return (u + 0x7fffu + ((u >> 16) & 1u)) >> 16; }
DI unsigned pk2(float lo, float hi) { unsigned r; asm volatile("v_cvt_pk_bf16_f32 %0, %1, %2" : "=v"(r) : "v"(lo), "v"(hi)); return r; }
DI float sigmoidf_(float x) { return 1.0f / (1.0f + __expf(-x)); }
DI float siluf_(float x) { return x / (1.0f + __expf(-x)); }
DI float softplusf_(float x) { return fmaxf(x, 0.f) + log1pf(__expf(-fabsf(x))); }
DI u32x4 pack8(const f32x4 a, const f32x4 b) { u32x4 w; w.x = pk2(a[0], a[1]); w.y = pk2(a[2], a[3]); w.z = pk2(b[0], b[1]); w.w = pk2(b[2], b[3]); return w; }
DI void unpack8(const u32x4 w, float (&o)[8]) { o[0] = bf2f(w.x & 0xffffu); o[1] = bf2f(w.x >> 16); o[2] = bf2f(w.y & 0xffffu); o[3] = bf2f(w.y >> 16);
    o[4] = bf2f(w.z & 0xffffu); o[5] = bf2f(w.z >> 16); o[6] = bf2f(w.w & 0xffffu); o[7] = bf2f(w.w >> 16); }

namespace pg8 {
constexpr int BM = 256, BK = 64, HALF = 128, HTB = HALF * BK * 2, STAGE_BYTES = 8 * HTB, NXCD = 8, WGM = 8;
DI int lds_byte(int r, int c) { const int st = (r >> 4) * 2 + (c >> 5), rr = r & 15, cc = c & 31, ob = rr * 64 + cc * 2; return st * 1024 + (ob ^ (((ob >> 9) & 1) << 5)); }
DI void stage_rc(int b, int& R, int& C) { const int st = b / 1024, sb = b % 1024, swz = sb ^ (((sb >> 9) & 1) << 5); R = (st >> 1) * 16 + swz / 64; C = (st & 1) * 32 + (swz % 64) / 2; }
DI int perm32(int rho) { const int n = rho >> 4, i = rho & 15; return 8 * (i >> 2) + 4 * n + (i & 3); }

struct Unit { int pm, pn, ak, brow, sub; };
struct Gemm { const bf16* A; const bf16* Bt; int K, lda, ldb; };

struct StaticOrder {
    int nM, nN, nwg, G, c;
    DI void init(int M, int N, int G_, int c_) { nM = M / BM; nN = N / BM; nwg = nM * nN; G = G_; c = c_; }
    DI bool next(int i, Unit& u) const {
        const long L = (long)i * G + c; if (L >= nwg) return false;
        int wgid = (int)L; { const int q = nwg / NXCD, r = nwg % NXCD, xcd = wgid % NXCD, off = wgid / NXCD; wgid = (xcd < r ? xcd * (q + 1) : r * (q + 1) + (xcd - r) * q) + off; }
        const int nig = WGM * nN, gid = wgid / nig, fm = gid * WGM, gsz = (nM - fm) < WGM ? (nM - fm) : WGM;
        u.pm = fm + ((wgid % nig) % gsz); u.pn = (wgid % nig) / gsz; u.ak = 0; u.brow = u.pn * BM; u.sub = 0; return true;
    }
};
struct BranchOrder {
    StaticOrder so;
    DI void init(int G_, int c_) { so.init(S, D, G_, c_); }
    DI bool next(int i, Unit& u) const { if (!so.next(i >> 2, u)) return false; u.sub = i & 3; u.ak = u.sub * 512; u.brow = u.sub * D + u.pn * BM; return true; }
};

typedef f32x4 Acc[2][2][4][2];

template <class Epi, class Sched, bool ALIGN_EPI>
DI void gemm_phase(LAS unsigned char* lds, const Gemm g, const Sched& Sc, const Epi& E, const int tid) {
    const int wid = __builtin_amdgcn_readfirstlane(tid >> 6), lane = tid & 63, wr = wid >> 2, wc = wid & 3, fr = lane & 15, fq = lane >> 4;
    const int K = g.K, nt = K / BK;
    unsigned voffA[2], voffB[2];
#pragma unroll
    for (int i = 0; i < 2; ++i) { int R, C; stage_rc(tid * 16 + i * 8192, R, C); const int Rb = (R & ~31) + perm32(R & 31);
        voffA[i] = (unsigned)(R * g.lda + C) * 2u; voffB[i] = (unsigned)(Rb * g.ldb + C) * 2u; }
    const size_t kstep = (size_t)(BK * 2);
    const size_t hA = (size_t)HALF * g.lda * 2, hB = (size_t)HALF * g.ldb * 2;
    const unsigned ldsw = (unsigned)wid * 1024u;
    const int aoff = lds_byte(wr * 64 + fr, fq * 8), boff = lds_byte(wc * 32 + fr, fq * 8);
#define PG8_SA(b, h) (((b) * 2 + (h)) * HTB)
#define PG8_SB(b, h) ((4 + (b) * 2 + (h)) * HTB)
#define PG8_STAGE(bufoff, gbase, voff) do { _Pragma("unroll") for (int _i = 0; _i < 2; ++_i) \
        __builtin_amdgcn_global_load_lds((const unsigned*)((const char*)(gbase) + (voff)[_i]), (LAS unsigned*)(lds + (bufoff) + ldsw + _i * 8192), 16, 0, 0); } while (0)
#define PG8_LDA(dst, b, h) do { _Pragma("unroll") for (int m = 0; m < 4; ++m) _Pragma("unroll") for (int k = 0; k < 2; ++k) dst[m][k] = *(const LAS bf16x8*)(lds + PG8_SA(b, h) + aoff + m * 2048 + k * 1024); } while (0)
#define PG8_LDB(dst, b, h) do { _Pragma("unroll") for (int n = 0; n < 2; ++n) _Pragma("unroll") for (int k = 0; k < 2; ++k) dst[n][k] = *(const LAS bf16x8*)(lds + PG8_SB(b, h) + boff + n * 2048 + k * 1024); } while (0)
#define PG8_MMA(ai, bj, At, Bt) do { __builtin_amdgcn_s_setprio(1); _Pragma("unroll") for (int m = 0; m < 4; ++m) _Pragma("unroll") for (int n = 0; n < 2; ++n) _Pragma("unroll") for (int k = 0; k < 2; ++k) \
        acc[ai][bj][m][n] = __builtin_amdgcn_mfma_f32_16x16x32_bf16(Bt[n][k], At[m][k], acc[ai][bj][m][n], 0, 0, 0); __builtin_amdgcn_s_setprio(0); } while (0)
#define PG8_WAIT_V(n) asm volatile("s_waitcnt vmcnt(" #n ")" ::: "memory")
#define PG8_WAIT_L(n) asm volatile("s_waitcnt lgkmcnt(" #n ")" ::: "memory")
#define PG8_BAR __builtin_amdgcn_s_barrier()
#define PG8_SCHED __builtin_amdgcn_sched_barrier(0)
    Unit cur, nxt; int ui = 0;
    if (!Sc.next(0, cur)) return;
    Acc acc;
#pragma unroll
    for (int a = 0; a < 2; ++a)
#pragma unroll
        for (int b = 0; b < 2; ++b)
#pragma unroll
            for (int m = 0; m < 4; ++m)
#pragma unroll
                for (int n = 0; n < 2; ++n) acc[a][b][m][n] = (f32x4){0.f, 0.f, 0.f, 0.f};
    bf16x8 At[4][2], B0[2][2], B1[2][2];
    const char* cA = (const char*)g.A + ((size_t)cur.pm * BM * g.lda + cur.ak) * 2; const char* cB = (const char*)g.Bt + (size_t)cur.brow * g.ldb * 2;
    PG8_STAGE(PG8_SB(0, 0), cB, voffB); PG8_STAGE(PG8_SB(0, 1), cB + hB, voffB); PG8_STAGE(PG8_SA(0, 0), cA, voffA); PG8_STAGE(PG8_SA(0, 1), cA + hA, voffA);
    if (wr == 1) PG8_BAR;
    PG8_WAIT_V(2); PG8_BAR;
    PG8_STAGE(PG8_SB(1, 0), cB + kstep, voffB); PG8_STAGE(PG8_SA(1, 0), cA + kstep, voffA); PG8_STAGE(PG8_SB(1, 1), cB + hB + kstep, voffB);
    PG8_WAIT_V(6); PG8_BAR;
    for (;;) {
        const bool has_next = Sc.next(ui + 1, nxt);
        const char* nA = has_next ? (const char*)g.A + ((size_t)nxt.pm * BM * g.lda + nxt.ak) * 2 : cA; const char* nB = has_next ? (const char*)g.Bt + (size_t)nxt.brow * g.ldb * 2 : cB;
        for (int t = 0; t < nt; t += 2) {
            const bool last = (t == nt - 2);
            const char* a1 = cA + (size_t)(t + 1) * kstep;
            const char* a2 = last ? nA : cA + (size_t)(t + 2) * kstep; const char* b2 = last ? nB : cB + (size_t)(t + 2) * kstep;
            const char* a3 = a2 + kstep; const char* b3 = b2 + kstep;
            PG8_LDB(B0, 0, 0); PG8_LDB(B1, 0, 1); PG8_SCHED; PG8_LDA(At, 0, 0); PG8_STAGE(PG8_SA(1, 1), a1 + hA, voffA);
            PG8_WAIT_V(8); PG8_WAIT_L(0); PG8_BAR; PG8_MMA(0, 0, At, B0); PG8_MMA(0, 1, At, B1); PG8_BAR; PG8_SCHED;
            PG8_LDA(At, 0, 1); PG8_STAGE(PG8_SB(0, 0), b2, voffB); PG8_STAGE(PG8_SB(0, 1), b2 + hB, voffB); PG8_STAGE(PG8_SA(0, 0), a2, voffA);
            PG8_WAIT_V(8); PG8_WAIT_L(0); PG8_BAR; PG8_MMA(1, 0, At, B0); PG8_MMA(1, 1, At, B1); PG8_BAR; PG8_SCHED;
            PG8_LDB(B0, 1, 0); PG8_LDB(B1, 1, 1); PG8_SCHED; PG8_LDA(At, 1, 0); PG8_STAGE(PG8_SA(0, 1), a2 + hA, voffA);
            PG8_WAIT_V(8); PG8_WAIT_L(0); PG8_BAR; PG8_MMA(0, 0, At, B0); PG8_MMA(0, 1, At, B1); PG8_BAR; PG8_SCHED;
            PG8_LDA(At, 1, 1); PG8_STAGE(PG8_SB(1, 0), b3, voffB); PG8_STAGE(PG8_SB(1, 1), b3 + hB, voffB); PG8_STAGE(PG8_SA(1, 0), a3, voffA);
            PG8_WAIT_V(8); PG8_WAIT_L(0); PG8_BAR; PG8_MMA(1, 0, At, B0); PG8_MMA(1, 1, At, B1); PG8_BAR; PG8_SCHED;
        }
        if constexpr (ALIGN_EPI) { if (wr == 0) PG8_BAR; }
        bool zero = true;
        if constexpr (!Epi::AFTER_DRAIN) { zero = E(acc, cur, wr, wc, fr, fq); }
        if (!has_next) break;
        if (zero) {
#pragma unroll
        for (int a = 0; a < 2; ++a)
#pragma unroll
            for (int b = 0; b < 2; ++b)
#pragma unroll
                for (int m = 0; m < 4; ++m)
#pragma unroll
                    for (int n = 0; n < 2; ++n) acc[a][b][m][n] = (f32x4){0.f, 0.f, 0.f, 0.f};
        }
        cur = nxt; cA = nA; cB = nB; ++ui;
        if constexpr (ALIGN_EPI) { if (wr == 1) PG8_BAR; }
    }
    PG8_WAIT_V(0);
    if constexpr (!ALIGN_EPI) { if (wr == 0) PG8_BAR; }
    PG8_BAR;
    if constexpr (Epi::AFTER_DRAIN) { E.fused(acc, cur, wr, wc, fr, fq, lds, wid, lane, tid); }
#undef PG8_SA
#undef PG8_SB
#undef PG8_STAGE
#undef PG8_LDA
#undef PG8_LDB
#undef PG8_MMA
#undef PG8_WAIT_V
#undef PG8_WAIT_L
#undef PG8_BAR
#undef PG8_SCHED
}
}

constexpr size_t MiB = 1u << 20;
constexpr size_t al256(size_t x) { return (x + 255) & ~(size_t)255; }
constexpr size_t WS_CTL = 0, CTL_ZERO_BYTES = 1 * MiB;
constexpr size_t WS_PRM = 1 * MiB;
constexpr int P_N1 = 0, P_N2 = 2048, P_GN = 4096, P_CW = 4608, P_CB = 8704, P_DTB = 9728, P_ALOG = 9736, P_SD = 9744, P_SNW = 9760, P_QNW = 10272, P_KNW = 10464, P_MU = 10656,
              P_W0 = 12448, P_A0 = 12960, P_V0 = 13472, P_KK = 13984, P_KA = 14496, P_RK = 15008, P_LNW = 15520, P_LNB = 16032, PRM_STRIDE = 16640;
constexpr size_t WS_COSR = 2 * MiB;
constexpr size_t WS_SINR = WS_COSR + (size_t)S * 64 * 4;
constexpr size_t WS_COSM = WS_SINR + (size_t)S * 64 * 4;
constexpr size_t WS_SINM = WS_COSM + (size_t)S * 32 * 4;
constexpr size_t WS_WIN  = WS_SINM + (size_t)S * 32 * 4;
constexpr size_t WS_WQB  = WS_WIN + (size_t)DEPTH * NINP * D * 2;
constexpr size_t WS_WKVB = WS_WQB + (size_t)DEPTH * 1024 * 512 * 2;
constexpr size_t WS_WV1  = WS_WKVB + (size_t)DEPTH * 1024 * 256 * 2;
constexpr size_t WS_WLORA = WS_WV1 + (size_t)DEPTH * 256 * 512 * 2;
constexpr size_t WS_WBR  = WS_WLORA + (size_t)DEPTH * 2048 * 512 * 2;
constexpr size_t WS_WOUT = WS_WBR + (size_t)DEPTH * 8192 * 512 * 2;
constexpr size_t WS_WGU  = WS_WOUT + (size_t)DEPTH * D * D * 2;
constexpr size_t WS_WDN  = WS_WGU + (size_t)DEPTH * 2 * DFF * D * 2;
constexpr size_t WS_ACT0 = WS_WDN + (size_t)DEPTH * D * DFF * 2;
constexpr size_t WS_XN   = WS_ACT0;
constexpr size_t WS_QR   = WS_XN + (size_t)S * D * 2;
constexpr size_t WS_KR   = WS_QR + (size_t)S * 512 * 2;
constexpr size_t WS_VR   = WS_KR + (size_t)S * 512 * 2;
constexpr size_t WS_GR   = WS_VR + (size_t)S * 512 * 2;
constexpr size_t WS_ZS   = WS_GR + (size_t)S * 512 * 2;
constexpr size_t WS_XBC  = WS_ZS + (size_t)S * 512 * 2;
constexpr size_t WS_XC   = WS_XBC + (size_t)S * 1024 * 2;
constexpr size_t WS_CQ   = WS_XC + (size_t)S * 1024 * 2;
constexpr size_t WS_CKV  = WS_CQ + (size_t)S * 512 * 2;
constexpr size_t WS_SSQ  = WS_CKV + (size_t)S * 256 * 2;
constexpr size_t WS_RW   = WS_SSQ + (size_t)S * 16 * 4;
constexpr size_t WS_GATE = WS_RW + (size_t)S * 1792 * 4;
constexpr size_t WS_MISC = WS_GATE + (size_t)S * 8192 * 2;
constexpr size_t WS_DTS  = WS_MISC + (size_t)S * 256 * 4;
constexpr size_t WS_ACS  = WS_DTS + (size_t)S * 8 * 4;
constexpr size_t WS_RKV  = WS_ACS + (size_t)S * 8 * 4;
constexpr size_t WS_MST  = WS_RKV + (size_t)NCH * 4 * 128 * 128 * 4;
constexpr size_t WS_QM   = WS_MST + (size_t)NCH * 8 * 64 * 128 * 4;
constexpr size_t WS_KM   = WS_QM + (size_t)S * 768 * 2;
constexpr size_t WS_VT   = WS_KM + (size_t)S * 768 * 2;
constexpr size_t WS_R32  = WS_VT + (size_t)512 * S * 2;
constexpr size_t SZ32    = (size_t)S * 512 * 4;
constexpr size_t WS_KKN  = WS_R32 + SZ32, WS_K32 = WS_KKN + SZ32, WS_VV = WS_K32 + SZ32, WS_VFIRST = WS_VV + SZ32, WS_DEC = WS_VFIRST + SZ32,
                 WS_KP = WS_DEC + SZ32, WS_BB = WS_KP + SZ32, WS_G32 = WS_BB + SZ32, WS_Y32 = WS_G32 + SZ32;
constexpr size_t WS_VB   = WS_Y32 + SZ32;
constexpr size_t WS_ALORA = WS_VB + (size_t)S * 512 * 2;
constexpr size_t WS_OB   = WS_ALORA + (size_t)S * 512 * 2;
constexpr size_t WS_MERGED = WS_OB + (size_t)S * D * 2;
constexpr size_t WS_ACT  = WS_MERGED + (size_t)S * D * 2;
constexpr size_t WS_END  = WS_ACT + (size_t)S * DFF * 2;

constexpr int CW_TMO = 0, CW_CODE = 1, CW_BAR = 4096;

constexpr int NWAVES = 8, NTHR = 512;
constexpr int RING_BYTES = 143360, LDSCTL_OFF = RING_BYTES, MISC_OFF = LDSCTL_OFF + 320, LDS_BYTES = 147456;
#define LDS_WAIT() asm volatile("s_waitcnt lgkmcnt(0)" ::: "memory")
#define VM_WAIT() asm volatile("s_waitcnt vmcnt(0)" ::: "memory")

#define XB_TMO      128
#define XB_XCNT(j)  (256  + 64 * (j))
#define XB_XSUB(j)  (1280 + 64 * (j))
#define XB_XGEN(j)  (2304 + 64 * (j))
#define XB_TOP      3328
#define XB_TOPGEN   3392
#define XCD_BAR_WORDS 3456
#define XB_SPIN_CAP (1u << 22)
DI unsigned xb_ld(unsigned* p)              { return __hip_atomic_load(p, __ATOMIC_RELAXED, __HIP_MEMORY_SCOPE_AGENT); }
DI unsigned xb_add(unsigned* p, unsigned v) { return __hip_atomic_fetch_add(p, v, __ATOMIC_RELAXED, __HIP_MEMORY_SCOPE_AGENT); }
DI unsigned xb_xcc_id() { return (unsigned)__builtin_amdgcn_s_getreg((3 << 11) | 20) & 0xFu; }
#define XB_SPIN(cond, bar) do { unsigned _sp = 0; while (cond) { __builtin_amdgcn_s_sleep(1); \
    if ((++_sp & 255u) == 0u) { if (xb_ld(&(bar)[XB_TMO])) break; if (_sp > XB_SPIN_CAP) { atomicAdd(&(bar)[XB_TMO], 1u); break; } } } } while (0)
struct XcdBarrier { unsigned* bar; unsigned x; volatile LAS unsigned* st; };
DI XcdBarrier xcd_barrier_post(unsigned* bar, volatile LAS unsigned* st) {
    XcdBarrier b; b.bar = bar; b.x = xb_xcc_id(); b.st = st;
    if (threadIdx.x == 0) (void)xb_add(&bar[XB_XCNT(b.x)], 1u);
    return b;
}
DI void xcd_barrier_complete(unsigned* bar, unsigned x, unsigned& nloc, unsigned& nx) {
    const unsigned G = gridDim.x * gridDim.y * gridDim.z;
    unsigned sum, cnt, mine, sp = 0u;
    for (;;) {
        sum = 0u; cnt = 0u; mine = 0u;
#pragma unroll
        for (unsigned j = 0; j < 16; ++j) { const unsigned c = xb_ld(&bar[XB_XCNT(j)]); sum += c; cnt += (c > 0u) ? 1u : 0u; mine = (j == x) ? c : mine; }
        if (sum == G) break;
        __builtin_amdgcn_s_sleep(1);
        if ((++sp & 255u) == 0u) { if (xb_ld(&bar[XB_TMO])) break; if (sp > XB_SPIN_CAP) { atomicAdd(&bar[XB_TMO], 1u); break; } }
    }
    nloc = mine > 0u ? mine : 1u; nx = cnt > 0u ? cnt : 1u;
}
DI void xcd_barrier(const XcdBarrier& b) {
    asm volatile("s_waitcnt vmcnt(0)" ::: "memory");
    __syncthreads();
    if (threadIdx.x == 0) {
        unsigned* bar = b.bar;
        __builtin_amdgcn_s_waitcnt(0);
        unsigned nloc = b.st[0], nx = b.st[1];
        if (nloc == 0u) { xcd_barrier_complete(bar, b.x, nloc, nx); b.st[0] = nloc; b.st[1] = nx; }
        const unsigned old = xb_add(&bar[XB_XSUB(b.x)], 1u);
        const unsigned gen = old / nloc;
        if (old + 1u == (gen + 1u) * nloc) {
            __builtin_amdgcn_fence(__ATOMIC_RELEASE, "agent");
            asm volatile("s_waitcnt vmcnt(0)" ::: "memory");
            const unsigned og = xb_add(&bar[XB_TOP], 1u);
            const unsigned tg = og / nx;
            if (og + 1u == (tg + 1u) * nx) xb_add(&bar[XB_TOPGEN], 1u);
            else XB_SPIN(xb_ld(&bar[XB_TOPGEN]) == tg, bar);
            __builtin_amdgcn_fence(__ATOMIC_ACQUIRE, "agent");
            xb_add(&bar[XB_XGEN(b.x)], 1u);
            asm volatile("s_waitcnt vmcnt(0)" ::: "memory");
        } else {
            XB_SPIN(xb_ld(&bar[XB_XGEN(b.x)]) == gen, bar);
            __builtin_amdgcn_fence(__ATOMIC_ACQUIRE, "agent");
            asm volatile("s_waitcnt vmcnt(0)" ::: "memory");
        }
    }
    __syncthreads();
}

struct Args { const float* in[36]; float* out; unsigned char* ws; int st_lo, st_hi; };
struct Frame {
    LAS unsigned char* lds; volatile LAS unsigned* MISC; gu32* ctl;
    int tid, lane, wave, G, bid;
    unsigned char* ws;
};
DI void relaunder(Frame& F, unsigned char* ws0, LAS unsigned char* lds0) {
    int t = threadIdx.x; asm volatile("" : "+v"(t)); F.tid = t; F.lane = t & 63; F.wave = __builtin_amdgcn_readfirstlane(t >> 6);
    unsigned long long w = (unsigned long long)ws0; asm volatile("" : "+s"(w)); F.ws = (unsigned char*)w; F.ctl = (gu32*)(F.ws + WS_CTL);
    unsigned lb = (unsigned)(unsigned long)lds0; asm volatile("" : "+s"(lb)); F.lds = (LAS unsigned char*)(unsigned long)lb; F.MISC = (volatile LAS unsigned*)(F.lds + MISC_OFF);
    int b = blockIdx.x; asm volatile("" : "+s"(b)); F.bid = b;
}
DI float wave_sum(float v) {
#pragma unroll
    for (int o = 1; o < 64; o <<= 1) v += __shfl_xor(v, o);
    return v;
}
template <int CTRL> DI float dpp_f(float v) { return __builtin_bit_cast(float, __builtin_amdgcn_update_dpp(0, __builtin_bit_cast(int, v), CTRL, 0xf, 0xf, true)); }
DI float row_sum16(float v) { v += dpp_f<0xB1>(v); v += dpp_f<0x4E>(v); v += dpp_f<0x141>(v); v += dpp_f<0x140>(v); return v; }
DI float wave_sum_dpp(float v) {
    const float t = row_sum16(v);
    const float s0 = __builtin_bit_cast(float, __builtin_amdgcn_readlane(__builtin_bit_cast(int, t), 0));
    const float s1 = __builtin_bit_cast(float, __builtin_amdgcn_readlane(__builtin_bit_cast(int, t), 16));
    const float s2 = __builtin_bit_cast(float, __builtin_amdgcn_readlane(__builtin_bit_cast(int, t), 32));
    const float s3 = __builtin_bit_cast(float, __builtin_amdgcn_readlane(__builtin_bit_cast(int, t), 48));
    return (s0 + s1) + (s2 + s3);
}

DI int map_in(int n) {
    const int T = n >> 8, c = n & 255;
    if (T < 4) { const int base = (T >> 1) * 512, tp = T & 1, half = c >> 7, hs = (c >> 6) & 1, j = c & 63; return base + (2 * tp + hs) * 128 + half * 64 + j; }
    if (T < 6) return 1024 + (T - 4) * 256 + c;
    if (T < 8) return 1536 + (T - 6) * 256 + c;
    if (T < 10) return 2048 + (T - 8) * 256 + c;
    if (T < 14) return 2560 + (T - 10) * 256 + c;
    if (T < 16) return 3592 + (T - 14) * 256 + c;
    if (T == 16) return 4104 + c;
    if (T < 24) return 4424 + (T - 17) * 256 + c;
    if (T < 56) return 6216 + (T - 24) * 256 + c;
    if (c < 8) return 3584 + c;
    if (c < 72) return 4360 + (c - 8);
    return -1;
}
DI int map_fn(int mapid, int n, int Nsrc) {
    if (mapid == 0) return n < Nsrc ? n : -1;
    if (mapid == 1) return map_in(n);
    if (mapid == 2) { const int T = n >> 8, c = n & 255; return c < 128 ? T * 128 + c : DFF + T * 128 + (c - 128); }
    if (mapid == 3) { const int h = n >> 8, c = n & 255; if (c < 96) return h * 192 + c; if (c < 128) return h * 192 + 128 + (c - 96); if (c < 160) return h * 192 + 96 + (c - 128); if (c < 224) return -1; return h * 192 + 160 + (c - 224); }
    return n < 32 ? n : -1;
}
DI void conv_item(const float* W, int K, int Nsrc, bf16* Wt, const float* kscale, int mapid, LAS float* scr, int item, int nblk, int lane) {
    const int kb = item / nblk, nb = item - kb * nblk, k0 = 64 * kb, n0 = 32 * nb;
    const int src = map_fn(mapid, n0 + (lane & 31), Nsrc);
#pragma unroll 8
    for (int i = 0; i < 32; ++i) { const int kk = 2 * i + (lane >> 5); float v = 0.f; if (src >= 0) v = W[(size_t)(k0 + kk) * Nsrc + src]; if (kscale) v *= kscale[k0 + kk]; scr[kk * 33 + (lane & 31)] = v; }
    LDS_WAIT(); asm volatile("" ::: "memory");
    const int c = lane & 7;
#pragma unroll
    for (int j = 0; j < 4; ++j) { const int n = (lane >> 3) + 8 * j; const LAS float* s = scr + (8 * c) * 33 + n;
        u32x4 o; o.x = pk2(s[0 * 33], s[1 * 33]); o.y = pk2(s[2 * 33], s[3 * 33]); o.z = pk2(s[4 * 33], s[5 * 33]); o.w = pk2(s[6 * 33], s[7 * 33]);
        *(GAS u32x4*)(Wt + (size_t)(n0 + n) * K + k0 + 8 * c) = o; }
    LDS_WAIT(); asm volatile("" ::: "memory");
}
struct ConvJob { const float* W; bf16* Wt; const float* kscale; int K, Nsrc, Ndst, mapid; };
DI void conv_job(Frame& F, const ConvJob j, int& base) {
    LAS float* scr = (LAS float*)(F.lds + F.wave * 16384);
    const int nblk = j.Ndst / 32, nitems = (j.K / 64) * nblk, NGW = F.G * NWAVES, gw = F.bid * NWAVES + F.wave;
    int first = (gw - base % NGW + NGW) % NGW;
    for (int it = first; it < nitems; it += NGW) conv_item(j.W, j.K, j.Nsrc, j.Wt, j.kscale, j.mapid, scr, it, nblk, F.lane);
    base += nitems;
}
DI void p_prologue(Frame& F, const Args& a) {
    unsigned char* ws = F.ws;
    const int gt = F.bid * NTHR + F.tid, NGT = F.G * NTHR;
    { float* prm = (float*)(ws + WS_PRM);
#define CPV(IDX, N, OFF, SRC_L) for (int e = gt; e < (N); e += NGT) prm[(size_t)l * PRM_STRIDE + (OFF) + e] = a.in[IDX][(size_t)(SRC_L) * (N) + e];
      for (int l = 0; l < DEPTH; ++l) {
          CPV(2, 2048, P_N1, l) CPV(33, 2048, P_N2, l) CPV(4, 512, P_GN, l) CPV(5, 4096, P_CW, l) CPV(6, 1024, P_CB, l) CPV(7, 8, P_DTB, l) CPV(8, 8, P_ALOG, l) CPV(9, 8, P_SD, l)
          CPV(10, 512, P_SNW, l) CPV(15, 192, P_QNW, l) CPV(16, 192, P_KNW, l) CPV(17, 1792, P_MU, l) CPV(18, 512, P_W0, l) CPV(20, 512, P_A0, l)
          CPV(23, 512, P_V0, (l > 0 ? l - 1 : 0)) CPV(26, 512, P_KK, l) CPV(27, 512, P_KA, l) CPV(28, 512, P_RK, l) CPV(29, 512, P_LNW, l) CPV(30, 512, P_LNB, l)
      }
#undef CPV
    }
    const int* pos = (const int*)a.in[1];
    for (int e = gt; e < S * 64; e += NGT) { const int t = e >> 6, i = e & 63;
        const float inv = 1.0f / powf(10000.0f, (float)(2 * i) / 128.0f); const float ang = (float)pos[t] * inv;
        double rev = (double)ang * 0.15915494309189535; rev -= rint(rev); const float r = (float)(rev * 6.283185307179586);
        ((float*)(ws + WS_COSR))[e] = __cosf(r); ((float*)(ws + WS_SINR))[e] = __sinf(r); }
    for (int e = gt; e < S * 32; e += NGT) { const int t = e >> 5, i = e & 31;
        const float inv = 1.0f / powf(10000.0f, (float)(2 * i) / 64.0f); const float ang = (float)pos[t] * inv;
        double rev = (double)ang * 0.15915494309189535; rev -= rint(rev); const float r = (float)(rev * 6.283185307179586);
        ((float*)(ws + WS_COSM))[e] = __cosf(r); ((float*)(ws + WS_SINM))[e] = __sinf(r); }
    for (int l = 0; l < DEPTH; ++l) {
        const float* w2 = a.in[19] + (size_t)l * 64 * 512; const float* a2 = a.in[21] + (size_t)l * 64 * 512; const float* g2 = a.in[22] + (size_t)l * 128 * 512;
        const float* v2 = a.in[25] + (size_t)(l > 0 ? l - 1 : 0) * 32 * 512;
        bf16* Lt = (bf16*)(ws + WS_WLORA) + (size_t)l * 2048 * 512;
        for (int w = gt; w < 2048 * 64; w += NGT) { const int kg = w >> 11, n = w & 2047, seg = n >> 9, j = n & 511; float v[8];
#pragma unroll
            for (int i = 0; i < 8; ++i) { const int k = kg * 8 + i; float x = 0.f;
                if (seg == 0) { if (k < 64) x = w2[k * 512 + j]; }
                else if (seg == 1) { if (k >= 128 && k < 192) x = a2[(k - 128) * 512 + j]; }
                else if (seg == 2) { if (k >= 256 && k < 384) x = g2[(k - 256) * 512 + j]; }
                else { if (l > 0 && k >= 384 && k < 416) x = v2[(k - 384) * 512 + j]; }
                v[i] = x; }
            u32x4 o; o.x = pk2(v[0], v[1]); o.y = pk2(v[2], v[3]); o.z = pk2(v[4], v[5]); o.w = pk2(v[6], v[7]);
            *(GAS u32x4*)(Lt + (size_t)n * 512 + kg * 8) = o; }
    }
    int base = 0;
    for (int l = 0; l < DEPTH; ++l) {
        conv_job(F, ConvJob{a.in[3] + (size_t)l * D * NIN, (bf16*)(ws + WS_WIN) + (size_t)l * NINP * D, nullptr, D, NIN, NINP, 1}, base);
        conv_job(F, ConvJob{a.in[34] + (size_t)l * D * 2 * DFF, (bf16*)(ws + WS_WGU) + (size_t)l * 2 * DFF * D, nullptr, D, 2 * DFF, 2 * DFF, 2}, base);
        conv_job(F, ConvJob{a.in[35] + (size_t)l * DFF * D, (bf16*)(ws + WS_WDN) + (size_t)l * D * DFF, nullptr, DFF, D, D, 0}, base);
        conv_job(F, ConvJob{a.in[32] + (size_t)l * D * D, (bf16*)(ws + WS_WOUT) + (size_t)l * D * D, nullptr, D, D, D, 0}, base);
        for (int n = 0; n < 4; ++n)
            conv_job(F, ConvJob{a.in[31] + ((size_t)l * 4 + n) * 512 * D, (bf16*)(ws + WS_WBR) + ((size_t)l * 4 + n) * D * 512, nullptr, 512, D, D, 0}, base);
        conv_job(F, ConvJob{a.in[12] + (size_t)l * 512 * 768, (bf16*)(ws + WS_WQB) + (size_t)l * 1024 * 512, a.in[11] + (size_t)l * 512, 512, 768, 1024, 3}, base);
        conv_job(F, ConvJob{a.in[14] + (size_t)l * 256 * 1024, (bf16*)(ws + WS_WKVB) + (size_t)l * 1024 * 256, a.in[13] + (size_t)l * 256, 256, 1024, 1024, 0}, base);
        if (l > 0) conv_job(F, ConvJob{a.in[24] + (size_t)(l - 1) * 512 * 32, (bf16*)(ws + WS_WV1) + (size_t)l * 256 * 512, nullptr, 512, 32, 256, 4}, base);
    }
}

DI void p_rmsnorm(Frame& F, const float* x, const float* w, bf16* out) {
    const int gw = F.bid * NWAVES + F.wave, NGW = F.G * NWAVES;
    for (int m = gw; m < S; m += NGW) {
        const GAS f32x4* xr = (const GAS f32x4*)(x + (size_t)m * D) + F.lane; f32x4 v[8]; float s = 0.f;
#pragma unroll
        for (int j = 0; j < 8; ++j) { v[j] = xr[64 * j]; s += (v[j].x * v[j].x + v[j].y * v[j].y) + (v[j].z * v[j].z + v[j].w * v[j].w); }
        const float rstd = rsqrtf(wave_sum(s) * (1.f / D) + 1e-6f);
        const GAS f32x4* wr = (const GAS f32x4*)w + F.lane;
        GAS u32x2* o8 = (GAS u32x2*)(out + (size_t)m * D) + F.lane;
#pragma unroll
        for (int j = 0; j < 8; ++j) { const f32x4 ww = wr[64 * j]; u32x2 o; o.x = pk2(v[j].x * rstd * ww.x, v[j].y * rstd * ww.y); o.y = pk2(v[j].z * rstd * ww.z, v[j].w * rstd * ww.w); o8[64 * j] = o; }
    }
}

DI void p_rwkv_prep(Frame& F, int l) {
    unsigned char* ws = F.ws;
    const float* RW = (const float*)(ws + WS_RW); const float* prm = (const float*)(ws + WS_PRM) + (size_t)l * PRM_STRIDE; const float* mu = prm + P_MU; const float* kk_w = prm + P_KK;
    const int gw = F.bid * NWAVES + F.wave, NGW = F.G * NWAVES, lane = F.lane;
    for (int t = gw; t < S; t += NGW) {
        const GAS f32x4* p = (const GAS f32x4*)(RW + (size_t)t * 1792) + lane; const GAS f32x4* pp = (const GAS f32x4*)(RW + (size_t)(t > 0 ? t - 1 : 0) * 1792) + lane;
        const GAS f32x4* m4 = (const GAS f32x4*)mu + lane;
        f32x4 pm[7];
#pragma unroll
        for (int j = 0; j < 7; ++j) { const f32x4 c = p[64 * j]; f32x4 pv = pp[64 * j]; if (t == 0) pv = (f32x4){0.f, 0.f, 0.f, 0.f}; pm[j] = c + (pv - c) * m4[64 * j]; }
        *((GAS f32x4*)((float*)(ws + WS_R32) + (size_t)t * 512) + lane) = pm[0]; *((GAS f32x4*)((float*)(ws + WS_R32) + (size_t)t * 512) + 64 + lane) = pm[1];
#pragma unroll
        for (int j = 0; j < 2; ++j) { const f32x4 k = pm[2 + j]; const f32x4 kw = *((const GAS f32x4*)kk_w + 64 * j + lane); const f32x4 kk = k * kw;
            float ss = (kk.x * kk.x + kk.y * kk.y) + (kk.z * kk.z + kk.w * kk.w);
            ss += __shfl_xor(ss, 1); ss += __shfl_xor(ss, 2); ss += __shfl_xor(ss, 4); ss += __shfl_xor(ss, 8);
            const float inv = 1.0f / fmaxf(sqrtf(ss), 1e-12f);
            *((GAS f32x4*)((float*)(ws + WS_K32) + (size_t)t * 512) + 64 * j + lane) = k;
            *((GAS f32x4*)((float*)(ws + WS_KKN) + (size_t)t * 512) + 64 * j + lane) = kk * inv; }
#pragma unroll
        for (int j = 0; j < 2; ++j) { const f32x4 v = pm[4 + j];
            *((GAS f32x4*)((float*)(ws + WS_VV) + (size_t)t * 512) + 64 * j + lane) = v;
            if (l == 0) *((GAS f32x4*)((float*)(ws + WS_VFIRST) + (size_t)t * 512) + 64 * j + lane) = v;
            u32x2 o; o.x = pk2(v.x, v.y); o.y = pk2(v.z, v.w); *((GAS u32x2*)((bf16*)(ws + WS_VB) + (size_t)t * 512) + 64 * j + lane) = o; }
        { const f32x4 x = pm[6]; f32x4 y; int dst;
            if (lane < 16) { y = (f32x4){tanhf(x.x), tanhf(x.y), tanhf(x.z), tanhf(x.w)}; dst = 4 * lane; }
            else if (lane < 32) { y = x; dst = 128 + 4 * (lane - 16); }
            else { y = (f32x4){sigmoidf_(x.x), sigmoidf_(x.y), sigmoidf_(x.z), sigmoidf_(x.w)}; dst = 256 + 4 * (lane - 32); }
            bf16* ar = (bf16*)(ws + WS_ALORA) + (size_t)t * 512;
            u32x2 o; o.x = pk2(y.x, y.y); o.y = pk2(y.z, y.w); *(GAS u32x2*)(ar + dst) = o;
            const int z = 4 * lane; const int zd = z < 64 ? 64 + z : (z < 128 ? 192 + (z - 64) : 384 + (z - 128));
            *(GAS u32x2*)(ar + zd) = (u32x2){0u, 0u}; }
    }
}

DI void p_mamba_prep(Frame& F, int l) {
    unsigned char* ws = F.ws;
    const bf16* XBC = (const bf16*)(ws + WS_XBC); bf16* XC = (bf16*)(ws + WS_XC);
    const float* prm = (const float*)(ws + WS_PRM) + (size_t)l * PRM_STRIDE; const float* cw = prm + P_CW; const float* cb = prm + P_CB;
    for (int c = F.bid; c < NCH; c += F.G) {
        const int ch = 2 * F.tid; const int t0 = c * 64;
        float w0[4], w1[4];
#pragma unroll
        for (int k = 0; k < 4; ++k) { w0[k] = cw[k * 1024 + ch]; w1[k] = cw[k * 1024 + ch + 1]; }
        const float b0 = cb[ch], b1 = cb[ch + 1];
        float h0[3], h1[3];
#pragma unroll
        for (int k = 0; k < 3; ++k) { const int t = t0 - 3 + k; unsigned u = 0u; if (t >= 0) u = *(const GAS unsigned*)(XBC + (size_t)t * 1024 + ch); h0[k] = bf2f(u & 0xffffu); h1[k] = bf2f(u >> 16); }
#pragma unroll 8
        for (int i = 0; i < 64; ++i) { const int t = t0 + i; const unsigned u = *(const GAS unsigned*)(XBC + (size_t)t * 1024 + ch); const float x0 = bf2f(u & 0xffffu), x1 = bf2f(u >> 16);
            const float y0 = b0 + w0[0] * h0[0] + w0[1] * h0[1] + w0[2] * h0[2] + w0[3] * x0, y1 = b1 + w1[0] * h1[0] + w1[1] * h1[1] + w1[2] * h1[2] + w1[3] * x1;
            h0[0] = h0[1]; h0[1] = h0[2]; h0[2] = x0; h1[0] = h1[1]; h1[1] = h1[2]; h1[2] = x1;
            *(GAS unsigned*)(XC + (size_t)t * 1024 + ch) = pk2(siluf_(y0), siluf_(y1)); }
        if (F.tid < 8) { const int h = F.tid; const float bias = prm[P_DTB + h], av = -__expf(prm[P_ALOG + h]); float cs = 0.f;
            const float* misc = (const float*)(ws + WS_MISC);
            for (int i = 0; i < 64; ++i) { const int t = t0 + i; const float dt = softplusf_(misc[(size_t)t * 256 + h] + bias); cs += dt * av;
                ((float*)(ws + WS_DTS))[(size_t)t * 8 + h] = dt; ((float*)(ws + WS_ACS))[(size_t)t * 8 + h] = cs; } }
    }
}

DI void p_scans(Frame& F) {
    unsigned char* ws = F.ws;
    const int gt = F.bid * NTHR + F.tid, NGT = F.G * NTHR;
    for (int e = gt; e < 131072; e += NGT) {
        if (e < 65536) {
            const int h = e >> 14; const float lg = log1pf(-exp2f(-5.0f - (float)h)); const float dec = __expf(lg * 64.0f);
            float* p = (float*)(ws + WS_RKV) + e; float st = 0.f;
#pragma unroll 8
            for (int c = 0; c < NCH; ++c) { const float v = p[(size_t)c * 65536]; p[(size_t)c * 65536] = st; st = dec * st + v; }
        } else {
            const int e2 = e - 65536, h = e2 >> 13; const float* acs = (const float*)(ws + WS_ACS);
            float* p = (float*)(ws + WS_MST) + e2; float st = 0.f;
#pragma unroll 8
            for (int c = 0; c < NCH; ++c) { const float v = p[(size_t)c * 65536]; const float dec = __expf(acs[(size_t)(c * 64 + 63) * 8 + h]); p[(size_t)c * 65536] = st; st = dec * st + v; }
        }
    }
}

DI void p_rwkv_scan(Frame& F, int nblk) {
    unsigned char* ws = F.ws;
    const int w = F.bid * NWAVES + F.wave; if (F.bid >= nblk) return;
    const int h = w >> 6, i = w & 63, lane = F.lane;
    const float* Ap = (const float*)(ws + WS_KKN) + h * 64 + lane; const float* Wp = (const float*)(ws + WS_DEC) + h * 64 + lane; const float* Bp = (const float*)(ws + WS_BB) + h * 64 + lane;
    const float* Kp = (const float*)(ws + WS_KP) + h * 64 + lane; const float* Rp = (const float*)(ws + WS_R32) + h * 64 + lane; const float* Vp = (const float*)(ws + WS_VV) + h * 64 + i;
    float* Yp = (float*)(ws + WS_Y32) + h * 64 + i;
    float s = 0.f;
    constexpr int U = 8;
    float ca[U], cw[U], cb[U], ck[U], cr[U], cv[U];
#pragma unroll
    for (int u = 0; u < U; ++u) { const size_t o = (size_t)u * 512; ca[u] = Ap[o]; cw[u] = Wp[o]; cb[u] = Bp[o]; ck[u] = Kp[o]; cr[u] = Rp[o]; cv[u] = Vp[o]; }
    for (int t0 = 0; t0 < S; t0 += U) {
        float na[U], nw[U], nb[U], nk[U], nr[U], nv[U];
        const int tn = (t0 + U < S) ? t0 + U : t0;
#pragma unroll
        for (int u = 0; u < U; ++u) { const size_t o = (size_t)(tn + u) * 512; na[u] = Ap[o]; nw[u] = Wp[o]; nb[u] = Bp[o]; nk[u] = Kp[o]; nr[u] = Rp[o]; nv[u] = Vp[o]; }
        float ys[U];
#pragma unroll
        for (int u = 0; u < U; ++u) {
            const float sa = wave_sum_dpp(s * (-ca[u]));
            s = s * cw[u] + sa * cb[u] + cv[u] * ck[u];
            ys[u] = wave_sum_dpp(s * cr[u]);
        }
        if (lane < U) { float y = ys[0];
#pragma unroll
            for (int u = 1; u < U; ++u) y = (lane == u) ? ys[u] : y;
            Yp[(size_t)(t0 + lane) * 512] = y; }
#pragma unroll
        for (int u = 0; u < U; ++u) { ca[u] = na[u]; cw[u] = nw[u]; cb[u] = nb[u]; ck[u] = nk[u]; cr[u] = nr[u]; cv[u] = nv[u]; }
    }
}

DI void p_rwkv_post(Frame& F, int l) {
    unsigned char* ws = F.ws;
    const float* prm = (const float*)(ws + WS_PRM) + (size_t)l * PRM_STRIDE; const float* lnw = prm + P_LNW; const float* lnb = prm + P_LNB; const float* rk = prm + P_RK;
    const int gw = F.bid * NWAVES + F.wave, NGW = F.G * NWAVES, lane = F.lane;
    for (int t = gw; t < S; t += NGW) {
#pragma unroll
        for (int j = 0; j < 2; ++j) {
            const size_t o = (size_t)t * 512 / 4 + 64 * j + lane;
            const f32x4 y = ((const GAS f32x4*)(ws + WS_Y32))[o], r = ((const GAS f32x4*)(ws + WS_R32))[o], k = ((const GAS f32x4*)(ws + WS_KP))[o], v = ((const GAS f32x4*)(ws + WS_VV))[o], g = ((const GAS f32x4*)(ws + WS_G32))[o];
            const f32x4 w4 = ((const GAS f32x4*)lnw)[64 * j + lane], b4 = ((const GAS f32x4*)lnb)[64 * j + lane], rk4 = ((const GAS f32x4*)rk)[64 * j + lane];
            float sm = (y.x + y.y) + (y.z + y.w);
            sm += __shfl_xor(sm, 1); sm += __shfl_xor(sm, 2); sm += __shfl_xor(sm, 4); sm += __shfl_xor(sm, 8);
            const float mean = sm * (1.f / 64.f); const f32x4 d = y - mean;
            float q = (d.x * d.x + d.y * d.y) + (d.z * d.z + d.w * d.w);
            q += __shfl_xor(q, 1); q += __shfl_xor(q, 2); q += __shfl_xor(q, 4); q += __shfl_xor(q, 8);
            const float rstd = rsqrtf(q * (1.f / 64.f) + 64e-5f);
            const f32x4 rkk = r * k * rk4; float bs = (rkk.x + rkk.y) + (rkk.z + rkk.w);
            bs += __shfl_xor(bs, 1); bs += __shfl_xor(bs, 2); bs += __shfl_xor(bs, 4); bs += __shfl_xor(bs, 8);
            const f32x4 o4 = (d * rstd * w4 + b4 + bs * v) * g;
            u32x2 ob; ob.x = pk2(o4.x, o4.y); ob.y = pk2(o4.z, o4.w);
            *((GAS u32x2*)((bf16*)(ws + WS_OB) + (size_t)t * D + 1536) + 64 * j + lane) = ob;
        }
    }
}

namespace pg8 {
DI unsigned char* lw(unsigned char* p) { unsigned long long w = (unsigned long long)p; asm volatile("" : "+s"(w)); return (unsigned char*)w; }
DI void st8bf(bf16* p, const f32x4 a, const f32x4 b) { *(GAS u32x4*)p = pack8(a, b); }
DI void st8f(float* p, const f32x4 a, const f32x4 b) { *(GAS f32x4*)p = a; *((GAS f32x4*)p + 1) = b; }
DI f32x4 map4(const f32x4 v, float (*f)(float)) { return (f32x4){f(v.x), f(v.y), f(v.z), f(v.w)}; }

struct EpiIn {
    static constexpr bool AFTER_DRAIN = false;
    unsigned char* ws_;
    DI bool operator()(Acc& acc, const Unit& u, int wr, int wc, int fr, int fq) const {
        unsigned char* ws = lw(ws_);
        const int T = u.pn, row0 = u.pm * BM + wr * 64 + fr, c0 = wc * 32 + fq * 8;
        if (T < 4) {
            const bool isK = T >= 2; const int head = 2 * (T & 1) + (c0 >> 6), j0 = c0 & 63; const float sc = isK ? 0.08838834764831845f : 1.0f;
            bf16* dst = (bf16*)(ws + (isK ? WS_KR : WS_QR)); const float* cs = (const float*)(ws + WS_COSR); const float* sn = (const float*)(ws + WS_SINR);
#pragma unroll
            for (int ai = 0; ai < 2; ++ai)
#pragma unroll
                for (int m = 0; m < 4; ++m) { const int row = row0 + ai * HALF + m * 16;
                    const f32x4 ca = *(const GAS f32x4*)(cs + (size_t)row * 64 + j0), cb = *(const GAS f32x4*)(cs + (size_t)row * 64 + j0 + 4);
                    const f32x4 sa = *(const GAS f32x4*)(sn + (size_t)row * 64 + j0), sb = *(const GAS f32x4*)(sn + (size_t)row * 64 + j0 + 4);
                    const f32x4 x1a = acc[ai][0][m][0], x1b = acc[ai][0][m][1], x2a = acc[ai][1][m][0], x2b = acc[ai][1][m][1];
                    bf16* o = dst + (size_t)row * 512 + head * 128 + j0;
                    st8bf(o, (x1a * ca - x2a * sa) * sc, (x1b * cb - x2b * sb) * sc);
                    st8bf(o + 64, (x2a * ca + x1a * sa) * sc, (x2b * cb + x1b * sb) * sc); }
            return true;
        }
        if (T < 17 && T != 14 && T != 15 && T != 16) {
            bf16* dst; int ld, cb; bool act;
            if (T < 6) { dst = (bf16*)(ws + WS_VR); ld = 512; cb = (T - 4) * 256; act = false; }
            else if (T < 8) { dst = (bf16*)(ws + WS_GR); ld = 512; cb = (T - 6) * 256; act = true; }
            else if (T < 10) { dst = (bf16*)(ws + WS_ZS); ld = 512; cb = (T - 8) * 256; act = true; }
            else { dst = (bf16*)(ws + WS_XBC); ld = 1024; cb = (T - 10) * 256; act = false; }
#pragma unroll
            for (int ai = 0; ai < 2; ++ai)
#pragma unroll
                for (int m = 0; m < 4; ++m) { const int row = row0 + ai * HALF + m * 16;
#pragma unroll
                    for (int bj = 0; bj < 2; ++bj) { f32x4 a = acc[ai][bj][m][0], b = acc[ai][bj][m][1];
                        if (act) { a = map4(a, siluf_); b = map4(b, siluf_); }
                        st8bf(dst + (size_t)row * ld + cb + bj * HALF + c0, a, b); } }
            return true;
        }
        if (T < 17) {
            bf16* dst; int ld, cb, slot;
            if (T < 16) { dst = (bf16*)(ws + WS_CQ); ld = 512; cb = (T - 14) * 256; slot = (T - 14) * 4 + wc; } else { dst = (bf16*)(ws + WS_CKV); ld = 256; cb = 0; slot = 8 + wc; }
            float* ssq = (float*)(ws + WS_SSQ);
#pragma unroll
            for (int ai = 0; ai < 2; ++ai)
#pragma unroll
                for (int m = 0; m < 4; ++m) { const int row = row0 + ai * HALF + m * 16; float ss = 0.f;
#pragma unroll
                    for (int bj = 0; bj < 2; ++bj) { const f32x4 a = acc[ai][bj][m][0], b = acc[ai][bj][m][1];
                        ss += (a.x * a.x + a.y * a.y) + (a.z * a.z + a.w * a.w) + (b.x * b.x + b.y * b.y) + (b.z * b.z + b.w * b.w);
                        st8bf(dst + (size_t)row * ld + cb + bj * HALF + c0, a, b); }
                    ss += __shfl_xor(ss, 16); ss += __shfl_xor(ss, 32);
                    if (fq == 0) ssq[(size_t)row * 16 + slot] = ss; }
            return true;
        }
        if (T < 24 || T == 56) {
            float* dst; int ld, cb;
            if (T < 24) { dst = (float*)(ws + WS_RW); ld = 1792; cb = (T - 17) * 256; } else { dst = (float*)(ws + WS_MISC); ld = 256; cb = 0; }
#pragma unroll
            for (int ai = 0; ai < 2; ++ai)
#pragma unroll
                for (int m = 0; m < 4; ++m) { const int row = row0 + ai * HALF + m * 16;
#pragma unroll
                    for (int bj = 0; bj < 2; ++bj) st8f(dst + (size_t)row * ld + cb + bj * HALF + c0, acc[ai][bj][m][0], acc[ai][bj][m][1]); }
            return true;
        }
        {
            bf16* dst = (bf16*)(ws + WS_GATE); const int cb = (T - 24) * 256;
#pragma unroll
            for (int ai = 0; ai < 2; ++ai)
#pragma unroll
                for (int m = 0; m < 4; ++m) { const int row = row0 + ai * HALF + m * 16;
#pragma unroll
                    for (int bj = 0; bj < 2; ++bj) st8bf(dst + (size_t)row * 8192 + cb + bj * HALF + c0, map4(acc[ai][bj][m][0], sigmoidf_), map4(acc[ai][bj][m][1], sigmoidf_)); }
        }
        return true;
    }
};

struct EpiQb {
    static constexpr bool AFTER_DRAIN = true;
    unsigned char* ws; const float* qnw;
    DI bool operator()(Acc&, const Unit&, int, int, int, int) const { return true; }
    DI void fused(Acc& acc, const Unit& u, int wr, int wc, int fr, int fq, LAS unsigned char* lds, int wid, int lane, int tid) const {
        const int h = u.pn, row0 = u.pm * BM + wr * 64 + fr, c0 = wc * 32 + fq * 8;
        const float* ssq = (const float*)(ws + WS_SSQ); LAS float* P = (LAS float*)lds;
        const float QS = 0.07216878364870322f * LOG2E;
#pragma unroll
        for (int ai = 0; ai < 2; ++ai)
#pragma unroll
            for (int m = 0; m < 4; ++m) { const int row = row0 + ai * HALF + m * 16, rl = ai * HALF + wr * 64 + m * 16 + fr;
                const f32x4 s0 = *(const GAS f32x4*)(ssq + (size_t)row * 16), s1 = *(const GAS f32x4*)(ssq + (size_t)row * 16 + 4);
                const float rs = rsqrtf(((s0.x + s0.y) + (s0.z + s0.w) + (s1.x + s1.y) + (s1.z + s1.w)) * (1.f / 512.f) + 1e-6f);
                float ss = 0.f;
#pragma unroll
                for (int bj = 0; bj < 2; ++bj)
#pragma unroll
                    for (int n = 0; n < 2; ++n) { f32x4 a = acc[ai][bj][m][n] * rs; acc[ai][bj][m][n] = a; ss += (a.x * a.x + a.y * a.y) + (a.z * a.z + a.w * a.w); }
                ss += __shfl_xor(ss, 16); ss += __shfl_xor(ss, 32);
                if (fq == 0) P[rl * 4 + wc] = ss; }
        __syncthreads();
        bf16* QM = (bf16*)(ws + WS_QM); const float* cs = (const float*)(ws + WS_COSM); const float* sn = (const float*)(ws + WS_SINM);
#pragma unroll
        for (int ai = 0; ai < 2; ++ai)
#pragma unroll
            for (int m = 0; m < 4; ++m) { const int row = row0 + ai * HALF + m * 16, rl = ai * HALF + wr * 64 + m * 16 + fr;
                const f32x4 pp = *(const LAS f32x4*)(P + rl * 4); const float rq = rsqrtf(((pp.x + pp.y) + (pp.z + pp.w)) * (1.f / 192.f) + 1e-6f) * QS;
                bf16* o = QM + (size_t)row * 768 + h * 192;
                if (wc < 3) {
                    const f32x4 wa = *(const GAS f32x4*)(qnw + c0), wb = *(const GAS f32x4*)(qnw + c0 + 4);
                    st8bf(o + c0, acc[ai][0][m][0] * rq * wa, acc[ai][0][m][1] * rq * wb);
                    if (wc == 0) { const f32x4 wc4 = *(const GAS f32x4*)(qnw + 96 + c0), wd = *(const GAS f32x4*)(qnw + 100 + c0);
                        st8bf(o + 96 + c0, acc[ai][1][m][0] * rq * wc4, acc[ai][1][m][1] * rq * wd); }
                } else {
                    const int i0 = 8 * fq;
                    const f32x4 w1a = *(const GAS f32x4*)(qnw + 128 + i0), w1b = *(const GAS f32x4*)(qnw + 132 + i0), w2a = *(const GAS f32x4*)(qnw + 160 + i0), w2b = *(const GAS f32x4*)(qnw + 164 + i0);
                    const f32x4 ca = *(const GAS f32x4*)(cs + (size_t)row * 32 + i0), cb = *(const GAS f32x4*)(cs + (size_t)row * 32 + i0 + 4), sa = *(const GAS f32x4*)(sn + (size_t)row * 32 + i0), sb = *(const GAS f32x4*)(sn + (size_t)row * 32 + i0 + 4);
                    const f32x4 x1a = acc[ai][0][m][0] * rq * w1a, x1b = acc[ai][0][m][1] * rq * w1b, x2a = acc[ai][1][m][0] * rq * w2a, x2b = acc[ai][1][m][1] * rq * w2b;
                    st8bf(o + 128 + i0, x1a * ca - x2a * sa, x1b * cb - x2b * sb);
                    st8bf(o + 160 + i0, x2a * ca + x1a * sa, x2b * cb + x1b * sb);
                } }
        __syncthreads();
    }
};

struct EpiKvb {
    static constexpr bool AFTER_DRAIN = true;
    unsigned char* ws; const float* knw;
    DI bool operator()(Acc&, const Unit&, int, int, int, int) const { return true; }
    DI void fused(Acc& acc, const Unit& u, int wr, int wc, int fr, int fq, LAS unsigned char* lds, int wid, int lane, int tid) const {
        const int h = u.pn, row0 = u.pm * BM + wr * 64 + fr, c0 = wc * 32 + fq * 8;
        const float* ssq = (const float*)(ws + WS_SSQ); const float* misc = (const float*)(ws + WS_MISC);
        LAS float* P = (LAS float*)lds; LAS float* KRS = P + 1024; LAS float* RK = P + 1280;
        if (tid < 256) { const float* kr = misc + (size_t)(u.pm * BM + tid) * 256 + 8; float s = 0.f;
#pragma unroll
            for (int i = 0; i < 16; ++i) { const f32x4 v = *(const GAS f32x4*)(kr + 4 * i); s += (v.x * v.x + v.y * v.y) + (v.z * v.z + v.w * v.w); }
            KRS[tid] = s; }
#pragma unroll
        for (int ai = 0; ai < 2; ++ai)
#pragma unroll
            for (int m = 0; m < 4; ++m) { const int row = row0 + ai * HALF + m * 16, rl = ai * HALF + wr * 64 + m * 16 + fr;
                const f32x4 s0 = *(const GAS f32x4*)(ssq + (size_t)row * 16 + 8);
                const float rs = rsqrtf(((s0.x + s0.y) + (s0.z + s0.w)) * (1.f / 256.f) + 1e-6f);
                float ss = 0.f;
#pragma unroll
                for (int bj = 0; bj < 2; ++bj)
#pragma unroll
                    for (int n = 0; n < 2; ++n) { f32x4 a = acc[ai][bj][m][n] * rs; acc[ai][bj][m][n] = a; if (bj == 0) ss += (a.x * a.x + a.y * a.y) + (a.z * a.z + a.w * a.w); }
                ss += __shfl_xor(ss, 16); ss += __shfl_xor(ss, 32);
                if (fq == 0) P[rl * 4 + wc] = ss; }
        __syncthreads();
        if (tid < 256) { const f32x4 pp = *(const LAS f32x4*)(P + tid * 4); RK[tid] = rsqrtf(((pp.x + pp.y) + (pp.z + pp.w) + KRS[tid]) * (1.f / 192.f) + 1e-6f); }
        __syncthreads();
        bf16* KM = (bf16*)(ws + WS_KM); bf16* VT = (bf16*)(ws + WS_VT);
        const f32x4 wa = *(const GAS f32x4*)(knw + c0), wb = *(const GAS f32x4*)(knw + c0 + 4);
#pragma unroll
        for (int ai = 0; ai < 2; ++ai)
#pragma unroll
            for (int m = 0; m < 4; ++m) { const int row = row0 + ai * HALF + m * 16, rl = ai * HALF + wr * 64 + m * 16 + fr;
                const float rk = RK[rl];
                st8bf(KM + (size_t)row * 768 + h * 192 + c0, acc[ai][0][m][0] * rk * wa, acc[ai][0][m][1] * rk * wb);
#pragma unroll
                for (int n = 0; n < 2; ++n)
#pragma unroll
                    for (int i = 0; i < 4; ++i) VT[(size_t)(h * 128 + c0 + n * 4 + i) * S + row] = (bf16)f2bf(acc[ai][1][m][n][i]); }
        {
            const int rl = tid >> 1, hf = tid & 1, row = u.pm * BM + rl, i0 = 16 * hf; const float rk = RK[rl];
            const float* kr = misc + (size_t)row * 256 + 8; const float* cs = (const float*)(ws + WS_COSM) + (size_t)row * 32; const float* sn = (const float*)(ws + WS_SINM) + (size_t)row * 32;
            bf16* o = KM + (size_t)row * 768 + h * 192 + 128;
#pragma unroll
            for (int q = 0; q < 2; ++q) { f32x4 o1[2], o2[2];
#pragma unroll
                for (int e = 0; e < 2; ++e) { const int i = i0 + 8 * q + 4 * e;
                    const f32x4 x1 = *(const GAS f32x4*)(kr + i) * *(const GAS f32x4*)(knw + 128 + i), x2 = *(const GAS f32x4*)(kr + 32 + i) * *(const GAS f32x4*)(knw + 160 + i);
                    const f32x4 c = *(const GAS f32x4*)(cs + i), s = *(const GAS f32x4*)(sn + i);
                    o1[e] = (x1 * c - x2 * s) * rk; o2[e] = (x2 * c + x1 * s) * rk; }
                st8bf(o + i0 + 8 * q, o1[0], o1[1]); st8bf(o + 32 + i0 + 8 * q, o2[0], o2[1]); }
        }
        __syncthreads();
    }
};

struct EpiV1 {
    static constexpr bool AFTER_DRAIN = false;
    unsigned char* ws_;
    DI bool operator()(Acc& acc, const Unit& u, int wr, int wc, int fr, int fq) const {
        if (wc != 0) return true;
        unsigned char* ws = lw(ws_);
        const int row0 = u.pm * BM + wr * 64 + fr; bf16* dst = (bf16*)(ws + WS_ALORA);
#pragma unroll
        for (int ai = 0; ai < 2; ++ai)
#pragma unroll
            for (int m = 0; m < 4; ++m) { const int row = row0 + ai * HALF + m * 16; st8bf(dst + (size_t)row * 512 + 384 + fq * 8, acc[ai][0][m][0], acc[ai][0][m][1]); }
        return true;
    }
};

struct EpiLora {
    static constexpr bool AFTER_DRAIN = false;
    unsigned char* ws_; const float* w0; const float* a0; const float* v0; const float* ka;
#define LORA_LOOP(BODY) _Pragma("unroll") for (int ai = 0; ai < 2; ++ai) _Pragma("unroll") for (int m = 0; m < 4; ++m) { const size_t ro = (size_t)(row0 + ai * HALF + m * 16) * 512; \
        _Pragma("unroll") for (int bj = 0; bj < 2; ++bj) _Pragma("unroll") for (int n = 0; n < 2; ++n) { const int j = jb + bj * HALF + n * 4; const size_t o = ro + j; const f32x4 x = acc[ai][bj][m][n]; BODY } }
    DI bool operator()(Acc& acc, const Unit& u, int wr, int wc, int fr, int fq) const {
        unsigned char* ws = lw(ws_);
        const int seg = u.pn >> 1, row0 = u.pm * BM + wr * 64 + fr, jb = (u.pn & 1) * 256 + wc * 32 + fq * 8;
        if (seg == 0) { float* dec = (float*)(ws + WS_DEC);
            LORA_LOOP({ const f32x4 b = *(const GAS f32x4*)(w0 + j); f32x4 r;
                _Pragma("unroll") for (int i = 0; i < 4; ++i) { const float wv = -softplusf_(-(b[i] + x[i])) - 0.5f; r[i] = __expf(-__expf(wv)); }
                *(GAS f32x4*)(dec + o) = r; })
        } else if (seg == 1) { const float* k32 = (const float*)(ws + WS_K32); const float* kkn_ = (const float*)(ws + WS_KKN); float* kp_ = (float*)(ws + WS_KP); float* bb_ = (float*)(ws + WS_BB);
            LORA_LOOP({ const f32x4 b = *(const GAS f32x4*)(a0 + j); const f32x4 kav = *(const GAS f32x4*)(ka + j);
                const f32x4 k = *(const GAS f32x4*)(k32 + o); const f32x4 kkn = *(const GAS f32x4*)(kkn_ + o); f32x4 kp; f32x4 bb;
                _Pragma("unroll") for (int i = 0; i < 4; ++i) { const float av = sigmoidf_(b[i] + x[i]); kp[i] = k[i] * (1.0f + (av - 1.0f) * kav[i]); bb[i] = kkn[i] * av; }
                *(GAS f32x4*)(kp_ + o) = kp; *(GAS f32x4*)(bb_ + o) = bb; })
        } else if (seg == 2) { float* g32 = (float*)(ws + WS_G32);
            LORA_LOOP({ *(GAS f32x4*)(g32 + o) = x; })
        } else { float* vv = (float*)(ws + WS_VV); const float* vf_ = (const float*)(ws + WS_VFIRST);
            LORA_LOOP({ const f32x4 b = *(const GAS f32x4*)(v0 + j); const f32x4 v = *(const GAS f32x4*)(vv + o); const f32x4 vf = *(const GAS f32x4*)(vf_ + o); f32x4 r;
                _Pragma("unroll") for (int i = 0; i < 4; ++i) r[i] = v[i] + (vf[i] - v[i]) * sigmoidf_(b[i] + x[i]);
                *(GAS f32x4*)(vv + o) = r; })
        }
        return true;
    }
#undef LORA_LOOP
};

struct EpiBranch {
    static constexpr bool AFTER_DRAIN = false;
    unsigned char* ws_;
    DI bool operator()(Acc& acc, const Unit& u, int wr, int wc, int fr, int fq) const {
        unsigned char* ws = lw(ws_);
        const int nb = u.sub, row0 = u.pm * BM + wr * 64 + fr, cb = u.pn * BM + wc * 32 + fq * 8;
        const bf16* G = (const bf16*)(ws + WS_GATE); bf16* M = (bf16*)(ws + WS_MERGED);
#pragma unroll
        for (int ai = 0; ai < 2; ++ai)
#pragma unroll
            for (int m = 0; m < 4; ++m) { const int row = row0 + ai * HALF + m * 16;
#pragma unroll
                for (int bj = 0; bj < 2; ++bj) { const int col = cb + bj * HALF;
                    float g[8]; unpack8(*(const GAS u32x4*)(G + (size_t)row * 8192 + nb * D + col), g);
                    if (nb < 3) { float gn[8]; unpack8(*(const GAS u32x4*)(G + (size_t)row * 8192 + (nb + 1) * D + col), gn);
#pragma unroll
                        for (int i = 0; i < 8; ++i) g[i] = fmaxf(g[i], 1e-30f) * __builtin_amdgcn_rcpf(fmaxf(gn[i], 1e-30f)); }
                    else {
#pragma unroll
                        for (int i = 0; i < 8; ++i) g[i] = fmaxf(g[i], 1e-30f); }
                    f32x4 a = acc[ai][bj][m][0], b = acc[ai][bj][m][1];
                    a = a * (f32x4){g[0], g[1], g[2], g[3]}; b = b * (f32x4){g[4], g[5], g[6], g[7]};
                    if (nb < 3) { acc[ai][bj][m][0] = a; acc[ai][bj][m][1] = b; } else st8bf(M + (size_t)row * D + col, a, b); } }
        return nb == 3;
    }
};

struct EpiRes {
    static constexpr bool AFTER_DRAIN = false;
    const float* xin; float* out;
    DI bool operator()(Acc& acc, const Unit& u, int wr, int wc, int fr, int fq) const {
        const int row0 = u.pm * BM + wr * 64 + fr, cb = u.pn * BM + wc * 32 + fq * 8;
#pragma unroll
        for (int ai = 0; ai < 2; ++ai)
#pragma unroll
            for (int m = 0; m < 4; ++m) { const int row = row0 + ai * HALF + m * 16;
#pragma unroll
                for (int bj = 0; bj < 2; ++bj) { const size_t o = (size_t)row * D + cb + bj * HALF;
                    const f32x4 xa = *(const GAS f32x4*)(xin + o), xb = *(const GAS f32x4*)(xin + o + 4);
                    st8f(out + o, xa + acc[ai][bj][m][0], xb + acc[ai][bj][m][1]); } }
        return true;
    }
};

struct EpiGu {
    static constexpr bool AFTER_DRAIN = false;
    unsigned char* ws_;
    DI bool operator()(Acc& acc, const Unit& u, int wr, int wc, int fr, int fq) const {
        unsigned char* ws = lw(ws_);
        const int row0 = u.pm * BM + wr * 64 + fr, cb = u.pn * 128 + wc * 32 + fq * 8; bf16* A = (bf16*)(ws + WS_ACT);
#pragma unroll
        for (int ai = 0; ai < 2; ++ai)
#pragma unroll
            for (int m = 0; m < 4; ++m) { const int row = row0 + ai * HALF + m * 16;
                st8bf(A + (size_t)row * DFF + cb, map4(acc[ai][0][m][0], siluf_) * acc[ai][1][m][0], map4(acc[ai][0][m][1], siluf_) * acc[ai][1][m][1]); }
        return true;
    }
};
}

DI bf16x8 ldfrag(const LAS bf16* M, int ld, int r0, int k0, int lane) { return *(const LAS bf16x8*)(M + (r0 + (lane & 15)) * ld + k0 + 8 * (lane >> 4)); }
#define MFMA16(a, b, c) __builtin_amdgcn_mfma_f32_16x16x32_bf16((a), (b), (c), 0, 0, 0)
DI void stage_nat(LAS bf16* dst, int lp, const bf16* src, size_t gp, int rows, int cols8, int tid) {
    for (int p = tid; p < rows * cols8; p += NTHR) { const int r = p / cols8, c = p - r * cols8; *(LAS u32x4*)(dst + r * lp + c * 8) = *(const GAS u32x4*)(src + (size_t)r * gp + c * 8); }
}
DI void stage_tr(LAS bf16* dst, int lp, const bf16* src, size_t gp, int rows, int cols8, int tid) {
    for (int p = tid; p < rows * cols8; p += NTHR) { const int r = p / cols8, c = p - r * cols8; const u32x4 w = *(const GAS u32x4*)(src + (size_t)r * gp + c * 8);
        LAS bf16* d = dst + (c * 8) * lp + r;
        d[0] = (bf16)(w.x & 0xffffu); d[lp] = (bf16)(w.x >> 16); d[2 * lp] = (bf16)(w.y & 0xffffu); d[3 * lp] = (bf16)(w.y >> 16);
        d[4 * lp] = (bf16)(w.z & 0xffffu); d[5 * lp] = (bf16)(w.z >> 16); d[6 * lp] = (bf16)(w.w & 0xffffu); d[7 * lp] = (bf16)(w.w >> 16); }
}
DI float ret_loggamma(int h) { return log1pf(-exp2f(-5.0f - (float)h)); }

DI void u_ret_kv(Frame& F, int c, int h) {
    unsigned char* ws = F.ws; const int tid = F.tid, lane = F.lane, w = F.wave;
    LAS bf16* Kt = (LAS bf16*)F.lds; LAS bf16* Vt = Kt + 128 * 72;
    const bf16* KR = (const bf16*)(ws + WS_KR) + (size_t)(c * 64) * 512 + h * 128; const bf16* VR = (const bf16*)(ws + WS_VR) + (size_t)(c * 64) * 512 + h * 128;
    const float lg = ret_loggamma(h);
    for (int p = tid; p < 1024; p += NTHR) { const int m = p >> 4, d0 = (p & 15) * 8; float k[8]; unpack8(*(const GAS u32x4*)(KR + (size_t)m * 512 + d0), k); const float sc = __expf(lg * (float)(63 - m));
        LAS bf16* d = Kt + d0 * 72 + m;
#pragma unroll
        for (int i = 0; i < 8; ++i) d[i * 72] = (bf16)f2bf(k[i] * sc); }
    stage_tr(Vt, 72, VR, 512, 64, 16, tid);
    __syncthreads();
    f32x4 acc[8];
#pragma unroll
    for (int bn = 0; bn < 8; ++bn) acc[bn] = (f32x4){0.f, 0.f, 0.f, 0.f};
#pragma unroll
    for (int ks = 0; ks < 2; ++ks) { const bf16x8 a = ldfrag(Kt, 72, 16 * w, 32 * ks, lane);
#pragma unroll
        for (int bn = 0; bn < 8; ++bn) acc[bn] = MFMA16(a, ldfrag(Vt, 72, 16 * bn, 32 * ks, lane), acc[bn]); }
    float* out = (float*)(ws + WS_RKV) + ((size_t)(c * 4 + h) * 128) * 128;
#pragma unroll
    for (int bn = 0; bn < 8; ++bn)
#pragma unroll
        for (int r = 0; r < 4; ++r) out[(size_t)(16 * w + 4 * (lane >> 4) + r) * 128 + 16 * bn + (lane & 15)] = acc[bn][r];
    __syncthreads();
}

DI void u_ret_out(Frame& F, int l_, int c, int h) {
    unsigned char* ws = F.ws; const int tid = F.tid, lane = F.lane, w = F.wave;
    LAS bf16* Qs = (LAS bf16*)F.lds; LAS bf16* Ks = Qs + 64 * 136; LAS bf16* Vt = Ks + 64 * 136; LAS bf16* St = Vt + 128 * 72; LAS bf16* Ps = St + 128 * 136; LAS float* Os = (LAS float*)(Ps + 64 * 72);
    const size_t rowb = (size_t)(c * 64) * 512 + h * 128;
    stage_nat(Qs, 136, (const bf16*)(ws + WS_QR) + rowb, 512, 64, 16, tid);
    stage_nat(Ks, 136, (const bf16*)(ws + WS_KR) + rowb, 512, 64, 16, tid);
    stage_tr(Vt, 72, (const bf16*)(ws + WS_VR) + rowb, 512, 64, 16, tid);
    { const float* sp = (const float*)(ws + WS_RKV) + ((size_t)(c * 4 + h) * 128) * 128;
      for (int p = tid; p < 4096; p += NTHR) { const int d = p >> 5, e0 = (p & 31) * 4; const f32x4 v = *(const GAS f32x4*)(sp + (size_t)d * 128 + e0);
          LAS bf16* q = St + e0 * 136 + d; q[0] = (bf16)f2bf(v.x); q[136] = (bf16)f2bf(v.y); q[272] = (bf16)f2bf(v.z); q[408] = (bf16)f2bf(v.w); } }
    __syncthreads();
    const float lg = ret_loggamma(h); const int g4 = lane >> 4, lc = lane & 15;
    {
        const int bm = w >> 1;
#pragma unroll
        for (int q = 0; q < 2; ++q) { const int bn = (w & 1) * 2 + q; f32x4 acc = (f32x4){0.f, 0.f, 0.f, 0.f};
#pragma unroll
            for (int ks = 0; ks < 4; ++ks) acc = MFMA16(ldfrag(Qs, 136, 16 * bm, 32 * ks, lane), ldfrag(Ks, 136, 16 * bn, 32 * ks, lane), acc);
#pragma unroll
            for (int r = 0; r < 4; ++r) { const int l = 16 * bm + 4 * g4 + r, m = 16 * bn + lc; const int dd = l > m ? l - m : m - l; Ps[l * 72 + m] = (bf16)f2bf(acc[r] * __expf(lg * (float)dd)); } }
    }
    __syncthreads();
    {
        const int bm = w >> 1;
#pragma unroll
        for (int q = 0; q < 4; ++q) { const int bn = (w & 1) * 4 + q; f32x4 a1 = (f32x4){0.f, 0.f, 0.f, 0.f}, a2 = (f32x4){0.f, 0.f, 0.f, 0.f};
#pragma unroll
            for (int ks = 0; ks < 2; ++ks) a1 = MFMA16(ldfrag(Ps, 72, 16 * bm, 32 * ks, lane), ldfrag(Vt, 72, 16 * bn, 32 * ks, lane), a1);
#pragma unroll
            for (int ks = 0; ks < 4; ++ks) a2 = MFMA16(ldfrag(Qs, 136, 16 * bm, 32 * ks, lane), ldfrag(St, 136, 16 * bn, 32 * ks, lane), a2);
#pragma unroll
            for (int r = 0; r < 4; ++r) { const int l = 16 * bm + 4 * g4 + r; Os[l * 132 + 16 * bn + lc] = a1[r] + __expf(lg * (float)(l + 1)) * a2[r]; } }
    }
    __syncthreads();
    { const float* gw = (const float*)(ws + WS_PRM) + (size_t)l_ * PRM_STRIDE + P_GN + h * 128; const bf16* GR = (const bf16*)(ws + WS_GR); bf16* OB = (bf16*)(ws + WS_OB);
#pragma unroll
      for (int rr = 0; rr < 8; ++rr) { const int l = 8 * w + rr; const float x0 = Os[l * 132 + lane], x1 = Os[l * 132 + 64 + lane];
          const float mean = wave_sum(x0 + x1) * (1.f / 128.f); const float d0 = x0 - mean, d1 = x1 - mean; const float rstd = rsqrtf(wave_sum(d0 * d0 + d1 * d1) * (1.f / 128.f) + 1e-5f);
          const size_t row = (size_t)(c * 64 + l);
          const float g0 = bf2f(GR[row * 512 + h * 128 + lane]), g1 = bf2f(GR[row * 512 + h * 128 + 64 + lane]);
          OB[row * D + h * 128 + lane] = (bf16)f2bf(d0 * rstd * gw[lane] * g0); OB[row * D + h * 128 + 64 + lane] = (bf16)f2bf(d1 * rstd * gw[64 + lane] * g1); } }
    __syncthreads();
}

DI void u_mamba_st(Frame& F, int c, int g) {
    unsigned char* ws = F.ws; const int tid = F.tid, lane = F.lane, w = F.wave;
    LAS bf16* Xt = (LAS bf16*)F.lds; LAS bf16* Bt = Xt + 256 * 72;
    const bf16* XC = (const bf16*)(ws + WS_XC) + (size_t)(c * 64) * 1024; const float* dts = (const float*)(ws + WS_DTS) + (size_t)(c * 64) * 8; const float* acs = (const float*)(ws + WS_ACS) + (size_t)(c * 64) * 8;
    for (int p = tid; p < 2048; p += NTHR) { const int l = p >> 5, c0 = (p & 31) * 8, h = g * 4 + (c0 >> 6); float x[8]; unpack8(*(const GAS u32x4*)(XC + (size_t)l * 1024 + g * 256 + c0), x);
        const float sc = dts[l * 8 + h] * __expf(acs[63 * 8 + h] - acs[l * 8 + h]); LAS bf16* d = Xt + c0 * 72 + l;
#pragma unroll
        for (int i = 0; i < 8; ++i) d[i * 72] = (bf16)f2bf(x[i] * sc); }
    stage_tr(Bt, 72, XC + 512 + g * 128, 1024, 64, 16, tid);
    __syncthreads();
    f32x4 acc[2][8];
#pragma unroll
    for (int i = 0; i < 2; ++i)
#pragma unroll
        for (int bn = 0; bn < 8; ++bn) acc[i][bn] = (f32x4){0.f, 0.f, 0.f, 0.f};
#pragma unroll
    for (int ks = 0; ks < 2; ++ks) { const bf16x8 a0 = ldfrag(Xt, 72, 32 * w, 32 * ks, lane), a1 = ldfrag(Xt, 72, 32 * w + 16, 32 * ks, lane);
#pragma unroll
        for (int bn = 0; bn < 8; ++bn) { const bf16x8 b = ldfrag(Bt, 72, 16 * bn, 32 * ks, lane); acc[0][bn] = MFMA16(a0, b, acc[0][bn]); acc[1][bn] = MFMA16(a1, b, acc[1][bn]); } }
    float* out = (float*)(ws + WS_MST) + ((size_t)(c * 8 + g * 4) * 64) * 128;
#pragma unroll
    for (int i = 0; i < 2; ++i)
#pragma unroll
        for (int bn = 0; bn < 8; ++bn)
#pragma unroll
            for (int r = 0; r < 4; ++r) out[(size_t)(32 * w + 16 * i + 4 * (lane >> 4) + r) * 128 + 16 * bn + (lane & 15)] = acc[i][bn][r];
    __syncthreads();
}

struct MambaLds { LAS bf16* Cs; LAS bf16* Bs; LAS float* CB; LAS bf16* Ph; LAS bf16* Xt; LAS bf16* Sh; LAS float* AC; LAS float* DT; LAS float* SSQ; };
DI void mamba_head(Frame& F, const MambaLds& L, const bf16* XC, const float* sp, int g, int hh, float dsk, const bf16* const (&zrow)[4], f32x4 (&y)[2]) {
    const int tid = F.tid, lane = F.lane, w = F.wave, g4 = lane >> 4, lc = lane & 15, bm = w >> 1;
    __syncthreads();
    { const int l = tid >> 3, m0 = (tid & 7) * 8; const float al = L.AC[l * 4 + hh]; float pv[8];
#pragma unroll
      for (int i = 0; i < 8; ++i) { const int m = m0 + i; pv[i] = (m <= l) ? L.CB[l * 68 + m] * __expf(al - L.AC[m * 4 + hh]) * L.DT[m * 4 + hh] : 0.f; }
      u32x4 o; o.x = pk2(pv[0], pv[1]); o.y = pk2(pv[2], pv[3]); o.z = pk2(pv[4], pv[5]); o.w = pk2(pv[6], pv[7]); *(LAS u32x4*)(L.Ph + l * 72 + m0) = o; }
    stage_tr(L.Xt, 72, XC + g * 256 + hh * 64, 1024, 64, 8, tid);
    for (int p = tid; p < 1024; p += NTHR) { const int pr = p >> 4, n0 = (p & 15) * 8; const f32x4 v0 = *(const GAS f32x4*)(sp + (size_t)pr * 128 + n0), v1 = *(const GAS f32x4*)(sp + (size_t)pr * 128 + n0 + 4);
        *(LAS u32x4*)(L.Sh + pr * 136 + n0) = pack8(v0, v1); }
    __syncthreads();
#pragma unroll
    for (int q = 0; q < 2; ++q) { const int bn = (w & 1) * 2 + q; f32x4 yd = (f32x4){0.f, 0.f, 0.f, 0.f}, yo = (f32x4){0.f, 0.f, 0.f, 0.f};
#pragma unroll
        for (int ks = 0; ks < 2; ++ks) yd = MFMA16(ldfrag(L.Ph, 72, 16 * bm, 32 * ks, lane), ldfrag(L.Xt, 72, 16 * bn, 32 * ks, lane), yd);
#pragma unroll
        for (int ks = 0; ks < 4; ++ks) yo = MFMA16(ldfrag(L.Cs, 136, 16 * bm, 32 * ks, lane), ldfrag(L.Sh, 136, 16 * bn, 32 * ks, lane), yo);
#pragma unroll
        for (int r = 0; r < 4; ++r) { const int l = 16 * bm + 4 * g4 + r, p = 16 * bn + lc; const float x = bf2f(L.Xt[p * 72 + l]);
            const float z = bf2f(zrow[r][hh * 64 + q * 16]);
            y[q][r] = (yd[r] + __expf(L.AC[l * 4 + hh]) * yo[r] + x * dsk) * z; } }
}
DI void u_mamba_out(Frame& F, int l_, int c, int g) {
    unsigned char* ws = F.ws; const int tid = F.tid, lane = F.lane, w = F.wave, g4 = lane >> 4, lc = lane & 15;
    MambaLds L; L.Cs = (LAS bf16*)F.lds; L.Bs = L.Cs + 64 * 136; L.CB = (LAS float*)(L.Bs + 64 * 136); L.Ph = (LAS bf16*)(L.CB + 64 * 68); L.Xt = L.Ph + 64 * 72; L.Sh = L.Xt + 64 * 72;
    L.AC = (LAS float*)(L.Sh + 64 * 136); L.DT = L.AC + 256; L.SSQ = L.DT + 256;
    const bf16* XC = (const bf16*)(ws + WS_XC) + (size_t)(c * 64) * 1024;
    stage_nat(L.Cs, 136, XC + 768 + g * 128, 1024, 64, 16, tid);
    stage_nat(L.Bs, 136, XC + 512 + g * 128, 1024, 64, 16, tid);
    if (tid < 256) { const int l = tid >> 2, hh = tid & 3; L.AC[tid] = ((const float*)(ws + WS_ACS))[(size_t)(c * 64 + l) * 8 + g * 4 + hh]; L.DT[tid] = ((const float*)(ws + WS_DTS))[(size_t)(c * 64 + l) * 8 + g * 4 + hh]; }
    __syncthreads();
    const int bm = w >> 1;
#pragma unroll
    for (int q = 0; q < 2; ++q) { const int bn = (w & 1) * 2 + q; f32x4 acc = (f32x4){0.f, 0.f, 0.f, 0.f};
#pragma unroll
        for (int ks = 0; ks < 4; ++ks) acc = MFMA16(ldfrag(L.Cs, 136, 16 * bm, 32 * ks, lane), ldfrag(L.Bs, 136, 16 * bn, 32 * ks, lane), acc);
#pragma unroll
        for (int r = 0; r < 4; ++r) L.CB[(16 * bm + 4 * g4 + r) * 68 + 16 * bn + lc] = acc[r]; }
    const int pcol = 16 * ((w & 1) * 2) + lc;
    const bf16* zrow[4]; bf16* orow[4];
#pragma unroll
    for (int r = 0; r < 4; ++r) { const size_t row = (size_t)(c * 64 + 16 * bm + 4 * g4 + r); zrow[r] = (const bf16*)(ws + WS_ZS) + row * 512 + g * 256 + pcol; orow[r] = (bf16*)(ws + WS_OB) + row * D + 512 + g * 256 + pcol; }
    const float* mst = (const float*)(ws + WS_MST) + ((size_t)(c * 8 + g * 4) * 64) * 128; const float* prm = (const float*)(ws + WS_PRM) + (size_t)l_ * PRM_STRIDE; const float* dskp = prm + P_SD + g * 4;
    float ss[4] = {0.f, 0.f, 0.f, 0.f};
#pragma unroll 1
    for (int hh = 0; hh < 4; ++hh) { f32x4 y[2]; mamba_head(F, L, XC, mst + (size_t)hh * 64 * 128, g, hh, dskp[hh], zrow, y);
#pragma unroll
        for (int r = 0; r < 4; ++r) ss[r] += y[0][r] * y[0][r] + y[1][r] * y[1][r]; }
#pragma unroll
    for (int r = 0; r < 4; ++r) { float t = ss[r]; t += __shfl_xor(t, 1); t += __shfl_xor(t, 2); t += __shfl_xor(t, 4); t += __shfl_xor(t, 8);
        if (lc == 0) L.SSQ[(16 * bm + 4 * g4 + r) * 2 + (w & 1)] = t; }
    __syncthreads();
    float rstd[4];
#pragma unroll
    for (int r = 0; r < 4; ++r) { const int l = 16 * bm + 4 * g4 + r; rstd[r] = rsqrtf((L.SSQ[l * 2] + L.SSQ[l * 2 + 1]) * (1.f / 256.f) + 1e-6f); }
    const float* nw = prm + P_SNW + g * 256 + pcol;
#pragma unroll 1
    for (int hh = 0; hh < 4; ++hh) { f32x4 y[2]; mamba_head(F, L, XC, mst + (size_t)hh * 64 * 128, g, hh, dskp[hh], zrow, y);
#pragma unroll
        for (int q = 0; q < 2; ++q)
#pragma unroll
            for (int r = 0; r < 4; ++r) orow[r][hh * 64 + q * 16] = (bf16)f2bf(y[q][r] * rstd[r] * nw[hh * 64 + q * 16]); }
    __syncthreads();
}

DI void u_attn(Frame& F, int c, int h) {
    unsigned char* ws = F.ws; const int tid = F.tid, lane = F.lane, w = F.wave, g4 = lane >> 4, lc = lane & 15, qh = w >> 2, kq = w & 3;
    LAS bf16* Ks = (LAS bf16*)F.lds; LAS bf16* Vs = Ks + 128 * 200;
    const bf16* QM = (const bf16*)(ws + WS_QM); const bf16* KM = (const bf16*)(ws + WS_KM) + h * 192; const bf16* VT = (const bf16*)(ws + WS_VT) + (size_t)(h * 128) * S;
    bf16x8 qf[2][6];
#pragma unroll
    for (int qb = 0; qb < 2; ++qb)
#pragma unroll
        for (int ks = 0; ks < 6; ++ks) qf[qb][ks] = *(const GAS bf16x8*)(QM + (size_t)(c * 64 + qh * 32 + qb * 16 + lc) * 768 + h * 192 + ks * 32 + g4 * 8);
    f32x4 o[8][2]; float mrun[2], lrun[2];
#pragma unroll
    for (int db = 0; db < 8; ++db)
#pragma unroll
        for (int qb = 0; qb < 2; ++qb) o[db][qb] = (f32x4){0.f, 0.f, 0.f, 0.f};
    mrun[0] = mrun[1] = -1e30f; lrun[0] = lrun[1] = 0.f;
    const int nkeys = 64 * (c + 1), ntile = (c + 2) >> 1;
    for (int t = 0; t < ntile; ++t) {
        const int key0 = t * 128;
        __syncthreads();
        for (int p = tid; p < 128 * 24; p += NTHR) { const int r = p / 24, cc = p - r * 24; *(LAS u32x4*)(Ks + r * 200 + cc * 8) = *(const GAS u32x4*)(KM + (size_t)(key0 + r) * 768 + cc * 8); }
        for (int p = tid; p < 128 * 16; p += NTHR) { const int r = p >> 4, cc = p & 15; *(LAS u32x4*)(Vs + r * 136 + cc * 8) = *(const GAS u32x4*)(VT + (size_t)r * S + key0 + cc * 8); }
        __syncthreads();
        if (key0 + kq * 32 < nkeys) {
            f32x4 s[2][2];
#pragma unroll
            for (int kb = 0; kb < 2; ++kb)
#pragma unroll
                for (int qb = 0; qb < 2; ++qb) s[kb][qb] = (f32x4){0.f, 0.f, 0.f, 0.f};
#pragma unroll
            for (int ks = 0; ks < 6; ++ks)
#pragma unroll
                for (int kb = 0; kb < 2; ++kb) { const bf16x8 kf = ldfrag(Ks, 200, kq * 32 + kb * 16, ks * 32, lane);
#pragma unroll
                    for (int qb = 0; qb < 2; ++qb) s[kb][qb] = MFMA16(kf, qf[qb][ks], s[kb][qb]); }
            bf16x8 pf[2];
#pragma unroll
            for (int qb = 0; qb < 2; ++qb) {
                float mx = fmaxf(fmaxf(fmaxf(s[0][qb][0], s[0][qb][1]), fmaxf(s[0][qb][2], s[0][qb][3])), fmaxf(fmaxf(s[1][qb][0], s[1][qb][1]), fmaxf(s[1][qb][2], s[1][qb][3])));
                mx = fmaxf(mx, __shfl_xor(mx, 16)); mx = fmaxf(mx, __shfl_xor(mx, 32));
                const float mn = fmaxf(mrun[qb], mx), alpha = exp2f(mrun[qb] - mn); mrun[qb] = mn;
                float p[8]; float ps = 0.f;
#pragma unroll
                for (int kb = 0; kb < 2; ++kb)
#pragma unroll
                    for (int r = 0; r < 4; ++r) { p[kb * 4 + r] = exp2f(s[kb][qb][r] - mn); ps += p[kb * 4 + r]; }
                ps += __shfl_xor(ps, 16); ps += __shfl_xor(ps, 32);
                lrun[qb] = lrun[qb] * alpha + ps;
#pragma unroll
                for (int db = 0; db < 8; ++db) o[db][qb] = o[db][qb] * alpha;
                u32x4 pw; pw.x = pk2(p[0], p[1]); pw.y = pk2(p[2], p[3]); pw.z = pk2(p[4], p[5]); pw.w = pk2(p[6], p[7]); pf[qb] = __builtin_bit_cast(bf16x8, pw);
            }
#pragma unroll
            for (int db = 0; db < 8; ++db) {
                const LAS bf16* vp = Vs + (db * 16 + lc) * 136 + kq * 32 + 4 * g4;
                const u32x2 v0 = *(const LAS u32x2*)vp, v1 = *(const LAS u32x2*)(vp + 16);
                const u32x4 vw = (u32x4){v0.x, v0.y, v1.x, v1.y}; const bf16x8 vf = __builtin_bit_cast(bf16x8, vw);
#pragma unroll
                for (int qb = 0; qb < 2; ++qb) o[db][qb] = MFMA16(vf, pf[qb], o[db][qb]);
            }
        }
    }
    __syncthreads();
    LAS float* OW = (LAS float*)F.lds; LAS float* ML = OW + 8 * 128 * 33;
#pragma unroll
    for (int db = 0; db < 8; ++db)
#pragma unroll
        for (int qb = 0; qb < 2; ++qb)
#pragma unroll
            for (int r = 0; r < 4; ++r) OW[(w * 128 + db * 16 + 4 * g4 + r) * 33 + qb * 16 + lc] = o[db][qb][r];
    if (g4 == 0) {
#pragma unroll
        for (int qb = 0; qb < 2; ++qb) { ML[(w * 32 + qb * 16 + lc) * 2] = mrun[qb]; ML[(w * 32 + qb * 16 + lc) * 2 + 1] = lrun[qb]; } }
    __syncthreads();
    { const int q = tid >> 3, dv0 = (tid & 7) * 16, qhh = q >> 5, ql = q & 31; float mw[4], lw[4]; float mstar = -1e30f;
#pragma unroll
      for (int k = 0; k < 4; ++k) { mw[k] = ML[((qhh * 4 + k) * 32 + ql) * 2]; lw[k] = ML[((qhh * 4 + k) * 32 + ql) * 2 + 1]; mstar = fmaxf(mstar, mw[k]); }
      float lt = 0.f, sc[4];
#pragma unroll
      for (int k = 0; k < 4; ++k) { sc[k] = exp2f(mw[k] - mstar); lt += lw[k] * sc[k]; }
      const float inv = 1.0f / lt; float ov[16];
#pragma unroll
      for (int i = 0; i < 16; ++i) { float v = 0.f;
#pragma unroll
          for (int k = 0; k < 4; ++k) v += OW[((qhh * 4 + k) * 128 + dv0 + i) * 33 + ql] * sc[k];
          ov[i] = v * inv; }
      bf16* ob = (bf16*)(ws + WS_OB) + (size_t)(c * 64 + q) * D + 1024 + h * 128 + dv0;
      u32x4 o0, o1; o0.x = pk2(ov[0], ov[1]); o0.y = pk2(ov[2], ov[3]); o0.z = pk2(ov[4], ov[5]); o0.w = pk2(ov[6], ov[7]); o1.x = pk2(ov[8], ov[9]); o1.y = pk2(ov[10], ov[11]); o1.z = pk2(ov[12], ov[13]); o1.w = pk2(ov[14], ov[15]);
      *(GAS u32x4*)ob = o0; *(GAS u32x4*)(ob + 8) = o1; }
    __syncthreads();
}

constexpr int STEPS_PER_LAYER = 12, NSTEPS = 1 + DEPTH * STEPS_PER_LAYER;
constexpr int NSCAN_BLK = 64;

__global__ void __launch_bounds__(NTHR, 2) mk_fwd(Args args) {
    extern __shared__ __attribute__((aligned(16))) unsigned char lds_raw[];
    Frame F;
    F.lds = (LAS unsigned char*)lds_raw; F.MISC = (volatile LAS unsigned*)(F.lds + MISC_OFF);
    F.tid = threadIdx.x; F.lane = F.tid & 63; F.wave = __builtin_amdgcn_readfirstlane(F.tid >> 6);
    F.G = gridDim.x; F.bid = blockIdx.x; F.ws = args.ws; F.ctl = (gu32*)(args.ws + WS_CTL);
    for (int u = F.tid; u < (LDS_BYTES - LDSCTL_OFF) / 4; u += NTHR) ((LAS unsigned*)(F.lds + LDSCTL_OFF))[u] = 0u;
    __syncthreads();
    const int lo = args.st_lo, hi = args.st_hi;
    XcdBarrier bar; bar.bar = (unsigned*)(F.ctl + CW_BAR); bar.x = 0; bar.st = nullptr;
    if (hi - lo > 1) bar = xcd_barrier_post((unsigned*)(F.ctl + CW_BAR), F.MISC + 8);
#ifndef MK_MASK
#define MK_MASK 0xFFFFu
#endif
#define EN(k) (((MK_MASK) >> (k)) & 1u)
#define RUN(s) (lo <= (s) && (s) < hi)
#define SEAM(s) do { if ((s) + 1 < hi) xcd_barrier(bar); } while (0)

    if (EN(12) && RUN(0)) { relaunder(F, args.ws, (LAS unsigned char*)lds_raw); p_prologue(F, args); SEAM(0); }

    for (int l = 0; l < DEPTH; ++l) {
        const int sb = 1 + l * STEPS_PER_LAYER;
        const float* xin = (l == 0) ? args.in[0] : args.out;
        if (EN(0) && RUN(sb + 0)) { relaunder(F, args.ws, (LAS unsigned char*)lds_raw); unsigned char* ws = F.ws; p_rmsnorm(F, xin, (const float*)(ws + WS_PRM) + (size_t)l * PRM_STRIDE + P_N1, (bf16*)(ws + WS_XN)); SEAM(sb + 0); }
        if (EN(1) && RUN(sb + 1)) { relaunder(F, args.ws, (LAS unsigned char*)lds_raw); unsigned char* ws = F.ws;
            pg8::Gemm g{(const bf16*)(ws + WS_XN), (const bf16*)(ws + WS_WIN) + (size_t)l * NINP * D, D, D, D};
            pg8::StaticOrder So; So.init(S, NINP, F.G, F.bid); pg8::EpiIn E{ws};
            pg8::gemm_phase<pg8::EpiIn, pg8::StaticOrder, true>(F.lds, g, So, E, F.tid);
            SEAM(sb + 1);
        }
        if (EN(2) && RUN(sb + 2)) { relaunder(F, args.ws, (LAS unsigned char*)lds_raw); unsigned char* ws = F.ws;
            p_rwkv_prep(F, l);
            relaunder(F, args.ws, (LAS unsigned char*)lds_raw); p_mamba_prep(F, l);
            __syncthreads(); relaunder(F, args.ws, (LAS unsigned char*)lds_raw);
            for (int u = (F.bid + 128) % F.G; u < 512; u += F.G) u_ret_kv(F, u >> 2, u & 3);
            SEAM(sb + 2);
        }
        if (EN(3) && RUN(sb + 3)) { relaunder(F, args.ws, (LAS unsigned char*)lds_raw); unsigned char* ws = F.ws;
            { pg8::Gemm g{(const bf16*)(ws + WS_CQ), (const bf16*)(ws + WS_WQB) + (size_t)l * 1024 * 512, 512, 512, 512};
              pg8::StaticOrder So; So.init(S, 1024, F.G, F.bid); pg8::EpiQb E{ws, (const float*)(ws + WS_PRM) + (size_t)l * PRM_STRIDE + P_QNW};
              pg8::gemm_phase<pg8::EpiQb, pg8::StaticOrder, false>(F.lds, g, So, E, F.tid); __syncthreads(); }
            relaunder(F, args.ws, (LAS unsigned char*)lds_raw); ws = F.ws;
            { pg8::Gemm g{(const bf16*)(ws + WS_CKV), (const bf16*)(ws + WS_WKVB) + (size_t)l * 1024 * 256, 256, 256, 256};
              pg8::StaticOrder So; So.init(S, 1024, F.G, (F.bid + 128) % F.G); pg8::EpiKvb E{ws, (const float*)(ws + WS_PRM) + (size_t)l * PRM_STRIDE + P_KNW};
              pg8::gemm_phase<pg8::EpiKvb, pg8::StaticOrder, false>(F.lds, g, So, E, F.tid); __syncthreads(); }
            relaunder(F, args.ws, (LAS unsigned char*)lds_raw); ws = F.ws;
            if (l > 0) { pg8::Gemm g{(const bf16*)(ws + WS_VB), (const bf16*)(ws + WS_WV1) + (size_t)l * 256 * 512, 512, 512, 512};
              pg8::StaticOrder So; So.init(S, 256, F.G, (F.bid + 64) % F.G); pg8::EpiV1 E{ws};
              pg8::gemm_phase<pg8::EpiV1, pg8::StaticOrder, true>(F.lds, g, So, E, F.tid); __syncthreads(); }
            relaunder(F, args.ws, (LAS unsigned char*)lds_raw);
            for (int u = F.bid; u < 256; u += F.G) u_mamba_st(F, u >> 1, u & 1);
            SEAM(sb + 3);
        }
        if (EN(4) && RUN(sb + 4)) { relaunder(F, args.ws, (LAS unsigned char*)lds_raw); unsigned char* ws = F.ws;
            p_scans(F);
            relaunder(F, args.ws, (LAS unsigned char*)lds_raw); ws = F.ws;
            { pg8::Gemm g{(const bf16*)(ws + WS_ALORA), (const bf16*)(ws + WS_WLORA) + (size_t)l * 2048 * 512, 512, 512, 512};
              pg8::StaticOrder So; So.init(S, l > 0 ? 2048 : 1536, F.G, F.bid);
              const float* prm = (const float*)(ws + WS_PRM) + (size_t)l * PRM_STRIDE; pg8::EpiLora E{ws, prm + P_W0, prm + P_A0, prm + P_V0, prm + P_KA};
              pg8::gemm_phase<pg8::EpiLora, pg8::StaticOrder, true>(F.lds, g, So, E, F.tid); }
            SEAM(sb + 4);
        }
        if (EN(5) && RUN(sb + 5)) { relaunder(F, args.ws, (LAS unsigned char*)lds_raw); unsigned char* ws = F.ws;
            if (F.bid < NSCAN_BLK) p_rwkv_scan(F, NSCAN_BLK);
            else {
                const int NB = F.G - NSCAN_BLK, b = F.bid - NSCAN_BLK;
                for (int r = 0; r * NB < 512; ++r) { const int pos = (r & 1) ? NB - 1 - b : b; const int i = r * NB + pos; if (i < 512) u_attn(F, 127 - (i >> 2), i & 3); }
                relaunder(F, args.ws, (LAS unsigned char*)lds_raw);
                for (int u = b; u < 512; u += NB) u_ret_out(F, l, u >> 2, u & 3);
                relaunder(F, args.ws, (LAS unsigned char*)lds_raw);
                for (int u = b; u < 256; u += NB) u_mamba_out(F, l, u >> 1, u & 1);
            }
            SEAM(sb + 5);
        }
        if (EN(6) && RUN(sb + 6)) { relaunder(F, args.ws, (LAS unsigned char*)lds_raw); unsigned char* ws = F.ws; p_rwkv_post(F, l); SEAM(sb + 6); }
        if (EN(7) && RUN(sb + 7)) { relaunder(F, args.ws, (LAS unsigned char*)lds_raw); unsigned char* ws = F.ws;
            pg8::Gemm g{(const bf16*)(ws + WS_OB), (const bf16*)(ws + WS_WBR) + (size_t)l * 8192 * 512, 512, D, 512};
            pg8::BranchOrder So; So.init(F.G, F.bid); pg8::EpiBranch E{ws};
            pg8::gemm_phase<pg8::EpiBranch, pg8::BranchOrder, true>(F.lds, g, So, E, F.tid);
            SEAM(sb + 7);
        }
        if (EN(8) && RUN(sb + 8)) { relaunder(F, args.ws, (LAS unsigned char*)lds_raw); unsigned char* ws = F.ws;
            pg8::Gemm g{(const bf16*)(ws + WS_MERGED), (const bf16*)(ws + WS_WOUT) + (size_t)l * D * D, D, D, D};
            pg8::StaticOrder So; So.init(S, D, F.G, F.bid); pg8::EpiRes E{xin, args.out};
            pg8::gemm_phase<pg8::EpiRes, pg8::StaticOrder, true>(F.lds, g, So, E, F.tid);
            SEAM(sb + 8);
        }
        if (EN(9) && RUN(sb + 9)) { relaunder(F, args.ws, (LAS unsigned char*)lds_raw); unsigned char* ws = F.ws; p_rmsnorm(F, args.out, (const float*)(ws + WS_PRM) + (size_t)l * PRM_STRIDE + P_N2, (bf16*)(ws + WS_XN)); SEAM(sb + 9); }
        if (EN(10) && RUN(sb + 10)) { relaunder(F, args.ws, (LAS unsigned char*)lds_raw); unsigned char* ws = F.ws;
            pg8::Gemm g{(const bf16*)(ws + WS_XN), (const bf16*)(ws + WS_WGU) + (size_t)l * 2 * DFF * D, D, D, D};
            pg8::StaticOrder So; So.init(S, 2 * DFF, F.G, F.bid); pg8::EpiGu E{ws};
            pg8::gemm_phase<pg8::EpiGu, pg8::StaticOrder, true>(F.lds, g, So, E, F.tid);
            SEAM(sb + 10);
        }
        if (EN(11) && RUN(sb + 11)) { relaunder(F, args.ws, (LAS unsigned char*)lds_raw); unsigned char* ws = F.ws;
            pg8::Gemm g{(const bf16*)(ws + WS_ACT), (const bf16*)(ws + WS_WDN) + (size_t)l * D * DFF, DFF, DFF, DFF};
            pg8::StaticOrder So; So.init(S, D, F.G, F.bid); pg8::EpiRes E{args.out, args.out};
            pg8::gemm_phase<pg8::EpiRes, pg8::StaticOrder, true>(F.lds, g, So, E, F.tid);
            SEAM(sb + 11);
        }
    }
#undef RUN
#undef SEAM
}

#ifndef MK_ONE_LAUNCH
#define MK_ONE_LAUNCH 1
#endif
extern "C" void kernel_launch(void* const* d_in, const int* in_sizes, int n_in, void* d_out, int out_size, void* d_ws, size_t ws_size, hipStream_t stream) {
    static int grid = 0;
    if (grid == 0) {
        if (n_in != 36 || in_sizes[0] != S * D || out_size != S * D || ws_size < WS_END) { fprintf(stderr, "kernel_launch: bad shapes: n_in %d in0 %d out %d ws %zu (need %zu)\n", n_in, n_in > 0 ? in_sizes[0] : -1, out_size, ws_size, (size_t)WS_END); grid = -1; return; }
        int dev = 0, cus = 0, per_cu = 0;
        if (hipGetDevice(&dev) != hipSuccess || hipDeviceGetAttribute(&cus, hipDeviceAttributeMultiprocessorCount, dev) != hipSuccess) { grid = -1; return; }
        if (hipFuncSetAttribute((const void*)mk_fwd, hipFuncAttributeMaxDynamicSharedMemorySize, LDS_BYTES) != hipSuccess) { fprintf(stderr, "kernel_launch: hipFuncSetAttribute failed\n"); grid = -1; return; }
        if (hipOccupancyMaxActiveBlocksPerMultiprocessor(&per_cu, (const void*)mk_fwd, NTHR, LDS_BYTES) != hipSuccess || per_cu < 1) fprintf(stderr, "kernel_launch: occupancy query says %d\n", per_cu);
        (void)hipGetLastError();
        grid = cus;
        if (grid != 256) fprintf(stderr, "kernel_launch: %d CUs (built for 256)\n", grid);
    }
    if (grid < 0) return;
    if (hipMemsetAsync((char*)d_ws + WS_CTL, 0, CTL_ZERO_BYTES, stream) != hipSuccess) return;
    Args a{};
    for (int i = 0; i < 36; ++i) a.in[i] = (const float*)d_in[i];
    a.out = (float*)d_out; a.ws = (unsigned char*)d_ws;
#if MK_ONE_LAUNCH
    a.st_lo = 0; a.st_hi = NSTEPS;
    hipLaunchKernelGGL(mk_fwd, dim3(grid), dim3(NTHR), LDS_BYTES, stream, a);
#else
    for (int s = 0; s < NSTEPS; ++s) { a.st_lo = s; a.st_hi = s + 1; hipLaunchKernelGGL(mk_fwd, dim3(grid), dim3(NTHR), LDS_BYTES, stream, a); }
#endif
}
```

```cpp
#include <hip/hip_runtime.h>
#include <cstdio>
#include <cstdint>

#define GAS __attribute__((address_space(1)))
#define LAS __attribute__((address_space(3)))
typedef unsigned short bf16;
typedef short bf16x8 __attribute__((ext_vector_type(8)));
typedef short s16x4 __attribute__((ext_vector_type(4)));
typedef float f32x4 __attribute__((ext_vector_type(4)));
typedef float f32x2 __attribute__((ext_vector_type(2)));
typedef unsigned u32x4 __attribute__((ext_vector_type(4)));
typedef unsigned u32x2 __attribute__((ext_vector_type(2)));
typedef GAS unsigned gu32;
#define RLX_AGENT __ATOMIC_RELAXED, __HIP_MEMORY_SCOPE_AGENT
#define DI __device__ __forceinline__

constexpr int S = 8192, D = 2048, DEPTH = 4, NIN = 14408, NINP = 14592, DFF = 5632;
constexpr int NCH = 128;
constexpr float LOG2E = 1.4426950408889634f;

DI float bf2f(unsigned v) { return __uint_as_float(v << 16); }
DI unsigned f2bf(float f) { unsigned u = __float_as_uint(f); return (u + 0x7fffu + ((u >> 16) & 1u)) >> 16; }
DI unsigned pk2(float lo, float hi) { unsigned r; asm volatile("v_cvt_pk_bf16_f32 %0, %1, %2" : "=v"(r) : "v"(lo), "v"(hi)); return r; }
DI float sigmoidf_(float x) { return 1.0f / (1.0f + __expf(-x)); }
DI float siluf_(float x) { return x / (1.0f + __expf(-x)); }
DI float softplusf_(float x) { return fmaxf(x, 0.f) + log1pf(__expf(-fabsf(x))); }
DI u32x4 pack8(const f32x4 a, const f32x4 b) { u32x4 w; w.x = pk2(a[0], a[1]); w.y = pk2(a[2], a[3]); w.z = pk2(b[0], b[1]); w.w = pk2(b[2], b[3]); return w; }
DI void unpack8(const u32x4 w, float (&o)[8]) { o[0] = bf2f(w.x & 0xffffu); o[1] = bf2f(w.x >> 16); o[2] = bf2f(w.y & 0xffffu); o[3] = bf2f(w.y >> 16);
    o[4] = bf2f(w.z & 0xffffu); o[5] = bf2f(w.z >> 16); o[6] = bf2f(w.w & 0xffffu); o[7] = bf2f(w.w >> 16); }

namespace pg8 {
constexpr int BM = 256, BK = 64, HALF = 128, HTB = HALF * BK * 2, STAGE_BYTES = 8 * HTB, NXCD = 8, WGM = 8;
DI int lds_byte(int r, int c) { const int st = (r >> 4) * 2 + (c >> 5), rr = r & 15, cc = c & 31, ob = rr * 64 + cc * 2; return st * 1024 + (ob ^ (((ob >> 9) & 1) << 5)); }
DI void stage_rc(int b, int& R, int& C) { const int st = b / 1024, sb = b % 1024, swz = sb ^ (((sb >> 9) & 1) << 5); R = (st >> 1) * 16 + swz / 64; C = (st & 1) * 32 + (swz % 64) / 2; }
DI int perm32(int rho) { const int n = rho >> 4, i = rho & 15; return 8 * (i >> 2) + 4 * n + (i & 3); }

struct Unit { int pm, pn, ak, brow, sub; };
struct Gemm { const bf16* A; const bf16* Bt; int K, lda, ldb; };

struct StaticOrder {
    int nM, nN, nwg, G, c;
    DI void init(int M, int N, int G_, int c_) { nM = M / BM; nN = N / BM; nwg = nM * nN; G = G_; c = c_; }
    DI bool next(int i, Unit& u) const {
        const long L = (long)i * G + c; if (L >= nwg) return false;
        int wgid = (int)L; { const int q = nwg / NXCD, r = nwg % NXCD, xcd = wgid % NXCD, off = wgid / NXCD; wgid = (xcd < r ? xcd * (q + 1) : r * (q + 1) + (xcd - r) * q) + off; }
        const int nig = WGM * nN, gid = wgid / nig, fm = gid * WGM, gsz = (nM - fm) < WGM ? (nM - fm) : WGM;
        u.pm = fm + ((wgid % nig) % gsz); u.pn = (wgid % nig) / gsz; u.ak = 0; u.brow = u.pn * BM; u.sub = 0; return true;
    }
};
struct BranchOrder {
    StaticOrder so;
    DI void init(int G_, int c_) { so.init(S, D, G_, c_); }
    DI bool next(int i, Unit& u) const { if (!so.next(i >> 2, u)) return false; u.sub = i & 3; u.ak = u.sub * 512; u.brow = u.sub * D + u.pn * BM; return true; }
};

typedef f32x4 Acc[2][2][4][2];

template <class Epi, class Sched, bool ALIGN_EPI>
DI void gemm_phase(LAS unsigned char* lds, const Gemm g, const Sched& Sc, const Epi& E, const int tid) {
    const int wid = __builtin_amdgcn_readfirstlane(tid >> 6), lane = tid & 63, wr = wid >> 2, wc = wid & 3, fr = lane & 15, fq = lane >> 4;
    const int K = g.K, nt = K / BK;
    unsigned voffA[2], voffB[2];
#pragma unroll
    for (int i = 0; i < 2; ++i) { int R, C; stage_rc(tid * 16 + i * 8192, R, C); const int Rb = (R & ~31) + perm32(R & 31);
        voffA[i] = (unsigned)(R * g.lda + C) * 2u; voffB[i] = (unsigned)(Rb * g.ldb + C) * 2u; }
    const size_t kstep = (size_t)(BK * 2);
    const size_t hA = (size_t)HALF * g.lda * 2, hB = (size_t)HALF * g.ldb * 2;
    const unsigned ldsw = (unsigned)wid * 1024u;
    const int aoff = lds_byte(wr * 64 + fr, fq * 8), boff = lds_byte(wc * 32 + fr, fq * 8);
#define PG8_SA(b, h) (((b) * 2 + (h)) * HTB)
#define PG8_SB(b, h) ((4 + (b) * 2 + (h)) * HTB)
#define PG8_STAGE(bufoff, gbase, voff) do { _Pragma("unroll") for (int _i = 0; _i < 2; ++_i) \
        __builtin_amdgcn_global_load_lds((const unsigned*)((const char*)(gbase) + (voff)[_i]), (LAS unsigned*)(lds + (bufoff) + ldsw + _i * 8192), 16, 0, 0); } while (0)
#define PG8_LDA(dst, b, h) do { _Pragma("unroll") for (int m = 0; m < 4; ++m) _Pragma("unroll") for (int k = 0; k < 2; ++k) dst[m][k] = *(const LAS bf16x8*)(lds + PG8_SA(b, h) + aoff + m * 2048 + k * 1024); } while (0)
#define PG8_LDB(dst, b, h) do { _Pragma("unroll") for (int n = 0; n < 2; ++n) _Pragma("unroll") for (int k = 0; k < 2; ++k) dst[n][k] = *(const LAS bf16x8*)(lds + PG8_SB(b, h) + boff + n * 2048 + k * 1024); } while (0)
#define PG8_MMA(ai, bj, At, Bt) do { __builtin_amdgcn_s_setprio(1); _Pragma("unroll") for (int m = 0; m < 4; ++m) _Pragma("unroll") for (int n = 0; n < 2; ++n) _Pragma("unroll") for (int k = 0; k < 2; ++k) \
        acc[ai][bj][m][n] = __builtin_amdgcn_mfma_f32_16x16x32_bf16(Bt[n][k], At[m][k], acc[ai][bj][m][n], 0, 0, 0); __builtin_amdgcn_s_setprio(0); } while (0)
#define PG8_WAIT_V(n) asm volatile("s_waitcnt vmcnt(" #n ")" ::: "memory")
#define PG8_WAIT_L(n) asm volatile("s_waitcnt lgkmcnt(" #n ")" ::: "memory")
#define PG8_BAR __builtin_amdgcn_s_barrier()
#define PG8_SCHED __builtin_amdgcn_sched_barrier(0)
    Unit cur, nxt; int ui = 0;
    if (!Sc.next(0, cur)) return;
    Acc acc;
#pragma unroll
    for (int a = 0; a < 2; ++a)
#pragma unroll
        for (int b = 0; b < 2; ++b)
#pragma unroll
            for (int m = 0; m < 4; ++m)
#pragma unroll
                for (int n = 0; n < 2; ++n) acc[a][b][m][n] = (f32x4){0.f, 0.f, 0.f, 0.f};
    bf16x8 At[4][2], B0[2][2], B1[2][2];
    const char* cA = (const char*)g.A + ((size_t)cur.pm * BM * g.lda + cur.ak) * 2; const char* cB = (const char*)g.Bt + (size_t)cur.brow * g.ldb * 2;
    PG8_STAGE(PG8_SB(0, 0), cB, voffB); PG8_STAGE(PG8_SB(0, 1), cB + hB, voffB); PG8_STAGE(PG8_SA(0, 0), cA, voffA); PG8_STAGE(PG8_SA(0, 1), cA + hA, voffA);
    if (wr == 1) PG8_BAR;
    PG8_WAIT_V(2); PG8_BAR;
    PG8_STAGE(PG8_SB(1, 0), cB + kstep, voffB); PG8_STAGE(PG8_SA(1, 0), cA + kstep, voffA); PG8_STAGE(PG8_SB(1, 1), cB + hB + kstep, voffB);
    PG8_WAIT_V(6); PG8_BAR;
    for (;;) {
        const bool has_next = Sc.next(ui + 1, nxt);
        const char* nA = has_next ? (const char*)g.A + ((size_t)nxt.pm * BM * g.lda + nxt.ak) * 2 : cA; const char* nB = has_next ? (const char*)g.Bt + (size_t)nxt.brow * g.ldb * 2 : cB;
        for (int t = 0; t < nt; t += 2) {
            const bool last = (t == nt - 2);
            const char* a1 = cA + (size_t)(t + 1) * kstep;
            const char* a2 = last ? nA : cA + (size_t)(t + 2) * kstep; const char* b2 = last ? nB : cB + (size_t)(t + 2) * kstep;
            const char* a3 = a2 + kstep; const char* b3 = b2 + kstep;
            PG8_LDB(B0, 0, 0); PG8_LDB(B1, 0, 1); PG8_SCHED; PG8_LDA(At, 0, 0); PG8_STAGE(PG8_SA(1, 1), a1 + hA, voffA);
            PG8_WAIT_V(8); PG8_WAIT_L(0); PG8_BAR; PG8_MMA(0, 0, At, B0); PG8_MMA(0, 1, At, B1); PG8_BAR; PG8_SCHED;
            PG8_LDA(At, 0, 1); PG8_STAGE(PG8_SB(0, 0), b2, voffB); PG8_STAGE(PG8_SB(0, 1), b2 + hB, voffB); PG8_STAGE(PG8_SA(0, 0), a2, voffA);
            PG8_WAIT_V(8); PG8_WAIT_L(0); PG8_BAR; PG8_MMA(1, 0, At, B0); PG8_MMA(1, 1, At, B1); PG8_BAR; PG8_SCHED;
            PG8_LDB(B0, 1, 0); PG8_LDB(B1, 1, 1); PG8_SCHED; PG8_LDA(At, 1, 0); PG8_STAGE(PG8_SA(0, 1), a2 + hA, voffA);
            PG8_WAIT_V(8); PG8_WAIT_L(0); PG8_BAR; PG8_MMA(0, 0, At, B0); PG8_MMA(0, 1, At, B1); PG8_BAR; PG8_SCHED;
            PG8_LDA(At, 1, 1); PG8_STAGE(PG8_SB(1, 0), b3, voffB); PG8_STAGE(PG8_SB(1, 1), b3 + hB, voffB); PG8_STAGE(PG8_SA(1, 0), a3, voffA);
            PG8_WAIT_V(8); PG8_WAIT_L(0); PG8_BAR; PG8_MMA(1, 0, At, B0); PG8_MMA(1, 1, At, B1); PG8_BAR; PG8_SCHED;
        }
        if constexpr (ALIGN_EPI) { if (wr == 0) PG8_BAR; }
        bool zero = true;
        if constexpr (!Epi::AFTER_DRAIN) { zero = E(acc, cur, wr, wc, fr, fq); }
        if (!has_next) break;
        if (zero) {
#pragma unroll
        for (int a = 0; a < 2; ++a)
#pragma unroll
            for (int b = 0; b < 2; ++b)
#pragma unroll
                for (int m = 0; m < 4; ++m)
#pragma unroll
                    for (int n = 0; n < 2; ++n) acc[a][b][m][n] = (f32x4){0.f, 0.f, 0.f, 0.f};
        }
        cur = nxt; cA = nA; cB = nB; ++ui;
        if constexpr (ALIGN_EPI) { if (wr == 1) PG8_BAR; }
    }
    PG8_WAIT_V(0);
    if constexpr (!ALIGN_EPI) { if (wr == 0) PG8_BAR; }
    PG8_BAR;
    if constexpr (Epi::AFTER_DRAIN) { E.fused(acc, cur, wr, wc, fr, fq, lds, wid, lane, tid); }
#undef PG8_SA
#undef PG8_SB
#undef PG8_STAGE
#undef PG8_LDA
#undef PG8_LDB
#undef PG8_MMA
#undef PG8_WAIT_V
#undef PG8_WAIT_L
#undef PG8_BAR
#undef PG8_SCHED
}
}

constexpr size_t MiB = 1u << 20;
constexpr size_t al256(size_t x) { return (x + 255) & ~(size_t)255; }
constexpr size_t WS_CTL = 0, CTL_ZERO_BYTES = 1 * MiB;
constexpr size_t WS_PRM = 1 * MiB;
constexpr int P_N1 = 0, P_N2 = 2048, P_GN = 4096, P_CW = 4608, P_CB = 8704, P_DTB = 9728, P_ALOG = 9736, P_SD = 9744, P_SNW = 9760, P_QNW = 10272, P_KNW = 10464, P_MU = 10656,
              P_W0 = 12448, P_A0 = 12960, P_V0 = 13472, P_KK = 13984, P_KA = 14496, P_RK = 15008, P_LNW = 15520, P_LNB = 16032, PRM_STRIDE = 16640;
constexpr size_t WS_COSR = 2 * MiB;
constexpr size_t WS_SINR = WS_COSR + (size_t)S * 64 * 4;
constexpr size_t WS_COSM = WS_SINR + (size_t)S * 64 * 4;
constexpr size_t WS_SINM = WS_COSM + (size_t)S * 32 * 4;
constexpr size_t WS_WIN  = WS_SINM + (size_t)S * 32 * 4;
constexpr size_t WS_WQB  = WS_WIN + (size_t)DEPTH * NINP * D * 2;
constexpr size_t WS_WKVB = WS_WQB + (size_t)DEPTH * 1024 * 512 * 2;
constexpr size_t WS_WV1  = WS_WKVB + (size_t)DEPTH * 1024 * 256 * 2;
constexpr size_t WS_WLORA = WS_WV1 + (size_t)DEPTH * 256 * 512 * 2;
constexpr size_t WS_WBR  = WS_WLORA + (size_t)DEPTH * 2048 * 512 * 2;
constexpr size_t WS_WOUT = WS_WBR + (size_t)DEPTH * 8192 * 512 * 2;
constexpr size_t WS_WGU  = WS_WOUT + (size_t)DEPTH * D * D * 2;
constexpr size_t WS_WDN  = WS_WGU + (size_t)DEPTH * 2 * DFF * D * 2;
constexpr size_t WS_ACT0 = WS_WDN + (size_t)DEPTH * D * DFF * 2;
constexpr size_t WS_XN   = WS_ACT0;
constexpr size_t WS_QR   = WS_XN + (size_t)S * D * 2;
constexpr size_t WS_KR   = WS_QR + (size_t)S * 512 * 2;
constexpr size_t WS_VR   = WS_KR + (size_t)S * 512 * 2;
constexpr size_t WS_GR   = WS_VR + (size_t)S * 512 * 2;
constexpr size_t WS_ZS   = WS_GR + (size_t)S * 512 * 2;
constexpr size_t WS_XBC  = WS_ZS + (size_t)S * 512 * 2;
constexpr size_t WS_XC   = WS_XBC + (size_t)S * 1024 * 2;
constexpr size_t WS_CQ   = WS_XC + (size_t)S * 1024 * 2;
constexpr size_t WS_CKV  = WS_CQ + (size_t)S * 512 * 2;
constexpr size_t WS_SSQ  = WS_CKV + (size_t)S * 256 * 2;
constexpr size_t WS_RW   = WS_SSQ + (size_t)S * 16 * 4;
constexpr size_t WS_GATE = WS_RW + (size_t)S * 1792 * 4;
constexpr size_t WS_MISC = WS_GATE + (size_t)S * 8192 * 2;
constexpr size_t WS_DTS  = WS_MISC + (size_t)S * 256 * 4;
constexpr size_t WS_ACS  = WS_DTS + (size_t)S * 8 * 4;
constexpr size_t WS_RKV  = WS_ACS + (size_t)S * 8 * 4;
constexpr size_t WS_MST  = WS_RKV + (size_t)NCH * 4 * 128 * 128 * 4;
constexpr size_t WS_QM   = WS_MST + (size_t)NCH * 8 * 64 * 128 * 4;
constexpr size_t WS_KM   = WS_QM + (size_t)S * 768 * 2;
constexpr size_t WS_VT   = WS_KM + (size_t)S * 768 * 2;
constexpr size_t WS_R32  = WS_VT + (size_t)512 * S * 2;
constexpr size_t SZ32    = (size_t)S * 512 * 4;
constexpr size_t WS_KKN  = WS_R32 + SZ32, WS_K32 = WS_KKN + SZ32, WS_VV = WS_K32 + SZ32, WS_VFIRST = WS_VV + SZ32, WS_DEC = WS_VFIRST + SZ32,
                 WS_KP = WS_DEC + SZ32, WS_BB = WS_KP + SZ32, WS_G32 = WS_BB + SZ32, WS_Y32 = WS_G32 + SZ32;
constexpr size_t WS_VB   = WS_Y32 + SZ32;
constexpr size_t WS_ALORA = WS_VB + (size_t)S * 512 * 2;
constexpr size_t WS_OB   = WS_ALORA + (size_t)S * 512 * 2;
constexpr size_t WS_MERGED = WS_OB + (size_t)S * D * 2;
constexpr size_t WS_ACT  = WS_MERGED + (size_t)S * D * 2;
constexpr size_t WS_END  = WS_ACT + (size_t)S * DFF * 2;

constexpr int CW_TMO = 0, CW_CODE = 1, CW_BAR = 4096;

constexpr int NWAVES = 8, NTHR = 512;
constexpr int RING_BYTES = 143360, LDSCTL_OFF = RING_BYTES, MISC_OFF = LDSCTL_OFF + 320, LDS_BYTES = 147456;
#define LDS_WAIT() asm volatile("s_waitcnt lgkmcnt(0)" ::: "memory")
#define VM_WAIT() asm volatile("s_waitcnt vmcnt(0)" ::: "memory")

#define XB_TMO      128
#define XB_XCNT(j)  (256  + 64 * (j))
#define XB_XSUB(j)  (1280 + 64 * (j))
#define XB_XGEN(j)  (2304 + 64 * (j))
#define XB_TOP      3328
#define XB_TOPGEN   3392
#define XCD_BAR_WORDS 3456
#define XB_SPIN_CAP (1u << 22)
DI unsigned xb_ld(unsigned* p)              { return __hip_atomic_load(p, __ATOMIC_RELAXED, __HIP_MEMORY_SCOPE_AGENT); }
DI unsigned xb_add(unsigned* p, unsigned v) { return __hip_atomic_fetch_add(p, v, __ATOMIC_RELAXED, __HIP_MEMORY_SCOPE_AGENT); }
DI unsigned xb_xcc_id() { return (unsigned)__builtin_amdgcn_s_getreg((3 << 11) | 20) & 0xFu; }
#define XB_SPIN(cond, bar) do { unsigned _sp = 0; while (cond) { __builtin_amdgcn_s_sleep(1); \
    if ((++_sp & 255u) == 0u) { if (xb_ld(&(bar)[XB_TMO])) break; if (_sp > XB_SPIN_CAP) { atomicAdd(&(bar)[XB_TMO], 1u); break; } } } } while (0)
struct XcdBarrier { unsigned* bar; unsigned x; volatile LAS unsigned* st; };
DI XcdBarrier xcd_barrier_post(unsigned* bar, volatile LAS unsigned* st) {
    XcdBarrier b; b.bar = bar; b.x = xb_xcc_id(); b.st = st;
    if (threadIdx.x == 0) (void)xb_add(&bar[XB_XCNT(b.x)], 1u);
    return b;
}
DI void xcd_barrier_complete(unsigned* bar, unsigned x, unsigned& nloc, unsigned& nx) {
    const unsigned G = gridDim.x * gridDim.y * gridDim.z;
    unsigned sum, cnt, mine, sp = 0u;
    for (;;) {
        sum = 0u; cnt = 0u; mine = 0u;
#pragma unroll
        for (unsigned j = 0; j < 16; ++j) { const unsigned c = xb_ld(&bar[XB_XCNT(j)]); sum += c; cnt += (c > 0u) ? 1u : 0u; mine = (j == x) ? c : mine; }
        if (sum == G) break;
        __builtin_amdgcn_s_sleep(1);
        if ((++sp & 255u) == 0u) { if (xb_ld(&bar[XB_TMO])) break; if (sp > XB_SPIN_CAP) { atomicAdd(&bar[XB_TMO], 1u); break; } }
    }
    nloc = mine > 0u ? mine : 1u; nx = cnt > 0u ? cnt : 1u;
}
DI void xcd_barrier(const XcdBarrier& b) {
    asm volatile("s_waitcnt vmcnt(0)" ::: "memory");
    __syncthreads();
    if (threadIdx.x == 0) {
        unsigned* bar = b.bar;
        __builtin_amdgcn_s_waitcnt(0);
        unsigned nloc = b.st[0], nx = b.st[1];
        if (nloc == 0u) { xcd_barrier_complete(bar, b.x, nloc, nx); b.st[0] = nloc; b.st[1] = nx; }
        const unsigned old = xb_add(&bar[XB_XSUB(b.x)], 1u);
        const unsigned gen = old / nloc;
        if (old + 1u == (gen + 1u) * nloc) {
            __builtin_amdgcn_fence(__ATOMIC_RELEASE, "agent");
            asm volatile("s_waitcnt vmcnt(0)" ::: "memory");
            const unsigned og = xb_add(&bar[XB_TOP], 1u);
            const unsigned tg = og / nx;
            if (og + 1u == (tg + 1u) * nx) xb_add(&bar[XB_TOPGEN], 1u);
            else XB_SPIN(xb_ld(&bar[XB_TOPGEN]) == tg, bar);
            __builtin_amdgcn_fence(__ATOMIC_ACQUIRE, "agent");
            xb_add(&bar[XB_XGEN(b.x)], 1u);
            asm volatile("s_waitcnt vmcnt(0)" ::: "memory");
        } else {
            XB_SPIN(xb_ld(&bar[XB_XGEN(b.x)]) == gen, bar);
            __builtin_amdgcn_fence(__ATOMIC_ACQUIRE, "agent");
            asm volatile("s_waitcnt vmcnt(0)" ::: "memory");
        }
    }
    __syncthreads();
}

struct Args { const float* in[36]; float* out; unsigned char* ws; int st_lo, st_hi; };
struct Frame {
    LAS unsigned char* lds; volatile LAS unsigned* MISC; gu32* ctl;
    int tid, lane, wave, G, bid;
    unsigned char* ws;
};
DI void relaunder(Frame& F, unsigned char* ws0, LAS unsigned char* lds0) {
    int t = threadIdx.x; asm volatile("" : "+v"(t)); F.tid = t; F.lane = t & 63; F.wave = __builtin_amdgcn_readfirstlane(t >> 6);
    unsigned long long w = (unsigned long long)ws0; asm volatile("" : "+s"(w)); F.ws = (unsigned char*)w; F.ctl = (gu32*)(F.ws + WS_CTL);
    unsigned lb = (unsigned)(unsigned long)lds0; asm volatile("" : "+s"(lb)); F.lds = (LAS unsigned char*)(unsigned long)lb; F.MISC = (volatile LAS unsigned*)(F.lds + MISC_OFF);
    int b = blockIdx.x; asm volatile("" : "+s"(b)); F.bid = b;
}
DI float wave_sum(float v) {
#pragma unroll
    for (int o = 1; o < 64; o <<= 1) v += __shfl_xor(v, o);
    return v;
}
template <int CTRL> DI float dpp_f(float v) { return __builtin_bit_cast(float, __builtin_amdgcn_update_dpp(0, __builtin_bit_cast(int, v), CTRL, 0xf, 0xf, true)); }
DI float row_sum16(float v) { v += dpp_f<0xB1>(v); v += dpp_f<0x4E>(v); v += dpp_f<0x141>(v); v += dpp_f<0x140>(v); return v; }
DI float wave_sum_dpp(float v) {
    const float t = row_sum16(v);
    const float s0 = __builtin_bit_cast(float, __builtin_amdgcn_readlane(__builtin_bit_cast(int, t), 0));
    const float s1 = __builtin_bit_cast(float, __builtin_amdgcn_readlane(__builtin_bit_cast(int, t), 16));
    const float s2 = __builtin_bit_cast(float, __builtin_amdgcn_readlane(__builtin_bit_cast(int, t), 32));
    const float s3 = __builtin_bit_cast(float, __builtin_amdgcn_readlane(__builtin_bit_cast(int, t), 48));
    return (s0 + s1) + (s2 + s3);
}
constexpr size_t WS_QYT = WS_END;
constexpr size_t WS_CYT = WS_QYT + (size_t)1024 * 4096 * 2;
constexpr size_t WS_TST = WS_CYT + (size_t)1024 * 4096 * 2;
constexpr size_t WS_NST = WS_TST + (size_t)1024 * 4096 * 2;
constexpr size_t WS_S0  = WS_NST + (size_t)1024 * 4096 * 4;
constexpr size_t WS_END2 = WS_S0 + (size_t)1024 * 4096 * 2;

DI int map_in(int n) {
    const int T = n >> 8, c = n & 255;
    if (T < 4) { const int base = (T >> 1) * 512, tp = T & 1, half = c >> 7, hs = (c >> 6) & 1, j = c & 63; return base + (2 * tp + hs) * 128 + half * 64 + j; }
    if (T < 6) return 1024 + (T - 4) * 256 + c;
    if (T < 8) return 1536 + (T - 6) * 256 + c;
    if (T < 10) return 2048 + (T - 8) * 256 + c;
    if (T < 14) return 2560 + (T - 10) * 256 + c;
    if (T < 16) return 3592 + (T - 14) * 256 + c;
    if (T == 16) return 4104 + c;
    if (T < 24) return 4424 + (T - 17) * 256 + c;
    if (T < 56) return 6216 + (T - 24) * 256 + c;
    if (c < 8) return 3584 + c;
    if (c < 72) return 4360 + (c - 8);
    return -1;
}
DI int map_fn(int mapid, int n, int Nsrc) {
    if (mapid == 0) return n < Nsrc ? n : -1;
    if (mapid == 1) return map_in(n);
    if (mapid == 2) { const int T = n >> 8, c = n & 255; return c < 128 ? T * 128 + c : DFF + T * 128 + (c - 128); }
    if (mapid == 3) { const int h = n >> 8, c = n & 255; if (c < 96) return h * 192 + c; if (c < 128) return h * 192 + 128 + (c - 96); if (c < 160) return h * 192 + 96 + (c - 128); if (c < 224) return -1; return h * 192 + 160 + (c - 224); }
    return n < 32 ? n : -1;
}
DI void conv_item(const float* W, int K, int Nsrc, bf16* Wt, const float* kscale, int mapid, LAS float* scr, int item, int nblk, int lane) {
    const int kb = item / nblk, nb = item - kb * nblk, k0 = 64 * kb, n0 = 32 * nb;
    const int src = map_fn(mapid, n0 + (lane & 31), Nsrc);
#pragma unroll 8
    for (int i = 0; i < 32; ++i) { const int kk = 2 * i + (lane >> 5); float v = 0.f; if (src >= 0) v = W[(size_t)(k0 + kk) * Nsrc + src]; if (kscale) v *= kscale[k0 + kk]; scr[kk * 33 + (lane & 31)] = v; }
    LDS_WAIT(); asm volatile("" ::: "memory");
    const int c = lane & 7;
#pragma unroll
    for (int j = 0; j < 4; ++j) { const int n = (lane >> 3) + 8 * j; const LAS float* s = scr + (8 * c) * 33 + n;
        u32x4 o; o.x = pk2(s[0 * 33], s[1 * 33]); o.y = pk2(s[2 * 33], s[3 * 33]); o.z = pk2(s[4 * 33], s[5 * 33]); o.w = pk2(s[6 * 33], s[7 * 33]);
        *(GAS u32x4*)(Wt + (size_t)(n0 + n) * K + k0 + 8 * c) = o; }
    LDS_WAIT(); asm volatile("" ::: "memory");
}
struct ConvJob { const float* W; bf16* Wt; const float* kscale; int K, Nsrc, Ndst, mapid; };
DI void conv_job(Frame& F, const ConvJob j, int& base) {
    LAS float* scr = (LAS float*)(F.lds + F.wave * 16384);
    const int nblk = j.Ndst / 32, nitems = (j.K / 64) * nblk, NGW = F.G * NWAVES, gw = F.bid * NWAVES + F.wave;
    int first = (gw - base % NGW + NGW) % NGW;
    for (int it = first; it < nitems; it += NGW) conv_item(j.W, j.K, j.Nsrc, j.Wt, j.kscale, j.mapid, scr, it, nblk, F.lane);
    base += nitems;
}
DI void p_prologue(Frame& F, const Args& a) {
    unsigned char* ws = F.ws;
    const int gt = F.bid * NTHR + F.tid, NGT = F.G * NTHR;
    { float* prm = (float*)(ws + WS_PRM);
#define CPV(IDX, N, OFF, SRC_L) for (int e = gt; e < (N); e += NGT) prm[(size_t)l * PRM_STRIDE + (OFF) + e] = a.in[IDX][(size_t)(SRC_L) * (N) + e];
      for (int l = 0; l < DEPTH; ++l) {
          CPV(2, 2048, P_N1, l) CPV(33, 2048, P_N2, l) CPV(4, 512, P_GN, l) CPV(5, 4096, P_CW, l) CPV(6, 1024, P_CB, l) CPV(7, 8, P_DTB, l) CPV(8, 8, P_ALOG, l) CPV(9, 8, P_SD, l)
          CPV(10, 512, P_SNW, l) CPV(15, 192, P_QNW, l) CPV(16, 192, P_KNW, l) CPV(17, 1792, P_MU, l) CPV(18, 512, P_W0, l) CPV(20, 512, P_A0, l)
          CPV(23, 512, P_V0, (l > 0 ? l - 1 : 0)) CPV(26, 512, P_KK, l) CPV(27, 512, P_KA, l) CPV(28, 512, P_RK, l) CPV(29, 512, P_LNW, l) CPV(30, 512, P_LNB, l)
      }
#undef CPV
    }
    const int* pos = (const int*)a.in[1];
    for (int e = gt; e < S * 64; e += NGT) { const int t = e >> 6, i = e & 63;
        const float inv = 1.0f / powf(10000.0f, (float)(2 * i) / 128.0f); const float ang = (float)pos[t] * inv;
        double rev = (double)ang * 0.15915494309189535; rev -= rint(rev); const float r = (float)(rev * 6.283185307179586);
        ((float*)(ws + WS_COSR))[e] = __cosf(r); ((float*)(ws + WS_SINR))[e] = __sinf(r); }
    for (int e = gt; e < S * 32; e += NGT) { const int t = e >> 5, i = e & 31;
        const float inv = 1.0f / powf(10000.0f, (float)(2 * i) / 64.0f); const float ang = (float)pos[t] * inv;
        double rev = (double)ang * 0.15915494309189535; rev -= rint(rev); const float r = (float)(rev * 6.283185307179586);
        ((float*)(ws + WS_COSM))[e] = __cosf(r); ((float*)(ws + WS_SINM))[e] = __sinf(r); }
    for (int l = 0; l < DEPTH; ++l) {
        const float* w2 = a.in[19] + (size_t)l * 64 * 512; const float* a2 = a.in[21] + (size_t)l * 64 * 512; const float* g2 = a.in[22] + (size_t)l * 128 * 512;
        const float* v2 = a.in[25] + (size_t)(l > 0 ? l - 1 : 0) * 32 * 512;
        bf16* Lt = (bf16*)(ws + WS_WLORA) + (size_t)l * 2048 * 512;
        for (int w = gt; w < 2048 * 64; w += NGT) { const int kg = w >> 11, n = w & 2047, seg = n >> 9, j = n & 511; float v[8];
#pragma unroll
            for (int i = 0; i < 8; ++i) { const int k = kg * 8 + i; float x = 0.f;
                if (seg == 0) { if (k < 64) x = w2[k * 512 + j]; }
                else if (seg == 1) { if (k >= 128 && k < 192) x = a2[(k - 128) * 512 + j]; }
                else if (seg == 2) { if (k >= 256 && k < 384) x = g2[(k - 256) * 512 + j]; }
                else { if (l > 0 && k >= 384 && k < 416) x = v2[(k - 384) * 512 + j]; }
                v[i] = x; }
            u32x4 o; o.x = pk2(v[0], v[1]); o.y = pk2(v[2], v[3]); o.z = pk2(v[4], v[5]); o.w = pk2(v[6], v[7]);
            *(GAS u32x4*)(Lt + (size_t)n * 512 + kg * 8) = o; }
    }
    int base = 0;
    for (int l = 0; l < DEPTH; ++l) {
        conv_job(F, ConvJob{a.in[3] + (size_t)l * D * NIN, (bf16*)(ws + WS_WIN) + (size_t)l * NINP * D, nullptr, D, NIN, NINP, 1}, base);
        conv_job(F, ConvJob{a.in[34] + (size_t)l * D * 2 * DFF, (bf16*)(ws + WS_WGU) + (size_t)l * 2 * DFF * D, nullptr, D, 2 * DFF, 2 * DFF, 2}, base);
        conv_job(F, ConvJob{a.in[35] + (size_t)l * DFF * D, (bf16*)(ws + WS_WDN) + (size_t)l * D * DFF, nullptr, DFF, D, D, 0}, base);
        conv_job(F, ConvJob{a.in[32] + (size_t)l * D * D, (bf16*)(ws + WS_WOUT) + (size_t)l * D * D, nullptr, D, D, D, 0}, base);
        for (int n = 0; n < 4; ++n)
            conv_job(F, ConvJob{a.in[31] + ((size_t)l * 4 + n) * 512 * D, (bf16*)(ws + WS_WBR) + ((size_t)l * 4 + n) * D * 512, nullptr, 512, D, D, 0}, base);
        conv_job(F, ConvJob{a.in[12] + (size_t)l * 512 * 768, (bf16*)(ws + WS_WQB) + (size_t)l * 1024 * 512, a.in[11] + (size_t)l * 512, 512, 768, 1024, 3}, base);
        conv_job(F, ConvJob{a.in[14] + (size_t)l * 256 * 1024, (bf16*)(ws + WS_WKVB) + (size_t)l * 1024 * 256, a.in[13] + (size_t)l * 256, 256, 1024, 1024, 0}, base);
        if (l > 0) conv_job(F, ConvJob{a.in[24] + (size_t)(l - 1) * 512 * 32, (bf16*)(ws + WS_WV1) + (size_t)l * 256 * 512, nullptr, 512, 32, 256, 4}, base);
    }
}

DI void p_rmsnorm(Frame& F, const float* x, const float* w, bf16* out) {
    const int gw = F.bid * NWAVES + F.wave, NGW = F.G * NWAVES;
    for (int m = gw; m < S; m += NGW) {
        const GAS f32x4* xr = (const GAS f32x4*)(x + (size_t)m * D) + F.lane; f32x4 v[8]; float s = 0.f;
#pragma unroll
        for (int j = 0; j < 8; ++j) { v[j] = xr[64 * j]; s += (v[j].x * v[j].x + v[j].y * v[j].y) + (v[j].z * v[j].z + v[j].w * v[j].w); }
        const float rstd = rsqrtf(wave_sum(s) * (1.f / D) + 1e-6f);
        const GAS f32x4* wr = (const GAS f32x4*)w + F.lane;
        GAS u32x2* o8 = (GAS u32x2*)(out + (size_t)m * D) + F.lane;
#pragma unroll
        for (int j = 0; j < 8; ++j) { const f32x4 ww = wr[64 * j]; u32x2 o; o.x = pk2(v[j].x * rstd * ww.x, v[j].y * rstd * ww.y); o.y = pk2(v[j].z * rstd * ww.z, v[j].w * rstd * ww.w); o8[64 * j] = o; }
    }
}

DI void p_rwkv_prep(Frame& F, int l) {
    unsigned char* ws = F.ws;
    const float* RW = (const float*)(ws + WS_RW); const float* prm = (const float*)(ws + WS_PRM) + (size_t)l * PRM_STRIDE; const float* mu = prm + P_MU; const float* kk_w = prm + P_KK;
    const int gw = F.bid * NWAVES + F.wave, NGW = F.G * NWAVES, lane = F.lane;
    for (int t = gw; t < S; t += NGW) {
        const GAS f32x4* p = (const GAS f32x4*)(RW + (size_t)t * 1792) + lane; const GAS f32x4* pp = (const GAS f32x4*)(RW + (size_t)(t > 0 ? t - 1 : 0) * 1792) + lane;
        const GAS f32x4* m4 = (const GAS f32x4*)mu + lane;
        f32x4 pm[7];
#pragma unroll
        for (int j = 0; j < 7; ++j) { const f32x4 c = p[64 * j]; f32x4 pv = pp[64 * j]; if (t == 0) pv = (f32x4){0.f, 0.f, 0.f, 0.f}; pm[j] = c + (pv - c) * m4[64 * j]; }
        *((GAS f32x4*)((float*)(ws + WS_R32) + (size_t)t * 512) + lane) = pm[0]; *((GAS f32x4*)((float*)(ws + WS_R32) + (size_t)t * 512) + 64 + lane) = pm[1];
#pragma unroll
        for (int j = 0; j < 2; ++j) { const f32x4 k = pm[2 + j]; const f32x4 kw = *((const GAS f32x4*)kk_w + 64 * j + lane); const f32x4 kk = k * kw;
            float ss = (kk.x * kk.x + kk.y * kk.y) + (kk.z * kk.z + kk.w * kk.w);
            ss += __shfl_xor(ss, 1); ss += __shfl_xor(ss, 2); ss += __shfl_xor(ss, 4); ss += __shfl_xor(ss, 8);
            const float inv = 1.0f / fmaxf(sqrtf(ss), 1e-12f);
            *((GAS f32x4*)((float*)(ws + WS_K32) + (size_t)t * 512) + 64 * j + lane) = k;
            *((GAS f32x4*)((float*)(ws + WS_KKN) + (size_t)t * 512) + 64 * j + lane) = kk * inv; }
#pragma unroll
        for (int j = 0; j < 2; ++j) { const f32x4 v = pm[4 + j];
            *((GAS f32x4*)((float*)(ws + WS_VV) + (size_t)t * 512) + 64 * j + lane) = v;
            if (l == 0) *((GAS f32x4*)((float*)(ws + WS_VFIRST) + (size_t)t * 512) + 64 * j + lane) = v;
            u32x2 o; o.x = pk2(v.x, v.y); o.y = pk2(v.z, v.w); *((GAS u32x2*)((bf16*)(ws + WS_VB) + (size_t)t * 512) + 64 * j + lane) = o; }
        { const f32x4 x = pm[6]; f32x4 y; int dst;
            if (lane < 16) { y = (f32x4){tanhf(x.x), tanhf(x.y), tanhf(x.z), tanhf(x.w)}; dst = 4 * lane; }
            else if (lane < 32) { y = x; dst = 128 + 4 * (lane - 16); }
            else { y = (f32x4){sigmoidf_(x.x), sigmoidf_(x.y), sigmoidf_(x.z), sigmoidf_(x.w)}; dst = 256 + 4 * (lane - 32); }
            bf16* ar = (bf16*)(ws + WS_ALORA) + (size_t)t * 512;
            u32x2 o; o.x = pk2(y.x, y.y); o.y = pk2(y.z, y.w); *(GAS u32x2*)(ar + dst) = o;
            const int z = 4 * lane; const int zd = z < 64 ? 64 + z : (z < 128 ? 192 + (z - 64) : 384 + (z - 128));
            *(GAS u32x2*)(ar + zd) = (u32x2){0u, 0u}; }
    }
}

DI void p_mamba_prep(Frame& F, int l) {
    unsigned char* ws = F.ws;
    const bf16* XBC = (const bf16*)(ws + WS_XBC); bf16* XC = (bf16*)(ws + WS_XC);
    const float* prm = (const float*)(ws + WS_PRM) + (size_t)l * PRM_STRIDE; const float* cw = prm + P_CW; const float* cb = prm + P_CB;
    for (int c = F.bid; c < NCH; c += F.G) {
        const int ch = 2 * F.tid; const int t0 = c * 64;
        float w0[4], w1[4];
#pragma unroll
        for (int k = 0; k < 4; ++k) { w0[k] = cw[k * 1024 + ch]; w1[k] = cw[k * 1024 + ch + 1]; }
        const float b0 = cb[ch], b1 = cb[ch + 1];
        float h0[3], h1[3];
#pragma unroll
        for (int k = 0; k < 3; ++k) { const int t = t0 - 3 + k; unsigned u = 0u; if (t >= 0) u = *(const GAS unsigned*)(XBC + (size_t)t * 1024 + ch); h0[k] = bf2f(u & 0xffffu); h1[k] = bf2f(u >> 16); }
#pragma unroll 8
        for (int i = 0; i < 64; ++i) { const int t = t0 + i; const unsigned u = *(const GAS unsigned*)(XBC + (size_t)t * 1024 + ch); const float x0 = bf2f(u & 0xffffu), x1 = bf2f(u >> 16);
            const float y0 = b0 + w0[0] * h0[0] + w0[1] * h0[1] + w0[2] * h0[2] + w0[3] * x0, y1 = b1 + w1[0] * h1[0] + w1[1] * h1[1] + w1[2] * h1[2] + w1[3] * x1;
            h0[0] = h0[1]; h0[1] = h0[2]; h0[2] = x0; h1[0] = h1[1]; h1[1] = h1[2]; h1[2] = x1;
            *(GAS unsigned*)(XC + (size_t)t * 1024 + ch) = pk2(siluf_(y0), siluf_(y1)); }
        if (F.tid < 8) { const int h = F.tid; const float bias = prm[P_DTB + h], av = -__expf(prm[P_ALOG + h]); float cs = 0.f;
            const float* misc = (const float*)(ws + WS_MISC);
            for (int i = 0; i < 64; ++i) { const int t = t0 + i; const float dt = softplusf_(misc[(size_t)t * 256 + h] + bias); cs += dt * av;
                ((float*)(ws + WS_DTS))[(size_t)t * 8 + h] = dt; ((float*)(ws + WS_ACS))[(size_t)t * 8 + h] = cs; } }
    }
}

DI void p_scans(Frame& F) {
    unsigned char* ws = F.ws;
    const int gt = F.bid * NTHR + F.tid, NGT = F.G * NTHR;
    for (int e = gt; e < 131072; e += NGT) {
        if (e < 65536) {
            const int h = e >> 14; const float lg = log1pf(-exp2f(-5.0f - (float)h)); const float dec = __expf(lg * 64.0f);
            float* p = (float*)(ws + WS_RKV) + e; float st = 0.f;
#pragma unroll 8
            for (int c = 0; c < NCH; ++c) { const float v = p[(size_t)c * 65536]; p[(size_t)c * 65536] = st; st = dec * st + v; }
        } else {
            const int e2 = e - 65536, h = e2 >> 13; const float* acs = (const float*)(ws + WS_ACS);
            float* p = (float*)(ws + WS_MST) + e2; float st = 0.f;
#pragma unroll 8
            for (int c = 0; c < NCH; ++c) { const float v = p[(size_t)c * 65536]; const float dec = __expf(acs[(size_t)(c * 64 + 63) * 8 + h]); p[(size_t)c * 65536] = st; st = dec * st + v; }
        }
    }
}

DI void p_rwkv_scan(Frame& F, int nblk) {
    unsigned char* ws = F.ws;
    const int w = F.bid * NWAVES + F.wave; if (F.bid >= nblk) return;
    const int h = w >> 6, i = w & 63, lane = F.lane;
    const float* Ap = (const float*)(ws + WS_KKN) + h * 64 + lane; const float* Wp = (const float*)(ws + WS_DEC) + h * 64 + lane; const float* Bp = (const float*)(ws + WS_BB) + h * 64 + lane;
    const float* Kp = (const float*)(ws + WS_KP) + h * 64 + lane; const float* Rp = (const float*)(ws + WS_R32) + h * 64 + lane; const float* Vp = (const float*)(ws + WS_VV) + h * 64 + i;
    float* Yp = (float*)(ws + WS_Y32) + h * 64 + i;
    float s = 0.f;
    constexpr int U = 8;
    float ca[U], cw[U], cb[U], ck[U], cr[U], cv[U];
#pragma unroll
    for (int u = 0; u < U; ++u) { const size_t o = (size_t)u * 512; ca[u] = Ap[o]; cw[u] = Wp[o]; cb[u] = Bp[o]; ck[u] = Kp[o]; cr[u] = Rp[o]; cv[u] = Vp[o]; }
    for (int t0 = 0; t0 < S; t0 += U) {
        float na[U], nw[U], nb[U], nk[U], nr[U], nv[U];
        const int tn = (t0 + U < S) ? t0 + U : t0;
#pragma unroll
        for (int u = 0; u < U; ++u) { const size_t o = (size_t)(tn + u) * 512; na[u] = Ap[o]; nw[u] = Wp[o]; nb[u] = Bp[o]; nk[u] = Kp[o]; nr[u] = Rp[o]; nv[u] = Vp[o]; }
        float ys[U];
#pragma unroll
        for (int u = 0; u < U; ++u) {
            const float sa = wave_sum_dpp(s * (-ca[u]));
            s = s * cw[u] + sa * cb[u] + cv[u] * ck[u];
            ys[u] = wave_sum_dpp(s * cr[u]);
        }
        if (lane < U) { float y = ys[0];
#pragma unroll
            for (int u = 1; u < U; ++u) y = (lane == u) ? ys[u] : y;
            Yp[(size_t)(t0 + lane) * 512] = y; }
#pragma unroll
        for (int u = 0; u < U; ++u) { ca[u] = na[u]; cw[u] = nw[u]; cb[u] = nb[u]; ck[u] = nk[u]; cr[u] = nr[u]; cv[u] = nv[u]; }
    }
}

DI void p_rwkv_post(Frame& F, int l) {
    unsigned char* ws = F.ws;
    const float* prm = (const float*)(ws + WS_PRM) + (size_t)l * PRM_STRIDE; const float* lnw = prm + P_LNW; const float* lnb = prm + P_LNB; const float* rk = prm + P_RK;
    const int gw = F.bid * NWAVES + F.wave, NGW = F.G * NWAVES, lane = F.lane;
    for (int t = gw; t < S; t += NGW) {
#pragma unroll
        for (int j = 0; j < 2; ++j) {
            const size_t o = (size_t)t * 512 / 4 + 64 * j + lane;
            const f32x4 y = ((const GAS f32x4*)(ws + WS_Y32))[o], r = ((const GAS f32x4*)(ws + WS_R32))[o], k = ((const GAS f32x4*)(ws + WS_KP))[o], v = ((const GAS f32x4*)(ws + WS_VV))[o], g = ((const GAS f32x4*)(ws + WS_G32))[o];
            const f32x4 w4 = ((const GAS f32x4*)lnw)[64 * j + lane], b4 = ((const GAS f32x4*)lnb)[64 * j + lane], rk4 = ((const GAS f32x4*)rk)[64 * j + lane];
            float sm = (y.x + y.y) + (y.z + y.w);
            sm += __shfl_xor(sm, 1); sm += __shfl_xor(sm, 2); sm += __shfl_xor(sm, 4); sm += __shfl_xor(sm, 8);
            const float mean = sm * (1.f / 64.f); const f32x4 d = y - mean;
            float q = (d.x * d.x + d.y * d.y) + (d.z * d.z + d.w * d.w);
            q += __shfl_xor(q, 1); q += __shfl_xor(q, 2); q += __shfl_xor(q, 4); q += __shfl_xor(q, 8);
            const float rstd = rsqrtf(q * (1.f / 64.f) + 64e-5f);
            const f32x4 rkk = r * k * rk4; float bs = (rkk.x + rkk.y) + (rkk.z + rkk.w);
            bs += __shfl_xor(bs, 1); bs += __shfl_xor(bs, 2); bs += __shfl_xor(bs, 4); bs += __shfl_xor(bs, 8);
            const f32x4 o4 = (d * rstd * w4 + b4 + bs * v) * g;
            u32x2 ob; ob.x = pk2(o4.x, o4.y); ob.y = pk2(o4.z, o4.w);
            *((GAS u32x2*)((bf16*)(ws + WS_OB) + (size_t)t * D + 1536) + 64 * j + lane) = ob;
        }
    }
}

namespace pg8 {
DI unsigned char* lw(unsigned char* p) { unsigned long long w = (unsigned long long)p; asm volatile("" : "+s"(w)); return (unsigned char*)w; }
DI void st8bf(bf16* p, const f32x4 a, const f32x4 b) { *(GAS u32x4*)p = pack8(a, b); }
DI void st8f(float* p, const f32x4 a, const f32x4 b) { *(GAS f32x4*)p = a; *((GAS f32x4*)p + 1) = b; }
DI f32x4 map4(const f32x4 v, float (*f)(float)) { return (f32x4){f(v.x), f(v.y), f(v.z), f(v.w)}; }

struct EpiIn {
    static constexpr bool AFTER_DRAIN = false;
    unsigned char* ws_;
    DI bool operator()(Acc& acc, const Unit& u, int wr, int wc, int fr, int fq) const {
        unsigned char* ws = lw(ws_);
        const int T = u.pn, row0 = u.pm * BM + wr * 64 + fr, c0 = wc * 32 + fq * 8;
        if (T < 4) {
            const bool isK = T >= 2; const int head = 2 * (T & 1) + (c0 >> 6), j0 = c0 & 63; const float sc = isK ? 0.08838834764831845f : 1.0f;
            bf16* dst = (bf16*)(ws + (isK ? WS_KR : WS_QR)); const float* cs = (const float*)(ws + WS_COSR); const float* sn = (const float*)(ws + WS_SINR);
#pragma unroll
            for (int ai = 0; ai < 2; ++ai)
#pragma unroll
                for (int m = 0; m < 4; ++m) { const int row = row0 + ai * HALF + m * 16;
                    const f32x4 ca = *(const GAS f32x4*)(cs + (size_t)row * 64 + j0), cb = *(const GAS f32x4*)(cs + (size_t)row * 64 + j0 + 4);
                    const f32x4 sa = *(const GAS f32x4*)(sn + (size_t)row * 64 + j0), sb = *(const GAS f32x4*)(sn + (size_t)row * 64 + j0 + 4);
                    const f32x4 x1a = acc[ai][0][m][0], x1b = acc[ai][0][m][1], x2a = acc[ai][1][m][0], x2b = acc[ai][1][m][1];
                    bf16* o = dst + (size_t)row * 512 + head * 128 + j0;
                    st8bf(o, (x1a * ca - x2a * sa) * sc, (x1b * cb - x2b * sb) * sc);
                    st8bf(o + 64, (x2a * ca + x1a * sa) * sc, (x2b * cb + x1b * sb) * sc); }
            return true;
        }
        if (T < 17 && T != 14 && T != 15 && T != 16) {
            bf16* dst; int ld, cb; bool act;
            if (T < 6) { dst = (bf16*)(ws + WS_VR); ld = 512; cb = (T - 4) * 256; act = false; }
            else if (T < 8) { dst = (bf16*)(ws + WS_GR); ld = 512; cb = (T - 6) * 256; act = true; }
            else if (T < 10) { dst = (bf16*)(ws + WS_ZS); ld = 512; cb = (T - 8) * 256; act = true; }
            else { dst = (bf16*)(ws + WS_XBC); ld = 1024; cb = (T - 10) * 256; act = false; }
#pragma unroll
            for (int ai = 0; ai < 2; ++ai)
#pragma unroll
                for (int m = 0; m < 4; ++m) { const int row = row0 + ai * HALF + m * 16;
#pragma unroll
                    for (int bj = 0; bj < 2; ++bj) { f32x4 a = acc[ai][bj][m][0], b = acc[ai][bj][m][1];
                        if (act) { a = map4(a, siluf_); b = map4(b, siluf_); }
                        st8bf(dst + (size_t)row * ld + cb + bj * HALF + c0, a, b); } }
            return true;
        }
        if (T < 17) {
            bf16* dst; int ld, cb, slot;
            if (T < 16) { dst = (bf16*)(ws + WS_CQ); ld = 512; cb = (T - 14) * 256; slot = (T - 14) * 4 + wc; } else { dst = (bf16*)(ws + WS_CKV); ld = 256; cb = 0; slot = 8 + wc; }
            float* ssq = (float*)(ws + WS_SSQ);
#pragma unroll
            for (int ai = 0; ai < 2; ++ai)
#pragma unroll
                for (int m = 0; m < 4; ++m) { const int row = row0 + ai * HALF + m * 16; float ss = 0.f;
#pragma unroll
                    for (int bj = 0; bj < 2; ++bj) { const f32x4 a = acc[ai][bj][m][0], b = acc[ai][bj][m][1];
                        ss += (a.x * a.x + a.y * a.y) + (a.z * a.z + a.w * a.w) + (b.x * b.x + b.y * b.y) + (b.z * b.z + b.w * b.w);
                        st8bf(dst + (size_t)row * ld + cb + bj * HALF + c0, a, b); }
                    ss += __shfl_xor(ss, 16); ss += __shfl_xor(ss, 32);
                    if (fq == 0) ssq[(size_t)row * 16 + slot] = ss; }
            return true;
        }
        if (T < 24 || T == 56) {
            float* dst; int ld, cb;
            if (T < 24) { dst = (float*)(ws + WS_RW); ld = 1792; cb = (T - 17) * 256; } else { dst = (float*)(ws + WS_MISC); ld = 256; cb = 0; }
#pragma unroll
            for (int ai = 0; ai < 2; ++ai)
#pragma unroll
                for (int m = 0; m < 4; ++m) { const int row = row0 + ai * HALF + m * 16;
#pragma unroll
                    for (int bj = 0; bj < 2; ++bj) st8f(dst + (size_t)row * ld + cb + bj * HALF + c0, acc[ai][bj][m][0], acc[ai][bj][m][1]); }
            return true;
        }
        {
            bf16* dst = (bf16*)(ws + WS_GATE); const int cb = (T - 24) * 256;
#pragma unroll
            for (int ai = 0; ai < 2; ++ai)
#pragma unroll
                for (int m = 0; m < 4; ++m) { const int row = row0 + ai * HALF + m * 16;
#pragma unroll
                    for (int bj = 0; bj < 2; ++bj) st8bf(dst + (size_t)row * 8192 + cb + bj * HALF + c0, map4(acc[ai][bj][m][0], sigmoidf_), map4(acc[ai][bj][m][1], sigmoidf_)); }
        }
        return true;
    }
};

struct EpiQb {
    static constexpr bool AFTER_DRAIN = true;
    unsigned char* ws; const float* qnw;
    DI bool operator()(Acc&, const Unit&, int, int, int, int) const { return true; }
    DI void fused(Acc& acc, const Unit& u, int wr, int wc, int fr, int fq, LAS unsigned char* lds, int wid, int lane, int tid) const {
        const int h = u.pn, row0 = u.pm * BM + wr * 64 + fr, c0 = wc * 32 + fq * 8;
        const float* ssq = (const float*)(ws + WS_SSQ); LAS float* P = (LAS float*)lds;
        const float QS = 0.07216878364870322f * LOG2E;
#pragma unroll
        for (int ai = 0; ai < 2; ++ai)
#pragma unroll
            for (int m = 0; m < 4; ++m) { const int row = row0 + ai * HALF + m * 16, rl = ai * HALF + wr * 64 + m * 16 + fr;
                const f32x4 s0 = *(const GAS f32x4*)(ssq + (size_t)row * 16), s1 = *(const GAS f32x4*)(ssq + (size_t)row * 16 + 4);
                const float rs = rsqrtf(((s0.x + s0.y) + (s0.z + s0.w) + (s1.x + s1.y) + (s1.z + s1.w)) * (1.f / 512.f) + 1e-6f);
                float ss = 0.f;
#pragma unroll
                for (int bj = 0; bj < 2; ++bj)
#pragma unroll
                    for (int n = 0; n < 2; ++n) { f32x4 a = acc[ai][bj][m][n] * rs; acc[ai][bj][m][n] = a; ss += (a.x * a.x + a.y * a.y) + (a.z * a.z + a.w * a.w); }
                ss += __shfl_xor(ss, 16); ss += __shfl_xor(ss, 32);
                if (fq == 0) P[rl * 4 + wc] = ss; }
        __syncthreads();
        bf16* QM = (bf16*)(ws + WS_QM); const float* cs = (const float*)(ws + WS_COSM); const float* sn = (const float*)(ws + WS_SINM);
#pragma unroll
        for (int ai = 0; ai < 2; ++ai)
#pragma unroll
            for (int m = 0; m < 4; ++m) { const int row = row0 + ai * HALF + m * 16, rl = ai * HALF + wr * 64 + m * 16 + fr;
                const f32x4 pp = *(const LAS f32x4*)(P + rl * 4); const float rq = rsqrtf(((pp.x + pp.y) + (pp.z + pp.w)) * (1.f / 192.f) + 1e-6f) * QS;
                bf16* o = QM + (size_t)row * 768 + h * 192;
                if (wc < 3) {
                    const f32x4 wa = *(const GAS f32x4*)(qnw + c0), wb = *(const GAS f32x4*)(qnw + c0 + 4);
                    st8bf(o + c0, acc[ai][0][m][0] * rq * wa, acc[ai][0][m][1] * rq * wb);
                    if (wc == 0) { const f32x4 wc4 = *(const GAS f32x4*)(qnw + 96 + c0), wd = *(const GAS f32x4*)(qnw + 100 + c0);
                        st8bf(o + 96 + c0, acc[ai][1][m][0] * rq * wc4, acc[ai][1][m][1] * rq * wd); }
                } else {
                    const int i0 = 8 * fq;
                    const f32x4 w1a = *(const GAS f32x4*)(qnw + 128 + i0), w1b = *(const GAS f32x4*)(qnw + 132 + i0), w2a = *(const GAS f32x4*)(qnw + 160 + i0), w2b = *(const GAS f32x4*)(qnw + 164 + i0);
                    const f32x4 ca = *(const GAS f32x4*)(cs + (size_t)row * 32 + i0), cb = *(const GAS f32x4*)(cs + (size_t)row * 32 + i0 + 4), sa = *(const GAS f32x4*)(sn + (size_t)row * 32 + i0), sb = *(const GAS f32x4*)(sn + (size_t)row * 32 + i0 + 4);
                    const f32x4 x1a = acc[ai][0][m][0] * rq * w1a, x1b = acc[ai][0][m][1] * rq * w1b, x2a = acc[ai][1][m][0] * rq * w2a, x2b = acc[ai][1][m][1] * rq * w2b;
                    st8bf(o + 128 + i0, x1a * ca - x2a * sa, x1b * cb - x2b * sb);
                    st8bf(o + 160 + i0, x2a * ca + x1a * sa, x2b * cb + x1b * sb);
                } }
        __syncthreads();
    }
};

struct EpiKvb {
    static constexpr bool AFTER_DRAIN = true;
    unsigned char* ws; const float* knw;
    DI bool operator()(Acc&, const Unit&, int, int, int, int) const { return true; }
    DI void fused(Acc& acc, const Unit& u, int wr, int wc, int fr, int fq, LAS unsigned char* lds, int wid, int lane, int tid) const {
        const int h = u.pn, row0 = u.pm * BM + wr * 64 + fr, c0 = wc * 32 + fq * 8;
        const float* ssq = (const float*)(ws + WS_SSQ); const float* misc = (const float*)(ws + WS_MISC);
        LAS float* P = (LAS float*)lds; LAS float* KRS = P + 1024; LAS float* RK = P + 1280;
        if (tid < 256) { const float* kr = misc + (size_t)(u.pm * BM + tid) * 256 + 8; float s = 0.f;
#pragma unroll
            for (int i = 0; i < 16; ++i) { const f32x4 v = *(const GAS f32x4*)(kr + 4 * i); s += (v.x * v.x + v.y * v.y) + (v.z * v.z + v.w * v.w); }
            KRS[tid] = s; }
#pragma unroll
        for (int ai = 0; ai < 2; ++ai)
#pragma unroll
            for (int m = 0; m < 4; ++m) { const int row = row0 + ai * HALF + m * 16, rl = ai * HALF + wr * 64 + m * 16 + fr;
                const f32x4 s0 = *(const GAS f32x4*)(ssq + (size_t)row * 16 + 8);
                const float rs = rsqrtf(((s0.x + s0.y) + (s0.z + s0.w)) * (1.f / 256.f) + 1e-6f);
                float ss = 0.f;
#pragma unroll
                for (int bj = 0; bj < 2; ++bj)
#pragma unroll
                    for (int n = 0; n < 2; ++n) { f32x4 a = acc[ai][bj][m][n] * rs; acc[ai][bj][m][n] = a; if (bj == 0) ss += (a.x * a.x + a.y * a.y) + (a.z * a.z + a.w * a.w); }
                ss += __shfl_xor(ss, 16); ss += __shfl_xor(ss, 32);
                if (fq == 0) P[rl * 4 + wc] = ss; }
        __syncthreads();
        if (tid < 256) { const f32x4 pp = *(const LAS f32x4*)(P + tid * 4); RK[tid] = rsqrtf(((pp.x + pp.y) + (pp.z + pp.w) + KRS[tid]) * (1.f / 192.f) + 1e-6f); }
        __syncthreads();
        bf16* KM = (bf16*)(ws + WS_KM); bf16* VT = (bf16*)(ws + WS_VT);
        const f32x4 wa = *(const GAS f32x4*)(knw + c0), wb = *(const GAS f32x4*)(knw + c0 + 4);
#pragma unroll
        for (int ai = 0; ai < 2; ++ai)
#pragma unroll
            for (int m = 0; m < 4; ++m) { const int row = row0 + ai * HALF + m * 16, rl = ai * HALF + wr * 64 + m * 16 + fr;
                const float rk = RK[rl];
                st8bf(KM + (size_t)row * 768 + h * 192 + c0, acc[ai][0][m][0] * rk * wa, acc[ai][0][m][1] * rk * wb);
#pragma unroll
                for (int n = 0; n < 2; ++n)
#pragma unroll
                    for (int i = 0; i < 4; ++i) VT[(size_t)(h * 128 + c0 + n * 4 + i) * S + row] = (bf16)f2bf(acc[ai][1][m][n][i]); }
        {
            const int rl = tid >> 1, hf = tid & 1, row = u.pm * BM + rl, i0 = 16 * hf; const float rk = RK[rl];
            const float* kr = misc + (size_t)row * 256 + 8; const float* cs = (const float*)(ws + WS_COSM) + (size_t)row * 32; const float* sn = (const float*)(ws + WS_SINM) + (size_t)row * 32;
            bf16* o = KM + (size_t)row * 768 + h * 192 + 128;
#pragma unroll
            for (int q = 0; q < 2; ++q) { f32x4 o1[2], o2[2];
#pragma unroll
                for (int e = 0; e < 2; ++e) { const int i = i0 + 8 * q + 4 * e;
                    const f32x4 x1 = *(const GAS f32x4*)(kr + i) * *(const GAS f32x4*)(knw + 128 + i), x2 = *(const GAS f32x4*)(kr + 32 + i) * *(const GAS f32x4*)(knw + 160 + i);
                    const f32x4 c = *(const GAS f32x4*)(cs + i), s = *(const GAS f32x4*)(sn + i);
                    o1[e] = (x1 * c - x2 * s) * rk; o2[e] = (x2 * c + x1 * s) * rk; }
                st8bf(o + i0 + 8 * q, o1[0], o1[1]); st8bf(o + 32 + i0 + 8 * q, o2[0], o2[1]); }
        }
        __syncthreads();
    }
};

struct EpiV1 {
    static constexpr bool AFTER_DRAIN = false;
    unsigned char* ws_;
    DI bool operator()(Acc& acc, const Unit& u, int wr, int wc, int fr, int fq) const {
        if (wc != 0) return true;
        unsigned char* ws = lw(ws_);
        const int row0 = u.pm * BM + wr * 64 + fr; bf16* dst = (bf16*)(ws + WS_ALORA);
#pragma unroll
        for (int ai = 0; ai < 2; ++ai)
#pragma unroll
            for (int m = 0; m < 4; ++m) { const int row = row0 + ai * HALF + m * 16; st8bf(dst + (size_t)row * 512 + 384 + fq * 8, acc[ai][0][m][0], acc[ai][0][m][1]); }
        return true;
    }
};

struct EpiLora {
    static constexpr bool AFTER_DRAIN = false;
    unsigned char* ws_; const float* w0; const float* a0; const float* v0; const float* ka;
#define LORA_LOOP(BODY) _Pragma("unroll") for (int ai = 0; ai < 2; ++ai) _Pragma("unroll") for (int m = 0; m < 4; ++m) { const size_t ro = (size_t)(row0 + ai * HALF + m * 16) * 512; \
        _Pragma("unroll") for (int bj = 0; bj < 2; ++bj) _Pragma("unroll") for (int n = 0; n < 2; ++n) { const int j = jb + bj * HALF + n * 4; const size_t o = ro + j; const f32x4 x = acc[ai][bj][m][n]; BODY } }
    DI bool operator()(Acc& acc, const Unit& u, int wr, int wc, int fr, int fq) const {
        unsigned char* ws = lw(ws_);
        const int seg = u.pn >> 1, row0 = u.pm * BM + wr * 64 + fr, jb = (u.pn & 1) * 256 + wc * 32 + fq * 8;
        if (seg == 0) { float* dec = (float*)(ws + WS_DEC);
            LORA_LOOP({ const f32x4 b = *(const GAS f32x4*)(w0 + j); f32x4 r;
                _Pragma("unroll") for (int i = 0; i < 4; ++i) { const float wv = -softplusf_(-(b[i] + x[i])) - 0.5f; r[i] = -__expf(wv); }
                *(GAS f32x4*)(dec + o) = r; })
        } else if (seg == 1) { const float* k32 = (const float*)(ws + WS_K32); const float* kkn_ = (const float*)(ws + WS_KKN); float* kp_ = (float*)(ws + WS_KP); float* bb_ = (float*)(ws + WS_BB);
            LORA_LOOP({ const f32x4 b = *(const GAS f32x4*)(a0 + j); const f32x4 kav = *(const GAS f32x4*)(ka + j);
                const f32x4 k = *(const GAS f32x4*)(k32 + o); const f32x4 kkn = *(const GAS f32x4*)(kkn_ + o); f32x4 kp; f32x4 bb;
                _Pragma("unroll") for (int i = 0; i < 4; ++i) { const float av = sigmoidf_(b[i] + x[i]); kp[i] = k[i] * (1.0f + (av - 1.0f) * kav[i]); bb[i] = kkn[i] * av; }
                *(GAS f32x4*)(kp_ + o) = kp; *(GAS f32x4*)(bb_ + o) = bb; })
        } else if (seg == 2) { float* g32 = (float*)(ws + WS_G32);
            LORA_LOOP({ *(GAS f32x4*)(g32 + o) = x; })
        } else { float* vv = (float*)(ws + WS_VV); const float* vf_ = (const float*)(ws + WS_VFIRST);
            LORA_LOOP({ const f32x4 b = *(const GAS f32x4*)(v0 + j); const f32x4 v = *(const GAS f32x4*)(vv + o); const f32x4 vf = *(const GAS f32x4*)(vf_ + o); f32x4 r;
                _Pragma("unroll") for (int i = 0; i < 4; ++i) r[i] = v[i] + (vf[i] - v[i]) * sigmoidf_(b[i] + x[i]);
                *(GAS f32x4*)(vv + o) = r; })
        }
        return true;
    }
#undef LORA_LOOP
};

struct EpiBranch {
    static constexpr bool AFTER_DRAIN = false;
    unsigned char* ws_;
    DI bool operator()(Acc& acc, const Unit& u, int wr, int wc, int fr, int fq) const {
        unsigned char* ws = lw(ws_);
        const int nb = u.sub, row0 = u.pm * BM + wr * 64 + fr, cb = u.pn * BM + wc * 32 + fq * 8;
        const bf16* G = (const bf16*)(ws + WS_GATE); bf16* M = (bf16*)(ws + WS_MERGED);
#pragma unroll
        for (int ai = 0; ai < 2; ++ai)
#pragma unroll
            for (int m = 0; m < 4; ++m) { const int row = row0 + ai * HALF + m * 16;
#pragma unroll
                for (int bj = 0; bj < 2; ++bj) { const int col = cb + bj * HALF;
                    float g[8]; unpack8(*(const GAS u32x4*)(G + (size_t)row * 8192 + nb * D + col), g);
                    if (nb < 3) { float gn[8]; unpack8(*(const GAS u32x4*)(G + (size_t)row * 8192 + (nb + 1) * D + col), gn);
#pragma unroll
                        for (int i = 0; i < 8; ++i) g[i] = fmaxf(g[i], 1e-30f) * __builtin_amdgcn_rcpf(fmaxf(gn[i], 1e-30f)); }
                    else {
#pragma unroll
                        for (int i = 0; i < 8; ++i) g[i] = fmaxf(g[i], 1e-30f); }
                    f32x4 a = acc[ai][bj][m][0], b = acc[ai][bj][m][1];
                    a = a * (f32x4){g[0], g[1], g[2], g[3]}; b = b * (f32x4){g[4], g[5], g[6], g[7]};
                    if (nb < 3) { acc[ai][bj][m][0] = a; acc[ai][bj][m][1] = b; } else st8bf(M + (size_t)row * D + col, a, b); } }
        return nb == 3;
    }
};

struct EpiRes {
    static constexpr bool AFTER_DRAIN = false;
    const float* xin; float* out;
    DI bool operator()(Acc& acc, const Unit& u, int wr, int wc, int fr, int fq) const {
        const int row0 = u.pm * BM + wr * 64 + fr, cb = u.pn * BM + wc * 32 + fq * 8;
#pragma unroll
        for (int ai = 0; ai < 2; ++ai)
#pragma unroll
            for (int m = 0; m < 4; ++m) { const int row = row0 + ai * HALF + m * 16;
#pragma unroll
                for (int bj = 0; bj < 2; ++bj) { const size_t o = (size_t)row * D + cb + bj * HALF;
                    const f32x4 xa = *(const GAS f32x4*)(xin + o), xb = *(const GAS f32x4*)(xin + o + 4);
                    st8f(out + o, xa + acc[ai][bj][m][0], xb + acc[ai][bj][m][1]); } }
        return true;
    }
};

struct EpiGu {
    static constexpr bool AFTER_DRAIN = false;
    unsigned char* ws_;
    DI bool operator()(Acc& acc, const Unit& u, int wr, int wc, int fr, int fq) const {
        unsigned char* ws = lw(ws_);
        const int row0 = u.pm * BM + wr * 64 + fr, cb = u.pn * 128 + wc * 32 + fq * 8; bf16* A = (bf16*)(ws + WS_ACT);
#pragma unroll
        for (int ai = 0; ai < 2; ++ai)
#pragma unroll
            for (int m = 0; m < 4; ++m) { const int row = row0 + ai * HALF + m * 16;
                st8bf(A + (size_t)row * DFF + cb, map4(acc[ai][0][m][0], siluf_) * acc[ai][1][m][0], map4(acc[ai][0][m][1], siluf_) * acc[ai][1][m][1]); }
        return true;
    }
};
}

DI bf16x8 ldfrag(const LAS bf16* M, int ld, int r0, int k0, int lane) { return *(const LAS bf16x8*)(M + (r0 + (lane & 15)) * ld + k0 + 8 * (lane >> 4)); }
#define MFMA16(a, b, c) __builtin_amdgcn_mfma_f32_16x16x32_bf16((a), (b), (c), 0, 0, 0)
DI void stage_nat(LAS bf16* dst, int lp, const bf16* src, size_t gp, int rows, int cols8, int tid) {
    for (int p = tid; p < rows * cols8; p += NTHR) { const int r = p / cols8, c = p - r * cols8; *(LAS u32x4*)(dst + r * lp + c * 8) = *(const GAS u32x4*)(src + (size_t)r * gp + c * 8); }
}
DI void stage_tr(LAS bf16* dst, int lp, const bf16* src, size_t gp, int rows, int cols8, int tid) {
    for (int p = tid; p < rows * cols8; p += NTHR) { const int r = p / cols8, c = p - r * cols8; const u32x4 w = *(const GAS u32x4*)(src + (size_t)r * gp + c * 8);
        LAS bf16* d = dst + (c * 8) * lp + r;
        d[0] = (bf16)(w.x & 0xffffu); d[lp] = (bf16)(w.x >> 16); d[2 * lp] = (bf16)(w.y & 0xffffu); d[3 * lp] = (bf16)(w.y >> 16);
        d[4 * lp] = (bf16)(w.z & 0xffffu); d[5 * lp] = (bf16)(w.z >> 16); d[6 * lp] = (bf16)(w.w & 0xffffu); d[7 * lp] = (bf16)(w.w >> 16); }
}
DI float ret_loggamma(int h) { return log1pf(-exp2f(-5.0f - (float)h)); }

DI void u_ret_kv(Frame& F, int c, int h) {
    unsigned char* ws = F.ws; const int tid = F.tid, lane = F.lane, w = F.wave;
    LAS bf16* Kt = (LAS bf16*)F.lds; LAS bf16* Vt = Kt + 128 * 72;
    const bf16* KR = (const bf16*)(ws + WS_KR) + (size_t)(c * 64) * 512 + h * 128; const bf16* VR = (const bf16*)(ws + WS_VR) + (size_t)(c * 64) * 512 + h * 128;
    const float lg = ret_loggamma(h);
    for (int p = tid; p < 1024; p += NTHR) { const int m = p >> 4, d0 = (p & 15) * 8; float k[8]; unpack8(*(const GAS u32x4*)(KR + (size_t)m * 512 + d0), k); const float sc = __expf(lg * (float)(63 - m));
        LAS bf16* d = Kt + d0 * 72 + m;
#pragma unroll
        for (int i = 0; i < 8; ++i) d[i * 72] = (bf16)f2bf(k[i] * sc); }
    stage_tr(Vt, 72, VR, 512, 64, 16, tid);
    __syncthreads();
    f32x4 acc[8];
#pragma unroll
    for (int bn = 0; bn < 8; ++bn) acc[bn] = (f32x4){0.f, 0.f, 0.f, 0.f};
#pragma unroll
    for (int ks = 0; ks < 2; ++ks) { const bf16x8 a = ldfrag(Kt, 72, 16 * w, 32 * ks, lane);
#pragma unroll
        for (int bn = 0; bn < 8; ++bn) acc[bn] = MFMA16(a, ldfrag(Vt, 72, 16 * bn, 32 * ks, lane), acc[bn]); }
    float* out = (float*)(ws + WS_RKV) + ((size_t)(c * 4 + h) * 128) * 128;
#pragma unroll
    for (int bn = 0; bn < 8; ++bn)
#pragma unroll
        for (int r = 0; r < 4; ++r) out[(size_t)(16 * w + 4 * (lane >> 4) + r) * 128 + 16 * bn + (lane & 15)] = acc[bn][r];
    __syncthreads();
}

DI void u_ret_out(Frame& F, int l_, int c, int h) {
    unsigned char* ws = F.ws; const int tid = F.tid, lane = F.lane, w = F.wave;
    LAS bf16* Qs = (LAS bf16*)F.lds; LAS bf16* Ks = Qs + 64 * 136; LAS bf16* Vt = Ks + 64 * 136; LAS bf16* St = Vt + 128 * 72; LAS bf16* Ps = St + 128 * 136; LAS float* Os = (LAS float*)(Ps + 64 * 72);
    const size_t rowb = (size_t)(c * 64) * 512 + h * 128;
    stage_nat(Qs, 136, (const bf16*)(ws + WS_QR) + rowb, 512, 64, 16, tid);
    stage_nat(Ks, 136, (const bf16*)(ws + WS_KR) + rowb, 512, 64, 16, tid);
    stage_tr(Vt, 72, (const bf16*)(ws + WS_VR) + rowb, 512, 64, 16, tid);
    { const float* sp = (const float*)(ws + WS_RKV) + ((size_t)(c * 4 + h) * 128) * 128;
      for (int p = tid; p < 4096; p += NTHR) { const int d = p >> 5, e0 = (p & 31) * 4; const f32x4 v = *(const GAS f32x4*)(sp + (size_t)d * 128 + e0);
          LAS bf16* q = St + e0 * 136 + d; q[0] = (bf16)f2bf(v.x); q[136] = (bf16)f2bf(v.y); q[272] = (bf16)f2bf(v.z); q[408] = (bf16)f2bf(v.w); } }
    __syncthreads();
    const float lg = ret_loggamma(h); const int g4 = lane >> 4, lc = lane & 15;
    {
        const int bm = w >> 1;
#pragma unroll
        for (int q = 0; q < 2; ++q) { const int bn = (w & 1) * 2 + q; f32x4 acc = (f32x4){0.f, 0.f, 0.f, 0.f};
#pragma unroll
            for (int ks = 0; ks < 4; ++ks) acc = MFMA16(ldfrag(Qs, 136, 16 * bm, 32 * ks, lane), ldfrag(Ks, 136, 16 * bn, 32 * ks, lane), acc);
#pragma unroll
            for (int r = 0; r < 4; ++r) { const int l = 16 * bm + 4 * g4 + r, m = 16 * bn + lc; const int dd = l > m ? l - m : m - l; Ps[l * 72 + m] = (bf16)f2bf(acc[r] * __expf(lg * (float)dd)); } }
    }
    __syncthreads();
    {
        const int bm = w >> 1;
#pragma unroll
        for (int q = 0; q < 4; ++q) { const int bn = (w & 1) * 4 + q; f32x4 a1 = (f32x4){0.f, 0.f, 0.f, 0.f}, a2 = (f32x4){0.f, 0.f, 0.f, 0.f};
#pragma unroll
            for (int ks = 0; ks < 2; ++ks) a1 = MFMA16(ldfrag(Ps, 72, 16 * bm, 32 * ks, lane), ldfrag(Vt, 72, 16 * bn, 32 * ks, lane), a1);
#pragma unroll
            for (int ks = 0; ks < 4; ++ks) a2 = MFMA16(ldfrag(Qs, 136, 16 * bm, 32 * ks, lane), ldfrag(St, 136, 16 * bn, 32 * ks, lane), a2);
#pragma unroll
            for (int r = 0; r < 4; ++r) { const int l = 16 * bm + 4 * g4 + r; Os[l * 132 + 16 * bn + lc] = a1[r] + __expf(lg * (float)(l + 1)) * a2[r]; } }
    }
    __syncthreads();
    { const float* gw = (const float*)(ws + WS_PRM) + (size_t)l_ * PRM_STRIDE + P_GN + h * 128; const bf16* GR = (const bf16*)(ws + WS_GR); bf16* OB = (bf16*)(ws + WS_OB);
#pragma unroll
      for (int rr = 0; rr < 8; ++rr) { const int l = 8 * w + rr; const float x0 = Os[l * 132 + lane], x1 = Os[l * 132 + 64 + lane];
          const float mean = wave_sum(x0 + x1) * (1.f / 128.f); const float d0 = x0 - mean, d1 = x1 - mean; const float rstd = rsqrtf(wave_sum(d0 * d0 + d1 * d1) * (1.f / 128.f) + 1e-5f);
          const size_t row = (size_t)(c * 64 + l);
          const float g0 = bf2f(GR[row * 512 + h * 128 + lane]), g1 = bf2f(GR[row * 512 + h * 128 + 64 + lane]);
          OB[row * D + h * 128 + lane] = (bf16)f2bf(d0 * rstd * gw[lane] * g0); OB[row * D + h * 128 + 64 + lane] = (bf16)f2bf(d1 * rstd * gw[64 + lane] * g1); } }
    __syncthreads();
}

DI void u_mamba_st(Frame& F, int c, int g) {
    unsigned char* ws = F.ws; const int tid = F.tid, lane = F.lane, w = F.wave;
    LAS bf16* Xt = (LAS bf16*)F.lds; LAS bf16* Bt = Xt + 256 * 72;
    const bf16* XC = (const bf16*)(ws + WS_XC) + (size_t)(c * 64) * 1024; const float* dts = (const float*)(ws + WS_DTS) + (size_t)(c * 64) * 8; const float* acs = (const float*)(ws + WS_ACS) + (size_t)(c * 64) * 8;
    for (int p = tid; p < 2048; p += NTHR) { const int l = p >> 5, c0 = (p & 31) * 8, h = g * 4 + (c0 >> 6); float x[8]; unpack8(*(const GAS u32x4*)(XC + (size_t)l * 1024 + g * 256 + c0), x);
        const float sc = dts[l * 8 + h] * __expf(acs[63 * 8 + h] - acs[l * 8 + h]); LAS bf16* d = Xt + c0 * 72 + l;
#pragma unroll
        for (int i = 0; i < 8; ++i) d[i * 72] = (bf16)f2bf(x[i] * sc); }
    stage_tr(Bt, 72, XC + 512 + g * 128, 1024, 64, 16, tid);
    __syncthreads();
    f32x4 acc[2][8];
#pragma unroll
    for (int i = 0; i < 2; ++i)
#pragma unroll
        for (int bn = 0; bn < 8; ++bn) acc[i][bn] = (f32x4){0.f, 0.f, 0.f, 0.f};
#pragma unroll
    for (int ks = 0; ks < 2; ++ks) { const bf16x8 a0 = ldfrag(Xt, 72, 32 * w, 32 * ks, lane), a1 = ldfrag(Xt, 72, 32 * w + 16, 32 * ks, lane);
#pragma unroll
        for (int bn = 0; bn < 8; ++bn) { const bf16x8 b = ldfrag(Bt, 72, 16 * bn, 32 * ks, lane); acc[0][bn] = MFMA16(a0, b, acc[0][bn]); acc[1][bn] = MFMA16(a1, b, acc[1][bn]); } }
    float* out = (float*)(ws + WS_MST) + ((size_t)(c * 8 + g * 4) * 64) * 128;
#pragma unroll
    for (int i = 0; i < 2; ++i)
#pragma unroll
        for (int bn = 0; bn < 8; ++bn)
#pragma unroll
            for (int r = 0; r < 4; ++r) out[(size_t)(32 * w + 16 * i + 4 * (lane >> 4) + r) * 128 + 16 * bn + (lane & 15)] = acc[i][bn][r];
    __syncthreads();
}

struct MambaLds { LAS bf16* Cs; LAS bf16* Bs; LAS float* CB; LAS bf16* Ph; LAS bf16* Xt; LAS bf16* Sh; LAS float* AC; LAS float* DT; LAS float* SSQ; };
DI void mamba_head(Frame& F, const MambaLds& L, const bf16* XC, const float* sp, int g, int hh, float dsk, const bf16* const (&zrow)[4], f32x4 (&y)[2]) {
    const int tid = F.tid, lane = F.lane, w = F.wave, g4 = lane >> 4, lc = lane & 15, bm = w >> 1;
    __syncthreads();
    { const int l = tid >> 3, m0 = (tid & 7) * 8; const float al = L.AC[l * 4 + hh]; float pv[8];
#pragma unroll
      for (int i = 0; i < 8; ++i) { const int m = m0 + i; pv[i] = (m <= l) ? L.CB[l * 68 + m] * __expf(al - L.AC[m * 4 + hh]) * L.DT[m * 4 + hh] : 0.f; }
      u32x4 o; o.x = pk2(pv[0], pv[1]); o.y = pk2(pv[2], pv[3]); o.z = pk2(pv[4], pv[5]); o.w = pk2(pv[6], pv[7]); *(LAS u32x4*)(L.Ph + l * 72 + m0) = o; }
    stage_tr(L.Xt, 72, XC + g * 256 + hh * 64, 1024, 64, 8, tid);
    for (int p = tid; p < 1024; p += NTHR) { const int pr = p >> 4, n0 = (p & 15) * 8; const f32x4 v0 = *(const GAS f32x4*)(sp + (size_t)pr * 128 + n0), v1 = *(const GAS f32x4*)(sp + (size_t)pr * 128 + n0 + 4);
        *(LAS u32x4*)(L.Sh + pr * 136 + n0) = pack8(v0, v1); }
    __syncthreads();
#pragma unroll
    for (int q = 0; q < 2; ++q) { const int bn = (w & 1) * 2 + q; f32x4 yd = (f32x4){0.f, 0.f, 0.f, 0.f}, yo = (f32x4){0.f, 0.f, 0.f, 0.f};
#pragma unroll
        for (int ks = 0; ks < 2; ++ks) yd = MFMA16(ldfrag(L.Ph, 72, 16 * bm, 32 * ks, lane), ldfrag(L.Xt, 72, 16 * bn, 32 * ks, lane), yd);
#pragma unroll
        for (int ks = 0; ks < 4; ++ks) yo = MFMA16(ldfrag(L.Cs, 136, 16 * bm, 32 * ks, lane), ldfrag(L.Sh, 136, 16 * bn, 32 * ks, lane), yo);
#pragma unroll
        for (int r = 0; r < 4; ++r) { const int l = 16 * bm + 4 * g4 + r, p = 16 * bn + lc; const float x = bf2f(L.Xt[p * 72 + l]);
            const float z = bf2f(zrow[r][hh * 64 + q * 16]);
            y[q][r] = (yd[r] + __expf(L.AC[l * 4 + hh]) * yo[r] + x * dsk) * z; } }
}
DI void u_mamba_out(Frame& F, int l_, int c, int g) {
    unsigned char* ws = F.ws; const int tid = F.tid, lane = F.lane, w = F.wave, g4 = lane >> 4, lc = lane & 15;
    MambaLds L; L.Cs = (LAS bf16*)F.lds; L.Bs = L.Cs + 64 * 136; L.CB = (LAS float*)(L.Bs + 64 * 136); L.Ph = (LAS bf16*)(L.CB + 64 * 68); L.Xt = L.Ph + 64 * 72; L.Sh = L.Xt + 64 * 72;
    L.AC = (LAS float*)(L.Sh + 64 * 136); L.DT = L.AC + 256; L.SSQ = L.DT + 256;
    const bf16* XC = (const bf16*)(ws + WS_XC) + (size_t)(c * 64) * 1024;
    stage_nat(L.Cs, 136, XC + 768 + g * 128, 1024, 64, 16, tid);
    stage_nat(L.Bs, 136, XC + 512 + g * 128, 1024, 64, 16, tid);
    if (tid < 256) { const int l = tid >> 2, hh = tid & 3; L.AC[tid] = ((const float*)(ws + WS_ACS))[(size_t)(c * 64 + l) * 8 + g * 4 + hh]; L.DT[tid] = ((const float*)(ws + WS_DTS))[(size_t)(c * 64 + l) * 8 + g * 4 + hh]; }
    __syncthreads();
    const int bm = w >> 1;
#pragma unroll
    for (int q = 0; q < 2; ++q) { const int bn = (w & 1) * 2 + q; f32x4 acc = (f32x4){0.f, 0.f, 0.f, 0.f};
#pragma unroll
        for (int ks = 0; ks < 4; ++ks) acc = MFMA16(ldfrag(L.Cs, 136, 16 * bm, 32 * ks, lane), ldfrag(L.Bs, 136, 16 * bn, 32 * ks, lane), acc);
#pragma unroll
        for (int r = 0; r < 4; ++r) L.CB[(16 * bm + 4 * g4 + r) * 68 + 16 * bn + lc] = acc[r]; }
    const int pcol = 16 * ((w & 1) * 2) + lc;
    const bf16* zrow[4]; bf16* orow[4];
#pragma unroll
    for (int r = 0; r < 4; ++r) { const size_t row = (size_t)(c * 64 + 16 * bm + 4 * g4 + r); zrow[r] = (const bf16*)(ws + WS_ZS) + row * 512 + g * 256 + pcol; orow[r] = (bf16*)(ws + WS_OB) + row * D + 512 + g * 256 + pcol; }
    const float* mst = (const float*)(ws + WS_MST) + ((size_t)(c * 8 + g * 4) * 64) * 128; const float* prm = (const float*)(ws + WS_PRM) + (size_t)l_ * PRM_STRIDE; const float* dskp = prm + P_SD + g * 4;
    float ss[4] = {0.f, 0.f, 0.f, 0.f};
#pragma unroll 1
    for (int hh = 0; hh < 4; ++hh) { f32x4 y[2]; mamba_head(F, L, XC, mst + (size_t)hh * 64 * 128, g, hh, dskp[hh], zrow, y);
#pragma unroll
        for (int r = 0; r < 4; ++r) ss[r] += y[0][r] * y[0][r] + y[1][r] * y[1][r]; }
#pragma unroll
    for (int r = 0; r < 4; ++r) { float t = ss[r]; t += __shfl_xor(t, 1); t += __shfl_xor(t, 2); t += __shfl_xor(t, 4); t += __shfl_xor(t, 8);
        if (lc == 0) L.SSQ[(16 * bm + 4 * g4 + r) * 2 + (w & 1)] = t; }
    __syncthreads();
    float rstd[4];
#pragma unroll
    for (int r = 0; r < 4; ++r) { const int l = 16 * bm + 4 * g4 + r; rstd[r] = rsqrtf((L.SSQ[l * 2] + L.SSQ[l * 2 + 1]) * (1.f / 256.f) + 1e-6f); }
    const float* nw = prm + P_SNW + g * 256 + pcol;
#pragma unroll 1
    for (int hh = 0; hh < 4; ++hh) { f32x4 y[2]; mamba_head(F, L, XC, mst + (size_t)hh * 64 * 128, g, hh, dskp[hh], zrow, y);
#pragma unroll
        for (int q = 0; q < 2; ++q)
#pragma unroll
            for (int r = 0; r < 4; ++r) orow[r][hh * 64 + q * 16] = (bf16)f2bf(y[q][r] * rstd[r] * nw[hh * 64 + q * 16]); }
    __syncthreads();
}

DI void u_attn(Frame& F, int c, int h) {
    unsigned char* ws = F.ws; const int tid = F.tid, lane = F.lane, w = F.wave, g4 = lane >> 4, lc = lane & 15, qh = w >> 2, kq = w & 3;
    LAS bf16* Ks = (LAS bf16*)F.lds; LAS bf16* Vs = Ks + 128 * 200;
    const bf16* QM = (const bf16*)(ws + WS_QM); const bf16* KM = (const bf16*)(ws + WS_KM) + h * 192; const bf16* VT = (const bf16*)(ws + WS_VT) + (size_t)(h * 128) * S;
    bf16x8 qf[2][6];
#pragma unroll
    for (int qb = 0; qb < 2; ++qb)
#pragma unroll
        for (int ks = 0; ks < 6; ++ks) qf[qb][ks] = *(const GAS bf16x8*)(QM + (size_t)(c * 64 + qh * 32 + qb * 16 + lc) * 768 + h * 192 + ks * 32 + g4 * 8);
    f32x4 o[8][2]; float mrun[2], lrun[2];
#pragma unroll
    for (int db = 0; db < 8; ++db)
#pragma unroll
        for (int qb = 0; qb < 2; ++qb) o[db][qb] = (f32x4){0.f, 0.f, 0.f, 0.f};
    mrun[0] = mrun[1] = -1e30f; lrun[0] = lrun[1] = 0.f;
    const int nkeys = 64 * (c + 1), ntile = (c + 2) >> 1;
    for (int t = 0; t < ntile; ++t) {
        const int key0 = t * 128;
        __syncthreads();
        for (int p = tid; p < 128 * 24; p += NTHR) { const int r = p / 24, cc = p - r * 24; *(LAS u32x4*)(Ks + r * 200 + cc * 8) = *(const GAS u32x4*)(KM + (size_t)(key0 + r) * 768 + cc * 8); }
        for (int p = tid; p < 128 * 16; p += NTHR) { const int r = p >> 4, cc = p & 15; *(LAS u32x4*)(Vs + r * 136 + cc * 8) = *(const GAS u32x4*)(VT + (size_t)r * S + key0 + cc * 8); }
        __syncthreads();
        if (key0 + kq * 32 < nkeys) {
            f32x4 s[2][2];
#pragma unroll
            for (int kb = 0; kb < 2; ++kb)
#pragma unroll
                for (int qb = 0; qb < 2; ++qb) s[kb][qb] = (f32x4){0.f, 0.f, 0.f, 0.f};
#pragma unroll
            for (int ks = 0; ks < 6; ++ks)
#pragma unroll
                for (int kb = 0; kb < 2; ++kb) { const bf16x8 kf = ldfrag(Ks, 200, kq * 32 + kb * 16, ks * 32, lane);
#pragma unroll
                    for (int qb = 0; qb < 2; ++qb) s[kb][qb] = MFMA16(kf, qf[qb][ks], s[kb][qb]); }
            bf16x8 pf[2];
#pragma unroll
            for (int qb = 0; qb < 2; ++qb) {
                float mx = fmaxf(fmaxf(fmaxf(s[0][qb][0], s[0][qb][1]), fmaxf(s[0][qb][2], s[0][qb][3])), fmaxf(fmaxf(s[1][qb][0], s[1][qb][1]), fmaxf(s[1][qb][2], s[1][qb][3])));
                mx = fmaxf(mx, __shfl_xor(mx, 16)); mx = fmaxf(mx, __shfl_xor(mx, 32));
                const float mn = fmaxf(mrun[qb], mx), alpha = exp2f(mrun[qb] - mn); mrun[qb] = mn;
                float p[8]; float ps = 0.f;
#pragma unroll
                for (int kb = 0; kb < 2; ++kb)
#pragma unroll
                    for (int r = 0; r < 4; ++r) { p[kb * 4 + r] = exp2f(s[kb][qb][r] - mn); ps += p[kb * 4 + r]; }
                ps += __shfl_xor(ps, 16); ps += __shfl_xor(ps, 32);
                lrun[qb] = lrun[qb] * alpha + ps;
#pragma unroll
                for (int db = 0; db < 8; ++db) o[db][qb] = o[db][qb] * alpha;
                u32x4 pw; pw.x = pk2(p[0], p[1]); pw.y = pk2(p[2], p[3]); pw.z = pk2(p[4], p[5]); pw.w = pk2(p[6], p[7]); pf[qb] = __builtin_bit_cast(bf16x8, pw);
            }
#pragma unroll
            for (int db = 0; db < 8; ++db) {
                const LAS bf16* vp = Vs + (db * 16 + lc) * 136 + kq * 32 + 4 * g4;
                const u32x2 v0 = *(const LAS u32x2*)vp, v1 = *(const LAS u32x2*)(vp + 16);
                const u32x4 vw = (u32x4){v0.x, v0.y, v1.x, v1.y}; const bf16x8 vf = __builtin_bit_cast(bf16x8, vw);
#pragma unroll
                for (int qb = 0; qb < 2; ++qb) o[db][qb] = MFMA16(vf, pf[qb], o[db][qb]);
            }
        }
    }
    __syncthreads();
    LAS float* OW = (LAS float*)F.lds; LAS float* ML = OW + 8 * 128 * 33;
#pragma unroll
    for (int db = 0; db < 8; ++db)
#pragma unroll
        for (int qb = 0; qb < 2; ++qb)
#pragma unroll
            for (int r = 0; r < 4; ++r) OW[(w * 128 + db * 16 + 4 * g4 + r) * 33 + qb * 16 + lc] = o[db][qb][r];
    if (g4 == 0) {
#pragma unroll
        for (int qb = 0; qb < 2; ++qb) { ML[(w * 32 + qb * 16 + lc) * 2] = mrun[qb]; ML[(w * 32 + qb * 16 + lc) * 2 + 1] = lrun[qb]; } }
    __syncthreads();
    { const int q = tid >> 3, dv0 = (tid & 7) * 16, qhh = q >> 5, ql = q & 31; float mw[4], lw[4]; float mstar = -1e30f;
#pragma unroll
      for (int k = 0; k < 4; ++k) { mw[k] = ML[((qhh * 4 + k) * 32 + ql) * 2]; lw[k] = ML[((qhh * 4 + k) * 32 + ql) * 2 + 1]; mstar = fmaxf(mstar, mw[k]); }
      float lt = 0.f, sc[4];
#pragma unroll
      for (int k = 0; k < 4; ++k) { sc[k] = exp2f(mw[k] - mstar); lt += lw[k] * sc[k]; }
      const float inv = 1.0f / lt; float ov[16];
#pragma unroll
      for (int i = 0; i < 16; ++i) { float v = 0.f;
#pragma unroll
          for (int k = 0; k < 4; ++k) v += OW[((qhh * 4 + k) * 128 + dv0 + i) * 33 + ql] * sc[k];
          ov[i] = v * inv; }
      bf16* ob = (bf16*)(ws + WS_OB) + (size_t)(c * 64 + q) * D + 1024 + h * 128 + dv0;
      u32x4 o0, o1; o0.x = pk2(ov[0], ov[1]); o0.y = pk2(ov[2], ov[3]); o0.z = pk2(ov[4], ov[5]); o0.w = pk2(ov[6], ov[7]); o1.x = pk2(ov[8], ov[9]); o1.y = pk2(ov[10], ov[11]); o1.z = pk2(ov[12], ov[13]); o1.w = pk2(ov[14], ov[15]);
      *(GAS u32x4*)ob = o0; *(GAS u32x4*)(ob + 8) = o1; }
    __syncthreads();
}

DI void u_rwkv_r1(Frame& F, int c, int h) {
    unsigned char* ws = F.ws; const int tid = F.tid, lane = F.lane, w = F.wave, g4 = lane >> 4, lc = lane & 15;
    LAS float* CUM = (LAS float*)F.lds;
    LAS float* PT = CUM + 64 * 68;
    LAS bf16* AT = (LAS bf16*)(PT + 64); LAS bf16* BH = AT + 4608; LAS bf16* KH = BH + 4608; LAS bf16* RT = KH + 4608;
    LAS bf16* AJ = RT + 4608; LAS bf16* BJ = AJ + 4608; LAS bf16* KJ = BJ + 4608; LAS bf16* VJ = KJ + 4608;
    LAS bf16* MAK = VJ + 4608; LAS bf16* MRBT = MAK + 4608; LAS bf16* MRKT = MRBT + 4608; LAS float* WF = (LAS float*)(MRKT + 4608);
    LAS bf16* WT = AT; LAS bf16* G1 = BH; LAS bf16* G2 = KH; LAS bf16* CST = MAK;
    const size_t gb = (size_t)(c * 64) * 512 + h * 64; const int unit = c * 8 + h;
    const int t = tid >> 3, j0 = (tid & 7) * 8;
    const size_t go = gb + (size_t)t * 512 + j0;
    float lw[8];
    { const f32x4 x0 = *(const GAS f32x4*)((const float*)(ws + WS_DEC) + go), x1 = *(const GAS f32x4*)((const float*)(ws + WS_DEC) + go + 4);
#pragma unroll
      for (int i = 0; i < 4; ++i) { lw[i] = x0[i]; lw[4 + i] = x1[i]; }
#pragma unroll
      for (int i = 0; i < 8; ++i) CUM[t * 68 + j0 + i] = lw[i]; }
    __syncthreads();
    if (tid < 64) { float s = 0.f;
#pragma unroll 8
        for (int tt = 0; tt < 64; ++tt) { s += CUM[tt * 68 + tid]; CUM[tt * 68 + tid] = s; } }
    __syncthreads();
    {
        float cum[8], cT[8];
#pragma unroll
        for (int i = 0; i < 8; ++i) { cum[i] = CUM[t * 68 + j0 + i]; cT[i] = CUM[63 * 68 + j0 + i]; }
        if (t == 0) {
#pragma unroll
            for (int i = 0; i < 8; ++i) PT[j0 + i] = __expf(cT[i]); }
        float av[8], bv[8], kv[8], rv[8], vv[8];
#define LD8(dst, OFF) { const f32x4 x0 = *(const GAS f32x4*)((const float*)(ws + (OFF)) + go), x1 = *(const GAS f32x4*)((const float*)(ws + (OFF)) + go + 4); _Pragma("unroll") for (int i = 0; i < 4; ++i) { dst[i] = x0[i]; dst[4 + i] = x1[i]; } }
        LD8(av, WS_KKN) LD8(bv, WS_BB) LD8(kv, WS_KP) LD8(rv, WS_R32) LD8(vv, WS_VV)
#undef LD8
        float at[8], bh[8], kh[8], rt[8], bj[8], kj[8];
#pragma unroll
        for (int i = 0; i < 8; ++i) { const float pprev = __expf(cum[i] - lw[i]), pinv = __expf(-cum[i]), pt = __expf(cum[i]), pend = __expf(cT[i] - cum[i]);
            at[i] = -av[i] * pprev; bh[i] = bv[i] * pinv; kh[i] = kv[i] * pinv; rt[i] = rv[i] * pt; bj[i] = bv[i] * pend; kj[i] = kv[i] * pend; }
#define ST8(M, v) { u32x4 o; o.x = pk2(v[0], v[1]); o.y = pk2(v[2], v[3]); o.z = pk2(v[4], v[5]); o.w = pk2(v[6], v[7]); *(LAS u32x4*)(M + t * 72 + j0) = o; }
        ST8(AT, at) ST8(BH, bh) ST8(KH, kh) ST8(RT, rt)
#undef ST8
#pragma unroll
        for (int i = 0; i < 8; ++i) { const int o = (j0 + i) * 72 + t; AJ[o] = (bf16)f2bf(at[i]); BJ[o] = (bf16)f2bf(bj[i]); KJ[o] = (bf16)f2bf(kj[i]); VJ[o] = (bf16)f2bf(vv[i]); }
    }
    __syncthreads();
    {
        const int q = w >> 1; const LAS bf16* Am = (q == 0) ? BH : (q == 1) ? KH : RT; const LAS bf16* Bm = (q < 2) ? AT : (q == 2) ? BH : KH;
#pragma unroll
        for (int bi = 0; bi < 2; ++bi) { const int bm = 2 * (w & 1) + bi; const bf16x8 a0 = ldfrag(Am, 72, 16 * bm, 0, lane), a1 = ldfrag(Am, 72, 16 * bm, 32, lane);
#pragma unroll
            for (int bn = 0; bn < 4; ++bn) { f32x4 acc = (f32x4){0.f, 0.f, 0.f, 0.f};
                acc = MFMA16(a0, ldfrag(Bm, 72, 16 * bn, 0, lane), acc); acc = MFMA16(a1, ldfrag(Bm, 72, 16 * bn, 32, lane), acc);
#pragma unroll
                for (int r = 0; r < 4; ++r) { const int row = 16 * bm + 4 * g4 + r, col = 16 * bn + lc; const bool keep = (q < 2) ? (row < col) : (col <= row); const float v = keep ? acc[r] : 0.f;
                    if (q == 0) CUM[row * 68 + col] = v; else { LAS bf16* O = (q == 1) ? MAK : (q == 2) ? MRBT : MRKT; O[row * 72 + col] = (bf16)f2bf(v); } } } }
    }
    __syncthreads();
    if (w == 0) {
        int z = 0; asm volatile("" : "+v"(z));
        const LAS float* Mz = CUM + z; LAS float* Wl = WF + lane * 68;
#pragma unroll
        for (int s4 = 0; s4 < 16; ++s4) *(LAS f32x4*)(Wl + 4 * s4) = (f32x4){0.f, 0.f, 0.f, 0.f};
#pragma unroll 1
        for (int tau = 63; tau >= 0; --tau) { float acc = (lane == tau) ? 1.f : 0.f;
#pragma unroll 4
            for (int s4 = (tau + 1) >> 2; s4 < 16; ++s4) { const f32x4 m = *(const LAS f32x4*)(Mz + tau * 68 + 4 * s4), wq = *(const LAS f32x4*)(Wl + 4 * s4);
                acc += m.x * wq.x; acc += m.y * wq.y; acc += m.z * wq.z; acc += m.w * wq.w; }
            Wl[tau] = acc; }
#pragma unroll
        for (int s8 = 0; s8 < 8; ++s8) { const f32x4 a = *(const LAS f32x4*)(Wl + 8 * s8), b = *(const LAS f32x4*)(Wl + 8 * s8 + 4); *(LAS u32x4*)(WT + lane * 72 + 8 * s8) = pack8(a, b); }
    }
    __syncthreads();
    {
        const int q = w >> 2, bm = w & 3; const LAS bf16* Am = q ? MAK : AJ; LAS bf16* O = q ? G2 : G1;
        const bf16x8 a0 = ldfrag(Am, 72, 16 * bm, 0, lane), a1 = ldfrag(Am, 72, 16 * bm, 32, lane);
        f32x4 acc[4];
#pragma unroll
        for (int bn = 0; bn < 4; ++bn) { acc[bn] = (f32x4){0.f, 0.f, 0.f, 0.f};
            acc[bn] = MFMA16(a0, ldfrag(WT, 72, 16 * bn, 0, lane), acc[bn]); acc[bn] = MFMA16(a1, ldfrag(WT, 72, 16 * bn, 32, lane), acc[bn]); }
        __syncthreads();
#pragma unroll
        for (int bn = 0; bn < 4; ++bn)
#pragma unroll
            for (int r = 0; r < 4; ++r) O[(16 * bm + 4 * g4 + r) * 72 + 16 * bn + lc] = (bf16)f2bf(acc[bn][r]);
    }
    __syncthreads();
    {
        const int q = w >> 1; const LAS bf16* Am = (q < 2) ? MRBT : BJ; const LAS bf16* Bm = (q & 1) ? G2 : G1;
        f32x4 acc[2][4];
#pragma unroll
        for (int bi = 0; bi < 2; ++bi) { const int bm = 2 * (w & 1) + bi; const bf16x8 a0 = ldfrag(Am, 72, 16 * bm, 0, lane), a1 = ldfrag(Am, 72, 16 * bm, 32, lane);
#pragma unroll
            for (int bn = 0; bn < 4; ++bn) { acc[bi][bn] = (f32x4){0.f, 0.f, 0.f, 0.f};
                acc[bi][bn] = MFMA16(a0, ldfrag(Bm, 72, 16 * bn, 0, lane), acc[bi][bn]); acc[bi][bn] = MFMA16(a1, ldfrag(Bm, 72, 16 * bn, 32, lane), acc[bi][bn]); } }
        __syncthreads();
        bf16* gout = (bf16*)(ws + (q == 0 ? WS_QYT : q == 1 ? WS_CYT : WS_TST)) + (size_t)unit * 4096;
#pragma unroll
        for (int bi = 0; bi < 2; ++bi) { const int bm = 2 * (w & 1) + bi;
#pragma unroll
            for (int bn = 0; bn < 4; ++bn)
#pragma unroll
                for (int r = 0; r < 4; ++r) { const int row = 16 * bm + 4 * g4 + r, col = 16 * bn + lc; float v = acc[bi][bn][r];
                    if (q == 0) v += bf2f(RT[row * 72 + col]); else if (q == 1) v += bf2f(MRKT[row * 72 + col]); else if (q == 2) v += (row == col) ? PT[row] : 0.f; else v += bf2f(KJ[row * 72 + col]);
                    if (q < 3) gout[row * 64 + col] = (bf16)f2bf(v); else CST[row * 72 + col] = (bf16)f2bf(v); } }
    }
    __syncthreads();
    {
        const int bm = w >> 1; float* nst = (float*)(ws + WS_NST) + (size_t)unit * 4096;
        const bf16x8 a0 = ldfrag(CST, 72, 16 * bm, 0, lane), a1 = ldfrag(CST, 72, 16 * bm, 32, lane);
#pragma unroll
        for (int qn = 0; qn < 2; ++qn) { const int bn = (w & 1) * 2 + qn; f32x4 acc = (f32x4){0.f, 0.f, 0.f, 0.f};
            acc = MFMA16(a0, ldfrag(VJ, 72, 16 * bn, 0, lane), acc); acc = MFMA16(a1, ldfrag(VJ, 72, 16 * bn, 32, lane), acc);
#pragma unroll
            for (int r = 0; r < 4; ++r) nst[(16 * bm + 4 * g4 + r) * 64 + 16 * bn + lc] = acc[r]; }
    }
    __syncthreads();
}

DI void p_rwkv_scan2(Frame& F, int wslot) {
    unsigned char* ws = F.ws; const int lane = F.lane, g4 = lane >> 4, lc = lane & 15, h = wslot >> 2, ib = wslot & 3;
    f32x4 st[4];
#pragma unroll
    for (int jb = 0; jb < 4; ++jb) st[jb] = (f32x4){0.f, 0.f, 0.f, 0.f};
    const bf16* TST = (const bf16*)(ws + WS_TST); const float* NST = (const float*)(ws + WS_NST); bf16* S0 = (bf16*)(ws + WS_S0);
    u32x2 ta[4][2][2]; f32x4 nn[4];
#define SC_LOAD(cc) { const size_t ub = (size_t)((cc) * 8 + h) * 4096; \
        _Pragma("unroll") for (int jb = 0; jb < 4; ++jb) { const bf16* rowp = TST + ub + (size_t)(16 * jb + lc) * 64 + 4 * g4; \
            _Pragma("unroll") for (int ks = 0; ks < 2; ++ks) { ta[jb][ks][0] = *(const GAS u32x2*)(rowp + 32 * ks); ta[jb][ks][1] = *(const GAS u32x2*)(rowp + 32 * ks + 16); } \
            _Pragma("unroll") for (int r = 0; r < 4; ++r) nn[jb][r] = NST[ub + (size_t)(16 * jb + 4 * g4 + r) * 64 + 16 * ib + lc]; } }
    SC_LOAD(0)
    for (int c = 0; c < NCH; ++c) {
        bf16* s0p = S0 + (size_t)(c * 8 + h) * 4096 + (size_t)(16 * ib + lc) * 64 + 4 * g4;
        bf16x8 bfr[2];
#pragma unroll
        for (int ks = 0; ks < 2; ++ks) { u32x4 p; p.x = pk2(st[2 * ks][0], st[2 * ks][1]); p.y = pk2(st[2 * ks][2], st[2 * ks][3]); p.z = pk2(st[2 * ks + 1][0], st[2 * ks + 1][1]); p.w = pk2(st[2 * ks + 1][2], st[2 * ks + 1][3]);
            bfr[ks] = __builtin_bit_cast(bf16x8, p);
            *(GAS u32x2*)(s0p + 32 * ks) = (u32x2){p.x, p.y}; *(GAS u32x2*)(s0p + 32 * ks + 16) = (u32x2){p.z, p.w}; }
        f32x4 nw[4];
#pragma unroll
        for (int jb = 0; jb < 4; ++jb) { nw[jb] = nn[jb];
#pragma unroll
            for (int ks = 0; ks < 2; ++ks) { const u32x4 aw = (u32x4){ta[jb][ks][0].x, ta[jb][ks][0].y, ta[jb][ks][1].x, ta[jb][ks][1].y}; nw[jb] = MFMA16(__builtin_bit_cast(bf16x8, aw), bfr[ks], nw[jb]); } }
        if (c + 1 < NCH) SC_LOAD(c + 1)
#pragma unroll
        for (int jb = 0; jb < 4; ++jb) st[jb] = nw[jb];
    }
#undef SC_LOAD
}

DI void u_rwkv_r3(Frame& F, int l_, int c, int h) {
    unsigned char* ws = F.ws; const int tid = F.tid, lane = F.lane, w = F.wave, g4 = lane >> 4, lc = lane & 15, unit = c * 8 + h;
    LAS bf16* QY = (LAS bf16*)F.lds; LAS bf16* CY = QY + 4608; LAS bf16* S0s = CY + 4608; LAS bf16* VJ = S0s + 4608; LAS float* Ys = (LAS float*)(VJ + 4608);
    stage_nat(QY, 72, (const bf16*)(ws + WS_QYT) + (size_t)unit * 4096, 64, 64, 8, tid);
    stage_nat(CY, 72, (const bf16*)(ws + WS_CYT) + (size_t)unit * 4096, 64, 64, 8, tid);
    stage_nat(S0s, 72, (const bf16*)(ws + WS_S0) + (size_t)unit * 4096, 64, 64, 8, tid);
    const size_t gb = (size_t)(c * 64) * 512 + h * 64;
    { const int t = tid >> 3, j0 = (tid & 7) * 8; const float* vp = (const float*)(ws + WS_VV) + gb + (size_t)t * 512 + j0; const f32x4 x0 = *(const GAS f32x4*)vp, x1 = *(const GAS f32x4*)(vp + 4);
#pragma unroll
      for (int i = 0; i < 4; ++i) { VJ[(j0 + i) * 72 + t] = (bf16)f2bf(x0[i]); VJ[(j0 + 4 + i) * 72 + t] = (bf16)f2bf(x1[i]); } }
    __syncthreads();
    { const int bm = w >> 1;
#pragma unroll
      for (int qn = 0; qn < 2; ++qn) { const int bn = (w & 1) * 2 + qn; f32x4 acc = (f32x4){0.f, 0.f, 0.f, 0.f};
#pragma unroll
          for (int ks = 0; ks < 2; ++ks) { acc = MFMA16(ldfrag(QY, 72, 16 * bm, 32 * ks, lane), ldfrag(S0s, 72, 16 * bn, 32 * ks, lane), acc); acc = MFMA16(ldfrag(CY, 72, 16 * bm, 32 * ks, lane), ldfrag(VJ, 72, 16 * bn, 32 * ks, lane), acc); }
#pragma unroll
          for (int r = 0; r < 4; ++r) Ys[(16 * bm + 4 * g4 + r) * 65 + 16 * bn + lc] = acc[r]; } }
    __syncthreads();
    { const float* prm = (const float*)(ws + WS_PRM) + (size_t)l_ * PRM_STRIDE; const float lnw = prm[P_LNW + h * 64 + lane], lnb = prm[P_LNB + h * 64 + lane], rk = prm[P_RK + h * 64 + lane];
#pragma unroll
      for (int rr = 0; rr < 8; ++rr) { const int t = 8 * w + rr; const size_t o = gb + (size_t)t * 512 + lane; const float y = Ys[t * 65 + lane];
          const float r = ((const float*)(ws + WS_R32))[o], k = ((const float*)(ws + WS_KP))[o], v = ((const float*)(ws + WS_VV))[o], g = ((const float*)(ws + WS_G32))[o];
          const float mean = wave_sum(y) * (1.f / 64.f), d = y - mean, rstd = rsqrtf(wave_sum(d * d) * (1.f / 64.f) + 64e-5f), bs = wave_sum(r * k * rk);
          ((bf16*)(ws + WS_OB))[(size_t)(c * 64 + t) * D + 1536 + h * 64 + lane] = (bf16)f2bf((d * rstd * lnw + lnb + bs * v) * g); } }
    __syncthreads();
}

constexpr int STEPS_PER_LAYER = 13, NSTEPS = 1 + DEPTH * STEPS_PER_LAYER;
constexpr int NSCAN_BLK = 8;

__global__ void __launch_bounds__(NTHR, 2) mk_fwd(Args args) {
    extern __shared__ __attribute__((aligned(16))) unsigned char lds_raw[];
    Frame F;
    F.lds = (LAS unsigned char*)lds_raw; F.MISC = (volatile LAS unsigned*)(F.lds + MISC_OFF);
    F.tid = threadIdx.x; F.lane = F.tid & 63; F.wave = __builtin_amdgcn_readfirstlane(F.tid >> 6);
    F.G = gridDim.x; F.bid = blockIdx.x; F.ws = args.ws; F.ctl = (gu32*)(args.ws + WS_CTL);
    for (int u = F.tid; u < (LDS_BYTES - LDSCTL_OFF) / 4; u += NTHR) ((LAS unsigned*)(F.lds + LDSCTL_OFF))[u] = 0u;
    __syncthreads();
    const int lo = args.st_lo, hi = args.st_hi;
    XcdBarrier bar; bar.bar = (unsigned*)(F.ctl + CW_BAR); bar.x = 0; bar.st = nullptr;
    if (hi - lo > 1) bar = xcd_barrier_post((unsigned*)(F.ctl + CW_BAR), F.MISC + 8);
#ifndef MK_MASK
#define MK_MASK 0xFFFFu
#endif
#define EN(k) (((MK_MASK) >> (k)) & 1u)
#ifndef MK_REP
#define MK_REP 0u
#endif
#define REP(k) (((MK_REP) >> (k)) & 1u)
#define RUN(s) (lo <= (s) && (s) < hi)
#define SEAM(s) do { if ((s) + 1 < hi) xcd_barrier(bar); } while (0)

    if (EN(13) && RUN(0)) { _Pragma("unroll 1") for (int rp = 0; rp <= (int)REP(13); ++rp) { relaunder(F, args.ws, (LAS unsigned char*)lds_raw); p_prologue(F, args); } SEAM(0); }

    for (int l = 0; l < DEPTH; ++l) {
        const int sb = 1 + l * STEPS_PER_LAYER;
        const float* xin = (l == 0) ? args.in[0] : args.out;
        if (EN(0) && RUN(sb + 0)) { _Pragma("unroll 1") for (int rp = 0; rp <= (int)REP(0); ++rp) { relaunder(F, args.ws, (LAS unsigned char*)lds_raw); unsigned char* ws = F.ws; p_rmsnorm(F, xin, (const float*)(ws + WS_PRM) + (size_t)l * PRM_STRIDE + P_N1, (bf16*)(ws + WS_XN)); } SEAM(sb + 0); }
        if (EN(1) && RUN(sb + 1)) { _Pragma("unroll 1") for (int rp = 0; rp <= (int)REP(1); ++rp) { relaunder(F, args.ws, (LAS unsigned char*)lds_raw); unsigned char* ws = F.ws;
            pg8::Gemm g{(const bf16*)(ws + WS_XN), (const bf16*)(ws + WS_WIN) + (size_t)l * NINP * D, D, D, D};
            pg8::StaticOrder So; So.init(S, NINP, F.G, F.bid); pg8::EpiIn E{ws};
            pg8::gemm_phase<pg8::EpiIn, pg8::StaticOrder, true>(F.lds, g, So, E, F.tid);
            } SEAM(sb + 1);
        }
        if (EN(2) && RUN(sb + 2)) { _Pragma("unroll 1") for (int rp = 0; rp <= (int)REP(2); ++rp) { relaunder(F, args.ws, (LAS unsigned char*)lds_raw); unsigned char* ws = F.ws;
            p_rwkv_prep(F, l);
            relaunder(F, args.ws, (LAS unsigned char*)lds_raw); p_mamba_prep(F, l);
            __syncthreads(); relaunder(F, args.ws, (LAS unsigned char*)lds_raw);
            for (int u = (F.bid + 128) % F.G; u < 512; u += F.G) u_ret_kv(F, u >> 2, u & 3);
            } SEAM(sb + 2);
        }
        if (EN(3) && RUN(sb + 3)) { _Pragma("unroll 1") for (int rp = 0; rp <= (int)REP(3); ++rp) { relaunder(F, args.ws, (LAS unsigned char*)lds_raw); unsigned char* ws = F.ws;
            { pg8::Gemm g{(const bf16*)(ws + WS_CQ), (const bf16*)(ws + WS_WQB) + (size_t)l * 1024 * 512, 512, 512, 512};
              pg8::StaticOrder So; So.init(S, 1024, F.G, F.bid); pg8::EpiQb E{ws, (const float*)(ws + WS_PRM) + (size_t)l * PRM_STRIDE + P_QNW};
              pg8::gemm_phase<pg8::EpiQb, pg8::StaticOrder, false>(F.lds, g, So, E, F.tid); __syncthreads(); }
            relaunder(F, args.ws, (LAS unsigned char*)lds_raw); ws = F.ws;
            { pg8::Gemm g{(const bf16*)(ws + WS_CKV), (const bf16*)(ws + WS_WKVB) + (size_t)l * 1024 * 256, 256, 256, 256};
              pg8::StaticOrder So; So.init(S, 1024, F.G, (F.bid + 128) % F.G); pg8::EpiKvb E{ws, (const float*)(ws + WS_PRM) + (size_t)l * PRM_STRIDE + P_KNW};
              pg8::gemm_phase<pg8::EpiKvb, pg8::StaticOrder, false>(F.lds, g, So, E, F.tid); __syncthreads(); }
            relaunder(F, args.ws, (LAS unsigned char*)lds_raw); ws = F.ws;
            if (l > 0) { pg8::Gemm g{(const bf16*)(ws + WS_VB), (const bf16*)(ws + WS_WV1) + (size_t)l * 256 * 512, 512, 512, 512};
              pg8::StaticOrder So; So.init(S, 256, F.G, (F.bid + 64) % F.G); pg8::EpiV1 E{ws};
              pg8::gemm_phase<pg8::EpiV1, pg8::StaticOrder, true>(F.lds, g, So, E, F.tid); __syncthreads(); }
            relaunder(F, args.ws, (LAS unsigned char*)lds_raw);
            for (int u = F.bid; u < 256; u += F.G) u_mamba_st(F, u >> 1, u & 1);
            } SEAM(sb + 3);
        }
        if (EN(4) && RUN(sb + 4)) { _Pragma("unroll 1") for (int rp = 0; rp <= (int)REP(4); ++rp) { relaunder(F, args.ws, (LAS unsigned char*)lds_raw); unsigned char* ws = F.ws;
            p_scans(F);
            relaunder(F, args.ws, (LAS unsigned char*)lds_raw); ws = F.ws;
            { pg8::Gemm g{(const bf16*)(ws + WS_ALORA), (const bf16*)(ws + WS_WLORA) + (size_t)l * 2048 * 512, 512, 512, 512};
              pg8::StaticOrder So; So.init(S, l > 0 ? 2048 : 1536, F.G, F.bid);
              const float* prm = (const float*)(ws + WS_PRM) + (size_t)l * PRM_STRIDE; pg8::EpiLora E{ws, prm + P_W0, prm + P_A0, prm + P_V0, prm + P_KA};
              pg8::gemm_phase<pg8::EpiLora, pg8::StaticOrder, true>(F.lds, g, So, E, F.tid); }
            } SEAM(sb + 4);
        }
        if (EN(5) && RUN(sb + 5)) { _Pragma("unroll 1") for (int rp = 0; rp <= (int)REP(5); ++rp) { relaunder(F, args.ws, (LAS unsigned char*)lds_raw); unsigned char* ws = F.ws; (void)ws;
            for (int u = F.bid; u < 1024; u += F.G) u_rwkv_r1(F, u >> 3, u & 7);
            } SEAM(sb + 5);
        }
        if (EN(6) && RUN(sb + 6)) { _Pragma("unroll 1") for (int rp = 0; rp <= (int)REP(6); ++rp) { relaunder(F, args.ws, (LAS unsigned char*)lds_raw); unsigned char* ws = F.ws; (void)ws;
            if (F.bid < NSCAN_BLK) { if (F.wave < 4) p_rwkv_scan2(F, F.bid * 4 + F.wave); }
            else {
                const int NB = F.G - NSCAN_BLK, b = F.bid - NSCAN_BLK;
                for (int r = 0; r * NB < 512; ++r) { const int pos = (r & 1) ? NB - 1 - b : b; const int i = r * NB + pos; if (i < 512) u_attn(F, 127 - (i >> 2), i & 3); }
                relaunder(F, args.ws, (LAS unsigned char*)lds_raw);
                for (int u = b; u < 512; u += NB) u_ret_out(F, l, u >> 2, u & 3);
                relaunder(F, args.ws, (LAS unsigned char*)lds_raw);
                for (int u = b; u < 256; u += NB) u_mamba_out(F, l, u >> 1, u & 1);
            }
            } SEAM(sb + 6);
        }
        if (EN(7) && RUN(sb + 7)) { _Pragma("unroll 1") for (int rp = 0; rp <= (int)REP(7); ++rp) { relaunder(F, args.ws, (LAS unsigned char*)lds_raw); unsigned char* ws = F.ws; (void)ws;
            for (int u = F.bid; u < 1024; u += F.G) u_rwkv_r3(F, l, u >> 3, u & 7);
            } SEAM(sb + 7);
        }
        if (EN(8) && RUN(sb + 8)) { _Pragma("unroll 1") for (int rp = 0; rp <= (int)REP(8); ++rp) { relaunder(F, args.ws, (LAS unsigned char*)lds_raw); unsigned char* ws = F.ws;
            pg8::Gemm g{(const bf16*)(ws + WS_OB), (const bf16*)(ws + WS_WBR) + (size_t)l * 8192 * 512, 512, D, 512};
            pg8::BranchOrder So; So.init(F.G, F.bid); pg8::EpiBranch E{ws};
            pg8::gemm_phase<pg8::EpiBranch, pg8::BranchOrder, true>(F.lds, g, So, E, F.tid);
            } SEAM(sb + 8);
        }
        if (EN(9) && RUN(sb + 9)) { _Pragma("unroll 1") for (int rp = 0; rp <= (int)REP(9); ++rp) { relaunder(F, args.ws, (LAS unsigned char*)lds_raw); unsigned char* ws = F.ws;
            pg8::Gemm g{(const bf16*)(ws + WS_MERGED), (const bf16*)(ws + WS_WOUT) + (size_t)l * D * D, D, D, D};
            pg8::StaticOrder So; So.init(S, D, F.G, F.bid); pg8::EpiRes E{xin, args.out};
            pg8::gemm_phase<pg8::EpiRes, pg8::StaticOrder, true>(F.lds, g, So, E, F.tid);
            } SEAM(sb + 9);
        }
        if (EN(10) && RUN(sb + 10)) { _Pragma("unroll 1") for (int rp = 0; rp <= (int)REP(10); ++rp) { relaunder(F, args.ws, (LAS unsigned char*)lds_raw); unsigned char* ws = F.ws; p_rmsnorm(F, args.out, (const float*)(ws + WS_PRM) + (size_t)l * PRM_STRIDE + P_N2, (bf16*)(ws + WS_XN)); } SEAM(sb + 10); }
        if (EN(11) && RUN(sb + 11)) { _Pragma("unroll 1") for (int rp = 0; rp <= (int)REP(11); ++rp) { relaunder(F, args.ws, (LAS unsigned char*)lds_raw); unsigned char* ws = F.ws;
            pg8::Gemm g{(const bf16*)(ws + WS_XN), (const bf16*)(ws + WS_WGU) + (size_t)l * 2 * DFF * D, D, D, D};
            pg8::StaticOrder So; So.init(S, 2 * DFF, F.G, F.bid); pg8::EpiGu E{ws};
            pg8::gemm_phase<pg8::EpiGu, pg8::StaticOrder, true>(F.lds, g, So, E, F.tid);
            } SEAM(sb + 11);
        }
        if (EN(12) && RUN(sb + 12)) { _Pragma("unroll 1") for (int rp = 0; rp <= (int)REP(12); ++rp) { relaunder(F, args.ws, (LAS unsigned char*)lds_raw); unsigned char* ws = F.ws;
            pg8::Gemm g{(const bf16*)(ws + WS_ACT), (const bf16*)(ws + WS_WDN) + (size_t)l * D * DFF, DFF, DFF, DFF};
            pg8::StaticOrder So; So.init(S, D, F.G, F.bid); pg8::EpiRes E{args.out, args.out};
            pg8::gemm_phase<pg8::EpiRes, pg8::StaticOrder, true>(F.lds, g, So, E, F.tid);
            } SEAM(sb + 12);
        }
    }
#undef RUN
#undef SEAM
}

#ifndef MK_ONE_LAUNCH
#define MK_ONE_LAUNCH 1
#endif
extern "C" void kernel_launch(void* const* d_in, const int* in_sizes, int n_in, void* d_out, int out_size, void* d_ws, size_t ws_size, hipStream_t stream) {
    static int grid = 0;
    if (grid == 0) {
        if (n_in != 36 || in_sizes[0] != S * D || out_size != S * D || ws_size < WS_END2) { fprintf(stderr, "kernel_launch: bad shapes: n_in %d in0 %d out %d ws %zu (need %zu)\n", n_in, n_in > 0 ? in_sizes[0] : -1, out_size, ws_size, (size_t)WS_END2); grid = -1; return; }
        int dev = 0, cus = 0, per_cu = 0;
        if (hipGetDevice(&dev) != hipSuccess || hipDeviceGetAttribute(&cus, hipDeviceAttributeMultiprocessorCount, dev) != hipSuccess) { grid = -1; return; }
        if (hipFuncSetAttribute((const void*)mk_fwd, hipFuncAttributeMaxDynamicSharedMemorySize, LDS_BYTES) != hipSuccess) { fprintf(stderr, "kernel_launch: hipFuncSetAttribute failed\n"); grid = -1; return; }
        if (hipOccupancyMaxActiveBlocksPerMultiprocessor(&per_cu, (const void*)mk_fwd, NTHR, LDS_BYTES) != hipSuccess || per_cu < 1) fprintf(stderr, "kernel_launch: occupancy query says %d\n", per_cu);
        (void)hipGetLastError();
        grid = cus;
        if (grid != 256) fprintf(stderr, "kernel_launch: %d CUs (built for 256)\n", grid);
    }
    if (grid < 0) return;
    if (hipMemsetAsync((char*)d_ws + WS_CTL, 0, CTL_ZERO_BYTES, stream) != hipSuccess) return;
    Args a{};
    for (int i = 0; i < 36; ++i) a.in[i] = (const float*)d_in[i];
    a.out = (float*)d_out; a.ws = (unsigned char*)d_ws;
#if MK_ONE_LAUNCH
    a.st_lo = 0; a.st_hi = NSTEPS;
    hipLaunchKernelGGL(mk_fwd, dim3(grid), dim3(NTHR), LDS_BYTES, stream, a);
#else
    for (int s = 0; s < NSTEPS; ++s) { a.st_lo = s; a.st_hi = s + 1; hipLaunchKernelGGL(mk_fwd, dim3(grid), dim3(NTHR), LDS_BYTES, stream, a); }
#endif
}
```

```cpp
#include <hip/hip_runtime.h>
#include <cstdio>
#include <cstdint>

#define GAS __attribute__((address_space(1)))
#define LAS __attribute__((address_space(3)))
typedef unsigned short bf16;
typedef short bf16x8 __attribute__((ext_vector_type(8)));
typedef short s16x4 __attribute__((ext_vector_type(4)));
typedef float f32x4 __attribute__((ext_vector_type(4)));
typedef float f32x2 __attribute__((ext_vector_type(2)));
typedef unsigned u32x4 __attribute__((ext_vector_type(4)));
typedef unsigned u32x2 __attribute__((ext_vector_type(2)));
typedef GAS unsigned gu32;
#define RLX_AGENT __ATOMIC_RELAXED, __HIP_MEMORY_SCOPE_AGENT
#define DI __device__ __forceinline__

constexpr int S = 8192, D = 2048, DEPTH = 4, NIN = 14408, NINP = 14592, DFF = 5632;
constexpr int NCH = 128;
constexpr float LOG2E = 1.4426950408889634f;

DI float bf2f(unsigned v) { return __uint_as_float(v << 16); }
DI unsigned f2bf(float f) { unsigned u = __float_as_uint(f); return (u + 0x7fffu + ((u >> 16) & 1u)) >> 16; }
DI unsigned pk2(float lo, float hi) { unsigned r; asm volatile("v_cvt_pk_bf16_f32 %0, %1, %2" : "=v"(r) : "v"(lo), "v"(hi)); return r; }
DI float sigmoidf_(float x) { return 1.0f / (1.0f + __expf(-x)); }
DI float siluf_(float x) { return x / (1.0f + __expf(-x)); }
DI float softplusf_(float x) { return fmaxf(x, 0.f) + log1pf(__expf(-fabsf(x))); }
DI u32x4 pack8(const f32x4 a, const f32x4 b) { u32x4 w; w.x = pk2(a[0], a[1]); w.y = pk2(a[2], a[3]); w.z = pk2(b[0], b[1]); w.w = pk2(b[2], b[3]); return w; }
DI void unpack8(const u32x4 w, float (&o)[8]) { o[0] = bf2f(w.x & 0xffffu); o[1] = bf2f(w.x >> 16); o[2] = bf2f(w.y & 0xffffu); o[3] = bf2f(w.y >> 16);
    o[4] = bf2f(w.z & 0xffffu); o[5] = bf2f(w.z >> 16); o[6] = bf2f(w.w & 0xffffu); o[7] = bf2f(w.w >> 16); }

namespace pg8 {
constexpr int BM = 256, BK = 64, HALF = 128, HTB = HALF * BK * 2, STAGE_BYTES = 8 * HTB, NXCD = 8, WGM = 8;
DI int lds_byte(int r, int c) { const int st = (r >> 4) * 2 + (c >> 5), rr = r & 15, cc = c & 31, ob = rr * 64 + cc * 2; return st * 1024 + (ob ^ (((ob >> 9) & 1) << 5)); }
DI void stage_rc(int b, int& R, int& C) { const int st = b / 1024, sb = b % 1024, swz = sb ^ (((sb >> 9) & 1) << 5); R = (st >> 1) * 16 + swz / 64; C = (st & 1) * 32 + (swz % 64) / 2; }
DI int perm32(int rho) { const int n = rho >> 4, i = rho & 15; return 8 * (i >> 2) + 4 * n + (i & 3); }

struct Unit { int pm, pn, ak, brow, sub; };
struct Gemm { const bf16* A; const bf16* Bt; int K, lda, ldb; };

struct StaticOrder {
    int nM, nN, nwg, G, c;
    DI void init(int M, int N, int G_, int c_) { nM = M / BM; nN = N / BM; nwg = nM * nN; G = G_; c = c_; }
    DI bool next(int i, Unit& u) const {
        const long L = (long)i * G + c; if (L >= nwg) return false;
        int wgid = (int)L; { const int q = nwg / NXCD, r = nwg % NXCD, xcd = wgid % NXCD, off = wgid / NXCD; wgid = (xcd < r ? xcd * (q + 1) : r * (q + 1) + (xcd - r) * q) + off; }
        const int nig = WGM * nN, gid = wgid / nig, fm = gid * WGM, gsz = (nM - fm) < WGM ? (nM - fm) : WGM;
        u.pm = fm + ((wgid % nig) % gsz); u.pn = (wgid % nig) / gsz; u.ak = 0; u.brow = u.pn * BM; u.sub = 0; return true;
    }
};
struct BranchOrder {
    StaticOrder so;
    DI void init(int G_, int c_) { so.init(S, D, G_, c_); }
    DI bool next(int i, Unit& u) const { if (!so.next(i >> 2, u)) return false; u.sub = i & 3; u.ak = u.sub * 512; u.brow = u.sub * D + u.pn * BM; return true; }
};

typedef f32x4 Acc[2][2][4][2];

template <class Epi, class Sched, bool ALIGN_EPI>
DI void gemm_phase(LAS unsigned char* lds, const Gemm g, const Sched& Sc, const Epi& E, const int tid) {
    const int wid = __builtin_amdgcn_readfirstlane(tid >> 6), lane = tid & 63, wr = wid >> 2, wc = wid & 3, fr = lane & 15, fq = lane >> 4;
    const int K = g.K, nt = K / BK;
    unsigned voffA[2], voffB[2];
#pragma unroll
    for (int i = 0; i < 2; ++i) { int R, C; stage_rc(tid * 16 + i * 8192, R, C); const int Rb = (R & ~31) + perm32(R & 31);
        voffA[i] = (unsigned)(R * g.lda + C) * 2u; voffB[i] = (unsigned)(Rb * g.ldb + C) * 2u; }
    const size_t kstep = (size_t)(BK * 2);
    const size_t hA = (size_t)HALF * g.lda * 2, hB = (size_t)HALF * g.ldb * 2;
    const unsigned ldsw = (unsigned)wid * 1024u;
    const int aoff = lds_byte(wr * 64 + fr, fq * 8), boff = lds_byte(wc * 32 + fr, fq * 8);
#define PG8_SA(b, h) (((b) * 2 + (h)) * HTB)
#define PG8_SB(b, h) ((4 + (b) * 2 + (h)) * HTB)
#define PG8_STAGE(bufoff, gbase, voff) do { _Pragma("unroll") for (int _i = 0; _i < 2; ++_i) \
        __builtin_amdgcn_global_load_lds((const unsigned*)((const char*)(gbase) + (voff)[_i]), (LAS unsigned*)(lds + (bufoff) + ldsw + _i * 8192), 16, 0, 0); } while (0)
#define PG8_LDA(dst, b, h) do { _Pragma("unroll") for (int m = 0; m < 4; ++m) _Pragma("unroll") for (int k = 0; k < 2; ++k) dst[m][k] = *(const LAS bf16x8*)(lds + PG8_SA(b, h) + aoff + m * 2048 + k * 1024); } while (0)
#define PG8_LDB(dst, b, h) do { _Pragma("unroll") for (int n = 0; n < 2; ++n) _Pragma("unroll") for (int k = 0; k < 2; ++k) dst[n][k] = *(const LAS bf16x8*)(lds + PG8_SB(b, h) + boff + n * 2048 + k * 1024); } while (0)
#define PG8_MMA(ai, bj, At, Bt) do { __builtin_amdgcn_s_setprio(1); _Pragma("unroll") for (int m = 0; m < 4; ++m) _Pragma("unroll") for (int n = 0; n < 2; ++n) _Pragma("unroll") for (int k = 0; k < 2; ++k) \
        acc[ai][bj][m][n] = __builtin_amdgcn_mfma_f32_16x16x32_bf16(Bt[n][k], At[m][k], acc[ai][bj][m][n], 0, 0, 0); __builtin_amdgcn_s_setprio(0); } while (0)
#define PG8_WAIT_V(n) asm volatile("s_waitcnt vmcnt(" #n ")" ::: "memory")
#define PG8_WAIT_L(n) asm volatile("s_waitcnt lgkmcnt(" #n ")" ::: "memory")
#define PG8_BAR __builtin_amdgcn_s_barrier()
#define PG8_SCHED __builtin_amdgcn_sched_barrier(0)
    Unit cur, nxt; int ui = 0;
    if (!Sc.next(0, cur)) return;
    Acc acc;
#pragma unroll
    for (int a = 0; a < 2; ++a)
#pragma unroll
        for (int b = 0; b < 2; ++b)
#pragma unroll
            for (int m = 0; m < 4; ++m)
#pragma unroll
                for (int n = 0; n < 2; ++n) acc[a][b][m][n] = (f32x4){0.f, 0.f, 0.f, 0.f};
    bf16x8 At[4][2], B0[2][2], B1[2][2];
    const char* cA = (const char*)g.A + ((size_t)cur.pm * BM * g.lda + cur.ak) * 2; const char* cB = (const char*)g.Bt + (size_t)cur.brow * g.ldb * 2;
    PG8_STAGE(PG8_SB(0, 0), cB, voffB); PG8_STAGE(PG8_SB(0, 1), cB + hB, voffB); PG8_STAGE(PG8_SA(0, 0), cA, voffA); PG8_STAGE(PG8_SA(0, 1), cA + hA, voffA);
    if (wr == 1) PG8_BAR;
    PG8_WAIT_V(2); PG8_BAR;
    PG8_STAGE(PG8_SB(1, 0), cB + kstep, voffB); PG8_STAGE(PG8_SA(1, 0), cA + kstep, voffA); PG8_STAGE(PG8_SB(1, 1), cB + hB + kstep, voffB);
    PG8_WAIT_V(6); PG8_BAR;
    for (;;) {
        const bool has_next = Sc.next(ui + 1, nxt);
        const char* nA = has_next ? (const char*)g.A + ((size_t)nxt.pm * BM * g.lda + nxt.ak) * 2 : cA; const char* nB = has_next ? (const char*)g.Bt + (size_t)nxt.brow * g.ldb * 2 : cB;
        for (int t = 0; t < nt; t += 2) {
            const bool last = (t == nt - 2);
            const char* a1 = cA + (size_t)(t + 1) * kstep;
            const char* a2 = last ? nA : cA + (size_t)(t + 2) * kstep; const char* b2 = last ? nB : cB + (size_t)(t + 2) * kstep;
            const char* a3 = a2 + kstep; const char* b3 = b2 + kstep;
            PG8_LDB(B0, 0, 0); PG8_LDB(B1, 0, 1); PG8_SCHED; PG8_LDA(At, 0, 0); PG8_STAGE(PG8_SA(1, 1), a1 + hA, voffA);
            PG8_WAIT_V(8); PG8_WAIT_L(0); PG8_BAR; PG8_MMA(0, 0, At, B0); PG8_MMA(0, 1, At, B1); PG8_BAR; PG8_SCHED;
            PG8_LDA(At, 0, 1); PG8_STAGE(PG8_SB(0, 0), b2, voffB); PG8_STAGE(PG8_SB(0, 1), b2 + hB, voffB); PG8_STAGE(PG8_SA(0, 0), a2, voffA);
            PG8_WAIT_V(8); PG8_WAIT_L(0); PG8_BAR; PG8_MMA(1, 0, At, B0); PG8_MMA(1, 1, At, B1); PG8_BAR; PG8_SCHED;
            PG8_LDB(B0, 1, 0); PG8_LDB(B1, 1, 1); PG8_SCHED; PG8_LDA(At, 1, 0); PG8_STAGE(PG8_SA(0, 1), a2 + hA, voffA);
            PG8_WAIT_V(8); PG8_WAIT_L(0); PG8_BAR; PG8_MMA(0, 0, At, B0); PG8_MMA(0, 1, At, B1); PG8_BAR; PG8_SCHED;
            PG8_LDA(At, 1, 1); PG8_STAGE(PG8_SB(1, 0), b3, voffB); PG8_STAGE(PG8_SB(1, 1), b3 + hB, voffB); PG8_STAGE(PG8_SA(1, 0), a3, voffA);
            PG8_WAIT_V(8); PG8_WAIT_L(0); PG8_BAR; PG8_MMA(1, 0, At, B0); PG8_MMA(1, 1, At, B1); PG8_BAR; PG8_SCHED;
        }
        if constexpr (ALIGN_EPI) { if (wr == 0) PG8_BAR; }
        bool zero = true;
        if constexpr (!Epi::AFTER_DRAIN) { zero = E(acc, cur, wr, wc, fr, fq); }
        if (!has_next) break;
        if (zero) {
#pragma unroll
        for (int a = 0; a < 2; ++a)
#pragma unroll
            for (int b = 0; b < 2; ++b)
#pragma unroll
                for (int m = 0; m < 4; ++m)
#pragma unroll
                    for (int n = 0; n < 2; ++n) acc[a][b][m][n] = (f32x4){0.f, 0.f, 0.f, 0.f};
        }
        cur = nxt; cA = nA; cB = nB; ++ui;
        if constexpr (ALIGN_EPI) { if (wr == 1) PG8_BAR; }
    }
    PG8_WAIT_V(0);
    if constexpr (!ALIGN_EPI) { if (wr == 0) PG8_BAR; }
    PG8_BAR;
    if constexpr (Epi::AFTER_DRAIN) { E.fused(acc, cur, wr, wc, fr, fq, lds, wid, lane, tid); }
#undef PG8_SA
#undef PG8_SB
#undef PG8_STAGE
#undef PG8_LDA
#undef PG8_LDB
#undef PG8_MMA
#undef PG8_WAIT_V
#undef PG8_WAIT_L
#undef PG8_BAR
#undef PG8_SCHED
}
}

constexpr size_t MiB = 1u << 20;
constexpr size_t al256(size_t x) { return (x + 255) & ~(size_t)255; }
constexpr size_t WS_CTL = 0, CTL_ZERO_BYTES = 1 * MiB;
constexpr size_t WS_PRM = 1 * MiB;
constexpr int P_N1 = 0, P_N2 = 2048, P_GN = 4096, P_CW = 4608, P_CB = 8704, P_DTB = 9728, P_ALOG = 9736, P_SD = 9744, P_SNW = 9760, P_QNW = 10272, P_KNW = 10464, P_MU = 10656,
              P_W0 = 12448, P_A0 = 12960, P_V0 = 13472, P_KK = 13984, P_KA = 14496, P_RK = 15008, P_LNW = 15520, P_LNB = 16032, PRM_STRIDE = 16640;
constexpr size_t WS_COSR = 2 * MiB;
constexpr size_t WS_SINR = WS_COSR + (size_t)S * 64 * 4;
constexpr size_t WS_COSM = WS_SINR + (size_t)S * 64 * 4;
constexpr size_t WS_SINM = WS_COSM + (size_t)S * 32 * 4;
constexpr size_t WS_WIN  = WS_SINM + (size_t)S * 32 * 4;
constexpr size_t WS_WQB  = WS_WIN + (size_t)DEPTH * NINP * D * 2;
constexpr size_t WS_WKVB = WS_WQB + (size_t)DEPTH * 1024 * 512 * 2;
constexpr size_t WS_WV1  = WS_WKVB + (size_t)DEPTH * 1024 * 256 * 2;
constexpr size_t WS_WLORA = WS_WV1 + (size_t)DEPTH * 256 * 512 * 2;
constexpr size_t WS_WBR  = WS_WLORA + (size_t)DEPTH * 2048 * 512 * 2;
constexpr size_t WS_WOUT = WS_WBR + (size_t)DEPTH * 8192 * 512 * 2;
constexpr size_t WS_WGU  = WS_WOUT + (size_t)DEPTH * D * D * 2;
constexpr size_t WS_WDN  = WS_WGU + (size_t)DEPTH * 2 * DFF * D * 2;
constexpr size_t WS_ACT0 = WS_WDN + (size_t)DEPTH * D * DFF * 2;
constexpr size_t WS_XN   = WS_ACT0;
constexpr size_t WS_QR   = WS_XN + (size_t)S * D * 2;
constexpr size_t WS_KR   = WS_QR + (size_t)S * 512 * 2;
constexpr size_t WS_VR   = WS_KR + (size_t)S * 512 * 2;
constexpr size_t WS_GR   = WS_VR + (size_t)S * 512 * 2;
constexpr size_t WS_ZS   = WS_GR + (size_t)S * 512 * 2;
constexpr size_t WS_XBC  = WS_ZS + (size_t)S * 512 * 2;
constexpr size_t WS_XC   = WS_XBC + (size_t)S * 1024 * 2;
constexpr size_t WS_CQ   = WS_XC + (size_t)S * 1024 * 2;
constexpr size_t WS_CKV  = WS_CQ + (size_t)S * 512 * 2;
constexpr size_t WS_SSQ  = WS_CKV + (size_t)S * 256 * 2;
constexpr size_t WS_RW   = WS_SSQ + (size_t)S * 16 * 4;
constexpr size_t WS_GATE = WS_RW + (size_t)S * 1792 * 4;
constexpr size_t WS_MISC = WS_GATE + (size_t)S * 8192 * 2;
constexpr size_t WS_DTS  = WS_MISC + (size_t)S * 256 * 4;
constexpr size_t WS_ACS  = WS_DTS + (size_t)S * 8 * 4;
constexpr size_t WS_RKV  = WS_ACS + (size_t)S * 8 * 4;
constexpr size_t WS_MST  = WS_RKV + (size_t)NCH * 4 * 128 * 128 * 4;
constexpr size_t WS_QM   = WS_MST + (size_t)NCH * 8 * 64 * 128 * 4;
constexpr size_t WS_KM   = WS_QM + (size_t)S * 768 * 2;
constexpr size_t WS_VT   = WS_KM + (size_t)S * 768 * 2;
constexpr size_t WS_R32  = WS_VT + (size_t)512 * S * 2;
constexpr size_t SZ32    = (size_t)S * 512 * 4;
constexpr size_t WS_KKN  = WS_R32 + SZ32, WS_K32 = WS_KKN + SZ32, WS_VV = WS_K32 + SZ32, WS_VFIRST = WS_VV + SZ32, WS_DEC = WS_VFIRST + SZ32,
                 WS_KP = WS_DEC + SZ32, WS_BB = WS_KP + SZ32, WS_G32 = WS_BB + SZ32, WS_Y32 = WS_G32 + SZ32;
constexpr size_t WS_VB   = WS_Y32 + SZ32;
constexpr size_t WS_ALORA = WS_VB + (size_t)S * 512 * 2;
constexpr size_t WS_OB   = WS_ALORA + (size_t)S * 512 * 2;
constexpr size_t WS_MERGED = WS_OB + (size_t)S * D * 2;
constexpr size_t WS_ACT  = WS_MERGED + (size_t)S * D * 2;
constexpr size_t WS_END  = WS_ACT + (size_t)S * DFF * 2;

constexpr int CW_TMO = 0, CW_CODE = 1, CW_BAR = 4096;

constexpr int NWAVES = 8, NTHR = 512;
constexpr int RING_BYTES = 143360, LDSCTL_OFF = RING_BYTES, MISC_OFF = LDSCTL_OFF + 320, LDS_BYTES = 147456;
#define LDS_WAIT() asm volatile("s_waitcnt lgkmcnt(0)" ::: "memory")
#define VM_WAIT() asm volatile("s_waitcnt vmcnt(0)" ::: "memory")

#define XB_TMO      128
#define XB_XCNT(j)  (256  + 64 * (j))
#define XB_XSUB(j)  (1280 + 64 * (j))
#define XB_XGEN(j)  (2304 + 64 * (j))
#define XB_TOP      3328
#define XB_TOPGEN   3392
#define XCD_BAR_WORDS 3456
#define XB_SPIN_CAP (1u << 22)
DI unsigned xb_ld(unsigned* p)              { return __hip_atomic_load(p, __ATOMIC_RELAXED, __HIP_MEMORY_SCOPE_AGENT); }
DI unsigned xb_add(unsigned* p, unsigned v) { return __hip_atomic_fetch_add(p, v, __ATOMIC_RELAXED, __HIP_MEMORY_SCOPE_AGENT); }
DI unsigned xb_xcc_id() { return (unsigned)__builtin_amdgcn_s_getreg((3 << 11) | 20) & 0xFu; }
#define XB_SPIN(cond, bar) do { unsigned _sp = 0; while (cond) { __builtin_amdgcn_s_sleep(1); \
    if ((++_sp & 255u) == 0u) { if (xb_ld(&(bar)[XB_TMO])) break; if (_sp > XB_SPIN_CAP) { atomicAdd(&(bar)[XB_TMO], 1u); break; } } } } while (0)
struct XcdBarrier { unsigned* bar; unsigned x; volatile LAS unsigned* st; };
DI XcdBarrier xcd_barrier_post(unsigned* bar, volatile LAS unsigned* st) {
    XcdBarrier b; b.bar = bar; b.x = xb_xcc_id(); b.st = st;
    if (threadIdx.x == 0) (void)xb_add(&bar[XB_XCNT(b.x)], 1u);
    return b;
}
DI void xcd_barrier_complete(unsigned* bar, unsigned x, unsigned& nloc, unsigned& nx) {
    const unsigned G = gridDim.x * gridDim.y * gridDim.z;
    unsigned sum, cnt, mine, sp = 0u;
    for (;;) {
        sum = 0u; cnt = 0u; mine = 0u;
#pragma unroll
        for (unsigned j = 0; j < 16; ++j) { const unsigned c = xb_ld(&bar[XB_XCNT(j)]); sum += c; cnt += (c > 0u) ? 1u : 0u; mine = (j == x) ? c : mine; }
        if (sum == G) break;
        __builtin_amdgcn_s_sleep(1);
        if ((++sp & 255u) == 0u) { if (xb_ld(&bar[XB_TMO])) break; if (sp > XB_SPIN_CAP) { atomicAdd(&bar[XB_TMO], 1u); break; } }
    }
    nloc = mine > 0u ? mine : 1u; nx = cnt > 0u ? cnt : 1u;
}
DI void xcd_barrier(const XcdBarrier& b) {
    asm volatile("s_waitcnt vmcnt(0)" ::: "memory");
    __syncthreads();
    if (threadIdx.x == 0) {
        unsigned* bar = b.bar;
        __builtin_amdgcn_s_waitcnt(0);
        unsigned nloc = b.st[0], nx = b.st[1];
        if (nloc == 0u) { xcd_barrier_complete(bar, b.x, nloc, nx); b.st[0] = nloc; b.st[1] = nx; }
        const unsigned old = xb_add(&bar[XB_XSUB(b.x)], 1u);
        const unsigned gen = old / nloc;
        if (old + 1u == (gen + 1u) * nloc) {
            __builtin_amdgcn_fence(__ATOMIC_RELEASE, "agent");
            asm volatile("s_waitcnt vmcnt(0)" ::: "memory");
            const unsigned og = xb_add(&bar[XB_TOP], 1u);
            const unsigned tg = og / nx;
            if (og + 1u == (tg + 1u) * nx) xb_add(&bar[XB_TOPGEN], 1u);
            else XB_SPIN(xb_ld(&bar[XB_TOPGEN]) == tg, bar);
            __builtin_amdgcn_fence(__ATOMIC_ACQUIRE, "agent");
            xb_add(&bar[XB_XGEN(b.x)], 1u);
            asm volatile("s_waitcnt vmcnt(0)" ::: "memory");
        } else {
            XB_SPIN(xb_ld(&bar[XB_XGEN(b.x)]) == gen, bar);
            __builtin_amdgcn_fence(__ATOMIC_ACQUIRE, "agent");
            asm volatile("s_waitcnt vmcnt(0)" ::: "memory");
        }
    }
    __syncthreads();
}

struct Args { const float* in[36]; float* out; unsigned char* ws; int st_lo, st_hi; };
struct Frame {
    LAS unsigned char* lds; volatile LAS unsigned* MISC; gu32* ctl;
    int tid, lane, wave, G, bid;
    unsigned char* ws;
};
DI void relaunder(Frame& F, unsigned char* ws0, LAS unsigned char* lds0) {
    int t = threadIdx.x; asm volatile("" : "+v"(t)); F.tid = t; F.lane = t & 63; F.wave = __builtin_amdgcn_readfirstlane(t >> 6);
    unsigned long long w = (unsigned long long)ws0; asm volatile("" : "+s"(w)); F.ws = (unsigned char*)w; F.ctl = (gu32*)(F.ws + WS_CTL);
    unsigned lb = (unsigned)(unsigned long)lds0; asm volatile("" : "+s"(lb)); F.lds = (LAS unsigned char*)(unsigned long)lb; F.MISC = (volatile LAS unsigned*)(F.lds + MISC_OFF);
    int b = blockIdx.x; asm volatile("" : "+s"(b)); F.bid = b;
}
DI float wave_sum(float v) {
#pragma unroll
    for (int o = 1; o < 64; o <<= 1) v += __shfl_xor(v, o);
    return v;
}
template <int CTRL> DI float dpp_f(float v) { return __builtin_bit_cast(float, __builtin_amdgcn_update_dpp(0, __builtin_bit_cast(int, v), CTRL, 0xf, 0xf, true)); }
DI float row_sum16(float v) { v += dpp_f<0xB1>(v); v += dpp_f<0x4E>(v); v += dpp_f<0x141>(v); v += dpp_f<0x140>(v); return v; }
DI float wave_sum_dpp(float v) {
    const float t = row_sum16(v);
    const float s0 = __builtin_bit_cast(float, __builtin_amdgcn_readlane(__builtin_bit_cast(int, t), 0));
    const float s1 = __builtin_bit_cast(float, __builtin_amdgcn_readlane(__builtin_bit_cast(int, t), 16));
    const float s2 = __builtin_bit_cast(float, __builtin_amdgcn_readlane(__builtin_bit_cast(int, t), 32));
    const float s3 = __builtin_bit_cast(float, __builtin_amdgcn_readlane(__builtin_bit_cast(int, t), 48));
    return (s0 + s1) + (s2 + s3);
}
constexpr size_t WS_QYT = WS_END;
constexpr size_t WS_CYT = WS_QYT + (size_t)1024 * 4096 * 2;
constexpr size_t WS_TST = WS_CYT + (size_t)1024 * 4096 * 2;
constexpr size_t WS_NST = WS_TST + (size_t)1024 * 4096 * 2;
constexpr size_t WS_S0  = WS_NST + (size_t)1024 * 4096 * 4;
constexpr size_t WS_END2 = WS_S0 + (size_t)1024 * 4096 * 2;

DI int map_in(int n) {
    const int T = n >> 8, c = n & 255;
    if (T < 4) { const int base = (T >> 1) * 512, tp = T & 1, half = c >> 7, hs = (c >> 6) & 1, j = c & 63; return base + (2 * tp + hs) * 128 + half * 64 + j; }
    if (T < 6) return 1024 + (T - 4) * 256 + c;
    if (T < 8) return 1536 + (T - 6) * 256 + c;
    if (T < 10) return 2048 + (T - 8) * 256 + c;
    if (T < 14) return 2560 + (T - 10) * 256 + c;
    if (T < 16) return 3592 + (T - 14) * 256 + c;
    if (T == 16) return 4104 + c;
    if (T < 24) return 4424 + (T - 17) * 256 + c;
    if (T < 56) return 6216 + (T - 24) * 256 + c;
    if (c < 8) return 3584 + c;
    if (c < 72) return 4360 + (c - 8);
    return -1;
}
DI int map_fn(int mapid, int n, int Nsrc) {
    if (mapid == 0) return n < Nsrc ? n : -1;
    if (mapid == 1) return map_in(n);
    if (mapid == 2) { const int T = n >> 8, c = n & 255; return c < 128 ? T * 128 + c : DFF + T * 128 + (c - 128); }
    if (mapid == 3) { const int h = n >> 8, c = n & 255; if (c < 96) return h * 192 + c; if (c < 128) return h * 192 + 128 + (c - 96); if (c < 160) return h * 192 + 96 + (c - 128); if (c < 224) return -1; return h * 192 + 160 + (c - 224); }
    return n < 32 ? n : -1;
}
DI void conv_item(const float* W, int K, int Nsrc, bf16* Wt, const float* kscale, int mapid, int item, int nblk, int lane) {
    const int kb = item / nblk, nb = item - kb * nblk, k0 = 64 * kb, n0 = 64 * nb;
    const int src = map_fn(mapid, n0 + lane, Nsrc);
    const float* wp = W + (size_t)k0 * Nsrc + (src >= 0 ? src : 0);
    bf16* op = Wt + (size_t)(n0 + lane) * K + k0;
#pragma unroll
    for (int hf = 0; hf < 2; ++hf) { float v[32];
#pragma unroll
        for (int i = 0; i < 32; ++i) v[i] = wp[(size_t)(32 * hf + i) * Nsrc];
        if (src < 0) {
#pragma unroll
            for (int i = 0; i < 32; ++i) v[i] = 0.f; }
        if (kscale) {
#pragma unroll
            for (int i = 0; i < 32; ++i) v[i] *= kscale[k0 + 32 * hf + i]; }
#pragma unroll
        for (int q = 0; q < 4; ++q) { u32x4 o; o.x = pk2(v[8 * q], v[8 * q + 1]); o.y = pk2(v[8 * q + 2], v[8 * q + 3]); o.z = pk2(v[8 * q + 4], v[8 * q + 5]); o.w = pk2(v[8 * q + 6], v[8 * q + 7]);
            *(GAS u32x4*)(op + 32 * hf + 8 * q) = o; } }
}
struct ConvJob { const float* W; bf16* Wt; const float* kscale; int K, Nsrc, Ndst, mapid; };
DI void conv_job(Frame& F, const ConvJob j, int& base) {
    const int nblk = j.Ndst / 64, nitems = (j.K / 64) * nblk, NGW = F.G * NWAVES, gw = F.bid * NWAVES + F.wave;
    int first = (gw - base % NGW + NGW) % NGW;
    for (int it = first; it < nitems; it += NGW) conv_item(j.W, j.K, j.Nsrc, j.Wt, j.kscale, j.mapid, it, nblk, F.lane);
    base += nitems;
}
DI void p_prologue(Frame& F, const Args& a) {
    unsigned char* ws = F.ws;
    const int gt = F.bid * NTHR + F.tid, NGT = F.G * NTHR;
    { float* prm = (float*)(ws + WS_PRM);
#define CPV(IDX, N, OFF, SRC_L) for (int e = gt; e < (N); e += NGT) prm[(size_t)l * PRM_STRIDE + (OFF) + e] = a.in[IDX][(size_t)(SRC_L) * (N) + e];
      for (int l = 0; l < DEPTH; ++l) {
          CPV(2, 2048, P_N1, l) CPV(33, 2048, P_N2, l) CPV(4, 512, P_GN, l) CPV(5, 4096, P_CW, l) CPV(6, 1024, P_CB, l) CPV(7, 8, P_DTB, l) CPV(8, 8, P_ALOG, l) CPV(9, 8, P_SD, l)
          CPV(10, 512, P_SNW, l) CPV(15, 192, P_QNW, l) CPV(16, 192, P_KNW, l) CPV(17, 1792, P_MU, l) CPV(18, 512, P_W0, l) CPV(20, 512, P_A0, l)
          CPV(23, 512, P_V0, (l > 0 ? l - 1 : 0)) CPV(26, 512, P_KK, l) CPV(27, 512, P_KA, l) CPV(28, 512, P_RK, l) CPV(29, 512, P_LNW, l) CPV(30, 512, P_LNB, l)
      }
#undef CPV
    }
    const int* pos = (const int*)a.in[1];
    for (int e = gt; e < S * 64; e += NGT) { const int t = e >> 6, i = e & 63;
        const float inv = 1.0f / powf(10000.0f, (float)(2 * i) / 128.0f); const float ang = (float)pos[t] * inv;
        double rev = (double)ang * 0.15915494309189535; rev -= rint(rev); const float r = (float)(rev * 6.283185307179586);
        ((float*)(ws + WS_COSR))[e] = __cosf(r); ((float*)(ws + WS_SINR))[e] = __sinf(r); }
    for (int e = gt; e < S * 32; e += NGT) { const int t = e >> 5, i = e & 31;
        const float inv = 1.0f / powf(10000.0f, (float)(2 * i) / 64.0f); const float ang = (float)pos[t] * inv;
        double rev = (double)ang * 0.15915494309189535; rev -= rint(rev); const float r = (float)(rev * 6.283185307179586);
        ((float*)(ws + WS_COSM))[e] = __cosf(r); ((float*)(ws + WS_SINM))[e] = __sinf(r); }
    for (int l = 0; l < DEPTH; ++l) {
        const float* w2 = a.in[19] + (size_t)l * 64 * 512; const float* a2 = a.in[21] + (size_t)l * 64 * 512; const float* g2 = a.in[22] + (size_t)l * 128 * 512;
        const float* v2 = a.in[25] + (size_t)(l > 0 ? l - 1 : 0) * 32 * 512;
        bf16* Lt = (bf16*)(ws + WS_WLORA) + (size_t)l * 2048 * 512;
        for (int w = gt; w < 2048 * 64; w += NGT) { const int kg = w >> 11, n = w & 2047, seg = n >> 9, j = n & 511; float v[8];
#pragma unroll
            for (int i = 0; i < 8; ++i) { const int k = kg * 8 + i; float x = 0.f;
                if (seg == 0) { if (k < 64) x = w2[k * 512 + j]; }
                else if (seg == 1) { if (k >= 128 && k < 192) x = a2[(k - 128) * 512 + j]; }
                else if (seg == 2) { if (k >= 256 && k < 384) x = g2[(k - 256) * 512 + j]; }
                else { if (l > 0 && k >= 384 && k < 416) x = v2[(k - 384) * 512 + j]; }
                v[i] = x; }
            u32x4 o; o.x = pk2(v[0], v[1]); o.y = pk2(v[2], v[3]); o.z = pk2(v[4], v[5]); o.w = pk2(v[6], v[7]);
            *(GAS u32x4*)(Lt + (size_t)n * 512 + kg * 8) = o; }
    }
    int base = 0;
    for (int l = 0; l < DEPTH; ++l) {
        conv_job(F, ConvJob{a.in[3] + (size_t)l * D * NIN, (bf16*)(ws + WS_WIN) + (size_t)l * NINP * D, nullptr, D, NIN, NINP, 1}, base);
        conv_job(F, ConvJob{a.in[34] + (size_t)l * D * 2 * DFF, (bf16*)(ws + WS_WGU) + (size_t)l * 2 * DFF * D, nullptr, D, 2 * DFF, 2 * DFF, 2}, base);
        conv_job(F, ConvJob{a.in[35] + (size_t)l * DFF * D, (bf16*)(ws + WS_WDN) + (size_t)l * D * DFF, nullptr, DFF, D, D, 0}, base);
        conv_job(F, ConvJob{a.in[32] + (size_t)l * D * D, (bf16*)(ws + WS_WOUT) + (size_t)l * D * D, nullptr, D, D, D, 0}, base);
        for (int n = 0; n < 4; ++n)
            conv_job(F, ConvJob{a.in[31] + ((size_t)l * 4 + n) * 512 * D, (bf16*)(ws + WS_WBR) + ((size_t)l * 4 + n) * D * 512, nullptr, 512, D, D, 0}, base);
        conv_job(F, ConvJob{a.in[12] + (size_t)l * 512 * 768, (bf16*)(ws + WS_WQB) + (size_t)l * 1024 * 512, a.in[11] + (size_t)l * 512, 512, 768, 1024, 3}, base);
        conv_job(F, ConvJob{a.in[14] + (size_t)l * 256 * 1024, (bf16*)(ws + WS_WKVB) + (size_t)l * 1024 * 256, a.in[13] + (size_t)l * 256, 256, 1024, 1024, 0}, base);
        if (l > 0) conv_job(F, ConvJob{a.in[24] + (size_t)(l - 1) * 512 * 32, (bf16*)(ws + WS_WV1) + (size_t)l * 256 * 512, nullptr, 512, 32, 256, 4}, base);
    }
}

DI void p_rmsnorm(Frame& F, const float* x, const float* w, bf16* out) {
    const int gw = F.bid * NWAVES + F.wave, NGW = F.G * NWAVES;
    for (int m = gw; m < S; m += NGW) {
        const GAS f32x4* xr = (const GAS f32x4*)(x + (size_t)m * D) + F.lane; f32x4 v[8]; float s = 0.f;
#pragma unroll
        for (int j = 0; j < 8; ++j) { v[j] = xr[64 * j]; s += (v[j].x * v[j].x + v[j].y * v[j].y) + (v[j].z * v[j].z + v[j].w * v[j].w); }
        const float rstd = rsqrtf(wave_sum(s) * (1.f / D) + 1e-6f);
        const GAS f32x4* wr = (const GAS f32x4*)w + F.lane;
        GAS u32x2* o8 = (GAS u32x2*)(out + (size_t)m * D) + F.lane;
#pragma unroll
        for (int j = 0; j < 8; ++j) { const f32x4 ww = wr[64 * j]; u32x2 o; o.x = pk2(v[j].x * rstd * ww.x, v[j].y * rstd * ww.y); o.y = pk2(v[j].z * rstd * ww.z, v[j].w * rstd * ww.w); o8[64 * j] = o; }
    }
}

DI void p_rwkv_prep(Frame& F, int l) {
    unsigned char* ws = F.ws;
    const float* RW = (const float*)(ws + WS_RW); const float* prm = (const float*)(ws + WS_PRM) + (size_t)l * PRM_STRIDE; const float* mu = prm + P_MU; const float* kk_w = prm + P_KK;
    const int gw = F.bid * NWAVES + F.wave, NGW = F.G * NWAVES, lane = F.lane;
    for (int t = gw; t < S; t += NGW) {
        const GAS f32x4* p = (const GAS f32x4*)(RW + (size_t)t * 1792) + lane; const GAS f32x4* pp = (const GAS f32x4*)(RW + (size_t)(t > 0 ? t - 1 : 0) * 1792) + lane;
        const GAS f32x4* m4 = (const GAS f32x4*)mu + lane;
        f32x4 pm[7];
#pragma unroll
        for (int j = 0; j < 7; ++j) { const f32x4 c = p[64 * j]; f32x4 pv = pp[64 * j]; if (t == 0) pv = (f32x4){0.f, 0.f, 0.f, 0.f}; pm[j] = c + (pv - c) * m4[64 * j]; }
        *((GAS f32x4*)((float*)(ws + WS_R32) + (size_t)t * 512) + lane) = pm[0]; *((GAS f32x4*)((float*)(ws + WS_R32) + (size_t)t * 512) + 64 + lane) = pm[1];
#pragma unroll
        for (int j = 0; j < 2; ++j) { const f32x4 k = pm[2 + j]; const f32x4 kw = *((const GAS f32x4*)kk_w + 64 * j + lane); const f32x4 kk = k * kw;
            float ss = (kk.x * kk.x + kk.y * kk.y) + (kk.z * kk.z + kk.w * kk.w);
            ss += __shfl_xor(ss, 1); ss += __shfl_xor(ss, 2); ss += __shfl_xor(ss, 4); ss += __shfl_xor(ss, 8);
            const float inv = 1.0f / fmaxf(sqrtf(ss), 1e-12f);
            *((GAS f32x4*)((float*)(ws + WS_K32) + (size_t)t * 512) + 64 * j + lane) = k;
            *((GAS f32x4*)((float*)(ws + WS_KKN) + (size_t)t * 512) + 64 * j + lane) = kk * inv; }
#pragma unroll
        for (int j = 0; j < 2; ++j) { const f32x4 v = pm[4 + j];
            *((GAS f32x4*)((float*)(ws + WS_VV) + (size_t)t * 512) + 64 * j + lane) = v;
            if (l == 0) *((GAS f32x4*)((float*)(ws + WS_VFIRST) + (size_t)t * 512) + 64 * j + lane) = v;
            u32x2 o; o.x = pk2(v.x, v.y); o.y = pk2(v.z, v.w); *((GAS u32x2*)((bf16*)(ws + WS_VB) + (size_t)t * 512) + 64 * j + lane) = o; }
        { const f32x4 x = pm[6]; f32x4 y; int dst;
            if (lane < 16) { y = (f32x4){tanhf(x.x), tanhf(x.y), tanhf(x.z), tanhf(x.w)}; dst = 4 * lane; }
            else if (lane < 32) { y = x; dst = 128 + 4 * (lane - 16); }
            else { y = (f32x4){sigmoidf_(x.x), sigmoidf_(x.y), sigmoidf_(x.z), sigmoidf_(x.w)}; dst = 256 + 4 * (lane - 32); }
            bf16* ar = (bf16*)(ws + WS_ALORA) + (size_t)t * 512;
            u32x2 o; o.x = pk2(y.x, y.y); o.y = pk2(y.z, y.w); *(GAS u32x2*)(ar + dst) = o;
            const int z = 4 * lane; const int zd = z < 64 ? 64 + z : (z < 128 ? 192 + (z - 64) : 384 + (z - 128));
            *(GAS u32x2*)(ar + zd) = (u32x2){0u, 0u}; }
    }
}

DI void p_mamba_prep(Frame& F, int l) {
    unsigned char* ws = F.ws;
    const bf16* XBC = (const bf16*)(ws + WS_XBC); bf16* XC = (bf16*)(ws + WS_XC);
    const float* prm = (const float*)(ws + WS_PRM) + (size_t)l * PRM_STRIDE; const float* cw = prm + P_CW; const float* cb = prm + P_CB;
    for (int c = F.bid; c < NCH; c += F.G) {
        const int ch = 2 * F.tid; const int t0 = c * 64;
        float w0[4], w1[4];
#pragma unroll
        for (int k = 0; k < 4; ++k) { w0[k] = cw[k * 1024 + ch]; w1[k] = cw[k * 1024 + ch + 1]; }
        const float b0 = cb[ch], b1 = cb[ch + 1];
        float h0[3], h1[3];
#pragma unroll
        for (int k = 0; k < 3; ++k) { const int t = t0 - 3 + k; unsigned u = 0u; if (t >= 0) u = *(const GAS unsigned*)(XBC + (size_t)t * 1024 + ch); h0[k] = bf2f(u & 0xffffu); h1[k] = bf2f(u >> 16); }
#pragma unroll 8
        for (int i = 0; i < 64; ++i) { const int t = t0 + i; const unsigned u = *(const GAS unsigned*)(XBC + (size_t)t * 1024 + ch); const float x0 = bf2f(u & 0xffffu), x1 = bf2f(u >> 16);
            const float y0 = b0 + w0[0] * h0[0] + w0[1] * h0[1] + w0[2] * h0[2] + w0[3] * x0, y1 = b1 + w1[0] * h1[0] + w1[1] * h1[1] + w1[2] * h1[2] + w1[3] * x1;
            h0[0] = h0[1]; h0[1] = h0[2]; h0[2] = x0; h1[0] = h1[1]; h1[1] = h1[2]; h1[2] = x1;
            *(GAS unsigned*)(XC + (size_t)t * 1024 + ch) = pk2(siluf_(y0), siluf_(y1)); }
        if (F.tid < 8) { const int h = F.tid; const float bias = prm[P_DTB + h], av = -__expf(prm[P_ALOG + h]); float cs = 0.f;
            const float* misc = (const float*)(ws + WS_MISC);
            for (int i = 0; i < 64; ++i) { const int t = t0 + i; const float dt = softplusf_(misc[(size_t)t * 256 + h] + bias); cs += dt * av;
                ((float*)(ws + WS_DTS))[(size_t)t * 8 + h] = dt; ((float*)(ws + WS_ACS))[(size_t)t * 8 + h] = cs; } }
    }
}

DI void p_scans(Frame& F) {
    unsigned char* ws = F.ws;
    const int gt = F.bid * NTHR + F.tid, NGT = F.G * NTHR;
    for (int e = gt; e < 131072; e += NGT) {
        if (e < 65536) {
            const int h = e >> 14; const float lg = log1pf(-exp2f(-5.0f - (float)h)); const float dec = __expf(lg * 64.0f);
            float* p = (float*)(ws + WS_RKV) + e; float st = 0.f;
#pragma unroll 8
            for (int c = 0; c < NCH; ++c) { const float v = p[(size_t)c * 65536]; p[(size_t)c * 65536] = st; st = dec * st + v; }
        } else {
            const int e2 = e - 65536, h = e2 >> 13; const float* acs = (const float*)(ws + WS_ACS);
            float* p = (float*)(ws + WS_MST) + e2; float st = 0.f;
#pragma unroll 8
            for (int c = 0; c < NCH; ++c) { const float v = p[(size_t)c * 65536]; const float dec = __expf(acs[(size_t)(c * 64 + 63) * 8 + h]); p[(size_t)c * 65536] = st; st = dec * st + v; }
        }
    }
}

DI void p_rwkv_scan(Frame& F, int nblk) {
    unsigned char* ws = F.ws;
    const int w = F.bid * NWAVES + F.wave; if (F.bid >= nblk) return;
    const int h = w >> 6, i = w & 63, lane = F.lane;
    const float* Ap = (const float*)(ws + WS_KKN) + h * 64 + lane; const float* Wp = (const float*)(ws + WS_DEC) + h * 64 + lane; const float* Bp = (const float*)(ws + WS_BB) + h * 64 + lane;
    const float* Kp = (const float*)(ws + WS_KP) + h * 64 + lane; const float* Rp = (const float*)(ws + WS_R32) + h * 64 + lane; const float* Vp = (const float*)(ws + WS_VV) + h * 64 + i;
    float* Yp = (float*)(ws + WS_Y32) + h * 64 + i;
    float s = 0.f;
    constexpr int U = 8;
    float ca[U], cw[U], cb[U], ck[U], cr[U], cv[U];
#pragma unroll
    for (int u = 0; u < U; ++u) { const size_t o = (size_t)u * 512; ca[u] = Ap[o]; cw[u] = Wp[o]; cb[u] = Bp[o]; ck[u] = Kp[o]; cr[u] = Rp[o]; cv[u] = Vp[o]; }
    for (int t0 = 0; t0 < S; t0 += U) {
        float na[U], nw[U], nb[U], nk[U], nr[U], nv[U];
        const int tn = (t0 + U < S) ? t0 + U : t0;
#pragma unroll
        for (int u = 0; u < U; ++u) { const size_t o = (size_t)(tn + u) * 512; na[u] = Ap[o]; nw[u] = Wp[o]; nb[u] = Bp[o]; nk[u] = Kp[o]; nr[u] = Rp[o]; nv[u] = Vp[o]; }
        float ys[U];
#pragma unroll
        for (int u = 0; u < U; ++u) {
            const float sa = wave_sum_dpp(s * (-ca[u]));
            s = s * cw[u] + sa * cb[u] + cv[u] * ck[u];
            ys[u] = wave_sum_dpp(s * cr[u]);
        }
        if (lane < U) { float y = ys[0];
#pragma unroll
            for (int u = 1; u < U; ++u) y = (lane == u) ? ys[u] : y;
            Yp[(size_t)(t0 + lane) * 512] = y; }
#pragma unroll
        for (int u = 0; u < U; ++u) { ca[u] = na[u]; cw[u] = nw[u]; cb[u] = nb[u]; ck[u] = nk[u]; cr[u] = nr[u]; cv[u] = nv[u]; }
    }
}

DI void p_rwkv_post(Frame& F, int l) {
    unsigned char* ws = F.ws;
    const float* prm = (const float*)(ws + WS_PRM) + (size_t)l * PRM_STRIDE; const float* lnw = prm + P_LNW; const float* lnb = prm + P_LNB; const float* rk = prm + P_RK;
    const int gw = F.bid * NWAVES + F.wave, NGW = F.G * NWAVES, lane = F.lane;
    for (int t = gw; t < S; t += NGW) {
#pragma unroll
        for (int j = 0; j < 2; ++j) {
            const size_t o = (size_t)t * 512 / 4 + 64 * j + lane;
            const f32x4 y = ((const GAS f32x4*)(ws + WS_Y32))[o], r = ((const GAS f32x4*)(ws + WS_R32))[o], k = ((const GAS f32x4*)(ws + WS_KP))[o], v = ((const GAS f32x4*)(ws + WS_VV))[o], g = ((const GAS f32x4*)(ws + WS_G32))[o];
            const f32x4 w4 = ((const GAS f32x4*)lnw)[64 * j + lane], b4 = ((const GAS f32x4*)lnb)[64 * j + lane], rk4 = ((const GAS f32x4*)rk)[64 * j + lane];
            float sm = (y.x + y.y) + (y.z + y.w);
            sm += __shfl_xor(sm, 1); sm += __shfl_xor(sm, 2); sm += __shfl_xor(sm, 4); sm += __shfl_xor(sm, 8);
            const float mean = sm * (1.f / 64.f); const f32x4 d = y - mean;
            float q = (d.x * d.x + d.y * d.y) + (d.z * d.z + d.w * d.w);
            q += __shfl_xor(q, 1); q += __shfl_xor(q, 2); q += __shfl_xor(q, 4); q += __shfl_xor(q, 8);
            const float rstd = rsqrtf(q * (1.f / 64.f) + 64e-5f);
            const f32x4 rkk = r * k * rk4; float bs = (rkk.x + rkk.y) + (rkk.z + rkk.w);
            bs += __shfl_xor(bs, 1); bs += __shfl_xor(bs, 2); bs += __shfl_xor(bs, 4); bs += __shfl_xor(bs, 8);
            const f32x4 o4 = (d * rstd * w4 + b4 + bs * v) * g;
            u32x2 ob; ob.x = pk2(o4.x, o4.y); ob.y = pk2(o4.z, o4.w);
            *((GAS u32x2*)((bf16*)(ws + WS_OB) + (size_t)t * D + 1536) + 64 * j + lane) = ob;
        }
    }
}

namespace pg8 {
DI unsigned char* lw(unsigned char* p) { unsigned long long w = (unsigned long long)p; asm volatile("" : "+s"(w)); return (unsigned char*)w; }
DI void st8bf(bf16* p, const f32x4 a, const f32x4 b) { *(GAS u32x4*)p = pack8(a, b); }
DI void st8f(float* p, const f32x4 a, const f32x4 b) { *(GAS f32x4*)p = a; *((GAS f32x4*)p + 1) = b; }
DI f32x4 map4(const f32x4 v, float (*f)(float)) { return (f32x4){f(v.x), f(v.y), f(v.z), f(v.w)}; }

struct TileDesc { unsigned long long off; int ld, cb, kind, slot; };
constexpr TileDesc mk_tile(int T) {
    return T < 2 ? TileDesc{WS_QR, 512, 0, 0, 0} : T < 4 ? TileDesc{WS_KR, 512, 0, 1, 0}
         : T < 6 ? TileDesc{WS_VR, 512, (T - 4) * 256, 2, 0} : T < 8 ? TileDesc{WS_GR, 512, (T - 6) * 256, 3, 0} : T < 10 ? TileDesc{WS_ZS, 512, (T - 8) * 256, 3, 0}
         : T < 14 ? TileDesc{WS_XBC, 1024, (T - 10) * 256, 2, 0} : T < 16 ? TileDesc{WS_CQ, 512, (T - 14) * 256, 5, (T - 14) * 4} : T == 16 ? TileDesc{WS_CKV, 256, 0, 5, 8}
         : T < 24 ? TileDesc{WS_RW, 1792, (T - 17) * 256, 6, 0} : T < 56 ? TileDesc{WS_GATE, 8192, (T - 24) * 256, 4, 0} : TileDesc{WS_MISC, 256, 0, 6, 0};
}
struct TileTab { TileDesc d[57]; };
constexpr TileTab mk_tiletab() { TileTab t{}; for (int i = 0; i < 57; ++i) t.d[i] = mk_tile(i); return t; }
__constant__ TileTab g_tiletab = mk_tiletab();

struct EpiIn {
    static constexpr bool AFTER_DRAIN = false;
    unsigned char* ws_;
    DI bool operator()(Acc& acc, const Unit& u, int wr, int wc, int fr, int fq) const {
        unsigned char* ws = lw(ws_);
        const int T = u.pn, row0 = u.pm * BM + wr * 64 + fr, c0 = wc * 32 + fq * 8;
        const TileDesc d = g_tiletab.d[T]; const int kind = d.kind;
        if (kind < 2) {
            const int head = 2 * (T & 1) + (c0 >> 6), j0 = c0 & 63; const float sc = kind ? 0.08838834764831845f : 1.0f;
            bf16* dst = (bf16*)(ws + d.off); const float* cs = (const float*)(ws + WS_COSR); const float* sn = (const float*)(ws + WS_SINR);
#pragma unroll
            for (int ai = 0; ai < 2; ++ai)
#pragma unroll
                for (int m = 0; m < 4; ++m) { const int row = row0 + ai * HALF + m * 16;
                    const f32x4 ca = *(const GAS f32x4*)(cs + (size_t)row * 64 + j0), cb = *(const GAS f32x4*)(cs + (size_t)row * 64 + j0 + 4);
                    const f32x4 sa = *(const GAS f32x4*)(sn + (size_t)row * 64 + j0), sb = *(const GAS f32x4*)(sn + (size_t)row * 64 + j0 + 4);
                    const f32x4 x1a = acc[ai][0][m][0], x1b = acc[ai][0][m][1], x2a = acc[ai][1][m][0], x2b = acc[ai][1][m][1];
                    bf16* o = dst + (size_t)row * 512 + head * 128 + j0;
                    st8bf(o, (x1a * ca - x2a * sa) * sc, (x1b * cb - x2b * sb) * sc);
                    st8bf(o + 64, (x2a * ca + x1a * sa) * sc, (x2b * cb + x1b * sb) * sc); }
            return true;
        }
        if (kind == 6) {
            float* dst = (float*)(ws + d.off) + d.cb + c0;
#pragma unroll
            for (int ai = 0; ai < 2; ++ai)
#pragma unroll
                for (int m = 0; m < 4; ++m) { const int row = row0 + ai * HALF + m * 16;
#pragma unroll
                    for (int bj = 0; bj < 2; ++bj) st8f(dst + (size_t)row * d.ld + bj * HALF, acc[ai][bj][m][0], acc[ai][bj][m][1]); }
            return true;
        }
        {
            bf16* dst = (bf16*)(ws + d.off) + d.cb + c0; float* ssq = (float*)(ws + WS_SSQ) + d.slot + wc;
            const float am = (kind == 3 || kind == 4) ? 1.f : 0.f, xm = (kind == 4) ? 0.f : 1.f;
#pragma unroll
            for (int ai = 0; ai < 2; ++ai)
#pragma unroll
                for (int m = 0; m < 4; ++m) { const int row = row0 + ai * HALF + m * 16; float ss = 0.f;
#pragma unroll
                    for (int bj = 0; bj < 2; ++bj) { f32x4 a = acc[ai][bj][m][0], b = acc[ai][bj][m][1];
                        ss += (a.x * a.x + a.y * a.y) + (a.z * a.z + a.w * a.w) + (b.x * b.x + b.y * b.y) + (b.z * b.z + b.w * b.w);
                        if (am != 0.f) {
#pragma unroll
                            for (int i = 0; i < 4; ++i) { const float s0 = sigmoidf_(a[i]), s1 = sigmoidf_(b[i]); a[i] = (xm != 0.f) ? a[i] * s0 : s0; b[i] = (xm != 0.f) ? b[i] * s1 : s1; } }
                        st8bf(dst + (size_t)row * d.ld + bj * HALF, a, b); }
                    if (kind == 5) { ss += __shfl_xor(ss, 16); ss += __shfl_xor(ss, 32); if (fq == 0) ssq[(size_t)row * 16] = ss; } }
        }
        return true;
    }
};

struct EpiQb {
    static constexpr bool AFTER_DRAIN = true;
    unsigned char* ws; const float* qnw;
    DI bool operator()(Acc&, const Unit&, int, int, int, int) const { return true; }
    DI void fused(Acc& acc, const Unit& u, int wr, int wc, int fr, int fq, LAS unsigned char* lds, int wid, int lane, int tid) const {
        const int h = u.pn, row0 = u.pm * BM + wr * 64 + fr, c0 = wc * 32 + fq * 8;
        const float* ssq = (const float*)(ws + WS_SSQ); LAS float* P = (LAS float*)lds;
        const float QS = 0.07216878364870322f * LOG2E;
#pragma unroll
        for (int ai = 0; ai < 2; ++ai)
#pragma unroll
            for (int m = 0; m < 4; ++m) { const int row = row0 + ai * HALF + m * 16, rl = ai * HALF + wr * 64 + m * 16 + fr;
                const f32x4 s0 = *(const GAS f32x4*)(ssq + (size_t)row * 16), s1 = *(const GAS f32x4*)(ssq + (size_t)row * 16 + 4);
                const float rs = rsqrtf(((s0.x + s0.y) + (s0.z + s0.w) + (s1.x + s1.y) + (s1.z + s1.w)) * (1.f / 512.f) + 1e-6f);
                float ss = 0.f;
#pragma unroll
                for (int bj = 0; bj < 2; ++bj)
#pragma unroll
                    for (int n = 0; n < 2; ++n) { f32x4 a = acc[ai][bj][m][n] * rs; acc[ai][bj][m][n] = a; ss += (a.x * a.x + a.y * a.y) + (a.z * a.z + a.w * a.w); }
                ss += __shfl_xor(ss, 16); ss += __shfl_xor(ss, 32);
                if (fq == 0) P[rl * 4 + wc] = ss; }
        __syncthreads();
        bf16* QM = (bf16*)(ws + WS_QM); const float* cs = (const float*)(ws + WS_COSM); const float* sn = (const float*)(ws + WS_SINM);
#pragma unroll
        for (int ai = 0; ai < 2; ++ai)
#pragma unroll
            for (int m = 0; m < 4; ++m) { const int row = row0 + ai * HALF + m * 16, rl = ai * HALF + wr * 64 + m * 16 + fr;
                const f32x4 pp = *(const LAS f32x4*)(P + rl * 4); const float rq = rsqrtf(((pp.x + pp.y) + (pp.z + pp.w)) * (1.f / 192.f) + 1e-6f) * QS;
                bf16* o = QM + (size_t)row * 768 + h * 192;
                if (wc < 3) {
                    const f32x4 wa = *(const GAS f32x4*)(qnw + c0), wb = *(const GAS f32x4*)(qnw + c0 + 4);
                    st8bf(o + c0, acc[ai][0][m][0] * rq * wa, acc[ai][0][m][1] * rq * wb);
                    if (wc == 0) { const f32x4 wc4 = *(const GAS f32x4*)(qnw + 96 + c0), wd = *(const GAS f32x4*)(qnw + 100 + c0);
                        st8bf(o + 96 + c0, acc[ai][1][m][0] * rq * wc4, acc[ai][1][m][1] * rq * wd); }
                } else {
                    const int i0 = 8 * fq;
                    const f32x4 w1a = *(const GAS f32x4*)(qnw + 128 + i0), w1b = *(const GAS f32x4*)(qnw + 132 + i0), w2a = *(const GAS f32x4*)(qnw + 160 + i0), w2b = *(const GAS f32x4*)(qnw + 164 + i0);
                    const f32x4 ca = *(const GAS f32x4*)(cs + (size_t)row * 32 + i0), cb = *(const GAS f32x4*)(cs + (size_t)row * 32 + i0 + 4), sa = *(const GAS f32x4*)(sn + (size_t)row * 32 + i0), sb = *(const GAS f32x4*)(sn + (size_t)row * 32 + i0 + 4);
                    const f32x4 x1a = acc[ai][0][m][0] * rq * w1a, x1b = acc[ai][0][m][1] * rq * w1b, x2a = acc[ai][1][m][0] * rq * w2a, x2b = acc[ai][1][m][1] * rq * w2b;
                    st8bf(o + 128 + i0, x1a * ca - x2a * sa, x1b * cb - x2b * sb);
                    st8bf(o + 160 + i0, x2a * ca + x1a * sa, x2b * cb + x1b * sb);
                } }
        __syncthreads();
    }
};

struct EpiKvb {
    static constexpr bool AFTER_DRAIN = true;
    unsigned char* ws; const float* knw;
    DI bool operator()(Acc&, const Unit&, int, int, int, int) const { return true; }
    DI void fused(Acc& acc, const Unit& u, int wr, int wc, int fr, int fq, LAS unsigned char* lds, int wid, int lane, int tid) const {
        const int h = u.pn, row0 = u.pm * BM + wr * 64 + fr, c0 = wc * 32 + fq * 8;
        const float* ssq = (const float*)(ws + WS_SSQ); const float* misc = (const float*)(ws + WS_MISC);
        LAS float* P = (LAS float*)lds; LAS float* KRS = P + 1024; LAS float* RK = P + 1280;
        if (tid < 256) { const float* kr = misc + (size_t)(u.pm * BM + tid) * 256 + 8; float s = 0.f;
#pragma unroll
            for (int i = 0; i < 16; ++i) { const f32x4 v = *(const GAS f32x4*)(kr + 4 * i); s += (v.x * v.x + v.y * v.y) + (v.z * v.z + v.w * v.w); }
            KRS[tid] = s; }
#pragma unroll
        for (int ai = 0; ai < 2; ++ai)
#pragma unroll
            for (int m = 0; m < 4; ++m) { const int row = row0 + ai * HALF + m * 16, rl = ai * HALF + wr * 64 + m * 16 + fr;
                const f32x4 s0 = *(const GAS f32x4*)(ssq + (size_t)row * 16 + 8);
                const float rs = rsqrtf(((s0.x + s0.y) + (s0.z + s0.w)) * (1.f / 256.f) + 1e-6f);
                float ss = 0.f;
#pragma unroll
                for (int bj = 0; bj < 2; ++bj)
#pragma unroll
                    for (int n = 0; n < 2; ++n) { f32x4 a = acc[ai][bj][m][n] * rs; acc[ai][bj][m][n] = a; if (bj == 0) ss += (a.x * a.x + a.y * a.y) + (a.z * a.z + a.w * a.w); }
                ss += __shfl_xor(ss, 16); ss += __shfl_xor(ss, 32);
                if (fq == 0) P[rl * 4 + wc] = ss; }
        __syncthreads();
        if (tid < 256) { const f32x4 pp = *(const LAS f32x4*)(P + tid * 4); RK[tid] = rsqrtf(((pp.x + pp.y) + (pp.z + pp.w) + KRS[tid]) * (1.f / 192.f) + 1e-6f); }
        __syncthreads();
        bf16* KM = (bf16*)(ws + WS_KM); bf16* VT = (bf16*)(ws + WS_VT);
        const f32x4 wa = *(const GAS f32x4*)(knw + c0), wb = *(const GAS f32x4*)(knw + c0 + 4);
#pragma unroll
        for (int ai = 0; ai < 2; ++ai)
#pragma unroll
            for (int m = 0; m < 4; ++m) { const int row = row0 + ai * HALF + m * 16, rl = ai * HALF + wr * 64 + m * 16 + fr;
                const float rk = RK[rl];
                st8bf(KM + (size_t)row * 768 + h * 192 + c0, acc[ai][0][m][0] * rk * wa, acc[ai][0][m][1] * rk * wb);
#pragma unroll
                for (int n = 0; n < 2; ++n)
#pragma unroll
                    for (int i = 0; i < 4; ++i) VT[(size_t)(h * 128 + c0 + n * 4 + i) * S + row] = (bf16)f2bf(acc[ai][1][m][n][i]); }
        {
            const int rl = tid >> 1, hf = tid & 1, row = u.pm * BM + rl, i0 = 16 * hf; const float rk = RK[rl];
            const float* kr = misc + (size_t)row * 256 + 8; const float* cs = (const float*)(ws + WS_COSM) + (size_t)row * 32; const float* sn = (const float*)(ws + WS_SINM) + (size_t)row * 32;
            bf16* o = KM + (size_t)row * 768 + h * 192 + 128;
#pragma unroll
            for (int q = 0; q < 2; ++q) { f32x4 o1[2], o2[2];
#pragma unroll
                for (int e = 0; e < 2; ++e) { const int i = i0 + 8 * q + 4 * e;
                    const f32x4 x1 = *(const GAS f32x4*)(kr + i) * *(const GAS f32x4*)(knw + 128 + i), x2 = *(const GAS f32x4*)(kr + 32 + i) * *(const GAS f32x4*)(knw + 160 + i);
                    const f32x4 c = *(const GAS f32x4*)(cs + i), s = *(const GAS f32x4*)(sn + i);
                    o1[e] = (x1 * c - x2 * s) * rk; o2[e] = (x2 * c + x1 * s) * rk; }
                st8bf(o + i0 + 8 * q, o1[0], o1[1]); st8bf(o + 32 + i0 + 8 * q, o2[0], o2[1]); }
        }
        __syncthreads();
    }
};

struct EpiV1 {
    static constexpr bool AFTER_DRAIN = false;
    unsigned char* ws_;
    DI bool operator()(Acc& acc, const Unit& u, int wr, int wc, int fr, int fq) const {
        if (wc != 0) return true;
        unsigned char* ws = lw(ws_);
        const int row0 = u.pm * BM + wr * 64 + fr; bf16* dst = (bf16*)(ws + WS_ALORA);
#pragma unroll
        for (int ai = 0; ai < 2; ++ai)
#pragma unroll
            for (int m = 0; m < 4; ++m) { const int row = row0 + ai * HALF + m * 16; st8bf(dst + (size_t)row * 512 + 384 + fq * 8, acc[ai][0][m][0], acc[ai][0][m][1]); }
        return true;
    }
};

struct EpiLora {
    static constexpr bool AFTER_DRAIN = false;
    unsigned char* ws_; const float* w0; const float* a0; const float* v0; const float* ka;
#define LORA_LOOP(BODY) _Pragma("unroll") for (int ai = 0; ai < 2; ++ai) _Pragma("unroll") for (int m = 0; m < 4; ++m) { const size_t ro = (size_t)(row0 + ai * HALF + m * 16) * 512; \
        _Pragma("unroll") for (int bj = 0; bj < 2; ++bj) _Pragma("unroll") for (int n = 0; n < 2; ++n) { const int j = jb + bj * HALF + n * 4; const size_t o = ro + j; const f32x4 x = acc[ai][bj][m][n]; BODY } }
    DI bool operator()(Acc& acc, const Unit& u, int wr, int wc, int fr, int fq) const {
        unsigned char* ws = lw(ws_);
        const int seg = u.pn >> 1, row0 = u.pm * BM + wr * 64 + fr, jb = (u.pn & 1) * 256 + wc * 32 + fq * 8;
        if (seg == 0) { float* dec = (float*)(ws + WS_DEC);
            LORA_LOOP({ const f32x4 b = *(const GAS f32x4*)(w0 + j); f32x4 r;
                _Pragma("unroll") for (int i = 0; i < 4; ++i) { const float wv = -softplusf_(-(b[i] + x[i])) - 0.5f; r[i] = -__expf(wv); }
                *(GAS f32x4*)(dec + o) = r; })
        } else if (seg == 1) { const float* k32 = (const float*)(ws + WS_K32); const float* kkn_ = (const float*)(ws + WS_KKN); float* kp_ = (float*)(ws + WS_KP); float* bb_ = (float*)(ws + WS_BB);
            LORA_LOOP({ const f32x4 b = *(const GAS f32x4*)(a0 + j); const f32x4 kav = *(const GAS f32x4*)(ka + j);
                const f32x4 k = *(const GAS f32x4*)(k32 + o); const f32x4 kkn = *(const GAS f32x4*)(kkn_ + o); f32x4 kp; f32x4 bb;
                _Pragma("unroll") for (int i = 0; i < 4; ++i) { const float av = sigmoidf_(b[i] + x[i]); kp[i] = k[i] * (1.0f + (av - 1.0f) * kav[i]); bb[i] = kkn[i] * av; }
                *(GAS f32x4*)(kp_ + o) = kp; *(GAS f32x4*)(bb_ + o) = bb; })
        } else if (seg == 2) { float* g32 = (float*)(ws + WS_G32);
            LORA_LOOP({ *(GAS f32x4*)(g32 + o) = x; })
        } else { float* vv = (float*)(ws + WS_VV); const float* vf_ = (const float*)(ws + WS_VFIRST);
            LORA_LOOP({ const f32x4 b = *(const GAS f32x4*)(v0 + j); const f32x4 v = *(const GAS f32x4*)(vv + o); const f32x4 vf = *(const GAS f32x4*)(vf_ + o); f32x4 r;
                _Pragma("unroll") for (int i = 0; i < 4; ++i) r[i] = v[i] + (vf[i] - v[i]) * sigmoidf_(b[i] + x[i]);
                *(GAS f32x4*)(vv + o) = r; })
        }
        return true;
    }
#undef LORA_LOOP
};

struct EpiBranch {
    static constexpr bool AFTER_DRAIN = false;
    unsigned char* ws_;
    DI bool operator()(Acc& acc, const Unit& u, int wr, int wc, int fr, int fq) const {
        unsigned char* ws = lw(ws_);
        const int nb = u.sub, row0 = u.pm * BM + wr * 64 + fr, cb = u.pn * BM + wc * 32 + fq * 8;
        const bf16* G = (const bf16*)(ws + WS_GATE); bf16* M = (bf16*)(ws + WS_MERGED);
#pragma unroll
        for (int ai = 0; ai < 2; ++ai)
#pragma unroll
            for (int m = 0; m < 4; ++m) { const int row = row0 + ai * HALF + m * 16;
#pragma unroll
                for (int bj = 0; bj < 2; ++bj) { const int col = cb + bj * HALF;
                    float g[8]; unpack8(*(const GAS u32x4*)(G + (size_t)row * 8192 + nb * D + col), g);
                    if (nb < 3) { float gn[8]; unpack8(*(const GAS u32x4*)(G + (size_t)row * 8192 + (nb + 1) * D + col), gn);
#pragma unroll
                        for (int i = 0; i < 8; ++i) g[i] = fmaxf(g[i], 1e-30f) * __builtin_amdgcn_rcpf(fmaxf(gn[i], 1e-30f)); }
                    else {
#pragma unroll
                        for (int i = 0; i < 8; ++i) g[i] = fmaxf(g[i], 1e-30f); }
                    f32x4 a = acc[ai][bj][m][0], b = acc[ai][bj][m][1];
                    a = a * (f32x4){g[0], g[1], g[2], g[3]}; b = b * (f32x4){g[4], g[5], g[6], g[7]};
                    if (nb < 3) { acc[ai][bj][m][0] = a; acc[ai][bj][m][1] = b; } else st8bf(M + (size_t)row * D + col, a, b); } }
        return nb == 3;
    }
};

struct EpiRes {
    static constexpr bool AFTER_DRAIN = false;
    const float* xin; float* out;
    DI bool operator()(Acc& acc, const Unit& u, int wr, int wc, int fr, int fq) const {
        const int row0 = u.pm * BM + wr * 64 + fr, cb = u.pn * BM + wc * 32 + fq * 8;
#pragma unroll
        for (int ai = 0; ai < 2; ++ai)
#pragma unroll
            for (int m = 0; m < 4; ++m) { const int row = row0 + ai * HALF + m * 16;
#pragma unroll
                for (int bj = 0; bj < 2; ++bj) { const size_t o = (size_t)row * D + cb + bj * HALF;
                    const f32x4 xa = *(const GAS f32x4*)(xin + o), xb = *(const GAS f32x4*)(xin + o + 4);
                    st8f(out + o, xa + acc[ai][bj][m][0], xb + acc[ai][bj][m][1]); } }
        return true;
    }
};

struct EpiGu {
    static constexpr bool AFTER_DRAIN = false;
    unsigned char* ws_;
    DI bool operator()(Acc& acc, const Unit& u, int wr, int wc, int fr, int fq) const {
        unsigned char* ws = lw(ws_);
        const int row0 = u.pm * BM + wr * 64 + fr, cb = u.pn * 128 + wc * 32 + fq * 8; bf16* A = (bf16*)(ws + WS_ACT);
#pragma unroll
        for (int ai = 0; ai < 2; ++ai)
#pragma unroll
            for (int m = 0; m < 4; ++m) { const int row = row0 + ai * HALF + m * 16;
                st8bf(A + (size_t)row * DFF + cb, map4(acc[ai][0][m][0], siluf_) * acc[ai][1][m][0], map4(acc[ai][0][m][1], siluf_) * acc[ai][1][m][1]); }
        return true;
    }
};
}

DI bf16x8 ldfrag(const LAS bf16* M, int ld, int r0, int k0, int lane) { return *(const LAS bf16x8*)(M + (r0 + (lane & 15)) * ld + k0 + 8 * (lane >> 4)); }
#define MFMA16(a, b, c) __builtin_amdgcn_mfma_f32_16x16x32_bf16((a), (b), (c), 0, 0, 0)
DI void stage_nat(LAS bf16* dst, int lp, const bf16* src, size_t gp, int rows, int cols8, int tid) {
    for (int p = tid; p < rows * cols8; p += NTHR) { const int r = p / cols8, c = p - r * cols8; *(LAS u32x4*)(dst + r * lp + c * 8) = *(const GAS u32x4*)(src + (size_t)r * gp + c * 8); }
}
DI void stage_tr(LAS bf16* dst, int lp, const bf16* src, size_t gp, int rows, int cols8, int tid) {
    for (int p = tid; p < rows * cols8; p += NTHR) { const int r = p / cols8, c = p - r * cols8; const u32x4 w = *(const GAS u32x4*)(src + (size_t)r * gp + c * 8);
        LAS bf16* d = dst + (c * 8) * lp + r;
        d[0] = (bf16)(w.x & 0xffffu); d[lp] = (bf16)(w.x >> 16); d[2 * lp] = (bf16)(w.y & 0xffffu); d[3 * lp] = (bf16)(w.y >> 16);
        d[4 * lp] = (bf16)(w.z & 0xffffu); d[5 * lp] = (bf16)(w.z >> 16); d[6 * lp] = (bf16)(w.w & 0xffffu); d[7 * lp] = (bf16)(w.w >> 16); }
}
DI float ret_loggamma(int h) { return log1pf(-exp2f(-5.0f - (float)h)); }

DI void u_ret_kv(Frame& F, int c, int h) {
    unsigned char* ws = F.ws; const int tid = F.tid, lane = F.lane, w = F.wave;
    LAS bf16* Kt = (LAS bf16*)F.lds; LAS bf16* Vt = Kt + 128 * 72;
    const bf16* KR = (const bf16*)(ws + WS_KR) + (size_t)(c * 64) * 512 + h * 128; const bf16* VR = (const bf16*)(ws + WS_VR) + (size_t)(c * 64) * 512 + h * 128;
    const float lg = ret_loggamma(h);
    for (int p = tid; p < 1024; p += NTHR) { const int m = p >> 4, d0 = (p & 15) * 8; float k[8]; unpack8(*(const GAS u32x4*)(KR + (size_t)m * 512 + d0), k); const float sc = __expf(lg * (float)(63 - m));
        LAS bf16* d = Kt + d0 * 72 + m;
#pragma unroll
        for (int i = 0; i < 8; ++i) d[i * 72] = (bf16)f2bf(k[i] * sc); }
    stage_tr(Vt, 72, VR, 512, 64, 16, tid);
    __syncthreads();
    f32x4 acc[8];
#pragma unroll
    for (int bn = 0; bn < 8; ++bn) acc[bn] = (f32x4){0.f, 0.f, 0.f, 0.f};
#pragma unroll
    for (int ks = 0; ks < 2; ++ks) { const bf16x8 a = ldfrag(Kt, 72, 16 * w, 32 * ks, lane);
#pragma unroll
        for (int bn = 0; bn < 8; ++bn) acc[bn] = MFMA16(a, ldfrag(Vt, 72, 16 * bn, 32 * ks, lane), acc[bn]); }
    float* out = (float*)(ws + WS_RKV) + ((size_t)(c * 4 + h) * 128) * 128;
#pragma unroll
    for (int bn = 0; bn < 8; ++bn)
#pragma unroll
        for (int r = 0; r < 4; ++r) out[(size_t)(16 * w + 4 * (lane >> 4) + r) * 128 + 16 * bn + (lane & 15)] = acc[bn][r];
    __syncthreads();
}

DI void u_ret_out(Frame& F, int l_, int c, int h) {
    unsigned char* ws = F.ws; const int tid = F.tid, lane = F.lane, w = F.wave;
    LAS bf16* Qs = (LAS bf16*)F.lds; LAS bf16* Ks = Qs + 64 * 136; LAS bf16* Vt = Ks + 64 * 136; LAS bf16* St = Vt + 128 * 72; LAS bf16* Ps = St + 128 * 136; LAS float* Os = (LAS float*)(Ps + 64 * 72);
    const size_t rowb = (size_t)(c * 64) * 512 + h * 128;
    stage_nat(Qs, 136, (const bf16*)(ws + WS_QR) + rowb, 512, 64, 16, tid);
    stage_nat(Ks, 136, (const bf16*)(ws + WS_KR) + rowb, 512, 64, 16, tid);
    stage_tr(Vt, 72, (const bf16*)(ws + WS_VR) + rowb, 512, 64, 16, tid);
    { const float* sp = (const float*)(ws + WS_RKV) + ((size_t)(c * 4 + h) * 128) * 128;
      for (int p = tid; p < 4096; p += NTHR) { const int d = p >> 5, e0 = (p & 31) * 4; const f32x4 v = *(const GAS f32x4*)(sp + (size_t)d * 128 + e0);
          LAS bf16* q = St + e0 * 136 + d; q[0] = (bf16)f2bf(v.x); q[136] = (bf16)f2bf(v.y); q[272] = (bf16)f2bf(v.z); q[408] = (bf16)f2bf(v.w); } }
    __syncthreads();
    const float lg = ret_loggamma(h); const int g4 = lane >> 4, lc = lane & 15;
    {
        const int bm = w >> 1;
#pragma unroll
        for (int q = 0; q < 2; ++q) { const int bn = (w & 1) * 2 + q; f32x4 acc = (f32x4){0.f, 0.f, 0.f, 0.f};
#pragma unroll
            for (int ks = 0; ks < 4; ++ks) acc = MFMA16(ldfrag(Qs, 136, 16 * bm, 32 * ks, lane), ldfrag(Ks, 136, 16 * bn, 32 * ks, lane), acc);
#pragma unroll
            for (int r = 0; r < 4; ++r) { const int l = 16 * bm + 4 * g4 + r, m = 16 * bn + lc; const int dd = l > m ? l - m : m - l; Ps[l * 72 + m] = (bf16)f2bf(acc[r] * __expf(lg * (float)dd)); } }
    }
    __syncthreads();
    {
        const int bm = w >> 1;
#pragma unroll
        for (int q = 0; q < 4; ++q) { const int bn = (w & 1) * 4 + q; f32x4 a1 = (f32x4){0.f, 0.f, 0.f, 0.f}, a2 = (f32x4){0.f, 0.f, 0.f, 0.f};
#pragma unroll
            for (int ks = 0; ks < 2; ++ks) a1 = MFMA16(ldfrag(Ps, 72, 16 * bm, 32 * ks, lane), ldfrag(Vt, 72, 16 * bn, 32 * ks, lane), a1);
#pragma unroll
            for (int ks = 0; ks < 4; ++ks) a2 = MFMA16(ldfrag(Qs, 136, 16 * bm, 32 * ks, lane), ldfrag(St, 136, 16 * bn, 32 * ks, lane), a2);
#pragma unroll
            for (int r = 0; r < 4; ++r) { const int l = 16 * bm + 4 * g4 + r; Os[l * 132 + 16 * bn + lc] = a1[r] + __expf(lg * (float)(l + 1)) * a2[r]; } }
    }
    __syncthreads();
    { const float* gw = (const float*)(ws + WS_PRM) + (size_t)l_ * PRM_STRIDE + P_GN + h * 128; const bf16* GR = (const bf16*)(ws + WS_GR); bf16* OB = (bf16*)(ws + WS_OB);
#pragma unroll
      for (int rr = 0; rr < 8; ++rr) { const int l = 8 * w + rr; const float x0 = Os[l * 132 + lane], x1 = Os[l * 132 + 64 + lane];
          const float mean = wave_sum(x0 + x1) * (1.f / 128.f); const float d0 = x0 - mean, d1 = x1 - mean; const float rstd = rsqrtf(wave_sum(d0 * d0 + d1 * d1) * (1.f / 128.f) + 1e-5f);
          const size_t row = (size_t)(c * 64 + l);
          const float g0 = bf2f(GR[row * 512 + h * 128 + lane]), g1 = bf2f(GR[row * 512 + h * 128 + 64 + lane]);
          OB[row * D + h * 128 + lane] = (bf16)f2bf(d0 * rstd * gw[lane] * g0); OB[row * D + h * 128 + 64 + lane] = (bf16)f2bf(d1 * rstd * gw[64 + lane] * g1); } }
    __syncthreads();
}

DI void u_mamba_st(Frame& F, int c, int g) {
    unsigned char* ws = F.ws; const int tid = F.tid, lane = F.lane, w = F.wave;
    LAS bf16* Xt = (LAS bf16*)F.lds; LAS bf16* Bt = Xt + 256 * 72;
    const bf16* XC = (const bf16*)(ws + WS_XC) + (size_t)(c * 64) * 1024; const float* dts = (const float*)(ws + WS_DTS) + (size_t)(c * 64) * 8; const float* acs = (const float*)(ws + WS_ACS) + (size_t)(c * 64) * 8;
    for (int p = tid; p < 2048; p += NTHR) { const int l = p >> 5, c0 = (p & 31) * 8, h = g * 4 + (c0 >> 6); float x[8]; unpack8(*(const GAS u32x4*)(XC + (size_t)l * 1024 + g * 256 + c0), x);
        const float sc = dts[l * 8 + h] * __expf(acs[63 * 8 + h] - acs[l * 8 + h]); LAS bf16* d = Xt + c0 * 72 + l;
#pragma unroll
        for (int i = 0; i < 8; ++i) d[i * 72] = (bf16)f2bf(x[i] * sc); }
    stage_tr(Bt, 72, XC + 512 + g * 128, 1024, 64, 16, tid);
    __syncthreads();
    f32x4 acc[2][8];
#pragma unroll
    for (int i = 0; i < 2; ++i)
#pragma unroll
        for (int bn = 0; bn < 8; ++bn) acc[i][bn] = (f32x4){0.f, 0.f, 0.f, 0.f};
#pragma unroll
    for (int ks = 0; ks < 2; ++ks) { const bf16x8 a0 = ldfrag(Xt, 72, 32 * w, 32 * ks, lane), a1 = ldfrag(Xt, 72, 32 * w + 16, 32 * ks, lane);
#pragma unroll
        for (int bn = 0; bn < 8; ++bn) { const bf16x8 b = ldfrag(Bt, 72, 16 * bn, 32 * ks, lane); acc[0][bn] = MFMA16(a0, b, acc[0][bn]); acc[1][bn] = MFMA16(a1, b, acc[1][bn]); } }
    float* out = (float*)(ws + WS_MST) + ((size_t)(c * 8 + g * 4) * 64) * 128;
#pragma unroll
    for (int i = 0; i < 2; ++i)
#pragma unroll
        for (int bn = 0; bn < 8; ++bn)
#pragma unroll
            for (int r = 0; r < 4; ++r) out[(size_t)(32 * w + 16 * i + 4 * (lane >> 4) + r) * 128 + 16 * bn + (lane & 15)] = acc[i][bn][r];
    __syncthreads();
}

struct MambaLds { LAS bf16* Cs; LAS bf16* Bs; LAS float* CB; LAS bf16* Ph; LAS bf16* Xt; LAS bf16* Sh; LAS float* AC; LAS float* DT; LAS float* SSQ; };
DI void mamba_head(Frame& F, const MambaLds& L, const bf16* XC, const float* sp, int g, int hh, float dsk, const bf16* const (&zrow)[4], f32x4 (&y)[2]) {
    const int tid = F.tid, lane = F.lane, w = F.wave, g4 = lane >> 4, lc = lane & 15, bm = w >> 1;
    __syncthreads();
    { const int l = tid >> 3, m0 = (tid & 7) * 8; const float al = L.AC[l * 4 + hh]; float pv[8];
#pragma unroll
      for (int i = 0; i < 8; ++i) { const int m = m0 + i; pv[i] = (m <= l) ? L.CB[l * 68 + m] * __expf(al - L.AC[m * 4 + hh]) * L.DT[m * 4 + hh] : 0.f; }
      u32x4 o; o.x = pk2(pv[0], pv[1]); o.y = pk2(pv[2], pv[3]); o.z = pk2(pv[4], pv[5]); o.w = pk2(pv[6], pv[7]); *(LAS u32x4*)(L.Ph + l * 72 + m0) = o; }
    stage_tr(L.Xt, 72, XC + g * 256 + hh * 64, 1024, 64, 8, tid);
    for (int p = tid; p < 1024; p += NTHR) { const int pr = p >> 4, n0 = (p & 15) * 8; const f32x4 v0 = *(const GAS f32x4*)(sp + (size_t)pr * 128 + n0), v1 = *(const GAS f32x4*)(sp + (size_t)pr * 128 + n0 + 4);
        *(LAS u32x4*)(L.Sh + pr * 136 + n0) = pack8(v0, v1); }
    __syncthreads();
#pragma unroll
    for (int q = 0; q < 2; ++q) { const int bn = (w & 1) * 2 + q; f32x4 yd = (f32x4){0.f, 0.f, 0.f, 0.f}, yo = (f32x4){0.f, 0.f, 0.f, 0.f};
#pragma unroll
        for (int ks = 0; ks < 2; ++ks) yd = MFMA16(ldfrag(L.Ph, 72, 16 * bm, 32 * ks, lane), ldfrag(L.Xt, 72, 16 * bn, 32 * ks, lane), yd);
#pragma unroll
        for (int ks = 0; ks < 4; ++ks) yo = MFMA16(ldfrag(L.Cs, 136, 16 * bm, 32 * ks, lane), ldfrag(L.Sh, 136, 16 * bn, 32 * ks, lane), yo);
#pragma unroll
        for (int r = 0; r < 4; ++r) { const int l = 16 * bm + 4 * g4 + r, p = 16 * bn + lc; const float x = bf2f(L.Xt[p * 72 + l]);
            const float z = bf2f(zrow[r][hh * 64 + q * 16]);
            y[q][r] = (yd[r] + __expf(L.AC[l * 4 + hh]) * yo[r] + x * dsk) * z; } }
}
DI void u_mamba_out(Frame& F, int l_, int c, int g) {
    unsigned char* ws = F.ws; const int tid = F.tid, lane = F.lane, w = F.wave, g4 = lane >> 4, lc = lane & 15;
    MambaLds L; L.Cs = (LAS bf16*)F.lds; L.Bs = L.Cs + 64 * 136; L.CB = (LAS float*)(L.Bs + 64 * 136); L.Ph = (LAS bf16*)(L.CB + 64 * 68); L.Xt = L.Ph + 64 * 72; L.Sh = L.Xt + 64 * 72;
    L.AC = (LAS float*)(L.Sh + 64 * 136); L.DT = L.AC + 256; L.SSQ = L.DT + 256;
    const bf16* XC = (const bf16*)(ws + WS_XC) + (size_t)(c * 64) * 1024;
    stage_nat(L.Cs, 136, XC + 768 + g * 128, 1024, 64, 16, tid);
    stage_nat(L.Bs, 136, XC + 512 + g * 128, 1024, 64, 16, tid);
    if (tid < 256) { const int l = tid >> 2, hh = tid & 3; L.AC[tid] = ((const float*)(ws + WS_ACS))[(size_t)(c * 64 + l) * 8 + g * 4 + hh]; L.DT[tid] = ((const float*)(ws + WS_DTS))[(size_t)(c * 64 + l) * 8 + g * 4 + hh]; }
    __syncthreads();
    const int bm = w >> 1;
#pragma unroll
    for (int q = 0; q < 2; ++q) { const int bn = (w & 1) * 2 + q; f32x4 acc = (f32x4){0.f, 0.f, 0.f, 0.f};
#pragma unroll
        for (int ks = 0; ks < 4; ++ks) acc = MFMA16(ldfrag(L.Cs, 136, 16 * bm, 32 * ks, lane), ldfrag(L.Bs, 136, 16 * bn, 32 * ks, lane), acc);
#pragma unroll
        for (int r = 0; r < 4; ++r) L.CB[(16 * bm + 4 * g4 + r) * 68 + 16 * bn + lc] = acc[r]; }
    const int pcol = 16 * ((w & 1) * 2) + lc;
    const bf16* zrow[4]; bf16* orow[4];
#pragma unroll
    for (int r = 0; r < 4; ++r) { const size_t row = (size_t)(c * 64 + 16 * bm + 4 * g4 + r); zrow[r] = (const bf16*)(ws + WS_ZS) + row * 512 + g * 256 + pcol; orow[r] = (bf16*)(ws + WS_OB) + row * D + 512 + g * 256 + pcol; }
    const float* mst = (const float*)(ws + WS_MST) + ((size_t)(c * 8 + g * 4) * 64) * 128; const float* prm = (const float*)(ws + WS_PRM) + (size_t)l_ * PRM_STRIDE; const float* dskp = prm + P_SD + g * 4;
    float ss[4] = {0.f, 0.f, 0.f, 0.f};
#pragma unroll 1
    for (int hh = 0; hh < 4; ++hh) { f32x4 y[2]; mamba_head(F, L, XC, mst + (size_t)hh * 64 * 128, g, hh, dskp[hh], zrow, y);
#pragma unroll
        for (int r = 0; r < 4; ++r) ss[r] += y[0][r] * y[0][r] + y[1][r] * y[1][r]; }
#pragma unroll
    for (int r = 0; r < 4; ++r) { float t = ss[r]; t += __shfl_xor(t, 1); t += __shfl_xor(t, 2); t += __shfl_xor(t, 4); t += __shfl_xor(t, 8);
        if (lc == 0) L.SSQ[(16 * bm + 4 * g4 + r) * 2 + (w & 1)] = t; }
    __syncthreads();
    float rstd[4];
#pragma unroll
    for (int r = 0; r < 4; ++r) { const int l = 16 * bm + 4 * g4 + r; rstd[r] = rsqrtf((L.SSQ[l * 2] + L.SSQ[l * 2 + 1]) * (1.f / 256.f) + 1e-6f); }
    const float* nw = prm + P_SNW + g * 256 + pcol;
#pragma unroll 1
    for (int hh = 0; hh < 4; ++hh) { f32x4 y[2]; mamba_head(F, L, XC, mst + (size_t)hh * 64 * 128, g, hh, dskp[hh], zrow, y);
#pragma unroll
        for (int q = 0; q < 2; ++q)
#pragma unroll
            for (int r = 0; r < 4; ++r) orow[r][hh * 64 + q * 16] = (bf16)f2bf(y[q][r] * rstd[r] * nw[hh * 64 + q * 16]); }
    __syncthreads();
}

DI void u_attn(Frame& F, int c, int h) {
    unsigned char* ws = F.ws; const int tid = F.tid, lane = F.lane, w = F.wave, g4 = lane >> 4, lc = lane & 15, qh = w >> 2, kq = w & 3;
    LAS bf16* Ks = (LAS bf16*)F.lds; LAS bf16* Vs = Ks + 128 * 200;
    const bf16* QM = (const bf16*)(ws + WS_QM); const bf16* KM = (const bf16*)(ws + WS_KM) + h * 192; const bf16* VT = (const bf16*)(ws + WS_VT) + (size_t)(h * 128) * S;
    bf16x8 qf[2][6];
#pragma unroll
    for (int qb = 0; qb < 2; ++qb)
#pragma unroll
        for (int ks = 0; ks < 6; ++ks) qf[qb][ks] = *(const GAS bf16x8*)(QM + (size_t)(c * 64 + qh * 32 + qb * 16 + lc) * 768 + h * 192 + ks * 32 + g4 * 8);
    f32x4 o[8][2]; float mrun[2], lrun[2];
#pragma unroll
    for (int db = 0; db < 8; ++db)
#pragma unroll
        for (int qb = 0; qb < 2; ++qb) o[db][qb] = (f32x4){0.f, 0.f, 0.f, 0.f};
    mrun[0] = mrun[1] = -1e30f; lrun[0] = lrun[1] = 0.f;
    const int nkeys = 64 * (c + 1), ntile = (c + 2) >> 1;
    for (int t = 0; t < ntile; ++t) {
        const int key0 = t * 128;
        __syncthreads();
        for (int p = tid; p < 128 * 24; p += NTHR) { const int r = p / 24, cc = p - r * 24; *(LAS u32x4*)(Ks + r * 200 + cc * 8) = *(const GAS u32x4*)(KM + (size_t)(key0 + r) * 768 + cc * 8); }
        for (int p = tid; p < 128 * 16; p += NTHR) { const int r = p >> 4, cc = p & 15; *(LAS u32x4*)(Vs + r * 136 + cc * 8) = *(const GAS u32x4*)(VT + (size_t)r * S + key0 + cc * 8); }
        __syncthreads();
        if (key0 + kq * 32 < nkeys) {
            f32x4 s[2][2];
#pragma unroll
            for (int kb = 0; kb < 2; ++kb)
#pragma unroll
                for (int qb = 0; qb < 2; ++qb) s[kb][qb] = (f32x4){0.f, 0.f, 0.f, 0.f};
#pragma unroll
            for (int ks = 0; ks < 6; ++ks)
#pragma unroll
                for (int kb = 0; kb < 2; ++kb) { const bf16x8 kf = ldfrag(Ks, 200, kq * 32 + kb * 16, ks * 32, lane);
#pragma unroll
                    for (int qb = 0; qb < 2; ++qb) s[kb][qb] = MFMA16(kf, qf[qb][ks], s[kb][qb]); }
            bf16x8 pf[2];
#pragma unroll
            for (int qb = 0; qb < 2; ++qb) {
                float mx = fmaxf(fmaxf(fmaxf(s[0][qb][0], s[0][qb][1]), fmaxf(s[0][qb][2], s[0][qb][3])), fmaxf(fmaxf(s[1][qb][0], s[1][qb][1]), fmaxf(s[1][qb][2], s[1][qb][3])));
                mx = fmaxf(mx, __shfl_xor(mx, 16)); mx = fmaxf(mx, __shfl_xor(mx, 32));
                const float mn = fmaxf(mrun[qb], mx), alpha = exp2f(mrun[qb] - mn); mrun[qb] = mn;
                float p[8]; float ps = 0.f;
#pragma unroll
                for (int kb = 0; kb < 2; ++kb)
#pragma unroll
                    for (int r = 0; r < 4; ++r) { p[kb * 4 + r] = exp2f(s[kb][qb][r] - mn); ps += p[kb * 4 + r]; }
                ps += __shfl_xor(ps, 16); ps += __shfl_xor(ps, 32);
                lrun[qb] = lrun[qb] * alpha + ps;
#pragma unroll
                for (int db = 0; db < 8; ++db) o[db][qb] = o[db][qb] * alpha;
                u32x4 pw; pw.x = pk2(p[0], p[1]); pw.y = pk2(p[2], p[3]); pw.z = pk2(p[4], p[5]); pw.w = pk2(p[6], p[7]); pf[qb] = __builtin_bit_cast(bf16x8, pw);
            }
#pragma unroll
            for (int db = 0; db < 8; ++db) {
                const LAS bf16* vp = Vs + (db * 16 + lc) * 136 + kq * 32 + 4 * g4;
                const u32x2 v0 = *(const LAS u32x2*)vp, v1 = *(const LAS u32x2*)(vp + 16);
                const u32x4 vw = (u32x4){v0.x, v0.y, v1.x, v1.y}; const bf16x8 vf = __builtin_bit_cast(bf16x8, vw);
#pragma unroll
                for (int qb = 0; qb < 2; ++qb) o[db][qb] = MFMA16(vf, pf[qb], o[db][qb]);
            }
        }
    }
    __syncthreads();
    LAS float* OW = (LAS float*)F.lds; LAS float* ML = OW + 8 * 128 * 33;
#pragma unroll
    for (int db = 0; db < 8; ++db)
#pragma unroll
        for (int qb = 0; qb < 2; ++qb)
#pragma unroll
            for (int r = 0; r < 4; ++r) OW[(w * 128 + db * 16 + 4 * g4 + r) * 33 + qb * 16 + lc] = o[db][qb][r];
    if (g4 == 0) {
#pragma unroll
        for (int qb = 0; qb < 2; ++qb) { ML[(w * 32 + qb * 16 + lc) * 2] = mrun[qb]; ML[(w * 32 + qb * 16 + lc) * 2 + 1] = lrun[qb]; } }
    __syncthreads();
    { const int q = tid >> 3, dv0 = (tid & 7) * 16, qhh = q >> 5, ql = q & 31; float mw[4], lw[4]; float mstar = -1e30f;
#pragma unroll
      for (int k = 0; k < 4; ++k) { mw[k] = ML[((qhh * 4 + k) * 32 + ql) * 2]; lw[k] = ML[((qhh * 4 + k) * 32 + ql) * 2 + 1]; mstar = fmaxf(mstar, mw[k]); }
      float lt = 0.f, sc[4];
#pragma unroll
      for (int k = 0; k < 4; ++k) { sc[k] = exp2f(mw[k] - mstar); lt += lw[k] * sc[k]; }
      const float inv = 1.0f / lt; float ov[16];
#pragma unroll
      for (int i = 0; i < 16; ++i) { float v = 0.f;
#pragma unroll
          for (int k = 0; k < 4; ++k) v += OW[((qhh * 4 + k) * 128 + dv0 + i) * 33 + ql] * sc[k];
          ov[i] = v * inv; }
      bf16* ob = (bf16*)(ws + WS_OB) + (size_t)(c * 64 + q) * D + 1024 + h * 128 + dv0;
      u32x4 o0, o1; o0.x = pk2(ov[0], ov[1]); o0.y = pk2(ov[2], ov[3]); o0.z = pk2(ov[4], ov[5]); o0.w = pk2(ov[6], ov[7]); o1.x = pk2(ov[8], ov[9]); o1.y = pk2(ov[10], ov[11]); o1.z = pk2(ov[12], ov[13]); o1.w = pk2(ov[14], ov[15]);
      *(GAS u32x4*)ob = o0; *(GAS u32x4*)(ob + 8) = o1; }
    __syncthreads();
}

DI void u_rwkv_r1(Frame& F, int c, int h) {
    unsigned char* ws = F.ws; const int tid = F.tid, lane = F.lane, w = F.wave, g4 = lane >> 4, lc = lane & 15;
    LAS float* CUM = (LAS float*)F.lds;
    LAS float* PT = CUM + 64 * 68;
    LAS bf16* AT = (LAS bf16*)(PT + 64); LAS bf16* BH = AT + 4608; LAS bf16* KH = BH + 4608; LAS bf16* RT = KH + 4608;
    LAS bf16* AJ = RT + 4608; LAS bf16* BJ = AJ + 4608; LAS bf16* KJ = BJ + 4608; LAS bf16* VJ = KJ + 4608;
    LAS bf16* MAK = VJ + 4608; LAS bf16* MRBT = MAK + 4608; LAS bf16* MRKT = MRBT + 4608; LAS float* WF = (LAS float*)(MRKT + 4608);
    LAS bf16* WT = AT; LAS bf16* G1 = BH; LAS bf16* G2 = KH; LAS bf16* CST = MAK;
    const size_t gb = (size_t)(c * 64) * 512 + h * 64; const int unit = c * 8 + h;
    const int t = tid >> 3, j0 = (tid & 7) * 8;
    const size_t go = gb + (size_t)t * 512 + j0;
    float lw[8];
    { const f32x4 x0 = *(const GAS f32x4*)((const float*)(ws + WS_DEC) + go), x1 = *(const GAS f32x4*)((const float*)(ws + WS_DEC) + go + 4);
#pragma unroll
      for (int i = 0; i < 4; ++i) { lw[i] = x0[i]; lw[4 + i] = x1[i]; }
#pragma unroll
      for (int i = 0; i < 8; ++i) CUM[t * 68 + j0 + i] = lw[i]; }
    __syncthreads();
    if (tid < 64) { float s = 0.f;
#pragma unroll 8
        for (int tt = 0; tt < 64; ++tt) { s += CUM[tt * 68 + tid]; CUM[tt * 68 + tid] = s; } }
    __syncthreads();
    {
        float cum[8], cT[8];
#pragma unroll
        for (int i = 0; i < 8; ++i) { cum[i] = CUM[t * 68 + j0 + i]; cT[i] = CUM[63 * 68 + j0 + i]; }
        if (t == 0) {
#pragma unroll
            for (int i = 0; i < 8; ++i) PT[j0 + i] = __expf(cT[i]); }
        float av[8], bv[8], kv[8], rv[8], vv[8];
#define LD8(dst, OFF) { const f32x4 x0 = *(const GAS f32x4*)((const float*)(ws + (OFF)) + go), x1 = *(const GAS f32x4*)((const float*)(ws + (OFF)) + go + 4); _Pragma("unroll") for (int i = 0; i < 4; ++i) { dst[i] = x0[i]; dst[4 + i] = x1[i]; } }
        LD8(av, WS_KKN) LD8(bv, WS_BB) LD8(kv, WS_KP) LD8(rv, WS_R32) LD8(vv, WS_VV)
#undef LD8
        float at[8], bh[8], kh[8], rt[8], bj[8], kj[8];
#pragma unroll
        for (int i = 0; i < 8; ++i) { const float pprev = __expf(cum[i] - lw[i]), pinv = __expf(-cum[i]), pt = __expf(cum[i]), pend = __expf(cT[i] - cum[i]);
            at[i] = -av[i] * pprev; bh[i] = bv[i] * pinv; kh[i] = kv[i] * pinv; rt[i] = rv[i] * pt; bj[i] = bv[i] * pend; kj[i] = kv[i] * pend; }
#define ST8(M, v) { u32x4 o; o.x = pk2(v[0], v[1]); o.y = pk2(v[2], v[3]); o.z = pk2(v[4], v[5]); o.w = pk2(v[6], v[7]); *(LAS u32x4*)(M + t * 72 + j0) = o; }
        ST8(AT, at) ST8(BH, bh) ST8(KH, kh) ST8(RT, rt)
#undef ST8
#pragma unroll
        for (int i = 0; i < 8; ++i) { const int o = (j0 + i) * 72 + t; AJ[o] = (bf16)f2bf(at[i]); BJ[o] = (bf16)f2bf(bj[i]); KJ[o] = (bf16)f2bf(kj[i]); VJ[o] = (bf16)f2bf(vv[i]); }
    }
    __syncthreads();
    {
        const int q = w >> 1; const LAS bf16* Am = (q == 0) ? BH : (q == 1) ? KH : RT; const LAS bf16* Bm = (q < 2) ? AT : (q == 2) ? BH : KH;
#pragma unroll
        for (int bi = 0; bi < 2; ++bi) { const int bm = 2 * (w & 1) + bi; const bf16x8 a0 = ldfrag(Am, 72, 16 * bm, 0, lane), a1 = ldfrag(Am, 72, 16 * bm, 32, lane);
#pragma unroll
            for (int bn = 0; bn < 4; ++bn) { f32x4 acc = (f32x4){0.f, 0.f, 0.f, 0.f};
                acc = MFMA16(a0, ldfrag(Bm, 72, 16 * bn, 0, lane), acc); acc = MFMA16(a1, ldfrag(Bm, 72, 16 * bn, 32, lane), acc);
#pragma unroll
                for (int r = 0; r < 4; ++r) { const int row = 16 * bm + 4 * g4 + r, col = 16 * bn + lc; const bool keep = (q < 2) ? (row < col) : (col <= row); const float v = keep ? acc[r] : 0.f;
                    if (q == 0) CUM[row * 68 + col] = v; else { LAS bf16* O = (q == 1) ? MAK : (q == 2) ? MRBT : MRKT; O[row * 72 + col] = (bf16)f2bf(v); } } } }
    }
    __syncthreads();
    if (w == 0) {
        int z = 0; asm volatile("" : "+v"(z));
        const LAS float* Mz = CUM + z; LAS float* Wl = WF + lane * 68;
#pragma unroll
        for (int s4 = 0; s4 < 16; ++s4) *(LAS f32x4*)(Wl + 4 * s4) = (f32x4){0.f, 0.f, 0.f, 0.f};
#pragma unroll 1
        for (int tau = 63; tau >= 0; --tau) { float acc = (lane == tau) ? 1.f : 0.f;
#pragma unroll 4
            for (int s4 = (tau + 1) >> 2; s4 < 16; ++s4) { const f32x4 m = *(const LAS f32x4*)(Mz + tau * 68 + 4 * s4), wq = *(const LAS f32x4*)(Wl + 4 * s4);
                acc += m.x * wq.x; acc += m.y * wq.y; acc += m.z * wq.z; acc += m.w * wq.w; }
            Wl[tau] = acc; }
#pragma unroll
        for (int s8 = 0; s8 < 8; ++s8) { const f32x4 a = *(const LAS f32x4*)(Wl + 8 * s8), b = *(const LAS f32x4*)(Wl + 8 * s8 + 4); *(LAS u32x4*)(WT + lane * 72 + 8 * s8) = pack8(a, b); }
    }
    __syncthreads();
    {
        const int q = w >> 2, bm = w & 3; const LAS bf16* Am = q ? MAK : AJ; LAS bf16* O = q ? G2 : G1;
        const bf16x8 a0 = ldfrag(Am, 72, 16 * bm, 0, lane), a1 = ldfrag(Am, 72, 16 * bm, 32, lane);
        f32x4 acc[4];
#pragma unroll
        for (int bn = 0; bn < 4; ++bn) { acc[bn] = (f32x4){0.f, 0.f, 0.f, 0.f};
            acc[bn] = MFMA16(a0, ldfrag(WT, 72, 16 * bn, 0, lane), acc[bn]); acc[bn] = MFMA16(a1, ldfrag(WT, 72, 16 * bn, 32, lane), acc[bn]); }
        __syncthreads();
#pragma unroll
        for (int bn = 0; bn < 4; ++bn)
#pragma unroll
            for (int r = 0; r < 4; ++r) O[(16 * bm + 4 * g4 + r) * 72 + 16 * bn + lc] = (bf16)f2bf(acc[bn][r]);
    }
    __syncthreads();
    {
        const int q = w >> 1; const LAS bf16* Am = (q < 2) ? MRBT : BJ; const LAS bf16* Bm = (q & 1) ? G2 : G1;
        f32x4 acc[2][4];
#pragma unroll
        for (int bi = 0; bi < 2; ++bi) { const int bm = 2 * (w & 1) + bi; const bf16x8 a0 = ldfrag(Am, 72, 16 * bm, 0, lane), a1 = ldfrag(Am, 72, 16 * bm, 32, lane);
#pragma unroll
            for (int bn = 0; bn < 4; ++bn) { acc[bi][bn] = (f32x4){0.f, 0.f, 0.f, 0.f};
                acc[bi][bn] = MFMA16(a0, ldfrag(Bm, 72, 16 * bn, 0, lane), acc[bi][bn]); acc[bi][bn] = MFMA16(a1, ldfrag(Bm, 72, 16 * bn, 32, lane), acc[bi][bn]); } }
        __syncthreads();
        bf16* gout = (bf16*)(ws + (q == 0 ? WS_QYT : q == 1 ? WS_CYT : WS_TST)) + (size_t)unit * 4096;
#pragma unroll
        for (int bi = 0; bi < 2; ++bi) { const int bm = 2 * (w & 1) + bi;
#pragma unroll
            for (int bn = 0; bn < 4; ++bn)
#pragma unroll
                for (int r = 0; r < 4; ++r) { const int row = 16 * bm + 4 * g4 + r, col = 16 * bn + lc; float v = acc[bi][bn][r];
                    if (q == 0) v += bf2f(RT[row * 72 + col]); else if (q == 1) v += bf2f(MRKT[row * 72 + col]); else if (q == 2) v += (row == col) ? PT[row] : 0.f; else v += bf2f(KJ[row * 72 + col]);
                    if (q < 3) gout[row * 64 + col] = (bf16)f2bf(v); else CST[row * 72 + col] = (bf16)f2bf(v); } }
    }
    __syncthreads();
    {
        const int bm = w >> 1; float* nst = (float*)(ws + WS_NST) + (size_t)unit * 4096;
        const bf16x8 a0 = ldfrag(CST, 72, 16 * bm, 0, lane), a1 = ldfrag(CST, 72, 16 * bm, 32, lane);
#pragma unroll
        for (int qn = 0; qn < 2; ++qn) { const int bn = (w & 1) * 2 + qn; f32x4 acc = (f32x4){0.f, 0.f, 0.f, 0.f};
            acc = MFMA16(a0, ldfrag(VJ, 72, 16 * bn, 0, lane), acc); acc = MFMA16(a1, ldfrag(VJ, 72, 16 * bn, 32, lane), acc);
#pragma unroll
            for (int r = 0; r < 4; ++r) nst[(16 * bm + 4 * g4 + r) * 64 + 16 * bn + lc] = acc[r]; }
    }
    __syncthreads();
}

DI void p_rwkv_scan2(Frame& F, int wslot) {
    unsigned char* ws = F.ws; const int lane = F.lane, g4 = lane >> 4, lc = lane & 15, h = wslot >> 2, ib = wslot & 3;
    f32x4 st[4];
#pragma unroll
    for (int jb = 0; jb < 4; ++jb) st[jb] = (f32x4){0.f, 0.f, 0.f, 0.f};
    const bf16* TST = (const bf16*)(ws + WS_TST); const float* NST = (const float*)(ws + WS_NST); bf16* S0 = (bf16*)(ws + WS_S0);
    u32x2 ta[4][2][2]; f32x4 nn[4];
#define SC_LOAD(cc) { const size_t ub = (size_t)((cc) * 8 + h) * 4096; \
        _Pragma("unroll") for (int jb = 0; jb < 4; ++jb) { const bf16* rowp = TST + ub + (size_t)(16 * jb + lc) * 64 + 4 * g4; \
            _Pragma("unroll") for (int ks = 0; ks < 2; ++ks) { ta[jb][ks][0] = *(const GAS u32x2*)(rowp + 32 * ks); ta[jb][ks][1] = *(const GAS u32x2*)(rowp + 32 * ks + 16); } \
            _Pragma("unroll") for (int r = 0; r < 4; ++r) nn[jb][r] = NST[ub + (size_t)(16 * jb + 4 * g4 + r) * 64 + 16 * ib + lc]; } }
    SC_LOAD(0)
    for (int c = 0; c < NCH; ++c) {
        bf16* s0p = S0 + (size_t)(c * 8 + h) * 4096 + (size_t)(16 * ib + lc) * 64 + 4 * g4;
        bf16x8 bfr[2];
#pragma unroll
        for (int ks = 0; ks < 2; ++ks) { u32x4 p; p.x = pk2(st[2 * ks][0], st[2 * ks][1]); p.y = pk2(st[2 * ks][2], st[2 * ks][3]); p.z = pk2(st[2 * ks + 1][0], st[2 * ks + 1][1]); p.w = pk2(st[2 * ks + 1][2], st[2 * ks + 1][3]);
            bfr[ks] = __builtin_bit_cast(bf16x8, p);
            *(GAS u32x2*)(s0p + 32 * ks) = (u32x2){p.x, p.y}; *(GAS u32x2*)(s0p + 32 * ks + 16) = (u32x2){p.z, p.w}; }
        f32x4 nw[4];
#pragma unroll
        for (int jb = 0; jb < 4; ++jb) { nw[jb] = nn[jb];
#pragma unroll
            for (int ks = 0; ks < 2; ++ks) { const u32x4 aw = (u32x4){ta[jb][ks][0].x, ta[jb][ks][0].y, ta[jb][ks][1].x, ta[jb][ks][1].y}; nw[jb] = MFMA16(__builtin_bit_cast(bf16x8, aw), bfr[ks], nw[jb]); } }
        if (c + 1 < NCH) SC_LOAD(c + 1)
#pragma unroll
        for (int jb = 0; jb < 4; ++jb) st[jb] = nw[jb];
    }
#undef SC_LOAD
}

DI void u_rwkv_r3(Frame& F, int l_, int c, int h) {
    unsigned char* ws = F.ws; const int tid = F.tid, lane = F.lane, w = F.wave, g4 = lane >> 4, lc = lane & 15, unit = c * 8 + h;
    LAS bf16* QY = (LAS bf16*)F.lds; LAS bf16* CY = QY + 4608; LAS bf16* S0s = CY + 4608; LAS bf16* VJ = S0s + 4608; LAS float* Ys = (LAS float*)(VJ + 4608);
    stage_nat(QY, 72, (const bf16*)(ws + WS_QYT) + (size_t)unit * 4096, 64, 64, 8, tid);
    stage_nat(CY, 72, (const bf16*)(ws + WS_CYT) + (size_t)unit * 4096, 64, 64, 8, tid);
    stage_nat(S0s, 72, (const bf16*)(ws + WS_S0) + (size_t)unit * 4096, 64, 64, 8, tid);
    const size_t gb = (size_t)(c * 64) * 512 + h * 64;
    { const int t = tid >> 3, j0 = (tid & 7) * 8; const float* vp = (const float*)(ws + WS_VV) + gb + (size_t)t * 512 + j0; const f32x4 x0 = *(const GAS f32x4*)vp, x1 = *(const GAS f32x4*)(vp + 4);
#pragma unroll
      for (int i = 0; i < 4; ++i) { VJ[(j0 + i) * 72 + t] = (bf16)f2bf(x0[i]); VJ[(j0 + 4 + i) * 72 + t] = (bf16)f2bf(x1[i]); } }
    __syncthreads();
    { const int bm = w >> 1;
#pragma unroll
      for (int qn = 0; qn < 2; ++qn) { const int bn = (w & 1) * 2 + qn; f32x4 acc = (f32x4){0.f, 0.f, 0.f, 0.f};
#pragma unroll
          for (int ks = 0; ks < 2; ++ks) { acc = MFMA16(ldfrag(QY, 72, 16 * bm, 32 * ks, lane), ldfrag(S0s, 72, 16 * bn, 32 * ks, lane), acc); acc = MFMA16(ldfrag(CY, 72, 16 * bm, 32 * ks, lane), ldfrag(VJ, 72, 16 * bn, 32 * ks, lane), acc); }
#pragma unroll
          for (int r = 0; r < 4; ++r) Ys[(16 * bm + 4 * g4 + r) * 65 + 16 * bn + lc] = acc[r]; } }
    __syncthreads();
    { const float* prm = (const float*)(ws + WS_PRM) + (size_t)l_ * PRM_STRIDE; const float lnw = prm[P_LNW + h * 64 + lane], lnb = prm[P_LNB + h * 64 + lane], rk = prm[P_RK + h * 64 + lane];
#pragma unroll
      for (int rr = 0; rr < 8; ++rr) { const int t = 8 * w + rr; const size_t o = gb + (size_t)t * 512 + lane; const float y = Ys[t * 65 + lane];
          const float r = ((const float*)(ws + WS_R32))[o], k = ((const float*)(ws + WS_KP))[o], v = ((const float*)(ws + WS_VV))[o], g = ((const float*)(ws + WS_G32))[o];
          const float mean = wave_sum(y) * (1.f / 64.f), d = y - mean, rstd = rsqrtf(wave_sum(d * d) * (1.f / 64.f) + 64e-5f), bs = wave_sum(r * k * rk);
          ((bf16*)(ws + WS_OB))[(size_t)(c * 64 + t) * D + 1536 + h * 64 + lane] = (bf16)f2bf((d * rstd * lnw + lnb + bs * v) * g); } }
    __syncthreads();
}

constexpr int STEPS_PER_LAYER = 13, NSTEPS = 1 + DEPTH * STEPS_PER_LAYER;
constexpr int NSCAN_BLK = 8;

__global__ void __launch_bounds__(NTHR, 2) mk_fwd(Args args) {
    extern __shared__ __attribute__((aligned(16))) unsigned char lds_raw[];
    Frame F;
    F.lds = (LAS unsigned char*)lds_raw; F.MISC = (volatile LAS unsigned*)(F.lds + MISC_OFF);
    F.tid = threadIdx.x; F.lane = F.tid & 63; F.wave = __builtin_amdgcn_readfirstlane(F.tid >> 6);
    F.G = gridDim.x; F.bid = blockIdx.x; F.ws = args.ws; F.ctl = (gu32*)(args.ws + WS_CTL);
    for (int u = F.tid; u < (LDS_BYTES - LDSCTL_OFF) / 4; u += NTHR) ((LAS unsigned*)(F.lds + LDSCTL_OFF))[u] = 0u;
    __syncthreads();
    const int lo = args.st_lo, hi = args.st_hi;
    XcdBarrier bar; bar.bar = (unsigned*)(F.ctl + CW_BAR); bar.x = 0; bar.st = nullptr;
    if (hi - lo > 1) bar = xcd_barrier_post((unsigned*)(F.ctl + CW_BAR), F.MISC + 8);
#ifndef MK_MASK
#define MK_MASK 0xFFFFu
#endif
#define EN(k) (((MK_MASK) >> (k)) & 1u)
#ifndef MK_REP
#define MK_REP 0u
#endif
#define REP(k) (((MK_REP) >> (k)) & 1u)
#ifndef MK_DUP
#define MK_DUP 0u
#endif
#define DUP(k, stmt) do { stmt; if (((MK_DUP) >> (k)) & 1u) { stmt; } } while (0)
#define RUN(s) (lo <= (s) && (s) < hi)
#define SEAM(s) do { if ((s) + 1 < hi) xcd_barrier(bar); } while (0)

    if (EN(13) && RUN(0)) { _Pragma("unroll 1") for (int rp = 0; rp <= (int)REP(13); ++rp) { relaunder(F, args.ws, (LAS unsigned char*)lds_raw); p_prologue(F, args); } SEAM(0); }

    for (int l = 0; l < DEPTH; ++l) {
        const int sb = 1 + l * STEPS_PER_LAYER;
        const float* xin = (l == 0) ? args.in[0] : args.out;
        if (EN(0) && RUN(sb + 0)) { _Pragma("unroll 1") for (int rp = 0; rp <= (int)REP(0); ++rp) { relaunder(F, args.ws, (LAS unsigned char*)lds_raw); unsigned char* ws = F.ws; p_rmsnorm(F, xin, (const float*)(ws + WS_PRM) + (size_t)l * PRM_STRIDE + P_N1, (bf16*)(ws + WS_XN)); } SEAM(sb + 0); }
        if (EN(1) && RUN(sb + 1)) { _Pragma("unroll 1") for (int rp = 0; rp <= (int)REP(1); ++rp) { relaunder(F, args.ws, (LAS unsigned char*)lds_raw); unsigned char* ws = F.ws;
            pg8::Gemm g{(const bf16*)(ws + WS_XN), (const bf16*)(ws + WS_WIN) + (size_t)l * NINP * D, D, D, D};
            pg8::StaticOrder So; So.init(S, NINP, F.G, F.bid); pg8::EpiIn E{ws};
            DUP(6, (pg8::gemm_phase<pg8::EpiIn, pg8::StaticOrder, true>(F.lds, g, So, E, F.tid)));
            } SEAM(sb + 1);
        }
        if (EN(2) && RUN(sb + 2)) { _Pragma("unroll 1") for (int rp = 0; rp <= (int)REP(2); ++rp) { relaunder(F, args.ws, (LAS unsigned char*)lds_raw); unsigned char* ws = F.ws;
            p_rwkv_prep(F, l);
            relaunder(F, args.ws, (LAS unsigned char*)lds_raw); p_mamba_prep(F, l);
            __syncthreads(); relaunder(F, args.ws, (LAS unsigned char*)lds_raw);
            for (int u = (F.bid + 128) % F.G; u < 512; u += F.G) DUP(5, u_ret_kv(F, u >> 2, u & 3));
            } SEAM(sb + 2);
        }
        if (EN(3) && RUN(sb + 3)) { _Pragma("unroll 1") for (int rp = 0; rp <= (int)REP(3); ++rp) { relaunder(F, args.ws, (LAS unsigned char*)lds_raw); unsigned char* ws = F.ws;
            { pg8::Gemm g{(const bf16*)(ws + WS_CQ), (const bf16*)(ws + WS_WQB) + (size_t)l * 1024 * 512, 512, 512, 512};
              pg8::StaticOrder So; So.init(S, 1024, F.G, F.bid); pg8::EpiQb E{ws, (const float*)(ws + WS_PRM) + (size_t)l * PRM_STRIDE + P_QNW};
              pg8::gemm_phase<pg8::EpiQb, pg8::StaticOrder, false>(F.lds, g, So, E, F.tid); __syncthreads(); }
            relaunder(F, args.ws, (LAS unsigned char*)lds_raw); ws = F.ws;
            { pg8::Gemm g{(const bf16*)(ws + WS_CKV), (const bf16*)(ws + WS_WKVB) + (size_t)l * 1024 * 256, 256, 256, 256};
              pg8::StaticOrder So; So.init(S, 1024, F.G, (F.bid + 128) % F.G); pg8::EpiKvb E{ws, (const float*)(ws + WS_PRM) + (size_t)l * PRM_STRIDE + P_KNW};
              pg8::gemm_phase<pg8::EpiKvb, pg8::StaticOrder, false>(F.lds, g, So, E, F.tid); __syncthreads(); }
            relaunder(F, args.ws, (LAS unsigned char*)lds_raw); ws = F.ws;
            if (l > 0) { pg8::Gemm g{(const bf16*)(ws + WS_VB), (const bf16*)(ws + WS_WV1) + (size_t)l * 256 * 512, 512, 512, 512};
              pg8::StaticOrder So; So.init(S, 256, F.G, (F.bid + 64) % F.G); pg8::EpiV1 E{ws};
              pg8::gemm_phase<pg8::EpiV1, pg8::StaticOrder, true>(F.lds, g, So, E, F.tid); __syncthreads(); }
            relaunder(F, args.ws, (LAS unsigned char*)lds_raw);
            for (int u = F.bid; u < 256; u += F.G) DUP(4, u_mamba_st(F, u >> 1, u & 1));
            } SEAM(sb + 3);
        }
        if (EN(4) && RUN(sb + 4)) { _Pragma("unroll 1") for (int rp = 0; rp <= (int)REP(4); ++rp) { relaunder(F, args.ws, (LAS unsigned char*)lds_raw); unsigned char* ws = F.ws;
            p_scans(F);
            relaunder(F, args.ws, (LAS unsigned char*)lds_raw); ws = F.ws;
            { pg8::Gemm g{(const bf16*)(ws + WS_ALORA), (const bf16*)(ws + WS_WLORA) + (size_t)l * 2048 * 512, 512, 512, 512};
              pg8::StaticOrder So; So.init(S, l > 0 ? 2048 : 1536, F.G, F.bid);
              const float* prm = (const float*)(ws + WS_PRM) + (size_t)l * PRM_STRIDE; pg8::EpiLora E{ws, prm + P_W0, prm + P_A0, prm + P_V0, prm + P_KA};
              DUP(9, (pg8::gemm_phase<pg8::EpiLora, pg8::StaticOrder, true>(F.lds, g, So, E, F.tid))); }
            } SEAM(sb + 4);
        }
        if (EN(5) && RUN(sb + 5)) { _Pragma("unroll 1") for (int rp = 0; rp <= (int)REP(5); ++rp) { relaunder(F, args.ws, (LAS unsigned char*)lds_raw); unsigned char* ws = F.ws; (void)ws;
            for (int u = F.bid; u < 1024; u += F.G) u_rwkv_r1(F, u >> 3, u & 7);
            } SEAM(sb + 5);
        }
        if (EN(6) && RUN(sb + 6)) { _Pragma("unroll 1") for (int rp = 0; rp <= (int)REP(6); ++rp) { relaunder(F, args.ws, (LAS unsigned char*)lds_raw); unsigned char* ws = F.ws; (void)ws;
            if (F.bid < NSCAN_BLK) { if (F.wave < 4) p_rwkv_scan2(F, F.bid * 4 + F.wave); }
            else {
                const int NB = F.G - NSCAN_BLK, b = F.bid - NSCAN_BLK;
                for (int r = 0; r * NB < 512; ++r) { const int pos = (r & 1) ? NB - 1 - b : b; const int i = r * NB + pos; if (i < 512) DUP(0, u_attn(F, 127 - (i >> 2), i & 3)); }
                relaunder(F, args.ws, (LAS unsigned char*)lds_raw);
                for (int u = b; u < 512; u += NB) DUP(1, u_ret_out(F, l, u >> 2, u & 3));
                relaunder(F, args.ws, (LAS unsigned char*)lds_raw);
                for (int u = b; u < 256; u += NB) DUP(2, u_mamba_out(F, l, u >> 1, u & 1));
            }
            } SEAM(sb + 6);
        }
        if (EN(7) && RUN(sb + 7)) { _Pragma("unroll 1") for (int rp = 0; rp <= (int)REP(7); ++rp) { relaunder(F, args.ws, (LAS unsigned char*)lds_raw); unsigned char* ws = F.ws; (void)ws;
            for (int u = F.bid; u < 1024; u += F.G) DUP(3, u_rwkv_r3(F, l, u >> 3, u & 7));
            } SEAM(sb + 7);
        }
        if (EN(8) && RUN(sb + 8)) { _Pragma("unroll 1") for (int rp = 0; rp <= (int)REP(8); ++rp) { relaunder(F, args.ws, (LAS unsigned char*)lds_raw); unsigned char* ws = F.ws;
            pg8::Gemm g{(const bf16*)(ws + WS_OB), (const bf16*)(ws + WS_WBR) + (size_t)l * 8192 * 512, 512, D, 512};
            pg8::BranchOrder So; So.init(F.G, F.bid); pg8::EpiBranch E{ws};
            DUP(8, (pg8::gemm_phase<pg8::EpiBranch, pg8::BranchOrder, true>(F.lds, g, So, E, F.tid)));
            } SEAM(sb + 8);
        }
        if (EN(9) && RUN(sb + 9)) { _Pragma("unroll 1") for (int rp = 0; rp <= (int)REP(9); ++rp) { relaunder(F, args.ws, (LAS unsigned char*)lds_raw); unsigned char* ws = F.ws;
            pg8::Gemm g{(const bf16*)(ws + WS_MERGED), (const bf16*)(ws + WS_WOUT) + (size_t)l * D * D, D, D, D};
            pg8::StaticOrder So; So.init(S, D, F.G, F.bid); pg8::EpiRes E{xin, args.out};
            pg8::gemm_phase<pg8::EpiRes, pg8::StaticOrder, true>(F.lds, g, So, E, F.tid);
            } SEAM(sb + 9);
        }
        if (EN(10) && RUN(sb + 10)) { _Pragma("unroll 1") for (int rp = 0; rp <= (int)REP(10); ++rp) { relaunder(F, args.ws, (LAS unsigned char*)lds_raw); unsigned char* ws = F.ws; p_rmsnorm(F, args.out, (const float*)(ws + WS_PRM) + (size_t)l * PRM_STRIDE + P_N2, (bf16*)(ws + WS_XN)); } SEAM(sb + 10); }
        if (EN(11) && RUN(sb + 11)) { _Pragma("unroll 1") for (int rp = 0; rp <= (int)REP(11); ++rp) { relaunder(F, args.ws, (LAS unsigned char*)lds_raw); unsigned char* ws = F.ws;
            pg8::Gemm g{(const bf16*)(ws + WS_XN), (const bf16*)(ws + WS_WGU) + (size_t)l * 2 * DFF * D, D, D, D};
            pg8::StaticOrder So; So.init(S, 2 * DFF, F.G, F.bid); pg8::EpiGu E{ws};
            DUP(7, (pg8::gemm_phase<pg8::EpiGu, pg8::StaticOrder, true>(F.lds, g, So, E, F.tid)));
            } SEAM(sb + 11);
        }
        if (EN(12) && RUN(sb + 12)) { _Pragma("unroll 1") for (int rp = 0; rp <= (int)REP(12); ++rp) { relaunder(F, args.ws, (LAS unsigned char*)lds_raw); unsigned char* ws = F.ws;
            pg8::Gemm g{(const bf16*)(ws + WS_ACT), (const bf16*)(ws + WS_WDN) + (size_t)l * D * DFF, DFF, DFF, DFF};
            pg8::StaticOrder So; So.init(S, D, F.G, F.bid); pg8::EpiRes E{args.out, args.out};
            pg8::gemm_phase<pg8::EpiRes, pg8::StaticOrder, true>(F.lds, g, So, E, F.tid);
            } SEAM(sb + 12);
        }
    }
#undef RUN
#undef SEAM
}

#ifndef MK_ONE_LAUNCH
#define MK_ONE_LAUNCH 1
#endif
extern "C" void kernel_launch(void* const* d_in, const int* in_sizes, int n_in, void* d_out, int out_size, void* d_ws, size_t ws_size, hipStream_t stream) {
    static int grid = 0;
    if (grid == 0) {
        if (n_in != 36 || in_sizes[0] != S * D || out_size != S * D || ws_size < WS_END2) { fprintf(stderr, "kernel_launch: bad shapes: n_in %d in0 %d out %d ws %zu (need %zu)\n", n_in, n_in > 0 ? in_sizes[0] : -1, out_size, ws_size, (size_t)WS_END2); grid = -1; return; }
        int dev = 0, cus = 0, per_cu = 0;
        if (hipGetDevice(&dev) != hipSuccess || hipDeviceGetAttribute(&cus, hipDeviceAttributeMultiprocessorCount, dev) != hipSuccess) { grid = -1; return; }
        if (hipFuncSetAttribute((const void*)mk_fwd, hipFuncAttributeMaxDynamicSharedMemorySize, LDS_BYTES) != hipSuccess) { fprintf(stderr, "kernel_launch: hipFuncSetAttribute failed\n"); grid = -1; return; }
        if (hipOccupancyMaxActiveBlocksPerMultiprocessor(&per_cu, (const void*)mk_fwd, NTHR, LDS_BYTES) != hipSuccess || per_cu < 1) fprintf(stderr, "kernel_launch: occupancy query says %d\n", per_cu);
        (void)hipGetLastError();
        grid = cus;
        if (grid != 256) fprintf(stderr, "kernel_launch: %d CUs (built for 256)\n", grid);
    }
    if (grid < 0) return;
    if (hipMemsetAsync((char*)d_ws + WS_CTL, 0, CTL_ZERO_BYTES, stream) != hipSuccess) return;
    Args a{};
    for (int i = 0; i < 36; ++i) a.in[i] = (const float*)d_in[i];
    a.out = (float*)d_out; a.ws = (unsigned char*)d_ws;
#if MK_ONE_LAUNCH
    a.st_lo = 0; a.st_hi = NSTEPS;
    hipLaunchKernelGGL(mk_fwd, dim3(grid), dim3(NTHR), LDS_BYTES, stream, a);
#else
    for (int s = 0; s < NSTEPS; ++s) { a.st_lo = s; a.st_hi = s + 1; hipLaunchKernelGGL(mk_fwd, dim3(grid), dim3(NTHR), LDS_BYTES, stream, a); }
#endif
}
```

```cpp
#include <hip/hip_runtime.h>
#include <cstdio>
#include <cstdint>

#define GAS __attribute__((address_space(1)))
#define LAS __attribute__((address_space(3)))
typedef unsigned short bf16;
typedef short bf16x8 __attribute__((ext_vector_type(8)));
typedef short s16x4 __attribute__((ext_vector_type(4)));
typedef float f32x4 __attribute__((ext_vector_type(4)));
typedef float f32x2 __attribute__((ext_vector_type(2)));
typedef unsigned u32x4 __attribute__((ext_vector_type(4)));
typedef unsigned u32x2 __attribute__((ext_vector_type(2)));
typedef GAS unsigned gu32;
#define RLX_AGENT __ATOMIC_RELAXED, __HIP_MEMORY_SCOPE_AGENT
#define DI __device__ __forceinline__

constexpr int S = 8192, D = 2048, DEPTH = 4, NIN = 14408, NINP = 14592, DFF = 5632;
constexpr int NCH = 128;
constexpr float LOG2E = 1.4426950408889634f;

DI float bf2f(unsigned v) { return __uint_as_float(v << 16); }
typedef __bf16 bf16x2_t __attribute__((ext_vector_type(2)));
DI unsigned pk2(float lo, float hi) { const f32x2 v = {lo, hi}; const bf16x2_t b = __builtin_convertvector(v, bf16x2_t); return __builtin_bit_cast(unsigned, b); }
DI unsigned f2bf(float f) { const __bf16 b = (__bf16)f; return (unsigned)__builtin_bit_cast(unsigned short, b); }
DI float fexp_(float x) { return __builtin_amdgcn_exp2f(x * 1.4426950408889634f); }
DI float ftanh_(float x) { return 1.0f - 2.0f * __builtin_amdgcn_rcpf(1.0f + fexp_(2.0f * x)); }
DI float sigmoidf_(float x) { return __builtin_amdgcn_rcpf(1.0f + fexp_(-x)); }
DI float siluf_(float x) { return x * __builtin_amdgcn_rcpf(1.0f + fexp_(-x)); }
DI float softplusf_(float x) { return fmaxf(x, 0.f) + log1pf(fexp_(-fabsf(x))); }
DI u32x4 pack8(const f32x4 a, const f32x4 b) { u32x4 w; w.x = pk2(a[0], a[1]); w.y = pk2(a[2], a[3]); w.z = pk2(b[0], b[1]); w.w = pk2(b[2], b[3]); return w; }
DI void unpack8(const u32x4 w, float (&o)[8]) { o[0] = bf2f(w.x & 0xffffu); o[1] = bf2f(w.x >> 16); o[2] = bf2f(w.y & 0xffffu); o[3] = bf2f(w.y >> 16);
    o[4] = bf2f(w.z & 0xffffu); o[5] = bf2f(w.z >> 16); o[6] = bf2f(w.w & 0xffffu); o[7] = bf2f(w.w >> 16); }

namespace pg8 {
constexpr int BM = 256, BK = 64, HALF = 128, HTB = HALF * BK * 2, STAGE_BYTES = 8 * HTB, NXCD = 8, WGM = 8;
DI int lds_byte(int r, int c) { const int st = (r >> 4) * 2 + (c >> 5), rr = r & 15, cc = c & 31, ob = rr * 64 + cc * 2; return st * 1024 + (ob ^ (((ob >> 9) & 1) << 5)); }
DI void stage_rc(int b, int& R, int& C) { const int st = b / 1024, sb = b % 1024, swz = sb ^ (((sb >> 9) & 1) << 5); R = (st >> 1) * 16 + swz / 64; C = (st & 1) * 32 + (swz % 64) / 2; }
DI int perm32(int rho) { const int n = rho >> 4, i = rho & 15; return 8 * (i >> 2) + 4 * n + (i & 3); }

struct Unit { int pm, pn, ak, brow, sub, ord; };
struct Gemm { const bf16* A; const bf16* Bt; int K, lda, ldb; };

struct StaticOrder {
    int nM, nN, nwg, G, c;
    DI void init(int M, int N, int G_, int c_) { nM = M / BM; nN = N / BM; nwg = nM * nN; G = G_; c = c_; }
    DI bool next(int i, Unit& u) const {
        const long L = (long)i * G + c; if (L >= nwg) return false;
        int wgid = (int)L; { const int q = nwg / NXCD, r = nwg % NXCD, xcd = wgid % NXCD, off = wgid / NXCD; wgid = (xcd < r ? xcd * (q + 1) : r * (q + 1) + (xcd - r) * q) + off; }
        const int nig = WGM * nN, gid = wgid / nig, fm = gid * WGM, gsz = (nM - fm) < WGM ? (nM - fm) : WGM;
        u.pm = fm + ((wgid % nig) % gsz); u.pn = (wgid % nig) / gsz; u.ak = 0; u.brow = u.pn * BM; u.sub = 0; return true;
    }
};
struct LoraOrder {
    StaticOrder so;
    DI void init(int N, int G_, int c_) { so.init(S, N, G_, c_); }
    DI bool next(int i, Unit& u) const { if (!so.next(i, u)) return false; u.ak = (u.pn >= 4) ? 256 : 0; return true; }
};
struct BranchOrder {
    StaticOrder so;
    DI void init(int G_, int c_) { so.init(S, D, G_, c_); }
    DI bool next(int i, Unit& u) const { if (!so.next(i >> 2, u)) return false; u.sub = i & 3; u.ak = u.sub * 512; u.brow = u.sub * D + u.pn * BM; return true; }
};

typedef f32x4 Acc[2][2][4][2];

template <class Epi, class Sched, bool ALIGN_EPI>
DI void gemm_phase(LAS unsigned char* lds, const Gemm g, const Sched& Sc, const Epi& E, const int tid) {
    const int wid = __builtin_amdgcn_readfirstlane(tid >> 6), lane = tid & 63, wr = wid >> 2, wc = wid & 3, fr = lane & 15, fq = lane >> 4;
    const int K = g.K, nt = K / BK;
    unsigned voffA[2], voffB[2];
#pragma unroll
    for (int i = 0; i < 2; ++i) { int R, C; stage_rc(tid * 16 + i * 8192, R, C); const int Rb = (R & ~31) + perm32(R & 31);
        voffA[i] = (unsigned)(R * g.lda + C) * 2u; voffB[i] = (unsigned)(Rb * g.ldb + C) * 2u; }
    const size_t kstep = (size_t)(BK * 2);
    const size_t hA = (size_t)HALF * g.lda * 2, hB = (size_t)HALF * g.ldb * 2;
    const unsigned ldsw = (unsigned)wid * 1024u;
    const int aoff = lds_byte(wr * 64 + fr, fq * 8), boff = lds_byte(wc * 32 + fr, fq * 8);
#define PG8_SA(b, h) (((b) * 2 + (h)) * HTB)
#define PG8_SB(b, h) ((4 + (b) * 2 + (h)) * HTB)
#define PG8_STAGE(bufoff, gbase, voff) do { _Pragma("unroll") for (int _i = 0; _i < 2; ++_i) \
        __builtin_amdgcn_global_load_lds((const unsigned*)((const char*)(gbase) + (voff)[_i]), (LAS unsigned*)(lds + (bufoff) + ldsw + _i * 8192), 16, 0, 0); } while (0)
#define PG8_LDA(dst, b, h) do { _Pragma("unroll") for (int m = 0; m < 4; ++m) _Pragma("unroll") for (int k = 0; k < 2; ++k) dst[m][k] = *(const LAS bf16x8*)(lds + PG8_SA(b, h) + aoff + m * 2048 + k * 1024); } while (0)
#define PG8_LDB(dst, b, h) do { _Pragma("unroll") for (int n = 0; n < 2; ++n) _Pragma("unroll") for (int k = 0; k < 2; ++k) dst[n][k] = *(const LAS bf16x8*)(lds + PG8_SB(b, h) + boff + n * 2048 + k * 1024); } while (0)
#define PG8_MMA(ai, bj, At, Bt) do { __builtin_amdgcn_s_setprio(1); _Pragma("unroll") for (int m = 0; m < 4; ++m) _Pragma("unroll") for (int n = 0; n < 2; ++n) _Pragma("unroll") for (int k = 0; k < 2; ++k) \
        acc[ai][bj][m][n] = __builtin_amdgcn_mfma_f32_16x16x32_bf16(Bt[n][k], At[m][k], acc[ai][bj][m][n], 0, 0, 0); __builtin_amdgcn_s_setprio(0); } while (0)
#define PG8_WAIT_V(n) asm volatile("s_waitcnt vmcnt(" #n ")" ::: "memory")
#define PG8_WAIT_L(n) asm volatile("s_waitcnt lgkmcnt(" #n ")" ::: "memory")
#define PG8_BAR __builtin_amdgcn_s_barrier()
#define PG8_SCHED __builtin_amdgcn_sched_barrier(0)
    Unit cur, nxt; int ui = 0;
    if (!Sc.next(0, cur)) return;
    cur.ord = 0;
    Acc acc;
#pragma unroll
    for (int a = 0; a < 2; ++a)
#pragma unroll
        for (int b = 0; b < 2; ++b)
#pragma unroll
            for (int m = 0; m < 4; ++m)
#pragma unroll
                for (int n = 0; n < 2; ++n) acc[a][b][m][n] = (f32x4){0.f, 0.f, 0.f, 0.f};
    bf16x8 At[4][2], B0[2][2], B1[2][2];
    const char* cA = (const char*)g.A + ((size_t)cur.pm * BM * g.lda + cur.ak) * 2; const char* cB = (const char*)g.Bt + (size_t)cur.brow * g.ldb * 2;
    PG8_STAGE(PG8_SB(0, 0), cB, voffB); PG8_STAGE(PG8_SB(0, 1), cB + hB, voffB); PG8_STAGE(PG8_SA(0, 0), cA, voffA); PG8_STAGE(PG8_SA(0, 1), cA + hA, voffA);
    if (wr == 1) PG8_BAR;
    PG8_WAIT_V(2); PG8_BAR;
    PG8_STAGE(PG8_SB(1, 0), cB + kstep, voffB); PG8_STAGE(PG8_SA(1, 0), cA + kstep, voffA); PG8_STAGE(PG8_SB(1, 1), cB + hB + kstep, voffB);
    PG8_WAIT_V(6); PG8_BAR;
    for (;;) {
        const bool has_next = Sc.next(ui + 1, nxt); nxt.ord = ui + 1;
        const char* nA = has_next ? (const char*)g.A + ((size_t)nxt.pm * BM * g.lda + nxt.ak) * 2 : cA; const char* nB = has_next ? (const char*)g.Bt + (size_t)nxt.brow * g.ldb * 2 : cB;
        for (int t = 0; t < nt; t += 2) {
            const bool last = (t == nt - 2);
            const char* a1 = cA + (size_t)(t + 1) * kstep;
            const char* a2 = last ? nA : cA + (size_t)(t + 2) * kstep; const char* b2 = last ? nB : cB + (size_t)(t + 2) * kstep;
            const char* a3 = a2 + kstep; const char* b3 = b2 + kstep;
            PG8_LDB(B0, 0, 0); PG8_LDB(B1, 0, 1); PG8_SCHED; PG8_LDA(At, 0, 0); PG8_STAGE(PG8_SA(1, 1), a1 + hA, voffA);
            PG8_WAIT_V(8); PG8_WAIT_L(0); PG8_BAR; PG8_MMA(0, 0, At, B0); PG8_MMA(0, 1, At, B1); PG8_BAR; PG8_SCHED;
            PG8_LDA(At, 0, 1); PG8_STAGE(PG8_SB(0, 0), b2, voffB); PG8_STAGE(PG8_SB(0, 1), b2 + hB, voffB); PG8_STAGE(PG8_SA(0, 0), a2, voffA);
            PG8_WAIT_V(8); PG8_WAIT_L(0); PG8_BAR; PG8_MMA(1, 0, At, B0); PG8_MMA(1, 1, At, B1); PG8_BAR; PG8_SCHED;
            PG8_LDB(B0, 1, 0); PG8_LDB(B1, 1, 1); PG8_SCHED; PG8_LDA(At, 1, 0); PG8_STAGE(PG8_SA(0, 1), a2 + hA, voffA);
            PG8_WAIT_V(8); PG8_WAIT_L(0); PG8_BAR; PG8_MMA(0, 0, At, B0); PG8_MMA(0, 1, At, B1); PG8_BAR; PG8_SCHED;
            PG8_LDA(At, 1, 1); PG8_STAGE(PG8_SB(1, 0), b3, voffB); PG8_STAGE(PG8_SB(1, 1), b3 + hB, voffB); PG8_STAGE(PG8_SA(1, 0), a3, voffA);
            PG8_WAIT_V(8); PG8_WAIT_L(0); PG8_BAR; PG8_MMA(1, 0, At, B0); PG8_MMA(1, 1, At, B1); PG8_BAR; PG8_SCHED;
        }
        if constexpr (ALIGN_EPI) { if (wr == 0) PG8_BAR; }
        bool zero = true;
        if constexpr (!Epi::AFTER_DRAIN) { zero = E(acc, cur, wr, wc, fr, fq); }
        if (!has_next) break;
        if (zero) {
#pragma unroll
        for (int a = 0; a < 2; ++a)
#pragma unroll
            for (int b = 0; b < 2; ++b)
#pragma unroll
                for (int m = 0; m < 4; ++m)
#pragma unroll
                    for (int n = 0; n < 2; ++n) acc[a][b][m][n] = (f32x4){0.f, 0.f, 0.f, 0.f};
        }
        cur = nxt; cA = nA; cB = nB; ++ui;
        if constexpr (ALIGN_EPI) { if (wr == 1) PG8_BAR; }
    }
    PG8_WAIT_V(0);
    if constexpr (!ALIGN_EPI) { if (wr == 0) PG8_BAR; }
    PG8_BAR;
    if constexpr (Epi::AFTER_DRAIN) { E.fused(acc, cur, wr, wc, fr, fq, lds, wid, lane, tid); }
#undef PG8_SA
#undef PG8_SB
#undef PG8_STAGE
#undef PG8_LDA
#undef PG8_LDB
#undef PG8_MMA
#undef PG8_WAIT_V
#undef PG8_WAIT_L
#undef PG8_BAR
#undef PG8_SCHED
}
}

constexpr size_t MiB = 1u << 20;
constexpr size_t al256(size_t x) { return (x + 255) & ~(size_t)255; }
constexpr size_t WS_CTL = 0, CTL_ZERO_BYTES = 1 * MiB;
constexpr size_t WS_PRM = 1 * MiB;
constexpr int P_N1 = 0, P_N2 = 2048, P_GN = 4096, P_CW = 4608, P_CB = 8704, P_DTB = 9728, P_ALOG = 9736, P_SD = 9744, P_SNW = 9760, P_QNW = 10272, P_KNW = 10464, P_MU = 10656,
              P_W0 = 12448, P_A0 = 12960, P_V0 = 13472, P_KK = 13984, P_KA = 14496, P_RK = 15008, P_LNW = 15520, P_LNB = 16032, PRM_STRIDE = 16640;
constexpr size_t WS_COSR = 2 * MiB;
constexpr size_t WS_SINR = WS_COSR + (size_t)S * 64 * 4;
constexpr size_t WS_COSM = WS_SINR + (size_t)S * 64 * 4;
constexpr size_t WS_SINM = WS_COSM + (size_t)S * 32 * 4;
constexpr size_t WS_WIN  = WS_SINM + (size_t)S * 32 * 4;
constexpr size_t WS_WQB  = WS_WIN + (size_t)DEPTH * NINP * D * 2;
constexpr size_t WS_WKVB = WS_WQB + (size_t)DEPTH * 1024 * 512 * 2;
constexpr size_t WS_WV1  = WS_WKVB + (size_t)DEPTH * 1024 * 256 * 2;
constexpr size_t WS_WLORA = WS_WV1 + (size_t)DEPTH * 256 * 512 * 2;
constexpr size_t WS_WBR  = WS_WLORA + (size_t)DEPTH * 2048 * 512 * 2;
constexpr size_t WS_WOUT = WS_WBR + (size_t)DEPTH * 8192 * 512 * 2;
constexpr size_t WS_WGU  = WS_WOUT + (size_t)DEPTH * D * D * 2;
constexpr size_t WS_WDN  = WS_WGU + (size_t)DEPTH * 2 * DFF * D * 2;
constexpr size_t WS_ACT0 = WS_WDN + (size_t)DEPTH * D * DFF * 2;
constexpr size_t WS_XN   = WS_ACT0;
constexpr size_t WS_QR   = WS_XN + (size_t)S * D * 2;
constexpr size_t WS_KR   = WS_QR + (size_t)S * 512 * 2;
constexpr size_t WS_VR   = WS_KR + (size_t)S * 512 * 2;
constexpr size_t WS_GR   = WS_VR + (size_t)S * 512 * 2;
constexpr size_t WS_ZS   = WS_GR + (size_t)S * 512 * 2;
constexpr size_t WS_XBC  = WS_ZS + (size_t)S * 512 * 2;
constexpr size_t WS_XC   = WS_XBC + (size_t)S * 1024 * 2;
constexpr size_t WS_CQ   = WS_XC + (size_t)S * 1024 * 2;
constexpr size_t WS_CKV  = WS_CQ + (size_t)S * 512 * 2;
constexpr size_t WS_SSQ  = WS_CKV + (size_t)S * 256 * 2;
constexpr size_t WS_RW   = WS_SSQ + (size_t)S * 16 * 4;
constexpr size_t WS_GATE = WS_RW + (size_t)S * 1792 * 4;
constexpr size_t WS_MISC = WS_GATE + (size_t)S * 8192 * 2;
constexpr size_t WS_DTS  = WS_MISC + (size_t)S * 256 * 4;
constexpr size_t WS_ACS  = WS_DTS + (size_t)S * 8 * 4;
constexpr size_t WS_RKV  = WS_ACS + (size_t)S * 8 * 4;
constexpr size_t WS_MST  = WS_RKV + (size_t)NCH * 4 * 128 * 128 * 4;
constexpr size_t WS_QM   = WS_MST + (size_t)NCH * 8 * 64 * 128 * 4;
constexpr size_t WS_KM   = WS_QM + (size_t)S * 768 * 2;
constexpr size_t WS_VT   = WS_KM + (size_t)S * 768 * 2;
constexpr size_t WS_R32  = WS_VT + (size_t)512 * S * 2;
constexpr size_t SZ32    = (size_t)S * 512 * 4;
constexpr size_t WS_KKN  = WS_R32 + SZ32, WS_K32 = WS_KKN + SZ32, WS_VV = WS_K32 + SZ32, WS_VFIRST = WS_VV + SZ32, WS_DEC = WS_VFIRST + SZ32,
                 WS_KP = WS_DEC + SZ32, WS_BB = WS_KP + SZ32, WS_G32 = WS_BB + SZ32, WS_Y32 = WS_G32 + SZ32;
constexpr size_t WS_VB   = WS_Y32 + SZ32;
constexpr size_t WS_ALORA = WS_VB + (size_t)S * 512 * 2;
constexpr size_t WS_OB   = WS_ALORA + (size_t)S * 512 * 2;
constexpr size_t WS_MERGED = WS_OB + (size_t)S * D * 2;
constexpr size_t WS_ACT  = WS_MERGED + (size_t)S * D * 2;
constexpr size_t WS_END  = WS_ACT + (size_t)S * DFF * 2;

constexpr int CW_TMO = 0, CW_CODE = 1, CW_BAR = 4096;


constexpr int NWAVES = 8, NTHR = 512;
constexpr int RING_BYTES = 143360, LDSCTL_OFF = RING_BYTES, MISC_OFF = LDSCTL_OFF + 320, LDS_BYTES = 147456;
#define LDS_WAIT() asm volatile("s_waitcnt lgkmcnt(0)" ::: "memory")
#define VM_WAIT() asm volatile("s_waitcnt vmcnt(0)" ::: "memory")

#define XB_TMO      128
#define XB_XCNT(j)  (256  + 64 * (j))
#define XB_XSUB(j)  (1280 + 64 * (j))
#define XB_XGEN(j)  (2304 + 64 * (j))
#define XB_TOP      3328
#define XB_TOPGEN   3392
#define XCD_BAR_WORDS 3456
#define XB_SPIN_CAP (1u << 22)
DI unsigned xb_ld(unsigned* p)              { return __hip_atomic_load(p, __ATOMIC_RELAXED, __HIP_MEMORY_SCOPE_AGENT); }
DI unsigned xb_add(unsigned* p, unsigned v) { return __hip_atomic_fetch_add(p, v, __ATOMIC_RELAXED, __HIP_MEMORY_SCOPE_AGENT); }
DI unsigned xb_xcc_id() { return (unsigned)__builtin_amdgcn_s_getreg((3 << 11) | 20) & 0xFu; }
#define XB_SPIN(cond, bar) do { unsigned _sp = 0; while (cond) { __builtin_amdgcn_s_sleep(1); \
    if ((++_sp & 255u) == 0u) { if (xb_ld(&(bar)[XB_TMO])) break; if (_sp > XB_SPIN_CAP) { atomicAdd(&(bar)[XB_TMO], 1u); break; } } } } while (0)
struct XcdBarrier { unsigned* bar; unsigned x; volatile LAS unsigned* st; };
DI XcdBarrier xcd_barrier_post(unsigned* bar, volatile LAS unsigned* st) {
    XcdBarrier b; b.bar = bar; b.x = xb_xcc_id(); b.st = st;
    if (threadIdx.x == 0) (void)xb_add(&bar[XB_XCNT(b.x)], 1u);
    return b;
}
DI void xcd_barrier_complete(unsigned* bar, unsigned x, unsigned& nloc, unsigned& nx) {
    const unsigned G = gridDim.x * gridDim.y * gridDim.z;
    unsigned sum, cnt, mine, sp = 0u;
    for (;;) {
        sum = 0u; cnt = 0u; mine = 0u;
#pragma unroll
        for (unsigned j = 0; j < 16; ++j) { const unsigned c = xb_ld(&bar[XB_XCNT(j)]); sum += c; cnt += (c > 0u) ? 1u : 0u; mine = (j == x) ? c : mine; }
        if (sum == G) break;
        __builtin_amdgcn_s_sleep(1);
        if ((++sp & 255u) == 0u) { if (xb_ld(&bar[XB_TMO])) break; if (sp > XB_SPIN_CAP) { atomicAdd(&bar[XB_TMO], 1u); break; } }
    }
    nloc = mine > 0u ? mine : 1u; nx = cnt > 0u ? cnt : 1u;
}
DI void xcd_barrier(const XcdBarrier& b) {
    asm volatile("s_waitcnt vmcnt(0)" ::: "memory");
    __syncthreads();
    if (threadIdx.x == 0) {
        unsigned* bar = b.bar;
        __builtin_amdgcn_s_waitcnt(0);
        unsigned nloc = b.st[0], nx = b.st[1];
        if (nloc == 0u) { xcd_barrier_complete(bar, b.x, nloc, nx); b.st[0] = nloc; b.st[1] = nx; }
        const unsigned old = xb_add(&bar[XB_XSUB(b.x)], 1u);
        const unsigned gen = old / nloc;
        if (old + 1u == (gen + 1u) * nloc) {
            __builtin_amdgcn_fence(__ATOMIC_RELEASE, "agent");
            asm volatile("s_waitcnt vmcnt(0)" ::: "memory");
            const unsigned og = xb_add(&bar[XB_TOP], 1u);
            const unsigned tg = og / nx;
            if (og + 1u == (tg + 1u) * nx) xb_add(&bar[XB_TOPGEN], 1u);
            else XB_SPIN(xb_ld(&bar[XB_TOPGEN]) == tg, bar);
            __builtin_amdgcn_fence(__ATOMIC_ACQUIRE, "agent");
            xb_add(&bar[XB_XGEN(b.x)], 1u);
            asm volatile("s_waitcnt vmcnt(0)" ::: "memory");
        } else {
            XB_SPIN(xb_ld(&bar[XB_XGEN(b.x)]) == gen, bar);
            __builtin_amdgcn_fence(__ATOMIC_ACQUIRE, "agent");
            asm volatile("s_waitcnt vmcnt(0)" ::: "memory");
        }
    }
    __syncthreads();
}

struct Args { const float* in[36]; float* out; unsigned char* ws; int st_lo, st_hi; };
struct Frame {
    LAS unsigned char* lds; volatile LAS unsigned* MISC; gu32* ctl;
    int tid, lane, wave, G, bid;
    unsigned char* ws;
};
DI void relaunder(Frame& F, unsigned char* ws0, LAS unsigned char* lds0) {
    int t = threadIdx.x; asm volatile("" : "+v"(t)); F.tid = t; F.lane = t & 63; F.wave = __builtin_amdgcn_readfirstlane(t >> 6);
    unsigned long long w = (unsigned long long)ws0; asm volatile("" : "+s"(w)); F.ws = (unsigned char*)w; F.ctl = (gu32*)(F.ws + WS_CTL);
    unsigned lb = (unsigned)(unsigned long)lds0; asm volatile("" : "+s"(lb)); F.lds = (LAS unsigned char*)(unsigned long)lb; F.MISC = (volatile LAS unsigned*)(F.lds + MISC_OFF);
    int b = blockIdx.x; asm volatile("" : "+s"(b)); F.bid = b;
}
#define XR_SWAP(INS, a, b) asm volatile("s_nop 1\n\t" INS " %0, %1" : "+v"(a), "+v"(b))
DI float xr16_max(float x) { float a = x, b = x; XR_SWAP("v_permlane16_swap_b32", a, b); return fmaxf(a, b); }
DI float xr32_max(float x) { float a = x, b = x; XR_SWAP("v_permlane32_swap_b32", a, b); return fmaxf(a, b); }
DI float xr16_sum(float x) { float a = x, b = x; XR_SWAP("v_permlane16_swap_b32", a, b); return a + b; }
DI float xr32_sum(float x) { float a = x, b = x; XR_SWAP("v_permlane32_swap_b32", a, b); return a + b; }
template <int CTRL> DI float dpp_f(float v) { return __builtin_bit_cast(float, __builtin_amdgcn_update_dpp(0, __builtin_bit_cast(int, v), CTRL, 0xf, 0xf, true)); }
DI float row_sum16(float v) { v += dpp_f<0xB1>(v); v += dpp_f<0x4E>(v); v += dpp_f<0x141>(v); v += dpp_f<0x140>(v); return v; }
DI float wave_sum(float v) { return xr32_sum(xr16_sum(row_sum16(v))); }
DI float wave_sum_dpp(float v) {
    const float t = row_sum16(v);
    const float s0 = __builtin_bit_cast(float, __builtin_amdgcn_readlane(__builtin_bit_cast(int, t), 0));
    const float s1 = __builtin_bit_cast(float, __builtin_amdgcn_readlane(__builtin_bit_cast(int, t), 16));
    const float s2 = __builtin_bit_cast(float, __builtin_amdgcn_readlane(__builtin_bit_cast(int, t), 32));
    const float s3 = __builtin_bit_cast(float, __builtin_amdgcn_readlane(__builtin_bit_cast(int, t), 48));
    return (s0 + s1) + (s2 + s3);
}
constexpr size_t WS_QYT = WS_END;
constexpr size_t WS_CYT = WS_QYT + (size_t)1024 * 4096 * 2;
constexpr size_t WS_TST = WS_CYT + (size_t)1024 * 4096 * 2;
constexpr size_t WS_NST = WS_TST + (size_t)1024 * 4096 * 2;
constexpr size_t WS_S0  = WS_NST + (size_t)1024 * 4096 * 4;
constexpr size_t WS_END2 = WS_S0 + (size_t)1024 * 4096 * 2;
constexpr int ATT_NSUB = 576, ATT_RUN = 16;
constexpr size_t WS_ATAB = WS_END2;
constexpr size_t WS_APO  = WS_ATAB + 8192;
constexpr size_t WS_APM  = WS_APO + (size_t)ATT_NSUB * 32768 * 4;
constexpr size_t WS_RSSA = WS_APM + (size_t)ATT_NSUB * 512 * 4;
constexpr size_t WS_RSSB = WS_RSSA + (size_t)S * 32 * 4;
constexpr size_t WS_END3 = WS_RSSB + (size_t)S * 32 * 4;
constexpr int RTAB_OFF = 131072;
DI int att_slot(int h, int qb, int s) { const int g = qb >> 2; return h * 144 + (g + 1) * (qb - 2 * g) + s; }

DI int map_in(int n) {
    const int T = n >> 8, c = n & 255;
    if (T < 4) { const int base = (T >> 1) * 512, tp = T & 1, half = c >> 7, hs = (c >> 6) & 1, j = c & 63; return base + (2 * tp + hs) * 128 + half * 64 + j; }
    if (T < 6) return 1024 + (T - 4) * 256 + c;
    if (T < 8) return 1536 + (T - 6) * 256 + c;
    if (T < 10) return 2048 + (T - 8) * 256 + c;
    if (T < 14) return 2560 + (T - 10) * 256 + c;
    if (T < 16) return 3592 + (T - 14) * 256 + c;
    if (T == 16) return 4104 + c;
    if (T < 24) return 4424 + (T - 17) * 256 + c;
    if (T < 56) return 6216 + (T - 24) * 256 + c;
    if (c < 8) return 3584 + c;
    if (c < 72) return 4360 + (c - 8);
    return -1;
}
DI int map_fn(int mapid, int n, int Nsrc) {
    if (mapid == 0) return n < Nsrc ? n : -1;
    if (mapid == 1) return map_in(n);
    if (mapid == 2) { const int T = n >> 8, c = n & 255; return c < 128 ? T * 128 + c : DFF + T * 128 + (c - 128); }
    if (mapid == 3) { const int h = n >> 8, c = n & 255; if (c < 96) return h * 192 + c; if (c < 128) return h * 192 + 128 + (c - 96); if (c < 160) return h * 192 + 96 + (c - 128); if (c < 224) return -1; return h * 192 + 160 + (c - 224); }
    return n < 32 ? n : -1;
}
DI void conv_item(const float* W, int K, int Nsrc, bf16* Wt, const float* kscale, int mapid, LAS bf16* tile, int item, int nblk, int lane) {
    const int kb = item / nblk, nb = item - kb * nblk, k0 = 64 * kb, n0 = 64 * nb;
    const int src = map_fn(mapid, n0 + lane, Nsrc);
    const float* wp = W + (size_t)k0 * Nsrc + (src >= 0 ? src : 0);
#pragma unroll
    for (int hf = 0; hf < 2; ++hf) { float v[32];
#pragma unroll
        for (int i = 0; i < 32; ++i) v[i] = wp[(size_t)(32 * hf + i) * Nsrc];
        if (src < 0) {
#pragma unroll
            for (int i = 0; i < 32; ++i) v[i] = 0.f; }
        if (kscale) {
#pragma unroll
            for (int i = 0; i < 32; ++i) v[i] *= kscale[k0 + 32 * hf + i]; }
#pragma unroll
        for (int q = 0; q < 4; ++q) { u32x4 o; o.x = pk2(v[8 * q], v[8 * q + 1]); o.y = pk2(v[8 * q + 2], v[8 * q + 3]); o.z = pk2(v[8 * q + 4], v[8 * q + 5]); o.w = pk2(v[8 * q + 6], v[8 * q + 7]);
            *(LAS u32x4*)(tile + lane * 72 + 32 * hf + 8 * q) = o; } }
    LDS_WAIT(); asm volatile("" ::: "memory");
#pragma unroll
    for (int i = 0; i < 8; ++i) { const int r = i * 8 + (lane >> 3), c8 = lane & 7;
        *(GAS u32x4*)(Wt + (size_t)(n0 + r) * K + k0 + 8 * c8) = *(const LAS u32x4*)(tile + r * 72 + 8 * c8); }
    LDS_WAIT(); asm volatile("" ::: "memory");
}
struct ConvJob { const float* W; bf16* Wt; const float* kscale; int K, Nsrc, Ndst, mapid; };
DI void conv_job(Frame& F, const ConvJob j, int& base) {
    const int nblk = j.Ndst / 64, nitems = (j.K / 64) * nblk, NGW = F.G * NWAVES, gw = F.bid * NWAVES + F.wave;
    int first = (gw - base % NGW + NGW) % NGW; LAS bf16* tile = (LAS bf16*)(F.lds + F.wave * 16384);
    for (int it = first; it < nitems; it += NGW) conv_item(j.W, j.K, j.Nsrc, j.Wt, j.kscale, j.mapid, tile, it, nblk, F.lane);
    base += nitems;
}
DI void p_prologue(Frame& F, const Args& a) {
    unsigned char* ws = F.ws;
    const int gt = F.bid * NTHR + F.tid, NGT = F.G * NTHR;
    if (F.bid == 0 && F.tid == 0) { int* tab = (int*)(ws + WS_ATAB); int n = 0;
        for (int pass = 16; pass >= 4; pass -= 4)
            for (int qb = 31; qb >= 0; --qb) { const int nt = 4 * (qb + 1), nfull = nt >> 4, rem = nt & 15;
                for (int h = 0; h < 4; ++h) {
                    if (pass == 16) { for (int s2 = 0; s2 < nfull; ++s2) tab[n++] = h | (qb << 2) | (s2 << 7) | (16 << 12); }
                    else if (rem == pass) tab[n++] = h | (qb << 2) | (nfull << 7) | (rem << 12); } }
        for (; n < 2048; ++n) tab[n] = 0; }
    { float* prm = (float*)(ws + WS_PRM);
#define CPV(IDX, N, OFF, SRC_L) for (int e = gt; e < (N); e += NGT) prm[(size_t)l * PRM_STRIDE + (OFF) + e] = a.in[IDX][(size_t)(SRC_L) * (N) + e];
      for (int l = 0; l < DEPTH; ++l) {
          CPV(2, 2048, P_N1, l) CPV(33, 2048, P_N2, l) CPV(4, 512, P_GN, l) CPV(5, 4096, P_CW, l) CPV(6, 1024, P_CB, l) CPV(7, 8, P_DTB, l) CPV(8, 8, P_ALOG, l) CPV(9, 8, P_SD, l)
          CPV(10, 512, P_SNW, l) CPV(15, 192, P_QNW, l) CPV(16, 192, P_KNW, l) CPV(17, 1792, P_MU, l) CPV(18, 512, P_W0, l) CPV(20, 512, P_A0, l)
          CPV(23, 512, P_V0, (l > 0 ? l - 1 : 0)) CPV(26, 512, P_KK, l) CPV(27, 512, P_KA, l) CPV(28, 512, P_RK, l) CPV(29, 512, P_LNW, l) CPV(30, 512, P_LNB, l)
      }
#undef CPV
    }
    const int* pos = (const int*)a.in[1];
    for (int e = gt; e < S * 64; e += NGT) { const int t = e >> 6, i = e & 63;
        const float inv = 1.0f / powf(10000.0f, (float)(2 * i) / 128.0f); const float ang = (float)pos[t] * inv;
        double rev = (double)ang * 0.15915494309189535; rev -= rint(rev); const float r = (float)(rev * 6.283185307179586);
        ((float*)(ws + WS_COSR))[e] = __cosf(r); ((float*)(ws + WS_SINR))[e] = __sinf(r); }
    for (int e = gt; e < S * 32; e += NGT) { const int t = e >> 5, i = e & 31;
        const float inv = 1.0f / powf(10000.0f, (float)(2 * i) / 64.0f); const float ang = (float)pos[t] * inv;
        double rev = (double)ang * 0.15915494309189535; rev -= rint(rev); const float r = (float)(rev * 6.283185307179586);
        ((float*)(ws + WS_COSM))[e] = __cosf(r); ((float*)(ws + WS_SINM))[e] = __sinf(r); }
    for (int l = 0; l < DEPTH; ++l) {
        const float* w2 = a.in[19] + (size_t)l * 64 * 512; const float* a2 = a.in[21] + (size_t)l * 64 * 512; const float* g2 = a.in[22] + (size_t)l * 128 * 512;
        const float* v2 = a.in[25] + (size_t)(l > 0 ? l - 1 : 0) * 32 * 512;
        bf16* Lt = (bf16*)(ws + WS_WLORA) + (size_t)l * 2048 * 512;
        for (int w = gt; w < 2048 * 64; w += NGT) { const int kg = w >> 11, n = w & 2047, seg = n >> 9, j = n & 511; float v[8];
#pragma unroll
            for (int i = 0; i < 8; ++i) { const int k = kg * 8 + i; float x = 0.f;
                if (seg == 0) { if (k < 64) x = w2[k * 512 + j]; }
                else if (seg == 1) { if (k >= 128 && k < 192) x = a2[(k - 128) * 512 + j]; }
                else if (seg == 2) { if (k >= 256 && k < 384) x = g2[(k - 256) * 512 + j]; }
                else { if (l > 0 && k >= 384 && k < 416) x = v2[(k - 384) * 512 + j]; }
                v[i] = x; }
            u32x4 o; o.x = pk2(v[0], v[1]); o.y = pk2(v[2], v[3]); o.z = pk2(v[4], v[5]); o.w = pk2(v[6], v[7]);
            *(GAS u32x4*)(Lt + (size_t)n * 512 + kg * 8) = o; }
    }
    { const int gw = F.bid * NWAVES + F.wave, NGW = F.G * NWAVES; float* rss = (float*)(ws + WS_RSSA);
      for (int m = gw; m < S; m += NGW) { const GAS f32x4* xr = (const GAS f32x4*)(a.in[0] + (size_t)m * D) + F.lane; GAS u32x2* o8 = (GAS u32x2*)((bf16*)(ws + WS_XN) + (size_t)m * D) + F.lane; float sq = 0.f;
#pragma unroll
          for (int j = 0; j < 8; ++j) { const f32x4 v = xr[64 * j]; sq += (v.x * v.x + v.y * v.y) + (v.z * v.z + v.w * v.w); u32x2 o; o.x = pk2(v.x, v.y); o.y = pk2(v.z, v.w); o8[64 * j] = o; }
          sq = wave_sum(sq); if (F.lane < 32) rss[(size_t)m * 32 + F.lane] = (F.lane == 0) ? sq : 0.f; } }
    int base = 0;
    for (int l = 0; l < DEPTH; ++l) {
        conv_job(F, ConvJob{a.in[3] + (size_t)l * D * NIN, (bf16*)(ws + WS_WIN) + (size_t)l * NINP * D, a.in[2] + (size_t)l * D, D, NIN, NINP, 1}, base);
        conv_job(F, ConvJob{a.in[34] + (size_t)l * D * 2 * DFF, (bf16*)(ws + WS_WGU) + (size_t)l * 2 * DFF * D, a.in[33] + (size_t)l * D, D, 2 * DFF, 2 * DFF, 2}, base);
        conv_job(F, ConvJob{a.in[35] + (size_t)l * DFF * D, (bf16*)(ws + WS_WDN) + (size_t)l * D * DFF, nullptr, DFF, D, D, 0}, base);
        conv_job(F, ConvJob{a.in[32] + (size_t)l * D * D, (bf16*)(ws + WS_WOUT) + (size_t)l * D * D, nullptr, D, D, D, 0}, base);
        for (int n = 0; n < 4; ++n)
            conv_job(F, ConvJob{a.in[31] + ((size_t)l * 4 + n) * 512 * D, (bf16*)(ws + WS_WBR) + ((size_t)l * 4 + n) * D * 512, nullptr, 512, D, D, 0}, base);
        conv_job(F, ConvJob{a.in[12] + (size_t)l * 512 * 768, (bf16*)(ws + WS_WQB) + (size_t)l * 1024 * 512, a.in[11] + (size_t)l * 512, 512, 768, 1024, 3}, base);
        conv_job(F, ConvJob{a.in[14] + (size_t)l * 256 * 1024, (bf16*)(ws + WS_WKVB) + (size_t)l * 1024 * 256, a.in[13] + (size_t)l * 256, 256, 1024, 1024, 0}, base);
        if (l > 0) conv_job(F, ConvJob{a.in[24] + (size_t)(l - 1) * 512 * 32, (bf16*)(ws + WS_WV1) + (size_t)l * 256 * 512, nullptr, 512, 32, 256, 4}, base);
    }
}

DI void p_rmsnorm(Frame& F, const float* x, const float* w, bf16* out) {
    const int gw = F.bid * NWAVES + F.wave, NGW = F.G * NWAVES;
    for (int m = gw; m < S; m += NGW) {
        const GAS f32x4* xr = (const GAS f32x4*)(x + (size_t)m * D) + F.lane; f32x4 v[8]; float s = 0.f;
#pragma unroll
        for (int j = 0; j < 8; ++j) { v[j] = xr[64 * j]; s += (v[j].x * v[j].x + v[j].y * v[j].y) + (v[j].z * v[j].z + v[j].w * v[j].w); }
        const float rstd = rsqrtf(wave_sum(s) * (1.f / D) + 1e-6f);
        const GAS f32x4* wr = (const GAS f32x4*)w + F.lane;
        GAS u32x2* o8 = (GAS u32x2*)(out + (size_t)m * D) + F.lane;
#pragma unroll
        for (int j = 0; j < 8; ++j) { const f32x4 ww = wr[64 * j]; u32x2 o; o.x = pk2(v[j].x * rstd * ww.x, v[j].y * rstd * ww.y); o.y = pk2(v[j].z * rstd * ww.z, v[j].w * rstd * ww.w); o8[64 * j] = o; }
    }
}

DI void p_rwkv_prep(Frame& F, int l) {
    unsigned char* ws = F.ws;
    const float* RW = (const float*)(ws + WS_RW); const float* prm = (const float*)(ws + WS_PRM) + (size_t)l * PRM_STRIDE; const float* mu = prm + P_MU; const float* kk_w = prm + P_KK;
    const int gw = F.bid * NWAVES + F.wave, NGW = F.G * NWAVES, lane = F.lane;
    for (int t = gw; t < S; t += NGW) {
        const GAS f32x4* p = (const GAS f32x4*)(RW + (size_t)t * 1792) + lane; const GAS f32x4* pp = (const GAS f32x4*)(RW + (size_t)(t > 0 ? t - 1 : 0) * 1792) + lane;
        const GAS f32x4* m4 = (const GAS f32x4*)mu + lane;
        f32x4 pm[7];
#pragma unroll
        for (int j = 0; j < 7; ++j) { const f32x4 c = p[64 * j]; f32x4 pv = pp[64 * j]; if (t == 0) pv = (f32x4){0.f, 0.f, 0.f, 0.f}; pm[j] = c + (pv - c) * m4[64 * j]; }
        *((GAS f32x4*)((float*)(ws + WS_R32) + (size_t)t * 512) + lane) = pm[0]; *((GAS f32x4*)((float*)(ws + WS_R32) + (size_t)t * 512) + 64 + lane) = pm[1];
#pragma unroll
        for (int j = 0; j < 2; ++j) { const f32x4 k = pm[2 + j]; const f32x4 kw = *((const GAS f32x4*)kk_w + 64 * j + lane); const f32x4 kk = k * kw;
            float ss = (kk.x * kk.x + kk.y * kk.y) + (kk.z * kk.z + kk.w * kk.w);
            ss = row_sum16(ss);
            const float inv = fminf(__builtin_amdgcn_rsqf(ss), 1e12f);
            *((GAS f32x4*)((float*)(ws + WS_K32) + (size_t)t * 512) + 64 * j + lane) = k;
            *((GAS f32x4*)((float*)(ws + WS_KKN) + (size_t)t * 512) + 64 * j + lane) = kk * inv; }
#pragma unroll
        for (int j = 0; j < 2; ++j) { const f32x4 v = pm[4 + j];
            *((GAS f32x4*)((float*)(ws + WS_VV) + (size_t)t * 512) + 64 * j + lane) = v;
            if (l == 0) *((GAS f32x4*)((float*)(ws + WS_VFIRST) + (size_t)t * 512) + 64 * j + lane) = v;
            u32x2 o; o.x = pk2(v.x, v.y); o.y = pk2(v.z, v.w); *((GAS u32x2*)((bf16*)(ws + WS_VB) + (size_t)t * 512) + 64 * j + lane) = o; }
        { const f32x4 x = pm[6]; f32x4 y; int dst;
            if (lane < 16) { y = (f32x4){ftanh_(x.x), ftanh_(x.y), ftanh_(x.z), ftanh_(x.w)}; dst = 4 * lane; }
            else if (lane < 32) { y = x; dst = 128 + 4 * (lane - 16); }
            else { y = (f32x4){sigmoidf_(x.x), sigmoidf_(x.y), sigmoidf_(x.z), sigmoidf_(x.w)}; dst = 256 + 4 * (lane - 32); }
            bf16* ar = (bf16*)(ws + WS_ALORA) + (size_t)t * 512;
            u32x2 o; o.x = pk2(y.x, y.y); o.y = pk2(y.z, y.w); *(GAS u32x2*)(ar + dst) = o;
            const int z = 4 * lane; const int zd = z < 64 ? 64 + z : (z < 128 ? 192 + (z - 64) : 384 + (z - 128));
            unsigned zz = 0u; asm volatile("" : "+v"(zz));
            *(GAS u32x2*)(ar + zd) = (u32x2){zz, zz}; }
    }
}

DI void p_mamba_prep(Frame& F, int l) {
    unsigned char* ws = F.ws;
    const bf16* XBC = (const bf16*)(ws + WS_XBC); bf16* XC = (bf16*)(ws + WS_XC);
    const float* prm = (const float*)(ws + WS_PRM) + (size_t)l * PRM_STRIDE; const float* cw = prm + P_CW; const float* cb = prm + P_CB;
    for (int u = F.bid; u < 2 * NCH; u += F.G) {
        const int c = u >> 1, ch = (u & 1) * 512 + F.tid; const int t0 = c * 64;
        float w0[4];
#pragma unroll
        for (int k = 0; k < 4; ++k) w0[k] = cw[k * 1024 + ch];
        const float b0 = cb[ch];
        float h0[3];
#pragma unroll
        for (int k = 0; k < 3; ++k) { const int t = t0 - 3 + k; h0[k] = (t >= 0) ? bf2f(XBC[(size_t)t * 1024 + ch]) : 0.f; }
#pragma unroll 16
        for (int i = 0; i < 64; ++i) { const int t = t0 + i; const float x0 = bf2f(XBC[(size_t)t * 1024 + ch]);
            const float y0 = b0 + w0[0] * h0[0] + w0[1] * h0[1] + w0[2] * h0[2] + w0[3] * x0;
            h0[0] = h0[1]; h0[1] = h0[2]; h0[2] = x0;
            XC[(size_t)t * 1024 + ch] = (bf16)f2bf(siluf_(y0)); }
    }
}
DI void u_mamba_dt(Frame& F, int l, int c) {
    unsigned char* ws = F.ws; LAS float* A = (LAS float*)F.lds;
    const float* prm = (const float*)(ws + WS_PRM) + (size_t)l * PRM_STRIDE; const int t = F.tid >> 3, h = F.tid & 7; const size_t row = (size_t)(c * 64 + t);
    const float dt = softplusf_(((const float*)(ws + WS_MISC))[row * 256 + h] + prm[P_DTB + h]);
    A[F.tid] = dt * -fexp_(prm[P_ALOG + h]);
    ((float*)(ws + WS_DTS))[row * 8 + h] = dt;
    __syncthreads();
    float cs = 0.f;
#pragma unroll 16
    for (int tt = 0; tt < 64; ++tt) { const float v = A[tt * 8 + h]; cs += (tt <= t) ? v : 0.f; }
    ((float*)(ws + WS_ACS))[row * 8 + h] = cs;
    __syncthreads();
}

DI void p_scans(Frame& F, int nblk) {
    unsigned char* ws = F.ws;
    if (F.tid >= 128) return;
    const int gt = F.bid * 128 + F.tid, NGT = nblk * 128;
    for (int q = gt; q < 32768; q += NGT) {
        const int e = q * 4; const bool ret = e < 65536; const int e2 = ret ? e : e - 65536, h = ret ? (e >> 14) : (e2 >> 13);
        float* p = (float*)(ws + (ret ? WS_RKV : WS_MST)) + e2; const float* acs = (const float*)(ws + WS_ACS);
        const float rdec = fexp_(log1pf(-exp2f(-5.0f - (float)h)) * 64.0f);
        f32x4 st = (f32x4){0.f, 0.f, 0.f, 0.f};
#pragma unroll 1
        for (int c0 = 0; c0 < NCH; c0 += 16) { f32x4 v[16]; float dc[16];
#pragma unroll
            for (int i = 0; i < 16; ++i) v[i] = *(const GAS f32x4*)(p + (size_t)(c0 + i) * 65536);
#pragma unroll
            for (int i = 0; i < 16; ++i) dc[i] = ret ? rdec : fexp_(acs[(size_t)((c0 + i) * 64 + 63) * 8 + h]);
#pragma unroll
            for (int i = 0; i < 16; ++i) { *(GAS f32x4*)(p + (size_t)(c0 + i) * 65536) = st; st = st * dc[i] + v[i]; } }
    }
}

DI void p_rwkv_scan(Frame& F, int nblk) {
    unsigned char* ws = F.ws;
    const int w = F.bid * NWAVES + F.wave; if (F.bid >= nblk) return;
    const int h = w >> 6, i = w & 63, lane = F.lane;
    const float* Ap = (const float*)(ws + WS_KKN) + h * 64 + lane; const float* Wp = (const float*)(ws + WS_DEC) + h * 64 + lane; const float* Bp = (const float*)(ws + WS_BB) + h * 64 + lane;
    const float* Kp = (const float*)(ws + WS_KP) + h * 64 + lane; const float* Rp = (const float*)(ws + WS_R32) + h * 64 + lane; const float* Vp = (const float*)(ws + WS_VV) + h * 64 + i;
    float* Yp = (float*)(ws + WS_Y32) + h * 64 + i;
    float s = 0.f;
    constexpr int U = 8;
    float ca[U], cw[U], cb[U], ck[U], cr[U], cv[U];
#pragma unroll
    for (int u = 0; u < U; ++u) { const size_t o = (size_t)u * 512; ca[u] = Ap[o]; cw[u] = Wp[o]; cb[u] = Bp[o]; ck[u] = Kp[o]; cr[u] = Rp[o]; cv[u] = Vp[o]; }
    for (int t0 = 0; t0 < S; t0 += U) {
        float na[U], nw[U], nb[U], nk[U], nr[U], nv[U];
        const int tn = (t0 + U < S) ? t0 + U : t0;
#pragma unroll
        for (int u = 0; u < U; ++u) { const size_t o = (size_t)(tn + u) * 512; na[u] = Ap[o]; nw[u] = Wp[o]; nb[u] = Bp[o]; nk[u] = Kp[o]; nr[u] = Rp[o]; nv[u] = Vp[o]; }
        float ys[U];
#pragma unroll
        for (int u = 0; u < U; ++u) {
            const float sa = wave_sum_dpp(s * (-ca[u]));
            s = s * cw[u] + sa * cb[u] + cv[u] * ck[u];
            ys[u] = wave_sum_dpp(s * cr[u]);
        }
        if (lane < U) { float y = ys[0];
#pragma unroll
            for (int u = 1; u < U; ++u) y = (lane == u) ? ys[u] : y;
            Yp[(size_t)(t0 + lane) * 512] = y; }
#pragma unroll
        for (int u = 0; u < U; ++u) { ca[u] = na[u]; cw[u] = nw[u]; cb[u] = nb[u]; ck[u] = nk[u]; cr[u] = nr[u]; cv[u] = nv[u]; }
    }
}

DI void p_rwkv_post(Frame& F, int l) {
    unsigned char* ws = F.ws;
    const float* prm = (const float*)(ws + WS_PRM) + (size_t)l * PRM_STRIDE; const float* lnw = prm + P_LNW; const float* lnb = prm + P_LNB; const float* rk = prm + P_RK;
    const int gw = F.bid * NWAVES + F.wave, NGW = F.G * NWAVES, lane = F.lane;
    for (int t = gw; t < S; t += NGW) {
#pragma unroll
        for (int j = 0; j < 2; ++j) {
            const size_t o = (size_t)t * 512 / 4 + 64 * j + lane;
            const f32x4 y = ((const GAS f32x4*)(ws + WS_Y32))[o], r = ((const GAS f32x4*)(ws + WS_R32))[o], k = ((const GAS f32x4*)(ws + WS_KP))[o], v = ((const GAS f32x4*)(ws + WS_VV))[o], g = ((const GAS f32x4*)(ws + WS_G32))[o];
            const f32x4 w4 = ((const GAS f32x4*)lnw)[64 * j + lane], b4 = ((const GAS f32x4*)lnb)[64 * j + lane], rk4 = ((const GAS f32x4*)rk)[64 * j + lane];
            float sm = (y.x + y.y) + (y.z + y.w);
            sm = row_sum16(sm);
            const float mean = sm * (1.f / 64.f); const f32x4 d = y - mean;
            float q = (d.x * d.x + d.y * d.y) + (d.z * d.z + d.w * d.w);
            q = row_sum16(q);
            const float rstd = rsqrtf(q * (1.f / 64.f) + 64e-5f);
            const f32x4 rkk = r * k * rk4; float bs = (rkk.x + rkk.y) + (rkk.z + rkk.w);
            bs = row_sum16(bs);
            const f32x4 o4 = (d * rstd * w4 + b4 + bs * v) * g;
            u32x2 ob; ob.x = pk2(o4.x, o4.y); ob.y = pk2(o4.z, o4.w);
            *((GAS u32x2*)((bf16*)(ws + WS_OB) + (size_t)t * D + 1536) + 64 * j + lane) = ob;
        }
    }
}

namespace pg8 {
DI unsigned char* lw(unsigned char* p) { unsigned long long w = (unsigned long long)p; asm volatile("" : "+s"(w)); return (unsigned char*)w; }
DI void st8bf(bf16* p, const f32x4 a, const f32x4 b) { *(GAS u32x4*)p = pack8(a, b); }
DI void st8f(float* p, const f32x4 a, const f32x4 b) { *(GAS f32x4*)p = a; *((GAS f32x4*)p + 1) = b; }
DI f32x4 map4(const f32x4 v, float (*f)(float)) { return (f32x4){f(v.x), f(v.y), f(v.z), f(v.w)}; }

DI void scale_rows(Acc& acc, const LAS float* rt, int rl0) {
#pragma unroll
    for (int ai = 0; ai < 2; ++ai)
#pragma unroll
        for (int m = 0; m < 4; ++m) { const float rs = rt[rl0 + ai * HALF + m * 16];
#pragma unroll
            for (int bj = 0; bj < 2; ++bj)
#pragma unroll
                for (int n = 0; n < 2; ++n) acc[ai][bj][m][n] = acc[ai][bj][m][n] * rs; }
}
template <class Sched> DI void fill_rstd(LAS float* rtab, const float* rss, const Sched& Sc, int tid) {
    pg8::Unit u;
    for (int i = 0; Sc.next(i, u); ++i) if (tid < 256) { const float* p = rss + (size_t)(u.pm * BM + tid) * 32; float s = 0.f;
#pragma unroll
        for (int q = 0; q < 8; ++q) { const f32x4 v = *(const GAS f32x4*)(p + 4 * q); s += (v.x + v.y) + (v.z + v.w); }
        rtab[i * 256 + tid] = rsqrtf(s * (1.f / D) + 1e-6f); }
    __syncthreads();
}
struct TileDesc { unsigned long long off; int ld, cb, kind, slot; };
constexpr TileDesc mk_tile(int T) {
    return T < 2 ? TileDesc{WS_QR, 512, 0, 0, 0} : T < 4 ? TileDesc{WS_KR, 512, 0, 1, 0}
         : T < 6 ? TileDesc{WS_VR, 512, (T - 4) * 256, 2, 0} : T < 8 ? TileDesc{WS_GR, 512, (T - 6) * 256, 3, 0} : T < 10 ? TileDesc{WS_ZS, 512, (T - 8) * 256, 3, 0}
         : T < 14 ? TileDesc{WS_XBC, 1024, (T - 10) * 256, 2, 0} : T < 16 ? TileDesc{WS_CQ, 512, (T - 14) * 256, 5, (T - 14) * 4} : T == 16 ? TileDesc{WS_CKV, 256, 0, 5, 8}
         : T < 24 ? TileDesc{WS_RW, 1792, (T - 17) * 256, 6, 0} : T < 56 ? TileDesc{WS_GATE, 8192, (T - 24) * 256, 4, 0} : TileDesc{WS_MISC, 256, 0, 6, 0};
}
struct TileTab { TileDesc d[57]; };
constexpr TileTab mk_tiletab() { TileTab t{}; for (int i = 0; i < 57; ++i) t.d[i] = mk_tile(i); return t; }
__constant__ TileTab g_tiletab = mk_tiletab();

struct EpiIn {
    static constexpr bool AFTER_DRAIN = false;
    unsigned char* ws_; int tile_off; const LAS float* rtab;
    DI bool operator()(Acc& acc, const Unit& u, int wr, int wc, int fr, int fq) const {
        unsigned char* ws = lw(ws_);
        const int T = u.pn + tile_off, row0 = u.pm * BM + wr * 64 + fr, c0 = wc * 32 + fq * 8;
        scale_rows(acc, rtab + u.ord * 256, wr * 64 + fr);
        const TileDesc d = g_tiletab.d[T]; const int kind = d.kind;
        if (kind < 2) {
            const int head = 2 * (T & 1) + (c0 >> 6), j0 = c0 & 63; const float sc = kind ? 0.08838834764831845f : 1.0f;
            bf16* dst = (bf16*)(ws + d.off); const float* cs = (const float*)(ws + WS_COSR); const float* sn = (const float*)(ws + WS_SINR);
#pragma unroll
            for (int ai = 0; ai < 2; ++ai)
#pragma unroll
                for (int m = 0; m < 4; ++m) { const int row = row0 + ai * HALF + m * 16;
                    const f32x4 ca = *(const GAS f32x4*)(cs + (size_t)row * 64 + j0), cb = *(const GAS f32x4*)(cs + (size_t)row * 64 + j0 + 4);
                    const f32x4 sa = *(const GAS f32x4*)(sn + (size_t)row * 64 + j0), sb = *(const GAS f32x4*)(sn + (size_t)row * 64 + j0 + 4);
                    const f32x4 x1a = acc[ai][0][m][0], x1b = acc[ai][0][m][1], x2a = acc[ai][1][m][0], x2b = acc[ai][1][m][1];
                    bf16* o = dst + (size_t)row * 512 + head * 128 + j0;
                    st8bf(o, (x1a * ca - x2a * sa) * sc, (x1b * cb - x2b * sb) * sc);
                    st8bf(o + 64, (x2a * ca + x1a * sa) * sc, (x2b * cb + x1b * sb) * sc); }
            return true;
        }
        if (kind == 6) {
            float* dst = (float*)(ws + d.off) + d.cb + c0;
#pragma unroll
            for (int ai = 0; ai < 2; ++ai)
#pragma unroll
                for (int m = 0; m < 4; ++m) { const int row = row0 + ai * HALF + m * 16;
#pragma unroll
                    for (int bj = 0; bj < 2; ++bj) st8f(dst + (size_t)row * d.ld + bj * HALF, acc[ai][bj][m][0], acc[ai][bj][m][1]); }
            return true;
        }
        {
            bf16* dst = (bf16*)(ws + d.off) + d.cb + c0; float* ssq = (float*)(ws + WS_SSQ) + d.slot + wc;
            const float am = (kind == 3 || kind == 4) ? 1.f : 0.f, xm = (kind == 4) ? 0.f : 1.f;
#pragma unroll
            for (int ai = 0; ai < 2; ++ai)
#pragma unroll
                for (int m = 0; m < 4; ++m) { const int row = row0 + ai * HALF + m * 16; float ss = 0.f;
#pragma unroll
                    for (int bj = 0; bj < 2; ++bj) { f32x4 a = acc[ai][bj][m][0], b = acc[ai][bj][m][1];
                        ss += (a.x * a.x + a.y * a.y) + (a.z * a.z + a.w * a.w) + (b.x * b.x + b.y * b.y) + (b.z * b.z + b.w * b.w);
                        if (am != 0.f) {
#pragma unroll
                            for (int i = 0; i < 4; ++i) { const float s0 = sigmoidf_(a[i]), s1 = sigmoidf_(b[i]); a[i] = (xm != 0.f) ? a[i] * s0 : s0; b[i] = (xm != 0.f) ? b[i] * s1 : s1; } }
                        st8bf(dst + (size_t)row * d.ld + bj * HALF, a, b); }
                    if (kind == 5) { ss = xr32_sum(xr16_sum(ss)); if (fq == 0) ssq[(size_t)row * 16] = ss; } }
        }
        return true;
    }
};

struct EpiMisc {
    static constexpr bool AFTER_DRAIN = false;
    unsigned char* ws_; const LAS float* rtab;
    DI bool operator()(Acc& acc, const Unit& u, int wr, int wc, int fr, int fq) const {
        float* dst = (float*)(lw(ws_) + WS_MISC) + wc * 32 + fq * 8; const int row0 = u.pm * BM + wr * 64 + fr;
        scale_rows(acc, rtab + u.ord * 256, wr * 64 + fr);
#pragma unroll
        for (int ai = 0; ai < 2; ++ai)
#pragma unroll
            for (int m = 0; m < 4; ++m) { const int row = row0 + ai * HALF + m * 16;
#pragma unroll
                for (int bj = 0; bj < 2; ++bj) st8f(dst + (size_t)row * 256 + bj * HALF, acc[ai][bj][m][0], acc[ai][bj][m][1]); }
        return true;
    }
};

struct EpiQb {
    static constexpr bool AFTER_DRAIN = true;
    unsigned char* ws; const float* qnw;
    DI bool operator()(Acc&, const Unit&, int, int, int, int) const { return true; }
    DI void fused(Acc& acc, const Unit& u, int wr, int wc, int fr, int fq, LAS unsigned char* lds, int wid, int lane, int tid) const {
        const int h = u.pn, row0 = u.pm * BM + wr * 64 + fr, c0 = wc * 32 + fq * 8;
        const float* ssq = (const float*)(ws + WS_SSQ); LAS float* P = (LAS float*)lds;
        const float QS = 0.07216878364870322f * LOG2E;
#pragma unroll
        for (int ai = 0; ai < 2; ++ai)
#pragma unroll
            for (int m = 0; m < 4; ++m) { const int row = row0 + ai * HALF + m * 16, rl = ai * HALF + wr * 64 + m * 16 + fr;
                const f32x4 s0 = *(const GAS f32x4*)(ssq + (size_t)row * 16), s1 = *(const GAS f32x4*)(ssq + (size_t)row * 16 + 4);
                const float rs = rsqrtf(((s0.x + s0.y) + (s0.z + s0.w) + (s1.x + s1.y) + (s1.z + s1.w)) * (1.f / 512.f) + 1e-6f);
                float ss = 0.f;
#pragma unroll
                for (int bj = 0; bj < 2; ++bj)
#pragma unroll
                    for (int n = 0; n < 2; ++n) { f32x4 a = acc[ai][bj][m][n] * rs; acc[ai][bj][m][n] = a; ss += (a.x * a.x + a.y * a.y) + (a.z * a.z + a.w * a.w); }
                ss = xr32_sum(xr16_sum(ss));
                if (fq == 0) P[rl * 4 + wc] = ss; }
        __syncthreads();
        bf16* QM = (bf16*)(ws + WS_QM); const float* cs = (const float*)(ws + WS_COSM); const float* sn = (const float*)(ws + WS_SINM);
#pragma unroll
        for (int ai = 0; ai < 2; ++ai)
#pragma unroll
            for (int m = 0; m < 4; ++m) { const int row = row0 + ai * HALF + m * 16, rl = ai * HALF + wr * 64 + m * 16 + fr;
                const f32x4 pp = *(const LAS f32x4*)(P + rl * 4); const float rq = rsqrtf(((pp.x + pp.y) + (pp.z + pp.w)) * (1.f / 192.f) + 1e-6f) * QS;
                bf16* o = QM + (size_t)row * 768 + h * 192;
                if (wc < 3) {
                    const f32x4 wa = *(const GAS f32x4*)(qnw + c0), wb = *(const GAS f32x4*)(qnw + c0 + 4);
                    st8bf(o + c0, acc[ai][0][m][0] * rq * wa, acc[ai][0][m][1] * rq * wb);
                    if (wc == 0) { const f32x4 wc4 = *(const GAS f32x4*)(qnw + 96 + c0), wd = *(const GAS f32x4*)(qnw + 100 + c0);
                        st8bf(o + 96 + c0, acc[ai][1][m][0] * rq * wc4, acc[ai][1][m][1] * rq * wd); }
                } else {
                    const int i0 = 8 * fq;
                    const f32x4 w1a = *(const GAS f32x4*)(qnw + 128 + i0), w1b = *(const GAS f32x4*)(qnw + 132 + i0), w2a = *(const GAS f32x4*)(qnw + 160 + i0), w2b = *(const GAS f32x4*)(qnw + 164 + i0);
                    const f32x4 ca = *(const GAS f32x4*)(cs + (size_t)row * 32 + i0), cb = *(const GAS f32x4*)(cs + (size_t)row * 32 + i0 + 4), sa = *(const GAS f32x4*)(sn + (size_t)row * 32 + i0), sb = *(const GAS f32x4*)(sn + (size_t)row * 32 + i0 + 4);
                    const f32x4 x1a = acc[ai][0][m][0] * rq * w1a, x1b = acc[ai][0][m][1] * rq * w1b, x2a = acc[ai][1][m][0] * rq * w2a, x2b = acc[ai][1][m][1] * rq * w2b;
                    st8bf(o + 128 + i0, x1a * ca - x2a * sa, x1b * cb - x2b * sb);
                    st8bf(o + 160 + i0, x2a * ca + x1a * sa, x2b * cb + x1b * sb);
                } }
        __syncthreads();
    }
};

struct EpiKvb {
    static constexpr bool AFTER_DRAIN = true;
    unsigned char* ws; const float* knw;
    DI bool operator()(Acc&, const Unit&, int, int, int, int) const { return true; }
    DI void fused(Acc& acc, const Unit& u, int wr, int wc, int fr, int fq, LAS unsigned char* lds, int wid, int lane, int tid) const {
        const int h = u.pn, row0 = u.pm * BM + wr * 64 + fr, c0 = wc * 32 + fq * 8;
        const float* ssq = (const float*)(ws + WS_SSQ); const float* misc = (const float*)(ws + WS_MISC);
        LAS float* P = (LAS float*)lds; LAS float* KRS = P + 1024; LAS float* RK = P + 1280;
        if (tid < 256) { const float* kr = misc + (size_t)(u.pm * BM + tid) * 256 + 8; float s = 0.f;
#pragma unroll
            for (int i = 0; i < 16; ++i) { const f32x4 v = *(const GAS f32x4*)(kr + 4 * i); s += (v.x * v.x + v.y * v.y) + (v.z * v.z + v.w * v.w); }
            KRS[tid] = s; }
#pragma unroll
        for (int ai = 0; ai < 2; ++ai)
#pragma unroll
            for (int m = 0; m < 4; ++m) { const int row = row0 + ai * HALF + m * 16, rl = ai * HALF + wr * 64 + m * 16 + fr;
                const f32x4 s0 = *(const GAS f32x4*)(ssq + (size_t)row * 16 + 8);
                const float rs = rsqrtf(((s0.x + s0.y) + (s0.z + s0.w)) * (1.f / 256.f) + 1e-6f);
                float ss = 0.f;
#pragma unroll
                for (int bj = 0; bj < 2; ++bj)
#pragma unroll
                    for (int n = 0; n < 2; ++n) { f32x4 a = acc[ai][bj][m][n] * rs; acc[ai][bj][m][n] = a; if (bj == 0) ss += (a.x * a.x + a.y * a.y) + (a.z * a.z + a.w * a.w); }
                ss = xr32_sum(xr16_sum(ss));
                if (fq == 0) P[rl * 4 + wc] = ss; }
        __syncthreads();
        if (tid < 256) { const f32x4 pp = *(const LAS f32x4*)(P + tid * 4); RK[tid] = rsqrtf(((pp.x + pp.y) + (pp.z + pp.w) + KRS[tid]) * (1.f / 192.f) + 1e-6f); }
        __syncthreads();
        bf16* KM = (bf16*)(ws + WS_KM); bf16* VT = (bf16*)(ws + WS_VT);
        const f32x4 wa = *(const GAS f32x4*)(knw + c0), wb = *(const GAS f32x4*)(knw + c0 + 4);
#pragma unroll
        for (int ai = 0; ai < 2; ++ai)
#pragma unroll
            for (int m = 0; m < 4; ++m) { const int row = row0 + ai * HALF + m * 16, rl = ai * HALF + wr * 64 + m * 16 + fr;
                const float rk = RK[rl];
                st8bf(KM + (size_t)row * 768 + h * 192 + c0, acc[ai][0][m][0] * rk * wa, acc[ai][0][m][1] * rk * wb);
#pragma unroll
                for (int n = 0; n < 2; ++n)
#pragma unroll
                    for (int i = 0; i < 4; ++i) VT[(size_t)(h * 128 + c0 + n * 4 + i) * S + row] = (bf16)f2bf(acc[ai][1][m][n][i]); }
        {
            const int rl = tid >> 1, hf = tid & 1, row = u.pm * BM + rl, i0 = 16 * hf; const float rk = RK[rl];
            const float* kr = misc + (size_t)row * 256 + 8; const float* cs = (const float*)(ws + WS_COSM) + (size_t)row * 32; const float* sn = (const float*)(ws + WS_SINM) + (size_t)row * 32;
            bf16* o = KM + (size_t)row * 768 + h * 192 + 128;
#pragma unroll
            for (int q = 0; q < 2; ++q) { f32x4 o1[2], o2[2];
#pragma unroll
                for (int e = 0; e < 2; ++e) { const int i = i0 + 8 * q + 4 * e;
                    const f32x4 x1 = *(const GAS f32x4*)(kr + i) * *(const GAS f32x4*)(knw + 128 + i), x2 = *(const GAS f32x4*)(kr + 32 + i) * *(const GAS f32x4*)(knw + 160 + i);
                    const f32x4 c = *(const GAS f32x4*)(cs + i), s = *(const GAS f32x4*)(sn + i);
                    o1[e] = (x1 * c - x2 * s) * rk; o2[e] = (x2 * c + x1 * s) * rk; }
                st8bf(o + i0 + 8 * q, o1[0], o1[1]); st8bf(o + 32 + i0 + 8 * q, o2[0], o2[1]); }
        }
        __syncthreads();
    }
};

struct EpiV1 {
    static constexpr bool AFTER_DRAIN = false;
    unsigned char* ws_;
    DI bool operator()(Acc& acc, const Unit& u, int wr, int wc, int fr, int fq) const {
        if (wc != 0) return true;
        unsigned char* ws = lw(ws_);
        const int row0 = u.pm * BM + wr * 64 + fr; bf16* dst = (bf16*)(ws + WS_ALORA);
#pragma unroll
        for (int ai = 0; ai < 2; ++ai)
#pragma unroll
            for (int m = 0; m < 4; ++m) { const int row = row0 + ai * HALF + m * 16; st8bf(dst + (size_t)row * 512 + 384 + fq * 8, acc[ai][0][m][0], acc[ai][0][m][1]); }
        return true;
    }
};

struct EpiLora {
    static constexpr bool AFTER_DRAIN = false;
    unsigned char* ws_; const float* w0; const float* a0; const float* v0; const float* ka;
#define LORA_LOOP(BODY) _Pragma("unroll") for (int ai = 0; ai < 2; ++ai) _Pragma("unroll") for (int m = 0; m < 4; ++m) { const size_t ro = (size_t)(row0 + ai * HALF + m * 16) * 512; \
        _Pragma("unroll") for (int bj = 0; bj < 2; ++bj) _Pragma("unroll") for (int n = 0; n < 2; ++n) { const int j = jb + bj * HALF + n * 4; const size_t o = ro + j; const f32x4 x = acc[ai][bj][m][n]; BODY } }
    DI bool operator()(Acc& acc, const Unit& u, int wr, int wc, int fr, int fq) const {
        unsigned char* ws = lw(ws_);
        const int seg = u.pn >> 1, row0 = u.pm * BM + wr * 64 + fr, jb = (u.pn & 1) * 256 + wc * 32 + fq * 8;
        if (seg == 0) { float* dec = (float*)(ws + WS_DEC);
            LORA_LOOP({ const f32x4 b = *(const GAS f32x4*)(w0 + j); f32x4 r;
                _Pragma("unroll") for (int i = 0; i < 4; ++i) { const float u_ = b[i] + x[i]; const float sp = fmaxf(-u_, 0.f) + __logf(1.0f + fexp_(-fabsf(u_))); r[i] = -fexp_(-sp - 0.5f); }
                *(GAS f32x4*)(dec + o) = r; })
        } else if (seg == 1) { const float* k32 = (const float*)(ws + WS_K32); const float* kkn_ = (const float*)(ws + WS_KKN); float* kp_ = (float*)(ws + WS_KP); float* bb_ = (float*)(ws + WS_BB);
            LORA_LOOP({ const f32x4 b = *(const GAS f32x4*)(a0 + j); const f32x4 kav = *(const GAS f32x4*)(ka + j);
                const f32x4 k = *(const GAS f32x4*)(k32 + o); const f32x4 kkn = *(const GAS f32x4*)(kkn_ + o); f32x4 kp; f32x4 bb;
                _Pragma("unroll") for (int i = 0; i < 4; ++i) { const float av = sigmoidf_(b[i] + x[i]); kp[i] = k[i] * (1.0f + (av - 1.0f) * kav[i]); bb[i] = kkn[i] * av; }
                *(GAS f32x4*)(kp_ + o) = kp; *(GAS f32x4*)(bb_ + o) = bb; })
        } else if (seg == 2) { float* g32 = (float*)(ws + WS_G32);
            LORA_LOOP({ *(GAS f32x4*)(g32 + o) = x; })
        } else { float* vv = (float*)(ws + WS_VV); const float* vf_ = (const float*)(ws + WS_VFIRST);
            LORA_LOOP({ const f32x4 b = *(const GAS f32x4*)(v0 + j); const f32x4 v = *(const GAS f32x4*)(vv + o); const f32x4 vf = *(const GAS f32x4*)(vf_ + o); f32x4 r;
                _Pragma("unroll") for (int i = 0; i < 4; ++i) r[i] = v[i] + (vf[i] - v[i]) * sigmoidf_(b[i] + x[i]);
                *(GAS f32x4*)(vv + o) = r; })
        }
        return true;
    }
#undef LORA_LOOP
};

struct EpiBranch {
    static constexpr bool AFTER_DRAIN = false;
    unsigned char* ws_;
    DI bool operator()(Acc& acc, const Unit& u, int wr, int wc, int fr, int fq) const {
        unsigned char* ws = lw(ws_);
        const int nb = u.sub, row0 = u.pm * BM + wr * 64 + fr, cb = u.pn * BM + wc * 32 + fq * 8;
        const bf16* G = (const bf16*)(ws + WS_GATE); bf16* M = (bf16*)(ws + WS_MERGED);
#pragma unroll
        for (int ai = 0; ai < 2; ++ai)
#pragma unroll
            for (int m = 0; m < 4; ++m) { const int row = row0 + ai * HALF + m * 16;
#pragma unroll
                for (int bj = 0; bj < 2; ++bj) { const int col = cb + bj * HALF;
                    float g[8]; unpack8(*(const GAS u32x4*)(G + (size_t)row * 8192 + nb * D + col), g);
                    if (nb < 3) { float gn[8]; unpack8(*(const GAS u32x4*)(G + (size_t)row * 8192 + (nb + 1) * D + col), gn);
#pragma unroll
                        for (int i = 0; i < 8; ++i) g[i] = fmaxf(g[i], 1e-30f) * __builtin_amdgcn_rcpf(fmaxf(gn[i], 1e-30f)); }
                    else {
#pragma unroll
                        for (int i = 0; i < 8; ++i) g[i] = fmaxf(g[i], 1e-30f); }
                    f32x4 a = acc[ai][bj][m][0], b = acc[ai][bj][m][1];
                    a = a * (f32x4){g[0], g[1], g[2], g[3]}; b = b * (f32x4){g[4], g[5], g[6], g[7]};
                    if (nb < 3) { acc[ai][bj][m][0] = a; acc[ai][bj][m][1] = b; } else st8bf(M + (size_t)row * D + col, a, b); } }
        return nb == 3;
    }
};

struct EpiRes {
    static constexpr bool AFTER_DRAIN = false;
    const float* xin; float* out; bf16* xb; float* rss;
    DI bool operator()(Acc& acc, const Unit& u, int wr, int wc, int fr, int fq) const {
        const int row0 = u.pm * BM + wr * 64 + fr, cb = u.pn * BM + wc * 32 + fq * 8;
#pragma unroll
        for (int ai = 0; ai < 2; ++ai)
#pragma unroll
            for (int m = 0; m < 4; ++m) { const int row = row0 + ai * HALF + m * 16; float ss = 0.f;
#pragma unroll
                for (int bj = 0; bj < 2; ++bj) { const size_t o = (size_t)row * D + cb + bj * HALF;
                    const f32x4 a = *(const GAS f32x4*)(xin + o) + acc[ai][bj][m][0], b = *(const GAS f32x4*)(xin + o + 4) + acc[ai][bj][m][1];
                    st8f(out + o, a, b); st8bf(xb + o, a, b);
                    ss += (a.x * a.x + a.y * a.y) + (a.z * a.z + a.w * a.w) + (b.x * b.x + b.y * b.y) + (b.z * b.z + b.w * b.w); }
                if (rss) { ss = xr32_sum(xr16_sum(ss)); if (fq == 0) rss[(size_t)row * 32 + u.pn * 4 + wc] = ss; } }
        return true;
    }
};

struct EpiGu {
    static constexpr bool AFTER_DRAIN = false;
    unsigned char* ws_; const LAS float* rtab;
    DI bool operator()(Acc& acc, const Unit& u, int wr, int wc, int fr, int fq) const {
        unsigned char* ws = lw(ws_);
        scale_rows(acc, rtab + u.ord * 256, wr * 64 + fr);
        const int row0 = u.pm * BM + wr * 64 + fr, cb = u.pn * 128 + wc * 32 + fq * 8; bf16* A = (bf16*)(ws + WS_ACT);
#pragma unroll
        for (int ai = 0; ai < 2; ++ai)
#pragma unroll
            for (int m = 0; m < 4; ++m) { const int row = row0 + ai * HALF + m * 16;
                st8bf(A + (size_t)row * DFF + cb, map4(acc[ai][0][m][0], siluf_) * acc[ai][1][m][0], map4(acc[ai][0][m][1], siluf_) * acc[ai][1][m][1]); }
        return true;
    }
};
}

DI bf16x8 ldfrag(const LAS bf16* M, int ld, int r0, int k0, int lane) { return *(const LAS bf16x8*)(M + (r0 + (lane & 15)) * ld + k0 + 8 * (lane >> 4)); }
#define MFMA16(a, b, c) __builtin_amdgcn_mfma_f32_16x16x32_bf16((a), (b), (c), 0, 0, 0)
DI void stage_nat(LAS bf16* dst, int lp, const bf16* src, size_t gp, int rows, int cols8, int tid) {
    for (int p = tid; p < rows * cols8; p += NTHR) { const int r = p / cols8, c = p - r * cols8; *(LAS u32x4*)(dst + r * lp + c * 8) = *(const GAS u32x4*)(src + (size_t)r * gp + c * 8); }
}
DI void stage_tr(LAS bf16* dst, int lp, const bf16* src, size_t gp, int rows, int cols8, int tid) {
    for (int p = tid; p < rows * cols8; p += NTHR) { const int r = p / cols8, c = p - r * cols8; const u32x4 w = *(const GAS u32x4*)(src + (size_t)r * gp + c * 8);
        LAS bf16* d = dst + (c * 8) * lp + r;
        d[0] = (bf16)(w.x & 0xffffu); d[lp] = (bf16)(w.x >> 16); d[2 * lp] = (bf16)(w.y & 0xffffu); d[3 * lp] = (bf16)(w.y >> 16);
        d[4 * lp] = (bf16)(w.z & 0xffffu); d[5 * lp] = (bf16)(w.z >> 16); d[6 * lp] = (bf16)(w.w & 0xffffu); d[7 * lp] = (bf16)(w.w >> 16); }
}
DI float ret_loggamma(int h) { return log1pf(-exp2f(-5.0f - (float)h)); }

DI void u_ret_kv(Frame& F, int c, int h) {
    int tid_ = F.tid; asm volatile("" : "+v"(tid_));
    unsigned char* ws = F.ws; const int tid = tid_, lane = tid_ & 63, w = F.wave;
    LAS bf16* Kt = (LAS bf16*)F.lds; LAS bf16* Vt = Kt + 128 * 72;
    const bf16* KR = (const bf16*)(ws + WS_KR) + (size_t)(c * 64) * 512 + h * 128; const bf16* VR = (const bf16*)(ws + WS_VR) + (size_t)(c * 64) * 512 + h * 128;
    const float lg = ret_loggamma(h);
    for (int p = tid; p < 1024; p += NTHR) { const int m = p >> 4, d0 = (p & 15) * 8; float k[8]; unpack8(*(const GAS u32x4*)(KR + (size_t)m * 512 + d0), k); const float sc = fexp_(lg * (float)(63 - m));
        LAS bf16* d = Kt + d0 * 72 + m;
#pragma unroll
        for (int i = 0; i < 8; ++i) d[i * 72] = (bf16)f2bf(k[i] * sc); }
    stage_tr(Vt, 72, VR, 512, 64, 16, tid);
    __syncthreads();
    f32x4 acc[8];
#pragma unroll
    for (int bn = 0; bn < 8; ++bn) acc[bn] = (f32x4){0.f, 0.f, 0.f, 0.f};
#pragma unroll
    for (int ks = 0; ks < 2; ++ks) { const bf16x8 a = ldfrag(Kt, 72, 16 * w, 32 * ks, lane);
#pragma unroll
        for (int bn = 0; bn < 8; ++bn) acc[bn] = MFMA16(a, ldfrag(Vt, 72, 16 * bn, 32 * ks, lane), acc[bn]); }
    float* out = (float*)(ws + WS_RKV) + ((size_t)(c * 4 + h) * 128) * 128;
#pragma unroll
    for (int bn = 0; bn < 8; ++bn)
#pragma unroll
        for (int r = 0; r < 4; ++r) out[(size_t)(16 * w + 4 * (lane >> 4) + r) * 128 + 16 * bn + (lane & 15)] = acc[bn][r];
    __syncthreads();
}

DI void u_ret_out(Frame& F, int l_, int c, int h) {
    int tid_ = F.tid; asm volatile("" : "+v"(tid_));
    unsigned char* ws = F.ws; const int tid = tid_, lane = tid_ & 63, w = F.wave;
    LAS bf16* Qs = (LAS bf16*)F.lds; LAS bf16* Ks = Qs + 64 * 136; LAS bf16* Vt = Ks + 64 * 136; LAS bf16* St = Vt + 128 * 72; LAS bf16* Ps = St + 128 * 136; LAS float* Os = (LAS float*)(Ps + 64 * 72);
    const size_t rowb = (size_t)(c * 64) * 512 + h * 128;
    stage_nat(Qs, 136, (const bf16*)(ws + WS_QR) + rowb, 512, 64, 16, tid);
    stage_nat(Ks, 136, (const bf16*)(ws + WS_KR) + rowb, 512, 64, 16, tid);
    stage_tr(Vt, 72, (const bf16*)(ws + WS_VR) + rowb, 512, 64, 16, tid);
    { const float* sp = (const float*)(ws + WS_RKV) + ((size_t)(c * 4 + h) * 128) * 128;
      for (int p = tid; p < 4096; p += NTHR) { const int d = p >> 5, e0 = (p & 31) * 4; const f32x4 v = *(const GAS f32x4*)(sp + (size_t)d * 128 + e0);
          LAS bf16* q = St + e0 * 136 + d; q[0] = (bf16)f2bf(v.x); q[136] = (bf16)f2bf(v.y); q[272] = (bf16)f2bf(v.z); q[408] = (bf16)f2bf(v.w); } }
    __syncthreads();
    const float lg = ret_loggamma(h); const int g4 = lane >> 4, lc = lane & 15;
    {
        const int bm = w >> 1;
#pragma unroll
        for (int q = 0; q < 2; ++q) { const int bn = (w & 1) * 2 + q; f32x4 acc = (f32x4){0.f, 0.f, 0.f, 0.f};
#pragma unroll
            for (int ks = 0; ks < 4; ++ks) acc = MFMA16(ldfrag(Qs, 136, 16 * bm, 32 * ks, lane), ldfrag(Ks, 136, 16 * bn, 32 * ks, lane), acc);
#pragma unroll
            for (int r = 0; r < 4; ++r) { const int l = 16 * bm + 4 * g4 + r, m = 16 * bn + lc; const int dd = l > m ? l - m : m - l; Ps[l * 72 + m] = (bf16)f2bf(acc[r] * fexp_(lg * (float)dd)); } }
    }
    __syncthreads();
    {
        const int bm = w >> 1;
#pragma unroll
        for (int q = 0; q < 4; ++q) { const int bn = (w & 1) * 4 + q; f32x4 a1 = (f32x4){0.f, 0.f, 0.f, 0.f}, a2 = (f32x4){0.f, 0.f, 0.f, 0.f};
#pragma unroll
            for (int ks = 0; ks < 2; ++ks) a1 = MFMA16(ldfrag(Ps, 72, 16 * bm, 32 * ks, lane), ldfrag(Vt, 72, 16 * bn, 32 * ks, lane), a1);
#pragma unroll
            for (int ks = 0; ks < 4; ++ks) a2 = MFMA16(ldfrag(Qs, 136, 16 * bm, 32 * ks, lane), ldfrag(St, 136, 16 * bn, 32 * ks, lane), a2);
#pragma unroll
            for (int r = 0; r < 4; ++r) { const int l = 16 * bm + 4 * g4 + r; Os[l * 132 + 16 * bn + lc] = a1[r] + fexp_(lg * (float)(l + 1)) * a2[r]; } }
    }
    __syncthreads();
    { const float* gw = (const float*)(ws + WS_PRM) + (size_t)l_ * PRM_STRIDE + P_GN + h * 128; const bf16* GR = (const bf16*)(ws + WS_GR); bf16* OB = (bf16*)(ws + WS_OB);
#pragma unroll
      for (int rr = 0; rr < 8; ++rr) { const int l = 8 * w + rr; const float x0 = Os[l * 132 + lane], x1 = Os[l * 132 + 64 + lane];
          const float mean = wave_sum(x0 + x1) * (1.f / 128.f); const float d0 = x0 - mean, d1 = x1 - mean; const float rstd = rsqrtf(wave_sum(d0 * d0 + d1 * d1) * (1.f / 128.f) + 1e-5f);
          const size_t row = (size_t)(c * 64 + l);
          const float g0 = bf2f(GR[row * 512 + h * 128 + lane]), g1 = bf2f(GR[row * 512 + h * 128 + 64 + lane]);
          OB[row * D + h * 128 + lane] = (bf16)f2bf(d0 * rstd * gw[lane] * g0); OB[row * D + h * 128 + 64 + lane] = (bf16)f2bf(d1 * rstd * gw[64 + lane] * g1); } }
    __syncthreads();
}

DI void u_mamba_st(Frame& F, int c, int g) {
    int tid_ = F.tid; asm volatile("" : "+v"(tid_));
    unsigned char* ws = F.ws; const int tid = tid_, lane = tid_ & 63, w = F.wave;
    LAS bf16* Xt = (LAS bf16*)F.lds; LAS bf16* Bt = Xt + 256 * 72;
    const bf16* XC = (const bf16*)(ws + WS_XC) + (size_t)(c * 64) * 1024; const float* dts = (const float*)(ws + WS_DTS) + (size_t)(c * 64) * 8; const float* acs = (const float*)(ws + WS_ACS) + (size_t)(c * 64) * 8;
    for (int p = tid; p < 2048; p += NTHR) { const int l = p >> 5, c0 = (p & 31) * 8, h = g * 4 + (c0 >> 6); float x[8]; unpack8(*(const GAS u32x4*)(XC + (size_t)l * 1024 + g * 256 + c0), x);
        const float sc = dts[l * 8 + h] * fexp_(acs[63 * 8 + h] - acs[l * 8 + h]); LAS bf16* d = Xt + c0 * 72 + l;
#pragma unroll
        for (int i = 0; i < 8; ++i) d[i * 72] = (bf16)f2bf(x[i] * sc); }
    stage_tr(Bt, 72, XC + 512 + g * 128, 1024, 64, 16, tid);
    __syncthreads();
    f32x4 acc[2][8];
#pragma unroll
    for (int i = 0; i < 2; ++i)
#pragma unroll
        for (int bn = 0; bn < 8; ++bn) acc[i][bn] = (f32x4){0.f, 0.f, 0.f, 0.f};
#pragma unroll
    for (int ks = 0; ks < 2; ++ks) { const bf16x8 a0 = ldfrag(Xt, 72, 32 * w, 32 * ks, lane), a1 = ldfrag(Xt, 72, 32 * w + 16, 32 * ks, lane);
#pragma unroll
        for (int bn = 0; bn < 8; ++bn) { const bf16x8 b = ldfrag(Bt, 72, 16 * bn, 32 * ks, lane); acc[0][bn] = MFMA16(a0, b, acc[0][bn]); acc[1][bn] = MFMA16(a1, b, acc[1][bn]); } }
    float* out = (float*)(ws + WS_MST) + ((size_t)(c * 8 + g * 4) * 64) * 128;
#pragma unroll
    for (int i = 0; i < 2; ++i)
#pragma unroll
        for (int bn = 0; bn < 8; ++bn)
#pragma unroll
            for (int r = 0; r < 4; ++r) out[(size_t)(32 * w + 16 * i + 4 * (lane >> 4) + r) * 128 + 16 * bn + (lane & 15)] = acc[i][bn][r];
    __syncthreads();
}

struct MambaLds { LAS bf16* Cs; LAS bf16* Bs; LAS float* CB; LAS bf16* Ph; LAS bf16* Xt; LAS bf16* Sh; LAS float* AC; LAS float* DT; LAS float* SSQ; };
DI void mamba_head(Frame& F, const MambaLds& L, const bf16* XC, const float* sp, int g, int hh, float dsk, const bf16* const (&zrow)[4], f32x4 (&y)[2]) {
    const int tid = F.tid, lane = F.lane, w = F.wave, g4 = lane >> 4, lc = lane & 15, bm = w >> 1;
    __syncthreads();
    { const int l = tid >> 3, m0 = (tid & 7) * 8; const float al = L.AC[l * 4 + hh]; float pv[8];
#pragma unroll
      for (int i = 0; i < 8; ++i) { const int m = m0 + i; pv[i] = (m <= l) ? L.CB[l * 68 + m] * fexp_(al - L.AC[m * 4 + hh]) * L.DT[m * 4 + hh] : 0.f; }
      u32x4 o; o.x = pk2(pv[0], pv[1]); o.y = pk2(pv[2], pv[3]); o.z = pk2(pv[4], pv[5]); o.w = pk2(pv[6], pv[7]); *(LAS u32x4*)(L.Ph + l * 72 + m0) = o; }
    stage_tr(L.Xt, 72, XC + g * 256 + hh * 64, 1024, 64, 8, tid);
    for (int p = tid; p < 1024; p += NTHR) { const int pr = p >> 4, n0 = (p & 15) * 8; const f32x4 v0 = *(const GAS f32x4*)(sp + (size_t)pr * 128 + n0), v1 = *(const GAS f32x4*)(sp + (size_t)pr * 128 + n0 + 4);
        *(LAS u32x4*)(L.Sh + pr * 136 + n0) = pack8(v0, v1); }
    __syncthreads();
#pragma unroll
    for (int q = 0; q < 2; ++q) { const int bn = (w & 1) * 2 + q; f32x4 yd = (f32x4){0.f, 0.f, 0.f, 0.f}, yo = (f32x4){0.f, 0.f, 0.f, 0.f};
#pragma unroll
        for (int ks = 0; ks < 2; ++ks) yd = MFMA16(ldfrag(L.Ph, 72, 16 * bm, 32 * ks, lane), ldfrag(L.Xt, 72, 16 * bn, 32 * ks, lane), yd);
#pragma unroll
        for (int ks = 0; ks < 4; ++ks) yo = MFMA16(ldfrag(L.Cs, 136, 16 * bm, 32 * ks, lane), ldfrag(L.Sh, 136, 16 * bn, 32 * ks, lane), yo);
#pragma unroll
        for (int r = 0; r < 4; ++r) { const int l = 16 * bm + 4 * g4 + r, p = 16 * bn + lc; const float x = bf2f(L.Xt[p * 72 + l]);
            const float z = bf2f(zrow[r][hh * 64 + q * 16]);
            y[q][r] = (yd[r] + fexp_(L.AC[l * 4 + hh]) * yo[r] + x * dsk) * z; } }
}
DI void u_mamba_out(Frame& F, int l_, int c, int g) {
    unsigned char* ws = F.ws; const int tid = F.tid, lane = F.lane, w = F.wave, g4 = lane >> 4, lc = lane & 15;
    MambaLds L; L.Cs = (LAS bf16*)F.lds; L.Bs = L.Cs + 64 * 136; L.CB = (LAS float*)(L.Bs + 64 * 136); L.Ph = (LAS bf16*)(L.CB + 64 * 68); L.Xt = L.Ph + 64 * 72; L.Sh = L.Xt + 64 * 72;
    L.AC = (LAS float*)(L.Sh + 64 * 136); L.DT = L.AC + 256; L.SSQ = L.DT + 256;
    const bf16* XC = (const bf16*)(ws + WS_XC) + (size_t)(c * 64) * 1024;
    stage_nat(L.Cs, 136, XC + 768 + g * 128, 1024, 64, 16, tid);
    stage_nat(L.Bs, 136, XC + 512 + g * 128, 1024, 64, 16, tid);
    if (tid < 256) { const int l = tid >> 2, hh = tid & 3; L.AC[tid] = ((const float*)(ws + WS_ACS))[(size_t)(c * 64 + l) * 8 + g * 4 + hh]; L.DT[tid] = ((const float*)(ws + WS_DTS))[(size_t)(c * 64 + l) * 8 + g * 4 + hh]; }
    __syncthreads();
    const int bm = w >> 1;
#pragma unroll
    for (int q = 0; q < 2; ++q) { const int bn = (w & 1) * 2 + q; f32x4 acc = (f32x4){0.f, 0.f, 0.f, 0.f};
#pragma unroll
        for (int ks = 0; ks < 4; ++ks) acc = MFMA16(ldfrag(L.Cs, 136, 16 * bm, 32 * ks, lane), ldfrag(L.Bs, 136, 16 * bn, 32 * ks, lane), acc);
#pragma unroll
        for (int r = 0; r < 4; ++r) L.CB[(16 * bm + 4 * g4 + r) * 68 + 16 * bn + lc] = acc[r]; }
    const int pcol = 16 * ((w & 1) * 2) + lc;
    const bf16* zrow[4]; bf16* orow[4];
#pragma unroll
    for (int r = 0; r < 4; ++r) { const size_t row = (size_t)(c * 64 + 16 * bm + 4 * g4 + r); zrow[r] = (const bf16*)(ws + WS_ZS) + row * 512 + g * 256 + pcol; orow[r] = (bf16*)(ws + WS_OB) + row * D + 512 + g * 256 + pcol; }
    const float* mst = (const float*)(ws + WS_MST) + ((size_t)(c * 8 + g * 4) * 64) * 128; const float* prm = (const float*)(ws + WS_PRM) + (size_t)l_ * PRM_STRIDE; const float* dskp = prm + P_SD + g * 4;
    float ss[4] = {0.f, 0.f, 0.f, 0.f};
#pragma unroll 1
    for (int hh = 0; hh < 4; ++hh) { f32x4 y[2]; mamba_head(F, L, XC, mst + (size_t)hh * 64 * 128, g, hh, dskp[hh], zrow, y);
#pragma unroll
        for (int r = 0; r < 4; ++r) ss[r] += y[0][r] * y[0][r] + y[1][r] * y[1][r]; }
#pragma unroll
    for (int r = 0; r < 4; ++r) { float t = ss[r]; t = row_sum16(t);
        if (lc == 0) L.SSQ[(16 * bm + 4 * g4 + r) * 2 + (w & 1)] = t; }
    __syncthreads();
    float rstd[4];
#pragma unroll
    for (int r = 0; r < 4; ++r) { const int l = 16 * bm + 4 * g4 + r; rstd[r] = rsqrtf((L.SSQ[l * 2] + L.SSQ[l * 2 + 1]) * (1.f / 256.f) + 1e-6f); }
    const float* nw = prm + P_SNW + g * 256 + pcol;
#pragma unroll 1
    for (int hh = 0; hh < 4; ++hh) { f32x4 y[2]; mamba_head(F, L, XC, mst + (size_t)hh * 64 * 128, g, hh, dskp[hh], zrow, y);
#pragma unroll
        for (int q = 0; q < 2; ++q)
#pragma unroll
            for (int r = 0; r < 4; ++r) orow[r][hh * 64 + q * 16] = (bf16)f2bf(y[q][r] * rstd[r] * nw[hh * 64 + q * 16]); }
    __syncthreads();
}

DI void u_attn2(Frame& F, int h, int qb, int sp, int ntile) {
    int tid_ = F.tid; asm volatile("" : "+v"(tid_));
    unsigned char* ws = F.ws; const int tid = tid_, lane = tid & 63, w = F.wave, g4 = lane >> 4, lc = lane & 15;
    LAS bf16* Ks = (LAS bf16*)F.lds; LAS bf16* Vs = Ks + 64 * 200;
    const bf16* QM = (const bf16*)(ws + WS_QM); const bf16* KM = (const bf16*)(ws + WS_KM) + h * 192; const bf16* VT = (const bf16*)(ws + WS_VT) + (size_t)(h * 128) * S;
    const int q0 = qb * 256 + w * 32, cw = 4 * qb + (w >> 1);
    bf16x8 qf[2][6];
#pragma unroll
    for (int qq = 0; qq < 2; ++qq)
#pragma unroll
        for (int ks = 0; ks < 6; ++ks) qf[qq][ks] = *(const GAS bf16x8*)(QM + (size_t)(q0 + qq * 16 + lc) * 768 + h * 192 + ks * 32 + g4 * 8);
    f32x4 o[8][2]; float mrun[2], lrun[2];
#pragma unroll
    for (int db = 0; db < 8; ++db)
#pragma unroll
        for (int qq = 0; qq < 2; ++qq) o[db][qq] = (f32x4){0.f, 0.f, 0.f, 0.f};
    mrun[0] = mrun[1] = -1e30f; lrun[0] = lrun[1] = 0.f;
    u32x4 kreg[3], vreg[2];
    const int kt0 = 16 * sp;
#define AT_LOAD(kt) { const int key0_ = (kt) * 64; \
        _Pragma("unroll") for (int i = 0; i < 3; ++i) { const int p = tid + 512 * i, r = p / 24, cc = p - r * 24; kreg[i] = *(const GAS u32x4*)(KM + (size_t)(key0_ + r) * 768 + cc * 8); } \
        _Pragma("unroll") for (int i = 0; i < 2; ++i) { const int p = tid + 512 * i, r = p >> 3, cc = p & 7; vreg[i] = *(const GAS u32x4*)(VT + (size_t)r * S + key0_ + cc * 8); } }
    AT_LOAD(kt0)
    for (int t = 0; t < ntile; ++t) {
        const int kt = kt0 + t;
        __syncthreads();
#pragma unroll
        for (int i = 0; i < 3; ++i) { const int p = tid + 512 * i, r = p / 24, cc = p - r * 24; *(LAS u32x4*)(Ks + r * 200 + cc * 8) = kreg[i]; }
#pragma unroll
        for (int i = 0; i < 2; ++i) { const int p = tid + 512 * i, r = p >> 3, cc = p & 7; *(LAS u32x4*)(Vs + r * 72 + cc * 8) = vreg[i]; }
        __syncthreads();
        if (t + 1 < ntile) AT_LOAD(kt + 1)
        if (kt <= cw) {
            f32x4 s[4][2];
#pragma unroll
            for (int kb = 0; kb < 4; ++kb)
#pragma unroll
                for (int qq = 0; qq < 2; ++qq) s[kb][qq] = (f32x4){0.f, 0.f, 0.f, 0.f};
#pragma unroll
            for (int ks = 0; ks < 6; ++ks)
#pragma unroll
                for (int kb = 0; kb < 4; ++kb) { const bf16x8 kf = ldfrag(Ks, 200, kb * 16, ks * 32, lane);
#pragma unroll
                    for (int qq = 0; qq < 2; ++qq) s[kb][qq] = MFMA16(kf, qf[qq][ks], s[kb][qq]);
                    if (kb == 3 && (ks & 1)) __builtin_amdgcn_sched_barrier(0); }
            bf16x8 pf[2][2];
#pragma unroll
            for (int qq = 0; qq < 2; ++qq) {
                float mx = -1e30f;
#pragma unroll
                for (int kb = 0; kb < 4; ++kb) mx = fmaxf(mx, fmaxf(fmaxf(s[kb][qq][0], s[kb][qq][1]), fmaxf(s[kb][qq][2], s[kb][qq][3])));
                mx = xr32_max(xr16_max(mx));
                const float mn = fmaxf(mrun[qq], mx), alpha = __builtin_amdgcn_exp2f(mrun[qq] - mn); mrun[qq] = mn;
                float ps = 0.f; float p[16];
#pragma unroll
                for (int kb = 0; kb < 4; ++kb)
#pragma unroll
                    for (int r = 0; r < 4; ++r) { p[kb * 4 + r] = __builtin_amdgcn_exp2f(s[kb][qq][r] - mn); ps += p[kb * 4 + r]; }
                ps = xr32_sum(xr16_sum(ps));
                lrun[qq] = lrun[qq] * alpha + ps;
if (__builtin_amdgcn_ballot_w64(alpha != 1.0f) != 0ull) {
#pragma unroll
                    for (int db = 0; db < 8; ++db) o[db][qq] = o[db][qq] * alpha; }
#pragma unroll
                for (int s2 = 0; s2 < 2; ++s2) { u32x4 pw; pw.x = pk2(p[8 * s2], p[8 * s2 + 1]); pw.y = pk2(p[8 * s2 + 2], p[8 * s2 + 3]); pw.z = pk2(p[8 * s2 + 4], p[8 * s2 + 5]); pw.w = pk2(p[8 * s2 + 6], p[8 * s2 + 7]); pf[qq][s2] = __builtin_bit_cast(bf16x8, pw); }
            }
#pragma unroll
            for (int db = 0; db < 8; ++db)
#pragma unroll
                for (int s2 = 0; s2 < 2; ++s2) {
                    const LAS bf16* vp = Vs + (db * 16 + lc) * 72 + 32 * s2 + 4 * g4;
                    const u32x2 v0 = *(const LAS u32x2*)vp, v1 = *(const LAS u32x2*)(vp + 16);
                    const u32x4 vw = (u32x4){v0.x, v0.y, v1.x, v1.y}; const bf16x8 vf = __builtin_bit_cast(bf16x8, vw);
#pragma unroll
                    for (int qq = 0; qq < 2; ++qq) o[db][qq] = MFMA16(vf, pf[qq][s2], o[db][qq]);
                }
        }
    }
#undef AT_LOAD
    const int slot = att_slot(h, qb, sp);
    float* po = (float*)(ws + WS_APO) + (size_t)slot * 32768; float* pm = (float*)(ws + WS_APM) + (size_t)slot * 512;
#pragma unroll
    for (int db = 0; db < 8; ++db)
#pragma unroll
        for (int qq = 0; qq < 2; ++qq)
#pragma unroll
            for (int r = 0; r < 4; ++r) po[(size_t)(db * 16 + 4 * g4 + r) * 256 + w * 32 + qq * 16 + lc] = o[db][qq][r];
    if (g4 == 0) {
#pragma unroll
        for (int qq = 0; qq < 2; ++qq) { *(GAS f32x2*)(pm + (w * 32 + qq * 16 + lc) * 2) = (f32x2){mrun[qq], lrun[qq]}; } }
    __syncthreads();
}
DI void u_attn_comb(Frame& F, int h, int qb, int qq) {
    unsigned char* ws = F.ws; const int tid = F.tid, q = qq * 64 + (tid & 63), dv0 = (tid >> 6) * 16;
    const int ns = (qb + 4) >> 2, slot0 = att_slot(h, qb, 0);
    const float* pm = (const float*)(ws + WS_APM) + (size_t)slot0 * 512 + q * 2; const float* po = (const float*)(ws + WS_APO) + (size_t)slot0 * 32768 + (size_t)dv0 * 256 + q;
    float mstar = -1e30f;
    for (int s = 0; s < ns; ++s) mstar = fmaxf(mstar, pm[(size_t)s * 512]);
    float lt = 0.f; float ov[16];
#pragma unroll
    for (int i = 0; i < 16; ++i) ov[i] = 0.f;
    for (int s = 0; s < ns; ++s) { const float sc = __builtin_amdgcn_exp2f(pm[(size_t)s * 512] - mstar); lt += pm[(size_t)s * 512 + 1] * sc;
#pragma unroll
        for (int i = 0; i < 16; ++i) ov[i] += po[(size_t)s * 32768 + i * 256] * sc; }
    const float inv = 1.0f / lt;
    bf16* ob = (bf16*)(ws + WS_OB) + (size_t)(qb * 256 + q) * D + 1024 + h * 128 + dv0;
    u32x4 o0, o1; o0.x = pk2(ov[0] * inv, ov[1] * inv); o0.y = pk2(ov[2] * inv, ov[3] * inv); o0.z = pk2(ov[4] * inv, ov[5] * inv); o0.w = pk2(ov[6] * inv, ov[7] * inv);
    o1.x = pk2(ov[8] * inv, ov[9] * inv); o1.y = pk2(ov[10] * inv, ov[11] * inv); o1.z = pk2(ov[12] * inv, ov[13] * inv); o1.w = pk2(ov[14] * inv, ov[15] * inv);
    *(GAS u32x4*)ob = o0; *(GAS u32x4*)(ob + 8) = o1;
}

DI void u_rwkv_r1(Frame& F, int c, int h) {
    int tid_ = F.tid; asm volatile("" : "+v"(tid_));
    unsigned char* ws = F.ws; const int tid = tid_, lane = tid_ & 63, w = F.wave, g4 = lane >> 4, lc = lane & 15;
    LAS float* CUM = (LAS float*)F.lds;
    LAS float* PT = CUM + 64 * 68;
    LAS bf16* AT = (LAS bf16*)(PT + 64); LAS bf16* BH = AT + 4608; LAS bf16* KH = BH + 4608; LAS bf16* RT = KH + 4608;
    LAS bf16* AJ = RT + 4608; LAS bf16* BJ = AJ + 4608; LAS bf16* KJ = BJ + 4608; LAS bf16* VJ = KJ + 4608;
    LAS bf16* MAK = VJ + 4608; LAS bf16* MRBT = MAK + 4608; LAS bf16* MRKT = MRBT + 4608; LAS bf16* X1 = MRKT + 4608; LAS bf16* X2 = X1 + 4608;
    LAS bf16* WT = AT; LAS bf16* G1 = BH; LAS bf16* G2 = KH; LAS bf16* CST = MAK;
    const size_t gb = (size_t)(c * 64) * 512 + h * 64; const int unit = c * 8 + h;
    const int t = tid >> 3, j0 = (tid & 7) * 8;
    const size_t go = gb + (size_t)t * 512 + j0;
    float lw[8];
    { const f32x4 x0 = *(const GAS f32x4*)((const float*)(ws + WS_DEC) + go), x1 = *(const GAS f32x4*)((const float*)(ws + WS_DEC) + go + 4);
#pragma unroll
      for (int i = 0; i < 4; ++i) { lw[i] = x0[i]; lw[4 + i] = x1[i]; }
#pragma unroll
      for (int i = 0; i < 8; ++i) CUM[t * 68 + j0 + i] = lw[i]; }
    __syncthreads();
    if (tid < 64) { float s = 0.f;
#pragma unroll 8
        for (int tt = 0; tt < 64; ++tt) { s += CUM[tt * 68 + tid]; CUM[tt * 68 + tid] = s; } }
    __syncthreads();
    {
        float cum[8], cT[8];
#pragma unroll
        for (int i = 0; i < 8; ++i) { cum[i] = CUM[t * 68 + j0 + i]; cT[i] = CUM[63 * 68 + j0 + i]; }
        if (t == 0) {
#pragma unroll
            for (int i = 0; i < 8; ++i) PT[j0 + i] = fexp_(cT[i]); }
        float av[8], bv[8], kv[8], rv[8], vv[8];
#define LD8(dst, OFF) { const f32x4 x0 = *(const GAS f32x4*)((const float*)(ws + (OFF)) + go), x1 = *(const GAS f32x4*)((const float*)(ws + (OFF)) + go + 4); _Pragma("unroll") for (int i = 0; i < 4; ++i) { dst[i] = x0[i]; dst[4 + i] = x1[i]; } }
        LD8(av, WS_KKN) LD8(bv, WS_BB) LD8(kv, WS_KP) LD8(rv, WS_R32) LD8(vv, WS_VV)
#undef LD8
        float at[8], bh[8], kh[8], rt[8], bj[8], kj[8];
#pragma unroll
        for (int i = 0; i < 8; ++i) { const float pprev = fexp_(cum[i] - lw[i]), pinv = fexp_(-cum[i]), pt = fexp_(cum[i]), pend = fexp_(cT[i] - cum[i]);
            at[i] = -av[i] * pprev; bh[i] = bv[i] * pinv; kh[i] = kv[i] * pinv; rt[i] = rv[i] * pt; bj[i] = bv[i] * pend; kj[i] = kv[i] * pend; }
#define ST8(M, v) { u32x4 o; o.x = pk2(v[0], v[1]); o.y = pk2(v[2], v[3]); o.z = pk2(v[4], v[5]); o.w = pk2(v[6], v[7]); *(LAS u32x4*)(M + t * 72 + j0) = o; }
        ST8(AT, at) ST8(BH, bh) ST8(KH, kh) ST8(RT, rt)
#undef ST8
#pragma unroll
        for (int i = 0; i < 8; ++i) { const int o = (j0 + i) * 72 + t; AJ[o] = (bf16)f2bf(at[i]); BJ[o] = (bf16)f2bf(bj[i]); KJ[o] = (bf16)f2bf(kj[i]); VJ[o] = (bf16)f2bf(vv[i]); }
    }
    __syncthreads();
    {
        const int q = w >> 1; const LAS bf16* Am = (q == 0) ? BH : (q == 1) ? KH : RT; const LAS bf16* Bm = (q < 2) ? AT : (q == 2) ? BH : KH;
#pragma unroll
        for (int bi = 0; bi < 2; ++bi) { const int bm = 2 * (w & 1) + bi; const bf16x8 a0 = ldfrag(Am, 72, 16 * bm, 0, lane), a1 = ldfrag(Am, 72, 16 * bm, 32, lane);
#pragma unroll
            for (int bn = 0; bn < 4; ++bn) { f32x4 acc = (f32x4){0.f, 0.f, 0.f, 0.f};
                acc = MFMA16(a0, ldfrag(Bm, 72, 16 * bn, 0, lane), acc); acc = MFMA16(a1, ldfrag(Bm, 72, 16 * bn, 32, lane), acc);
#pragma unroll
                for (int r = 0; r < 4; ++r) { const int row = 16 * bm + 4 * g4 + r, col = 16 * bn + lc; const bool keep = (q < 2) ? (row < col) : (col <= row); const float v = keep ? acc[r] : 0.f;
                    if (q == 0) CUM[row * 68 + col] = v; else { LAS bf16* O = (q == 1) ? MAK : (q == 2) ? MRBT : MRKT; O[row * 72 + col] = (bf16)f2bf(v); } } } }
    }
    __syncthreads();
    {
        LAS bf16* Qn[2] = {BH, X1}; LAS bf16* Qt[2] = {KH, X2}; LAS bf16* Wn = AT;
        const int bm = w >> 1; f32x4 wreg[2];
#pragma unroll
        for (int qn = 0; qn < 2; ++qn) { const int bn = (w & 1) * 2 + qn;
#pragma unroll
            for (int r = 0; r < 4; ++r) { const int row = 16 * bm + 4 * g4 + r, col = 16 * bn + lc; const float m = CUM[row * 68 + col]; wreg[qn][r] = m + ((row == col) ? 1.f : 0.f);
                const bf16 mb = (bf16)f2bf(m); Qn[0][row * 72 + col] = mb; Qt[0][col * 72 + row] = mb; Wn[row * 72 + col] = (bf16)f2bf(wreg[qn][r]); } }
        __syncthreads();
#pragma unroll
        for (int it = 0; it < 5; ++it) { const int cu = it & 1, nx = cu ^ 1;
            { const bf16x8 a0 = ldfrag(Qn[cu], 72, 16 * bm, 0, lane), a1 = ldfrag(Qn[cu], 72, 16 * bm, 32, lane);
#pragma unroll
              for (int qn = 0; qn < 2; ++qn) { const int bn = (w & 1) * 2 + qn; f32x4 acc = (f32x4){0.f, 0.f, 0.f, 0.f};
                  acc = MFMA16(a0, ldfrag(Qt[cu], 72, 16 * bn, 0, lane), acc); acc = MFMA16(a1, ldfrag(Qt[cu], 72, 16 * bn, 32, lane), acc);
#pragma unroll
                  for (int r = 0; r < 4; ++r) { const int row = 16 * bm + 4 * g4 + r, col = 16 * bn + lc; const bf16 v = (bf16)f2bf(acc[r]); Qn[nx][row * 72 + col] = v; Qt[nx][col * 72 + row] = v; } } }
            __syncthreads();
            { const bf16x8 a0 = ldfrag(Wn, 72, 16 * bm, 0, lane), a1 = ldfrag(Wn, 72, 16 * bm, 32, lane);
#pragma unroll
              for (int qn = 0; qn < 2; ++qn) { const int bn = (w & 1) * 2 + qn;
                  wreg[qn] = MFMA16(a0, ldfrag(Qt[nx], 72, 16 * bn, 0, lane), wreg[qn]); wreg[qn] = MFMA16(a1, ldfrag(Qt[nx], 72, 16 * bn, 32, lane), wreg[qn]); } }
            __syncthreads();
            if (it < 4) {
#pragma unroll
                for (int qn = 0; qn < 2; ++qn) { const int bn = (w & 1) * 2 + qn;
#pragma unroll
                    for (int r = 0; r < 4; ++r) Wn[(16 * bm + 4 * g4 + r) * 72 + 16 * bn + lc] = (bf16)f2bf(wreg[qn][r]); }
                __syncthreads();
            }
        }
#pragma unroll
        for (int qn = 0; qn < 2; ++qn) { const int bn = (w & 1) * 2 + qn;
#pragma unroll
            for (int r = 0; r < 4; ++r) WT[(16 * bn + lc) * 72 + 16 * bm + 4 * g4 + r] = (bf16)f2bf(wreg[qn][r]); }
    }
    __syncthreads();
    {
        const int q = w >> 2, bm = w & 3; const LAS bf16* Am = q ? MAK : AJ; LAS bf16* O = q ? G2 : G1;
        const bf16x8 a0 = ldfrag(Am, 72, 16 * bm, 0, lane), a1 = ldfrag(Am, 72, 16 * bm, 32, lane);
        f32x4 acc[4];
#pragma unroll
        for (int bn = 0; bn < 4; ++bn) { acc[bn] = (f32x4){0.f, 0.f, 0.f, 0.f};
            acc[bn] = MFMA16(a0, ldfrag(WT, 72, 16 * bn, 0, lane), acc[bn]); acc[bn] = MFMA16(a1, ldfrag(WT, 72, 16 * bn, 32, lane), acc[bn]); }
        __syncthreads();
#pragma unroll
        for (int bn = 0; bn < 4; ++bn)
#pragma unroll
            for (int r = 0; r < 4; ++r) O[(16 * bm + 4 * g4 + r) * 72 + 16 * bn + lc] = (bf16)f2bf(acc[bn][r]);
    }
    __syncthreads();
    {
        const int q = w >> 1; const LAS bf16* Am = (q < 2) ? MRBT : BJ; const LAS bf16* Bm = (q & 1) ? G2 : G1;
        f32x4 acc[2][4];
#pragma unroll
        for (int bi = 0; bi < 2; ++bi) { const int bm = 2 * (w & 1) + bi; const bf16x8 a0 = ldfrag(Am, 72, 16 * bm, 0, lane), a1 = ldfrag(Am, 72, 16 * bm, 32, lane);
#pragma unroll
            for (int bn = 0; bn < 4; ++bn) { acc[bi][bn] = (f32x4){0.f, 0.f, 0.f, 0.f};
                acc[bi][bn] = MFMA16(a0, ldfrag(Bm, 72, 16 * bn, 0, lane), acc[bi][bn]); acc[bi][bn] = MFMA16(a1, ldfrag(Bm, 72, 16 * bn, 32, lane), acc[bi][bn]); } }
        __syncthreads();
        bf16* gout = (bf16*)(ws + (q == 0 ? WS_QYT : q == 1 ? WS_CYT : WS_TST)) + (size_t)unit * 4096;
#pragma unroll
        for (int bi = 0; bi < 2; ++bi) { const int bm = 2 * (w & 1) + bi;
#pragma unroll
            for (int bn = 0; bn < 4; ++bn)
#pragma unroll
                for (int r = 0; r < 4; ++r) { const int row = 16 * bm + 4 * g4 + r, col = 16 * bn + lc; float v = acc[bi][bn][r];
                    if (q == 0) v += bf2f(RT[row * 72 + col]); else if (q == 1) v += bf2f(MRKT[row * 72 + col]); else if (q == 2) v += (row == col) ? PT[row] : 0.f; else v += bf2f(KJ[row * 72 + col]);
                    if (q < 3) gout[row * 64 + col] = (bf16)f2bf(v); else CST[row * 72 + col] = (bf16)f2bf(v); } }
    }
    __syncthreads();
    {
        const int bm = w >> 1; float* nst = (float*)(ws + WS_NST) + (size_t)unit * 4096;
        const bf16x8 a0 = ldfrag(CST, 72, 16 * bm, 0, lane), a1 = ldfrag(CST, 72, 16 * bm, 32, lane);
#pragma unroll
        for (int qn = 0; qn < 2; ++qn) { const int bn = (w & 1) * 2 + qn; f32x4 acc = (f32x4){0.f, 0.f, 0.f, 0.f};
            acc = MFMA16(a0, ldfrag(VJ, 72, 16 * bn, 0, lane), acc); acc = MFMA16(a1, ldfrag(VJ, 72, 16 * bn, 32, lane), acc);
#pragma unroll
            for (int r = 0; r < 4; ++r) nst[(16 * bm + 4 * g4 + r) * 64 + 16 * bn + lc] = acc[r]; }
    }
    __syncthreads();
}

DI void p_rwkv_scan2(Frame& F, int h) {
    unsigned char* ws = F.ws; const int lane = F.lane, w = F.wave, g4 = lane >> 4, lc = lane & 15;
    constexpr int SLOT_B = 9216 + 17408;
    const bf16* TST = (const bf16*)(ws + WS_TST) + (size_t)h * 4096; const float* NST = (const float*)(ws + WS_NST) + (size_t)h * 4096; bf16* S0 = (bf16*)(ws + WS_S0) + (size_t)h * 4096;
    if (w >= 4) {
        const int lt = (w - 4) * 64 + lane;
        u32x4 rt[8][2]; f32x4 rn[8][4];
#define SC_ISSUE(u, cc) { const size_t ub = (size_t)(cc) * 8 * 4096; \
            _Pragma("unroll") for (int i = 0; i < 2; ++i) { const int p = lt + 256 * i; rt[u][i] = *(const GAS u32x4*)(TST + ub + (size_t)p * 8); } \
            _Pragma("unroll") for (int i = 0; i < 4; ++i) { const int p = lt + 256 * i; rn[u][i] = *(const GAS f32x4*)(NST + ub + (size_t)p * 4); } }
#define SC_WRITE(u, cc) { LAS unsigned char* sl = F.lds + ((cc) & 1) * SLOT_B; \
            _Pragma("unroll") for (int i = 0; i < 2; ++i) { const int p = lt + 256 * i, r = p >> 3, c8 = p & 7; *(LAS u32x4*)(sl + (r * 72 + c8 * 8) * 2) = rt[u][i]; } \
            _Pragma("unroll") for (int i = 0; i < 4; ++i) { const int p = lt + 256 * i, r = p >> 4, c4 = p & 15; *(LAS f32x4*)(sl + 9216 + (r * 68 + c4 * 4) * 4) = rn[u][i]; } }
#pragma unroll
        for (int u = 0; u < 8; ++u) SC_ISSUE(u, u)
        for (int c0 = 0; c0 < NCH; c0 += 8) {
#pragma unroll
            for (int u = 0; u < 8; ++u) { const int c = c0 + u;
                SC_WRITE(u, c)
                if (c + 8 < NCH) SC_ISSUE(u, c + 8)
                asm volatile("s_waitcnt lgkmcnt(0)" ::: "memory"); __builtin_amdgcn_s_barrier(); asm volatile("" ::: "memory");
            }
        }
#undef SC_ISSUE
#undef SC_WRITE
    } else {
        const int ib = w;
        f32x4 st[4];
#pragma unroll
        for (int jb = 0; jb < 4; ++jb) st[jb] = (f32x4){0.f, 0.f, 0.f, 0.f};
        for (int c = 0; c < NCH; ++c) {
            bf16* s0p = S0 + (size_t)c * 8 * 4096 + (size_t)(16 * ib + lc) * 64 + 4 * g4;
            bf16x8 bfr[2];
#pragma unroll
            for (int ks = 0; ks < 2; ++ks) { u32x4 p; p.x = pk2(st[2 * ks][0], st[2 * ks][1]); p.y = pk2(st[2 * ks][2], st[2 * ks][3]); p.z = pk2(st[2 * ks + 1][0], st[2 * ks + 1][1]); p.w = pk2(st[2 * ks + 1][2], st[2 * ks + 1][3]);
                bfr[ks] = __builtin_bit_cast(bf16x8, p);
                *(GAS u32x2*)(s0p + 32 * ks) = (u32x2){p.x, p.y}; *(GAS u32x2*)(s0p + 32 * ks + 16) = (u32x2){p.z, p.w}; }
            asm volatile("s_waitcnt lgkmcnt(0)" ::: "memory"); __builtin_amdgcn_s_barrier(); asm volatile("" ::: "memory");
            const LAS bf16* ts = (const LAS bf16*)(F.lds + (c & 1) * SLOT_B); const LAS float* ns = (const LAS float*)(F.lds + (c & 1) * SLOT_B + 9216);
#pragma unroll
            for (int jb = 0; jb < 4; ++jb) { f32x4 nw;
#pragma unroll
                for (int r = 0; r < 4; ++r) nw[r] = ns[(16 * jb + 4 * g4 + r) * 68 + 16 * ib + lc];
#pragma unroll
                for (int ks = 0; ks < 2; ++ks) { const LAS bf16* ap = ts + (16 * jb + lc) * 72 + 32 * ks + 4 * g4; const u32x2 a0 = *(const LAS u32x2*)ap, a1 = *(const LAS u32x2*)(ap + 16);
                    const u32x4 aw = (u32x4){a0.x, a0.y, a1.x, a1.y}; nw = MFMA16(__builtin_bit_cast(bf16x8, aw), bfr[ks], nw); }
                st[jb] = nw; }
        }
    }
}

DI void u_rwkv_r3(Frame& F, int l_, int c, int h) {
    int tid_ = F.tid; asm volatile("" : "+v"(tid_));
    unsigned char* ws = F.ws; const int tid = tid_, lane = tid_ & 63, w = F.wave, g4 = lane >> 4, lc = lane & 15, unit = c * 8 + h;
    LAS bf16* QY = (LAS bf16*)F.lds; LAS bf16* CY = QY + 4608; LAS bf16* S0s = CY + 4608; LAS bf16* VJ = S0s + 4608; LAS float* Ys = (LAS float*)(VJ + 4608);
    stage_nat(QY, 72, (const bf16*)(ws + WS_QYT) + (size_t)unit * 4096, 64, 64, 8, tid);
    stage_nat(CY, 72, (const bf16*)(ws + WS_CYT) + (size_t)unit * 4096, 64, 64, 8, tid);
    stage_nat(S0s, 72, (const bf16*)(ws + WS_S0) + (size_t)unit * 4096, 64, 64, 8, tid);
    const size_t gb = (size_t)(c * 64) * 512 + h * 64;
    { const int t = tid >> 3, j0 = (tid & 7) * 8; const float* vp = (const float*)(ws + WS_VV) + gb + (size_t)t * 512 + j0; const f32x4 x0 = *(const GAS f32x4*)vp, x1 = *(const GAS f32x4*)(vp + 4);
#pragma unroll
      for (int i = 0; i < 4; ++i) { VJ[(j0 + i) * 72 + t] = (bf16)f2bf(x0[i]); VJ[(j0 + 4 + i) * 72 + t] = (bf16)f2bf(x1[i]); } }
    __syncthreads();
    { const int bm = w >> 1;
#pragma unroll
      for (int qn = 0; qn < 2; ++qn) { const int bn = (w & 1) * 2 + qn; f32x4 acc = (f32x4){0.f, 0.f, 0.f, 0.f};
#pragma unroll
          for (int ks = 0; ks < 2; ++ks) { acc = MFMA16(ldfrag(QY, 72, 16 * bm, 32 * ks, lane), ldfrag(S0s, 72, 16 * bn, 32 * ks, lane), acc); acc = MFMA16(ldfrag(CY, 72, 16 * bm, 32 * ks, lane), ldfrag(VJ, 72, 16 * bn, 32 * ks, lane), acc); }
#pragma unroll
          for (int r = 0; r < 4; ++r) Ys[(16 * bm + 4 * g4 + r) * 65 + 16 * bn + lc] = acc[r]; } }
    __syncthreads();
    { const float* prm = (const float*)(ws + WS_PRM) + (size_t)l_ * PRM_STRIDE; const float lnw = prm[P_LNW + h * 64 + lane], lnb = prm[P_LNB + h * 64 + lane], rk = prm[P_RK + h * 64 + lane];
      float rr_[8], kk_[8], vv_[8], gg_[8];
#pragma unroll
      for (int rr = 0; rr < 8; ++rr) { const size_t o = gb + (size_t)(8 * w + rr) * 512 + lane;
          rr_[rr] = ((const float*)(ws + WS_R32))[o]; kk_[rr] = ((const float*)(ws + WS_KP))[o]; vv_[rr] = ((const float*)(ws + WS_VV))[o]; gg_[rr] = ((const float*)(ws + WS_G32))[o]; }
#pragma unroll
      for (int rr = 0; rr < 8; ++rr) { const int t = 8 * w + rr; const float y = Ys[t * 65 + lane];
          const float mean = wave_sum(y) * (1.f / 64.f), d = y - mean, rstd = rsqrtf(wave_sum(d * d) * (1.f / 64.f) + 64e-5f), bs = wave_sum(rr_[rr] * kk_[rr] * rk);
          ((bf16*)(ws + WS_OB))[(size_t)(c * 64 + t) * D + 1536 + h * 64 + lane] = (bf16)f2bf((d * rstd * lnw + lnb + bs * vv_[rr]) * gg_[rr]); } }
    __syncthreads();
}

constexpr int STEPS_PER_LAYER = 13, NSTEPS = 1 + DEPTH * STEPS_PER_LAYER;
constexpr int NSCAN_BLK = 8;

__global__ void __launch_bounds__(NTHR, 2) mk_fwd(Args args) {
    extern __shared__ __attribute__((aligned(16))) unsigned char lds_raw[];
    Frame F;
    F.lds = (LAS unsigned char*)lds_raw; F.MISC = (volatile LAS unsigned*)(F.lds + MISC_OFF);
    F.tid = threadIdx.x; F.lane = F.tid & 63; F.wave = __builtin_amdgcn_readfirstlane(F.tid >> 6);
    F.G = gridDim.x; F.bid = blockIdx.x; F.ws = args.ws; F.ctl = (gu32*)(args.ws + WS_CTL);
    for (int u = F.tid; u < (LDS_BYTES - LDSCTL_OFF) / 4; u += NTHR) ((LAS unsigned*)(F.lds + LDSCTL_OFF))[u] = 0u;
    __syncthreads();
    const int lo = args.st_lo, hi = args.st_hi;
    XcdBarrier bar; bar.bar = (unsigned*)(F.ctl + CW_BAR); bar.x = 0; bar.st = nullptr;
    if (hi - lo > 1) bar = xcd_barrier_post((unsigned*)(F.ctl + CW_BAR), F.MISC + 8);
#ifndef MK_MASK
#define MK_MASK 0xFBFEu
#endif
#define EN(k) (((MK_MASK) >> (k)) & 1u)
#ifndef MK_REP
#define MK_REP 0u
#endif
#define REP(k) (((MK_REP) >> (k)) & 1u)
#ifndef MK_DUP
#define MK_DUP 0u
#endif
#define DUP(k, stmt) do { stmt; if (((MK_DUP) >> (k)) & 1u) { stmt; } } while (0)
#define RUN(s) (lo <= (s) && (s) < hi)
#define SEAM(s) do { if ((s) + 1 < hi) xcd_barrier(bar); } while (0)

    if (EN(13) && RUN(0)) { _Pragma("unroll 1") for (int rp = 0; rp <= (int)REP(13); ++rp) { relaunder(F, args.ws, (LAS unsigned char*)lds_raw); p_prologue(F, args); } SEAM(0); }

    for (int l = 0; l < DEPTH; ++l) {
        const int sb = 1 + l * STEPS_PER_LAYER;
        const float* xin = (l == 0) ? args.in[0] : args.out;
        if (EN(0) && RUN(sb + 0)) { _Pragma("unroll 1") for (int rp = 0; rp <= (int)REP(0); ++rp) { relaunder(F, args.ws, (LAS unsigned char*)lds_raw); unsigned char* ws = F.ws; DUP(11, p_rmsnorm(F, xin, (const float*)(ws + WS_PRM) + (size_t)l * PRM_STRIDE + P_N1, (bf16*)(ws + WS_XN))); } SEAM(sb + 0); }
        if (EN(1) && RUN(sb + 1)) { _Pragma("unroll 1") for (int rp = 0; rp <= (int)REP(1); ++rp) { relaunder(F, args.ws, (LAS unsigned char*)lds_raw); unsigned char* ws = F.ws;
            pg8::Gemm g{(const bf16*)(ws + WS_XN), (const bf16*)(ws + WS_WIN) + (size_t)l * NINP * D, D, D, D};
            pg8::StaticOrder So; So.init(S, NINP - 256, F.G, F.bid); pg8::EpiIn E{ws, 0, (const LAS float*)(F.lds + RTAB_OFF)};
            pg8::fill_rstd((LAS float*)(F.lds + RTAB_OFF), (const float*)(ws + WS_RSSA), So, F.tid);
            DUP(6, (pg8::gemm_phase<pg8::EpiIn, pg8::StaticOrder, true>(F.lds, g, So, E, F.tid)));
            } SEAM(sb + 1);
        }
        if (EN(2) && RUN(sb + 2)) { _Pragma("unroll 1") for (int rp = 0; rp <= (int)REP(2); ++rp) { relaunder(F, args.ws, (LAS unsigned char*)lds_raw); unsigned char* ws = F.ws;
            if (F.bid >= F.G - 32) {
                pg8::Gemm g{(const bf16*)(ws + WS_XN), (const bf16*)(ws + WS_WIN) + ((size_t)l * NINP + (NINP - 256)) * D, D, D, D};
                pg8::StaticOrder So; So.init(S, 256, 32, F.bid - (F.G - 32)); pg8::EpiMisc E{ws, (const LAS float*)(F.lds + RTAB_OFF)};
                pg8::fill_rstd((LAS float*)(F.lds + RTAB_OFF), (const float*)(ws + WS_RSSA), So, F.tid);
                pg8::gemm_phase<pg8::EpiMisc, pg8::StaticOrder, true>(F.lds, g, So, E, F.tid);
            } else {
                const int Gs = F.G; F.G = Gs - 32;
                DUP(12, p_rwkv_prep(F, l));
                relaunder(F, args.ws, (LAS unsigned char*)lds_raw); F.G = Gs - 32; DUP(13, p_mamba_prep(F, l));
                __syncthreads(); relaunder(F, args.ws, (LAS unsigned char*)lds_raw); F.G = Gs - 32;
                for (int u = F.bid; u < 512; u += F.G) DUP(5, u_ret_kv(F, u >> 2, u & 3));
                F.G = Gs;
            }
            } SEAM(sb + 2);
        }
        if (EN(3) && RUN(sb + 3)) { _Pragma("unroll 1") for (int rp = 0; rp <= (int)REP(3); ++rp) { relaunder(F, args.ws, (LAS unsigned char*)lds_raw); unsigned char* ws = F.ws;
            { pg8::Gemm g{(const bf16*)(ws + WS_CQ), (const bf16*)(ws + WS_WQB) + (size_t)l * 1024 * 512, 512, 512, 512};
              pg8::StaticOrder So; So.init(S, 1024, F.G, F.bid); pg8::EpiQb E{ws, (const float*)(ws + WS_PRM) + (size_t)l * PRM_STRIDE + P_QNW};
              pg8::gemm_phase<pg8::EpiQb, pg8::StaticOrder, false>(F.lds, g, So, E, F.tid); __syncthreads(); }
            relaunder(F, args.ws, (LAS unsigned char*)lds_raw); ws = F.ws;
            { pg8::Gemm g{(const bf16*)(ws + WS_CKV), (const bf16*)(ws + WS_WKVB) + (size_t)l * 1024 * 256, 256, 256, 256};
              pg8::StaticOrder So; So.init(S, 1024, F.G, (F.bid + 128) % F.G); pg8::EpiKvb E{ws, (const float*)(ws + WS_PRM) + (size_t)l * PRM_STRIDE + P_KNW};
              pg8::gemm_phase<pg8::EpiKvb, pg8::StaticOrder, false>(F.lds, g, So, E, F.tid); __syncthreads(); }
            relaunder(F, args.ws, (LAS unsigned char*)lds_raw); ws = F.ws;
            if (l > 0) { pg8::Gemm g{(const bf16*)(ws + WS_VB), (const bf16*)(ws + WS_WV1) + (size_t)l * 256 * 512, 512, 512, 512};
              pg8::StaticOrder So; So.init(S, 256, F.G, (F.bid + 64) % F.G); pg8::EpiV1 E{ws};
              pg8::gemm_phase<pg8::EpiV1, pg8::StaticOrder, true>(F.lds, g, So, E, F.tid); __syncthreads(); }
            relaunder(F, args.ws, (LAS unsigned char*)lds_raw);
            for (int u = F.bid; u < 256; u += F.G) { u_mamba_dt(F, l, u >> 1); DUP(4, u_mamba_st(F, u >> 1, u & 1)); }
            } SEAM(sb + 3);
        }
        if (EN(4) && RUN(sb + 4)) { _Pragma("unroll 1") for (int rp = 0; rp <= (int)REP(4); ++rp) { relaunder(F, args.ws, (LAS unsigned char*)lds_raw); unsigned char* ws = F.ws;
            p_scans(F, F.G);
            relaunder(F, args.ws, (LAS unsigned char*)lds_raw); ws = F.ws;
            {
              pg8::Gemm g{(const bf16*)(ws + WS_ALORA), (const bf16*)(ws + WS_WLORA) + (size_t)l * 2048 * 512, 512, 512, 512};
              pg8::StaticOrder So; So.init(S, l > 0 ? 2048 : 1536, F.G, F.bid);
              const float* prm = (const float*)(ws + WS_PRM) + (size_t)l * PRM_STRIDE; pg8::EpiLora E{ws, prm + P_W0, prm + P_A0, prm + P_V0, prm + P_KA};
              DUP(9, (pg8::gemm_phase<pg8::EpiLora, pg8::StaticOrder, true>(F.lds, g, So, E, F.tid))); }
            } SEAM(sb + 4);
        }
        if (EN(5) && RUN(sb + 5)) { _Pragma("unroll 1") for (int rp = 0; rp <= (int)REP(5); ++rp) { relaunder(F, args.ws, (LAS unsigned char*)lds_raw); unsigned char* ws = F.ws; (void)ws;
            for (int u = F.bid; u < 1024; u += F.G) u_rwkv_r1(F, u >> 3, u & 7);
            relaunder(F, args.ws, (LAS unsigned char*)lds_raw);
            for (int u = F.bid; u < 512; u += F.G) DUP(1, u_ret_out(F, l, u >> 2, u & 3));
            } SEAM(sb + 5);
        }
        if (EN(6) && RUN(sb + 6)) { _Pragma("unroll 1") for (int rp = 0; rp <= (int)REP(6); ++rp) { relaunder(F, args.ws, (LAS unsigned char*)lds_raw); unsigned char* ws = F.ws; (void)ws;
            if (F.bid < NSCAN_BLK) { p_rwkv_scan2(F, F.bid); }
            else {
                const int NB = F.G - NSCAN_BLK, b = F.bid - NSCAN_BLK;
                { const int* tab = (const int*)(ws + WS_ATAB);
                  for (int r = 0; r * NB < ATT_NSUB; ++r) { const int pos = (r & 1) ? NB - 1 - b : b; const int i = r * NB + pos;
                      if (i < ATT_NSUB) { const int e = tab[i]; DUP(0, u_attn2(F, e & 3, (e >> 2) & 31, (e >> 7) & 31, e >> 12)); } } }
            }
            } SEAM(sb + 6);
        }
        if (EN(7) && RUN(sb + 7)) { _Pragma("unroll 1") for (int rp = 0; rp <= (int)REP(7); ++rp) { relaunder(F, args.ws, (LAS unsigned char*)lds_raw); unsigned char* ws = F.ws; (void)ws;
            for (int u = F.bid; u < 1024; u += F.G) DUP(3, u_rwkv_r3(F, l, u >> 3, u & 7));
            for (int u = F.bid; u < 512; u += F.G) DUP(10, u_attn_comb(F, u >> 7, (u >> 2) & 31, u & 3));
            relaunder(F, args.ws, (LAS unsigned char*)lds_raw);
            for (int u = F.bid; u < 256; u += F.G) DUP(2, u_mamba_out(F, l, u >> 1, u & 1));
            } SEAM(sb + 7);
        }
        if (EN(8) && RUN(sb + 8)) { _Pragma("unroll 1") for (int rp = 0; rp <= (int)REP(8); ++rp) { relaunder(F, args.ws, (LAS unsigned char*)lds_raw); unsigned char* ws = F.ws;
            pg8::Gemm g{(const bf16*)(ws + WS_OB), (const bf16*)(ws + WS_WBR) + (size_t)l * 8192 * 512, 512, D, 512};
            pg8::BranchOrder So; So.init(F.G, F.bid); pg8::EpiBranch E{ws};
            DUP(8, (pg8::gemm_phase<pg8::EpiBranch, pg8::BranchOrder, true>(F.lds, g, So, E, F.tid)));
            } SEAM(sb + 8);
        }
        if (EN(9) && RUN(sb + 9)) { _Pragma("unroll 1") for (int rp = 0; rp <= (int)REP(9); ++rp) { relaunder(F, args.ws, (LAS unsigned char*)lds_raw); unsigned char* ws = F.ws;
            pg8::Gemm g{(const bf16*)(ws + WS_MERGED), (const bf16*)(ws + WS_WOUT) + (size_t)l * D * D, D, D, D};
            pg8::StaticOrder So; So.init(S, D, F.G, F.bid); pg8::EpiRes E{xin, args.out, (bf16*)(ws + WS_XN), (float*)(ws + WS_RSSB)};
            pg8::gemm_phase<pg8::EpiRes, pg8::StaticOrder, true>(F.lds, g, So, E, F.tid);
            } SEAM(sb + 9);
        }
        if (EN(10) && RUN(sb + 10)) { _Pragma("unroll 1") for (int rp = 0; rp <= (int)REP(10); ++rp) { relaunder(F, args.ws, (LAS unsigned char*)lds_raw); unsigned char* ws = F.ws; DUP(11, p_rmsnorm(F, args.out, (const float*)(ws + WS_PRM) + (size_t)l * PRM_STRIDE + P_N2, (bf16*)(ws + WS_XN))); } SEAM(sb + 10); }
        if (EN(11) && RUN(sb + 11)) { _Pragma("unroll 1") for (int rp = 0; rp <= (int)REP(11); ++rp) { relaunder(F, args.ws, (LAS unsigned char*)lds_raw); unsigned char* ws = F.ws;
            pg8::Gemm g{(const bf16*)(ws + WS_XN), (const bf16*)(ws + WS_WGU) + (size_t)l * 2 * DFF * D, D, D, D};
            pg8::StaticOrder So; So.init(S, 2 * DFF, F.G, F.bid); pg8::EpiGu E{ws, (const LAS float*)(F.lds + RTAB_OFF)};
            pg8::fill_rstd((LAS float*)(F.lds + RTAB_OFF), (const float*)(ws + WS_RSSB), So, F.tid);
            DUP(7, (pg8::gemm_phase<pg8::EpiGu, pg8::StaticOrder, true>(F.lds, g, So, E, F.tid)));
            } SEAM(sb + 11);
        }
        if (EN(12) && RUN(sb + 12)) { _Pragma("unroll 1") for (int rp = 0; rp <= (int)REP(12); ++rp) { relaunder(F, args.ws, (LAS unsigned char*)lds_raw); unsigned char* ws = F.ws;
            pg8::Gemm g{(const bf16*)(ws + WS_ACT), (const bf16*)(ws + WS_WDN) + (size_t)l * D * DFF, DFF, DFF, DFF};
            pg8::StaticOrder So; So.init(S, D, F.G, F.bid); pg8::EpiRes E{args.out, args.out, (bf16*)(ws + WS_XN), (l + 1 < DEPTH) ? (float*)(ws + WS_RSSA) : nullptr};
            pg8::gemm_phase<pg8::EpiRes, pg8::StaticOrder, true>(F.lds, g, So, E, F.tid);
            } SEAM(sb + 12);
        }
    }
#undef RUN
#undef SEAM
}

#ifndef MK_ONE_LAUNCH
#define MK_ONE_LAUNCH 1
#endif
extern "C" void kernel_launch(void* const* d_in, const int* in_sizes, int n_in, void* d_out, int out_size, void* d_ws, size_t ws_size, hipStream_t stream) {
    static int grid = 0;
    if (grid == 0) {
        if (n_in != 36 || in_sizes[0] != S * D || out_size != S * D || ws_size < WS_END3) { fprintf(stderr, "kernel_launch: bad shapes: n_in %d in0 %d out %d ws %zu (need %zu)\n", n_in, n_in > 0 ? in_sizes[0] : -1, out_size, ws_size, (size_t)WS_END3); grid = -1; return; }
        int dev = 0, cus = 0, per_cu = 0;
        if (hipGetDevice(&dev) != hipSuccess || hipDeviceGetAttribute(&cus, hipDeviceAttributeMultiprocessorCount, dev) != hipSuccess) { grid = -1; return; }
        if (hipFuncSetAttribute((const void*)mk_fwd, hipFuncAttributeMaxDynamicSharedMemorySize, LDS_BYTES) != hipSuccess) { fprintf(stderr, "kernel_launch: hipFuncSetAttribute failed\n"); grid = -1; return; }
        if (hipOccupancyMaxActiveBlocksPerMultiprocessor(&per_cu, (const void*)mk_fwd, NTHR, LDS_BYTES) != hipSuccess || per_cu < 1) fprintf(stderr, "kernel_launch: occupancy query says %d\n", per_cu);
        (void)hipGetLastError();
        grid = cus;
        if (grid != 256) fprintf(stderr, "kernel_launch: %d CUs (built for 256)\n", grid);
    }
    if (grid < 0) return;
    if (hipMemsetAsync((char*)d_ws + WS_CTL, 0, CTL_ZERO_BYTES, stream) != hipSuccess) return;
    Args a{};
    for (int i = 0; i < 36; ++i) a.in[i] = (const float*)d_in[i];
    a.out = (float*)d_out; a.ws = (unsigned char*)d_ws;
#if MK_ONE_LAUNCH
    a.st_lo = 0; a.st_hi = NSTEPS;
    hipLaunchKernelGGL(mk_fwd, dim3(grid), dim3(NTHR), LDS_BYTES, stream, a);
#ifndef MK_EXTRA_FLAGS
#define MK_EXTRA_FLAGS 0
#endif
#ifdef MK_EXTRA_STEPS
    { const int xs[] = {MK_EXTRA_STEPS};
      for (int r = 0; r < MK_EXTRA_N; ++r) for (unsigned i = 0; i < sizeof(xs) / sizeof(xs[0]); ++i) { a.st_lo = xs[i]; a.st_hi = xs[i] + 1; hipLaunchKernelGGL(mk_fwd, dim3(grid), dim3(NTHR), LDS_BYTES, stream, a); } }
#endif
#else
    for (int s = 0; s < NSTEPS; ++s) { a.st_lo = s; a.st_hi = s + 1; hipLaunchKernelGGL(mk_fwd, dim3(grid), dim3(NTHR), LDS_BYTES, stream, a); }
#endif
}
```

```cpp
#include <hip/hip_runtime.h>
#include <cstdio>
#include <cstdint>

#define GAS __attribute__((address_space(1)))
#define LAS __attribute__((address_space(3)))
typedef unsigned short bf16;
typedef short bf16x8 __attribute__((ext_vector_type(8)));
typedef short s16x4 __attribute__((ext_vector_type(4)));
typedef float f32x4 __attribute__((ext_vector_type(4)));
typedef float f32x2 __attribute__((ext_vector_type(2)));
typedef unsigned u32x4 __attribute__((ext_vector_type(4)));
typedef unsigned u32x2 __attribute__((ext_vector_type(2)));
typedef GAS unsigned gu32;
#define RLX_AGENT __ATOMIC_RELAXED, __HIP_MEMORY_SCOPE_AGENT
#define DI __device__ __forceinline__

constexpr int S = 8192, D = 2048, DEPTH = 4, NIN = 14408, NINP = 14592, DFF = 5632;
constexpr int NCH = 128;
constexpr float LOG2E = 1.4426950408889634f;

DI float bf2f(unsigned v) { return __uint_as_float(v << 16); }
typedef __bf16 bf16x2_t __attribute__((ext_vector_type(2)));
DI unsigned pk2(float lo, float hi) { const f32x2 v = {lo, hi}; const bf16x2_t b = __builtin_convertvector(v, bf16x2_t); return __builtin_bit_cast(unsigned, b); }
DI unsigned f2bf(float f) { const __bf16 b = (__bf16)f; return (unsigned)__builtin_bit_cast(unsigned short, b); }
DI float fexp_(float x) { return __builtin_amdgcn_exp2f(x * 1.4426950408889634f); }
DI float ftanh_(float x) { return 1.0f - 2.0f * __builtin_amdgcn_rcpf(1.0f + fexp_(2.0f * x)); }
DI float sigmoidf_(float x) { return __builtin_amdgcn_rcpf(1.0f + fexp_(-x)); }
DI float siluf_(float x) { return x * __builtin_amdgcn_rcpf(1.0f + fexp_(-x)); }
DI float softplusf_(float x) { return fmaxf(x, 0.f) + log1pf(fexp_(-fabsf(x))); }
DI u32x4 pack8(const f32x4 a, const f32x4 b) { u32x4 w; w.x = pk2(a[0], a[1]); w.y = pk2(a[2], a[3]); w.z = pk2(b[0], b[1]); w.w = pk2(b[2], b[3]); return w; }
DI void unpack8(const u32x4 w, float (&o)[8]) { o[0] = bf2f(w.x & 0xffffu); o[1] = bf2f(w.x >> 16); o[2] = bf2f(w.y & 0xffffu); o[3] = bf2f(w.y >> 16);
    o[4] = bf2f(w.z & 0xffffu); o[5] = bf2f(w.z >> 16); o[6] = bf2f(w.w & 0xffffu); o[7] = bf2f(w.w >> 16); }

namespace pg8 {
constexpr int BM = 256, BK = 64, HALF = 128, HTB = HALF * BK * 2, STAGE_BYTES = 8 * HTB, NXCD = 8, WGM = 8;
DI int lds_byte(int r, int c) { const int st = (r >> 4) * 2 + (c >> 5), rr = r & 15, cc = c & 31, ob = rr * 64 + cc * 2; return st * 1024 + (ob ^ (((ob >> 9) & 1) << 5)); }
DI void stage_rc(int b, int& R, int& C) { const int st = b / 1024, sb = b % 1024, swz = sb ^ (((sb >> 9) & 1) << 5); R = (st >> 1) * 16 + swz / 64; C = (st & 1) * 32 + (swz % 64) / 2; }
DI int perm32(int rho) { const int n = rho >> 4, i = rho & 15; return 8 * (i >> 2) + 4 * n + (i & 3); }

struct Unit { int pm, pn, ak, brow, sub, ord; };
struct Gemm { const bf16* A; const bf16* Bt; int K, lda, ldb; };

struct StaticOrder {
    int nM, nN, nwg, G, c;
    DI void init(int M, int N, int G_, int c_) { nM = M / BM; nN = N / BM; nwg = nM * nN; G = G_; c = c_; }
    DI bool next(int i, Unit& u) const {
        const long L = (long)i * G + c; if (L >= nwg) return false;
        int wgid = (int)L; { const int q = nwg / NXCD, r = nwg % NXCD, xcd = wgid % NXCD, off = wgid / NXCD; wgid = (xcd < r ? xcd * (q + 1) : r * (q + 1) + (xcd - r) * q) + off; }
        const int nig = WGM * nN, gid = wgid / nig, fm = gid * WGM, gsz = (nM - fm) < WGM ? (nM - fm) : WGM;
        u.pm = fm + ((wgid % nig) % gsz); u.pn = (wgid % nig) / gsz; u.ak = 0; u.brow = u.pn * BM; u.sub = 0; return true;
    }
};
struct LoraOrder {
    StaticOrder so;
    DI void init(int N, int G_, int c_) { so.init(S, N, G_, c_); }
    DI bool next(int i, Unit& u) const { if (!so.next(i, u)) return false; u.ak = (u.pn >= 4) ? 256 : 0; return true; }
};
struct BranchOrder {
    StaticOrder so;
    DI void init(int G_, int c_) { so.init(S, D, G_, c_); }
    DI bool next(int i, Unit& u) const { if (!so.next(i >> 2, u)) return false; u.sub = i & 3; u.ak = u.sub * 512; u.brow = u.sub * D + u.pn * BM; return true; }
};

typedef f32x4 Acc[2][2][4][2];

template <class Epi, class Sched, bool ALIGN_EPI>
DI void gemm_phase(LAS unsigned char* lds, const Gemm g, const Sched& Sc, const Epi& E, const int tid) {
    const int wid = __builtin_amdgcn_readfirstlane(tid >> 6), lane = tid & 63, wr = wid >> 2, wc = wid & 3, fr = lane & 15, fq = lane >> 4;
    const int K = g.K, nt = K / BK;
    unsigned voffA[2], voffB[2];
#pragma unroll
    for (int i = 0; i < 2; ++i) { int R, C; stage_rc(tid * 16 + i * 8192, R, C); const int Rb = (R & ~31) + perm32(R & 31);
        voffA[i] = (unsigned)(R * g.lda + C) * 2u; voffB[i] = (unsigned)(Rb * g.ldb + C) * 2u; }
    const size_t kstep = (size_t)(BK * 2);
    const size_t hA = (size_t)HALF * g.lda * 2, hB = (size_t)HALF * g.ldb * 2;
    const unsigned ldsw = (unsigned)wid * 1024u;
    const int aoff = lds_byte(wr * 64 + fr, fq * 8), boff = lds_byte(wc * 32 + fr, fq * 8);
#define PG8_SA(b, h) (((b) * 2 + (h)) * HTB)
#define PG8_SB(b, h) ((4 + (b) * 2 + (h)) * HTB)
#define PG8_STAGE(bufoff, gbase, voff) do { _Pragma("unroll") for (int _i = 0; _i < 2; ++_i) \
        __builtin_amdgcn_global_load_lds((const unsigned*)((const char*)(gbase) + (voff)[_i]), (LAS unsigned*)(lds + (bufoff) + ldsw + _i * 8192), 16, 0, 0); } while (0)
#define PG8_LDA(dst, b, h) do { _Pragma("unroll") for (int m = 0; m < 4; ++m) _Pragma("unroll") for (int k = 0; k < 2; ++k) dst[m][k] = *(const LAS bf16x8*)(lds + PG8_SA(b, h) + aoff + m * 2048 + k * 1024); } while (0)
#define PG8_LDB(dst, b, h) do { _Pragma("unroll") for (int n = 0; n < 2; ++n) _Pragma("unroll") for (int k = 0; k < 2; ++k) dst[n][k] = *(const LAS bf16x8*)(lds + PG8_SB(b, h) + boff + n * 2048 + k * 1024); } while (0)
#define PG8_MMA(ai, bj, At, Bt) do { __builtin_amdgcn_s_setprio(1); _Pragma("unroll") for (int m = 0; m < 4; ++m) _Pragma("unroll") for (int n = 0; n < 2; ++n) _Pragma("unroll") for (int k = 0; k < 2; ++k) \
        acc[ai][bj][m][n] = __builtin_amdgcn_mfma_f32_16x16x32_bf16(Bt[n][k], At[m][k], acc[ai][bj][m][n], 0, 0, 0); __builtin_amdgcn_s_setprio(0); } while (0)
#define PG8_WAIT_V(n) asm volatile("s_waitcnt vmcnt(" #n ")" ::: "memory")
#define PG8_WAIT_L(n) asm volatile("s_waitcnt lgkmcnt(" #n ")" ::: "memory")
#define PG8_BAR __builtin_amdgcn_s_barrier()
#define PG8_SCHED __builtin_amdgcn_sched_barrier(0)
    Unit cur, nxt; int ui = 0;
    if (!Sc.next(0, cur)) return;
    cur.ord = 0;
    Acc acc;
#pragma unroll
    for (int a = 0; a < 2; ++a)
#pragma unroll
        for (int b = 0; b < 2; ++b)
#pragma unroll
            for (int m = 0; m < 4; ++m)
#pragma unroll
                for (int n = 0; n < 2; ++n) acc[a][b][m][n] = (f32x4){0.f, 0.f, 0.f, 0.f};
    bf16x8 At[4][2], B0[2][2], B1[2][2];
    const char* cA = (const char*)g.A + ((size_t)cur.pm * BM * g.lda + cur.ak) * 2; const char* cB = (const char*)g.Bt + (size_t)cur.brow * g.ldb * 2;
    PG8_STAGE(PG8_SB(0, 0), cB, voffB); PG8_STAGE(PG8_SB(0, 1), cB + hB, voffB); PG8_STAGE(PG8_SA(0, 0), cA, voffA); PG8_STAGE(PG8_SA(0, 1), cA + hA, voffA);
    if (wr == 1) PG8_BAR;
    PG8_WAIT_V(2); PG8_BAR;
    PG8_STAGE(PG8_SB(1, 0), cB + kstep, voffB); PG8_STAGE(PG8_SA(1, 0), cA + kstep, voffA); PG8_STAGE(PG8_SB(1, 1), cB + hB + kstep, voffB);
    PG8_WAIT_V(6); PG8_BAR;
    for (;;) {
        const bool has_next = Sc.next(ui + 1, nxt); nxt.ord = ui + 1;
        const char* nA = has_next ? (const char*)g.A + ((size_t)nxt.pm * BM * g.lda + nxt.ak) * 2 : cA; const char* nB = has_next ? (const char*)g.Bt + (size_t)nxt.brow * g.ldb * 2 : cB;
        for (int t = 0; t < nt; t += 2) {
            const bool last = (t == nt - 2);
            const char* a1 = cA + (size_t)(t + 1) * kstep;
            const char* a2 = last ? nA : cA + (size_t)(t + 2) * kstep; const char* b2 = last ? nB : cB + (size_t)(t + 2) * kstep;
            const char* a3 = a2 + kstep; const char* b3 = b2 + kstep;
            PG8_LDB(B0, 0, 0); PG8_LDB(B1, 0, 1); PG8_SCHED; PG8_LDA(At, 0, 0); PG8_STAGE(PG8_SA(1, 1), a1 + hA, voffA);
            PG8_WAIT_V(8); PG8_WAIT_L(0); PG8_BAR; PG8_MMA(0, 0, At, B0); PG8_MMA(0, 1, At, B1); PG8_BAR; PG8_SCHED;
            PG8_LDA(At, 0, 1); PG8_STAGE(PG8_SB(0, 0), b2, voffB); PG8_STAGE(PG8_SB(0, 1), b2 + hB, voffB); PG8_STAGE(PG8_SA(0, 0), a2, voffA);
            PG8_WAIT_V(8); PG8_WAIT_L(0); PG8_BAR; PG8_MMA(1, 0, At, B0); PG8_MMA(1, 1, At, B1); PG8_BAR; PG8_SCHED;
            PG8_LDB(B0, 1, 0); PG8_LDB(B1, 1, 1); PG8_SCHED; PG8_LDA(At, 1, 0); PG8_STAGE(PG8_SA(0, 1), a2 + hA, voffA);
            PG8_WAIT_V(8); PG8_WAIT_L(0); PG8_BAR; PG8_MMA(0, 0, At, B0); PG8_MMA(0, 1, At, B1); PG8_BAR; PG8_SCHED;
            PG8_LDA(At, 1, 1); PG8_STAGE(PG8_SB(1, 0), b3, voffB); PG8_STAGE(PG8_SB(1, 1), b3 + hB, voffB); PG8_STAGE(PG8_SA(1, 0), a3, voffA);
            PG8_WAIT_V(8); PG8_WAIT_L(0); PG8_BAR; PG8_MMA(1, 0, At, B0); PG8_MMA(1, 1, At, B1); PG8_BAR; PG8_SCHED;
        }
        if constexpr (ALIGN_EPI) { if (wr == 0) PG8_BAR; }
        bool zero = true;
        if constexpr (!Epi::AFTER_DRAIN) { zero = E(acc, cur, wr, wc, fr, fq); }
        if (!has_next) break;
        if (zero) {
#pragma unroll
        for (int a = 0; a < 2; ++a)
#pragma unroll
            for (int b = 0; b < 2; ++b)
#pragma unroll
                for (int m = 0; m < 4; ++m)
#pragma unroll
                    for (int n = 0; n < 2; ++n) acc[a][b][m][n] = (f32x4){0.f, 0.f, 0.f, 0.f};
        }
        cur = nxt; cA = nA; cB = nB; ++ui;
        if constexpr (ALIGN_EPI) { if (wr == 1) PG8_BAR; }
    }
    PG8_WAIT_V(0);
    if constexpr (!ALIGN_EPI) { if (wr == 0) PG8_BAR; }
    PG8_BAR;
    if constexpr (Epi::AFTER_DRAIN) { E.fused(acc, cur, wr, wc, fr, fq, lds, wid, lane, tid); }
#undef PG8_SA
#undef PG8_SB
#undef PG8_STAGE
#undef PG8_LDA
#undef PG8_LDB
#undef PG8_MMA
#undef PG8_WAIT_V
#undef PG8_WAIT_L
#undef PG8_BAR
#undef PG8_SCHED
}
}

constexpr size_t MiB = 1u << 20;
constexpr size_t al256(size_t x) { return (x + 255) & ~(size_t)255; }
constexpr size_t WS_CTL = 0, CTL_ZERO_BYTES = 1 * MiB;
constexpr size_t WS_PRM = 1 * MiB;
constexpr int P_N1 = 0, P_N2 = 2048, P_GN = 4096, P_CW = 4608, P_CB = 8704, P_DTB = 9728, P_ALOG = 9736, P_SD = 9744, P_SNW = 9760, P_QNW = 10272, P_KNW = 10464, P_MU = 10656,
              P_W0 = 12448, P_A0 = 12960, P_V0 = 13472, P_KK = 13984, P_KA = 14496, P_RK = 15008, P_LNW = 15520, P_LNB = 16032, PRM_STRIDE = 16640;
constexpr size_t WS_COSR = 2 * MiB;
constexpr size_t WS_SINR = WS_COSR + (size_t)S * 64 * 4;
constexpr size_t WS_COSM = WS_SINR + (size_t)S * 64 * 4;
constexpr size_t WS_SINM = WS_COSM + (size_t)S * 32 * 4;
constexpr size_t WS_WIN  = WS_SINM + (size_t)S * 32 * 4;
constexpr size_t WS_WQB  = WS_WIN + (size_t)DEPTH * NINP * D * 2;
constexpr size_t WS_WKVB = WS_WQB + (size_t)DEPTH * 1024 * 512 * 2;
constexpr size_t WS_WV1  = WS_WKVB + (size_t)DEPTH * 1024 * 256 * 2;
constexpr size_t WS_WLORA = WS_WV1 + (size_t)DEPTH * 256 * 512 * 2;
constexpr size_t WS_WBR  = WS_WLORA + (size_t)DEPTH * 2048 * 512 * 2;
constexpr size_t WS_WOUT = WS_WBR + (size_t)DEPTH * 8192 * 512 * 2;
constexpr size_t WS_WGU  = WS_WOUT + (size_t)DEPTH * D * D * 2;
constexpr size_t WS_WDN  = WS_WGU + (size_t)DEPTH * 2 * DFF * D * 2;
constexpr size_t WS_ACT0 = WS_WDN + (size_t)DEPTH * D * DFF * 2;
constexpr size_t WS_XN   = WS_ACT0;
constexpr size_t WS_QR   = WS_XN + (size_t)S * D * 2;
constexpr size_t WS_KR   = WS_QR + (size_t)S * 512 * 2;
constexpr size_t WS_VR   = WS_KR + (size_t)S * 512 * 2;
constexpr size_t WS_GR   = WS_VR + (size_t)S * 512 * 2;
constexpr size_t WS_ZS   = WS_GR + (size_t)S * 512 * 2;
constexpr size_t WS_XBC  = WS_ZS + (size_t)S * 512 * 2;
constexpr size_t WS_XC   = WS_XBC + (size_t)S * 1024 * 2;
constexpr size_t WS_CQ   = WS_XC + (size_t)S * 1024 * 2;
constexpr size_t WS_CKV  = WS_CQ + (size_t)S * 512 * 2;
constexpr size_t WS_SSQ  = WS_CKV + (size_t)S * 256 * 2;
constexpr size_t WS_RW   = WS_SSQ + (size_t)S * 16 * 4;
constexpr size_t WS_GATE = WS_RW + (size_t)S * 1792 * 4;
constexpr size_t WS_MISC = WS_GATE + (size_t)S * 8192 * 2;
constexpr size_t WS_DTS  = WS_MISC + (size_t)S * 256 * 4;
constexpr size_t WS_ACS  = WS_DTS + (size_t)S * 8 * 4;
constexpr size_t WS_RKV  = WS_ACS + (size_t)S * 8 * 4;
constexpr size_t WS_MST  = WS_RKV + (size_t)NCH * 4 * 128 * 128 * 4;
constexpr size_t WS_QM   = WS_MST + (size_t)NCH * 8 * 64 * 128 * 4;
constexpr size_t WS_KM   = WS_QM + (size_t)S * 768 * 2;
constexpr size_t WS_VT   = WS_KM + (size_t)S * 768 * 2;
constexpr size_t WS_R32  = WS_VT + (size_t)512 * S * 2;
constexpr size_t SZ32    = (size_t)S * 512 * 4;
constexpr size_t WS_KKN  = WS_R32 + SZ32, WS_K32 = WS_KKN + SZ32, WS_VV = WS_K32 + SZ32, WS_VFIRST = WS_VV + SZ32, WS_DEC = WS_VFIRST + SZ32,
                 WS_KP = WS_DEC + SZ32, WS_BB = WS_KP + SZ32, WS_G32 = WS_BB + SZ32, WS_Y32 = WS_G32 + SZ32;
constexpr size_t WS_VB   = WS_Y32 + SZ32;
constexpr size_t WS_ALORA = WS_VB + (size_t)S * 512 * 2;
constexpr size_t WS_OB   = WS_ALORA + (size_t)S * 512 * 2;
constexpr size_t WS_MERGED = WS_OB + (size_t)S * D * 2;
constexpr size_t WS_ACT  = WS_MERGED + (size_t)S * D * 2;
constexpr size_t WS_END  = WS_ACT + (size_t)S * DFF * 2;

constexpr int CW_TMO = 0, CW_CODE = 1, CW_BAR = 4096;


constexpr int NWAVES = 8, NTHR = 512;
constexpr int RING_BYTES = 143360, LDSCTL_OFF = RING_BYTES, MISC_OFF = LDSCTL_OFF + 320, LDS_BYTES = 147456;
#define LDS_WAIT() asm volatile("s_waitcnt lgkmcnt(0)" ::: "memory")
#define VM_WAIT() asm volatile("s_waitcnt vmcnt(0)" ::: "memory")

#define XB_TMO      128
#define XB_XCNT(j)  (256  + 64 * (j))
#define XB_XSUB(j)  (1280 + 64 * (j))
#define XB_XGEN(j)  (2304 + 64 * (j))
#define XB_TOP      3328
#define XB_TOPGEN   3392
#define XCD_BAR_WORDS 3456
#define XB_SPIN_CAP (1u << 22)
DI unsigned xb_ld(unsigned* p)              { return __hip_atomic_load(p, __ATOMIC_RELAXED, __HIP_MEMORY_SCOPE_AGENT); }
DI unsigned xb_add(unsigned* p, unsigned v) { return __hip_atomic_fetch_add(p, v, __ATOMIC_RELAXED, __HIP_MEMORY_SCOPE_AGENT); }
DI unsigned xb_xcc_id() { return (unsigned)__builtin_amdgcn_s_getreg((3 << 11) | 20) & 0xFu; }
#define XB_SPIN(cond, bar) do { unsigned _sp = 0; while (cond) { __builtin_amdgcn_s_sleep(1); \
    if ((++_sp & 255u) == 0u) { if (xb_ld(&(bar)[XB_TMO])) break; if (_sp > XB_SPIN_CAP) { atomicAdd(&(bar)[XB_TMO], 1u); break; } } } } while (0)
struct XcdBarrier { unsigned* bar; unsigned x; volatile LAS unsigned* st; };
DI XcdBarrier xcd_barrier_post(unsigned* bar, volatile LAS unsigned* st) {
    XcdBarrier b; b.bar = bar; b.x = xb_xcc_id(); b.st = st;
    if (threadIdx.x == 0) (void)xb_add(&bar[XB_XCNT(b.x)], 1u);
    return b;
}
DI void xcd_barrier_complete(unsigned* bar, unsigned x, unsigned& nloc, unsigned& nx) {
    const unsigned G = gridDim.x * gridDim.y * gridDim.z;
    unsigned sum, cnt, mine, sp = 0u;
    for (;;) {
        sum = 0u; cnt = 0u; mine = 0u;
#pragma unroll
        for (unsigned j = 0; j < 16; ++j) { const unsigned c = xb_ld(&bar[XB_XCNT(j)]); sum += c; cnt += (c > 0u) ? 1u : 0u; mine = (j == x) ? c : mine; }
        if (sum == G) break;
        __builtin_amdgcn_s_sleep(1);
        if ((++sp & 255u) == 0u) { if (xb_ld(&bar[XB_TMO])) break; if (sp > XB_SPIN_CAP) { atomicAdd(&bar[XB_TMO], 1u); break; } }
    }
    nloc = mine > 0u ? mine : 1u; nx = cnt > 0u ? cnt : 1u;
}
DI void xcd_barrier(const XcdBarrier& b) {
    asm volatile("s_waitcnt vmcnt(0)" ::: "memory");
    __syncthreads();
    if (threadIdx.x == 0) {
        unsigned* bar = b.bar;
        __builtin_amdgcn_s_waitcnt(0);
        unsigned nloc = b.st[0], nx = b.st[1];
        if (nloc == 0u) { xcd_barrier_complete(bar, b.x, nloc, nx); b.st[0] = nloc; b.st[1] = nx; }
        const unsigned old = xb_add(&bar[XB_XSUB(b.x)], 1u);
        const unsigned gen = old / nloc;
        if (old + 1u == (gen + 1u) * nloc) {
            __builtin_amdgcn_fence(__ATOMIC_RELEASE, "agent");
            asm volatile("s_waitcnt vmcnt(0)" ::: "memory");
            const unsigned og = xb_add(&bar[XB_TOP], 1u);
            const unsigned tg = og / nx;
            if (og + 1u == (tg + 1u) * nx) xb_add(&bar[XB_TOPGEN], 1u);
            else XB_SPIN(xb_ld(&bar[XB_TOPGEN]) == tg, bar);
            __builtin_amdgcn_fence(__ATOMIC_ACQUIRE, "agent");
            xb_add(&bar[XB_XGEN(b.x)], 1u);
            asm volatile("s_waitcnt vmcnt(0)" ::: "memory");
        } else {
            XB_SPIN(xb_ld(&bar[XB_XGEN(b.x)]) == gen, bar);
            __builtin_amdgcn_fence(__ATOMIC_ACQUIRE, "agent");
            asm volatile("s_waitcnt vmcnt(0)" ::: "memory");
        }
    }
    __syncthreads();
}

struct Args { const float* in[36]; float* out; unsigned char* ws; int st_lo, st_hi; };
struct Frame {
    LAS unsigned char* lds; volatile LAS unsigned* MISC; gu32* ctl;
    int tid, lane, wave, G, bid;
    unsigned char* ws;
};
DI void relaunder(Frame& F, unsigned char* ws0, LAS unsigned char* lds0) {
    int t = threadIdx.x; asm volatile("" : "+v"(t)); F.tid = t; F.lane = t & 63; F.wave = __builtin_amdgcn_readfirstlane(t >> 6);
    unsigned long long w = (unsigned long long)ws0; asm volatile("" : "+s"(w)); F.ws = (unsigned char*)w; F.ctl = (gu32*)(F.ws + WS_CTL);
    unsigned lb = (unsigned)(unsigned long)lds0; asm volatile("" : "+s"(lb)); F.lds = (LAS unsigned char*)(unsigned long)lb; F.MISC = (volatile LAS unsigned*)(F.lds + MISC_OFF);
    int b = blockIdx.x; asm volatile("" : "+s"(b)); F.bid = b;
}
#define XR_SWAP(INS, a, b) asm volatile("s_nop 1\n\t" INS " %0, %1" : "+v"(a), "+v"(b))
DI float xr16_max(float x) { float a = x, b = x; XR_SWAP("v_permlane16_swap_b32", a, b); return fmaxf(a, b); }
DI float xr32_max(float x) { float a = x, b = x; XR_SWAP("v_permlane32_swap_b32", a, b); return fmaxf(a, b); }
DI float xr16_sum(float x) { float a = x, b = x; XR_SWAP("v_permlane16_swap_b32", a, b); return a + b; }
DI float xr32_sum(float x) { float a = x, b = x; XR_SWAP("v_permlane32_swap_b32", a, b); return a + b; }
template <int CTRL> DI float dpp_f(float v) { return __builtin_bit_cast(float, __builtin_amdgcn_update_dpp(0, __builtin_bit_cast(int, v), CTRL, 0xf, 0xf, true)); }
DI float row_sum16(float v) { v += dpp_f<0xB1>(v); v += dpp_f<0x4E>(v); v += dpp_f<0x141>(v); v += dpp_f<0x140>(v); return v; }
DI float wave_sum(float v) { return xr32_sum(xr16_sum(row_sum16(v))); }
DI float wave_sum_dpp(float v) {
    const float t = row_sum16(v);
    const float s0 = __builtin_bit_cast(float, __builtin_amdgcn_readlane(__builtin_bit_cast(int, t), 0));
    const float s1 = __builtin_bit_cast(float, __builtin_amdgcn_readlane(__builtin_bit_cast(int, t), 16));
    const float s2 = __builtin_bit_cast(float, __builtin_amdgcn_readlane(__builtin_bit_cast(int, t), 32));
    const float s3 = __builtin_bit_cast(float, __builtin_amdgcn_readlane(__builtin_bit_cast(int, t), 48));
    return (s0 + s1) + (s2 + s3);
}
constexpr size_t WS_QYT = WS_END;
constexpr size_t WS_CYT = WS_QYT + (size_t)1024 * 4096 * 2;
constexpr size_t WS_TST = WS_CYT + (size_t)1024 * 4096 * 2;
constexpr size_t WS_NST = WS_TST + (size_t)1024 * 4096 * 2;
constexpr size_t WS_S0  = WS_NST + (size_t)1024 * 4096 * 4;
constexpr size_t WS_END2 = WS_S0 + (size_t)1024 * 4096 * 2;
constexpr int ATT_NSUB = 576, ATT_RUN = 16;
constexpr size_t WS_ATAB = WS_END2;
constexpr size_t WS_APO  = WS_ATAB + 8192;
constexpr size_t WS_APM  = WS_APO + (size_t)ATT_NSUB * 32768 * 4;
constexpr size_t WS_RSSA = WS_APM + (size_t)ATT_NSUB * 512 * 4;
constexpr size_t WS_RSSB = WS_RSSA + (size_t)S * 32 * 4;
constexpr size_t WS_END3 = WS_RSSB + (size_t)S * 32 * 4;
constexpr int RTAB_OFF = 131072;
DI int att_slot(int h, int qb, int s) { const int g = qb >> 2; return h * 144 + (g + 1) * (qb - 2 * g) + s; }

DI int map_in(int n) {
    const int T = n >> 8, c = n & 255;
    if (T < 4) { const int base = (T >> 1) * 512, tp = T & 1, half = c >> 7, hs = (c >> 6) & 1, j = c & 63; return base + (2 * tp + hs) * 128 + half * 64 + j; }
    if (T < 6) return 1024 + (T - 4) * 256 + c;
    if (T < 8) return 1536 + (T - 6) * 256 + c;
    if (T < 10) return 2048 + (T - 8) * 256 + c;
    if (T < 14) return 2560 + (T - 10) * 256 + c;
    if (T < 16) return 3592 + (T - 14) * 256 + c;
    if (T == 16) return 4104 + c;
    if (T < 24) return 4424 + (T - 17) * 256 + c;
    if (T < 56) return 6216 + (T - 24) * 256 + c;
    if (c < 8) return 3584 + c;
    if (c < 72) return 4360 + (c - 8);
    return -1;
}
DI int map_fn(int mapid, int n, int Nsrc) {
    if (mapid == 0) return n < Nsrc ? n : -1;
    if (mapid == 1) return map_in(n);
    if (mapid == 2) { const int T = n >> 8, c = n & 255; return c < 128 ? T * 128 + c : DFF + T * 128 + (c - 128); }
    if (mapid == 3) { const int h = n >> 8, c = n & 255; if (c < 96) return h * 192 + c; if (c < 128) return h * 192 + 128 + (c - 96); if (c < 160) return h * 192 + 96 + (c - 128); if (c < 224) return -1; return h * 192 + 160 + (c - 224); }
    return n < 32 ? n : -1;
}
DI void conv_item(const float* W, int K, int Nsrc, bf16* Wt, const float* kscale, int mapid, LAS bf16* tile, int item, int nblk, int lane) {
    const int kb = item / nblk, nb = item - kb * nblk, k0 = 64 * kb, n0 = 64 * nb;
    const int src = map_fn(mapid, n0 + lane, Nsrc);
    const float* wp = W + (size_t)k0 * Nsrc + (src >= 0 ? src : 0);
#pragma unroll
    for (int hf = 0; hf < 2; ++hf) { float v[32];
#pragma unroll
        for (int i = 0; i < 32; ++i) v[i] = wp[(size_t)(32 * hf + i) * Nsrc];
        if (src < 0) {
#pragma unroll
            for (int i = 0; i < 32; ++i) v[i] = 0.f; }
        if (kscale) {
#pragma unroll
            for (int i = 0; i < 32; ++i) v[i] *= kscale[k0 + 32 * hf + i]; }
#pragma unroll
        for (int q = 0; q < 4; ++q) { u32x4 o; o.x = pk2(v[8 * q], v[8 * q + 1]); o.y = pk2(v[8 * q + 2], v[8 * q + 3]); o.z = pk2(v[8 * q + 4], v[8 * q + 5]); o.w = pk2(v[8 * q + 6], v[8 * q + 7]);
            *(LAS u32x4*)(tile + lane * 72 + 32 * hf + 8 * q) = o; } }
    LDS_WAIT(); asm volatile("" ::: "memory");
#pragma unroll
    for (int i = 0; i < 8; ++i) { const int r = i * 8 + (lane >> 3), c8 = lane & 7;
        *(GAS u32x4*)(Wt + (size_t)(n0 + r) * K + k0 + 8 * c8) = *(const LAS u32x4*)(tile + r * 72 + 8 * c8); }
    LDS_WAIT(); asm volatile("" ::: "memory");
}
struct ConvJob { const float* W; bf16* Wt; const float* kscale; int K, Nsrc, Ndst, mapid; };
DI void conv_job(Frame& F, const ConvJob j, int& base) {
    const int nblk = j.Ndst / 64, nitems = (j.K / 64) * nblk, NGW = F.G * NWAVES, gw = F.bid * NWAVES + F.wave;
    int first = (gw - base % NGW + NGW) % NGW; LAS bf16* tile = (LAS bf16*)(F.lds + F.wave * 16384);
    for (int it = first; it < nitems; it += NGW) conv_item(j.W, j.K, j.Nsrc, j.Wt, j.kscale, j.mapid, tile, it, nblk, F.lane);
    base += nitems;
}
DI void p_prologue(Frame& F, const Args& a) {
    unsigned char* ws = F.ws;
    const int gt = F.bid * NTHR + F.tid, NGT = F.G * NTHR;
    if (F.bid == 0 && F.tid == 0) { int* tab = (int*)(ws + WS_ATAB); int n = 0;
        for (int pass = 16; pass >= 4; pass -= 4)
            for (int qb = 31; qb >= 0; --qb) { const int nt = 4 * (qb + 1), nfull = nt >> 4, rem = nt & 15;
                for (int h = 0; h < 4; ++h) {
                    if (pass == 16) { for (int s2 = 0; s2 < nfull; ++s2) tab[n++] = h | (qb << 2) | (s2 << 7) | (16 << 12); }
                    else if (rem == pass) tab[n++] = h | (qb << 2) | (nfull << 7) | (rem << 12); } }
        for (; n < 2048; ++n) tab[n] = 0; }
    { float* prm = (float*)(ws + WS_PRM);
#define CPV(IDX, N, OFF, SRC_L) for (int e = gt; e < (N); e += NGT) prm[(size_t)l * PRM_STRIDE + (OFF) + e] = a.in[IDX][(size_t)(SRC_L) * (N) + e];
      for (int l = 0; l < DEPTH; ++l) {
          CPV(2, 2048, P_N1, l) CPV(33, 2048, P_N2, l) CPV(4, 512, P_GN, l) CPV(5, 4096, P_CW, l) CPV(6, 1024, P_CB, l) CPV(7, 8, P_DTB, l) CPV(8, 8, P_ALOG, l) CPV(9, 8, P_SD, l)
          CPV(10, 512, P_SNW, l) CPV(15, 192, P_QNW, l) CPV(16, 192, P_KNW, l) CPV(17, 1792, P_MU, l) CPV(18, 512, P_W0, l) CPV(20, 512, P_A0, l)
          CPV(23, 512, P_V0, (l > 0 ? l - 1 : 0)) CPV(26, 512, P_KK, l) CPV(27, 512, P_KA, l) CPV(28, 512, P_RK, l) CPV(29, 512, P_LNW, l) CPV(30, 512, P_LNB, l)
      }
#undef CPV
    }
    const int* pos = (const int*)a.in[1];
    for (int e = gt; e < S * 64; e += NGT) { const int t = e >> 6, i = e & 63;
        const float inv = 1.0f / powf(10000.0f, (float)(2 * i) / 128.0f); const float ang = (float)pos[t] * inv;
        double rev = (double)ang * 0.15915494309189535; rev -= rint(rev); const float r = (float)(rev * 6.283185307179586);
        ((float*)(ws + WS_COSR))[e] = __cosf(r); ((float*)(ws + WS_SINR))[e] = __sinf(r); }
    for (int e = gt; e < S * 32; e += NGT) { const int t = e >> 5, i = e & 31;
        const float inv = 1.0f / powf(10000.0f, (float)(2 * i) / 64.0f); const float ang = (float)pos[t] * inv;
        double rev = (double)ang * 0.15915494309189535; rev -= rint(rev); const float r = (float)(rev * 6.283185307179586);
        ((float*)(ws + WS_COSM))[e] = __cosf(r); ((float*)(ws + WS_SINM))[e] = __sinf(r); }
    for (int l = 0; l < DEPTH; ++l) {
        const float* w2 = a.in[19] + (size_t)l * 64 * 512; const float* a2 = a.in[21] + (size_t)l * 64 * 512; const float* g2 = a.in[22] + (size_t)l * 128 * 512;
        const float* v2 = a.in[25] + (size_t)(l > 0 ? l - 1 : 0) * 32 * 512;
        bf16* Lt = (bf16*)(ws + WS_WLORA) + (size_t)l * 2048 * 512;
        for (int w = gt; w < 2048 * 64; w += NGT) { const int kg = w >> 11, n = w & 2047, seg = n >> 9, j = n & 511; float v[8];
#pragma unroll
            for (int i = 0; i < 8; ++i) { const int k = kg * 8 + i; float x = 0.f;
                if (seg == 0) { if (k < 64) x = w2[k * 512 + j]; }
                else if (seg == 1) { if (k >= 128 && k < 192) x = a2[(k - 128) * 512 + j]; }
                else if (seg == 2) { if (k >= 256 && k < 384) x = g2[(k - 256) * 512 + j]; }
                else { if (l > 0 && k >= 384 && k < 416) x = v2[(k - 384) * 512 + j]; }
                v[i] = x; }
            u32x4 o; o.x = pk2(v[0], v[1]); o.y = pk2(v[2], v[3]); o.z = pk2(v[4], v[5]); o.w = pk2(v[6], v[7]);
            *(GAS u32x4*)(Lt + (size_t)n * 512 + kg * 8) = o; }
    }
    { const int gw = F.bid * NWAVES + F.wave, NGW = F.G * NWAVES; float* rss = (float*)(ws + WS_RSSA);
      for (int m = gw; m < S; m += NGW) { const GAS f32x4* xr = (const GAS f32x4*)(a.in[0] + (size_t)m * D) + F.lane; GAS u32x2* o8 = (GAS u32x2*)((bf16*)(ws + WS_XN) + (size_t)m * D) + F.lane; float sq = 0.f;
#pragma unroll
          for (int j = 0; j < 8; ++j) { const f32x4 v = xr[64 * j]; sq += (v.x * v.x + v.y * v.y) + (v.z * v.z + v.w * v.w); u32x2 o; o.x = pk2(v.x, v.y); o.y = pk2(v.z, v.w); o8[64 * j] = o; }
          sq = wave_sum(sq); if (F.lane < 32) rss[(size_t)m * 32 + F.lane] = (F.lane == 0) ? sq : 0.f; } }
    int base = 0;
    for (int l = 0; l < DEPTH; ++l) {
        conv_job(F, ConvJob{a.in[3] + (size_t)l * D * NIN, (bf16*)(ws + WS_WIN) + (size_t)l * NINP * D, a.in[2] + (size_t)l * D, D, NIN, NINP, 1}, base);
        conv_job(F, ConvJob{a.in[34] + (size_t)l * D * 2 * DFF, (bf16*)(ws + WS_WGU) + (size_t)l * 2 * DFF * D, a.in[33] + (size_t)l * D, D, 2 * DFF, 2 * DFF, 2}, base);
        conv_job(F, ConvJob{a.in[35] + (size_t)l * DFF * D, (bf16*)(ws + WS_WDN) + (size_t)l * D * DFF, nullptr, DFF, D, D, 0}, base);
        conv_job(F, ConvJob{a.in[32] + (size_t)l * D * D, (bf16*)(ws + WS_WOUT) + (size_t)l * D * D, nullptr, D, D, D, 0}, base);
        for (int n = 0; n < 4; ++n)
            conv_job(F, ConvJob{a.in[31] + ((size_t)l * 4 + n) * 512 * D, (bf16*)(ws + WS_WBR) + ((size_t)l * 4 + n) * D * 512, nullptr, 512, D, D, 0}, base);
        conv_job(F, ConvJob{a.in[12] + (size_t)l * 512 * 768, (bf16*)(ws + WS_WQB) + (size_t)l * 1024 * 512, a.in[11] + (size_t)l * 512, 512, 768, 1024, 3}, base);
        conv_job(F, ConvJob{a.in[14] + (size_t)l * 256 * 1024, (bf16*)(ws + WS_WKVB) + (size_t)l * 1024 * 256, a.in[13] + (size_t)l * 256, 256, 1024, 1024, 0}, base);
        if (l > 0) conv_job(F, ConvJob{a.in[24] + (size_t)(l - 1) * 512 * 32, (bf16*)(ws + WS_WV1) + (size_t)l * 256 * 512, nullptr, 512, 32, 256, 4}, base);
    }
}

DI void p_rmsnorm(Frame& F, const float* x, const float* w, bf16* out) {
    const int gw = F.bid * NWAVES + F.wave, NGW = F.G * NWAVES;
    for (int m = gw; m < S; m += NGW) {
        const GAS f32x4* xr = (const GAS f32x4*)(x + (size_t)m * D) + F.lane; f32x4 v[8]; float s = 0.f;
#pragma unroll
        for (int j = 0; j < 8; ++j) { v[j] = xr[64 * j]; s += (v[j].x * v[j].x + v[j].y * v[j].y) + (v[j].z * v[j].z + v[j].w * v[j].w); }
        const float rstd = rsqrtf(wave_sum(s) * (1.f / D) + 1e-6f);
        const GAS f32x4* wr = (const GAS f32x4*)w + F.lane;
        GAS u32x2* o8 = (GAS u32x2*)(out + (size_t)m * D) + F.lane;
#pragma unroll
        for (int j = 0; j < 8; ++j) { const f32x4 ww = wr[64 * j]; u32x2 o; o.x = pk2(v[j].x * rstd * ww.x, v[j].y * rstd * ww.y); o.y = pk2(v[j].z * rstd * ww.z, v[j].w * rstd * ww.w); o8[64 * j] = o; }
    }
}

DI f32x4 bf4_(const u32x2 w) { return (f32x4){bf2f(w.x & 0xffffu), bf2f(w.x >> 16), bf2f(w.y & 0xffffu), bf2f(w.y >> 16)}; }
DI u32x2 pk4_(const f32x4 v) { u32x2 o; o.x = pk2(v.x, v.y); o.y = pk2(v.z, v.w); return o; }
DI void p_rwkv_prep(Frame& F, int l) {
    unsigned char* ws = F.ws;
    const bf16* RW = (const bf16*)(ws + WS_RW); const float* prm = (const float*)(ws + WS_PRM) + (size_t)l * PRM_STRIDE; const float* mu = prm + P_MU; const float* kk_w = prm + P_KK;
    const int gw = F.bid * NWAVES + F.wave, NGW = F.G * NWAVES, lane = F.lane;
    for (int t = gw; t < S; t += NGW) {
        const GAS u32x2* p = (const GAS u32x2*)(RW + (size_t)t * 1792) + lane; const GAS u32x2* pp = (const GAS u32x2*)(RW + (size_t)(t > 0 ? t - 1 : 0) * 1792) + lane;
        const GAS f32x4* m4 = (const GAS f32x4*)mu + lane;
        f32x4 pm[7];
#pragma unroll
        for (int j = 0; j < 7; ++j) { const f32x4 c = bf4_(p[64 * j]); f32x4 pv = bf4_(pp[64 * j]); if (t == 0) pv = (f32x4){0.f, 0.f, 0.f, 0.f}; pm[j] = c + (pv - c) * m4[64 * j]; }
        const size_t ro = (size_t)t * 512;
        *((GAS u32x2*)((bf16*)(ws + WS_R32) + ro) + lane) = pk4_(pm[0]); *((GAS u32x2*)((bf16*)(ws + WS_R32) + ro) + 64 + lane) = pk4_(pm[1]);
#pragma unroll
        for (int j = 0; j < 2; ++j) { const f32x4 k = pm[2 + j]; const f32x4 kw = *((const GAS f32x4*)kk_w + 64 * j + lane); const f32x4 kk = k * kw;
            float ss = (kk.x * kk.x + kk.y * kk.y) + (kk.z * kk.z + kk.w * kk.w);
            ss = row_sum16(ss);
            const float inv = fminf(__builtin_amdgcn_rsqf(ss), 1e12f);
            *((GAS u32x2*)((bf16*)(ws + WS_K32) + ro) + 64 * j + lane) = pk4_(k);
            *((GAS u32x2*)((bf16*)(ws + WS_KKN) + ro) + 64 * j + lane) = pk4_(kk * inv); }
#pragma unroll
        for (int j = 0; j < 2; ++j) { const u32x2 vb = pk4_(pm[4 + j]);
            *((GAS u32x2*)((bf16*)(ws + WS_VV) + ro) + 64 * j + lane) = vb;
            if (l == 0) *((GAS u32x2*)((bf16*)(ws + WS_VFIRST) + ro) + 64 * j + lane) = vb; }
        { const f32x4 x = pm[6]; f32x4 y; int dst;
            if (lane < 16) { y = (f32x4){ftanh_(x.x), ftanh_(x.y), ftanh_(x.z), ftanh_(x.w)}; dst = 4 * lane; }
            else if (lane < 32) { y = x; dst = 128 + 4 * (lane - 16); }
            else { y = (f32x4){sigmoidf_(x.x), sigmoidf_(x.y), sigmoidf_(x.z), sigmoidf_(x.w)}; dst = 256 + 4 * (lane - 32); }
            bf16* ar = (bf16*)(ws + WS_ALORA) + (size_t)t * 512;
            *(GAS u32x2*)(ar + dst) = pk4_(y);
            const int z = 4 * lane; const int zd = z < 64 ? 64 + z : (z < 128 ? 192 + (z - 64) : 384 + (z - 128));
            unsigned zz = 0u; asm volatile("" : "+v"(zz));
            *(GAS u32x2*)(ar + zd) = (u32x2){zz, zz}; }
    }
}

DI void p_mamba_prep(Frame& F, int l) {
    unsigned char* ws = F.ws;
    const bf16* XBC = (const bf16*)(ws + WS_XBC); bf16* XC = (bf16*)(ws + WS_XC);
    const float* prm = (const float*)(ws + WS_PRM) + (size_t)l * PRM_STRIDE; const float* cw = prm + P_CW; const float* cb = prm + P_CB;
    for (int u = F.bid; u < 2 * NCH; u += F.G) {
        const int c = u >> 1, ch = (u & 1) * 512 + F.tid; const int t0 = c * 64;
        float w0[4];
#pragma unroll
        for (int k = 0; k < 4; ++k) w0[k] = cw[k * 1024 + ch];
        const float b0 = cb[ch];
        float h0[3];
#pragma unroll
        for (int k = 0; k < 3; ++k) { const int t = t0 - 3 + k; h0[k] = (t >= 0) ? bf2f(XBC[(size_t)t * 1024 + ch]) : 0.f; }
#pragma unroll 16
        for (int i = 0; i < 64; ++i) { const int t = t0 + i; const float x0 = bf2f(XBC[(size_t)t * 1024 + ch]);
            const float y0 = b0 + w0[0] * h0[0] + w0[1] * h0[1] + w0[2] * h0[2] + w0[3] * x0;
            h0[0] = h0[1]; h0[1] = h0[2]; h0[2] = x0;
            XC[(size_t)t * 1024 + ch] = (bf16)f2bf(siluf_(y0)); }
    }
}
DI void u_mamba_dt(Frame& F, int l, int c) {
    unsigned char* ws = F.ws; LAS float* A = (LAS float*)F.lds;
    const float* prm = (const float*)(ws + WS_PRM) + (size_t)l * PRM_STRIDE; const int t = F.tid >> 3, h = F.tid & 7; const size_t row = (size_t)(c * 64 + t);
    const float dt = softplusf_(((const float*)(ws + WS_MISC))[row * 256 + h] + prm[P_DTB + h]);
    A[F.tid] = dt * -fexp_(prm[P_ALOG + h]);
    ((float*)(ws + WS_DTS))[row * 8 + h] = dt;
    __syncthreads();
    float cs = 0.f;
#pragma unroll 16
    for (int tt = 0; tt < 64; ++tt) { const float v = A[tt * 8 + h]; cs += (tt <= t) ? v : 0.f; }
    ((float*)(ws + WS_ACS))[row * 8 + h] = cs;
    __syncthreads();
}

DI void p_scans(Frame& F, int nblk) {
    unsigned char* ws = F.ws;
    const int gt = F.bid * NTHR + F.tid, NGT = nblk * NTHR;
    for (int q = gt; q < 32768; q += NGT) {
        const int e = q * 4; const bool ret = e < 65536; const int e2 = ret ? e : e - 65536, h = ret ? (e >> 14) : (e2 >> 13);
        float* p = (float*)(ws + (ret ? WS_RKV : WS_MST)) + e2; const float* acs = (const float*)(ws + WS_ACS);
        const float rdec = fexp_(log1pf(-exp2f(-5.0f - (float)h)) * 64.0f);
        f32x4 st = (f32x4){0.f, 0.f, 0.f, 0.f};
#pragma unroll 1
        for (int c0 = 0; c0 < NCH; c0 += 16) { f32x4 v[16]; float dc[16];
#pragma unroll
            for (int i = 0; i < 16; ++i) v[i] = *(const GAS f32x4*)(p + (size_t)(c0 + i) * 65536);
#pragma unroll
            for (int i = 0; i < 16; ++i) dc[i] = ret ? rdec : fexp_(acs[(size_t)((c0 + i) * 64 + 63) * 8 + h]);
#pragma unroll
            for (int i = 0; i < 16; ++i) { *(GAS f32x4*)(p + (size_t)(c0 + i) * 65536) = st; st = st * dc[i] + v[i]; } }
    }
}


namespace pg8 {
DI unsigned char* lw(unsigned char* p) { unsigned long long w = (unsigned long long)p; asm volatile("" : "+s"(w)); return (unsigned char*)w; }
DI void st8bf(bf16* p, const f32x4 a, const f32x4 b) { *(GAS u32x4*)p = pack8(a, b); }
DI void st8f(float* p, const f32x4 a, const f32x4 b) { *(GAS f32x4*)p = a; *((GAS f32x4*)p + 1) = b; }
DI f32x4 map4(const f32x4 v, float (*f)(float)) { return (f32x4){f(v.x), f(v.y), f(v.z), f(v.w)}; }

DI void scale_rows(Acc& acc, const LAS float* rt, int rl0) {
#pragma unroll
    for (int ai = 0; ai < 2; ++ai)
#pragma unroll
        for (int m = 0; m < 4; ++m) { const float rs = rt[rl0 + ai * HALF + m * 16];
#pragma unroll
            for (int bj = 0; bj < 2; ++bj)
#pragma unroll
                for (int n = 0; n < 2; ++n) acc[ai][bj][m][n] = acc[ai][bj][m][n] * rs; }
}
template <class Sched> DI void fill_rstd(LAS float* rtab, const float* rss, const Sched& Sc, int tid) {
    pg8::Unit u;
    for (int i = 0; Sc.next(i, u); ++i) if (tid < 256) { const float* p = rss + (size_t)(u.pm * BM + tid) * 32; float s = 0.f;
#pragma unroll
        for (int q = 0; q < 8; ++q) { const f32x4 v = *(const GAS f32x4*)(p + 4 * q); s += (v.x + v.y) + (v.z + v.w); }
        rtab[i * 256 + tid] = rsqrtf(s * (1.f / D) + 1e-6f); }
    __syncthreads();
}
struct TileDesc { unsigned long long off; int ld, cb, kind, slot; };
constexpr TileDesc mk_tile(int T) {
    return T < 2 ? TileDesc{WS_QR, 512, 0, 0, 0} : T < 4 ? TileDesc{WS_KR, 512, 0, 1, 0}
         : T < 6 ? TileDesc{WS_VR, 512, (T - 4) * 256, 2, 0} : T < 8 ? TileDesc{WS_GR, 512, (T - 6) * 256, 3, 0} : T < 10 ? TileDesc{WS_ZS, 512, (T - 8) * 256, 3, 0}
         : T < 14 ? TileDesc{WS_XBC, 1024, (T - 10) * 256, 2, 0} : T < 16 ? TileDesc{WS_CQ, 512, (T - 14) * 256, 5, (T - 14) * 4} : T == 16 ? TileDesc{WS_CKV, 256, 0, 5, 8}
         : T < 24 ? TileDesc{WS_RW, 1792, (T - 17) * 256, 2, 0} : T < 56 ? TileDesc{WS_GATE, 8192, (T - 24) * 256, 4, 0} : TileDesc{WS_MISC, 256, 0, 6, 0};
}
struct TileTab { TileDesc d[57]; };
constexpr TileTab mk_tiletab() { TileTab t{}; for (int i = 0; i < 57; ++i) t.d[i] = mk_tile(i); return t; }
__constant__ TileTab g_tiletab = mk_tiletab();

struct EpiIn {
    static constexpr bool AFTER_DRAIN = false;
    unsigned char* ws_; int tile_off; const LAS float* rtab;
    DI bool operator()(Acc& acc, const Unit& u, int wr, int wc, int fr, int fq) const {
        unsigned char* ws = lw(ws_);
        const int T = u.pn + tile_off, row0 = u.pm * BM + wr * 64 + fr, c0 = wc * 32 + fq * 8;
        scale_rows(acc, rtab + u.ord * 256, wr * 64 + fr);
        const TileDesc d = g_tiletab.d[T]; const int kind = d.kind;
        if (kind < 2) {
            const int head = 2 * (T & 1) + (c0 >> 6), j0 = c0 & 63; const float sc = kind ? 0.08838834764831845f : 1.0f;
            bf16* dst = (bf16*)(ws + d.off); const float* cs = (const float*)(ws + WS_COSR); const float* sn = (const float*)(ws + WS_SINR);
#pragma unroll
            for (int ai = 0; ai < 2; ++ai)
#pragma unroll
                for (int m = 0; m < 4; ++m) { const int row = row0 + ai * HALF + m * 16;
                    const f32x4 ca = *(const GAS f32x4*)(cs + (size_t)row * 64 + j0), cb = *(const GAS f32x4*)(cs + (size_t)row * 64 + j0 + 4);
                    const f32x4 sa = *(const GAS f32x4*)(sn + (size_t)row * 64 + j0), sb = *(const GAS f32x4*)(sn + (size_t)row * 64 + j0 + 4);
                    const f32x4 x1a = acc[ai][0][m][0], x1b = acc[ai][0][m][1], x2a = acc[ai][1][m][0], x2b = acc[ai][1][m][1];
                    bf16* o = dst + (size_t)row * 512 + head * 128 + j0;
                    st8bf(o, (x1a * ca - x2a * sa) * sc, (x1b * cb - x2b * sb) * sc);
                    st8bf(o + 64, (x2a * ca + x1a * sa) * sc, (x2b * cb + x1b * sb) * sc); }
            return true;
        }
        if (kind == 6) {
            float* dst = (float*)(ws + d.off) + d.cb + c0;
#pragma unroll
            for (int ai = 0; ai < 2; ++ai)
#pragma unroll
                for (int m = 0; m < 4; ++m) { const int row = row0 + ai * HALF + m * 16;
#pragma unroll
                    for (int bj = 0; bj < 2; ++bj) st8f(dst + (size_t)row * d.ld + bj * HALF, acc[ai][bj][m][0], acc[ai][bj][m][1]); }
            return true;
        }
        {
            bf16* dst = (bf16*)(ws + d.off) + d.cb + c0; float* ssq = (float*)(ws + WS_SSQ) + d.slot + wc;
            const float am = (kind == 3 || kind == 4) ? 1.f : 0.f, xm = (kind == 4) ? 0.f : 1.f;
#pragma unroll
            for (int ai = 0; ai < 2; ++ai)
#pragma unroll
                for (int m = 0; m < 4; ++m) { const int row = row0 + ai * HALF + m * 16; float ss = 0.f;
#pragma unroll
                    for (int bj = 0; bj < 2; ++bj) { f32x4 a = acc[ai][bj][m][0], b = acc[ai][bj][m][1];
                        ss += (a.x * a.x + a.y * a.y) + (a.z * a.z + a.w * a.w) + (b.x * b.x + b.y * b.y) + (b.z * b.z + b.w * b.w);
                        if (am != 0.f) {
#pragma unroll
                            for (int i = 0; i < 4; ++i) { const float s0 = sigmoidf_(a[i]), s1 = sigmoidf_(b[i]); a[i] = (xm != 0.f) ? a[i] * s0 : s0; b[i] = (xm != 0.f) ? b[i] * s1 : s1; } }
                        st8bf(dst + (size_t)row * d.ld + bj * HALF, a, b); }
                    if (kind == 5) { ss = xr32_sum(xr16_sum(ss)); if (fq == 0) ssq[(size_t)row * 16] = ss; } }
        }
        return true;
    }
};

struct EpiMisc {
    static constexpr bool AFTER_DRAIN = false;
    unsigned char* ws_; const LAS float* rtab;
    DI bool operator()(Acc& acc, const Unit& u, int wr, int wc, int fr, int fq) const {
        float* dst = (float*)(lw(ws_) + WS_MISC) + wc * 32 + fq * 8; const int row0 = u.pm * BM + wr * 64 + fr;
        scale_rows(acc, rtab + u.ord * 256, wr * 64 + fr);
#pragma unroll
        for (int ai = 0; ai < 2; ++ai)
#pragma unroll
            for (int m = 0; m < 4; ++m) { const int row = row0 + ai * HALF + m * 16;
#pragma unroll
                for (int bj = 0; bj < 2; ++bj) st8f(dst + (size_t)row * 256 + bj * HALF, acc[ai][bj][m][0], acc[ai][bj][m][1]); }
        return true;
    }
};

struct EpiQb {
    static constexpr bool AFTER_DRAIN = true;
    unsigned char* ws; const float* qnw;
    DI bool operator()(Acc&, const Unit&, int, int, int, int) const { return true; }
    DI void fused(Acc& acc, const Unit& u, int wr, int wc, int fr, int fq, LAS unsigned char* lds, int wid, int lane, int tid) const {
        const int h = u.pn, row0 = u.pm * BM + wr * 64 + fr, c0 = wc * 32 + fq * 8;
        const float* ssq = (const float*)(ws + WS_SSQ); LAS float* P = (LAS float*)lds;
        const float QS = 0.07216878364870322f * LOG2E;
#pragma unroll
        for (int ai = 0; ai < 2; ++ai)
#pragma unroll
            for (int m = 0; m < 4; ++m) { const int row = row0 + ai * HALF + m * 16, rl = ai * HALF + wr * 64 + m * 16 + fr;
                const f32x4 s0 = *(const GAS f32x4*)(ssq + (size_t)row * 16), s1 = *(const GAS f32x4*)(ssq + (size_t)row * 16 + 4);
                const float rs = rsqrtf(((s0.x + s0.y) + (s0.z + s0.w) + (s1.x + s1.y) + (s1.z + s1.w)) * (1.f / 512.f) + 1e-6f);
                float ss = 0.f;
#pragma unroll
                for (int bj = 0; bj < 2; ++bj)
#pragma unroll
                    for (int n = 0; n < 2; ++n) { f32x4 a = acc[ai][bj][m][n] * rs; acc[ai][bj][m][n] = a; ss += (a.x * a.x + a.y * a.y) + (a.z * a.z + a.w * a.w); }
                ss = xr32_sum(xr16_sum(ss));
                if (fq == 0) P[rl * 4 + wc] = ss; }
        __syncthreads();
        bf16* QM = (bf16*)(ws + WS_QM); const float* cs = (const float*)(ws + WS_COSM); const float* sn = (const float*)(ws + WS_SINM);
#pragma unroll
        for (int ai = 0; ai < 2; ++ai)
#pragma unroll
            for (int m = 0; m < 4; ++m) { const int row = row0 + ai * HALF + m * 16, rl = ai * HALF + wr * 64 + m * 16 + fr;
                const f32x4 pp = *(const LAS f32x4*)(P + rl * 4); const float rq = rsqrtf(((pp.x + pp.y) + (pp.z + pp.w)) * (1.f / 192.f) + 1e-6f) * QS;
                bf16* o = QM + (size_t)row * 768 + h * 192;
                if (wc < 3) {
                    const f32x4 wa = *(const GAS f32x4*)(qnw + c0), wb = *(const GAS f32x4*)(qnw + c0 + 4);
                    st8bf(o + c0, acc[ai][0][m][0] * rq * wa, acc[ai][0][m][1] * rq * wb);
                    if (wc == 0) { const f32x4 wc4 = *(const GAS f32x4*)(qnw + 96 + c0), wd = *(const GAS f32x4*)(qnw + 100 + c0);
                        st8bf(o + 96 + c0, acc[ai][1][m][0] * rq * wc4, acc[ai][1][m][1] * rq * wd); }
                } else {
                    const int i0 = 8 * fq;
                    const f32x4 w1a = *(const GAS f32x4*)(qnw + 128 + i0), w1b = *(const GAS f32x4*)(qnw + 132 + i0), w2a = *(const GAS f32x4*)(qnw + 160 + i0), w2b = *(const GAS f32x4*)(qnw + 164 + i0);
                    const f32x4 ca = *(const GAS f32x4*)(cs + (size_t)row * 32 + i0), cb = *(const GAS f32x4*)(cs + (size_t)row * 32 + i0 + 4), sa = *(const GAS f32x4*)(sn + (size_t)row * 32 + i0), sb = *(const GAS f32x4*)(sn + (size_t)row * 32 + i0 + 4);
                    const f32x4 x1a = acc[ai][0][m][0] * rq * w1a, x1b = acc[ai][0][m][1] * rq * w1b, x2a = acc[ai][1][m][0] * rq * w2a, x2b = acc[ai][1][m][1] * rq * w2b;
                    st8bf(o + 128 + i0, x1a * ca - x2a * sa, x1b * cb - x2b * sb);
                    st8bf(o + 160 + i0, x2a * ca + x1a * sa, x2b * cb + x1b * sb);
                } }
        __syncthreads();
    }
};

struct EpiKvb {
    static constexpr bool AFTER_DRAIN = true;
    unsigned char* ws; const float* knw;
    DI bool operator()(Acc&, const Unit&, int, int, int, int) const { return true; }
    DI void fused(Acc& acc, const Unit& u, int wr, int wc, int fr, int fq, LAS unsigned char* lds, int wid, int lane, int tid) const {
        const int h = u.pn, row0 = u.pm * BM + wr * 64 + fr, c0 = wc * 32 + fq * 8;
        const float* ssq = (const float*)(ws + WS_SSQ); const float* misc = (const float*)(ws + WS_MISC);
        LAS float* P = (LAS float*)lds; LAS float* KRS = P + 1024; LAS float* RK = P + 1280;
        if (tid < 256) { const float* kr = misc + (size_t)(u.pm * BM + tid) * 256 + 8; float s = 0.f;
#pragma unroll
            for (int i = 0; i < 16; ++i) { const f32x4 v = *(const GAS f32x4*)(kr + 4 * i); s += (v.x * v.x + v.y * v.y) + (v.z * v.z + v.w * v.w); }
            KRS[tid] = s; }
#pragma unroll
        for (int ai = 0; ai < 2; ++ai)
#pragma unroll
            for (int m = 0; m < 4; ++m) { const int row = row0 + ai * HALF + m * 16, rl = ai * HALF + wr * 64 + m * 16 + fr;
                const f32x4 s0 = *(const GAS f32x4*)(ssq + (size_t)row * 16 + 8);
                const float rs = rsqrtf(((s0.x + s0.y) + (s0.z + s0.w)) * (1.f / 256.f) + 1e-6f);
                float ss = 0.f;
#pragma unroll
                for (int bj = 0; bj < 2; ++bj)
#pragma unroll
                    for (int n = 0; n < 2; ++n) { f32x4 a = acc[ai][bj][m][n] * rs; acc[ai][bj][m][n] = a; if (bj == 0) ss += (a.x * a.x + a.y * a.y) + (a.z * a.z + a.w * a.w); }
                ss = xr32_sum(xr16_sum(ss));
                if (fq == 0) P[rl * 4 + wc] = ss; }
        __syncthreads();
        if (tid < 256) { const f32x4 pp = *(const LAS f32x4*)(P + tid * 4); RK[tid] = rsqrtf(((pp.x + pp.y) + (pp.z + pp.w) + KRS[tid]) * (1.f / 192.f) + 1e-6f); }
        __syncthreads();
        bf16* KM = (bf16*)(ws + WS_KM); bf16* VT = (bf16*)(ws + WS_VT);
        const f32x4 wa = *(const GAS f32x4*)(knw + c0), wb = *(const GAS f32x4*)(knw + c0 + 4);
#pragma unroll
        for (int ai = 0; ai < 2; ++ai)
#pragma unroll
            for (int m = 0; m < 4; ++m) { const int row = row0 + ai * HALF + m * 16, rl = ai * HALF + wr * 64 + m * 16 + fr;
                const float rk = RK[rl];
                st8bf(KM + (size_t)row * 768 + h * 192 + c0, acc[ai][0][m][0] * rk * wa, acc[ai][0][m][1] * rk * wb);
#pragma unroll
                for (int n = 0; n < 2; ++n)
#pragma unroll
                    for (int i = 0; i < 4; ++i) VT[(size_t)(h * 128 + c0 + n * 4 + i) * S + row] = (bf16)f2bf(acc[ai][1][m][n][i]); }
        {
            const int rl = tid >> 1, hf = tid & 1, row = u.pm * BM + rl, i0 = 16 * hf; const float rk = RK[rl];
            const float* kr = misc + (size_t)row * 256 + 8; const float* cs = (const float*)(ws + WS_COSM) + (size_t)row * 32; const float* sn = (const float*)(ws + WS_SINM) + (size_t)row * 32;
            bf16* o = KM + (size_t)row * 768 + h * 192 + 128;
#pragma unroll
            for (int q = 0; q < 2; ++q) { f32x4 o1[2], o2[2];
#pragma unroll
                for (int e = 0; e < 2; ++e) { const int i = i0 + 8 * q + 4 * e;
                    const f32x4 x1 = *(const GAS f32x4*)(kr + i) * *(const GAS f32x4*)(knw + 128 + i), x2 = *(const GAS f32x4*)(kr + 32 + i) * *(const GAS f32x4*)(knw + 160 + i);
                    const f32x4 c = *(const GAS f32x4*)(cs + i), s = *(const GAS f32x4*)(sn + i);
                    o1[e] = (x1 * c - x2 * s) * rk; o2[e] = (x2 * c + x1 * s) * rk; }
                st8bf(o + i0 + 8 * q, o1[0], o1[1]); st8bf(o + 32 + i0 + 8 * q, o2[0], o2[1]); }
        }
        __syncthreads();
    }
};

struct EpiV1 {
    static constexpr bool AFTER_DRAIN = false;
    unsigned char* ws_;
    DI bool operator()(Acc& acc, const Unit& u, int wr, int wc, int fr, int fq) const {
        if (wc != 0) return true;
        unsigned char* ws = lw(ws_);
        const int row0 = u.pm * BM + wr * 64 + fr; bf16* dst = (bf16*)(ws + WS_ALORA);
#pragma unroll
        for (int ai = 0; ai < 2; ++ai)
#pragma unroll
            for (int m = 0; m < 4; ++m) { const int row = row0 + ai * HALF + m * 16; st8bf(dst + (size_t)row * 512 + 384 + fq * 8, acc[ai][0][m][0], acc[ai][0][m][1]); }
        return true;
    }
};

struct EpiLora {
    static constexpr bool AFTER_DRAIN = false;
    unsigned char* ws_; const float* w0; const float* a0; const float* v0; const float* ka;
#define LORA_LOOP(BODY) _Pragma("unroll") for (int ai = 0; ai < 2; ++ai) _Pragma("unroll") for (int m = 0; m < 4; ++m) { const size_t ro = (size_t)(row0 + ai * HALF + m * 16) * 512; \
        _Pragma("unroll") for (int bj = 0; bj < 2; ++bj) _Pragma("unroll") for (int n = 0; n < 2; ++n) { const int j = jb + bj * HALF + n * 4; const size_t o = ro + j; const f32x4 x = acc[ai][bj][m][n]; BODY } }
    DI bool operator()(Acc& acc, const Unit& u, int wr, int wc, int fr, int fq) const {
        unsigned char* ws = lw(ws_);
        const int seg = u.pn >> 1, row0 = u.pm * BM + wr * 64 + fr, jb = (u.pn & 1) * 256 + wc * 32 + fq * 8;
        if (seg == 0) { float* dec = (float*)(ws + WS_DEC);
            LORA_LOOP({ const f32x4 b = *(const GAS f32x4*)(w0 + j); f32x4 r;
                _Pragma("unroll") for (int i = 0; i < 4; ++i) { const float u_ = b[i] + x[i]; const float sp = fmaxf(-u_, 0.f) + __logf(1.0f + fexp_(-fabsf(u_))); r[i] = -fexp_(-sp - 0.5f); }
                *(GAS f32x4*)(dec + o) = r; })
        } else if (seg == 1) { const bf16* k32 = (const bf16*)(ws + WS_K32); const bf16* kkn_ = (const bf16*)(ws + WS_KKN); bf16* kp_ = (bf16*)(ws + WS_KP); bf16* bb_ = (bf16*)(ws + WS_BB);
            LORA_LOOP({ const f32x4 b = *(const GAS f32x4*)(a0 + j); const f32x4 kav = *(const GAS f32x4*)(ka + j);
                const u32x2 kw = *(const GAS u32x2*)(k32 + o); const u32x2 nw = *(const GAS u32x2*)(kkn_ + o);
                const f32x4 k = bf4_(kw); const f32x4 kkn = bf4_(nw); f32x4 kp; f32x4 bb;
                _Pragma("unroll") for (int i = 0; i < 4; ++i) { const float av = sigmoidf_(b[i] + x[i]); kp[i] = k[i] * (1.0f + (av - 1.0f) * kav[i]); bb[i] = kkn[i] * av; }
                *(GAS u32x2*)(kp_ + o) = pk4_(kp); *(GAS u32x2*)(bb_ + o) = pk4_(bb); })
        } else if (seg == 2) { bf16* g32 = (bf16*)(ws + WS_G32);
            LORA_LOOP({ *(GAS u32x2*)(g32 + o) = pk4_(x); })
        } else { bf16* vv = (bf16*)(ws + WS_VV); const bf16* vf_ = (const bf16*)(ws + WS_VFIRST);
            LORA_LOOP({ const f32x4 b = *(const GAS f32x4*)(v0 + j); const u32x2 vw = *(const GAS u32x2*)(vv + o); const u32x2 fw = *(const GAS u32x2*)(vf_ + o);
                const f32x4 v = bf4_(vw); const f32x4 vf = bf4_(fw); f32x4 r;
                _Pragma("unroll") for (int i = 0; i < 4; ++i) r[i] = v[i] + (vf[i] - v[i]) * sigmoidf_(b[i] + x[i]);
                *(GAS u32x2*)(vv + o) = pk4_(r); })
        }
        return true;
    }
#undef LORA_LOOP
};

struct EpiBranch {
    static constexpr bool AFTER_DRAIN = false;
    unsigned char* ws_;
    DI bool operator()(Acc& acc, const Unit& u, int wr, int wc, int fr, int fq) const {
        unsigned char* ws = lw(ws_);
        const int nb = u.sub, row0 = u.pm * BM + wr * 64 + fr, cb = u.pn * BM + wc * 32 + fq * 8;
        const bf16* G = (const bf16*)(ws + WS_GATE); bf16* M = (bf16*)(ws + WS_MERGED);
#pragma unroll
        for (int ai = 0; ai < 2; ++ai)
#pragma unroll
            for (int m = 0; m < 4; ++m) { const int row = row0 + ai * HALF + m * 16;
#pragma unroll
                for (int bj = 0; bj < 2; ++bj) { const int col = cb + bj * HALF;
                    float g[8]; unpack8(*(const GAS u32x4*)(G + (size_t)row * 8192 + nb * D + col), g);
                    if (nb < 3) { float gn[8]; unpack8(*(const GAS u32x4*)(G + (size_t)row * 8192 + (nb + 1) * D + col), gn);
#pragma unroll
                        for (int i = 0; i < 8; ++i) g[i] = fmaxf(g[i], 1e-30f) * __builtin_amdgcn_rcpf(fmaxf(gn[i], 1e-30f)); }
                    else {
#pragma unroll
                        for (int i = 0; i < 8; ++i) g[i] = fmaxf(g[i], 1e-30f); }
                    f32x4 a = acc[ai][bj][m][0], b = acc[ai][bj][m][1];
                    a = a * (f32x4){g[0], g[1], g[2], g[3]}; b = b * (f32x4){g[4], g[5], g[6], g[7]};
                    if (nb < 3) { acc[ai][bj][m][0] = a; acc[ai][bj][m][1] = b; } else st8bf(M + (size_t)row * D + col, a, b); } }
        return nb == 3;
    }
};

struct EpiRes {
    static constexpr bool AFTER_DRAIN = false;
    const float* xin; float* out; bf16* xb; float* rss;
    DI bool operator()(Acc& acc, const Unit& u, int wr, int wc, int fr, int fq) const {
        const int row0 = u.pm * BM + wr * 64 + fr, cb = u.pn * BM + wc * 32 + fq * 8;
#pragma unroll
        for (int ai = 0; ai < 2; ++ai)
#pragma unroll
            for (int m = 0; m < 4; ++m) { const int row = row0 + ai * HALF + m * 16; float ss = 0.f;
#pragma unroll
                for (int bj = 0; bj < 2; ++bj) { const size_t o = (size_t)row * D + cb + bj * HALF;
                    const f32x4 a = *(const GAS f32x4*)(xin + o) + acc[ai][bj][m][0], b = *(const GAS f32x4*)(xin + o + 4) + acc[ai][bj][m][1];
                    st8f(out + o, a, b); st8bf(xb + o, a, b);
                    ss += (a.x * a.x + a.y * a.y) + (a.z * a.z + a.w * a.w) + (b.x * b.x + b.y * b.y) + (b.z * b.z + b.w * b.w); }
                if (rss) { ss = xr32_sum(xr16_sum(ss)); if (fq == 0) rss[(size_t)row * 32 + u.pn * 4 + wc] = ss; } }
        return true;
    }
};

struct EpiGu {
    static constexpr bool AFTER_DRAIN = false;
    unsigned char* ws_; const LAS float* rtab;
    DI bool operator()(Acc& acc, const Unit& u, int wr, int wc, int fr, int fq) const {
        unsigned char* ws = lw(ws_);
        scale_rows(acc, rtab + u.ord * 256, wr * 64 + fr);
        const int row0 = u.pm * BM + wr * 64 + fr, cb = u.pn * 128 + wc * 32 + fq * 8; bf16* A = (bf16*)(ws + WS_ACT);
#pragma unroll
        for (int ai = 0; ai < 2; ++ai)
#pragma unroll
            for (int m = 0; m < 4; ++m) { const int row = row0 + ai * HALF + m * 16;
                st8bf(A + (size_t)row * DFF + cb, map4(acc[ai][0][m][0], siluf_) * acc[ai][1][m][0], map4(acc[ai][0][m][1], siluf_) * acc[ai][1][m][1]); }
        return true;
    }
};
}

DI bf16x8 ldfrag(const LAS bf16* M, int ld, int r0, int k0, int lane) { return *(const LAS bf16x8*)(M + (r0 + (lane & 15)) * ld + k0 + 8 * (lane >> 4)); }
#define MFMA16(a, b, c) __builtin_amdgcn_mfma_f32_16x16x32_bf16((a), (b), (c), 0, 0, 0)
DI void stage_nat(LAS bf16* dst, int lp, const bf16* src, size_t gp, int rows, int cols8, int tid) {
    for (int p = tid; p < rows * cols8; p += NTHR) { const int r = p / cols8, c = p - r * cols8; *(LAS u32x4*)(dst + r * lp + c * 8) = *(const GAS u32x4*)(src + (size_t)r * gp + c * 8); }
}
DI void stage_tr(LAS bf16* dst, int lp, const bf16* src, size_t gp, int rows, int cols8, int tid) {
    for (int p = tid; p < rows * cols8; p += NTHR) { const int r = p / cols8, c = p - r * cols8; const u32x4 w = *(const GAS u32x4*)(src + (size_t)r * gp + c * 8);
        LAS bf16* d = dst + (c * 8) * lp + r;
        d[0] = (bf16)(w.x & 0xffffu); d[lp] = (bf16)(w.x >> 16); d[2 * lp] = (bf16)(w.y & 0xffffu); d[3 * lp] = (bf16)(w.y >> 16);
        d[4 * lp] = (bf16)(w.z & 0xffffu); d[5 * lp] = (bf16)(w.z >> 16); d[6 * lp] = (bf16)(w.w & 0xffffu); d[7 * lp] = (bf16)(w.w >> 16); }
}
DI float ret_loggamma(int h) { return log1pf(-exp2f(-5.0f - (float)h)); }

DI void u_ret_kv(Frame& F, int c, int h) {
    int tid_ = F.tid; asm volatile("" : "+v"(tid_));
    unsigned char* ws = F.ws; const int tid = tid_, lane = tid_ & 63, w = F.wave;
    LAS bf16* Kt = (LAS bf16*)F.lds; LAS bf16* Vt = Kt + 128 * 72;
    const bf16* KR = (const bf16*)(ws + WS_KR) + (size_t)(c * 64) * 512 + h * 128; const bf16* VR = (const bf16*)(ws + WS_VR) + (size_t)(c * 64) * 512 + h * 128;
    const float lg = ret_loggamma(h);
    for (int p = tid; p < 1024; p += NTHR) { const int m = p >> 4, d0 = (p & 15) * 8; float k[8]; unpack8(*(const GAS u32x4*)(KR + (size_t)m * 512 + d0), k); const float sc = fexp_(lg * (float)(63 - m));
        LAS bf16* d = Kt + d0 * 72 + m;
#pragma unroll
        for (int i = 0; i < 8; ++i) d[i * 72] = (bf16)f2bf(k[i] * sc); }
    stage_tr(Vt, 72, VR, 512, 64, 16, tid);
    __syncthreads();
    f32x4 acc[8];
#pragma unroll
    for (int bn = 0; bn < 8; ++bn) acc[bn] = (f32x4){0.f, 0.f, 0.f, 0.f};
#pragma unroll
    for (int ks = 0; ks < 2; ++ks) { const bf16x8 a = ldfrag(Kt, 72, 16 * w, 32 * ks, lane);
#pragma unroll
        for (int bn = 0; bn < 8; ++bn) acc[bn] = MFMA16(a, ldfrag(Vt, 72, 16 * bn, 32 * ks, lane), acc[bn]); }
    float* out = (float*)(ws + WS_RKV) + ((size_t)(c * 4 + h) * 128) * 128;
#pragma unroll
    for (int bn = 0; bn < 8; ++bn)
#pragma unroll
        for (int r = 0; r < 4; ++r) out[(size_t)(16 * w + 4 * (lane >> 4) + r) * 128 + 16 * bn + (lane & 15)] = acc[bn][r];
    __syncthreads();
}

DI void u_ret_out(Frame& F, int l_, int c, int h) {
    int tid_ = F.tid; asm volatile("" : "+v"(tid_));
    unsigned char* ws = F.ws; const int tid = tid_, lane = tid_ & 63, w = F.wave;
    LAS bf16* Qs = (LAS bf16*)F.lds; LAS bf16* Ks = Qs + 64 * 136; LAS bf16* Vt = Ks + 64 * 136; LAS bf16* St = Vt + 128 * 72; LAS bf16* Ps = St + 128 * 136; LAS float* Os = (LAS float*)(Ps + 64 * 72);
    const size_t rowb = (size_t)(c * 64) * 512 + h * 128;
    stage_nat(Qs, 136, (const bf16*)(ws + WS_QR) + rowb, 512, 64, 16, tid);
    stage_nat(Ks, 136, (const bf16*)(ws + WS_KR) + rowb, 512, 64, 16, tid);
    stage_tr(Vt, 72, (const bf16*)(ws + WS_VR) + rowb, 512, 64, 16, tid);
    { const float* sp = (const float*)(ws + WS_RKV) + ((size_t)(c * 4 + h) * 128) * 128;
      for (int p = tid; p < 4096; p += NTHR) { const int d = p >> 5, e0 = (p & 31) * 4; const f32x4 v = *(const GAS f32x4*)(sp + (size_t)d * 128 + e0);
          LAS bf16* q = St + e0 * 136 + d; q[0] = (bf16)f2bf(v.x); q[136] = (bf16)f2bf(v.y); q[272] = (bf16)f2bf(v.z); q[408] = (bf16)f2bf(v.w); } }
    __syncthreads();
    const float lg = ret_loggamma(h); const int g4 = lane >> 4, lc = lane & 15;
    {
        const int bm = w >> 1;
#pragma unroll
        for (int q = 0; q < 2; ++q) { const int bn = (w & 1) * 2 + q; f32x4 acc = (f32x4){0.f, 0.f, 0.f, 0.f};
#pragma unroll
            for (int ks = 0; ks < 4; ++ks) acc = MFMA16(ldfrag(Qs, 136, 16 * bm, 32 * ks, lane), ldfrag(Ks, 136, 16 * bn, 32 * ks, lane), acc);
#pragma unroll
            for (int r = 0; r < 4; ++r) { const int l = 16 * bm + 4 * g4 + r, m = 16 * bn + lc; const int dd = l > m ? l - m : m - l; Ps[l * 72 + m] = (bf16)f2bf(acc[r] * fexp_(lg * (float)dd)); } }
    }
    __syncthreads();
    {
        const int bm = w >> 1;
#pragma unroll
        for (int q = 0; q < 4; ++q) { const int bn = (w & 1) * 4 + q; f32x4 a1 = (f32x4){0.f, 0.f, 0.f, 0.f}, a2 = (f32x4){0.f, 0.f, 0.f, 0.f};
#pragma unroll
            for (int ks = 0; ks < 2; ++ks) a1 = MFMA16(ldfrag(Ps, 72, 16 * bm, 32 * ks, lane), ldfrag(Vt, 72, 16 * bn, 32 * ks, lane), a1);
#pragma unroll
            for (int ks = 0; ks < 4; ++ks) a2 = MFMA16(ldfrag(Qs, 136, 16 * bm, 32 * ks, lane), ldfrag(St, 136, 16 * bn, 32 * ks, lane), a2);
#pragma unroll
            for (int r = 0; r < 4; ++r) { const int l = 16 * bm + 4 * g4 + r; Os[l * 132 + 16 * bn + lc] = a1[r] + fexp_(lg * (float)(l + 1)) * a2[r]; } }
    }
    __syncthreads();
    { const float* gw = (const float*)(ws + WS_PRM) + (size_t)l_ * PRM_STRIDE + P_GN + h * 128; const bf16* GR = (const bf16*)(ws + WS_GR); bf16* OB = (bf16*)(ws + WS_OB);
#pragma unroll
      for (int rr = 0; rr < 8; ++rr) { const int l = 8 * w + rr; const float x0 = Os[l * 132 + lane], x1 = Os[l * 132 + 64 + lane];
          const float mean = wave_sum(x0 + x1) * (1.f / 128.f); const float d0 = x0 - mean, d1 = x1 - mean; const float rstd = rsqrtf(wave_sum(d0 * d0 + d1 * d1) * (1.f / 128.f) + 1e-5f);
          const size_t row = (size_t)(c * 64 + l);
          const float g0 = bf2f(GR[row * 512 + h * 128 + lane]), g1 = bf2f(GR[row * 512 + h * 128 + 64 + lane]);
          OB[row * D + h * 128 + lane] = (bf16)f2bf(d0 * rstd * gw[lane] * g0); OB[row * D + h * 128 + 64 + lane] = (bf16)f2bf(d1 * rstd * gw[64 + lane] * g1); } }
    __syncthreads();
}

DI void u_mamba_st(Frame& F, int c, int g) {
    int tid_ = F.tid; asm volatile("" : "+v"(tid_));
    unsigned char* ws = F.ws; const int tid = tid_, lane = tid_ & 63, w = F.wave;
    LAS bf16* Xt = (LAS bf16*)F.lds; LAS bf16* Bt = Xt + 256 * 72;
    const bf16* XC = (const bf16*)(ws + WS_XC) + (size_t)(c * 64) * 1024; const float* dts = (const float*)(ws + WS_DTS) + (size_t)(c * 64) * 8; const float* acs = (const float*)(ws + WS_ACS) + (size_t)(c * 64) * 8;
    for (int p = tid; p < 2048; p += NTHR) { const int l = p >> 5, c0 = (p & 31) * 8, h = g * 4 + (c0 >> 6); float x[8]; unpack8(*(const GAS u32x4*)(XC + (size_t)l * 1024 + g * 256 + c0), x);
        const float sc = dts[l * 8 + h] * fexp_(acs[63 * 8 + h] - acs[l * 8 + h]); LAS bf16* d = Xt + c0 * 72 + l;
#pragma unroll
        for (int i = 0; i < 8; ++i) d[i * 72] = (bf16)f2bf(x[i] * sc); }
    stage_tr(Bt, 72, XC + 512 + g * 128, 1024, 64, 16, tid);
    __syncthreads();
    f32x4 acc[2][8];
#pragma unroll
    for (int i = 0; i < 2; ++i)
#pragma unroll
        for (int bn = 0; bn < 8; ++bn) acc[i][bn] = (f32x4){0.f, 0.f, 0.f, 0.f};
#pragma unroll
    for (int ks = 0; ks < 2; ++ks) { const bf16x8 a0 = ldfrag(Xt, 72, 32 * w, 32 * ks, lane), a1 = ldfrag(Xt, 72, 32 * w + 16, 32 * ks, lane);
#pragma unroll
        for (int bn = 0; bn < 8; ++bn) { const bf16x8 b = ldfrag(Bt, 72, 16 * bn, 32 * ks, lane); acc[0][bn] = MFMA16(a0, b, acc[0][bn]); acc[1][bn] = MFMA16(a1, b, acc[1][bn]); } }
    float* out = (float*)(ws + WS_MST) + ((size_t)(c * 8 + g * 4) * 64) * 128;
#pragma unroll
    for (int i = 0; i < 2; ++i)
#pragma unroll
        for (int bn = 0; bn < 8; ++bn)
#pragma unroll
            for (int r = 0; r < 4; ++r) out[(size_t)(32 * w + 16 * i + 4 * (lane >> 4) + r) * 128 + 16 * bn + (lane & 15)] = acc[i][bn][r];
    __syncthreads();
}

struct MambaLds { LAS bf16* Cs; LAS bf16* Bs; LAS float* CB; LAS bf16* Ph; LAS bf16* Xt; LAS bf16* Sh; LAS float* AC; LAS float* DT; LAS float* SSQ; };
DI void mamba_head(Frame& F, const MambaLds& L, const bf16* XC, const float* sp, int g, int hh, float dsk, const bf16* const (&zrow)[4], f32x4 (&y)[2]) {
    const int tid = F.tid, lane = F.lane, w = F.wave, g4 = lane >> 4, lc = lane & 15, bm = w >> 1;
    __syncthreads();
    { const int l = tid >> 3, m0 = (tid & 7) * 8; const float al = L.AC[l * 4 + hh]; float pv[8];
#pragma unroll
      for (int i = 0; i < 8; ++i) { const int m = m0 + i; pv[i] = (m <= l) ? L.CB[l * 68 + m] * fexp_(al - L.AC[m * 4 + hh]) * L.DT[m * 4 + hh] : 0.f; }
      u32x4 o; o.x = pk2(pv[0], pv[1]); o.y = pk2(pv[2], pv[3]); o.z = pk2(pv[4], pv[5]); o.w = pk2(pv[6], pv[7]); *(LAS u32x4*)(L.Ph + l * 72 + m0) = o; }
    stage_tr(L.Xt, 72, XC + g * 256 + hh * 64, 1024, 64, 8, tid);
    for (int p = tid; p < 1024; p += NTHR) { const int pr = p >> 4, n0 = (p & 15) * 8; const f32x4 v0 = *(const GAS f32x4*)(sp + (size_t)pr * 128 + n0), v1 = *(const GAS f32x4*)(sp + (size_t)pr * 128 + n0 + 4);
        *(LAS u32x4*)(L.Sh + pr * 136 + n0) = pack8(v0, v1); }
    __syncthreads();
#pragma unroll
    for (int q = 0; q < 2; ++q) { const int bn = (w & 1) * 2 + q; f32x4 yd = (f32x4){0.f, 0.f, 0.f, 0.f}, yo = (f32x4){0.f, 0.f, 0.f, 0.f};
#pragma unroll
        for (int ks = 0; ks < 2; ++ks) yd = MFMA16(ldfrag(L.Ph, 72, 16 * bm, 32 * ks, lane), ldfrag(L.Xt, 72, 16 * bn, 32 * ks, lane), yd);
#pragma unroll
        for (int ks = 0; ks < 4; ++ks) yo = MFMA16(ldfrag(L.Cs, 136, 16 * bm, 32 * ks, lane), ldfrag(L.Sh, 136, 16 * bn, 32 * ks, lane), yo);
#pragma unroll
        for (int r = 0; r < 4; ++r) { const int l = 16 * bm + 4 * g4 + r, p = 16 * bn + lc; const float x = bf2f(L.Xt[p * 72 + l]);
            const float z = bf2f(zrow[r][hh * 64 + q * 16]);
            y[q][r] = (yd[r] + fexp_(L.AC[l * 4 + hh]) * yo[r] + x * dsk) * z; } }
}
DI void u_mamba_out(Frame& F, int l_, int c, int g) {
    unsigned char* ws = F.ws; const int tid = F.tid, lane = F.lane, w = F.wave, g4 = lane >> 4, lc = lane & 15;
    MambaLds L; L.Cs = (LAS bf16*)F.lds; L.Bs = L.Cs + 64 * 136; L.CB = (LAS float*)(L.Bs + 64 * 136); L.Ph = (LAS bf16*)(L.CB + 64 * 68); L.Xt = L.Ph + 64 * 72; L.Sh = L.Xt + 64 * 72;
    L.AC = (LAS float*)(L.Sh + 64 * 136); L.DT = L.AC + 256; L.SSQ = L.DT + 256;
    const bf16* XC = (const bf16*)(ws + WS_XC) + (size_t)(c * 64) * 1024;
    stage_nat(L.Cs, 136, XC + 768 + g * 128, 1024, 64, 16, tid);
    stage_nat(L.Bs, 136, XC + 512 + g * 128, 1024, 64, 16, tid);
    if (tid < 256) { const int l = tid >> 2, hh = tid & 3; L.AC[tid] = ((const float*)(ws + WS_ACS))[(size_t)(c * 64 + l) * 8 + g * 4 + hh]; L.DT[tid] = ((const float*)(ws + WS_DTS))[(size_t)(c * 64 + l) * 8 + g * 4 + hh]; }
    __syncthreads();
    const int bm = w >> 1;
#pragma unroll
    for (int q = 0; q < 2; ++q) { const int bn = (w & 1) * 2 + q; f32x4 acc = (f32x4){0.f, 0.f, 0.f, 0.f};
#pragma unroll
        for (int ks = 0; ks < 4; ++ks) acc = MFMA16(ldfrag(L.Cs, 136, 16 * bm, 32 * ks, lane), ldfrag(L.Bs, 136, 16 * bn, 32 * ks, lane), acc);
#pragma unroll
        for (int r = 0; r < 4; ++r) L.CB[(16 * bm + 4 * g4 + r) * 68 + 16 * bn + lc] = acc[r]; }
    const int pcol = 16 * ((w & 1) * 2) + lc;
    const bf16* zrow[4]; bf16* orow[4];
#pragma unroll
    for (int r = 0; r < 4; ++r) { const size_t row = (size_t)(c * 64 + 16 * bm + 4 * g4 + r); zrow[r] = (const bf16*)(ws + WS_ZS) + row * 512 + g * 256 + pcol; orow[r] = (bf16*)(ws + WS_OB) + row * D + 512 + g * 256 + pcol; }
    const float* mst = (const float*)(ws + WS_MST) + ((size_t)(c * 8 + g * 4) * 64) * 128; const float* prm = (const float*)(ws + WS_PRM) + (size_t)l_ * PRM_STRIDE; const float* dskp = prm + P_SD + g * 4;
    float ss[4] = {0.f, 0.f, 0.f, 0.f};
#pragma unroll 1
    for (int hh = 0; hh < 4; ++hh) { f32x4 y[2]; mamba_head(F, L, XC, mst + (size_t)hh * 64 * 128, g, hh, dskp[hh], zrow, y);
#pragma unroll
        for (int r = 0; r < 4; ++r) ss[r] += y[0][r] * y[0][r] + y[1][r] * y[1][r]; }
#pragma unroll
    for (int r = 0; r < 4; ++r) { float t = ss[r]; t = row_sum16(t);
        if (lc == 0) L.SSQ[(16 * bm + 4 * g4 + r) * 2 + (w & 1)] = t; }
    __syncthreads();
    float rstd[4];
#pragma unroll
    for (int r = 0; r < 4; ++r) { const int l = 16 * bm + 4 * g4 + r; rstd[r] = rsqrtf((L.SSQ[l * 2] + L.SSQ[l * 2 + 1]) * (1.f / 256.f) + 1e-6f); }
    const float* nw = prm + P_SNW + g * 256 + pcol;
#pragma unroll 1
    for (int hh = 0; hh < 4; ++hh) { f32x4 y[2]; mamba_head(F, L, XC, mst + (size_t)hh * 64 * 128, g, hh, dskp[hh], zrow, y);
#pragma unroll
        for (int q = 0; q < 2; ++q)
#pragma unroll
            for (int r = 0; r < 4; ++r) orow[r][hh * 64 + q * 16] = (bf16)f2bf(y[q][r] * rstd[r] * nw[hh * 64 + q * 16]); }
    __syncthreads();
}

DI void u_attn2(Frame& F, int h, int qb, int sp, int ntile) {
    int tid_ = F.tid; asm volatile("" : "+v"(tid_));
    unsigned char* ws = F.ws; const int tid = tid_, lane = tid & 63, w = F.wave, g4 = lane >> 4, lc = lane & 15;
    LAS bf16* Ks = (LAS bf16*)F.lds; LAS bf16* Vs = Ks + 64 * 200;
    const bf16* QM = (const bf16*)(ws + WS_QM); const bf16* KM = (const bf16*)(ws + WS_KM) + h * 192; const bf16* VT = (const bf16*)(ws + WS_VT) + (size_t)(h * 128) * S;
    const int q0 = qb * 256 + w * 32, cw = 4 * qb + (w >> 1);
    bf16x8 qf[2][6];
#pragma unroll
    for (int qq = 0; qq < 2; ++qq)
#pragma unroll
        for (int ks = 0; ks < 6; ++ks) qf[qq][ks] = *(const GAS bf16x8*)(QM + (size_t)(q0 + qq * 16 + lc) * 768 + h * 192 + ks * 32 + g4 * 8);
    f32x4 o[8][2]; float mrun[2], lrun[2];
#pragma unroll
    for (int db = 0; db < 8; ++db)
#pragma unroll
        for (int qq = 0; qq < 2; ++qq) o[db][qq] = (f32x4){0.f, 0.f, 0.f, 0.f};
    mrun[0] = mrun[1] = -1e30f; lrun[0] = lrun[1] = 0.f;
    u32x4 kreg[3], vreg[2];
    const int kt0 = 16 * sp;
#define AT_LOAD(kt) { const int key0_ = (kt) * 64; \
        _Pragma("unroll") for (int i = 0; i < 3; ++i) { const int p = tid + 512 * i, r = p / 24, cc = p - r * 24; kreg[i] = *(const GAS u32x4*)(KM + (size_t)(key0_ + r) * 768 + cc * 8); } \
        _Pragma("unroll") for (int i = 0; i < 2; ++i) { const int p = tid + 512 * i, r = p >> 3, cc = p & 7; vreg[i] = *(const GAS u32x4*)(VT + (size_t)r * S + key0_ + cc * 8); } }
    AT_LOAD(kt0)
    for (int t = 0; t < ntile; ++t) {
        const int kt = kt0 + t;
        __syncthreads();
#pragma unroll
        for (int i = 0; i < 3; ++i) { const int p = tid + 512 * i, r = p / 24, cc = p - r * 24; *(LAS u32x4*)(Ks + r * 200 + cc * 8) = kreg[i]; }
#pragma unroll
        for (int i = 0; i < 2; ++i) { const int p = tid + 512 * i, r = p >> 3, cc = p & 7; *(LAS u32x4*)(Vs + r * 72 + cc * 8) = vreg[i]; }
        __syncthreads();
        if (t + 1 < ntile) AT_LOAD(kt + 1)
        if (kt <= cw) {
            f32x4 s[4][2];
#pragma unroll
            for (int kb = 0; kb < 4; ++kb)
#pragma unroll
                for (int qq = 0; qq < 2; ++qq) s[kb][qq] = (f32x4){0.f, 0.f, 0.f, 0.f};
#pragma unroll
            for (int ks = 0; ks < 6; ++ks)
#pragma unroll
                for (int kb = 0; kb < 4; ++kb) { const bf16x8 kf = ldfrag(Ks, 200, kb * 16, ks * 32, lane);
#pragma unroll
                    for (int qq = 0; qq < 2; ++qq) s[kb][qq] = MFMA16(kf, qf[qq][ks], s[kb][qq]);
                    if (kb == 3 && (ks & 1)) __builtin_amdgcn_sched_barrier(0); }
            bf16x8 pf[2][2];
#pragma unroll
            for (int qq = 0; qq < 2; ++qq) {
                float mx = -1e30f;
#pragma unroll
                for (int kb = 0; kb < 4; ++kb) mx = fmaxf(mx, fmaxf(fmaxf(s[kb][qq][0], s[kb][qq][1]), fmaxf(s[kb][qq][2], s[kb][qq][3])));
                mx = xr32_max(xr16_max(mx));
                const float mn = fmaxf(mrun[qq], mx), alpha = __builtin_amdgcn_exp2f(mrun[qq] - mn); mrun[qq] = mn;
                float ps = 0.f; float p[16];
#pragma unroll
                for (int kb = 0; kb < 4; ++kb)
#pragma unroll
                    for (int r = 0; r < 4; ++r) { p[kb * 4 + r] = __builtin_amdgcn_exp2f(s[kb][qq][r] - mn); ps += p[kb * 4 + r]; }
                ps = xr32_sum(xr16_sum(ps));
                lrun[qq] = lrun[qq] * alpha + ps;
if (__builtin_amdgcn_ballot_w64(alpha != 1.0f) != 0ull) {
#pragma unroll
                    for (int db = 0; db < 8; ++db) o[db][qq] = o[db][qq] * alpha; }
#pragma unroll
                for (int s2 = 0; s2 < 2; ++s2) { u32x4 pw; pw.x = pk2(p[8 * s2], p[8 * s2 + 1]); pw.y = pk2(p[8 * s2 + 2], p[8 * s2 + 3]); pw.z = pk2(p[8 * s2 + 4], p[8 * s2 + 5]); pw.w = pk2(p[8 * s2 + 6], p[8 * s2 + 7]); pf[qq][s2] = __builtin_bit_cast(bf16x8, pw); }
            }
#pragma unroll
            for (int db = 0; db < 8; ++db)
#pragma unroll
                for (int s2 = 0; s2 < 2; ++s2) {
                    const LAS bf16* vp = Vs + (db * 16 + lc) * 72 + 32 * s2 + 4 * g4;
                    const u32x2 v0 = *(const LAS u32x2*)vp, v1 = *(const LAS u32x2*)(vp + 16);
                    const u32x4 vw = (u32x4){v0.x, v0.y, v1.x, v1.y}; const bf16x8 vf = __builtin_bit_cast(bf16x8, vw);
#pragma unroll
                    for (int qq = 0; qq < 2; ++qq) o[db][qq] = MFMA16(vf, pf[qq][s2], o[db][qq]);
                }
        }
    }
#undef AT_LOAD
    const int slot = att_slot(h, qb, sp);
    float* po = (float*)(ws + WS_APO) + (size_t)slot * 32768; float* pm = (float*)(ws + WS_APM) + (size_t)slot * 512;
#pragma unroll
    for (int db = 0; db < 8; ++db)
#pragma unroll
        for (int qq = 0; qq < 2; ++qq)
#pragma unroll
            for (int r = 0; r < 4; ++r) po[(size_t)(db * 16 + 4 * g4 + r) * 256 + w * 32 + qq * 16 + lc] = o[db][qq][r];
    if (g4 == 0) {
#pragma unroll
        for (int qq = 0; qq < 2; ++qq) { *(GAS f32x2*)(pm + (w * 32 + qq * 16 + lc) * 2) = (f32x2){mrun[qq], lrun[qq]}; } }
    __syncthreads();
}
DI void u_attn_comb(Frame& F, int h, int qb, int qq) {
    unsigned char* ws = F.ws; const int tid = F.tid, q = qq * 64 + (tid & 63), dv0 = (tid >> 6) * 16;
    const int ns = (qb + 4) >> 2, slot0 = att_slot(h, qb, 0);
    const float* pm = (const float*)(ws + WS_APM) + (size_t)slot0 * 512 + q * 2; const float* po = (const float*)(ws + WS_APO) + (size_t)slot0 * 32768 + (size_t)dv0 * 256 + q;
    float mstar = -1e30f;
    for (int s = 0; s < ns; ++s) mstar = fmaxf(mstar, pm[(size_t)s * 512]);
    float lt = 0.f; float ov[16];
#pragma unroll
    for (int i = 0; i < 16; ++i) ov[i] = 0.f;
    for (int s = 0; s < ns; ++s) { const float sc = __builtin_amdgcn_exp2f(pm[(size_t)s * 512] - mstar); lt += pm[(size_t)s * 512 + 1] * sc;
#pragma unroll
        for (int i = 0; i < 16; ++i) ov[i] += po[(size_t)s * 32768 + i * 256] * sc; }
    const float inv = 1.0f / lt;
    bf16* ob = (bf16*)(ws + WS_OB) + (size_t)(qb * 256 + q) * D + 1024 + h * 128 + dv0;
    u32x4 o0, o1; o0.x = pk2(ov[0] * inv, ov[1] * inv); o0.y = pk2(ov[2] * inv, ov[3] * inv); o0.z = pk2(ov[4] * inv, ov[5] * inv); o0.w = pk2(ov[6] * inv, ov[7] * inv);
    o1.x = pk2(ov[8] * inv, ov[9] * inv); o1.y = pk2(ov[10] * inv, ov[11] * inv); o1.z = pk2(ov[12] * inv, ov[13] * inv); o1.w = pk2(ov[14] * inv, ov[15] * inv);
    *(GAS u32x4*)ob = o0; *(GAS u32x4*)(ob + 8) = o1;
}

DI void u_rwkv_r1(Frame& F, int c, int h) {
    int tid_ = F.tid; asm volatile("" : "+v"(tid_));
    unsigned char* ws = F.ws; const int tid = tid_, lane = tid_ & 63, w = F.wave, g4 = lane >> 4, lc = lane & 15;
    LAS float* CUM = (LAS float*)F.lds;
    LAS float* PT = CUM + 64 * 68;
    LAS bf16* AT = (LAS bf16*)(PT + 64); LAS bf16* BH = AT + 4608; LAS bf16* KH = BH + 4608; LAS bf16* RT = KH + 4608;
    LAS bf16* AJ = RT + 4608; LAS bf16* BJ = AJ + 4608; LAS bf16* KJ = BJ + 4608; LAS bf16* VJ = KJ + 4608;
    LAS bf16* MAK = VJ + 4608; LAS bf16* MRBT = MAK + 4608; LAS bf16* MRKT = MRBT + 4608; LAS bf16* X1 = MRKT + 4608; LAS bf16* X2 = X1 + 4608;
    LAS bf16* WT = AT; LAS bf16* G1 = BH; LAS bf16* G2 = KH; LAS bf16* CST = MAK;
    const size_t gb = (size_t)(c * 64) * 512 + h * 64; const int unit = c * 8 + h;
    const int t = tid >> 3, j0 = (tid & 7) * 8;
    const size_t go = gb + (size_t)t * 512 + j0;
    float lw[8];
    { const f32x4 x0 = *(const GAS f32x4*)((const float*)(ws + WS_DEC) + go), x1 = *(const GAS f32x4*)((const float*)(ws + WS_DEC) + go + 4);
#pragma unroll
      for (int i = 0; i < 4; ++i) { lw[i] = x0[i]; lw[4 + i] = x1[i]; }
#pragma unroll
      for (int i = 0; i < 8; ++i) CUM[t * 68 + j0 + i] = lw[i]; }
    __syncthreads();
    if (tid < 64) { float s = 0.f;
#pragma unroll 8
        for (int tt = 0; tt < 64; ++tt) { s += CUM[tt * 68 + tid]; CUM[tt * 68 + tid] = s; } }
    __syncthreads();
    {
        float cum[8], cT[8];
#pragma unroll
        for (int i = 0; i < 8; ++i) { cum[i] = CUM[t * 68 + j0 + i]; cT[i] = CUM[63 * 68 + j0 + i]; }
        if (t == 0) {
#pragma unroll
            for (int i = 0; i < 8; ++i) PT[j0 + i] = fexp_(cT[i]); }
        float av[8], bv[8], kv[8], rv[8], vv[8];
#define LD8(dst, OFF) { unpack8(*(const GAS u32x4*)((const bf16*)(ws + (OFF)) + go), dst); }
        LD8(av, WS_KKN) LD8(bv, WS_BB) LD8(kv, WS_KP) LD8(rv, WS_R32) LD8(vv, WS_VV)
#undef LD8
        float at[8], bh[8], kh[8], rt[8], bj[8], kj[8];
#pragma unroll
        for (int i = 0; i < 8; ++i) { const float pprev = fexp_(cum[i] - lw[i]), pinv = fexp_(-cum[i]), pt = fexp_(cum[i]), pend = fexp_(cT[i] - cum[i]);
            at[i] = -av[i] * pprev; bh[i] = bv[i] * pinv; kh[i] = kv[i] * pinv; rt[i] = rv[i] * pt; bj[i] = bv[i] * pend; kj[i] = kv[i] * pend; }
#define ST8(M, v) { u32x4 o; o.x = pk2(v[0], v[1]); o.y = pk2(v[2], v[3]); o.z = pk2(v[4], v[5]); o.w = pk2(v[6], v[7]); *(LAS u32x4*)(M + t * 72 + j0) = o; }
        ST8(AT, at) ST8(BH, bh) ST8(KH, kh) ST8(RT, rt)
#undef ST8
#pragma unroll
        for (int i = 0; i < 8; ++i) { const int o = (j0 + i) * 72 + t; AJ[o] = (bf16)f2bf(at[i]); BJ[o] = (bf16)f2bf(bj[i]); KJ[o] = (bf16)f2bf(kj[i]); VJ[o] = (bf16)f2bf(vv[i]); }
    }
    __syncthreads();
    {
        const int q = w >> 1; const LAS bf16* Am = (q == 0) ? BH : (q == 1) ? KH : RT; const LAS bf16* Bm = (q < 2) ? AT : (q == 2) ? BH : KH;
#pragma unroll
        for (int bi = 0; bi < 2; ++bi) { const int bm = 2 * (w & 1) + bi; const bf16x8 a0 = ldfrag(Am, 72, 16 * bm, 0, lane), a1 = ldfrag(Am, 72, 16 * bm, 32, lane);
#pragma unroll
            for (int bn = 0; bn < 4; ++bn) { f32x4 acc = (f32x4){0.f, 0.f, 0.f, 0.f};
                acc = MFMA16(a0, ldfrag(Bm, 72, 16 * bn, 0, lane), acc); acc = MFMA16(a1, ldfrag(Bm, 72, 16 * bn, 32, lane), acc);
#pragma unroll
                for (int r = 0; r < 4; ++r) { const int row = 16 * bm + 4 * g4 + r, col = 16 * bn + lc; const bool keep = (q < 2) ? (row < col) : (col <= row); const float v = keep ? acc[r] : 0.f;
                    if (q == 0) CUM[row * 68 + col] = v; else { LAS bf16* O = (q == 1) ? MAK : (q == 2) ? MRBT : MRKT; O[row * 72 + col] = (bf16)f2bf(v); } } } }
    }
    __syncthreads();
    {
        LAS bf16* Qn[2] = {BH, X1}; LAS bf16* Qt[2] = {KH, X2}; LAS bf16* Wn = AT;
        const int bm = w >> 1; f32x4 wreg[2];
#pragma unroll
        for (int qn = 0; qn < 2; ++qn) { const int bn = (w & 1) * 2 + qn;
#pragma unroll
            for (int r = 0; r < 4; ++r) { const int row = 16 * bm + 4 * g4 + r, col = 16 * bn + lc; const float m = CUM[row * 68 + col]; wreg[qn][r] = m + ((row == col) ? 1.f : 0.f);
                const bf16 mb = (bf16)f2bf(m); Qn[0][row * 72 + col] = mb; Qt[0][col * 72 + row] = mb; Wn[row * 72 + col] = (bf16)f2bf(wreg[qn][r]); } }
        __syncthreads();
#pragma unroll
        for (int it = 0; it < 5; ++it) { const int cu = it & 1, nx = cu ^ 1;
            { const bf16x8 a0 = ldfrag(Qn[cu], 72, 16 * bm, 0, lane), a1 = ldfrag(Qn[cu], 72, 16 * bm, 32, lane);
#pragma unroll
              for (int qn = 0; qn < 2; ++qn) { const int bn = (w & 1) * 2 + qn; f32x4 acc = (f32x4){0.f, 0.f, 0.f, 0.f};
                  acc = MFMA16(a0, ldfrag(Qt[cu], 72, 16 * bn, 0, lane), acc); acc = MFMA16(a1, ldfrag(Qt[cu], 72, 16 * bn, 32, lane), acc);
#pragma unroll
                  for (int r = 0; r < 4; ++r) { const int row = 16 * bm + 4 * g4 + r, col = 16 * bn + lc; const bf16 v = (bf16)f2bf(acc[r]); Qn[nx][row * 72 + col] = v; Qt[nx][col * 72 + row] = v; } } }
            __syncthreads();
            { const bf16x8 a0 = ldfrag(Wn, 72, 16 * bm, 0, lane), a1 = ldfrag(Wn, 72, 16 * bm, 32, lane);
#pragma unroll
              for (int qn = 0; qn < 2; ++qn) { const int bn = (w & 1) * 2 + qn;
                  wreg[qn] = MFMA16(a0, ldfrag(Qt[nx], 72, 16 * bn, 0, lane), wreg[qn]); wreg[qn] = MFMA16(a1, ldfrag(Qt[nx], 72, 16 * bn, 32, lane), wreg[qn]); } }
            __syncthreads();
            if (it < 4) {
#pragma unroll
                for (int qn = 0; qn < 2; ++qn) { const int bn = (w & 1) * 2 + qn;
#pragma unroll
                    for (int r = 0; r < 4; ++r) Wn[(16 * bm + 4 * g4 + r) * 72 + 16 * bn + lc] = (bf16)f2bf(wreg[qn][r]); }
                __syncthreads();
            }
        }
#pragma unroll
        for (int qn = 0; qn < 2; ++qn) { const int bn = (w & 1) * 2 + qn;
#pragma unroll
            for (int r = 0; r < 4; ++r) WT[(16 * bn + lc) * 72 + 16 * bm + 4 * g4 + r] = (bf16)f2bf(wreg[qn][r]); }
    }
    __syncthreads();
    {
        const int q = w >> 2, bm = w & 3; const LAS bf16* Am = q ? MAK : AJ; LAS bf16* O = q ? G2 : G1;
        const bf16x8 a0 = ldfrag(Am, 72, 16 * bm, 0, lane), a1 = ldfrag(Am, 72, 16 * bm, 32, lane);
        f32x4 acc[4];
#pragma unroll
        for (int bn = 0; bn < 4; ++bn) { acc[bn] = (f32x4){0.f, 0.f, 0.f, 0.f};
            acc[bn] = MFMA16(a0, ldfrag(WT, 72, 16 * bn, 0, lane), acc[bn]); acc[bn] = MFMA16(a1, ldfrag(WT, 72, 16 * bn, 32, lane), acc[bn]); }
        __syncthreads();
#pragma unroll
        for (int bn = 0; bn < 4; ++bn)
#pragma unroll
            for (int r = 0; r < 4; ++r) O[(16 * bm + 4 * g4 + r) * 72 + 16 * bn + lc] = (bf16)f2bf(acc[bn][r]);
    }
    __syncthreads();
    {
        const int q = w >> 1; const LAS bf16* Am = (q < 2) ? MRBT : BJ; const LAS bf16* Bm = (q & 1) ? G2 : G1;
        f32x4 acc[2][4];
#pragma unroll
        for (int bi = 0; bi < 2; ++bi) { const int bm = 2 * (w & 1) + bi; const bf16x8 a0 = ldfrag(Am, 72, 16 * bm, 0, lane), a1 = ldfrag(Am, 72, 16 * bm, 32, lane);
#pragma unroll
            for (int bn = 0; bn < 4; ++bn) { acc[bi][bn] = (f32x4){0.f, 0.f, 0.f, 0.f};
                acc[bi][bn] = MFMA16(a0, ldfrag(Bm, 72, 16 * bn, 0, lane), acc[bi][bn]); acc[bi][bn] = MFMA16(a1, ldfrag(Bm, 72, 16 * bn, 32, lane), acc[bi][bn]); } }
        __syncthreads();
        bf16* gout = (bf16*)(ws + (q == 0 ? WS_QYT : q == 1 ? WS_CYT : WS_TST)) + (size_t)unit * 4096;
#pragma unroll
        for (int bi = 0; bi < 2; ++bi) { const int bm = 2 * (w & 1) + bi;
#pragma unroll
            for (int bn = 0; bn < 4; ++bn)
#pragma unroll
                for (int r = 0; r < 4; ++r) { const int row = 16 * bm + 4 * g4 + r, col = 16 * bn + lc; float v = acc[bi][bn][r];
                    if (q == 0) v += bf2f(RT[row * 72 + col]); else if (q == 1) v += bf2f(MRKT[row * 72 + col]); else if (q == 2) v += (row == col) ? PT[row] : 0.f; else v += bf2f(KJ[row * 72 + col]);
                    if (q < 3) gout[row * 64 + col] = (bf16)f2bf(v); else CST[row * 72 + col] = (bf16)f2bf(v); } }
    }
    __syncthreads();
    {
        const int bm = w >> 1; float* nst = (float*)(ws + WS_NST) + (size_t)unit * 4096;
        const bf16x8 a0 = ldfrag(CST, 72, 16 * bm, 0, lane), a1 = ldfrag(CST, 72, 16 * bm, 32, lane);
#pragma unroll
        for (int qn = 0; qn < 2; ++qn) { const int bn = (w & 1) * 2 + qn; f32x4 acc = (f32x4){0.f, 0.f, 0.f, 0.f};
            acc = MFMA16(a0, ldfrag(VJ, 72, 16 * bn, 0, lane), acc); acc = MFMA16(a1, ldfrag(VJ, 72, 16 * bn, 32, lane), acc);
#pragma unroll
            for (int r = 0; r < 4; ++r) nst[(16 * bm + 4 * g4 + r) * 64 + 16 * bn + lc] = acc[r]; }
    }
    __syncthreads();
}

DI void p_rwkv_scan2(Frame& F, int h) {
    unsigned char* ws = F.ws; const int lane = F.lane, w = F.wave, g4 = lane >> 4, lc = lane & 15;
    constexpr int SLOT_B = 9216 + 17408;
    const bf16* TST = (const bf16*)(ws + WS_TST) + (size_t)h * 4096; const float* NST = (const float*)(ws + WS_NST) + (size_t)h * 4096; bf16* S0 = (bf16*)(ws + WS_S0) + (size_t)h * 4096;
    if (w >= 4) {
        const int lt = (w - 4) * 64 + lane;
        u32x4 rt[8][2]; f32x4 rn[8][4];
#define SC_ISSUE(u, cc) { const size_t ub = (size_t)(cc) * 8 * 4096; \
            _Pragma("unroll") for (int i = 0; i < 2; ++i) { const int p = lt + 256 * i; rt[u][i] = *(const GAS u32x4*)(TST + ub + (size_t)p * 8); } \
            _Pragma("unroll") for (int i = 0; i < 4; ++i) { const int p = lt + 256 * i; rn[u][i] = *(const GAS f32x4*)(NST + ub + (size_t)p * 4); } }
#define SC_WRITE(u, cc) { LAS unsigned char* sl = F.lds + ((cc) & 1) * SLOT_B; \
            _Pragma("unroll") for (int i = 0; i < 2; ++i) { const int p = lt + 256 * i, r = p >> 3, c8 = p & 7; *(LAS u32x4*)(sl + (r * 72 + c8 * 8) * 2) = rt[u][i]; } \
            _Pragma("unroll") for (int i = 0; i < 4; ++i) { const int p = lt + 256 * i, r = p >> 4, c4 = p & 15; *(LAS f32x4*)(sl + 9216 + (r * 68 + c4 * 4) * 4) = rn[u][i]; } }
#pragma unroll
        for (int u = 0; u < 8; ++u) SC_ISSUE(u, u)
        for (int c0 = 0; c0 < NCH; c0 += 8) {
#pragma unroll
            for (int u = 0; u < 8; ++u) { const int c = c0 + u;
                SC_WRITE(u, c)
                if (c + 8 < NCH) SC_ISSUE(u, c + 8)
                asm volatile("s_waitcnt lgkmcnt(0)" ::: "memory"); __builtin_amdgcn_s_barrier(); asm volatile("" ::: "memory");
            }
        }
#undef SC_ISSUE
#undef SC_WRITE
    } else {
        const int ib = w;
        f32x4 st[4];
#pragma unroll
        for (int jb = 0; jb < 4; ++jb) st[jb] = (f32x4){0.f, 0.f, 0.f, 0.f};
        for (int c = 0; c < NCH; ++c) {
            bf16* s0p = S0 + (size_t)c * 8 * 4096 + (size_t)(16 * ib + lc) * 64 + 4 * g4;
            bf16x8 bfr[2];
#pragma unroll
            for (int ks = 0; ks < 2; ++ks) { u32x4 p; p.x = pk2(st[2 * ks][0], st[2 * ks][1]); p.y = pk2(st[2 * ks][2], st[2 * ks][3]); p.z = pk2(st[2 * ks + 1][0], st[2 * ks + 1][1]); p.w = pk2(st[2 * ks + 1][2], st[2 * ks + 1][3]);
                bfr[ks] = __builtin_bit_cast(bf16x8, p);
                *(GAS u32x2*)(s0p + 32 * ks) = (u32x2){p.x, p.y}; *(GAS u32x2*)(s0p + 32 * ks + 16) = (u32x2){p.z, p.w}; }
            asm volatile("s_waitcnt lgkmcnt(0)" ::: "memory"); __builtin_amdgcn_s_barrier(); asm volatile("" ::: "memory");
            const LAS bf16* ts = (const LAS bf16*)(F.lds + (c & 1) * SLOT_B); const LAS float* ns = (const LAS float*)(F.lds + (c & 1) * SLOT_B + 9216);
#pragma unroll
            for (int jb = 0; jb < 4; ++jb) { f32x4 nw;
#pragma unroll
                for (int r = 0; r < 4; ++r) nw[r] = ns[(16 * jb + 4 * g4 + r) * 68 + 16 * ib + lc];
#pragma unroll
                for (int ks = 0; ks < 2; ++ks) { const LAS bf16* ap = ts + (16 * jb + lc) * 72 + 32 * ks + 4 * g4; const u32x2 a0 = *(const LAS u32x2*)ap, a1 = *(const LAS u32x2*)(ap + 16);
                    const u32x4 aw = (u32x4){a0.x, a0.y, a1.x, a1.y}; nw = MFMA16(__builtin_bit_cast(bf16x8, aw), bfr[ks], nw); }
                st[jb] = nw; }
        }
    }
}

DI void u_rwkv_r3(Frame& F, int l_, int c, int h) {
    int tid_ = F.tid; asm volatile("" : "+v"(tid_));
    unsigned char* ws = F.ws; const int tid = tid_, lane = tid_ & 63, w = F.wave, g4 = lane >> 4, lc = lane & 15, unit = c * 8 + h;
    LAS bf16* QY = (LAS bf16*)F.lds; LAS bf16* CY = QY + 4608; LAS bf16* S0s = CY + 4608; LAS bf16* VJ = S0s + 4608; LAS float* Ys = (LAS float*)(VJ + 4608);
    stage_nat(QY, 72, (const bf16*)(ws + WS_QYT) + (size_t)unit * 4096, 64, 64, 8, tid);
    stage_nat(CY, 72, (const bf16*)(ws + WS_CYT) + (size_t)unit * 4096, 64, 64, 8, tid);
    stage_nat(S0s, 72, (const bf16*)(ws + WS_S0) + (size_t)unit * 4096, 64, 64, 8, tid);
    const size_t gb = (size_t)(c * 64) * 512 + h * 64;
    { const int t = tid >> 3, j0 = (tid & 7) * 8; const u32x4 w4 = *(const GAS u32x4*)((const bf16*)(ws + WS_VV) + gb + (size_t)t * 512 + j0); LAS bf16* d = VJ + j0 * 72 + t;
      d[0] = (bf16)(w4.x & 0xffffu); d[72] = (bf16)(w4.x >> 16); d[144] = (bf16)(w4.y & 0xffffu); d[216] = (bf16)(w4.y >> 16); d[288] = (bf16)(w4.z & 0xffffu); d[360] = (bf16)(w4.z >> 16); d[432] = (bf16)(w4.w & 0xffffu); d[504] = (bf16)(w4.w >> 16); }
    __syncthreads();
    { const int bm = w >> 1;
#pragma unroll
      for (int qn = 0; qn < 2; ++qn) { const int bn = (w & 1) * 2 + qn; f32x4 acc = (f32x4){0.f, 0.f, 0.f, 0.f};
#pragma unroll
          for (int ks = 0; ks < 2; ++ks) { acc = MFMA16(ldfrag(QY, 72, 16 * bm, 32 * ks, lane), ldfrag(S0s, 72, 16 * bn, 32 * ks, lane), acc); acc = MFMA16(ldfrag(CY, 72, 16 * bm, 32 * ks, lane), ldfrag(VJ, 72, 16 * bn, 32 * ks, lane), acc); }
#pragma unroll
          for (int r = 0; r < 4; ++r) Ys[(16 * bm + 4 * g4 + r) * 65 + 16 * bn + lc] = acc[r]; } }
    __syncthreads();
    { const float* prm = (const float*)(ws + WS_PRM) + (size_t)l_ * PRM_STRIDE; const float lnw = prm[P_LNW + h * 64 + lane], lnb = prm[P_LNB + h * 64 + lane], rk = prm[P_RK + h * 64 + lane];
      float rr_[8], kk_[8], vv_[8], gg_[8];
#pragma unroll
      for (int rr = 0; rr < 8; ++rr) { const size_t o = gb + (size_t)(8 * w + rr) * 512 + lane;
          rr_[rr] = bf2f(((const bf16*)(ws + WS_R32))[o]); kk_[rr] = bf2f(((const bf16*)(ws + WS_KP))[o]); vv_[rr] = bf2f(((const bf16*)(ws + WS_VV))[o]); gg_[rr] = bf2f(((const bf16*)(ws + WS_G32))[o]); }
#pragma unroll
      for (int rr = 0; rr < 8; ++rr) { const int t = 8 * w + rr; const float y = Ys[t * 65 + lane];
          const float mean = wave_sum(y) * (1.f / 64.f), d = y - mean, rstd = rsqrtf(wave_sum(d * d) * (1.f / 64.f) + 64e-5f), bs = wave_sum(rr_[rr] * kk_[rr] * rk);
          ((bf16*)(ws + WS_OB))[(size_t)(c * 64 + t) * D + 1536 + h * 64 + lane] = (bf16)f2bf((d * rstd * lnw + lnb + bs * vv_[rr]) * gg_[rr]); } }
    __syncthreads();
}

constexpr int STEPS_PER_LAYER = 13, NSTEPS = 1 + DEPTH * STEPS_PER_LAYER;
constexpr int NSCAN_BLK = 8;

__global__ void __launch_bounds__(NTHR, 2) mk_fwd(Args args) {
    extern __shared__ __attribute__((aligned(16))) unsigned char lds_raw[];
    Frame F;
    F.lds = (LAS unsigned char*)lds_raw; F.MISC = (volatile LAS unsigned*)(F.lds + MISC_OFF);
    F.tid = threadIdx.x; F.lane = F.tid & 63; F.wave = __builtin_amdgcn_readfirstlane(F.tid >> 6);
    F.G = gridDim.x; F.bid = blockIdx.x; F.ws = args.ws; F.ctl = (gu32*)(args.ws + WS_CTL);
    for (int u = F.tid; u < (LDS_BYTES - LDSCTL_OFF) / 4; u += NTHR) ((LAS unsigned*)(F.lds + LDSCTL_OFF))[u] = 0u;
    __syncthreads();
    const int lo = args.st_lo, hi = args.st_hi;
    XcdBarrier bar; bar.bar = (unsigned*)(F.ctl + CW_BAR); bar.x = 0; bar.st = nullptr;
    if (hi - lo > 1) bar = xcd_barrier_post((unsigned*)(F.ctl + CW_BAR), F.MISC + 8);
#ifndef MK_MASK
#define MK_MASK 0xFBFEu
#endif
#define EN(k) (((MK_MASK) >> (k)) & 1u)
#ifndef MK_REP
#define MK_REP 0u
#endif
#define REP(k) (((MK_REP) >> (k)) & 1u)
#ifndef MK_DUP
#define MK_DUP 0u
#endif
#define DUP(k, stmt) do { stmt; if (((MK_DUP) >> (k)) & 1u) { stmt; } } while (0)
#define RUN(s) (lo <= (s) && (s) < hi)
#define SEAM(s) do { if ((s) + 1 < hi) xcd_barrier(bar); } while (0)

    if (EN(13) && RUN(0)) { _Pragma("unroll 1") for (int rp = 0; rp <= (int)REP(13); ++rp) { relaunder(F, args.ws, (LAS unsigned char*)lds_raw); p_prologue(F, args); } SEAM(0); }

    for (int l = 0; l < DEPTH; ++l) {
        const int sb = 1 + l * STEPS_PER_LAYER;
        const float* xin = (l == 0) ? args.in[0] : args.out;
        if (EN(0) && RUN(sb + 0)) { _Pragma("unroll 1") for (int rp = 0; rp <= (int)REP(0); ++rp) { relaunder(F, args.ws, (LAS unsigned char*)lds_raw); unsigned char* ws = F.ws; DUP(11, p_rmsnorm(F, xin, (const float*)(ws + WS_PRM) + (size_t)l * PRM_STRIDE + P_N1, (bf16*)(ws + WS_XN))); } SEAM(sb + 0); }
        if (EN(1) && RUN(sb + 1)) { _Pragma("unroll 1") for (int rp = 0; rp <= (int)REP(1); ++rp) { relaunder(F, args.ws, (LAS unsigned char*)lds_raw); unsigned char* ws = F.ws;
            pg8::Gemm g{(const bf16*)(ws + WS_XN), (const bf16*)(ws + WS_WIN) + (size_t)l * NINP * D, D, D, D};
            pg8::StaticOrder So; So.init(S, NINP - 256, F.G, F.bid); pg8::EpiIn E{ws, 0, (const LAS float*)(F.lds + RTAB_OFF)};
            pg8::fill_rstd((LAS float*)(F.lds + RTAB_OFF), (const float*)(ws + WS_RSSA), So, F.tid);
            DUP(6, (pg8::gemm_phase<pg8::EpiIn, pg8::StaticOrder, true>(F.lds, g, So, E, F.tid)));
            } SEAM(sb + 1);
        }
        if (EN(2) && RUN(sb + 2)) { _Pragma("unroll 1") for (int rp = 0; rp <= (int)REP(2); ++rp) { relaunder(F, args.ws, (LAS unsigned char*)lds_raw); unsigned char* ws = F.ws;
            if (F.bid >= F.G - 32) {
                pg8::Gemm g{(const bf16*)(ws + WS_XN), (const bf16*)(ws + WS_WIN) + ((size_t)l * NINP + (NINP - 256)) * D, D, D, D};
                pg8::StaticOrder So; So.init(S, 256, 32, F.bid - (F.G - 32)); pg8::EpiMisc E{ws, (const LAS float*)(F.lds + RTAB_OFF)};
                pg8::fill_rstd((LAS float*)(F.lds + RTAB_OFF), (const float*)(ws + WS_RSSA), So, F.tid);
                pg8::gemm_phase<pg8::EpiMisc, pg8::StaticOrder, true>(F.lds, g, So, E, F.tid);
            } else {
                const int Gs = F.G; F.G = Gs - 32;
                DUP(12, p_rwkv_prep(F, l));
                relaunder(F, args.ws, (LAS unsigned char*)lds_raw); F.G = Gs - 32; DUP(13, p_mamba_prep(F, l));
                __syncthreads(); relaunder(F, args.ws, (LAS unsigned char*)lds_raw); F.G = Gs - 32;
                for (int u = F.bid; u < 512; u += F.G) DUP(5, u_ret_kv(F, u >> 2, u & 3));
                F.G = Gs;
            }
            } SEAM(sb + 2);
        }
        if (EN(3) && RUN(sb + 3)) { _Pragma("unroll 1") for (int rp = 0; rp <= (int)REP(3); ++rp) { relaunder(F, args.ws, (LAS unsigned char*)lds_raw); unsigned char* ws = F.ws;
            { pg8::Gemm g{(const bf16*)(ws + WS_CQ), (const bf16*)(ws + WS_WQB) + (size_t)l * 1024 * 512, 512, 512, 512};
              pg8::StaticOrder So; So.init(S, 1024, F.G, F.bid); pg8::EpiQb E{ws, (const float*)(ws + WS_PRM) + (size_t)l * PRM_STRIDE + P_QNW};
              pg8::gemm_phase<pg8::EpiQb, pg8::StaticOrder, false>(F.lds, g, So, E, F.tid); __syncthreads(); }
            relaunder(F, args.ws, (LAS unsigned char*)lds_raw); ws = F.ws;
            { pg8::Gemm g{(const bf16*)(ws + WS_CKV), (const bf16*)(ws + WS_WKVB) + (size_t)l * 1024 * 256, 256, 256, 256};
              pg8::StaticOrder So; So.init(S, 1024, F.G, (F.bid + 128) % F.G); pg8::EpiKvb E{ws, (const float*)(ws + WS_PRM) + (size_t)l * PRM_STRIDE + P_KNW};
              pg8::gemm_phase<pg8::EpiKvb, pg8::StaticOrder, false>(F.lds, g, So, E, F.tid); __syncthreads(); }
            relaunder(F, args.ws, (LAS unsigned char*)lds_raw); ws = F.ws;
            if (l > 0) { pg8::Gemm g{(const bf16*)(ws + WS_VV), (const bf16*)(ws + WS_WV1) + (size_t)l * 256 * 512, 512, 512, 512};
              pg8::StaticOrder So; So.init(S, 256, F.G, (F.bid + 64) % F.G); pg8::EpiV1 E{ws};
              pg8::gemm_phase<pg8::EpiV1, pg8::StaticOrder, true>(F.lds, g, So, E, F.tid); __syncthreads(); }
            relaunder(F, args.ws, (LAS unsigned char*)lds_raw);
            for (int u = F.bid; u < 256; u += F.G) { u_mamba_dt(F, l, u >> 1); DUP(4, u_mamba_st(F, u >> 1, u & 1)); }
            } SEAM(sb + 3);
        }
        if (EN(4) && RUN(sb + 4)) { _Pragma("unroll 1") for (int rp = 0; rp <= (int)REP(4); ++rp) { relaunder(F, args.ws, (LAS unsigned char*)lds_raw); unsigned char* ws = F.ws;
            {
              pg8::Gemm g{(const bf16*)(ws + WS_ALORA), (const bf16*)(ws + WS_WLORA) + (size_t)l * 2048 * 512, 512, 512, 512};
              pg8::StaticOrder So; So.init(S, l > 0 ? 2048 : 1536, F.G, F.bid);
              const float* prm = (const float*)(ws + WS_PRM) + (size_t)l * PRM_STRIDE; pg8::EpiLora E{ws, prm + P_W0, prm + P_A0, prm + P_V0, prm + P_KA};
              DUP(9, (pg8::gemm_phase<pg8::EpiLora, pg8::StaticOrder, true>(F.lds, g, So, E, F.tid))); }
            } SEAM(sb + 4);
        }
        if (EN(5) && RUN(sb + 5)) { _Pragma("unroll 1") for (int rp = 0; rp <= (int)REP(5); ++rp) { relaunder(F, args.ws, (LAS unsigned char*)lds_raw); unsigned char* ws = F.ws; (void)ws;
            if (F.bid < 64) { p_scans(F, 64); relaunder(F, args.ws, (LAS unsigned char*)lds_raw);
                for (int u = F.bid * 2; u < F.bid * 2 + 2; ++u) u_rwkv_r1(F, u >> 3, u & 7); }
            else { for (int u = 128 + (F.bid - 64); u < 1024; u += F.G - 64) u_rwkv_r1(F, u >> 3, u & 7); }
            } SEAM(sb + 5);
        }
        if (EN(6) && RUN(sb + 6)) { _Pragma("unroll 1") for (int rp = 0; rp <= (int)REP(6); ++rp) { relaunder(F, args.ws, (LAS unsigned char*)lds_raw); unsigned char* ws = F.ws; (void)ws;
            if (F.bid < NSCAN_BLK) { p_rwkv_scan2(F, F.bid); }
            else {
                const int NB = F.G - NSCAN_BLK, b = F.bid - NSCAN_BLK;
                { const int* tab = (const int*)(ws + WS_ATAB);
                  for (int r = 0; r * NB < ATT_NSUB; ++r) { const int pos = (r & 1) ? NB - 1 - b : b; const int i = r * NB + pos;
                      if (i < ATT_NSUB) { const int e = tab[i]; DUP(0, u_attn2(F, e & 3, (e >> 2) & 31, (e >> 7) & 31, e >> 12)); } } }
            }
            } SEAM(sb + 6);
        }
        if (EN(7) && RUN(sb + 7)) { _Pragma("unroll 1") for (int rp = 0; rp <= (int)REP(7); ++rp) { relaunder(F, args.ws, (LAS unsigned char*)lds_raw); unsigned char* ws = F.ws; (void)ws;
            for (int u = F.bid; u < 1024; u += F.G) DUP(3, u_rwkv_r3(F, l, u >> 3, u & 7));
            for (int u = F.bid; u < 512; u += F.G) DUP(10, u_attn_comb(F, u >> 7, (u >> 2) & 31, u & 3));
            relaunder(F, args.ws, (LAS unsigned char*)lds_raw);
            for (int u = F.bid; u < 256; u += F.G) DUP(2, u_mamba_out(F, l, u >> 1, u & 1));
            relaunder(F, args.ws, (LAS unsigned char*)lds_raw);
            for (int u = F.bid; u < 512; u += F.G) DUP(1, u_ret_out(F, l, u >> 2, u & 3));
            } SEAM(sb + 7);
        }
        if (EN(8) && RUN(sb + 8)) { _Pragma("unroll 1") for (int rp = 0; rp <= (int)REP(8); ++rp) { relaunder(F, args.ws, (LAS unsigned char*)lds_raw); unsigned char* ws = F.ws;
            pg8::Gemm g{(const bf16*)(ws + WS_OB), (const bf16*)(ws + WS_WBR) + (size_t)l * 8192 * 512, 512, D, 512};
            pg8::BranchOrder So; So.init(F.G, F.bid); pg8::EpiBranch E{ws};
            DUP(8, (pg8::gemm_phase<pg8::EpiBranch, pg8::BranchOrder, true>(F.lds, g, So, E, F.tid)));
            } SEAM(sb + 8);
        }
        if (EN(9) && RUN(sb + 9)) { _Pragma("unroll 1") for (int rp = 0; rp <= (int)REP(9); ++rp) { relaunder(F, args.ws, (LAS unsigned char*)lds_raw); unsigned char* ws = F.ws;
            pg8::Gemm g{(const bf16*)(ws + WS_MERGED), (const bf16*)(ws + WS_WOUT) + (size_t)l * D * D, D, D, D};
            pg8::StaticOrder So; So.init(S, D, F.G, F.bid); pg8::EpiRes E{xin, args.out, (bf16*)(ws + WS_XN), (float*)(ws + WS_RSSB)};
            pg8::gemm_phase<pg8::EpiRes, pg8::StaticOrder, true>(F.lds, g, So, E, F.tid);
            } SEAM(sb + 9);
        }
        if (EN(10) && RUN(sb + 10)) { _Pragma("unroll 1") for (int rp = 0; rp <= (int)REP(10); ++rp) { relaunder(F, args.ws, (LAS unsigned char*)lds_raw); unsigned char* ws = F.ws; DUP(11, p_rmsnorm(F, args.out, (const float*)(ws + WS_PRM) + (size_t)l * PRM_STRIDE + P_N2, (bf16*)(ws + WS_XN))); } SEAM(sb + 10); }
        if (EN(11) && RUN(sb + 11)) { _Pragma("unroll 1") for (int rp = 0; rp <= (int)REP(11); ++rp) { relaunder(F, args.ws, (LAS unsigned char*)lds_raw); unsigned char* ws = F.ws;
            pg8::Gemm g{(const bf16*)(ws + WS_XN), (const bf16*)(ws + WS_WGU) + (size_t)l * 2 * DFF * D, D, D, D};
            pg8::StaticOrder So; So.init(S, 2 * DFF, F.G, F.bid); pg8::EpiGu E{ws, (const LAS float*)(F.lds + RTAB_OFF)};
            pg8::fill_rstd((LAS float*)(F.lds + RTAB_OFF), (const float*)(ws + WS_RSSB), So, F.tid);
            DUP(7, (pg8::gemm_phase<pg8::EpiGu, pg8::StaticOrder, true>(F.lds, g, So, E, F.tid)));
            } SEAM(sb + 11);
        }
        if (EN(12) && RUN(sb + 12)) { _Pragma("unroll 1") for (int rp = 0; rp <= (int)REP(12); ++rp) { relaunder(F, args.ws, (LAS unsigned char*)lds_raw); unsigned char* ws = F.ws;
            pg8::Gemm g{(const bf16*)(ws + WS_ACT), (const bf16*)(ws + WS_WDN) + (size_t)l * D * DFF, DFF, DFF, DFF};
            pg8::StaticOrder So; So.init(S, D, F.G, F.bid); pg8::EpiRes E{args.out, args.out, (bf16*)(ws + WS_XN), (l + 1 < DEPTH) ? (float*)(ws + WS_RSSA) : nullptr};
            pg8::gemm_phase<pg8::EpiRes, pg8::StaticOrder, true>(F.lds, g, So, E, F.tid);
            } SEAM(sb + 12);
        }
    }
#undef RUN
#undef SEAM
}

#ifndef MK_ONE_LAUNCH
#define MK_ONE_LAUNCH 1
#endif
extern "C" void kernel_launch(void* const* d_in, const int* in_sizes, int n_in, void* d_out, int out_size, void* d_ws, size_t ws_size, hipStream_t stream) {
    static int grid = 0;
    if (grid == 0) {
        if (n_in != 36 || in_sizes[0] != S * D || out_size != S * D || ws_size < WS_END3) { fprintf(stderr, "kernel_launch: bad shapes: n_in %d in0 %d out %d ws %zu (need %zu)\n", n_in, n_in > 0 ? in_sizes[0] : -1, out_size, ws_size, (size_t)WS_END3); grid = -1; return; }
        int dev = 0, cus = 0, per_cu = 0;
        if (hipGetDevice(&dev) != hipSuccess || hipDeviceGetAttribute(&cus, hipDeviceAttributeMultiprocessorCount, dev) != hipSuccess) { grid = -1; return; }
        if (hipFuncSetAttribute((const void*)mk_fwd, hipFuncAttributeMaxDynamicSharedMemorySize, LDS_BYTES) != hipSuccess) { fprintf(stderr, "kernel_launch: hipFuncSetAttribute failed\n"); grid = -1; return; }
        if (hipOccupancyMaxActiveBlocksPerMultiprocessor(&per_cu, (const void*)mk_fwd, NTHR, LDS_BYTES) != hipSuccess || per_cu < 1) fprintf(stderr, "kernel_launch: occupancy query says %d\n", per_cu);
        (void)hipGetLastError();
        grid = cus;
        if (grid != 256) fprintf(stderr, "kernel_launch: %d CUs (built for 256)\n", grid);
    }
    if (grid < 0) return;
    if (hipMemsetAsync((char*)d_ws + WS_CTL, 0, CTL_ZERO_BYTES, stream) != hipSuccess) return;
    Args a{};
    for (int i = 0; i < 36; ++i) a.in[i] = (const float*)d_in[i];
    a.out = (float*)d_out; a.ws = (unsigned char*)d_ws;
#if MK_ONE_LAUNCH
    a.st_lo = 0; a.st_hi = NSTEPS;
    hipLaunchKernelGGL(mk_fwd, dim3(grid), dim3(NTHR), LDS_BYTES, stream, a);
#ifndef MK_EXTRA_FLAGS
#define MK_EXTRA_FLAGS 0
#endif
#ifdef MK_EXTRA_STEPS
    { const int xs[] = {MK_EXTRA_STEPS};
      for (int r = 0; r < MK_EXTRA_N; ++r) for (unsigned i = 0; i < sizeof(xs) / sizeof(xs[0]); ++i) { a.st_lo = xs[i]; a.st_hi = xs[i] + 1; hipLaunchKernelGGL(mk_fwd, dim3(grid), dim3(NTHR), LDS_BYTES, stream, a); } }
#endif
#else
    for (int s = 0; s < NSTEPS; ++s) { a.st_lo = s; a.st_hi = s + 1; hipLaunchKernelGGL(mk_fwd, dim3(grid), dim3(NTHR), LDS_BYTES, stream, a); }
#endif
}
```

```cpp
#include <hip/hip_runtime.h>
#include <cstdio>
#include <cstdint>

#define GAS __attribute__((address_space(1)))
#define LAS __attribute__((address_space(3)))
typedef unsigned short bf16;
typedef short bf16x8 __attribute__((ext_vector_type(8)));
typedef short s16x4 __attribute__((ext_vector_type(4)));
typedef float f32x4 __attribute__((ext_vector_type(4)));
typedef float f32x2 __attribute__((ext_vector_type(2)));
typedef unsigned u32x4 __attribute__((ext_vector_type(4)));
typedef unsigned u32x2 __attribute__((ext_vector_type(2)));
typedef GAS unsigned gu32;
#define RLX_AGENT __ATOMIC_RELAXED, __HIP_MEMORY_SCOPE_AGENT
#define DI __device__ __forceinline__

constexpr int S = 8192, D = 2048, DEPTH = 4, NIN = 14408, NINP = 14592, DFF = 5632;
constexpr int NCH = 128;
constexpr float LOG2E = 1.4426950408889634f;

DI float bf2f(unsigned v) { return __uint_as_float(v << 16); }
typedef __bf16 bf16x2_t __attribute__((ext_vector_type(2)));
DI unsigned pk2(float lo, float hi) { const f32x2 v = {lo, hi}; const bf16x2_t b = __builtin_convertvector(v, bf16x2_t); return __builtin_bit_cast(unsigned, b); }
DI unsigned f2bf(float f) { const __bf16 b = (__bf16)f; return (unsigned)__builtin_bit_cast(unsigned short, b); }
DI float fexp_(float x) { return __builtin_amdgcn_exp2f(x * 1.4426950408889634f); }
DI float ftanh_(float x) { return 1.0f - 2.0f * __builtin_amdgcn_rcpf(1.0f + fexp_(2.0f * x)); }
DI float sigmoidf_(float x) { return __builtin_amdgcn_rcpf(1.0f + fexp_(-x)); }
DI float siluf_(float x) { return x * __builtin_amdgcn_rcpf(1.0f + fexp_(-x)); }
DI float softplusf_(float x) { return fmaxf(x, 0.f) + log1pf(fexp_(-fabsf(x))); }
DI u32x4 pack8(const f32x4 a, const f32x4 b) { u32x4 w; w.x = pk2(a[0], a[1]); w.y = pk2(a[2], a[3]); w.z = pk2(b[0], b[1]); w.w = pk2(b[2], b[3]); return w; }
DI void unpack8(const u32x4 w, float (&o)[8]) { o[0] = bf2f(w.x & 0xffffu); o[1] = bf2f(w.x >> 16); o[2] = bf2f(w.y & 0xffffu); o[3] = bf2f(w.y >> 16);
    o[4] = bf2f(w.z & 0xffffu); o[5] = bf2f(w.z >> 16); o[6] = bf2f(w.w & 0xffffu); o[7] = bf2f(w.w >> 16); }

namespace pg8 {
constexpr int BM = 256, BK = 64, HALF = 128, HTB = HALF * BK * 2, STAGE_BYTES = 8 * HTB, NXCD = 8, WGM = 8;
DI int lds_byte(int r, int c) { const int st = (r >> 4) * 2 + (c >> 5), rr = r & 15, cc = c & 31, ob = rr * 64 + cc * 2; return st * 1024 + (ob ^ (((ob >> 9) & 1) << 5)); }
DI void stage_rc(int b, int& R, int& C) { const int st = b / 1024, sb = b % 1024, swz = sb ^ (((sb >> 9) & 1) << 5); R = (st >> 1) * 16 + swz / 64; C = (st & 1) * 32 + (swz % 64) / 2; }
DI int perm32(int rho) { const int n = rho >> 4, i = rho & 15; return 8 * (i >> 2) + 4 * n + (i & 3); }

struct Unit { int pm, pn, ak, brow, sub, ord; };
struct Gemm { const bf16* A; const bf16* Bt; int K, lda, ldb; };

struct StaticOrder {
    int nM, nN, nwg, G, c;
    DI void init(int M, int N, int G_, int c_) { nM = M / BM; nN = N / BM; nwg = nM * nN; G = G_; c = c_; }
    DI bool next(int i, Unit& u) const {
        const long L = (long)i * G + c; if (L >= nwg) return false;
        int wgid = (int)L; { const int q = nwg / NXCD, r = nwg % NXCD, xcd = wgid % NXCD, off = wgid / NXCD; wgid = (xcd < r ? xcd * (q + 1) : r * (q + 1) + (xcd - r) * q) + off; }
        const int nig = WGM * nN, gid = wgid / nig, fm = gid * WGM, gsz = (nM - fm) < WGM ? (nM - fm) : WGM;
        u.pm = fm + ((wgid % nig) % gsz); u.pn = (wgid % nig) / gsz; u.ak = 0; u.brow = u.pn * BM; u.sub = 0; return true;
    }
};
struct LoraOrder {
    StaticOrder so;
    DI void init(int N, int G_, int c_) { so.init(S, N, G_, c_); }
    DI bool next(int i, Unit& u) const { if (!so.next(i, u)) return false; u.ak = (u.pn >= 4) ? 256 : 0; return true; }
};
struct BranchOrder {
    StaticOrder so;
    DI void init(int G_, int c_) { so.init(S, D, G_, c_); }
    DI bool next(int i, Unit& u) const { if (!so.next(i >> 2, u)) return false; u.sub = i & 3; u.ak = u.sub * 512; u.brow = u.sub * D + u.pn * BM; return true; }
};

typedef f32x4 Acc[2][2][4][2];

template <class Epi, class Sched, bool ALIGN_EPI>
DI void gemm_phase(LAS unsigned char* lds, const Gemm g, const Sched& Sc, const Epi& E, const int tid) {
    const int wid = __builtin_amdgcn_readfirstlane(tid >> 6), lane = tid & 63, wr = wid >> 2, wc = wid & 3, fr = lane & 15, fq = lane >> 4;
    const int K = g.K, nt = K / BK;
    unsigned voffA[2], voffB[2];
#pragma unroll
    for (int i = 0; i < 2; ++i) { int R, C; stage_rc(tid * 16 + i * 8192, R, C); const int Rb = (R & ~31) + perm32(R & 31);
        voffA[i] = (unsigned)(R * g.lda + C) * 2u; voffB[i] = (unsigned)(Rb * g.ldb + C) * 2u; }
    const size_t kstep = (size_t)(BK * 2);
    const size_t hA = (size_t)HALF * g.lda * 2, hB = (size_t)HALF * g.ldb * 2;
    const unsigned ldsw = (unsigned)wid * 1024u;
    const int aoff = lds_byte(wr * 64 + fr, fq * 8), boff = lds_byte(wc * 32 + fr, fq * 8);
#define PG8_SA(b, h) (((b) * 2 + (h)) * HTB)
#define PG8_SB(b, h) ((4 + (b) * 2 + (h)) * HTB)
#define PG8_STAGE(bufoff, gbase, voff) do { _Pragma("unroll") for (int _i = 0; _i < 2; ++_i) \
        __builtin_amdgcn_global_load_lds((const unsigned*)((const char*)(gbase) + (voff)[_i]), (LAS unsigned*)(lds + (bufoff) + ldsw + _i * 8192), 16, 0, 0); } while (0)
#define PG8_LDA(dst, b, h) do { _Pragma("unroll") for (int m = 0; m < 4; ++m) _Pragma("unroll") for (int k = 0; k < 2; ++k) dst[m][k] = *(const LAS bf16x8*)(lds + PG8_SA(b, h) + aoff + m * 2048 + k * 1024); } while (0)
#define PG8_LDB(dst, b, h) do { _Pragma("unroll") for (int n = 0; n < 2; ++n) _Pragma("unroll") for (int k = 0; k < 2; ++k) dst[n][k] = *(const LAS bf16x8*)(lds + PG8_SB(b, h) + boff + n * 2048 + k * 1024); } while (0)
#define PG8_MMA(ai, bj, At, Bt) do { __builtin_amdgcn_s_setprio(1); _Pragma("unroll") for (int m = 0; m < 4; ++m) _Pragma("unroll") for (int n = 0; n < 2; ++n) _Pragma("unroll") for (int k = 0; k < 2; ++k) \
        acc[ai][bj][m][n] = __builtin_amdgcn_mfma_f32_16x16x32_bf16(Bt[n][k], At[m][k], acc[ai][bj][m][n], 0, 0, 0); __builtin_amdgcn_s_setprio(0); } while (0)
#define PG8_WAIT_V(n) asm volatile("s_waitcnt vmcnt(" #n ")" ::: "memory")
#define PG8_WAIT_L(n) asm volatile("s_waitcnt lgkmcnt(" #n ")" ::: "memory")
#define PG8_BAR __builtin_amdgcn_s_barrier()
#define PG8_SCHED __builtin_amdgcn_sched_barrier(0)
    Unit cur, nxt; int ui = 0;
    if (!Sc.next(0, cur)) return;
    cur.ord = 0;
    Acc acc;
#pragma unroll
    for (int a = 0; a < 2; ++a)
#pragma unroll
        for (int b = 0; b < 2; ++b)
#pragma unroll
            for (int m = 0; m < 4; ++m)
#pragma unroll
                for (int n = 0; n < 2; ++n) acc[a][b][m][n] = (f32x4){0.f, 0.f, 0.f, 0.f};
    bf16x8 At[4][2], B0[2][2], B1[2][2];
    const char* cA = (const char*)g.A + ((size_t)cur.pm * BM * g.lda + cur.ak) * 2; const char* cB = (const char*)g.Bt + (size_t)cur.brow * g.ldb * 2;
    PG8_STAGE(PG8_SB(0, 0), cB, voffB); PG8_STAGE(PG8_SB(0, 1), cB + hB, voffB); PG8_STAGE(PG8_SA(0, 0), cA, voffA); PG8_STAGE(PG8_SA(0, 1), cA + hA, voffA);
    if (wr == 1) PG8_BAR;
    PG8_WAIT_V(2); PG8_BAR;
    PG8_STAGE(PG8_SB(1, 0), cB + kstep, voffB); PG8_STAGE(PG8_SA(1, 0), cA + kstep, voffA); PG8_STAGE(PG8_SB(1, 1), cB + hB + kstep, voffB);
    PG8_WAIT_V(6); PG8_BAR;
    for (;;) {
        const bool has_next = Sc.next(ui + 1, nxt); nxt.ord = ui + 1;
        const char* nA = has_next ? (const char*)g.A + ((size_t)nxt.pm * BM * g.lda + nxt.ak) * 2 : cA; const char* nB = has_next ? (const char*)g.Bt + (size_t)nxt.brow * g.ldb * 2 : cB;
        for (int t = 0; t < nt; t += 2) {
            const bool last = (t == nt - 2);
            const char* a1 = cA + (size_t)(t + 1) * kstep;
            const char* a2 = last ? nA : cA + (size_t)(t + 2) * kstep; const char* b2 = last ? nB : cB + (size_t)(t + 2) * kstep;
            const char* a3 = a2 + kstep; const char* b3 = b2 + kstep;
            PG8_LDB(B0, 0, 0); PG8_LDB(B1, 0, 1); PG8_SCHED; PG8_LDA(At, 0, 0); PG8_STAGE(PG8_SA(1, 1), a1 + hA, voffA);
            PG8_WAIT_V(8); PG8_WAIT_L(0); PG8_BAR; PG8_MMA(0, 0, At, B0); PG8_MMA(0, 1, At, B1); PG8_BAR; PG8_SCHED;
            PG8_LDA(At, 0, 1); PG8_STAGE(PG8_SB(0, 0), b2, voffB); PG8_STAGE(PG8_SB(0, 1), b2 + hB, voffB); PG8_STAGE(PG8_SA(0, 0), a2, voffA);
            PG8_WAIT_V(8); PG8_WAIT_L(0); PG8_BAR; PG8_MMA(1, 0, At, B0); PG8_MMA(1, 1, At, B1); PG8_BAR; PG8_SCHED;
            PG8_LDB(B0, 1, 0); PG8_LDB(B1, 1, 1); PG8_SCHED; PG8_LDA(At, 1, 0); PG8_STAGE(PG8_SA(0, 1), a2 + hA, voffA);
            PG8_WAIT_V(8); PG8_WAIT_L(0); PG8_BAR; PG8_MMA(0, 0, At, B0); PG8_MMA(0, 1, At, B1); PG8_BAR; PG8_SCHED;
            PG8_LDA(At, 1, 1); PG8_STAGE(PG8_SB(1, 0), b3, voffB); PG8_STAGE(PG8_SB(1, 1), b3 + hB, voffB); PG8_STAGE(PG8_SA(1, 0), a3, voffA);
            PG8_WAIT_V(8); PG8_WAIT_L(0); PG8_BAR; PG8_MMA(1, 0, At, B0); PG8_MMA(1, 1, At, B1); PG8_BAR; PG8_SCHED;
        }
        if constexpr (ALIGN_EPI) { if (wr == 0) PG8_BAR; }
        bool zero = true;
        if constexpr (!Epi::AFTER_DRAIN) { zero = E(acc, cur, wr, wc, fr, fq); }
        if (!has_next) break;
        if (zero) {
#pragma unroll
        for (int a = 0; a < 2; ++a)
#pragma unroll
            for (int b = 0; b < 2; ++b)
#pragma unroll
                for (int m = 0; m < 4; ++m)
#pragma unroll
                    for (int n = 0; n < 2; ++n) acc[a][b][m][n] = (f32x4){0.f, 0.f, 0.f, 0.f};
        }
        cur = nxt; cA = nA; cB = nB; ++ui;
        if constexpr (ALIGN_EPI) { if (wr == 1) PG8_BAR; }
    }
    PG8_WAIT_V(0);
    if constexpr (!ALIGN_EPI) { if (wr == 0) PG8_BAR; }
    PG8_BAR;
    if constexpr (Epi::AFTER_DRAIN) { E.fused(acc, cur, wr, wc, fr, fq, lds, wid, lane, tid); }
#undef PG8_SA
#undef PG8_SB
#undef PG8_STAGE
#undef PG8_LDA
#undef PG8_LDB
#undef PG8_MMA
#undef PG8_WAIT_V
#undef PG8_WAIT_L
#undef PG8_BAR
#undef PG8_SCHED
}
}

constexpr size_t MiB = 1u << 20;
constexpr size_t al256(size_t x) { return (x + 255) & ~(size_t)255; }
constexpr size_t WS_CTL = 0, CTL_ZERO_BYTES = 1 * MiB;
constexpr size_t WS_PRM = 1 * MiB;
constexpr int P_N1 = 0, P_N2 = 2048, P_GN = 4096, P_CW = 4608, P_CB = 8704, P_DTB = 9728, P_ALOG = 9736, P_SD = 9744, P_SNW = 9760, P_QNW = 10272, P_KNW = 10464, P_MU = 10656,
              P_W0 = 12448, P_A0 = 12960, P_V0 = 13472, P_KK = 13984, P_KA = 14496, P_RK = 15008, P_LNW = 15520, P_LNB = 16032, PRM_STRIDE = 16640;
constexpr size_t WS_COSR = 2 * MiB;
constexpr size_t WS_SINR = WS_COSR + (size_t)S * 64 * 4;
constexpr size_t WS_COSM = WS_SINR + (size_t)S * 64 * 4;
constexpr size_t WS_SINM = WS_COSM + (size_t)S * 32 * 4;
constexpr size_t WS_WIN  = WS_SINM + (size_t)S * 32 * 4;
constexpr size_t WS_WQB  = WS_WIN + (size_t)DEPTH * NINP * D * 2;
constexpr size_t WS_WKVB = WS_WQB + (size_t)DEPTH * 1024 * 512 * 2;
constexpr size_t WS_WV1  = WS_WKVB + (size_t)DEPTH * 1024 * 256 * 2;
constexpr size_t WS_WLORA = WS_WV1 + (size_t)DEPTH * 256 * 512 * 2;
constexpr size_t WS_WBR  = WS_WLORA + (size_t)DEPTH * 2048 * 512 * 2;
constexpr size_t WS_WOUT = WS_WBR + (size_t)DEPTH * 8192 * 512 * 2;
constexpr size_t WS_WGU  = WS_WOUT + (size_t)DEPTH * D * D * 2;
constexpr size_t WS_WDN  = WS_WGU + (size_t)DEPTH * 2 * DFF * D * 2;
constexpr size_t WS_ACT0 = WS_WDN + (size_t)DEPTH * D * DFF * 2;
constexpr size_t WS_XN   = WS_ACT0;
constexpr size_t WS_QR   = WS_XN + (size_t)S * D * 2;
constexpr size_t WS_KR   = WS_QR + (size_t)S * 512 * 2;
constexpr size_t WS_VR   = WS_KR + (size_t)S * 512 * 2;
constexpr size_t WS_GR   = WS_VR + (size_t)S * 512 * 2;
constexpr size_t WS_ZS   = WS_GR + (size_t)S * 512 * 2;
constexpr size_t WS_XBC  = WS_ZS + (size_t)S * 512 * 2;
constexpr size_t WS_XC   = WS_XBC + (size_t)S * 1024 * 2;
constexpr size_t WS_CQ   = WS_XC + (size_t)S * 1024 * 2;
constexpr size_t WS_CKV  = WS_CQ + (size_t)S * 512 * 2;
constexpr size_t WS_SSQ  = WS_CKV + (size_t)S * 256 * 2;
constexpr size_t WS_RW   = WS_SSQ + (size_t)S * 16 * 4;
constexpr size_t WS_GATE = WS_RW + (size_t)S * 1792 * 4;
constexpr size_t WS_MISC = WS_GATE + (size_t)S * 8192 * 2;
constexpr size_t WS_DTS  = WS_MISC + (size_t)S * 256 * 4;
constexpr size_t WS_ACS  = WS_DTS + (size_t)S * 8 * 4;
constexpr size_t WS_RKV  = WS_ACS + (size_t)S * 8 * 4;
constexpr size_t WS_MST  = WS_RKV + (size_t)NCH * 4 * 128 * 128 * 4;
constexpr size_t WS_QM   = WS_MST + (size_t)NCH * 8 * 64 * 128 * 4;
constexpr size_t WS_KM   = WS_QM + (size_t)S * 768 * 2;
constexpr size_t WS_VT   = WS_KM + (size_t)S * 768 * 2;
constexpr size_t WS_R32  = WS_VT + (size_t)512 * S * 2;
constexpr size_t SZ32    = (size_t)S * 512 * 4;
constexpr size_t WS_KKN  = WS_R32 + SZ32, WS_K32 = WS_KKN + SZ32, WS_VV = WS_K32 + SZ32, WS_VFIRST = WS_VV + SZ32, WS_DEC = WS_VFIRST + SZ32,
                 WS_KP = WS_DEC + SZ32, WS_BB = WS_KP + SZ32, WS_G32 = WS_BB + SZ32, WS_Y32 = WS_G32 + SZ32;
constexpr size_t WS_VB   = WS_Y32 + SZ32;
constexpr size_t WS_ALORA = WS_VB + (size_t)S * 512 * 2;
constexpr size_t WS_OB   = WS_ALORA + (size_t)S * 512 * 2;
constexpr size_t WS_MERGED = WS_OB + (size_t)S * D * 2;
constexpr size_t WS_ACT  = WS_MERGED + (size_t)S * D * 2;
constexpr size_t WS_END  = WS_ACT + (size_t)S * DFF * 2;

constexpr int CW_TMO = 0, CW_CODE = 1, CW_BAR = 4096;


constexpr int NWAVES = 8, NTHR = 512;
constexpr int RING_BYTES = 143360, LDSCTL_OFF = RING_BYTES, MISC_OFF = LDSCTL_OFF + 320, LDS_BYTES = 147456;
#define LDS_WAIT() asm volatile("s_waitcnt lgkmcnt(0)" ::: "memory")
#define VM_WAIT() asm volatile("s_waitcnt vmcnt(0)" ::: "memory")

#define XB_TMO      128
#define XB_XCNT(j)  (256  + 64 * (j))
#define XB_XSUB(j)  (1280 + 64 * (j))
#define XB_XGEN(j)  (2304 + 64 * (j))
#define XB_TOP      3328
#define XB_TOPGEN   3392
#define XCD_BAR_WORDS 3456
#define XB_SPIN_CAP (1u << 22)
DI unsigned xb_ld(unsigned* p)              { return __hip_atomic_load(p, __ATOMIC_RELAXED, __HIP_MEMORY_SCOPE_AGENT); }
DI unsigned xb_add(unsigned* p, unsigned v) { return __hip_atomic_fetch_add(p, v, __ATOMIC_RELAXED, __HIP_MEMORY_SCOPE_AGENT); }
DI unsigned xb_xcc_id() { return (unsigned)__builtin_amdgcn_s_getreg((3 << 11) | 20) & 0xFu; }
#define XB_SPIN(cond, bar) do { unsigned _sp = 0; while (cond) { __builtin_amdgcn_s_sleep(1); \
    if ((++_sp & 255u) == 0u) { if (xb_ld(&(bar)[XB_TMO])) break; if (_sp > XB_SPIN_CAP) { atomicAdd(&(bar)[XB_TMO], 1u); break; } } } } while (0)
struct XcdBarrier { unsigned* bar; unsigned x; volatile LAS unsigned* st; };
DI XcdBarrier xcd_barrier_post(unsigned* bar, volatile LAS unsigned* st) {
    XcdBarrier b; b.bar = bar; b.x = xb_xcc_id(); b.st = st;
    if (threadIdx.x == 0) (void)xb_add(&bar[XB_XCNT(b.x)], 1u);
    return b;
}
DI void xcd_barrier_complete(unsigned* bar, unsigned x, unsigned& nloc, unsigned& nx) {
    const unsigned G = gridDim.x * gridDim.y * gridDim.z;
    unsigned sum, cnt, mine, sp = 0u;
    for (;;) {
        sum = 0u; cnt = 0u; mine = 0u;
#pragma unroll
        for (unsigned j = 0; j < 16; ++j) { const unsigned c = xb_ld(&bar[XB_XCNT(j)]); sum += c; cnt += (c > 0u) ? 1u : 0u; mine = (j == x) ? c : mine; }
        if (sum == G) break;
        __builtin_amdgcn_s_sleep(1);
        if ((++sp & 255u) == 0u) { if (xb_ld(&bar[XB_TMO])) break; if (sp > XB_SPIN_CAP) { atomicAdd(&bar[XB_TMO], 1u); break; } }
    }
    nloc = mine > 0u ? mine : 1u; nx = cnt > 0u ? cnt : 1u;
}
DI void xcd_barrier(const XcdBarrier& b) {
    asm volatile("s_waitcnt vmcnt(0)" ::: "memory");
    __syncthreads();
    if (threadIdx.x == 0) {
        unsigned* bar = b.bar;
        __builtin_amdgcn_s_waitcnt(0);
        unsigned nloc = b.st[0], nx = b.st[1];
        if (nloc == 0u) { xcd_barrier_complete(bar, b.x, nloc, nx); b.st[0] = nloc; b.st[1] = nx; }
        const unsigned old = xb_add(&bar[XB_XSUB(b.x)], 1u);
        const unsigned gen = old / nloc;
        if (old + 1u == (gen + 1u) * nloc) {
            __builtin_amdgcn_fence(__ATOMIC_RELEASE, "agent");
            asm volatile("s_waitcnt vmcnt(0)" ::: "memory");
            const unsigned og = xb_add(&bar[XB_TOP], 1u);
            const unsigned tg = og / nx;
            if (og + 1u == (tg + 1u) * nx) xb_add(&bar[XB_TOPGEN], 1u);
            else XB_SPIN(xb_ld(&bar[XB_TOPGEN]) == tg, bar);
            __builtin_amdgcn_fence(__ATOMIC_ACQUIRE, "agent");
            xb_add(&bar[XB_XGEN(b.x)], 1u);
            asm volatile("s_waitcnt vmcnt(0)" ::: "memory");
        } else {
            XB_SPIN(xb_ld(&bar[XB_XGEN(b.x)]) == gen, bar);
            __builtin_amdgcn_fence(__ATOMIC_ACQUIRE, "agent");
            asm volatile("s_waitcnt vmcnt(0)" ::: "memory");
        }
    }
    __syncthreads();
}

struct Args { const float* in[36]; float* out; unsigned char* ws; int st_lo, st_hi; };
struct Frame {
    LAS unsigned char* lds; volatile LAS unsigned* MISC; gu32* ctl;
    int tid, lane, wave, G, bid;
    unsigned char* ws;
};
DI void relaunder(Frame& F, unsigned char* ws0, LAS unsigned char* lds0) {
    int t = threadIdx.x; asm volatile("" : "+v"(t)); F.tid = t; F.lane = t & 63; F.wave = __builtin_amdgcn_readfirstlane(t >> 6);
    unsigned long long w = (unsigned long long)ws0; asm volatile("" : "+s"(w)); F.ws = (unsigned char*)w; F.ctl = (gu32*)(F.ws + WS_CTL);
    unsigned lb = (unsigned)(unsigned long)lds0; asm volatile("" : "+s"(lb)); F.lds = (LAS unsigned char*)(unsigned long)lb; F.MISC = (volatile LAS unsigned*)(F.lds + MISC_OFF);
    int b = blockIdx.x; asm volatile("" : "+s"(b)); F.bid = b;
}
#define XR_SWAP(INS, a, b) asm volatile("s_nop 1\n\t" INS " %0, %1" : "+v"(a), "+v"(b))
DI float xr16_max(float x) { float a = x, b = x; XR_SWAP("v_permlane16_swap_b32", a, b); return fmaxf(a, b); }
DI float xr32_max(float x) { float a = x, b = x; XR_SWAP("v_permlane32_swap_b32", a, b); return fmaxf(a, b); }
DI float xr16_sum(float x) { float a = x, b = x; XR_SWAP("v_permlane16_swap_b32", a, b); return a + b; }
DI float xr32_sum(float x) { float a = x, b = x; XR_SWAP("v_permlane32_swap_b32", a, b); return a + b; }
template <int CTRL> DI float dpp_f(float v) { return __builtin_bit_cast(float, __builtin_amdgcn_update_dpp(0, __builtin_bit_cast(int, v), CTRL, 0xf, 0xf, true)); }
DI float row_sum16(float v) { v += dpp_f<0xB1>(v); v += dpp_f<0x4E>(v); v += dpp_f<0x141>(v); v += dpp_f<0x140>(v); return v; }
DI float wave_sum(float v) { return xr32_sum(xr16_sum(row_sum16(v))); }
DI float wave_sum_dpp(float v) {
    const float t = row_sum16(v);
    const float s0 = __builtin_bit_cast(float, __builtin_amdgcn_readlane(__builtin_bit_cast(int, t), 0));
    const float s1 = __builtin_bit_cast(float, __builtin_amdgcn_readlane(__builtin_bit_cast(int, t), 16));
    const float s2 = __builtin_bit_cast(float, __builtin_amdgcn_readlane(__builtin_bit_cast(int, t), 32));
    const float s3 = __builtin_bit_cast(float, __builtin_amdgcn_readlane(__builtin_bit_cast(int, t), 48));
    return (s0 + s1) + (s2 + s3);
}
constexpr size_t WS_QYT = WS_END;
constexpr size_t WS_CYT = WS_QYT + (size_t)1024 * 4096 * 2;
constexpr size_t WS_TST = WS_CYT + (size_t)1024 * 4096 * 2;
constexpr size_t WS_NST = WS_TST + (size_t)1024 * 4096 * 2;
constexpr size_t WS_S0  = WS_NST + (size_t)1024 * 4096 * 4;
constexpr size_t WS_END2 = WS_S0 + (size_t)1024 * 4096 * 2;
constexpr int ATT_NSUB = 576, ATT_RUN = 16;
constexpr size_t WS_ATAB = WS_END2;
constexpr size_t WS_APO  = WS_ATAB + 8192;
constexpr size_t WS_APM  = WS_APO + (size_t)ATT_NSUB * 32768 * 4;
constexpr size_t WS_RSSA = WS_APM + (size_t)ATT_NSUB * 512 * 4;
constexpr size_t WS_RSSB = WS_RSSA + (size_t)S * 32 * 4;
constexpr size_t WS_END3 = WS_RSSB + (size_t)S * 32 * 4;
constexpr int RTAB_OFF = 131072;
DI int att_slot(int h, int qb, int s) { const int g = qb >> 2; return h * 144 + (g + 1) * (qb - 2 * g) + s; }

DI int map_in(int n) {
    const int T = n >> 8, c = n & 255;
    if (T < 4) { const int base = (T >> 1) * 512, tp = T & 1, half = c >> 7, hs = (c >> 6) & 1, j = c & 63; return base + (2 * tp + hs) * 128 + half * 64 + j; }
    if (T < 6) return 1024 + (T - 4) * 256 + c;
    if (T < 8) return 1536 + (T - 6) * 256 + c;
    if (T < 10) return 2048 + (T - 8) * 256 + c;
    if (T < 14) return 2560 + (T - 10) * 256 + c;
    if (T < 16) return 3592 + (T - 14) * 256 + c;
    if (T == 16) return 4104 + c;
    if (T < 24) return 4424 + (T - 17) * 256 + c;
    if (T < 56) return 6216 + (T - 24) * 256 + c;
    if (c < 8) return 3584 + c;
    if (c < 72) return 4360 + (c - 8);
    return -1;
}
DI int map_fn(int mapid, int n, int Nsrc) {
    if (mapid == 0) return n < Nsrc ? n : -1;
    if (mapid == 1) return map_in(n);
    if (mapid == 2) { const int T = n >> 8, c = n & 255; return c < 128 ? T * 128 + c : DFF + T * 128 + (c - 128); }
    if (mapid == 3) { const int h = n >> 8, c = n & 255; if (c < 96) return h * 192 + c; if (c < 128) return h * 192 + 128 + (c - 96); if (c < 160) return h * 192 + 96 + (c - 128); if (c < 224) return -1; return h * 192 + 160 + (c - 224); }
    return n < 32 ? n : -1;
}
DI void conv_item(const float* W, int K, int Nsrc, bf16* Wt, const float* kscale, int mapid, LAS bf16* tile, int item, int nblk, int lane) {
    const int kb = item / nblk, nb = item - kb * nblk, k0 = 64 * kb, n0 = 64 * nb;
    const int src = map_fn(mapid, n0 + lane, Nsrc);
    const float* wp = W + (size_t)k0 * Nsrc + (src >= 0 ? src : 0);
#pragma unroll
    for (int hf = 0; hf < 2; ++hf) { float v[32];
#pragma unroll
        for (int i = 0; i < 32; ++i) v[i] = wp[(size_t)(32 * hf + i) * Nsrc];
        if (src < 0) {
#pragma unroll
            for (int i = 0; i < 32; ++i) v[i] = 0.f; }
        if (kscale) {
#pragma unroll
            for (int i = 0; i < 32; ++i) v[i] *= kscale[k0 + 32 * hf + i]; }
#pragma unroll
        for (int q = 0; q < 4; ++q) { u32x4 o; o.x = pk2(v[8 * q], v[8 * q + 1]); o.y = pk2(v[8 * q + 2], v[8 * q + 3]); o.z = pk2(v[8 * q + 4], v[8 * q + 5]); o.w = pk2(v[8 * q + 6], v[8 * q + 7]);
            *(LAS u32x4*)(tile + lane * 72 + 32 * hf + 8 * q) = o; } }
    LDS_WAIT(); asm volatile("" ::: "memory");
#pragma unroll
    for (int i = 0; i < 8; ++i) { const int r = i * 8 + (lane >> 3), c8 = lane & 7;
        *(GAS u32x4*)(Wt + (size_t)(n0 + r) * K + k0 + 8 * c8) = *(const LAS u32x4*)(tile + r * 72 + 8 * c8); }
    LDS_WAIT(); asm volatile("" ::: "memory");
}
struct ConvJob { const float* W; bf16* Wt; const float* kscale; int K, Nsrc, Ndst, mapid; };
DI void conv_job(Frame& F, const ConvJob j, int& base) {
    const int nblk = j.Ndst / 64, nitems = (j.K / 64) * nblk, NGW = F.G * NWAVES, gw = F.bid * NWAVES + F.wave;
    int first = (gw - base % NGW + NGW) % NGW; LAS bf16* tile = (LAS bf16*)(F.lds + F.wave * 16384);
    for (int it = first; it < nitems; it += NGW) conv_item(j.W, j.K, j.Nsrc, j.Wt, j.kscale, j.mapid, tile, it, nblk, F.lane);
    base += nitems;
}
DI void p_prologue(Frame& F, const Args& a) {
    unsigned char* ws = F.ws;
    const int gt = F.bid * NTHR + F.tid, NGT = F.G * NTHR;
    if (F.bid == 0 && F.tid == 0) { int* tab = (int*)(ws + WS_ATAB); int n = 0;
        for (int pass = 16; pass >= 4; pass -= 4)
            for (int qb = 31; qb >= 0; --qb) { const int nt = 4 * (qb + 1), nfull = nt >> 4, rem = nt & 15;
                for (int h = 0; h < 4; ++h) {
                    if (pass == 16) { for (int s2 = 0; s2 < nfull; ++s2) tab[n++] = h | (qb << 2) | (s2 << 7) | (16 << 12); }
                    else if (rem == pass) tab[n++] = h | (qb << 2) | (nfull << 7) | (rem << 12); } }
        for (; n < 2048; ++n) tab[n] = 0; }
    { float* prm = (float*)(ws + WS_PRM);
#define CPV(IDX, N, OFF, SRC_L) for (int e = gt; e < (N); e += NGT) prm[(size_t)l * PRM_STRIDE + (OFF) + e] = a.in[IDX][(size_t)(SRC_L) * (N) + e];
      for (int l = 0; l < DEPTH; ++l) {
          CPV(2, 2048, P_N1, l) CPV(33, 2048, P_N2, l) CPV(4, 512, P_GN, l) CPV(5, 4096, P_CW, l) CPV(6, 1024, P_CB, l) CPV(7, 8, P_DTB, l) CPV(8, 8, P_ALOG, l) CPV(9, 8, P_SD, l)
          CPV(10, 512, P_SNW, l) CPV(15, 192, P_QNW, l) CPV(16, 192, P_KNW, l) CPV(17, 1792, P_MU, l) CPV(18, 512, P_W0, l) CPV(20, 512, P_A0, l)
          CPV(23, 512, P_V0, (l > 0 ? l - 1 : 0)) CPV(26, 512, P_KK, l) CPV(27, 512, P_KA, l) CPV(28, 512, P_RK, l) CPV(29, 512, P_LNW, l) CPV(30, 512, P_LNB, l)
      }
#undef CPV
    }
    const int* pos = (const int*)a.in[1];
    for (int e = gt; e < S * 64; e += NGT) { const int t = e >> 6, i = e & 63;
        const float inv = 1.0f / powf(10000.0f, (float)(2 * i) / 128.0f); const float ang = (float)pos[t] * inv;
        double rev = (double)ang * 0.15915494309189535; rev -= rint(rev); const float r = (float)(rev * 6.283185307179586);
        ((float*)(ws + WS_COSR))[e] = __cosf(r); ((float*)(ws + WS_SINR))[e] = __sinf(r); }
    for (int e = gt; e < S * 32; e += NGT) { const int t = e >> 5, i = e & 31;
        const float inv = 1.0f / powf(10000.0f, (float)(2 * i) / 64.0f); const float ang = (float)pos[t] * inv;
        double rev = (double)ang * 0.15915494309189535; rev -= rint(rev); const float r = (float)(rev * 6.283185307179586);
        ((float*)(ws + WS_COSM))[e] = __cosf(r); ((float*)(ws + WS_SINM))[e] = __sinf(r); }
    for (int l = 0; l < DEPTH; ++l) {
        const float* w2 = a.in[19] + (size_t)l * 64 * 512; const float* a2 = a.in[21] + (size_t)l * 64 * 512; const float* g2 = a.in[22] + (size_t)l * 128 * 512;
        const float* v2 = a.in[25] + (size_t)(l > 0 ? l - 1 : 0) * 32 * 512;
        bf16* Lt = (bf16*)(ws + WS_WLORA) + (size_t)l * 2048 * 512;
        for (int w = gt; w < 2048 * 64; w += NGT) { const int kg = w >> 11, n = w & 2047, seg = n >> 9, j = n & 511; float v[8];
#pragma unroll
            for (int i = 0; i < 8; ++i) { const int k = kg * 8 + i; float x = 0.f;
                if (seg == 0) { if (k < 64) x = w2[k * 512 + j]; }
                else if (seg == 1) { if (k >= 128 && k < 192) x = a2[(k - 128) * 512 + j]; }
                else if (seg == 2) { if (k >= 256 && k < 384) x = g2[(k - 256) * 512 + j]; }
                else { if (l > 0 && k >= 384 && k < 416) x = v2[(k - 384) * 512 + j]; }
                v[i] = x; }
            u32x4 o; o.x = pk2(v[0], v[1]); o.y = pk2(v[2], v[3]); o.z = pk2(v[4], v[5]); o.w = pk2(v[6], v[7]);
            *(GAS u32x4*)(Lt + (size_t)n * 512 + kg * 8) = o; }
    }
    { const int gw = F.bid * NWAVES + F.wave, NGW = F.G * NWAVES; float* rss = (float*)(ws + WS_RSSA);
      for (int m = gw; m < S; m += NGW) { const GAS f32x4* xr = (const GAS f32x4*)(a.in[0] + (size_t)m * D) + F.lane; GAS u32x2* o8 = (GAS u32x2*)((bf16*)(ws + WS_XN) + (size_t)m * D) + F.lane; float sq = 0.f;
#pragma unroll
          for (int j = 0; j < 8; ++j) { const f32x4 v = xr[64 * j]; sq += (v.x * v.x + v.y * v.y) + (v.z * v.z + v.w * v.w); u32x2 o; o.x = pk2(v.x, v.y); o.y = pk2(v.z, v.w); o8[64 * j] = o; }
          sq = wave_sum(sq); if (F.lane < 32) rss[(size_t)m * 32 + F.lane] = (F.lane == 0) ? sq : 0.f; } }
    int base = 0;
    for (int l = 0; l < DEPTH; ++l) {
        conv_job(F, ConvJob{a.in[3] + (size_t)l * D * NIN, (bf16*)(ws + WS_WIN) + (size_t)l * NINP * D, a.in[2] + (size_t)l * D, D, NIN, NINP, 1}, base);
        conv_job(F, ConvJob{a.in[34] + (size_t)l * D * 2 * DFF, (bf16*)(ws + WS_WGU) + (size_t)l * 2 * DFF * D, a.in[33] + (size_t)l * D, D, 2 * DFF, 2 * DFF, 2}, base);
        conv_job(F, ConvJob{a.in[35] + (size_t)l * DFF * D, (bf16*)(ws + WS_WDN) + (size_t)l * D * DFF, nullptr, DFF, D, D, 0}, base);
        conv_job(F, ConvJob{a.in[32] + (size_t)l * D * D, (bf16*)(ws + WS_WOUT) + (size_t)l * D * D, nullptr, D, D, D, 0}, base);
        for (int n = 0; n < 4; ++n)
            conv_job(F, ConvJob{a.in[31] + ((size_t)l * 4 + n) * 512 * D, (bf16*)(ws + WS_WBR) + ((size_t)l * 4 + n) * D * 512, nullptr, 512, D, D, 0}, base);
        conv_job(F, ConvJob{a.in[12] + (size_t)l * 512 * 768, (bf16*)(ws + WS_WQB) + (size_t)l * 1024 * 512, a.in[11] + (size_t)l * 512, 512, 768, 1024, 3}, base);
        conv_job(F, ConvJob{a.in[14] + (size_t)l * 256 * 1024, (bf16*)(ws + WS_WKVB) + (size_t)l * 1024 * 256, a.in[13] + (size_t)l * 256, 256, 1024, 1024, 0}, base);
        if (l > 0) conv_job(F, ConvJob{a.in[24] + (size_t)(l - 1) * 512 * 32, (bf16*)(ws + WS_WV1) + (size_t)l * 256 * 512, nullptr, 512, 32, 256, 4}, base);
    }
}

DI void p_rmsnorm(Frame& F, const float* x, const float* w, bf16* out) {
    const int gw = F.bid * NWAVES + F.wave, NGW = F.G * NWAVES;
    for (int m = gw; m < S; m += NGW) {
        const GAS f32x4* xr = (const GAS f32x4*)(x + (size_t)m * D) + F.lane; f32x4 v[8]; float s = 0.f;
#pragma unroll
        for (int j = 0; j < 8; ++j) { v[j] = xr[64 * j]; s += (v[j].x * v[j].x + v[j].y * v[j].y) + (v[j].z * v[j].z + v[j].w * v[j].w); }
        const float rstd = rsqrtf(wave_sum(s) * (1.f / D) + 1e-6f);
        const GAS f32x4* wr = (const GAS f32x4*)w + F.lane;
        GAS u32x2* o8 = (GAS u32x2*)(out + (size_t)m * D) + F.lane;
#pragma unroll
        for (int j = 0; j < 8; ++j) { const f32x4 ww = wr[64 * j]; u32x2 o; o.x = pk2(v[j].x * rstd * ww.x, v[j].y * rstd * ww.y); o.y = pk2(v[j].z * rstd * ww.z, v[j].w * rstd * ww.w); o8[64 * j] = o; }
    }
}

DI f32x4 bf4_(const u32x2 w) { return (f32x4){bf2f(w.x & 0xffffu), bf2f(w.x >> 16), bf2f(w.y & 0xffffu), bf2f(w.y >> 16)}; }
DI u32x2 pk4_(const f32x4 v) { u32x2 o; o.x = pk2(v.x, v.y); o.y = pk2(v.z, v.w); return o; }
DI void p_rwkv_prep(Frame& F, int l) {
    unsigned char* ws = F.ws;
    const bf16* RW = (const bf16*)(ws + WS_RW); const float* prm = (const float*)(ws + WS_PRM) + (size_t)l * PRM_STRIDE; const float* mu = prm + P_MU; const float* kk_w = prm + P_KK;
    const int gw = F.bid * NWAVES + F.wave, NGW = F.G * NWAVES, lane = F.lane;
    for (int t = gw; t < S; t += NGW) {
        const GAS u32x2* p = (const GAS u32x2*)(RW + (size_t)t * 1792) + lane; const GAS u32x2* pp = (const GAS u32x2*)(RW + (size_t)(t > 0 ? t - 1 : 0) * 1792) + lane;
        const GAS f32x4* m4 = (const GAS f32x4*)mu + lane;
        f32x4 pm[7];
#pragma unroll
        for (int j = 0; j < 7; ++j) { const f32x4 c = bf4_(p[64 * j]); f32x4 pv = bf4_(pp[64 * j]); if (t == 0) pv = (f32x4){0.f, 0.f, 0.f, 0.f}; pm[j] = c + (pv - c) * m4[64 * j]; }
        const size_t ro = (size_t)t * 512;
        *((GAS u32x2*)((bf16*)(ws + WS_R32) + ro) + lane) = pk4_(pm[0]); *((GAS u32x2*)((bf16*)(ws + WS_R32) + ro) + 64 + lane) = pk4_(pm[1]);
#pragma unroll
        for (int j = 0; j < 2; ++j) { const f32x4 k = pm[2 + j]; const f32x4 kw = *((const GAS f32x4*)kk_w + 64 * j + lane); const f32x4 kk = k * kw;
            float ss = (kk.x * kk.x + kk.y * kk.y) + (kk.z * kk.z + kk.w * kk.w);
            ss = row_sum16(ss);
            const float inv = fminf(__builtin_amdgcn_rsqf(ss), 1e12f);
            *((GAS u32x2*)((bf16*)(ws + WS_K32) + ro) + 64 * j + lane) = pk4_(k);
            *((GAS u32x2*)((bf16*)(ws + WS_KKN) + ro) + 64 * j + lane) = pk4_(kk * inv); }
#pragma unroll
        for (int j = 0; j < 2; ++j) { const u32x2 vb = pk4_(pm[4 + j]);
            *((GAS u32x2*)((bf16*)(ws + WS_VV) + ro) + 64 * j + lane) = vb;
            if (l == 0) *((GAS u32x2*)((bf16*)(ws + WS_VFIRST) + ro) + 64 * j + lane) = vb; }
        { const f32x4 x = pm[6]; f32x4 y; int dst;
            if (lane < 16) { y = (f32x4){ftanh_(x.x), ftanh_(x.y), ftanh_(x.z), ftanh_(x.w)}; dst = 4 * lane; }
            else if (lane < 32) { y = x; dst = 128 + 4 * (lane - 16); }
            else { y = (f32x4){sigmoidf_(x.x), sigmoidf_(x.y), sigmoidf_(x.z), sigmoidf_(x.w)}; dst = 256 + 4 * (lane - 32); }
            bf16* ar = (bf16*)(ws + WS_ALORA) + (size_t)t * 512;
            *(GAS u32x2*)(ar + dst) = pk4_(y);
            const int z = 4 * lane; const int zd = z < 64 ? 64 + z : (z < 128 ? 192 + (z - 64) : 384 + (z - 128));
            unsigned zz = 0u; asm volatile("" : "+v"(zz));
            *(GAS u32x2*)(ar + zd) = (u32x2){zz, zz}; }
    }
}

DI void p_mamba_prep(Frame& F, int l) {
    unsigned char* ws = F.ws;
    const bf16* XBC = (const bf16*)(ws + WS_XBC); bf16* XC = (bf16*)(ws + WS_XC);
    const float* prm = (const float*)(ws + WS_PRM) + (size_t)l * PRM_STRIDE; const float* cw = prm + P_CW; const float* cb = prm + P_CB;
    for (int u = F.bid; u < 2 * NCH; u += F.G) {
        const int c = u >> 1, ch = (u & 1) * 512 + F.tid; const int t0 = c * 64;
        float w0[4];
#pragma unroll
        for (int k = 0; k < 4; ++k) w0[k] = cw[k * 1024 + ch];
        const float b0 = cb[ch];
        float h0[3];
#pragma unroll
        for (int k = 0; k < 3; ++k) { const int t = t0 - 3 + k; h0[k] = (t >= 0) ? bf2f(XBC[(size_t)t * 1024 + ch]) : 0.f; }
#pragma unroll 16
        for (int i = 0; i < 64; ++i) { const int t = t0 + i; const float x0 = bf2f(XBC[(size_t)t * 1024 + ch]);
            const float y0 = b0 + w0[0] * h0[0] + w0[1] * h0[1] + w0[2] * h0[2] + w0[3] * x0;
            h0[0] = h0[1]; h0[1] = h0[2]; h0[2] = x0;
            XC[(size_t)t * 1024 + ch] = (bf16)f2bf(siluf_(y0)); }
    }
}
DI void u_mamba_dt(Frame& F, int l, int c) {
    unsigned char* ws = F.ws; LAS float* A = (LAS float*)F.lds;
    const float* prm = (const float*)(ws + WS_PRM) + (size_t)l * PRM_STRIDE; const int t = F.tid >> 3, h = F.tid & 7; const size_t row = (size_t)(c * 64 + t);
    const float dt = softplusf_(((const float*)(ws + WS_MISC))[row * 256 + h] + prm[P_DTB + h]);
    A[F.tid] = dt * -fexp_(prm[P_ALOG + h]);
    ((float*)(ws + WS_DTS))[row * 8 + h] = dt;
    __syncthreads();
    float cs = 0.f;
#pragma unroll 16
    for (int tt = 0; tt < 64; ++tt) { const float v = A[tt * 8 + h]; cs += (tt <= t) ? v : 0.f; }
    ((float*)(ws + WS_ACS))[row * 8 + h] = cs;
    __syncthreads();
}

DI void p_scans(Frame& F, int nblk) {
    unsigned char* ws = F.ws;
    const int gt = F.bid * NTHR + F.tid, NGT = nblk * NTHR;
    for (int q = gt; q < 32768; q += NGT) {
        const int e = q * 4; const bool ret = e < 65536; const int e2 = ret ? e : e - 65536, h = ret ? (e >> 14) : (e2 >> 13);
        float* p = (float*)(ws + (ret ? WS_RKV : WS_MST)) + e2; const float* acs = (const float*)(ws + WS_ACS);
        const float rdec = fexp_(log1pf(-exp2f(-5.0f - (float)h)) * 64.0f);
        f32x4 st = (f32x4){0.f, 0.f, 0.f, 0.f};
#pragma unroll 1
        for (int c0 = 0; c0 < NCH; c0 += 16) { f32x4 v[16]; float dc[16];
#pragma unroll
            for (int i = 0; i < 16; ++i) v[i] = *(const GAS f32x4*)(p + (size_t)(c0 + i) * 65536);
#pragma unroll
            for (int i = 0; i < 16; ++i) dc[i] = ret ? rdec : fexp_(acs[(size_t)((c0 + i) * 64 + 63) * 8 + h]);
#pragma unroll
            for (int i = 0; i < 16; ++i) { *(GAS f32x4*)(p + (size_t)(c0 + i) * 65536) = st; st = st * dc[i] + v[i]; } }
    }
}


namespace pg8 {
DI unsigned char* lw(unsigned char* p) { unsigned long long w = (unsigned long long)p; asm volatile("" : "+s"(w)); return (unsigned char*)w; }
DI void st8bf(bf16* p, const f32x4 a, const f32x4 b) { *(GAS u32x4*)p = pack8(a, b); }
DI void st8f(float* p, const f32x4 a, const f32x4 b) { *(GAS f32x4*)p = a; *((GAS f32x4*)p + 1) = b; }
DI f32x4 map4(const f32x4 v, float (*f)(float)) { return (f32x4){f(v.x), f(v.y), f(v.z), f(v.w)}; }

DI void scale_rows(Acc& acc, const LAS float* rt, int rl0) {
#pragma unroll
    for (int ai = 0; ai < 2; ++ai)
#pragma unroll
        for (int m = 0; m < 4; ++m) { const float rs = rt[rl0 + ai * HALF + m * 16];
#pragma unroll
            for (int bj = 0; bj < 2; ++bj)
#pragma unroll
                for (int n = 0; n < 2; ++n) acc[ai][bj][m][n] = acc[ai][bj][m][n] * rs; }
}
template <class Sched> DI void fill_rstd(LAS float* rtab, const float* rss, const Sched& Sc, int tid) {
    pg8::Unit u;
    for (int i = 0; Sc.next(i, u); ++i) if (tid < 256) { const float* p = rss + (size_t)(u.pm * BM + tid) * 32; float s = 0.f;
#pragma unroll
        for (int q = 0; q < 8; ++q) { const f32x4 v = *(const GAS f32x4*)(p + 4 * q); s += (v.x + v.y) + (v.z + v.w); }
        rtab[i * 256 + tid] = rsqrtf(s * (1.f / D) + 1e-6f); }
    __syncthreads();
}
struct TileDesc { unsigned long long off; int ld, cb, kind, slot; };
constexpr TileDesc mk_tile(int T) {
    return T < 2 ? TileDesc{WS_QR, 512, 0, 0, 0} : T < 4 ? TileDesc{WS_KR, 512, 0, 1, 0}
         : T < 6 ? TileDesc{WS_VR, 512, (T - 4) * 256, 2, 0} : T < 8 ? TileDesc{WS_GR, 512, (T - 6) * 256, 3, 0} : T < 10 ? TileDesc{WS_ZS, 512, (T - 8) * 256, 3, 0}
         : T < 14 ? TileDesc{WS_XBC, 1024, (T - 10) * 256, 2, 0} : T < 16 ? TileDesc{WS_CQ, 512, (T - 14) * 256, 5, (T - 14) * 4} : T == 16 ? TileDesc{WS_CKV, 256, 0, 5, 8}
         : T < 24 ? TileDesc{WS_RW, 1792, (T - 17) * 256, 2, 0} : T < 56 ? TileDesc{WS_GATE, 8192, (T - 24) * 256, 4, 0} : TileDesc{WS_MISC, 256, 0, 6, 0};
}
struct TileTab { TileDesc d[57]; };
constexpr TileTab mk_tiletab() { TileTab t{}; for (int i = 0; i < 57; ++i) t.d[i] = mk_tile(i); return t; }
__constant__ TileTab g_tiletab = mk_tiletab();

struct EpiIn {
    static constexpr bool AFTER_DRAIN = false;
    unsigned char* ws_; int tile_off; const LAS float* rtab;
    DI bool operator()(Acc& acc, const Unit& u, int wr, int wc, int fr, int fq) const {
        unsigned char* ws = lw(ws_);
        const int T = u.pn + tile_off, row0 = u.pm * BM + wr * 64 + fr, c0 = wc * 32 + fq * 8;
        scale_rows(acc, rtab + u.ord * 256, wr * 64 + fr);
        const TileDesc d = g_tiletab.d[T]; const int kind = d.kind;
        if (kind < 2) {
            const int head = 2 * (T & 1) + (c0 >> 6), j0 = c0 & 63; const float sc = kind ? 0.08838834764831845f : 1.0f;
            bf16* dst = (bf16*)(ws + d.off); const float* cs = (const float*)(ws + WS_COSR); const float* sn = (const float*)(ws + WS_SINR);
#pragma unroll
            for (int ai = 0; ai < 2; ++ai)
#pragma unroll
                for (int m = 0; m < 4; ++m) { const int row = row0 + ai * HALF + m * 16;
                    const f32x4 ca = *(const GAS f32x4*)(cs + (size_t)row * 64 + j0), cb = *(const GAS f32x4*)(cs + (size_t)row * 64 + j0 + 4);
                    const f32x4 sa = *(const GAS f32x4*)(sn + (size_t)row * 64 + j0), sb = *(const GAS f32x4*)(sn + (size_t)row * 64 + j0 + 4);
                    const f32x4 x1a = acc[ai][0][m][0], x1b = acc[ai][0][m][1], x2a = acc[ai][1][m][0], x2b = acc[ai][1][m][1];
                    bf16* o = dst + (size_t)row * 512 + head * 128 + j0;
                    st8bf(o, (x1a * ca - x2a * sa) * sc, (x1b * cb - x2b * sb) * sc);
                    st8bf(o + 64, (x2a * ca + x1a * sa) * sc, (x2b * cb + x1b * sb) * sc); }
            return true;
        }
        if (kind == 6) {
            float* dst = (float*)(ws + d.off) + d.cb + c0;
#pragma unroll
            for (int ai = 0; ai < 2; ++ai)
#pragma unroll
                for (int m = 0; m < 4; ++m) { const int row = row0 + ai * HALF + m * 16;
#pragma unroll
                    for (int bj = 0; bj < 2; ++bj) st8f(dst + (size_t)row * d.ld + bj * HALF, acc[ai][bj][m][0], acc[ai][bj][m][1]); }
            return true;
        }
        {
            bf16* dst = (bf16*)(ws + d.off) + d.cb + c0; float* ssq = (float*)(ws + WS_SSQ) + d.slot + wc;
            const float am = (kind == 3 || kind == 4) ? 1.f : 0.f, xm = (kind == 4) ? 0.f : 1.f;
#pragma unroll
            for (int ai = 0; ai < 2; ++ai)
#pragma unroll
                for (int m = 0; m < 4; ++m) { const int row = row0 + ai * HALF + m * 16; float ss = 0.f;
#pragma unroll
                    for (int bj = 0; bj < 2; ++bj) { f32x4 a = acc[ai][bj][m][0], b = acc[ai][bj][m][1];
                        ss += (a.x * a.x + a.y * a.y) + (a.z * a.z + a.w * a.w) + (b.x * b.x + b.y * b.y) + (b.z * b.z + b.w * b.w);
                        if (am != 0.f) {
#pragma unroll
                            for (int i = 0; i < 4; ++i) { const float s0 = sigmoidf_(a[i]), s1 = sigmoidf_(b[i]); a[i] = (xm != 0.f) ? a[i] * s0 : s0; b[i] = (xm != 0.f) ? b[i] * s1 : s1; } }
                        st8bf(dst + (size_t)row * d.ld + bj * HALF, a, b); }
                    if (kind == 5) { ss = xr32_sum(xr16_sum(ss)); if (fq == 0) ssq[(size_t)row * 16] = ss; } }
        }
        return true;
    }
};

struct EpiMisc {
    static constexpr bool AFTER_DRAIN = false;
    unsigned char* ws_; const LAS float* rtab;
    DI bool operator()(Acc& acc, const Unit& u, int wr, int wc, int fr, int fq) const {
        float* dst = (float*)(lw(ws_) + WS_MISC) + wc * 32 + fq * 8; const int row0 = u.pm * BM + wr * 64 + fr;
        scale_rows(acc, rtab + u.ord * 256, wr * 64 + fr);
#pragma unroll
        for (int ai = 0; ai < 2; ++ai)
#pragma unroll
            for (int m = 0; m < 4; ++m) { const int row = row0 + ai * HALF + m * 16;
#pragma unroll
                for (int bj = 0; bj < 2; ++bj) st8f(dst + (size_t)row * 256 + bj * HALF, acc[ai][bj][m][0], acc[ai][bj][m][1]); }
        return true;
    }
};

struct EpiQb {
    static constexpr bool AFTER_DRAIN = true;
    unsigned char* ws; const float* qnw;
    DI bool operator()(Acc&, const Unit&, int, int, int, int) const { return true; }
    DI void fused(Acc& acc, const Unit& u, int wr, int wc, int fr, int fq, LAS unsigned char* lds, int wid, int lane, int tid) const {
        const int h = u.pn, row0 = u.pm * BM + wr * 64 + fr, c0 = wc * 32 + fq * 8;
        const float* ssq = (const float*)(ws + WS_SSQ); LAS float* P = (LAS float*)lds;
        const float QS = 0.07216878364870322f * LOG2E;
#pragma unroll
        for (int ai = 0; ai < 2; ++ai)
#pragma unroll
            for (int m = 0; m < 4; ++m) { const int row = row0 + ai * HALF + m * 16, rl = ai * HALF + wr * 64 + m * 16 + fr;
                const f32x4 s0 = *(const GAS f32x4*)(ssq + (size_t)row * 16), s1 = *(const GAS f32x4*)(ssq + (size_t)row * 16 + 4);
                const float rs = rsqrtf(((s0.x + s0.y) + (s0.z + s0.w) + (s1.x + s1.y) + (s1.z + s1.w)) * (1.f / 512.f) + 1e-6f);
                float ss = 0.f;
#pragma unroll
                for (int bj = 0; bj < 2; ++bj)
#pragma unroll
                    for (int n = 0; n < 2; ++n) { f32x4 a = acc[ai][bj][m][n] * rs; acc[ai][bj][m][n] = a; ss += (a.x * a.x + a.y * a.y) + (a.z * a.z + a.w * a.w); }
                ss = xr32_sum(xr16_sum(ss));
                if (fq == 0) P[rl * 4 + wc] = ss; }
        __syncthreads();
        bf16* QM = (bf16*)(ws + WS_QM); const float* cs = (const float*)(ws + WS_COSM); const float* sn = (const float*)(ws + WS_SINM);
#pragma unroll
        for (int ai = 0; ai < 2; ++ai)
#pragma unroll
            for (int m = 0; m < 4; ++m) { const int row = row0 + ai * HALF + m * 16, rl = ai * HALF + wr * 64 + m * 16 + fr;
                const f32x4 pp = *(const LAS f32x4*)(P + rl * 4); const float rq = rsqrtf(((pp.x + pp.y) + (pp.z + pp.w)) * (1.f / 192.f) + 1e-6f) * QS;
                bf16* o = QM + (size_t)row * 768 + h * 192;
                if (wc < 3) {
                    const f32x4 wa = *(const GAS f32x4*)(qnw + c0), wb = *(const GAS f32x4*)(qnw + c0 + 4);
                    st8bf(o + c0, acc[ai][0][m][0] * rq * wa, acc[ai][0][m][1] * rq * wb);
                    if (wc == 0) { const f32x4 wc4 = *(const GAS f32x4*)(qnw + 96 + c0), wd = *(const GAS f32x4*)(qnw + 100 + c0);
                        st8bf(o + 96 + c0, acc[ai][1][m][0] * rq * wc4, acc[ai][1][m][1] * rq * wd); }
                } else {
                    const int i0 = 8 * fq;
                    const f32x4 w1a = *(const GAS f32x4*)(qnw + 128 + i0), w1b = *(const GAS f32x4*)(qnw + 132 + i0), w2a = *(const GAS f32x4*)(qnw + 160 + i0), w2b = *(const GAS f32x4*)(qnw + 164 + i0);
                    const f32x4 ca = *(const GAS f32x4*)(cs + (size_t)row * 32 + i0), cb = *(const GAS f32x4*)(cs + (size_t)row * 32 + i0 + 4), sa = *(const GAS f32x4*)(sn + (size_t)row * 32 + i0), sb = *(const GAS f32x4*)(sn + (size_t)row * 32 + i0 + 4);
                    const f32x4 x1a = acc[ai][0][m][0] * rq * w1a, x1b = acc[ai][0][m][1] * rq * w1b, x2a = acc[ai][1][m][0] * rq * w2a, x2b = acc[ai][1][m][1] * rq * w2b;
                    st8bf(o + 128 + i0, x1a * ca - x2a * sa, x1b * cb - x2b * sb);
                    st8bf(o + 160 + i0, x2a * ca + x1a * sa, x2b * cb + x1b * sb);
                } }
        __syncthreads();
    }
};

struct EpiKvb {
    static constexpr bool AFTER_DRAIN = true;
    unsigned char* ws; const float* knw;
    DI bool operator()(Acc&, const Unit&, int, int, int, int) const { return true; }
    DI void fused(Acc& acc, const Unit& u, int wr, int wc, int fr, int fq, LAS unsigned char* lds, int wid, int lane, int tid) const {
        const int h = u.pn, row0 = u.pm * BM + wr * 64 + fr, c0 = wc * 32 + fq * 8;
        const float* ssq = (const float*)(ws + WS_SSQ); const float* misc = (const float*)(ws + WS_MISC);
        LAS float* P = (LAS float*)lds; LAS float* KRS = P + 1024; LAS float* RK = P + 1280;
        if (tid < 256) { const float* kr = misc + (size_t)(u.pm * BM + tid) * 256 + 8; float s = 0.f;
#pragma unroll
            for (int i = 0; i < 16; ++i) { const f32x4 v = *(const GAS f32x4*)(kr + 4 * i); s += (v.x * v.x + v.y * v.y) + (v.z * v.z + v.w * v.w); }
            KRS[tid] = s; }
#pragma unroll
        for (int ai = 0; ai < 2; ++ai)
#pragma unroll
            for (int m = 0; m < 4; ++m) { const int row = row0 + ai * HALF + m * 16, rl = ai * HALF + wr * 64 + m * 16 + fr;
                const f32x4 s0 = *(const GAS f32x4*)(ssq + (size_t)row * 16 + 8);
                const float rs = rsqrtf(((s0.x + s0.y) + (s0.z + s0.w)) * (1.f / 256.f) + 1e-6f);
                float ss = 0.f;
#pragma unroll
                for (int bj = 0; bj < 2; ++bj)
#pragma unroll
                    for (int n = 0; n < 2; ++n) { f32x4 a = acc[ai][bj][m][n] * rs; acc[ai][bj][m][n] = a; if (bj == 0) ss += (a.x * a.x + a.y * a.y) + (a.z * a.z + a.w * a.w); }
                ss = xr32_sum(xr16_sum(ss));
                if (fq == 0) P[rl * 4 + wc] = ss; }
        __syncthreads();
        if (tid < 256) { const f32x4 pp = *(const LAS f32x4*)(P + tid * 4); RK[tid] = rsqrtf(((pp.x + pp.y) + (pp.z + pp.w) + KRS[tid]) * (1.f / 192.f) + 1e-6f); }
        __syncthreads();
        bf16* KM = (bf16*)(ws + WS_KM); bf16* VT = (bf16*)(ws + WS_VT);
        const f32x4 wa = *(const GAS f32x4*)(knw + c0), wb = *(const GAS f32x4*)(knw + c0 + 4);
#pragma unroll
        for (int ai = 0; ai < 2; ++ai)
#pragma unroll
            for (int m = 0; m < 4; ++m) { const int row = row0 + ai * HALF + m * 16, rl = ai * HALF + wr * 64 + m * 16 + fr;
                const float rk = RK[rl];
                st8bf(KM + (size_t)row * 768 + h * 192 + c0, acc[ai][0][m][0] * rk * wa, acc[ai][0][m][1] * rk * wb);
#pragma unroll
                for (int n = 0; n < 2; ++n)
#pragma unroll
                    for (int i = 0; i < 4; ++i) VT[(size_t)(h * 128 + c0 + n * 4 + i) * S + row] = (bf16)f2bf(acc[ai][1][m][n][i]); }
        {
            const int rl = tid >> 1, hf = tid & 1, row = u.pm * BM + rl, i0 = 16 * hf; const float rk = RK[rl];
            const float* kr = misc + (size_t)row * 256 + 8; const float* cs = (const float*)(ws + WS_COSM) + (size_t)row * 32; const float* sn = (const float*)(ws + WS_SINM) + (size_t)row * 32;
            bf16* o = KM + (size_t)row * 768 + h * 192 + 128;
#pragma unroll
            for (int q = 0; q < 2; ++q) { f32x4 o1[2], o2[2];
#pragma unroll
                for (int e = 0; e < 2; ++e) { const int i = i0 + 8 * q + 4 * e;
                    const f32x4 x1 = *(const GAS f32x4*)(kr + i) * *(const GAS f32x4*)(knw + 128 + i), x2 = *(const GAS f32x4*)(kr + 32 + i) * *(const GAS f32x4*)(knw + 160 + i);
                    const f32x4 c = *(const GAS f32x4*)(cs + i), s = *(const GAS f32x4*)(sn + i);
                    o1[e] = (x1 * c - x2 * s) * rk; o2[e] = (x2 * c + x1 * s) * rk; }
                st8bf(o + i0 + 8 * q, o1[0], o1[1]); st8bf(o + 32 + i0 + 8 * q, o2[0], o2[1]); }
        }
        __syncthreads();
    }
};

struct EpiV1 {
    static constexpr bool AFTER_DRAIN = false;
    unsigned char* ws_;
    DI bool operator()(Acc& acc, const Unit& u, int wr, int wc, int fr, int fq) const {
        if (wc != 0) return true;
        unsigned char* ws = lw(ws_);
        const int row0 = u.pm * BM + wr * 64 + fr; bf16* dst = (bf16*)(ws + WS_ALORA);
#pragma unroll
        for (int ai = 0; ai < 2; ++ai)
#pragma unroll
            for (int m = 0; m < 4; ++m) { const int row = row0 + ai * HALF + m * 16; st8bf(dst + (size_t)row * 512 + 384 + fq * 8, acc[ai][0][m][0], acc[ai][0][m][1]); }
        return true;
    }
};

struct EpiLora {
    static constexpr bool AFTER_DRAIN = false;
    unsigned char* ws_; const float* w0; const float* a0; const float* v0; const float* ka;
#define LORA_LOOP(BODY) _Pragma("unroll") for (int ai = 0; ai < 2; ++ai) _Pragma("unroll") for (int m = 0; m < 4; ++m) { const size_t ro = (size_t)(row0 + ai * HALF + m * 16) * 512; \
        _Pragma("unroll") for (int bj = 0; bj < 2; ++bj) _Pragma("unroll") for (int n = 0; n < 2; ++n) { const int j = jb + bj * HALF + n * 4; const size_t o = ro + j; const f32x4 x = acc[ai][bj][m][n]; BODY } }
    DI bool operator()(Acc& acc, const Unit& u, int wr, int wc, int fr, int fq) const {
        unsigned char* ws = lw(ws_);
        const int seg = u.pn >> 1, row0 = u.pm * BM + wr * 64 + fr, jb = (u.pn & 1) * 256 + wc * 32 + fq * 8;
        if (seg == 0) { float* dec = (float*)(ws + WS_DEC);
            LORA_LOOP({ const f32x4 b = *(const GAS f32x4*)(w0 + j); f32x4 r;
                _Pragma("unroll") for (int i = 0; i < 4; ++i) { const float u_ = b[i] + x[i]; const float sp = fmaxf(-u_, 0.f) + __logf(1.0f + fexp_(-fabsf(u_))); r[i] = -fexp_(-sp - 0.5f); }
                *(GAS f32x4*)(dec + o) = r; })
        } else if (seg == 1) { const bf16* k32 = (const bf16*)(ws + WS_K32); const bf16* kkn_ = (const bf16*)(ws + WS_KKN); bf16* kp_ = (bf16*)(ws + WS_KP); bf16* bb_ = (bf16*)(ws + WS_BB);
            LORA_LOOP({ const f32x4 b = *(const GAS f32x4*)(a0 + j); const f32x4 kav = *(const GAS f32x4*)(ka + j);
                const u32x2 kw = *(const GAS u32x2*)(k32 + o); const u32x2 nw = *(const GAS u32x2*)(kkn_ + o);
                const f32x4 k = bf4_(kw); const f32x4 kkn = bf4_(nw); f32x4 kp; f32x4 bb;
                _Pragma("unroll") for (int i = 0; i < 4; ++i) { const float av = sigmoidf_(b[i] + x[i]); kp[i] = k[i] * (1.0f + (av - 1.0f) * kav[i]); bb[i] = kkn[i] * av; }
                *(GAS u32x2*)(kp_ + o) = pk4_(kp); *(GAS u32x2*)(bb_ + o) = pk4_(bb); })
        } else if (seg == 2) { bf16* g32 = (bf16*)(ws + WS_G32);
            LORA_LOOP({ *(GAS u32x2*)(g32 + o) = pk4_(x); })
        } else { bf16* vv = (bf16*)(ws + WS_VV); const bf16* vf_ = (const bf16*)(ws + WS_VFIRST);
            LORA_LOOP({ const f32x4 b = *(const GAS f32x4*)(v0 + j); const u32x2 vw = *(const GAS u32x2*)(vv + o); const u32x2 fw = *(const GAS u32x2*)(vf_ + o);
                const f32x4 v = bf4_(vw); const f32x4 vf = bf4_(fw); f32x4 r;
                _Pragma("unroll") for (int i = 0; i < 4; ++i) r[i] = v[i] + (vf[i] - v[i]) * sigmoidf_(b[i] + x[i]);
                *(GAS u32x2*)(vv + o) = pk4_(r); })
        }
        return true;
    }
#undef LORA_LOOP
};

struct EpiBranch {
    static constexpr bool AFTER_DRAIN = false;
    unsigned char* ws_;
    DI bool operator()(Acc& acc, const Unit& u, int wr, int wc, int fr, int fq) const {
        unsigned char* ws = lw(ws_);
        const int nb = u.sub, row0 = u.pm * BM + wr * 64 + fr, cb = u.pn * BM + wc * 32 + fq * 8;
        const bf16* G = (const bf16*)(ws + WS_GATE); bf16* M = (bf16*)(ws + WS_MERGED);
#pragma unroll
        for (int ai = 0; ai < 2; ++ai)
#pragma unroll
            for (int m = 0; m < 4; ++m) { const int row = row0 + ai * HALF + m * 16;
#pragma unroll
                for (int bj = 0; bj < 2; ++bj) { const int col = cb + bj * HALF;
                    float g[8]; unpack8(*(const GAS u32x4*)(G + (size_t)row * 8192 + nb * D + col), g);
                    if (nb < 3) { float gn[8]; unpack8(*(const GAS u32x4*)(G + (size_t)row * 8192 + (nb + 1) * D + col), gn);
#pragma unroll
                        for (int i = 0; i < 8; ++i) g[i] = fmaxf(g[i], 1e-30f) * __builtin_amdgcn_rcpf(fmaxf(gn[i], 1e-30f)); }
                    else {
#pragma unroll
                        for (int i = 0; i < 8; ++i) g[i] = fmaxf(g[i], 1e-30f); }
                    f32x4 a = acc[ai][bj][m][0], b = acc[ai][bj][m][1];
                    a = a * (f32x4){g[0], g[1], g[2], g[3]}; b = b * (f32x4){g[4], g[5], g[6], g[7]};
                    if (nb < 3) { acc[ai][bj][m][0] = a; acc[ai][bj][m][1] = b; } else st8bf(M + (size_t)row * D + col, a, b); } }
        return nb == 3;
    }
};

struct EpiRes {
    static constexpr bool AFTER_DRAIN = false;
    const float* xin; float* out; bf16* xb; float* rss;
    DI bool operator()(Acc& acc, const Unit& u, int wr, int wc, int fr, int fq) const {
        const int row0 = u.pm * BM + wr * 64 + fr, cb = u.pn * BM + wc * 32 + fq * 8;
#pragma unroll
        for (int ai = 0; ai < 2; ++ai)
#pragma unroll
            for (int m = 0; m < 4; ++m) { const int row = row0 + ai * HALF + m * 16; float ss = 0.f;
#pragma unroll
                for (int bj = 0; bj < 2; ++bj) { const size_t o = (size_t)row * D + cb + bj * HALF;
                    const f32x4 a = *(const GAS f32x4*)(xin + o) + acc[ai][bj][m][0], b = *(const GAS f32x4*)(xin + o + 4) + acc[ai][bj][m][1];
                    st8f(out + o, a, b); st8bf(xb + o, a, b);
                    ss += (a.x * a.x + a.y * a.y) + (a.z * a.z + a.w * a.w) + (b.x * b.x + b.y * b.y) + (b.z * b.z + b.w * b.w); }
                if (rss) { ss = xr32_sum(xr16_sum(ss)); if (fq == 0) rss[(size_t)row * 32 + u.pn * 4 + wc] = ss; } }
        return true;
    }
};

struct EpiGu {
    static constexpr bool AFTER_DRAIN = false;
    unsigned char* ws_; const LAS float* rtab;
    DI bool operator()(Acc& acc, const Unit& u, int wr, int wc, int fr, int fq) const {
        unsigned char* ws = lw(ws_);
        scale_rows(acc, rtab + u.ord * 256, wr * 64 + fr);
        const int row0 = u.pm * BM + wr * 64 + fr, cb = u.pn * 128 + wc * 32 + fq * 8; bf16* A = (bf16*)(ws + WS_ACT);
#pragma unroll
        for (int ai = 0; ai < 2; ++ai)
#pragma unroll
            for (int m = 0; m < 4; ++m) { const int row = row0 + ai * HALF + m * 16;
                st8bf(A + (size_t)row * DFF + cb, map4(acc[ai][0][m][0], siluf_) * acc[ai][1][m][0], map4(acc[ai][0][m][1], siluf_) * acc[ai][1][m][1]); }
        return true;
    }
};
}

DI bf16x8 ldfrag(const LAS bf16* M, int ld, int r0, int k0, int lane) { return *(const LAS bf16x8*)(M + (r0 + (lane & 15)) * ld + k0 + 8 * (lane >> 4)); }
#define MFMA16(a, b, c) __builtin_amdgcn_mfma_f32_16x16x32_bf16((a), (b), (c), 0, 0, 0)
DI void stage_nat(LAS bf16* dst, int lp, const bf16* src, size_t gp, int rows, int cols8, int tid) {
    for (int p = tid; p < rows * cols8; p += NTHR) { const int r = p / cols8, c = p - r * cols8; *(LAS u32x4*)(dst + r * lp + c * 8) = *(const GAS u32x4*)(src + (size_t)r * gp + c * 8); }
}
DI void stage_tr(LAS bf16* dst, int lp, const bf16* src, size_t gp, int rows, int cols8, int tid) {
    for (int p = tid; p < rows * cols8; p += NTHR) { const int r = p / cols8, c = p - r * cols8; const u32x4 w = *(const GAS u32x4*)(src + (size_t)r * gp + c * 8);
        LAS bf16* d = dst + (c * 8) * lp + r;
        d[0] = (bf16)(w.x & 0xffffu); d[lp] = (bf16)(w.x >> 16); d[2 * lp] = (bf16)(w.y & 0xffffu); d[3 * lp] = (bf16)(w.y >> 16);
        d[4 * lp] = (bf16)(w.z & 0xffffu); d[5 * lp] = (bf16)(w.z >> 16); d[6 * lp] = (bf16)(w.w & 0xffffu); d[7 * lp] = (bf16)(w.w >> 16); }
}
DI float ret_loggamma(int h) { return log1pf(-exp2f(-5.0f - (float)h)); }

DI void u_ret_kv(Frame& F, int c, int h) {
    int tid_ = F.tid; asm volatile("" : "+v"(tid_));
    unsigned char* ws = F.ws; const int tid = tid_, lane = tid_ & 63, w = F.wave;
    LAS bf16* Kt = (LAS bf16*)F.lds; LAS bf16* Vt = Kt + 128 * 72;
    const bf16* KR = (const bf16*)(ws + WS_KR) + (size_t)(c * 64) * 512 + h * 128; const bf16* VR = (const bf16*)(ws + WS_VR) + (size_t)(c * 64) * 512 + h * 128;
    const float lg = ret_loggamma(h);
    for (int p = tid; p < 1024; p += NTHR) { const int m = p >> 4, d0 = (p & 15) * 8; float k[8]; unpack8(*(const GAS u32x4*)(KR + (size_t)m * 512 + d0), k); const float sc = fexp_(lg * (float)(63 - m));
        LAS bf16* d = Kt + d0 * 72 + m;
#pragma unroll
        for (int i = 0; i < 8; ++i) d[i * 72] = (bf16)f2bf(k[i] * sc); }
    stage_tr(Vt, 72, VR, 512, 64, 16, tid);
    __syncthreads();
    f32x4 acc[8];
#pragma unroll
    for (int bn = 0; bn < 8; ++bn) acc[bn] = (f32x4){0.f, 0.f, 0.f, 0.f};
#pragma unroll
    for (int ks = 0; ks < 2; ++ks) { const bf16x8 a = ldfrag(Kt, 72, 16 * w, 32 * ks, lane);
#pragma unroll
        for (int bn = 0; bn < 8; ++bn) acc[bn] = MFMA16(a, ldfrag(Vt, 72, 16 * bn, 32 * ks, lane), acc[bn]); }
    float* out = (float*)(ws + WS_RKV) + ((size_t)(c * 4 + h) * 128) * 128;
#pragma unroll
    for (int bn = 0; bn < 8; ++bn)
#pragma unroll
        for (int r = 0; r < 4; ++r) out[(size_t)(16 * w + 4 * (lane >> 4) + r) * 128 + 16 * bn + (lane & 15)] = acc[bn][r];
    __syncthreads();
}

DI void u_ret_out(Frame& F, int l_, int c, int h) {
    int tid_ = F.tid; asm volatile("" : "+v"(tid_));
    unsigned char* ws = F.ws; const int tid = tid_, lane = tid_ & 63, w = F.wave;
    LAS bf16* Qs = (LAS bf16*)F.lds; LAS bf16* Ks = Qs + 64 * 136; LAS bf16* Vt = Ks + 64 * 136; LAS bf16* St = Vt + 128 * 72; LAS bf16* Ps = St + 128 * 136; LAS float* Os = (LAS float*)(Ps + 64 * 72);
    const size_t rowb = (size_t)(c * 64) * 512 + h * 128;
    stage_nat(Qs, 136, (const bf16*)(ws + WS_QR) + rowb, 512, 64, 16, tid);
    stage_nat(Ks, 136, (const bf16*)(ws + WS_KR) + rowb, 512, 64, 16, tid);
    stage_tr(Vt, 72, (const bf16*)(ws + WS_VR) + rowb, 512, 64, 16, tid);
    { const float* sp = (const float*)(ws + WS_RKV) + ((size_t)(c * 4 + h) * 128) * 128;
      for (int p = tid; p < 4096; p += NTHR) { const int d = p >> 5, e0 = (p & 31) * 4; const f32x4 v = *(const GAS f32x4*)(sp + (size_t)d * 128 + e0);
          LAS bf16* q = St + e0 * 136 + d; q[0] = (bf16)f2bf(v.x); q[136] = (bf16)f2bf(v.y); q[272] = (bf16)f2bf(v.z); q[408] = (bf16)f2bf(v.w); } }
    __syncthreads();
    const float lg = ret_loggamma(h); const int g4 = lane >> 4, lc = lane & 15;
    {
        const int bm = w >> 1;
#pragma unroll
        for (int q = 0; q < 2; ++q) { const int bn = (w & 1) * 2 + q; f32x4 acc = (f32x4){0.f, 0.f, 0.f, 0.f};
#pragma unroll
            for (int ks = 0; ks < 4; ++ks) acc = MFMA16(ldfrag(Qs, 136, 16 * bm, 32 * ks, lane), ldfrag(Ks, 136, 16 * bn, 32 * ks, lane), acc);
#pragma unroll
            for (int r = 0; r < 4; ++r) { const int l = 16 * bm + 4 * g4 + r, m = 16 * bn + lc; const int dd = l > m ? l - m : m - l; Ps[l * 72 + m] = (bf16)f2bf(acc[r] * fexp_(lg * (float)dd)); } }
    }
    __syncthreads();
    {
        const int bm = w >> 1;
#pragma unroll
        for (int q = 0; q < 4; ++q) { const int bn = (w & 1) * 4 + q; f32x4 a1 = (f32x4){0.f, 0.f, 0.f, 0.f}, a2 = (f32x4){0.f, 0.f, 0.f, 0.f};
#pragma unroll
            for (int ks = 0; ks < 2; ++ks) a1 = MFMA16(ldfrag(Ps, 72, 16 * bm, 32 * ks, lane), ldfrag(Vt, 72, 16 * bn, 32 * ks, lane), a1);
#pragma unroll
            for (int ks = 0; ks < 4; ++ks) a2 = MFMA16(ldfrag(Qs, 136, 16 * bm, 32 * ks, lane), ldfrag(St, 136, 16 * bn, 32 * ks, lane), a2);
#pragma unroll
            for (int r = 0; r < 4; ++r) { const int l = 16 * bm + 4 * g4 + r; Os[l * 132 + 16 * bn + lc] = a1[r] + fexp_(lg * (float)(l + 1)) * a2[r]; } }
    }
    __syncthreads();
    { const float* gw = (const float*)(ws + WS_PRM) + (size_t)l_ * PRM_STRIDE + P_GN + h * 128; const bf16* GR = (const bf16*)(ws + WS_GR); bf16* OB = (bf16*)(ws + WS_OB);
#pragma unroll
      for (int rr = 0; rr < 8; ++rr) { const int l = 8 * w + rr; const float x0 = Os[l * 132 + lane], x1 = Os[l * 132 + 64 + lane];
          const float mean = wave_sum(x0 + x1) * (1.f / 128.f); const float d0 = x0 - mean, d1 = x1 - mean; const float rstd = rsqrtf(wave_sum(d0 * d0 + d1 * d1) * (1.f / 128.f) + 1e-5f);
          const size_t row = (size_t)(c * 64 + l);
          const float g0 = bf2f(GR[row * 512 + h * 128 + lane]), g1 = bf2f(GR[row * 512 + h * 128 + 64 + lane]);
          OB[row * D + h * 128 + lane] = (bf16)f2bf(d0 * rstd * gw[lane] * g0); OB[row * D + h * 128 + 64 + lane] = (bf16)f2bf(d1 * rstd * gw[64 + lane] * g1); } }
    __syncthreads();
}

DI void u_mamba_st(Frame& F, int c, int g) {
    int tid_ = F.tid; asm volatile("" : "+v"(tid_));
    unsigned char* ws = F.ws; const int tid = tid_, lane = tid_ & 63, w = F.wave;
    LAS bf16* Xt = (LAS bf16*)F.lds; LAS bf16* Bt = Xt + 256 * 72;
    const bf16* XC = (const bf16*)(ws + WS_XC) + (size_t)(c * 64) * 1024; const float* dts = (const float*)(ws + WS_DTS) + (size_t)(c * 64) * 8; const float* acs = (const float*)(ws + WS_ACS) + (size_t)(c * 64) * 8;
    for (int p = tid; p < 2048; p += NTHR) { const int l = p >> 5, c0 = (p & 31) * 8, h = g * 4 + (c0 >> 6); float x[8]; unpack8(*(const GAS u32x4*)(XC + (size_t)l * 1024 + g * 256 + c0), x);
        const float sc = dts[l * 8 + h] * fexp_(acs[63 * 8 + h] - acs[l * 8 + h]); LAS bf16* d = Xt + c0 * 72 + l;
#pragma unroll
        for (int i = 0; i < 8; ++i) d[i * 72] = (bf16)f2bf(x[i] * sc); }
    stage_tr(Bt, 72, XC + 512 + g * 128, 1024, 64, 16, tid);
    __syncthreads();
    f32x4 acc[2][8];
#pragma unroll
    for (int i = 0; i < 2; ++i)
#pragma unroll
        for (int bn = 0; bn < 8; ++bn) acc[i][bn] = (f32x4){0.f, 0.f, 0.f, 0.f};
#pragma unroll
    for (int ks = 0; ks < 2; ++ks) { const bf16x8 a0 = ldfrag(Xt, 72, 32 * w, 32 * ks, lane), a1 = ldfrag(Xt, 72, 32 * w + 16, 32 * ks, lane);
#pragma unroll
        for (int bn = 0; bn < 8; ++bn) { const bf16x8 b = ldfrag(Bt, 72, 16 * bn, 32 * ks, lane); acc[0][bn] = MFMA16(a0, b, acc[0][bn]); acc[1][bn] = MFMA16(a1, b, acc[1][bn]); } }
    float* out = (float*)(ws + WS_MST) + ((size_t)(c * 8 + g * 4) * 64) * 128;
#pragma unroll
    for (int i = 0; i < 2; ++i)
#pragma unroll
        for (int bn = 0; bn < 8; ++bn)
#pragma unroll
            for (int r = 0; r < 4; ++r) out[(size_t)(32 * w + 16 * i + 4 * (lane >> 4) + r) * 128 + 16 * bn + (lane & 15)] = acc[i][bn][r];
    __syncthreads();
}

struct MambaLds { LAS bf16* Cs; LAS bf16* Bs; LAS float* CB; LAS bf16* Ph; LAS bf16* Xt; LAS bf16* Sh; LAS float* AC; LAS float* DT; LAS float* SSQ; };
DI void mamba_head(Frame& F, const MambaLds& L, const bf16* XC, const float* sp, int g, int hh, float dsk, const bf16* const (&zrow)[4], f32x4 (&y)[2]) {
    const int tid = F.tid, lane = F.lane, w = F.wave, g4 = lane >> 4, lc = lane & 15, bm = w >> 1;
    __syncthreads();
    { const int l = tid >> 3, m0 = (tid & 7) * 8; const float al = L.AC[l * 4 + hh]; float pv[8];
#pragma unroll
      for (int i = 0; i < 8; ++i) { const int m = m0 + i; pv[i] = (m <= l) ? L.CB[l * 68 + m] * fexp_(al - L.AC[m * 4 + hh]) * L.DT[m * 4 + hh] : 0.f; }
      u32x4 o; o.x = pk2(pv[0], pv[1]); o.y = pk2(pv[2], pv[3]); o.z = pk2(pv[4], pv[5]); o.w = pk2(pv[6], pv[7]); *(LAS u32x4*)(L.Ph + l * 72 + m0) = o; }
    stage_tr(L.Xt, 72, XC + g * 256 + hh * 64, 1024, 64, 8, tid);
    for (int p = tid; p < 1024; p += NTHR) { const int pr = p >> 4, n0 = (p & 15) * 8; const f32x4 v0 = *(const GAS f32x4*)(sp + (size_t)pr * 128 + n0), v1 = *(const GAS f32x4*)(sp + (size_t)pr * 128 + n0 + 4);
        *(LAS u32x4*)(L.Sh + pr * 136 + n0) = pack8(v0, v1); }
    __syncthreads();
#pragma unroll
    for (int q = 0; q < 2; ++q) { const int bn = (w & 1) * 2 + q; f32x4 yd = (f32x4){0.f, 0.f, 0.f, 0.f}, yo = (f32x4){0.f, 0.f, 0.f, 0.f};
#pragma unroll
        for (int ks = 0; ks < 2; ++ks) yd = MFMA16(ldfrag(L.Ph, 72, 16 * bm, 32 * ks, lane), ldfrag(L.Xt, 72, 16 * bn, 32 * ks, lane), yd);
#pragma unroll
        for (int ks = 0; ks < 4; ++ks) yo = MFMA16(ldfrag(L.Cs, 136, 16 * bm, 32 * ks, lane), ldfrag(L.Sh, 136, 16 * bn, 32 * ks, lane), yo);
#pragma unroll
        for (int r = 0; r < 4; ++r) { const int l = 16 * bm + 4 * g4 + r, p = 16 * bn + lc; const float x = bf2f(L.Xt[p * 72 + l]);
            const float z = bf2f(zrow[r][hh * 64 + q * 16]);
            y[q][r] = (yd[r] + fexp_(L.AC[l * 4 + hh]) * yo[r] + x * dsk) * z; } }
}
DI void u_mamba_out(Frame& F, int l_, int c, int g) {
    unsigned char* ws = F.ws; const int tid = F.tid, lane = F.lane, w = F.wave, g4 = lane >> 4, lc = lane & 15;
    MambaLds L; L.Cs = (LAS bf16*)F.lds; L.Bs = L.Cs + 64 * 136; L.CB = (LAS float*)(L.Bs + 64 * 136); L.Ph = (LAS bf16*)(L.CB + 64 * 68); L.Xt = L.Ph + 64 * 72; L.Sh = L.Xt + 64 * 72;
    L.AC = (LAS float*)(L.Sh + 64 * 136); L.DT = L.AC + 256; L.SSQ = L.DT + 256;
    const bf16* XC = (const bf16*)(ws + WS_XC) + (size_t)(c * 64) * 1024;
    stage_nat(L.Cs, 136, XC + 768 + g * 128, 1024, 64, 16, tid);
    stage_nat(L.Bs, 136, XC + 512 + g * 128, 1024, 64, 16, tid);
    if (tid < 256) { const int l = tid >> 2, hh = tid & 3; L.AC[tid] = ((const float*)(ws + WS_ACS))[(size_t)(c * 64 + l) * 8 + g * 4 + hh]; L.DT[tid] = ((const float*)(ws + WS_DTS))[(size_t)(c * 64 + l) * 8 + g * 4 + hh]; }
    __syncthreads();
    const int bm = w >> 1;
#pragma unroll
    for (int q = 0; q < 2; ++q) { const int bn = (w & 1) * 2 + q; f32x4 acc = (f32x4){0.f, 0.f, 0.f, 0.f};
#pragma unroll
        for (int ks = 0; ks < 4; ++ks) acc = MFMA16(ldfrag(L.Cs, 136, 16 * bm, 32 * ks, lane), ldfrag(L.Bs, 136, 16 * bn, 32 * ks, lane), acc);
#pragma unroll
        for (int r = 0; r < 4; ++r) L.CB[(16 * bm + 4 * g4 + r) * 68 + 16 * bn + lc] = acc[r]; }
    const int pcol = 16 * ((w & 1) * 2) + lc;
    const bf16* zrow[4]; bf16* orow[4];
#pragma unroll
    for (int r = 0; r < 4; ++r) { const size_t row = (size_t)(c * 64 + 16 * bm + 4 * g4 + r); zrow[r] = (const bf16*)(ws + WS_ZS) + row * 512 + g * 256 + pcol; orow[r] = (bf16*)(ws + WS_OB) + row * D + 512 + g * 256 + pcol; }
    const float* mst = (const float*)(ws + WS_MST) + ((size_t)(c * 8 + g * 4) * 64) * 128; const float* prm = (const float*)(ws + WS_PRM) + (size_t)l_ * PRM_STRIDE; const float* dskp = prm + P_SD + g * 4;
    float ss[4] = {0.f, 0.f, 0.f, 0.f};
#pragma unroll 1
    for (int hh = 0; hh < 4; ++hh) { f32x4 y[2]; mamba_head(F, L, XC, mst + (size_t)hh * 64 * 128, g, hh, dskp[hh], zrow, y);
#pragma unroll
        for (int r = 0; r < 4; ++r) ss[r] += y[0][r] * y[0][r] + y[1][r] * y[1][r]; }
#pragma unroll
    for (int r = 0; r < 4; ++r) { float t = ss[r]; t = row_sum16(t);
        if (lc == 0) L.SSQ[(16 * bm + 4 * g4 + r) * 2 + (w & 1)] = t; }
    __syncthreads();
    float rstd[4];
#pragma unroll
    for (int r = 0; r < 4; ++r) { const int l = 16 * bm + 4 * g4 + r; rstd[r] = rsqrtf((L.SSQ[l * 2] + L.SSQ[l * 2 + 1]) * (1.f / 256.f) + 1e-6f); }
    const float* nw = prm + P_SNW + g * 256 + pcol;
#pragma unroll 1
    for (int hh = 0; hh < 4; ++hh) { f32x4 y[2]; mamba_head(F, L, XC, mst + (size_t)hh * 64 * 128, g, hh, dskp[hh], zrow, y);
#pragma unroll
        for (int q = 0; q < 2; ++q)
#pragma unroll
            for (int r = 0; r < 4; ++r) orow[r][hh * 64 + q * 16] = (bf16)f2bf(y[q][r] * rstd[r] * nw[hh * 64 + q * 16]); }
    __syncthreads();
}

DI void u_attn2(Frame& F, int h, int qb, int sp, int ntile) {
    int tid_ = F.tid; asm volatile("" : "+v"(tid_));
    unsigned char* ws = F.ws; const int tid = tid_, lane = tid & 63, w = F.wave, g4 = lane >> 4, lc = lane & 15;
    LAS bf16* Ks = (LAS bf16*)F.lds; LAS bf16* Vs = Ks + 64 * 200;
    const bf16* QM = (const bf16*)(ws + WS_QM); const bf16* KM = (const bf16*)(ws + WS_KM) + h * 192; const bf16* VT = (const bf16*)(ws + WS_VT) + (size_t)(h * 128) * S;
    const int q0 = qb * 256 + w * 32, cw = 4 * qb + (w >> 1);
    bf16x8 qf[2][6];
#pragma unroll
    for (int qq = 0; qq < 2; ++qq)
#pragma unroll
        for (int ks = 0; ks < 6; ++ks) qf[qq][ks] = *(const GAS bf16x8*)(QM + (size_t)(q0 + qq * 16 + lc) * 768 + h * 192 + ks * 32 + g4 * 8);
    f32x4 o[8][2]; float mrun[2], lrun[2];
#pragma unroll
    for (int db = 0; db < 8; ++db)
#pragma unroll
        for (int qq = 0; qq < 2; ++qq) o[db][qq] = (f32x4){0.f, 0.f, 0.f, 0.f};
    mrun[0] = mrun[1] = -1e30f; lrun[0] = lrun[1] = 0.f;
    u32x4 kreg[3], vreg[2];
    const int kt0 = 16 * sp;
#define AT_LOAD(kt) { const int key0_ = (kt) * 64; \
        _Pragma("unroll") for (int i = 0; i < 3; ++i) { const int p = tid + 512 * i, r = p / 24, cc = p - r * 24; kreg[i] = *(const GAS u32x4*)(KM + (size_t)(key0_ + r) * 768 + cc * 8); } \
        _Pragma("unroll") for (int i = 0; i < 2; ++i) { const int p = tid + 512 * i, r = p >> 3, cc = p & 7; vreg[i] = *(const GAS u32x4*)(VT + (size_t)r * S + key0_ + cc * 8); } }
    AT_LOAD(kt0)
    for (int t = 0; t < ntile; ++t) {
        const int kt = kt0 + t;
        __syncthreads();
#pragma unroll
        for (int i = 0; i < 3; ++i) { const int p = tid + 512 * i, r = p / 24, cc = p - r * 24; *(LAS u32x4*)(Ks + r * 200 + cc * 8) = kreg[i]; }
#pragma unroll
        for (int i = 0; i < 2; ++i) { const int p = tid + 512 * i, r = p >> 3, cc = p & 7; *(LAS u32x4*)(Vs + r * 72 + cc * 8) = vreg[i]; }
        __syncthreads();
        if (t + 1 < ntile) AT_LOAD(kt + 1)
        if (kt <= cw) {
            f32x4 s[4][2];
#pragma unroll
            for (int kb = 0; kb < 4; ++kb)
#pragma unroll
                for (int qq = 0; qq < 2; ++qq) s[kb][qq] = (f32x4){0.f, 0.f, 0.f, 0.f};
#pragma unroll
            for (int ks = 0; ks < 6; ++ks)
#pragma unroll
                for (int kb = 0; kb < 4; ++kb) { const bf16x8 kf = ldfrag(Ks, 200, kb * 16, ks * 32, lane);
#pragma unroll
                    for (int qq = 0; qq < 2; ++qq) s[kb][qq] = MFMA16(kf, qf[qq][ks], s[kb][qq]);
                    if (kb == 3 && (ks & 1)) __builtin_amdgcn_sched_barrier(0); }
            bf16x8 pf[2][2];
#pragma unroll
            for (int qq = 0; qq < 2; ++qq) {
                float mx = -1e30f;
#pragma unroll
                for (int kb = 0; kb < 4; ++kb) mx = fmaxf(mx, fmaxf(fmaxf(s[kb][qq][0], s[kb][qq][1]), fmaxf(s[kb][qq][2], s[kb][qq][3])));
                mx = xr32_max(xr16_max(mx));
                const float mn = fmaxf(mrun[qq], mx), alpha = __builtin_amdgcn_exp2f(mrun[qq] - mn); mrun[qq] = mn;
                float ps = 0.f; float p[16];
#pragma unroll
                for (int kb = 0; kb < 4; ++kb)
#pragma unroll
                    for (int r = 0; r < 4; ++r) { p[kb * 4 + r] = __builtin_amdgcn_exp2f(s[kb][qq][r] - mn); ps += p[kb * 4 + r]; }
                ps = xr32_sum(xr16_sum(ps));
                lrun[qq] = lrun[qq] * alpha + ps;
if (__builtin_amdgcn_ballot_w64(alpha != 1.0f) != 0ull) {
#pragma unroll
                    for (int db = 0; db < 8; ++db) o[db][qq] = o[db][qq] * alpha; }
#pragma unroll
                for (int s2 = 0; s2 < 2; ++s2) { u32x4 pw; pw.x = pk2(p[8 * s2], p[8 * s2 + 1]); pw.y = pk2(p[8 * s2 + 2], p[8 * s2 + 3]); pw.z = pk2(p[8 * s2 + 4], p[8 * s2 + 5]); pw.w = pk2(p[8 * s2 + 6], p[8 * s2 + 7]); pf[qq][s2] = __builtin_bit_cast(bf16x8, pw); }
            }
#pragma unroll
            for (int db = 0; db < 8; ++db)
#pragma unroll
                for (int s2 = 0; s2 < 2; ++s2) {
                    const LAS bf16* vp = Vs + (db * 16 + lc) * 72 + 32 * s2 + 4 * g4;
                    const u32x2 v0 = *(const LAS u32x2*)vp, v1 = *(const LAS u32x2*)(vp + 16);
                    const u32x4 vw = (u32x4){v0.x, v0.y, v1.x, v1.y}; const bf16x8 vf = __builtin_bit_cast(bf16x8, vw);
#pragma unroll
                    for (int qq = 0; qq < 2; ++qq) o[db][qq] = MFMA16(vf, pf[qq][s2], o[db][qq]);
                }
        }
    }
#undef AT_LOAD
    const int slot = att_slot(h, qb, sp);
    float* po = (float*)(ws + WS_APO) + (size_t)slot * 32768; float* pm = (float*)(ws + WS_APM) + (size_t)slot * 512;
#pragma unroll
    for (int db = 0; db < 8; ++db)
#pragma unroll
        for (int qq = 0; qq < 2; ++qq)
#pragma unroll
            for (int r = 0; r < 4; ++r) po[(size_t)(db * 16 + 4 * g4 + r) * 256 + w * 32 + qq * 16 + lc] = o[db][qq][r];
    if (g4 == 0) {
#pragma unroll
        for (int qq = 0; qq < 2; ++qq) { *(GAS f32x2*)(pm + (w * 32 + qq * 16 + lc) * 2) = (f32x2){mrun[qq], lrun[qq]}; } }
    __syncthreads();
}
DI void u_attn_comb(Frame& F, int h, int qb, int qq) {
    unsigned char* ws = F.ws; const int tid = F.tid, q = qq * 64 + (tid & 63), dv0 = (tid >> 6) * 16;
    const int ns = (qb + 4) >> 2, slot0 = att_slot(h, qb, 0);
    const float* pm = (const float*)(ws + WS_APM) + (size_t)slot0 * 512 + q * 2; const float* po = (const float*)(ws + WS_APO) + (size_t)slot0 * 32768 + (size_t)dv0 * 256 + q;
    float mstar = -1e30f;
    for (int s = 0; s < ns; ++s) mstar = fmaxf(mstar, pm[(size_t)s * 512]);
    float lt = 0.f; float ov[16];
#pragma unroll
    for (int i = 0; i < 16; ++i) ov[i] = 0.f;
    for (int s = 0; s < ns; ++s) { const float sc = __builtin_amdgcn_exp2f(pm[(size_t)s * 512] - mstar); lt += pm[(size_t)s * 512 + 1] * sc;
#pragma unroll
        for (int i = 0; i < 16; ++i) ov[i] += po[(size_t)s * 32768 + i * 256] * sc; }
    const float inv = 1.0f / lt;
    bf16* ob = (bf16*)(ws + WS_OB) + (size_t)(qb * 256 + q) * D + 1024 + h * 128 + dv0;
    u32x4 o0, o1; o0.x = pk2(ov[0] * inv, ov[1] * inv); o0.y = pk2(ov[2] * inv, ov[3] * inv); o0.z = pk2(ov[4] * inv, ov[5] * inv); o0.w = pk2(ov[6] * inv, ov[7] * inv);
    o1.x = pk2(ov[8] * inv, ov[9] * inv); o1.y = pk2(ov[10] * inv, ov[11] * inv); o1.z = pk2(ov[12] * inv, ov[13] * inv); o1.w = pk2(ov[14] * inv, ov[15] * inv);
    *(GAS u32x4*)ob = o0; *(GAS u32x4*)(ob + 8) = o1;
}

DI void u_rwkv_r1(Frame& F, int c, int h) {
    int tid_ = F.tid; asm volatile("" : "+v"(tid_));
    unsigned char* ws = F.ws; const int tid = tid_, lane = tid_ & 63, w = F.wave, g4 = lane >> 4, lc = lane & 15;
    LAS float* CUM = (LAS float*)F.lds;
    LAS float* PT = CUM + 64 * 68;
    LAS bf16* AT = (LAS bf16*)(PT + 64); LAS bf16* BH = AT + 4608; LAS bf16* KH = BH + 4608; LAS bf16* RT = KH + 4608;
    LAS bf16* AJ = RT + 4608; LAS bf16* BJ = AJ + 4608; LAS bf16* KJ = BJ + 4608; LAS bf16* VJ = KJ + 4608;
    LAS bf16* MAK = VJ + 4608; LAS bf16* MRBT = MAK + 4608; LAS bf16* MRKT = MRBT + 4608; LAS bf16* X1 = MRKT + 4608; LAS bf16* X2 = X1 + 4608;
    LAS bf16* WT = AT; LAS bf16* G1 = BH; LAS bf16* G2 = KH; LAS bf16* CST = MAK;
    const size_t gb = (size_t)(c * 64) * 512 + h * 64; const int unit = c * 8 + h;
    const int t = tid >> 3, j0 = (tid & 7) * 8;
    const size_t go = gb + (size_t)t * 512 + j0;
    float lw[8];
    { const f32x4 x0 = *(const GAS f32x4*)((const float*)(ws + WS_DEC) + go), x1 = *(const GAS f32x4*)((const float*)(ws + WS_DEC) + go + 4);
#pragma unroll
      for (int i = 0; i < 4; ++i) { lw[i] = x0[i]; lw[4 + i] = x1[i]; }
#pragma unroll
      for (int i = 0; i < 8; ++i) CUM[t * 68 + j0 + i] = lw[i]; }
    __syncthreads();
    if (tid < 64) { float s = 0.f;
#pragma unroll 8
        for (int tt = 0; tt < 64; ++tt) { s += CUM[tt * 68 + tid]; CUM[tt * 68 + tid] = s; } }
    __syncthreads();
    {
        float cum[8], cT[8];
#pragma unroll
        for (int i = 0; i < 8; ++i) { cum[i] = CUM[t * 68 + j0 + i]; cT[i] = CUM[63 * 68 + j0 + i]; }
        if (t == 0) {
#pragma unroll
            for (int i = 0; i < 8; ++i) PT[j0 + i] = fexp_(cT[i]); }
        float av[8], bv[8], kv[8], rv[8], vv[8];
#define LD8(dst, OFF) { unpack8(*(const GAS u32x4*)((const bf16*)(ws + (OFF)) + go), dst); }
        LD8(av, WS_KKN) LD8(bv, WS_BB) LD8(kv, WS_KP) LD8(rv, WS_R32) LD8(vv, WS_VV)
#undef LD8
        float at[8], bh[8], kh[8], rt[8], bj[8], kj[8];
#pragma unroll
        for (int i = 0; i < 8; ++i) { const float pprev = fexp_(cum[i] - lw[i]), pinv = fexp_(-cum[i]), pt = fexp_(cum[i]), pend = fexp_(cT[i] - cum[i]);
            at[i] = -av[i] * pprev; bh[i] = bv[i] * pinv; kh[i] = kv[i] * pinv; rt[i] = rv[i] * pt; bj[i] = bv[i] * pend; kj[i] = kv[i] * pend; }
#define ST8(M, v) { u32x4 o; o.x = pk2(v[0], v[1]); o.y = pk2(v[2], v[3]); o.z = pk2(v[4], v[5]); o.w = pk2(v[6], v[7]); *(LAS u32x4*)(M + t * 72 + j0) = o; }
        ST8(AT, at) ST8(BH, bh) ST8(KH, kh) ST8(RT, rt)
#undef ST8
#pragma unroll
        for (int i = 0; i < 8; ++i) { const int o = (j0 + i) * 72 + t; AJ[o] = (bf16)f2bf(at[i]); BJ[o] = (bf16)f2bf(bj[i]); KJ[o] = (bf16)f2bf(kj[i]); VJ[o] = (bf16)f2bf(vv[i]); }
    }
    __syncthreads();
    {
        const int q = w >> 1; const LAS bf16* Am = (q == 0) ? BH : (q == 1) ? KH : RT; const LAS bf16* Bm = (q < 2) ? AT : (q == 2) ? BH : KH;
#pragma unroll
        for (int bi = 0; bi < 2; ++bi) { const int bm = 2 * (w & 1) + bi; const bf16x8 a0 = ldfrag(Am, 72, 16 * bm, 0, lane), a1 = ldfrag(Am, 72, 16 * bm, 32, lane);
#pragma unroll
            for (int bn = 0; bn < 4; ++bn) { f32x4 acc = (f32x4){0.f, 0.f, 0.f, 0.f};
                acc = MFMA16(a0, ldfrag(Bm, 72, 16 * bn, 0, lane), acc); acc = MFMA16(a1, ldfrag(Bm, 72, 16 * bn, 32, lane), acc);
#pragma unroll
                for (int r = 0; r < 4; ++r) { const int row = 16 * bm + 4 * g4 + r, col = 16 * bn + lc; const bool keep = (q < 2) ? (row < col) : (col <= row); const float v = keep ? acc[r] : 0.f;
                    if (q == 0) CUM[row * 68 + col] = v; else { LAS bf16* O = (q == 1) ? MAK : (q == 2) ? MRBT : MRKT; O[row * 72 + col] = (bf16)f2bf(v); } } } }
    }
    __syncthreads();
    {
        LAS bf16* Qn[2] = {BH, X1}; LAS bf16* Qt[2] = {KH, X2}; LAS bf16* Wn[2] = {AT, (LAS bf16*)CUM};
        const int bm = w >> 1; f32x4 wreg[2];
#pragma unroll
        for (int qn = 0; qn < 2; ++qn) { const int bn = (w & 1) * 2 + qn;
#pragma unroll
            for (int r = 0; r < 4; ++r) { const int row = 16 * bm + 4 * g4 + r, col = 16 * bn + lc; const float m = CUM[row * 68 + col]; wreg[qn][r] = m + ((row == col) ? 1.f : 0.f);
                const bf16 mb = (bf16)f2bf(m); Qn[0][row * 72 + col] = mb; Qt[0][col * 72 + row] = mb; Wn[0][row * 72 + col] = (bf16)f2bf(wreg[qn][r]); } }
        __syncthreads();
#pragma unroll
        for (int it = 0; it < 5; ++it) { const int cu = it & 1, nx = cu ^ 1;
            { const bf16x8 a0 = ldfrag(Qn[cu], 72, 16 * bm, 0, lane), a1 = ldfrag(Qn[cu], 72, 16 * bm, 32, lane);
#pragma unroll
              for (int qn = 0; qn < 2; ++qn) { const int bn = (w & 1) * 2 + qn; f32x4 acc = (f32x4){0.f, 0.f, 0.f, 0.f};
                  acc = MFMA16(a0, ldfrag(Qt[cu], 72, 16 * bn, 0, lane), acc); acc = MFMA16(a1, ldfrag(Qt[cu], 72, 16 * bn, 32, lane), acc);
#pragma unroll
                  for (int r = 0; r < 4; ++r) { const int row = 16 * bm + 4 * g4 + r, col = 16 * bn + lc; const bf16 v = (bf16)f2bf(acc[r]); Qn[nx][row * 72 + col] = v; Qt[nx][col * 72 + row] = v; } } }
            __syncthreads();
            { const bf16x8 a0 = ldfrag(Wn[cu], 72, 16 * bm, 0, lane), a1 = ldfrag(Wn[cu], 72, 16 * bm, 32, lane);
#pragma unroll
              for (int qn = 0; qn < 2; ++qn) { const int bn = (w & 1) * 2 + qn;
                  wreg[qn] = MFMA16(a0, ldfrag(Qt[nx], 72, 16 * bn, 0, lane), wreg[qn]); wreg[qn] = MFMA16(a1, ldfrag(Qt[nx], 72, 16 * bn, 32, lane), wreg[qn]); } }
            if (it < 4) {
#pragma unroll
                for (int qn = 0; qn < 2; ++qn) { const int bn = (w & 1) * 2 + qn;
#pragma unroll
                    for (int r = 0; r < 4; ++r) Wn[nx][(16 * bm + 4 * g4 + r) * 72 + 16 * bn + lc] = (bf16)f2bf(wreg[qn][r]); }
            }
        }
        __syncthreads();
#pragma unroll
        for (int qn = 0; qn < 2; ++qn) { const int bn = (w & 1) * 2 + qn;
#pragma unroll
            for (int r = 0; r < 4; ++r) WT[(16 * bn + lc) * 72 + 16 * bm + 4 * g4 + r] = (bf16)f2bf(wreg[qn][r]); }
    }
    __syncthreads();
    {
        const int q = w >> 2, bm = w & 3; const LAS bf16* Am = q ? MAK : AJ; LAS bf16* O = q ? G2 : G1;
        const bf16x8 a0 = ldfrag(Am, 72, 16 * bm, 0, lane), a1 = ldfrag(Am, 72, 16 * bm, 32, lane);
        f32x4 acc[4];
#pragma unroll
        for (int bn = 0; bn < 4; ++bn) { acc[bn] = (f32x4){0.f, 0.f, 0.f, 0.f};
            acc[bn] = MFMA16(a0, ldfrag(WT, 72, 16 * bn, 0, lane), acc[bn]); acc[bn] = MFMA16(a1, ldfrag(WT, 72, 16 * bn, 32, lane), acc[bn]); }
#pragma unroll
        for (int bn = 0; bn < 4; ++bn)
#pragma unroll
            for (int r = 0; r < 4; ++r) O[(16 * bm + 4 * g4 + r) * 72 + 16 * bn + lc] = (bf16)f2bf(acc[bn][r]);
    }
    __syncthreads();
    {
        const int q = w >> 1; const LAS bf16* Am = (q < 2) ? MRBT : BJ; const LAS bf16* Bm = (q & 1) ? G2 : G1;
        f32x4 acc[2][4];
#pragma unroll
        for (int bi = 0; bi < 2; ++bi) { const int bm = 2 * (w & 1) + bi; const bf16x8 a0 = ldfrag(Am, 72, 16 * bm, 0, lane), a1 = ldfrag(Am, 72, 16 * bm, 32, lane);
#pragma unroll
            for (int bn = 0; bn < 4; ++bn) { acc[bi][bn] = (f32x4){0.f, 0.f, 0.f, 0.f};
                acc[bi][bn] = MFMA16(a0, ldfrag(Bm, 72, 16 * bn, 0, lane), acc[bi][bn]); acc[bi][bn] = MFMA16(a1, ldfrag(Bm, 72, 16 * bn, 32, lane), acc[bi][bn]); } }
        bf16* gout = (bf16*)(ws + (q == 0 ? WS_QYT : q == 1 ? WS_CYT : WS_TST)) + (size_t)unit * 4096;
#pragma unroll
        for (int bi = 0; bi < 2; ++bi) { const int bm = 2 * (w & 1) + bi;
#pragma unroll
            for (int bn = 0; bn < 4; ++bn)
#pragma unroll
                for (int r = 0; r < 4; ++r) { const int row = 16 * bm + 4 * g4 + r, col = 16 * bn + lc; float v = acc[bi][bn][r];
                    if (q == 0) v += bf2f(RT[row * 72 + col]); else if (q == 1) v += bf2f(MRKT[row * 72 + col]); else if (q == 2) v += (row == col) ? PT[row] : 0.f; else v += bf2f(KJ[row * 72 + col]);
                    if (q < 3) gout[row * 64 + col] = (bf16)f2bf(v); else CST[row * 72 + col] = (bf16)f2bf(v); } }
    }
    __syncthreads();
    {
        const int bm = w >> 1; float* nst = (float*)(ws + WS_NST) + (size_t)unit * 4096;
        const bf16x8 a0 = ldfrag(CST, 72, 16 * bm, 0, lane), a1 = ldfrag(CST, 72, 16 * bm, 32, lane);
#pragma unroll
        for (int qn = 0; qn < 2; ++qn) { const int bn = (w & 1) * 2 + qn; f32x4 acc = (f32x4){0.f, 0.f, 0.f, 0.f};
            acc = MFMA16(a0, ldfrag(VJ, 72, 16 * bn, 0, lane), acc); acc = MFMA16(a1, ldfrag(VJ, 72, 16 * bn, 32, lane), acc);
#pragma unroll
            for (int r = 0; r < 4; ++r) nst[(16 * bm + 4 * g4 + r) * 64 + 16 * bn + lc] = acc[r]; }
    }
    __syncthreads();
}

DI void p_rwkv_scan2(Frame& F, int h) {
    unsigned char* ws = F.ws; const int lane = F.lane, w = F.wave, g4 = lane >> 4, lc = lane & 15;
    constexpr int SLOT_B = 9216 + 17408;
    const bf16* TST = (const bf16*)(ws + WS_TST) + (size_t)h * 4096; const float* NST = (const float*)(ws + WS_NST) + (size_t)h * 4096; bf16* S0 = (bf16*)(ws + WS_S0) + (size_t)h * 4096;
    if (w >= 4) {
        const int lt = (w - 4) * 64 + lane;
        u32x4 rt[8][2]; f32x4 rn[8][4];
#define SC_ISSUE(u, cc) { const size_t ub = (size_t)(cc) * 8 * 4096; \
            _Pragma("unroll") for (int i = 0; i < 2; ++i) { const int p = lt + 256 * i; rt[u][i] = *(const GAS u32x4*)(TST + ub + (size_t)p * 8); } \
            _Pragma("unroll") for (int i = 0; i < 4; ++i) { const int p = lt + 256 * i; rn[u][i] = *(const GAS f32x4*)(NST + ub + (size_t)p * 4); } }
#define SC_WRITE(u, cc) { LAS unsigned char* sl = F.lds + ((cc) & 1) * SLOT_B; \
            _Pragma("unroll") for (int i = 0; i < 2; ++i) { const int p = lt + 256 * i, r = p >> 3, c8 = p & 7; *(LAS u32x4*)(sl + (r * 72 + c8 * 8) * 2) = rt[u][i]; } \
            _Pragma("unroll") for (int i = 0; i < 4; ++i) { const int p = lt + 256 * i, r = p >> 4, c4 = p & 15; *(LAS f32x4*)(sl + 9216 + (r * 68 + c4 * 4) * 4) = rn[u][i]; } }
#pragma unroll
        for (int u = 0; u < 8; ++u) SC_ISSUE(u, u)
        for (int c0 = 0; c0 < NCH; c0 += 8) {
#pragma unroll
            for (int u = 0; u < 8; ++u) { const int c = c0 + u;
                SC_WRITE(u, c)
                if (c + 8 < NCH) SC_ISSUE(u, c + 8)
                asm volatile("s_waitcnt lgkmcnt(0)" ::: "memory"); __builtin_amdgcn_s_barrier(); asm volatile("" ::: "memory");
            }
        }
#undef SC_ISSUE
#undef SC_WRITE
    } else {
        const int ib = w;
        f32x4 st[4];
#pragma unroll
        for (int jb = 0; jb < 4; ++jb) st[jb] = (f32x4){0.f, 0.f, 0.f, 0.f};
        for (int c = 0; c < NCH; ++c) {
            bf16* s0p = S0 + (size_t)c * 8 * 4096 + (size_t)(16 * ib + lc) * 64 + 4 * g4;
            bf16x8 bfr[2];
#pragma unroll
            for (int ks = 0; ks < 2; ++ks) { u32x4 p; p.x = pk2(st[2 * ks][0], st[2 * ks][1]); p.y = pk2(st[2 * ks][2], st[2 * ks][3]); p.z = pk2(st[2 * ks + 1][0], st[2 * ks + 1][1]); p.w = pk2(st[2 * ks + 1][2], st[2 * ks + 1][3]);
                bfr[ks] = __builtin_bit_cast(bf16x8, p);
                *(GAS u32x2*)(s0p + 32 * ks) = (u32x2){p.x, p.y}; *(GAS u32x2*)(s0p + 32 * ks + 16) = (u32x2){p.z, p.w}; }
            asm volatile("s_waitcnt lgkmcnt(0)" ::: "memory"); __builtin_amdgcn_s_barrier(); asm volatile("" ::: "memory");
            const LAS bf16* ts = (const LAS bf16*)(F.lds + (c & 1) * SLOT_B); const LAS float* ns = (const LAS float*)(F.lds + (c & 1) * SLOT_B + 9216);
#pragma unroll
            for (int jb = 0; jb < 4; ++jb) { f32x4 nw;
#pragma unroll
                for (int r = 0; r < 4; ++r) nw[r] = ns[(16 * jb + 4 * g4 + r) * 68 + 16 * ib + lc];
#pragma unroll
                for (int ks = 0; ks < 2; ++ks) { const LAS bf16* ap = ts + (16 * jb + lc) * 72 + 32 * ks + 4 * g4; const u32x2 a0 = *(const LAS u32x2*)ap, a1 = *(const LAS u32x2*)(ap + 16);
                    const u32x4 aw = (u32x4){a0.x, a0.y, a1.x, a1.y}; nw = MFMA16(__builtin_bit_cast(bf16x8, aw), bfr[ks], nw); }
                st[jb] = nw; }
        }
    }
}

DI void u_rwkv_r3(Frame& F, int l_, int c, int h) {
    int tid_ = F.tid; asm volatile("" : "+v"(tid_));
    unsigned char* ws = F.ws; const int tid = tid_, lane = tid_ & 63, w = F.wave, g4 = lane >> 4, lc = lane & 15, unit = c * 8 + h;
    LAS bf16* QY = (LAS bf16*)F.lds; LAS bf16* CY = QY + 4608; LAS bf16* S0s = CY + 4608; LAS bf16* VJ = S0s + 4608; LAS float* Ys = (LAS float*)(VJ + 4608);
    stage_nat(QY, 72, (const bf16*)(ws + WS_QYT) + (size_t)unit * 4096, 64, 64, 8, tid);
    stage_nat(CY, 72, (const bf16*)(ws + WS_CYT) + (size_t)unit * 4096, 64, 64, 8, tid);
    stage_nat(S0s, 72, (const bf16*)(ws + WS_S0) + (size_t)unit * 4096, 64, 64, 8, tid);
    const size_t gb = (size_t)(c * 64) * 512 + h * 64;
    { const int t = tid >> 3, j0 = (tid & 7) * 8; const u32x4 w4 = *(const GAS u32x4*)((const bf16*)(ws + WS_VV) + gb + (size_t)t * 512 + j0); LAS bf16* d = VJ + j0 * 72 + t;
      d[0] = (bf16)(w4.x & 0xffffu); d[72] = (bf16)(w4.x >> 16); d[144] = (bf16)(w4.y & 0xffffu); d[216] = (bf16)(w4.y >> 16); d[288] = (bf16)(w4.z & 0xffffu); d[360] = (bf16)(w4.z >> 16); d[432] = (bf16)(w4.w & 0xffffu); d[504] = (bf16)(w4.w >> 16); }
    __syncthreads();
    { const int bm = w >> 1;
#pragma unroll
      for (int qn = 0; qn < 2; ++qn) { const int bn = (w & 1) * 2 + qn; f32x4 acc = (f32x4){0.f, 0.f, 0.f, 0.f};
#pragma unroll
          for (int ks = 0; ks < 2; ++ks) { acc = MFMA16(ldfrag(QY, 72, 16 * bm, 32 * ks, lane), ldfrag(S0s, 72, 16 * bn, 32 * ks, lane), acc); acc = MFMA16(ldfrag(CY, 72, 16 * bm, 32 * ks, lane), ldfrag(VJ, 72, 16 * bn, 32 * ks, lane), acc); }
#pragma unroll
          for (int r = 0; r < 4; ++r) Ys[(16 * bm + 4 * g4 + r) * 65 + 16 * bn + lc] = acc[r]; } }
    __syncthreads();
    { const float* prm = (const float*)(ws + WS_PRM) + (size_t)l_ * PRM_STRIDE; const float lnw = prm[P_LNW + h * 64 + lane], lnb = prm[P_LNB + h * 64 + lane], rk = prm[P_RK + h * 64 + lane];
      float rr_[8], kk_[8], vv_[8], gg_[8];
#pragma unroll
      for (int rr = 0; rr < 8; ++rr) { const size_t o = gb + (size_t)(8 * w + rr) * 512 + lane;
          rr_[rr] = bf2f(((const bf16*)(ws + WS_R32))[o]); kk_[rr] = bf2f(((const bf16*)(ws + WS_KP))[o]); vv_[rr] = bf2f(((const bf16*)(ws + WS_VV))[o]); gg_[rr] = bf2f(((const bf16*)(ws + WS_G32))[o]); }
#pragma unroll
      for (int rr = 0; rr < 8; ++rr) { const int t = 8 * w + rr; const float y = Ys[t * 65 + lane];
          const float mean = wave_sum(y) * (1.f / 64.f), d = y - mean, rstd = rsqrtf(wave_sum(d * d) * (1.f / 64.f) + 64e-5f), bs = wave_sum(rr_[rr] * kk_[rr] * rk);
          ((bf16*)(ws + WS_OB))[(size_t)(c * 64 + t) * D + 1536 + h * 64 + lane] = (bf16)f2bf((d * rstd * lnw + lnb + bs * vv_[rr]) * gg_[rr]); } }
    __syncthreads();
}

constexpr int STEPS_PER_LAYER = 13, NSTEPS = 1 + DEPTH * STEPS_PER_LAYER;
constexpr int NSCAN_BLK = 8;

__global__ void __launch_bounds__(NTHR, 2) mk_fwd(Args args) {
    extern __shared__ __attribute__((aligned(16))) unsigned char lds_raw[];
    Frame F;
    F.lds = (LAS unsigned char*)lds_raw; F.MISC = (volatile LAS unsigned*)(F.lds + MISC_OFF);
    F.tid = threadIdx.x; F.lane = F.tid & 63; F.wave = __builtin_amdgcn_readfirstlane(F.tid >> 6);
    F.G = gridDim.x; F.bid = blockIdx.x; F.ws = args.ws; F.ctl = (gu32*)(args.ws + WS_CTL);
    for (int u = F.tid; u < (LDS_BYTES - LDSCTL_OFF) / 4; u += NTHR) ((LAS unsigned*)(F.lds + LDSCTL_OFF))[u] = 0u;
    __syncthreads();
    const int lo = args.st_lo, hi = args.st_hi;
    XcdBarrier bar; bar.bar = (unsigned*)(F.ctl + CW_BAR); bar.x = 0; bar.st = nullptr;
    if (hi - lo > 1) bar = xcd_barrier_post((unsigned*)(F.ctl + CW_BAR), F.MISC + 8);
#ifndef MK_MASK
#define MK_MASK 0xFBFEu
#endif
#define EN(k) (((MK_MASK) >> (k)) & 1u)
#ifndef MK_REP
#define MK_REP 0u
#endif
#define REP(k) (((MK_REP) >> (k)) & 1u)
#ifndef MK_DUP
#define MK_DUP 0u
#endif
#define DUP(k, stmt) do { stmt; if (((MK_DUP) >> (k)) & 1u) { stmt; } } while (0)
#define RUN(s) (lo <= (s) && (s) < hi)
#define SEAM(s) do { if ((s) + 1 < hi) xcd_barrier(bar); } while (0)

    if (EN(13) && RUN(0)) { _Pragma("unroll 1") for (int rp = 0; rp <= (int)REP(13); ++rp) { relaunder(F, args.ws, (LAS unsigned char*)lds_raw); p_prologue(F, args); } SEAM(0); }

    for (int l = 0; l < DEPTH; ++l) {
        const int sb = 1 + l * STEPS_PER_LAYER;
        const float* xin = (l == 0) ? args.in[0] : args.out;
        if (EN(0) && RUN(sb + 0)) { _Pragma("unroll 1") for (int rp = 0; rp <= (int)REP(0); ++rp) { relaunder(F, args.ws, (LAS unsigned char*)lds_raw); unsigned char* ws = F.ws; DUP(11, p_rmsnorm(F, xin, (const float*)(ws + WS_PRM) + (size_t)l * PRM_STRIDE + P_N1, (bf16*)(ws + WS_XN))); } SEAM(sb + 0); }
        if (EN(1) && RUN(sb + 1)) { _Pragma("unroll 1") for (int rp = 0; rp <= (int)REP(1); ++rp) { relaunder(F, args.ws, (LAS unsigned char*)lds_raw); unsigned char* ws = F.ws;
            pg8::Gemm g{(const bf16*)(ws + WS_XN), (const bf16*)(ws + WS_WIN) + (size_t)l * NINP * D, D, D, D};
            pg8::StaticOrder So; So.init(S, NINP - 256, F.G, F.bid); pg8::EpiIn E{ws, 0, (const LAS float*)(F.lds + RTAB_OFF)};
            pg8::fill_rstd((LAS float*)(F.lds + RTAB_OFF), (const float*)(ws + WS_RSSA), So, F.tid);
            DUP(6, (pg8::gemm_phase<pg8::EpiIn, pg8::StaticOrder, true>(F.lds, g, So, E, F.tid)));
            } SEAM(sb + 1);
        }
        if (EN(2) && RUN(sb + 2)) { _Pragma("unroll 1") for (int rp = 0; rp <= (int)REP(2); ++rp) { relaunder(F, args.ws, (LAS unsigned char*)lds_raw); unsigned char* ws = F.ws;
            if (F.bid >= F.G - 32) {
                pg8::Gemm g{(const bf16*)(ws + WS_XN), (const bf16*)(ws + WS_WIN) + ((size_t)l * NINP + (NINP - 256)) * D, D, D, D};
                pg8::StaticOrder So; So.init(S, 256, 32, F.bid - (F.G - 32)); pg8::EpiMisc E{ws, (const LAS float*)(F.lds + RTAB_OFF)};
                pg8::fill_rstd((LAS float*)(F.lds + RTAB_OFF), (const float*)(ws + WS_RSSA), So, F.tid);
                pg8::gemm_phase<pg8::EpiMisc, pg8::StaticOrder, true>(F.lds, g, So, E, F.tid);
            } else {
                const int Gs = F.G; F.G = Gs - 32;
                DUP(12, p_rwkv_prep(F, l));
                relaunder(F, args.ws, (LAS unsigned char*)lds_raw); F.G = Gs - 32; DUP(13, p_mamba_prep(F, l));
                __syncthreads(); relaunder(F, args.ws, (LAS unsigned char*)lds_raw); F.G = Gs - 32;
                for (int u = F.bid; u < 512; u += F.G) DUP(5, u_ret_kv(F, u >> 2, u & 3));
                F.G = Gs;
            }
            } SEAM(sb + 2);
        }
        if (EN(3) && RUN(sb + 3)) { _Pragma("unroll 1") for (int rp = 0; rp <= (int)REP(3); ++rp) { relaunder(F, args.ws, (LAS unsigned char*)lds_raw); unsigned char* ws = F.ws;
            { pg8::Gemm g{(const bf16*)(ws + WS_CQ), (const bf16*)(ws + WS_WQB) + (size_t)l * 1024 * 512, 512, 512, 512};
              pg8::StaticOrder So; So.init(S, 1024, F.G, F.bid); pg8::EpiQb E{ws, (const float*)(ws + WS_PRM) + (size_t)l * PRM_STRIDE + P_QNW};
              pg8::gemm_phase<pg8::EpiQb, pg8::StaticOrder, false>(F.lds, g, So, E, F.tid); __syncthreads(); }
            relaunder(F, args.ws, (LAS unsigned char*)lds_raw); ws = F.ws;
            { pg8::Gemm g{(const bf16*)(ws + WS_CKV), (const bf16*)(ws + WS_WKVB) + (size_t)l * 1024 * 256, 256, 256, 256};
              pg8::StaticOrder So; So.init(S, 1024, F.G, (F.bid + 128) % F.G); pg8::EpiKvb E{ws, (const float*)(ws + WS_PRM) + (size_t)l * PRM_STRIDE + P_KNW};
              pg8::gemm_phase<pg8::EpiKvb, pg8::StaticOrder, false>(F.lds, g, So, E, F.tid); __syncthreads(); }
            relaunder(F, args.ws, (LAS unsigned char*)lds_raw); ws = F.ws;
            if (l > 0) { pg8::Gemm g{(const bf16*)(ws + WS_VV), (const bf16*)(ws + WS_WV1) + (size_t)l * 256 * 512, 512, 512, 512};
              pg8::StaticOrder So; So.init(S, 256, F.G, (F.bid + 64) % F.G); pg8::EpiV1 E{ws};
              pg8::gemm_phase<pg8::EpiV1, pg8::StaticOrder, true>(F.lds, g, So, E, F.tid); __syncthreads(); }
            relaunder(F, args.ws, (LAS unsigned char*)lds_raw);
            for (int u = F.bid; u < 256; u += F.G) { u_mamba_dt(F, l, u >> 1); DUP(4, u_mamba_st(F, u >> 1, u & 1)); }
            } SEAM(sb + 3);
        }
        if (EN(4) && RUN(sb + 4)) { _Pragma("unroll 1") for (int rp = 0; rp <= (int)REP(4); ++rp) { relaunder(F, args.ws, (LAS unsigned char*)lds_raw); unsigned char* ws = F.ws;
            {
              pg8::Gemm g{(const bf16*)(ws + WS_ALORA), (const bf16*)(ws + WS_WLORA) + (size_t)l * 2048 * 512, 512, 512, 512};
              pg8::StaticOrder So; So.init(S, l > 0 ? 2048 : 1536, F.G, F.bid);
              const float* prm = (const float*)(ws + WS_PRM) + (size_t)l * PRM_STRIDE; pg8::EpiLora E{ws, prm + P_W0, prm + P_A0, prm + P_V0, prm + P_KA};
              DUP(9, (pg8::gemm_phase<pg8::EpiLora, pg8::StaticOrder, true>(F.lds, g, So, E, F.tid))); }
            } SEAM(sb + 4);
        }
        if (EN(5) && RUN(sb + 5)) { _Pragma("unroll 1") for (int rp = 0; rp <= (int)REP(5); ++rp) { relaunder(F, args.ws, (LAS unsigned char*)lds_raw); unsigned char* ws = F.ws; (void)ws;
            if (F.bid < 64) { p_scans(F, 64); relaunder(F, args.ws, (LAS unsigned char*)lds_raw);
                for (int u = F.bid * 2; u < F.bid * 2 + 2; ++u) u_rwkv_r1(F, u >> 3, u & 7); }
            else { for (int u = 128 + (F.bid - 64); u < 1024; u += F.G - 64) u_rwkv_r1(F, u >> 3, u & 7); }
            } SEAM(sb + 5);
        }
        if (EN(6) && RUN(sb + 6)) { _Pragma("unroll 1") for (int rp = 0; rp <= (int)REP(6); ++rp) { relaunder(F, args.ws, (LAS unsigned char*)lds_raw); unsigned char* ws = F.ws; (void)ws;
            if (F.bid < NSCAN_BLK) { p_rwkv_scan2(F, F.bid); }
            else {
                const int NB = F.G - NSCAN_BLK, b = F.bid - NSCAN_BLK;
                { const int* tab = (const int*)(ws + WS_ATAB);
                  for (int r = 0; r * NB < ATT_NSUB; ++r) { const int pos = (r & 1) ? NB - 1 - b : b; const int i = r * NB + pos;
                      if (i < ATT_NSUB) { const int e = tab[i]; DUP(0, u_attn2(F, e & 3, (e >> 2) & 31, (e >> 7) & 31, e >> 12)); } } }
            }
            } SEAM(sb + 6);
        }
        if (EN(7) && RUN(sb + 7)) { _Pragma("unroll 1") for (int rp = 0; rp <= (int)REP(7); ++rp) { relaunder(F, args.ws, (LAS unsigned char*)lds_raw); unsigned char* ws = F.ws; (void)ws;
            for (int u = F.bid; u < 1024; u += F.G) DUP(3, u_rwkv_r3(F, l, u >> 3, u & 7));
            for (int u = F.bid; u < 512; u += F.G) DUP(10, u_attn_comb(F, u >> 7, (u >> 2) & 31, u & 3));
            relaunder(F, args.ws, (LAS unsigned char*)lds_raw);
            for (int u = F.bid; u < 256; u += F.G) DUP(2, u_mamba_out(F, l, u >> 1, u & 1));
            relaunder(F, args.ws, (LAS unsigned char*)lds_raw);
            for (int u = F.bid; u < 512; u += F.G) DUP(1, u_ret_out(F, l, u >> 2, u & 3));
            } SEAM(sb + 7);
        }
        if (EN(8) && RUN(sb + 8)) { _Pragma("unroll 1") for (int rp = 0; rp <= (int)REP(8); ++rp) { relaunder(F, args.ws, (LAS unsigned char*)lds_raw); unsigned char* ws = F.ws;
            pg8::Gemm g{(const bf16*)(ws + WS_OB), (const bf16*)(ws + WS_WBR) + (size_t)l * 8192 * 512, 512, D, 512};
            pg8::BranchOrder So; So.init(F.G, F.bid); pg8::EpiBranch E{ws};
            DUP(8, (pg8::gemm_phase<pg8::EpiBranch, pg8::BranchOrder, true>(F.lds, g, So, E, F.tid)));
            } SEAM(sb + 8);
        }
        if (EN(9) && RUN(sb + 9)) { _Pragma("unroll 1") for (int rp = 0; rp <= (int)REP(9); ++rp) { relaunder(F, args.ws, (LAS unsigned char*)lds_raw); unsigned char* ws = F.ws;
            pg8::Gemm g{(const bf16*)(ws + WS_MERGED), (const bf16*)(ws + WS_WOUT) + (size_t)l * D * D, D, D, D};
            pg8::StaticOrder So; So.init(S, D, F.G, F.bid); pg8::EpiRes E{xin, args.out, (bf16*)(ws + WS_XN), (float*)(ws + WS_RSSB)};
            pg8::gemm_phase<pg8::EpiRes, pg8::StaticOrder, true>(F.lds, g, So, E, F.tid);
            } SEAM(sb + 9);
        }
        if (EN(10) && RUN(sb + 10)) { _Pragma("unroll 1") for (int rp = 0; rp <= (int)REP(10); ++rp) { relaunder(F, args.ws, (LAS unsigned char*)lds_raw); unsigned char* ws = F.ws; DUP(11, p_rmsnorm(F, args.out, (const float*)(ws + WS_PRM) + (size_t)l * PRM_STRIDE + P_N2, (bf16*)(ws + WS_XN))); } SEAM(sb + 10); }
        if (EN(11) && RUN(sb + 11)) { _Pragma("unroll 1") for (int rp = 0; rp <= (int)REP(11); ++rp) { relaunder(F, args.ws, (LAS unsigned char*)lds_raw); unsigned char* ws = F.ws;
            pg8::Gemm g{(const bf16*)(ws + WS_XN), (const bf16*)(ws + WS_WGU) + (size_t)l * 2 * DFF * D, D, D, D};
            pg8::StaticOrder So; So.init(S, 2 * DFF, F.G, F.bid); pg8::EpiGu E{ws, (const LAS float*)(F.lds + RTAB_OFF)};
            pg8::fill_rstd((LAS float*)(F.lds + RTAB_OFF), (const float*)(ws + WS_RSSB), So, F.tid);
            DUP(7, (pg8::gemm_phase<pg8::EpiGu, pg8::StaticOrder, true>(F.lds, g, So, E, F.tid)));
            } SEAM(sb + 11);
        }
        if (EN(12) && RUN(sb + 12)) { _Pragma("unroll 1") for (int rp = 0; rp <= (int)REP(12); ++rp) { relaunder(F, args.ws, (LAS unsigned char*)lds_raw); unsigned char* ws = F.ws;
            pg8::Gemm g{(const bf16*)(ws + WS_ACT), (const bf16*)(ws + WS_WDN) + (size_t)l * D * DFF, DFF, DFF, DFF};
            pg8::StaticOrder So; So.init(S, D, F.G, F.bid); pg8::EpiRes E{args.out, args.out, (bf16*)(ws + WS_XN), (l + 1 < DEPTH) ? (float*)(ws + WS_RSSA) : nullptr};
            pg8::gemm_phase<pg8::EpiRes, pg8::StaticOrder, true>(F.lds, g, So, E, F.tid);
            } SEAM(sb + 12);
        }
    }
#undef RUN
#undef SEAM
}

#ifndef MK_ONE_LAUNCH
#define MK_ONE_LAUNCH 1
#endif
extern "C" void kernel_launch(void* const* d_in, const int* in_sizes, int n_in, void* d_out, int out_size, void* d_ws, size_t ws_size, hipStream_t stream) {
    static int grid = 0;
    if (grid == 0) {
        if (n_in != 36 || in_sizes[0] != S * D || out_size != S * D || ws_size < WS_END3) { fprintf(stderr, "kernel_launch: bad shapes: n_in %d in0 %d out %d ws %zu (need %zu)\n", n_in, n_in > 0 ? in_sizes[0] : -1, out_size, ws_size, (size_t)WS_END3); grid = -1; return; }
        int dev = 0, cus = 0, per_cu = 0;
        if (hipGetDevice(&dev) != hipSuccess || hipDeviceGetAttribute(&cus, hipDeviceAttributeMultiprocessorCount, dev) != hipSuccess) { grid = -1; return; }
        if (hipFuncSetAttribute((const void*)mk_fwd, hipFuncAttributeMaxDynamicSharedMemorySize, LDS_BYTES) != hipSuccess) { fprintf(stderr, "kernel_launch: hipFuncSetAttribute failed\n"); grid = -1; return; }
        if (hipOccupancyMaxActiveBlocksPerMultiprocessor(&per_cu, (const void*)mk_fwd, NTHR, LDS_BYTES) != hipSuccess || per_cu < 1) fprintf(stderr, "kernel_launch: occupancy query says %d\n", per_cu);
        (void)hipGetLastError();
        grid = cus;
        if (grid != 256) fprintf(stderr, "kernel_launch: %d CUs (built for 256)\n", grid);
    }
    if (grid < 0) return;
    if (hipMemsetAsync((char*)d_ws + WS_CTL, 0, CTL_ZERO_BYTES, stream) != hipSuccess) return;
    Args a{};
    for (int i = 0; i < 36; ++i) a.in[i] = (const float*)d_in[i];
    a.out = (float*)d_out; a.ws = (unsigned char*)d_ws;
#if MK_ONE_LAUNCH
    a.st_lo = 0; a.st_hi = NSTEPS;
    hipLaunchKernelGGL(mk_fwd, dim3(grid), dim3(NTHR), LDS_BYTES, stream, a);
#ifndef MK_EXTRA_FLAGS
#define MK_EXTRA_FLAGS 0
#endif
#ifdef MK_EXTRA_STEPS
    { const int xs[] = {MK_EXTRA_STEPS};
      for (int r = 0; r < MK_EXTRA_N; ++r) for (unsigned i = 0; i < sizeof(xs) / sizeof(xs[0]); ++i) { a.st_lo = xs[i]; a.st_hi = xs[i] + 1; hipLaunchKernelGGL(mk_fwd, dim3(grid), dim3(NTHR), LDS_BYTES, stream, a); } }
#endif
#else
    for (int s = 0; s < NSTEPS; ++s) { a.st_lo = s; a.st_hi = s + 1; hipLaunchKernelGGL(mk_fwd, dim3(grid), dim3(NTHR), LDS_BYTES, stream, a); }
#endif
}
```

```cpp
#include <hip/hip_runtime.h>
#include <cstdio>
#include <cstdint>

#define GAS __attribute__((address_space(1)))
#define LAS __attribute__((address_space(3)))
typedef unsigned short bf16;
typedef short bf16x8 __attribute__((ext_vector_type(8)));
typedef short s16x4 __attribute__((ext_vector_type(4)));
typedef float f32x4 __attribute__((ext_vector_type(4)));
typedef float f32x2 __attribute__((ext_vector_type(2)));
typedef unsigned u32x4 __attribute__((ext_vector_type(4)));
typedef unsigned u32x2 __attribute__((ext_vector_type(2)));
typedef GAS unsigned gu32;
#define RLX_AGENT __ATOMIC_RELAXED, __HIP_MEMORY_SCOPE_AGENT
#define DI __device__ __forceinline__

constexpr int S = 8192, D = 2048, DEPTH = 4, NIN = 14408, NINP = 14592, DFF = 5632;
constexpr int NCH = 128;
constexpr float LOG2E = 1.4426950408889634f;

DI float bf2f(unsigned v) { return __uint_as_float(v << 16); }
typedef __bf16 bf16x2_t __attribute__((ext_vector_type(2)));
DI unsigned pk2(float lo, float hi) { const f32x2 v = {lo, hi}; const bf16x2_t b = __builtin_convertvector(v, bf16x2_t); return __builtin_bit_cast(unsigned, b); }
DI unsigned f2bf(float f) { const __bf16 b = (__bf16)f; return (unsigned)__builtin_bit_cast(unsigned short, b); }
DI float fexp_(float x) { return __builtin_amdgcn_exp2f(x * 1.4426950408889634f); }
DI float ftanh_(float x) { return 1.0f - 2.0f * __builtin_amdgcn_rcpf(1.0f + fexp_(2.0f * x)); }
DI float sigmoidf_(float x) { return __builtin_amdgcn_rcpf(1.0f + fexp_(-x)); }
DI float siluf_(float x) { return x * __builtin_amdgcn_rcpf(1.0f + fexp_(-x)); }
DI float softplusf_(float x) { return fmaxf(x, 0.f) + log1pf(fexp_(-fabsf(x))); }
DI u32x4 pack8(const f32x4 a, const f32x4 b) { u32x4 w; w.x = pk2(a[0], a[1]); w.y = pk2(a[2], a[3]); w.z = pk2(b[0], b[1]); w.w = pk2(b[2], b[3]); return w; }
DI void unpack8(const u32x4 w, float (&o)[8]) { o[0] = bf2f(w.x & 0xffffu); o[1] = bf2f(w.x >> 16); o[2] = bf2f(w.y & 0xffffu); o[3] = bf2f(w.y >> 16);
    o[4] = bf2f(w.z & 0xffffu); o[5] = bf2f(w.z >> 16); o[6] = bf2f(w.w & 0xffffu); o[7] = bf2f(w.w >> 16); }

namespace pg8 {
constexpr int BM = 256, BK = 64, HALF = 128, HTB = HALF * BK * 2, STAGE_BYTES = 8 * HTB, NXCD = 8, WGM = 8;
DI int lds_byte(int r, int c) { const int st = (r >> 4) * 2 + (c >> 5), rr = r & 15, cc = c & 31, ob = rr * 64 + cc * 2; return st * 1024 + (ob ^ (((ob >> 9) & 1) << 5)); }
DI void stage_rc(int b, int& R, int& C) { const int st = b / 1024, sb = b % 1024, swz = sb ^ (((sb >> 9) & 1) << 5); R = (st >> 1) * 16 + swz / 64; C = (st & 1) * 32 + (swz % 64) / 2; }
DI int perm32(int rho) { const int n = rho >> 4, i = rho & 15; return 8 * (i >> 2) + 4 * n + (i & 3); }

struct Unit { int pm, pn, ak, brow, sub, ord; };
struct Gemm { const bf16* A; const bf16* Bt; int K, lda, ldb; };

struct StaticOrder {
    int nM, nN, nwg, G, c;
    DI void init(int M, int N, int G_, int c_) { nM = M / BM; nN = N / BM; nwg = nM * nN; G = G_; c = c_; }
    DI bool next(int i, Unit& u) const {
        const long L = (long)i * G + c; if (L >= nwg) return false;
        int wgid = (int)L; { const int q = nwg / NXCD, r = nwg % NXCD, xcd = wgid % NXCD, off = wgid / NXCD; wgid = (xcd < r ? xcd * (q + 1) : r * (q + 1) + (xcd - r) * q) + off; }
        const int nig = WGM * nN, gid = wgid / nig, fm = gid * WGM, gsz = (nM - fm) < WGM ? (nM - fm) : WGM;
        u.pm = fm + ((wgid % nig) % gsz); u.pn = (wgid % nig) / gsz; u.ak = 0; u.brow = u.pn * BM; u.sub = 0; return true;
    }
};
struct LoraOrder {
    StaticOrder so;
    DI void init(int N, int G_, int c_) { so.init(S, N, G_, c_); }
    DI bool next(int i, Unit& u) const { if (!so.next(i, u)) return false; u.ak = (u.pn >= 4) ? 256 : 0; return true; }
};
struct BranchOrder {
    StaticOrder so;
    DI void init(int G_, int c_) { so.init(S, D, G_, c_); }
    DI bool next(int i, Unit& u) const { if (!so.next(i >> 2, u)) return false; u.sub = i & 3; u.ak = u.sub * 512; u.brow = u.sub * D + u.pn * BM; return true; }
};

typedef f32x4 Acc[2][2][4][2];

template <class Epi, class Sched, bool ALIGN_EPI>
DI void gemm_phase(LAS unsigned char* lds, const Gemm g, const Sched& Sc, const Epi& E, const int tid) {
    const int wid = __builtin_amdgcn_readfirstlane(tid >> 6), lane = tid & 63, wr = wid >> 2, wc = wid & 3, fr = lane & 15, fq = lane >> 4;
    const int K = g.K, nt = K / BK;
    unsigned voffA[2], voffB[2];
#pragma unroll
    for (int i = 0; i < 2; ++i) { int R, C; stage_rc(tid * 16 + i * 8192, R, C); const int Rb = (R & ~31) + perm32(R & 31);
        voffA[i] = (unsigned)(R * g.lda + C) * 2u; voffB[i] = (unsigned)(Rb * g.ldb + C) * 2u; }
    const size_t kstep = (size_t)(BK * 2);
    const size_t hA = (size_t)HALF * g.lda * 2, hB = (size_t)HALF * g.ldb * 2;
    const unsigned ldsw = (unsigned)wid * 1024u;
    const int aoff = lds_byte(wr * 64 + fr, fq * 8), boff = lds_byte(wc * 32 + fr, fq * 8);
#define PG8_SA(b, h) (((b) * 2 + (h)) * HTB)
#define PG8_SB(b, h) ((4 + (b) * 2 + (h)) * HTB)
#define PG8_STAGE(bufoff, gbase, voff) do { _Pragma("unroll") for (int _i = 0; _i < 2; ++_i) \
        __builtin_amdgcn_global_load_lds((const unsigned*)((const char*)(gbase) + (voff)[_i]), (LAS unsigned*)(lds + (bufoff) + ldsw + _i * 8192), 16, 0, 0); } while (0)
#define PG8_LDA(dst, b, h) do { _Pragma("unroll") for (int m = 0; m < 4; ++m) _Pragma("unroll") for (int k = 0; k < 2; ++k) dst[m][k] = *(const LAS bf16x8*)(lds + PG8_SA(b, h) + aoff + m * 2048 + k * 1024); } while (0)
#define PG8_LDB(dst, b, h) do { _Pragma("unroll") for (int n = 0; n < 2; ++n) _Pragma("unroll") for (int k = 0; k < 2; ++k) dst[n][k] = *(const LAS bf16x8*)(lds + PG8_SB(b, h) + boff + n * 2048 + k * 1024); } while (0)
#define PG8_MMA(ai, bj, At, Bt) do { __builtin_amdgcn_s_setprio(1); _Pragma("unroll") for (int m = 0; m < 4; ++m) _Pragma("unroll") for (int n = 0; n < 2; ++n) _Pragma("unroll") for (int k = 0; k < 2; ++k) \
        acc[ai][bj][m][n] = __builtin_amdgcn_mfma_f32_16x16x32_bf16(Bt[n][k], At[m][k], acc[ai][bj][m][n], 0, 0, 0); __builtin_amdgcn_s_setprio(0); } while (0)
#define PG8_WAIT_V(n) asm volatile("s_waitcnt vmcnt(" #n ")" ::: "memory")
#define PG8_WAIT_L(n) asm volatile("s_waitcnt lgkmcnt(" #n ")" ::: "memory")
#define PG8_BAR __builtin_amdgcn_s_barrier()
#define PG8_SCHED __builtin_amdgcn_sched_barrier(0)
    Unit cur, nxt; int ui = 0;
    if (!Sc.next(0, cur)) return;
    cur.ord = 0;
    Acc acc;
#pragma unroll
    for (int a = 0; a < 2; ++a)
#pragma unroll
        for (int b = 0; b < 2; ++b)
#pragma unroll
            for (int m = 0; m < 4; ++m)
#pragma unroll
                for (int n = 0; n < 2; ++n) acc[a][b][m][n] = (f32x4){0.f, 0.f, 0.f, 0.f};
    bf16x8 At[4][2], B0[2][2], B1[2][2];
    const char* cA = (const char*)g.A + ((size_t)cur.pm * BM * g.lda + cur.ak) * 2; const char* cB = (const char*)g.Bt + (size_t)cur.brow * g.ldb * 2;
    PG8_STAGE(PG8_SB(0, 0), cB, voffB); PG8_STAGE(PG8_SB(0, 1), cB + hB, voffB); PG8_STAGE(PG8_SA(0, 0), cA, voffA); PG8_STAGE(PG8_SA(0, 1), cA + hA, voffA);
    if (wr == 1) PG8_BAR;
    PG8_WAIT_V(2); PG8_BAR;
    PG8_STAGE(PG8_SB(1, 0), cB + kstep, voffB); PG8_STAGE(PG8_SA(1, 0), cA + kstep, voffA); PG8_STAGE(PG8_SB(1, 1), cB + hB + kstep, voffB);
    PG8_WAIT_V(6); PG8_BAR;
    for (;;) {
        const bool has_next = Sc.next(ui + 1, nxt); nxt.ord = ui + 1;
        const char* nA = has_next ? (const char*)g.A + ((size_t)nxt.pm * BM * g.lda + nxt.ak) * 2 : cA; const char* nB = has_next ? (const char*)g.Bt + (size_t)nxt.brow * g.ldb * 2 : cB;
        for (int t = 0; t < nt; t += 2) {
            const bool last = (t == nt - 2);
            const char* a1 = cA + (size_t)(t + 1) * kstep;
            const char* a2 = last ? nA : cA + (size_t)(t + 2) * kstep; const char* b2 = last ? nB : cB + (size_t)(t + 2) * kstep;
            const char* a3 = a2 + kstep; const char* b3 = b2 + kstep;
            PG8_LDB(B0, 0, 0); PG8_LDB(B1, 0, 1); PG8_SCHED; PG8_LDA(At, 0, 0); PG8_STAGE(PG8_SA(1, 1), a1 + hA, voffA);
            PG8_WAIT_V(8); PG8_WAIT_L(0); PG8_BAR; PG8_MMA(0, 0, At, B0); PG8_MMA(0, 1, At, B1); PG8_BAR; PG8_SCHED;
            PG8_LDA(At, 0, 1); PG8_STAGE(PG8_SB(0, 0), b2, voffB); PG8_STAGE(PG8_SB(0, 1), b2 + hB, voffB); PG8_STAGE(PG8_SA(0, 0), a2, voffA);
            PG8_WAIT_V(8); PG8_WAIT_L(0); PG8_BAR; PG8_MMA(1, 0, At, B0); PG8_MMA(1, 1, At, B1); PG8_BAR; PG8_SCHED;
            PG8_LDB(B0, 1, 0); PG8_LDB(B1, 1, 1); PG8_SCHED; PG8_LDA(At, 1, 0); PG8_STAGE(PG8_SA(0, 1), a2 + hA, voffA);
            PG8_WAIT_V(8); PG8_WAIT_L(0); PG8_BAR; PG8_MMA(0, 0, At, B0); PG8_MMA(0, 1, At, B1); PG8_BAR; PG8_SCHED;
            PG8_LDA(At, 1, 1); PG8_STAGE(PG8_SB(1, 0), b3, voffB); PG8_STAGE(PG8_SB(1, 1), b3 + hB, voffB); PG8_STAGE(PG8_SA(1, 0), a3, voffA);
            PG8_WAIT_V(8); PG8_WAIT_L(0); PG8_BAR; PG8_MMA(1, 0, At, B0); PG8_MMA(1, 1, At, B1); PG8_BAR; PG8_SCHED;
        }
        if constexpr (ALIGN_EPI) { if (wr == 0) PG8_BAR; }
        bool zero = true;
        if constexpr (!Epi::AFTER_DRAIN) { zero = E(acc, cur, wr, wc, fr, fq); }
        if (!has_next) break;
        if (zero) {
#pragma unroll
        for (int a = 0; a < 2; ++a)
#pragma unroll
            for (int b = 0; b < 2; ++b)
#pragma unroll
                for (int m = 0; m < 4; ++m)
#pragma unroll
                    for (int n = 0; n < 2; ++n) acc[a][b][m][n] = (f32x4){0.f, 0.f, 0.f, 0.f};
        }
        cur = nxt; cA = nA; cB = nB; ++ui;
        if constexpr (ALIGN_EPI) { if (wr == 1) PG8_BAR; }
    }
    PG8_WAIT_V(0);
    if constexpr (!ALIGN_EPI) { if (wr == 0) PG8_BAR; }
    PG8_BAR;
    if constexpr (Epi::AFTER_DRAIN) { E.fused(acc, cur, wr, wc, fr, fq, lds, wid, lane, tid); }
#undef PG8_SA
#undef PG8_SB
#undef PG8_STAGE
#undef PG8_LDA
#undef PG8_LDB
#undef PG8_MMA
#undef PG8_WAIT_V
#undef PG8_WAIT_L
#undef PG8_BAR
#undef PG8_SCHED
}
}

constexpr size_t MiB = 1u << 20;
constexpr size_t al256(size_t x) { return (x + 255) & ~(size_t)255; }
constexpr size_t WS_CTL = 0, CTL_ZERO_BYTES = 1 * MiB;
constexpr size_t WS_PRM = 1 * MiB;
constexpr int P_N1 = 0, P_N2 = 2048, P_GN = 4096, P_CW = 4608, P_CB = 8704, P_DTB = 9728, P_ALOG = 9736, P_SD = 9744, P_SNW = 9760, P_QNW = 10272, P_KNW = 10464, P_MU = 10656,
              P_W0 = 12448, P_A0 = 12960, P_V0 = 13472, P_KK = 13984, P_KA = 14496, P_RK = 15008, P_LNW = 15520, P_LNB = 16032, PRM_STRIDE = 16640;
constexpr size_t WS_COSR = 2 * MiB;
constexpr size_t WS_SINR = WS_COSR + (size_t)S * 64 * 4;
constexpr size_t WS_COSM = WS_SINR + (size_t)S * 64 * 4;
constexpr size_t WS_SINM = WS_COSM + (size_t)S * 32 * 4;
constexpr size_t WS_WIN  = WS_SINM + (size_t)S * 32 * 4;
constexpr size_t WS_WQB  = WS_WIN + (size_t)DEPTH * NINP * D * 2;
constexpr size_t WS_WKVB = WS_WQB + (size_t)DEPTH * 1024 * 512 * 2;
constexpr size_t WS_WV1  = WS_WKVB + (size_t)DEPTH * 1024 * 256 * 2;
constexpr size_t WS_WLORA = WS_WV1 + (size_t)DEPTH * 256 * 512 * 2;
constexpr size_t WS_WBR  = WS_WLORA + (size_t)DEPTH * 2048 * 512 * 2;
constexpr size_t WS_WOUT = WS_WBR + (size_t)DEPTH * 8192 * 512 * 2;
constexpr size_t WS_WGU  = WS_WOUT + (size_t)DEPTH * D * D * 2;
constexpr size_t WS_WDN  = WS_WGU + (size_t)DEPTH * 2 * DFF * D * 2;
constexpr size_t WS_ACT0 = WS_WDN + (size_t)DEPTH * D * DFF * 2;
constexpr size_t WS_XN   = WS_ACT0;
constexpr size_t WS_QR   = WS_XN + (size_t)S * D * 2;
constexpr size_t WS_KR   = WS_QR + (size_t)S * 512 * 2;
constexpr size_t WS_VR   = WS_KR + (size_t)S * 512 * 2;
constexpr size_t WS_GR   = WS_VR + (size_t)S * 512 * 2;
constexpr size_t WS_ZS   = WS_GR + (size_t)S * 512 * 2;
constexpr size_t WS_XBC  = WS_ZS + (size_t)S * 512 * 2;
constexpr size_t WS_XC   = WS_XBC + (size_t)S * 1024 * 2;
constexpr size_t WS_CQ   = WS_XC + (size_t)S * 1024 * 2;
constexpr size_t WS_CKV  = WS_CQ + (size_t)S * 512 * 2;
constexpr size_t WS_SSQ  = WS_CKV + (size_t)S * 256 * 2;
constexpr size_t WS_RW   = WS_SSQ + (size_t)S * 16 * 4;
constexpr size_t WS_GATE = WS_RW + (size_t)S * 1792 * 4;
constexpr size_t WS_MISC = WS_GATE + (size_t)S * 8192 * 2;
constexpr size_t WS_DTS  = WS_MISC + (size_t)S * 256 * 4;
constexpr size_t WS_ACS  = WS_DTS + (size_t)S * 8 * 4;
constexpr size_t WS_RKV  = WS_ACS + (size_t)S * 8 * 4;
constexpr size_t WS_MST  = WS_RKV + (size_t)NCH * 4 * 128 * 128 * 4;
constexpr size_t WS_QM   = WS_MST + (size_t)NCH * 8 * 64 * 128 * 4;
constexpr size_t WS_KM   = WS_QM + (size_t)S * 768 * 2;
constexpr size_t WS_VT   = WS_KM + (size_t)S * 768 * 2;
constexpr size_t WS_R32  = WS_VT + (size_t)512 * S * 2;
constexpr size_t SZ32    = (size_t)S * 512 * 4;
constexpr size_t WS_KKN  = WS_R32 + SZ32, WS_K32 = WS_KKN + SZ32, WS_VV = WS_K32 + SZ32, WS_VFIRST = WS_VV + SZ32, WS_DEC = WS_VFIRST + SZ32,
                 WS_KP = WS_DEC + SZ32, WS_BB = WS_KP + SZ32, WS_G32 = WS_BB + SZ32, WS_Y32 = WS_G32 + SZ32;
constexpr size_t WS_VB   = WS_Y32 + SZ32;
constexpr size_t WS_ALORA = WS_VB + (size_t)S * 512 * 2;
constexpr size_t WS_OB   = WS_ALORA + (size_t)S * 512 * 2;
constexpr size_t WS_MERGED = WS_OB + (size_t)S * D * 2;
constexpr size_t WS_ACT  = WS_MERGED + (size_t)S * D * 2;
constexpr size_t WS_END  = WS_ACT + (size_t)S * DFF * 2;

constexpr int CW_TMO = 0, CW_CODE = 1, CW_BAR = 4096;


constexpr int NWAVES = 8, NTHR = 512;
constexpr int RING_BYTES = 143360, LDSCTL_OFF = RING_BYTES, MISC_OFF = LDSCTL_OFF + 320, LDS_BYTES = 147456;
#define LDS_WAIT() asm volatile("s_waitcnt lgkmcnt(0)" ::: "memory")
#define VM_WAIT() asm volatile("s_waitcnt vmcnt(0)" ::: "memory")

#define XB_TMO      128
#define XB_XCNT(j)  (256  + 64 * (j))
#define XB_XSUB(j)  (1280 + 64 * (j))
#define XB_XGEN(j)  (2304 + 64 * (j))
#define XB_TOP      3328
#define XB_TOPGEN   3392
#define XCD_BAR_WORDS 3456
#define XB_SPIN_CAP (1u << 22)
DI unsigned xb_ld(unsigned* p)              { return __hip_atomic_load(p, __ATOMIC_RELAXED, __HIP_MEMORY_SCOPE_AGENT); }
DI unsigned xb_add(unsigned* p, unsigned v) { return __hip_atomic_fetch_add(p, v, __ATOMIC_RELAXED, __HIP_MEMORY_SCOPE_AGENT); }
DI unsigned xb_xcc_id() { return (unsigned)__builtin_amdgcn_s_getreg((3 << 11) | 20) & 0xFu; }
#define XB_SPIN(cond, bar) do { unsigned _sp = 0; while (cond) { __builtin_amdgcn_s_sleep(1); \
    if ((++_sp & 255u) == 0u) { if (xb_ld(&(bar)[XB_TMO])) break; if (_sp > XB_SPIN_CAP) { atomicAdd(&(bar)[XB_TMO], 1u); break; } } } } while (0)
struct XcdBarrier { unsigned* bar; unsigned x; volatile LAS unsigned* st; };
DI XcdBarrier xcd_barrier_post(unsigned* bar, volatile LAS unsigned* st) {
    XcdBarrier b; b.bar = bar; b.x = xb_xcc_id(); b.st = st;
    if (threadIdx.x == 0) (void)xb_add(&bar[XB_XCNT(b.x)], 1u);
    return b;
}
DI void xcd_barrier_complete(unsigned* bar, unsigned x, unsigned& nloc, unsigned& nx) {
    const unsigned G = gridDim.x * gridDim.y * gridDim.z;
    unsigned sum, cnt, mine, sp = 0u;
    for (;;) {
        sum = 0u; cnt = 0u; mine = 0u;
#pragma unroll
        for (unsigned j = 0; j < 16; ++j) { const unsigned c = xb_ld(&bar[XB_XCNT(j)]); sum += c; cnt += (c > 0u) ? 1u : 0u; mine = (j == x) ? c : mine; }
        if (sum == G) break;
        __builtin_amdgcn_s_sleep(1);
        if ((++sp & 255u) == 0u) { if (xb_ld(&bar[XB_TMO])) break; if (sp > XB_SPIN_CAP) { atomicAdd(&bar[XB_TMO], 1u); break; } }
    }
    nloc = mine > 0u ? mine : 1u; nx = cnt > 0u ? cnt : 1u;
}
DI void xcd_barrier(const XcdBarrier& b) {
    asm volatile("s_waitcnt vmcnt(0)" ::: "memory");
    __syncthreads();
    if (threadIdx.x == 0) {
        unsigned* bar = b.bar;
        __builtin_amdgcn_s_waitcnt(0);
        unsigned nloc = b.st[0], nx = b.st[1];
        if (nloc == 0u) { xcd_barrier_complete(bar, b.x, nloc, nx); b.st[0] = nloc; b.st[1] = nx; }
        const unsigned old = xb_add(&bar[XB_XSUB(b.x)], 1u);
        const unsigned gen = old / nloc;
        if (old + 1u == (gen + 1u) * nloc) {
            __builtin_amdgcn_fence(__ATOMIC_RELEASE, "agent");
            asm volatile("s_waitcnt vmcnt(0)" ::: "memory");
            const unsigned og = xb_add(&bar[XB_TOP], 1u);
            const unsigned tg = og / nx;
            if (og + 1u == (tg + 1u) * nx) xb_add(&bar[XB_TOPGEN], 1u);
            else XB_SPIN(xb_ld(&bar[XB_TOPGEN]) == tg, bar);
            __builtin_amdgcn_fence(__ATOMIC_ACQUIRE, "agent");
            xb_add(&bar[XB_XGEN(b.x)], 1u);
            asm volatile("s_waitcnt vmcnt(0)" ::: "memory");
        } else {
            XB_SPIN(xb_ld(&bar[XB_XGEN(b.x)]) == gen, bar);
            __builtin_amdgcn_fence(__ATOMIC_ACQUIRE, "agent");
            asm volatile("s_waitcnt vmcnt(0)" ::: "memory");
        }
    }
    __syncthreads();
}

struct Args { const float* in[36]; float* out; unsigned char* ws; int st_lo, st_hi; };
struct Frame {
    LAS unsigned char* lds; volatile LAS unsigned* MISC; gu32* ctl;
    int tid, lane, wave, G, bid;
    unsigned char* ws;
};
DI void relaunder(Frame& F, unsigned char* ws0, LAS unsigned char* lds0) {
    int t = threadIdx.x; asm volatile("" : "+v"(t)); F.tid = t; F.lane = t & 63; F.wave = __builtin_amdgcn_readfirstlane(t >> 6);
    unsigned long long w = (unsigned long long)ws0; asm volatile("" : "+s"(w)); F.ws = (unsigned char*)w; F.ctl = (gu32*)(F.ws + WS_CTL);
    unsigned lb = (unsigned)(unsigned long)lds0; asm volatile("" : "+s"(lb)); F.lds = (LAS unsigned char*)(unsigned long)lb; F.MISC = (volatile LAS unsigned*)(F.lds + MISC_OFF);
    int b = blockIdx.x; asm volatile("" : "+s"(b)); F.bid = b;
}
#define XR_SWAP(INS, a, b) asm volatile("s_nop 1\n\t" INS " %0, %1" : "+v"(a), "+v"(b))
DI float xr16_max(float x) { float a = x, b = x; XR_SWAP("v_permlane16_swap_b32", a, b); return fmaxf(a, b); }
DI float xr32_max(float x) { float a = x, b = x; XR_SWAP("v_permlane32_swap_b32", a, b); return fmaxf(a, b); }
DI float xr16_sum(float x) { float a = x, b = x; XR_SWAP("v_permlane16_swap_b32", a, b); return a + b; }
DI float xr32_sum(float x) { float a = x, b = x; XR_SWAP("v_permlane32_swap_b32", a, b); return a + b; }
template <int CTRL> DI float dpp_f(float v) { return __builtin_bit_cast(float, __builtin_amdgcn_update_dpp(0, __builtin_bit_cast(int, v), CTRL, 0xf, 0xf, true)); }
DI float row_sum16(float v) { v += dpp_f<0xB1>(v); v += dpp_f<0x4E>(v); v += dpp_f<0x141>(v); v += dpp_f<0x140>(v); return v; }
DI float wave_sum(float v) { return xr32_sum(xr16_sum(row_sum16(v))); }
DI float wave_sum_dpp(float v) {
    const float t = row_sum16(v);
    const float s0 = __builtin_bit_cast(float, __builtin_amdgcn_readlane(__builtin_bit_cast(int, t), 0));
    const float s1 = __builtin_bit_cast(float, __builtin_amdgcn_readlane(__builtin_bit_cast(int, t), 16));
    const float s2 = __builtin_bit_cast(float, __builtin_amdgcn_readlane(__builtin_bit_cast(int, t), 32));
    const float s3 = __builtin_bit_cast(float, __builtin_amdgcn_readlane(__builtin_bit_cast(int, t), 48));
    return (s0 + s1) + (s2 + s3);
}
constexpr size_t WS_QYT = WS_END;
constexpr size_t WS_CYT = WS_QYT + (size_t)1024 * 4096 * 2;
constexpr size_t WS_TST = WS_CYT + (size_t)1024 * 4096 * 2;
constexpr size_t WS_NST = WS_TST + (size_t)1024 * 4096 * 2;
constexpr size_t WS_S0  = WS_NST + (size_t)1024 * 4096 * 4;
constexpr size_t WS_END2 = WS_S0 + (size_t)1024 * 4096 * 2;
constexpr int ATT_NSUB = 576, ATT_RUN = 16;
constexpr size_t WS_ATAB = WS_END2;
constexpr size_t WS_APO  = WS_ATAB + 8192;
constexpr size_t WS_APM  = WS_APO + (size_t)ATT_NSUB * 32768 * 4;
constexpr size_t WS_RSSA = WS_APM + (size_t)ATT_NSUB * 512 * 4;
constexpr size_t WS_RSSB = WS_RSSA + (size_t)S * 32 * 4;
constexpr size_t WS_END3 = WS_RSSB + (size_t)S * 32 * 4;
constexpr int RTAB_OFF = 131072;
DI int att_slot(int h, int qb, int s) { const int g = qb >> 2; return h * 144 + (g + 1) * (qb - 2 * g) + s; }

DI int map_in(int n) {
    const int T = n >> 8, c = n & 255;
    if (T < 4) { const int base = (T >> 1) * 512, tp = T & 1, half = c >> 7, hs = (c >> 6) & 1, j = c & 63; return base + (2 * tp + hs) * 128 + half * 64 + j; }
    if (T < 6) return 1024 + (T - 4) * 256 + c;
    if (T < 8) return 1536 + (T - 6) * 256 + c;
    if (T < 10) return 2048 + (T - 8) * 256 + c;
    if (T < 14) return 2560 + (T - 10) * 256 + c;
    if (T < 16) return 3592 + (T - 14) * 256 + c;
    if (T == 16) return 4104 + c;
    if (T < 24) return 4424 + (T - 17) * 256 + c;
    if (T < 56) return 6216 + (T - 24) * 256 + c;
    if (c < 8) return 3584 + c;
    if (c < 72) return 4360 + (c - 8);
    return -1;
}
DI int map_fn(int mapid, int n, int Nsrc) {
    if (mapid == 0) return n < Nsrc ? n : -1;
    if (mapid == 1) return map_in(n);
    if (mapid == 2) { const int T = n >> 8, c = n & 255; return c < 128 ? T * 128 + c : DFF + T * 128 + (c - 128); }
    if (mapid == 3) { const int h = n >> 8, c = n & 255; if (c < 96) return h * 192 + c; if (c < 128) return h * 192 + 128 + (c - 96); if (c < 160) return h * 192 + 96 + (c - 128); if (c < 224) return -1; return h * 192 + 160 + (c - 224); }
    return n < 32 ? n : -1;
}
DI void conv_item(const float* W, int K, int Nsrc, bf16* Wt, const float* kscale, int mapid, LAS bf16* tile, int item, int nblk, int lane) {
    const int kb = item / nblk, nb = item - kb * nblk, k0 = 64 * kb, n0 = 64 * nb;
    const int src = map_fn(mapid, n0 + lane, Nsrc);
    const float* wp = W + (size_t)k0 * Nsrc + (src >= 0 ? src : 0);
    float v[64];
#pragma unroll
    for (int i = 0; i < 64; ++i) v[i] = wp[(size_t)i * Nsrc];
    if (src < 0) {
#pragma unroll
        for (int i = 0; i < 64; ++i) v[i] = 0.f; }
    if (kscale) {
#pragma unroll
        for (int i = 0; i < 64; ++i) v[i] *= kscale[k0 + i]; }
#pragma unroll
    for (int q = 0; q < 8; ++q) { u32x4 o; o.x = pk2(v[8 * q], v[8 * q + 1]); o.y = pk2(v[8 * q + 2], v[8 * q + 3]); o.z = pk2(v[8 * q + 4], v[8 * q + 5]); o.w = pk2(v[8 * q + 6], v[8 * q + 7]);
        *(LAS u32x4*)(tile + lane * 72 + 8 * q) = o; }
    LDS_WAIT(); asm volatile("" ::: "memory");
#pragma unroll
    for (int i = 0; i < 8; ++i) { const int r = i * 8 + (lane >> 3), c8 = lane & 7;
        *(GAS u32x4*)(Wt + (size_t)(n0 + r) * K + k0 + 8 * c8) = *(const LAS u32x4*)(tile + r * 72 + 8 * c8); }
    LDS_WAIT(); asm volatile("" ::: "memory");
}
struct ConvJob { const float* W; bf16* Wt; const float* kscale; int K, Nsrc, Ndst, mapid; };
DI void conv_job(Frame& F, const ConvJob j, int& base) {
    const int nblk = j.Ndst / 64, nitems = (j.K / 64) * nblk, NGW = F.G * NWAVES, gw = F.bid * NWAVES + F.wave;
    int first = (gw - base % NGW + NGW) % NGW; LAS bf16* tile = (LAS bf16*)(F.lds + F.wave * 16384);
    for (int it = first; it < nitems; it += NGW) conv_item(j.W, j.K, j.Nsrc, j.Wt, j.kscale, j.mapid, tile, it, nblk, F.lane);
    base += nitems;
}
DI void p_prologue(Frame& F, const Args& a) {
    unsigned char* ws = F.ws;
    const int gt = F.bid * NTHR + F.tid, NGT = F.G * NTHR;
    if (F.bid == 0 && F.tid == 0) { int* tab = (int*)(ws + WS_ATAB); int n = 0;
        for (int pass = 16; pass >= 4; pass -= 4)
            for (int qb = 31; qb >= 0; --qb) { const int nt = 4 * (qb + 1), nfull = nt >> 4, rem = nt & 15;
                for (int h = 0; h < 4; ++h) {
                    if (pass == 16) { for (int s2 = 0; s2 < nfull; ++s2) tab[n++] = h | (qb << 2) | (s2 << 7) | (16 << 12); }
                    else if (rem == pass) tab[n++] = h | (qb << 2) | (nfull << 7) | (rem << 12); } }
        for (; n < 2048; ++n) tab[n] = 0; }
    { float* prm = (float*)(ws + WS_PRM);
#define CPV(IDX, N, OFF, SRC_L) for (int e = gt; e < (N); e += NGT) prm[(size_t)l * PRM_STRIDE + (OFF) + e] = a.in[IDX][(size_t)(SRC_L) * (N) + e];
      for (int l = 0; l < DEPTH; ++l) {
          CPV(2, 2048, P_N1, l) CPV(33, 2048, P_N2, l) CPV(4, 512, P_GN, l) CPV(5, 4096, P_CW, l) CPV(6, 1024, P_CB, l) CPV(7, 8, P_DTB, l) CPV(8, 8, P_ALOG, l) CPV(9, 8, P_SD, l)
          CPV(10, 512, P_SNW, l) CPV(15, 192, P_QNW, l) CPV(16, 192, P_KNW, l) CPV(17, 1792, P_MU, l) CPV(18, 512, P_W0, l) CPV(20, 512, P_A0, l)
          CPV(23, 512, P_V0, (l > 0 ? l - 1 : 0)) CPV(26, 512, P_KK, l) CPV(27, 512, P_KA, l) CPV(28, 512, P_RK, l) CPV(29, 512, P_LNW, l) CPV(30, 512, P_LNB, l)
      }
#undef CPV
    }
    const int* pos = (const int*)a.in[1];
    for (int e = gt; e < S * 64; e += NGT) { const int t = e >> 6, i = e & 63;
        const float inv = 1.0f / powf(10000.0f, (float)(2 * i) / 128.0f); const float ang = (float)pos[t] * inv;
        double rev = (double)ang * 0.15915494309189535; rev -= rint(rev); const float r = (float)(rev * 6.283185307179586);
        ((float*)(ws + WS_COSR))[e] = __cosf(r); ((float*)(ws + WS_SINR))[e] = __sinf(r); }
    for (int e = gt; e < S * 32; e += NGT) { const int t = e >> 5, i = e & 31;
        const float inv = 1.0f / powf(10000.0f, (float)(2 * i) / 64.0f); const float ang = (float)pos[t] * inv;
        double rev = (double)ang * 0.15915494309189535; rev -= rint(rev); const float r = (float)(rev * 6.283185307179586);
        ((float*)(ws + WS_COSM))[e] = __cosf(r); ((float*)(ws + WS_SINM))[e] = __sinf(r); }
    for (int l = 0; l < DEPTH; ++l) {
        const float* w2 = a.in[19] + (size_t)l * 64 * 512; const float* a2 = a.in[21] + (size_t)l * 64 * 512; const float* g2 = a.in[22] + (size_t)l * 128 * 512;
        const float* v2 = a.in[25] + (size_t)(l > 0 ? l - 1 : 0) * 32 * 512;
        bf16* Lt = (bf16*)(ws + WS_WLORA) + (size_t)l * 2048 * 512;
        for (int w = gt; w < 2048 * 64; w += NGT) { const int kg = w >> 11, n = w & 2047, seg = n >> 9, j = n & 511; float v[8];
#pragma unroll
            for (int i = 0; i < 8; ++i) { const int k = kg * 8 + i; float x = 0.f;
                if (seg == 0) { if (k < 64) x = w2[k * 512 + j]; }
                else if (seg == 1) { if (k >= 128 && k < 192) x = a2[(k - 128) * 512 + j]; }
                else if (seg == 2) { if (k >= 256 && k < 384) x = g2[(k - 256) * 512 + j]; }
                else { if (l > 0 && k >= 384 && k < 416) x = v2[(k - 384) * 512 + j]; }
                v[i] = x; }
            u32x4 o; o.x = pk2(v[0], v[1]); o.y = pk2(v[2], v[3]); o.z = pk2(v[4], v[5]); o.w = pk2(v[6], v[7]);
            *(GAS u32x4*)(Lt + (size_t)n * 512 + kg * 8) = o; }
    }
    { const int gw = F.bid * NWAVES + F.wave, NGW = F.G * NWAVES; float* rss = (float*)(ws + WS_RSSA);
      for (int m = gw; m < S; m += NGW) { const GAS f32x4* xr = (const GAS f32x4*)(a.in[0] + (size_t)m * D) + F.lane; GAS u32x2* o8 = (GAS u32x2*)((bf16*)(ws + WS_XN) + (size_t)m * D) + F.lane; float sq = 0.f;
#pragma unroll
          for (int j = 0; j < 8; ++j) { const f32x4 v = xr[64 * j]; sq += (v.x * v.x + v.y * v.y) + (v.z * v.z + v.w * v.w); u32x2 o; o.x = pk2(v.x, v.y); o.y = pk2(v.z, v.w); o8[64 * j] = o; }
          sq = wave_sum(sq); if (F.lane < 32) rss[(size_t)m * 32 + F.lane] = (F.lane == 0) ? sq : 0.f; } }
    int base = 0;
    for (int l = 0; l < DEPTH; ++l) {
        conv_job(F, ConvJob{a.in[3] + (size_t)l * D * NIN, (bf16*)(ws + WS_WIN) + (size_t)l * NINP * D, a.in[2] + (size_t)l * D, D, NIN, NINP, 1}, base);
        conv_job(F, ConvJob{a.in[34] + (size_t)l * D * 2 * DFF, (bf16*)(ws + WS_WGU) + (size_t)l * 2 * DFF * D, a.in[33] + (size_t)l * D, D, 2 * DFF, 2 * DFF, 2}, base);
        conv_job(F, ConvJob{a.in[35] + (size_t)l * DFF * D, (bf16*)(ws + WS_WDN) + (size_t)l * D * DFF, nullptr, DFF, D, D, 0}, base);
        conv_job(F, ConvJob{a.in[32] + (size_t)l * D * D, (bf16*)(ws + WS_WOUT) + (size_t)l * D * D, nullptr, D, D, D, 0}, base);
        for (int n = 0; n < 4; ++n)
            conv_job(F, ConvJob{a.in[31] + ((size_t)l * 4 + n) * 512 * D, (bf16*)(ws + WS_WBR) + ((size_t)l * 4 + n) * D * 512, nullptr, 512, D, D, 0}, base);
        conv_job(F, ConvJob{a.in[12] + (size_t)l * 512 * 768, (bf16*)(ws + WS_WQB) + (size_t)l * 1024 * 512, a.in[11] + (size_t)l * 512, 512, 768, 1024, 3}, base);
        conv_job(F, ConvJob{a.in[14] + (size_t)l * 256 * 1024, (bf16*)(ws + WS_WKVB) + (size_t)l * 1024 * 256, a.in[13] + (size_t)l * 256, 256, 1024, 1024, 0}, base);
        if (l > 0) conv_job(F, ConvJob{a.in[24] + (size_t)(l - 1) * 512 * 32, (bf16*)(ws + WS_WV1) + (size_t)l * 256 * 512, nullptr, 512, 32, 256, 4}, base);
    }
}

DI void p_rmsnorm(Frame& F, const float* x, const float* w, bf16* out) {
    const int gw = F.bid * NWAVES + F.wave, NGW = F.G * NWAVES;
    for (int m = gw; m < S; m += NGW) {
        const GAS f32x4* xr = (const GAS f32x4*)(x + (size_t)m * D) + F.lane; f32x4 v[8]; float s = 0.f;
#pragma unroll
        for (int j = 0; j < 8; ++j) { v[j] = xr[64 * j]; s += (v[j].x * v[j].x + v[j].y * v[j].y) + (v[j].z * v[j].z + v[j].w * v[j].w); }
        const float rstd = rsqrtf(wave_sum(s) * (1.f / D) + 1e-6f);
        const GAS f32x4* wr = (const GAS f32x4*)w + F.lane;
        GAS u32x2* o8 = (GAS u32x2*)(out + (size_t)m * D) + F.lane;
#pragma unroll
        for (int j = 0; j < 8; ++j) { const f32x4 ww = wr[64 * j]; u32x2 o; o.x = pk2(v[j].x * rstd * ww.x, v[j].y * rstd * ww.y); o.y = pk2(v[j].z * rstd * ww.z, v[j].w * rstd * ww.w); o8[64 * j] = o; }
    }
}

DI f32x4 bf4_(const u32x2 w) { return (f32x4){bf2f(w.x & 0xffffu), bf2f(w.x >> 16), bf2f(w.y & 0xffffu), bf2f(w.y >> 16)}; }
DI u32x2 pk4_(const f32x4 v) { u32x2 o; o.x = pk2(v.x, v.y); o.y = pk2(v.z, v.w); return o; }
DI void p_rwkv_prep(Frame& F, int l) {
    unsigned char* ws = F.ws;
    const bf16* RW = (const bf16*)(ws + WS_RW); const float* prm = (const float*)(ws + WS_PRM) + (size_t)l * PRM_STRIDE; const float* mu = prm + P_MU; const float* kk_w = prm + P_KK;
    const int gw = F.bid * NWAVES + F.wave, NGW = F.G * NWAVES, lane = F.lane;
    for (int t = gw; t < S; t += NGW) {
        const GAS u32x2* p = (const GAS u32x2*)(RW + (size_t)t * 1792) + lane; const GAS u32x2* pp = (const GAS u32x2*)(RW + (size_t)(t > 0 ? t - 1 : 0) * 1792) + lane;
        const GAS f32x4* m4 = (const GAS f32x4*)mu + lane;
        f32x4 pm[7];
#pragma unroll
        for (int j = 0; j < 7; ++j) { const f32x4 c = bf4_(p[64 * j]); f32x4 pv = bf4_(pp[64 * j]); if (t == 0) pv = (f32x4){0.f, 0.f, 0.f, 0.f}; pm[j] = c + (pv - c) * m4[64 * j]; }
        const size_t ro = (size_t)t * 512;
        *((GAS u32x2*)((bf16*)(ws + WS_R32) + ro) + lane) = pk4_(pm[0]); *((GAS u32x2*)((bf16*)(ws + WS_R32) + ro) + 64 + lane) = pk4_(pm[1]);
#pragma unroll
        for (int j = 0; j < 2; ++j) { const f32x4 k = pm[2 + j]; const f32x4 kw = *((const GAS f32x4*)kk_w + 64 * j + lane); const f32x4 kk = k * kw;
            float ss = (kk.x * kk.x + kk.y * kk.y) + (kk.z * kk.z + kk.w * kk.w);
            ss = row_sum16(ss);
            const float inv = fminf(__builtin_amdgcn_rsqf(ss), 1e12f);
            *((GAS u32x2*)((bf16*)(ws + WS_K32) + ro) + 64 * j + lane) = pk4_(k);
            *((GAS u32x2*)((bf16*)(ws + WS_KKN) + ro) + 64 * j + lane) = pk4_(kk * inv); }
#pragma unroll
        for (int j = 0; j < 2; ++j) { const u32x2 vb = pk4_(pm[4 + j]);
            *((GAS u32x2*)((bf16*)(ws + WS_VV) + ro) + 64 * j + lane) = vb;
            if (l == 0) *((GAS u32x2*)((bf16*)(ws + WS_VFIRST) + ro) + 64 * j + lane) = vb; }
        { const f32x4 x = pm[6]; f32x4 y; int dst;
            if (lane < 16) { y = (f32x4){ftanh_(x.x), ftanh_(x.y), ftanh_(x.z), ftanh_(x.w)}; dst = 4 * lane; }
            else if (lane < 32) { y = x; dst = 128 + 4 * (lane - 16); }
            else { y = (f32x4){sigmoidf_(x.x), sigmoidf_(x.y), sigmoidf_(x.z), sigmoidf_(x.w)}; dst = 256 + 4 * (lane - 32); }
            bf16* ar = (bf16*)(ws + WS_ALORA) + (size_t)t * 512;
            *(GAS u32x2*)(ar + dst) = pk4_(y);
            const int z = 4 * lane; const int zd = z < 64 ? 64 + z : (z < 128 ? 192 + (z - 64) : 384 + (z - 128));
            unsigned zz = 0u; asm volatile("" : "+v"(zz));
            *(GAS u32x2*)(ar + zd) = (u32x2){zz, zz}; }
    }
}

DI void p_mamba_prep(Frame& F, int l) {
    unsigned char* ws = F.ws;
    const bf16* XBC = (const bf16*)(ws + WS_XBC); bf16* XC = (bf16*)(ws + WS_XC);
    const float* prm = (const float*)(ws + WS_PRM) + (size_t)l * PRM_STRIDE; const float* cw = prm + P_CW; const float* cb = prm + P_CB;
    for (int u = F.bid; u < 2 * NCH; u += F.G) {
        const int c = u >> 1, ch = (u & 1) * 512 + F.tid; const int t0 = c * 64;
        float w0[4];
#pragma unroll
        for (int k = 0; k < 4; ++k) w0[k] = cw[k * 1024 + ch];
        const float b0 = cb[ch];
        float h0[3];
#pragma unroll
        for (int k = 0; k < 3; ++k) { const int t = t0 - 3 + k; h0[k] = (t >= 0) ? bf2f(XBC[(size_t)t * 1024 + ch]) : 0.f; }
#pragma unroll 16
        for (int i = 0; i < 64; ++i) { const int t = t0 + i; const float x0 = bf2f(XBC[(size_t)t * 1024 + ch]);
            const float y0 = b0 + w0[0] * h0[0] + w0[1] * h0[1] + w0[2] * h0[2] + w0[3] * x0;
            h0[0] = h0[1]; h0[1] = h0[2]; h0[2] = x0;
            XC[(size_t)t * 1024 + ch] = (bf16)f2bf(siluf_(y0)); }
    }
}
DI void u_mamba_dt(Frame& F, int l, int c) {
    unsigned char* ws = F.ws; LAS float* A = (LAS float*)F.lds;
    const float* prm = (const float*)(ws + WS_PRM) + (size_t)l * PRM_STRIDE; const int t = F.tid >> 3, h = F.tid & 7; const size_t row = (size_t)(c * 64 + t);
    const float dt = softplusf_(((const float*)(ws + WS_MISC))[row * 256 + h] + prm[P_DTB + h]);
    A[F.tid] = dt * -fexp_(prm[P_ALOG + h]);
    ((float*)(ws + WS_DTS))[row * 8 + h] = dt;
    __syncthreads();
    float cs = 0.f;
#pragma unroll 16
    for (int tt = 0; tt < 64; ++tt) { const float v = A[tt * 8 + h]; cs += (tt <= t) ? v : 0.f; }
    ((float*)(ws + WS_ACS))[row * 8 + h] = cs;
    __syncthreads();
}

DI void p_scans(Frame& F, int nblk) {
    unsigned char* ws = F.ws;
    const int gt = F.bid * NTHR + F.tid, NGT = nblk * NTHR;
    for (int q = gt; q < 32768; q += NGT) {
        const int e = q * 4; const bool ret = e < 65536; const int e2 = ret ? e : e - 65536, h = ret ? (e >> 14) : (e2 >> 13);
        float* p = (float*)(ws + (ret ? WS_RKV : WS_MST)) + e2; const float* acs = (const float*)(ws + WS_ACS);
        const float rdec = fexp_(log1pf(-exp2f(-5.0f - (float)h)) * 64.0f);
        f32x4 st = (f32x4){0.f, 0.f, 0.f, 0.f};
#pragma unroll 1
        for (int c0 = 0; c0 < NCH; c0 += 16) { f32x4 v[16]; float dc[16];
#pragma unroll
            for (int i = 0; i < 16; ++i) v[i] = *(const GAS f32x4*)(p + (size_t)(c0 + i) * 65536);
#pragma unroll
            for (int i = 0; i < 16; ++i) dc[i] = ret ? rdec : fexp_(acs[(size_t)((c0 + i) * 64 + 63) * 8 + h]);
#pragma unroll
            for (int i = 0; i < 16; ++i) { *(GAS f32x4*)(p + (size_t)(c0 + i) * 65536) = st; st = st * dc[i] + v[i]; } }
    }
}


namespace pg8 {
DI unsigned char* lw(unsigned char* p) { unsigned long long w = (unsigned long long)p; asm volatile("" : "+s"(w)); return (unsigned char*)w; }
DI void st8bf(bf16* p, const f32x4 a, const f32x4 b) { *(GAS u32x4*)p = pack8(a, b); }
DI void st8f(float* p, const f32x4 a, const f32x4 b) { *(GAS f32x4*)p = a; *((GAS f32x4*)p + 1) = b; }
DI f32x4 map4(const f32x4 v, float (*f)(float)) { return (f32x4){f(v.x), f(v.y), f(v.z), f(v.w)}; }

DI void scale_rows(Acc& acc, const LAS float* rt, int rl0) {
#pragma unroll
    for (int ai = 0; ai < 2; ++ai)
#pragma unroll
        for (int m = 0; m < 4; ++m) { const float rs = rt[rl0 + ai * HALF + m * 16];
#pragma unroll
            for (int bj = 0; bj < 2; ++bj)
#pragma unroll
                for (int n = 0; n < 2; ++n) acc[ai][bj][m][n] = acc[ai][bj][m][n] * rs; }
}
template <class Sched> DI void fill_rstd(LAS float* rtab, const float* rss, const Sched& Sc, int tid) {
    pg8::Unit u;
    for (int i = 0; Sc.next(i, u); ++i) if (tid < 256) { const float* p = rss + (size_t)(u.pm * BM + tid) * 32; float s = 0.f;
#pragma unroll
        for (int q = 0; q < 8; ++q) { const f32x4 v = *(const GAS f32x4*)(p + 4 * q); s += (v.x + v.y) + (v.z + v.w); }
        rtab[i * 256 + tid] = rsqrtf(s * (1.f / D) + 1e-6f); }
    __syncthreads();
}
struct TileDesc { unsigned long long off; int ld, cb, kind, slot; };
constexpr TileDesc mk_tile(int T) {
    return T < 2 ? TileDesc{WS_QR, 512, 0, 0, 0} : T < 4 ? TileDesc{WS_KR, 512, 0, 1, 0}
         : T < 6 ? TileDesc{WS_VR, 512, (T - 4) * 256, 2, 0} : T < 8 ? TileDesc{WS_GR, 512, (T - 6) * 256, 3, 0} : T < 10 ? TileDesc{WS_ZS, 512, (T - 8) * 256, 3, 0}
         : T < 14 ? TileDesc{WS_XBC, 1024, (T - 10) * 256, 2, 0} : T < 16 ? TileDesc{WS_CQ, 512, (T - 14) * 256, 5, (T - 14) * 4} : T == 16 ? TileDesc{WS_CKV, 256, 0, 5, 8}
         : T < 24 ? TileDesc{WS_RW, 1792, (T - 17) * 256, 2, 0} : T < 56 ? TileDesc{WS_GATE, 8192, (T - 24) * 256, 4, 0} : TileDesc{WS_MISC, 256, 0, 6, 0};
}
struct TileTab { TileDesc d[57]; };
constexpr TileTab mk_tiletab() { TileTab t{}; for (int i = 0; i < 57; ++i) t.d[i] = mk_tile(i); return t; }
__constant__ TileTab g_tiletab = mk_tiletab();

struct EpiIn {
    static constexpr bool AFTER_DRAIN = false;
    unsigned char* ws_; int tile_off; const LAS float* rtab;
    DI bool operator()(Acc& acc, const Unit& u, int wr, int wc, int fr, int fq) const {
        unsigned char* ws = lw(ws_);
        const int T = u.pn + tile_off, row0 = u.pm * BM + wr * 64 + fr, c0 = wc * 32 + fq * 8;
        scale_rows(acc, rtab + u.ord * 256, wr * 64 + fr);
        const TileDesc d = g_tiletab.d[T]; const int kind = d.kind;
        if (kind < 2) {
            const int head = 2 * (T & 1) + (c0 >> 6), j0 = c0 & 63; const float sc = kind ? 0.08838834764831845f : 1.0f;
            bf16* dst = (bf16*)(ws + d.off); const float* cs = (const float*)(ws + WS_COSR); const float* sn = (const float*)(ws + WS_SINR);
#pragma unroll
            for (int ai = 0; ai < 2; ++ai)
#pragma unroll
                for (int m = 0; m < 4; ++m) { const int row = row0 + ai * HALF + m * 16;
                    const f32x4 ca = *(const GAS f32x4*)(cs + (size_t)row * 64 + j0), cb = *(const GAS f32x4*)(cs + (size_t)row * 64 + j0 + 4);
                    const f32x4 sa = *(const GAS f32x4*)(sn + (size_t)row * 64 + j0), sb = *(const GAS f32x4*)(sn + (size_t)row * 64 + j0 + 4);
                    const f32x4 x1a = acc[ai][0][m][0], x1b = acc[ai][0][m][1], x2a = acc[ai][1][m][0], x2b = acc[ai][1][m][1];
                    bf16* o = dst + (size_t)row * 512 + head * 128 + j0;
                    st8bf(o, (x1a * ca - x2a * sa) * sc, (x1b * cb - x2b * sb) * sc);
                    st8bf(o + 64, (x2a * ca + x1a * sa) * sc, (x2b * cb + x1b * sb) * sc); }
            return true;
        }
        if (kind == 6) {
            float* dst = (float*)(ws + d.off) + d.cb + c0;
#pragma unroll
            for (int ai = 0; ai < 2; ++ai)
#pragma unroll
                for (int m = 0; m < 4; ++m) { const int row = row0 + ai * HALF + m * 16;
#pragma unroll
                    for (int bj = 0; bj < 2; ++bj) st8f(dst + (size_t)row * d.ld + bj * HALF, acc[ai][bj][m][0], acc[ai][bj][m][1]); }
            return true;
        }
        {
            bf16* dst = (bf16*)(ws + d.off) + d.cb + c0; float* ssq = (float*)(ws + WS_SSQ) + d.slot + wc;
            const float am = (kind == 3 || kind == 4) ? 1.f : 0.f, xm = (kind == 4) ? 0.f : 1.f;
#pragma unroll
            for (int ai = 0; ai < 2; ++ai)
#pragma unroll
                for (int m = 0; m < 4; ++m) { const int row = row0 + ai * HALF + m * 16; float ss = 0.f;
#pragma unroll
                    for (int bj = 0; bj < 2; ++bj) { f32x4 a = acc[ai][bj][m][0], b = acc[ai][bj][m][1];
                        ss += (a.x * a.x + a.y * a.y) + (a.z * a.z + a.w * a.w) + (b.x * b.x + b.y * b.y) + (b.z * b.z + b.w * b.w);
                        if (am != 0.f) {
#pragma unroll
                            for (int i = 0; i < 4; ++i) { const float s0 = sigmoidf_(a[i]), s1 = sigmoidf_(b[i]); a[i] = (xm != 0.f) ? a[i] * s0 : s0; b[i] = (xm != 0.f) ? b[i] * s1 : s1; } }
                        st8bf(dst + (size_t)row * d.ld + bj * HALF, a, b); }
                    if (kind == 5) { ss = xr32_sum(xr16_sum(ss)); if (fq == 0) ssq[(size_t)row * 16] = ss; } }
        }
        return true;
    }
};

struct EpiMisc {
    static constexpr bool AFTER_DRAIN = false;
    unsigned char* ws_; const LAS float* rtab;
    DI bool operator()(Acc& acc, const Unit& u, int wr, int wc, int fr, int fq) const {
        float* dst = (float*)(lw(ws_) + WS_MISC) + wc * 32 + fq * 8; const int row0 = u.pm * BM + wr * 64 + fr;
        scale_rows(acc, rtab + u.ord * 256, wr * 64 + fr);
#pragma unroll
        for (int ai = 0; ai < 2; ++ai)
#pragma unroll
            for (int m = 0; m < 4; ++m) { const int row = row0 + ai * HALF + m * 16;
#pragma unroll
                for (int bj = 0; bj < 2; ++bj) st8f(dst + (size_t)row * 256 + bj * HALF, acc[ai][bj][m][0], acc[ai][bj][m][1]); }
        return true;
    }
};

struct EpiQb {
    static constexpr bool AFTER_DRAIN = true;
    unsigned char* ws; const float* qnw;
    DI bool operator()(Acc&, const Unit&, int, int, int, int) const { return true; }
    DI void fused(Acc& acc, const Unit& u, int wr, int wc, int fr, int fq, LAS unsigned char* lds, int wid, int lane, int tid) const {
        const int h = u.pn, row0 = u.pm * BM + wr * 64 + fr, c0 = wc * 32 + fq * 8;
        const float* ssq = (const float*)(ws + WS_SSQ); LAS float* P = (LAS float*)lds;
        const float QS = 0.07216878364870322f * LOG2E;
#pragma unroll
        for (int ai = 0; ai < 2; ++ai)
#pragma unroll
            for (int m = 0; m < 4; ++m) { const int row = row0 + ai * HALF + m * 16, rl = ai * HALF + wr * 64 + m * 16 + fr;
                const f32x4 s0 = *(const GAS f32x4*)(ssq + (size_t)row * 16), s1 = *(const GAS f32x4*)(ssq + (size_t)row * 16 + 4);
                const float rs = rsqrtf(((s0.x + s0.y) + (s0.z + s0.w) + (s1.x + s1.y) + (s1.z + s1.w)) * (1.f / 512.f) + 1e-6f);
                float ss = 0.f;
#pragma unroll
                for (int bj = 0; bj < 2; ++bj)
#pragma unroll
                    for (int n = 0; n < 2; ++n) { f32x4 a = acc[ai][bj][m][n] * rs; acc[ai][bj][m][n] = a; ss += (a.x * a.x + a.y * a.y) + (a.z * a.z + a.w * a.w); }
                ss = xr32_sum(xr16_sum(ss));
                if (fq == 0) P[rl * 4 + wc] = ss; }
        __syncthreads();
        bf16* QM = (bf16*)(ws + WS_QM); const float* cs = (const float*)(ws + WS_COSM); const float* sn = (const float*)(ws + WS_SINM);
#pragma unroll
        for (int ai = 0; ai < 2; ++ai)
#pragma unroll
            for (int m = 0; m < 4; ++m) { const int row = row0 + ai * HALF + m * 16, rl = ai * HALF + wr * 64 + m * 16 + fr;
                const f32x4 pp = *(const LAS f32x4*)(P + rl * 4); const float rq = rsqrtf(((pp.x + pp.y) + (pp.z + pp.w)) * (1.f / 192.f) + 1e-6f) * QS;
                bf16* o = QM + (size_t)row * 768 + h * 192;
                if (wc < 3) {
                    const f32x4 wa = *(const GAS f32x4*)(qnw + c0), wb = *(const GAS f32x4*)(qnw + c0 + 4);
                    st8bf(o + c0, acc[ai][0][m][0] * rq * wa, acc[ai][0][m][1] * rq * wb);
                    if (wc == 0) { const f32x4 wc4 = *(const GAS f32x4*)(qnw + 96 + c0), wd = *(const GAS f32x4*)(qnw + 100 + c0);
                        st8bf(o + 96 + c0, acc[ai][1][m][0] * rq * wc4, acc[ai][1][m][1] * rq * wd); }
                } else {
                    const int i0 = 8 * fq;
                    const f32x4 w1a = *(const GAS f32x4*)(qnw + 128 + i0), w1b = *(const GAS f32x4*)(qnw + 132 + i0), w2a = *(const GAS f32x4*)(qnw + 160 + i0), w2b = *(const GAS f32x4*)(qnw + 164 + i0);
                    const f32x4 ca = *(const GAS f32x4*)(cs + (size_t)row * 32 + i0), cb = *(const GAS f32x4*)(cs + (size_t)row * 32 + i0 + 4), sa = *(const GAS f32x4*)(sn + (size_t)row * 32 + i0), sb = *(const GAS f32x4*)(sn + (size_t)row * 32 + i0 + 4);
                    const f32x4 x1a = acc[ai][0][m][0] * rq * w1a, x1b = acc[ai][0][m][1] * rq * w1b, x2a = acc[ai][1][m][0] * rq * w2a, x2b = acc[ai][1][m][1] * rq * w2b;
                    st8bf(o + 128 + i0, x1a * ca - x2a * sa, x1b * cb - x2b * sb);
                    st8bf(o + 160 + i0, x2a * ca + x1a * sa, x2b * cb + x1b * sb);
                } }
        __syncthreads();
    }
};

struct EpiKvb {
    static constexpr bool AFTER_DRAIN = true;
    unsigned char* ws; const float* knw;
    DI bool operator()(Acc&, const Unit&, int, int, int, int) const { return true; }
    DI void fused(Acc& acc, const Unit& u, int wr, int wc, int fr, int fq, LAS unsigned char* lds, int wid, int lane, int tid) const {
        const int h = u.pn, row0 = u.pm * BM + wr * 64 + fr, c0 = wc * 32 + fq * 8;
        const float* ssq = (const float*)(ws + WS_SSQ); const float* misc = (const float*)(ws + WS_MISC);
        LAS float* P = (LAS float*)lds; LAS float* KRS = P + 1024; LAS float* RK = P + 1280;
        if (tid < 256) { const float* kr = misc + (size_t)(u.pm * BM + tid) * 256 + 8; float s = 0.f;
#pragma unroll
            for (int i = 0; i < 16; ++i) { const f32x4 v = *(const GAS f32x4*)(kr + 4 * i); s += (v.x * v.x + v.y * v.y) + (v.z * v.z + v.w * v.w); }
            KRS[tid] = s; }
#pragma unroll
        for (int ai = 0; ai < 2; ++ai)
#pragma unroll
            for (int m = 0; m < 4; ++m) { const int row = row0 + ai * HALF + m * 16, rl = ai * HALF + wr * 64 + m * 16 + fr;
                const f32x4 s0 = *(const GAS f32x4*)(ssq + (size_t)row * 16 + 8);
                const float rs = rsqrtf(((s0.x + s0.y) + (s0.z + s0.w)) * (1.f / 256.f) + 1e-6f);
                float ss = 0.f;
#pragma unroll
                for (int bj = 0; bj < 2; ++bj)
#pragma unroll
                    for (int n = 0; n < 2; ++n) { f32x4 a = acc[ai][bj][m][n] * rs; acc[ai][bj][m][n] = a; if (bj == 0) ss += (a.x * a.x + a.y * a.y) + (a.z * a.z + a.w * a.w); }
                ss = xr32_sum(xr16_sum(ss));
                if (fq == 0) P[rl * 4 + wc] = ss; }
        __syncthreads();
        if (tid < 256) { const f32x4 pp = *(const LAS f32x4*)(P + tid * 4); RK[tid] = rsqrtf(((pp.x + pp.y) + (pp.z + pp.w) + KRS[tid]) * (1.f / 192.f) + 1e-6f); }
        __syncthreads();
        bf16* KM = (bf16*)(ws + WS_KM); bf16* VT = (bf16*)(ws + WS_VT);
        const f32x4 wa = *(const GAS f32x4*)(knw + c0), wb = *(const GAS f32x4*)(knw + c0 + 4);
#pragma unroll
        for (int ai = 0; ai < 2; ++ai)
#pragma unroll
            for (int m = 0; m < 4; ++m) { const int row = row0 + ai * HALF + m * 16, rl = ai * HALF + wr * 64 + m * 16 + fr;
                const float rk = RK[rl];
                st8bf(KM + (size_t)row * 768 + h * 192 + c0, acc[ai][0][m][0] * rk * wa, acc[ai][0][m][1] * rk * wb);
#pragma unroll
                for (int n = 0; n < 2; ++n)
#pragma unroll
                    for (int i = 0; i < 4; ++i) VT[(size_t)(h * 128 + c0 + n * 4 + i) * S + row] = (bf16)f2bf(acc[ai][1][m][n][i]); }
        {
            const int rl = tid >> 1, hf = tid & 1, row = u.pm * BM + rl, i0 = 16 * hf; const float rk = RK[rl];
            const float* kr = misc + (size_t)row * 256 + 8; const float* cs = (const float*)(ws + WS_COSM) + (size_t)row * 32; const float* sn = (const float*)(ws + WS_SINM) + (size_t)row * 32;
            bf16* o = KM + (size_t)row * 768 + h * 192 + 128;
#pragma unroll
            for (int q = 0; q < 2; ++q) { f32x4 o1[2], o2[2];
#pragma unroll
                for (int e = 0; e < 2; ++e) { const int i = i0 + 8 * q + 4 * e;
                    const f32x4 x1 = *(const GAS f32x4*)(kr + i) * *(const GAS f32x4*)(knw + 128 + i), x2 = *(const GAS f32x4*)(kr + 32 + i) * *(const GAS f32x4*)(knw + 160 + i);
                    const f32x4 c = *(const GAS f32x4*)(cs + i), s = *(const GAS f32x4*)(sn + i);
                    o1[e] = (x1 * c - x2 * s) * rk; o2[e] = (x2 * c + x1 * s) * rk; }
                st8bf(o + i0 + 8 * q, o1[0], o1[1]); st8bf(o + 32 + i0 + 8 * q, o2[0], o2[1]); }
        }
        __syncthreads();
    }
};

struct EpiV1 {
    static constexpr bool AFTER_DRAIN = false;
    unsigned char* ws_;
    DI bool operator()(Acc& acc, const Unit& u, int wr, int wc, int fr, int fq) const {
        if (wc != 0) return true;
        unsigned char* ws = lw(ws_);
        const int row0 = u.pm * BM + wr * 64 + fr; bf16* dst = (bf16*)(ws + WS_ALORA);
#pragma unroll
        for (int ai = 0; ai < 2; ++ai)
#pragma unroll
            for (int m = 0; m < 4; ++m) { const int row = row0 + ai * HALF + m * 16; st8bf(dst + (size_t)row * 512 + 384 + fq * 8, acc[ai][0][m][0], acc[ai][0][m][1]); }
        return true;
    }
};

struct EpiLora {
    static constexpr bool AFTER_DRAIN = false;
    unsigned char* ws_; const float* w0; const float* a0; const float* v0; const float* ka;
#define LORA_LOOP(BODY) _Pragma("unroll") for (int ai = 0; ai < 2; ++ai) _Pragma("unroll") for (int m = 0; m < 4; ++m) { const size_t ro = (size_t)(row0 + ai * HALF + m * 16) * 512; \
        _Pragma("unroll") for (int bj = 0; bj < 2; ++bj) _Pragma("unroll") for (int n = 0; n < 2; ++n) { const int j = jb + bj * HALF + n * 4; const size_t o = ro + j; const f32x4 x = acc[ai][bj][m][n]; BODY } }
    DI bool operator()(Acc& acc, const Unit& u, int wr, int wc, int fr, int fq) const {
        unsigned char* ws = lw(ws_);
        const int seg = u.pn >> 1, row0 = u.pm * BM + wr * 64 + fr, jb = (u.pn & 1) * 256 + wc * 32 + fq * 8;
        if (seg == 0) { float* dec = (float*)(ws + WS_DEC);
            LORA_LOOP({ const f32x4 b = *(const GAS f32x4*)(w0 + j); f32x4 r;
                _Pragma("unroll") for (int i = 0; i < 4; ++i) { const float u_ = b[i] + x[i]; const float sp = fmaxf(-u_, 0.f) + __logf(1.0f + fexp_(-fabsf(u_))); r[i] = -fexp_(-sp - 0.5f); }
                *(GAS f32x4*)(dec + o) = r; })
        } else if (seg == 1) { const bf16* k32 = (const bf16*)(ws + WS_K32); const bf16* kkn_ = (const bf16*)(ws + WS_KKN); bf16* kp_ = (bf16*)(ws + WS_KP); bf16* bb_ = (bf16*)(ws + WS_BB);
            LORA_LOOP({ const f32x4 b = *(const GAS f32x4*)(a0 + j); const f32x4 kav = *(const GAS f32x4*)(ka + j);
                const u32x2 kw = *(const GAS u32x2*)(k32 + o); const u32x2 nw = *(const GAS u32x2*)(kkn_ + o);
                const f32x4 k = bf4_(kw); const f32x4 kkn = bf4_(nw); f32x4 kp; f32x4 bb;
                _Pragma("unroll") for (int i = 0; i < 4; ++i) { const float av = sigmoidf_(b[i] + x[i]); kp[i] = k[i] * (1.0f + (av - 1.0f) * kav[i]); bb[i] = kkn[i] * av; }
                *(GAS u32x2*)(kp_ + o) = pk4_(kp); *(GAS u32x2*)(bb_ + o) = pk4_(bb); })
        } else if (seg == 2) { bf16* g32 = (bf16*)(ws + WS_G32);
            LORA_LOOP({ *(GAS u32x2*)(g32 + o) = pk4_(x); })
        } else { bf16* vv = (bf16*)(ws + WS_VV); const bf16* vf_ = (const bf16*)(ws + WS_VFIRST);
            LORA_LOOP({ const f32x4 b = *(const GAS f32x4*)(v0 + j); const u32x2 vw = *(const GAS u32x2*)(vv + o); const u32x2 fw = *(const GAS u32x2*)(vf_ + o);
                const f32x4 v = bf4_(vw); const f32x4 vf = bf4_(fw); f32x4 r;
                _Pragma("unroll") for (int i = 0; i < 4; ++i) r[i] = v[i] + (vf[i] - v[i]) * sigmoidf_(b[i] + x[i]);
                *(GAS u32x2*)(vv + o) = pk4_(r); })
        }
        return true;
    }
#undef LORA_LOOP
};

struct EpiBranch {
    static constexpr bool AFTER_DRAIN = false;
    unsigned char* ws_;
    DI bool operator()(Acc& acc, const Unit& u, int wr, int wc, int fr, int fq) const {
        unsigned char* ws = lw(ws_);
        const int nb = u.sub, row0 = u.pm * BM + wr * 64 + fr, cb = u.pn * BM + wc * 32 + fq * 8;
        const bf16* G = (const bf16*)(ws + WS_GATE); bf16* M = (bf16*)(ws + WS_MERGED);
#pragma unroll
        for (int ai = 0; ai < 2; ++ai)
#pragma unroll
            for (int m = 0; m < 4; ++m) { const int row = row0 + ai * HALF + m * 16;
#pragma unroll
                for (int bj = 0; bj < 2; ++bj) { const int col = cb + bj * HALF;
                    float g[8]; unpack8(*(const GAS u32x4*)(G + (size_t)row * 8192 + nb * D + col), g);
                    if (nb < 3) { float gn[8]; unpack8(*(const GAS u32x4*)(G + (size_t)row * 8192 + (nb + 1) * D + col), gn);
#pragma unroll
                        for (int i = 0; i < 8; ++i) g[i] = fmaxf(g[i], 1e-30f) * __builtin_amdgcn_rcpf(fmaxf(gn[i], 1e-30f)); }
                    else {
#pragma unroll
                        for (int i = 0; i < 8; ++i) g[i] = fmaxf(g[i], 1e-30f); }
                    f32x4 a = acc[ai][bj][m][0], b = acc[ai][bj][m][1];
                    a = a * (f32x4){g[0], g[1], g[2], g[3]}; b = b * (f32x4){g[4], g[5], g[6], g[7]};
                    if (nb < 3) { acc[ai][bj][m][0] = a; acc[ai][bj][m][1] = b; } else st8bf(M + (size_t)row * D + col, a, b); } }
        return nb == 3;
    }
};

struct EpiRes {
    static constexpr bool AFTER_DRAIN = false;
    const float* xin; float* out; bf16* xb; float* rss;
    DI bool operator()(Acc& acc, const Unit& u, int wr, int wc, int fr, int fq) const {
        const int row0 = u.pm * BM + wr * 64 + fr, cb = u.pn * BM + wc * 32 + fq * 8;
#pragma unroll
        for (int ai = 0; ai < 2; ++ai)
#pragma unroll
            for (int m = 0; m < 4; ++m) { const int row = row0 + ai * HALF + m * 16; float ss = 0.f;
#pragma unroll
                for (int bj = 0; bj < 2; ++bj) { const size_t o = (size_t)row * D + cb + bj * HALF;
                    const f32x4 a = *(const GAS f32x4*)(xin + o) + acc[ai][bj][m][0], b = *(const GAS f32x4*)(xin + o + 4) + acc[ai][bj][m][1];
                    st8f(out + o, a, b); st8bf(xb + o, a, b);
                    ss += (a.x * a.x + a.y * a.y) + (a.z * a.z + a.w * a.w) + (b.x * b.x + b.y * b.y) + (b.z * b.z + b.w * b.w); }
                if (rss) { ss = xr32_sum(xr16_sum(ss)); if (fq == 0) rss[(size_t)row * 32 + u.pn * 4 + wc] = ss; } }
        return true;
    }
};

struct EpiGu {
    static constexpr bool AFTER_DRAIN = false;
    unsigned char* ws_; const LAS float* rtab;
    DI bool operator()(Acc& acc, const Unit& u, int wr, int wc, int fr, int fq) const {
        unsigned char* ws = lw(ws_);
        scale_rows(acc, rtab + u.ord * 256, wr * 64 + fr);
        const int row0 = u.pm * BM + wr * 64 + fr, cb = u.pn * 128 + wc * 32 + fq * 8; bf16* A = (bf16*)(ws + WS_ACT);
#pragma unroll
        for (int ai = 0; ai < 2; ++ai)
#pragma unroll
            for (int m = 0; m < 4; ++m) { const int row = row0 + ai * HALF + m * 16;
                st8bf(A + (size_t)row * DFF + cb, map4(acc[ai][0][m][0], siluf_) * acc[ai][1][m][0], map4(acc[ai][0][m][1], siluf_) * acc[ai][1][m][1]); }
        return true;
    }
};
}

DI bf16x8 ldfrag(const LAS bf16* M, int ld, int r0, int k0, int lane) { return *(const LAS bf16x8*)(M + (r0 + (lane & 15)) * ld + k0 + 8 * (lane >> 4)); }
#define MFMA16(a, b, c) __builtin_amdgcn_mfma_f32_16x16x32_bf16((a), (b), (c), 0, 0, 0)
DI void stage_nat(LAS bf16* dst, int lp, const bf16* src, size_t gp, int rows, int cols8, int tid) {
    for (int p = tid; p < rows * cols8; p += NTHR) { const int r = p / cols8, c = p - r * cols8; *(LAS u32x4*)(dst + r * lp + c * 8) = *(const GAS u32x4*)(src + (size_t)r * gp + c * 8); }
}
DI void stage_tr(LAS bf16* dst, int lp, const bf16* src, size_t gp, int rows, int cols8, int tid) {
    for (int p = tid; p < rows * cols8; p += NTHR) { const int r = p / cols8, c = p - r * cols8; const u32x4 w = *(const GAS u32x4*)(src + (size_t)r * gp + c * 8);
        LAS bf16* d = dst + (c * 8) * lp + r;
        d[0] = (bf16)(w.x & 0xffffu); d[lp] = (bf16)(w.x >> 16); d[2 * lp] = (bf16)(w.y & 0xffffu); d[3 * lp] = (bf16)(w.y >> 16);
        d[4 * lp] = (bf16)(w.z & 0xffffu); d[5 * lp] = (bf16)(w.z >> 16); d[6 * lp] = (bf16)(w.w & 0xffffu); d[7 * lp] = (bf16)(w.w >> 16); }
}
DI float ret_loggamma(int h) { return log1pf(-exp2f(-5.0f - (float)h)); }

DI void u_ret_kv(Frame& F, int c, int h) {
    int tid_ = F.tid; asm volatile("" : "+v"(tid_));
    unsigned char* ws = F.ws; const int tid = tid_, lane = tid_ & 63, w = F.wave;
    LAS bf16* Kt = (LAS bf16*)F.lds; LAS bf16* Vt = Kt + 128 * 72;
    const bf16* KR = (const bf16*)(ws + WS_KR) + (size_t)(c * 64) * 512 + h * 128; const bf16* VR = (const bf16*)(ws + WS_VR) + (size_t)(c * 64) * 512 + h * 128;
    const float lg = ret_loggamma(h);
    for (int p = tid; p < 1024; p += NTHR) { const int m = p >> 4, d0 = (p & 15) * 8; float k[8]; unpack8(*(const GAS u32x4*)(KR + (size_t)m * 512 + d0), k); const float sc = fexp_(lg * (float)(63 - m));
        LAS bf16* d = Kt + d0 * 72 + m;
#pragma unroll
        for (int i = 0; i < 8; ++i) d[i * 72] = (bf16)f2bf(k[i] * sc); }
    stage_tr(Vt, 72, VR, 512, 64, 16, tid);
    __syncthreads();
    f32x4 acc[8];
#pragma unroll
    for (int bn = 0; bn < 8; ++bn) acc[bn] = (f32x4){0.f, 0.f, 0.f, 0.f};
#pragma unroll
    for (int ks = 0; ks < 2; ++ks) { const bf16x8 a = ldfrag(Kt, 72, 16 * w, 32 * ks, lane);
#pragma unroll
        for (int bn = 0; bn < 8; ++bn) acc[bn] = MFMA16(a, ldfrag(Vt, 72, 16 * bn, 32 * ks, lane), acc[bn]); }
    float* out = (float*)(ws + WS_RKV) + ((size_t)(c * 4 + h) * 128) * 128;
#pragma unroll
    for (int bn = 0; bn < 8; ++bn)
#pragma unroll
        for (int r = 0; r < 4; ++r) out[(size_t)(16 * w + 4 * (lane >> 4) + r) * 128 + 16 * bn + (lane & 15)] = acc[bn][r];
    __syncthreads();
}

DI void u_ret_out(Frame& F, int l_, int c, int h) {
    int tid_ = F.tid; asm volatile("" : "+v"(tid_));
    unsigned char* ws = F.ws; const int tid = tid_, lane = tid_ & 63, w = F.wave;
    LAS bf16* Qs = (LAS bf16*)F.lds; LAS bf16* Ks = Qs + 64 * 136; LAS bf16* Vt = Ks + 64 * 136; LAS bf16* St = Vt + 128 * 72; LAS bf16* Ps = St + 128 * 136; LAS float* Os = (LAS float*)(Ps + 64 * 72);
    const size_t rowb = (size_t)(c * 64) * 512 + h * 128;
    stage_nat(Qs, 136, (const bf16*)(ws + WS_QR) + rowb, 512, 64, 16, tid);
    stage_nat(Ks, 136, (const bf16*)(ws + WS_KR) + rowb, 512, 64, 16, tid);
    stage_tr(Vt, 72, (const bf16*)(ws + WS_VR) + rowb, 512, 64, 16, tid);
    { const float* sp = (const float*)(ws + WS_RKV) + ((size_t)(c * 4 + h) * 128) * 128;
      for (int p = tid; p < 4096; p += NTHR) { const int d = p >> 5, e0 = (p & 31) * 4; const f32x4 v = *(const GAS f32x4*)(sp + (size_t)d * 128 + e0);
          LAS bf16* q = St + e0 * 136 + d; q[0] = (bf16)f2bf(v.x); q[136] = (bf16)f2bf(v.y); q[272] = (bf16)f2bf(v.z); q[408] = (bf16)f2bf(v.w); } }
    __syncthreads();
    const float lg = ret_loggamma(h); const int g4 = lane >> 4, lc = lane & 15;
    {
        const int bm = w >> 1;
#pragma unroll
        for (int q = 0; q < 2; ++q) { const int bn = (w & 1) * 2 + q; f32x4 acc = (f32x4){0.f, 0.f, 0.f, 0.f};
#pragma unroll
            for (int ks = 0; ks < 4; ++ks) acc = MFMA16(ldfrag(Qs, 136, 16 * bm, 32 * ks, lane), ldfrag(Ks, 136, 16 * bn, 32 * ks, lane), acc);
#pragma unroll
            for (int r = 0; r < 4; ++r) { const int l = 16 * bm + 4 * g4 + r, m = 16 * bn + lc; const int dd = l > m ? l - m : m - l; Ps[l * 72 + m] = (bf16)f2bf(acc[r] * fexp_(lg * (float)dd)); } }
    }
    __syncthreads();
    {
        const int bm = w >> 1;
#pragma unroll
        for (int q = 0; q < 4; ++q) { const int bn = (w & 1) * 4 + q; f32x4 a1 = (f32x4){0.f, 0.f, 0.f, 0.f}, a2 = (f32x4){0.f, 0.f, 0.f, 0.f};
#pragma unroll
            for (int ks = 0; ks < 2; ++ks) a1 = MFMA16(ldfrag(Ps, 72, 16 * bm, 32 * ks, lane), ldfrag(Vt, 72, 16 * bn, 32 * ks, lane), a1);
#pragma unroll
            for (int ks = 0; ks < 4; ++ks) a2 = MFMA16(ldfrag(Qs, 136, 16 * bm, 32 * ks, lane), ldfrag(St, 136, 16 * bn, 32 * ks, lane), a2);
#pragma unroll
            for (int r = 0; r < 4; ++r) { const int l = 16 * bm + 4 * g4 + r; Os[l * 132 + 16 * bn + lc] = a1[r] + fexp_(lg * (float)(l + 1)) * a2[r]; } }
    }
    __syncthreads();
    { const float* gw = (const float*)(ws + WS_PRM) + (size_t)l_ * PRM_STRIDE + P_GN + h * 128; const bf16* GR = (const bf16*)(ws + WS_GR); bf16* OB = (bf16*)(ws + WS_OB);
#pragma unroll
      for (int rr = 0; rr < 8; ++rr) { const int l = 8 * w + rr; const float x0 = Os[l * 132 + lane], x1 = Os[l * 132 + 64 + lane];
          const float mean = wave_sum(x0 + x1) * (1.f / 128.f); const float d0 = x0 - mean, d1 = x1 - mean; const float rstd = rsqrtf(wave_sum(d0 * d0 + d1 * d1) * (1.f / 128.f) + 1e-5f);
          const size_t row = (size_t)(c * 64 + l);
          const float g0 = bf2f(GR[row * 512 + h * 128 + lane]), g1 = bf2f(GR[row * 512 + h * 128 + 64 + lane]);
          OB[row * D + h * 128 + lane] = (bf16)f2bf(d0 * rstd * gw[lane] * g0); OB[row * D + h * 128 + 64 + lane] = (bf16)f2bf(d1 * rstd * gw[64 + lane] * g1); } }
    __syncthreads();
}

DI void u_mamba_st(Frame& F, int c, int g) {
    int tid_ = F.tid; asm volatile("" : "+v"(tid_));
    unsigned char* ws = F.ws; const int tid = tid_, lane = tid_ & 63, w = F.wave;
    LAS bf16* Xt = (LAS bf16*)F.lds; LAS bf16* Bt = Xt + 256 * 72;
    const bf16* XC = (const bf16*)(ws + WS_XC) + (size_t)(c * 64) * 1024; const float* dts = (const float*)(ws + WS_DTS) + (size_t)(c * 64) * 8; const float* acs = (const float*)(ws + WS_ACS) + (size_t)(c * 64) * 8;
    for (int p = tid; p < 2048; p += NTHR) { const int l = p >> 5, c0 = (p & 31) * 8, h = g * 4 + (c0 >> 6); float x[8]; unpack8(*(const GAS u32x4*)(XC + (size_t)l * 1024 + g * 256 + c0), x);
        const float sc = dts[l * 8 + h] * fexp_(acs[63 * 8 + h] - acs[l * 8 + h]); LAS bf16* d = Xt + c0 * 72 + l;
#pragma unroll
        for (int i = 0; i < 8; ++i) d[i * 72] = (bf16)f2bf(x[i] * sc); }
    stage_tr(Bt, 72, XC + 512 + g * 128, 1024, 64, 16, tid);
    __syncthreads();
    f32x4 acc[2][8];
#pragma unroll
    for (int i = 0; i < 2; ++i)
#pragma unroll
        for (int bn = 0; bn < 8; ++bn) acc[i][bn] = (f32x4){0.f, 0.f, 0.f, 0.f};
#pragma unroll
    for (int ks = 0; ks < 2; ++ks) { const bf16x8 a0 = ldfrag(Xt, 72, 32 * w, 32 * ks, lane), a1 = ldfrag(Xt, 72, 32 * w + 16, 32 * ks, lane);
#pragma unroll
        for (int bn = 0; bn < 8; ++bn) { const bf16x8 b = ldfrag(Bt, 72, 16 * bn, 32 * ks, lane); acc[0][bn] = MFMA16(a0, b, acc[0][bn]); acc[1][bn] = MFMA16(a1, b, acc[1][bn]); } }
    float* out = (float*)(ws + WS_MST) + ((size_t)(c * 8 + g * 4) * 64) * 128;
#pragma unroll
    for (int i = 0; i < 2; ++i)
#pragma unroll
        for (int bn = 0; bn < 8; ++bn)
#pragma unroll
            for (int r = 0; r < 4; ++r) out[(size_t)(32 * w + 16 * i + 4 * (lane >> 4) + r) * 128 + 16 * bn + (lane & 15)] = acc[i][bn][r];
    __syncthreads();
}

struct MambaLds { LAS bf16* Cs; LAS bf16* Bs; LAS float* CB; LAS bf16* Ph; LAS bf16* Xt; LAS bf16* Sh; LAS float* AC; LAS float* DT; LAS float* SSQ; };
DI void mamba_head(Frame& F, const MambaLds& L, const bf16* XC, const float* sp, int g, int hh, float dsk, const bf16* const (&zrow)[4], f32x4 (&y)[2]) {
    const int tid = F.tid, lane = F.lane, w = F.wave, g4 = lane >> 4, lc = lane & 15, bm = w >> 1;
    __syncthreads();
    { const int l = tid >> 3, m0 = (tid & 7) * 8; const float al = L.AC[l * 4 + hh]; float pv[8];
#pragma unroll
      for (int i = 0; i < 8; ++i) { const int m = m0 + i; pv[i] = (m <= l) ? L.CB[l * 68 + m] * fexp_(al - L.AC[m * 4 + hh]) * L.DT[m * 4 + hh] : 0.f; }
      u32x4 o; o.x = pk2(pv[0], pv[1]); o.y = pk2(pv[2], pv[3]); o.z = pk2(pv[4], pv[5]); o.w = pk2(pv[6], pv[7]); *(LAS u32x4*)(L.Ph + l * 72 + m0) = o; }
    stage_tr(L.Xt, 72, XC + g * 256 + hh * 64, 1024, 64, 8, tid);
    for (int p = tid; p < 1024; p += NTHR) { const int pr = p >> 4, n0 = (p & 15) * 8; const f32x4 v0 = *(const GAS f32x4*)(sp + (size_t)pr * 128 + n0), v1 = *(const GAS f32x4*)(sp + (size_t)pr * 128 + n0 + 4);
        *(LAS u32x4*)(L.Sh + pr * 136 + n0) = pack8(v0, v1); }
    __syncthreads();
#pragma unroll
    for (int q = 0; q < 2; ++q) { const int bn = (w & 1) * 2 + q; f32x4 yd = (f32x4){0.f, 0.f, 0.f, 0.f}, yo = (f32x4){0.f, 0.f, 0.f, 0.f};
#pragma unroll
        for (int ks = 0; ks < 2; ++ks) yd = MFMA16(ldfrag(L.Ph, 72, 16 * bm, 32 * ks, lane), ldfrag(L.Xt, 72, 16 * bn, 32 * ks, lane), yd);
#pragma unroll
        for (int ks = 0; ks < 4; ++ks) yo = MFMA16(ldfrag(L.Cs, 136, 16 * bm, 32 * ks, lane), ldfrag(L.Sh, 136, 16 * bn, 32 * ks, lane), yo);
#pragma unroll
        for (int r = 0; r < 4; ++r) { const int l = 16 * bm + 4 * g4 + r, p = 16 * bn + lc; const float x = bf2f(L.Xt[p * 72 + l]);
            const float z = bf2f(zrow[r][hh * 64 + q * 16]);
            y[q][r] = (yd[r] + fexp_(L.AC[l * 4 + hh]) * yo[r] + x * dsk) * z; } }
}
DI void u_mamba_out(Frame& F, int l_, int c, int g) {
    unsigned char* ws = F.ws; const int tid = F.tid, lane = F.lane, w = F.wave, g4 = lane >> 4, lc = lane & 15;
    MambaLds L; L.Cs = (LAS bf16*)F.lds; L.Bs = L.Cs + 64 * 136; L.CB = (LAS float*)(L.Bs + 64 * 136); L.Ph = (LAS bf16*)(L.CB + 64 * 68); L.Xt = L.Ph + 64 * 72; L.Sh = L.Xt + 64 * 72;
    L.AC = (LAS float*)(L.Sh + 64 * 136); L.DT = L.AC + 256; L.SSQ = L.DT + 256;
    const bf16* XC = (const bf16*)(ws + WS_XC) + (size_t)(c * 64) * 1024;
    stage_nat(L.Cs, 136, XC + 768 + g * 128, 1024, 64, 16, tid);
    stage_nat(L.Bs, 136, XC + 512 + g * 128, 1024, 64, 16, tid);
    if (tid < 256) { const int l = tid >> 2, hh = tid & 3; L.AC[tid] = ((const float*)(ws + WS_ACS))[(size_t)(c * 64 + l) * 8 + g * 4 + hh]; L.DT[tid] = ((const float*)(ws + WS_DTS))[(size_t)(c * 64 + l) * 8 + g * 4 + hh]; }
    __syncthreads();
    const int bm = w >> 1;
#pragma unroll
    for (int q = 0; q < 2; ++q) { const int bn = (w & 1) * 2 + q; f32x4 acc = (f32x4){0.f, 0.f, 0.f, 0.f};
#pragma unroll
        for (int ks = 0; ks < 4; ++ks) acc = MFMA16(ldfrag(L.Cs, 136, 16 * bm, 32 * ks, lane), ldfrag(L.Bs, 136, 16 * bn, 32 * ks, lane), acc);
#pragma unroll
        for (int r = 0; r < 4; ++r) L.CB[(16 * bm + 4 * g4 + r) * 68 + 16 * bn + lc] = acc[r]; }
    const int pcol = 16 * ((w & 1) * 2) + lc;
    const bf16* zrow[4]; bf16* orow[4];
#pragma unroll
    for (int r = 0; r < 4; ++r) { const size_t row = (size_t)(c * 64 + 16 * bm + 4 * g4 + r); zrow[r] = (const bf16*)(ws + WS_ZS) + row * 512 + g * 256 + pcol; orow[r] = (bf16*)(ws + WS_OB) + row * D + 512 + g * 256 + pcol; }
    const float* mst = (const float*)(ws + WS_MST) + ((size_t)(c * 8 + g * 4) * 64) * 128; const float* prm = (const float*)(ws + WS_PRM) + (size_t)l_ * PRM_STRIDE; const float* dskp = prm + P_SD + g * 4;
    float ss[4] = {0.f, 0.f, 0.f, 0.f};
#pragma unroll 1
    for (int hh = 0; hh < 4; ++hh) { f32x4 y[2]; mamba_head(F, L, XC, mst + (size_t)hh * 64 * 128, g, hh, dskp[hh], zrow, y);
#pragma unroll
        for (int r = 0; r < 4; ++r) ss[r] += y[0][r] * y[0][r] + y[1][r] * y[1][r]; }
#pragma unroll
    for (int r = 0; r < 4; ++r) { float t = ss[r]; t = row_sum16(t);
        if (lc == 0) L.SSQ[(16 * bm + 4 * g4 + r) * 2 + (w & 1)] = t; }
    __syncthreads();
    float rstd[4];
#pragma unroll
    for (int r = 0; r < 4; ++r) { const int l = 16 * bm + 4 * g4 + r; rstd[r] = rsqrtf((L.SSQ[l * 2] + L.SSQ[l * 2 + 1]) * (1.f / 256.f) + 1e-6f); }
    const float* nw = prm + P_SNW + g * 256 + pcol;
#pragma unroll 1
    for (int hh = 0; hh < 4; ++hh) { f32x4 y[2]; mamba_head(F, L, XC, mst + (size_t)hh * 64 * 128, g, hh, dskp[hh], zrow, y);
#pragma unroll
        for (int q = 0; q < 2; ++q)
#pragma unroll
            for (int r = 0; r < 4; ++r) orow[r][hh * 64 + q * 16] = (bf16)f2bf(y[q][r] * rstd[r] * nw[hh * 64 + q * 16]); }
    __syncthreads();
}

DI void u_attn2(Frame& F, int h, int qb, int sp, int ntile) {
    int tid_ = F.tid; asm volatile("" : "+v"(tid_));
    unsigned char* ws = F.ws; const int tid = tid_, lane = tid & 63, w = F.wave, g4 = lane >> 4, lc = lane & 15;
    LAS bf16* Ks = (LAS bf16*)F.lds; LAS bf16* Vs = Ks + 64 * 200;
    const bf16* QM = (const bf16*)(ws + WS_QM); const bf16* KM = (const bf16*)(ws + WS_KM) + h * 192; const bf16* VT = (const bf16*)(ws + WS_VT) + (size_t)(h * 128) * S;
    const int q0 = qb * 256 + w * 32, cw = 4 * qb + (w >> 1);
    bf16x8 qf[2][6];
#pragma unroll
    for (int qq = 0; qq < 2; ++qq)
#pragma unroll
        for (int ks = 0; ks < 6; ++ks) qf[qq][ks] = *(const GAS bf16x8*)(QM + (size_t)(q0 + qq * 16 + lc) * 768 + h * 192 + ks * 32 + g4 * 8);
    f32x4 o[8][2]; float mrun[2], lrun[2];
#pragma unroll
    for (int db = 0; db < 8; ++db)
#pragma unroll
        for (int qq = 0; qq < 2; ++qq) o[db][qq] = (f32x4){0.f, 0.f, 0.f, 0.f};
    mrun[0] = mrun[1] = -1e30f; lrun[0] = lrun[1] = 0.f;
    u32x4 kreg[3], vreg[2];
    const int kt0 = 16 * sp;
#define AT_LOAD(kt) { const int key0_ = (kt) * 64; \
        _Pragma("unroll") for (int i = 0; i < 3; ++i) { const int p = tid + 512 * i, r = p / 24, cc = p - r * 24; kreg[i] = *(const GAS u32x4*)(KM + (size_t)(key0_ + r) * 768 + cc * 8); } \
        _Pragma("unroll") for (int i = 0; i < 2; ++i) { const int p = tid + 512 * i, r = p >> 3, cc = p & 7; vreg[i] = *(const GAS u32x4*)(VT + (size_t)r * S + key0_ + cc * 8); } }
    AT_LOAD(kt0)
    for (int t = 0; t < ntile; ++t) {
        const int kt = kt0 + t;
        __syncthreads();
#pragma unroll
        for (int i = 0; i < 3; ++i) { const int p = tid + 512 * i, r = p / 24, cc = p - r * 24; *(LAS u32x4*)(Ks + r * 200 + cc * 8) = kreg[i]; }
#pragma unroll
        for (int i = 0; i < 2; ++i) { const int p = tid + 512 * i, r = p >> 3, cc = p & 7; *(LAS u32x4*)(Vs + r * 72 + cc * 8) = vreg[i]; }
        __syncthreads();
        if (t + 1 < ntile) AT_LOAD(kt + 1)
        if (kt <= cw) {
            f32x4 s[4][2];
#pragma unroll
            for (int kb = 0; kb < 4; ++kb)
#pragma unroll
                for (int qq = 0; qq < 2; ++qq) s[kb][qq] = (f32x4){0.f, 0.f, 0.f, 0.f};
#pragma unroll
            for (int ks = 0; ks < 6; ++ks)
#pragma unroll
                for (int kb = 0; kb < 4; ++kb) { const bf16x8 kf = ldfrag(Ks, 200, kb * 16, ks * 32, lane);
#pragma unroll
                    for (int qq = 0; qq < 2; ++qq) s[kb][qq] = MFMA16(kf, qf[qq][ks], s[kb][qq]);
                    if (kb == 3 && (ks & 1)) __builtin_amdgcn_sched_barrier(0); }
            bf16x8 pf[2][2];
#pragma unroll
            for (int qq = 0; qq < 2; ++qq) {
                float mx = -1e30f;
#pragma unroll
                for (int kb = 0; kb < 4; ++kb) mx = fmaxf(mx, fmaxf(fmaxf(s[kb][qq][0], s[kb][qq][1]), fmaxf(s[kb][qq][2], s[kb][qq][3])));
                mx = xr32_max(xr16_max(mx));
                const float mn = fmaxf(mrun[qq], mx), alpha = __builtin_amdgcn_exp2f(mrun[qq] - mn); mrun[qq] = mn;
                float ps = 0.f; float p[16];
#pragma unroll
                for (int kb = 0; kb < 4; ++kb)
#pragma unroll
                    for (int r = 0; r < 4; ++r) { p[kb * 4 + r] = __builtin_amdgcn_exp2f(s[kb][qq][r] - mn); ps += p[kb * 4 + r]; }
                ps = xr32_sum(xr16_sum(ps));
                lrun[qq] = lrun[qq] * alpha + ps;
if (__builtin_amdgcn_ballot_w64(alpha != 1.0f) != 0ull) {
#pragma unroll
                    for (int db = 0; db < 8; ++db) o[db][qq] = o[db][qq] * alpha; }
#pragma unroll
                for (int s2 = 0; s2 < 2; ++s2) { u32x4 pw; pw.x = pk2(p[8 * s2], p[8 * s2 + 1]); pw.y = pk2(p[8 * s2 + 2], p[8 * s2 + 3]); pw.z = pk2(p[8 * s2 + 4], p[8 * s2 + 5]); pw.w = pk2(p[8 * s2 + 6], p[8 * s2 + 7]); pf[qq][s2] = __builtin_bit_cast(bf16x8, pw); }
            }
#pragma unroll
            for (int db = 0; db < 8; ++db)
#pragma unroll
                for (int s2 = 0; s2 < 2; ++s2) {
                    const LAS bf16* vp = Vs + (db * 16 + lc) * 72 + 32 * s2 + 4 * g4;
                    const u32x2 v0 = *(const LAS u32x2*)vp, v1 = *(const LAS u32x2*)(vp + 16);
                    const u32x4 vw = (u32x4){v0.x, v0.y, v1.x, v1.y}; const bf16x8 vf = __builtin_bit_cast(bf16x8, vw);
#pragma unroll
                    for (int qq = 0; qq < 2; ++qq) o[db][qq] = MFMA16(vf, pf[qq][s2], o[db][qq]);
                }
        }
    }
#undef AT_LOAD
    const int slot = att_slot(h, qb, sp);
    float* po = (float*)(ws + WS_APO) + (size_t)slot * 32768; float* pm = (float*)(ws + WS_APM) + (size_t)slot * 512;
#pragma unroll
    for (int db = 0; db < 8; ++db)
#pragma unroll
        for (int qq = 0; qq < 2; ++qq)
#pragma unroll
            for (int r = 0; r < 4; ++r) po[(size_t)(db * 16 + 4 * g4 + r) * 256 + w * 32 + qq * 16 + lc] = o[db][qq][r];
    if (g4 == 0) {
#pragma unroll
        for (int qq = 0; qq < 2; ++qq) { *(GAS f32x2*)(pm + (w * 32 + qq * 16 + lc) * 2) = (f32x2){mrun[qq], lrun[qq]}; } }
    __syncthreads();
}
DI void u_attn_comb(Frame& F, int h, int qb, int qq) {
    unsigned char* ws = F.ws; const int tid = F.tid, q = qq * 64 + (tid & 63), dv0 = (tid >> 6) * 16;
    const int ns = (qb + 4) >> 2, slot0 = att_slot(h, qb, 0);
    const float* pm = (const float*)(ws + WS_APM) + (size_t)slot0 * 512 + q * 2; const float* po = (const float*)(ws + WS_APO) + (size_t)slot0 * 32768 + (size_t)dv0 * 256 + q;
    float mstar = -1e30f;
    for (int s = 0; s < ns; ++s) mstar = fmaxf(mstar, pm[(size_t)s * 512]);
    float lt = 0.f; float ov[16];
#pragma unroll
    for (int i = 0; i < 16; ++i) ov[i] = 0.f;
    for (int s = 0; s < ns; ++s) { const float sc = __builtin_amdgcn_exp2f(pm[(size_t)s * 512] - mstar); lt += pm[(size_t)s * 512 + 1] * sc;
#pragma unroll
        for (int i = 0; i < 16; ++i) ov[i] += po[(size_t)s * 32768 + i * 256] * sc; }
    const float inv = 1.0f / lt;
    bf16* ob = (bf16*)(ws + WS_OB) + (size_t)(qb * 256 + q) * D + 1024 + h * 128 + dv0;
    u32x4 o0, o1; o0.x = pk2(ov[0] * inv, ov[1] * inv); o0.y = pk2(ov[2] * inv, ov[3] * inv); o0.z = pk2(ov[4] * inv, ov[5] * inv); o0.w = pk2(ov[6] * inv, ov[7] * inv);
    o1.x = pk2(ov[8] * inv, ov[9] * inv); o1.y = pk2(ov[10] * inv, ov[11] * inv); o1.z = pk2(ov[12] * inv, ov[13] * inv); o1.w = pk2(ov[14] * inv, ov[15] * inv);
    *(GAS u32x4*)ob = o0; *(GAS u32x4*)(ob + 8) = o1;
}

DI void u_rwkv_r1(Frame& F, int c, int h) {
    int tid_ = F.tid; asm volatile("" : "+v"(tid_));
    unsigned char* ws = F.ws; const int tid = tid_, lane = tid_ & 63, w = F.wave, g4 = lane >> 4, lc = lane & 15;
    LAS float* CUM = (LAS float*)F.lds;
    LAS float* PT = CUM + 64 * 68;
    LAS bf16* AT = (LAS bf16*)(PT + 64); LAS bf16* BH = AT + 4608; LAS bf16* KH = BH + 4608; LAS bf16* RT = KH + 4608;
    LAS bf16* AJ = RT + 4608; LAS bf16* BJ = AJ + 4608; LAS bf16* KJ = BJ + 4608; LAS bf16* VJ = KJ + 4608;
    LAS bf16* MAK = VJ + 4608; LAS bf16* MRBT = MAK + 4608; LAS bf16* MRKT = MRBT + 4608; LAS bf16* X1 = MRKT + 4608; LAS bf16* X2 = X1 + 4608;
    LAS bf16* WT = AT; LAS bf16* G1 = BH; LAS bf16* G2 = KH; LAS bf16* CST = MAK;
    const size_t gb = (size_t)(c * 64) * 512 + h * 64; const int unit = c * 8 + h;
    const int t = tid >> 3, j0 = (tid & 7) * 8;
    const size_t go = gb + (size_t)t * 512 + j0;
    float lw[8];
    { const f32x4 x0 = *(const GAS f32x4*)((const float*)(ws + WS_DEC) + go), x1 = *(const GAS f32x4*)((const float*)(ws + WS_DEC) + go + 4);
#pragma unroll
      for (int i = 0; i < 4; ++i) { lw[i] = x0[i]; lw[4 + i] = x1[i]; }
#pragma unroll
      for (int i = 0; i < 8; ++i) CUM[t * 68 + j0 + i] = lw[i]; }
    __syncthreads();
    if (tid < 64) { float s = 0.f;
#pragma unroll 8
        for (int tt = 0; tt < 64; ++tt) { s += CUM[tt * 68 + tid]; CUM[tt * 68 + tid] = s; } }
    __syncthreads();
    {
        float cum[8], cT[8];
#pragma unroll
        for (int i = 0; i < 8; ++i) { cum[i] = CUM[t * 68 + j0 + i]; cT[i] = CUM[63 * 68 + j0 + i]; }
        if (t == 0) {
#pragma unroll
            for (int i = 0; i < 8; ++i) PT[j0 + i] = fexp_(cT[i]); }
        float av[8], bv[8], kv[8], rv[8], vv[8];
#define LD8(dst, OFF) { unpack8(*(const GAS u32x4*)((const bf16*)(ws + (OFF)) + go), dst); }
        LD8(av, WS_KKN) LD8(bv, WS_BB) LD8(kv, WS_KP) LD8(rv, WS_R32) LD8(vv, WS_VV)
#undef LD8
        float at[8], bh[8], kh[8], rt[8], bj[8], kj[8];
#pragma unroll
        for (int i = 0; i < 8; ++i) { const float pprev = fexp_(cum[i] - lw[i]), pinv = fexp_(-cum[i]), pt = fexp_(cum[i]), pend = fexp_(cT[i] - cum[i]);
            at[i] = -av[i] * pprev; bh[i] = bv[i] * pinv; kh[i] = kv[i] * pinv; rt[i] = rv[i] * pt; bj[i] = bv[i] * pend; kj[i] = kv[i] * pend; }
#define ST8(M, v) { u32x4 o; o.x = pk2(v[0], v[1]); o.y = pk2(v[2], v[3]); o.z = pk2(v[4], v[5]); o.w = pk2(v[6], v[7]); *(LAS u32x4*)(M + t * 72 + j0) = o; }
        ST8(AT, at) ST8(BH, bh) ST8(KH, kh) ST8(RT, rt)
#undef ST8
#pragma unroll
        for (int i = 0; i < 8; ++i) { const int o = (j0 + i) * 72 + t; AJ[o] = (bf16)f2bf(at[i]); BJ[o] = (bf16)f2bf(bj[i]); KJ[o] = (bf16)f2bf(kj[i]); VJ[o] = (bf16)f2bf(vv[i]); }
    }
    __syncthreads();
    {
        const int q = w >> 1; const LAS bf16* Am = (q == 0) ? BH : (q == 1) ? KH : RT; const LAS bf16* Bm = (q < 2) ? AT : (q == 2) ? BH : KH;
#pragma unroll
        for (int bi = 0; bi < 2; ++bi) { const int bm = 2 * (w & 1) + bi; const bf16x8 a0 = ldfrag(Am, 72, 16 * bm, 0, lane), a1 = ldfrag(Am, 72, 16 * bm, 32, lane);
#pragma unroll
            for (int bn = 0; bn < 4; ++bn) { f32x4 acc = (f32x4){0.f, 0.f, 0.f, 0.f};
                acc = MFMA16(a0, ldfrag(Bm, 72, 16 * bn, 0, lane), acc); acc = MFMA16(a1, ldfrag(Bm, 72, 16 * bn, 32, lane), acc);
#pragma unroll
                for (int r = 0; r < 4; ++r) { const int row = 16 * bm + 4 * g4 + r, col = 16 * bn + lc; const bool keep = (q < 2) ? (row < col) : (col <= row); const float v = keep ? acc[r] : 0.f;
                    if (q == 0) CUM[row * 68 + col] = v; else { LAS bf16* O = (q == 1) ? MAK : (q == 2) ? MRBT : MRKT; O[row * 72 + col] = (bf16)f2bf(v); } } } }
    }
    __syncthreads();
    {
        LAS bf16* Qn[2] = {BH, X1}; LAS bf16* Qt[2] = {KH, X2}; LAS bf16* Wn[2] = {AT, (LAS bf16*)CUM};
        const int bm = w >> 1; f32x4 wreg[2];
#pragma unroll
        for (int qn = 0; qn < 2; ++qn) { const int bn = (w & 1) * 2 + qn;
#pragma unroll
            for (int r = 0; r < 4; ++r) { const int row = 16 * bm + 4 * g4 + r, col = 16 * bn + lc; const float m = CUM[row * 68 + col]; wreg[qn][r] = m + ((row == col) ? 1.f : 0.f);
                const bf16 mb = (bf16)f2bf(m); Qn[0][row * 72 + col] = mb; Qt[0][col * 72 + row] = mb; Wn[0][row * 72 + col] = (bf16)f2bf(wreg[qn][r]); } }
        __syncthreads();
#pragma unroll
        for (int it = 0; it < 5; ++it) { const int cu = it & 1, nx = cu ^ 1;
            { const bf16x8 a0 = ldfrag(Qn[cu], 72, 16 * bm, 0, lane), a1 = ldfrag(Qn[cu], 72, 16 * bm, 32, lane);
#pragma unroll
              for (int qn = 0; qn < 2; ++qn) { const int bn = (w & 1) * 2 + qn; f32x4 acc = (f32x4){0.f, 0.f, 0.f, 0.f};
                  acc = MFMA16(a0, ldfrag(Qt[cu], 72, 16 * bn, 0, lane), acc); acc = MFMA16(a1, ldfrag(Qt[cu], 72, 16 * bn, 32, lane), acc);
#pragma unroll
                  for (int r = 0; r < 4; ++r) { const int row = 16 * bm + 4 * g4 + r, col = 16 * bn + lc; const bf16 v = (bf16)f2bf(acc[r]); Qn[nx][row * 72 + col] = v; Qt[nx][col * 72 + row] = v; } } }
            __syncthreads();
            { const bf16x8 a0 = ldfrag(Wn[cu], 72, 16 * bm, 0, lane), a1 = ldfrag(Wn[cu], 72, 16 * bm, 32, lane);
#pragma unroll
              for (int qn = 0; qn < 2; ++qn) { const int bn = (w & 1) * 2 + qn;
                  wreg[qn] = MFMA16(a0, ldfrag(Qt[nx], 72, 16 * bn, 0, lane), wreg[qn]); wreg[qn] = MFMA16(a1, ldfrag(Qt[nx], 72, 16 * bn, 32, lane), wreg[qn]); } }
            if (it < 4) {
#pragma unroll
                for (int qn = 0; qn < 2; ++qn) { const int bn = (w & 1) * 2 + qn;
#pragma unroll
                    for (int r = 0; r < 4; ++r) Wn[nx][(16 * bm + 4 * g4 + r) * 72 + 16 * bn + lc] = (bf16)f2bf(wreg[qn][r]); }
            }
        }
        __syncthreads();
#pragma unroll
        for (int qn = 0; qn < 2; ++qn) { const int bn = (w & 1) * 2 + qn;
#pragma unroll
            for (int r = 0; r < 4; ++r) WT[(16 * bn + lc) * 72 + 16 * bm + 4 * g4 + r] = (bf16)f2bf(wreg[qn][r]); }
    }
    __syncthreads();
    {
        const int q = w >> 2, bm = w & 3; const LAS bf16* Am = q ? MAK : AJ; LAS bf16* O = q ? G2 : G1;
        const bf16x8 a0 = ldfrag(Am, 72, 16 * bm, 0, lane), a1 = ldfrag(Am, 72, 16 * bm, 32, lane);
        f32x4 acc[4];
#pragma unroll
        for (int bn = 0; bn < 4; ++bn) { acc[bn] = (f32x4){0.f, 0.f, 0.f, 0.f};
            acc[bn] = MFMA16(a0, ldfrag(WT, 72, 16 * bn, 0, lane), acc[bn]); acc[bn] = MFMA16(a1, ldfrag(WT, 72, 16 * bn, 32, lane), acc[bn]); }
#pragma unroll
        for (int bn = 0; bn < 4; ++bn)
#pragma unroll
            for (int r = 0; r < 4; ++r) O[(16 * bm + 4 * g4 + r) * 72 + 16 * bn + lc] = (bf16)f2bf(acc[bn][r]);
    }
    __syncthreads();
    {
        const int q = w >> 1; const LAS bf16* Am = (q < 2) ? MRBT : BJ; const LAS bf16* Bm = (q & 1) ? G2 : G1;
        f32x4 acc[2][4];
#pragma unroll
        for (int bi = 0; bi < 2; ++bi) { const int bm = 2 * (w & 1) + bi; const bf16x8 a0 = ldfrag(Am, 72, 16 * bm, 0, lane), a1 = ldfrag(Am, 72, 16 * bm, 32, lane);
#pragma unroll
            for (int bn = 0; bn < 4; ++bn) { acc[bi][bn] = (f32x4){0.f, 0.f, 0.f, 0.f};
                acc[bi][bn] = MFMA16(a0, ldfrag(Bm, 72, 16 * bn, 0, lane), acc[bi][bn]); acc[bi][bn] = MFMA16(a1, ldfrag(Bm, 72, 16 * bn, 32, lane), acc[bi][bn]); } }
        bf16* gout = (bf16*)(ws + (q == 0 ? WS_QYT : q == 1 ? WS_CYT : WS_TST)) + (size_t)unit * 4096;
#pragma unroll
        for (int bi = 0; bi < 2; ++bi) { const int bm = 2 * (w & 1) + bi;
#pragma unroll
            for (int bn = 0; bn < 4; ++bn)
#pragma unroll
                for (int r = 0; r < 4; ++r) { const int row = 16 * bm + 4 * g4 + r, col = 16 * bn + lc; float v = acc[bi][bn][r];
                    if (q == 0) v += bf2f(RT[row * 72 + col]); else if (q == 1) v += bf2f(MRKT[row * 72 + col]); else if (q == 2) v += (row == col) ? PT[row] : 0.f; else v += bf2f(KJ[row * 72 + col]);
                    if (q < 3) gout[row * 64 + col] = (bf16)f2bf(v); else CST[row * 72 + col] = (bf16)f2bf(v); } }
    }
    __syncthreads();
    {
        const int bm = w >> 1; float* nst = (float*)(ws + WS_NST) + (size_t)unit * 4096;
        const bf16x8 a0 = ldfrag(CST, 72, 16 * bm, 0, lane), a1 = ldfrag(CST, 72, 16 * bm, 32, lane);
#pragma unroll
        for (int qn = 0; qn < 2; ++qn) { const int bn = (w & 1) * 2 + qn; f32x4 acc = (f32x4){0.f, 0.f, 0.f, 0.f};
            acc = MFMA16(a0, ldfrag(VJ, 72, 16 * bn, 0, lane), acc); acc = MFMA16(a1, ldfrag(VJ, 72, 16 * bn, 32, lane), acc);
#pragma unroll
            for (int r = 0; r < 4; ++r) nst[(16 * bm + 4 * g4 + r) * 64 + 16 * bn + lc] = acc[r]; }
    }
    __syncthreads();
}

DI void p_rwkv_scan2(Frame& F, int h) {
    unsigned char* ws = F.ws; const int lane = F.lane, w = F.wave, g4 = lane >> 4, lc = lane & 15;
    constexpr int SLOT_B = 9216 + 17408;
    const bf16* TST = (const bf16*)(ws + WS_TST) + (size_t)h * 4096; const float* NST = (const float*)(ws + WS_NST) + (size_t)h * 4096; bf16* S0 = (bf16*)(ws + WS_S0) + (size_t)h * 4096;
    if (w >= 4) {
        const int lt = (w - 4) * 64 + lane;
        u32x4 rt[8][2]; f32x4 rn[8][4];
#define SC_ISSUE(u, cc) { const size_t ub = (size_t)(cc) * 8 * 4096; \
            _Pragma("unroll") for (int i = 0; i < 2; ++i) { const int p = lt + 256 * i; rt[u][i] = *(const GAS u32x4*)(TST + ub + (size_t)p * 8); } \
            _Pragma("unroll") for (int i = 0; i < 4; ++i) { const int p = lt + 256 * i; rn[u][i] = *(const GAS f32x4*)(NST + ub + (size_t)p * 4); } }
#define SC_WRITE(u, cc) { LAS unsigned char* sl = F.lds + ((cc) & 1) * SLOT_B; \
            _Pragma("unroll") for (int i = 0; i < 2; ++i) { const int p = lt + 256 * i, r = p >> 3, c8 = p & 7; *(LAS u32x4*)(sl + (r * 72 + c8 * 8) * 2) = rt[u][i]; } \
            _Pragma("unroll") for (int i = 0; i < 4; ++i) { const int p = lt + 256 * i, r = p >> 4, c4 = p & 15; *(LAS f32x4*)(sl + 9216 + (r * 68 + c4 * 4) * 4) = rn[u][i]; } }
#pragma unroll
        for (int u = 0; u < 8; ++u) SC_ISSUE(u, u)
        for (int c0 = 0; c0 < NCH; c0 += 8) {
#pragma unroll
            for (int u = 0; u < 8; ++u) { const int c = c0 + u;
                SC_WRITE(u, c)
                if (c + 8 < NCH) SC_ISSUE(u, c + 8)
                asm volatile("s_waitcnt lgkmcnt(0)" ::: "memory"); __builtin_amdgcn_s_barrier(); asm volatile("" ::: "memory");
            }
        }
#undef SC_ISSUE
#undef SC_WRITE
    } else {
        const int ib = w;
        f32x4 st[4];
#pragma unroll
        for (int jb = 0; jb < 4; ++jb) st[jb] = (f32x4){0.f, 0.f, 0.f, 0.f};
        for (int c = 0; c < NCH; ++c) {
            bf16* s0p = S0 + (size_t)c * 8 * 4096 + (size_t)(16 * ib + lc) * 64 + 4 * g4;
            bf16x8 bfr[2];
#pragma unroll
            for (int ks = 0; ks < 2; ++ks) { u32x4 p; p.x = pk2(st[2 * ks][0], st[2 * ks][1]); p.y = pk2(st[2 * ks][2], st[2 * ks][3]); p.z = pk2(st[2 * ks + 1][0], st[2 * ks + 1][1]); p.w = pk2(st[2 * ks + 1][2], st[2 * ks + 1][3]);
                bfr[ks] = __builtin_bit_cast(bf16x8, p);
                *(GAS u32x2*)(s0p + 32 * ks) = (u32x2){p.x, p.y}; *(GAS u32x2*)(s0p + 32 * ks + 16) = (u32x2){p.z, p.w}; }
            asm volatile("s_waitcnt lgkmcnt(0)" ::: "memory"); __builtin_amdgcn_s_barrier(); asm volatile("" ::: "memory");
            const LAS bf16* ts = (const LAS bf16*)(F.lds + (c & 1) * SLOT_B); const LAS float* ns = (const LAS float*)(F.lds + (c & 1) * SLOT_B + 9216);
#pragma unroll
            for (int jb = 0; jb < 4; ++jb) { f32x4 nw;
#pragma unroll
                for (int r = 0; r < 4; ++r) nw[r] = ns[(16 * jb + 4 * g4 + r) * 68 + 16 * ib + lc];
#pragma unroll
                for (int ks = 0; ks < 2; ++ks) { const LAS bf16* ap = ts + (16 * jb + lc) * 72 + 32 * ks + 4 * g4; const u32x2 a0 = *(const LAS u32x2*)ap, a1 = *(const LAS u32x2*)(ap + 16);
                    const u32x4 aw = (u32x4){a0.x, a0.y, a1.x, a1.y}; nw = MFMA16(__builtin_bit_cast(bf16x8, aw), bfr[ks], nw); }
                st[jb] = nw; }
        }
    }
}

DI void u_rwkv_r3(Frame& F, int l_, int c, int h) {
    int tid_ = F.tid; asm volatile("" : "+v"(tid_));
    unsigned char* ws = F.ws; const int tid = tid_, lane = tid_ & 63, w = F.wave, g4 = lane >> 4, lc = lane & 15, unit = c * 8 + h;
    LAS bf16* QY = (LAS bf16*)F.lds; LAS bf16* CY = QY + 4608; LAS bf16* S0s = CY + 4608; LAS bf16* VJ = S0s + 4608; LAS float* Ys = (LAS float*)(VJ + 4608);
    stage_nat(QY, 72, (const bf16*)(ws + WS_QYT) + (size_t)unit * 4096, 64, 64, 8, tid);
    stage_nat(CY, 72, (const bf16*)(ws + WS_CYT) + (size_t)unit * 4096, 64, 64, 8, tid);
    stage_nat(S0s, 72, (const bf16*)(ws + WS_S0) + (size_t)unit * 4096, 64, 64, 8, tid);
    const size_t gb = (size_t)(c * 64) * 512 + h * 64;
    { const int t = tid >> 3, j0 = (tid & 7) * 8; const u32x4 w4 = *(const GAS u32x4*)((const bf16*)(ws + WS_VV) + gb + (size_t)t * 512 + j0); LAS bf16* d = VJ + j0 * 72 + t;
      d[0] = (bf16)(w4.x & 0xffffu); d[72] = (bf16)(w4.x >> 16); d[144] = (bf16)(w4.y & 0xffffu); d[216] = (bf16)(w4.y >> 16); d[288] = (bf16)(w4.z & 0xffffu); d[360] = (bf16)(w4.z >> 16); d[432] = (bf16)(w4.w & 0xffffu); d[504] = (bf16)(w4.w >> 16); }
    __syncthreads();
    { const int bm = w >> 1;
#pragma unroll
      for (int qn = 0; qn < 2; ++qn) { const int bn = (w & 1) * 2 + qn; f32x4 acc = (f32x4){0.f, 0.f, 0.f, 0.f};
#pragma unroll
          for (int ks = 0; ks < 2; ++ks) { acc = MFMA16(ldfrag(QY, 72, 16 * bm, 32 * ks, lane), ldfrag(S0s, 72, 16 * bn, 32 * ks, lane), acc); acc = MFMA16(ldfrag(CY, 72, 16 * bm, 32 * ks, lane), ldfrag(VJ, 72, 16 * bn, 32 * ks, lane), acc); }
#pragma unroll
          for (int r = 0; r < 4; ++r) Ys[(16 * bm + 4 * g4 + r) * 65 + 16 * bn + lc] = acc[r]; } }
    __syncthreads();
    { const float* prm = (const float*)(ws + WS_PRM) + (size_t)l_ * PRM_STRIDE; const float lnw = prm[P_LNW + h * 64 + lane], lnb = prm[P_LNB + h * 64 + lane], rk = prm[P_RK + h * 64 + lane];
      float rr_[8], kk_[8], vv_[8], gg_[8];
#pragma unroll
      for (int rr = 0; rr < 8; ++rr) { const size_t o = gb + (size_t)(8 * w + rr) * 512 + lane;
          rr_[rr] = bf2f(((const bf16*)(ws + WS_R32))[o]); kk_[rr] = bf2f(((const bf16*)(ws + WS_KP))[o]); vv_[rr] = bf2f(((const bf16*)(ws + WS_VV))[o]); gg_[rr] = bf2f(((const bf16*)(ws + WS_G32))[o]); }
#pragma unroll
      for (int rr = 0; rr < 8; ++rr) { const int t = 8 * w + rr; const float y = Ys[t * 65 + lane];
          const float mean = wave_sum(y) * (1.f / 64.f), d = y - mean, rstd = rsqrtf(wave_sum(d * d) * (1.f / 64.f) + 64e-5f), bs = wave_sum(rr_[rr] * kk_[rr] * rk);
          ((bf16*)(ws + WS_OB))[(size_t)(c * 64 + t) * D + 1536 + h * 64 + lane] = (bf16)f2bf((d * rstd * lnw + lnb + bs * vv_[rr]) * gg_[rr]); } }
    __syncthreads();
}

constexpr int STEPS_PER_LAYER = 13, NSTEPS = 1 + DEPTH * STEPS_PER_LAYER;
constexpr int NSCAN_BLK = 8;

__global__ void __launch_bounds__(NTHR, 2) mk_fwd(Args args) {
    extern __shared__ __attribute__((aligned(16))) unsigned char lds_raw[];
    Frame F;
    F.lds = (LAS unsigned char*)lds_raw; F.MISC = (volatile LAS unsigned*)(F.lds + MISC_OFF);
    F.tid = threadIdx.x; F.lane = F.tid & 63; F.wave = __builtin_amdgcn_readfirstlane(F.tid >> 6);
    F.G = gridDim.x; F.bid = blockIdx.x; F.ws = args.ws; F.ctl = (gu32*)(args.ws + WS_CTL);
    for (int u = F.tid; u < (LDS_BYTES - LDSCTL_OFF) / 4; u += NTHR) ((LAS unsigned*)(F.lds + LDSCTL_OFF))[u] = 0u;
    __syncthreads();
    const int lo = args.st_lo, hi = args.st_hi;
    XcdBarrier bar; bar.bar = (unsigned*)(F.ctl + CW_BAR); bar.x = 0; bar.st = nullptr;
    if (hi - lo > 1) bar = xcd_barrier_post((unsigned*)(F.ctl + CW_BAR), F.MISC + 8);
#ifndef MK_MASK
#define MK_MASK 0xFBFEu
#endif
#define EN(k) (((MK_MASK) >> (k)) & 1u)
#ifndef MK_REP
#define MK_REP 0u
#endif
#define REP(k) (((MK_REP) >> (k)) & 1u)
#ifndef MK_DUP
#define MK_DUP 0u
#endif
#define DUP(k, stmt) do { stmt; if (((MK_DUP) >> (k)) & 1u) { stmt; } } while (0)
#define RUN(s) (lo <= (s) && (s) < hi)
#define SEAM(s) do { if ((s) + 1 < hi) xcd_barrier(bar); } while (0)

    if (EN(13) && RUN(0)) { _Pragma("unroll 1") for (int rp = 0; rp <= (int)REP(13); ++rp) { relaunder(F, args.ws, (LAS unsigned char*)lds_raw); p_prologue(F, args); } SEAM(0); }

    for (int l = 0; l < DEPTH; ++l) {
        const int sb = 1 + l * STEPS_PER_LAYER;
        const float* xin = (l == 0) ? args.in[0] : args.out;
        if (EN(0) && RUN(sb + 0)) { _Pragma("unroll 1") for (int rp = 0; rp <= (int)REP(0); ++rp) { relaunder(F, args.ws, (LAS unsigned char*)lds_raw); unsigned char* ws = F.ws; DUP(11, p_rmsnorm(F, xin, (const float*)(ws + WS_PRM) + (size_t)l * PRM_STRIDE + P_N1, (bf16*)(ws + WS_XN))); } SEAM(sb + 0); }
        if (EN(1) && RUN(sb + 1)) { _Pragma("unroll 1") for (int rp = 0; rp <= (int)REP(1); ++rp) { relaunder(F, args.ws, (LAS unsigned char*)lds_raw); unsigned char* ws = F.ws;
            pg8::Gemm g{(const bf16*)(ws + WS_XN), (const bf16*)(ws + WS_WIN) + (size_t)l * NINP * D, D, D, D};
            pg8::StaticOrder So; So.init(S, NINP - 256, F.G, F.bid); pg8::EpiIn E{ws, 0, (const LAS float*)(F.lds + RTAB_OFF)};
            pg8::fill_rstd((LAS float*)(F.lds + RTAB_OFF), (const float*)(ws + WS_RSSA), So, F.tid);
            DUP(6, (pg8::gemm_phase<pg8::EpiIn, pg8::StaticOrder, true>(F.lds, g, So, E, F.tid)));
            } SEAM(sb + 1);
        }
        if (EN(2) && RUN(sb + 2)) { _Pragma("unroll 1") for (int rp = 0; rp <= (int)REP(2); ++rp) { relaunder(F, args.ws, (LAS unsigned char*)lds_raw); unsigned char* ws = F.ws;
            if (F.bid >= F.G - 32) {
                pg8::Gemm g{(const bf16*)(ws + WS_XN), (const bf16*)(ws + WS_WIN) + ((size_t)l * NINP + (NINP - 256)) * D, D, D, D};
                pg8::StaticOrder So; So.init(S, 256, 32, F.bid - (F.G - 32)); pg8::EpiMisc E{ws, (const LAS float*)(F.lds + RTAB_OFF)};
                pg8::fill_rstd((LAS float*)(F.lds + RTAB_OFF), (const float*)(ws + WS_RSSA), So, F.tid);
                pg8::gemm_phase<pg8::EpiMisc, pg8::StaticOrder, true>(F.lds, g, So, E, F.tid);
            } else {
                const int Gs = F.G; F.G = Gs - 32;
                DUP(12, p_rwkv_prep(F, l));
                relaunder(F, args.ws, (LAS unsigned char*)lds_raw); F.G = Gs - 32; DUP(13, p_mamba_prep(F, l));
                __syncthreads(); relaunder(F, args.ws, (LAS unsigned char*)lds_raw); F.G = Gs - 32;
                for (int u = F.bid; u < 512; u += F.G) DUP(5, u_ret_kv(F, u >> 2, u & 3));
                F.G = Gs;
            }
            } SEAM(sb + 2);
        }
        if (EN(3) && RUN(sb + 3)) { _Pragma("unroll 1") for (int rp = 0; rp <= (int)REP(3); ++rp) { relaunder(F, args.ws, (LAS unsigned char*)lds_raw); unsigned char* ws = F.ws;
            { pg8::Gemm g{(const bf16*)(ws + WS_CQ), (const bf16*)(ws + WS_WQB) + (size_t)l * 1024 * 512, 512, 512, 512};
              pg8::StaticOrder So; So.init(S, 1024, F.G, F.bid); pg8::EpiQb E{ws, (const float*)(ws + WS_PRM) + (size_t)l * PRM_STRIDE + P_QNW};
              pg8::gemm_phase<pg8::EpiQb, pg8::StaticOrder, false>(F.lds, g, So, E, F.tid); __syncthreads(); }
            relaunder(F, args.ws, (LAS unsigned char*)lds_raw); ws = F.ws;
            { pg8::Gemm g{(const bf16*)(ws + WS_CKV), (const bf16*)(ws + WS_WKVB) + (size_t)l * 1024 * 256, 256, 256, 256};
              pg8::StaticOrder So; So.init(S, 1024, F.G, (F.bid + 128) % F.G); pg8::EpiKvb E{ws, (const float*)(ws + WS_PRM) + (size_t)l * PRM_STRIDE + P_KNW};
              pg8::gemm_phase<pg8::EpiKvb, pg8::StaticOrder, false>(F.lds, g, So, E, F.tid); __syncthreads(); }
            relaunder(F, args.ws, (LAS unsigned char*)lds_raw); ws = F.ws;
            if (l > 0) { pg8::Gemm g{(const bf16*)(ws + WS_VV), (const bf16*)(ws + WS_WV1) + (size_t)l * 256 * 512, 512, 512, 512};
              pg8::StaticOrder So; So.init(S, 256, F.G, (F.bid + 64) % F.G); pg8::EpiV1 E{ws};
              pg8::gemm_phase<pg8::EpiV1, pg8::StaticOrder, true>(F.lds, g, So, E, F.tid); __syncthreads(); }
            relaunder(F, args.ws, (LAS unsigned char*)lds_raw);
            for (int u = F.bid; u < 256; u += F.G) { u_mamba_dt(F, l, u >> 1); DUP(4, u_mamba_st(F, u >> 1, u & 1)); }
            } SEAM(sb + 3);
        }
        if (EN(4) && RUN(sb + 4)) { _Pragma("unroll 1") for (int rp = 0; rp <= (int)REP(4); ++rp) { relaunder(F, args.ws, (LAS unsigned char*)lds_raw); unsigned char* ws = F.ws;
            {
              pg8::Gemm g{(const bf16*)(ws + WS_ALORA), (const bf16*)(ws + WS_WLORA) + (size_t)l * 2048 * 512, 512, 512, 512};
              pg8::StaticOrder So; So.init(S, l > 0 ? 2048 : 1536, F.G, F.bid);
              const float* prm = (const float*)(ws + WS_PRM) + (size_t)l * PRM_STRIDE; pg8::EpiLora E{ws, prm + P_W0, prm + P_A0, prm + P_V0, prm + P_KA};
              DUP(9, (pg8::gemm_phase<pg8::EpiLora, pg8::StaticOrder, true>(F.lds, g, So, E, F.tid))); }
            } SEAM(sb + 4);
        }
        if (EN(5) && RUN(sb + 5)) { _Pragma("unroll 1") for (int rp = 0; rp <= (int)REP(5); ++rp) { relaunder(F, args.ws, (LAS unsigned char*)lds_raw); unsigned char* ws = F.ws; (void)ws;
            if (F.bid < 64) { p_scans(F, 64); relaunder(F, args.ws, (LAS unsigned char*)lds_raw);
                for (int u = F.bid * 2; u < F.bid * 2 + 2; ++u) u_rwkv_r1(F, u >> 3, u & 7); }
            else { for (int u = 128 + (F.bid - 64); u < 1024; u += F.G - 64) u_rwkv_r1(F, u >> 3, u & 7); }
            } SEAM(sb + 5);
        }
        if (EN(6) && RUN(sb + 6)) { _Pragma("unroll 1") for (int rp = 0; rp <= (int)REP(6); ++rp) { relaunder(F, args.ws, (LAS unsigned char*)lds_raw); unsigned char* ws = F.ws; (void)ws;
            if (F.bid < NSCAN_BLK) { p_rwkv_scan2(F, F.bid); }
            else {
                const int NB = F.G - NSCAN_BLK, b = F.bid - NSCAN_BLK;
                { const int* tab = (const int*)(ws + WS_ATAB);
                  for (int r = 0; r * NB < ATT_NSUB; ++r) { const int pos = (r & 1) ? NB - 1 - b : b; const int i = r * NB + pos;
                      if (i < ATT_NSUB) { const int e = tab[i]; DUP(0, u_attn2(F, e & 3, (e >> 2) & 31, (e >> 7) & 31, e >> 12)); } } }
            }
            } SEAM(sb + 6);
        }
        if (EN(7) && RUN(sb + 7)) { _Pragma("unroll 1") for (int rp = 0; rp <= (int)REP(7); ++rp) { relaunder(F, args.ws, (LAS unsigned char*)lds_raw); unsigned char* ws = F.ws; (void)ws;
            for (int u = F.bid; u < 1024; u += F.G) DUP(3, u_rwkv_r3(F, l, u >> 3, u & 7));
            for (int u = F.bid; u < 512; u += F.G) DUP(10, u_attn_comb(F, u >> 7, (u >> 2) & 31, u & 3));
            relaunder(F, args.ws, (LAS unsigned char*)lds_raw);
            for (int u = F.bid; u < 256; u += F.G) DUP(2, u_mamba_out(F, l, u >> 1, u & 1));
            relaunder(F, args.ws, (LAS unsigned char*)lds_raw);
            for (int u = F.bid; u < 512; u += F.G) DUP(1, u_ret_out(F, l, u >> 2, u & 3));
            } SEAM(sb + 7);
        }
        if (EN(8) && RUN(sb + 8)) { _Pragma("unroll 1") for (int rp = 0; rp <= (int)REP(8); ++rp) { relaunder(F, args.ws, (LAS unsigned char*)lds_raw); unsigned char* ws = F.ws;
            pg8::Gemm g{(const bf16*)(ws + WS_OB), (const bf16*)(ws + WS_WBR) + (size_t)l * 8192 * 512, 512, D, 512};
            pg8::BranchOrder So; So.init(F.G, F.bid); pg8::EpiBranch E{ws};
            DUP(8, (pg8::gemm_phase<pg8::EpiBranch, pg8::BranchOrder, true>(F.lds, g, So, E, F.tid)));
            } SEAM(sb + 8);
        }
        if (EN(9) && RUN(sb + 9)) { _Pragma("unroll 1") for (int rp = 0; rp <= (int)REP(9); ++rp) { relaunder(F, args.ws, (LAS unsigned char*)lds_raw); unsigned char* ws = F.ws;
            pg8::Gemm g{(const bf16*)(ws + WS_MERGED), (const bf16*)(ws + WS_WOUT) + (size_t)l * D * D, D, D, D};
            pg8::StaticOrder So; So.init(S, D, F.G, F.bid); pg8::EpiRes E{xin, args.out, (bf16*)(ws + WS_XN), (float*)(ws + WS_RSSB)};
            pg8::gemm_phase<pg8::EpiRes, pg8::StaticOrder, true>(F.lds, g, So, E, F.tid);
            } SEAM(sb + 9);
        }
        if (EN(10) && RUN(sb + 10)) { _Pragma("unroll 1") for (int rp = 0; rp <= (int)REP(10); ++rp) { relaunder(F, args.ws, (LAS unsigned char*)lds_raw); unsigned char* ws = F.ws; DUP(11, p_rmsnorm(F, args.out, (const float*)(ws + WS_PRM) + (size_t)l * PRM_STRIDE + P_N2, (bf16*)(ws + WS_XN))); } SEAM(sb + 10); }
        if (EN(11) && RUN(sb + 11)) { _Pragma("unroll 1") for (int rp = 0; rp <= (int)REP(11); ++rp) { relaunder(F, args.ws, (LAS unsigned char*)lds_raw); unsigned char* ws = F.ws;
            pg8::Gemm g{(const bf16*)(ws + WS_XN), (const bf16*)(ws + WS_WGU) + (size_t)l * 2 * DFF * D, D, D, D};
            pg8::StaticOrder So; So.init(S, 2 * DFF, F.G, F.bid); pg8::EpiGu E{ws, (const LAS float*)(F.lds + RTAB_OFF)};
            pg8::fill_rstd((LAS float*)(F.lds + RTAB_OFF), (const float*)(ws + WS_RSSB), So, F.tid);
            DUP(7, (pg8::gemm_phase<pg8::EpiGu, pg8::StaticOrder, true>(F.lds, g, So, E, F.tid)));
            } SEAM(sb + 11);
        }
        if (EN(12) && RUN(sb + 12)) { _Pragma("unroll 1") for (int rp = 0; rp <= (int)REP(12); ++rp) { relaunder(F, args.ws, (LAS unsigned char*)lds_raw); unsigned char* ws = F.ws;
            pg8::Gemm g{(const bf16*)(ws + WS_ACT), (const bf16*)(ws + WS_WDN) + (size_t)l * D * DFF, DFF, DFF, DFF};
            pg8::StaticOrder So; So.init(S, D, F.G, F.bid); pg8::EpiRes E{args.out, args.out, (bf16*)(ws + WS_XN), (l + 1 < DEPTH) ? (float*)(ws + WS_RSSA) : nullptr};
            pg8::gemm_phase<pg8::EpiRes, pg8::StaticOrder, true>(F.lds, g, So, E, F.tid);
            } SEAM(sb + 12);
        }
    }
#undef RUN
#undef SEAM
}

#ifndef MK_ONE_LAUNCH
#define MK_ONE_LAUNCH 1
#endif
extern "C" void kernel_launch(void* const* d_in, const int* in_sizes, int n_in, void* d_out, int out_size, void* d_ws, size_t ws_size, hipStream_t stream) {
    static int grid = 0;
    if (grid == 0) {
        if (n_in != 36 || in_sizes[0] != S * D || out_size != S * D || ws_size < WS_END3) { fprintf(stderr, "kernel_launch: bad shapes: n_in %d in0 %d out %d ws %zu (need %zu)\n", n_in, n_in > 0 ? in_sizes[0] : -1, out_size, ws_size, (size_t)WS_END3); grid = -1; return; }
        int dev = 0, cus = 0, per_cu = 0;
        if (hipGetDevice(&dev) != hipSuccess || hipDeviceGetAttribute(&cus, hipDeviceAttributeMultiprocessorCount, dev) != hipSuccess) { grid = -1; return; }
        if (hipFuncSetAttribute((const void*)mk_fwd, hipFuncAttributeMaxDynamicSharedMemorySize, LDS_BYTES) != hipSuccess) { fprintf(stderr, "kernel_launch: hipFuncSetAttribute failed\n"); grid = -1; return; }
        if (hipOccupancyMaxActiveBlocksPerMultiprocessor(&per_cu, (const void*)mk_fwd, NTHR, LDS_BYTES) != hipSuccess || per_cu < 1) fprintf(stderr, "kernel_launch: occupancy query says %d\n", per_cu);
        (void)hipGetLastError();
        grid = cus;
        if (grid != 256) fprintf(stderr, "kernel_launch: %d CUs (built for 256)\n", grid);
    }
    if (grid < 0) return;
    if (hipMemsetAsync((char*)d_ws + WS_CTL, 0, CTL_ZERO_BYTES, stream) != hipSuccess) return;
    Args a{};
    for (int i = 0; i < 36; ++i) a.in[i] = (const float*)d_in[i];
    a.out = (float*)d_out; a.ws = (unsigned char*)d_ws;
#if MK_ONE_LAUNCH
    a.st_lo = 0; a.st_hi = NSTEPS;
    hipLaunchKernelGGL(mk_fwd, dim3(grid), dim3(NTHR), LDS_BYTES, stream, a);
#ifndef MK_EXTRA_FLAGS
#define MK_EXTRA_FLAGS 0
#endif
#ifdef MK_EXTRA_STEPS
    { const int xs[] = {MK_EXTRA_STEPS};
      for (int r = 0; r < MK_EXTRA_N; ++r) for (unsigned i = 0; i < sizeof(xs) / sizeof(xs[0]); ++i) { a.st_lo = xs[i]; a.st_hi = xs[i] + 1; hipLaunchKernelGGL(mk_fwd, dim3(grid), dim3(NTHR), LDS_BYTES, stream, a); } }
#endif
#else
    for (int s = 0; s < NSTEPS; ++s) { a.st_lo = s; a.st_hi = s + 1; hipLaunchKernelGGL(mk_fwd, dim3(grid), dim3(NTHR), LDS_BYTES, stream, a); }
#endif
}
```

```cpp
#include <hip/hip_runtime.h>
#include <cstdio>
#include <cstdint>

#define GAS __attribute__((address_space(1)))
#define LAS __attribute__((address_space(3)))
typedef unsigned short bf16;
typedef short bf16x8 __attribute__((ext_vector_type(8)));
typedef short s16x4 __attribute__((ext_vector_type(4)));
typedef float f32x4 __attribute__((ext_vector_type(4)));
typedef float f32x2 __attribute__((ext_vector_type(2)));
typedef unsigned u32x4 __attribute__((ext_vector_type(4)));
typedef unsigned u32x2 __attribute__((ext_vector_type(2)));
typedef GAS unsigned gu32;
#define RLX_AGENT __ATOMIC_RELAXED, __HIP_MEMORY_SCOPE_AGENT
#define DI __device__ __forceinline__

constexpr int S = 8192, D = 2048, DEPTH = 4, NIN = 14408, NINP = 14592, DFF = 5632;
constexpr int NCH = 128;
constexpr float LOG2E = 1.4426950408889634f;

DI float bf2f(unsigned v) { return __uint_as_float(v << 16); }
typedef __bf16 bf16x2_t __attribute__((ext_vector_type(2)));
DI unsigned pk2(float lo, float hi) { const f32x2 v = {lo, hi}; const bf16x2_t b = __builtin_convertvector(v, bf16x2_t); return __builtin_bit_cast(unsigned, b); }
DI unsigned f2bf(float f) { const __bf16 b = (__bf16)f; return (unsigned)__builtin_bit_cast(unsigned short, b); }
DI float fexp_(float x) { return __builtin_amdgcn_exp2f(x * 1.4426950408889634f); }
DI float ftanh_(float x) { return 1.0f - 2.0f * __builtin_amdgcn_rcpf(1.0f + fexp_(2.0f * x)); }
DI float sigmoidf_(float x) { return __builtin_amdgcn_rcpf(1.0f + fexp_(-x)); }
DI float siluf_(float x) { return x * __builtin_amdgcn_rcpf(1.0f + fexp_(-x)); }
DI float softplusf_(float x) { return fmaxf(x, 0.f) + log1pf(fexp_(-fabsf(x))); }
DI u32x4 pack8(const f32x4 a, const f32x4 b) { u32x4 w; w.x = pk2(a[0], a[1]); w.y = pk2(a[2], a[3]); w.z = pk2(b[0], b[1]); w.w = pk2(b[2], b[3]); return w; }
DI void unpack8(const u32x4 w, float (&o)[8]) { o[0] = bf2f(w.x & 0xffffu); o[1] = bf2f(w.x >> 16); o[2] = bf2f(w.y & 0xffffu); o[3] = bf2f(w.y >> 16);
    o[4] = bf2f(w.z & 0xffffu); o[5] = bf2f(w.z >> 16); o[6] = bf2f(w.w & 0xffffu); o[7] = bf2f(w.w >> 16); }

namespace pg8 {
constexpr int BM = 256, BK = 64, HALF = 128, HTB = HALF * BK * 2, STAGE_BYTES = 8 * HTB, NXCD = 8, WGM = 8;
DI int lds_byte(int r, int c) { const int st = (r >> 4) * 2 + (c >> 5), rr = r & 15, cc = c & 31, ob = rr * 64 + cc * 2; return st * 1024 + (ob ^ (((ob >> 9) & 1) << 5)); }
DI void stage_rc(int b, int& R, int& C) { const int st = b / 1024, sb = b % 1024, swz = sb ^ (((sb >> 9) & 1) << 5); R = (st >> 1) * 16 + swz / 64; C = (st & 1) * 32 + (swz % 64) / 2; }
DI int perm32(int rho) { const int n = rho >> 4, i = rho & 15; return 8 * (i >> 2) + 4 * n + (i & 3); }

struct Unit { int pm, pn, ak, brow, sub, ord; };
struct Gemm { const bf16* A; const bf16* Bt; int K, lda, ldb; };

struct StaticOrder {
    int nM, nN, nwg, G, c;
    DI void init(int M, int N, int G_, int c_) { nM = M / BM; nN = N / BM; nwg = nM * nN; G = G_; c = c_; }
    DI bool next(int i, Unit& u) const {
        const long L = (long)i * G + c; if (L >= nwg) return false;
        int wgid = (int)L; { const int q = nwg / NXCD, r = nwg % NXCD, xcd = wgid % NXCD, off = wgid / NXCD; wgid = (xcd < r ? xcd * (q + 1) : r * (q + 1) + (xcd - r) * q) + off; }
        const int nig = WGM * nN, gid = wgid / nig, fm = gid * WGM, gsz = (nM - fm) < WGM ? (nM - fm) : WGM;
        u.pm = fm + ((wgid % nig) % gsz); u.pn = (wgid % nig) / gsz; u.ak = 0; u.brow = u.pn * BM; u.sub = 0; return true;
    }
};
struct LoraOrder {
    StaticOrder so;
    DI void init(int N, int G_, int c_) { so.init(S, N, G_, c_); }
    DI bool next(int i, Unit& u) const { if (!so.next(i, u)) return false; u.ak = (u.pn >= 4) ? 256 : 0; return true; }
};
struct BranchOrder {
    StaticOrder so;
    DI void init(int G_, int c_) { so.init(S, D, G_, c_); }
    DI bool next(int i, Unit& u) const { if (!so.next(i >> 2, u)) return false; u.sub = i & 3; u.ak = u.sub * 512; u.brow = u.sub * D + u.pn * BM; return true; }
};

typedef f32x4 Acc[2][2][4][2];

template <class Epi, class Sched, bool ALIGN_EPI>
DI void gemm_phase(LAS unsigned char* lds, const Gemm g, const Sched& Sc, const Epi& E, const int tid) {
    const int wid = __builtin_amdgcn_readfirstlane(tid >> 6), lane = tid & 63, wr = wid >> 2, wc = wid & 3, fr = lane & 15, fq = lane >> 4;
    const int K = g.K, nt = K / BK;
    unsigned voffA[2], voffB[2];
#pragma unroll
    for (int i = 0; i < 2; ++i) { int R, C; stage_rc(tid * 16 + i * 8192, R, C); const int Rb = (R & ~31) + perm32(R & 31);
        voffA[i] = (unsigned)(R * g.lda + C) * 2u; voffB[i] = (unsigned)(Rb * g.ldb + C) * 2u; }
    const size_t kstep = (size_t)(BK * 2);
    const size_t hA = (size_t)HALF * g.lda * 2, hB = (size_t)HALF * g.ldb * 2;
    const unsigned ldsw = (unsigned)wid * 1024u;
    const int aoff = lds_byte(wr * 64 + fr, fq * 8), boff = lds_byte(wc * 32 + fr, fq * 8);
#define PG8_SA(b, h) (((b) * 2 + (h)) * HTB)
#define PG8_SB(b, h) ((4 + (b) * 2 + (h)) * HTB)
#define PG8_STAGE(bufoff, gbase, voff) do { _Pragma("unroll") for (int _i = 0; _i < 2; ++_i) \
        __builtin_amdgcn_global_load_lds((const unsigned*)((const char*)(gbase) + (voff)[_i]), (LAS unsigned*)(lds + (bufoff) + ldsw + _i * 8192), 16, 0, 0); } while (0)
#define PG8_LDA(dst, b, h) do { _Pragma("unroll") for (int m = 0; m < 4; ++m) _Pragma("unroll") for (int k = 0; k < 2; ++k) dst[m][k] = *(const LAS bf16x8*)(lds + PG8_SA(b, h) + aoff + m * 2048 + k * 1024); } while (0)
#define PG8_LDB(dst, b, h) do { _Pragma("unroll") for (int n = 0; n < 2; ++n) _Pragma("unroll") for (int k = 0; k < 2; ++k) dst[n][k] = *(const LAS bf16x8*)(lds + PG8_SB(b, h) + boff + n * 2048 + k * 1024); } while (0)
#define PG8_MMA(ai, bj, At, Bt) do { __builtin_amdgcn_s_setprio(1); _Pragma("unroll") for (int m = 0; m < 4; ++m) _Pragma("unroll") for (int n = 0; n < 2; ++n) _Pragma("unroll") for (int k = 0; k < 2; ++k) \
        acc[ai][bj][m][n] = __builtin_amdgcn_mfma_f32_16x16x32_bf16(Bt[n][k], At[m][k], acc[ai][bj][m][n], 0, 0, 0); __builtin_amdgcn_s_setprio(0); } while (0)
#define PG8_WAIT_V(n) asm volatile("s_waitcnt vmcnt(" #n ")" ::: "memory")
#define PG8_WAIT_L(n) asm volatile("s_waitcnt lgkmcnt(" #n ")" ::: "memory")
#define PG8_BAR __builtin_amdgcn_s_barrier()
#define PG8_SCHED __builtin_amdgcn_sched_barrier(0)
    Unit cur, nxt; int ui = 0;
    if (!Sc.next(0, cur)) return;
    cur.ord = 0;
    Acc acc;
#pragma unroll
    for (int a = 0; a < 2; ++a)
#pragma unroll
        for (int b = 0; b < 2; ++b)
#pragma unroll
            for (int m = 0; m < 4; ++m)
#pragma unroll
                for (int n = 0; n < 2; ++n) acc[a][b][m][n] = (f32x4){0.f, 0.f, 0.f, 0.f};
    bf16x8 At[4][2], B0[2][2], B1[2][2];
    const char* cA = (const char*)g.A + ((size_t)cur.pm * BM * g.lda + cur.ak) * 2; const char* cB = (const char*)g.Bt + (size_t)cur.brow * g.ldb * 2;
    PG8_STAGE(PG8_SB(0, 0), cB, voffB); PG8_STAGE(PG8_SB(0, 1), cB + hB, voffB); PG8_STAGE(PG8_SA(0, 0), cA, voffA); PG8_STAGE(PG8_SA(0, 1), cA + hA, voffA);
    if (wr == 1) PG8_BAR;
    PG8_WAIT_V(2); PG8_BAR;
    PG8_STAGE(PG8_SB(1, 0), cB + kstep, voffB); PG8_STAGE(PG8_SA(1, 0), cA + kstep, voffA); PG8_STAGE(PG8_SB(1, 1), cB + hB + kstep, voffB);
    PG8_WAIT_V(6); PG8_BAR;
    for (;;) {
        const bool has_next = Sc.next(ui + 1, nxt); nxt.ord = ui + 1;
        const char* nA = has_next ? (const char*)g.A + ((size_t)nxt.pm * BM * g.lda + nxt.ak) * 2 : cA; const char* nB = has_next ? (const char*)g.Bt + (size_t)nxt.brow * g.ldb * 2 : cB;
        for (int t = 0; t < nt; t += 2) {
            const bool last = (t == nt - 2);
            const char* a1 = cA + (size_t)(t + 1) * kstep;
            const char* a2 = last ? nA : cA + (size_t)(t + 2) * kstep; const char* b2 = last ? nB : cB + (size_t)(t + 2) * kstep;
            const char* a3 = a2 + kstep; const char* b3 = b2 + kstep;
            PG8_LDB(B0, 0, 0); PG8_LDB(B1, 0, 1); PG8_SCHED; PG8_LDA(At, 0, 0); PG8_STAGE(PG8_SA(1, 1), a1 + hA, voffA);
            PG8_WAIT_V(8); PG8_WAIT_L(0); PG8_BAR; PG8_MMA(0, 0, At, B0); PG8_MMA(0, 1, At, B1); PG8_BAR; PG8_SCHED;
            PG8_LDA(At, 0, 1); PG8_STAGE(PG8_SB(0, 0), b2, voffB); PG8_STAGE(PG8_SB(0, 1), b2 + hB, voffB); PG8_STAGE(PG8_SA(0, 0), a2, voffA);
            PG8_WAIT_V(8); PG8_WAIT_L(0); PG8_BAR; PG8_MMA(1, 0, At, B0); PG8_MMA(1, 1, At, B1); PG8_BAR; PG8_SCHED;
            PG8_LDB(B0, 1, 0); PG8_LDB(B1, 1, 1); PG8_SCHED; PG8_LDA(At, 1, 0); PG8_STAGE(PG8_SA(0, 1), a2 + hA, voffA);
            PG8_WAIT_V(8); PG8_WAIT_L(0); PG8_BAR; PG8_MMA(0, 0, At, B0); PG8_MMA(0, 1, At, B1); PG8_BAR; PG8_SCHED;
            PG8_LDA(At, 1, 1); PG8_STAGE(PG8_SB(1, 0), b3, voffB); PG8_STAGE(PG8_SB(1, 1), b3 + hB, voffB); PG8_STAGE(PG8_SA(1, 0), a3, voffA);
            PG8_WAIT_V(8); PG8_WAIT_L(0); PG8_BAR; PG8_MMA(1, 0, At, B0); PG8_MMA(1, 1, At, B1); PG8_BAR; PG8_SCHED;
        }
        if constexpr (ALIGN_EPI) { if (wr == 0) PG8_BAR; }
        bool zero = true;
        if constexpr (!Epi::AFTER_DRAIN) { zero = E(acc, cur, wr, wc, fr, fq); }
        if (!has_next) break;
        if (zero) {
#pragma unroll
        for (int a = 0; a < 2; ++a)
#pragma unroll
            for (int b = 0; b < 2; ++b)
#pragma unroll
                for (int m = 0; m < 4; ++m)
#pragma unroll
                    for (int n = 0; n < 2; ++n) acc[a][b][m][n] = (f32x4){0.f, 0.f, 0.f, 0.f};
        }
        cur = nxt; cA = nA; cB = nB; ++ui;
        if constexpr (ALIGN_EPI) { if (wr == 1) PG8_BAR; }
    }
    PG8_WAIT_V(0);
    if constexpr (!ALIGN_EPI) { if (wr == 0) PG8_BAR; }
    PG8_BAR;
    if constexpr (Epi::AFTER_DRAIN) { E.fused(acc, cur, wr, wc, fr, fq, lds, wid, lane, tid); }
#undef PG8_SA
#undef PG8_SB
#undef PG8_STAGE
#undef PG8_LDA
#undef PG8_LDB
#undef PG8_MMA
#undef PG8_WAIT_V
#undef PG8_WAIT_L
#undef PG8_BAR
#undef PG8_SCHED
}
}

constexpr size_t MiB = 1u << 20;
constexpr size_t al256(size_t x) { return (x + 255) & ~(size_t)255; }
constexpr size_t WS_CTL = 0, CTL_ZERO_BYTES = 1 * MiB;
constexpr size_t WS_PRM = 1 * MiB;
constexpr int P_N1 = 0, P_N2 = 2048, P_GN = 4096, P_CW = 4608, P_CB = 8704, P_DTB = 9728, P_ALOG = 9736, P_SD = 9744, P_SNW = 9760, P_QNW = 10272, P_KNW = 10464, P_MU = 10656,
              P_W0 = 12448, P_A0 = 12960, P_V0 = 13472, P_KK = 13984, P_KA = 14496, P_RK = 15008, P_LNW = 15520, P_LNB = 16032, PRM_STRIDE = 16640;
constexpr size_t WS_COSR = 2 * MiB;
constexpr size_t WS_SINR = WS_COSR + (size_t)S * 64 * 4;
constexpr size_t WS_COSM = WS_SINR + (size_t)S * 64 * 4;
constexpr size_t WS_SINM = WS_COSM + (size_t)S * 32 * 4;
constexpr size_t WS_WIN  = WS_SINM + (size_t)S * 32 * 4;
constexpr size_t WS_WQB  = WS_WIN + (size_t)DEPTH * NINP * D * 2;
constexpr size_t WS_WKVB = WS_WQB + (size_t)DEPTH * 1024 * 512 * 2;
constexpr size_t WS_WV1  = WS_WKVB + (size_t)DEPTH * 1024 * 256 * 2;
constexpr size_t WS_WLORA = WS_WV1 + (size_t)DEPTH * 256 * 512 * 2;
constexpr size_t WS_WBR  = WS_WLORA + (size_t)DEPTH * 2048 * 512 * 2;
constexpr size_t WS_WOUT = WS_WBR + (size_t)DEPTH * 8192 * 512 * 2;
constexpr size_t WS_WGU  = WS_WOUT + (size_t)DEPTH * D * D * 2;
constexpr size_t WS_WDN  = WS_WGU + (size_t)DEPTH * 2 * DFF * D * 2;
constexpr size_t WS_ACT0 = WS_WDN + (size_t)DEPTH * D * DFF * 2;
constexpr size_t WS_XN   = WS_ACT0;
constexpr size_t WS_QR   = WS_XN + (size_t)S * D * 2;
constexpr size_t WS_KR   = WS_QR + (size_t)S * 512 * 2;
constexpr size_t WS_VR   = WS_KR + (size_t)S * 512 * 2;
constexpr size_t WS_GR   = WS_VR + (size_t)S * 512 * 2;
constexpr size_t WS_ZS   = WS_GR + (size_t)S * 512 * 2;
constexpr size_t WS_XBC  = WS_ZS + (size_t)S * 512 * 2;
constexpr size_t WS_XC   = WS_XBC + (size_t)S * 1024 * 2;
constexpr size_t WS_CQ   = WS_XC + (size_t)S * 1024 * 2;
constexpr size_t WS_CKV  = WS_CQ + (size_t)S * 512 * 2;
constexpr size_t WS_SSQ  = WS_CKV + (size_t)S * 256 * 2;
constexpr size_t WS_RW   = WS_SSQ + (size_t)S * 16 * 4;
constexpr size_t WS_GATE = WS_RW + (size_t)S * 1792 * 4;
constexpr size_t WS_MISC = WS_GATE + (size_t)S * 8192 * 2;
constexpr size_t WS_DTS  = WS_MISC + (size_t)S * 256 * 4;
constexpr size_t WS_ACS  = WS_DTS + (size_t)S * 8 * 4;
constexpr size_t WS_RKV  = WS_ACS + (size_t)S * 8 * 4;
constexpr size_t WS_MST  = WS_RKV + (size_t)NCH * 4 * 128 * 128 * 4;
constexpr size_t WS_QM   = WS_MST + (size_t)NCH * 8 * 64 * 128 * 4;
constexpr size_t WS_KM   = WS_QM + (size_t)S * 768 * 2;
constexpr size_t WS_VT   = WS_KM + (size_t)S * 768 * 2;
constexpr size_t WS_R32  = WS_VT + (size_t)512 * S * 2;
constexpr size_t SZ32    = (size_t)S * 512 * 4;
constexpr size_t WS_KKN  = WS_R32 + SZ32, WS_K32 = WS_KKN + SZ32, WS_VV = WS_K32 + SZ32, WS_VFIRST = WS_VV + SZ32, WS_DEC = WS_VFIRST + SZ32,
                 WS_KP = WS_DEC + SZ32, WS_BB = WS_KP + SZ32, WS_G32 = WS_BB + SZ32, WS_Y32 = WS_G32 + SZ32;
constexpr size_t WS_VB   = WS_Y32 + SZ32;
constexpr size_t WS_ALORA = WS_VB + (size_t)S * 512 * 2;
constexpr size_t WS_OB   = WS_ALORA + (size_t)S * 512 * 2;
constexpr size_t WS_MERGED = WS_OB + (size_t)S * D * 2;
constexpr size_t WS_ACT  = WS_MERGED + (size_t)S * D * 2;
constexpr size_t WS_END  = WS_ACT + (size_t)S * DFF * 2;

constexpr int CW_TMO = 0, CW_CODE = 1, CW_BAR = 4096;


constexpr int NWAVES = 8, NTHR = 512;
constexpr int RING_BYTES = 143360, LDSCTL_OFF = RING_BYTES, MISC_OFF = LDSCTL_OFF + 320, LDS_BYTES = 147456;
#define LDS_WAIT() asm volatile("s_waitcnt lgkmcnt(0)" ::: "memory")
#define VM_WAIT() asm volatile("s_waitcnt vmcnt(0)" ::: "memory")

#define XB_TMO      128
#define XB_XCNT(j)  (256  + 64 * (j))
#define XB_XSUB(j)  (1280 + 64 * (j))
#define XB_XGEN(j)  (2304 + 64 * (j))
#define XB_TOP      3328
#define XB_TOPGEN   3392
#define XCD_BAR_WORDS 3456
#define XB_SPIN_CAP (1u << 22)
DI unsigned xb_ld(unsigned* p)              { return __hip_atomic_load(p, __ATOMIC_RELAXED, __HIP_MEMORY_SCOPE_AGENT); }
DI unsigned xb_add(unsigned* p, unsigned v) { return __hip_atomic_fetch_add(p, v, __ATOMIC_RELAXED, __HIP_MEMORY_SCOPE_AGENT); }
DI unsigned xb_xcc_id() { return (unsigned)__builtin_amdgcn_s_getreg((3 << 11) | 20) & 0xFu; }
#define XB_SPIN(cond, bar) do { unsigned _sp = 0; while (cond) { __builtin_amdgcn_s_sleep(1); \
    if ((++_sp & 255u) == 0u) { if (xb_ld(&(bar)[XB_TMO])) break; if (_sp > XB_SPIN_CAP) { atomicAdd(&(bar)[XB_TMO], 1u); break; } } } } while (0)
struct XcdBarrier { unsigned* bar; unsigned x; volatile LAS unsigned* st; };
DI XcdBarrier xcd_barrier_post(unsigned* bar, volatile LAS unsigned* st) {
    XcdBarrier b; b.bar = bar; b.x = xb_xcc_id(); b.st = st;
    if (threadIdx.x == 0) (void)xb_add(&bar[XB_XCNT(b.x)], 1u);
    return b;
}
DI void xcd_barrier_complete(unsigned* bar, unsigned x, unsigned& nloc, unsigned& nx) {
    const unsigned G = gridDim.x * gridDim.y * gridDim.z;
    unsigned sum, cnt, mine, sp = 0u;
    for (;;) {
        sum = 0u; cnt = 0u; mine = 0u;
#pragma unroll
        for (unsigned j = 0; j < 16; ++j) { const unsigned c = xb_ld(&bar[XB_XCNT(j)]); sum += c; cnt += (c > 0u) ? 1u : 0u; mine = (j == x) ? c : mine; }
        if (sum == G) break;
        __builtin_amdgcn_s_sleep(1);
        if ((++sp & 255u) == 0u) { if (xb_ld(&bar[XB_TMO])) break; if (sp > XB_SPIN_CAP) { atomicAdd(&bar[XB_TMO], 1u); break; } }
    }
    nloc = mine > 0u ? mine : 1u; nx = cnt > 0u ? cnt : 1u;
}
DI void xcd_barrier(const XcdBarrier& b) {
    asm volatile("s_waitcnt vmcnt(0)" ::: "memory");
    __syncthreads();
    if (threadIdx.x == 0) {
        unsigned* bar = b.bar;
        __builtin_amdgcn_s_waitcnt(0);
        unsigned nloc = b.st[0], nx = b.st[1];
        if (nloc == 0u) { xcd_barrier_complete(bar, b.x, nloc, nx); b.st[0] = nloc; b.st[1] = nx; }
        const unsigned old = xb_add(&bar[XB_XSUB(b.x)], 1u);
        const unsigned gen = old / nloc;
        if (old + 1u == (gen + 1u) * nloc) {
            __builtin_amdgcn_fence(__ATOMIC_RELEASE, "agent");
            asm volatile("s_waitcnt vmcnt(0)" ::: "memory");
            const unsigned og = xb_add(&bar[XB_TOP], 1u);
            const unsigned tg = og / nx;
            if (og + 1u == (tg + 1u) * nx) xb_add(&bar[XB_TOPGEN], 1u);
            else XB_SPIN(xb_ld(&bar[XB_TOPGEN]) == tg, bar);
            __builtin_amdgcn_fence(__ATOMIC_ACQUIRE, "agent");
            xb_add(&bar[XB_XGEN(b.x)], 1u);
            asm volatile("s_waitcnt vmcnt(0)" ::: "memory");
        } else {
            XB_SPIN(xb_ld(&bar[XB_XGEN(b.x)]) == gen, bar);
            __builtin_amdgcn_fence(__ATOMIC_ACQUIRE, "agent");
            asm volatile("s_waitcnt vmcnt(0)" ::: "memory");
        }
    }
    __syncthreads();
}

struct Args { const float* in[36]; float* out; unsigned char* ws; int st_lo, st_hi; };
struct Frame {
    LAS unsigned char* lds; volatile LAS unsigned* MISC; gu32* ctl;
    int tid, lane, wave, G, bid;
    unsigned char* ws;
};
DI void relaunder(Frame& F, unsigned char* ws0, LAS unsigned char* lds0) {
    int t = threadIdx.x; asm volatile("" : "+v"(t)); F.tid = t; F.lane = t & 63; F.wave = __builtin_amdgcn_readfirstlane(t >> 6);
    unsigned long long w = (unsigned long long)ws0; asm volatile("" : "+s"(w)); F.ws = (unsigned char*)w; F.ctl = (gu32*)(F.ws + WS_CTL);
    unsigned lb = (unsigned)(unsigned long)lds0; asm volatile("" : "+s"(lb)); F.lds = (LAS unsigned char*)(unsigned long)lb; F.MISC = (volatile LAS unsigned*)(F.lds + MISC_OFF);
    int b = blockIdx.x; asm volatile("" : "+s"(b)); F.bid = b;
}
#define XR_SWAP(INS, a, b) asm volatile("s_nop 1\n\t" INS " %0, %1" : "+v"(a), "+v"(b))
DI float xr16_max(float x) { float a = x, b = x; XR_SWAP("v_permlane16_swap_b32", a, b); return fmaxf(a, b); }
DI float xr32_max(float x) { float a = x, b = x; XR_SWAP("v_permlane32_swap_b32", a, b); return fmaxf(a, b); }
DI float xr16_sum(float x) { float a = x, b = x; XR_SWAP("v_permlane16_swap_b32", a, b); return a + b; }
DI float xr32_sum(float x) { float a = x, b = x; XR_SWAP("v_permlane32_swap_b32", a, b); return a + b; }
template <int CTRL> DI float dpp_f(float v) { return __builtin_bit_cast(float, __builtin_amdgcn_update_dpp(0, __builtin_bit_cast(int, v), CTRL, 0xf, 0xf, true)); }
DI float row_sum16(float v) { v += dpp_f<0xB1>(v); v += dpp_f<0x4E>(v); v += dpp_f<0x141>(v); v += dpp_f<0x140>(v); return v; }
DI float wave_sum(float v) { return xr32_sum(xr16_sum(row_sum16(v))); }
DI float wave_sum_dpp(float v) {
    const float t = row_sum16(v);
    const float s0 = __builtin_bit_cast(float, __builtin_amdgcn_readlane(__builtin_bit_cast(int, t), 0));
    const float s1 = __builtin_bit_cast(float, __builtin_amdgcn_readlane(__builtin_bit_cast(int, t), 16));
    const float s2 = __builtin_bit_cast(float, __builtin_amdgcn_readlane(__builtin_bit_cast(int, t), 32));
    const float s3 = __builtin_bit_cast(float, __builtin_amdgcn_readlane(__builtin_bit_cast(int, t), 48));
    return (s0 + s1) + (s2 + s3);
}
constexpr size_t WS_QYT = WS_END;
constexpr size_t WS_CYT = WS_QYT + (size_t)1024 * 4096 * 2;
constexpr size_t WS_TST = WS_CYT + (size_t)1024 * 4096 * 2;
constexpr size_t WS_NST = WS_TST + (size_t)1024 * 4096 * 2;
constexpr size_t WS_S0  = WS_NST + (size_t)1024 * 4096 * 4;
constexpr size_t WS_END2 = WS_S0 + (size_t)1024 * 4096 * 2;
constexpr int ATT_NSUB = 576, ATT_RUN = 16;
constexpr size_t WS_ATAB = WS_END2;
constexpr size_t WS_APO  = WS_ATAB + 8192;
constexpr size_t WS_APM  = WS_APO + (size_t)ATT_NSUB * 32768 * 4;
constexpr size_t WS_RSSA = WS_APM + (size_t)ATT_NSUB * 512 * 4;
constexpr size_t WS_RSSB = WS_RSSA + (size_t)S * 32 * 4;
constexpr size_t WS_END3 = WS_RSSB + (size_t)S * 32 * 4;
constexpr int RTAB_OFF = 131072;
DI int att_slot(int h, int qb, int s) { const int g = qb >> 2; return h * 144 + (g + 1) * (qb - 2 * g) + s; }

DI int map_in(int n) {
    const int T = n >> 8, c = n & 255;
    if (T < 4) { const int base = (T >> 1) * 512, tp = T & 1, half = c >> 7, hs = (c >> 6) & 1, j = c & 63; return base + (2 * tp + hs) * 128 + half * 64 + j; }
    if (T < 6) return 1024 + (T - 4) * 256 + c;
    if (T < 8) return 1536 + (T - 6) * 256 + c;
    if (T < 10) return 2048 + (T - 8) * 256 + c;
    if (T < 14) return 2560 + (T - 10) * 256 + c;
    if (T < 16) return 3592 + (T - 14) * 256 + c;
    if (T == 16) return 4104 + c;
    if (T < 24) return 4424 + (T - 17) * 256 + c;
    if (T < 56) {
        const int j = T - 24, bj = c >> 7, wc = (c >> 5) & 3, fq = (c >> 3) & 3, n = (c >> 2) & 1, i = c & 3; return 6216 + (2 * bj + n) * 2048 + 64 * j + wc * 16 + fq * 4 + i; }
    if (c < 8) return 3584 + c;
    if (c < 72) return 4360 + (c - 8);
    return -1;
}
DI int map_fn(int mapid, int n, int Nsrc) {
    if (mapid == 0) return n < Nsrc ? n : -1;
    if (mapid == 1) return map_in(n);
    if (mapid == 2) { const int T = n >> 8, c = n & 255; return c < 128 ? T * 128 + c : DFF + T * 128 + (c - 128); }
    if (mapid == 3) { const int h = n >> 8, c = n & 255; if (c < 96) return h * 192 + c; if (c < 128) return h * 192 + 128 + (c - 96); if (c < 160) return h * 192 + 96 + (c - 128); if (c < 224) return -1; return h * 192 + 160 + (c - 224); }
    return n < 32 ? n : -1;
}
DI void conv_item(const float* W, int K, int Nsrc, bf16* Wt, const float* kscale, int mapid, LAS bf16* tile, int item, int nblk, int lane) {
    const int kb = item / nblk, nb = item - kb * nblk, k0 = 64 * kb, n0 = 64 * nb;
    const int src = map_fn(mapid, n0 + lane, Nsrc);
    const float* wp = W + (size_t)k0 * Nsrc + (src >= 0 ? src : 0);
    float v[64];
#pragma unroll
    for (int i = 0; i < 64; ++i) v[i] = wp[(size_t)i * Nsrc];
    if (src < 0) {
#pragma unroll
        for (int i = 0; i < 64; ++i) v[i] = 0.f; }
    if (kscale) {
#pragma unroll
        for (int i = 0; i < 64; ++i) v[i] *= kscale[k0 + i]; }
#pragma unroll
    for (int q = 0; q < 8; ++q) { u32x4 o; o.x = pk2(v[8 * q], v[8 * q + 1]); o.y = pk2(v[8 * q + 2], v[8 * q + 3]); o.z = pk2(v[8 * q + 4], v[8 * q + 5]); o.w = pk2(v[8 * q + 6], v[8 * q + 7]);
        *(LAS u32x4*)(tile + lane * 72 + 8 * q) = o; }
    LDS_WAIT(); asm volatile("" ::: "memory");
#pragma unroll
    for (int i = 0; i < 8; ++i) { const int r = i * 8 + (lane >> 3), c8 = lane & 7;
        *(GAS u32x4*)(Wt + (size_t)(n0 + r) * K + k0 + 8 * c8) = *(const LAS u32x4*)(tile + r * 72 + 8 * c8); }
    LDS_WAIT(); asm volatile("" ::: "memory");
}
struct ConvJob { const float* W; bf16* Wt; const float* kscale; int K, Nsrc, Ndst, mapid; };
DI void conv_job(Frame& F, const ConvJob j, int& base) {
    const int nblk = j.Ndst / 64, nitems = (j.K / 64) * nblk, NGW = F.G * NWAVES, gw = F.bid * NWAVES + F.wave;
    int first = (gw - base % NGW + NGW) % NGW; LAS bf16* tile = (LAS bf16*)(F.lds + F.wave * 16384);
    for (int it = first; it < nitems; it += NGW) conv_item(j.W, j.K, j.Nsrc, j.Wt, j.kscale, j.mapid, tile, it, nblk, F.lane);
    base += nitems;
}
DI void p_prologue(Frame& F, const Args& a) {
    unsigned char* ws = F.ws;
    const int gt = F.bid * NTHR + F.tid, NGT = F.G * NTHR;
    if (F.bid == 0 && F.tid == 0) { int* tab = (int*)(ws + WS_ATAB); int n = 0;
        for (int pass = 16; pass >= 4; pass -= 4)
            for (int qb = 31; qb >= 0; --qb) { const int nt = 4 * (qb + 1), nfull = nt >> 4, rem = nt & 15;
                for (int h = 0; h < 4; ++h) {
                    if (pass == 16) { for (int s2 = 0; s2 < nfull; ++s2) tab[n++] = h | (qb << 2) | (s2 << 7) | (16 << 12); }
                    else if (rem == pass) tab[n++] = h | (qb << 2) | (nfull << 7) | (rem << 12); } }
        for (; n < 2048; ++n) tab[n] = 0; }
    { float* prm = (float*)(ws + WS_PRM);
#define CPV(IDX, N, OFF, SRC_L) for (int e = gt; e < (N); e += NGT) prm[(size_t)l * PRM_STRIDE + (OFF) + e] = a.in[IDX][(size_t)(SRC_L) * (N) + e];
      for (int l = 0; l < DEPTH; ++l) {
          CPV(2, 2048, P_N1, l) CPV(33, 2048, P_N2, l) CPV(4, 512, P_GN, l) CPV(5, 4096, P_CW, l) CPV(6, 1024, P_CB, l) CPV(7, 8, P_DTB, l) CPV(8, 8, P_ALOG, l) CPV(9, 8, P_SD, l)
          CPV(10, 512, P_SNW, l) CPV(15, 192, P_QNW, l) CPV(16, 192, P_KNW, l) CPV(17, 1792, P_MU, l) CPV(18, 512, P_W0, l) CPV(20, 512, P_A0, l)
          CPV(23, 512, P_V0, (l > 0 ? l - 1 : 0)) CPV(26, 512, P_KK, l) CPV(27, 512, P_KA, l) CPV(28, 512, P_RK, l) CPV(29, 512, P_LNW, l) CPV(30, 512, P_LNB, l)
      }
#undef CPV
    }
    const int* pos = (const int*)a.in[1];
    for (int e = gt; e < S * 64; e += NGT) { const int t = e >> 6, i = e & 63;
        const float inv = 1.0f / powf(10000.0f, (float)(2 * i) / 128.0f); const float ang = (float)pos[t] * inv;
        double rev = (double)ang * 0.15915494309189535; rev -= rint(rev); const float r = (float)(rev * 6.283185307179586);
        ((float*)(ws + WS_COSR))[e] = __cosf(r); ((float*)(ws + WS_SINR))[e] = __sinf(r); }
    for (int e = gt; e < S * 32; e += NGT) { const int t = e >> 5, i = e & 31;
        const float inv = 1.0f / powf(10000.0f, (float)(2 * i) / 64.0f); const float ang = (float)pos[t] * inv;
        double rev = (double)ang * 0.15915494309189535; rev -= rint(rev); const float r = (float)(rev * 6.283185307179586);
        ((float*)(ws + WS_COSM))[e] = __cosf(r); ((float*)(ws + WS_SINM))[e] = __sinf(r); }
    for (int l = 0; l < DEPTH; ++l) {
        const float* w2 = a.in[19] + (size_t)l * 64 * 512; const float* a2 = a.in[21] + (size_t)l * 64 * 512; const float* g2 = a.in[22] + (size_t)l * 128 * 512;
        const float* v2 = a.in[25] + (size_t)(l > 0 ? l - 1 : 0) * 32 * 512;
        bf16* Lt = (bf16*)(ws + WS_WLORA) + (size_t)l * 2048 * 512;
        for (int w = gt; w < 2048 * 64; w += NGT) { const int kg = w >> 11, n = w & 2047, seg = n >> 9, j = n & 511; float v[8];
#pragma unroll
            for (int i = 0; i < 8; ++i) { const int k = kg * 8 + i; float x = 0.f;
                if (seg == 0) { if (k < 64) x = w2[k * 512 + j]; }
                else if (seg == 1) { if (k >= 128 && k < 192) x = a2[(k - 128) * 512 + j]; }
                else if (seg == 2) { if (k >= 256 && k < 384) x = g2[(k - 256) * 512 + j]; }
                else { if (l > 0 && k >= 384 && k < 416) x = v2[(k - 384) * 512 + j]; }
                v[i] = x; }
            u32x4 o; o.x = pk2(v[0], v[1]); o.y = pk2(v[2], v[3]); o.z = pk2(v[4], v[5]); o.w = pk2(v[6], v[7]);
            *(GAS u32x4*)(Lt + (size_t)n * 512 + kg * 8) = o; }
    }
    { const int gw = F.bid * NWAVES + F.wave, NGW = F.G * NWAVES; float* rss = (float*)(ws + WS_RSSA);
      for (int m = gw; m < S; m += NGW) { const GAS f32x4* xr = (const GAS f32x4*)(a.in[0] + (size_t)m * D) + F.lane; GAS u32x2* o8 = (GAS u32x2*)((bf16*)(ws + WS_XN) + (size_t)m * D) + F.lane; float sq = 0.f;
#pragma unroll
          for (int j = 0; j < 8; ++j) { const f32x4 v = xr[64 * j]; sq += (v.x * v.x + v.y * v.y) + (v.z * v.z + v.w * v.w); u32x2 o; o.x = pk2(v.x, v.y); o.y = pk2(v.z, v.w); o8[64 * j] = o; }
          sq = wave_sum(sq); if (F.lane < 32) rss[(size_t)m * 32 + F.lane] = (F.lane == 0) ? sq : 0.f; } }
    int base = 0;
    for (int l = 0; l < DEPTH; ++l) {
        conv_job(F, ConvJob{a.in[3] + (size_t)l * D * NIN, (bf16*)(ws + WS_WIN) + (size_t)l * NINP * D, a.in[2] + (size_t)l * D, D, NIN, NINP, 1}, base);
        conv_job(F, ConvJob{a.in[34] + (size_t)l * D * 2 * DFF, (bf16*)(ws + WS_WGU) + (size_t)l * 2 * DFF * D, a.in[33] + (size_t)l * D, D, 2 * DFF, 2 * DFF, 2}, base);
        conv_job(F, ConvJob{a.in[35] + (size_t)l * DFF * D, (bf16*)(ws + WS_WDN) + (size_t)l * D * DFF, nullptr, DFF, D, D, 0}, base);
        conv_job(F, ConvJob{a.in[32] + (size_t)l * D * D, (bf16*)(ws + WS_WOUT) + (size_t)l * D * D, nullptr, D, D, D, 0}, base);
        for (int n = 0; n < 4; ++n)
            conv_job(F, ConvJob{a.in[31] + ((size_t)l * 4 + n) * 512 * D, (bf16*)(ws + WS_WBR) + ((size_t)l * 4 + n) * D * 512, nullptr, 512, D, D, 0}, base);
        conv_job(F, ConvJob{a.in[12] + (size_t)l * 512 * 768, (bf16*)(ws + WS_WQB) + (size_t)l * 1024 * 512, a.in[11] + (size_t)l * 512, 512, 768, 1024, 3}, base);
        conv_job(F, ConvJob{a.in[14] + (size_t)l * 256 * 1024, (bf16*)(ws + WS_WKVB) + (size_t)l * 1024 * 256, a.in[13] + (size_t)l * 256, 256, 1024, 1024, 0}, base);
        if (l > 0) conv_job(F, ConvJob{a.in[24] + (size_t)(l - 1) * 512 * 32, (bf16*)(ws + WS_WV1) + (size_t)l * 256 * 512, nullptr, 512, 32, 256, 4}, base);
    }
}

DI void p_rmsnorm(Frame& F, const float* x, const float* w, bf16* out) {
    const int gw = F.bid * NWAVES + F.wave, NGW = F.G * NWAVES;
    for (int m = gw; m < S; m += NGW) {
        const GAS f32x4* xr = (const GAS f32x4*)(x + (size_t)m * D) + F.lane; f32x4 v[8]; float s = 0.f;
#pragma unroll
        for (int j = 0; j < 8; ++j) { v[j] = xr[64 * j]; s += (v[j].x * v[j].x + v[j].y * v[j].y) + (v[j].z * v[j].z + v[j].w * v[j].w); }
        const float rstd = rsqrtf(wave_sum(s) * (1.f / D) + 1e-6f);
        const GAS f32x4* wr = (const GAS f32x4*)w + F.lane;
        GAS u32x2* o8 = (GAS u32x2*)(out + (size_t)m * D) + F.lane;
#pragma unroll
        for (int j = 0; j < 8; ++j) { const f32x4 ww = wr[64 * j]; u32x2 o; o.x = pk2(v[j].x * rstd * ww.x, v[j].y * rstd * ww.y); o.y = pk2(v[j].z * rstd * ww.z, v[j].w * rstd * ww.w); o8[64 * j] = o; }
    }
}

DI f32x4 bf4_(const u32x2 w) { return (f32x4){bf2f(w.x & 0xffffu), bf2f(w.x >> 16), bf2f(w.y & 0xffffu), bf2f(w.y >> 16)}; }
DI u32x2 pk4_(const f32x4 v) { u32x2 o; o.x = pk2(v.x, v.y); o.y = pk2(v.z, v.w); return o; }
DI void p_rwkv_prep(Frame& F, int l) {
    unsigned char* ws = F.ws;
    const bf16* RW = (const bf16*)(ws + WS_RW); const float* prm = (const float*)(ws + WS_PRM) + (size_t)l * PRM_STRIDE; const float* mu = prm + P_MU; const float* kk_w = prm + P_KK;
    const int gw = F.bid * NWAVES + F.wave, NGW = F.G * NWAVES, lane = F.lane;
    for (int t = gw; t < S; t += NGW) {
        const GAS u32x2* p = (const GAS u32x2*)(RW + (size_t)t * 1792) + lane; const GAS u32x2* pp = (const GAS u32x2*)(RW + (size_t)(t > 0 ? t - 1 : 0) * 1792) + lane;
        const GAS f32x4* m4 = (const GAS f32x4*)mu + lane;
        f32x4 pm[7];
#pragma unroll
        for (int j = 0; j < 7; ++j) { const f32x4 c = bf4_(p[64 * j]); f32x4 pv = bf4_(pp[64 * j]); if (t == 0) pv = (f32x4){0.f, 0.f, 0.f, 0.f}; pm[j] = c + (pv - c) * m4[64 * j]; }
        const size_t ro = (size_t)t * 512;
        *((GAS u32x2*)((bf16*)(ws + WS_R32) + ro) + lane) = pk4_(pm[0]); *((GAS u32x2*)((bf16*)(ws + WS_R32) + ro) + 64 + lane) = pk4_(pm[1]);
#pragma unroll
        for (int j = 0; j < 2; ++j) { const f32x4 k = pm[2 + j]; const f32x4 kw = *((const GAS f32x4*)kk_w + 64 * j + lane); const f32x4 kk = k * kw;
            float ss = (kk.x * kk.x + kk.y * kk.y) + (kk.z * kk.z + kk.w * kk.w);
            ss = row_sum16(ss);
            const float inv = fminf(__builtin_amdgcn_rsqf(ss), 1e12f);
            *((GAS u32x2*)((bf16*)(ws + WS_K32) + ro) + 64 * j + lane) = pk4_(k);
            *((GAS u32x2*)((bf16*)(ws + WS_KKN) + ro) + 64 * j + lane) = pk4_(kk * inv); }
#pragma unroll
        for (int j = 0; j < 2; ++j) { const u32x2 vb = pk4_(pm[4 + j]);
            *((GAS u32x2*)((bf16*)(ws + WS_VV) + ro) + 64 * j + lane) = vb;
            if (l == 0) *((GAS u32x2*)((bf16*)(ws + WS_VFIRST) + ro) + 64 * j + lane) = vb; }
        { const f32x4 x = pm[6]; f32x4 y; int dst;
            if (lane < 16) { y = (f32x4){ftanh_(x.x), ftanh_(x.y), ftanh_(x.z), ftanh_(x.w)}; dst = 4 * lane; }
            else if (lane < 32) { y = x; dst = 128 + 4 * (lane - 16); }
            else { y = (f32x4){sigmoidf_(x.x), sigmoidf_(x.y), sigmoidf_(x.z), sigmoidf_(x.w)}; dst = 256 + 4 * (lane - 32); }
            bf16* ar = (bf16*)(ws + WS_ALORA) + (size_t)t * 512;
            *(GAS u32x2*)(ar + dst) = pk4_(y);
            const int z = 4 * lane; const int zd = z < 64 ? 64 + z : (z < 128 ? 192 + (z - 64) : 384 + (z - 128));
            unsigned zz = 0u; asm volatile("" : "+v"(zz));
            *(GAS u32x2*)(ar + zd) = (u32x2){zz, zz}; }
    }
}

DI void p_mamba_prep(Frame& F, int l) {
    unsigned char* ws = F.ws;
    const bf16* XBC = (const bf16*)(ws + WS_XBC); bf16* XC = (bf16*)(ws + WS_XC);
    const float* prm = (const float*)(ws + WS_PRM) + (size_t)l * PRM_STRIDE; const float* cw = prm + P_CW; const float* cb = prm + P_CB;
    for (int u = F.bid; u < 2 * NCH; u += F.G) {
        const int ch = 2 * F.tid, t0 = (u >> 1) * 64 + (u & 1) * 32;
        float w0[4], w1[4];
#pragma unroll
        for (int k = 0; k < 4; ++k) { const f32x2 wv = *(const GAS f32x2*)(cw + k * 1024 + ch); w0[k] = wv.x; w1[k] = wv.y; }
        const f32x2 bv = *(const GAS f32x2*)(cb + ch);
        float h0[3], h1[3];
#pragma unroll
        for (int k = 0; k < 3; ++k) { const int t = t0 - 3 + k; unsigned x = 0u; if (t >= 0) x = *(const GAS unsigned*)(XBC + (size_t)t * 1024 + ch); h0[k] = bf2f(x & 0xffffu); h1[k] = bf2f(x >> 16); }
        unsigned xin[32];
#pragma unroll
        for (int i = 0; i < 32; ++i) xin[i] = *(const GAS unsigned*)(XBC + (size_t)(t0 + i) * 1024 + ch);
#pragma unroll
        for (int i = 0; i < 32; ++i) { const float x0 = bf2f(xin[i] & 0xffffu), x1 = bf2f(xin[i] >> 16);
            const float y0 = bv.x + w0[0] * h0[0] + w0[1] * h0[1] + w0[2] * h0[2] + w0[3] * x0, y1 = bv.y + w1[0] * h1[0] + w1[1] * h1[1] + w1[2] * h1[2] + w1[3] * x1;
            h0[0] = h0[1]; h0[1] = h0[2]; h0[2] = x0; h1[0] = h1[1]; h1[1] = h1[2]; h1[2] = x1;
            *(GAS unsigned*)(XC + (size_t)(t0 + i) * 1024 + ch) = pk2(siluf_(y0), siluf_(y1)); }
    }
}
DI void u_mamba_dt(Frame& F, int l, int c) {
    unsigned char* ws = F.ws; LAS float* A = (LAS float*)F.lds;
    const float* prm = (const float*)(ws + WS_PRM) + (size_t)l * PRM_STRIDE; const int t = F.tid >> 3, h = F.tid & 7; const size_t row = (size_t)(c * 64 + t);
    const float dt = softplusf_(((const float*)(ws + WS_MISC))[row * 256 + h] + prm[P_DTB + h]);
    A[F.tid] = dt * -fexp_(prm[P_ALOG + h]);
    ((float*)(ws + WS_DTS))[row * 8 + h] = dt;
    __syncthreads();
    float cs = 0.f;
#pragma unroll 16
    for (int tt = 0; tt < 64; ++tt) { const float v = A[tt * 8 + h]; cs += (tt <= t) ? v : 0.f; }
    ((float*)(ws + WS_ACS))[row * 8 + h] = cs;
    __syncthreads();
}

DI void p_scans(Frame& F, int nblk) {
    unsigned char* ws = F.ws;
    const int gt = F.bid * NTHR + F.tid, NGT = nblk * NTHR;
    for (int q = gt; q < 32768; q += NGT) {
        const int e = q * 4; const bool ret = e < 65536; const int e2 = ret ? e : e - 65536, h = ret ? (e >> 14) : (e2 >> 13);
        float* p = (float*)(ws + (ret ? WS_RKV : WS_MST)) + e2; const float* acs = (const float*)(ws + WS_ACS);
        const float rdec = fexp_(log1pf(-exp2f(-5.0f - (float)h)) * 64.0f);
        f32x4 st = (f32x4){0.f, 0.f, 0.f, 0.f};
#pragma unroll 1
        for (int c0 = 0; c0 < NCH; c0 += 16) { f32x4 v[16]; float dc[16];
#pragma unroll
            for (int i = 0; i < 16; ++i) v[i] = *(const GAS f32x4*)(p + (size_t)(c0 + i) * 65536);
#pragma unroll
            for (int i = 0; i < 16; ++i) dc[i] = ret ? rdec : fexp_(acs[(size_t)((c0 + i) * 64 + 63) * 8 + h]);
#pragma unroll
            for (int i = 0; i < 16; ++i) { *(GAS f32x4*)(p + (size_t)(c0 + i) * 65536) = st; st = st * dc[i] + v[i]; } }
    }
}


namespace pg8 {
DI unsigned char* lw(unsigned char* p) { unsigned long long w = (unsigned long long)p; asm volatile("" : "+s"(w)); return (unsigned char*)w; }
DI void st8bf(bf16* p, const f32x4 a, const f32x4 b) { *(GAS u32x4*)p = pack8(a, b); }
DI void st8f(float* p, const f32x4 a, const f32x4 b) { *(GAS f32x4*)p = a; *((GAS f32x4*)p + 1) = b; }
DI f32x4 map4(const f32x4 v, float (*f)(float)) { return (f32x4){f(v.x), f(v.y), f(v.z), f(v.w)}; }

DI void scale_rows(Acc& acc, const LAS float* rt, int rl0) {
#pragma unroll
    for (int ai = 0; ai < 2; ++ai)
#pragma unroll
        for (int m = 0; m < 4; ++m) { const float rs = rt[rl0 + ai * HALF + m * 16];
#pragma unroll
            for (int bj = 0; bj < 2; ++bj)
#pragma unroll
                for (int n = 0; n < 2; ++n) acc[ai][bj][m][n] = acc[ai][bj][m][n] * rs; }
}
template <class Sched> DI void fill_rstd(LAS float* rtab, const float* rss, const Sched& Sc, int tid) {
    pg8::Unit u;
    for (int i = 0; Sc.next(i, u); ++i) if (tid < 256) { const float* p = rss + (size_t)(u.pm * BM + tid) * 32; float s = 0.f;
#pragma unroll
        for (int q = 0; q < 8; ++q) { const f32x4 v = *(const GAS f32x4*)(p + 4 * q); s += (v.x + v.y) + (v.z + v.w); }
        rtab[i * 256 + tid] = rsqrtf(s * (1.f / D) + 1e-6f); }
    __syncthreads();
}
struct TileDesc { unsigned long long off; int ld, cb, kind, slot; };
constexpr TileDesc mk_tile(int T) {
    return T < 2 ? TileDesc{WS_QR, 512, 0, 0, 0} : T < 4 ? TileDesc{WS_KR, 512, 0, 1, 0}
         : T < 6 ? TileDesc{WS_VR, 512, (T - 4) * 256, 2, 0} : T < 8 ? TileDesc{WS_GR, 512, (T - 6) * 256, 3, 0} : T < 10 ? TileDesc{WS_ZS, 512, (T - 8) * 256, 3, 0}
         : T < 14 ? TileDesc{WS_XBC, 1024, (T - 10) * 256, 2, 0} : T < 16 ? TileDesc{WS_CQ, 512, (T - 14) * 256, 5, (T - 14) * 4} : T == 16 ? TileDesc{WS_CKV, 256, 0, 5, 8}
         : T < 24 ? TileDesc{WS_RW, 1792, (T - 17) * 256, 2, 0} : T < 56 ? TileDesc{WS_GATE, 8192, (T - 24) * 64, 7, 0} : TileDesc{WS_MISC, 256, 0, 6, 0};
}
struct TileTab { TileDesc d[57]; };
constexpr TileTab mk_tiletab() { TileTab t{}; for (int i = 0; i < 57; ++i) t.d[i] = mk_tile(i); return t; }
__constant__ TileTab g_tiletab = mk_tiletab();

struct EpiIn {
    static constexpr bool AFTER_DRAIN = false;
    unsigned char* ws_; int tile_off; const LAS float* rtab;
    DI bool operator()(Acc& acc, const Unit& u, int wr, int wc, int fr, int fq) const {
        unsigned char* ws = lw(ws_);
        const int T = u.pn + tile_off, row0 = u.pm * BM + wr * 64 + fr, c0 = wc * 32 + fq * 8;
        scale_rows(acc, rtab + u.ord * 256, wr * 64 + fr);
        const TileDesc d = g_tiletab.d[T]; const int kind = d.kind;
        if (kind < 2) {
            const int head = 2 * (T & 1) + (c0 >> 6), j0 = c0 & 63; const float sc = kind ? 0.08838834764831845f : 1.0f;
            bf16* dst = (bf16*)(ws + d.off); const float* cs = (const float*)(ws + WS_COSR); const float* sn = (const float*)(ws + WS_SINR);
#pragma unroll
            for (int ai = 0; ai < 2; ++ai)
#pragma unroll
                for (int m = 0; m < 4; ++m) { const int row = row0 + ai * HALF + m * 16;
                    const f32x4 ca = *(const GAS f32x4*)(cs + (size_t)row * 64 + j0), cb = *(const GAS f32x4*)(cs + (size_t)row * 64 + j0 + 4);
                    const f32x4 sa = *(const GAS f32x4*)(sn + (size_t)row * 64 + j0), sb = *(const GAS f32x4*)(sn + (size_t)row * 64 + j0 + 4);
                    const f32x4 x1a = acc[ai][0][m][0], x1b = acc[ai][0][m][1], x2a = acc[ai][1][m][0], x2b = acc[ai][1][m][1];
                    bf16* o = dst + (size_t)row * 512 + head * 128 + j0;
                    st8bf(o, (x1a * ca - x2a * sa) * sc, (x1b * cb - x2b * sb) * sc);
                    st8bf(o + 64, (x2a * ca + x1a * sa) * sc, (x2b * cb + x1b * sb) * sc); }
            return true;
        }
        if (kind == 7) {
            bf16* dst = (bf16*)(ws + d.off) + d.cb + wc * 16 + fq * 4;
#pragma unroll
            for (int ai = 0; ai < 2; ++ai)
#pragma unroll
                for (int m = 0; m < 4; ++m) { const size_t ro = (size_t)(row0 + ai * HALF + m * 16) * 8192; f32x4 sv[4], gv[4];
#pragma unroll
                    for (int nb = 0; nb < 4; ++nb) { const f32x4 x = acc[ai][nb >> 1][m][nb & 1];
#pragma unroll
                        for (int i = 0; i < 4; ++i) { const float sk = 1.0f + fminf(fexp_(-x[i]), 1e30f); sv[nb][i] = sk; gv[nb][i] = __builtin_amdgcn_rcpf(sk); } }
                    *(GAS u32x2*)(dst + ro) = pk4_(gv[0] * sv[1]); *(GAS u32x2*)(dst + ro + 2048) = pk4_(gv[1] * sv[2]);
                    *(GAS u32x2*)(dst + ro + 4096) = pk4_(gv[2] * sv[3]); *(GAS u32x2*)(dst + ro + 6144) = pk4_(gv[3]); }
            return true;
        }
        if (kind == 6) {
            float* dst = (float*)(ws + d.off) + d.cb + c0;
#pragma unroll
            for (int ai = 0; ai < 2; ++ai)
#pragma unroll
                for (int m = 0; m < 4; ++m) { const int row = row0 + ai * HALF + m * 16;
#pragma unroll
                    for (int bj = 0; bj < 2; ++bj) st8f(dst + (size_t)row * d.ld + bj * HALF, acc[ai][bj][m][0], acc[ai][bj][m][1]); }
            return true;
        }
        {
            bf16* dst = (bf16*)(ws + d.off) + d.cb + c0; float* ssq = (float*)(ws + WS_SSQ) + d.slot + wc;
            const float am = (kind == 3 || kind == 4) ? 1.f : 0.f, xm = (kind == 4) ? 0.f : 1.f;
#pragma unroll
            for (int ai = 0; ai < 2; ++ai)
#pragma unroll
                for (int m = 0; m < 4; ++m) { const int row = row0 + ai * HALF + m * 16; float ss = 0.f;
#pragma unroll
                    for (int bj = 0; bj < 2; ++bj) { f32x4 a = acc[ai][bj][m][0], b = acc[ai][bj][m][1];
                        ss += (a.x * a.x + a.y * a.y) + (a.z * a.z + a.w * a.w) + (b.x * b.x + b.y * b.y) + (b.z * b.z + b.w * b.w);
                        if (am != 0.f) {
#pragma unroll
                            for (int i = 0; i < 4; ++i) { const float s0 = sigmoidf_(a[i]), s1 = sigmoidf_(b[i]); a[i] = (xm != 0.f) ? a[i] * s0 : s0; b[i] = (xm != 0.f) ? b[i] * s1 : s1; } }
                        st8bf(dst + (size_t)row * d.ld + bj * HALF, a, b); }
                    if (kind == 5) { ss = xr32_sum(xr16_sum(ss)); if (fq == 0) ssq[(size_t)row * 16] = ss; } }
        }
        return true;
    }
};

struct EpiMisc {
    static constexpr bool AFTER_DRAIN = false;
    unsigned char* ws_; const LAS float* rtab;
    DI bool operator()(Acc& acc, const Unit& u, int wr, int wc, int fr, int fq) const {
        float* dst = (float*)(lw(ws_) + WS_MISC) + wc * 32 + fq * 8; const int row0 = u.pm * BM + wr * 64 + fr;
        scale_rows(acc, rtab + u.ord * 256, wr * 64 + fr);
#pragma unroll
        for (int ai = 0; ai < 2; ++ai)
#pragma unroll
            for (int m = 0; m < 4; ++m) { const int row = row0 + ai * HALF + m * 16;
#pragma unroll
                for (int bj = 0; bj < 2; ++bj) st8f(dst + (size_t)row * 256 + bj * HALF, acc[ai][bj][m][0], acc[ai][bj][m][1]); }
        return true;
    }
};

struct EpiQb {
    static constexpr bool AFTER_DRAIN = true;
    unsigned char* ws; const float* qnw;
    DI bool operator()(Acc&, const Unit&, int, int, int, int) const { return true; }
    DI void fused(Acc& acc, const Unit& u, int wr, int wc, int fr, int fq, LAS unsigned char* lds, int wid, int lane, int tid) const {
        const int h = u.pn, row0 = u.pm * BM + wr * 64 + fr, c0 = wc * 32 + fq * 8;
        const float* ssq = (const float*)(ws + WS_SSQ); LAS float* P = (LAS float*)lds;
        const float QS = 0.07216878364870322f * LOG2E;
#pragma unroll
        for (int ai = 0; ai < 2; ++ai)
#pragma unroll
            for (int m = 0; m < 4; ++m) { const int row = row0 + ai * HALF + m * 16, rl = ai * HALF + wr * 64 + m * 16 + fr;
                const f32x4 s0 = *(const GAS f32x4*)(ssq + (size_t)row * 16), s1 = *(const GAS f32x4*)(ssq + (size_t)row * 16 + 4);
                const float rs = rsqrtf(((s0.x + s0.y) + (s0.z + s0.w) + (s1.x + s1.y) + (s1.z + s1.w)) * (1.f / 512.f) + 1e-6f);
                float ss = 0.f;
#pragma unroll
                for (int bj = 0; bj < 2; ++bj)
#pragma unroll
                    for (int n = 0; n < 2; ++n) { f32x4 a = acc[ai][bj][m][n] * rs; acc[ai][bj][m][n] = a; ss += (a.x * a.x + a.y * a.y) + (a.z * a.z + a.w * a.w); }
                ss = xr32_sum(xr16_sum(ss));
                if (fq == 0) P[rl * 4 + wc] = ss; }
        __syncthreads();
        bf16* QM = (bf16*)(ws + WS_QM); const float* cs = (const float*)(ws + WS_COSM); const float* sn = (const float*)(ws + WS_SINM);
#pragma unroll
        for (int ai = 0; ai < 2; ++ai)
#pragma unroll
            for (int m = 0; m < 4; ++m) { const int row = row0 + ai * HALF + m * 16, rl = ai * HALF + wr * 64 + m * 16 + fr;
                const f32x4 pp = *(const LAS f32x4*)(P + rl * 4); const float rq = rsqrtf(((pp.x + pp.y) + (pp.z + pp.w)) * (1.f / 192.f) + 1e-6f) * QS;
                bf16* o = QM + (size_t)row * 768 + h * 192;
                if (wc < 3) {
                    const f32x4 wa = *(const GAS f32x4*)(qnw + c0), wb = *(const GAS f32x4*)(qnw + c0 + 4);
                    st8bf(o + c0, acc[ai][0][m][0] * rq * wa, acc[ai][0][m][1] * rq * wb);
                    if (wc == 0) { const f32x4 wc4 = *(const GAS f32x4*)(qnw + 96 + c0), wd = *(const GAS f32x4*)(qnw + 100 + c0);
                        st8bf(o + 96 + c0, acc[ai][1][m][0] * rq * wc4, acc[ai][1][m][1] * rq * wd); }
                } else {
                    const int i0 = 8 * fq;
                    const f32x4 w1a = *(const GAS f32x4*)(qnw + 128 + i0), w1b = *(const GAS f32x4*)(qnw + 132 + i0), w2a = *(const GAS f32x4*)(qnw + 160 + i0), w2b = *(const GAS f32x4*)(qnw + 164 + i0);
                    const f32x4 ca = *(const GAS f32x4*)(cs + (size_t)row * 32 + i0), cb = *(const GAS f32x4*)(cs + (size_t)row * 32 + i0 + 4), sa = *(const GAS f32x4*)(sn + (size_t)row * 32 + i0), sb = *(const GAS f32x4*)(sn + (size_t)row * 32 + i0 + 4);
                    const f32x4 x1a = acc[ai][0][m][0] * rq * w1a, x1b = acc[ai][0][m][1] * rq * w1b, x2a = acc[ai][1][m][0] * rq * w2a, x2b = acc[ai][1][m][1] * rq * w2b;
                    st8bf(o + 128 + i0, x1a * ca - x2a * sa, x1b * cb - x2b * sb);
                    st8bf(o + 160 + i0, x2a * ca + x1a * sa, x2b * cb + x1b * sb);
                } }
        __syncthreads();
    }
};

struct EpiKvb {
    static constexpr bool AFTER_DRAIN = true;
    unsigned char* ws; const float* knw;
    DI bool operator()(Acc&, const Unit&, int, int, int, int) const { return true; }
    DI void fused(Acc& acc, const Unit& u, int wr, int wc, int fr, int fq, LAS unsigned char* lds, int wid, int lane, int tid) const {
        const int h = u.pn, row0 = u.pm * BM + wr * 64 + fr, c0 = wc * 32 + fq * 8;
        const float* ssq = (const float*)(ws + WS_SSQ); const float* misc = (const float*)(ws + WS_MISC);
        LAS float* P = (LAS float*)lds; LAS float* KRS = P + 1024; LAS float* RK = P + 1280;
        LAS bf16* VTs = (LAS bf16*)(lds + 8192);
        if (tid < 256) { const float* kr = misc + (size_t)(u.pm * BM + tid) * 256 + 8; float s = 0.f;
#pragma unroll
            for (int i = 0; i < 16; ++i) { const f32x4 v = *(const GAS f32x4*)(kr + 4 * i); s += (v.x * v.x + v.y * v.y) + (v.z * v.z + v.w * v.w); }
            KRS[tid] = s; }
#pragma unroll
        for (int ai = 0; ai < 2; ++ai)
#pragma unroll
            for (int m = 0; m < 4; ++m) { const int row = row0 + ai * HALF + m * 16, rl = ai * HALF + wr * 64 + m * 16 + fr;
                const f32x4 s0 = *(const GAS f32x4*)(ssq + (size_t)row * 16 + 8);
                const float rs = rsqrtf(((s0.x + s0.y) + (s0.z + s0.w)) * (1.f / 256.f) + 1e-6f);
                float ss = 0.f;
#pragma unroll
                for (int bj = 0; bj < 2; ++bj)
#pragma unroll
                    for (int n = 0; n < 2; ++n) { f32x4 a = acc[ai][bj][m][n] * rs; acc[ai][bj][m][n] = a; if (bj == 0) ss += (a.x * a.x + a.y * a.y) + (a.z * a.z + a.w * a.w); }
                ss = xr32_sum(xr16_sum(ss));
                if (fq == 0) P[rl * 4 + wc] = ss; }
        __syncthreads();
        if (tid < 256) { const f32x4 pp = *(const LAS f32x4*)(P + tid * 4); RK[tid] = rsqrtf(((pp.x + pp.y) + (pp.z + pp.w) + KRS[tid]) * (1.f / 192.f) + 1e-6f); }
        __syncthreads();
        bf16* KM = (bf16*)(ws + WS_KM); bf16* VT = (bf16*)(ws + WS_VT);
        const f32x4 wa = *(const GAS f32x4*)(knw + c0), wb = *(const GAS f32x4*)(knw + c0 + 4);
#pragma unroll
        for (int ai = 0; ai < 2; ++ai)
#pragma unroll
            for (int m = 0; m < 4; ++m) { const int row = row0 + ai * HALF + m * 16, rl = ai * HALF + wr * 64 + m * 16 + fr;
                const float rk = RK[rl];
                st8bf(KM + (size_t)row * 768 + h * 192 + c0, acc[ai][0][m][0] * rk * wa, acc[ai][0][m][1] * rk * wb);
#pragma unroll
                for (int n = 0; n < 2; ++n)
#pragma unroll
                    for (int i = 0; i < 4; ++i) VTs[(c0 + n * 4 + i) * 264 + rl] = (bf16)f2bf(acc[ai][1][m][n][i]); }
        {
            const int rl = tid >> 1, hf = tid & 1, row = u.pm * BM + rl, i0 = 16 * hf; const float rk = RK[rl];
            const float* kr = misc + (size_t)row * 256 + 8; const float* cs = (const float*)(ws + WS_COSM) + (size_t)row * 32; const float* sn = (const float*)(ws + WS_SINM) + (size_t)row * 32;
            bf16* o = KM + (size_t)row * 768 + h * 192 + 128;
#pragma unroll
            for (int q = 0; q < 2; ++q) { f32x4 o1[2], o2[2];
#pragma unroll
                for (int e = 0; e < 2; ++e) { const int i = i0 + 8 * q + 4 * e;
                    const f32x4 x1 = *(const GAS f32x4*)(kr + i) * *(const GAS f32x4*)(knw + 128 + i), x2 = *(const GAS f32x4*)(kr + 32 + i) * *(const GAS f32x4*)(knw + 160 + i);
                    const f32x4 c = *(const GAS f32x4*)(cs + i), s = *(const GAS f32x4*)(sn + i);
                    o1[e] = (x1 * c - x2 * s) * rk; o2[e] = (x2 * c + x1 * s) * rk; }
                st8bf(o + i0 + 8 * q, o1[0], o1[1]); st8bf(o + 32 + i0 + 8 * q, o2[0], o2[1]); }
        }
        __syncthreads();
#pragma unroll
        for (int k = 0; k < 8; ++k) { const int p = tid + 512 * k, dv = p >> 5, c8 = (p & 31) * 8; *(GAS u32x4*)(VT + (size_t)(h * 128 + dv) * S + u.pm * BM + c8) = *(const LAS u32x4*)(VTs + dv * 264 + c8); }
        __syncthreads();
    }
};

struct EpiV1 {
    static constexpr bool AFTER_DRAIN = false;
    unsigned char* ws_;
    DI bool operator()(Acc& acc, const Unit& u, int wr, int wc, int fr, int fq) const {
        if (wc != 0) return true;
        unsigned char* ws = lw(ws_);
        const int row0 = u.pm * BM + wr * 64 + fr; bf16* dst = (bf16*)(ws + WS_ALORA);
#pragma unroll
        for (int ai = 0; ai < 2; ++ai)
#pragma unroll
            for (int m = 0; m < 4; ++m) { const int row = row0 + ai * HALF + m * 16; st8bf(dst + (size_t)row * 512 + 384 + fq * 8, acc[ai][0][m][0], acc[ai][0][m][1]); }
        return true;
    }
};

struct EpiLora {
    static constexpr bool AFTER_DRAIN = false;
    unsigned char* ws_; const float* w0; const float* a0; const float* v0; const float* ka;
#define LORA_LOOP(BODY) _Pragma("unroll") for (int ai = 0; ai < 2; ++ai) _Pragma("unroll") for (int m = 0; m < 4; ++m) { const size_t ro = (size_t)(row0 + ai * HALF + m * 16) * 512; \
        _Pragma("unroll") for (int bj = 0; bj < 2; ++bj) _Pragma("unroll") for (int n = 0; n < 2; ++n) { const int j = jb + bj * HALF + n * 4; const size_t o = ro + j; const f32x4 x = acc[ai][bj][m][n]; BODY } }
    DI bool operator()(Acc& acc, const Unit& u, int wr, int wc, int fr, int fq) const {
        unsigned char* ws = lw(ws_);
        const int seg = u.pn >> 1, row0 = u.pm * BM + wr * 64 + fr, jb = (u.pn & 1) * 256 + wc * 32 + fq * 8;
        if (seg == 0) { float* dec = (float*)(ws + WS_DEC);
            LORA_LOOP({ const f32x4 b = *(const GAS f32x4*)(w0 + j); f32x4 r;
                _Pragma("unroll") for (int i = 0; i < 4; ++i) { const float u_ = b[i] + x[i]; const float sp = fmaxf(-u_, 0.f) + __logf(1.0f + fexp_(-fabsf(u_))); r[i] = -fexp_(-sp - 0.5f); }
                *(GAS f32x4*)(dec + o) = r; })
        } else if (seg == 1) { const bf16* k32 = (const bf16*)(ws + WS_K32); const bf16* kkn_ = (const bf16*)(ws + WS_KKN); bf16* kp_ = (bf16*)(ws + WS_KP); bf16* bb_ = (bf16*)(ws + WS_BB);
            LORA_LOOP({ const f32x4 b = *(const GAS f32x4*)(a0 + j); const f32x4 kav = *(const GAS f32x4*)(ka + j);
                const u32x2 kw = *(const GAS u32x2*)(k32 + o); const u32x2 nw = *(const GAS u32x2*)(kkn_ + o);
                const f32x4 k = bf4_(kw); const f32x4 kkn = bf4_(nw); f32x4 kp; f32x4 bb;
                _Pragma("unroll") for (int i = 0; i < 4; ++i) { const float av = sigmoidf_(b[i] + x[i]); kp[i] = k[i] * (1.0f + (av - 1.0f) * kav[i]); bb[i] = kkn[i] * av; }
                *(GAS u32x2*)(kp_ + o) = pk4_(kp); *(GAS u32x2*)(bb_ + o) = pk4_(bb); })
        } else if (seg == 2) { bf16* g32 = (bf16*)(ws + WS_G32);
            LORA_LOOP({ *(GAS u32x2*)(g32 + o) = pk4_(x); })
        } else { bf16* vv = (bf16*)(ws + WS_VV); const bf16* vf_ = (const bf16*)(ws + WS_VFIRST);
            LORA_LOOP({ const f32x4 b = *(const GAS f32x4*)(v0 + j); const u32x2 vw = *(const GAS u32x2*)(vv + o); const u32x2 fw = *(const GAS u32x2*)(vf_ + o);
                const f32x4 v = bf4_(vw); const f32x4 vf = bf4_(fw); f32x4 r;
                _Pragma("unroll") for (int i = 0; i < 4; ++i) r[i] = v[i] + (vf[i] - v[i]) * sigmoidf_(b[i] + x[i]);
                *(GAS u32x2*)(vv + o) = pk4_(r); })
        }
        return true;
    }
#undef LORA_LOOP
};

struct EpiBranch {
    static constexpr bool AFTER_DRAIN = false;
    unsigned char* ws_;
    DI bool operator()(Acc& acc, const Unit& u, int wr, int wc, int fr, int fq) const {
        unsigned char* ws = lw(ws_);
        const int nb = u.sub, row0 = u.pm * BM + wr * 64 + fr, cb = u.pn * BM + wc * 32 + fq * 8;
        const bf16* G = (const bf16*)(ws + WS_GATE) + nb * D; bf16* M = (bf16*)(ws + WS_MERGED);
#pragma unroll
        for (int ai = 0; ai < 2; ++ai)
#pragma unroll
            for (int m = 0; m < 4; ++m) { const int row = row0 + ai * HALF + m * 16;
#pragma unroll
                for (int bj = 0; bj < 2; ++bj) { const int col = cb + bj * HALF;
                    float g[8]; unpack8(*(const GAS u32x4*)(G + (size_t)row * 8192 + col), g);
                    const f32x4 a = acc[ai][bj][m][0] * (f32x4){g[0], g[1], g[2], g[3]}, b = acc[ai][bj][m][1] * (f32x4){g[4], g[5], g[6], g[7]};
                    if (nb < 3) { acc[ai][bj][m][0] = a; acc[ai][bj][m][1] = b; } else st8bf(M + (size_t)row * D + col, a, b); } }
        return nb == 3;
    }
};

struct EpiRes {
    static constexpr bool AFTER_DRAIN = false;
    const float* xin; float* out; bf16* xb; float* rss;
    DI bool operator()(Acc& acc, const Unit& u, int wr, int wc, int fr, int fq) const {
        const int row0 = u.pm * BM + wr * 64 + fr, cb = u.pn * BM + wc * 32 + fq * 8;
#pragma unroll
        for (int ai = 0; ai < 2; ++ai)
#pragma unroll
            for (int m = 0; m < 4; ++m) { const int row = row0 + ai * HALF + m * 16; float ss = 0.f;
#pragma unroll
                for (int bj = 0; bj < 2; ++bj) { const size_t o = (size_t)row * D + cb + bj * HALF;
                    const f32x4 a = *(const GAS f32x4*)(xin + o) + acc[ai][bj][m][0], b = *(const GAS f32x4*)(xin + o + 4) + acc[ai][bj][m][1];
                    st8f(out + o, a, b); st8bf(xb + o, a, b);
                    ss += (a.x * a.x + a.y * a.y) + (a.z * a.z + a.w * a.w) + (b.x * b.x + b.y * b.y) + (b.z * b.z + b.w * b.w); }
                if (rss) { ss = xr32_sum(xr16_sum(ss)); if (fq == 0) rss[(size_t)row * 32 + u.pn * 4 + wc] = ss; } }
        return true;
    }
};

struct EpiGu {
    static constexpr bool AFTER_DRAIN = false;
    unsigned char* ws_; const LAS float* rtab;
    DI bool operator()(Acc& acc, const Unit& u, int wr, int wc, int fr, int fq) const {
        unsigned char* ws = lw(ws_);
        scale_rows(acc, rtab + u.ord * 256, wr * 64 + fr);
        const int row0 = u.pm * BM + wr * 64 + fr, cb = u.pn * 128 + wc * 32 + fq * 8; bf16* A = (bf16*)(ws + WS_ACT);
#pragma unroll
        for (int ai = 0; ai < 2; ++ai)
#pragma unroll
            for (int m = 0; m < 4; ++m) { const int row = row0 + ai * HALF + m * 16;
                st8bf(A + (size_t)row * DFF + cb, map4(acc[ai][0][m][0], siluf_) * acc[ai][1][m][0], map4(acc[ai][0][m][1], siluf_) * acc[ai][1][m][1]); }
        return true;
    }
};
}

DI bf16x8 ldfrag(const LAS bf16* M, int ld, int r0, int k0, int lane) { return *(const LAS bf16x8*)(M + (r0 + (lane & 15)) * ld + k0 + 8 * (lane >> 4)); }
#define MFMA16(a, b, c) __builtin_amdgcn_mfma_f32_16x16x32_bf16((a), (b), (c), 0, 0, 0)
DI void stage_nat(LAS bf16* dst, int lp, const bf16* src, size_t gp, int rows, int cols8, int tid) {
    for (int p = tid; p < rows * cols8; p += NTHR) { const int r = p / cols8, c = p - r * cols8; *(LAS u32x4*)(dst + r * lp + c * 8) = *(const GAS u32x4*)(src + (size_t)r * gp + c * 8); }
}
DI void stage_tr(LAS bf16* dst, int lp, const bf16* src, size_t gp, int rows, int cols8, int tid) {
    for (int p = tid; p < rows * cols8; p += NTHR) { const int r = p / cols8, c = p - r * cols8; const u32x4 w = *(const GAS u32x4*)(src + (size_t)r * gp + c * 8);
        LAS bf16* d = dst + (c * 8) * lp + r;
        d[0] = (bf16)(w.x & 0xffffu); d[lp] = (bf16)(w.x >> 16); d[2 * lp] = (bf16)(w.y & 0xffffu); d[3 * lp] = (bf16)(w.y >> 16);
        d[4 * lp] = (bf16)(w.z & 0xffffu); d[5 * lp] = (bf16)(w.z >> 16); d[6 * lp] = (bf16)(w.w & 0xffffu); d[7 * lp] = (bf16)(w.w >> 16); }
}
DI float ret_loggamma(int h) { return log1pf(-exp2f(-5.0f - (float)h)); }

DI void u_ret_kv(Frame& F, int c, int h) {
    int tid_ = F.tid; asm volatile("" : "+v"(tid_));
    unsigned char* ws = F.ws; const int tid = tid_, lane = tid_ & 63, w = F.wave;
    LAS bf16* Kt = (LAS bf16*)F.lds; LAS bf16* Vt = Kt + 128 * 72;
    const bf16* KR = (const bf16*)(ws + WS_KR) + (size_t)(c * 64) * 512 + h * 128; const bf16* VR = (const bf16*)(ws + WS_VR) + (size_t)(c * 64) * 512 + h * 128;
    const float lg = ret_loggamma(h);
    for (int p = tid; p < 1024; p += NTHR) { const int m = p >> 4, d0 = (p & 15) * 8; float k[8]; unpack8(*(const GAS u32x4*)(KR + (size_t)m * 512 + d0), k); const float sc = fexp_(lg * (float)(63 - m));
        LAS bf16* d = Kt + d0 * 72 + m;
#pragma unroll
        for (int i = 0; i < 8; ++i) d[i * 72] = (bf16)f2bf(k[i] * sc); }
    stage_tr(Vt, 72, VR, 512, 64, 16, tid);
    __syncthreads();
    f32x4 acc[8];
#pragma unroll
    for (int bn = 0; bn < 8; ++bn) acc[bn] = (f32x4){0.f, 0.f, 0.f, 0.f};
#pragma unroll
    for (int ks = 0; ks < 2; ++ks) { const bf16x8 a = ldfrag(Kt, 72, 16 * w, 32 * ks, lane);
#pragma unroll
        for (int bn = 0; bn < 8; ++bn) acc[bn] = MFMA16(a, ldfrag(Vt, 72, 16 * bn, 32 * ks, lane), acc[bn]); }
    float* out = (float*)(ws + WS_RKV) + ((size_t)(c * 4 + h) * 128) * 128;
    __syncthreads();
    { LAS float* T = (LAS float*)F.lds;
#pragma unroll
      for (int bn = 0; bn < 8; ++bn)
#pragma unroll
          for (int r = 0; r < 4; ++r) T[(16 * w + 4 * (lane >> 4) + r) * 132 + 16 * bn + (lane & 15)] = acc[bn][r];
      __syncthreads();
#pragma unroll
      for (int k = 0; k < 8; ++k) { const int p = tid + 512 * k, row = p >> 5, c4 = (p & 31) * 4; *(GAS f32x4*)(out + (size_t)row * 128 + c4) = *(const LAS f32x4*)(T + row * 132 + c4); } }
    __syncthreads();
}

DI void u_ret_out(Frame& F, int l_, int c, int h) {
    int tid_ = F.tid; asm volatile("" : "+v"(tid_));
    unsigned char* ws = F.ws; const int tid = tid_, lane = tid_ & 63, w = F.wave;
    LAS bf16* Qs = (LAS bf16*)F.lds; LAS bf16* Ks = Qs + 64 * 136; LAS bf16* Vt = Ks + 64 * 136; LAS bf16* St = Vt + 128 * 72; LAS bf16* Ps = St + 128 * 136; LAS float* Os = (LAS float*)(Ps + 64 * 72);
    const size_t rowb = (size_t)(c * 64) * 512 + h * 128;
    stage_nat(Qs, 136, (const bf16*)(ws + WS_QR) + rowb, 512, 64, 16, tid);
    stage_nat(Ks, 136, (const bf16*)(ws + WS_KR) + rowb, 512, 64, 16, tid);
    stage_tr(Vt, 72, (const bf16*)(ws + WS_VR) + rowb, 512, 64, 16, tid);
    { const float* sp = (const float*)(ws + WS_RKV) + ((size_t)(c * 4 + h) * 128) * 128;
      for (int p = tid; p < 4096; p += NTHR) { const int d = p >> 5, e0 = (p & 31) * 4; const f32x4 v = *(const GAS f32x4*)(sp + (size_t)d * 128 + e0);
          LAS bf16* q = St + e0 * 136 + d; q[0] = (bf16)f2bf(v.x); q[136] = (bf16)f2bf(v.y); q[272] = (bf16)f2bf(v.z); q[408] = (bf16)f2bf(v.w); } }
    __syncthreads();
    const float lg = ret_loggamma(h); const int g4 = lane >> 4, lc = lane & 15;
    {
        const int bm = w >> 1;
#pragma unroll
        for (int q = 0; q < 2; ++q) { const int bn = (w & 1) * 2 + q; f32x4 acc = (f32x4){0.f, 0.f, 0.f, 0.f};
#pragma unroll
            for (int ks = 0; ks < 4; ++ks) acc = MFMA16(ldfrag(Qs, 136, 16 * bm, 32 * ks, lane), ldfrag(Ks, 136, 16 * bn, 32 * ks, lane), acc);
#pragma unroll
            for (int r = 0; r < 4; ++r) { const int l = 16 * bm + 4 * g4 + r, m = 16 * bn + lc; const int dd = l > m ? l - m : m - l; Ps[l * 72 + m] = (bf16)f2bf(acc[r] * fexp_(lg * (float)dd)); } }
    }
    __syncthreads();
    {
        const int bm = w >> 1;
#pragma unroll
        for (int q = 0; q < 4; ++q) { const int bn = (w & 1) * 4 + q; f32x4 a1 = (f32x4){0.f, 0.f, 0.f, 0.f}, a2 = (f32x4){0.f, 0.f, 0.f, 0.f};
#pragma unroll
            for (int ks = 0; ks < 2; ++ks) a1 = MFMA16(ldfrag(Ps, 72, 16 * bm, 32 * ks, lane), ldfrag(Vt, 72, 16 * bn, 32 * ks, lane), a1);
#pragma unroll
            for (int ks = 0; ks < 4; ++ks) a2 = MFMA16(ldfrag(Qs, 136, 16 * bm, 32 * ks, lane), ldfrag(St, 136, 16 * bn, 32 * ks, lane), a2);
#pragma unroll
            for (int r = 0; r < 4; ++r) { const int l = 16 * bm + 4 * g4 + r; Os[l * 132 + 16 * bn + lc] = a1[r] + fexp_(lg * (float)(l + 1)) * a2[r]; } }
    }
    __syncthreads();
    { const float* gw = (const float*)(ws + WS_PRM) + (size_t)l_ * PRM_STRIDE + P_GN + h * 128; const bf16* GR = (const bf16*)(ws + WS_GR); bf16* OB = (bf16*)(ws + WS_OB);
#pragma unroll
      for (int rr = 0; rr < 8; ++rr) { const int l = 8 * w + rr; const float x0 = Os[l * 132 + lane], x1 = Os[l * 132 + 64 + lane];
          const float mean = wave_sum(x0 + x1) * (1.f / 128.f); const float d0 = x0 - mean, d1 = x1 - mean; const float rstd = rsqrtf(wave_sum(d0 * d0 + d1 * d1) * (1.f / 128.f) + 1e-5f);
          const size_t row = (size_t)(c * 64 + l);
          const float g0 = bf2f(GR[row * 512 + h * 128 + lane]), g1 = bf2f(GR[row * 512 + h * 128 + 64 + lane]);
          OB[row * D + h * 128 + lane] = (bf16)f2bf(d0 * rstd * gw[lane] * g0); OB[row * D + h * 128 + 64 + lane] = (bf16)f2bf(d1 * rstd * gw[64 + lane] * g1); } }
    __syncthreads();
}

DI void u_mamba_st(Frame& F, int c, int g) {
    int tid_ = F.tid; asm volatile("" : "+v"(tid_));
    unsigned char* ws = F.ws; const int tid = tid_, lane = tid_ & 63, w = F.wave;
    LAS bf16* Xt = (LAS bf16*)F.lds; LAS bf16* Bt = Xt + 256 * 72;
    const bf16* XC = (const bf16*)(ws + WS_XC) + (size_t)(c * 64) * 1024; const float* dts = (const float*)(ws + WS_DTS) + (size_t)(c * 64) * 8; const float* acs = (const float*)(ws + WS_ACS) + (size_t)(c * 64) * 8;
    for (int p = tid; p < 2048; p += NTHR) { const int l = p >> 5, c0 = (p & 31) * 8, h = g * 4 + (c0 >> 6); float x[8]; unpack8(*(const GAS u32x4*)(XC + (size_t)l * 1024 + g * 256 + c0), x);
        const float sc = dts[l * 8 + h] * fexp_(acs[63 * 8 + h] - acs[l * 8 + h]); LAS bf16* d = Xt + c0 * 72 + l;
#pragma unroll
        for (int i = 0; i < 8; ++i) d[i * 72] = (bf16)f2bf(x[i] * sc); }
    stage_tr(Bt, 72, XC + 512 + g * 128, 1024, 64, 16, tid);
    __syncthreads();
    f32x4 acc[2][8];
#pragma unroll
    for (int i = 0; i < 2; ++i)
#pragma unroll
        for (int bn = 0; bn < 8; ++bn) acc[i][bn] = (f32x4){0.f, 0.f, 0.f, 0.f};
#pragma unroll
    for (int ks = 0; ks < 2; ++ks) { const bf16x8 a0 = ldfrag(Xt, 72, 32 * w, 32 * ks, lane), a1 = ldfrag(Xt, 72, 32 * w + 16, 32 * ks, lane);
#pragma unroll
        for (int bn = 0; bn < 8; ++bn) { const bf16x8 b = ldfrag(Bt, 72, 16 * bn, 32 * ks, lane); acc[0][bn] = MFMA16(a0, b, acc[0][bn]); acc[1][bn] = MFMA16(a1, b, acc[1][bn]); } }
    float* out = (float*)(ws + WS_MST) + ((size_t)(c * 8 + g * 4) * 64) * 128;
    __syncthreads();
    { LAS float* T = (LAS float*)F.lds;
#pragma unroll
      for (int i = 0; i < 2; ++i)
#pragma unroll
          for (int bn = 0; bn < 8; ++bn)
#pragma unroll
              for (int r = 0; r < 4; ++r) T[(32 * w + 16 * i + 4 * (lane >> 4) + r) * 132 + 16 * bn + (lane & 15)] = acc[i][bn][r];
      __syncthreads();
#pragma unroll
      for (int k = 0; k < 16; ++k) { const int p = tid + 512 * k, row = p >> 5, c4 = (p & 31) * 4; *(GAS f32x4*)(out + (size_t)row * 128 + c4) = *(const LAS f32x4*)(T + row * 132 + c4); } }
    __syncthreads();
}

struct MambaLds { LAS bf16* Cs; LAS bf16* Bs; LAS float* CB; LAS bf16* Ph; LAS bf16* Xt; LAS bf16* Sh; LAS float* AC; LAS float* DT; LAS float* SSQ; };
DI void mamba_head(Frame& F, const MambaLds& L, const bf16* XC, const float* sp, int g, int hh, float dsk, const bf16* const (&zrow)[4], f32x4 (&y)[2]) {
    const int tid = F.tid, lane = F.lane, w = F.wave, g4 = lane >> 4, lc = lane & 15, bm = w >> 1;
    __syncthreads();
    { const int l = tid >> 3, m0 = (tid & 7) * 8; const float al = L.AC[l * 4 + hh]; float pv[8];
#pragma unroll
      for (int i = 0; i < 8; ++i) { const int m = m0 + i; pv[i] = (m <= l) ? L.CB[l * 68 + m] * fexp_(al - L.AC[m * 4 + hh]) * L.DT[m * 4 + hh] : 0.f; }
      u32x4 o; o.x = pk2(pv[0], pv[1]); o.y = pk2(pv[2], pv[3]); o.z = pk2(pv[4], pv[5]); o.w = pk2(pv[6], pv[7]); *(LAS u32x4*)(L.Ph + l * 72 + m0) = o; }
    stage_tr(L.Xt, 72, XC + g * 256 + hh * 64, 1024, 64, 8, tid);
    for (int p = tid; p < 1024; p += NTHR) { const int pr = p >> 4, n0 = (p & 15) * 8; const f32x4 v0 = *(const GAS f32x4*)(sp + (size_t)pr * 128 + n0), v1 = *(const GAS f32x4*)(sp + (size_t)pr * 128 + n0 + 4);
        *(LAS u32x4*)(L.Sh + pr * 136 + n0) = pack8(v0, v1); }
    __syncthreads();
#pragma unroll
    for (int q = 0; q < 2; ++q) { const int bn = (w & 1) * 2 + q; f32x4 yd = (f32x4){0.f, 0.f, 0.f, 0.f}, yo = (f32x4){0.f, 0.f, 0.f, 0.f};
#pragma unroll
        for (int ks = 0; ks < 2; ++ks) yd = MFMA16(ldfrag(L.Ph, 72, 16 * bm, 32 * ks, lane), ldfrag(L.Xt, 72, 16 * bn, 32 * ks, lane), yd);
#pragma unroll
        for (int ks = 0; ks < 4; ++ks) yo = MFMA16(ldfrag(L.Cs, 136, 16 * bm, 32 * ks, lane), ldfrag(L.Sh, 136, 16 * bn, 32 * ks, lane), yo);
#pragma unroll
        for (int r = 0; r < 4; ++r) { const int l = 16 * bm + 4 * g4 + r, p = 16 * bn + lc; const float x = bf2f(L.Xt[p * 72 + l]);
            const float z = bf2f(zrow[r][hh * 64 + q * 16]);
            y[q][r] = (yd[r] + fexp_(L.AC[l * 4 + hh]) * yo[r] + x * dsk) * z; } }
}
DI void u_mamba_out(Frame& F, int l_, int c, int g) {
    int tid_ = F.tid; asm volatile("" : "+v"(tid_));
    unsigned char* ws = F.ws; const int tid = tid_, lane = tid_ & 63, w = F.wave, g4 = lane >> 4, lc = lane & 15;
    MambaLds L; L.Cs = (LAS bf16*)F.lds; L.Bs = L.Cs + 64 * 136; L.CB = (LAS float*)(L.Bs + 64 * 136); L.Ph = (LAS bf16*)(L.CB + 64 * 68); L.Xt = L.Ph + 64 * 72; L.Sh = L.Xt + 64 * 72;
    L.AC = (LAS float*)(L.Sh + 64 * 136); L.DT = L.AC + 256; L.SSQ = L.DT + 256;
    LAS bf16* Y = (LAS bf16*)(L.SSQ + 128);
    const bf16* XC = (const bf16*)(ws + WS_XC) + (size_t)(c * 64) * 1024;
    stage_nat(L.Cs, 136, XC + 768 + g * 128, 1024, 64, 16, tid);
    stage_nat(L.Bs, 136, XC + 512 + g * 128, 1024, 64, 16, tid);
    if (tid < 256) { const int l = tid >> 2, hh = tid & 3; L.AC[tid] = ((const float*)(ws + WS_ACS))[(size_t)(c * 64 + l) * 8 + g * 4 + hh]; L.DT[tid] = ((const float*)(ws + WS_DTS))[(size_t)(c * 64 + l) * 8 + g * 4 + hh]; }
    __syncthreads();
    const int bm = w >> 1;
#pragma unroll
    for (int q = 0; q < 2; ++q) { const int bn = (w & 1) * 2 + q; f32x4 acc = (f32x4){0.f, 0.f, 0.f, 0.f};
#pragma unroll
        for (int ks = 0; ks < 4; ++ks) acc = MFMA16(ldfrag(L.Cs, 136, 16 * bm, 32 * ks, lane), ldfrag(L.Bs, 136, 16 * bn, 32 * ks, lane), acc);
#pragma unroll
        for (int r = 0; r < 4; ++r) L.CB[(16 * bm + 4 * g4 + r) * 68 + 16 * bn + lc] = acc[r]; }
    const int pcol = 16 * ((w & 1) * 2) + lc;
    const bf16* zrow[4];
#pragma unroll
    for (int r = 0; r < 4; ++r) { const size_t row = (size_t)(c * 64 + 16 * bm + 4 * g4 + r); zrow[r] = (const bf16*)(ws + WS_ZS) + row * 512 + g * 256 + pcol; }
    const float* mst = (const float*)(ws + WS_MST) + ((size_t)(c * 8 + g * 4) * 64) * 128; const float* prm = (const float*)(ws + WS_PRM) + (size_t)l_ * PRM_STRIDE; const float* dskp = prm + P_SD + g * 4;
    float ss[4] = {0.f, 0.f, 0.f, 0.f};
#pragma unroll 1
    for (int hh = 0; hh < 4; ++hh) { f32x4 y[2]; mamba_head(F, L, XC, mst + (size_t)hh * 64 * 128, g, hh, dskp[hh], zrow, y);
#pragma unroll
        for (int q = 0; q < 2; ++q)
#pragma unroll
            for (int r = 0; r < 4; ++r) { ss[r] += y[q][r] * y[q][r]; Y[(16 * bm + 4 * g4 + r) * 264 + hh * 64 + pcol + q * 16] = (bf16)f2bf(y[q][r]); } }
#pragma unroll
    for (int r = 0; r < 4; ++r) { float t = ss[r]; t = row_sum16(t);
        if (lc == 0) L.SSQ[(16 * bm + 4 * g4 + r) * 2 + (w & 1)] = t; }
    __syncthreads();
    {
        const int l = tid >> 3, c0 = (tid & 7) * 32; const float rstd = rsqrtf((L.SSQ[l * 2] + L.SSQ[l * 2 + 1]) * (1.f / 256.f) + 1e-6f);
        const float* nw = prm + P_SNW + g * 256 + c0; bf16* orow = (bf16*)(ws + WS_OB) + (size_t)(c * 64 + l) * D + 512 + g * 256 + c0;
#pragma unroll
        for (int q = 0; q < 4; ++q) { float v[8]; unpack8(*(const LAS u32x4*)(Y + l * 264 + c0 + 8 * q), v);
            const f32x4 w0 = *(const GAS f32x4*)(nw + 8 * q), w1 = *(const GAS f32x4*)(nw + 8 * q + 4);
            *(GAS u32x4*)(orow + 8 * q) = pack8((f32x4){v[0], v[1], v[2], v[3]} * rstd * w0, (f32x4){v[4], v[5], v[6], v[7]} * rstd * w1); } }
    __syncthreads();
}

DI void u_attn2(Frame& F, int h, int qb, int sp, int ntile) {
    int tid_ = F.tid; asm volatile("" : "+v"(tid_));
    unsigned char* ws = F.ws; const int tid = tid_, lane = tid & 63, w = F.wave, g4 = lane >> 4, lc = lane & 15;
    LAS bf16* Ks = (LAS bf16*)F.lds; LAS bf16* Vs = Ks + 64 * 200;
    const bf16* QM = (const bf16*)(ws + WS_QM); const bf16* KM = (const bf16*)(ws + WS_KM) + h * 192; const bf16* VT = (const bf16*)(ws + WS_VT) + (size_t)(h * 128) * S;
    const int q0 = qb * 256 + w * 32, cw = 4 * qb + (w >> 1);
    bf16x8 qf[2][6];
#pragma unroll
    for (int qq = 0; qq < 2; ++qq)
#pragma unroll
        for (int ks = 0; ks < 6; ++ks) qf[qq][ks] = *(const GAS bf16x8*)(QM + (size_t)(q0 + qq * 16 + lc) * 768 + h * 192 + ks * 32 + g4 * 8);
    f32x4 o[8][2]; float mrun[2], lrun[2];
#pragma unroll
    for (int db = 0; db < 8; ++db)
#pragma unroll
        for (int qq = 0; qq < 2; ++qq) o[db][qq] = (f32x4){0.f, 0.f, 0.f, 0.f};
    mrun[0] = mrun[1] = -1e30f; lrun[0] = lrun[1] = 0.f;
    u32x4 kreg[3], vreg[2];
    const int kt0 = 16 * sp;
#define AT_LOAD(kt) { const int key0_ = (kt) * 64; \
        _Pragma("unroll") for (int i = 0; i < 3; ++i) { const int p = tid + 512 * i, r = p / 24, cc = p - r * 24; kreg[i] = *(const GAS u32x4*)(KM + (size_t)(key0_ + r) * 768 + cc * 8); } \
        _Pragma("unroll") for (int i = 0; i < 2; ++i) { const int p = tid + 512 * i, r = p >> 3, cc = p & 7; vreg[i] = *(const GAS u32x4*)(VT + (size_t)r * S + key0_ + cc * 8); } }
    AT_LOAD(kt0)
    for (int t = 0; t < ntile; ++t) {
        const int kt = kt0 + t;
        __syncthreads();
#pragma unroll
        for (int i = 0; i < 3; ++i) { const int p = tid + 512 * i, r = p / 24, cc = p - r * 24; *(LAS u32x4*)(Ks + r * 200 + cc * 8) = kreg[i]; }
#pragma unroll
        for (int i = 0; i < 2; ++i) { const int p = tid + 512 * i, r = p >> 3, cc = p & 7; *(LAS u32x4*)(Vs + r * 72 + cc * 8) = vreg[i]; }
        __syncthreads();
        if (t + 1 < ntile) AT_LOAD(kt + 1)
        if (kt <= cw) {
            f32x4 s[4][2];
#pragma unroll
            for (int kb = 0; kb < 4; ++kb)
#pragma unroll
                for (int qq = 0; qq < 2; ++qq) s[kb][qq] = (f32x4){0.f, 0.f, 0.f, 0.f};
#pragma unroll
            for (int ks = 0; ks < 6; ++ks)
#pragma unroll
                for (int kb = 0; kb < 4; ++kb) { const bf16x8 kf = ldfrag(Ks, 200, kb * 16, ks * 32, lane);
#pragma unroll
                    for (int qq = 0; qq < 2; ++qq) s[kb][qq] = MFMA16(kf, qf[qq][ks], s[kb][qq]);
                    if (kb == 3 && (ks & 1)) __builtin_amdgcn_sched_barrier(0); }
            bf16x8 pf[2][2];
#pragma unroll
            for (int qq = 0; qq < 2; ++qq) {
                float mx = -1e30f;
#pragma unroll
                for (int kb = 0; kb < 4; ++kb) mx = fmaxf(mx, fmaxf(fmaxf(s[kb][qq][0], s[kb][qq][1]), fmaxf(s[kb][qq][2], s[kb][qq][3])));
                mx = xr32_max(xr16_max(mx));
                const float mn = fmaxf(mrun[qq], mx), alpha = __builtin_amdgcn_exp2f(mrun[qq] - mn); mrun[qq] = mn;
                float ps = 0.f; float p[16];
#pragma unroll
                for (int kb = 0; kb < 4; ++kb)
#pragma unroll
                    for (int r = 0; r < 4; ++r) { p[kb * 4 + r] = __builtin_amdgcn_exp2f(s[kb][qq][r] - mn); ps += p[kb * 4 + r]; }
                ps = xr32_sum(xr16_sum(ps));
                lrun[qq] = lrun[qq] * alpha + ps;
if (__builtin_amdgcn_ballot_w64(alpha != 1.0f) != 0ull) {
#pragma unroll
                    for (int db = 0; db < 8; ++db) o[db][qq] = o[db][qq] * alpha; }
#pragma unroll
                for (int s2 = 0; s2 < 2; ++s2) { u32x4 pw; pw.x = pk2(p[8 * s2], p[8 * s2 + 1]); pw.y = pk2(p[8 * s2 + 2], p[8 * s2 + 3]); pw.z = pk2(p[8 * s2 + 4], p[8 * s2 + 5]); pw.w = pk2(p[8 * s2 + 6], p[8 * s2 + 7]); pf[qq][s2] = __builtin_bit_cast(bf16x8, pw); }
            }
#pragma unroll
            for (int db = 0; db < 8; ++db)
#pragma unroll
                for (int s2 = 0; s2 < 2; ++s2) {
                    const LAS bf16* vp = Vs + (db * 16 + lc) * 72 + 32 * s2 + 4 * g4;
                    const u32x2 v0 = *(const LAS u32x2*)vp, v1 = *(const LAS u32x2*)(vp + 16);
                    const u32x4 vw = (u32x4){v0.x, v0.y, v1.x, v1.y}; const bf16x8 vf = __builtin_bit_cast(bf16x8, vw);
#pragma unroll
                    for (int qq = 0; qq < 2; ++qq) o[db][qq] = MFMA16(vf, pf[qq][s2], o[db][qq]);
                }
        }
    }
#undef AT_LOAD
    const int slot = att_slot(h, qb, sp);
    bf16* po = (bf16*)(ws + WS_APO) + (size_t)slot * 32768; float* pm = (float*)(ws + WS_APM) + (size_t)slot * 512;
#pragma unroll
    for (int db = 0; db < 8; ++db)
#pragma unroll
        for (int qq = 0; qq < 2; ++qq) *(GAS u32x2*)(po + (size_t)(w * 32 + qq * 16 + lc) * 128 + db * 16 + 4 * g4) = pk4_(o[db][qq]);
    if (g4 == 0) {
#pragma unroll
        for (int qq = 0; qq < 2; ++qq) { *(GAS f32x2*)(pm + (w * 32 + qq * 16 + lc) * 2) = (f32x2){mrun[qq], lrun[qq]}; } }
    __syncthreads();
}
DI void u_attn_comb(Frame& F, int h, int qb, int qq) {
    unsigned char* ws = F.ws; const int tid = F.tid, q = qq * 64 + (tid >> 3), dv0 = (tid & 7) * 16;
    const int ns = (qb + 4) >> 2, slot0 = att_slot(h, qb, 0);
    const float* pm = (const float*)(ws + WS_APM) + (size_t)slot0 * 512 + q * 2; const bf16* po = (const bf16*)(ws + WS_APO) + (size_t)slot0 * 32768 + (size_t)q * 128 + dv0;
    float mstar = -1e30f;
    for (int s = 0; s < ns; ++s) mstar = fmaxf(mstar, pm[(size_t)s * 512]);
    float lt = 0.f; float ov[16];
#pragma unroll
    for (int i = 0; i < 16; ++i) ov[i] = 0.f;
    for (int s = 0; s < ns; ++s) { const float sc = __builtin_amdgcn_exp2f(pm[(size_t)s * 512] - mstar); lt += pm[(size_t)s * 512 + 1] * sc;
        float v[16]; unpack8(*(const GAS u32x4*)(po + (size_t)s * 32768), *(float(*)[8])&v[0]); unpack8(*(const GAS u32x4*)(po + (size_t)s * 32768 + 8), *(float(*)[8])&v[8]);
#pragma unroll
        for (int i = 0; i < 16; ++i) ov[i] += v[i] * sc; }
    const float inv = 1.0f / lt;
    bf16* ob = (bf16*)(ws + WS_OB) + (size_t)(qb * 256 + q) * D + 1024 + h * 128 + dv0;
    u32x4 o0, o1; o0.x = pk2(ov[0] * inv, ov[1] * inv); o0.y = pk2(ov[2] * inv, ov[3] * inv); o0.z = pk2(ov[4] * inv, ov[5] * inv); o0.w = pk2(ov[6] * inv, ov[7] * inv);
    o1.x = pk2(ov[8] * inv, ov[9] * inv); o1.y = pk2(ov[10] * inv, ov[11] * inv); o1.z = pk2(ov[12] * inv, ov[13] * inv); o1.w = pk2(ov[14] * inv, ov[15] * inv);
    *(GAS u32x4*)ob = o0; *(GAS u32x4*)(ob + 8) = o1;
}

DI void u_rwkv_r1(Frame& F, int c, int h) {
    int tid_ = F.tid; asm volatile("" : "+v"(tid_));
    unsigned char* ws = F.ws; const int tid = tid_, lane = tid_ & 63, w = F.wave, g4 = lane >> 4, lc = lane & 15;
    LAS float* CUM = (LAS float*)F.lds;
    LAS float* PT = CUM + 64 * 68;
    LAS bf16* AT = (LAS bf16*)(PT + 64); LAS bf16* BH = AT + 4608; LAS bf16* KH = BH + 4608; LAS bf16* RT = KH + 4608;
    LAS bf16* AJ = RT + 4608; LAS bf16* BJ = AJ + 4608; LAS bf16* KJ = BJ + 4608; LAS bf16* VJ = KJ + 4608;
    LAS bf16* MAK = VJ + 4608; LAS bf16* MRBT = MAK + 4608; LAS bf16* MRKT = MRBT + 4608; LAS bf16* X1 = MRKT + 4608; LAS bf16* X2 = X1 + 4608;
    LAS bf16* WT = AT; LAS bf16* G1 = BH; LAS bf16* G2 = KH; LAS bf16* CST = MAK;
    const size_t gb = (size_t)(c * 64) * 512 + h * 64; const int unit = c * 8 + h;
    const int t = tid >> 3, j0 = (tid & 7) * 8;
    const size_t go = gb + (size_t)t * 512 + j0;
    float lw[8];
    { const f32x4 x0 = *(const GAS f32x4*)((const float*)(ws + WS_DEC) + go), x1 = *(const GAS f32x4*)((const float*)(ws + WS_DEC) + go + 4);
#pragma unroll
      for (int i = 0; i < 4; ++i) { lw[i] = x0[i]; lw[4 + i] = x1[i]; }
#pragma unroll
      for (int i = 0; i < 8; ++i) CUM[t * 68 + j0 + i] = lw[i]; }
    __syncthreads();
    if (tid < 64) { float s = 0.f;
#pragma unroll 8
        for (int tt = 0; tt < 64; ++tt) { s += CUM[tt * 68 + tid]; CUM[tt * 68 + tid] = s; } }
    __syncthreads();
    {
        float cum[8], cT[8];
#pragma unroll
        for (int i = 0; i < 8; ++i) { cum[i] = CUM[t * 68 + j0 + i]; cT[i] = CUM[63 * 68 + j0 + i]; }
        if (t == 0) {
#pragma unroll
            for (int i = 0; i < 8; ++i) PT[j0 + i] = fexp_(cT[i]); }
        float av[8], bv[8], kv[8], rv[8], vv[8];
#define LD8(dst, OFF) { unpack8(*(const GAS u32x4*)((const bf16*)(ws + (OFF)) + go), dst); }
        LD8(av, WS_KKN) LD8(bv, WS_BB) LD8(kv, WS_KP) LD8(rv, WS_R32) LD8(vv, WS_VV)
#undef LD8
        float at[8], bh[8], kh[8], rt[8], bj[8], kj[8];
#pragma unroll
        for (int i = 0; i < 8; ++i) { const float pprev = fexp_(cum[i] - lw[i]), pinv = fexp_(-cum[i]), pt = fexp_(cum[i]), pend = fexp_(cT[i] - cum[i]);
            at[i] = -av[i] * pprev; bh[i] = bv[i] * pinv; kh[i] = kv[i] * pinv; rt[i] = rv[i] * pt; bj[i] = bv[i] * pend; kj[i] = kv[i] * pend; }
#define ST8(M, v) { u32x4 o; o.x = pk2(v[0], v[1]); o.y = pk2(v[2], v[3]); o.z = pk2(v[4], v[5]); o.w = pk2(v[6], v[7]); *(LAS u32x4*)(M + t * 72 + j0) = o; }
        ST8(AT, at) ST8(BH, bh) ST8(KH, kh) ST8(RT, rt)
#undef ST8
#pragma unroll
        for (int i = 0; i < 8; ++i) { const int o = (j0 + i) * 72 + t; AJ[o] = (bf16)f2bf(at[i]); BJ[o] = (bf16)f2bf(bj[i]); KJ[o] = (bf16)f2bf(kj[i]); VJ[o] = (bf16)f2bf(vv[i]); }
    }
    __syncthreads();
    {
        const int q = w >> 1; const LAS bf16* Am = (q == 0) ? BH : (q == 1) ? KH : RT; const LAS bf16* Bm = (q < 2) ? AT : (q == 2) ? BH : KH;
#pragma unroll
        for (int bi = 0; bi < 2; ++bi) { const int bm = 2 * (w & 1) + bi; const bf16x8 a0 = ldfrag(Am, 72, 16 * bm, 0, lane), a1 = ldfrag(Am, 72, 16 * bm, 32, lane);
#pragma unroll
            for (int bn = 0; bn < 4; ++bn) { f32x4 acc = (f32x4){0.f, 0.f, 0.f, 0.f};
                acc = MFMA16(a0, ldfrag(Bm, 72, 16 * bn, 0, lane), acc); acc = MFMA16(a1, ldfrag(Bm, 72, 16 * bn, 32, lane), acc);
#pragma unroll
                for (int r = 0; r < 4; ++r) { const int row = 16 * bm + 4 * g4 + r, col = 16 * bn + lc; const bool keep = (q < 2) ? (row < col) : (col <= row); const float v = keep ? acc[r] : 0.f;
                    if (q == 0) CUM[row * 68 + col] = v; else { LAS bf16* O = (q == 1) ? MAK : (q == 2) ? MRBT : MRKT; O[row * 72 + col] = (bf16)f2bf(v); } } } }
    }
    __syncthreads();
    {
        LAS bf16* Qn[2] = {BH, X1}; LAS bf16* Qt[2] = {KH, X2}; LAS bf16* Wn[2] = {AT, (LAS bf16*)CUM};
        const int bm = w >> 1; f32x4 wreg[2];
#pragma unroll
        for (int qn = 0; qn < 2; ++qn) { const int bn = (w & 1) * 2 + qn;
#pragma unroll
            for (int r = 0; r < 4; ++r) { const int row = 16 * bm + 4 * g4 + r, col = 16 * bn + lc; const float m = CUM[row * 68 + col]; wreg[qn][r] = m + ((row == col) ? 1.f : 0.f);
                const bf16 mb = (bf16)f2bf(m); Qn[0][row * 72 + col] = mb; Qt[0][col * 72 + row] = mb; Wn[0][row * 72 + col] = (bf16)f2bf(wreg[qn][r]); } }
        __syncthreads();
#pragma unroll
        for (int it = 0; it < 5; ++it) { const int cu = it & 1, nx = cu ^ 1;
            { const bf16x8 a0 = ldfrag(Qn[cu], 72, 16 * bm, 0, lane), a1 = ldfrag(Qn[cu], 72, 16 * bm, 32, lane);
#pragma unroll
              for (int qn = 0; qn < 2; ++qn) { const int bn = (w & 1) * 2 + qn; f32x4 acc = (f32x4){0.f, 0.f, 0.f, 0.f};
                  acc = MFMA16(a0, ldfrag(Qt[cu], 72, 16 * bn, 0, lane), acc); acc = MFMA16(a1, ldfrag(Qt[cu], 72, 16 * bn, 32, lane), acc);
#pragma unroll
                  for (int r = 0; r < 4; ++r) { const int row = 16 * bm + 4 * g4 + r, col = 16 * bn + lc; const bf16 v = (bf16)f2bf(acc[r]); Qn[nx][row * 72 + col] = v; Qt[nx][col * 72 + row] = v; } } }
            __syncthreads();
            { const bf16x8 a0 = ldfrag(Wn[cu], 72, 16 * bm, 0, lane), a1 = ldfrag(Wn[cu], 72, 16 * bm, 32, lane);
#pragma unroll
              for (int qn = 0; qn < 2; ++qn) { const int bn = (w & 1) * 2 + qn;
                  wreg[qn] = MFMA16(a0, ldfrag(Qt[nx], 72, 16 * bn, 0, lane), wreg[qn]); wreg[qn] = MFMA16(a1, ldfrag(Qt[nx], 72, 16 * bn, 32, lane), wreg[qn]); } }
            if (it < 4) {
#pragma unroll
                for (int qn = 0; qn < 2; ++qn) { const int bn = (w & 1) * 2 + qn;
#pragma unroll
                    for (int r = 0; r < 4; ++r) Wn[nx][(16 * bm + 4 * g4 + r) * 72 + 16 * bn + lc] = (bf16)f2bf(wreg[qn][r]); }
            }
        }
        __syncthreads();
#pragma unroll
        for (int qn = 0; qn < 2; ++qn) { const int bn = (w & 1) * 2 + qn;
#pragma unroll
            for (int r = 0; r < 4; ++r) WT[(16 * bn + lc) * 72 + 16 * bm + 4 * g4 + r] = (bf16)f2bf(wreg[qn][r]); }
    }
    __syncthreads();
    {
        const int q = w >> 2, bm = w & 3; const LAS bf16* Am = q ? MAK : AJ; LAS bf16* O = q ? G2 : G1;
        const bf16x8 a0 = ldfrag(Am, 72, 16 * bm, 0, lane), a1 = ldfrag(Am, 72, 16 * bm, 32, lane);
        f32x4 acc[4];
#pragma unroll
        for (int bn = 0; bn < 4; ++bn) { acc[bn] = (f32x4){0.f, 0.f, 0.f, 0.f};
            acc[bn] = MFMA16(a0, ldfrag(WT, 72, 16 * bn, 0, lane), acc[bn]); acc[bn] = MFMA16(a1, ldfrag(WT, 72, 16 * bn, 32, lane), acc[bn]); }
#pragma unroll
        for (int bn = 0; bn < 4; ++bn)
#pragma unroll
            for (int r = 0; r < 4; ++r) O[(16 * bm + 4 * g4 + r) * 72 + 16 * bn + lc] = (bf16)f2bf(acc[bn][r]);
    }
    __syncthreads();
    {
        const int q = w >> 1; const LAS bf16* Am = (q < 2) ? MRBT : BJ; const LAS bf16* Bm = (q & 1) ? G2 : G1;
        f32x4 acc[2][4];
#pragma unroll
        for (int bi = 0; bi < 2; ++bi) { const int bm = 2 * (w & 1) + bi; const bf16x8 a0 = ldfrag(Am, 72, 16 * bm, 0, lane), a1 = ldfrag(Am, 72, 16 * bm, 32, lane);
#pragma unroll
            for (int bn = 0; bn < 4; ++bn) { acc[bi][bn] = (f32x4){0.f, 0.f, 0.f, 0.f};
                acc[bi][bn] = MFMA16(a0, ldfrag(Bm, 72, 16 * bn, 0, lane), acc[bi][bn]); acc[bi][bn] = MFMA16(a1, ldfrag(Bm, 72, 16 * bn, 32, lane), acc[bi][bn]); } }
        LAS bf16* lout = (q == 0) ? AT : (q == 1) ? AJ : (q == 2) ? X1 : CST;
#pragma unroll
        for (int bi = 0; bi < 2; ++bi) { const int bm = 2 * (w & 1) + bi;
#pragma unroll
            for (int bn = 0; bn < 4; ++bn)
#pragma unroll
                for (int r = 0; r < 4; ++r) { const int row = 16 * bm + 4 * g4 + r, col = 16 * bn + lc; float v = acc[bi][bn][r];
                    if (q == 0) v += bf2f(RT[row * 72 + col]); else if (q == 1) v += bf2f(MRKT[row * 72 + col]); else if (q == 2) v += (row == col) ? PT[row] : 0.f; else v += bf2f(KJ[row * 72 + col]);
                    lout[row * 72 + col] = (bf16)f2bf(v); } }
    }
    __syncthreads();
    { const int row = tid >> 3, c8 = (tid & 7) * 8; const size_t go2 = (size_t)unit * 4096 + row * 64 + c8;
      *(GAS u32x4*)((bf16*)(ws + WS_QYT) + go2) = *(const LAS u32x4*)(AT + row * 72 + c8);
      *(GAS u32x4*)((bf16*)(ws + WS_CYT) + go2) = *(const LAS u32x4*)(AJ + row * 72 + c8);
      *(GAS u32x4*)((bf16*)(ws + WS_TST) + go2) = *(const LAS u32x4*)(X1 + row * 72 + c8); }
    {
        const int bm = w >> 1;
        const bf16x8 a0 = ldfrag(CST, 72, 16 * bm, 0, lane), a1 = ldfrag(CST, 72, 16 * bm, 32, lane);
#pragma unroll
        for (int qn = 0; qn < 2; ++qn) { const int bn = (w & 1) * 2 + qn; f32x4 acc = (f32x4){0.f, 0.f, 0.f, 0.f};
            acc = MFMA16(a0, ldfrag(VJ, 72, 16 * bn, 0, lane), acc); acc = MFMA16(a1, ldfrag(VJ, 72, 16 * bn, 32, lane), acc);
#pragma unroll
            for (int r = 0; r < 4; ++r) CUM[(16 * bm + 4 * g4 + r) * 68 + 16 * bn + lc] = acc[r]; }
    }
    __syncthreads();
    { float* nst = (float*)(ws + WS_NST) + (size_t)unit * 4096;
#pragma unroll
      for (int k = 0; k < 2; ++k) { const int p = tid + 512 * k, row = p >> 4, c4 = (p & 15) * 4; *(GAS f32x4*)(nst + row * 64 + c4) = *(const LAS f32x4*)(CUM + row * 68 + c4); } }
    __syncthreads();
}

DI void p_rwkv_scan2(Frame& F, int h) {
    unsigned char* ws = F.ws; const int lane = F.lane, w = F.wave, g4 = lane >> 4, lc = lane & 15;
    constexpr int SLOT_B = 9216 + 17408;
    const bf16* TST = (const bf16*)(ws + WS_TST) + (size_t)h * 4096; const float* NST = (const float*)(ws + WS_NST) + (size_t)h * 4096; bf16* S0 = (bf16*)(ws + WS_S0) + (size_t)h * 4096;
    if (w >= 4) {
        const int lt = (w - 4) * 64 + lane;
        u32x4 rt[8][2]; f32x4 rn[8][4];
#define SC_ISSUE(u, cc) { const size_t ub = (size_t)(cc) * 8 * 4096; \
            _Pragma("unroll") for (int i = 0; i < 2; ++i) { const int p = lt + 256 * i; rt[u][i] = *(const GAS u32x4*)(TST + ub + (size_t)p * 8); } \
            _Pragma("unroll") for (int i = 0; i < 4; ++i) { const int p = lt + 256 * i; rn[u][i] = *(const GAS f32x4*)(NST + ub + (size_t)p * 4); } }
#define SC_WRITE(u, cc) { LAS unsigned char* sl = F.lds + ((cc) & 1) * SLOT_B; \
            _Pragma("unroll") for (int i = 0; i < 2; ++i) { const int p = lt + 256 * i, r = p >> 3, c8 = p & 7; *(LAS u32x4*)(sl + (r * 72 + c8 * 8) * 2) = rt[u][i]; } \
            _Pragma("unroll") for (int i = 0; i < 4; ++i) { const int p = lt + 256 * i, r = p >> 4, c4 = p & 15; *(LAS f32x4*)(sl + 9216 + (r * 68 + c4 * 4) * 4) = rn[u][i]; } }
#pragma unroll
        for (int u = 0; u < 8; ++u) SC_ISSUE(u, u)
        for (int c0 = 0; c0 < NCH; c0 += 8) {
#pragma unroll
            for (int u = 0; u < 8; ++u) { const int c = c0 + u;
                SC_WRITE(u, c)
                if (c + 8 < NCH) SC_ISSUE(u, c + 8)
                asm volatile("s_waitcnt lgkmcnt(0)" ::: "memory"); __builtin_amdgcn_s_barrier(); asm volatile("" ::: "memory");
            }
        }
#undef SC_ISSUE
#undef SC_WRITE
    } else {
        const int ib = w;
        f32x4 st[4];
#pragma unroll
        for (int jb = 0; jb < 4; ++jb) st[jb] = (f32x4){0.f, 0.f, 0.f, 0.f};
        for (int c = 0; c < NCH; ++c) {
            bf16* s0p = S0 + (size_t)c * 8 * 4096 + (size_t)(16 * ib + lc) * 64 + 4 * g4;
            bf16x8 bfr[2];
#pragma unroll
            for (int ks = 0; ks < 2; ++ks) { u32x4 p; p.x = pk2(st[2 * ks][0], st[2 * ks][1]); p.y = pk2(st[2 * ks][2], st[2 * ks][3]); p.z = pk2(st[2 * ks + 1][0], st[2 * ks + 1][1]); p.w = pk2(st[2 * ks + 1][2], st[2 * ks + 1][3]);
                bfr[ks] = __builtin_bit_cast(bf16x8, p);
                *(GAS u32x2*)(s0p + 32 * ks) = (u32x2){p.x, p.y}; *(GAS u32x2*)(s0p + 32 * ks + 16) = (u32x2){p.z, p.w}; }
            asm volatile("s_waitcnt lgkmcnt(0)" ::: "memory"); __builtin_amdgcn_s_barrier(); asm volatile("" ::: "memory");
            const LAS bf16* ts = (const LAS bf16*)(F.lds + (c & 1) * SLOT_B); const LAS float* ns = (const LAS float*)(F.lds + (c & 1) * SLOT_B + 9216);
#pragma unroll
            for (int jb = 0; jb < 4; ++jb) { f32x4 nw;
#pragma unroll
                for (int r = 0; r < 4; ++r) nw[r] = ns[(16 * jb + 4 * g4 + r) * 68 + 16 * ib + lc];
#pragma unroll
                for (int ks = 0; ks < 2; ++ks) { const LAS bf16* ap = ts + (16 * jb + lc) * 72 + 32 * ks + 4 * g4; const u32x2 a0 = *(const LAS u32x2*)ap, a1 = *(const LAS u32x2*)(ap + 16);
                    const u32x4 aw = (u32x4){a0.x, a0.y, a1.x, a1.y}; nw = MFMA16(__builtin_bit_cast(bf16x8, aw), bfr[ks], nw); }
                st[jb] = nw; }
        }
    }
}

DI void u_rwkv_r3(Frame& F, int l_, int c, int h) {
    int tid_ = F.tid; asm volatile("" : "+v"(tid_));
    unsigned char* ws = F.ws; const int tid = tid_, lane = tid_ & 63, w = F.wave, g4 = lane >> 4, lc = lane & 15, unit = c * 8 + h;
    LAS bf16* QY = (LAS bf16*)F.lds; LAS bf16* CY = QY + 4608; LAS bf16* S0s = CY + 4608; LAS bf16* VJ = S0s + 4608; LAS float* Ys = (LAS float*)(VJ + 4608);
    stage_nat(QY, 72, (const bf16*)(ws + WS_QYT) + (size_t)unit * 4096, 64, 64, 8, tid);
    stage_nat(CY, 72, (const bf16*)(ws + WS_CYT) + (size_t)unit * 4096, 64, 64, 8, tid);
    stage_nat(S0s, 72, (const bf16*)(ws + WS_S0) + (size_t)unit * 4096, 64, 64, 8, tid);
    const size_t gb = (size_t)(c * 64) * 512 + h * 64;
    { const int t = tid >> 3, j0 = (tid & 7) * 8; const u32x4 w4 = *(const GAS u32x4*)((const bf16*)(ws + WS_VV) + gb + (size_t)t * 512 + j0); LAS bf16* d = VJ + j0 * 72 + t;
      d[0] = (bf16)(w4.x & 0xffffu); d[72] = (bf16)(w4.x >> 16); d[144] = (bf16)(w4.y & 0xffffu); d[216] = (bf16)(w4.y >> 16); d[288] = (bf16)(w4.z & 0xffffu); d[360] = (bf16)(w4.z >> 16); d[432] = (bf16)(w4.w & 0xffffu); d[504] = (bf16)(w4.w >> 16); }
    __syncthreads();
    { const int bm = w >> 1;
#pragma unroll
      for (int qn = 0; qn < 2; ++qn) { const int bn = (w & 1) * 2 + qn; f32x4 acc = (f32x4){0.f, 0.f, 0.f, 0.f};
#pragma unroll
          for (int ks = 0; ks < 2; ++ks) { acc = MFMA16(ldfrag(QY, 72, 16 * bm, 32 * ks, lane), ldfrag(S0s, 72, 16 * bn, 32 * ks, lane), acc); acc = MFMA16(ldfrag(CY, 72, 16 * bm, 32 * ks, lane), ldfrag(VJ, 72, 16 * bn, 32 * ks, lane), acc); }
#pragma unroll
          for (int r = 0; r < 4; ++r) Ys[(16 * bm + 4 * g4 + r) * 65 + 16 * bn + lc] = acc[r]; } }
    __syncthreads();
    { const float* prm = (const float*)(ws + WS_PRM) + (size_t)l_ * PRM_STRIDE; const float lnw = prm[P_LNW + h * 64 + lane], lnb = prm[P_LNB + h * 64 + lane], rk = prm[P_RK + h * 64 + lane];
      float rr_[8], kk_[8], vv_[8], gg_[8];
#pragma unroll
      for (int rr = 0; rr < 8; ++rr) { const size_t o = gb + (size_t)(8 * w + rr) * 512 + lane;
          rr_[rr] = bf2f(((const bf16*)(ws + WS_R32))[o]); kk_[rr] = bf2f(((const bf16*)(ws + WS_KP))[o]); vv_[rr] = bf2f(((const bf16*)(ws + WS_VV))[o]); gg_[rr] = bf2f(((const bf16*)(ws + WS_G32))[o]); }
#pragma unroll
      for (int rr = 0; rr < 8; ++rr) { const int t = 8 * w + rr; const float y = Ys[t * 65 + lane];
          const float mean = wave_sum(y) * (1.f / 64.f), d = y - mean, rstd = rsqrtf(wave_sum(d * d) * (1.f / 64.f) + 64e-5f), bs = wave_sum(rr_[rr] * kk_[rr] * rk);
          ((bf16*)(ws + WS_OB))[(size_t)(c * 64 + t) * D + 1536 + h * 64 + lane] = (bf16)f2bf((d * rstd * lnw + lnb + bs * vv_[rr]) * gg_[rr]); } }
    __syncthreads();
}

constexpr int STEPS_PER_LAYER = 13, NSTEPS = 1 + DEPTH * STEPS_PER_LAYER;
constexpr int NSCAN_BLK = 8;

__global__ void __launch_bounds__(NTHR, 2) mk_fwd(Args args) {
    extern __shared__ __attribute__((aligned(16))) unsigned char lds_raw[];
    Frame F;
    F.lds = (LAS unsigned char*)lds_raw; F.MISC = (volatile LAS unsigned*)(F.lds + MISC_OFF);
    F.tid = threadIdx.x; F.lane = F.tid & 63; F.wave = __builtin_amdgcn_readfirstlane(F.tid >> 6);
    F.G = gridDim.x; F.bid = blockIdx.x; F.ws = args.ws; F.ctl = (gu32*)(args.ws + WS_CTL);
    for (int u = F.tid; u < (LDS_BYTES - LDSCTL_OFF) / 4; u += NTHR) ((LAS unsigned*)(F.lds + LDSCTL_OFF))[u] = 0u;
    __syncthreads();
    const int lo = args.st_lo, hi = args.st_hi;
    XcdBarrier bar; bar.bar = (unsigned*)(F.ctl + CW_BAR); bar.x = 0; bar.st = nullptr;
    if (hi - lo > 1) bar = xcd_barrier_post((unsigned*)(F.ctl + CW_BAR), F.MISC + 8);
#ifndef MK_MASK
#define MK_MASK 0xFBFEu
#endif
#define EN(k) (((MK_MASK) >> (k)) & 1u)
#ifndef MK_REP
#define MK_REP 0u
#endif
#define REP(k) (((MK_REP) >> (k)) & 1u)
#ifndef MK_DUP
#define MK_DUP 0u
#endif
#define DUP(k, stmt) do { stmt; if (((MK_DUP) >> (k)) & 1u) { stmt; } } while (0)
#define RUN(s) (lo <= (s) && (s) < hi)
#define SEAM(s) do { if ((s) + 1 < hi) xcd_barrier(bar); } while (0)

    if (EN(13) && RUN(0)) { _Pragma("unroll 1") for (int rp = 0; rp <= (int)REP(13); ++rp) { relaunder(F, args.ws, (LAS unsigned char*)lds_raw); p_prologue(F, args); } SEAM(0); }

    for (int l = 0; l < DEPTH; ++l) {
        const int sb = 1 + l * STEPS_PER_LAYER;
        const float* xin = (l == 0) ? args.in[0] : args.out;
        if (EN(0) && RUN(sb + 0)) { _Pragma("unroll 1") for (int rp = 0; rp <= (int)REP(0); ++rp) { relaunder(F, args.ws, (LAS unsigned char*)lds_raw); unsigned char* ws = F.ws; DUP(11, p_rmsnorm(F, xin, (const float*)(ws + WS_PRM) + (size_t)l * PRM_STRIDE + P_N1, (bf16*)(ws + WS_XN))); } SEAM(sb + 0); }
        if (EN(1) && RUN(sb + 1)) { _Pragma("unroll 1") for (int rp = 0; rp <= (int)REP(1); ++rp) { relaunder(F, args.ws, (LAS unsigned char*)lds_raw); unsigned char* ws = F.ws;
            pg8::Gemm g{(const bf16*)(ws + WS_XN), (const bf16*)(ws + WS_WIN) + (size_t)l * NINP * D, D, D, D};
            pg8::StaticOrder So; So.init(S, NINP - 256, F.G, F.bid); pg8::EpiIn E{ws, 0, (const LAS float*)(F.lds + RTAB_OFF)};
            pg8::fill_rstd((LAS float*)(F.lds + RTAB_OFF), (const float*)(ws + WS_RSSA), So, F.tid);
            DUP(6, (pg8::gemm_phase<pg8::EpiIn, pg8::StaticOrder, true>(F.lds, g, So, E, F.tid)));
            } SEAM(sb + 1);
        }
        if (EN(2) && RUN(sb + 2)) { _Pragma("unroll 1") for (int rp = 0; rp <= (int)REP(2); ++rp) { relaunder(F, args.ws, (LAS unsigned char*)lds_raw); unsigned char* ws = F.ws;
            if (F.bid >= F.G - 32) {
                pg8::Gemm g{(const bf16*)(ws + WS_XN), (const bf16*)(ws + WS_WIN) + ((size_t)l * NINP + (NINP - 256)) * D, D, D, D};
                pg8::StaticOrder So; So.init(S, 256, 32, F.bid - (F.G - 32)); pg8::EpiMisc E{ws, (const LAS float*)(F.lds + RTAB_OFF)};
                pg8::fill_rstd((LAS float*)(F.lds + RTAB_OFF), (const float*)(ws + WS_RSSA), So, F.tid);
                pg8::gemm_phase<pg8::EpiMisc, pg8::StaticOrder, true>(F.lds, g, So, E, F.tid);
            } else {
                const int Gs = F.G; F.G = Gs - 32;
                DUP(12, p_rwkv_prep(F, l));
                relaunder(F, args.ws, (LAS unsigned char*)lds_raw); F.G = Gs - 32; DUP(13, p_mamba_prep(F, l));
                __syncthreads(); relaunder(F, args.ws, (LAS unsigned char*)lds_raw); F.G = Gs - 32;
                for (int u = F.bid; u < 512; u += F.G) DUP(5, u_ret_kv(F, u >> 2, u & 3));
                F.G = Gs;
            }
            } SEAM(sb + 2);
        }
        if (EN(3) && RUN(sb + 3)) { _Pragma("unroll 1") for (int rp = 0; rp <= (int)REP(3); ++rp) { relaunder(F, args.ws, (LAS unsigned char*)lds_raw); unsigned char* ws = F.ws;
            { pg8::Gemm g{(const bf16*)(ws + WS_CQ), (const bf16*)(ws + WS_WQB) + (size_t)l * 1024 * 512, 512, 512, 512};
              pg8::StaticOrder So; So.init(S, 1024, F.G, F.bid); pg8::EpiQb E{ws, (const float*)(ws + WS_PRM) + (size_t)l * PRM_STRIDE + P_QNW};
              pg8::gemm_phase<pg8::EpiQb, pg8::StaticOrder, false>(F.lds, g, So, E, F.tid); __syncthreads(); }
            relaunder(F, args.ws, (LAS unsigned char*)lds_raw); ws = F.ws;
            { pg8::Gemm g{(const bf16*)(ws + WS_CKV), (const bf16*)(ws + WS_WKVB) + (size_t)l * 1024 * 256, 256, 256, 256};
              pg8::StaticOrder So; So.init(S, 1024, F.G, (F.bid + 128) % F.G); pg8::EpiKvb E{ws, (const float*)(ws + WS_PRM) + (size_t)l * PRM_STRIDE + P_KNW};
              pg8::gemm_phase<pg8::EpiKvb, pg8::StaticOrder, false>(F.lds, g, So, E, F.tid); __syncthreads(); }
            relaunder(F, args.ws, (LAS unsigned char*)lds_raw); ws = F.ws;
            if (l > 0) { pg8::Gemm g{(const bf16*)(ws + WS_VV), (const bf16*)(ws + WS_WV1) + (size_t)l * 256 * 512, 512, 512, 512};
              pg8::StaticOrder So; So.init(S, 256, F.G, (F.bid + 64) % F.G); pg8::EpiV1 E{ws};
              pg8::gemm_phase<pg8::EpiV1, pg8::StaticOrder, true>(F.lds, g, So, E, F.tid); __syncthreads(); }
            relaunder(F, args.ws, (LAS unsigned char*)lds_raw);
            for (int u = F.bid; u < 256; u += F.G) { u_mamba_dt(F, l, u >> 1); DUP(4, u_mamba_st(F, u >> 1, u & 1)); }
            } SEAM(sb + 3);
        }
        if (EN(4) && RUN(sb + 4)) { _Pragma("unroll 1") for (int rp = 0; rp <= (int)REP(4); ++rp) { relaunder(F, args.ws, (LAS unsigned char*)lds_raw); unsigned char* ws = F.ws;
            {
              pg8::Gemm g{(const bf16*)(ws + WS_ALORA), (const bf16*)(ws + WS_WLORA) + (size_t)l * 2048 * 512, 512, 512, 512};
              pg8::StaticOrder So; So.init(S, l > 0 ? 2048 : 1536, F.G, F.bid);
              const float* prm = (const float*)(ws + WS_PRM) + (size_t)l * PRM_STRIDE; pg8::EpiLora E{ws, prm + P_W0, prm + P_A0, prm + P_V0, prm + P_KA};
              DUP(9, (pg8::gemm_phase<pg8::EpiLora, pg8::StaticOrder, true>(F.lds, g, So, E, F.tid))); }
            } SEAM(sb + 4);
        }
        if (EN(5) && RUN(sb + 5)) { _Pragma("unroll 1") for (int rp = 0; rp <= (int)REP(5); ++rp) { relaunder(F, args.ws, (LAS unsigned char*)lds_raw); unsigned char* ws = F.ws; (void)ws;
            if (F.bid < 64) { p_scans(F, 64); relaunder(F, args.ws, (LAS unsigned char*)lds_raw);
                for (int u = F.bid * 2; u < F.bid * 2 + 2; ++u) u_rwkv_r1(F, u >> 3, u & 7); }
            else { for (int u = 128 + (F.bid - 64); u < 1024; u += F.G - 64) u_rwkv_r1(F, u >> 3, u & 7); }
            } SEAM(sb + 5);
        }
        if (EN(6) && RUN(sb + 6)) { _Pragma("unroll 1") for (int rp = 0; rp <= (int)REP(6); ++rp) { relaunder(F, args.ws, (LAS unsigned char*)lds_raw); unsigned char* ws = F.ws; (void)ws;
            if (F.bid < NSCAN_BLK) { p_rwkv_scan2(F, F.bid); }
            else {
                const int NB = F.G - NSCAN_BLK, b = F.bid - NSCAN_BLK;
                { const int* tab = (const int*)(ws + WS_ATAB);
                  for (int r = 0; r * NB < ATT_NSUB; ++r) { const int pos = (r & 1) ? NB - 1 - b : b; const int i = r * NB + pos;
                      if (i < ATT_NSUB) { const int e = tab[i]; DUP(0, u_attn2(F, e & 3, (e >> 2) & 31, (e >> 7) & 31, e >> 12)); } } }
            }
            } SEAM(sb + 6);
        }
        if (EN(7) && RUN(sb + 7)) { _Pragma("unroll 1") for (int rp = 0; rp <= (int)REP(7); ++rp) { relaunder(F, args.ws, (LAS unsigned char*)lds_raw); unsigned char* ws = F.ws; (void)ws;
            for (int u = F.bid; u < 1024; u += F.G) DUP(3, u_rwkv_r3(F, l, u >> 3, u & 7));
            for (int u = F.bid; u < 512; u += F.G) DUP(10, u_attn_comb(F, u >> 7, (u >> 2) & 31, u & 3));
            relaunder(F, args.ws, (LAS unsigned char*)lds_raw);
            for (int u = F.bid; u < 256; u += F.G) DUP(2, u_mamba_out(F, l, u >> 1, u & 1));
            relaunder(F, args.ws, (LAS unsigned char*)lds_raw);
            for (int u = F.bid; u < 512; u += F.G) DUP(1, u_ret_out(F, l, u >> 2, u & 3));
            } SEAM(sb + 7);
        }
        if (EN(8) && RUN(sb + 8)) { _Pragma("unroll 1") for (int rp = 0; rp <= (int)REP(8); ++rp) { relaunder(F, args.ws, (LAS unsigned char*)lds_raw); unsigned char* ws = F.ws;
            pg8::Gemm g{(const bf16*)(ws + WS_OB), (const bf16*)(ws + WS_WBR) + (size_t)l * 8192 * 512, 512, D, 512};
            pg8::BranchOrder So; So.init(F.G, F.bid); pg8::EpiBranch E{ws};
            DUP(8, (pg8::gemm_phase<pg8::EpiBranch, pg8::BranchOrder, true>(F.lds, g, So, E, F.tid)));
            } SEAM(sb + 8);
        }
        if (EN(9) && RUN(sb + 9)) { _Pragma("unroll 1") for (int rp = 0; rp <= (int)REP(9); ++rp) { relaunder(F, args.ws, (LAS unsigned char*)lds_raw); unsigned char* ws = F.ws;
            pg8::Gemm g{(const bf16*)(ws + WS_MERGED), (const bf16*)(ws + WS_WOUT) + (size_t)l * D * D, D, D, D};
            pg8::StaticOrder So; So.init(S, D, F.G, F.bid); pg8::EpiRes E{xin, args.out, (bf16*)(ws + WS_XN), (float*)(ws + WS_RSSB)};
            pg8::gemm_phase<pg8::EpiRes, pg8::StaticOrder, true>(F.lds, g, So, E, F.tid);
            } SEAM(sb + 9);
        }
        if (EN(10) && RUN(sb + 10)) { _Pragma("unroll 1") for (int rp = 0; rp <= (int)REP(10); ++rp) { relaunder(F, args.ws, (LAS unsigned char*)lds_raw); unsigned char* ws = F.ws; DUP(11, p_rmsnorm(F, args.out, (const float*)(ws + WS_PRM) + (size_t)l * PRM_STRIDE + P_N2, (bf16*)(ws + WS_XN))); } SEAM(sb + 10); }
        if (EN(11) && RUN(sb + 11)) { _Pragma("unroll 1") for (int rp = 0; rp <= (int)REP(11); ++rp) { relaunder(F, args.ws, (LAS unsigned char*)lds_raw); unsigned char* ws = F.ws;
            pg8::Gemm g{(const bf16*)(ws + WS_XN), (const bf16*)(ws + WS_WGU) + (size_t)l * 2 * DFF * D, D, D, D};
            pg8::StaticOrder So; So.init(S, 2 * DFF, F.G, F.bid); pg8::EpiGu E{ws, (const LAS float*)(F.lds + RTAB_OFF)};
            pg8::fill_rstd((LAS float*)(F.lds + RTAB_OFF), (const float*)(ws + WS_RSSB), So, F.tid);
            DUP(7, (pg8::gemm_phase<pg8::EpiGu, pg8::StaticOrder, true>(F.lds, g, So, E, F.tid)));
            } SEAM(sb + 11);
        }
        if (EN(12) && RUN(sb + 12)) { _Pragma("unroll 1") for (int rp = 0; rp <= (int)REP(12); ++rp) { relaunder(F, args.ws, (LAS unsigned char*)lds_raw); unsigned char* ws = F.ws;
            pg8::Gemm g{(const bf16*)(ws + WS_ACT), (const bf16*)(ws + WS_WDN) + (size_t)l * D * DFF, DFF, DFF, DFF};
            pg8::StaticOrder So; So.init(S, D, F.G, F.bid); pg8::EpiRes E{args.out, args.out, (bf16*)(ws + WS_XN), (l + 1 < DEPTH) ? (float*)(ws + WS_RSSA) : nullptr};
            pg8::gemm_phase<pg8::EpiRes, pg8::StaticOrder, true>(F.lds, g, So, E, F.tid);
            } SEAM(sb + 12);
        }
    }
#ifdef MK_PROBE
    { const int l = 3;
      if (RUN(200)) { relaunder(F, args.ws, (LAS unsigned char*)lds_raw); for (int u = F.bid; u < 1024; u += F.G) u_rwkv_r3(F, l, u >> 3, u & 7); }
      if (RUN(201)) { relaunder(F, args.ws, (LAS unsigned char*)lds_raw); for (int u = F.bid; u < 512; u += F.G) u_attn_comb(F, u >> 7, (u >> 2) & 31, u & 3); }
      if (RUN(202)) { relaunder(F, args.ws, (LAS unsigned char*)lds_raw); for (int u = F.bid; u < 256; u += F.G) u_mamba_out(F, l, u >> 1, u & 1); }
      if (RUN(203)) { relaunder(F, args.ws, (LAS unsigned char*)lds_raw); for (int u = F.bid; u < 512; u += F.G) u_ret_out(F, l, u >> 2, u & 3); }
      if (RUN(204)) { relaunder(F, args.ws, (LAS unsigned char*)lds_raw); if (F.bid < F.G - 32) { const int Gs = F.G; F.G = Gs - 32; p_rwkv_prep(F, l); F.G = Gs; } }
      if (RUN(205)) { relaunder(F, args.ws, (LAS unsigned char*)lds_raw); if (F.bid < F.G - 32) { const int Gs = F.G; F.G = Gs - 32; p_mamba_prep(F, l); F.G = Gs; } }
      if (RUN(206)) { relaunder(F, args.ws, (LAS unsigned char*)lds_raw); if (F.bid < F.G - 32) { const int Gs = F.G; F.G = Gs - 32; for (int u = F.bid; u < 512; u += F.G) u_ret_kv(F, u >> 2, u & 3); F.G = Gs; } }
      if (RUN(207)) { relaunder(F, args.ws, (LAS unsigned char*)lds_raw); if (F.bid < 64) p_scans(F, 64); }
      if (RUN(208)) { relaunder(F, args.ws, (LAS unsigned char*)lds_raw); if (F.bid >= 64) { for (int u = 128 + (F.bid - 64); u < 1024; u += F.G - 64) u_rwkv_r1(F, u >> 3, u & 7); } }
      if (RUN(210)) { relaunder(F, args.ws, (LAS unsigned char*)lds_raw); unsigned char* ws = F.ws; if (F.bid >= F.G - 32) {
                pg8::Gemm g{(const bf16*)(ws + WS_XN), (const bf16*)(ws + WS_WIN) + ((size_t)l * NINP + (NINP - 256)) * D, D, D, D};
                pg8::StaticOrder So; So.init(S, 256, 32, F.bid - (F.G - 32)); pg8::EpiMisc E{ws, (const LAS float*)(F.lds + RTAB_OFF)};
                pg8::fill_rstd((LAS float*)(F.lds + RTAB_OFF), (const float*)(ws + WS_RSSA), So, F.tid);
                pg8::gemm_phase<pg8::EpiMisc, pg8::StaticOrder, true>(F.lds, g, So, E, F.tid); } }
      if (RUN(209)) { relaunder(F, args.ws, (LAS unsigned char*)lds_raw); if (F.bid < NSCAN_BLK) p_rwkv_scan2(F, F.bid); }
    }
#endif
#undef RUN
#undef SEAM
}

#ifndef MK_ONE_LAUNCH
#define MK_ONE_LAUNCH 1
#endif
extern "C" void kernel_launch(void* const* d_in, const int* in_sizes, int n_in, void* d_out, int out_size, void* d_ws, size_t ws_size, hipStream_t stream) {
    static int grid = 0;
    if (grid == 0) {
        if (n_in != 36 || in_sizes[0] != S * D || out_size != S * D || ws_size < WS_END3) { fprintf(stderr, "kernel_launch: bad shapes: n_in %d in0 %d out %d ws %zu (need %zu)\n", n_in, n_in > 0 ? in_sizes[0] : -1, out_size, ws_size, (size_t)WS_END3); grid = -1; return; }
        int dev = 0, cus = 0, per_cu = 0;
        if (hipGetDevice(&dev) != hipSuccess || hipDeviceGetAttribute(&cus, hipDeviceAttributeMultiprocessorCount, dev) != hipSuccess) { grid = -1; return; }
        if (hipFuncSetAttribute((const void*)mk_fwd, hipFuncAttributeMaxDynamicSharedMemorySize, LDS_BYTES) != hipSuccess) { fprintf(stderr, "kernel_launch: hipFuncSetAttribute failed\n"); grid = -1; return; }
        if (hipOccupancyMaxActiveBlocksPerMultiprocessor(&per_cu, (const void*)mk_fwd, NTHR, LDS_BYTES) != hipSuccess || per_cu < 1) fprintf(stderr, "kernel_launch: occupancy query says %d\n", per_cu);
        (void)hipGetLastError();
        grid = cus;
        if (grid != 256) fprintf(stderr, "kernel_launch: %d CUs (built for 256)\n", grid);
    }
    if (grid < 0) return;
    if (hipMemsetAsync((char*)d_ws + WS_CTL, 0, CTL_ZERO_BYTES, stream) != hipSuccess) return;
    Args a{};
    for (int i = 0; i < 36; ++i) a.in[i] = (const float*)d_in[i];
    a.out = (float*)d_out; a.ws = (unsigned char*)d_ws;
#if MK_ONE_LAUNCH
    a.st_lo = 0; a.st_hi = NSTEPS;
    hipLaunchKernelGGL(mk_fwd, dim3(grid), dim3(NTHR), LDS_BYTES, stream, a);
#ifndef MK_EXTRA_FLAGS
#define MK_EXTRA_FLAGS 0
#endif
#ifdef MK_EXTRA_STEPS
    { const int xs[] = {MK_EXTRA_STEPS};
      for (int r = 0; r < MK_EXTRA_N; ++r) for (unsigned i = 0; i < sizeof(xs) / sizeof(xs[0]); ++i) { a.st_lo = xs[i]; a.st_hi = xs[i] + 1; hipLaunchKernelGGL(mk_fwd, dim3(grid), dim3(NTHR), LDS_BYTES, stream, a); } }
#endif
#else
    for (int s = 0; s < NSTEPS; ++s) { a.st_lo = s; a.st_hi = s + 1; hipLaunchKernelGGL(mk_fwd, dim3(grid), dim3(NTHR), LDS_BYTES, stream, a); }
#endif
}
```

```cpp
#include <hip/hip_runtime.h>
#include <cstdio>
#include <cstdint>

#define GAS __attribute__((address_space(1)))
#define LAS __attribute__((address_space(3)))
typedef unsigned short bf16;
typedef short bf16x8 __attribute__((ext_vector_type(8)));
typedef short s16x4 __attribute__((ext_vector_type(4)));
typedef float f32x4 __attribute__((ext_vector_type(4)));
typedef float f32x2 __attribute__((ext_vector_type(2)));
typedef unsigned u32x4 __attribute__((ext_vector_type(4)));
typedef unsigned u32x2 __attribute__((ext_vector_type(2)));
typedef GAS unsigned gu32;
#define RLX_AGENT __ATOMIC_RELAXED, __HIP_MEMORY_SCOPE_AGENT
#define DI __device__ __forceinline__

constexpr int S = 8192, D = 2048, DEPTH = 4, NIN = 14408, NINP = 14592, DFF = 5632;
constexpr int NCH = 128;
constexpr float LOG2E = 1.4426950408889634f;

DI float bf2f(unsigned v) { return __uint_as_float(v << 16); }
typedef __bf16 bf16x2_t __attribute__((ext_vector_type(2)));
DI unsigned pk2(float lo, float hi) { const f32x2 v = {lo, hi}; const bf16x2_t b = __builtin_convertvector(v, bf16x2_t); return __builtin_bit_cast(unsigned, b); }
DI unsigned f2bf(float f) { const __bf16 b = (__bf16)f; return (unsigned)__builtin_bit_cast(unsigned short, b); }
DI float fexp_(float x) { return __builtin_amdgcn_exp2f(x * 1.4426950408889634f); }
DI float ftanh_(float x) { return 1.0f - 2.0f * __builtin_amdgcn_rcpf(1.0f + fexp_(2.0f * x)); }
DI float sigmoidf_(float x) { return __builtin_amdgcn_rcpf(1.0f + fexp_(-x)); }
DI float siluf_(float x) { return x * __builtin_amdgcn_rcpf(1.0f + fexp_(-x)); }
DI float softplusf_(float x) { return fmaxf(x, 0.f) + log1pf(fexp_(-fabsf(x))); }
DI u32x4 pack8(const f32x4 a, const f32x4 b) { u32x4 w; w.x = pk2(a[0], a[1]); w.y = pk2(a[2], a[3]); w.z = pk2(b[0], b[1]); w.w = pk2(b[2], b[3]); return w; }
DI void unpack8(const u32x4 w, float (&o)[8]) { o[0] = bf2f(w.x & 0xffffu); o[1] = bf2f(w.x >> 16); o[2] = bf2f(w.y & 0xffffu); o[3] = bf2f(w.y >> 16);
    o[4] = bf2f(w.z & 0xffffu); o[5] = bf2f(w.z >> 16); o[6] = bf2f(w.w & 0xffffu); o[7] = bf2f(w.w >> 16); }

namespace pg8 {
constexpr int BM = 256, BK = 64, HALF = 128, HTB = HALF * BK * 2, STAGE_BYTES = 8 * HTB, NXCD = 8, WGM = 8;
DI int lds_byte(int r, int c) { const int st = (r >> 4) * 2 + (c >> 5), rr = r & 15, cc = c & 31, ob = rr * 64 + cc * 2; return st * 1024 + (ob ^ (((ob >> 9) & 1) << 5)); }
DI void stage_rc(int b, int& R, int& C) { const int st = b / 1024, sb = b % 1024, swz = sb ^ (((sb >> 9) & 1) << 5); R = (st >> 1) * 16 + swz / 64; C = (st & 1) * 32 + (swz % 64) / 2; }
DI int perm32(int rho) { const int n = rho >> 4, i = rho & 15; return 8 * (i >> 2) + 4 * n + (i & 3); }

struct Unit { int pm, pn, ak, brow, sub, ord; };
struct Gemm { const bf16* A; const bf16* Bt; int K, lda, ldb; };

struct StaticOrder {
    int nM, nN, nwg, G, c;
    DI void init(int M, int N, int G_, int c_) { nM = M / BM; nN = N / BM; nwg = nM * nN; G = G_; c = c_; }
    DI bool next(int i, Unit& u) const {
        const long L = (long)i * G + c; if (L >= nwg) return false;
        int wgid = (int)L; { const int q = nwg / NXCD, r = nwg % NXCD, xcd = wgid % NXCD, off = wgid / NXCD; wgid = (xcd < r ? xcd * (q + 1) : r * (q + 1) + (xcd - r) * q) + off; }
        const int nig = WGM * nN, gid = wgid / nig, fm = gid * WGM, gsz = (nM - fm) < WGM ? (nM - fm) : WGM;
        u.pm = fm + ((wgid % nig) % gsz); u.pn = (wgid % nig) / gsz; u.ak = 0; u.brow = u.pn * BM; u.sub = 0; return true;
    }
};
struct LoraOrder {
    StaticOrder so;
    DI void init(int N, int G_, int c_) { so.init(S, N, G_, c_); }
    DI bool next(int i, Unit& u) const { if (!so.next(i, u)) return false; u.ak = (u.pn >= 4) ? 256 : 0; return true; }
};
struct BranchOrder {
    StaticOrder so;
    DI void init(int G_, int c_) { so.init(S, D, G_, c_); }
    DI bool next(int i, Unit& u) const { if (!so.next(i >> 2, u)) return false; u.sub = i & 3; u.ak = u.sub * 512; u.brow = u.sub * D + u.pn * BM; return true; }
};

typedef f32x4 Acc[2][2][4][2];

template <class Epi, class Sched, bool ALIGN_EPI>
DI void gemm_phase(LAS unsigned char* lds, const Gemm g, const Sched& Sc, const Epi& E, const int tid) {
    const int wid = __builtin_amdgcn_readfirstlane(tid >> 6), lane = tid & 63, wr = wid >> 2, wc = wid & 3, fr = lane & 15, fq = lane >> 4;
    const int K = g.K, nt = K / BK;
    unsigned voffA[2], voffB[2];
#pragma unroll
    for (int i = 0; i < 2; ++i) { int R, C; stage_rc(tid * 16 + i * 8192, R, C); const int Rb = (R & ~31) + perm32(R & 31);
        voffA[i] = (unsigned)(R * g.lda + C) * 2u; voffB[i] = (unsigned)(Rb * g.ldb + C) * 2u; }
    const size_t kstep = (size_t)(BK * 2);
    const size_t hA = (size_t)HALF * g.lda * 2, hB = (size_t)HALF * g.ldb * 2;
    const unsigned ldsw = (unsigned)wid * 1024u;
    const int aoff = lds_byte(wr * 64 + fr, fq * 8), boff = lds_byte(wc * 32 + fr, fq * 8);
#define PG8_SA(b, h) (((b) * 2 + (h)) * HTB)
#define PG8_SB(b, h) ((4 + (b) * 2 + (h)) * HTB)
#define PG8_STAGE(bufoff, gbase, voff) do { _Pragma("unroll") for (int _i = 0; _i < 2; ++_i) \
        __builtin_amdgcn_global_load_lds((const unsigned*)((const char*)(gbase) + (voff)[_i]), (LAS unsigned*)(lds + (bufoff) + ldsw + _i * 8192), 16, 0, 0); } while (0)
#define PG8_LDA(dst, b, h) do { _Pragma("unroll") for (int m = 0; m < 4; ++m) _Pragma("unroll") for (int k = 0; k < 2; ++k) dst[m][k] = *(const LAS bf16x8*)(lds + PG8_SA(b, h) + aoff + m * 2048 + k * 1024); } while (0)
#define PG8_LDB(dst, b, h) do { _Pragma("unroll") for (int n = 0; n < 2; ++n) _Pragma("unroll") for (int k = 0; k < 2; ++k) dst[n][k] = *(const LAS bf16x8*)(lds + PG8_SB(b, h) + boff + n * 2048 + k * 1024); } while (0)
#define PG8_MMA(ai, bj, At, Bt) do { __builtin_amdgcn_s_setprio(1); _Pragma("unroll") for (int m = 0; m < 4; ++m) _Pragma("unroll") for (int n = 0; n < 2; ++n) _Pragma("unroll") for (int k = 0; k < 2; ++k) \
        acc[ai][bj][m][n] = __builtin_amdgcn_mfma_f32_16x16x32_bf16(Bt[n][k], At[m][k], acc[ai][bj][m][n], 0, 0, 0); __builtin_amdgcn_s_setprio(0); } while (0)
#define PG8_WAIT_V(n) asm volatile("s_waitcnt vmcnt(" #n ")" ::: "memory")
#define PG8_WAIT_L(n) asm volatile("s_waitcnt lgkmcnt(" #n ")" ::: "memory")
#define PG8_BAR __builtin_amdgcn_s_barrier()
#define PG8_SCHED __builtin_amdgcn_sched_barrier(0)
    Unit cur, nxt; int ui = 0;
    if (!Sc.next(0, cur)) return;
    cur.ord = 0;
    Acc acc;
#pragma unroll
    for (int a = 0; a < 2; ++a)
#pragma unroll
        for (int b = 0; b < 2; ++b)
#pragma unroll
            for (int m = 0; m < 4; ++m)
#pragma unroll
                for (int n = 0; n < 2; ++n) acc[a][b][m][n] = (f32x4){0.f, 0.f, 0.f, 0.f};
    bf16x8 At[4][2], B0[2][2], B1[2][2];
    const char* cA = (const char*)g.A + ((size_t)cur.pm * BM * g.lda + cur.ak) * 2; const char* cB = (const char*)g.Bt + (size_t)cur.brow * g.ldb * 2;
    PG8_STAGE(PG8_SB(0, 0), cB, voffB); PG8_STAGE(PG8_SB(0, 1), cB + hB, voffB); PG8_STAGE(PG8_SA(0, 0), cA, voffA); PG8_STAGE(PG8_SA(0, 1), cA + hA, voffA);
    if (wr == 1) PG8_BAR;
    PG8_WAIT_V(2); PG8_BAR;
    PG8_STAGE(PG8_SB(1, 0), cB + kstep, voffB); PG8_STAGE(PG8_SA(1, 0), cA + kstep, voffA); PG8_STAGE(PG8_SB(1, 1), cB + hB + kstep, voffB);
    PG8_WAIT_V(6); PG8_BAR;
    for (;;) {
        const bool has_next = Sc.next(ui + 1, nxt); nxt.ord = ui + 1;
        const char* nA = has_next ? (const char*)g.A + ((size_t)nxt.pm * BM * g.lda + nxt.ak) * 2 : cA; const char* nB = has_next ? (const char*)g.Bt + (size_t)nxt.brow * g.ldb * 2 : cB;
        for (int t = 0; t < nt; t += 2) {
            const bool last = (t == nt - 2);
            const char* a1 = cA + (size_t)(t + 1) * kstep;
            const char* a2 = last ? nA : cA + (size_t)(t + 2) * kstep; const char* b2 = last ? nB : cB + (size_t)(t + 2) * kstep;
            const char* a3 = a2 + kstep; const char* b3 = b2 + kstep;
            PG8_LDB(B0, 0, 0); PG8_LDB(B1, 0, 1); PG8_SCHED; PG8_LDA(At, 0, 0); PG8_STAGE(PG8_SA(1, 1), a1 + hA, voffA);
            PG8_WAIT_V(8); PG8_WAIT_L(0); PG8_BAR; PG8_MMA(0, 0, At, B0); PG8_MMA(0, 1, At, B1); PG8_BAR; PG8_SCHED;
            PG8_LDA(At, 0, 1); PG8_STAGE(PG8_SB(0, 0), b2, voffB); PG8_STAGE(PG8_SB(0, 1), b2 + hB, voffB); PG8_STAGE(PG8_SA(0, 0), a2, voffA);
            PG8_WAIT_V(8); PG8_WAIT_L(0); PG8_BAR; PG8_MMA(1, 0, At, B0); PG8_MMA(1, 1, At, B1); PG8_BAR; PG8_SCHED;
            PG8_LDB(B0, 1, 0); PG8_LDB(B1, 1, 1); PG8_SCHED; PG8_LDA(At, 1, 0); PG8_STAGE(PG8_SA(0, 1), a2 + hA, voffA);
            PG8_WAIT_V(8); PG8_WAIT_L(0); PG8_BAR; PG8_MMA(0, 0, At, B0); PG8_MMA(0, 1, At, B1); PG8_BAR; PG8_SCHED;
            PG8_LDA(At, 1, 1); PG8_STAGE(PG8_SB(1, 0), b3, voffB); PG8_STAGE(PG8_SB(1, 1), b3 + hB, voffB); PG8_STAGE(PG8_SA(1, 0), a3, voffA);
            PG8_WAIT_V(8); PG8_WAIT_L(0); PG8_BAR; PG8_MMA(1, 0, At, B0); PG8_MMA(1, 1, At, B1); PG8_BAR; PG8_SCHED;
        }
        if constexpr (ALIGN_EPI) { if (wr == 0) PG8_BAR; }
        bool zero = true;
        if constexpr (!Epi::AFTER_DRAIN) { zero = E(acc, cur, wr, wc, fr, fq); }
        if (!has_next) break;
        if (zero) {
#pragma unroll
        for (int a = 0; a < 2; ++a)
#pragma unroll
            for (int b = 0; b < 2; ++b)
#pragma unroll
                for (int m = 0; m < 4; ++m)
#pragma unroll
                    for (int n = 0; n < 2; ++n) acc[a][b][m][n] = (f32x4){0.f, 0.f, 0.f, 0.f};
        }
        cur = nxt; cA = nA; cB = nB; ++ui;
        if constexpr (ALIGN_EPI) { if (wr == 1) PG8_BAR; }
    }
    PG8_WAIT_V(0);
    if constexpr (!ALIGN_EPI) { if (wr == 0) PG8_BAR; }
    PG8_BAR;
    if constexpr (Epi::AFTER_DRAIN) { E.fused(acc, cur, wr, wc, fr, fq, lds, wid, lane, tid); }
#undef PG8_SA
#undef PG8_SB
#undef PG8_STAGE
#undef PG8_LDA
#undef PG8_LDB
#undef PG8_MMA
#undef PG8_WAIT_V
#undef PG8_WAIT_L
#undef PG8_BAR
#undef PG8_SCHED
}
}

constexpr size_t MiB = 1u << 20;
constexpr size_t al256(size_t x) { return (x + 255) & ~(size_t)255; }
constexpr size_t WS_CTL = 0, CTL_ZERO_BYTES = 1 * MiB;
constexpr size_t WS_PRM = 1 * MiB;
constexpr int P_N1 = 0, P_N2 = 2048, P_GN = 4096, P_CW = 4608, P_CB = 8704, P_DTB = 9728, P_ALOG = 9736, P_SD = 9744, P_SNW = 9760, P_QNW = 10272, P_KNW = 10464, P_MU = 10656,
              P_W0 = 12448, P_A0 = 12960, P_V0 = 13472, P_KK = 13984, P_KA = 14496, P_RK = 15008, P_LNW = 15520, P_LNB = 16032, PRM_STRIDE = 16640;
constexpr size_t WS_COSR = 2 * MiB;
constexpr size_t WS_SINR = WS_COSR + (size_t)S * 64 * 4;
constexpr size_t WS_COSM = WS_SINR + (size_t)S * 64 * 4;
constexpr size_t WS_SINM = WS_COSM + (size_t)S * 32 * 4;
constexpr size_t WS_WIN  = WS_SINM + (size_t)S * 32 * 4;
constexpr size_t WS_WQB  = WS_WIN + (size_t)DEPTH * NINP * D * 2;
constexpr size_t WS_WKVB = WS_WQB + (size_t)DEPTH * 1024 * 512 * 2;
constexpr size_t WS_WV1  = WS_WKVB + (size_t)DEPTH * 1024 * 256 * 2;
constexpr size_t WS_WLORA = WS_WV1 + (size_t)DEPTH * 256 * 512 * 2;
constexpr size_t WS_WBR  = WS_WLORA + (size_t)DEPTH * 2048 * 512 * 2;
constexpr size_t WS_WOUT = WS_WBR + (size_t)DEPTH * 8192 * 512 * 2;
constexpr size_t WS_WGU  = WS_WOUT + (size_t)DEPTH * D * D * 2;
constexpr size_t WS_WDN  = WS_WGU + (size_t)DEPTH * 2 * DFF * D * 2;
constexpr size_t WS_ACT0 = WS_WDN + (size_t)DEPTH * D * DFF * 2;
constexpr size_t WS_XN   = WS_ACT0;
constexpr size_t WS_QR   = WS_XN + (size_t)S * D * 2;
constexpr size_t WS_KR   = WS_QR + (size_t)S * 512 * 2;
constexpr size_t WS_VR   = WS_KR + (size_t)S * 512 * 2;
constexpr size_t WS_GR   = WS_VR + (size_t)S * 512 * 2;
constexpr size_t WS_ZS   = WS_GR + (size_t)S * 512 * 2;
constexpr size_t WS_XBC  = WS_ZS + (size_t)S * 512 * 2;
constexpr size_t WS_XC   = WS_XBC + (size_t)S * 1024 * 2;
constexpr size_t WS_CQ   = WS_XC + (size_t)S * 1024 * 2;
constexpr size_t WS_CKV  = WS_CQ + (size_t)S * 512 * 2;
constexpr size_t WS_SSQ  = WS_CKV + (size_t)S * 256 * 2;
constexpr size_t WS_RW   = WS_SSQ + (size_t)S * 16 * 4;
constexpr size_t WS_GATE = WS_RW + (size_t)S * 1792 * 4;
constexpr size_t WS_MISC = WS_GATE + (size_t)S * 8192 * 2;
constexpr size_t WS_DTS  = WS_MISC + (size_t)S * 256 * 4;
constexpr size_t WS_ACS  = WS_DTS + (size_t)S * 8 * 4;
constexpr size_t WS_RKV  = WS_ACS + (size_t)S * 8 * 4;
constexpr size_t WS_MST  = WS_RKV + (size_t)NCH * 4 * 128 * 128 * 4;
constexpr size_t WS_QM   = WS_MST + (size_t)NCH * 8 * 64 * 128 * 4;
constexpr size_t WS_KM   = WS_QM + (size_t)S * 768 * 2;
constexpr size_t WS_VT   = WS_KM + (size_t)S * 768 * 2;
constexpr size_t WS_R32  = WS_VT + (size_t)512 * S * 2;
constexpr size_t SZ32    = (size_t)S * 512 * 4;
constexpr size_t WS_KKN  = WS_R32 + SZ32, WS_K32 = WS_KKN + SZ32, WS_VV = WS_K32 + SZ32, WS_VFIRST = WS_VV + SZ32, WS_DEC = WS_VFIRST + SZ32,
                 WS_KP = WS_DEC + SZ32, WS_BB = WS_KP + SZ32, WS_G32 = WS_BB + SZ32, WS_Y32 = WS_G32 + SZ32;
constexpr size_t WS_VB   = WS_Y32 + SZ32;
constexpr size_t WS_ALORA = WS_VB + (size_t)S * 512 * 2;
constexpr size_t WS_OB   = WS_ALORA + (size_t)S * 512 * 2;
constexpr size_t WS_MERGED = WS_OB + (size_t)S * D * 2;
constexpr size_t WS_ACT  = WS_MERGED + (size_t)S * D * 2;
constexpr size_t WS_END  = WS_ACT + (size_t)S * DFF * 2;

constexpr int CW_TMO = 0, CW_CODE = 1, CW_BAR = 4096;


constexpr int NWAVES = 8, NTHR = 512;
constexpr int RING_BYTES = 143360, LDSCTL_OFF = RING_BYTES, MISC_OFF = LDSCTL_OFF + 320, LDS_BYTES = 147456;
#define LDS_WAIT() asm volatile("s_waitcnt lgkmcnt(0)" ::: "memory")
#define VM_WAIT() asm volatile("s_waitcnt vmcnt(0)" ::: "memory")

#define XB_TMO      128
#define XB_XCNT(j)  (256  + 64 * (j))
#define XB_XSUB(j)  (1280 + 64 * (j))
#define XB_XGEN(j)  (2304 + 64 * (j))
#define XB_TOP      3328
#define XB_TOPGEN   3392
#define XCD_BAR_WORDS 3456
#define XB_SPIN_CAP (1u << 22)
DI unsigned xb_ld(unsigned* p)              { return __hip_atomic_load(p, __ATOMIC_RELAXED, __HIP_MEMORY_SCOPE_AGENT); }
DI unsigned xb_add(unsigned* p, unsigned v) { return __hip_atomic_fetch_add(p, v, __ATOMIC_RELAXED, __HIP_MEMORY_SCOPE_AGENT); }
DI unsigned xb_xcc_id() { return (unsigned)__builtin_amdgcn_s_getreg((3 << 11) | 20) & 0xFu; }
#define XB_SPIN(cond, bar) do { unsigned _sp = 0; while (cond) { __builtin_amdgcn_s_sleep(1); \
    if ((++_sp & 255u) == 0u) { if (xb_ld(&(bar)[XB_TMO])) break; if (_sp > XB_SPIN_CAP) { atomicAdd(&(bar)[XB_TMO], 1u); break; } } } } while (0)
struct XcdBarrier { unsigned* bar; unsigned x; volatile LAS unsigned* st; };
DI XcdBarrier xcd_barrier_post(unsigned* bar, volatile LAS unsigned* st) {
    XcdBarrier b; b.bar = bar; b.x = xb_xcc_id(); b.st = st;
    if (threadIdx.x == 0) (void)xb_add(&bar[XB_XCNT(b.x)], 1u);
    return b;
}
DI void xcd_barrier_complete(unsigned* bar, unsigned x, unsigned& nloc, unsigned& nx) {
    const unsigned G = gridDim.x * gridDim.y * gridDim.z;
    unsigned sum, cnt, mine, sp = 0u;
    for (;;) {
        sum = 0u; cnt = 0u; mine = 0u;
#pragma unroll
        for (unsigned j = 0; j < 16; ++j) { const unsigned c = xb_ld(&bar[XB_XCNT(j)]); sum += c; cnt += (c > 0u) ? 1u : 0u; mine = (j == x) ? c : mine; }
        if (sum == G) break;
        __builtin_amdgcn_s_sleep(1);
        if ((++sp & 255u) == 0u) { if (xb_ld(&bar[XB_TMO])) break; if (sp > XB_SPIN_CAP) { atomicAdd(&bar[XB_TMO], 1u); break; } }
    }
    nloc = mine > 0u ? mine : 1u; nx = cnt > 0u ? cnt : 1u;
}
DI void xcd_barrier(const XcdBarrier& b) {
    asm volatile("s_waitcnt vmcnt(0)" ::: "memory");
    __syncthreads();
    if (threadIdx.x == 0) {
        unsigned* bar = b.bar;
        __builtin_amdgcn_s_waitcnt(0);
        unsigned nloc = b.st[0], nx = b.st[1];
        if (nloc == 0u) { xcd_barrier_complete(bar, b.x, nloc, nx); b.st[0] = nloc; b.st[1] = nx; }
        const unsigned old = xb_add(&bar[XB_XSUB(b.x)], 1u);
        const unsigned gen = old / nloc;
        if (old + 1u == (gen + 1u) * nloc) {
            __builtin_amdgcn_fence(__ATOMIC_RELEASE, "agent");
            asm volatile("s_waitcnt vmcnt(0)" ::: "memory");
            const unsigned og = xb_add(&bar[XB_TOP], 1u);
            const unsigned tg = og / nx;
            if (og + 1u == (tg + 1u) * nx) xb_add(&bar[XB_TOPGEN], 1u);
            else XB_SPIN(xb_ld(&bar[XB_TOPGEN]) == tg, bar);
            __builtin_amdgcn_fence(__ATOMIC_ACQUIRE, "agent");
            xb_add(&bar[XB_XGEN(b.x)], 1u);
            asm volatile("s_waitcnt vmcnt(0)" ::: "memory");
        } else {
            XB_SPIN(xb_ld(&bar[XB_XGEN(b.x)]) == gen, bar);
            __builtin_amdgcn_fence(__ATOMIC_ACQUIRE, "agent");
            asm volatile("s_waitcnt vmcnt(0)" ::: "memory");
        }
    }
    __syncthreads();
}

struct Args { const float* in[36]; float* out; unsigned char* ws; int st_lo, st_hi; };
struct Frame {
    LAS unsigned char* lds; volatile LAS unsigned* MISC; gu32* ctl;
    int tid, lane, wave, G, bid;
    unsigned char* ws;
};
DI void relaunder(Frame& F, unsigned char* ws0, LAS unsigned char* lds0) {
    int t = threadIdx.x; asm volatile("" : "+v"(t)); F.tid = t; F.lane = t & 63; F.wave = __builtin_amdgcn_readfirstlane(t >> 6);
    unsigned long long w = (unsigned long long)ws0; asm volatile("" : "+s"(w)); F.ws = (unsigned char*)w; F.ctl = (gu32*)(F.ws + WS_CTL);
    unsigned lb = (unsigned)(unsigned long)lds0; asm volatile("" : "+s"(lb)); F.lds = (LAS unsigned char*)(unsigned long)lb; F.MISC = (volatile LAS unsigned*)(F.lds + MISC_OFF);
    int b = blockIdx.x; asm volatile("" : "+s"(b)); F.bid = b;
}
#define XR_SWAP(INS, a, b) asm volatile("s_nop 1\n\t" INS " %0, %1" : "+v"(a), "+v"(b))
DI float xr16_max(float x) { float a = x, b = x; XR_SWAP("v_permlane16_swap_b32", a, b); return fmaxf(a, b); }
DI float xr32_max(float x) { float a = x, b = x; XR_SWAP("v_permlane32_swap_b32", a, b); return fmaxf(a, b); }
DI float xr16_sum(float x) { float a = x, b = x; XR_SWAP("v_permlane16_swap_b32", a, b); return a + b; }
DI float xr32_sum(float x) { float a = x, b = x; XR_SWAP("v_permlane32_swap_b32", a, b); return a + b; }
template <int CTRL> DI float dpp_f(float v) { return __builtin_bit_cast(float, __builtin_amdgcn_update_dpp(0, __builtin_bit_cast(int, v), CTRL, 0xf, 0xf, true)); }
DI float row_sum8(float v) { v += dpp_f<0xB1>(v); v += dpp_f<0x4E>(v); v += dpp_f<0x141>(v); return v; }
DI float row_sum16(float v) { v += dpp_f<0xB1>(v); v += dpp_f<0x4E>(v); v += dpp_f<0x141>(v); v += dpp_f<0x140>(v); return v; }
DI float wave_sum(float v) { return xr32_sum(xr16_sum(row_sum16(v))); }
DI float wave_sum_dpp(float v) {
    const float t = row_sum16(v);
    const float s0 = __builtin_bit_cast(float, __builtin_amdgcn_readlane(__builtin_bit_cast(int, t), 0));
    const float s1 = __builtin_bit_cast(float, __builtin_amdgcn_readlane(__builtin_bit_cast(int, t), 16));
    const float s2 = __builtin_bit_cast(float, __builtin_amdgcn_readlane(__builtin_bit_cast(int, t), 32));
    const float s3 = __builtin_bit_cast(float, __builtin_amdgcn_readlane(__builtin_bit_cast(int, t), 48));
    return (s0 + s1) + (s2 + s3);
}
constexpr size_t WS_QYT = WS_END;
constexpr size_t WS_CYT = WS_QYT + (size_t)1024 * 4096 * 2;
constexpr size_t WS_TST = WS_CYT + (size_t)1024 * 4096 * 2;
constexpr size_t WS_NST = WS_TST + (size_t)1024 * 4096 * 2;
constexpr size_t WS_S0  = WS_NST + (size_t)1024 * 4096 * 4;
constexpr size_t WS_END2 = WS_S0 + (size_t)1024 * 4096 * 2;
constexpr int ATT_NSUB = 576, ATT_RUN = 16;
constexpr size_t WS_ATAB = WS_END2;
constexpr size_t WS_APO  = WS_ATAB + 8192;
constexpr size_t WS_APM  = WS_APO + (size_t)ATT_NSUB * 32768 * 4;
constexpr size_t WS_RSSA = WS_APM + (size_t)ATT_NSUB * 512 * 4;
constexpr size_t WS_RSSB = WS_RSSA + (size_t)S * 32 * 4;
constexpr size_t WS_END3 = WS_RSSB + (size_t)S * 32 * 4;
constexpr int RTAB_OFF = 131072;
DI int att_slot(int h, int qb, int s) { const int g = qb >> 2; return h * 144 + (g + 1) * (qb - 2 * g) + s; }

DI int map_in(int n) {
    const int T = n >> 8, c = n & 255;
    if (T < 4) { const int base = (T >> 1) * 512, tp = T & 1, half = c >> 7, hs = (c >> 6) & 1, j = c & 63; return base + (2 * tp + hs) * 128 + half * 64 + j; }
    if (T < 6) return 1024 + (T - 4) * 256 + c;
    if (T < 8) return 1536 + (T - 6) * 256 + c;
    if (T < 10) return 2048 + (T - 8) * 256 + c;
    if (T < 14) return 2560 + (T - 10) * 256 + c;
    if (T < 16) return 3592 + (T - 14) * 256 + c;
    if (T == 16) return 4104 + c;
    if (T < 24) return 4424 + (T - 17) * 256 + c;
    if (T < 56) {
        const int j = T - 24, bj = c >> 7, wc = (c >> 5) & 3, fq = (c >> 3) & 3, n = (c >> 2) & 1, i = c & 3; return 6216 + (2 * bj + n) * 2048 + 64 * j + wc * 16 + fq * 4 + i; }
    if (c < 8) return 3584 + c;
    if (c < 72) return 4360 + (c - 8);
    return -1;
}
DI int map_fn(int mapid, int n, int Nsrc) {
    if (mapid == 0) return n < Nsrc ? n : -1;
    if (mapid == 1) return map_in(n);
    if (mapid == 2) { const int T = n >> 8, c = n & 255; return c < 128 ? T * 128 + c : DFF + T * 128 + (c - 128); }
    if (mapid == 3) { const int h = n >> 8, c = n & 255; if (c < 96) return h * 192 + c; if (c < 128) return h * 192 + 128 + (c - 96); if (c < 160) return h * 192 + 96 + (c - 128); if (c < 224) return -1; return h * 192 + 160 + (c - 224); }
    return n < 32 ? n : -1;
}
DI void conv_item(const float* W, int K, int Nsrc, bf16* Wt, const float* kscale, int mapid, LAS bf16* tile, int item, int nblk, int lane) {
    const int kb = item / nblk, nb = item - kb * nblk, k0 = 64 * kb, n0 = 64 * nb;
    const int src = map_fn(mapid, n0 + lane, Nsrc);
    const float* wp = W + (size_t)k0 * Nsrc + (src >= 0 ? src : 0);
    float v[64];
#pragma unroll
    for (int i = 0; i < 64; ++i) v[i] = wp[(size_t)i * Nsrc];
    if (src < 0) {
#pragma unroll
        for (int i = 0; i < 64; ++i) v[i] = 0.f; }
    if (kscale) {
#pragma unroll
        for (int i = 0; i < 64; ++i) v[i] *= kscale[k0 + i]; }
#pragma unroll
    for (int q = 0; q < 8; ++q) { u32x4 o; o.x = pk2(v[8 * q], v[8 * q + 1]); o.y = pk2(v[8 * q + 2], v[8 * q + 3]); o.z = pk2(v[8 * q + 4], v[8 * q + 5]); o.w = pk2(v[8 * q + 6], v[8 * q + 7]);
        *(LAS u32x4*)(tile + lane * 72 + 8 * q) = o; }
    LDS_WAIT(); asm volatile("" ::: "memory");
#pragma unroll
    for (int i = 0; i < 8; ++i) { const int r = i * 8 + (lane >> 3), c8 = lane & 7;
        *(GAS u32x4*)(Wt + (size_t)(n0 + r) * K + k0 + 8 * c8) = *(const LAS u32x4*)(tile + r * 72 + 8 * c8); }
    LDS_WAIT(); asm volatile("" ::: "memory");
}
struct ConvJob { const float* W; bf16* Wt; const float* kscale; int K, Nsrc, Ndst, mapid; };
DI void conv_job(Frame& F, const ConvJob j, int& base) {
    const int nblk = j.Ndst / 64, nitems = (j.K / 64) * nblk, NGW = F.G * NWAVES, gw = F.bid * NWAVES + F.wave;
    int first = (gw - base % NGW + NGW) % NGW; LAS bf16* tile = (LAS bf16*)(F.lds + F.wave * 16384);
    for (int it = first; it < nitems; it += NGW) conv_item(j.W, j.K, j.Nsrc, j.Wt, j.kscale, j.mapid, tile, it, nblk, F.lane);
    base += nitems;
}
DI void p_prologue(Frame& F, const Args& a) {
    unsigned char* ws = F.ws;
    const int gt = F.bid * NTHR + F.tid, NGT = F.G * NTHR;
    if (F.bid == 0 && F.tid == 0) { int* tab = (int*)(ws + WS_ATAB); int n = 0;
        for (int pass = 16; pass >= 4; pass -= 4)
            for (int qb = 31; qb >= 0; --qb) { const int nt = 4 * (qb + 1), nfull = nt >> 4, rem = nt & 15;
                for (int h = 0; h < 4; ++h) {
                    if (pass == 16) { for (int s2 = 0; s2 < nfull; ++s2) tab[n++] = h | (qb << 2) | (s2 << 7) | (16 << 12); }
                    else if (rem == pass) tab[n++] = h | (qb << 2) | (nfull << 7) | (rem << 12); } }
        for (; n < 2048; ++n) tab[n] = 0; }
    { float* prm = (float*)(ws + WS_PRM);
#define CPV(IDX, N, OFF, SRC_L) for (int e = gt; e < (N); e += NGT) prm[(size_t)l * PRM_STRIDE + (OFF) + e] = a.in[IDX][(size_t)(SRC_L) * (N) + e];
      for (int l = 0; l < DEPTH; ++l) {
          CPV(2, 2048, P_N1, l) CPV(33, 2048, P_N2, l) CPV(4, 512, P_GN, l) CPV(5, 4096, P_CW, l) CPV(6, 1024, P_CB, l) CPV(7, 8, P_DTB, l) CPV(8, 8, P_ALOG, l) CPV(9, 8, P_SD, l)
          CPV(10, 512, P_SNW, l) CPV(15, 192, P_QNW, l) CPV(16, 192, P_KNW, l) CPV(17, 1792, P_MU, l) CPV(18, 512, P_W0, l) CPV(20, 512, P_A0, l)
          CPV(23, 512, P_V0, (l > 0 ? l - 1 : 0)) CPV(26, 512, P_KK, l) CPV(27, 512, P_KA, l) CPV(28, 512, P_RK, l) CPV(29, 512, P_LNW, l) CPV(30, 512, P_LNB, l)
      }
#undef CPV
    }
    const int* pos = (const int*)a.in[1];
    for (int e = gt; e < S * 64; e += NGT) { const int t = e >> 6, i = e & 63;
        const float inv = 1.0f / powf(10000.0f, (float)(2 * i) / 128.0f); const float ang = (float)pos[t] * inv;
        double rev = (double)ang * 0.15915494309189535; rev -= rint(rev); const float r = (float)(rev * 6.283185307179586);
        ((float*)(ws + WS_COSR))[e] = __cosf(r); ((float*)(ws + WS_SINR))[e] = __sinf(r); }
    for (int e = gt; e < S * 32; e += NGT) { const int t = e >> 5, i = e & 31;
        const float inv = 1.0f / powf(10000.0f, (float)(2 * i) / 64.0f); const float ang = (float)pos[t] * inv;
        double rev = (double)ang * 0.15915494309189535; rev -= rint(rev); const float r = (float)(rev * 6.283185307179586);
        ((float*)(ws + WS_COSM))[e] = __cosf(r); ((float*)(ws + WS_SINM))[e] = __sinf(r); }
    for (int l = 0; l < DEPTH; ++l) {
        const float* w2 = a.in[19] + (size_t)l * 64 * 512; const float* a2 = a.in[21] + (size_t)l * 64 * 512; const float* g2 = a.in[22] + (size_t)l * 128 * 512;
        const float* v2 = a.in[25] + (size_t)(l > 0 ? l - 1 : 0) * 32 * 512;
        bf16* Lt = (bf16*)(ws + WS_WLORA) + (size_t)l * 2048 * 512;
        for (int w = gt; w < 2048 * 64; w += NGT) { const int kg = w >> 11, n = w & 2047, seg = n >> 9, j = n & 511; float v[8];
#pragma unroll
            for (int i = 0; i < 8; ++i) { const int k = kg * 8 + i; float x = 0.f;
                if (seg == 0) { if (k < 64) x = w2[k * 512 + j]; }
                else if (seg == 1) { if (k >= 128 && k < 192) x = a2[(k - 128) * 512 + j]; }
                else if (seg == 2) { if (k >= 256 && k < 384) x = g2[(k - 256) * 512 + j]; }
                else { if (l > 0 && k >= 384 && k < 416) x = v2[(k - 384) * 512 + j]; }
                v[i] = x; }
            u32x4 o; o.x = pk2(v[0], v[1]); o.y = pk2(v[2], v[3]); o.z = pk2(v[4], v[5]); o.w = pk2(v[6], v[7]);
            *(GAS u32x4*)(Lt + (size_t)n * 512 + kg * 8) = o; }
    }
    { const int gw = F.bid * NWAVES + F.wave, NGW = F.G * NWAVES; float* rss = (float*)(ws + WS_RSSA);
      for (int m = gw; m < S; m += NGW) { const GAS f32x4* xr = (const GAS f32x4*)(a.in[0] + (size_t)m * D) + F.lane; GAS u32x2* o8 = (GAS u32x2*)((bf16*)(ws + WS_XN) + (size_t)m * D) + F.lane; float sq = 0.f;
#pragma unroll
          for (int j = 0; j < 8; ++j) { const f32x4 v = xr[64 * j]; sq += (v.x * v.x + v.y * v.y) + (v.z * v.z + v.w * v.w); u32x2 o; o.x = pk2(v.x, v.y); o.y = pk2(v.z, v.w); o8[64 * j] = o; }
          sq = wave_sum(sq); if (F.lane < 32) rss[(size_t)m * 32 + F.lane] = (F.lane == 0) ? sq : 0.f; } }
    int base = 0;
    for (int l = 0; l < DEPTH; ++l) {
        conv_job(F, ConvJob{a.in[3] + (size_t)l * D * NIN, (bf16*)(ws + WS_WIN) + (size_t)l * NINP * D, a.in[2] + (size_t)l * D, D, NIN, NINP, 1}, base);
        conv_job(F, ConvJob{a.in[34] + (size_t)l * D * 2 * DFF, (bf16*)(ws + WS_WGU) + (size_t)l * 2 * DFF * D, a.in[33] + (size_t)l * D, D, 2 * DFF, 2 * DFF, 2}, base);
        conv_job(F, ConvJob{a.in[35] + (size_t)l * DFF * D, (bf16*)(ws + WS_WDN) + (size_t)l * D * DFF, nullptr, DFF, D, D, 0}, base);
        conv_job(F, ConvJob{a.in[32] + (size_t)l * D * D, (bf16*)(ws + WS_WOUT) + (size_t)l * D * D, nullptr, D, D, D, 0}, base);
        for (int n = 0; n < 4; ++n)
            conv_job(F, ConvJob{a.in[31] + ((size_t)l * 4 + n) * 512 * D, (bf16*)(ws + WS_WBR) + ((size_t)l * 4 + n) * D * 512, nullptr, 512, D, D, 0}, base);
        conv_job(F, ConvJob{a.in[12] + (size_t)l * 512 * 768, (bf16*)(ws + WS_WQB) + (size_t)l * 1024 * 512, a.in[11] + (size_t)l * 512, 512, 768, 1024, 3}, base);
        conv_job(F, ConvJob{a.in[14] + (size_t)l * 256 * 1024, (bf16*)(ws + WS_WKVB) + (size_t)l * 1024 * 256, a.in[13] + (size_t)l * 256, 256, 1024, 1024, 0}, base);
        if (l > 0) conv_job(F, ConvJob{a.in[24] + (size_t)(l - 1) * 512 * 32, (bf16*)(ws + WS_WV1) + (size_t)l * 256 * 512, nullptr, 512, 32, 256, 4}, base);
    }
}

DI void p_rmsnorm(Frame& F, const float* x, const float* w, bf16* out) {
    const int gw = F.bid * NWAVES + F.wave, NGW = F.G * NWAVES;
    for (int m = gw; m < S; m += NGW) {
        const GAS f32x4* xr = (const GAS f32x4*)(x + (size_t)m * D) + F.lane; f32x4 v[8]; float s = 0.f;
#pragma unroll
        for (int j = 0; j < 8; ++j) { v[j] = xr[64 * j]; s += (v[j].x * v[j].x + v[j].y * v[j].y) + (v[j].z * v[j].z + v[j].w * v[j].w); }
        const float rstd = rsqrtf(wave_sum(s) * (1.f / D) + 1e-6f);
        const GAS f32x4* wr = (const GAS f32x4*)w + F.lane;
        GAS u32x2* o8 = (GAS u32x2*)(out + (size_t)m * D) + F.lane;
#pragma unroll
        for (int j = 0; j < 8; ++j) { const f32x4 ww = wr[64 * j]; u32x2 o; o.x = pk2(v[j].x * rstd * ww.x, v[j].y * rstd * ww.y); o.y = pk2(v[j].z * rstd * ww.z, v[j].w * rstd * ww.w); o8[64 * j] = o; }
    }
}

DI f32x4 bf4_(const u32x2 w) { return (f32x4){bf2f(w.x & 0xffffu), bf2f(w.x >> 16), bf2f(w.y & 0xffffu), bf2f(w.y >> 16)}; }
DI u32x2 pk4_(const f32x4 v) { u32x2 o; o.x = pk2(v.x, v.y); o.y = pk2(v.z, v.w); return o; }
DI void p_rwkv_prep(Frame& F, int l) {
    unsigned char* ws = F.ws;
    const bf16* RW = (const bf16*)(ws + WS_RW); const float* prm = (const float*)(ws + WS_PRM) + (size_t)l * PRM_STRIDE; const float* mu = prm + P_MU; const float* kk_w = prm + P_KK;
    const int gw = F.bid * NWAVES + F.wave, NGW = F.G * NWAVES, lane = F.lane;
    for (int t = gw; t < S; t += NGW) {
        const GAS u32x2* p = (const GAS u32x2*)(RW + (size_t)t * 1792) + lane; const GAS u32x2* pp = (const GAS u32x2*)(RW + (size_t)(t > 0 ? t - 1 : 0) * 1792) + lane;
        const GAS f32x4* m4 = (const GAS f32x4*)mu + lane;
        f32x4 pm[7];
#pragma unroll
        for (int j = 0; j < 7; ++j) { const f32x4 c = bf4_(p[64 * j]); f32x4 pv = bf4_(pp[64 * j]); if (t == 0) pv = (f32x4){0.f, 0.f, 0.f, 0.f}; pm[j] = c + (pv - c) * m4[64 * j]; }
        const size_t ro = (size_t)t * 512;
        *((GAS u32x2*)((bf16*)(ws + WS_R32) + ro) + lane) = pk4_(pm[0]); *((GAS u32x2*)((bf16*)(ws + WS_R32) + ro) + 64 + lane) = pk4_(pm[1]);
#pragma unroll
        for (int j = 0; j < 2; ++j) { const f32x4 k = pm[2 + j]; const f32x4 kw = *((const GAS f32x4*)kk_w + 64 * j + lane); const f32x4 kk = k * kw;
            float ss = (kk.x * kk.x + kk.y * kk.y) + (kk.z * kk.z + kk.w * kk.w);
            ss = row_sum16(ss);
            const float inv = fminf(__builtin_amdgcn_rsqf(ss), 1e12f);
            *((GAS u32x2*)((bf16*)(ws + WS_K32) + ro) + 64 * j + lane) = pk4_(k);
            *((GAS u32x2*)((bf16*)(ws + WS_KKN) + ro) + 64 * j + lane) = pk4_(kk * inv); }
#pragma unroll
        for (int j = 0; j < 2; ++j) { const u32x2 vb = pk4_(pm[4 + j]);
            *((GAS u32x2*)((bf16*)(ws + WS_VV) + ro) + 64 * j + lane) = vb;
            if (l == 0) *((GAS u32x2*)((bf16*)(ws + WS_VFIRST) + ro) + 64 * j + lane) = vb; }
        { const f32x4 x = pm[6]; f32x4 y; int dst;
            if (lane < 16) { y = (f32x4){ftanh_(x.x), ftanh_(x.y), ftanh_(x.z), ftanh_(x.w)}; dst = 4 * lane; }
            else if (lane < 32) { y = x; dst = 128 + 4 * (lane - 16); }
            else { y = (f32x4){sigmoidf_(x.x), sigmoidf_(x.y), sigmoidf_(x.z), sigmoidf_(x.w)}; dst = 256 + 4 * (lane - 32); }
            bf16* ar = (bf16*)(ws + WS_ALORA) + (size_t)t * 512;
            *(GAS u32x2*)(ar + dst) = pk4_(y);
            const int z = 4 * lane; const int zd = z < 64 ? 64 + z : (z < 128 ? 192 + (z - 64) : 384 + (z - 128));
            unsigned zz = 0u; asm volatile("" : "+v"(zz));
            *(GAS u32x2*)(ar + zd) = (u32x2){zz, zz}; }
    }
}

DI void p_mamba_prep(Frame& F, int l) {
    unsigned char* ws = F.ws;
    const bf16* XBC = (const bf16*)(ws + WS_XBC); bf16* XC = (bf16*)(ws + WS_XC);
    const float* prm = (const float*)(ws + WS_PRM) + (size_t)l * PRM_STRIDE; const float* cw = prm + P_CW; const float* cb = prm + P_CB;
    for (int u = F.bid; u < 2 * NCH; u += F.G) {
        const int ch = 2 * F.tid, t0 = (u >> 1) * 64 + (u & 1) * 32;
        float w0[4], w1[4];
#pragma unroll
        for (int k = 0; k < 4; ++k) { const f32x2 wv = *(const GAS f32x2*)(cw + k * 1024 + ch); w0[k] = wv.x; w1[k] = wv.y; }
        const f32x2 bv = *(const GAS f32x2*)(cb + ch);
        float h0[3], h1[3];
#pragma unroll
        for (int k = 0; k < 3; ++k) { const int t = t0 - 3 + k; unsigned x = 0u; if (t >= 0) x = *(const GAS unsigned*)(XBC + (size_t)t * 1024 + ch); h0[k] = bf2f(x & 0xffffu); h1[k] = bf2f(x >> 16); }
        unsigned xin[32];
#pragma unroll
        for (int i = 0; i < 32; ++i) xin[i] = *(const GAS unsigned*)(XBC + (size_t)(t0 + i) * 1024 + ch);
#pragma unroll
        for (int i = 0; i < 32; ++i) { const float x0 = bf2f(xin[i] & 0xffffu), x1 = bf2f(xin[i] >> 16);
            const float y0 = bv.x + w0[0] * h0[0] + w0[1] * h0[1] + w0[2] * h0[2] + w0[3] * x0, y1 = bv.y + w1[0] * h1[0] + w1[1] * h1[1] + w1[2] * h1[2] + w1[3] * x1;
            h0[0] = h0[1]; h0[1] = h0[2]; h0[2] = x0; h1[0] = h1[1]; h1[1] = h1[2]; h1[2] = x1;
            *(GAS unsigned*)(XC + (size_t)(t0 + i) * 1024 + ch) = pk2(siluf_(y0), siluf_(y1)); }
    }
}
DI void u_mamba_dt(Frame& F, int l, int c) {
    unsigned char* ws = F.ws; LAS float* A = (LAS float*)F.lds;
    const float* prm = (const float*)(ws + WS_PRM) + (size_t)l * PRM_STRIDE; const int t = F.tid >> 3, h = F.tid & 7; const size_t row = (size_t)(c * 64 + t);
    const float dt = softplusf_(((const float*)(ws + WS_MISC))[row * 256 + h] + prm[P_DTB + h]);
    A[F.tid] = dt * -fexp_(prm[P_ALOG + h]);
    ((float*)(ws + WS_DTS))[row * 8 + h] = dt;
    __syncthreads();
    float cs = 0.f;
#pragma unroll 16
    for (int tt = 0; tt < 64; ++tt) { const float v = A[tt * 8 + h]; cs += (tt <= t) ? v : 0.f; }
    ((float*)(ws + WS_ACS))[row * 8 + h] = cs;
    __syncthreads();
}

DI void p_scans(Frame& F, int nblk) {
    unsigned char* ws = F.ws;
    const int gt = F.bid * NTHR + F.tid, NGT = nblk * NTHR;
    for (int q = gt; q < 32768; q += NGT) {
        const int e = q * 4; const bool ret = e < 65536; const int e2 = ret ? e : e - 65536, h = ret ? (e >> 14) : (e2 >> 13);
        float* p = (float*)(ws + (ret ? WS_RKV : WS_MST)) + e2; const float* acs = (const float*)(ws + WS_ACS);
        const float rdec = fexp_(log1pf(-exp2f(-5.0f - (float)h)) * 64.0f);
        f32x4 st = (f32x4){0.f, 0.f, 0.f, 0.f};
#pragma unroll 1
        for (int c0 = 0; c0 < NCH; c0 += 16) { f32x4 v[16]; float dc[16];
#pragma unroll
            for (int i = 0; i < 16; ++i) v[i] = *(const GAS f32x4*)(p + (size_t)(c0 + i) * 65536);
#pragma unroll
            for (int i = 0; i < 16; ++i) dc[i] = ret ? rdec : fexp_(acs[(size_t)((c0 + i) * 64 + 63) * 8 + h]);
#pragma unroll
            for (int i = 0; i < 16; ++i) { *(GAS f32x4*)(p + (size_t)(c0 + i) * 65536) = st; st = st * dc[i] + v[i]; } }
    }
}


namespace pg8 {
DI unsigned char* lw(unsigned char* p) { unsigned long long w = (unsigned long long)p; asm volatile("" : "+s"(w)); return (unsigned char*)w; }
DI void st8bf(bf16* p, const f32x4 a, const f32x4 b) { *(GAS u32x4*)p = pack8(a, b); }
DI void st8f(float* p, const f32x4 a, const f32x4 b) { *(GAS f32x4*)p = a; *((GAS f32x4*)p + 1) = b; }
DI f32x4 map4(const f32x4 v, float (*f)(float)) { return (f32x4){f(v.x), f(v.y), f(v.z), f(v.w)}; }

DI void scale_rows(Acc& acc, const LAS float* rt, int rl0) {
#pragma unroll
    for (int ai = 0; ai < 2; ++ai)
#pragma unroll
        for (int m = 0; m < 4; ++m) { const float rs = rt[rl0 + ai * HALF + m * 16];
#pragma unroll
            for (int bj = 0; bj < 2; ++bj)
#pragma unroll
                for (int n = 0; n < 2; ++n) acc[ai][bj][m][n] = acc[ai][bj][m][n] * rs; }
}
template <class Sched> DI void fill_rstd(LAS float* rtab, const float* rss, const Sched& Sc, int tid) {
    pg8::Unit u;
    for (int i = 0; Sc.next(i, u); ++i) if (tid < 256) { const float* p = rss + (size_t)(u.pm * BM + tid) * 32; float s = 0.f;
#pragma unroll
        for (int q = 0; q < 8; ++q) { const f32x4 v = *(const GAS f32x4*)(p + 4 * q); s += (v.x + v.y) + (v.z + v.w); }
        rtab[i * 256 + tid] = rsqrtf(s * (1.f / D) + 1e-6f); }
    __syncthreads();
}
struct TileDesc { unsigned long long off; int ld, cb, kind, slot; };
constexpr TileDesc mk_tile(int T) {
    return T < 2 ? TileDesc{WS_QR, 512, 0, 0, 0} : T < 4 ? TileDesc{WS_KR, 512, 0, 1, 0}
         : T < 6 ? TileDesc{WS_VR, 512, (T - 4) * 256, 2, 0} : T < 8 ? TileDesc{WS_GR, 512, (T - 6) * 256, 3, 0} : T < 10 ? TileDesc{WS_ZS, 512, (T - 8) * 256, 3, 0}
         : T < 14 ? TileDesc{WS_XBC, 1024, (T - 10) * 256, 2, 0} : T < 16 ? TileDesc{WS_CQ, 512, (T - 14) * 256, 5, (T - 14) * 4} : T == 16 ? TileDesc{WS_CKV, 256, 0, 5, 8}
         : T < 24 ? TileDesc{WS_RW, 1792, (T - 17) * 256, 2, 0} : T < 56 ? TileDesc{WS_GATE, 8192, (T - 24) * 64, 7, 0} : TileDesc{WS_MISC, 256, 0, 6, 0};
}
struct TileTab { TileDesc d[57]; };
constexpr TileTab mk_tiletab() { TileTab t{}; for (int i = 0; i < 57; ++i) t.d[i] = mk_tile(i); return t; }
__constant__ TileTab g_tiletab = mk_tiletab();

struct EpiIn {
    static constexpr bool AFTER_DRAIN = false;
    unsigned char* ws_; int tile_off; const LAS float* rtab;
    DI bool operator()(Acc& acc, const Unit& u, int wr, int wc, int fr, int fq) const {
        unsigned char* ws = lw(ws_);
        const int T = u.pn + tile_off, row0 = u.pm * BM + wr * 64 + fr, c0 = wc * 32 + fq * 8;
        scale_rows(acc, rtab + u.ord * 256, wr * 64 + fr);
        const TileDesc d = g_tiletab.d[T]; const int kind = d.kind;
        if (kind < 2) {
            const int head = 2 * (T & 1) + (c0 >> 6), j0 = c0 & 63; const float sc = kind ? 0.08838834764831845f : 1.0f;
            bf16* dst = (bf16*)(ws + d.off); const float* cs = (const float*)(ws + WS_COSR); const float* sn = (const float*)(ws + WS_SINR);
#pragma unroll
            for (int ai = 0; ai < 2; ++ai)
#pragma unroll
                for (int m = 0; m < 4; ++m) { const int row = row0 + ai * HALF + m * 16;
                    const f32x4 ca = *(const GAS f32x4*)(cs + (size_t)row * 64 + j0), cb = *(const GAS f32x4*)(cs + (size_t)row * 64 + j0 + 4);
                    const f32x4 sa = *(const GAS f32x4*)(sn + (size_t)row * 64 + j0), sb = *(const GAS f32x4*)(sn + (size_t)row * 64 + j0 + 4);
                    const f32x4 x1a = acc[ai][0][m][0], x1b = acc[ai][0][m][1], x2a = acc[ai][1][m][0], x2b = acc[ai][1][m][1];
                    bf16* o = dst + (size_t)row * 512 + head * 128 + j0;
                    st8bf(o, (x1a * ca - x2a * sa) * sc, (x1b * cb - x2b * sb) * sc);
                    st8bf(o + 64, (x2a * ca + x1a * sa) * sc, (x2b * cb + x1b * sb) * sc); }
            return true;
        }
        if (kind == 7) {
            bf16* dst = (bf16*)(ws + d.off) + d.cb + wc * 16 + fq * 4;
#pragma unroll
            for (int ai = 0; ai < 2; ++ai)
#pragma unroll
                for (int m = 0; m < 4; ++m) { const size_t ro = (size_t)(row0 + ai * HALF + m * 16) * 8192; f32x4 sv[4], gv[4];
#pragma unroll
                    for (int nb = 0; nb < 4; ++nb) { const f32x4 x = acc[ai][nb >> 1][m][nb & 1];
#pragma unroll
                        for (int i = 0; i < 4; ++i) { const float sk = 1.0f + fminf(fexp_(-x[i]), 1e30f); sv[nb][i] = sk; gv[nb][i] = __builtin_amdgcn_rcpf(sk); } }
                    *(GAS u32x2*)(dst + ro) = pk4_(gv[0] * sv[1]); *(GAS u32x2*)(dst + ro + 2048) = pk4_(gv[1] * sv[2]);
                    *(GAS u32x2*)(dst + ro + 4096) = pk4_(gv[2] * sv[3]); *(GAS u32x2*)(dst + ro + 6144) = pk4_(gv[3]); }
            return true;
        }
        if (kind == 6) {
            float* dst = (float*)(ws + d.off) + d.cb + c0;
#pragma unroll
            for (int ai = 0; ai < 2; ++ai)
#pragma unroll
                for (int m = 0; m < 4; ++m) { const int row = row0 + ai * HALF + m * 16;
#pragma unroll
                    for (int bj = 0; bj < 2; ++bj) st8f(dst + (size_t)row * d.ld + bj * HALF, acc[ai][bj][m][0], acc[ai][bj][m][1]); }
            return true;
        }
        {
            bf16* dst = (bf16*)(ws + d.off) + d.cb + c0; float* ssq = (float*)(ws + WS_SSQ) + d.slot + wc;
            const float am = (kind == 3 || kind == 4) ? 1.f : 0.f, xm = (kind == 4) ? 0.f : 1.f;
#pragma unroll
            for (int ai = 0; ai < 2; ++ai)
#pragma unroll
                for (int m = 0; m < 4; ++m) { const int row = row0 + ai * HALF + m * 16; float ss = 0.f;
#pragma unroll
                    for (int bj = 0; bj < 2; ++bj) { f32x4 a = acc[ai][bj][m][0], b = acc[ai][bj][m][1];
                        ss += (a.x * a.x + a.y * a.y) + (a.z * a.z + a.w * a.w) + (b.x * b.x + b.y * b.y) + (b.z * b.z + b.w * b.w);
                        if (am != 0.f) {
#pragma unroll
                            for (int i = 0; i < 4; ++i) { const float s0 = sigmoidf_(a[i]), s1 = sigmoidf_(b[i]); a[i] = (xm != 0.f) ? a[i] * s0 : s0; b[i] = (xm != 0.f) ? b[i] * s1 : s1; } }
                        st8bf(dst + (size_t)row * d.ld + bj * HALF, a, b); }
                    if (kind == 5) { ss = xr32_sum(xr16_sum(ss)); if (fq == 0) ssq[(size_t)row * 16] = ss; } }
        }
        return true;
    }
};

struct EpiMisc {
    static constexpr bool AFTER_DRAIN = false;
    unsigned char* ws_; const LAS float* rtab;
    DI bool operator()(Acc& acc, const Unit& u, int wr, int wc, int fr, int fq) const {
        float* dst = (float*)(lw(ws_) + WS_MISC) + wc * 32 + fq * 8; const int row0 = u.pm * BM + wr * 64 + fr;
        scale_rows(acc, rtab + u.ord * 256, wr * 64 + fr);
#pragma unroll
        for (int ai = 0; ai < 2; ++ai)
#pragma unroll
            for (int m = 0; m < 4; ++m) { const int row = row0 + ai * HALF + m * 16;
#pragma unroll
                for (int bj = 0; bj < 2; ++bj) st8f(dst + (size_t)row * 256 + bj * HALF, acc[ai][bj][m][0], acc[ai][bj][m][1]); }
        return true;
    }
};

struct EpiQb {
    static constexpr bool AFTER_DRAIN = true;
    unsigned char* ws; const float* qnw;
    DI bool operator()(Acc&, const Unit&, int, int, int, int) const { return true; }
    DI void fused(Acc& acc, const Unit& u, int wr, int wc, int fr, int fq, LAS unsigned char* lds, int wid, int lane, int tid) const {
        const int h = u.pn, row0 = u.pm * BM + wr * 64 + fr, c0 = wc * 32 + fq * 8;
        const float* ssq = (const float*)(ws + WS_SSQ); LAS float* P = (LAS float*)lds;
        const float QS = 0.07216878364870322f * LOG2E;
#pragma unroll
        for (int ai = 0; ai < 2; ++ai)
#pragma unroll
            for (int m = 0; m < 4; ++m) { const int row = row0 + ai * HALF + m * 16, rl = ai * HALF + wr * 64 + m * 16 + fr;
                const f32x4 s0 = *(const GAS f32x4*)(ssq + (size_t)row * 16), s1 = *(const GAS f32x4*)(ssq + (size_t)row * 16 + 4);
                const float rs = rsqrtf(((s0.x + s0.y) + (s0.z + s0.w) + (s1.x + s1.y) + (s1.z + s1.w)) * (1.f / 512.f) + 1e-6f);
                float ss = 0.f;
#pragma unroll
                for (int bj = 0; bj < 2; ++bj)
#pragma unroll
                    for (int n = 0; n < 2; ++n) { f32x4 a = acc[ai][bj][m][n] * rs; acc[ai][bj][m][n] = a; ss += (a.x * a.x + a.y * a.y) + (a.z * a.z + a.w * a.w); }
                ss = xr32_sum(xr16_sum(ss));
                if (fq == 0) P[rl * 4 + wc] = ss; }
        __syncthreads();
        bf16* QM = (bf16*)(ws + WS_QM); const float* cs = (const float*)(ws + WS_COSM); const float* sn = (const float*)(ws + WS_SINM);
#pragma unroll
        for (int ai = 0; ai < 2; ++ai)
#pragma unroll
            for (int m = 0; m < 4; ++m) { const int row = row0 + ai * HALF + m * 16, rl = ai * HALF + wr * 64 + m * 16 + fr;
                const f32x4 pp = *(const LAS f32x4*)(P + rl * 4); const float rq = rsqrtf(((pp.x + pp.y) + (pp.z + pp.w)) * (1.f / 192.f) + 1e-6f) * QS;
                bf16* o = QM + (size_t)row * 768 + h * 192;
                if (wc < 3) {
                    const f32x4 wa = *(const GAS f32x4*)(qnw + c0), wb = *(const GAS f32x4*)(qnw + c0 + 4);
                    st8bf(o + c0, acc[ai][0][m][0] * rq * wa, acc[ai][0][m][1] * rq * wb);
                    if (wc == 0) { const f32x4 wc4 = *(const GAS f32x4*)(qnw + 96 + c0), wd = *(const GAS f32x4*)(qnw + 100 + c0);
                        st8bf(o + 96 + c0, acc[ai][1][m][0] * rq * wc4, acc[ai][1][m][1] * rq * wd); }
                } else {
                    const int i0 = 8 * fq;
                    const f32x4 w1a = *(const GAS f32x4*)(qnw + 128 + i0), w1b = *(const GAS f32x4*)(qnw + 132 + i0), w2a = *(const GAS f32x4*)(qnw + 160 + i0), w2b = *(const GAS f32x4*)(qnw + 164 + i0);
                    const f32x4 ca = *(const GAS f32x4*)(cs + (size_t)row * 32 + i0), cb = *(const GAS f32x4*)(cs + (size_t)row * 32 + i0 + 4), sa = *(const GAS f32x4*)(sn + (size_t)row * 32 + i0), sb = *(const GAS f32x4*)(sn + (size_t)row * 32 + i0 + 4);
                    const f32x4 x1a = acc[ai][0][m][0] * rq * w1a, x1b = acc[ai][0][m][1] * rq * w1b, x2a = acc[ai][1][m][0] * rq * w2a, x2b = acc[ai][1][m][1] * rq * w2b;
                    st8bf(o + 128 + i0, x1a * ca - x2a * sa, x1b * cb - x2b * sb);
                    st8bf(o + 160 + i0, x2a * ca + x1a * sa, x2b * cb + x1b * sb);
                } }
        __syncthreads();
    }
};

struct EpiKvb {
    static constexpr bool AFTER_DRAIN = true;
    unsigned char* ws; const float* knw;
    DI bool operator()(Acc&, const Unit&, int, int, int, int) const { return true; }
    DI void fused(Acc& acc, const Unit& u, int wr, int wc, int fr, int fq, LAS unsigned char* lds, int wid, int lane, int tid) const {
        const int h = u.pn, row0 = u.pm * BM + wr * 64 + fr, c0 = wc * 32 + fq * 8;
        const float* ssq = (const float*)(ws + WS_SSQ); const float* misc = (const float*)(ws + WS_MISC);
        LAS float* P = (LAS float*)lds; LAS float* KRS = P + 1024; LAS float* RK = P + 1280;
        LAS bf16* VTs = (LAS bf16*)(lds + 8192);
        if (tid < 256) { const float* kr = misc + (size_t)(u.pm * BM + tid) * 256 + 8; float s = 0.f;
#pragma unroll
            for (int i = 0; i < 16; ++i) { const f32x4 v = *(const GAS f32x4*)(kr + 4 * i); s += (v.x * v.x + v.y * v.y) + (v.z * v.z + v.w * v.w); }
            KRS[tid] = s; }
#pragma unroll
        for (int ai = 0; ai < 2; ++ai)
#pragma unroll
            for (int m = 0; m < 4; ++m) { const int row = row0 + ai * HALF + m * 16, rl = ai * HALF + wr * 64 + m * 16 + fr;
                const f32x4 s0 = *(const GAS f32x4*)(ssq + (size_t)row * 16 + 8);
                const float rs = rsqrtf(((s0.x + s0.y) + (s0.z + s0.w)) * (1.f / 256.f) + 1e-6f);
                float ss = 0.f;
#pragma unroll
                for (int bj = 0; bj < 2; ++bj)
#pragma unroll
                    for (int n = 0; n < 2; ++n) { f32x4 a = acc[ai][bj][m][n] * rs; acc[ai][bj][m][n] = a; if (bj == 0) ss += (a.x * a.x + a.y * a.y) + (a.z * a.z + a.w * a.w); }
                ss = xr32_sum(xr16_sum(ss));
                if (fq == 0) P[rl * 4 + wc] = ss; }
        __syncthreads();
        if (tid < 256) { const f32x4 pp = *(const LAS f32x4*)(P + tid * 4); RK[tid] = rsqrtf(((pp.x + pp.y) + (pp.z + pp.w) + KRS[tid]) * (1.f / 192.f) + 1e-6f); }
        __syncthreads();
        bf16* KM = (bf16*)(ws + WS_KM); bf16* VT = (bf16*)(ws + WS_VT);
        const f32x4 wa = *(const GAS f32x4*)(knw + c0), wb = *(const GAS f32x4*)(knw + c0 + 4);
#pragma unroll
        for (int ai = 0; ai < 2; ++ai)
#pragma unroll
            for (int m = 0; m < 4; ++m) { const int row = row0 + ai * HALF + m * 16, rl = ai * HALF + wr * 64 + m * 16 + fr;
                const float rk = RK[rl];
                st8bf(KM + (size_t)row * 768 + h * 192 + c0, acc[ai][0][m][0] * rk * wa, acc[ai][0][m][1] * rk * wb);
#pragma unroll
                for (int n = 0; n < 2; ++n)
#pragma unroll
                    for (int i = 0; i < 4; ++i) VTs[(c0 + n * 4 + i) * 264 + rl] = (bf16)f2bf(acc[ai][1][m][n][i]); }
        {
            const int rl = tid >> 1, hf = tid & 1, row = u.pm * BM + rl, i0 = 16 * hf; const float rk = RK[rl];
            const float* kr = misc + (size_t)row * 256 + 8; const float* cs = (const float*)(ws + WS_COSM) + (size_t)row * 32; const float* sn = (const float*)(ws + WS_SINM) + (size_t)row * 32;
            bf16* o = KM + (size_t)row * 768 + h * 192 + 128;
#pragma unroll
            for (int q = 0; q < 2; ++q) { f32x4 o1[2], o2[2];
#pragma unroll
                for (int e = 0; e < 2; ++e) { const int i = i0 + 8 * q + 4 * e;
                    const f32x4 x1 = *(const GAS f32x4*)(kr + i) * *(const GAS f32x4*)(knw + 128 + i), x2 = *(const GAS f32x4*)(kr + 32 + i) * *(const GAS f32x4*)(knw + 160 + i);
                    const f32x4 c = *(const GAS f32x4*)(cs + i), s = *(const GAS f32x4*)(sn + i);
                    o1[e] = (x1 * c - x2 * s) * rk; o2[e] = (x2 * c + x1 * s) * rk; }
                st8bf(o + i0 + 8 * q, o1[0], o1[1]); st8bf(o + 32 + i0 + 8 * q, o2[0], o2[1]); }
        }
        __syncthreads();
#pragma unroll
        for (int k = 0; k < 8; ++k) { const int p = tid + 512 * k, dv = p >> 5, c8 = (p & 31) * 8; *(GAS u32x4*)(VT + (size_t)(h * 128 + dv) * S + u.pm * BM + c8) = *(const LAS u32x4*)(VTs + dv * 264 + c8); }
        __syncthreads();
    }
};

struct EpiV1 {
    static constexpr bool AFTER_DRAIN = false;
    unsigned char* ws_;
    DI bool operator()(Acc& acc, const Unit& u, int wr, int wc, int fr, int fq) const {
        if (wc != 0) return true;
        unsigned char* ws = lw(ws_);
        const int row0 = u.pm * BM + wr * 64 + fr; bf16* dst = (bf16*)(ws + WS_ALORA);
#pragma unroll
        for (int ai = 0; ai < 2; ++ai)
#pragma unroll
            for (int m = 0; m < 4; ++m) { const int row = row0 + ai * HALF + m * 16; st8bf(dst + (size_t)row * 512 + 384 + fq * 8, acc[ai][0][m][0], acc[ai][0][m][1]); }
        return true;
    }
};

struct EpiLora {
    static constexpr bool AFTER_DRAIN = false;
    unsigned char* ws_; const float* w0; const float* a0; const float* v0; const float* ka;
#define LORA_LOOP(BODY) _Pragma("unroll") for (int ai = 0; ai < 2; ++ai) _Pragma("unroll") for (int m = 0; m < 4; ++m) { const size_t ro = (size_t)(row0 + ai * HALF + m * 16) * 512; \
        _Pragma("unroll") for (int bj = 0; bj < 2; ++bj) _Pragma("unroll") for (int n = 0; n < 2; ++n) { const int j = jb + bj * HALF + n * 4; const size_t o = ro + j; const f32x4 x = acc[ai][bj][m][n]; BODY } }
    DI bool operator()(Acc& acc, const Unit& u, int wr, int wc, int fr, int fq) const {
        unsigned char* ws = lw(ws_);
        const int seg = u.pn >> 1, row0 = u.pm * BM + wr * 64 + fr, jb = (u.pn & 1) * 256 + wc * 32 + fq * 8;
        if (seg == 0) { float* dec = (float*)(ws + WS_DEC);
            LORA_LOOP({ const f32x4 b = *(const GAS f32x4*)(w0 + j); f32x4 r;
                _Pragma("unroll") for (int i = 0; i < 4; ++i) { const float u_ = b[i] + x[i]; const float sp = fmaxf(-u_, 0.f) + __logf(1.0f + fexp_(-fabsf(u_))); r[i] = -fexp_(-sp - 0.5f); }
                *(GAS f32x4*)(dec + o) = r; })
        } else if (seg == 1) { const bf16* k32 = (const bf16*)(ws + WS_K32); const bf16* kkn_ = (const bf16*)(ws + WS_KKN); bf16* kp_ = (bf16*)(ws + WS_KP); bf16* bb_ = (bf16*)(ws + WS_BB);
            LORA_LOOP({ const f32x4 b = *(const GAS f32x4*)(a0 + j); const f32x4 kav = *(const GAS f32x4*)(ka + j);
                const u32x2 kw = *(const GAS u32x2*)(k32 + o); const u32x2 nw = *(const GAS u32x2*)(kkn_ + o);
                const f32x4 k = bf4_(kw); const f32x4 kkn = bf4_(nw); f32x4 kp; f32x4 bb;
                _Pragma("unroll") for (int i = 0; i < 4; ++i) { const float av = sigmoidf_(b[i] + x[i]); kp[i] = k[i] * (1.0f + (av - 1.0f) * kav[i]); bb[i] = kkn[i] * av; }
                *(GAS u32x2*)(kp_ + o) = pk4_(kp); *(GAS u32x2*)(bb_ + o) = pk4_(bb); })
        } else if (seg == 2) { bf16* g32 = (bf16*)(ws + WS_G32);
            LORA_LOOP({ *(GAS u32x2*)(g32 + o) = pk4_(x); })
        } else { bf16* vv = (bf16*)(ws + WS_VV); const bf16* vf_ = (const bf16*)(ws + WS_VFIRST);
            LORA_LOOP({ const f32x4 b = *(const GAS f32x4*)(v0 + j); const u32x2 vw = *(const GAS u32x2*)(vv + o); const u32x2 fw = *(const GAS u32x2*)(vf_ + o);
                const f32x4 v = bf4_(vw); const f32x4 vf = bf4_(fw); f32x4 r;
                _Pragma("unroll") for (int i = 0; i < 4; ++i) r[i] = v[i] + (vf[i] - v[i]) * sigmoidf_(b[i] + x[i]);
                *(GAS u32x2*)(vv + o) = pk4_(r); })
        }
        return true;
    }
#undef LORA_LOOP
};

struct EpiBranch {
    static constexpr bool AFTER_DRAIN = false;
    unsigned char* ws_;
    DI bool operator()(Acc& acc, const Unit& u, int wr, int wc, int fr, int fq) const {
        unsigned char* ws = lw(ws_);
        const int nb = u.sub, row0 = u.pm * BM + wr * 64 + fr, cb = u.pn * BM + wc * 32 + fq * 8;
        const bf16* G = (const bf16*)(ws + WS_GATE) + nb * D; bf16* M = (bf16*)(ws + WS_MERGED);
#pragma unroll
        for (int ai = 0; ai < 2; ++ai)
#pragma unroll
            for (int m = 0; m < 4; ++m) { const int row = row0 + ai * HALF + m * 16;
#pragma unroll
                for (int bj = 0; bj < 2; ++bj) { const int col = cb + bj * HALF;
                    float g[8]; unpack8(*(const GAS u32x4*)(G + (size_t)row * 8192 + col), g);
                    const f32x4 a = acc[ai][bj][m][0] * (f32x4){g[0], g[1], g[2], g[3]}, b = acc[ai][bj][m][1] * (f32x4){g[4], g[5], g[6], g[7]};
                    if (nb < 3) { acc[ai][bj][m][0] = a; acc[ai][bj][m][1] = b; } else st8bf(M + (size_t)row * D + col, a, b); } }
        return nb == 3;
    }
};

struct EpiRes {
    static constexpr bool AFTER_DRAIN = false;
    const float* xin; float* out; bf16* xb; float* rss;
    DI bool operator()(Acc& acc, const Unit& u, int wr, int wc, int fr, int fq) const {
        const int row0 = u.pm * BM + wr * 64 + fr, cb = u.pn * BM + wc * 32 + fq * 8;
#pragma unroll
        for (int ai = 0; ai < 2; ++ai)
#pragma unroll
            for (int m = 0; m < 4; ++m) { const int row = row0 + ai * HALF + m * 16; float ss = 0.f;
#pragma unroll
                for (int bj = 0; bj < 2; ++bj) { const size_t o = (size_t)row * D + cb + bj * HALF;
                    const f32x4 a = *(const GAS f32x4*)(xin + o) + acc[ai][bj][m][0], b = *(const GAS f32x4*)(xin + o + 4) + acc[ai][bj][m][1];
                    st8f(out + o, a, b); st8bf(xb + o, a, b);
                    ss += (a.x * a.x + a.y * a.y) + (a.z * a.z + a.w * a.w) + (b.x * b.x + b.y * b.y) + (b.z * b.z + b.w * b.w); }
                if (rss) { ss = xr32_sum(xr16_sum(ss)); if (fq == 0) rss[(size_t)row * 32 + u.pn * 4 + wc] = ss; } }
        return true;
    }
};

struct EpiGu {
    static constexpr bool AFTER_DRAIN = false;
    unsigned char* ws_; const LAS float* rtab;
    DI bool operator()(Acc& acc, const Unit& u, int wr, int wc, int fr, int fq) const {
        unsigned char* ws = lw(ws_);
        scale_rows(acc, rtab + u.ord * 256, wr * 64 + fr);
        const int row0 = u.pm * BM + wr * 64 + fr, cb = u.pn * 128 + wc * 32 + fq * 8; bf16* A = (bf16*)(ws + WS_ACT);
#pragma unroll
        for (int ai = 0; ai < 2; ++ai)
#pragma unroll
            for (int m = 0; m < 4; ++m) { const int row = row0 + ai * HALF + m * 16;
                st8bf(A + (size_t)row * DFF + cb, map4(acc[ai][0][m][0], siluf_) * acc[ai][1][m][0], map4(acc[ai][0][m][1], siluf_) * acc[ai][1][m][1]); }
        return true;
    }
};
}

DI bf16x8 ldfrag(const LAS bf16* M, int ld, int r0, int k0, int lane) { return *(const LAS bf16x8*)(M + (r0 + (lane & 15)) * ld + k0 + 8 * (lane >> 4)); }
#define MFMA16(a, b, c) __builtin_amdgcn_mfma_f32_16x16x32_bf16((a), (b), (c), 0, 0, 0)
DI void stage_nat(LAS bf16* dst, int lp, const bf16* src, size_t gp, int rows, int cols8, int tid) {
    for (int p = tid; p < rows * cols8; p += NTHR) { const int r = p / cols8, c = p - r * cols8; *(LAS u32x4*)(dst + r * lp + c * 8) = *(const GAS u32x4*)(src + (size_t)r * gp + c * 8); }
}
DI void stage_tr(LAS bf16* dst, int lp, const bf16* src, size_t gp, int rows, int cols8, int tid) {
    for (int p = tid; p < rows * cols8; p += NTHR) { const int r = p / cols8, c = p - r * cols8; const u32x4 w = *(const GAS u32x4*)(src + (size_t)r * gp + c * 8);
        LAS bf16* d = dst + (c * 8) * lp + r;
        d[0] = (bf16)(w.x & 0xffffu); d[lp] = (bf16)(w.x >> 16); d[2 * lp] = (bf16)(w.y & 0xffffu); d[3 * lp] = (bf16)(w.y >> 16);
        d[4 * lp] = (bf16)(w.z & 0xffffu); d[5 * lp] = (bf16)(w.z >> 16); d[6 * lp] = (bf16)(w.w & 0xffffu); d[7 * lp] = (bf16)(w.w >> 16); }
}
DI float ret_loggamma(int h) { return log1pf(-exp2f(-5.0f - (float)h)); }

DI void u_ret_kv(Frame& F, int c, int h) {
    int tid_ = F.tid; asm volatile("" : "+v"(tid_));
    unsigned char* ws = F.ws; const int tid = tid_, lane = tid_ & 63, w = F.wave;
    LAS bf16* Kt = (LAS bf16*)F.lds; LAS bf16* Vt = Kt + 128 * 72;
    const bf16* KR = (const bf16*)(ws + WS_KR) + (size_t)(c * 64) * 512 + h * 128; const bf16* VR = (const bf16*)(ws + WS_VR) + (size_t)(c * 64) * 512 + h * 128;
    const float lg = ret_loggamma(h);
    for (int p = tid; p < 1024; p += NTHR) { const int m = p >> 4, d0 = (p & 15) * 8; float k[8]; unpack8(*(const GAS u32x4*)(KR + (size_t)m * 512 + d0), k); const float sc = fexp_(lg * (float)(63 - m));
        LAS bf16* d = Kt + d0 * 72 + m;
#pragma unroll
        for (int i = 0; i < 8; ++i) d[i * 72] = (bf16)f2bf(k[i] * sc); }
    stage_tr(Vt, 72, VR, 512, 64, 16, tid);
    __syncthreads();
    f32x4 acc[8];
#pragma unroll
    for (int bn = 0; bn < 8; ++bn) acc[bn] = (f32x4){0.f, 0.f, 0.f, 0.f};
#pragma unroll
    for (int ks = 0; ks < 2; ++ks) { const bf16x8 a = ldfrag(Kt, 72, 16 * w, 32 * ks, lane);
#pragma unroll
        for (int bn = 0; bn < 8; ++bn) acc[bn] = MFMA16(a, ldfrag(Vt, 72, 16 * bn, 32 * ks, lane), acc[bn]); }
    float* out = (float*)(ws + WS_RKV) + ((size_t)(c * 4 + h) * 128) * 128;
    __syncthreads();
    { LAS float* T = (LAS float*)F.lds;
#pragma unroll
      for (int bn = 0; bn < 8; ++bn)
#pragma unroll
          for (int r = 0; r < 4; ++r) T[(16 * w + 4 * (lane >> 4) + r) * 132 + 16 * bn + (lane & 15)] = acc[bn][r];
      __syncthreads();
#pragma unroll
      for (int k = 0; k < 8; ++k) { const int p = tid + 512 * k, row = p >> 5, c4 = (p & 31) * 4; *(GAS f32x4*)(out + (size_t)row * 128 + c4) = *(const LAS f32x4*)(T + row * 132 + c4); } }
    __syncthreads();
}

DI void u_ret_out(Frame& F, int l_, int c, int h) {
    int tid_ = F.tid; asm volatile("" : "+v"(tid_));
    unsigned char* ws = F.ws; const int tid = tid_, lane = tid_ & 63, w = F.wave;
    LAS bf16* Qs = (LAS bf16*)F.lds; LAS bf16* Ks = Qs + 64 * 136; LAS bf16* Vt = Ks + 64 * 136; LAS bf16* St = Vt + 128 * 72; LAS bf16* Ps = St + 128 * 136; LAS float* Os = (LAS float*)(Ps + 64 * 72);
    const size_t rowb = (size_t)(c * 64) * 512 + h * 128;
    stage_nat(Qs, 136, (const bf16*)(ws + WS_QR) + rowb, 512, 64, 16, tid);
    stage_nat(Ks, 136, (const bf16*)(ws + WS_KR) + rowb, 512, 64, 16, tid);
    stage_tr(Vt, 72, (const bf16*)(ws + WS_VR) + rowb, 512, 64, 16, tid);
    { const float* sp = (const float*)(ws + WS_RKV) + ((size_t)(c * 4 + h) * 128) * 128;
      for (int p = tid; p < 4096; p += NTHR) { const int d = p >> 5, e0 = (p & 31) * 4; const f32x4 v = *(const GAS f32x4*)(sp + (size_t)d * 128 + e0);
          LAS bf16* q = St + e0 * 136 + d; q[0] = (bf16)f2bf(v.x); q[136] = (bf16)f2bf(v.y); q[272] = (bf16)f2bf(v.z); q[408] = (bf16)f2bf(v.w); } }
    __syncthreads();
    const float lg = ret_loggamma(h); const int g4 = lane >> 4, lc = lane & 15;
    {
        const int bm = w >> 1;
#pragma unroll
        for (int q = 0; q < 2; ++q) { const int bn = (w & 1) * 2 + q; f32x4 acc = (f32x4){0.f, 0.f, 0.f, 0.f};
#pragma unroll
            for (int ks = 0; ks < 4; ++ks) acc = MFMA16(ldfrag(Qs, 136, 16 * bm, 32 * ks, lane), ldfrag(Ks, 136, 16 * bn, 32 * ks, lane), acc);
#pragma unroll
            for (int r = 0; r < 4; ++r) { const int l = 16 * bm + 4 * g4 + r, m = 16 * bn + lc; const int dd = l > m ? l - m : m - l; Ps[l * 72 + m] = (bf16)f2bf(acc[r] * fexp_(lg * (float)dd)); } }
    }
    __syncthreads();
    {
        const int bm = w >> 1;
#pragma unroll
        for (int q = 0; q < 4; ++q) { const int bn = (w & 1) * 4 + q; f32x4 a1 = (f32x4){0.f, 0.f, 0.f, 0.f}, a2 = (f32x4){0.f, 0.f, 0.f, 0.f};
#pragma unroll
            for (int ks = 0; ks < 2; ++ks) a1 = MFMA16(ldfrag(Ps, 72, 16 * bm, 32 * ks, lane), ldfrag(Vt, 72, 16 * bn, 32 * ks, lane), a1);
#pragma unroll
            for (int ks = 0; ks < 4; ++ks) a2 = MFMA16(ldfrag(Qs, 136, 16 * bm, 32 * ks, lane), ldfrag(St, 136, 16 * bn, 32 * ks, lane), a2);
#pragma unroll
            for (int r = 0; r < 4; ++r) { const int l = 16 * bm + 4 * g4 + r; Os[l * 132 + 16 * bn + lc] = a1[r] + fexp_(lg * (float)(l + 1)) * a2[r]; } }
    }
    __syncthreads();
    {
        const float* gw = (const float*)(ws + WS_PRM) + (size_t)l_ * PRM_STRIDE + P_GN + h * 128; const int l = 8 * w + (lane >> 3), e0 = (lane & 7) * 16; const size_t row = (size_t)(c * 64 + l);
        float x[16], gg[16];
#pragma unroll
        for (int q = 0; q < 4; ++q) { const f32x4 v = *(const LAS f32x4*)(Os + l * 132 + e0 + 4 * q); x[4 * q] = v.x; x[4 * q + 1] = v.y; x[4 * q + 2] = v.z; x[4 * q + 3] = v.w; }
        unpack8(*(const GAS u32x4*)((const bf16*)(ws + WS_GR) + row * 512 + h * 128 + e0), *(float(*)[8])&gg[0]); unpack8(*(const GAS u32x4*)((const bf16*)(ws + WS_GR) + row * 512 + h * 128 + e0 + 8), *(float(*)[8])&gg[8]);
        float sm = 0.f;
#pragma unroll
        for (int i = 0; i < 16; ++i) sm += x[i];
        const float mean = row_sum8(sm) * (1.f / 128.f); float sq = 0.f;
#pragma unroll
        for (int i = 0; i < 16; ++i) { x[i] -= mean; sq += x[i] * x[i]; }
        const float rstd = rsqrtf(row_sum8(sq) * (1.f / 128.f) + 1e-5f);
        float ov[16];
#pragma unroll
        for (int q = 0; q < 4; ++q) { const f32x4 wv = *(const GAS f32x4*)(gw + e0 + 4 * q);
#pragma unroll
            for (int i = 0; i < 4; ++i) ov[4 * q + i] = x[4 * q + i] * rstd * wv[i] * gg[4 * q + i]; }
        bf16* ob = (bf16*)(ws + WS_OB) + row * D + h * 128 + e0;
        *(GAS u32x4*)ob = pack8((f32x4){ov[0], ov[1], ov[2], ov[3]}, (f32x4){ov[4], ov[5], ov[6], ov[7]}); *(GAS u32x4*)(ob + 8) = pack8((f32x4){ov[8], ov[9], ov[10], ov[11]}, (f32x4){ov[12], ov[13], ov[14], ov[15]});
    }
    __syncthreads();
}

DI void u_mamba_st(Frame& F, int c, int g) {
    int tid_ = F.tid; asm volatile("" : "+v"(tid_));
    unsigned char* ws = F.ws; const int tid = tid_, lane = tid_ & 63, w = F.wave;
    LAS bf16* Xt = (LAS bf16*)F.lds; LAS bf16* Bt = Xt + 256 * 72;
    const bf16* XC = (const bf16*)(ws + WS_XC) + (size_t)(c * 64) * 1024; const float* dts = (const float*)(ws + WS_DTS) + (size_t)(c * 64) * 8; const float* acs = (const float*)(ws + WS_ACS) + (size_t)(c * 64) * 8;
    for (int p = tid; p < 2048; p += NTHR) { const int l = p >> 5, c0 = (p & 31) * 8, h = g * 4 + (c0 >> 6); float x[8]; unpack8(*(const GAS u32x4*)(XC + (size_t)l * 1024 + g * 256 + c0), x);
        const float sc = dts[l * 8 + h] * fexp_(acs[63 * 8 + h] - acs[l * 8 + h]); LAS bf16* d = Xt + c0 * 72 + l;
#pragma unroll
        for (int i = 0; i < 8; ++i) d[i * 72] = (bf16)f2bf(x[i] * sc); }
    stage_tr(Bt, 72, XC + 512 + g * 128, 1024, 64, 16, tid);
    __syncthreads();
    f32x4 acc[2][8];
#pragma unroll
    for (int i = 0; i < 2; ++i)
#pragma unroll
        for (int bn = 0; bn < 8; ++bn) acc[i][bn] = (f32x4){0.f, 0.f, 0.f, 0.f};
#pragma unroll
    for (int ks = 0; ks < 2; ++ks) { const bf16x8 a0 = ldfrag(Xt, 72, 32 * w, 32 * ks, lane), a1 = ldfrag(Xt, 72, 32 * w + 16, 32 * ks, lane);
#pragma unroll
        for (int bn = 0; bn < 8; ++bn) { const bf16x8 b = ldfrag(Bt, 72, 16 * bn, 32 * ks, lane); acc[0][bn] = MFMA16(a0, b, acc[0][bn]); acc[1][bn] = MFMA16(a1, b, acc[1][bn]); } }
    float* out = (float*)(ws + WS_MST) + ((size_t)(c * 8 + g * 4) * 64) * 128;
    __syncthreads();
    { LAS float* T = (LAS float*)F.lds;
#pragma unroll
      for (int i = 0; i < 2; ++i)
#pragma unroll
          for (int bn = 0; bn < 8; ++bn)
#pragma unroll
              for (int r = 0; r < 4; ++r) T[(32 * w + 16 * i + 4 * (lane >> 4) + r) * 132 + 16 * bn + (lane & 15)] = acc[i][bn][r];
      __syncthreads();
#pragma unroll
      for (int k = 0; k < 16; ++k) { const int p = tid + 512 * k, row = p >> 5, c4 = (p & 31) * 4; *(GAS f32x4*)(out + (size_t)row * 128 + c4) = *(const LAS f32x4*)(T + row * 132 + c4); } }
    __syncthreads();
}

struct MambaLds { LAS bf16* Cs; LAS bf16* Bs; LAS float* CB; LAS bf16* Ph; LAS bf16* Xt; LAS bf16* Sh; LAS float* AC; LAS float* DT; LAS float* SSQ; };
DI void mamba_head(Frame& F, const MambaLds& L, const bf16* XC, const float* sp, int g, int hh, float dsk, const bf16* const (&zrow)[4], f32x4 (&y)[2]) {
    const int tid = F.tid, lane = F.lane, w = F.wave, g4 = lane >> 4, lc = lane & 15, bm = w >> 1;
    __syncthreads();
    { const int l = tid >> 3, m0 = (tid & 7) * 8; const float al = L.AC[l * 4 + hh]; float pv[8];
#pragma unroll
      for (int i = 0; i < 8; ++i) { const int m = m0 + i; pv[i] = (m <= l) ? L.CB[l * 68 + m] * fexp_(al - L.AC[m * 4 + hh]) * L.DT[m * 4 + hh] : 0.f; }
      u32x4 o; o.x = pk2(pv[0], pv[1]); o.y = pk2(pv[2], pv[3]); o.z = pk2(pv[4], pv[5]); o.w = pk2(pv[6], pv[7]); *(LAS u32x4*)(L.Ph + l * 72 + m0) = o; }
    stage_tr(L.Xt, 72, XC + g * 256 + hh * 64, 1024, 64, 8, tid);
    for (int p = tid; p < 1024; p += NTHR) { const int pr = p >> 4, n0 = (p & 15) * 8; const f32x4 v0 = *(const GAS f32x4*)(sp + (size_t)pr * 128 + n0), v1 = *(const GAS f32x4*)(sp + (size_t)pr * 128 + n0 + 4);
        *(LAS u32x4*)(L.Sh + pr * 136 + n0) = pack8(v0, v1); }
    __syncthreads();
#pragma unroll
    for (int q = 0; q < 2; ++q) { const int bn = (w & 1) * 2 + q; f32x4 yd = (f32x4){0.f, 0.f, 0.f, 0.f}, yo = (f32x4){0.f, 0.f, 0.f, 0.f};
#pragma unroll
        for (int ks = 0; ks < 2; ++ks) yd = MFMA16(ldfrag(L.Ph, 72, 16 * bm, 32 * ks, lane), ldfrag(L.Xt, 72, 16 * bn, 32 * ks, lane), yd);
#pragma unroll
        for (int ks = 0; ks < 4; ++ks) yo = MFMA16(ldfrag(L.Cs, 136, 16 * bm, 32 * ks, lane), ldfrag(L.Sh, 136, 16 * bn, 32 * ks, lane), yo);
#pragma unroll
        for (int r = 0; r < 4; ++r) { const int l = 16 * bm + 4 * g4 + r, p = 16 * bn + lc; const float x = bf2f(L.Xt[p * 72 + l]);
            const float z = bf2f(zrow[r][hh * 64 + q * 16]);
            y[q][r] = (yd[r] + fexp_(L.AC[l * 4 + hh]) * yo[r] + x * dsk) * z; } }
}
DI void u_mamba_out(Frame& F, int l_, int c, int g) {
    int tid_ = F.tid; asm volatile("" : "+v"(tid_));
    unsigned char* ws = F.ws; const int tid = tid_, lane = tid_ & 63, w = F.wave, g4 = lane >> 4, lc = lane & 15;
    MambaLds L; L.Cs = (LAS bf16*)F.lds; L.Bs = L.Cs + 64 * 136; L.CB = (LAS float*)(L.Bs + 64 * 136); L.Ph = (LAS bf16*)(L.CB + 64 * 68); L.Xt = L.Ph + 64 * 72; L.Sh = L.Xt + 64 * 72;
    L.AC = (LAS float*)(L.Sh + 64 * 136); L.DT = L.AC + 256; L.SSQ = L.DT + 256;
    LAS bf16* Y = (LAS bf16*)(L.SSQ + 128);
    const bf16* XC = (const bf16*)(ws + WS_XC) + (size_t)(c * 64) * 1024;
    stage_nat(L.Cs, 136, XC + 768 + g * 128, 1024, 64, 16, tid);
    stage_nat(L.Bs, 136, XC + 512 + g * 128, 1024, 64, 16, tid);
    if (tid < 256) { const int l = tid >> 2, hh = tid & 3; L.AC[tid] = ((const float*)(ws + WS_ACS))[(size_t)(c * 64 + l) * 8 + g * 4 + hh]; L.DT[tid] = ((const float*)(ws + WS_DTS))[(size_t)(c * 64 + l) * 8 + g * 4 + hh]; }
    __syncthreads();
    const int bm = w >> 1;
#pragma unroll
    for (int q = 0; q < 2; ++q) { const int bn = (w & 1) * 2 + q; f32x4 acc = (f32x4){0.f, 0.f, 0.f, 0.f};
#pragma unroll
        for (int ks = 0; ks < 4; ++ks) acc = MFMA16(ldfrag(L.Cs, 136, 16 * bm, 32 * ks, lane), ldfrag(L.Bs, 136, 16 * bn, 32 * ks, lane), acc);
#pragma unroll
        for (int r = 0; r < 4; ++r) L.CB[(16 * bm + 4 * g4 + r) * 68 + 16 * bn + lc] = acc[r]; }
    const int pcol = 16 * ((w & 1) * 2) + lc;
    const bf16* zrow[4];
#pragma unroll
    for (int r = 0; r < 4; ++r) { const size_t row = (size_t)(c * 64 + 16 * bm + 4 * g4 + r); zrow[r] = (const bf16*)(ws + WS_ZS) + row * 512 + g * 256 + pcol; }
    const float* mst = (const float*)(ws + WS_MST) + ((size_t)(c * 8 + g * 4) * 64) * 128; const float* prm = (const float*)(ws + WS_PRM) + (size_t)l_ * PRM_STRIDE; const float* dskp = prm + P_SD + g * 4;
    float ss[4] = {0.f, 0.f, 0.f, 0.f};
#pragma unroll 1
    for (int hh = 0; hh < 4; ++hh) { f32x4 y[2]; mamba_head(F, L, XC, mst + (size_t)hh * 64 * 128, g, hh, dskp[hh], zrow, y);
#pragma unroll
        for (int q = 0; q < 2; ++q)
#pragma unroll
            for (int r = 0; r < 4; ++r) { ss[r] += y[q][r] * y[q][r]; Y[(16 * bm + 4 * g4 + r) * 264 + hh * 64 + pcol + q * 16] = (bf16)f2bf(y[q][r]); } }
#pragma unroll
    for (int r = 0; r < 4; ++r) { float t = ss[r]; t = row_sum16(t);
        if (lc == 0) L.SSQ[(16 * bm + 4 * g4 + r) * 2 + (w & 1)] = t; }
    __syncthreads();
    {
        const int l = tid >> 3, c0 = (tid & 7) * 32; const float rstd = rsqrtf((L.SSQ[l * 2] + L.SSQ[l * 2 + 1]) * (1.f / 256.f) + 1e-6f);
        const float* nw = prm + P_SNW + g * 256 + c0; bf16* orow = (bf16*)(ws + WS_OB) + (size_t)(c * 64 + l) * D + 512 + g * 256 + c0;
#pragma unroll
        for (int q = 0; q < 4; ++q) { float v[8]; unpack8(*(const LAS u32x4*)(Y + l * 264 + c0 + 8 * q), v);
            const f32x4 w0 = *(const GAS f32x4*)(nw + 8 * q), w1 = *(const GAS f32x4*)(nw + 8 * q + 4);
            *(GAS u32x4*)(orow + 8 * q) = pack8((f32x4){v[0], v[1], v[2], v[3]} * rstd * w0, (f32x4){v[4], v[5], v[6], v[7]} * rstd * w1); } }
    __syncthreads();
}

DI void u_attn2(Frame& F, int h, int qb, int sp, int ntile) {
    int tid_ = F.tid; asm volatile("" : "+v"(tid_));
    unsigned char* ws = F.ws; const int tid = tid_, lane = tid & 63, w = F.wave, g4 = lane >> 4, lc = lane & 15;
    LAS bf16* Ks = (LAS bf16*)F.lds; LAS bf16* Vs = Ks + 64 * 200;
    const bf16* QM = (const bf16*)(ws + WS_QM); const bf16* KM = (const bf16*)(ws + WS_KM) + h * 192; const bf16* VT = (const bf16*)(ws + WS_VT) + (size_t)(h * 128) * S;
    const int q0 = qb * 256 + w * 32, cw = 4 * qb + (w >> 1);
    bf16x8 qf[2][6];
#pragma unroll
    for (int qq = 0; qq < 2; ++qq)
#pragma unroll
        for (int ks = 0; ks < 6; ++ks) qf[qq][ks] = *(const GAS bf16x8*)(QM + (size_t)(q0 + qq * 16 + lc) * 768 + h * 192 + ks * 32 + g4 * 8);
    f32x4 o[8][2]; float mrun[2], lrun[2];
#pragma unroll
    for (int db = 0; db < 8; ++db)
#pragma unroll
        for (int qq = 0; qq < 2; ++qq) o[db][qq] = (f32x4){0.f, 0.f, 0.f, 0.f};
    mrun[0] = mrun[1] = -1e30f; lrun[0] = lrun[1] = 0.f;
    u32x4 kreg[3], vreg[2];
    const int kt0 = 16 * sp;
#define AT_LOAD(kt) { const int key0_ = (kt) * 64; \
        _Pragma("unroll") for (int i = 0; i < 3; ++i) { const int p = tid + 512 * i, r = p / 24, cc = p - r * 24; kreg[i] = *(const GAS u32x4*)(KM + (size_t)(key0_ + r) * 768 + cc * 8); } \
        _Pragma("unroll") for (int i = 0; i < 2; ++i) { const int p = tid + 512 * i, r = p >> 3, cc = p & 7; vreg[i] = *(const GAS u32x4*)(VT + (size_t)r * S + key0_ + cc * 8); } }
    AT_LOAD(kt0)
    for (int t = 0; t < ntile; ++t) {
        const int kt = kt0 + t;
        __syncthreads();
#pragma unroll
        for (int i = 0; i < 3; ++i) { const int p = tid + 512 * i, r = p / 24, cc = p - r * 24; *(LAS u32x4*)(Ks + r * 200 + cc * 8) = kreg[i]; }
#pragma unroll
        for (int i = 0; i < 2; ++i) { const int p = tid + 512 * i, r = p >> 3, cc = p & 7; *(LAS u32x4*)(Vs + r * 72 + cc * 8) = vreg[i]; }
        __syncthreads();
        if (t + 1 < ntile) AT_LOAD(kt + 1)
        if (kt <= cw) {
            f32x4 s[4][2];
#pragma unroll
            for (int kb = 0; kb < 4; ++kb)
#pragma unroll
                for (int qq = 0; qq < 2; ++qq) s[kb][qq] = (f32x4){0.f, 0.f, 0.f, 0.f};
            {
                bf16x8 kfr[2][4];
#pragma unroll
                for (int kb = 0; kb < 4; ++kb) kfr[0][kb] = ldfrag(Ks, 200, kb * 16, 0, lane);
#pragma unroll
                for (int ks = 0; ks < 6; ++ks) {
                    if (ks < 5) {
#pragma unroll
                        for (int kb = 0; kb < 4; ++kb) kfr[(ks + 1) & 1][kb] = ldfrag(Ks, 200, kb * 16, (ks + 1) * 32, lane); }
#pragma unroll
                    for (int kb = 0; kb < 4; ++kb)
#pragma unroll
                        for (int qq = 0; qq < 2; ++qq) s[kb][qq] = MFMA16(kfr[ks & 1][kb], qf[qq][ks], s[kb][qq]);
                }
            }
            bf16x8 pf[2][2];
#pragma unroll
            for (int qq = 0; qq < 2; ++qq) {
                float mx = -1e30f;
#pragma unroll
                for (int kb = 0; kb < 4; ++kb) mx = fmaxf(mx, fmaxf(fmaxf(s[kb][qq][0], s[kb][qq][1]), fmaxf(s[kb][qq][2], s[kb][qq][3])));
                mx = xr32_max(xr16_max(mx));
                const float mn = fmaxf(mrun[qq], mx), alpha = __builtin_amdgcn_exp2f(mrun[qq] - mn); mrun[qq] = mn;
                float ps = 0.f; float p[16];
#pragma unroll
                for (int kb = 0; kb < 4; ++kb)
#pragma unroll
                    for (int r = 0; r < 4; ++r) { p[kb * 4 + r] = __builtin_amdgcn_exp2f(s[kb][qq][r] - mn); ps += p[kb * 4 + r]; }
                ps = xr32_sum(xr16_sum(ps));
                lrun[qq] = lrun[qq] * alpha + ps;
if (__builtin_amdgcn_ballot_w64(alpha != 1.0f) != 0ull) {
#pragma unroll
                    for (int db = 0; db < 8; ++db) o[db][qq] = o[db][qq] * alpha; }
#pragma unroll
                for (int s2 = 0; s2 < 2; ++s2) { u32x4 pw; pw.x = pk2(p[8 * s2], p[8 * s2 + 1]); pw.y = pk2(p[8 * s2 + 2], p[8 * s2 + 3]); pw.z = pk2(p[8 * s2 + 4], p[8 * s2 + 5]); pw.w = pk2(p[8 * s2 + 6], p[8 * s2 + 7]); pf[qq][s2] = __builtin_bit_cast(bf16x8, pw); }
            }
            {
                bf16x8 vfr[2][2];
#define AT_VLD(dst, db_) { _Pragma("unroll") for (int s2 = 0; s2 < 2; ++s2) { const LAS bf16* vp = Vs + ((db_) * 16 + lc) * 72 + 32 * s2 + 4 * g4; \
                    const u32x2 v0 = *(const LAS u32x2*)vp, v1 = *(const LAS u32x2*)(vp + 16); const u32x4 vw = (u32x4){v0.x, v0.y, v1.x, v1.y}; dst[s2] = __builtin_bit_cast(bf16x8, vw); } }
                AT_VLD(vfr[0], 0)
#pragma unroll
                for (int db = 0; db < 8; ++db) {
                    if (db < 7) AT_VLD(vfr[(db + 1) & 1], db + 1)
#pragma unroll
                    for (int s2 = 0; s2 < 2; ++s2)
#pragma unroll
                        for (int qq = 0; qq < 2; ++qq) o[db][qq] = MFMA16(vfr[db & 1][s2], pf[qq][s2], o[db][qq]);
                }
#undef AT_VLD
            }
        }
    }
#undef AT_LOAD
    const int slot = att_slot(h, qb, sp);
    bf16* po = (bf16*)(ws + WS_APO) + (size_t)slot * 32768; float* pm = (float*)(ws + WS_APM) + (size_t)slot * 512;
#pragma unroll
    for (int db = 0; db < 8; ++db)
#pragma unroll
        for (int qq = 0; qq < 2; ++qq) *(GAS u32x2*)(po + (size_t)(w * 32 + qq * 16 + lc) * 128 + db * 16 + 4 * g4) = pk4_(o[db][qq]);
    if (g4 == 0) {
#pragma unroll
        for (int qq = 0; qq < 2; ++qq) { *(GAS f32x2*)(pm + (w * 32 + qq * 16 + lc) * 2) = (f32x2){mrun[qq], lrun[qq]}; } }
    __syncthreads();
}
DI void u_attn_comb(Frame& F, int h, int qb, int qq) {
    unsigned char* ws = F.ws; const int tid = F.tid, q = qq * 64 + (tid >> 3), dv0 = (tid & 7) * 16;
    const int ns = (qb + 4) >> 2, slot0 = att_slot(h, qb, 0);
    const float* pm = (const float*)(ws + WS_APM) + (size_t)slot0 * 512 + q * 2; const bf16* po = (const bf16*)(ws + WS_APO) + (size_t)slot0 * 32768 + (size_t)q * 128 + dv0;
    float mstar = -1e30f;
    for (int s = 0; s < ns; ++s) mstar = fmaxf(mstar, pm[(size_t)s * 512]);
    float lt = 0.f; float ov[16];
#pragma unroll
    for (int i = 0; i < 16; ++i) ov[i] = 0.f;
    for (int s = 0; s < ns; ++s) { const float sc = __builtin_amdgcn_exp2f(pm[(size_t)s * 512] - mstar); lt += pm[(size_t)s * 512 + 1] * sc;
        float v[16]; unpack8(*(const GAS u32x4*)(po + (size_t)s * 32768), *(float(*)[8])&v[0]); unpack8(*(const GAS u32x4*)(po + (size_t)s * 32768 + 8), *(float(*)[8])&v[8]);
#pragma unroll
        for (int i = 0; i < 16; ++i) ov[i] += v[i] * sc; }
    const float inv = 1.0f / lt;
    bf16* ob = (bf16*)(ws + WS_OB) + (size_t)(qb * 256 + q) * D + 1024 + h * 128 + dv0;
    u32x4 o0, o1; o0.x = pk2(ov[0] * inv, ov[1] * inv); o0.y = pk2(ov[2] * inv, ov[3] * inv); o0.z = pk2(ov[4] * inv, ov[5] * inv); o0.w = pk2(ov[6] * inv, ov[7] * inv);
    o1.x = pk2(ov[8] * inv, ov[9] * inv); o1.y = pk2(ov[10] * inv, ov[11] * inv); o1.z = pk2(ov[12] * inv, ov[13] * inv); o1.w = pk2(ov[14] * inv, ov[15] * inv);
    *(GAS u32x4*)ob = o0; *(GAS u32x4*)(ob + 8) = o1;
}

DI void u_rwkv_r1(Frame& F, int c, int h) {
    int tid_ = F.tid; asm volatile("" : "+v"(tid_));
    unsigned char* ws = F.ws; const int tid = tid_, lane = tid_ & 63, w = F.wave, g4 = lane >> 4, lc = lane & 15;
    LAS float* CUM = (LAS float*)F.lds;
    LAS float* PT = CUM + 64 * 68;
    LAS bf16* AT = (LAS bf16*)(PT + 64); LAS bf16* BH = AT + 4608; LAS bf16* KH = BH + 4608; LAS bf16* RT = KH + 4608;
    LAS bf16* AJ = RT + 4608; LAS bf16* BJ = AJ + 4608; LAS bf16* KJ = BJ + 4608; LAS bf16* VJ = KJ + 4608;
    LAS bf16* MAK = VJ + 4608; LAS bf16* MRBT = MAK + 4608; LAS bf16* MRKT = MRBT + 4608; LAS bf16* X1 = MRKT + 4608; LAS bf16* X2 = X1 + 4608;
    LAS bf16* WT = AT; LAS bf16* G1 = BH; LAS bf16* G2 = KH; LAS bf16* CST = MAK;
    const size_t gb = (size_t)(c * 64) * 512 + h * 64; const int unit = c * 8 + h;
    const int t = tid >> 3, j0 = (tid & 7) * 8;
    const size_t go = gb + (size_t)t * 512 + j0;
    float lw[8];
    { const f32x4 x0 = *(const GAS f32x4*)((const float*)(ws + WS_DEC) + go), x1 = *(const GAS f32x4*)((const float*)(ws + WS_DEC) + go + 4);
#pragma unroll
      for (int i = 0; i < 4; ++i) { lw[i] = x0[i]; lw[4 + i] = x1[i]; }
#pragma unroll
      for (int i = 0; i < 8; ++i) CUM[t * 68 + j0 + i] = lw[i]; }
    __syncthreads();
    if (tid < 64) { float s = 0.f;
#pragma unroll 8
        for (int tt = 0; tt < 64; ++tt) { s += CUM[tt * 68 + tid]; CUM[tt * 68 + tid] = s; } }
    __syncthreads();
    {
        float cum[8], cT[8];
#pragma unroll
        for (int i = 0; i < 8; ++i) { cum[i] = CUM[t * 68 + j0 + i]; cT[i] = CUM[63 * 68 + j0 + i]; }
        if (t == 0) {
#pragma unroll
            for (int i = 0; i < 8; ++i) PT[j0 + i] = fexp_(cT[i]); }
        float av[8], bv[8], kv[8], rv[8], vv[8];
#define LD8(dst, OFF) { unpack8(*(const GAS u32x4*)((const bf16*)(ws + (OFF)) + go), dst); }
        LD8(av, WS_KKN) LD8(bv, WS_BB) LD8(kv, WS_KP) LD8(rv, WS_R32) LD8(vv, WS_VV)
#undef LD8
        float at[8], bh[8], kh[8], rt[8], bj[8], kj[8];
#pragma unroll
        for (int i = 0; i < 8; ++i) { const float pprev = fexp_(cum[i] - lw[i]), pinv = fexp_(-cum[i]), pt = fexp_(cum[i]), pend = fexp_(cT[i] - cum[i]);
            at[i] = -av[i] * pprev; bh[i] = bv[i] * pinv; kh[i] = kv[i] * pinv; rt[i] = rv[i] * pt; bj[i] = bv[i] * pend; kj[i] = kv[i] * pend; }
#define ST8(M, v) { u32x4 o; o.x = pk2(v[0], v[1]); o.y = pk2(v[2], v[3]); o.z = pk2(v[4], v[5]); o.w = pk2(v[6], v[7]); *(LAS u32x4*)(M + t * 72 + j0) = o; }
        ST8(AT, at) ST8(BH, bh) ST8(KH, kh) ST8(RT, rt)
#undef ST8
#pragma unroll
        for (int i = 0; i < 8; ++i) { const int o = (j0 + i) * 72 + t; AJ[o] = (bf16)f2bf(at[i]); BJ[o] = (bf16)f2bf(bj[i]); KJ[o] = (bf16)f2bf(kj[i]); VJ[o] = (bf16)f2bf(vv[i]); }
    }
    __syncthreads();
    {
        const int q = w >> 1; const LAS bf16* Am = (q == 0) ? BH : (q == 1) ? KH : RT; const LAS bf16* Bm = (q < 2) ? AT : (q == 2) ? BH : KH;
#pragma unroll
        for (int bi = 0; bi < 2; ++bi) { const int bm = 2 * (w & 1) + bi; const bf16x8 a0 = ldfrag(Am, 72, 16 * bm, 0, lane), a1 = ldfrag(Am, 72, 16 * bm, 32, lane);
#pragma unroll
            for (int bn = 0; bn < 4; ++bn) { f32x4 acc = (f32x4){0.f, 0.f, 0.f, 0.f};
                acc = MFMA16(a0, ldfrag(Bm, 72, 16 * bn, 0, lane), acc); acc = MFMA16(a1, ldfrag(Bm, 72, 16 * bn, 32, lane), acc);
#pragma unroll
                for (int r = 0; r < 4; ++r) { const int row = 16 * bm + 4 * g4 + r, col = 16 * bn + lc; const bool keep = (q < 2) ? (row < col) : (col <= row); const float v = keep ? acc[r] : 0.f;
                    if (q == 0) CUM[row * 68 + col] = v; else { LAS bf16* O = (q == 1) ? MAK : (q == 2) ? MRBT : MRKT; O[row * 72 + col] = (bf16)f2bf(v); } } } }
    }
    __syncthreads();
    {
        LAS bf16* Qn[2] = {BH, X1}; LAS bf16* Qt[2] = {KH, X2}; LAS bf16* Wn[2] = {AT, (LAS bf16*)CUM};
        const int bm = w >> 1; f32x4 wreg[2];
#pragma unroll
        for (int qn = 0; qn < 2; ++qn) { const int bn = (w & 1) * 2 + qn;
#pragma unroll
            for (int r = 0; r < 4; ++r) { const int row = 16 * bm + 4 * g4 + r, col = 16 * bn + lc; const float m = CUM[row * 68 + col]; wreg[qn][r] = m + ((row == col) ? 1.f : 0.f);
                const bf16 mb = (bf16)f2bf(m); Qn[0][row * 72 + col] = mb; Qt[0][col * 72 + row] = mb; Wn[0][row * 72 + col] = (bf16)f2bf(wreg[qn][r]); } }
        __syncthreads();
#pragma unroll
        for (int it = 0; it < 5; ++it) { const int cu = it & 1, nx = cu ^ 1;
            { const bf16x8 a0 = ldfrag(Qn[cu], 72, 16 * bm, 0, lane), a1 = ldfrag(Qn[cu], 72, 16 * bm, 32, lane);
#pragma unroll
              for (int qn = 0; qn < 2; ++qn) { const int bn = (w & 1) * 2 + qn; f32x4 acc = (f32x4){0.f, 0.f, 0.f, 0.f};
                  acc = MFMA16(a0, ldfrag(Qt[cu], 72, 16 * bn, 0, lane), acc); acc = MFMA16(a1, ldfrag(Qt[cu], 72, 16 * bn, 32, lane), acc);
#pragma unroll
                  for (int r = 0; r < 4; ++r) { const int row = 16 * bm + 4 * g4 + r, col = 16 * bn + lc; const bf16 v = (bf16)f2bf(acc[r]); Qn[nx][row * 72 + col] = v; Qt[nx][col * 72 + row] = v; } } }
            __syncthreads();
            { const bf16x8 a0 = ldfrag(Wn[cu], 72, 16 * bm, 0, lane), a1 = ldfrag(Wn[cu], 72, 16 * bm, 32, lane);
#pragma unroll
              for (int qn = 0; qn < 2; ++qn) { const int bn = (w & 1) * 2 + qn;
                  wreg[qn] = MFMA16(a0, ldfrag(Qt[nx], 72, 16 * bn, 0, lane), wreg[qn]); wreg[qn] = MFMA16(a1, ldfrag(Qt[nx], 72, 16 * bn, 32, lane), wreg[qn]); } }
            if (it < 4) {
#pragma unroll
                for (int qn = 0; qn < 2; ++qn) { const int bn = (w & 1) * 2 + qn;
#pragma unroll
                    for (int r = 0; r < 4; ++r) Wn[nx][(16 * bm + 4 * g4 + r) * 72 + 16 * bn + lc] = (bf16)f2bf(wreg[qn][r]); }
            }
        }
        __syncthreads();
#pragma unroll
        for (int qn = 0; qn < 2; ++qn) { const int bn = (w & 1) * 2 + qn;
#pragma unroll
            for (int r = 0; r < 4; ++r) WT[(16 * bn + lc) * 72 + 16 * bm + 4 * g4 + r] = (bf16)f2bf(wreg[qn][r]); }
    }
    __syncthreads();
    {
        const int q = w >> 2, bm = w & 3; const LAS bf16* Am = q ? MAK : AJ; LAS bf16* O = q ? G2 : G1;
        const bf16x8 a0 = ldfrag(Am, 72, 16 * bm, 0, lane), a1 = ldfrag(Am, 72, 16 * bm, 32, lane);
        f32x4 acc[4];
#pragma unroll
        for (int bn = 0; bn < 4; ++bn) { acc[bn] = (f32x4){0.f, 0.f, 0.f, 0.f};
            acc[bn] = MFMA16(a0, ldfrag(WT, 72, 16 * bn, 0, lane), acc[bn]); acc[bn] = MFMA16(a1, ldfrag(WT, 72, 16 * bn, 32, lane), acc[bn]); }
#pragma unroll
        for (int bn = 0; bn < 4; ++bn)
#pragma unroll
            for (int r = 0; r < 4; ++r) O[(16 * bm + 4 * g4 + r) * 72 + 16 * bn + lc] = (bf16)f2bf(acc[bn][r]);
    }
    __syncthreads();
    {
        const int q = w >> 1; const LAS bf16* Am = (q < 2) ? MRBT : BJ; const LAS bf16* Bm = (q & 1) ? G2 : G1;
        f32x4 acc[2][4];
#pragma unroll
        for (int bi = 0; bi < 2; ++bi) { const int bm = 2 * (w & 1) + bi; const bf16x8 a0 = ldfrag(Am, 72, 16 * bm, 0, lane), a1 = ldfrag(Am, 72, 16 * bm, 32, lane);
#pragma unroll
            for (int bn = 0; bn < 4; ++bn) { acc[bi][bn] = (f32x4){0.f, 0.f, 0.f, 0.f};
                acc[bi][bn] = MFMA16(a0, ldfrag(Bm, 72, 16 * bn, 0, lane), acc[bi][bn]); acc[bi][bn] = MFMA16(a1, ldfrag(Bm, 72, 16 * bn, 32, lane), acc[bi][bn]); } }
        LAS bf16* lout = (q == 0) ? AT : (q == 1) ? AJ : (q == 2) ? X1 : CST;
#pragma unroll
        for (int bi = 0; bi < 2; ++bi) { const int bm = 2 * (w & 1) + bi;
#pragma unroll
            for (int bn = 0; bn < 4; ++bn)
#pragma unroll
                for (int r = 0; r < 4; ++r) { const int row = 16 * bm + 4 * g4 + r, col = 16 * bn + lc; float v = acc[bi][bn][r];
                    if (q == 0) v += bf2f(RT[row * 72 + col]); else if (q == 1) v += bf2f(MRKT[row * 72 + col]); else if (q == 2) v += (row == col) ? PT[row] : 0.f; else v += bf2f(KJ[row * 72 + col]);
                    lout[row * 72 + col] = (bf16)f2bf(v); } }
    }
    __syncthreads();
    { const int row = tid >> 3, c8 = (tid & 7) * 8; const size_t go2 = (size_t)unit * 4096 + row * 64 + c8;
      *(GAS u32x4*)((bf16*)(ws + WS_QYT) + go2) = *(const LAS u32x4*)(AT + row * 72 + c8);
      *(GAS u32x4*)((bf16*)(ws + WS_CYT) + go2) = *(const LAS u32x4*)(AJ + row * 72 + c8);
      *(GAS u32x4*)((bf16*)(ws + WS_TST) + go2) = *(const LAS u32x4*)(X1 + row * 72 + c8); }
    {
        const int bm = w >> 1;
        const bf16x8 a0 = ldfrag(CST, 72, 16 * bm, 0, lane), a1 = ldfrag(CST, 72, 16 * bm, 32, lane);
#pragma unroll
        for (int qn = 0; qn < 2; ++qn) { const int bn = (w & 1) * 2 + qn; f32x4 acc = (f32x4){0.f, 0.f, 0.f, 0.f};
            acc = MFMA16(a0, ldfrag(VJ, 72, 16 * bn, 0, lane), acc); acc = MFMA16(a1, ldfrag(VJ, 72, 16 * bn, 32, lane), acc);
#pragma unroll
            for (int r = 0; r < 4; ++r) CUM[(16 * bm + 4 * g4 + r) * 68 + 16 * bn + lc] = acc[r]; }
    }
    __syncthreads();
    { float* nst = (float*)(ws + WS_NST) + (size_t)unit * 4096;
#pragma unroll
      for (int k = 0; k < 2; ++k) { const int p = tid + 512 * k, row = p >> 4, c4 = (p & 15) * 4; *(GAS f32x4*)(nst + row * 64 + c4) = *(const LAS f32x4*)(CUM + row * 68 + c4); } }
    __syncthreads();
}

DI void p_rwkv_scan2(Frame& F, int h) {
    unsigned char* ws = F.ws; const int lane = F.lane, w = F.wave, g4 = lane >> 4, lc = lane & 15;
    constexpr int SLOT_B = 9216 + 17408;
    const bf16* TST = (const bf16*)(ws + WS_TST) + (size_t)h * 4096; const float* NST = (const float*)(ws + WS_NST) + (size_t)h * 4096; bf16* S0 = (bf16*)(ws + WS_S0) + (size_t)h * 4096;
    if (w >= 4) {
        const int lt = (w - 4) * 64 + lane;
        u32x4 rt[8][2]; f32x4 rn[8][4];
#define SC_ISSUE(u, cc) { const size_t ub = (size_t)(cc) * 8 * 4096; \
            _Pragma("unroll") for (int i = 0; i < 2; ++i) { const int p = lt + 256 * i; rt[u][i] = *(const GAS u32x4*)(TST + ub + (size_t)p * 8); } \
            _Pragma("unroll") for (int i = 0; i < 4; ++i) { const int p = lt + 256 * i; rn[u][i] = *(const GAS f32x4*)(NST + ub + (size_t)p * 4); } }
#define SC_WRITE(u, cc) { LAS unsigned char* sl = F.lds + ((cc) & 1) * SLOT_B; \
            _Pragma("unroll") for (int i = 0; i < 2; ++i) { const int p = lt + 256 * i, r = p >> 3, c8 = p & 7; *(LAS u32x4*)(sl + (r * 72 + c8 * 8) * 2) = rt[u][i]; } \
            _Pragma("unroll") for (int i = 0; i < 4; ++i) { const int p = lt + 256 * i, r = p >> 4, c4 = p & 15; *(LAS f32x4*)(sl + 9216 + (r * 68 + c4 * 4) * 4) = rn[u][i]; } }
#pragma unroll
        for (int u = 0; u < 8; ++u) SC_ISSUE(u, u)
        for (int c0 = 0; c0 < NCH; c0 += 8) {
#pragma unroll
            for (int u = 0; u < 8; ++u) { const int c = c0 + u;
                SC_WRITE(u, c)
                SC_ISSUE(u, (c + 8 < NCH) ? c + 8 : NCH - 1)
                asm volatile("s_waitcnt lgkmcnt(0)" ::: "memory"); __builtin_amdgcn_s_barrier(); asm volatile("" ::: "memory");
            }
        }
#undef SC_ISSUE
#undef SC_WRITE
    } else {
        const int ib = w;
        f32x4 st[4];
#pragma unroll
        for (int jb = 0; jb < 4; ++jb) st[jb] = (f32x4){0.f, 0.f, 0.f, 0.f};
        for (int c = 0; c < NCH; ++c) {
            bf16* s0p = S0 + (size_t)c * 8 * 4096 + (size_t)(16 * ib + lc) * 64 + 4 * g4;
            bf16x8 bfr[2];
#pragma unroll
            for (int ks = 0; ks < 2; ++ks) { u32x4 p; p.x = pk2(st[2 * ks][0], st[2 * ks][1]); p.y = pk2(st[2 * ks][2], st[2 * ks][3]); p.z = pk2(st[2 * ks + 1][0], st[2 * ks + 1][1]); p.w = pk2(st[2 * ks + 1][2], st[2 * ks + 1][3]);
                bfr[ks] = __builtin_bit_cast(bf16x8, p);
                *(GAS u32x2*)(s0p + 32 * ks) = (u32x2){p.x, p.y}; *(GAS u32x2*)(s0p + 32 * ks + 16) = (u32x2){p.z, p.w}; }
            asm volatile("s_waitcnt lgkmcnt(0)" ::: "memory"); __builtin_amdgcn_s_barrier(); asm volatile("" ::: "memory");
            const LAS bf16* ts = (const LAS bf16*)(F.lds + (c & 1) * SLOT_B); const LAS float* ns = (const LAS float*)(F.lds + (c & 1) * SLOT_B + 9216);
#pragma unroll
            for (int jb = 0; jb < 4; ++jb) { f32x4 nw;
#pragma unroll
                for (int r = 0; r < 4; ++r) nw[r] = ns[(16 * jb + 4 * g4 + r) * 68 + 16 * ib + lc];
#pragma unroll
                for (int ks = 0; ks < 2; ++ks) { const LAS bf16* ap = ts + (16 * jb + lc) * 72 + 32 * ks + 4 * g4; const u32x2 a0 = *(const LAS u32x2*)ap, a1 = *(const LAS u32x2*)(ap + 16);
                    const u32x4 aw = (u32x4){a0.x, a0.y, a1.x, a1.y}; nw = MFMA16(__builtin_bit_cast(bf16x8, aw), bfr[ks], nw); }
                st[jb] = nw; }
        }
    }
}

DI void u_rwkv_r3(Frame& F, int l_, int c, int h) {
    int tid_ = F.tid; asm volatile("" : "+v"(tid_));
    unsigned char* ws = F.ws; const int tid = tid_, lane = tid_ & 63, w = F.wave, g4 = lane >> 4, lc = lane & 15, unit = c * 8 + h;
    LAS bf16* QY = (LAS bf16*)F.lds; LAS bf16* CY = QY + 4608; LAS bf16* S0s = CY + 4608; LAS bf16* VJ = S0s + 4608; LAS float* Ys = (LAS float*)(VJ + 4608);
    stage_nat(QY, 72, (const bf16*)(ws + WS_QYT) + (size_t)unit * 4096, 64, 64, 8, tid);
    stage_nat(CY, 72, (const bf16*)(ws + WS_CYT) + (size_t)unit * 4096, 64, 64, 8, tid);
    stage_nat(S0s, 72, (const bf16*)(ws + WS_S0) + (size_t)unit * 4096, 64, 64, 8, tid);
    const size_t gb = (size_t)(c * 64) * 512 + h * 64;
    { const int t = tid >> 3, j0 = (tid & 7) * 8; const u32x4 w4 = *(const GAS u32x4*)((const bf16*)(ws + WS_VV) + gb + (size_t)t * 512 + j0); LAS bf16* d = VJ + j0 * 72 + t;
      d[0] = (bf16)(w4.x & 0xffffu); d[72] = (bf16)(w4.x >> 16); d[144] = (bf16)(w4.y & 0xffffu); d[216] = (bf16)(w4.y >> 16); d[288] = (bf16)(w4.z & 0xffffu); d[360] = (bf16)(w4.z >> 16); d[432] = (bf16)(w4.w & 0xffffu); d[504] = (bf16)(w4.w >> 16); }
    __syncthreads();
    { const int bm = w >> 1;
#pragma unroll
      for (int qn = 0; qn < 2; ++qn) { const int bn = (w & 1) * 2 + qn; f32x4 acc = (f32x4){0.f, 0.f, 0.f, 0.f};
#pragma unroll
          for (int ks = 0; ks < 2; ++ks) { acc = MFMA16(ldfrag(QY, 72, 16 * bm, 32 * ks, lane), ldfrag(S0s, 72, 16 * bn, 32 * ks, lane), acc); acc = MFMA16(ldfrag(CY, 72, 16 * bm, 32 * ks, lane), ldfrag(VJ, 72, 16 * bn, 32 * ks, lane), acc); }
#pragma unroll
          for (int r = 0; r < 4; ++r) Ys[(16 * bm + 4 * g4 + r) * 68 + 16 * bn + lc] = acc[r]; } }
    __syncthreads();
    {
        const float* prm = (const float*)(ws + WS_PRM) + (size_t)l_ * PRM_STRIDE + h * 64; const int t = 8 * w + (lane >> 3), i0 = (lane & 7) * 8; const size_t o = gb + (size_t)t * 512 + i0;
        float r8[8], k8[8], v8[8], g8[8];
        unpack8(*(const GAS u32x4*)((const bf16*)(ws + WS_R32) + o), r8); unpack8(*(const GAS u32x4*)((const bf16*)(ws + WS_KP) + o), k8);
        unpack8(*(const GAS u32x4*)((const bf16*)(ws + WS_VV) + o), v8); unpack8(*(const GAS u32x4*)((const bf16*)(ws + WS_G32) + o), g8);
        const f32x4 y0 = *(const LAS f32x4*)(Ys + t * 68 + i0), y1 = *(const LAS f32x4*)(Ys + t * 68 + i0 + 4);
        const f32x4 lw0 = *(const GAS f32x4*)(prm + P_LNW + i0), lw1 = *(const GAS f32x4*)(prm + P_LNW + i0 + 4), lb0 = *(const GAS f32x4*)(prm + P_LNB + i0), lb1 = *(const GAS f32x4*)(prm + P_LNB + i0 + 4);
        const f32x4 rk0 = *(const GAS f32x4*)(prm + P_RK + i0), rk1 = *(const GAS f32x4*)(prm + P_RK + i0 + 4);
        const float mean = row_sum8((y0.x + y0.y) + (y0.z + y0.w) + (y1.x + y1.y) + (y1.z + y1.w)) * (1.f / 64.f);
        const f32x4 d0 = y0 - mean, d1 = y1 - mean;
        const float rstd = rsqrtf(row_sum8((d0.x * d0.x + d0.y * d0.y) + (d0.z * d0.z + d0.w * d0.w) + (d1.x * d1.x + d1.y * d1.y) + (d1.z * d1.z + d1.w * d1.w)) * (1.f / 64.f) + 64e-5f);
        float bsp = 0.f;
#pragma unroll
        for (int i = 0; i < 4; ++i) bsp += r8[i] * k8[i] * rk0[i] + r8[4 + i] * k8[4 + i] * rk1[i];
        const float bs = row_sum8(bsp);
        f32x4 o0, o1;
#pragma unroll
        for (int i = 0; i < 4; ++i) { o0[i] = (d0[i] * rstd * lw0[i] + lb0[i] + bs * v8[i]) * g8[i]; o1[i] = (d1[i] * rstd * lw1[i] + lb1[i] + bs * v8[4 + i]) * g8[4 + i]; }
        *(GAS u32x4*)((bf16*)(ws + WS_OB) + (size_t)(c * 64 + t) * D + 1536 + h * 64 + i0) = pack8(o0, o1);
    }
    __syncthreads();
}

constexpr int STEPS_PER_LAYER = 13, NSTEPS = 1 + DEPTH * STEPS_PER_LAYER;
constexpr int NSCAN_BLK = 8;

__global__ void __launch_bounds__(NTHR, 2) mk_fwd(Args args) {
    extern __shared__ __attribute__((aligned(16))) unsigned char lds_raw[];
    Frame F;
    F.lds = (LAS unsigned char*)lds_raw; F.MISC = (volatile LAS unsigned*)(F.lds + MISC_OFF);
    F.tid = threadIdx.x; F.lane = F.tid & 63; F.wave = __builtin_amdgcn_readfirstlane(F.tid >> 6);
    F.G = gridDim.x; F.bid = blockIdx.x; F.ws = args.ws; F.ctl = (gu32*)(args.ws + WS_CTL);
    for (int u = F.tid; u < (LDS_BYTES - LDSCTL_OFF) / 4; u += NTHR) ((LAS unsigned*)(F.lds + LDSCTL_OFF))[u] = 0u;
    __syncthreads();
    const int lo = args.st_lo, hi = args.st_hi;
    XcdBarrier bar; bar.bar = (unsigned*)(F.ctl + CW_BAR); bar.x = 0; bar.st = nullptr;
    if (hi - lo > 1) bar = xcd_barrier_post((unsigned*)(F.ctl + CW_BAR), F.MISC + 8);
#ifndef MK_MASK
#define MK_MASK 0xFBFEu
#endif
#define EN(k) (((MK_MASK) >> (k)) & 1u)
#ifndef MK_REP
#define MK_REP 0u
#endif
#define REP(k) (((MK_REP) >> (k)) & 1u)
#ifndef MK_DUP
#define MK_DUP 0u
#endif
#define DUP(k, stmt) do { stmt; if (((MK_DUP) >> (k)) & 1u) { stmt; } } while (0)
#define RUN(s) (lo <= (s) && (s) < hi)
#define SEAM(s) do { if ((s) + 1 < hi) xcd_barrier(bar); } while (0)

    if (EN(13) && RUN(0)) { _Pragma("unroll 1") for (int rp = 0; rp <= (int)REP(13); ++rp) { relaunder(F, args.ws, (LAS unsigned char*)lds_raw); p_prologue(F, args); } SEAM(0); }

    for (int l = 0; l < DEPTH; ++l) {
        const int sb = 1 + l * STEPS_PER_LAYER;
        const float* xin = (l == 0) ? args.in[0] : args.out;
        if (EN(0) && RUN(sb + 0)) { _Pragma("unroll 1") for (int rp = 0; rp <= (int)REP(0); ++rp) { relaunder(F, args.ws, (LAS unsigned char*)lds_raw); unsigned char* ws = F.ws; DUP(11, p_rmsnorm(F, xin, (const float*)(ws + WS_PRM) + (size_t)l * PRM_STRIDE + P_N1, (bf16*)(ws + WS_XN))); } SEAM(sb + 0); }
        if (EN(1) && RUN(sb + 1)) { _Pragma("unroll 1") for (int rp = 0; rp <= (int)REP(1); ++rp) { relaunder(F, args.ws, (LAS unsigned char*)lds_raw); unsigned char* ws = F.ws;
            pg8::Gemm g{(const bf16*)(ws + WS_XN), (const bf16*)(ws + WS_WIN) + (size_t)l * NINP * D, D, D, D};
            pg8::StaticOrder So; So.init(S, NINP - 256, F.G, F.bid); pg8::EpiIn E{ws, 0, (const LAS float*)(F.lds + RTAB_OFF)};
            pg8::fill_rstd((LAS float*)(F.lds + RTAB_OFF), (const float*)(ws + WS_RSSA), So, F.tid);
            DUP(6, (pg8::gemm_phase<pg8::EpiIn, pg8::StaticOrder, true>(F.lds, g, So, E, F.tid)));
            } SEAM(sb + 1);
        }
        if (EN(2) && RUN(sb + 2)) { _Pragma("unroll 1") for (int rp = 0; rp <= (int)REP(2); ++rp) { relaunder(F, args.ws, (LAS unsigned char*)lds_raw); unsigned char* ws = F.ws;
            if (F.bid >= F.G - 32) {
                pg8::Gemm g{(const bf16*)(ws + WS_XN), (const bf16*)(ws + WS_WIN) + ((size_t)l * NINP + (NINP - 256)) * D, D, D, D};
                pg8::StaticOrder So; So.init(S, 256, 32, F.bid - (F.G - 32)); pg8::EpiMisc E{ws, (const LAS float*)(F.lds + RTAB_OFF)};
                pg8::fill_rstd((LAS float*)(F.lds + RTAB_OFF), (const float*)(ws + WS_RSSA), So, F.tid);
                pg8::gemm_phase<pg8::EpiMisc, pg8::StaticOrder, true>(F.lds, g, So, E, F.tid);
            } else {
                const int Gs = F.G; F.G = Gs - 32;
                DUP(12, p_rwkv_prep(F, l));
                relaunder(F, args.ws, (LAS unsigned char*)lds_raw); F.G = Gs - 32; DUP(13, p_mamba_prep(F, l));
                __syncthreads(); relaunder(F, args.ws, (LAS unsigned char*)lds_raw); F.G = Gs - 32;
                for (int u = F.bid; u < 512; u += F.G) DUP(5, u_ret_kv(F, u >> 2, u & 3));
                F.G = Gs;
            }
            } SEAM(sb + 2);
        }
        if (EN(3) && RUN(sb + 3)) { _Pragma("unroll 1") for (int rp = 0; rp <= (int)REP(3); ++rp) { relaunder(F, args.ws, (LAS unsigned char*)lds_raw); unsigned char* ws = F.ws;
            { pg8::Gemm g{(const bf16*)(ws + WS_CQ), (const bf16*)(ws + WS_WQB) + (size_t)l * 1024 * 512, 512, 512, 512};
              pg8::StaticOrder So; So.init(S, 1024, F.G, F.bid); pg8::EpiQb E{ws, (const float*)(ws + WS_PRM) + (size_t)l * PRM_STRIDE + P_QNW};
              pg8::gemm_phase<pg8::EpiQb, pg8::StaticOrder, false>(F.lds, g, So, E, F.tid); __syncthreads(); }
            relaunder(F, args.ws, (LAS unsigned char*)lds_raw); ws = F.ws;
            { pg8::Gemm g{(const bf16*)(ws + WS_CKV), (const bf16*)(ws + WS_WKVB) + (size_t)l * 1024 * 256, 256, 256, 256};
              pg8::StaticOrder So; So.init(S, 1024, F.G, (F.bid + 128) % F.G); pg8::EpiKvb E{ws, (const float*)(ws + WS_PRM) + (size_t)l * PRM_STRIDE + P_KNW};
              pg8::gemm_phase<pg8::EpiKvb, pg8::StaticOrder, false>(F.lds, g, So, E, F.tid); __syncthreads(); }
            relaunder(F, args.ws, (LAS unsigned char*)lds_raw); ws = F.ws;
            if (l > 0) { pg8::Gemm g{(const bf16*)(ws + WS_VV), (const bf16*)(ws + WS_WV1) + (size_t)l * 256 * 512, 512, 512, 512};
              pg8::StaticOrder So; So.init(S, 256, F.G, (F.bid + 64) % F.G); pg8::EpiV1 E{ws};
              pg8::gemm_phase<pg8::EpiV1, pg8::StaticOrder, true>(F.lds, g, So, E, F.tid); __syncthreads(); }
            relaunder(F, args.ws, (LAS unsigned char*)lds_raw);
            for (int u = F.bid; u < 256; u += F.G) { u_mamba_dt(F, l, u >> 1); DUP(4, u_mamba_st(F, u >> 1, u & 1)); }
            } SEAM(sb + 3);
        }
        if (EN(4) && RUN(sb + 4)) { _Pragma("unroll 1") for (int rp = 0; rp <= (int)REP(4); ++rp) { relaunder(F, args.ws, (LAS unsigned char*)lds_raw); unsigned char* ws = F.ws;
            {
              pg8::Gemm g{(const bf16*)(ws + WS_ALORA), (const bf16*)(ws + WS_WLORA) + (size_t)l * 2048 * 512, 512, 512, 512};
              pg8::StaticOrder So; So.init(S, l > 0 ? 2048 : 1536, F.G, F.bid);
              const float* prm = (const float*)(ws + WS_PRM) + (size_t)l * PRM_STRIDE; pg8::EpiLora E{ws, prm + P_W0, prm + P_A0, prm + P_V0, prm + P_KA};
              DUP(9, (pg8::gemm_phase<pg8::EpiLora, pg8::StaticOrder, true>(F.lds, g, So, E, F.tid))); }
            } SEAM(sb + 4);
        }
        if (EN(5) && RUN(sb + 5)) { _Pragma("unroll 1") for (int rp = 0; rp <= (int)REP(5); ++rp) { relaunder(F, args.ws, (LAS unsigned char*)lds_raw); unsigned char* ws = F.ws; (void)ws;
            if (F.bid < 64) { p_scans(F, 64); relaunder(F, args.ws, (LAS unsigned char*)lds_raw);
                for (int u = F.bid * 2; u < F.bid * 2 + 2; ++u) u_rwkv_r1(F, u >> 3, u & 7); }
            else { for (int u = 128 + (F.bid - 64); u < 1024; u += F.G - 64) u_rwkv_r1(F, u >> 3, u & 7); }
            } SEAM(sb + 5);
        }
        if (EN(6) && RUN(sb + 6)) { _Pragma("unroll 1") for (int rp = 0; rp <= (int)REP(6); ++rp) { relaunder(F, args.ws, (LAS unsigned char*)lds_raw); unsigned char* ws = F.ws; (void)ws;
            if (F.bid < NSCAN_BLK) { p_rwkv_scan2(F, F.bid); }
            else {
                const int NB = F.G - NSCAN_BLK, b = F.bid - NSCAN_BLK;
                { const int* tab = (const int*)(ws + WS_ATAB);
                  for (int r = 0; r * NB < ATT_NSUB; ++r) { const int pos = (r & 1) ? NB - 1 - b : b; const int i = r * NB + pos;
                      if (i < ATT_NSUB) { const int e = tab[i]; DUP(0, u_attn2(F, e & 3, (e >> 2) & 31, (e >> 7) & 31, e >> 12)); } } }
            }
            } SEAM(sb + 6);
        }
        if (EN(7) && RUN(sb + 7)) { _Pragma("unroll 1") for (int rp = 0; rp <= (int)REP(7); ++rp) { relaunder(F, args.ws, (LAS unsigned char*)lds_raw); unsigned char* ws = F.ws; (void)ws;
            for (int u = F.bid; u < 1024; u += F.G) DUP(3, u_rwkv_r3(F, l, u >> 3, u & 7));
            for (int u = F.bid; u < 512; u += F.G) DUP(10, u_attn_comb(F, u >> 7, (u >> 2) & 31, u & 3));
            relaunder(F, args.ws, (LAS unsigned char*)lds_raw);
            for (int u = F.bid; u < 256; u += F.G) DUP(2, u_mamba_out(F, l, u >> 1, u & 1));
            relaunder(F, args.ws, (LAS unsigned char*)lds_raw);
            for (int u = F.bid; u < 512; u += F.G) DUP(1, u_ret_out(F, l, u >> 2, u & 3));
            } SEAM(sb + 7);
        }
        if (EN(8) && RUN(sb + 8)) { _Pragma("unroll 1") for (int rp = 0; rp <= (int)REP(8); ++rp) { relaunder(F, args.ws, (LAS unsigned char*)lds_raw); unsigned char* ws = F.ws;
            pg8::Gemm g{(const bf16*)(ws + WS_OB), (const bf16*)(ws + WS_WBR) + (size_t)l * 8192 * 512, 512, D, 512};
            pg8::BranchOrder So; So.init(F.G, F.bid); pg8::EpiBranch E{ws};
            DUP(8, (pg8::gemm_phase<pg8::EpiBranch, pg8::BranchOrder, true>(F.lds, g, So, E, F.tid)));
            } SEAM(sb + 8);
        }
        if (EN(9) && RUN(sb + 9)) { _Pragma("unroll 1") for (int rp = 0; rp <= (int)REP(9); ++rp) { relaunder(F, args.ws, (LAS unsigned char*)lds_raw); unsigned char* ws = F.ws;
            pg8::Gemm g{(const bf16*)(ws + WS_MERGED), (const bf16*)(ws + WS_WOUT) + (size_t)l * D * D, D, D, D};
            pg8::StaticOrder So; So.init(S, D, F.G, F.bid); pg8::EpiRes E{xin, args.out, (bf16*)(ws + WS_XN), (float*)(ws + WS_RSSB)};
            pg8::gemm_phase<pg8::EpiRes, pg8::StaticOrder, true>(F.lds, g, So, E, F.tid);
            } SEAM(sb + 9);
        }
        if (EN(10) && RUN(sb + 10)) { _Pragma("unroll 1") for (int rp = 0; rp <= (int)REP(10); ++rp) { relaunder(F, args.ws, (LAS unsigned char*)lds_raw); unsigned char* ws = F.ws; DUP(11, p_rmsnorm(F, args.out, (const float*)(ws + WS_PRM) + (size_t)l * PRM_STRIDE + P_N2, (bf16*)(ws + WS_XN))); } SEAM(sb + 10); }
        if (EN(11) && RUN(sb + 11)) { _Pragma("unroll 1") for (int rp = 0; rp <= (int)REP(11); ++rp) { relaunder(F, args.ws, (LAS unsigned char*)lds_raw); unsigned char* ws = F.ws;
            pg8::Gemm g{(const bf16*)(ws + WS_XN), (const bf16*)(ws + WS_WGU) + (size_t)l * 2 * DFF * D, D, D, D};
            pg8::StaticOrder So; So.init(S, 2 * DFF, F.G, F.bid); pg8::EpiGu E{ws, (const LAS float*)(F.lds + RTAB_OFF)};
            pg8::fill_rstd((LAS float*)(F.lds + RTAB_OFF), (const float*)(ws + WS_RSSB), So, F.tid);
            DUP(7, (pg8::gemm_phase<pg8::EpiGu, pg8::StaticOrder, true>(F.lds, g, So, E, F.tid)));
            } SEAM(sb + 11);
        }
        if (EN(12) && RUN(sb + 12)) { _Pragma("unroll 1") for (int rp = 0; rp <= (int)REP(12); ++rp) { relaunder(F, args.ws, (LAS unsigned char*)lds_raw); unsigned char* ws = F.ws;
            pg8::Gemm g{(const bf16*)(ws + WS_ACT), (const bf16*)(ws + WS_WDN) + (size_t)l * D * DFF, DFF, DFF, DFF};
            pg8::StaticOrder So; So.init(S, D, F.G, F.bid); pg8::EpiRes E{args.out, args.out, (bf16*)(ws + WS_XN), (l + 1 < DEPTH) ? (float*)(ws + WS_RSSA) : nullptr};
            pg8::gemm_phase<pg8::EpiRes, pg8::StaticOrder, true>(F.lds, g, So, E, F.tid);
            } SEAM(sb + 12);
        }
    }
#ifdef MK_PROBE
    { const int l = 3;
      if (RUN(200)) { relaunder(F, args.ws, (LAS unsigned char*)lds_raw); for (int u = F.bid; u < 1024; u += F.G) u_rwkv_r3(F, l, u >> 3, u & 7); }
      if (RUN(201)) { relaunder(F, args.ws, (LAS unsigned char*)lds_raw); for (int u = F.bid; u < 512; u += F.G) u_attn_comb(F, u >> 7, (u >> 2) & 31, u & 3); }
      if (RUN(202)) { relaunder(F, args.ws, (LAS unsigned char*)lds_raw); for (int u = F.bid; u < 256; u += F.G) u_mamba_out(F, l, u >> 1, u & 1); }
      if (RUN(203)) { relaunder(F, args.ws, (LAS unsigned char*)lds_raw); for (int u = F.bid; u < 512; u += F.G) u_ret_out(F, l, u >> 2, u & 3); }
      if (RUN(204)) { relaunder(F, args.ws, (LAS unsigned char*)lds_raw); if (F.bid < F.G - 32) { const int Gs = F.G; F.G = Gs - 32; p_rwkv_prep(F, l); F.G = Gs; } }
      if (RUN(205)) { relaunder(F, args.ws, (LAS unsigned char*)lds_raw); if (F.bid < F.G - 32) { const int Gs = F.G; F.G = Gs - 32; p_mamba_prep(F, l); F.G = Gs; } }
      if (RUN(206)) { relaunder(F, args.ws, (LAS unsigned char*)lds_raw); if (F.bid < F.G - 32) { const int Gs = F.G; F.G = Gs - 32; for (int u = F.bid; u < 512; u += F.G) u_ret_kv(F, u >> 2, u & 3); F.G = Gs; } }
      if (RUN(207)) { relaunder(F, args.ws, (LAS unsigned char*)lds_raw); if (F.bid < 64) p_scans(F, 64); }
      if (RUN(208)) { relaunder(F, args.ws, (LAS unsigned char*)lds_raw); if (F.bid >= 64) { for (int u = 128 + (F.bid - 64); u < 1024; u += F.G - 64) u_rwkv_r1(F, u >> 3, u & 7); } }
      if (RUN(210)) { relaunder(F, args.ws, (LAS unsigned char*)lds_raw); unsigned char* ws = F.ws; if (F.bid >= F.G - 32) {
                pg8::Gemm g{(const bf16*)(ws + WS_XN), (const bf16*)(ws + WS_WIN) + ((size_t)l * NINP + (NINP - 256)) * D, D, D, D};
                pg8::StaticOrder So; So.init(S, 256, 32, F.bid - (F.G - 32)); pg8::EpiMisc E{ws, (const LAS float*)(F.lds + RTAB_OFF)};
                pg8::fill_rstd((LAS float*)(F.lds + RTAB_OFF), (const float*)(ws + WS_RSSA), So, F.tid);
                pg8::gemm_phase<pg8::EpiMisc, pg8::StaticOrder, true>(F.lds, g, So, E, F.tid); } }
      if (RUN(211)) { relaunder(F, args.ws, (LAS unsigned char*)lds_raw); unsigned char* ws = F.ws; if (F.bid >= NSCAN_BLK) { const int NB = F.G - NSCAN_BLK, b = F.bid - NSCAN_BLK; const int* tab = (const int*)(ws + WS_ATAB);
                  for (int r = 0; r * NB < ATT_NSUB; ++r) { const int pos = (r & 1) ? NB - 1 - b : b; const int i = r * NB + pos;
                      if (i < ATT_NSUB) { const int e = tab[i]; u_attn2(F, e & 3, (e >> 2) & 31, (e >> 7) & 31, e >> 12); } } } }
      if (RUN(209)) { relaunder(F, args.ws, (LAS unsigned char*)lds_raw); if (F.bid < NSCAN_BLK) p_rwkv_scan2(F, F.bid); }
    }
#endif
#undef RUN
#undef SEAM
}

#ifndef MK_ONE_LAUNCH
#define MK_ONE_LAUNCH 1
#endif
extern "C" void kernel_launch(void* const* d_in, const int* in_sizes, int n_in, void* d_out, int out_size, void* d_ws, size_t ws_size, hipStream_t stream) {
    static int grid = 0;
    if (grid == 0) {
        if (n_in != 36 || in_sizes[0] != S * D || out_size != S * D || ws_size < WS_END3) { fprintf(stderr, "kernel_launch: bad shapes: n_in %d in0 %d out %d ws %zu (need %zu)\n", n_in, n_in > 0 ? in_sizes[0] : -1, out_size, ws_size, (size_t)WS_END3); grid = -1; return; }
        int dev = 0, cus = 0, per_cu = 0;
        if (hipGetDevice(&dev) != hipSuccess || hipDeviceGetAttribute(&cus, hipDeviceAttributeMultiprocessorCount, dev) != hipSuccess) { grid = -1; return; }
        if (hipFuncSetAttribute((const void*)mk_fwd, hipFuncAttributeMaxDynamicSharedMemorySize, LDS_BYTES) != hipSuccess) { fprintf(stderr, "kernel_launch: hipFuncSetAttribute failed\n"); grid = -1; return; }
        if (hipOccupancyMaxActiveBlocksPerMultiprocessor(&per_cu, (const void*)mk_fwd, NTHR, LDS_BYTES) != hipSuccess || per_cu < 1) fprintf(stderr, "kernel_launch: occupancy query says %d\n", per_cu);
        (void)hipGetLastError();
        grid = cus;
        if (grid != 256) fprintf(stderr, "kernel_launch: %d CUs (built for 256)\n", grid);
    }
    if (grid < 0) return;
    if (hipMemsetAsync((char*)d_ws + WS_CTL, 0, CTL_ZERO_BYTES, stream) != hipSuccess) return;
    Args a{};
    for (int i = 0; i < 36; ++i) a.in[i] = (const float*)d_in[i];
    a.out = (float*)d_out; a.ws = (unsigned char*)d_ws;
#if MK_ONE_LAUNCH
    a.st_lo = 0; a.st_hi = NSTEPS;
    hipLaunchKernelGGL(mk_fwd, dim3(grid), dim3(NTHR), LDS_BYTES, stream, a);
#ifndef MK_EXTRA_FLAGS
#define MK_EXTRA_FLAGS 0
#endif
#ifdef MK_EXTRA_STEPS
    { const int xs[] = {MK_EXTRA_STEPS};
      for (int r = 0; r < MK_EXTRA_N; ++r) for (unsigned i = 0; i < sizeof(xs) / sizeof(xs[0]); ++i) { a.st_lo = xs[i]; a.st_hi = xs[i] + 1; hipLaunchKernelGGL(mk_fwd, dim3(grid), dim3(NTHR), LDS_BYTES, stream, a); } }
#endif
#else
    for (int s = 0; s < NSTEPS; ++s) { a.st_lo = s; a.st_hi = s + 1; hipLaunchKernelGGL(mk_fwd, dim3(grid), dim3(NTHR), LDS_BYTES, stream, a); }
#endif
}
```

```cpp
#include <hip/hip_runtime.h>
#include <cstdio>
#include <cstdint>

#define GAS __attribute__((address_space(1)))
#define LAS __attribute__((address_space(3)))
typedef unsigned short bf16;
typedef short bf16x8 __attribute__((ext_vector_type(8)));
typedef short s16x4 __attribute__((ext_vector_type(4)));
typedef float f32x4 __attribute__((ext_vector_type(4)));
typedef float f32x2 __attribute__((ext_vector_type(2)));
typedef unsigned u32x4 __attribute__((ext_vector_type(4)));
typedef unsigned u32x2 __attribute__((ext_vector_type(2)));
typedef GAS unsigned gu32;
#define RLX_AGENT __ATOMIC_RELAXED, __HIP_MEMORY_SCOPE_AGENT
#define DI __device__ __forceinline__

constexpr int S = 8192, D = 2048, DEPTH = 4, NIN = 14408, NINP = 14592, DFF = 5632;
constexpr int NCH = 128;
constexpr float LOG2E = 1.4426950408889634f;

DI float bf2f(unsigned v) { return __uint_as_float(v << 16); }
typedef __bf16 bf16x2_t __attribute__((ext_vector_type(2)));
DI unsigned pk2(float lo, float hi) { const f32x2 v = {lo, hi}; const bf16x2_t b = __builtin_convertvector(v, bf16x2_t); return __builtin_bit_cast(unsigned, b); }
DI unsigned f2bf(float f) { const __bf16 b = (__bf16)f; return (unsigned)__builtin_bit_cast(unsigned short, b); }
DI float fexp_(float x) { return __builtin_amdgcn_exp2f(x * 1.4426950408889634f); }
DI float ftanh_(float x) { return 1.0f - 2.0f * __builtin_amdgcn_rcpf(1.0f + fexp_(2.0f * x)); }
DI float sigmoidf_(float x) { return __builtin_amdgcn_rcpf(1.0f + fexp_(-x)); }
DI float siluf_(float x) { return x * __builtin_amdgcn_rcpf(1.0f + fexp_(-x)); }
DI float softplusf_(float x) { return fmaxf(x, 0.f) + log1pf(fexp_(-fabsf(x))); }
DI u32x4 pack8(const f32x4 a, const f32x4 b) { u32x4 w; w.x = pk2(a[0], a[1]); w.y = pk2(a[2], a[3]); w.z = pk2(b[0], b[1]); w.w = pk2(b[2], b[3]); return w; }
DI void unpack8(const u32x4 w, float (&o)[8]) { o[0] = bf2f(w.x & 0xffffu); o[1] = bf2f(w.x >> 16); o[2] = bf2f(w.y & 0xffffu); o[3] = bf2f(w.y >> 16);
    o[4] = bf2f(w.z & 0xffffu); o[5] = bf2f(w.z >> 16); o[6] = bf2f(w.w & 0xffffu); o[7] = bf2f(w.w >> 16); }

namespace pg8 {
constexpr int BM = 256, BK = 64, HALF = 128, HTB = HALF * BK * 2, STAGE_BYTES = 8 * HTB, NXCD = 8, WGM = 8;
DI int lds_byte(int r, int c) { const int st = (r >> 4) * 2 + (c >> 5), rr = r & 15, cc = c & 31, ob = rr * 64 + cc * 2; return st * 1024 + (ob ^ (((ob >> 9) & 1) << 5)); }
DI void stage_rc(int b, int& R, int& C) { const int st = b / 1024, sb = b % 1024, swz = sb ^ (((sb >> 9) & 1) << 5); R = (st >> 1) * 16 + swz / 64; C = (st & 1) * 32 + (swz % 64) / 2; }
DI int perm32(int rho) { const int n = rho >> 4, i = rho & 15; return 8 * (i >> 2) + 4 * n + (i & 3); }

struct Unit { int pm, pn, ak, brow, sub, ord; };
struct Gemm { const bf16* A; const bf16* Bt; int K, lda, ldb; };

struct StaticOrder {
    int nM, nN, nwg, G, c;
    DI void init(int M, int N, int G_, int c_) { nM = M / BM; nN = N / BM; nwg = nM * nN; G = G_; c = c_; }
    DI bool next(int i, Unit& u) const {
        const long L = (long)i * G + c; if (L >= nwg) return false;
        int wgid = (int)L; { const int q = nwg / NXCD, r = nwg % NXCD, xcd = wgid % NXCD, off = wgid / NXCD; wgid = (xcd < r ? xcd * (q + 1) : r * (q + 1) + (xcd - r) * q) + off; }
        const int nig = WGM * nN, gid = wgid / nig, fm = gid * WGM, gsz = (nM - fm) < WGM ? (nM - fm) : WGM;
        u.pm = fm + ((wgid % nig) % gsz); u.pn = (wgid % nig) / gsz; u.ak = 0; u.brow = u.pn * BM; u.sub = 0; return true;
    }
};
struct LoraOrder {
    StaticOrder so;
    DI void init(int N, int G_, int c_) { so.init(S, N, G_, c_); }
    DI bool next(int i, Unit& u) const { if (!so.next(i, u)) return false; u.ak = (u.pn >= 4) ? 256 : 0; return true; }
};
struct BranchOrder {
    StaticOrder so;
    DI void init(int G_, int c_) { so.init(S, D, G_, c_); }
    DI bool next(int i, Unit& u) const { if (!so.next(i >> 2, u)) return false; u.sub = i & 3; u.ak = u.sub * 512; u.brow = u.sub * D + u.pn * BM; return true; }
};

typedef f32x4 Acc[2][2][4][2];

template <class Epi, class Sched, bool ALIGN_EPI>
DI void gemm_phase(LAS unsigned char* lds, const Gemm g, const Sched& Sc, const Epi& E, const int tid) {
    const int wid = __builtin_amdgcn_readfirstlane(tid >> 6), lane = tid & 63, wr = wid >> 2, wc = wid & 3, fr = lane & 15, fq = lane >> 4;
    const int K = g.K, nt = K / BK;
    unsigned voffA[2], voffB[2];
#pragma unroll
    for (int i = 0; i < 2; ++i) { int R, C; stage_rc(tid * 16 + i * 8192, R, C); const int Rb = (R & ~31) + perm32(R & 31);
        voffA[i] = (unsigned)(R * g.lda + C) * 2u; voffB[i] = (unsigned)(Rb * g.ldb + C) * 2u; }
    const size_t kstep = (size_t)(BK * 2);
    const size_t hA = (size_t)HALF * g.lda * 2, hB = (size_t)HALF * g.ldb * 2;
    const unsigned ldsw = (unsigned)wid * 1024u;
    const int aoff = lds_byte(wr * 64 + fr, fq * 8), boff = lds_byte(wc * 32 + fr, fq * 8);
#define PG8_SA(b, h) (((b) * 2 + (h)) * HTB)
#define PG8_SB(b, h) ((4 + (b) * 2 + (h)) * HTB)
#define PG8_STAGE(bufoff, gbase, voff) do { _Pragma("unroll") for (int _i = 0; _i < 2; ++_i) \
        __builtin_amdgcn_global_load_lds((const unsigned*)((const char*)(gbase) + (voff)[_i]), (LAS unsigned*)(lds + (bufoff) + ldsw + _i * 8192), 16, 0, 0); } while (0)
#define PG8_LDA(dst, b, h) do { _Pragma("unroll") for (int m = 0; m < 4; ++m) _Pragma("unroll") for (int k = 0; k < 2; ++k) dst[m][k] = *(const LAS bf16x8*)(lds + PG8_SA(b, h) + aoff + m * 2048 + k * 1024); } while (0)
#define PG8_LDB(dst, b, h) do { _Pragma("unroll") for (int n = 0; n < 2; ++n) _Pragma("unroll") for (int k = 0; k < 2; ++k) dst[n][k] = *(const LAS bf16x8*)(lds + PG8_SB(b, h) + boff + n * 2048 + k * 1024); } while (0)
#define PG8_MMA(ai, bj, At, Bt) do { __builtin_amdgcn_s_setprio(1); _Pragma("unroll") for (int m = 0; m < 4; ++m) _Pragma("unroll") for (int n = 0; n < 2; ++n) _Pragma("unroll") for (int k = 0; k < 2; ++k) \
        acc[ai][bj][m][n] = __builtin_amdgcn_mfma_f32_16x16x32_bf16(Bt[n][k], At[m][k], acc[ai][bj][m][n], 0, 0, 0); __builtin_amdgcn_s_setprio(0); } while (0)
#define PG8_WAIT_V(n) asm volatile("s_waitcnt vmcnt(" #n ")" ::: "memory")
#define PG8_WAIT_L(n) asm volatile("s_waitcnt lgkmcnt(" #n ")" ::: "memory")
#define PG8_BAR __builtin_amdgcn_s_barrier()
#define PG8_SCHED __builtin_amdgcn_sched_barrier(0)
    Unit cur, nxt; int ui = 0;
    if (!Sc.next(0, cur)) return;
    cur.ord = 0;
    Acc acc;
#pragma unroll
    for (int a = 0; a < 2; ++a)
#pragma unroll
        for (int b = 0; b < 2; ++b)
#pragma unroll
            for (int m = 0; m < 4; ++m)
#pragma unroll
                for (int n = 0; n < 2; ++n) acc[a][b][m][n] = (f32x4){0.f, 0.f, 0.f, 0.f};
    bf16x8 At[4][2], B0[2][2], B1[2][2];
    const char* cA = (const char*)g.A + ((size_t)cur.pm * BM * g.lda + cur.ak) * 2; const char* cB = (const char*)g.Bt + (size_t)cur.brow * g.ldb * 2;
    PG8_STAGE(PG8_SB(0, 0), cB, voffB); PG8_STAGE(PG8_SB(0, 1), cB + hB, voffB); PG8_STAGE(PG8_SA(0, 0), cA, voffA); PG8_STAGE(PG8_SA(0, 1), cA + hA, voffA);
    if (wr == 1) PG8_BAR;
    PG8_WAIT_V(2); PG8_BAR;
    PG8_STAGE(PG8_SB(1, 0), cB + kstep, voffB); PG8_STAGE(PG8_SA(1, 0), cA + kstep, voffA); PG8_STAGE(PG8_SB(1, 1), cB + hB + kstep, voffB);
    PG8_WAIT_V(6); PG8_BAR;
    for (;;) {
        const bool has_next = Sc.next(ui + 1, nxt); nxt.ord = ui + 1;
        const char* nA = has_next ? (const char*)g.A + ((size_t)nxt.pm * BM * g.lda + nxt.ak) * 2 : cA; const char* nB = has_next ? (const char*)g.Bt + (size_t)nxt.brow * g.ldb * 2 : cB;
        for (int t = 0; t < nt; t += 2) {
            const bool last = (t == nt - 2);
            const char* a1 = cA + (size_t)(t + 1) * kstep;
            const char* a2 = last ? nA : cA + (size_t)(t + 2) * kstep; const char* b2 = last ? nB : cB + (size_t)(t + 2) * kstep;
            const char* a3 = a2 + kstep; const char* b3 = b2 + kstep;
            PG8_LDB(B0, 0, 0); PG8_LDB(B1, 0, 1); PG8_SCHED; PG8_LDA(At, 0, 0); PG8_STAGE(PG8_SA(1, 1), a1 + hA, voffA);
            PG8_WAIT_V(8); PG8_WAIT_L(0); PG8_BAR; PG8_MMA(0, 0, At, B0); PG8_MMA(0, 1, At, B1); PG8_BAR; PG8_SCHED;
            PG8_LDA(At, 0, 1); PG8_STAGE(PG8_SB(0, 0), b2, voffB); PG8_STAGE(PG8_SB(0, 1), b2 + hB, voffB); PG8_STAGE(PG8_SA(0, 0), a2, voffA);
            PG8_WAIT_V(8); PG8_WAIT_L(0); PG8_BAR; PG8_MMA(1, 0, At, B0); PG8_MMA(1, 1, At, B1); PG8_BAR; PG8_SCHED;
            PG8_LDB(B0, 1, 0); PG8_LDB(B1, 1, 1); PG8_SCHED; PG8_LDA(At, 1, 0); PG8_STAGE(PG8_SA(0, 1), a2 + hA, voffA);
            PG8_WAIT_V(8); PG8_WAIT_L(0); PG8_BAR; PG8_MMA(0, 0, At, B0); PG8_MMA(0, 1, At, B1); PG8_BAR; PG8_SCHED;
            PG8_LDA(At, 1, 1); PG8_STAGE(PG8_SB(1, 0), b3, voffB); PG8_STAGE(PG8_SB(1, 1), b3 + hB, voffB); PG8_STAGE(PG8_SA(1, 0), a3, voffA);
            PG8_WAIT_V(8); PG8_WAIT_L(0); PG8_BAR; PG8_MMA(1, 0, At, B0); PG8_MMA(1, 1, At, B1); PG8_BAR; PG8_SCHED;
        }
        if constexpr (ALIGN_EPI) { if (wr == 0) PG8_BAR; }
        bool zero = true;
        if constexpr (!Epi::AFTER_DRAIN) { zero = E(acc, cur, wr, wc, fr, fq); }
        if (!has_next) break;
        if (zero) {
#pragma unroll
        for (int a = 0; a < 2; ++a)
#pragma unroll
            for (int b = 0; b < 2; ++b)
#pragma unroll
                for (int m = 0; m < 4; ++m)
#pragma unroll
                    for (int n = 0; n < 2; ++n) acc[a][b][m][n] = (f32x4){0.f, 0.f, 0.f, 0.f};
        }
        cur = nxt; cA = nA; cB = nB; ++ui;
        if constexpr (ALIGN_EPI) { if (wr == 1) PG8_BAR; }
    }
    PG8_WAIT_V(0);
    if constexpr (!ALIGN_EPI) { if (wr == 0) PG8_BAR; }
    PG8_BAR;
    if constexpr (Epi::AFTER_DRAIN) { E.fused(acc, cur, wr, wc, fr, fq, lds, wid, lane, tid); }
#undef PG8_SA
#undef PG8_SB
#undef PG8_STAGE
#undef PG8_LDA
#undef PG8_LDB
#undef PG8_MMA
#undef PG8_WAIT_V
#undef PG8_WAIT_L
#undef PG8_BAR
#undef PG8_SCHED
}
}

constexpr size_t MiB = 1u << 20;
constexpr size_t al256(size_t x) { return (x + 255) & ~(size_t)255; }
constexpr size_t WS_CTL = 0, CTL_ZERO_BYTES = 1 * MiB;
constexpr size_t WS_PRM = 1 * MiB;
constexpr int P_N1 = 0, P_N2 = 2048, P_GN = 4096, P_CW = 4608, P_CB = 8704, P_DTB = 9728, P_ALOG = 9736, P_SD = 9744, P_SNW = 9760, P_QNW = 10272, P_KNW = 10464, P_MU = 10656,
              P_W0 = 12448, P_A0 = 12960, P_V0 = 13472, P_KK = 13984, P_KA = 14496, P_RK = 15008, P_LNW = 15520, P_LNB = 16032, PRM_STRIDE = 16640;
constexpr size_t WS_COSR = 2 * MiB;
constexpr size_t WS_SINR = WS_COSR + (size_t)S * 64 * 4;
constexpr size_t WS_COSM = WS_SINR + (size_t)S * 64 * 4;
constexpr size_t WS_SINM = WS_COSM + (size_t)S * 32 * 4;
constexpr size_t WS_WIN  = WS_SINM + (size_t)S * 32 * 4;
constexpr size_t WS_WQB  = WS_WIN + (size_t)DEPTH * NINP * D * 2;
constexpr size_t WS_WKVB = WS_WQB + (size_t)DEPTH * 1024 * 512 * 2;
constexpr size_t WS_WV1  = WS_WKVB + (size_t)DEPTH * 1024 * 256 * 2;
constexpr size_t WS_WLORA = WS_WV1 + (size_t)DEPTH * 256 * 512 * 2;
constexpr size_t WS_WBR  = WS_WLORA + (size_t)DEPTH * 2048 * 512 * 2;
constexpr size_t WS_WOUT = WS_WBR + (size_t)DEPTH * 8192 * 512 * 2;
constexpr size_t WS_WGU  = WS_WOUT + (size_t)DEPTH * D * D * 2;
constexpr size_t WS_WDN  = WS_WGU + (size_t)DEPTH * 2 * DFF * D * 2;
constexpr size_t WS_ACT0 = WS_WDN + (size_t)DEPTH * D * DFF * 2;
constexpr size_t WS_XN   = WS_ACT0;
constexpr size_t WS_QR   = WS_XN + (size_t)S * D * 2;
constexpr size_t WS_KR   = WS_QR + (size_t)S * 512 * 2;
constexpr size_t WS_VR   = WS_KR + (size_t)S * 512 * 2;
constexpr size_t WS_GR   = WS_VR + (size_t)S * 512 * 2;
constexpr size_t WS_ZS   = WS_GR + (size_t)S * 512 * 2;
constexpr size_t WS_XBC  = WS_ZS + (size_t)S * 512 * 2;
constexpr size_t WS_XC   = WS_XBC + (size_t)S * 1024 * 2;
constexpr size_t WS_CQ   = WS_XC + (size_t)S * 1024 * 2;
constexpr size_t WS_CKV  = WS_CQ + (size_t)S * 512 * 2;
constexpr size_t WS_SSQ  = WS_CKV + (size_t)S * 256 * 2;
constexpr size_t WS_RW   = WS_SSQ + (size_t)S * 16 * 4;
constexpr size_t WS_GATE = WS_RW + (size_t)S * 1792 * 4;
constexpr size_t WS_MISC = WS_GATE + (size_t)S * 8192 * 2;
constexpr size_t WS_DTS  = WS_MISC + (size_t)S * 256 * 4;
constexpr size_t WS_ACS  = WS_DTS + (size_t)S * 8 * 4;
constexpr size_t WS_RKV  = WS_ACS + (size_t)S * 8 * 4;
constexpr size_t WS_MST  = WS_RKV + (size_t)NCH * 4 * 128 * 128 * 4;
constexpr size_t WS_QM   = WS_MST + (size_t)NCH * 8 * 64 * 128 * 4;
constexpr size_t WS_KM   = WS_QM + (size_t)S * 768 * 2;
constexpr size_t WS_VT   = WS_KM + (size_t)S * 768 * 2;
constexpr size_t WS_R32  = WS_VT + (size_t)512 * S * 2;
constexpr size_t SZ32    = (size_t)S * 512 * 4;
constexpr size_t WS_KKN  = WS_R32 + SZ32, WS_K32 = WS_KKN + SZ32, WS_VV = WS_K32 + SZ32, WS_VFIRST = WS_VV + SZ32, WS_DEC = WS_VFIRST + SZ32,
                 WS_KP = WS_DEC + SZ32, WS_BB = WS_KP + SZ32, WS_G32 = WS_BB + SZ32, WS_Y32 = WS_G32 + SZ32;
constexpr size_t WS_VB   = WS_Y32 + SZ32;
constexpr size_t WS_ALORA = WS_VB + (size_t)S * 512 * 2;
constexpr size_t WS_OB   = WS_ALORA + (size_t)S * 512 * 2;
constexpr size_t WS_MERGED = WS_OB + (size_t)S * D * 2;
constexpr size_t WS_ACT  = WS_MERGED + (size_t)S * D * 2;
constexpr size_t WS_END  = WS_ACT + (size_t)S * DFF * 2;

constexpr int CW_TMO = 0, CW_CODE = 1, CW_BAR = 4096;


constexpr int NWAVES = 8, NTHR = 512;
constexpr int RING_BYTES = 143360, LDSCTL_OFF = RING_BYTES, MISC_OFF = LDSCTL_OFF + 320, LDS_BYTES = 147456;
#define LDS_WAIT() asm volatile("s_waitcnt lgkmcnt(0)" ::: "memory")
#define VM_WAIT() asm volatile("s_waitcnt vmcnt(0)" ::: "memory")

#define XB_TMO      128
#define XB_XCNT(j)  (256  + 64 * (j))
#define XB_XSUB(j)  (1280 + 64 * (j))
#define XB_XGEN(j)  (2304 + 64 * (j))
#define XB_TOP      3328
#define XB_TOPGEN   3392
#define XCD_BAR_WORDS 3456
#define XB_SPIN_CAP (1u << 22)
DI unsigned xb_ld(unsigned* p)              { return __hip_atomic_load(p, __ATOMIC_RELAXED, __HIP_MEMORY_SCOPE_AGENT); }
DI unsigned xb_add(unsigned* p, unsigned v) { return __hip_atomic_fetch_add(p, v, __ATOMIC_RELAXED, __HIP_MEMORY_SCOPE_AGENT); }
DI unsigned xb_xcc_id() { return (unsigned)__builtin_amdgcn_s_getreg((3 << 11) | 20) & 0xFu; }
#define XB_SPIN(cond, bar) do { unsigned _sp = 0; while (cond) { __builtin_amdgcn_s_sleep(1); \
    if ((++_sp & 255u) == 0u) { if (xb_ld(&(bar)[XB_TMO])) break; if (_sp > XB_SPIN_CAP) { atomicAdd(&(bar)[XB_TMO], 1u); break; } } } } while (0)
struct XcdBarrier { unsigned* bar; unsigned x; volatile LAS unsigned* st; };
DI XcdBarrier xcd_barrier_post(unsigned* bar, volatile LAS unsigned* st) {
    XcdBarrier b; b.bar = bar; b.x = xb_xcc_id(); b.st = st;
    if (threadIdx.x == 0) (void)xb_add(&bar[XB_XCNT(b.x)], 1u);
    return b;
}
DI void xcd_barrier_complete(unsigned* bar, unsigned x, unsigned& nloc, unsigned& nx) {
    const unsigned G = gridDim.x * gridDim.y * gridDim.z;
    unsigned sum, cnt, mine, sp = 0u;
    for (;;) {
        sum = 0u; cnt = 0u; mine = 0u;
#pragma unroll
        for (unsigned j = 0; j < 16; ++j) { const unsigned c = xb_ld(&bar[XB_XCNT(j)]); sum += c; cnt += (c > 0u) ? 1u : 0u; mine = (j == x) ? c : mine; }
        if (sum == G) break;
        __builtin_amdgcn_s_sleep(1);
        if ((++sp & 255u) == 0u) { if (xb_ld(&bar[XB_TMO])) break; if (sp > XB_SPIN_CAP) { atomicAdd(&bar[XB_TMO], 1u); break; } }
    }
    nloc = mine > 0u ? mine : 1u; nx = cnt > 0u ? cnt : 1u;
}
DI void xcd_barrier(const XcdBarrier& b) {
    asm volatile("s_waitcnt vmcnt(0)" ::: "memory");
    __syncthreads();
    if (threadIdx.x == 0) {
        unsigned* bar = b.bar;
        __builtin_amdgcn_s_waitcnt(0);
        unsigned nloc = b.st[0], nx = b.st[1];
        if (nloc == 0u) { xcd_barrier_complete(bar, b.x, nloc, nx); b.st[0] = nloc; b.st[1] = nx; }
        const unsigned old = xb_add(&bar[XB_XSUB(b.x)], 1u);
        const unsigned gen = old / nloc;
        if (old + 1u == (gen + 1u) * nloc) {
            __builtin_amdgcn_fence(__ATOMIC_RELEASE, "agent");
            asm volatile("s_waitcnt vmcnt(0)" ::: "memory");
            const unsigned og = xb_add(&bar[XB_TOP], 1u);
            const unsigned tg = og / nx;
            if (og + 1u == (tg + 1u) * nx) xb_add(&bar[XB_TOPGEN], 1u);
            else XB_SPIN(xb_ld(&bar[XB_TOPGEN]) == tg, bar);
            __builtin_amdgcn_fence(__ATOMIC_ACQUIRE, "agent");
            xb_add(&bar[XB_XGEN(b.x)], 1u);
            asm volatile("s_waitcnt vmcnt(0)" ::: "memory");
        } else {
            XB_SPIN(xb_ld(&bar[XB_XGEN(b.x)]) == gen, bar);
            __builtin_amdgcn_fence(__ATOMIC_ACQUIRE, "agent");
            asm volatile("s_waitcnt vmcnt(0)" ::: "memory");
        }
    }
    __syncthreads();
}

struct Args { const float* in[36]; float* out; unsigned char* ws; int st_lo, st_hi; };
struct Frame {
    LAS unsigned char* lds; volatile LAS unsigned* MISC; gu32* ctl;
    int tid, lane, wave, G, bid;
    unsigned char* ws;
};
DI void relaunder(Frame& F, unsigned char* ws0, LAS unsigned char* lds0) {
    int t = threadIdx.x; asm volatile("" : "+v"(t)); F.tid = t; F.lane = t & 63; F.wave = __builtin_amdgcn_readfirstlane(t >> 6);
    unsigned long long w = (unsigned long long)ws0; asm volatile("" : "+s"(w)); F.ws = (unsigned char*)w; F.ctl = (gu32*)(F.ws + WS_CTL);
    unsigned lb = (unsigned)(unsigned long)lds0; asm volatile("" : "+s"(lb)); F.lds = (LAS unsigned char*)(unsigned long)lb; F.MISC = (volatile LAS unsigned*)(F.lds + MISC_OFF);
    int b = blockIdx.x; asm volatile("" : "+s"(b)); F.bid = b;
}
#define XR_SWAP(INS, a, b) asm volatile("s_nop 1\n\t" INS " %0, %1" : "+v"(a), "+v"(b))
DI float xr16_max(float x) { float a = x, b = x; XR_SWAP("v_permlane16_swap_b32", a, b); return fmaxf(a, b); }
DI float xr32_max(float x) { float a = x, b = x; XR_SWAP("v_permlane32_swap_b32", a, b); return fmaxf(a, b); }
DI float xr16_sum(float x) { float a = x, b = x; XR_SWAP("v_permlane16_swap_b32", a, b); return a + b; }
DI float xr32_sum(float x) { float a = x, b = x; XR_SWAP("v_permlane32_swap_b32", a, b); return a + b; }
template <int CTRL> DI float dpp_f(float v) { return __builtin_bit_cast(float, __builtin_amdgcn_update_dpp(0, __builtin_bit_cast(int, v), CTRL, 0xf, 0xf, true)); }
DI float row_sum8(float v) { v += dpp_f<0xB1>(v); v += dpp_f<0x4E>(v); v += dpp_f<0x141>(v); return v; }
DI float row_sum16(float v) { v += dpp_f<0xB1>(v); v += dpp_f<0x4E>(v); v += dpp_f<0x141>(v); v += dpp_f<0x140>(v); return v; }
DI float wave_sum(float v) { return xr32_sum(xr16_sum(row_sum16(v))); }
DI float wave_sum_dpp(float v) {
    const float t = row_sum16(v);
    const float s0 = __builtin_bit_cast(float, __builtin_amdgcn_readlane(__builtin_bit_cast(int, t), 0));
    const float s1 = __builtin_bit_cast(float, __builtin_amdgcn_readlane(__builtin_bit_cast(int, t), 16));
    const float s2 = __builtin_bit_cast(float, __builtin_amdgcn_readlane(__builtin_bit_cast(int, t), 32));
    const float s3 = __builtin_bit_cast(float, __builtin_amdgcn_readlane(__builtin_bit_cast(int, t), 48));
    return (s0 + s1) + (s2 + s3);
}
constexpr size_t WS_QYT = WS_END;
constexpr size_t WS_CYT = WS_QYT + (size_t)1024 * 4096 * 2;
constexpr size_t WS_TST = WS_CYT + (size_t)1024 * 4096 * 2;
constexpr size_t WS_NST = WS_TST + (size_t)1024 * 4096 * 2;
constexpr size_t WS_S0  = WS_NST + (size_t)1024 * 4096 * 4;
constexpr size_t WS_END2 = WS_S0 + (size_t)1024 * 4096 * 2;
constexpr int ATT_NSUB = 576, ATT_RUN = 16;
constexpr size_t WS_ATAB = WS_END2;
constexpr size_t WS_APO  = WS_ATAB + 8192;
constexpr size_t WS_APM  = WS_APO + (size_t)ATT_NSUB * 32768 * 4;
constexpr size_t WS_RSSA = WS_APM + (size_t)ATT_NSUB * 512 * 4;
constexpr size_t WS_RSSB = WS_RSSA + (size_t)S * 32 * 4;
constexpr size_t WS_END3 = WS_RSSB + (size_t)S * 32 * 4;
constexpr int RTAB_OFF = 131072;
DI int att_slot(int h, int qb, int s) { const int g = qb >> 2; return h * 144 + (g + 1) * (qb - 2 * g) + s; }

DI int map_in(int n) {
    const int T = n >> 8, c = n & 255;
    if (T < 4) { const int base = (T >> 1) * 512, tp = T & 1, half = c >> 7, hs = (c >> 6) & 1, j = c & 63; return base + (2 * tp + hs) * 128 + half * 64 + j; }
    if (T < 6) return 1024 + (T - 4) * 256 + c;
    if (T < 8) return 1536 + (T - 6) * 256 + c;
    if (T < 10) return 2048 + (T - 8) * 256 + c;
    if (T < 14) return 2560 + (T - 10) * 256 + c;
    if (T < 16) return 3592 + (T - 14) * 256 + c;
    if (T == 16) return 4104 + c;
    if (T < 24) return 4424 + (T - 17) * 256 + c;
    if (T < 56) {
        const int j = T - 24, bj = c >> 7, wc = (c >> 5) & 3, fq = (c >> 3) & 3, n = (c >> 2) & 1, i = c & 3; return 6216 + (2 * bj + n) * 2048 + 64 * j + wc * 16 + fq * 4 + i; }
    if (c < 8) return 3584 + c;
    if (c < 72) return 4360 + (c - 8);
    return -1;
}
DI int map_fn(int mapid, int n, int Nsrc) {
    if (mapid == 0) return n < Nsrc ? n : -1;
    if (mapid == 1) return map_in(n);
    if (mapid == 2) { const int T = n >> 8, c = n & 255; return c < 128 ? T * 128 + c : DFF + T * 128 + (c - 128); }
    if (mapid == 3) { const int h = n >> 8, c = n & 255; if (c < 96) return h * 192 + c; if (c < 128) return h * 192 + 128 + (c - 96); if (c < 160) return h * 192 + 96 + (c - 128); if (c < 224) return -1; return h * 192 + 160 + (c - 224); }
    return n < 32 ? n : -1;
}
DI void conv_item(const float* W, int K, int Nsrc, bf16* Wt, const float* kscale, int mapid, LAS bf16* tile, int item, int nblk, int lane) {
    const int kb = item / nblk, nb = item - kb * nblk, k0 = 64 * kb, n0 = 64 * nb;
    const int src = map_fn(mapid, n0 + lane, Nsrc);
    const float* wp = W + (size_t)k0 * Nsrc + (src >= 0 ? src : 0);
    float v[64];
#pragma unroll
    for (int i = 0; i < 64; ++i) v[i] = wp[(size_t)i * Nsrc];
    if (src < 0) {
#pragma unroll
        for (int i = 0; i < 64; ++i) v[i] = 0.f; }
    if (kscale) {
#pragma unroll
        for (int i = 0; i < 64; ++i) v[i] *= kscale[k0 + i]; }
#pragma unroll
    for (int q = 0; q < 8; ++q) { u32x4 o; o.x = pk2(v[8 * q], v[8 * q + 1]); o.y = pk2(v[8 * q + 2], v[8 * q + 3]); o.z = pk2(v[8 * q + 4], v[8 * q + 5]); o.w = pk2(v[8 * q + 6], v[8 * q + 7]);
        *(LAS u32x4*)(tile + lane * 72 + 8 * q) = o; }
    LDS_WAIT(); asm volatile("" ::: "memory");
#pragma unroll
    for (int i = 0; i < 8; ++i) { const int r = i * 8 + (lane >> 3), c8 = lane & 7;
        *(GAS u32x4*)(Wt + (size_t)(n0 + r) * K + k0 + 8 * c8) = *(const LAS u32x4*)(tile + r * 72 + 8 * c8); }
    LDS_WAIT(); asm volatile("" ::: "memory");
}
struct ConvJob { const float* W; bf16* Wt; const float* kscale; int K, Nsrc, Ndst, mapid; };
DI void conv_job(Frame& F, const ConvJob j, int& base) {
    const int nblk = j.Ndst / 64, nitems = (j.K / 64) * nblk, NGW = F.G * NWAVES, gw = F.bid * NWAVES + F.wave;
    int first = (gw - base % NGW + NGW) % NGW; LAS bf16* tile = (LAS bf16*)(F.lds + F.wave * 16384);
    for (int it = first; it < nitems; it += NGW) conv_item(j.W, j.K, j.Nsrc, j.Wt, j.kscale, j.mapid, tile, it, nblk, F.lane);
    base += nitems;
}
DI void p_prologue(Frame& F, const Args& a) {
    unsigned char* ws = F.ws;
    const int gt = F.bid * NTHR + F.tid, NGT = F.G * NTHR;
    if (F.bid == 0 && F.tid == 0) { int* tab = (int*)(ws + WS_ATAB); int n = 0;
        for (int pass = 16; pass >= 4; pass -= 4)
            for (int qb = 31; qb >= 0; --qb) { const int nt = 4 * (qb + 1), nfull = nt >> 4, rem = nt & 15;
                for (int h = 0; h < 4; ++h) {
                    if (pass == 16) { for (int s2 = 0; s2 < nfull; ++s2) tab[n++] = h | (qb << 2) | (s2 << 7) | (16 << 12); }
                    else if (rem == pass) tab[n++] = h | (qb << 2) | (nfull << 7) | (rem << 12); } }
        for (; n < 2048; ++n) tab[n] = 0; }
    { float* prm = (float*)(ws + WS_PRM);
#define CPV(IDX, N, OFF, SRC_L) for (int e = gt; e < (N); e += NGT) prm[(size_t)l * PRM_STRIDE + (OFF) + e] = a.in[IDX][(size_t)(SRC_L) * (N) + e];
      for (int l = 0; l < DEPTH; ++l) {
          CPV(2, 2048, P_N1, l) CPV(33, 2048, P_N2, l) CPV(4, 512, P_GN, l) CPV(5, 4096, P_CW, l) CPV(6, 1024, P_CB, l) CPV(7, 8, P_DTB, l) CPV(8, 8, P_ALOG, l) CPV(9, 8, P_SD, l)
          CPV(10, 512, P_SNW, l) CPV(15, 192, P_QNW, l) CPV(16, 192, P_KNW, l) CPV(17, 1792, P_MU, l) CPV(18, 512, P_W0, l) CPV(20, 512, P_A0, l)
          CPV(23, 512, P_V0, (l > 0 ? l - 1 : 0)) CPV(26, 512, P_KK, l) CPV(27, 512, P_KA, l) CPV(28, 512, P_RK, l) CPV(29, 512, P_LNW, l) CPV(30, 512, P_LNB, l)
      }
#undef CPV
    }
    const int* pos = (const int*)a.in[1];
    for (int e = gt; e < S * 64; e += NGT) { const int t = e >> 6, i = e & 63;
        const float inv = 1.0f / powf(10000.0f, (float)(2 * i) / 128.0f); const float ang = (float)pos[t] * inv;
        double rev = (double)ang * 0.15915494309189535; rev -= rint(rev); const float r = (float)(rev * 6.283185307179586);
        ((float*)(ws + WS_COSR))[e] = __cosf(r); ((float*)(ws + WS_SINR))[e] = __sinf(r); }
    for (int e = gt; e < S * 32; e += NGT) { const int t = e >> 5, i = e & 31;
        const float inv = 1.0f / powf(10000.0f, (float)(2 * i) / 64.0f); const float ang = (float)pos[t] * inv;
        double rev = (double)ang * 0.15915494309189535; rev -= rint(rev); const float r = (float)(rev * 6.283185307179586);
        ((float*)(ws + WS_COSM))[e] = __cosf(r); ((float*)(ws + WS_SINM))[e] = __sinf(r); }
    for (int l = 0; l < DEPTH; ++l) {
        const float* w2 = a.in[19] + (size_t)l * 64 * 512; const float* a2 = a.in[21] + (size_t)l * 64 * 512; const float* g2 = a.in[22] + (size_t)l * 128 * 512;
        const float* v2 = a.in[25] + (size_t)(l > 0 ? l - 1 : 0) * 32 * 512;
        bf16* Lt = (bf16*)(ws + WS_WLORA) + (size_t)l * 2048 * 512;
        for (int w = gt; w < 2048 * 64; w += NGT) { const int kg = w >> 11, n = w & 2047, seg = n >> 9, j = n & 511; float v[8];
#pragma unroll
            for (int i = 0; i < 8; ++i) { const int k = kg * 8 + i; float x = 0.f;
                if (seg == 0) { if (k < 64) x = w2[k * 512 + j]; }
                else if (seg == 1) { if (k >= 128 && k < 192) x = a2[(k - 128) * 512 + j]; }
                else if (seg == 2) { if (k >= 256 && k < 384) x = g2[(k - 256) * 512 + j]; }
                else { if (l > 0 && k >= 384 && k < 416) x = v2[(k - 384) * 512 + j]; }
                v[i] = x; }
            u32x4 o; o.x = pk2(v[0], v[1]); o.y = pk2(v[2], v[3]); o.z = pk2(v[4], v[5]); o.w = pk2(v[6], v[7]);
            *(GAS u32x4*)(Lt + (size_t)n * 512 + kg * 8) = o; }
    }
    { const int gw = F.bid * NWAVES + F.wave, NGW = F.G * NWAVES; float* rss = (float*)(ws + WS_RSSA);
      for (int m = gw; m < S; m += NGW) { const GAS f32x4* xr = (const GAS f32x4*)(a.in[0] + (size_t)m * D) + F.lane; GAS u32x2* o8 = (GAS u32x2*)((bf16*)(ws + WS_XN) + (size_t)m * D) + F.lane; float sq = 0.f;
#pragma unroll
          for (int j = 0; j < 8; ++j) { const f32x4 v = xr[64 * j]; sq += (v.x * v.x + v.y * v.y) + (v.z * v.z + v.w * v.w); u32x2 o; o.x = pk2(v.x, v.y); o.y = pk2(v.z, v.w); o8[64 * j] = o; }
          sq = wave_sum(sq); if (F.lane < 32) rss[(size_t)m * 32 + F.lane] = (F.lane == 0) ? sq : 0.f; } }
    int base = 0;
    for (int l = 0; l < DEPTH; ++l) {
        conv_job(F, ConvJob{a.in[3] + (size_t)l * D * NIN, (bf16*)(ws + WS_WIN) + (size_t)l * NINP * D, a.in[2] + (size_t)l * D, D, NIN, NINP, 1}, base);
        conv_job(F, ConvJob{a.in[34] + (size_t)l * D * 2 * DFF, (bf16*)(ws + WS_WGU) + (size_t)l * 2 * DFF * D, a.in[33] + (size_t)l * D, D, 2 * DFF, 2 * DFF, 2}, base);
        conv_job(F, ConvJob{a.in[35] + (size_t)l * DFF * D, (bf16*)(ws + WS_WDN) + (size_t)l * D * DFF, nullptr, DFF, D, D, 0}, base);
        conv_job(F, ConvJob{a.in[32] + (size_t)l * D * D, (bf16*)(ws + WS_WOUT) + (size_t)l * D * D, nullptr, D, D, D, 0}, base);
        for (int n = 0; n < 4; ++n)
            conv_job(F, ConvJob{a.in[31] + ((size_t)l * 4 + n) * 512 * D, (bf16*)(ws + WS_WBR) + ((size_t)l * 4 + n) * D * 512, nullptr, 512, D, D, 0}, base);
        conv_job(F, ConvJob{a.in[12] + (size_t)l * 512 * 768, (bf16*)(ws + WS_WQB) + (size_t)l * 1024 * 512, a.in[11] + (size_t)l * 512, 512, 768, 1024, 3}, base);
        conv_job(F, ConvJob{a.in[14] + (size_t)l * 256 * 1024, (bf16*)(ws + WS_WKVB) + (size_t)l * 1024 * 256, a.in[13] + (size_t)l * 256, 256, 1024, 1024, 0}, base);
        if (l > 0) conv_job(F, ConvJob{a.in[24] + (size_t)(l - 1) * 512 * 32, (bf16*)(ws + WS_WV1) + (size_t)l * 256 * 512, nullptr, 512, 32, 256, 4}, base);
    }
}

DI void p_rmsnorm(Frame& F, const float* x, const float* w, bf16* out) {
    const int gw = F.bid * NWAVES + F.wave, NGW = F.G * NWAVES;
    for (int m = gw; m < S; m += NGW) {
        const GAS f32x4* xr = (const GAS f32x4*)(x + (size_t)m * D) + F.lane; f32x4 v[8]; float s = 0.f;
#pragma unroll
        for (int j = 0; j < 8; ++j) { v[j] = xr[64 * j]; s += (v[j].x * v[j].x + v[j].y * v[j].y) + (v[j].z * v[j].z + v[j].w * v[j].w); }
        const float rstd = rsqrtf(wave_sum(s) * (1.f / D) + 1e-6f);
        const GAS f32x4* wr = (const GAS f32x4*)w + F.lane;
        GAS u32x2* o8 = (GAS u32x2*)(out + (size_t)m * D) + F.lane;
#pragma unroll
        for (int j = 0; j < 8; ++j) { const f32x4 ww = wr[64 * j]; u32x2 o; o.x = pk2(v[j].x * rstd * ww.x, v[j].y * rstd * ww.y); o.y = pk2(v[j].z * rstd * ww.z, v[j].w * rstd * ww.w); o8[64 * j] = o; }
    }
}

DI f32x4 bf4_(const u32x2 w) { return (f32x4){bf2f(w.x & 0xffffu), bf2f(w.x >> 16), bf2f(w.y & 0xffffu), bf2f(w.y >> 16)}; }
DI u32x2 pk4_(const f32x4 v) { u32x2 o; o.x = pk2(v.x, v.y); o.y = pk2(v.z, v.w); return o; }
DI void p_rwkv_prep(Frame& F, int l) {
    unsigned char* ws = F.ws;
    const bf16* RW = (const bf16*)(ws + WS_RW); const float* prm = (const float*)(ws + WS_PRM) + (size_t)l * PRM_STRIDE; const float* mu = prm + P_MU; const float* kk_w = prm + P_KK;
    const int gw = F.bid * NWAVES + F.wave, NGW = F.G * NWAVES, lane = F.lane;
    for (int t = gw; t < S; t += NGW) {
        const GAS u32x2* p = (const GAS u32x2*)(RW + (size_t)t * 1792) + lane; const GAS u32x2* pp = (const GAS u32x2*)(RW + (size_t)(t > 0 ? t - 1 : 0) * 1792) + lane;
        const GAS f32x4* m4 = (const GAS f32x4*)mu + lane;
        f32x4 pm[7];
#pragma unroll
        for (int j = 0; j < 7; ++j) { const f32x4 c = bf4_(p[64 * j]); f32x4 pv = bf4_(pp[64 * j]); if (t == 0) pv = (f32x4){0.f, 0.f, 0.f, 0.f}; pm[j] = c + (pv - c) * m4[64 * j]; }
        const size_t ro = (size_t)t * 512;
        *((GAS u32x2*)((bf16*)(ws + WS_R32) + ro) + lane) = pk4_(pm[0]); *((GAS u32x2*)((bf16*)(ws + WS_R32) + ro) + 64 + lane) = pk4_(pm[1]);
#pragma unroll
        for (int j = 0; j < 2; ++j) { const f32x4 k = pm[2 + j]; const f32x4 kw = *((const GAS f32x4*)kk_w + 64 * j + lane); const f32x4 kk = k * kw;
            float ss = (kk.x * kk.x + kk.y * kk.y) + (kk.z * kk.z + kk.w * kk.w);
            ss = row_sum16(ss);
            const float inv = fminf(__builtin_amdgcn_rsqf(ss), 1e12f);
            *((GAS u32x2*)((bf16*)(ws + WS_K32) + ro) + 64 * j + lane) = pk4_(k);
            *((GAS u32x2*)((bf16*)(ws + WS_KKN) + ro) + 64 * j + lane) = pk4_(kk * inv); }
#pragma unroll
        for (int j = 0; j < 2; ++j) { const u32x2 vb = pk4_(pm[4 + j]);
            *((GAS u32x2*)((bf16*)(ws + WS_VV) + ro) + 64 * j + lane) = vb;
            if (l == 0) *((GAS u32x2*)((bf16*)(ws + WS_VFIRST) + ro) + 64 * j + lane) = vb; }
        { const f32x4 x = pm[6]; f32x4 y; int dst;
            if (lane < 16) { y = (f32x4){ftanh_(x.x), ftanh_(x.y), ftanh_(x.z), ftanh_(x.w)}; dst = 4 * lane; }
            else if (lane < 32) { y = x; dst = 128 + 4 * (lane - 16); }
            else { y = (f32x4){sigmoidf_(x.x), sigmoidf_(x.y), sigmoidf_(x.z), sigmoidf_(x.w)}; dst = 256 + 4 * (lane - 32); }
            bf16* ar = (bf16*)(ws + WS_ALORA) + (size_t)t * 512;
            *(GAS u32x2*)(ar + dst) = pk4_(y);
            const int z = 4 * lane; const int zd = z < 64 ? 64 + z : (z < 128 ? 192 + (z - 64) : 384 + (z - 128));
            unsigned zz = 0u; asm volatile("" : "+v"(zz));
            *(GAS u32x2*)(ar + zd) = (u32x2){zz, zz}; }
    }
}

DI void p_mamba_prep(Frame& F, int l) {
    unsigned char* ws = F.ws;
    const bf16* XBC = (const bf16*)(ws + WS_XBC); bf16* XC = (bf16*)(ws + WS_XC);
    const float* prm = (const float*)(ws + WS_PRM) + (size_t)l * PRM_STRIDE; const float* cw = prm + P_CW; const float* cb = prm + P_CB;
    for (int u = F.bid; u < 2 * NCH; u += F.G) {
        const int ch = 2 * F.tid, t0 = (u >> 1) * 64 + (u & 1) * 32;
        float w0[4], w1[4];
#pragma unroll
        for (int k = 0; k < 4; ++k) { const f32x2 wv = *(const GAS f32x2*)(cw + k * 1024 + ch); w0[k] = wv.x; w1[k] = wv.y; }
        const f32x2 bv = *(const GAS f32x2*)(cb + ch);
        float h0[3], h1[3];
#pragma unroll
        for (int k = 0; k < 3; ++k) { const int t = t0 - 3 + k; unsigned x = 0u; if (t >= 0) x = *(const GAS unsigned*)(XBC + (size_t)t * 1024 + ch); h0[k] = bf2f(x & 0xffffu); h1[k] = bf2f(x >> 16); }
        unsigned xin[32];
#pragma unroll
        for (int i = 0; i < 32; ++i) xin[i] = *(const GAS unsigned*)(XBC + (size_t)(t0 + i) * 1024 + ch);
#pragma unroll
        for (int i = 0; i < 32; ++i) { const float x0 = bf2f(xin[i] & 0xffffu), x1 = bf2f(xin[i] >> 16);
            const float y0 = bv.x + w0[0] * h0[0] + w0[1] * h0[1] + w0[2] * h0[2] + w0[3] * x0, y1 = bv.y + w1[0] * h1[0] + w1[1] * h1[1] + w1[2] * h1[2] + w1[3] * x1;
            h0[0] = h0[1]; h0[1] = h0[2]; h0[2] = x0; h1[0] = h1[1]; h1[1] = h1[2]; h1[2] = x1;
            *(GAS unsigned*)(XC + (size_t)(t0 + i) * 1024 + ch) = pk2(siluf_(y0), siluf_(y1)); }
    }
}
DI void u_mamba_dt(Frame& F, int l, int c) {
    unsigned char* ws = F.ws; LAS float* A = (LAS float*)F.lds;
    const float* prm = (const float*)(ws + WS_PRM) + (size_t)l * PRM_STRIDE; const int t = F.tid >> 3, h = F.tid & 7; const size_t row = (size_t)(c * 64 + t);
    const float dt = softplusf_(((const float*)(ws + WS_MISC))[row * 256 + h] + prm[P_DTB + h]);
    A[F.tid] = dt * -fexp_(prm[P_ALOG + h]);
    ((float*)(ws + WS_DTS))[row * 8 + h] = dt;
    __syncthreads();
    float cs = 0.f;
#pragma unroll 16
    for (int tt = 0; tt < 64; ++tt) { const float v = A[tt * 8 + h]; cs += (tt <= t) ? v : 0.f; }
    ((float*)(ws + WS_ACS))[row * 8 + h] = cs;
    __syncthreads();
}

DI void p_scans(Frame& F, int nblk) {
    unsigned char* ws = F.ws;
    const int gt = F.bid * NTHR + F.tid, NGT = nblk * NTHR;
    for (int q = gt; q < 32768; q += NGT) {
        const int e = q * 4; const bool ret = e < 65536; const int e2 = ret ? e : e - 65536, h = ret ? (e >> 14) : (e2 >> 13);
        float* p = (float*)(ws + (ret ? WS_RKV : WS_MST)) + e2; const float* acs = (const float*)(ws + WS_ACS);
        const float rdec = fexp_(log1pf(-exp2f(-5.0f - (float)h)) * 64.0f);
        f32x4 st = (f32x4){0.f, 0.f, 0.f, 0.f};
#pragma unroll 1
        for (int c0 = 0; c0 < NCH; c0 += 16) { f32x4 v[16]; float dc[16];
#pragma unroll
            for (int i = 0; i < 16; ++i) v[i] = *(const GAS f32x4*)(p + (size_t)(c0 + i) * 65536);
#pragma unroll
            for (int i = 0; i < 16; ++i) dc[i] = ret ? rdec : fexp_(acs[(size_t)((c0 + i) * 64 + 63) * 8 + h]);
#pragma unroll
            for (int i = 0; i < 16; ++i) { *(GAS f32x4*)(p + (size_t)(c0 + i) * 65536) = st; st = st * dc[i] + v[i]; } }
    }
}


namespace pg8 {
DI unsigned char* lw(unsigned char* p) { unsigned long long w = (unsigned long long)p; asm volatile("" : "+s"(w)); return (unsigned char*)w; }
DI void st8bf(bf16* p, const f32x4 a, const f32x4 b) { *(GAS u32x4*)p = pack8(a, b); }
DI void st8f(float* p, const f32x4 a, const f32x4 b) { *(GAS f32x4*)p = a; *((GAS f32x4*)p + 1) = b; }
DI f32x4 map4(const f32x4 v, float (*f)(float)) { return (f32x4){f(v.x), f(v.y), f(v.z), f(v.w)}; }

DI void scale_rows(Acc& acc, const LAS float* rt, int rl0) {
#pragma unroll
    for (int ai = 0; ai < 2; ++ai)
#pragma unroll
        for (int m = 0; m < 4; ++m) { const float rs = rt[rl0 + ai * HALF + m * 16];
#pragma unroll
            for (int bj = 0; bj < 2; ++bj)
#pragma unroll
                for (int n = 0; n < 2; ++n) acc[ai][bj][m][n] = acc[ai][bj][m][n] * rs; }
}
template <class Sched> DI void fill_rstd(LAS float* rtab, const float* rss, const Sched& Sc, int tid) {
    pg8::Unit u;
    for (int i = 0; Sc.next(i, u); ++i) if (tid < 256) { const float* p = rss + (size_t)(u.pm * BM + tid) * 32; float s = 0.f;
#pragma unroll
        for (int q = 0; q < 8; ++q) { const f32x4 v = *(const GAS f32x4*)(p + 4 * q); s += (v.x + v.y) + (v.z + v.w); }
        rtab[i * 256 + tid] = rsqrtf(s * (1.f / D) + 1e-6f); }
    __syncthreads();
}
struct TileDesc { unsigned long long off; int ld, cb, kind, slot; };
constexpr TileDesc mk_tile(int T) {
    return T < 2 ? TileDesc{WS_QR, 512, 0, 0, 0} : T < 4 ? TileDesc{WS_KR, 512, 0, 1, 0}
         : T < 6 ? TileDesc{WS_VR, 512, (T - 4) * 256, 2, 0} : T < 8 ? TileDesc{WS_GR, 512, (T - 6) * 256, 3, 0} : T < 10 ? TileDesc{WS_ZS, 512, (T - 8) * 256, 3, 0}
         : T < 14 ? TileDesc{WS_XBC, 1024, (T - 10) * 256, 2, 0} : T < 16 ? TileDesc{WS_CQ, 512, (T - 14) * 256, 5, (T - 14) * 4} : T == 16 ? TileDesc{WS_CKV, 256, 0, 5, 8}
         : T < 24 ? TileDesc{WS_RW, 1792, (T - 17) * 256, 2, 0} : T < 56 ? TileDesc{WS_GATE, 8192, (T - 24) * 64, 7, 0} : TileDesc{WS_MISC, 256, 0, 6, 0};
}
struct TileTab { TileDesc d[57]; };
constexpr TileTab mk_tiletab() { TileTab t{}; for (int i = 0; i < 57; ++i) t.d[i] = mk_tile(i); return t; }
__constant__ TileTab g_tiletab = mk_tiletab();

struct EpiIn {
    static constexpr bool AFTER_DRAIN = false;
    unsigned char* ws_; int tile_off; const LAS float* rtab;
    DI bool operator()(Acc& acc, const Unit& u, int wr, int wc, int fr, int fq) const {
        unsigned char* ws = lw(ws_);
        const int T = u.pn + tile_off, row0 = u.pm * BM + wr * 64 + fr, c0 = wc * 32 + fq * 8;
        scale_rows(acc, rtab + u.ord * 256, wr * 64 + fr);
        const TileDesc d = g_tiletab.d[T]; const int kind = d.kind;
        if (kind < 2) {
            const int head = 2 * (T & 1) + (c0 >> 6), j0 = c0 & 63; const float sc = kind ? 0.08838834764831845f : 1.0f;
            bf16* dst = (bf16*)(ws + d.off); const float* cs = (const float*)(ws + WS_COSR); const float* sn = (const float*)(ws + WS_SINR);
#pragma unroll
            for (int ai = 0; ai < 2; ++ai)
#pragma unroll
                for (int m = 0; m < 4; ++m) { const int row = row0 + ai * HALF + m * 16;
                    const f32x4 ca = *(const GAS f32x4*)(cs + (size_t)row * 64 + j0), cb = *(const GAS f32x4*)(cs + (size_t)row * 64 + j0 + 4);
                    const f32x4 sa = *(const GAS f32x4*)(sn + (size_t)row * 64 + j0), sb = *(const GAS f32x4*)(sn + (size_t)row * 64 + j0 + 4);
                    const f32x4 x1a = acc[ai][0][m][0], x1b = acc[ai][0][m][1], x2a = acc[ai][1][m][0], x2b = acc[ai][1][m][1];
                    bf16* o = dst + (size_t)row * 512 + head * 128 + j0;
                    st8bf(o, (x1a * ca - x2a * sa) * sc, (x1b * cb - x2b * sb) * sc);
                    st8bf(o + 64, (x2a * ca + x1a * sa) * sc, (x2b * cb + x1b * sb) * sc); }
            return true;
        }
        if (kind == 7) {
            bf16* dst = (bf16*)(ws + d.off) + d.cb + wc * 16 + fq * 4;
#pragma unroll
            for (int ai = 0; ai < 2; ++ai)
#pragma unroll
                for (int m = 0; m < 4; ++m) { const size_t ro = (size_t)(row0 + ai * HALF + m * 16) * 8192; f32x4 sv[4], gv[4];
#pragma unroll
                    for (int nb = 0; nb < 4; ++nb) { const f32x4 x = acc[ai][nb >> 1][m][nb & 1];
#pragma unroll
                        for (int i = 0; i < 4; ++i) { const float sk = 1.0f + fminf(fexp_(-x[i]), 1e30f); sv[nb][i] = sk; gv[nb][i] = __builtin_amdgcn_rcpf(sk); } }
                    *(GAS u32x2*)(dst + ro) = pk4_(gv[0] * sv[1]); *(GAS u32x2*)(dst + ro + 2048) = pk4_(gv[1] * sv[2]);
                    *(GAS u32x2*)(dst + ro + 4096) = pk4_(gv[2] * sv[3]); *(GAS u32x2*)(dst + ro + 6144) = pk4_(gv[3]); }
            return true;
        }
        if (kind == 6) {
            float* dst = (float*)(ws + d.off) + d.cb + c0;
#pragma unroll
            for (int ai = 0; ai < 2; ++ai)
#pragma unroll
                for (int m = 0; m < 4; ++m) { const int row = row0 + ai * HALF + m * 16;
#pragma unroll
                    for (int bj = 0; bj < 2; ++bj) st8f(dst + (size_t)row * d.ld + bj * HALF, acc[ai][bj][m][0], acc[ai][bj][m][1]); }
            return true;
        }
        {
            bf16* dst = (bf16*)(ws + d.off) + d.cb + c0; float* ssq = (float*)(ws + WS_SSQ) + d.slot + wc;
            const float am = (kind == 3 || kind == 4) ? 1.f : 0.f, xm = (kind == 4) ? 0.f : 1.f;
#pragma unroll
            for (int ai = 0; ai < 2; ++ai)
#pragma unroll
                for (int m = 0; m < 4; ++m) { const int row = row0 + ai * HALF + m * 16; float ss = 0.f;
#pragma unroll
                    for (int bj = 0; bj < 2; ++bj) { f32x4 a = acc[ai][bj][m][0], b = acc[ai][bj][m][1];
                        ss += (a.x * a.x + a.y * a.y) + (a.z * a.z + a.w * a.w) + (b.x * b.x + b.y * b.y) + (b.z * b.z + b.w * b.w);
                        if (am != 0.f) {
#pragma unroll
                            for (int i = 0; i < 4; ++i) { const float s0 = sigmoidf_(a[i]), s1 = sigmoidf_(b[i]); a[i] = (xm != 0.f) ? a[i] * s0 : s0; b[i] = (xm != 0.f) ? b[i] * s1 : s1; } }
                        st8bf(dst + (size_t)row * d.ld + bj * HALF, a, b); }
                    if (kind == 5) { ss = xr32_sum(xr16_sum(ss)); if (fq == 0) ssq[(size_t)row * 16] = ss; } }
        }
        return true;
    }
};

struct EpiMisc {
    static constexpr bool AFTER_DRAIN = false;
    unsigned char* ws_; const LAS float* rtab;
    DI bool operator()(Acc& acc, const Unit& u, int wr, int wc, int fr, int fq) const {
        float* dst = (float*)(lw(ws_) + WS_MISC) + wc * 32 + fq * 8; const int row0 = u.pm * BM + wr * 64 + fr;
        scale_rows(acc, rtab + u.ord * 256, wr * 64 + fr);
#pragma unroll
        for (int ai = 0; ai < 2; ++ai)
#pragma unroll
            for (int m = 0; m < 4; ++m) { const int row = row0 + ai * HALF + m * 16;
#pragma unroll
                for (int bj = 0; bj < 2; ++bj) st8f(dst + (size_t)row * 256 + bj * HALF, acc[ai][bj][m][0], acc[ai][bj][m][1]); }
        return true;
    }
};

struct EpiQb {
    static constexpr bool AFTER_DRAIN = true;
    unsigned char* ws; const float* qnw;
    DI bool operator()(Acc&, const Unit&, int, int, int, int) const { return true; }
    DI void fused(Acc& acc, const Unit& u, int wr, int wc, int fr, int fq, LAS unsigned char* lds, int wid, int lane, int tid) const {
        const int h = u.pn, row0 = u.pm * BM + wr * 64 + fr, c0 = wc * 32 + fq * 8;
        const float* ssq = (const float*)(ws + WS_SSQ); LAS float* P = (LAS float*)lds;
        const float QS = 0.07216878364870322f * LOG2E;
#pragma unroll
        for (int ai = 0; ai < 2; ++ai)
#pragma unroll
            for (int m = 0; m < 4; ++m) { const int row = row0 + ai * HALF + m * 16, rl = ai * HALF + wr * 64 + m * 16 + fr;
                const f32x4 s0 = *(const GAS f32x4*)(ssq + (size_t)row * 16), s1 = *(const GAS f32x4*)(ssq + (size_t)row * 16 + 4);
                const float rs = rsqrtf(((s0.x + s0.y) + (s0.z + s0.w) + (s1.x + s1.y) + (s1.z + s1.w)) * (1.f / 512.f) + 1e-6f);
                float ss = 0.f;
#pragma unroll
                for (int bj = 0; bj < 2; ++bj)
#pragma unroll
                    for (int n = 0; n < 2; ++n) { f32x4 a = acc[ai][bj][m][n] * rs; acc[ai][bj][m][n] = a; ss += (a.x * a.x + a.y * a.y) + (a.z * a.z + a.w * a.w); }
                ss = xr32_sum(xr16_sum(ss));
                if (fq == 0) P[rl * 4 + wc] = ss; }
        __syncthreads();
        bf16* QM = (bf16*)(ws + WS_QM); const float* cs = (const float*)(ws + WS_COSM); const float* sn = (const float*)(ws + WS_SINM);
#pragma unroll
        for (int ai = 0; ai < 2; ++ai)
#pragma unroll
            for (int m = 0; m < 4; ++m) { const int row = row0 + ai * HALF + m * 16, rl = ai * HALF + wr * 64 + m * 16 + fr;
                const f32x4 pp = *(const LAS f32x4*)(P + rl * 4); const float rq = rsqrtf(((pp.x + pp.y) + (pp.z + pp.w)) * (1.f / 192.f) + 1e-6f) * QS;
                bf16* o = QM + (size_t)row * 768 + h * 192;
                if (wc < 3) {
                    const f32x4 wa = *(const GAS f32x4*)(qnw + c0), wb = *(const GAS f32x4*)(qnw + c0 + 4);
                    st8bf(o + c0, acc[ai][0][m][0] * rq * wa, acc[ai][0][m][1] * rq * wb);
                    if (wc == 0) { const f32x4 wc4 = *(const GAS f32x4*)(qnw + 96 + c0), wd = *(const GAS f32x4*)(qnw + 100 + c0);
                        st8bf(o + 96 + c0, acc[ai][1][m][0] * rq * wc4, acc[ai][1][m][1] * rq * wd); }
                } else {
                    const int i0 = 8 * fq;
                    const f32x4 w1a = *(const GAS f32x4*)(qnw + 128 + i0), w1b = *(const GAS f32x4*)(qnw + 132 + i0), w2a = *(const GAS f32x4*)(qnw + 160 + i0), w2b = *(const GAS f32x4*)(qnw + 164 + i0);
                    const f32x4 ca = *(const GAS f32x4*)(cs + (size_t)row * 32 + i0), cb = *(const GAS f32x4*)(cs + (size_t)row * 32 + i0 + 4), sa = *(const GAS f32x4*)(sn + (size_t)row * 32 + i0), sb = *(const GAS f32x4*)(sn + (size_t)row * 32 + i0 + 4);
                    const f32x4 x1a = acc[ai][0][m][0] * rq * w1a, x1b = acc[ai][0][m][1] * rq * w1b, x2a = acc[ai][1][m][0] * rq * w2a, x2b = acc[ai][1][m][1] * rq * w2b;
                    st8bf(o + 128 + i0, x1a * ca - x2a * sa, x1b * cb - x2b * sb);
                    st8bf(o + 160 + i0, x2a * ca + x1a * sa, x2b * cb + x1b * sb);
                } }
        __syncthreads();
    }
};

struct EpiKvb {
    static constexpr bool AFTER_DRAIN = true;
    unsigned char* ws; const float* knw;
    DI bool operator()(Acc&, const Unit&, int, int, int, int) const { return true; }
    DI void fused(Acc& acc, const Unit& u, int wr, int wc, int fr, int fq, LAS unsigned char* lds, int wid, int lane, int tid) const {
        const int h = u.pn, row0 = u.pm * BM + wr * 64 + fr, c0 = wc * 32 + fq * 8;
        const float* ssq = (const float*)(ws + WS_SSQ); const float* misc = (const float*)(ws + WS_MISC);
        LAS float* P = (LAS float*)lds; LAS float* KRS = P + 1024; LAS float* RK = P + 1280;
        LAS bf16* VTs = (LAS bf16*)(lds + 8192);
        if (tid < 256) { const float* kr = misc + (size_t)(u.pm * BM + tid) * 256 + 8; float s = 0.f;
#pragma unroll
            for (int i = 0; i < 16; ++i) { const f32x4 v = *(const GAS f32x4*)(kr + 4 * i); s += (v.x * v.x + v.y * v.y) + (v.z * v.z + v.w * v.w); }
            KRS[tid] = s; }
#pragma unroll
        for (int ai = 0; ai < 2; ++ai)
#pragma unroll
            for (int m = 0; m < 4; ++m) { const int row = row0 + ai * HALF + m * 16, rl = ai * HALF + wr * 64 + m * 16 + fr;
                const f32x4 s0 = *(const GAS f32x4*)(ssq + (size_t)row * 16 + 8);
                const float rs = rsqrtf(((s0.x + s0.y) + (s0.z + s0.w)) * (1.f / 256.f) + 1e-6f);
                float ss = 0.f;
#pragma unroll
                for (int bj = 0; bj < 2; ++bj)
#pragma unroll
                    for (int n = 0; n < 2; ++n) { f32x4 a = acc[ai][bj][m][n] * rs; acc[ai][bj][m][n] = a; if (bj == 0) ss += (a.x * a.x + a.y * a.y) + (a.z * a.z + a.w * a.w); }
                ss = xr32_sum(xr16_sum(ss));
                if (fq == 0) P[rl * 4 + wc] = ss; }
        __syncthreads();
        if (tid < 256) { const f32x4 pp = *(const LAS f32x4*)(P + tid * 4); RK[tid] = rsqrtf(((pp.x + pp.y) + (pp.z + pp.w) + KRS[tid]) * (1.f / 192.f) + 1e-6f); }
        __syncthreads();
        bf16* KM = (bf16*)(ws + WS_KM); bf16* VT = (bf16*)(ws + WS_VT);
        const f32x4 wa = *(const GAS f32x4*)(knw + c0), wb = *(const GAS f32x4*)(knw + c0 + 4);
#pragma unroll
        for (int ai = 0; ai < 2; ++ai)
#pragma unroll
            for (int m = 0; m < 4; ++m) { const int row = row0 + ai * HALF + m * 16, rl = ai * HALF + wr * 64 + m * 16 + fr;
                const float rk = RK[rl];
                st8bf(KM + (size_t)row * 768 + h * 192 + c0, acc[ai][0][m][0] * rk * wa, acc[ai][0][m][1] * rk * wb);
#pragma unroll
                for (int n = 0; n < 2; ++n)
#pragma unroll
                    for (int i = 0; i < 4; ++i) VTs[(c0 + n * 4 + i) * 264 + rl] = (bf16)f2bf(acc[ai][1][m][n][i]); }
        {
            const int rl = tid >> 1, hf = tid & 1, row = u.pm * BM + rl, i0 = 16 * hf; const float rk = RK[rl];
            const float* kr = misc + (size_t)row * 256 + 8; const float* cs = (const float*)(ws + WS_COSM) + (size_t)row * 32; const float* sn = (const float*)(ws + WS_SINM) + (size_t)row * 32;
            bf16* o = KM + (size_t)row * 768 + h * 192 + 128;
#pragma unroll
            for (int q = 0; q < 2; ++q) { f32x4 o1[2], o2[2];
#pragma unroll
                for (int e = 0; e < 2; ++e) { const int i = i0 + 8 * q + 4 * e;
                    const f32x4 x1 = *(const GAS f32x4*)(kr + i) * *(const GAS f32x4*)(knw + 128 + i), x2 = *(const GAS f32x4*)(kr + 32 + i) * *(const GAS f32x4*)(knw + 160 + i);
                    const f32x4 c = *(const GAS f32x4*)(cs + i), s = *(const GAS f32x4*)(sn + i);
                    o1[e] = (x1 * c - x2 * s) * rk; o2[e] = (x2 * c + x1 * s) * rk; }
                st8bf(o + i0 + 8 * q, o1[0], o1[1]); st8bf(o + 32 + i0 + 8 * q, o2[0], o2[1]); }
        }
        __syncthreads();
#pragma unroll
        for (int k = 0; k < 8; ++k) { const int p = tid + 512 * k, dv = p >> 5, c8 = (p & 31) * 8; *(GAS u32x4*)(VT + (size_t)(h * 128 + dv) * S + u.pm * BM + c8) = *(const LAS u32x4*)(VTs + dv * 264 + c8); }
        __syncthreads();
    }
};

struct EpiV1 {
    static constexpr bool AFTER_DRAIN = false;
    unsigned char* ws_;
    DI bool operator()(Acc& acc, const Unit& u, int wr, int wc, int fr, int fq) const {
        if (wc != 0) return true;
        unsigned char* ws = lw(ws_);
        const int row0 = u.pm * BM + wr * 64 + fr; bf16* dst = (bf16*)(ws + WS_ALORA);
#pragma unroll
        for (int ai = 0; ai < 2; ++ai)
#pragma unroll
            for (int m = 0; m < 4; ++m) { const int row = row0 + ai * HALF + m * 16; st8bf(dst + (size_t)row * 512 + 384 + fq * 8, acc[ai][0][m][0], acc[ai][0][m][1]); }
        return true;
    }
};

struct EpiLora {
    static constexpr bool AFTER_DRAIN = false;
    unsigned char* ws_; const float* w0; const float* a0; const float* v0; const float* ka;
#define LORA_LOOP(BODY) _Pragma("unroll") for (int ai = 0; ai < 2; ++ai) _Pragma("unroll") for (int m = 0; m < 4; ++m) { const size_t ro = (size_t)(row0 + ai * HALF + m * 16) * 512; \
        _Pragma("unroll") for (int bj = 0; bj < 2; ++bj) _Pragma("unroll") for (int n = 0; n < 2; ++n) { const int j = jb + bj * HALF + n * 4; const size_t o = ro + j; const f32x4 x = acc[ai][bj][m][n]; BODY } }
#define LORA_LOOP8(BODY) _Pragma("unroll") for (int ai = 0; ai < 2; ++ai) _Pragma("unroll") for (int m = 0; m < 4; ++m) { const size_t ro = (size_t)(row0 + ai * HALF + m * 16) * 512; \
        _Pragma("unroll") for (int bj = 0; bj < 2; ++bj) { const int j = jb + bj * HALF; const size_t o = ro + j; const f32x4 x0 = acc[ai][bj][m][0]; const f32x4 x1 = acc[ai][bj][m][1]; BODY } }
    DI bool operator()(Acc& acc, const Unit& u, int wr, int wc, int fr, int fq) const {
        unsigned char* ws = lw(ws_);
        const int seg = u.pn >> 1, row0 = u.pm * BM + wr * 64 + fr, jb = (u.pn & 1) * 256 + wc * 32 + fq * 8;
        if (seg == 0) { float* dec = (float*)(ws + WS_DEC);
            LORA_LOOP({ const f32x4 b = *(const GAS f32x4*)(w0 + j); f32x4 r;
                _Pragma("unroll") for (int i = 0; i < 4; ++i) { const float u_ = b[i] + x[i]; const float sp = fmaxf(-u_, 0.f) + __logf(1.0f + fexp_(-fabsf(u_))); r[i] = -fexp_(-sp - 0.5f); }
                *(GAS f32x4*)(dec + o) = r; })
        } else if (seg == 1) { const bf16* k32 = (const bf16*)(ws + WS_K32); const bf16* kkn_ = (const bf16*)(ws + WS_KKN); bf16* kp_ = (bf16*)(ws + WS_KP); bf16* bb_ = (bf16*)(ws + WS_BB);
            LORA_LOOP8({ float k[8]; float kkn[8]; unpack8(*(const GAS u32x4*)(k32 + o), k); unpack8(*(const GAS u32x4*)(kkn_ + o), kkn);
                const f32x4 b0 = *(const GAS f32x4*)(a0 + j); const f32x4 b1 = *(const GAS f32x4*)(a0 + j + 4); const f32x4 ka0 = *(const GAS f32x4*)(ka + j); const f32x4 ka1 = *(const GAS f32x4*)(ka + j + 4);
                f32x4 kp0; f32x4 kp1; f32x4 bb0; f32x4 bb1;
                _Pragma("unroll") for (int i = 0; i < 4; ++i) { const float av0 = sigmoidf_(b0[i] + x0[i]); const float av1 = sigmoidf_(b1[i] + x1[i]);
                    kp0[i] = k[i] * (1.0f + (av0 - 1.0f) * ka0[i]); kp1[i] = k[4 + i] * (1.0f + (av1 - 1.0f) * ka1[i]); bb0[i] = kkn[i] * av0; bb1[i] = kkn[4 + i] * av1; }
                *(GAS u32x4*)(kp_ + o) = pack8(kp0, kp1); *(GAS u32x4*)(bb_ + o) = pack8(bb0, bb1); })
        } else if (seg == 2) { bf16* g32 = (bf16*)(ws + WS_G32);
            LORA_LOOP8({ *(GAS u32x4*)(g32 + o) = pack8(x0, x1); })
        } else { bf16* vv = (bf16*)(ws + WS_VV); const bf16* vf_ = (const bf16*)(ws + WS_VFIRST);
            LORA_LOOP8({ float v[8]; float vf[8]; unpack8(*(const GAS u32x4*)(vv + o), v); unpack8(*(const GAS u32x4*)(vf_ + o), vf);
                const f32x4 b0 = *(const GAS f32x4*)(v0 + j); const f32x4 b1 = *(const GAS f32x4*)(v0 + j + 4); f32x4 r0; f32x4 r1;
                _Pragma("unroll") for (int i = 0; i < 4; ++i) { r0[i] = v[i] + (vf[i] - v[i]) * sigmoidf_(b0[i] + x0[i]); r1[i] = v[4 + i] + (vf[4 + i] - v[4 + i]) * sigmoidf_(b1[i] + x1[i]); }
                *(GAS u32x4*)(vv + o) = pack8(r0, r1); })
        }
        return true;
    }
#undef LORA_LOOP
#undef LORA_LOOP8
};

struct EpiBranch {
    static constexpr bool AFTER_DRAIN = false;
    unsigned char* ws_;
    DI bool operator()(Acc& acc, const Unit& u, int wr, int wc, int fr, int fq) const {
        unsigned char* ws = lw(ws_);
        const int nb = u.sub, row0 = u.pm * BM + wr * 64 + fr, cb = u.pn * BM + wc * 32 + fq * 8;
        const bf16* G = (const bf16*)(ws + WS_GATE) + nb * D; bf16* M = (bf16*)(ws + WS_MERGED);
#pragma unroll
        for (int ai = 0; ai < 2; ++ai)
#pragma unroll
            for (int m = 0; m < 4; ++m) { const int row = row0 + ai * HALF + m * 16;
#pragma unroll
                for (int bj = 0; bj < 2; ++bj) { const int col = cb + bj * HALF;
                    float g[8]; unpack8(*(const GAS u32x4*)(G + (size_t)row * 8192 + col), g);
                    const f32x4 a = acc[ai][bj][m][0] * (f32x4){g[0], g[1], g[2], g[3]}, b = acc[ai][bj][m][1] * (f32x4){g[4], g[5], g[6], g[7]};
                    if (nb < 3) { acc[ai][bj][m][0] = a; acc[ai][bj][m][1] = b; } else st8bf(M + (size_t)row * D + col, a, b); } }
        return nb == 3;
    }
};

struct EpiRes {
    static constexpr bool AFTER_DRAIN = false;
    const float* xin; float* out; bf16* xb; float* rss;
    DI bool operator()(Acc& acc, const Unit& u, int wr, int wc, int fr, int fq) const {
        const int row0 = u.pm * BM + wr * 64 + fr, cb = u.pn * BM + wc * 32 + fq * 8;
#pragma unroll
        for (int ai = 0; ai < 2; ++ai)
#pragma unroll
            for (int m = 0; m < 4; ++m) { const int row = row0 + ai * HALF + m * 16; float ss = 0.f;
#pragma unroll
                for (int bj = 0; bj < 2; ++bj) { const size_t o = (size_t)row * D + cb + bj * HALF;
                    const f32x4 a = *(const GAS f32x4*)(xin + o) + acc[ai][bj][m][0], b = *(const GAS f32x4*)(xin + o + 4) + acc[ai][bj][m][1];
                    st8f(out + o, a, b); st8bf(xb + o, a, b);
                    ss += (a.x * a.x + a.y * a.y) + (a.z * a.z + a.w * a.w) + (b.x * b.x + b.y * b.y) + (b.z * b.z + b.w * b.w); }
                if (rss) { ss = xr32_sum(xr16_sum(ss)); if (fq == 0) rss[(size_t)row * 32 + u.pn * 4 + wc] = ss; } }
        return true;
    }
};

struct EpiGu {
    static constexpr bool AFTER_DRAIN = false;
    unsigned char* ws_; const LAS float* rtab;
    DI bool operator()(Acc& acc, const Unit& u, int wr, int wc, int fr, int fq) const {
        unsigned char* ws = lw(ws_);
        scale_rows(acc, rtab + u.ord * 256, wr * 64 + fr);
        const int row0 = u.pm * BM + wr * 64 + fr, cb = u.pn * 128 + wc * 32 + fq * 8; bf16* A = (bf16*)(ws + WS_ACT);
#pragma unroll
        for (int ai = 0; ai < 2; ++ai)
#pragma unroll
            for (int m = 0; m < 4; ++m) { const int row = row0 + ai * HALF + m * 16;
                st8bf(A + (size_t)row * DFF + cb, map4(acc[ai][0][m][0], siluf_) * acc[ai][1][m][0], map4(acc[ai][0][m][1], siluf_) * acc[ai][1][m][1]); }
        return true;
    }
};
}

DI bf16x8 ldfrag(const LAS bf16* M, int ld, int r0, int k0, int lane) { return *(const LAS bf16x8*)(M + (r0 + (lane & 15)) * ld + k0 + 8 * (lane >> 4)); }
#define MFMA16(a, b, c) __builtin_amdgcn_mfma_f32_16x16x32_bf16((a), (b), (c), 0, 0, 0)
DI void stage_nat(LAS bf16* dst, int lp, const bf16* src, size_t gp, int rows, int cols8, int tid) {
    for (int p = tid; p < rows * cols8; p += NTHR) { const int r = p / cols8, c = p - r * cols8; *(LAS u32x4*)(dst + r * lp + c * 8) = *(const GAS u32x4*)(src + (size_t)r * gp + c * 8); }
}
DI void stage_tr(LAS bf16* dst, int lp, const bf16* src, size_t gp, int rows, int cols8, int tid) {
    for (int p = tid; p < rows * cols8; p += NTHR) { const int r = p / cols8, c = p - r * cols8; const u32x4 w = *(const GAS u32x4*)(src + (size_t)r * gp + c * 8);
        LAS bf16* d = dst + (c * 8) * lp + r;
        d[0] = (bf16)(w.x & 0xffffu); d[lp] = (bf16)(w.x >> 16); d[2 * lp] = (bf16)(w.y & 0xffffu); d[3 * lp] = (bf16)(w.y >> 16);
        d[4 * lp] = (bf16)(w.z & 0xffffu); d[5 * lp] = (bf16)(w.z >> 16); d[6 * lp] = (bf16)(w.w & 0xffffu); d[7 * lp] = (bf16)(w.w >> 16); }
}
DI float ret_loggamma(int h) { return log1pf(-exp2f(-5.0f - (float)h)); }

DI void u_ret_kv(Frame& F, int c, int h) {
    int tid_ = F.tid; asm volatile("" : "+v"(tid_));
    unsigned char* ws = F.ws; const int tid = tid_, lane = tid_ & 63, w = F.wave;
    LAS bf16* Kt = (LAS bf16*)F.lds; LAS bf16* Vt = Kt + 128 * 72;
    const bf16* KR = (const bf16*)(ws + WS_KR) + (size_t)(c * 64) * 512 + h * 128; const bf16* VR = (const bf16*)(ws + WS_VR) + (size_t)(c * 64) * 512 + h * 128;
    const float lg = ret_loggamma(h);
    for (int p = tid; p < 1024; p += NTHR) { const int m = p >> 4, d0 = (p & 15) * 8; float k[8]; unpack8(*(const GAS u32x4*)(KR + (size_t)m * 512 + d0), k); const float sc = fexp_(lg * (float)(63 - m));
        LAS bf16* d = Kt + d0 * 72 + m;
#pragma unroll
        for (int i = 0; i < 8; ++i) d[i * 72] = (bf16)f2bf(k[i] * sc); }
    stage_tr(Vt, 72, VR, 512, 64, 16, tid);
    __syncthreads();
    f32x4 acc[8];
#pragma unroll
    for (int bn = 0; bn < 8; ++bn) acc[bn] = (f32x4){0.f, 0.f, 0.f, 0.f};
#pragma unroll
    for (int ks = 0; ks < 2; ++ks) { const bf16x8 a = ldfrag(Kt, 72, 16 * w, 32 * ks, lane);
#pragma unroll
        for (int bn = 0; bn < 8; ++bn) acc[bn] = MFMA16(a, ldfrag(Vt, 72, 16 * bn, 32 * ks, lane), acc[bn]); }
    float* out = (float*)(ws + WS_RKV) + ((size_t)(c * 4 + h) * 128) * 128;
    __syncthreads();
    { LAS float* T = (LAS float*)F.lds;
#pragma unroll
      for (int bn = 0; bn < 8; ++bn)
#pragma unroll
          for (int r = 0; r < 4; ++r) T[(16 * w + 4 * (lane >> 4) + r) * 132 + 16 * bn + (lane & 15)] = acc[bn][r];
      __syncthreads();
#pragma unroll
      for (int k = 0; k < 8; ++k) { const int p = tid + 512 * k, row = p >> 5, c4 = (p & 31) * 4; *(GAS f32x4*)(out + (size_t)row * 128 + c4) = *(const LAS f32x4*)(T + row * 132 + c4); } }
    __syncthreads();
}

DI void u_ret_out(Frame& F, int l_, int c, int h) {
    int tid_ = F.tid; asm volatile("" : "+v"(tid_));
    unsigned char* ws = F.ws; const int tid = tid_, lane = tid_ & 63, w = F.wave;
    LAS bf16* Qs = (LAS bf16*)F.lds; LAS bf16* Ks = Qs + 64 * 136; LAS bf16* Vt = Ks + 64 * 136; LAS bf16* St = Vt + 128 * 72; LAS bf16* Ps = St + 128 * 136; LAS float* Os = (LAS float*)(Ps + 64 * 72);
    const size_t rowb = (size_t)(c * 64) * 512 + h * 128;
    stage_nat(Qs, 136, (const bf16*)(ws + WS_QR) + rowb, 512, 64, 16, tid);
    stage_nat(Ks, 136, (const bf16*)(ws + WS_KR) + rowb, 512, 64, 16, tid);
    stage_tr(Vt, 72, (const bf16*)(ws + WS_VR) + rowb, 512, 64, 16, tid);
    { const float* sp = (const float*)(ws + WS_RKV) + ((size_t)(c * 4 + h) * 128) * 128;
      for (int p = tid; p < 4096; p += NTHR) { const int d = p >> 5, e0 = (p & 31) * 4; const f32x4 v = *(const GAS f32x4*)(sp + (size_t)d * 128 + e0);
          LAS bf16* q = St + e0 * 136 + d; q[0] = (bf16)f2bf(v.x); q[136] = (bf16)f2bf(v.y); q[272] = (bf16)f2bf(v.z); q[408] = (bf16)f2bf(v.w); } }
    __syncthreads();
    const float lg = ret_loggamma(h); const int g4 = lane >> 4, lc = lane & 15;
    {
        const int bm = w >> 1;
#pragma unroll
        for (int q = 0; q < 2; ++q) { const int bn = (w & 1) * 2 + q; f32x4 acc = (f32x4){0.f, 0.f, 0.f, 0.f};
#pragma unroll
            for (int ks = 0; ks < 4; ++ks) acc = MFMA16(ldfrag(Qs, 136, 16 * bm, 32 * ks, lane), ldfrag(Ks, 136, 16 * bn, 32 * ks, lane), acc);
#pragma unroll
            for (int r = 0; r < 4; ++r) { const int l = 16 * bm + 4 * g4 + r, m = 16 * bn + lc; const int dd = l > m ? l - m : m - l; Ps[l * 72 + m] = (bf16)f2bf(acc[r] * fexp_(lg * (float)dd)); } }
    }
    __syncthreads();
    {
        const int bm = w >> 1;
#pragma unroll
        for (int q = 0; q < 4; ++q) { const int bn = (w & 1) * 4 + q; f32x4 a1 = (f32x4){0.f, 0.f, 0.f, 0.f}, a2 = (f32x4){0.f, 0.f, 0.f, 0.f};
#pragma unroll
            for (int ks = 0; ks < 2; ++ks) a1 = MFMA16(ldfrag(Ps, 72, 16 * bm, 32 * ks, lane), ldfrag(Vt, 72, 16 * bn, 32 * ks, lane), a1);
#pragma unroll
            for (int ks = 0; ks < 4; ++ks) a2 = MFMA16(ldfrag(Qs, 136, 16 * bm, 32 * ks, lane), ldfrag(St, 136, 16 * bn, 32 * ks, lane), a2);
#pragma unroll
            for (int r = 0; r < 4; ++r) { const int l = 16 * bm + 4 * g4 + r; Os[l * 132 + 16 * bn + lc] = a1[r] + fexp_(lg * (float)(l + 1)) * a2[r]; } }
    }
    __syncthreads();
    {
        const float* gw = (const float*)(ws + WS_PRM) + (size_t)l_ * PRM_STRIDE + P_GN + h * 128; const int l = 8 * w + (lane >> 3), e0 = (lane & 7) * 16; const size_t row = (size_t)(c * 64 + l);
        float x[16], gg[16];
#pragma unroll
        for (int q = 0; q < 4; ++q) { const f32x4 v = *(const LAS f32x4*)(Os + l * 132 + e0 + 4 * q); x[4 * q] = v.x; x[4 * q + 1] = v.y; x[4 * q + 2] = v.z; x[4 * q + 3] = v.w; }
        unpack8(*(const GAS u32x4*)((const bf16*)(ws + WS_GR) + row * 512 + h * 128 + e0), *(float(*)[8])&gg[0]); unpack8(*(const GAS u32x4*)((const bf16*)(ws + WS_GR) + row * 512 + h * 128 + e0 + 8), *(float(*)[8])&gg[8]);
        float sm = 0.f;
#pragma unroll
        for (int i = 0; i < 16; ++i) sm += x[i];
        const float mean = row_sum8(sm) * (1.f / 128.f); float sq = 0.f;
#pragma unroll
        for (int i = 0; i < 16; ++i) { x[i] -= mean; sq += x[i] * x[i]; }
        const float rstd = rsqrtf(row_sum8(sq) * (1.f / 128.f) + 1e-5f);
        float ov[16];
#pragma unroll
        for (int q = 0; q < 4; ++q) { const f32x4 wv = *(const GAS f32x4*)(gw + e0 + 4 * q);
#pragma unroll
            for (int i = 0; i < 4; ++i) ov[4 * q + i] = x[4 * q + i] * rstd * wv[i] * gg[4 * q + i]; }
        bf16* ob = (bf16*)(ws + WS_OB) + row * D + h * 128 + e0;
        *(GAS u32x4*)ob = pack8((f32x4){ov[0], ov[1], ov[2], ov[3]}, (f32x4){ov[4], ov[5], ov[6], ov[7]}); *(GAS u32x4*)(ob + 8) = pack8((f32x4){ov[8], ov[9], ov[10], ov[11]}, (f32x4){ov[12], ov[13], ov[14], ov[15]});
    }
    __syncthreads();
}

DI void u_mamba_st(Frame& F, int c, int g) {
    int tid_ = F.tid; asm volatile("" : "+v"(tid_));
    unsigned char* ws = F.ws; const int tid = tid_, lane = tid_ & 63, w = F.wave;
    LAS bf16* Xt = (LAS bf16*)F.lds; LAS bf16* Bt = Xt + 256 * 72;
    const bf16* XC = (const bf16*)(ws + WS_XC) + (size_t)(c * 64) * 1024; const float* dts = (const float*)(ws + WS_DTS) + (size_t)(c * 64) * 8; const float* acs = (const float*)(ws + WS_ACS) + (size_t)(c * 64) * 8;
    for (int p = tid; p < 2048; p += NTHR) { const int l = p >> 5, c0 = (p & 31) * 8, h = g * 4 + (c0 >> 6); float x[8]; unpack8(*(const GAS u32x4*)(XC + (size_t)l * 1024 + g * 256 + c0), x);
        const float sc = dts[l * 8 + h] * fexp_(acs[63 * 8 + h] - acs[l * 8 + h]); LAS bf16* d = Xt + c0 * 72 + l;
#pragma unroll
        for (int i = 0; i < 8; ++i) d[i * 72] = (bf16)f2bf(x[i] * sc); }
    stage_tr(Bt, 72, XC + 512 + g * 128, 1024, 64, 16, tid);
    __syncthreads();
    f32x4 acc[2][8];
#pragma unroll
    for (int i = 0; i < 2; ++i)
#pragma unroll
        for (int bn = 0; bn < 8; ++bn) acc[i][bn] = (f32x4){0.f, 0.f, 0.f, 0.f};
#pragma unroll
    for (int ks = 0; ks < 2; ++ks) { const bf16x8 a0 = ldfrag(Xt, 72, 32 * w, 32 * ks, lane), a1 = ldfrag(Xt, 72, 32 * w + 16, 32 * ks, lane);
#pragma unroll
        for (int bn = 0; bn < 8; ++bn) { const bf16x8 b = ldfrag(Bt, 72, 16 * bn, 32 * ks, lane); acc[0][bn] = MFMA16(a0, b, acc[0][bn]); acc[1][bn] = MFMA16(a1, b, acc[1][bn]); } }
    float* out = (float*)(ws + WS_MST) + ((size_t)(c * 8 + g * 4) * 64) * 128;
    __syncthreads();
    { LAS float* T = (LAS float*)F.lds;
#pragma unroll
      for (int i = 0; i < 2; ++i)
#pragma unroll
          for (int bn = 0; bn < 8; ++bn)
#pragma unroll
              for (int r = 0; r < 4; ++r) T[(32 * w + 16 * i + 4 * (lane >> 4) + r) * 132 + 16 * bn + (lane & 15)] = acc[i][bn][r];
      __syncthreads();
#pragma unroll
      for (int k = 0; k < 16; ++k) { const int p = tid + 512 * k, row = p >> 5, c4 = (p & 31) * 4; *(GAS f32x4*)(out + (size_t)row * 128 + c4) = *(const LAS f32x4*)(T + row * 132 + c4); } }
    __syncthreads();
}

struct MambaLds { LAS bf16* Cs; LAS bf16* Bs; LAS float* CB; LAS bf16* Ph; LAS bf16* Xt; LAS bf16* Sh; LAS float* AC; LAS float* DT; LAS float* SSQ; };
DI void mamba_head(Frame& F, const MambaLds& L, const bf16* XC, const float* sp, int g, int hh, float dsk, const bf16* const (&zrow)[4], f32x4 (&y)[2]) {
    const int tid = F.tid, lane = F.lane, w = F.wave, g4 = lane >> 4, lc = lane & 15, bm = w >> 1;
    __syncthreads();
    { const int l = tid >> 3, m0 = (tid & 7) * 8; const float al = L.AC[l * 4 + hh]; float pv[8];
#pragma unroll
      for (int i = 0; i < 8; ++i) { const int m = m0 + i; pv[i] = (m <= l) ? L.CB[l * 68 + m] * fexp_(al - L.AC[m * 4 + hh]) * L.DT[m * 4 + hh] : 0.f; }
      u32x4 o; o.x = pk2(pv[0], pv[1]); o.y = pk2(pv[2], pv[3]); o.z = pk2(pv[4], pv[5]); o.w = pk2(pv[6], pv[7]); *(LAS u32x4*)(L.Ph + l * 72 + m0) = o; }
    stage_tr(L.Xt, 72, XC + g * 256 + hh * 64, 1024, 64, 8, tid);
    for (int p = tid; p < 1024; p += NTHR) { const int pr = p >> 4, n0 = (p & 15) * 8; const f32x4 v0 = *(const GAS f32x4*)(sp + (size_t)pr * 128 + n0), v1 = *(const GAS f32x4*)(sp + (size_t)pr * 128 + n0 + 4);
        *(LAS u32x4*)(L.Sh + pr * 136 + n0) = pack8(v0, v1); }
    __syncthreads();
#pragma unroll
    for (int q = 0; q < 2; ++q) { const int bn = (w & 1) * 2 + q; f32x4 yd = (f32x4){0.f, 0.f, 0.f, 0.f}, yo = (f32x4){0.f, 0.f, 0.f, 0.f};
#pragma unroll
        for (int ks = 0; ks < 2; ++ks) yd = MFMA16(ldfrag(L.Ph, 72, 16 * bm, 32 * ks, lane), ldfrag(L.Xt, 72, 16 * bn, 32 * ks, lane), yd);
#pragma unroll
        for (int ks = 0; ks < 4; ++ks) yo = MFMA16(ldfrag(L.Cs, 136, 16 * bm, 32 * ks, lane), ldfrag(L.Sh, 136, 16 * bn, 32 * ks, lane), yo);
#pragma unroll
        for (int r = 0; r < 4; ++r) { const int l = 16 * bm + 4 * g4 + r, p = 16 * bn + lc; const float x = bf2f(L.Xt[p * 72 + l]);
            const float z = bf2f(zrow[r][hh * 64 + q * 16]);
            y[q][r] = (yd[r] + fexp_(L.AC[l * 4 + hh]) * yo[r] + x * dsk) * z; } }
}
DI void u_mamba_out(Frame& F, int l_, int c, int g) {
    int tid_ = F.tid; asm volatile("" : "+v"(tid_));
    unsigned char* ws = F.ws; const int tid = tid_, lane = tid_ & 63, w = F.wave, g4 = lane >> 4, lc = lane & 15;
    MambaLds L; L.Cs = (LAS bf16*)F.lds; L.Bs = L.Cs + 64 * 136; L.CB = (LAS float*)(L.Bs + 64 * 136); L.Ph = (LAS bf16*)(L.CB + 64 * 68); L.Xt = L.Ph + 64 * 72; L.Sh = L.Xt + 64 * 72;
    L.AC = (LAS float*)(L.Sh + 64 * 136); L.DT = L.AC + 256; L.SSQ = L.DT + 256;
    LAS bf16* Y = (LAS bf16*)(L.SSQ + 128);
    const bf16* XC = (const bf16*)(ws + WS_XC) + (size_t)(c * 64) * 1024;
    stage_nat(L.Cs, 136, XC + 768 + g * 128, 1024, 64, 16, tid);
    stage_nat(L.Bs, 136, XC + 512 + g * 128, 1024, 64, 16, tid);
    if (tid < 256) { const int l = tid >> 2, hh = tid & 3; L.AC[tid] = ((const float*)(ws + WS_ACS))[(size_t)(c * 64 + l) * 8 + g * 4 + hh]; L.DT[tid] = ((const float*)(ws + WS_DTS))[(size_t)(c * 64 + l) * 8 + g * 4 + hh]; }
    __syncthreads();
    const int bm = w >> 1;
#pragma unroll
    for (int q = 0; q < 2; ++q) { const int bn = (w & 1) * 2 + q; f32x4 acc = (f32x4){0.f, 0.f, 0.f, 0.f};
#pragma unroll
        for (int ks = 0; ks < 4; ++ks) acc = MFMA16(ldfrag(L.Cs, 136, 16 * bm, 32 * ks, lane), ldfrag(L.Bs, 136, 16 * bn, 32 * ks, lane), acc);
#pragma unroll
        for (int r = 0; r < 4; ++r) L.CB[(16 * bm + 4 * g4 + r) * 68 + 16 * bn + lc] = acc[r]; }
    const int pcol = 16 * ((w & 1) * 2) + lc;
    const bf16* zrow[4];
#pragma unroll
    for (int r = 0; r < 4; ++r) { const size_t row = (size_t)(c * 64 + 16 * bm + 4 * g4 + r); zrow[r] = (const bf16*)(ws + WS_ZS) + row * 512 + g * 256 + pcol; }
    const float* mst = (const float*)(ws + WS_MST) + ((size_t)(c * 8 + g * 4) * 64) * 128; const float* prm = (const float*)(ws + WS_PRM) + (size_t)l_ * PRM_STRIDE; const float* dskp = prm + P_SD + g * 4;
    float ss[4] = {0.f, 0.f, 0.f, 0.f};
#pragma unroll 1
    for (int hh = 0; hh < 4; ++hh) { f32x4 y[2]; mamba_head(F, L, XC, mst + (size_t)hh * 64 * 128, g, hh, dskp[hh], zrow, y);
#pragma unroll
        for (int q = 0; q < 2; ++q)
#pragma unroll
            for (int r = 0; r < 4; ++r) { ss[r] += y[q][r] * y[q][r]; Y[(16 * bm + 4 * g4 + r) * 264 + hh * 64 + pcol + q * 16] = (bf16)f2bf(y[q][r]); } }
#pragma unroll
    for (int r = 0; r < 4; ++r) { float t = ss[r]; t = row_sum16(t);
        if (lc == 0) L.SSQ[(16 * bm + 4 * g4 + r) * 2 + (w & 1)] = t; }
    __syncthreads();
    {
        const int l = tid >> 3, c0 = (tid & 7) * 32; const float rstd = rsqrtf((L.SSQ[l * 2] + L.SSQ[l * 2 + 1]) * (1.f / 256.f) + 1e-6f);
        const float* nw = prm + P_SNW + g * 256 + c0; bf16* orow = (bf16*)(ws + WS_OB) + (size_t)(c * 64 + l) * D + 512 + g * 256 + c0;
#pragma unroll
        for (int q = 0; q < 4; ++q) { float v[8]; unpack8(*(const LAS u32x4*)(Y + l * 264 + c0 + 8 * q), v);
            const f32x4 w0 = *(const GAS f32x4*)(nw + 8 * q), w1 = *(const GAS f32x4*)(nw + 8 * q + 4);
            *(GAS u32x4*)(orow + 8 * q) = pack8((f32x4){v[0], v[1], v[2], v[3]} * rstd * w0, (f32x4){v[4], v[5], v[6], v[7]} * rstd * w1); } }
    __syncthreads();
}

DI void u_attn2(Frame& F, int h, int qb, int sp, int ntile) {
    int tid_ = F.tid; asm volatile("" : "+v"(tid_));
    unsigned char* ws = F.ws; const int tid = tid_, lane = tid & 63, w = F.wave, g4 = lane >> 4, lc = lane & 15;
    LAS bf16* Ks = (LAS bf16*)F.lds; LAS bf16* Vs = Ks + 64 * 200;
    const bf16* QM = (const bf16*)(ws + WS_QM); const bf16* KM = (const bf16*)(ws + WS_KM) + h * 192; const bf16* VT = (const bf16*)(ws + WS_VT) + (size_t)(h * 128) * S;
    const int q0 = qb * 256 + w * 32, cw = 4 * qb + (w >> 1);
    bf16x8 qf[2][6];
#pragma unroll
    for (int qq = 0; qq < 2; ++qq)
#pragma unroll
        for (int ks = 0; ks < 6; ++ks) qf[qq][ks] = *(const GAS bf16x8*)(QM + (size_t)(q0 + qq * 16 + lc) * 768 + h * 192 + ks * 32 + g4 * 8);
    f32x4 o[8][2]; float mrun[2], lrun[2];
#pragma unroll
    for (int db = 0; db < 8; ++db)
#pragma unroll
        for (int qq = 0; qq < 2; ++qq) o[db][qq] = (f32x4){0.f, 0.f, 0.f, 0.f};
    mrun[0] = mrun[1] = -1e30f; lrun[0] = lrun[1] = 0.f;
    u32x4 kreg[3], vreg[2];
    const int kt0 = 16 * sp;
#define AT_LOAD(kt) { const int key0_ = (kt) * 64; \
        _Pragma("unroll") for (int i = 0; i < 3; ++i) { const int p = tid + 512 * i, r = p / 24, cc = p - r * 24; kreg[i] = *(const GAS u32x4*)(KM + (size_t)(key0_ + r) * 768 + cc * 8); } \
        _Pragma("unroll") for (int i = 0; i < 2; ++i) { const int p = tid + 512 * i, r = p >> 3, cc = p & 7; vreg[i] = *(const GAS u32x4*)(VT + (size_t)r * S + key0_ + cc * 8); } }
    AT_LOAD(kt0)
    for (int t = 0; t < ntile; ++t) {
        const int kt = kt0 + t;
        __syncthreads();
#pragma unroll
        for (int i = 0; i < 3; ++i) { const int p = tid + 512 * i, r = p / 24, cc = p - r * 24; *(LAS u32x4*)(Ks + r * 200 + cc * 8) = kreg[i]; }
#pragma unroll
        for (int i = 0; i < 2; ++i) { const int p = tid + 512 * i, r = p >> 3, cc = p & 7; *(LAS u32x4*)(Vs + r * 72 + cc * 8) = vreg[i]; }
        __syncthreads();
        if (t + 1 < ntile) AT_LOAD(kt + 1)
        if (kt <= cw) {
            f32x4 s[4][2];
#pragma unroll
            for (int kb = 0; kb < 4; ++kb)
#pragma unroll
                for (int qq = 0; qq < 2; ++qq) s[kb][qq] = (f32x4){0.f, 0.f, 0.f, 0.f};
            {
                bf16x8 kfr[2][4];
#pragma unroll
                for (int kb = 0; kb < 4; ++kb) kfr[0][kb] = ldfrag(Ks, 200, kb * 16, 0, lane);
#pragma unroll
                for (int ks = 0; ks < 6; ++ks) {
                    if (ks < 5) {
#pragma unroll
                        for (int kb = 0; kb < 4; ++kb) kfr[(ks + 1) & 1][kb] = ldfrag(Ks, 200, kb * 16, (ks + 1) * 32, lane); }
#pragma unroll
                    for (int kb = 0; kb < 4; ++kb)
#pragma unroll
                        for (int qq = 0; qq < 2; ++qq) s[kb][qq] = MFMA16(kfr[ks & 1][kb], qf[qq][ks], s[kb][qq]);
                }
            }
            bf16x8 pf[2][2];
#pragma unroll
            for (int qq = 0; qq < 2; ++qq) {
                float mx = -1e30f;
#pragma unroll
                for (int kb = 0; kb < 4; ++kb) mx = fmaxf(mx, fmaxf(fmaxf(s[kb][qq][0], s[kb][qq][1]), fmaxf(s[kb][qq][2], s[kb][qq][3])));
                mx = xr32_max(xr16_max(mx));
                const float mn = fmaxf(mrun[qq], mx), alpha = __builtin_amdgcn_exp2f(mrun[qq] - mn); mrun[qq] = mn;
                float ps = 0.f; float p[16];
#pragma unroll
                for (int kb = 0; kb < 4; ++kb)
#pragma unroll
                    for (int r = 0; r < 4; ++r) { p[kb * 4 + r] = __builtin_amdgcn_exp2f(s[kb][qq][r] - mn); ps += p[kb * 4 + r]; }
                ps = xr32_sum(xr16_sum(ps));
                lrun[qq] = lrun[qq] * alpha + ps;
if (__builtin_amdgcn_ballot_w64(alpha != 1.0f) != 0ull) {
#pragma unroll
                    for (int db = 0; db < 8; ++db) o[db][qq] = o[db][qq] * alpha; }
#pragma unroll
                for (int s2 = 0; s2 < 2; ++s2) { u32x4 pw; pw.x = pk2(p[8 * s2], p[8 * s2 + 1]); pw.y = pk2(p[8 * s2 + 2], p[8 * s2 + 3]); pw.z = pk2(p[8 * s2 + 4], p[8 * s2 + 5]); pw.w = pk2(p[8 * s2 + 6], p[8 * s2 + 7]); pf[qq][s2] = __builtin_bit_cast(bf16x8, pw); }
            }
            {
                bf16x8 vfr[2][2];
#define AT_VLD(dst, db_) { _Pragma("unroll") for (int s2 = 0; s2 < 2; ++s2) { const LAS bf16* vp = Vs + ((db_) * 16 + lc) * 72 + 32 * s2 + 4 * g4; \
                    const u32x2 v0 = *(const LAS u32x2*)vp, v1 = *(const LAS u32x2*)(vp + 16); const u32x4 vw = (u32x4){v0.x, v0.y, v1.x, v1.y}; dst[s2] = __builtin_bit_cast(bf16x8, vw); } }
                AT_VLD(vfr[0], 0)
#pragma unroll
                for (int db = 0; db < 8; ++db) {
                    if (db < 7) AT_VLD(vfr[(db + 1) & 1], db + 1)
#pragma unroll
                    for (int s2 = 0; s2 < 2; ++s2)
#pragma unroll
                        for (int qq = 0; qq < 2; ++qq) o[db][qq] = MFMA16(vfr[db & 1][s2], pf[qq][s2], o[db][qq]);
                }
#undef AT_VLD
            }
        }
    }
#undef AT_LOAD
    const int slot = att_slot(h, qb, sp);
    bf16* po = (bf16*)(ws + WS_APO) + (size_t)slot * 32768; float* pm = (float*)(ws + WS_APM) + (size_t)slot * 512;
#pragma unroll
    for (int db = 0; db < 8; ++db)
#pragma unroll
        for (int qq = 0; qq < 2; ++qq) *(GAS u32x2*)(po + (size_t)(w * 32 + qq * 16 + lc) * 128 + db * 16 + 4 * g4) = pk4_(o[db][qq]);
    if (g4 == 0) {
#pragma unroll
        for (int qq = 0; qq < 2; ++qq) { *(GAS f32x2*)(pm + (w * 32 + qq * 16 + lc) * 2) = (f32x2){mrun[qq], lrun[qq]}; } }
    __syncthreads();
}
DI void u_attn_comb(Frame& F, int h, int qb, int qq) {
    unsigned char* ws = F.ws; const int tid = F.tid, q = qq * 64 + (tid >> 3), dv0 = (tid & 7) * 16;
    const int ns = (qb + 4) >> 2, slot0 = att_slot(h, qb, 0);
    const float* pm = (const float*)(ws + WS_APM) + (size_t)slot0 * 512 + q * 2; const bf16* po = (const bf16*)(ws + WS_APO) + (size_t)slot0 * 32768 + (size_t)q * 128 + dv0;
    float mstar = -1e30f;
    for (int s = 0; s < ns; ++s) mstar = fmaxf(mstar, pm[(size_t)s * 512]);
    float lt = 0.f; float ov[16];
#pragma unroll
    for (int i = 0; i < 16; ++i) ov[i] = 0.f;
    for (int s = 0; s < ns; ++s) { const float sc = __builtin_amdgcn_exp2f(pm[(size_t)s * 512] - mstar); lt += pm[(size_t)s * 512 + 1] * sc;
        float v[16]; unpack8(*(const GAS u32x4*)(po + (size_t)s * 32768), *(float(*)[8])&v[0]); unpack8(*(const GAS u32x4*)(po + (size_t)s * 32768 + 8), *(float(*)[8])&v[8]);
#pragma unroll
        for (int i = 0; i < 16; ++i) ov[i] += v[i] * sc; }
    const float inv = 1.0f / lt;
    bf16* ob = (bf16*)(ws + WS_OB) + (size_t)(qb * 256 + q) * D + 1024 + h * 128 + dv0;
    u32x4 o0, o1; o0.x = pk2(ov[0] * inv, ov[1] * inv); o0.y = pk2(ov[2] * inv, ov[3] * inv); o0.z = pk2(ov[4] * inv, ov[5] * inv); o0.w = pk2(ov[6] * inv, ov[7] * inv);
    o1.x = pk2(ov[8] * inv, ov[9] * inv); o1.y = pk2(ov[10] * inv, ov[11] * inv); o1.z = pk2(ov[12] * inv, ov[13] * inv); o1.w = pk2(ov[14] * inv, ov[15] * inv);
    *(GAS u32x4*)ob = o0; *(GAS u32x4*)(ob + 8) = o1;
}

DI void u_rwkv_r1(Frame& F, int c, int h) {
    int tid_ = F.tid; asm volatile("" : "+v"(tid_));
    unsigned char* ws = F.ws; const int tid = tid_, lane = tid_ & 63, w = F.wave, g4 = lane >> 4, lc = lane & 15;
    LAS float* CUM = (LAS float*)F.lds;
    LAS float* PT = CUM + 64 * 68;
    LAS bf16* AT = (LAS bf16*)(PT + 64); LAS bf16* BH = AT + 4608; LAS bf16* KH = BH + 4608; LAS bf16* RT = KH + 4608;
    LAS bf16* AJ = RT + 4608; LAS bf16* BJ = AJ + 4608; LAS bf16* KJ = BJ + 4608; LAS bf16* VJ = KJ + 4608;
    LAS bf16* MAK = VJ + 4608; LAS bf16* MRBT = MAK + 4608; LAS bf16* MRKT = MRBT + 4608; LAS bf16* X1 = MRKT + 4608; LAS bf16* X2 = X1 + 4608;
    LAS bf16* WT = AT; LAS bf16* G1 = BH; LAS bf16* G2 = KH; LAS bf16* CST = MAK;
    const size_t gb = (size_t)(c * 64) * 512 + h * 64; const int unit = c * 8 + h;
    const int t = tid >> 3, j0 = (tid & 7) * 8;
    const size_t go = gb + (size_t)t * 512 + j0;
    float lw[8];
    { const f32x4 x0 = *(const GAS f32x4*)((const float*)(ws + WS_DEC) + go), x1 = *(const GAS f32x4*)((const float*)(ws + WS_DEC) + go + 4);
#pragma unroll
      for (int i = 0; i < 4; ++i) { lw[i] = x0[i]; lw[4 + i] = x1[i]; }
#pragma unroll
      for (int i = 0; i < 8; ++i) CUM[t * 68 + j0 + i] = lw[i]; }
    __syncthreads();
    if (tid < 64) { float s = 0.f;
#pragma unroll 8
        for (int tt = 0; tt < 64; ++tt) { s += CUM[tt * 68 + tid]; CUM[tt * 68 + tid] = s; } }
    __syncthreads();
    {
        float cum[8], cT[8];
#pragma unroll
        for (int i = 0; i < 8; ++i) { cum[i] = CUM[t * 68 + j0 + i]; cT[i] = CUM[63 * 68 + j0 + i]; }
        if (t == 0) {
#pragma unroll
            for (int i = 0; i < 8; ++i) PT[j0 + i] = fexp_(cT[i]); }
        float av[8], bv[8], kv[8], rv[8], vv[8];
#define LD8(dst, OFF) { unpack8(*(const GAS u32x4*)((const bf16*)(ws + (OFF)) + go), dst); }
        LD8(av, WS_KKN) LD8(bv, WS_BB) LD8(kv, WS_KP) LD8(rv, WS_R32) LD8(vv, WS_VV)
#undef LD8
        float at[8], bh[8], kh[8], rt[8], bj[8], kj[8];
#pragma unroll
        for (int i = 0; i < 8; ++i) { const float pprev = fexp_(cum[i] - lw[i]), pinv = fexp_(-cum[i]), pt = fexp_(cum[i]), pend = fexp_(cT[i] - cum[i]);
            at[i] = -av[i] * pprev; bh[i] = bv[i] * pinv; kh[i] = kv[i] * pinv; rt[i] = rv[i] * pt; bj[i] = bv[i] * pend; kj[i] = kv[i] * pend; }
#define ST8(M, v) { u32x4 o; o.x = pk2(v[0], v[1]); o.y = pk2(v[2], v[3]); o.z = pk2(v[4], v[5]); o.w = pk2(v[6], v[7]); *(LAS u32x4*)(M + t * 72 + j0) = o; }
        ST8(AT, at) ST8(BH, bh) ST8(KH, kh) ST8(RT, rt)
#undef ST8
#pragma unroll
        for (int i = 0; i < 8; ++i) { const int o = (j0 + i) * 72 + t; AJ[o] = (bf16)f2bf(at[i]); BJ[o] = (bf16)f2bf(bj[i]); KJ[o] = (bf16)f2bf(kj[i]); VJ[o] = (bf16)f2bf(vv[i]); }
    }
    __syncthreads();
    {
        const int q = w >> 1; const LAS bf16* Am = (q == 0) ? BH : (q == 1) ? KH : RT; const LAS bf16* Bm = (q < 2) ? AT : (q == 2) ? BH : KH;
#pragma unroll
        for (int bi = 0; bi < 2; ++bi) { const int bm = 2 * (w & 1) + bi; const bf16x8 a0 = ldfrag(Am, 72, 16 * bm, 0, lane), a1 = ldfrag(Am, 72, 16 * bm, 32, lane);
#pragma unroll
            for (int bn = 0; bn < 4; ++bn) { f32x4 acc = (f32x4){0.f, 0.f, 0.f, 0.f};
                acc = MFMA16(a0, ldfrag(Bm, 72, 16 * bn, 0, lane), acc); acc = MFMA16(a1, ldfrag(Bm, 72, 16 * bn, 32, lane), acc);
#pragma unroll
                for (int r = 0; r < 4; ++r) { const int row = 16 * bm + 4 * g4 + r, col = 16 * bn + lc; const bool keep = (q < 2) ? (row < col) : (col <= row); const float v = keep ? acc[r] : 0.f;
                    if (q == 0) CUM[row * 68 + col] = v; else { LAS bf16* O = (q == 1) ? MAK : (q == 2) ? MRBT : MRKT; O[row * 72 + col] = (bf16)f2bf(v); } } } }
    }
    __syncthreads();
    {
        LAS bf16* Qn[2] = {BH, X1}; LAS bf16* Qt[2] = {KH, X2}; LAS bf16* Wn[2] = {AT, (LAS bf16*)CUM};
        const int bm = w >> 1; f32x4 wreg[2];
#pragma unroll
        for (int qn = 0; qn < 2; ++qn) { const int bn = (w & 1) * 2 + qn;
#pragma unroll
            for (int r = 0; r < 4; ++r) { const int row = 16 * bm + 4 * g4 + r, col = 16 * bn + lc; const float m = CUM[row * 68 + col]; wreg[qn][r] = m + ((row == col) ? 1.f : 0.f);
                const bf16 mb = (bf16)f2bf(m); Qn[0][row * 72 + col] = mb; Qt[0][col * 72 + row] = mb; Wn[0][row * 72 + col] = (bf16)f2bf(wreg[qn][r]); } }
        __syncthreads();
#pragma unroll
        for (int it = 0; it < 5; ++it) { const int cu = it & 1, nx = cu ^ 1;
            { const bf16x8 a0 = ldfrag(Qn[cu], 72, 16 * bm, 0, lane), a1 = ldfrag(Qn[cu], 72, 16 * bm, 32, lane);
#pragma unroll
              for (int qn = 0; qn < 2; ++qn) { const int bn = (w & 1) * 2 + qn; f32x4 acc = (f32x4){0.f, 0.f, 0.f, 0.f};
                  acc = MFMA16(a0, ldfrag(Qt[cu], 72, 16 * bn, 0, lane), acc); acc = MFMA16(a1, ldfrag(Qt[cu], 72, 16 * bn, 32, lane), acc);
#pragma unroll
                  for (int r = 0; r < 4; ++r) { const int row = 16 * bm + 4 * g4 + r, col = 16 * bn + lc; const bf16 v = (bf16)f2bf(acc[r]); Qn[nx][row * 72 + col] = v; Qt[nx][col * 72 + row] = v; } } }
            __syncthreads();
            { const bf16x8 a0 = ldfrag(Wn[cu], 72, 16 * bm, 0, lane), a1 = ldfrag(Wn[cu], 72, 16 * bm, 32, lane);
#pragma unroll
              for (int qn = 0; qn < 2; ++qn) { const int bn = (w & 1) * 2 + qn;
                  wreg[qn] = MFMA16(a0, ldfrag(Qt[nx], 72, 16 * bn, 0, lane), wreg[qn]); wreg[qn] = MFMA16(a1, ldfrag(Qt[nx], 72, 16 * bn, 32, lane), wreg[qn]); } }
            if (it < 4) {
#pragma unroll
                for (int qn = 0; qn < 2; ++qn) { const int bn = (w & 1) * 2 + qn;
#pragma unroll
                    for (int r = 0; r < 4; ++r) Wn[nx][(16 * bm + 4 * g4 + r) * 72 + 16 * bn + lc] = (bf16)f2bf(wreg[qn][r]); }
            }
        }
        __syncthreads();
#pragma unroll
        for (int qn = 0; qn < 2; ++qn) { const int bn = (w & 1) * 2 + qn;
#pragma unroll
            for (int r = 0; r < 4; ++r) WT[(16 * bn + lc) * 72 + 16 * bm + 4 * g4 + r] = (bf16)f2bf(wreg[qn][r]); }
    }
    __syncthreads();
    {
        const int q = w >> 2, bm = w & 3; const LAS bf16* Am = q ? MAK : AJ; LAS bf16* O = q ? G2 : G1;
        const bf16x8 a0 = ldfrag(Am, 72, 16 * bm, 0, lane), a1 = ldfrag(Am, 72, 16 * bm, 32, lane);
        f32x4 acc[4];
#pragma unroll
        for (int bn = 0; bn < 4; ++bn) { acc[bn] = (f32x4){0.f, 0.f, 0.f, 0.f};
            acc[bn] = MFMA16(a0, ldfrag(WT, 72, 16 * bn, 0, lane), acc[bn]); acc[bn] = MFMA16(a1, ldfrag(WT, 72, 16 * bn, 32, lane), acc[bn]); }
#pragma unroll
        for (int bn = 0; bn < 4; ++bn)
#pragma unroll
            for (int r = 0; r < 4; ++r) O[(16 * bm + 4 * g4 + r) * 72 + 16 * bn + lc] = (bf16)f2bf(acc[bn][r]);
    }
    __syncthreads();
    {
        const int q = w >> 1; const LAS bf16* Am = (q < 2) ? MRBT : BJ; const LAS bf16* Bm = (q & 1) ? G2 : G1;
        f32x4 acc[2][4];
#pragma unroll
        for (int bi = 0; bi < 2; ++bi) { const int bm = 2 * (w & 1) + bi; const bf16x8 a0 = ldfrag(Am, 72, 16 * bm, 0, lane), a1 = ldfrag(Am, 72, 16 * bm, 32, lane);
#pragma unroll
            for (int bn = 0; bn < 4; ++bn) { acc[bi][bn] = (f32x4){0.f, 0.f, 0.f, 0.f};
                acc[bi][bn] = MFMA16(a0, ldfrag(Bm, 72, 16 * bn, 0, lane), acc[bi][bn]); acc[bi][bn] = MFMA16(a1, ldfrag(Bm, 72, 16 * bn, 32, lane), acc[bi][bn]); } }
        LAS bf16* lout = (q == 0) ? AT : (q == 1) ? AJ : (q == 2) ? X1 : CST;
#pragma unroll
        for (int bi = 0; bi < 2; ++bi) { const int bm = 2 * (w & 1) + bi;
#pragma unroll
            for (int bn = 0; bn < 4; ++bn)
#pragma unroll
                for (int r = 0; r < 4; ++r) { const int row = 16 * bm + 4 * g4 + r, col = 16 * bn + lc; float v = acc[bi][bn][r];
                    if (q == 0) v += bf2f(RT[row * 72 + col]); else if (q == 1) v += bf2f(MRKT[row * 72 + col]); else if (q == 2) v += (row == col) ? PT[row] : 0.f; else v += bf2f(KJ[row * 72 + col]);
                    lout[row * 72 + col] = (bf16)f2bf(v); } }
    }
    __syncthreads();
    { const int row = tid >> 3, c8 = (tid & 7) * 8; const size_t go2 = (size_t)unit * 4096 + row * 64 + c8;
      *(GAS u32x4*)((bf16*)(ws + WS_QYT) + go2) = *(const LAS u32x4*)(AT + row * 72 + c8);
      *(GAS u32x4*)((bf16*)(ws + WS_CYT) + go2) = *(const LAS u32x4*)(AJ + row * 72 + c8);
      *(GAS u32x4*)((bf16*)(ws + WS_TST) + go2) = *(const LAS u32x4*)(X1 + row * 72 + c8); }
    {
        const int bm = w >> 1;
        const bf16x8 a0 = ldfrag(CST, 72, 16 * bm, 0, lane), a1 = ldfrag(CST, 72, 16 * bm, 32, lane);
#pragma unroll
        for (int qn = 0; qn < 2; ++qn) { const int bn = (w & 1) * 2 + qn; f32x4 acc = (f32x4){0.f, 0.f, 0.f, 0.f};
            acc = MFMA16(a0, ldfrag(VJ, 72, 16 * bn, 0, lane), acc); acc = MFMA16(a1, ldfrag(VJ, 72, 16 * bn, 32, lane), acc);
#pragma unroll
            for (int r = 0; r < 4; ++r) CUM[(16 * bm + 4 * g4 + r) * 68 + 16 * bn + lc] = acc[r]; }
    }
    __syncthreads();
    { float* nst = (float*)(ws + WS_NST) + (size_t)unit * 4096;
#pragma unroll
      for (int k = 0; k < 2; ++k) { const int p = tid + 512 * k, row = p >> 4, c4 = (p & 15) * 4; *(GAS f32x4*)(nst + row * 64 + c4) = *(const LAS f32x4*)(CUM + row * 68 + c4); } }
    __syncthreads();
}

DI void p_rwkv_scan2(Frame& F, int h) {
    unsigned char* ws = F.ws; const int lane = F.lane, w = F.wave, g4 = lane >> 4, lc = lane & 15;
    constexpr int SLOT_B = 9216 + 17408;
    const bf16* TST = (const bf16*)(ws + WS_TST) + (size_t)h * 4096; const float* NST = (const float*)(ws + WS_NST) + (size_t)h * 4096; bf16* S0 = (bf16*)(ws + WS_S0) + (size_t)h * 4096;
    if (w >= 4) {
        const int lt = (w - 4) * 64 + lane;
        u32x4 rt[8][2]; f32x4 rn[8][4];
#define SC_ISSUE(u, cc) { const size_t ub = (size_t)(cc) * 8 * 4096; \
            _Pragma("unroll") for (int i = 0; i < 2; ++i) { const int p = lt + 256 * i; rt[u][i] = *(const GAS u32x4*)(TST + ub + (size_t)p * 8); } \
            _Pragma("unroll") for (int i = 0; i < 4; ++i) { const int p = lt + 256 * i; rn[u][i] = *(const GAS f32x4*)(NST + ub + (size_t)p * 4); } }
#define SC_WRITE(u, cc) { LAS unsigned char* sl = F.lds + ((cc) & 1) * SLOT_B; \
            _Pragma("unroll") for (int i = 0; i < 2; ++i) { const int p = lt + 256 * i, r = p >> 3, c8 = p & 7; *(LAS u32x4*)(sl + (r * 72 + c8 * 8) * 2) = rt[u][i]; } \
            _Pragma("unroll") for (int i = 0; i < 4; ++i) { const int p = lt + 256 * i, r = p >> 4, c4 = p & 15; *(LAS f32x4*)(sl + 9216 + (r * 68 + c4 * 4) * 4) = rn[u][i]; } }
#pragma unroll
        for (int u = 0; u < 8; ++u) SC_ISSUE(u, u)
        for (int c0 = 0; c0 < NCH; c0 += 8) {
#pragma unroll
            for (int u = 0; u < 8; ++u) { const int c = c0 + u;
                SC_WRITE(u, c)
                SC_ISSUE(u, (c + 8 < NCH) ? c + 8 : NCH - 1)
                asm volatile("s_waitcnt lgkmcnt(0)" ::: "memory"); __builtin_amdgcn_s_barrier(); asm volatile("" ::: "memory");
            }
        }
#undef SC_ISSUE
#undef SC_WRITE
    } else {
        const int ib = w;
        f32x4 st[4];
#pragma unroll
        for (int jb = 0; jb < 4; ++jb) st[jb] = (f32x4){0.f, 0.f, 0.f, 0.f};
        for (int c = 0; c < NCH; ++c) {
            bf16* s0p = S0 + (size_t)c * 8 * 4096 + (size_t)(16 * ib + lc) * 64 + 4 * g4;
            bf16x8 bfr[2];
#pragma unroll
            for (int ks = 0; ks < 2; ++ks) { u32x4 p; p.x = pk2(st[2 * ks][0], st[2 * ks][1]); p.y = pk2(st[2 * ks][2], st[2 * ks][3]); p.z = pk2(st[2 * ks + 1][0], st[2 * ks + 1][1]); p.w = pk2(st[2 * ks + 1][2], st[2 * ks + 1][3]);
                bfr[ks] = __builtin_bit_cast(bf16x8, p);
                *(GAS u32x2*)(s0p + 32 * ks) = (u32x2){p.x, p.y}; *(GAS u32x2*)(s0p + 32 * ks + 16) = (u32x2){p.z, p.w}; }
            asm volatile("s_waitcnt lgkmcnt(0)" ::: "memory"); __builtin_amdgcn_s_barrier(); asm volatile("" ::: "memory");
            const LAS bf16* ts = (const LAS bf16*)(F.lds + (c & 1) * SLOT_B); const LAS float* ns = (const LAS float*)(F.lds + (c & 1) * SLOT_B + 9216);
#pragma unroll
            for (int jb = 0; jb < 4; ++jb) { f32x4 nw;
#pragma unroll
                for (int r = 0; r < 4; ++r) nw[r] = ns[(16 * jb + 4 * g4 + r) * 68 + 16 * ib + lc];
#pragma unroll
                for (int ks = 0; ks < 2; ++ks) { const LAS bf16* ap = ts + (16 * jb + lc) * 72 + 32 * ks + 4 * g4; const u32x2 a0 = *(const LAS u32x2*)ap, a1 = *(const LAS u32x2*)(ap + 16);
                    const u32x4 aw = (u32x4){a0.x, a0.y, a1.x, a1.y}; nw = MFMA16(__builtin_bit_cast(bf16x8, aw), bfr[ks], nw); }
                st[jb] = nw; }
        }
    }
}

DI void u_rwkv_r3(Frame& F, int l_, int c, int h) {
    int tid_ = F.tid; asm volatile("" : "+v"(tid_));
    unsigned char* ws = F.ws; const int tid = tid_, lane = tid_ & 63, w = F.wave, g4 = lane >> 4, lc = lane & 15, unit = c * 8 + h;
    LAS bf16* QY = (LAS bf16*)F.lds; LAS bf16* CY = QY + 4608; LAS bf16* S0s = CY + 4608; LAS bf16* VJ = S0s + 4608; LAS float* Ys = (LAS float*)(VJ + 4608);
    stage_nat(QY, 72, (const bf16*)(ws + WS_QYT) + (size_t)unit * 4096, 64, 64, 8, tid);
    stage_nat(CY, 72, (const bf16*)(ws + WS_CYT) + (size_t)unit * 4096, 64, 64, 8, tid);
    stage_nat(S0s, 72, (const bf16*)(ws + WS_S0) + (size_t)unit * 4096, 64, 64, 8, tid);
    const size_t gb = (size_t)(c * 64) * 512 + h * 64;
    { const int t = tid >> 3, j0 = (tid & 7) * 8; const u32x4 w4 = *(const GAS u32x4*)((const bf16*)(ws + WS_VV) + gb + (size_t)t * 512 + j0); LAS bf16* d = VJ + j0 * 72 + t;
      d[0] = (bf16)(w4.x & 0xffffu); d[72] = (bf16)(w4.x >> 16); d[144] = (bf16)(w4.y & 0xffffu); d[216] = (bf16)(w4.y >> 16); d[288] = (bf16)(w4.z & 0xffffu); d[360] = (bf16)(w4.z >> 16); d[432] = (bf16)(w4.w & 0xffffu); d[504] = (bf16)(w4.w >> 16); }
    __syncthreads();
    { const int bm = w >> 1;
#pragma unroll
      for (int qn = 0; qn < 2; ++qn) { const int bn = (w & 1) * 2 + qn; f32x4 acc = (f32x4){0.f, 0.f, 0.f, 0.f};
#pragma unroll
          for (int ks = 0; ks < 2; ++ks) { acc = MFMA16(ldfrag(QY, 72, 16 * bm, 32 * ks, lane), ldfrag(S0s, 72, 16 * bn, 32 * ks, lane), acc); acc = MFMA16(ldfrag(CY, 72, 16 * bm, 32 * ks, lane), ldfrag(VJ, 72, 16 * bn, 32 * ks, lane), acc); }
#pragma unroll
          for (int r = 0; r < 4; ++r) Ys[(16 * bm + 4 * g4 + r) * 68 + 16 * bn + lc] = acc[r]; } }
    __syncthreads();
    {
        const float* prm = (const float*)(ws + WS_PRM) + (size_t)l_ * PRM_STRIDE + h * 64; const int t = 8 * w + (lane >> 3), i0 = (lane & 7) * 8; const size_t o = gb + (size_t)t * 512 + i0;
        float r8[8], k8[8], v8[8], g8[8];
        unpack8(*(const GAS u32x4*)((const bf16*)(ws + WS_R32) + o), r8); unpack8(*(const GAS u32x4*)((const bf16*)(ws + WS_KP) + o), k8);
        unpack8(*(const GAS u32x4*)((const bf16*)(ws + WS_VV) + o), v8); unpack8(*(const GAS u32x4*)((const bf16*)(ws + WS_G32) + o), g8);
        const f32x4 y0 = *(const LAS f32x4*)(Ys + t * 68 + i0), y1 = *(const LAS f32x4*)(Ys + t * 68 + i0 + 4);
        const f32x4 lw0 = *(const GAS f32x4*)(prm + P_LNW + i0), lw1 = *(const GAS f32x4*)(prm + P_LNW + i0 + 4), lb0 = *(const GAS f32x4*)(prm + P_LNB + i0), lb1 = *(const GAS f32x4*)(prm + P_LNB + i0 + 4);
        const f32x4 rk0 = *(const GAS f32x4*)(prm + P_RK + i0), rk1 = *(const GAS f32x4*)(prm + P_RK + i0 + 4);
        const float mean = row_sum8((y0.x + y0.y) + (y0.z + y0.w) + (y1.x + y1.y) + (y1.z + y1.w)) * (1.f / 64.f);
        const f32x4 d0 = y0 - mean, d1 = y1 - mean;
        const float rstd = rsqrtf(row_sum8((d0.x * d0.x + d0.y * d0.y) + (d0.z * d0.z + d0.w * d0.w) + (d1.x * d1.x + d1.y * d1.y) + (d1.z * d1.z + d1.w * d1.w)) * (1.f / 64.f) + 64e-5f);
        float bsp = 0.f;
#pragma unroll
        for (int i = 0; i < 4; ++i) bsp += r8[i] * k8[i] * rk0[i] + r8[4 + i] * k8[4 + i] * rk1[i];
        const float bs = row_sum8(bsp);
        f32x4 o0, o1;
#pragma unroll
        for (int i = 0; i < 4; ++i) { o0[i] = (d0[i] * rstd * lw0[i] + lb0[i] + bs * v8[i]) * g8[i]; o1[i] = (d1[i] * rstd * lw1[i] + lb1[i] + bs * v8[4 + i]) * g8[4 + i]; }
        *(GAS u32x4*)((bf16*)(ws + WS_OB) + (size_t)(c * 64 + t) * D + 1536 + h * 64 + i0) = pack8(o0, o1);
    }
    __syncthreads();
}

constexpr int STEPS_PER_LAYER = 13, NSTEPS = 1 + DEPTH * STEPS_PER_LAYER;
constexpr int NSCAN_BLK = 8;

__global__ void __launch_bounds__(NTHR, 2) mk_fwd(Args args) {
    extern __shared__ __attribute__((aligned(16))) unsigned char lds_raw[];
    Frame F;
    F.lds = (LAS unsigned char*)lds_raw; F.MISC = (volatile LAS unsigned*)(F.lds + MISC_OFF);
    F.tid = threadIdx.x; F.lane = F.tid & 63; F.wave = __builtin_amdgcn_readfirstlane(F.tid >> 6);
    F.G = gridDim.x; F.bid = blockIdx.x; F.ws = args.ws; F.ctl = (gu32*)(args.ws + WS_CTL);
    for (int u = F.tid; u < (LDS_BYTES - LDSCTL_OFF) / 4; u += NTHR) ((LAS unsigned*)(F.lds + LDSCTL_OFF))[u] = 0u;
    __syncthreads();
    const int lo = args.st_lo, hi = args.st_hi;
    XcdBarrier bar; bar.bar = (unsigned*)(F.ctl + CW_BAR); bar.x = 0; bar.st = nullptr;
    if (hi - lo > 1) bar = xcd_barrier_post((unsigned*)(F.ctl + CW_BAR), F.MISC + 8);
#ifndef MK_MASK
#define MK_MASK 0xFBFEu
#endif
#define EN(k) (((MK_MASK) >> (k)) & 1u)
#ifndef MK_REP
#define MK_REP 0u
#endif
#define REP(k) (((MK_REP) >> (k)) & 1u)
#ifndef MK_DUP
#define MK_DUP 0u
#endif
#define DUP(k, stmt) do { stmt; if (((MK_DUP) >> (k)) & 1u) { stmt; } } while (0)
#define RUN(s) (lo <= (s) && (s) < hi)
#define SEAM(s) do { if ((s) + 1 < hi) xcd_barrier(bar); } while (0)

    if (EN(13) && RUN(0)) { _Pragma("unroll 1") for (int rp = 0; rp <= (int)REP(13); ++rp) { relaunder(F, args.ws, (LAS unsigned char*)lds_raw); p_prologue(F, args); } SEAM(0); }

    for (int l = 0; l < DEPTH; ++l) {
        const int sb = 1 + l * STEPS_PER_LAYER;
        const float* xin = (l == 0) ? args.in[0] : args.out;
        if (EN(0) && RUN(sb + 0)) { _Pragma("unroll 1") for (int rp = 0; rp <= (int)REP(0); ++rp) { relaunder(F, args.ws, (LAS unsigned char*)lds_raw); unsigned char* ws = F.ws; DUP(11, p_rmsnorm(F, xin, (const float*)(ws + WS_PRM) + (size_t)l * PRM_STRIDE + P_N1, (bf16*)(ws + WS_XN))); } SEAM(sb + 0); }
        if (EN(1) && RUN(sb + 1)) { _Pragma("unroll 1") for (int rp = 0; rp <= (int)REP(1); ++rp) { relaunder(F, args.ws, (LAS unsigned char*)lds_raw); unsigned char* ws = F.ws;
            pg8::Gemm g{(const bf16*)(ws + WS_XN), (const bf16*)(ws + WS_WIN) + (size_t)l * NINP * D, D, D, D};
            pg8::StaticOrder So; So.init(S, NINP - 256, F.G, F.bid); pg8::EpiIn E{ws, 0, (const LAS float*)(F.lds + RTAB_OFF)};
            pg8::fill_rstd((LAS float*)(F.lds + RTAB_OFF), (const float*)(ws + WS_RSSA), So, F.tid);
            DUP(6, (pg8::gemm_phase<pg8::EpiIn, pg8::StaticOrder, true>(F.lds, g, So, E, F.tid)));
            } SEAM(sb + 1);
        }
        if (EN(2) && RUN(sb + 2)) { _Pragma("unroll 1") for (int rp = 0; rp <= (int)REP(2); ++rp) { relaunder(F, args.ws, (LAS unsigned char*)lds_raw); unsigned char* ws = F.ws;
            if (F.bid >= F.G - 32) {
                pg8::Gemm g{(const bf16*)(ws + WS_XN), (const bf16*)(ws + WS_WIN) + ((size_t)l * NINP + (NINP - 256)) * D, D, D, D};
                pg8::StaticOrder So; So.init(S, 256, 32, F.bid - (F.G - 32)); pg8::EpiMisc E{ws, (const LAS float*)(F.lds + RTAB_OFF)};
                pg8::fill_rstd((LAS float*)(F.lds + RTAB_OFF), (const float*)(ws + WS_RSSA), So, F.tid);
                pg8::gemm_phase<pg8::EpiMisc, pg8::StaticOrder, true>(F.lds, g, So, E, F.tid);
            } else {
                const int Gs = F.G; F.G = Gs - 32;
                DUP(12, p_rwkv_prep(F, l));
                relaunder(F, args.ws, (LAS unsigned char*)lds_raw); F.G = Gs - 32; DUP(13, p_mamba_prep(F, l));
                __syncthreads(); relaunder(F, args.ws, (LAS unsigned char*)lds_raw); F.G = Gs - 32;
                for (int u = F.bid; u < 512; u += F.G) DUP(5, u_ret_kv(F, u >> 2, u & 3));
                F.G = Gs;
            }
            } SEAM(sb + 2);
        }
        if (EN(3) && RUN(sb + 3)) { _Pragma("unroll 1") for (int rp = 0; rp <= (int)REP(3); ++rp) { relaunder(F, args.ws, (LAS unsigned char*)lds_raw); unsigned char* ws = F.ws;
            { pg8::Gemm g{(const bf16*)(ws + WS_CQ), (const bf16*)(ws + WS_WQB) + (size_t)l * 1024 * 512, 512, 512, 512};
              pg8::StaticOrder So; So.init(S, 1024, F.G, F.bid); pg8::EpiQb E{ws, (const float*)(ws + WS_PRM) + (size_t)l * PRM_STRIDE + P_QNW};
              pg8::gemm_phase<pg8::EpiQb, pg8::StaticOrder, false>(F.lds, g, So, E, F.tid); __syncthreads(); }
            relaunder(F, args.ws, (LAS unsigned char*)lds_raw); ws = F.ws;
            { pg8::Gemm g{(const bf16*)(ws + WS_CKV), (const bf16*)(ws + WS_WKVB) + (size_t)l * 1024 * 256, 256, 256, 256};
              pg8::StaticOrder So; So.init(S, 1024, F.G, (F.bid + 128) % F.G); pg8::EpiKvb E{ws, (const float*)(ws + WS_PRM) + (size_t)l * PRM_STRIDE + P_KNW};
              pg8::gemm_phase<pg8::EpiKvb, pg8::StaticOrder, false>(F.lds, g, So, E, F.tid); __syncthreads(); }
            relaunder(F, args.ws, (LAS unsigned char*)lds_raw); ws = F.ws;
            if (l > 0) { pg8::Gemm g{(const bf16*)(ws + WS_VV), (const bf16*)(ws + WS_WV1) + (size_t)l * 256 * 512, 512, 512, 512};
              pg8::StaticOrder So; So.init(S, 256, F.G, (F.bid + 64) % F.G); pg8::EpiV1 E{ws};
              pg8::gemm_phase<pg8::EpiV1, pg8::StaticOrder, true>(F.lds, g, So, E, F.tid); __syncthreads(); }
            relaunder(F, args.ws, (LAS unsigned char*)lds_raw);
            for (int u = F.bid; u < 256; u += F.G) { u_mamba_dt(F, l, u >> 1); DUP(4, u_mamba_st(F, u >> 1, u & 1)); }
            } SEAM(sb + 3);
        }
        if (EN(4) && RUN(sb + 4)) { _Pragma("unroll 1") for (int rp = 0; rp <= (int)REP(4); ++rp) { relaunder(F, args.ws, (LAS unsigned char*)lds_raw); unsigned char* ws = F.ws;
            {
              pg8::Gemm g{(const bf16*)(ws + WS_ALORA), (const bf16*)(ws + WS_WLORA) + (size_t)l * 2048 * 512, 512, 512, 512};
              pg8::StaticOrder So; So.init(S, l > 0 ? 2048 : 1536, F.G, F.bid);
              const float* prm = (const float*)(ws + WS_PRM) + (size_t)l * PRM_STRIDE; pg8::EpiLora E{ws, prm + P_W0, prm + P_A0, prm + P_V0, prm + P_KA};
              DUP(9, (pg8::gemm_phase<pg8::EpiLora, pg8::StaticOrder, true>(F.lds, g, So, E, F.tid))); }
            } SEAM(sb + 4);
        }
        if (EN(5) && RUN(sb + 5)) { _Pragma("unroll 1") for (int rp = 0; rp <= (int)REP(5); ++rp) { relaunder(F, args.ws, (LAS unsigned char*)lds_raw); unsigned char* ws = F.ws; (void)ws;
            if (F.bid < 64) { p_scans(F, 64); relaunder(F, args.ws, (LAS unsigned char*)lds_raw);
                for (int u = F.bid * 2; u < F.bid * 2 + 2; ++u) u_rwkv_r1(F, u >> 3, u & 7); }
            else { for (int u = 128 + (F.bid - 64); u < 1024; u += F.G - 64) u_rwkv_r1(F, u >> 3, u & 7); }
            } SEAM(sb + 5);
        }
        if (EN(6) && RUN(sb + 6)) { _Pragma("unroll 1") for (int rp = 0; rp <= (int)REP(6); ++rp) { relaunder(F, args.ws, (LAS unsigned char*)lds_raw); unsigned char* ws = F.ws; (void)ws;
            if (F.bid < NSCAN_BLK) { p_rwkv_scan2(F, F.bid); }
            else {
                const int NB = F.G - NSCAN_BLK, b = F.bid - NSCAN_BLK;
                { const int* tab = (const int*)(ws + WS_ATAB);
                  for (int r = 0; r * NB < ATT_NSUB; ++r) { const int pos = (r & 1) ? NB - 1 - b : b; const int i = r * NB + pos;
                      if (i < ATT_NSUB) { const int e = tab[i]; DUP(0, u_attn2(F, e & 3, (e >> 2) & 31, (e >> 7) & 31, e >> 12)); } } }
            }
            } SEAM(sb + 6);
        }
        if (EN(7) && RUN(sb + 7)) { _Pragma("unroll 1") for (int rp = 0; rp <= (int)REP(7); ++rp) { relaunder(F, args.ws, (LAS unsigned char*)lds_raw); unsigned char* ws = F.ws; (void)ws;
            for (int u = F.bid; u < 1024; u += F.G) DUP(3, u_rwkv_r3(F, l, u >> 3, u & 7));
            for (int u = F.bid; u < 512; u += F.G) DUP(10, u_attn_comb(F, u >> 7, (u >> 2) & 31, u & 3));
            relaunder(F, args.ws, (LAS unsigned char*)lds_raw);
            for (int u = F.bid; u < 256; u += F.G) DUP(2, u_mamba_out(F, l, u >> 1, u & 1));
            relaunder(F, args.ws, (LAS unsigned char*)lds_raw);
            for (int u = F.bid; u < 512; u += F.G) DUP(1, u_ret_out(F, l, u >> 2, u & 3));
            } SEAM(sb + 7);
        }
        if (EN(8) && RUN(sb + 8)) { _Pragma("unroll 1") for (int rp = 0; rp <= (int)REP(8); ++rp) { relaunder(F, args.ws, (LAS unsigned char*)lds_raw); unsigned char* ws = F.ws;
            pg8::Gemm g{(const bf16*)(ws + WS_OB), (const bf16*)(ws + WS_WBR) + (size_t)l * 8192 * 512, 512, D, 512};
            pg8::BranchOrder So; So.init(F.G, F.bid); pg8::EpiBranch E{ws};
            DUP(8, (pg8::gemm_phase<pg8::EpiBranch, pg8::BranchOrder, true>(F.lds, g, So, E, F.tid)));
            } SEAM(sb + 8);
        }
        if (EN(9) && RUN(sb + 9)) { _Pragma("unroll 1") for (int rp = 0; rp <= (int)REP(9); ++rp) { relaunder(F, args.ws, (LAS unsigned char*)lds_raw); unsigned char* ws = F.ws;
            pg8::Gemm g{(const bf16*)(ws + WS_MERGED), (const bf16*)(ws + WS_WOUT) + (size_t)l * D * D, D, D, D};
            pg8::StaticOrder So; So.init(S, D, F.G, F.bid); pg8::EpiRes E{xin, args.out, (bf16*)(ws + WS_XN), (float*)(ws + WS_RSSB)};
            pg8::gemm_phase<pg8::EpiRes, pg8::StaticOrder, true>(F.lds, g, So, E, F.tid);
            } SEAM(sb + 9);
        }
        if (EN(10) && RUN(sb + 10)) { _Pragma("unroll 1") for (int rp = 0; rp <= (int)REP(10); ++rp) { relaunder(F, args.ws, (LAS unsigned char*)lds_raw); unsigned char* ws = F.ws; DUP(11, p_rmsnorm(F, args.out, (const float*)(ws + WS_PRM) + (size_t)l * PRM_STRIDE + P_N2, (bf16*)(ws + WS_XN))); } SEAM(sb + 10); }
        if (EN(11) && RUN(sb + 11)) { _Pragma("unroll 1") for (int rp = 0; rp <= (int)REP(11); ++rp) { relaunder(F, args.ws, (LAS unsigned char*)lds_raw); unsigned char* ws = F.ws;
            pg8::Gemm g{(const bf16*)(ws + WS_XN), (const bf16*)(ws + WS_WGU) + (size_t)l * 2 * DFF * D, D, D, D};
            pg8::StaticOrder So; So.init(S, 2 * DFF, F.G, F.bid); pg8::EpiGu E{ws, (const LAS float*)(F.lds + RTAB_OFF)};
            pg8::fill_rstd((LAS float*)(F.lds + RTAB_OFF), (const float*)(ws + WS_RSSB), So, F.tid);
            DUP(7, (pg8::gemm_phase<pg8::EpiGu, pg8::StaticOrder, true>(F.lds, g, So, E, F.tid)));
            } SEAM(sb + 11);
        }
        if (EN(12) && RUN(sb + 12)) { _Pragma("unroll 1") for (int rp = 0; rp <= (int)REP(12); ++rp) { relaunder(F, args.ws, (LAS unsigned char*)lds_raw); unsigned char* ws = F.ws;
            pg8::Gemm g{(const bf16*)(ws + WS_ACT), (const bf16*)(ws + WS_WDN) + (size_t)l * D * DFF, DFF, DFF, DFF};
            pg8::StaticOrder So; So.init(S, D, F.G, F.bid); pg8::EpiRes E{args.out, args.out, (bf16*)(ws + WS_XN), (l + 1 < DEPTH) ? (float*)(ws + WS_RSSA) : nullptr};
            pg8::gemm_phase<pg8::EpiRes, pg8::StaticOrder, true>(F.lds, g, So, E, F.tid);
            } SEAM(sb + 12);
        }
    }
#ifdef MK_PROBE
    { const int l = 3;
      if (RUN(200)) { relaunder(F, args.ws, (LAS unsigned char*)lds_raw); for (int u = F.bid; u < 1024; u += F.G) u_rwkv_r3(F, l, u >> 3, u & 7); }
      if (RUN(201)) { relaunder(F, args.ws, (LAS unsigned char*)lds_raw); for (int u = F.bid; u < 512; u += F.G) u_attn_comb(F, u >> 7, (u >> 2) & 31, u & 3); }
      if (RUN(202)) { relaunder(F, args.ws, (LAS unsigned char*)lds_raw); for (int u = F.bid; u < 256; u += F.G) u_mamba_out(F, l, u >> 1, u & 1); }
      if (RUN(203)) { relaunder(F, args.ws, (LAS unsigned char*)lds_raw); for (int u = F.bid; u < 512; u += F.G) u_ret_out(F, l, u >> 2, u & 3); }
      if (RUN(204)) { relaunder(F, args.ws, (LAS unsigned char*)lds_raw); if (F.bid < F.G - 32) { const int Gs = F.G; F.G = Gs - 32; p_rwkv_prep(F, l); F.G = Gs; } }
      if (RUN(205)) { relaunder(F, args.ws, (LAS unsigned char*)lds_raw); if (F.bid < F.G - 32) { const int Gs = F.G; F.G = Gs - 32; p_mamba_prep(F, l); F.G = Gs; } }
      if (RUN(206)) { relaunder(F, args.ws, (LAS unsigned char*)lds_raw); if (F.bid < F.G - 32) { const int Gs = F.G; F.G = Gs - 32; for (int u = F.bid; u < 512; u += F.G) u_ret_kv(F, u >> 2, u & 3); F.G = Gs; } }
      if (RUN(207)) { relaunder(F, args.ws, (LAS unsigned char*)lds_raw); if (F.bid < 64) p_scans(F, 64); }
      if (RUN(208)) { relaunder(F, args.ws, (LAS unsigned char*)lds_raw); if (F.bid >= 64) { for (int u = 128 + (F.bid - 64); u < 1024; u += F.G - 64) u_rwkv_r1(F, u >> 3, u & 7); } }
      if (RUN(210)) { relaunder(F, args.ws, (LAS unsigned char*)lds_raw); unsigned char* ws = F.ws; if (F.bid >= F.G - 32) {
                pg8::Gemm g{(const bf16*)(ws + WS_XN), (const bf16*)(ws + WS_WIN) + ((size_t)l * NINP + (NINP - 256)) * D, D, D, D};
                pg8::StaticOrder So; So.init(S, 256, 32, F.bid - (F.G - 32)); pg8::EpiMisc E{ws, (const LAS float*)(F.lds + RTAB_OFF)};
                pg8::fill_rstd((LAS float*)(F.lds + RTAB_OFF), (const float*)(ws + WS_RSSA), So, F.tid);
                pg8::gemm_phase<pg8::EpiMisc, pg8::StaticOrder, true>(F.lds, g, So, E, F.tid); } }
      if (RUN(211)) { relaunder(F, args.ws, (LAS unsigned char*)lds_raw); unsigned char* ws = F.ws; if (F.bid >= NSCAN_BLK) { const int NB = F.G - NSCAN_BLK, b = F.bid - NSCAN_BLK; const int* tab = (const int*)(ws + WS_ATAB);
                  for (int r = 0; r * NB < ATT_NSUB; ++r) { const int pos = (r & 1) ? NB - 1 - b : b; const int i = r * NB + pos;
                      if (i < ATT_NSUB) { const int e = tab[i]; u_attn2(F, e & 3, (e >> 2) & 31, (e >> 7) & 31, e >> 12); } } } }
      if (RUN(209)) { relaunder(F, args.ws, (LAS unsigned char*)lds_raw); if (F.bid < NSCAN_BLK) p_rwkv_scan2(F, F.bid); }
    }
#endif
#undef RUN
#undef SEAM
}

#ifndef MK_ONE_LAUNCH
#define MK_ONE_LAUNCH 1
#endif
extern "C" void kernel_launch(void* const* d_in, const int* in_sizes, int n_in, void* d_out, int out_size, void* d_ws, size_t ws_size, hipStream_t stream) {
    static int grid = 0;
    if (grid == 0) {
        if (n_in != 36 || in_sizes[0] != S * D || out_size != S * D || ws_size < WS_END3) { fprintf(stderr, "kernel_launch: bad shapes: n_in %d in0 %d out %d ws %zu (need %zu)\n", n_in, n_in > 0 ? in_sizes[0] : -1, out_size, ws_size, (size_t)WS_END3); grid = -1; return; }
        int dev = 0, cus = 0, per_cu = 0;
        if (hipGetDevice(&dev) != hipSuccess || hipDeviceGetAttribute(&cus, hipDeviceAttributeMultiprocessorCount, dev) != hipSuccess) { grid = -1; return; }
        if (hipFuncSetAttribute((const void*)mk_fwd, hipFuncAttributeMaxDynamicSharedMemorySize, LDS_BYTES) != hipSuccess) { fprintf(stderr, "kernel_launch: hipFuncSetAttribute failed\n"); grid = -1; return; }
        if (hipOccupancyMaxActiveBlocksPerMultiprocessor(&per_cu, (const void*)mk_fwd, NTHR, LDS_BYTES) != hipSuccess || per_cu < 1) fprintf(stderr, "kernel_launch: occupancy query says %d\n", per_cu);
        (void)hipGetLastError();
        grid = cus;
        if (grid != 256) fprintf(stderr, "kernel_launch: %d CUs (built for 256)\n", grid);
    }
    if (grid < 0) return;
    if (hipMemsetAsync((char*)d_ws + WS_CTL, 0, CTL_ZERO_BYTES, stream) != hipSuccess) return;
    Args a{};
    for (int i = 0; i < 36; ++i) a.in[i] = (const float*)d_in[i];
    a.out = (float*)d_out; a.ws = (unsigned char*)d_ws;
#if MK_ONE_LAUNCH
    a.st_lo = 0; a.st_hi = NSTEPS;
    hipLaunchKernelGGL(mk_fwd, dim3(grid), dim3(NTHR), LDS_BYTES, stream, a);
#ifndef MK_EXTRA_FLAGS
#define MK_EXTRA_FLAGS 0
#endif
#ifdef MK_EXTRA_STEPS
    { const int xs[] = {MK_EXTRA_STEPS};
      for (int r = 0; r < MK_EXTRA_N; ++r) for (unsigned i = 0; i < sizeof(xs) / sizeof(xs[0]); ++i) { a.st_lo = xs[i]; a.st_hi = xs[i] + 1; hipLaunchKernelGGL(mk_fwd, dim3(grid), dim3(NTHR), LDS_BYTES, stream, a); } }
#endif
#else
    for (int s = 0; s < NSTEPS; ++s) { a.st_lo = s; a.st_hi = s + 1; hipLaunchKernelGGL(mk_fwd, dim3(grid), dim3(NTHR), LDS_BYTES, stream, a); }
#endif
}
```

```cpp
#include <hip/hip_runtime.h>
#include <cstdio>
#include <cstdint>

#define GAS __attribute__((address_space(1)))
#define LAS __attribute__((address_space(3)))
typedef unsigned short bf16;
typedef short bf16x8 __attribute__((ext_vector_type(8)));
typedef short s16x4 __attribute__((ext_vector_type(4)));
typedef float f32x4 __attribute__((ext_vector_type(4)));
typedef float f32x2 __attribute__((ext_vector_type(2)));
typedef unsigned u32x4 __attribute__((ext_vector_type(4)));
typedef unsigned u32x2 __attribute__((ext_vector_type(2)));
typedef GAS unsigned gu32;
#define RLX_AGENT __ATOMIC_RELAXED, __HIP_MEMORY_SCOPE_AGENT
#define DI __device__ __forceinline__

constexpr int S = 8192, D = 2048, DEPTH = 4, NIN = 14408, NINP = 14592, DFF = 5632;
constexpr int NCH = 128;
constexpr float LOG2E = 1.4426950408889634f;

DI float bf2f(unsigned v) { return __uint_as_float(v << 16); }
typedef __bf16 bf16x2_t __attribute__((ext_vector_type(2)));
DI unsigned pk2(float lo, float hi) { const f32x2 v = {lo, hi}; const bf16x2_t b = __builtin_convertvector(v, bf16x2_t); return __builtin_bit_cast(unsigned, b); }
DI unsigned f2bf(float f) { const __bf16 b = (__bf16)f; return (unsigned)__builtin_bit_cast(unsigned short, b); }
DI float fexp_(float x) { return __builtin_amdgcn_exp2f(x * 1.4426950408889634f); }
DI float ftanh_(float x) { return 1.0f - 2.0f * __builtin_amdgcn_rcpf(1.0f + fexp_(2.0f * x)); }
DI float sigmoidf_(float x) { return __builtin_amdgcn_rcpf(1.0f + fexp_(-x)); }
DI float siluf_(float x) { return x * __builtin_amdgcn_rcpf(1.0f + fexp_(-x)); }
DI float softplusf_(float x) { return fmaxf(x, 0.f) + log1pf(fexp_(-fabsf(x))); }
DI u32x4 pack8(const f32x4 a, const f32x4 b) { u32x4 w; w.x = pk2(a[0], a[1]); w.y = pk2(a[2], a[3]); w.z = pk2(b[0], b[1]); w.w = pk2(b[2], b[3]); return w; }
DI void unpack8(const u32x4 w, float (&o)[8]) { o[0] = bf2f(w.x & 0xffffu); o[1] = bf2f(w.x >> 16); o[2] = bf2f(w.y & 0xffffu); o[3] = bf2f(w.y >> 16);
    o[4] = bf2f(w.z & 0xffffu); o[5] = bf2f(w.z >> 16); o[6] = bf2f(w.w & 0xffffu); o[7] = bf2f(w.w >> 16); }

namespace pg8 {
constexpr int BM = 256, BK = 64, HALF = 128, HTB = HALF * BK * 2, STAGE_BYTES = 8 * HTB, NXCD = 8, WGM = 8;
DI int lds_byte(int r, int c) { const int st = (r >> 4) * 2 + (c >> 5), rr = r & 15, cc = c & 31, ob = rr * 64 + cc * 2; return st * 1024 + (ob ^ (((ob >> 9) & 1) << 5)); }
DI void stage_rc(int b, int& R, int& C) { const int st = b / 1024, sb = b % 1024, swz = sb ^ (((sb >> 9) & 1) << 5); R = (st >> 1) * 16 + swz / 64; C = (st & 1) * 32 + (swz % 64) / 2; }
DI int perm32(int rho) { const int n = rho >> 4, i = rho & 15; return 8 * (i >> 2) + 4 * n + (i & 3); }

struct Unit { int pm, pn, ak, brow, sub, ord; };
struct Gemm { const bf16* A; const bf16* Bt; int K, lda, ldb; };

struct StaticOrder {
    int nM, nN, nwg, G, c;
    DI void init(int M, int N, int G_, int c_) { nM = M / BM; nN = N / BM; nwg = nM * nN; G = G_; c = c_; }
    DI bool next(int i, Unit& u) const {
        const long L = (long)i * G + c; if (L >= nwg) return false;
        int wgid = (int)L; { const int q = nwg / NXCD, r = nwg % NXCD, xcd = wgid % NXCD, off = wgid / NXCD; wgid = (xcd < r ? xcd * (q + 1) : r * (q + 1) + (xcd - r) * q) + off; }
        const int nig = WGM * nN, gid = wgid / nig, fm = gid * WGM, gsz = (nM - fm) < WGM ? (nM - fm) : WGM;
        u.pm = fm + ((wgid % nig) % gsz); u.pn = (wgid % nig) / gsz; u.ak = 0; u.brow = u.pn * BM; u.sub = 0; return true;
    }
};
struct LoraOrder {
    StaticOrder so;
    DI void init(int N, int G_, int c_) { so.init(S, N, G_, c_); }
    DI bool next(int i, Unit& u) const { if (!so.next(i, u)) return false; u.ak = (u.pn >= 4) ? 256 : 0; return true; }
};
struct BranchOrder {
    StaticOrder so;
    DI void init(int G_, int c_) { so.init(S, D, G_, c_); }
    DI bool next(int i, Unit& u) const { if (!so.next(i >> 2, u)) return false; u.sub = i & 3; u.ak = u.sub * 512; u.brow = u.sub * D + u.pn * BM; return true; }
};

typedef f32x4 Acc[2][2][4][2];

template <class Epi, class Sched, bool ALIGN_EPI>
DI void gemm_phase(LAS unsigned char* lds, const Gemm g, const Sched& Sc, const Epi& E, const int tid) {
    const int wid = __builtin_amdgcn_readfirstlane(tid >> 6), lane = tid & 63, wr = wid >> 2, wc = wid & 3, fr = lane & 15, fq = lane >> 4;
    const int K = g.K, nt = K / BK;
    unsigned voffA[2], voffB[2];
#pragma unroll
    for (int i = 0; i < 2; ++i) { int R, C; stage_rc(tid * 16 + i * 8192, R, C); const int Rb = (R & ~31) + perm32(R & 31);
        voffA[i] = (unsigned)(R * g.lda + C) * 2u; voffB[i] = (unsigned)(Rb * g.ldb + C) * 2u; }
    const size_t kstep = (size_t)(BK * 2);
    const size_t hA = (size_t)HALF * g.lda * 2, hB = (size_t)HALF * g.ldb * 2;
    const unsigned ldsw = (unsigned)wid * 1024u;
    const int aoff = lds_byte(wr * 64 + fr, fq * 8), boff = lds_byte(wc * 32 + fr, fq * 8);
#define PG8_SA(b, h) (((b) * 2 + (h)) * HTB)
#define PG8_SB(b, h) ((4 + (b) * 2 + (h)) * HTB)
#define PG8_STAGE(bufoff, gbase, voff) do { _Pragma("unroll") for (int _i = 0; _i < 2; ++_i) \
        __builtin_amdgcn_global_load_lds((const unsigned*)((const char*)(gbase) + (voff)[_i]), (LAS unsigned*)(lds + (bufoff) + ldsw + _i * 8192), 16, 0, 0); } while (0)
#define PG8_LDA(dst, b, h) do { _Pragma("unroll") for (int m = 0; m < 4; ++m) _Pragma("unroll") for (int k = 0; k < 2; ++k) dst[m][k] = *(const LAS bf16x8*)(lds + PG8_SA(b, h) + aoff + m * 2048 + k * 1024); } while (0)
#define PG8_LDB(dst, b, h) do { _Pragma("unroll") for (int n = 0; n < 2; ++n) _Pragma("unroll") for (int k = 0; k < 2; ++k) dst[n][k] = *(const LAS bf16x8*)(lds + PG8_SB(b, h) + boff + n * 2048 + k * 1024); } while (0)
#define PG8_MMA(ai, bj, At, Bt) do { __builtin_amdgcn_s_setprio(1); _Pragma("unroll") for (int m = 0; m < 4; ++m) _Pragma("unroll") for (int n = 0; n < 2; ++n) _Pragma("unroll") for (int k = 0; k < 2; ++k) \
        acc[ai][bj][m][n] = __builtin_amdgcn_mfma_f32_16x16x32_bf16(Bt[n][k], At[m][k], acc[ai][bj][m][n], 0, 0, 0); __builtin_amdgcn_s_setprio(0); } while (0)
#define PG8_WAIT_V(n) asm volatile("s_waitcnt vmcnt(" #n ")" ::: "memory")
#define PG8_WAIT_L(n) asm volatile("s_waitcnt lgkmcnt(" #n ")" ::: "memory")
#define PG8_BAR __builtin_amdgcn_s_barrier()
#define PG8_SCHED __builtin_amdgcn_sched_barrier(0)
    Unit cur, nxt; int ui = 0;
    if (!Sc.next(0, cur)) return;
    cur.ord = 0;
    Acc acc;
#pragma unroll
    for (int a = 0; a < 2; ++a)
#pragma unroll
        for (int b = 0; b < 2; ++b)
#pragma unroll
            for (int m = 0; m < 4; ++m)
#pragma unroll
                for (int n = 0; n < 2; ++n) acc[a][b][m][n] = (f32x4){0.f, 0.f, 0.f, 0.f};
    bf16x8 At[4][2], B0[2][2], B1[2][2];
    const char* cA = (const char*)g.A + ((size_t)cur.pm * BM * g.lda + cur.ak) * 2; const char* cB = (const char*)g.Bt + (size_t)cur.brow * g.ldb * 2;
    PG8_STAGE(PG8_SB(0, 0), cB, voffB); PG8_STAGE(PG8_SB(0, 1), cB + hB, voffB); PG8_STAGE(PG8_SA(0, 0), cA, voffA); PG8_STAGE(PG8_SA(0, 1), cA + hA, voffA);
    if (wr == 1) PG8_BAR;
    PG8_WAIT_V(2); PG8_BAR;
    PG8_STAGE(PG8_SB(1, 0), cB + kstep, voffB); PG8_STAGE(PG8_SA(1, 0), cA + kstep, voffA); PG8_STAGE(PG8_SB(1, 1), cB + hB + kstep, voffB);
    PG8_WAIT_V(6); PG8_BAR;
    for (;;) {
        const bool has_next = Sc.next(ui + 1, nxt); nxt.ord = ui + 1;
        const char* nA = has_next ? (const char*)g.A + ((size_t)nxt.pm * BM * g.lda + nxt.ak) * 2 : cA; const char* nB = has_next ? (const char*)g.Bt + (size_t)nxt.brow * g.ldb * 2 : cB;
        for (int t = 0; t < nt; t += 2) {
            const bool last = (t == nt - 2);
            const char* a1 = cA + (size_t)(t + 1) * kstep;
            const char* a2 = last ? nA : cA + (size_t)(t + 2) * kstep; const char* b2 = last ? nB : cB + (size_t)(t + 2) * kstep;
            const char* a3 = a2 + kstep; const char* b3 = b2 + kstep;
            PG8_LDB(B0, 0, 0); PG8_LDB(B1, 0, 1); PG8_SCHED; PG8_LDA(At, 0, 0); PG8_STAGE(PG8_SA(1, 1), a1 + hA, voffA);
            PG8_WAIT_V(8); PG8_WAIT_L(0); PG8_BAR; PG8_MMA(0, 0, At, B0); PG8_MMA(0, 1, At, B1); PG8_BAR; PG8_SCHED;
            PG8_LDA(At, 0, 1); PG8_STAGE(PG8_SB(0, 0), b2, voffB); PG8_STAGE(PG8_SB(0, 1), b2 + hB, voffB); PG8_STAGE(PG8_SA(0, 0), a2, voffA);
            PG8_WAIT_V(8); PG8_WAIT_L(0); PG8_BAR; PG8_MMA(1, 0, At, B0); PG8_MMA(1, 1, At, B1); PG8_BAR; PG8_SCHED;
            PG8_LDB(B0, 1, 0); PG8_LDB(B1, 1, 1); PG8_SCHED; PG8_LDA(At, 1, 0); PG8_STAGE(PG8_SA(0, 1), a2 + hA, voffA);
            PG8_WAIT_V(8); PG8_WAIT_L(0); PG8_BAR; PG8_MMA(0, 0, At, B0); PG8_MMA(0, 1, At, B1); PG8_BAR; PG8_SCHED;
            PG8_LDA(At, 1, 1); PG8_STAGE(PG8_SB(1, 0), b3, voffB); PG8_STAGE(PG8_SB(1, 1), b3 + hB, voffB); PG8_STAGE(PG8_SA(1, 0), a3, voffA);
            PG8_WAIT_V(8); PG8_WAIT_L(0); PG8_BAR; PG8_MMA(1, 0, At, B0); PG8_MMA(1, 1, At, B1); PG8_BAR; PG8_SCHED;
        }
        if constexpr (ALIGN_EPI) { if (wr == 0) PG8_BAR; }
        bool zero = true;
        if constexpr (!Epi::AFTER_DRAIN) { zero = E(acc, cur, wr, wc, fr, fq); }
        if (!has_next) break;
        if (zero) {
#pragma unroll
        for (int a = 0; a < 2; ++a)
#pragma unroll
            for (int b = 0; b < 2; ++b)
#pragma unroll
                for (int m = 0; m < 4; ++m)
#pragma unroll
                    for (int n = 0; n < 2; ++n) acc[a][b][m][n] = (f32x4){0.f, 0.f, 0.f, 0.f};
        }
        cur = nxt; cA = nA; cB = nB; ++ui;
        if constexpr (ALIGN_EPI) { if (wr == 1) PG8_BAR; }
    }
    PG8_WAIT_V(0);
    if constexpr (!ALIGN_EPI) { if (wr == 0) PG8_BAR; }
    PG8_BAR;
    if constexpr (Epi::AFTER_DRAIN) { E.fused(acc, cur, wr, wc, fr, fq, lds, wid, lane, tid); }
#undef PG8_SA
#undef PG8_SB
#undef PG8_STAGE
#undef PG8_LDA
#undef PG8_LDB
#undef PG8_MMA
#undef PG8_WAIT_V
#undef PG8_WAIT_L
#undef PG8_BAR
#undef PG8_SCHED
}
}

constexpr size_t MiB = 1u << 20;
constexpr size_t al256(size_t x) { return (x + 255) & ~(size_t)255; }
constexpr size_t WS_CTL = 0, CTL_ZERO_BYTES = 1 * MiB;
constexpr size_t WS_PRM = 1 * MiB;
constexpr int P_N1 = 0, P_N2 = 2048, P_GN = 4096, P_CW = 4608, P_CB = 8704, P_DTB = 9728, P_ALOG = 9736, P_SD = 9744, P_SNW = 9760, P_QNW = 10272, P_KNW = 10464, P_MU = 10656,
              P_W0 = 12448, P_A0 = 12960, P_V0 = 13472, P_KK = 13984, P_KA = 14496, P_RK = 15008, P_LNW = 15520, P_LNB = 16032, PRM_STRIDE = 16640;
constexpr size_t WS_COSR = 2 * MiB;
constexpr size_t WS_SINR = WS_COSR + (size_t)S * 64 * 4;
constexpr size_t WS_COSM = WS_SINR + (size_t)S * 64 * 4;
constexpr size_t WS_SINM = WS_COSM + (size_t)S * 32 * 4;
constexpr size_t WS_WIN  = WS_SINM + (size_t)S * 32 * 4;
constexpr size_t WS_WQB  = WS_WIN + (size_t)DEPTH * NINP * D * 2;
constexpr size_t WS_WKVB = WS_WQB + (size_t)DEPTH * 1024 * 512 * 2;
constexpr size_t WS_WV1  = WS_WKVB + (size_t)DEPTH * 1024 * 256 * 2;
constexpr size_t WS_WLORA = WS_WV1 + (size_t)DEPTH * 256 * 512 * 2;
constexpr size_t WS_WBR  = WS_WLORA + (size_t)DEPTH * 2048 * 512 * 2;
constexpr size_t WS_WOUT = WS_WBR + (size_t)DEPTH * 8192 * 512 * 2;
constexpr size_t WS_WGU  = WS_WOUT + (size_t)DEPTH * D * D * 2;
constexpr size_t WS_WDN  = WS_WGU + (size_t)DEPTH * 2 * DFF * D * 2;
constexpr size_t WS_ACT0 = WS_WDN + (size_t)DEPTH * D * DFF * 2;
constexpr size_t WS_XN   = WS_ACT0;
constexpr size_t WS_QR   = WS_XN + (size_t)S * D * 2;
constexpr size_t WS_KR   = WS_QR + (size_t)S * 512 * 2;
constexpr size_t WS_VR   = WS_KR + (size_t)S * 512 * 2;
constexpr size_t WS_GR   = WS_VR + (size_t)S * 512 * 2;
constexpr size_t WS_ZS   = WS_GR + (size_t)S * 512 * 2;
constexpr size_t WS_XBC  = WS_ZS + (size_t)S * 512 * 2;
constexpr size_t WS_XC   = WS_XBC + (size_t)S * 1024 * 2;
constexpr size_t WS_CQ   = WS_XC + (size_t)S * 1024 * 2;
constexpr size_t WS_CKV  = WS_CQ + (size_t)S * 512 * 2;
constexpr size_t WS_SSQ  = WS_CKV + (size_t)S * 256 * 2;
constexpr size_t WS_RW   = WS_SSQ + (size_t)S * 16 * 4;
constexpr size_t WS_GATE = WS_RW + (size_t)S * 1792 * 4;
constexpr size_t WS_MISC = WS_GATE + (size_t)S * 8192 * 2;
constexpr size_t WS_DTS  = WS_MISC + (size_t)S * 256 * 4;
constexpr size_t WS_ACS  = WS_DTS + (size_t)S * 8 * 4;
constexpr size_t WS_RKV  = WS_ACS + (size_t)S * 8 * 4;
constexpr size_t WS_MST  = WS_RKV + (size_t)NCH * 4 * 128 * 128 * 4;
constexpr size_t WS_QM   = WS_MST + (size_t)NCH * 8 * 64 * 128 * 4;
constexpr size_t WS_KM   = WS_QM + (size_t)S * 768 * 2;
constexpr size_t WS_VT   = WS_KM + (size_t)S * 768 * 2;
constexpr size_t WS_R32  = WS_VT + (size_t)512 * S * 2;
constexpr size_t SZ32    = (size_t)S * 512 * 4;
constexpr size_t WS_KKN  = WS_R32 + SZ32, WS_K32 = WS_KKN + SZ32, WS_VV = WS_K32 + SZ32, WS_VFIRST = WS_VV + SZ32, WS_DEC = WS_VFIRST + SZ32,
                 WS_KP = WS_DEC + SZ32, WS_BB = WS_KP + SZ32, WS_G32 = WS_BB + SZ32, WS_Y32 = WS_G32 + SZ32;
constexpr size_t WS_VB   = WS_Y32 + SZ32;
constexpr size_t WS_ALORA = WS_VB + (size_t)S * 512 * 2;
constexpr size_t WS_OB   = WS_ALORA + (size_t)S * 512 * 2;
constexpr size_t WS_MERGED = WS_OB + (size_t)S * D * 2;
constexpr size_t WS_ACT  = WS_MERGED + (size_t)S * D * 2;
constexpr size_t WS_END  = WS_ACT + (size_t)S * DFF * 2;

constexpr int CW_TMO = 0, CW_CODE = 1, CW_BAR = 4096;


constexpr int NWAVES = 8, NTHR = 512;
constexpr int RING_BYTES = 143360, LDSCTL_OFF = RING_BYTES, MISC_OFF = LDSCTL_OFF + 320, LDS_BYTES = 147456;
#define LDS_WAIT() asm volatile("s_waitcnt lgkmcnt(0)" ::: "memory")
#define VM_WAIT() asm volatile("s_waitcnt vmcnt(0)" ::: "memory")

#define XB_TMO      128
#define XB_XCNT(j)  (256  + 64 * (j))
#define XB_XSUB(j)  (1280 + 64 * (j))
#define XB_XGEN(j)  (2304 + 64 * (j))
#define XB_TOP      3328
#define XB_TOPGEN   3392
#define XCD_BAR_WORDS 3456
#define XB_SPIN_CAP (1u << 22)
DI unsigned xb_ld(unsigned* p)              { return __hip_atomic_load(p, __ATOMIC_RELAXED, __HIP_MEMORY_SCOPE_AGENT); }
DI unsigned xb_add(unsigned* p, unsigned v) { return __hip_atomic_fetch_add(p, v, __ATOMIC_RELAXED, __HIP_MEMORY_SCOPE_AGENT); }
DI unsigned xb_xcc_id() { return (unsigned)__builtin_amdgcn_s_getreg((3 << 11) | 20) & 0xFu; }
#define XB_SPIN(cond, bar) do { unsigned _sp = 0; while (cond) { __builtin_amdgcn_s_sleep(1); \
    if ((++_sp & 255u) == 0u) { if (xb_ld(&(bar)[XB_TMO])) break; if (_sp > XB_SPIN_CAP) { atomicAdd(&(bar)[XB_TMO], 1u); break; } } } } while (0)
struct XcdBarrier { unsigned* bar; unsigned x; volatile LAS unsigned* st; };
DI XcdBarrier xcd_barrier_post(unsigned* bar, volatile LAS unsigned* st) {
    XcdBarrier b; b.bar = bar; b.x = xb_xcc_id(); b.st = st;
    if (threadIdx.x == 0) (void)xb_add(&bar[XB_XCNT(b.x)], 1u);
    return b;
}
DI void xcd_barrier_complete(unsigned* bar, unsigned x, unsigned& nloc, unsigned& nx) {
    const unsigned G = gridDim.x * gridDim.y * gridDim.z;
    unsigned sum, cnt, mine, sp = 0u;
    for (;;) {
        sum = 0u; cnt = 0u; mine = 0u;
#pragma unroll
        for (unsigned j = 0; j < 16; ++j) { const unsigned c = xb_ld(&bar[XB_XCNT(j)]); sum += c; cnt += (c > 0u) ? 1u : 0u; mine = (j == x) ? c : mine; }
        if (sum == G) break;
        __builtin_amdgcn_s_sleep(1);
        if ((++sp & 255u) == 0u) { if (xb_ld(&bar[XB_TMO])) break; if (sp > XB_SPIN_CAP) { atomicAdd(&bar[XB_TMO], 1u); break; } }
    }
    nloc = mine > 0u ? mine : 1u; nx = cnt > 0u ? cnt : 1u;
}
DI void xcd_barrier(const XcdBarrier& b) {
    asm volatile("s_waitcnt vmcnt(0)" ::: "memory");
    __syncthreads();
    if (threadIdx.x == 0) {
        unsigned* bar = b.bar;
        __builtin_amdgcn_s_waitcnt(0);
        unsigned nloc = b.st[0], nx = b.st[1];
        if (nloc == 0u) { xcd_barrier_complete(bar, b.x, nloc, nx); b.st[0] = nloc; b.st[1] = nx; }
        const unsigned old = xb_add(&bar[XB_XSUB(b.x)], 1u);
        const unsigned gen = old / nloc;
        if (old + 1u == (gen + 1u) * nloc) {
            __builtin_amdgcn_fence(__ATOMIC_RELEASE, "agent");
            asm volatile("s_waitcnt vmcnt(0)" ::: "memory");
            const unsigned og = xb_add(&bar[XB_TOP], 1u);
            const unsigned tg = og / nx;
            if (og + 1u == (tg + 1u) * nx) xb_add(&bar[XB_TOPGEN], 1u);
            else XB_SPIN(xb_ld(&bar[XB_TOPGEN]) == tg, bar);
            __builtin_amdgcn_fence(__ATOMIC_ACQUIRE, "agent");
            xb_add(&bar[XB_XGEN(b.x)], 1u);
            asm volatile("s_waitcnt vmcnt(0)" ::: "memory");
        } else {
            XB_SPIN(xb_ld(&bar[XB_XGEN(b.x)]) == gen, bar);
            __builtin_amdgcn_fence(__ATOMIC_ACQUIRE, "agent");
            asm volatile("s_waitcnt vmcnt(0)" ::: "memory");
        }
    }
    __syncthreads();
}

struct Args { const float* in[36]; float* out; unsigned char* ws; int st_lo, st_hi; };
struct Frame {
    LAS unsigned char* lds; volatile LAS unsigned* MISC; gu32* ctl;
    int tid, lane, wave, G, bid;
    unsigned char* ws;
};
DI void relaunder(Frame& F, unsigned char* ws0, LAS unsigned char* lds0) {
    int t = threadIdx.x; asm volatile("" : "+v"(t)); F.tid = t; F.lane = t & 63; F.wave = __builtin_amdgcn_readfirstlane(t >> 6);
    unsigned long long w = (unsigned long long)ws0; asm volatile("" : "+s"(w)); F.ws = (unsigned char*)w; F.ctl = (gu32*)(F.ws + WS_CTL);
    unsigned lb = (unsigned)(unsigned long)lds0; asm volatile("" : "+s"(lb)); F.lds = (LAS unsigned char*)(unsigned long)lb; F.MISC = (volatile LAS unsigned*)(F.lds + MISC_OFF);
    int b = blockIdx.x; asm volatile("" : "+s"(b)); F.bid = b;
}
#define XR_SWAP(INS, a, b) asm volatile("s_nop 1\n\t" INS " %0, %1" : "+v"(a), "+v"(b))
DI float xr16_max(float x) { float a = x, b = x; XR_SWAP("v_permlane16_swap_b32", a, b); return fmaxf(a, b); }
DI float xr32_max(float x) { float a = x, b = x; XR_SWAP("v_permlane32_swap_b32", a, b); return fmaxf(a, b); }
DI float xr16_sum(float x) { float a = x, b = x; XR_SWAP("v_permlane16_swap_b32", a, b); return a + b; }
DI float xr32_sum(float x) { float a = x, b = x; XR_SWAP("v_permlane32_swap_b32", a, b); return a + b; }
template <int CTRL> DI float dpp_f(float v) { return __builtin_bit_cast(float, __builtin_amdgcn_update_dpp(0, __builtin_bit_cast(int, v), CTRL, 0xf, 0xf, true)); }
DI float row_sum8(float v) { v += dpp_f<0xB1>(v); v += dpp_f<0x4E>(v); v += dpp_f<0x141>(v); return v; }
DI float row_sum16(float v) { v += dpp_f<0xB1>(v); v += dpp_f<0x4E>(v); v += dpp_f<0x141>(v); v += dpp_f<0x140>(v); return v; }
DI float wave_sum(float v) { return xr32_sum(xr16_sum(row_sum16(v))); }
DI float wave_sum_dpp(float v) {
    const float t = row_sum16(v);
    const float s0 = __builtin_bit_cast(float, __builtin_amdgcn_readlane(__builtin_bit_cast(int, t), 0));
    const float s1 = __builtin_bit_cast(float, __builtin_amdgcn_readlane(__builtin_bit_cast(int, t), 16));
    const float s2 = __builtin_bit_cast(float, __builtin_amdgcn_readlane(__builtin_bit_cast(int, t), 32));
    const float s3 = __builtin_bit_cast(float, __builtin_amdgcn_readlane(__builtin_bit_cast(int, t), 48));
    return (s0 + s1) + (s2 + s3);
}
constexpr size_t WS_QYT = WS_END;
constexpr size_t WS_CYT = WS_QYT + (size_t)1024 * 4096 * 2;
constexpr size_t WS_TST = WS_CYT + (size_t)1024 * 4096 * 2;
constexpr size_t WS_NST = WS_TST + (size_t)1024 * 4096 * 2;
constexpr size_t WS_S0  = WS_NST + (size_t)1024 * 4096 * 4;
constexpr size_t WS_END2 = WS_S0 + (size_t)1024 * 4096 * 2;
constexpr int ATT_NSUB = 576, ATT_RUN = 16;
constexpr size_t WS_ATAB = WS_END2;
constexpr size_t WS_APO  = WS_ATAB + 8192;
constexpr size_t WS_APM  = WS_APO + (size_t)ATT_NSUB * 32768 * 4;
constexpr size_t WS_RSSA = WS_APM + (size_t)ATT_NSUB * 512 * 4;
constexpr size_t WS_RSSB = WS_RSSA + (size_t)S * 32 * 4;
constexpr size_t WS_END3 = WS_RSSB + (size_t)S * 32 * 4;
constexpr int RTAB_OFF = 131072;
DI int att_slot(int h, int qb, int s) { const int g = qb >> 2; return h * 144 + (g + 1) * (qb - 2 * g) + s; }

DI int map_in(int n) {
    const int T = n >> 8, c = n & 255;
    if (T < 4) { const int base = (T >> 1) * 512, tp = T & 1, half = c >> 7, hs = (c >> 6) & 1, j = c & 63; return base + (2 * tp + hs) * 128 + half * 64 + j; }
    if (T < 6) return 1024 + (T - 4) * 256 + c;
    if (T < 8) return 1536 + (T - 6) * 256 + c;
    if (T < 10) return 2048 + (T - 8) * 256 + c;
    if (T < 14) return 2560 + (T - 10) * 256 + c;
    if (T < 16) return 3592 + (T - 14) * 256 + c;
    if (T == 16) return 4104 + c;
    if (T < 24) return 4424 + (T - 17) * 256 + c;
    if (T < 56) {
        const int j = T - 24, bj = c >> 7, wc = (c >> 5) & 3, fq = (c >> 3) & 3, n = (c >> 2) & 1, i = c & 3; return 6216 + (2 * bj + n) * 2048 + 64 * j + wc * 16 + fq * 4 + i; }
    if (c < 8) return 3584 + c;
    if (c < 72) return 4360 + (c - 8);
    return -1;
}
DI int map_fn(int mapid, int n, int Nsrc) {
    if (mapid == 0) return n < Nsrc ? n : -1;
    if (mapid == 1) return map_in(n);
    if (mapid == 2) { const int T = n >> 8, c = n & 255; return c < 128 ? T * 128 + c : DFF + T * 128 + (c - 128); }
    if (mapid == 3) { const int h = n >> 8, c = n & 255; if (c < 96) return h * 192 + c; if (c < 128) return h * 192 + 128 + (c - 96); if (c < 160) return h * 192 + 96 + (c - 128); if (c < 224) return -1; return h * 192 + 160 + (c - 224); }
    return n < 32 ? n : -1;
}
DI void conv_item(const float* W, int K, int Nsrc, bf16* Wt, const float* kscale, int mapid, LAS bf16* tile, int item, int nblk, int lane) {
    const int kb = item / nblk, nb = item - kb * nblk, k0 = 64 * kb, n0 = 64 * nb;
    const int src = map_fn(mapid, n0 + lane, Nsrc);
    const float* wp = W + (size_t)k0 * Nsrc + (src >= 0 ? src : 0);
    float v[64];
#pragma unroll
    for (int i = 0; i < 64; ++i) v[i] = wp[(size_t)i * Nsrc];
    if (src < 0) {
#pragma unroll
        for (int i = 0; i < 64; ++i) v[i] = 0.f; }
    if (kscale) {
#pragma unroll
        for (int i = 0; i < 64; ++i) v[i] *= kscale[k0 + i]; }
#pragma unroll
    for (int q = 0; q < 8; ++q) { u32x4 o; o.x = pk2(v[8 * q], v[8 * q + 1]); o.y = pk2(v[8 * q + 2], v[8 * q + 3]); o.z = pk2(v[8 * q + 4], v[8 * q + 5]); o.w = pk2(v[8 * q + 6], v[8 * q + 7]);
        *(LAS u32x4*)(tile + lane * 72 + 8 * q) = o; }
    LDS_WAIT(); asm volatile("" ::: "memory");
#pragma unroll
    for (int i = 0; i < 8; ++i) { const int r = i * 8 + (lane >> 3), c8 = lane & 7;
        *(GAS u32x4*)(Wt + (size_t)(n0 + r) * K + k0 + 8 * c8) = *(const LAS u32x4*)(tile + r * 72 + 8 * c8); }
    LDS_WAIT(); asm volatile("" ::: "memory");
}
struct ConvJob { const float* W; bf16* Wt; const float* kscale; int K, Nsrc, Ndst, mapid; };
DI void conv_job(Frame& F, const ConvJob j, int& base) {
    const int nblk = j.Ndst / 64, nitems = (j.K / 64) * nblk, NGW = F.G * NWAVES, gw = F.bid * NWAVES + F.wave;
    int first = (gw - base % NGW + NGW) % NGW; LAS bf16* tile = (LAS bf16*)(F.lds + F.wave * 16384);
    for (int it = first; it < nitems; it += NGW) conv_item(j.W, j.K, j.Nsrc, j.Wt, j.kscale, j.mapid, tile, it, nblk, F.lane);
    base += nitems;
}
DI void p_prologue(Frame& F, const Args& a) {
    unsigned char* ws = F.ws;
    const int gt = F.bid * NTHR + F.tid, NGT = F.G * NTHR;
    if (F.bid == 0 && F.tid == 0) { int* tab = (int*)(ws + WS_ATAB); int n = 0;
        for (int pass = 16; pass >= 4; pass -= 4)
            for (int qb = 31; qb >= 0; --qb) { const int nt = 4 * (qb + 1), nfull = nt >> 4, rem = nt & 15;
                for (int h = 0; h < 4; ++h) {
                    if (pass == 16) { for (int s2 = 0; s2 < nfull; ++s2) tab[n++] = h | (qb << 2) | (s2 << 7) | (16 << 12); }
                    else if (rem == pass) tab[n++] = h | (qb << 2) | (nfull << 7) | (rem << 12); } }
        for (; n < 2048; ++n) tab[n] = 0; }
    { float* prm = (float*)(ws + WS_PRM);
#define CPV(IDX, N, OFF, SRC_L) for (int e = gt; e < (N); e += NGT) prm[(size_t)l * PRM_STRIDE + (OFF) + e] = a.in[IDX][(size_t)(SRC_L) * (N) + e];
      for (int l = 0; l < DEPTH; ++l) {
          CPV(2, 2048, P_N1, l) CPV(33, 2048, P_N2, l) CPV(4, 512, P_GN, l) CPV(5, 4096, P_CW, l) CPV(6, 1024, P_CB, l) CPV(7, 8, P_DTB, l) CPV(8, 8, P_ALOG, l) CPV(9, 8, P_SD, l)
          CPV(10, 512, P_SNW, l) CPV(15, 192, P_QNW, l) CPV(16, 192, P_KNW, l) CPV(17, 1792, P_MU, l) CPV(18, 512, P_W0, l) CPV(20, 512, P_A0, l)
          CPV(23, 512, P_V0, (l > 0 ? l - 1 : 0)) CPV(26, 512, P_KK, l) CPV(27, 512, P_KA, l) CPV(28, 512, P_RK, l) CPV(29, 512, P_LNW, l) CPV(30, 512, P_LNB, l)
      }
#undef CPV
    }
    const int* pos = (const int*)a.in[1];
    for (int e = gt; e < S * 64; e += NGT) { const int t = e >> 6, i = e & 63;
        const float inv = 1.0f / powf(10000.0f, (float)(2 * i) / 128.0f); const float ang = (float)pos[t] * inv;
        double rev = (double)ang * 0.15915494309189535; rev -= rint(rev); const float r = (float)(rev * 6.283185307179586);
        ((float*)(ws + WS_COSR))[e] = __cosf(r); ((float*)(ws + WS_SINR))[e] = __sinf(r); }
    for (int e = gt; e < S * 32; e += NGT) { const int t = e >> 5, i = e & 31;
        const float inv = 1.0f / powf(10000.0f, (float)(2 * i) / 64.0f); const float ang = (float)pos[t] * inv;
        double rev = (double)ang * 0.15915494309189535; rev -= rint(rev); const float r = (float)(rev * 6.283185307179586);
        ((float*)(ws + WS_COSM))[e] = __cosf(r); ((float*)(ws + WS_SINM))[e] = __sinf(r); }
    for (int l = 0; l < DEPTH; ++l) {
        const float* w2 = a.in[19] + (size_t)l * 64 * 512; const float* a2 = a.in[21] + (size_t)l * 64 * 512; const float* g2 = a.in[22] + (size_t)l * 128 * 512;
        const float* v2 = a.in[25] + (size_t)(l > 0 ? l - 1 : 0) * 32 * 512;
        bf16* Lt = (bf16*)(ws + WS_WLORA) + (size_t)l * 2048 * 512;
        for (int w = gt; w < 2048 * 64; w += NGT) { const int kg = w >> 11, n = w & 2047, seg = n >> 9, j = n & 511; float v[8];
#pragma unroll
            for (int i = 0; i < 8; ++i) { const int k = kg * 8 + i; float x = 0.f;
                if (seg == 0) { if (k < 64) x = w2[k * 512 + j]; }
                else if (seg == 1) { if (k >= 128 && k < 192) x = a2[(k - 128) * 512 + j]; }
                else if (seg == 2) { if (k >= 256 && k < 384) x = g2[(k - 256) * 512 + j]; }
                else { if (l > 0 && k >= 384 && k < 416) x = v2[(k - 384) * 512 + j]; }
                v[i] = x; }
            u32x4 o; o.x = pk2(v[0], v[1]); o.y = pk2(v[2], v[3]); o.z = pk2(v[4], v[5]); o.w = pk2(v[6], v[7]);
            *(GAS u32x4*)(Lt + (size_t)n * 512 + kg * 8) = o; }
    }
    { const int gw = F.bid * NWAVES + F.wave, NGW = F.G * NWAVES; float* rss = (float*)(ws + WS_RSSA);
      for (int m = gw; m < S; m += NGW) { const GAS f32x4* xr = (const GAS f32x4*)(a.in[0] + (size_t)m * D) + F.lane; GAS u32x2* o8 = (GAS u32x2*)((bf16*)(ws + WS_XN) + (size_t)m * D) + F.lane; float sq = 0.f;
#pragma unroll
          for (int j = 0; j < 8; ++j) { const f32x4 v = xr[64 * j]; sq += (v.x * v.x + v.y * v.y) + (v.z * v.z + v.w * v.w); u32x2 o; o.x = pk2(v.x, v.y); o.y = pk2(v.z, v.w); o8[64 * j] = o; }
          sq = wave_sum(sq); if (F.lane < 32) rss[(size_t)m * 32 + F.lane] = (F.lane == 0) ? sq : 0.f; } }
    int base = 0;
    for (int l = 0; l < DEPTH; ++l) {
        conv_job(F, ConvJob{a.in[3] + (size_t)l * D * NIN, (bf16*)(ws + WS_WIN) + (size_t)l * NINP * D, a.in[2] + (size_t)l * D, D, NIN, NINP, 1}, base);
        conv_job(F, ConvJob{a.in[34] + (size_t)l * D * 2 * DFF, (bf16*)(ws + WS_WGU) + (size_t)l * 2 * DFF * D, a.in[33] + (size_t)l * D, D, 2 * DFF, 2 * DFF, 2}, base);
        conv_job(F, ConvJob{a.in[35] + (size_t)l * DFF * D, (bf16*)(ws + WS_WDN) + (size_t)l * D * DFF, nullptr, DFF, D, D, 0}, base);
        conv_job(F, ConvJob{a.in[32] + (size_t)l * D * D, (bf16*)(ws + WS_WOUT) + (size_t)l * D * D, nullptr, D, D, D, 0}, base);
        for (int n = 0; n < 4; ++n)
            conv_job(F, ConvJob{a.in[31] + ((size_t)l * 4 + n) * 512 * D, (bf16*)(ws + WS_WBR) + ((size_t)l * 4 + n) * D * 512, nullptr, 512, D, D, 0}, base);
        conv_job(F, ConvJob{a.in[12] + (size_t)l * 512 * 768, (bf16*)(ws + WS_WQB) + (size_t)l * 1024 * 512, a.in[11] + (size_t)l * 512, 512, 768, 1024, 3}, base);
        conv_job(F, ConvJob{a.in[14] + (size_t)l * 256 * 1024, (bf16*)(ws + WS_WKVB) + (size_t)l * 1024 * 256, a.in[13] + (size_t)l * 256, 256, 1024, 1024, 0}, base);
        if (l > 0) conv_job(F, ConvJob{a.in[24] + (size_t)(l - 1) * 512 * 32, (bf16*)(ws + WS_WV1) + (size_t)l * 256 * 512, nullptr, 512, 32, 256, 4}, base);
    }
}

DI void p_rmsnorm(Frame& F, const float* x, const float* w, bf16* out) {
    const int gw = F.bid * NWAVES + F.wave, NGW = F.G * NWAVES;
    for (int m = gw; m < S; m += NGW) {
        const GAS f32x4* xr = (const GAS f32x4*)(x + (size_t)m * D) + F.lane; f32x4 v[8]; float s = 0.f;
#pragma unroll
        for (int j = 0; j < 8; ++j) { v[j] = xr[64 * j]; s += (v[j].x * v[j].x + v[j].y * v[j].y) + (v[j].z * v[j].z + v[j].w * v[j].w); }
        const float rstd = rsqrtf(wave_sum(s) * (1.f / D) + 1e-6f);
        const GAS f32x4* wr = (const GAS f32x4*)w + F.lane;
        GAS u32x2* o8 = (GAS u32x2*)(out + (size_t)m * D) + F.lane;
#pragma unroll
        for (int j = 0; j < 8; ++j) { const f32x4 ww = wr[64 * j]; u32x2 o; o.x = pk2(v[j].x * rstd * ww.x, v[j].y * rstd * ww.y); o.y = pk2(v[j].z * rstd * ww.z, v[j].w * rstd * ww.w); o8[64 * j] = o; }
    }
}

DI f32x4 bf4_(const u32x2 w) { return (f32x4){bf2f(w.x & 0xffffu), bf2f(w.x >> 16), bf2f(w.y & 0xffffu), bf2f(w.y >> 16)}; }
DI u32x2 pk4_(const f32x4 v) { u32x2 o; o.x = pk2(v.x, v.y); o.y = pk2(v.z, v.w); return o; }
DI void p_rwkv_prep(Frame& F, int l) {
    unsigned char* ws = F.ws;
    const bf16* RW = (const bf16*)(ws + WS_RW); const float* prm = (const float*)(ws + WS_PRM) + (size_t)l * PRM_STRIDE; const float* mu = prm + P_MU; const float* kk_w = prm + P_KK;
    const int gw = F.bid * NWAVES + F.wave, NGW = F.G * NWAVES, lane = F.lane;
    for (int t = gw; t < S; t += NGW) {
        const bf16* p = RW + (size_t)t * 1792 + 8 * lane; const bf16* pp = RW + (size_t)(t > 0 ? t - 1 : 0) * 1792 + 8 * lane;
        float pm[4][8];
#pragma unroll
        for (int jj = 0; jj < 4; ++jj) if (jj < 3 || lane < 32) { float c[8], pv[8]; unpack8(*(const GAS u32x4*)(p + 512 * jj), c); unpack8(*(const GAS u32x4*)(pp + 512 * jj), pv);
            const f32x4 m0 = *(const GAS f32x4*)(mu + 512 * jj + 8 * lane), m1 = *(const GAS f32x4*)(mu + 512 * jj + 8 * lane + 4);
#pragma unroll
            for (int i = 0; i < 8; ++i) { const float pvv = (t == 0) ? 0.f : pv[i]; pm[jj][i] = c[i] + (pvv - c[i]) * (i < 4 ? m0[i] : m1[i - 4]); } }
        const size_t ro = (size_t)t * 512 + 8 * lane;
        *(GAS u32x4*)((bf16*)(ws + WS_R32) + ro) = pack8((f32x4){pm[0][0], pm[0][1], pm[0][2], pm[0][3]}, (f32x4){pm[0][4], pm[0][5], pm[0][6], pm[0][7]});
        { const f32x4 kw0 = *(const GAS f32x4*)(kk_w + 8 * lane), kw1 = *(const GAS f32x4*)(kk_w + 8 * lane + 4); float kk[8]; float ss = 0.f;
#pragma unroll
          for (int i = 0; i < 8; ++i) { kk[i] = pm[1][i] * (i < 4 ? kw0[i] : kw1[i - 4]); ss += kk[i] * kk[i]; }
          ss = row_sum8(ss);
          const float inv = fminf(__builtin_amdgcn_rsqf(ss), 1e12f);
          *(GAS u32x4*)((bf16*)(ws + WS_K32) + ro) = pack8((f32x4){pm[1][0], pm[1][1], pm[1][2], pm[1][3]}, (f32x4){pm[1][4], pm[1][5], pm[1][6], pm[1][7]});
          *(GAS u32x4*)((bf16*)(ws + WS_KKN) + ro) = pack8((f32x4){kk[0], kk[1], kk[2], kk[3]} * inv, (f32x4){kk[4], kk[5], kk[6], kk[7]} * inv); }
        { const u32x4 vb = pack8((f32x4){pm[2][0], pm[2][1], pm[2][2], pm[2][3]}, (f32x4){pm[2][4], pm[2][5], pm[2][6], pm[2][7]});
          *(GAS u32x4*)((bf16*)(ws + WS_VV) + ro) = vb; if (l == 0) *(GAS u32x4*)((bf16*)(ws + WS_VFIRST) + ro) = vb; }
        { bf16* ar = (bf16*)(ws + WS_ALORA) + (size_t)t * 512;
          if (lane < 32) { float y[8]; int dst;
              if (lane < 8) { _Pragma("unroll") for (int i = 0; i < 8; ++i) y[i] = ftanh_(pm[3][i]); dst = 8 * lane; }
              else if (lane < 16) { _Pragma("unroll") for (int i = 0; i < 8; ++i) y[i] = pm[3][i]; dst = 128 + 8 * (lane - 8); }
              else { _Pragma("unroll") for (int i = 0; i < 8; ++i) y[i] = sigmoidf_(pm[3][i]); dst = 256 + 8 * (lane - 16); }
              *(GAS u32x4*)(ar + dst) = pack8((f32x4){y[0], y[1], y[2], y[3]}, (f32x4){y[4], y[5], y[6], y[7]}); }
          else { const int z = 8 * (lane - 32); const int zd = z < 64 ? 64 + z : (z < 128 ? 192 + (z - 64) : 384 + (z - 128));
              unsigned zz = 0u; asm volatile("" : "+v"(zz));
              *(GAS u32x4*)(ar + zd) = (u32x4){zz, zz, zz, zz}; } }
    }
}

DI void p_mamba_prep(Frame& F, int l) {
    unsigned char* ws = F.ws;
    const bf16* XBC = (const bf16*)(ws + WS_XBC); bf16* XC = (bf16*)(ws + WS_XC);
    const float* prm = (const float*)(ws + WS_PRM) + (size_t)l * PRM_STRIDE; const float* cw = prm + P_CW; const float* cb = prm + P_CB;
    for (int u = F.bid; u < 2 * NCH; u += F.G) {
        const int ch = 2 * F.tid, t0 = (u >> 1) * 64 + (u & 1) * 32;
        float w0[4], w1[4];
#pragma unroll
        for (int k = 0; k < 4; ++k) { const f32x2 wv = *(const GAS f32x2*)(cw + k * 1024 + ch); w0[k] = wv.x; w1[k] = wv.y; }
        const f32x2 bv = *(const GAS f32x2*)(cb + ch);
        float h0[3], h1[3];
#pragma unroll
        for (int k = 0; k < 3; ++k) { const int t = t0 - 3 + k; unsigned x = 0u; if (t >= 0) x = *(const GAS unsigned*)(XBC + (size_t)t * 1024 + ch); h0[k] = bf2f(x & 0xffffu); h1[k] = bf2f(x >> 16); }
        unsigned xin[32];
#pragma unroll
        for (int i = 0; i < 32; ++i) xin[i] = *(const GAS unsigned*)(XBC + (size_t)(t0 + i) * 1024 + ch);
#pragma unroll
        for (int i = 0; i < 32; ++i) { const float x0 = bf2f(xin[i] & 0xffffu), x1 = bf2f(xin[i] >> 16);
            const float y0 = bv.x + w0[0] * h0[0] + w0[1] * h0[1] + w0[2] * h0[2] + w0[3] * x0, y1 = bv.y + w1[0] * h1[0] + w1[1] * h1[1] + w1[2] * h1[2] + w1[3] * x1;
            h0[0] = h0[1]; h0[1] = h0[2]; h0[2] = x0; h1[0] = h1[1]; h1[1] = h1[2]; h1[2] = x1;
            *(GAS unsigned*)(XC + (size_t)(t0 + i) * 1024 + ch) = pk2(siluf_(y0), siluf_(y1)); }
    }
}
DI void u_mamba_dt(Frame& F, int l, int c) {
    unsigned char* ws = F.ws; LAS float* A = (LAS float*)F.lds;
    const float* prm = (const float*)(ws + WS_PRM) + (size_t)l * PRM_STRIDE; const int t = F.tid >> 3, h = F.tid & 7; const size_t row = (size_t)(c * 64 + t);
    const float dt = softplusf_(((const float*)(ws + WS_MISC))[row * 256 + h] + prm[P_DTB + h]);
    A[F.tid] = dt * -fexp_(prm[P_ALOG + h]);
    ((float*)(ws + WS_DTS))[row * 8 + h] = dt;
    __syncthreads();
    float cs = 0.f;
#pragma unroll 16
    for (int tt = 0; tt < 64; ++tt) { const float v = A[tt * 8 + h]; cs += (tt <= t) ? v : 0.f; }
    ((float*)(ws + WS_ACS))[row * 8 + h] = cs;
    __syncthreads();
}

DI void p_scans(Frame& F, int nblk) {
    unsigned char* ws = F.ws;
    const int gt = F.bid * NTHR + F.tid, NGT = nblk * NTHR;
    for (int q = gt; q < 32768; q += NGT) {
        const int e = q * 4; const bool ret = e < 65536; const int e2 = ret ? e : e - 65536, h = ret ? (e >> 14) : (e2 >> 13);
        float* p = (float*)(ws + (ret ? WS_RKV : WS_MST)) + e2; const float* acs = (const float*)(ws + WS_ACS);
        const float rdec = fexp_(log1pf(-exp2f(-5.0f - (float)h)) * 64.0f);
        f32x4 st = (f32x4){0.f, 0.f, 0.f, 0.f};
#pragma unroll 1
        for (int c0 = 0; c0 < NCH; c0 += 16) { f32x4 v[16]; float dc[16];
#pragma unroll
            for (int i = 0; i < 16; ++i) v[i] = *(const GAS f32x4*)(p + (size_t)(c0 + i) * 65536);
#pragma unroll
            for (int i = 0; i < 16; ++i) dc[i] = ret ? rdec : fexp_(acs[(size_t)((c0 + i) * 64 + 63) * 8 + h]);
#pragma unroll
            for (int i = 0; i < 16; ++i) { *(GAS f32x4*)(p + (size_t)(c0 + i) * 65536) = st; st = st * dc[i] + v[i]; } }
    }
}


namespace pg8 {
DI unsigned char* lw(unsigned char* p) { unsigned long long w = (unsigned long long)p; asm volatile("" : "+s"(w)); return (unsigned char*)w; }
DI void st8bf(bf16* p, const f32x4 a, const f32x4 b) { *(GAS u32x4*)p = pack8(a, b); }
DI void st8f(float* p, const f32x4 a, const f32x4 b) { *(GAS f32x4*)p = a; *((GAS f32x4*)p + 1) = b; }
DI f32x4 map4(const f32x4 v, float (*f)(float)) { return (f32x4){f(v.x), f(v.y), f(v.z), f(v.w)}; }

DI void scale_rows(Acc& acc, const LAS float* rt, int rl0) {
#pragma unroll
    for (int ai = 0; ai < 2; ++ai)
#pragma unroll
        for (int m = 0; m < 4; ++m) { const float rs = rt[rl0 + ai * HALF + m * 16];
#pragma unroll
            for (int bj = 0; bj < 2; ++bj)
#pragma unroll
                for (int n = 0; n < 2; ++n) acc[ai][bj][m][n] = acc[ai][bj][m][n] * rs; }
}
template <class Sched> DI void fill_rstd(LAS float* rtab, const float* rss, const Sched& Sc, int tid) {
    pg8::Unit u;
    for (int i = 0; Sc.next(i, u); ++i) if (tid < 256) { const float* p = rss + (size_t)(u.pm * BM + tid) * 32; float s = 0.f;
#pragma unroll
        for (int q = 0; q < 8; ++q) { const f32x4 v = *(const GAS f32x4*)(p + 4 * q); s += (v.x + v.y) + (v.z + v.w); }
        rtab[i * 256 + tid] = rsqrtf(s * (1.f / D) + 1e-6f); }
    __syncthreads();
}
struct TileDesc { unsigned long long off; int ld, cb, kind, slot; };
constexpr TileDesc mk_tile(int T) {
    return T < 2 ? TileDesc{WS_QR, 512, 0, 0, 0} : T < 4 ? TileDesc{WS_KR, 512, 0, 1, 0}
         : T < 6 ? TileDesc{WS_VR, 512, (T - 4) * 256, 2, 0} : T < 8 ? TileDesc{WS_GR, 512, (T - 6) * 256, 3, 0} : T < 10 ? TileDesc{WS_ZS, 512, (T - 8) * 256, 3, 0}
         : T < 14 ? TileDesc{WS_XBC, 1024, (T - 10) * 256, 2, 0} : T < 16 ? TileDesc{WS_CQ, 512, (T - 14) * 256, 5, (T - 14) * 4} : T == 16 ? TileDesc{WS_CKV, 256, 0, 5, 8}
         : T < 24 ? TileDesc{WS_RW, 1792, (T - 17) * 256, 2, 0} : T < 56 ? TileDesc{WS_GATE, 8192, (T - 24) * 64, 7, 0} : TileDesc{WS_MISC, 256, 0, 6, 0};
}
struct TileTab { TileDesc d[57]; };
constexpr TileTab mk_tiletab() { TileTab t{}; for (int i = 0; i < 57; ++i) t.d[i] = mk_tile(i); return t; }
__constant__ TileTab g_tiletab = mk_tiletab();

struct EpiIn {
    static constexpr bool AFTER_DRAIN = false;
    unsigned char* ws_; int tile_off; const LAS float* rtab;
    DI bool operator()(Acc& acc, const Unit& u, int wr, int wc, int fr, int fq) const {
        unsigned char* ws = lw(ws_);
        const int T = u.pn + tile_off, row0 = u.pm * BM + wr * 64 + fr, c0 = wc * 32 + fq * 8;
        scale_rows(acc, rtab + u.ord * 256, wr * 64 + fr);
        const TileDesc d = g_tiletab.d[T]; const int kind = d.kind;
        if (kind < 2) {
            const int head = 2 * (T & 1) + (c0 >> 6), j0 = c0 & 63; const float sc = kind ? 0.08838834764831845f : 1.0f;
            bf16* dst = (bf16*)(ws + d.off); const float* cs = (const float*)(ws + WS_COSR); const float* sn = (const float*)(ws + WS_SINR);
#pragma unroll
            for (int ai = 0; ai < 2; ++ai)
#pragma unroll
                for (int m = 0; m < 4; ++m) { const int row = row0 + ai * HALF + m * 16;
                    const f32x4 ca = *(const GAS f32x4*)(cs + (size_t)row * 64 + j0), cb = *(const GAS f32x4*)(cs + (size_t)row * 64 + j0 + 4);
                    const f32x4 sa = *(const GAS f32x4*)(sn + (size_t)row * 64 + j0), sb = *(const GAS f32x4*)(sn + (size_t)row * 64 + j0 + 4);
                    const f32x4 x1a = acc[ai][0][m][0], x1b = acc[ai][0][m][1], x2a = acc[ai][1][m][0], x2b = acc[ai][1][m][1];
                    bf16* o = dst + (size_t)row * 512 + head * 128 + j0;
                    st8bf(o, (x1a * ca - x2a * sa) * sc, (x1b * cb - x2b * sb) * sc);
                    st8bf(o + 64, (x2a * ca + x1a * sa) * sc, (x2b * cb + x1b * sb) * sc); }
            return true;
        }
        if (kind == 7) {
            const int nb0 = (fq & 1) * 2; bf16* dst = (bf16*)(ws + d.off) + d.cb + wc * 16 + (fq & 2) * 4 + nb0 * 2048;
#pragma unroll
            for (int ai = 0; ai < 2; ++ai)
#pragma unroll
                for (int m = 0; m < 4; ++m) { const size_t ro = (size_t)(row0 + ai * HALF + m * 16) * 8192; f32x4 sv[4], gv[4];
#pragma unroll
                    for (int nb = 0; nb < 4; ++nb) { const f32x4 x = acc[ai][nb >> 1][m][nb & 1];
#pragma unroll
                        for (int i = 0; i < 4; ++i) { const float sk = 1.0f + fminf(fexp_(-x[i]), 1e30f); sv[nb][i] = sk; gv[nb][i] = __builtin_amdgcn_rcpf(sk); } }
                    u32x2 p0 = pk4_(gv[0] * sv[1]), p1 = pk4_(gv[1] * sv[2]), p2 = pk4_(gv[2] * sv[3]), p3 = pk4_(gv[3]);
                    XR_SWAP("v_permlane16_swap_b32", p0.x, p2.x); XR_SWAP("v_permlane16_swap_b32", p0.y, p2.y); XR_SWAP("v_permlane16_swap_b32", p1.x, p3.x); XR_SWAP("v_permlane16_swap_b32", p1.y, p3.y);
                    *(GAS u32x4*)(dst + ro) = (u32x4){p0.x, p0.y, p2.x, p2.y}; *(GAS u32x4*)(dst + ro + 2048) = (u32x4){p1.x, p1.y, p3.x, p3.y}; }
            return true;
        }
        if (kind == 6) {
            float* dst = (float*)(ws + d.off) + d.cb + c0;
#pragma unroll
            for (int ai = 0; ai < 2; ++ai)
#pragma unroll
                for (int m = 0; m < 4; ++m) { const int row = row0 + ai * HALF + m * 16;
#pragma unroll
                    for (int bj = 0; bj < 2; ++bj) st8f(dst + (size_t)row * d.ld + bj * HALF, acc[ai][bj][m][0], acc[ai][bj][m][1]); }
            return true;
        }
        {
            bf16* dst = (bf16*)(ws + d.off) + d.cb + c0; float* ssq = (float*)(ws + WS_SSQ) + d.slot + wc;
            const float am = (kind == 3 || kind == 4) ? 1.f : 0.f, xm = (kind == 4) ? 0.f : 1.f;
#pragma unroll
            for (int ai = 0; ai < 2; ++ai)
#pragma unroll
                for (int m = 0; m < 4; ++m) { const int row = row0 + ai * HALF + m * 16; float ss = 0.f;
#pragma unroll
                    for (int bj = 0; bj < 2; ++bj) { f32x4 a = acc[ai][bj][m][0], b = acc[ai][bj][m][1];
                        ss += (a.x * a.x + a.y * a.y) + (a.z * a.z + a.w * a.w) + (b.x * b.x + b.y * b.y) + (b.z * b.z + b.w * b.w);
                        if (am != 0.f) {
#pragma unroll
                            for (int i = 0; i < 4; ++i) { const float s0 = sigmoidf_(a[i]), s1 = sigmoidf_(b[i]); a[i] = (xm != 0.f) ? a[i] * s0 : s0; b[i] = (xm != 0.f) ? b[i] * s1 : s1; } }
                        st8bf(dst + (size_t)row * d.ld + bj * HALF, a, b); }
                    if (kind == 5) { ss = xr32_sum(xr16_sum(ss)); if (fq == 0) ssq[(size_t)row * 16] = ss; } }
        }
        return true;
    }
};

struct EpiMisc {
    static constexpr bool AFTER_DRAIN = false;
    unsigned char* ws_; const LAS float* rtab;
    DI bool operator()(Acc& acc, const Unit& u, int wr, int wc, int fr, int fq) const {
        float* dst = (float*)(lw(ws_) + WS_MISC) + wc * 32 + fq * 8; const int row0 = u.pm * BM + wr * 64 + fr;
        scale_rows(acc, rtab + u.ord * 256, wr * 64 + fr);
#pragma unroll
        for (int ai = 0; ai < 2; ++ai)
#pragma unroll
            for (int m = 0; m < 4; ++m) { const int row = row0 + ai * HALF + m * 16;
#pragma unroll
                for (int bj = 0; bj < 2; ++bj) st8f(dst + (size_t)row * 256 + bj * HALF, acc[ai][bj][m][0], acc[ai][bj][m][1]); }
        return true;
    }
};

struct EpiQb {
    static constexpr bool AFTER_DRAIN = true;
    unsigned char* ws; const float* qnw;
    DI bool operator()(Acc&, const Unit&, int, int, int, int) const { return true; }
    DI void fused(Acc& acc, const Unit& u, int wr, int wc, int fr, int fq, LAS unsigned char* lds, int wid, int lane, int tid) const {
        const int h = u.pn, row0 = u.pm * BM + wr * 64 + fr, c0 = wc * 32 + fq * 8;
        const float* ssq = (const float*)(ws + WS_SSQ); LAS float* P = (LAS float*)lds;
        const float QS = 0.07216878364870322f * LOG2E;
#pragma unroll
        for (int ai = 0; ai < 2; ++ai)
#pragma unroll
            for (int m = 0; m < 4; ++m) { const int row = row0 + ai * HALF + m * 16, rl = ai * HALF + wr * 64 + m * 16 + fr;
                const f32x4 s0 = *(const GAS f32x4*)(ssq + (size_t)row * 16), s1 = *(const GAS f32x4*)(ssq + (size_t)row * 16 + 4);
                const float rs = rsqrtf(((s0.x + s0.y) + (s0.z + s0.w) + (s1.x + s1.y) + (s1.z + s1.w)) * (1.f / 512.f) + 1e-6f);
                float ss = 0.f;
#pragma unroll
                for (int bj = 0; bj < 2; ++bj)
#pragma unroll
                    for (int n = 0; n < 2; ++n) { f32x4 a = acc[ai][bj][m][n] * rs; acc[ai][bj][m][n] = a; ss += (a.x * a.x + a.y * a.y) + (a.z * a.z + a.w * a.w); }
                ss = xr32_sum(xr16_sum(ss));
                if (fq == 0) P[rl * 4 + wc] = ss; }
        __syncthreads();
        bf16* QM = (bf16*)(ws + WS_QM); const float* cs = (const float*)(ws + WS_COSM); const float* sn = (const float*)(ws + WS_SINM);
#pragma unroll
        for (int ai = 0; ai < 2; ++ai)
#pragma unroll
            for (int m = 0; m < 4; ++m) { const int row = row0 + ai * HALF + m * 16, rl = ai * HALF + wr * 64 + m * 16 + fr;
                const f32x4 pp = *(const LAS f32x4*)(P + rl * 4); const float rq = rsqrtf(((pp.x + pp.y) + (pp.z + pp.w)) * (1.f / 192.f) + 1e-6f) * QS;
                bf16* o = QM + (size_t)row * 768 + h * 192;
                if (wc < 3) {
                    const f32x4 wa = *(const GAS f32x4*)(qnw + c0), wb = *(const GAS f32x4*)(qnw + c0 + 4);
                    st8bf(o + c0, acc[ai][0][m][0] * rq * wa, acc[ai][0][m][1] * rq * wb);
                    if (wc == 0) { const f32x4 wc4 = *(const GAS f32x4*)(qnw + 96 + c0), wd = *(const GAS f32x4*)(qnw + 100 + c0);
                        st8bf(o + 96 + c0, acc[ai][1][m][0] * rq * wc4, acc[ai][1][m][1] * rq * wd); }
                } else {
                    const int i0 = 8 * fq;
                    const f32x4 w1a = *(const GAS f32x4*)(qnw + 128 + i0), w1b = *(const GAS f32x4*)(qnw + 132 + i0), w2a = *(const GAS f32x4*)(qnw + 160 + i0), w2b = *(const GAS f32x4*)(qnw + 164 + i0);
                    const f32x4 ca = *(const GAS f32x4*)(cs + (size_t)row * 32 + i0), cb = *(const GAS f32x4*)(cs + (size_t)row * 32 + i0 + 4), sa = *(const GAS f32x4*)(sn + (size_t)row * 32 + i0), sb = *(const GAS f32x4*)(sn + (size_t)row * 32 + i0 + 4);
                    const f32x4 x1a = acc[ai][0][m][0] * rq * w1a, x1b = acc[ai][0][m][1] * rq * w1b, x2a = acc[ai][1][m][0] * rq * w2a, x2b = acc[ai][1][m][1] * rq * w2b;
                    st8bf(o + 128 + i0, x1a * ca - x2a * sa, x1b * cb - x2b * sb);
                    st8bf(o + 160 + i0, x2a * ca + x1a * sa, x2b * cb + x1b * sb);
                } }
        __syncthreads();
    }
};

struct EpiKvb {
    static constexpr bool AFTER_DRAIN = true;
    unsigned char* ws; const float* knw;
    DI bool operator()(Acc&, const Unit&, int, int, int, int) const { return true; }
    DI void fused(Acc& acc, const Unit& u, int wr, int wc, int fr, int fq, LAS unsigned char* lds, int wid, int lane, int tid) const {
        const int h = u.pn, row0 = u.pm * BM + wr * 64 + fr, c0 = wc * 32 + fq * 8;
        const float* ssq = (const float*)(ws + WS_SSQ); const float* misc = (const float*)(ws + WS_MISC);
        LAS float* P = (LAS float*)lds; LAS float* KRS = P + 1024; LAS float* RK = P + 1280;
        LAS bf16* VTs = (LAS bf16*)(lds + 8192);
        if (tid < 256) { const float* kr = misc + (size_t)(u.pm * BM + tid) * 256 + 8; float s = 0.f;
#pragma unroll
            for (int i = 0; i < 16; ++i) { const f32x4 v = *(const GAS f32x4*)(kr + 4 * i); s += (v.x * v.x + v.y * v.y) + (v.z * v.z + v.w * v.w); }
            KRS[tid] = s; }
#pragma unroll
        for (int ai = 0; ai < 2; ++ai)
#pragma unroll
            for (int m = 0; m < 4; ++m) { const int row = row0 + ai * HALF + m * 16, rl = ai * HALF + wr * 64 + m * 16 + fr;
                const f32x4 s0 = *(const GAS f32x4*)(ssq + (size_t)row * 16 + 8);
                const float rs = rsqrtf(((s0.x + s0.y) + (s0.z + s0.w)) * (1.f / 256.f) + 1e-6f);
                float ss = 0.f;
#pragma unroll
                for (int bj = 0; bj < 2; ++bj)
#pragma unroll
                    for (int n = 0; n < 2; ++n) { f32x4 a = acc[ai][bj][m][n] * rs; acc[ai][bj][m][n] = a; if (bj == 0) ss += (a.x * a.x + a.y * a.y) + (a.z * a.z + a.w * a.w); }
                ss = xr32_sum(xr16_sum(ss));
                if (fq == 0) P[rl * 4 + wc] = ss; }
        __syncthreads();
        if (tid < 256) { const f32x4 pp = *(const LAS f32x4*)(P + tid * 4); RK[tid] = rsqrtf(((pp.x + pp.y) + (pp.z + pp.w) + KRS[tid]) * (1.f / 192.f) + 1e-6f); }
        __syncthreads();
        bf16* KM = (bf16*)(ws + WS_KM); bf16* VT = (bf16*)(ws + WS_VT);
        const f32x4 wa = *(const GAS f32x4*)(knw + c0), wb = *(const GAS f32x4*)(knw + c0 + 4);
#pragma unroll
        for (int ai = 0; ai < 2; ++ai)
#pragma unroll
            for (int m = 0; m < 4; ++m) { const int row = row0 + ai * HALF + m * 16, rl = ai * HALF + wr * 64 + m * 16 + fr;
                const float rk = RK[rl];
                st8bf(KM + (size_t)row * 768 + h * 192 + c0, acc[ai][0][m][0] * rk * wa, acc[ai][0][m][1] * rk * wb);
#pragma unroll
                for (int n = 0; n < 2; ++n)
#pragma unroll
                    for (int i = 0; i < 4; ++i) VTs[(c0 + n * 4 + i) * 264 + rl] = (bf16)f2bf(acc[ai][1][m][n][i]); }
        {
            const int rl = tid >> 1, hf = tid & 1, row = u.pm * BM + rl, i0 = 16 * hf; const float rk = RK[rl];
            const float* kr = misc + (size_t)row * 256 + 8; const float* cs = (const float*)(ws + WS_COSM) + (size_t)row * 32; const float* sn = (const float*)(ws + WS_SINM) + (size_t)row * 32;
            bf16* o = KM + (size_t)row * 768 + h * 192 + 128;
#pragma unroll
            for (int q = 0; q < 2; ++q) { f32x4 o1[2], o2[2];
#pragma unroll
                for (int e = 0; e < 2; ++e) { const int i = i0 + 8 * q + 4 * e;
                    const f32x4 x1 = *(const GAS f32x4*)(kr + i) * *(const GAS f32x4*)(knw + 128 + i), x2 = *(const GAS f32x4*)(kr + 32 + i) * *(const GAS f32x4*)(knw + 160 + i);
                    const f32x4 c = *(const GAS f32x4*)(cs + i), s = *(const GAS f32x4*)(sn + i);
                    o1[e] = (x1 * c - x2 * s) * rk; o2[e] = (x2 * c + x1 * s) * rk; }
                st8bf(o + i0 + 8 * q, o1[0], o1[1]); st8bf(o + 32 + i0 + 8 * q, o2[0], o2[1]); }
        }
        __syncthreads();
#pragma unroll
        for (int k = 0; k < 8; ++k) { const int p = tid + 512 * k, dv = p >> 5, c8 = (p & 31) * 8; *(GAS u32x4*)(VT + (size_t)(h * 128 + dv) * S + u.pm * BM + c8) = *(const LAS u32x4*)(VTs + dv * 264 + c8); }
        __syncthreads();
    }
};

struct EpiV1 {
    static constexpr bool AFTER_DRAIN = false;
    unsigned char* ws_;
    DI bool operator()(Acc& acc, const Unit& u, int wr, int wc, int fr, int fq) const {
        if (wc != 0) return true;
        unsigned char* ws = lw(ws_);
        const int row0 = u.pm * BM + wr * 64 + fr; bf16* dst = (bf16*)(ws + WS_ALORA);
#pragma unroll
        for (int ai = 0; ai < 2; ++ai)
#pragma unroll
            for (int m = 0; m < 4; ++m) { const int row = row0 + ai * HALF + m * 16; st8bf(dst + (size_t)row * 512 + 384 + fq * 8, acc[ai][0][m][0], acc[ai][0][m][1]); }
        return true;
    }
};

struct EpiLora {
    static constexpr bool AFTER_DRAIN = false;
    unsigned char* ws_; const float* w0; const float* a0; const float* v0; const float* ka;
#define LORA_LOOP(BODY) _Pragma("unroll") for (int ai = 0; ai < 2; ++ai) _Pragma("unroll") for (int m = 0; m < 4; ++m) { const size_t ro = (size_t)(row0 + ai * HALF + m * 16) * 512; \
        _Pragma("unroll") for (int bj = 0; bj < 2; ++bj) _Pragma("unroll") for (int n = 0; n < 2; ++n) { const int j = jb + bj * HALF + n * 4; const size_t o = ro + j; const f32x4 x = acc[ai][bj][m][n]; BODY } }
#define LORA_LOOP8(BODY) _Pragma("unroll") for (int ai = 0; ai < 2; ++ai) _Pragma("unroll") for (int m = 0; m < 4; ++m) { const size_t ro = (size_t)(row0 + ai * HALF + m * 16) * 512; \
        _Pragma("unroll") for (int bj = 0; bj < 2; ++bj) { const int j = jb + bj * HALF; const size_t o = ro + j; const f32x4 x0 = acc[ai][bj][m][0]; const f32x4 x1 = acc[ai][bj][m][1]; BODY } }
    DI bool operator()(Acc& acc, const Unit& u, int wr, int wc, int fr, int fq) const {
        unsigned char* ws = lw(ws_);
        const int seg = u.pn >> 1, row0 = u.pm * BM + wr * 64 + fr, jb = (u.pn & 1) * 256 + wc * 32 + fq * 8;
        if (seg == 0) { float* dec = (float*)(ws + WS_DEC);
            LORA_LOOP({ const f32x4 b = *(const GAS f32x4*)(w0 + j); f32x4 r;
                _Pragma("unroll") for (int i = 0; i < 4; ++i) { const float u_ = b[i] + x[i]; const float sp = fmaxf(-u_, 0.f) + __logf(1.0f + fexp_(-fabsf(u_))); r[i] = -fexp_(-sp - 0.5f); }
                *(GAS f32x4*)(dec + o) = r; })
        } else if (seg == 1) { const bf16* k32 = (const bf16*)(ws + WS_K32); const bf16* kkn_ = (const bf16*)(ws + WS_KKN); bf16* kp_ = (bf16*)(ws + WS_KP); bf16* bb_ = (bf16*)(ws + WS_BB);
            LORA_LOOP8({ float k[8]; float kkn[8]; unpack8(*(const GAS u32x4*)(k32 + o), k); unpack8(*(const GAS u32x4*)(kkn_ + o), kkn);
                const f32x4 b0 = *(const GAS f32x4*)(a0 + j); const f32x4 b1 = *(const GAS f32x4*)(a0 + j + 4); const f32x4 ka0 = *(const GAS f32x4*)(ka + j); const f32x4 ka1 = *(const GAS f32x4*)(ka + j + 4);
                f32x4 kp0; f32x4 kp1; f32x4 bb0; f32x4 bb1;
                _Pragma("unroll") for (int i = 0; i < 4; ++i) { const float av0 = sigmoidf_(b0[i] + x0[i]); const float av1 = sigmoidf_(b1[i] + x1[i]);
                    kp0[i] = k[i] * (1.0f + (av0 - 1.0f) * ka0[i]); kp1[i] = k[4 + i] * (1.0f + (av1 - 1.0f) * ka1[i]); bb0[i] = kkn[i] * av0; bb1[i] = kkn[4 + i] * av1; }
                *(GAS u32x4*)(kp_ + o) = pack8(kp0, kp1); *(GAS u32x4*)(bb_ + o) = pack8(bb0, bb1); })
        } else if (seg == 2) { bf16* g32 = (bf16*)(ws + WS_G32);
            LORA_LOOP8({ *(GAS u32x4*)(g32 + o) = pack8(x0, x1); })
        } else { bf16* vv = (bf16*)(ws + WS_VV); const bf16* vf_ = (const bf16*)(ws + WS_VFIRST);
            LORA_LOOP8({ float v[8]; float vf[8]; unpack8(*(const GAS u32x4*)(vv + o), v); unpack8(*(const GAS u32x4*)(vf_ + o), vf);
                const f32x4 b0 = *(const GAS f32x4*)(v0 + j); const f32x4 b1 = *(const GAS f32x4*)(v0 + j + 4); f32x4 r0; f32x4 r1;
                _Pragma("unroll") for (int i = 0; i < 4; ++i) { r0[i] = v[i] + (vf[i] - v[i]) * sigmoidf_(b0[i] + x0[i]); r1[i] = v[4 + i] + (vf[4 + i] - v[4 + i]) * sigmoidf_(b1[i] + x1[i]); }
                *(GAS u32x4*)(vv + o) = pack8(r0, r1); })
        }
        return true;
    }
#undef LORA_LOOP
#undef LORA_LOOP8
};

struct EpiBranch {
    static constexpr bool AFTER_DRAIN = false;
    unsigned char* ws_;
    DI bool operator()(Acc& acc, const Unit& u, int wr, int wc, int fr, int fq) const {
        unsigned char* ws = lw(ws_);
        const int nb = u.sub, row0 = u.pm * BM + wr * 64 + fr, cb = u.pn * BM + wc * 32 + fq * 8;
        const bf16* G = (const bf16*)(ws + WS_GATE) + nb * D; bf16* M = (bf16*)(ws + WS_MERGED);
#pragma unroll
        for (int ai = 0; ai < 2; ++ai)
#pragma unroll
            for (int m = 0; m < 4; ++m) { const int row = row0 + ai * HALF + m * 16;
#pragma unroll
                for (int bj = 0; bj < 2; ++bj) { const int col = cb + bj * HALF;
                    float g[8]; unpack8(*(const GAS u32x4*)(G + (size_t)row * 8192 + col), g);
                    const f32x4 a = acc[ai][bj][m][0] * (f32x4){g[0], g[1], g[2], g[3]}, b = acc[ai][bj][m][1] * (f32x4){g[4], g[5], g[6], g[7]};
                    if (nb < 3) { acc[ai][bj][m][0] = a; acc[ai][bj][m][1] = b; } else st8bf(M + (size_t)row * D + col, a, b); } }
        return nb == 3;
    }
};

struct EpiRes {
    static constexpr bool AFTER_DRAIN = false;
    const float* xin; float* out; bf16* xb; float* rss;
    DI bool operator()(Acc& acc, const Unit& u, int wr, int wc, int fr, int fq) const {
        const int row0 = u.pm * BM + wr * 64 + fr, cb = u.pn * BM + wc * 32 + fq * 8;
#pragma unroll
        for (int ai = 0; ai < 2; ++ai)
#pragma unroll
            for (int m = 0; m < 4; ++m) { const int row = row0 + ai * HALF + m * 16; float ss = 0.f;
#pragma unroll
                for (int bj = 0; bj < 2; ++bj) { const size_t o = (size_t)row * D + cb + bj * HALF;
                    const f32x4 a = *(const GAS f32x4*)(xin + o) + acc[ai][bj][m][0], b = *(const GAS f32x4*)(xin + o + 4) + acc[ai][bj][m][1];
                    st8f(out + o, a, b); st8bf(xb + o, a, b);
                    ss += (a.x * a.x + a.y * a.y) + (a.z * a.z + a.w * a.w) + (b.x * b.x + b.y * b.y) + (b.z * b.z + b.w * b.w); }
                if (rss) { ss = xr32_sum(xr16_sum(ss)); if (fq == 0) rss[(size_t)row * 32 + u.pn * 4 + wc] = ss; } }
        return true;
    }
};

struct EpiGu {
    static constexpr bool AFTER_DRAIN = false;
    unsigned char* ws_; const LAS float* rtab;
    DI bool operator()(Acc& acc, const Unit& u, int wr, int wc, int fr, int fq) const {
        unsigned char* ws = lw(ws_);
        scale_rows(acc, rtab + u.ord * 256, wr * 64 + fr);
        const int row0 = u.pm * BM + wr * 64 + fr, cb = u.pn * 128 + wc * 32 + fq * 8; bf16* A = (bf16*)(ws + WS_ACT);
#pragma unroll
        for (int ai = 0; ai < 2; ++ai)
#pragma unroll
            for (int m = 0; m < 4; ++m) { const int row = row0 + ai * HALF + m * 16;
                st8bf(A + (size_t)row * DFF + cb, map4(acc[ai][0][m][0], siluf_) * acc[ai][1][m][0], map4(acc[ai][0][m][1], siluf_) * acc[ai][1][m][1]); }
        return true;
    }
};
}

DI bf16x8 ldfrag(const LAS bf16* M, int ld, int r0, int k0, int lane) { return *(const LAS bf16x8*)(M + (r0 + (lane & 15)) * ld + k0 + 8 * (lane >> 4)); }
#define MFMA16(a, b, c) __builtin_amdgcn_mfma_f32_16x16x32_bf16((a), (b), (c), 0, 0, 0)
DI void stage_nat(LAS bf16* dst, int lp, const bf16* src, size_t gp, int rows, int cols8, int tid) {
    for (int p = tid; p < rows * cols8; p += NTHR) { const int r = p / cols8, c = p - r * cols8; *(LAS u32x4*)(dst + r * lp + c * 8) = *(const GAS u32x4*)(src + (size_t)r * gp + c * 8); }
}
DI void stage_tr(LAS bf16* dst, int lp, const bf16* src, size_t gp, int rows, int cols8, int tid) {
    for (int p = tid; p < rows * cols8; p += NTHR) { const int r = p / cols8, c = p - r * cols8; const u32x4 w = *(const GAS u32x4*)(src + (size_t)r * gp + c * 8);
        LAS bf16* d = dst + (c * 8) * lp + r;
        d[0] = (bf16)(w.x & 0xffffu); d[lp] = (bf16)(w.x >> 16); d[2 * lp] = (bf16)(w.y & 0xffffu); d[3 * lp] = (bf16)(w.y >> 16);
        d[4 * lp] = (bf16)(w.z & 0xffffu); d[5 * lp] = (bf16)(w.z >> 16); d[6 * lp] = (bf16)(w.w & 0xffffu); d[7 * lp] = (bf16)(w.w >> 16); }
}
DI float ret_loggamma(int h) { return log1pf(-exp2f(-5.0f - (float)h)); }

DI void u_ret_kv(Frame& F, int c, int h) {
    int tid_ = F.tid; asm volatile("" : "+v"(tid_));
    unsigned char* ws = F.ws; const int tid = tid_, lane = tid_ & 63, w = F.wave;
    LAS bf16* Kt = (LAS bf16*)F.lds; LAS bf16* Vt = Kt + 128 * 72;
    const bf16* KR = (const bf16*)(ws + WS_KR) + (size_t)(c * 64) * 512 + h * 128; const bf16* VR = (const bf16*)(ws + WS_VR) + (size_t)(c * 64) * 512 + h * 128;
    const float lg = ret_loggamma(h);
    for (int p = tid; p < 1024; p += NTHR) { const int m = p >> 4, d0 = (p & 15) * 8; float k[8]; unpack8(*(const GAS u32x4*)(KR + (size_t)m * 512 + d0), k); const float sc = fexp_(lg * (float)(63 - m));
        LAS bf16* d = Kt + d0 * 72 + m;
#pragma unroll
        for (int i = 0; i < 8; ++i) d[i * 72] = (bf16)f2bf(k[i] * sc); }
    stage_tr(Vt, 72, VR, 512, 64, 16, tid);
    __syncthreads();
    f32x4 acc[8];
#pragma unroll
    for (int bn = 0; bn < 8; ++bn) acc[bn] = (f32x4){0.f, 0.f, 0.f, 0.f};
#pragma unroll
    for (int ks = 0; ks < 2; ++ks) { const bf16x8 a = ldfrag(Kt, 72, 16 * w, 32 * ks, lane);
#pragma unroll
        for (int bn = 0; bn < 8; ++bn) acc[bn] = MFMA16(a, ldfrag(Vt, 72, 16 * bn, 32 * ks, lane), acc[bn]); }
    float* out = (float*)(ws + WS_RKV) + ((size_t)(c * 4 + h) * 128) * 128;
    __syncthreads();
    { LAS float* T = (LAS float*)F.lds;
#pragma unroll
      for (int bn = 0; bn < 8; ++bn)
#pragma unroll
          for (int r = 0; r < 4; ++r) T[(16 * w + 4 * (lane >> 4) + r) * 132 + 16 * bn + (lane & 15)] = acc[bn][r];
      __syncthreads();
#pragma unroll
      for (int k = 0; k < 8; ++k) { const int p = tid + 512 * k, row = p >> 5, c4 = (p & 31) * 4; *(GAS f32x4*)(out + (size_t)row * 128 + c4) = *(const LAS f32x4*)(T + row * 132 + c4); } }
    __syncthreads();
}

DI void u_ret_out(Frame& F, int l_, int c, int h) {
    int tid_ = F.tid; asm volatile("" : "+v"(tid_));
    unsigned char* ws = F.ws; const int tid = tid_, lane = tid_ & 63, w = F.wave;
    LAS bf16* Qs = (LAS bf16*)F.lds; LAS bf16* Ks = Qs + 64 * 136; LAS bf16* Vt = Ks + 64 * 136; LAS bf16* St = Vt + 128 * 72; LAS bf16* Ps = St + 128 * 136; LAS float* Os = (LAS float*)(Ps + 64 * 72);
    const size_t rowb = (size_t)(c * 64) * 512 + h * 128;
    stage_nat(Qs, 136, (const bf16*)(ws + WS_QR) + rowb, 512, 64, 16, tid);
    stage_nat(Ks, 136, (const bf16*)(ws + WS_KR) + rowb, 512, 64, 16, tid);
    stage_tr(Vt, 72, (const bf16*)(ws + WS_VR) + rowb, 512, 64, 16, tid);
    { const float* sp = (const float*)(ws + WS_RKV) + ((size_t)(c * 4 + h) * 128) * 128;
      for (int p = tid; p < 4096; p += NTHR) { const int d = p >> 5, e0 = (p & 31) * 4; const f32x4 v = *(const GAS f32x4*)(sp + (size_t)d * 128 + e0);
          LAS bf16* q = St + e0 * 136 + d; q[0] = (bf16)f2bf(v.x); q[136] = (bf16)f2bf(v.y); q[272] = (bf16)f2bf(v.z); q[408] = (bf16)f2bf(v.w); } }
    __syncthreads();
    const float lg = ret_loggamma(h); const int g4 = lane >> 4, lc = lane & 15;
    {
        const int bm = w >> 1;
#pragma unroll
        for (int q = 0; q < 2; ++q) { const int bn = (w & 1) * 2 + q; f32x4 acc = (f32x4){0.f, 0.f, 0.f, 0.f};
#pragma unroll
            for (int ks = 0; ks < 4; ++ks) acc = MFMA16(ldfrag(Qs, 136, 16 * bm, 32 * ks, lane), ldfrag(Ks, 136, 16 * bn, 32 * ks, lane), acc);
#pragma unroll
            for (int r = 0; r < 4; ++r) { const int l = 16 * bm + 4 * g4 + r, m = 16 * bn + lc; const int dd = l > m ? l - m : m - l; Ps[l * 72 + m] = (bf16)f2bf(acc[r] * fexp_(lg * (float)dd)); } }
    }
    __syncthreads();
    {
        const int bm = w >> 1;
#pragma unroll
        for (int q = 0; q < 4; ++q) { const int bn = (w & 1) * 4 + q; f32x4 a1 = (f32x4){0.f, 0.f, 0.f, 0.f}, a2 = (f32x4){0.f, 0.f, 0.f, 0.f};
#pragma unroll
            for (int ks = 0; ks < 2; ++ks) a1 = MFMA16(ldfrag(Ps, 72, 16 * bm, 32 * ks, lane), ldfrag(Vt, 72, 16 * bn, 32 * ks, lane), a1);
#pragma unroll
            for (int ks = 0; ks < 4; ++ks) a2 = MFMA16(ldfrag(Qs, 136, 16 * bm, 32 * ks, lane), ldfrag(St, 136, 16 * bn, 32 * ks, lane), a2);
#pragma unroll
            for (int r = 0; r < 4; ++r) { const int l = 16 * bm + 4 * g4 + r; Os[l * 132 + 16 * bn + lc] = a1[r] + fexp_(lg * (float)(l + 1)) * a2[r]; } }
    }
    __syncthreads();
    {
        const float* gw = (const float*)(ws + WS_PRM) + (size_t)l_ * PRM_STRIDE + P_GN + h * 128; const int l = 8 * w + (lane >> 3), e0 = (lane & 7) * 16; const size_t row = (size_t)(c * 64 + l);
        float x[16], gg[16];
#pragma unroll
        for (int q = 0; q < 4; ++q) { const f32x4 v = *(const LAS f32x4*)(Os + l * 132 + e0 + 4 * q); x[4 * q] = v.x; x[4 * q + 1] = v.y; x[4 * q + 2] = v.z; x[4 * q + 3] = v.w; }
        unpack8(*(const GAS u32x4*)((const bf16*)(ws + WS_GR) + row * 512 + h * 128 + e0), *(float(*)[8])&gg[0]); unpack8(*(const GAS u32x4*)((const bf16*)(ws + WS_GR) + row * 512 + h * 128 + e0 + 8), *(float(*)[8])&gg[8]);
        float sm = 0.f;
#pragma unroll
        for (int i = 0; i < 16; ++i) sm += x[i];
        const float mean = row_sum8(sm) * (1.f / 128.f); float sq = 0.f;
#pragma unroll
        for (int i = 0; i < 16; ++i) { x[i] -= mean; sq += x[i] * x[i]; }
        const float rstd = rsqrtf(row_sum8(sq) * (1.f / 128.f) + 1e-5f);
        float ov[16];
#pragma unroll
        for (int q = 0; q < 4; ++q) { const f32x4 wv = *(const GAS f32x4*)(gw + e0 + 4 * q);
#pragma unroll
            for (int i = 0; i < 4; ++i) ov[4 * q + i] = x[4 * q + i] * rstd * wv[i] * gg[4 * q + i]; }
        bf16* ob = (bf16*)(ws + WS_OB) + row * D + h * 128 + e0;
        *(GAS u32x4*)ob = pack8((f32x4){ov[0], ov[1], ov[2], ov[3]}, (f32x4){ov[4], ov[5], ov[6], ov[7]}); *(GAS u32x4*)(ob + 8) = pack8((f32x4){ov[8], ov[9], ov[10], ov[11]}, (f32x4){ov[12], ov[13], ov[14], ov[15]});
    }
    __syncthreads();
}

DI void u_mamba_st(Frame& F, int c, int g) {
    int tid_ = F.tid; asm volatile("" : "+v"(tid_));
    unsigned char* ws = F.ws; const int tid = tid_, lane = tid_ & 63, w = F.wave;
    LAS bf16* Xt = (LAS bf16*)F.lds; LAS bf16* Bt = Xt + 256 * 72;
    const bf16* XC = (const bf16*)(ws + WS_XC) + (size_t)(c * 64) * 1024; const float* dts = (const float*)(ws + WS_DTS) + (size_t)(c * 64) * 8; const float* acs = (const float*)(ws + WS_ACS) + (size_t)(c * 64) * 8;
    for (int p = tid; p < 2048; p += NTHR) { const int l = p >> 5, c0 = (p & 31) * 8, h = g * 4 + (c0 >> 6); float x[8]; unpack8(*(const GAS u32x4*)(XC + (size_t)l * 1024 + g * 256 + c0), x);
        const float sc = dts[l * 8 + h] * fexp_(acs[63 * 8 + h] - acs[l * 8 + h]); LAS bf16* d = Xt + c0 * 72 + l;
#pragma unroll
        for (int i = 0; i < 8; ++i) d[i * 72] = (bf16)f2bf(x[i] * sc); }
    stage_tr(Bt, 72, XC + 512 + g * 128, 1024, 64, 16, tid);
    __syncthreads();
    f32x4 acc[2][8];
#pragma unroll
    for (int i = 0; i < 2; ++i)
#pragma unroll
        for (int bn = 0; bn < 8; ++bn) acc[i][bn] = (f32x4){0.f, 0.f, 0.f, 0.f};
#pragma unroll
    for (int ks = 0; ks < 2; ++ks) { const bf16x8 a0 = ldfrag(Xt, 72, 32 * w, 32 * ks, lane), a1 = ldfrag(Xt, 72, 32 * w + 16, 32 * ks, lane);
#pragma unroll
        for (int bn = 0; bn < 8; ++bn) { const bf16x8 b = ldfrag(Bt, 72, 16 * bn, 32 * ks, lane); acc[0][bn] = MFMA16(a0, b, acc[0][bn]); acc[1][bn] = MFMA16(a1, b, acc[1][bn]); } }
    float* out = (float*)(ws + WS_MST) + ((size_t)(c * 8 + g * 4) * 64) * 128;
    __syncthreads();
    { LAS float* T = (LAS float*)F.lds;
#pragma unroll
      for (int i = 0; i < 2; ++i)
#pragma unroll
          for (int bn = 0; bn < 8; ++bn)
#pragma unroll
              for (int r = 0; r < 4; ++r) T[(32 * w + 16 * i + 4 * (lane >> 4) + r) * 132 + 16 * bn + (lane & 15)] = acc[i][bn][r];
      __syncthreads();
#pragma unroll
      for (int k = 0; k < 16; ++k) { const int p = tid + 512 * k, row = p >> 5, c4 = (p & 31) * 4; *(GAS f32x4*)(out + (size_t)row * 128 + c4) = *(const LAS f32x4*)(T + row * 132 + c4); } }
    __syncthreads();
}

struct MambaLds { LAS bf16* Cs; LAS bf16* Bs; LAS float* CB; LAS bf16* Ph; LAS bf16* Xt; LAS bf16* Sh; LAS float* AC; LAS float* DT; LAS float* SSQ; };
DI void mamba_head(Frame& F, const MambaLds& L, const bf16* XC, const float* sp, int g, int hh, float dsk, const bf16* const (&zrow)[4], f32x4 (&y)[2]) {
    const int tid = F.tid, lane = F.lane, w = F.wave, g4 = lane >> 4, lc = lane & 15, bm = w >> 1;
    __syncthreads();
    { const int l = tid >> 3, m0 = (tid & 7) * 8; const float al = L.AC[l * 4 + hh]; float pv[8];
#pragma unroll
      for (int i = 0; i < 8; ++i) { const int m = m0 + i; pv[i] = (m <= l) ? L.CB[l * 68 + m] * fexp_(al - L.AC[m * 4 + hh]) * L.DT[m * 4 + hh] : 0.f; }
      u32x4 o; o.x = pk2(pv[0], pv[1]); o.y = pk2(pv[2], pv[3]); o.z = pk2(pv[4], pv[5]); o.w = pk2(pv[6], pv[7]); *(LAS u32x4*)(L.Ph + l * 72 + m0) = o; }
    stage_tr(L.Xt, 72, XC + g * 256 + hh * 64, 1024, 64, 8, tid);
    for (int p = tid; p < 1024; p += NTHR) { const int pr = p >> 4, n0 = (p & 15) * 8; const f32x4 v0 = *(const GAS f32x4*)(sp + (size_t)pr * 128 + n0), v1 = *(const GAS f32x4*)(sp + (size_t)pr * 128 + n0 + 4);
        *(LAS u32x4*)(L.Sh + pr * 136 + n0) = pack8(v0, v1); }
    __syncthreads();
#pragma unroll
    for (int q = 0; q < 2; ++q) { const int bn = (w & 1) * 2 + q; f32x4 yd = (f32x4){0.f, 0.f, 0.f, 0.f}, yo = (f32x4){0.f, 0.f, 0.f, 0.f};
#pragma unroll
        for (int ks = 0; ks < 2; ++ks) yd = MFMA16(ldfrag(L.Ph, 72, 16 * bm, 32 * ks, lane), ldfrag(L.Xt, 72, 16 * bn, 32 * ks, lane), yd);
#pragma unroll
        for (int ks = 0; ks < 4; ++ks) yo = MFMA16(ldfrag(L.Cs, 136, 16 * bm, 32 * ks, lane), ldfrag(L.Sh, 136, 16 * bn, 32 * ks, lane), yo);
#pragma unroll
        for (int r = 0; r < 4; ++r) { const int l = 16 * bm + 4 * g4 + r, p = 16 * bn + lc; const float x = bf2f(L.Xt[p * 72 + l]);
            const float z = bf2f(zrow[r][hh * 64 + q * 16]);
            y[q][r] = (yd[r] + fexp_(L.AC[l * 4 + hh]) * yo[r] + x * dsk) * z; } }
}
DI void u_mamba_out(Frame& F, int l_, int c, int g) {
    int tid_ = F.tid; asm volatile("" : "+v"(tid_));
    unsigned char* ws = F.ws; const int tid = tid_, lane = tid_ & 63, w = F.wave, g4 = lane >> 4, lc = lane & 15;
    MambaLds L; L.Cs = (LAS bf16*)F.lds; L.Bs = L.Cs + 64 * 136; L.CB = (LAS float*)(L.Bs + 64 * 136); L.Ph = (LAS bf16*)(L.CB + 64 * 68); L.Xt = L.Ph + 64 * 72; L.Sh = L.Xt + 64 * 72;
    L.AC = (LAS float*)(L.Sh + 64 * 136); L.DT = L.AC + 256; L.SSQ = L.DT + 256;
    LAS bf16* Y = (LAS bf16*)(L.SSQ + 128);
    const bf16* XC = (const bf16*)(ws + WS_XC) + (size_t)(c * 64) * 1024;
    stage_nat(L.Cs, 136, XC + 768 + g * 128, 1024, 64, 16, tid);
    stage_nat(L.Bs, 136, XC + 512 + g * 128, 1024, 64, 16, tid);
    if (tid < 256) { const int l = tid >> 2, hh = tid & 3; L.AC[tid] = ((const float*)(ws + WS_ACS))[(size_t)(c * 64 + l) * 8 + g * 4 + hh]; L.DT[tid] = ((const float*)(ws + WS_DTS))[(size_t)(c * 64 + l) * 8 + g * 4 + hh]; }
    __syncthreads();
    const int bm = w >> 1;
#pragma unroll
    for (int q = 0; q < 2; ++q) { const int bn = (w & 1) * 2 + q; f32x4 acc = (f32x4){0.f, 0.f, 0.f, 0.f};
#pragma unroll
        for (int ks = 0; ks < 4; ++ks) acc = MFMA16(ldfrag(L.Cs, 136, 16 * bm, 32 * ks, lane), ldfrag(L.Bs, 136, 16 * bn, 32 * ks, lane), acc);
#pragma unroll
        for (int r = 0; r < 4; ++r) L.CB[(16 * bm + 4 * g4 + r) * 68 + 16 * bn + lc] = acc[r]; }
    const int pcol = 16 * ((w & 1) * 2) + lc;
    const bf16* zrow[4];
#pragma unroll
    for (int r = 0; r < 4; ++r) { const size_t row = (size_t)(c * 64 + 16 * bm + 4 * g4 + r); zrow[r] = (const bf16*)(ws + WS_ZS) + row * 512 + g * 256 + pcol; }
    const float* mst = (const float*)(ws + WS_MST) + ((size_t)(c * 8 + g * 4) * 64) * 128; const float* prm = (const float*)(ws + WS_PRM) + (size_t)l_ * PRM_STRIDE; const float* dskp = prm + P_SD + g * 4;
    float ss[4] = {0.f, 0.f, 0.f, 0.f};
#pragma unroll 1
    for (int hh = 0; hh < 4; ++hh) { f32x4 y[2]; mamba_head(F, L, XC, mst + (size_t)hh * 64 * 128, g, hh, dskp[hh], zrow, y);
#pragma unroll
        for (int q = 0; q < 2; ++q)
#pragma unroll
            for (int r = 0; r < 4; ++r) { ss[r] += y[q][r] * y[q][r]; Y[(16 * bm + 4 * g4 + r) * 264 + hh * 64 + pcol + q * 16] = (bf16)f2bf(y[q][r]); } }
#pragma unroll
    for (int r = 0; r < 4; ++r) { float t = ss[r]; t = row_sum16(t);
        if (lc == 0) L.SSQ[(16 * bm + 4 * g4 + r) * 2 + (w & 1)] = t; }
    __syncthreads();
    {
        const int l = tid >> 3, c0 = (tid & 7) * 32; const float rstd = rsqrtf((L.SSQ[l * 2] + L.SSQ[l * 2 + 1]) * (1.f / 256.f) + 1e-6f);
        const float* nw = prm + P_SNW + g * 256 + c0; bf16* orow = (bf16*)(ws + WS_OB) + (size_t)(c * 64 + l) * D + 512 + g * 256 + c0;
#pragma unroll
        for (int q = 0; q < 4; ++q) { float v[8]; unpack8(*(const LAS u32x4*)(Y + l * 264 + c0 + 8 * q), v);
            const f32x4 w0 = *(const GAS f32x4*)(nw + 8 * q), w1 = *(const GAS f32x4*)(nw + 8 * q + 4);
            *(GAS u32x4*)(orow + 8 * q) = pack8((f32x4){v[0], v[1], v[2], v[3]} * rstd * w0, (f32x4){v[4], v[5], v[6], v[7]} * rstd * w1); } }
    __syncthreads();
}

DI void u_attn2(Frame& F, int h, int qb, int sp, int ntile) {
    int tid_ = F.tid; asm volatile("" : "+v"(tid_));
    unsigned char* ws = F.ws; const int tid = tid_, lane = tid & 63, w = F.wave, g4 = lane >> 4, lc = lane & 15;
    LAS bf16* Ks = (LAS bf16*)F.lds; LAS bf16* Vs = Ks + 64 * 200;
    const bf16* QM = (const bf16*)(ws + WS_QM); const bf16* KM = (const bf16*)(ws + WS_KM) + h * 192; const bf16* VT = (const bf16*)(ws + WS_VT) + (size_t)(h * 128) * S;
    const int q0 = qb * 256 + w * 32, cw = 4 * qb + (w >> 1);
    bf16x8 qf[2][6];
#pragma unroll
    for (int qq = 0; qq < 2; ++qq)
#pragma unroll
        for (int ks = 0; ks < 6; ++ks) qf[qq][ks] = *(const GAS bf16x8*)(QM + (size_t)(q0 + qq * 16 + lc) * 768 + h * 192 + ks * 32 + g4 * 8);
    f32x4 o[8][2]; float mrun[2], lrun[2];
#pragma unroll
    for (int db = 0; db < 8; ++db)
#pragma unroll
        for (int qq = 0; qq < 2; ++qq) o[db][qq] = (f32x4){0.f, 0.f, 0.f, 0.f};
    mrun[0] = mrun[1] = -1e30f; lrun[0] = lrun[1] = 0.f;
    u32x4 kreg[3], vreg[2];
    const int kt0 = 16 * sp;
#define AT_LOAD(kt) { const int key0_ = (kt) * 64; \
        _Pragma("unroll") for (int i = 0; i < 3; ++i) { const int p = tid + 512 * i, r = p / 24, cc = p - r * 24; kreg[i] = *(const GAS u32x4*)(KM + (size_t)(key0_ + r) * 768 + cc * 8); } \
        _Pragma("unroll") for (int i = 0; i < 2; ++i) { const int p = tid + 512 * i, r = p >> 3, cc = p & 7; vreg[i] = *(const GAS u32x4*)(VT + (size_t)r * S + key0_ + cc * 8); } }
    AT_LOAD(kt0)
    for (int t = 0; t < ntile; ++t) {
        const int kt = kt0 + t;
        __syncthreads();
#pragma unroll
        for (int i = 0; i < 3; ++i) { const int p = tid + 512 * i, r = p / 24, cc = p - r * 24; *(LAS u32x4*)(Ks + r * 200 + cc * 8) = kreg[i]; }
#pragma unroll
        for (int i = 0; i < 2; ++i) { const int p = tid + 512 * i, r = p >> 3, cc = p & 7; *(LAS u32x4*)(Vs + r * 72 + cc * 8) = vreg[i]; }
        __syncthreads();
        if (t + 1 < ntile) AT_LOAD(kt + 1)
        if (kt <= cw) {
            f32x4 s[4][2];
#pragma unroll
            for (int kb = 0; kb < 4; ++kb)
#pragma unroll
                for (int qq = 0; qq < 2; ++qq) s[kb][qq] = (f32x4){0.f, 0.f, 0.f, 0.f};
            {
                bf16x8 kfr[2][4];
#pragma unroll
                for (int kb = 0; kb < 4; ++kb) kfr[0][kb] = ldfrag(Ks, 200, kb * 16, 0, lane);
#pragma unroll
                for (int ks = 0; ks < 6; ++ks) {
                    if (ks < 5) {
#pragma unroll
                        for (int kb = 0; kb < 4; ++kb) kfr[(ks + 1) & 1][kb] = ldfrag(Ks, 200, kb * 16, (ks + 1) * 32, lane); }
#pragma unroll
                    for (int kb = 0; kb < 4; ++kb)
#pragma unroll
                        for (int qq = 0; qq < 2; ++qq) s[kb][qq] = MFMA16(kfr[ks & 1][kb], qf[qq][ks], s[kb][qq]);
                }
            }
            bf16x8 pf[2][2];
#pragma unroll
            for (int qq = 0; qq < 2; ++qq) {
                float mx = -1e30f;
#pragma unroll
                for (int kb = 0; kb < 4; ++kb) mx = fmaxf(mx, fmaxf(fmaxf(s[kb][qq][0], s[kb][qq][1]), fmaxf(s[kb][qq][2], s[kb][qq][3])));
                mx = xr32_max(xr16_max(mx));
                const float mn = fmaxf(mrun[qq], mx), alpha = __builtin_amdgcn_exp2f(mrun[qq] - mn); mrun[qq] = mn;
                float ps = 0.f; float p[16];
#pragma unroll
                for (int kb = 0; kb < 4; ++kb)
#pragma unroll
                    for (int r = 0; r < 4; ++r) { p[kb * 4 + r] = __builtin_amdgcn_exp2f(s[kb][qq][r] - mn); ps += p[kb * 4 + r]; }
                ps = xr32_sum(xr16_sum(ps));
                lrun[qq] = lrun[qq] * alpha + ps;
if (__builtin_amdgcn_ballot_w64(alpha != 1.0f) != 0ull) {
#pragma unroll
                    for (int db = 0; db < 8; ++db) o[db][qq] = o[db][qq] * alpha; }
#pragma unroll
                for (int s2 = 0; s2 < 2; ++s2) { u32x4 pw; pw.x = pk2(p[8 * s2], p[8 * s2 + 1]); pw.y = pk2(p[8 * s2 + 2], p[8 * s2 + 3]); pw.z = pk2(p[8 * s2 + 4], p[8 * s2 + 5]); pw.w = pk2(p[8 * s2 + 6], p[8 * s2 + 7]); pf[qq][s2] = __builtin_bit_cast(bf16x8, pw); }
            }
            {
                bf16x8 vfr[2][2];
#define AT_VLD(dst, db_) { _Pragma("unroll") for (int s2 = 0; s2 < 2; ++s2) { const LAS bf16* vp = Vs + ((db_) * 16 + lc) * 72 + 32 * s2 + 4 * g4; \
                    const u32x2 v0 = *(const LAS u32x2*)vp, v1 = *(const LAS u32x2*)(vp + 16); const u32x4 vw = (u32x4){v0.x, v0.y, v1.x, v1.y}; dst[s2] = __builtin_bit_cast(bf16x8, vw); } }
                AT_VLD(vfr[0], 0)
#pragma unroll
                for (int db = 0; db < 8; ++db) {
                    if (db < 7) AT_VLD(vfr[(db + 1) & 1], db + 1)
#pragma unroll
                    for (int s2 = 0; s2 < 2; ++s2)
#pragma unroll
                        for (int qq = 0; qq < 2; ++qq) o[db][qq] = MFMA16(vfr[db & 1][s2], pf[qq][s2], o[db][qq]);
                }
#undef AT_VLD
            }
        }
    }
#undef AT_LOAD
    const int slot = att_slot(h, qb, sp);
    bf16* po = (bf16*)(ws + WS_APO) + (size_t)slot * 32768; float* pm = (float*)(ws + WS_APM) + (size_t)slot * 512;
#pragma unroll
    for (int db = 0; db < 8; ++db)
#pragma unroll
        for (int qq = 0; qq < 2; ++qq) *(GAS u32x2*)(po + (size_t)(w * 32 + qq * 16 + lc) * 128 + db * 16 + 4 * g4) = pk4_(o[db][qq]);
    if (g4 == 0) {
#pragma unroll
        for (int qq = 0; qq < 2; ++qq) { *(GAS f32x2*)(pm + (w * 32 + qq * 16 + lc) * 2) = (f32x2){mrun[qq], lrun[qq]}; } }
    __syncthreads();
}
DI void u_attn_comb(Frame& F, int h, int qb, int qq) {
    unsigned char* ws = F.ws; const int tid = F.tid, q = qq * 64 + (tid >> 3), dv0 = (tid & 7) * 16;
    const int ns = (qb + 4) >> 2, slot0 = att_slot(h, qb, 0);
    const float* pm = (const float*)(ws + WS_APM) + (size_t)slot0 * 512 + q * 2; const bf16* po = (const bf16*)(ws + WS_APO) + (size_t)slot0 * 32768 + (size_t)q * 128 + dv0;
    float mstar = -1e30f;
    for (int s = 0; s < ns; ++s) mstar = fmaxf(mstar, pm[(size_t)s * 512]);
    float lt = 0.f; float ov[16];
#pragma unroll
    for (int i = 0; i < 16; ++i) ov[i] = 0.f;
    for (int s = 0; s < ns; ++s) { const float sc = __builtin_amdgcn_exp2f(pm[(size_t)s * 512] - mstar); lt += pm[(size_t)s * 512 + 1] * sc;
        float v[16]; unpack8(*(const GAS u32x4*)(po + (size_t)s * 32768), *(float(*)[8])&v[0]); unpack8(*(const GAS u32x4*)(po + (size_t)s * 32768 + 8), *(float(*)[8])&v[8]);
#pragma unroll
        for (int i = 0; i < 16; ++i) ov[i] += v[i] * sc; }
    const float inv = 1.0f / lt;
    bf16* ob = (bf16*)(ws + WS_OB) + (size_t)(qb * 256 + q) * D + 1024 + h * 128 + dv0;
    u32x4 o0, o1; o0.x = pk2(ov[0] * inv, ov[1] * inv); o0.y = pk2(ov[2] * inv, ov[3] * inv); o0.z = pk2(ov[4] * inv, ov[5] * inv); o0.w = pk2(ov[6] * inv, ov[7] * inv);
    o1.x = pk2(ov[8] * inv, ov[9] * inv); o1.y = pk2(ov[10] * inv, ov[11] * inv); o1.z = pk2(ov[12] * inv, ov[13] * inv); o1.w = pk2(ov[14] * inv, ov[15] * inv);
    *(GAS u32x4*)ob = o0; *(GAS u32x4*)(ob + 8) = o1;
}

DI void u_rwkv_r1(Frame& F, int c, int h) {
    int tid_ = F.tid; asm volatile("" : "+v"(tid_));
    unsigned char* ws = F.ws; const int tid = tid_, lane = tid_ & 63, w = F.wave, g4 = lane >> 4, lc = lane & 15;
    LAS float* CUM = (LAS float*)F.lds;
    LAS float* PT = CUM + 64 * 68;
    LAS bf16* AT = (LAS bf16*)(PT + 64); LAS bf16* BH = AT + 4608; LAS bf16* KH = BH + 4608; LAS bf16* RT = KH + 4608;
    LAS bf16* AJ = RT + 4608; LAS bf16* BJ = AJ + 4608; LAS bf16* KJ = BJ + 4608; LAS bf16* VJ = KJ + 4608;
    LAS bf16* MAK = VJ + 4608; LAS bf16* MRBT = MAK + 4608; LAS bf16* MRKT = MRBT + 4608; LAS bf16* X1 = MRKT + 4608; LAS bf16* X2 = X1 + 4608;
    LAS bf16* WT = AT; LAS bf16* G1 = BH; LAS bf16* G2 = KH; LAS bf16* CST = MAK;
    const size_t gb = (size_t)(c * 64) * 512 + h * 64; const int unit = c * 8 + h;
    const int t = tid >> 3, j0 = (tid & 7) * 8;
    const size_t go = gb + (size_t)t * 512 + j0;
    float lw[8];
    { const f32x4 x0 = *(const GAS f32x4*)((const float*)(ws + WS_DEC) + go), x1 = *(const GAS f32x4*)((const float*)(ws + WS_DEC) + go + 4);
#pragma unroll
      for (int i = 0; i < 4; ++i) { lw[i] = x0[i]; lw[4 + i] = x1[i]; }
#pragma unroll
      for (int i = 0; i < 8; ++i) CUM[t * 68 + j0 + i] = lw[i]; }
    __syncthreads();
    if (tid < 64) { float s = 0.f;
#pragma unroll 8
        for (int tt = 0; tt < 64; ++tt) { s += CUM[tt * 68 + tid]; CUM[tt * 68 + tid] = s; } }
    __syncthreads();
    {
        float cum[8], cT[8];
#pragma unroll
        for (int i = 0; i < 8; ++i) { cum[i] = CUM[t * 68 + j0 + i]; cT[i] = CUM[63 * 68 + j0 + i]; }
        if (t == 0) {
#pragma unroll
            for (int i = 0; i < 8; ++i) PT[j0 + i] = fexp_(cT[i]); }
        float av[8], bv[8], kv[8], rv[8], vv[8];
#define LD8(dst, OFF) { unpack8(*(const GAS u32x4*)((const bf16*)(ws + (OFF)) + go), dst); }
        LD8(av, WS_KKN) LD8(bv, WS_BB) LD8(kv, WS_KP) LD8(rv, WS_R32) LD8(vv, WS_VV)
#undef LD8
        float at[8], bh[8], kh[8], rt[8], bj[8], kj[8];
#pragma unroll
        for (int i = 0; i < 8; ++i) { const float pprev = fexp_(cum[i] - lw[i]), pinv = fexp_(-cum[i]), pt = fexp_(cum[i]), pend = fexp_(cT[i] - cum[i]);
            at[i] = -av[i] * pprev; bh[i] = bv[i] * pinv; kh[i] = kv[i] * pinv; rt[i] = rv[i] * pt; bj[i] = bv[i] * pend; kj[i] = kv[i] * pend; }
#define ST8(M, v) { u32x4 o; o.x = pk2(v[0], v[1]); o.y = pk2(v[2], v[3]); o.z = pk2(v[4], v[5]); o.w = pk2(v[6], v[7]); *(LAS u32x4*)(M + t * 72 + j0) = o; }
        ST8(AT, at) ST8(BH, bh) ST8(KH, kh) ST8(RT, rt)
#undef ST8
#pragma unroll
        for (int i = 0; i < 8; ++i) { const int o = (j0 + i) * 72 + t; AJ[o] = (bf16)f2bf(at[i]); BJ[o] = (bf16)f2bf(bj[i]); KJ[o] = (bf16)f2bf(kj[i]); VJ[o] = (bf16)f2bf(vv[i]); }
    }
    __syncthreads();
    {
        const int q = w >> 1; const LAS bf16* Am = (q == 0) ? BH : (q == 1) ? KH : RT; const LAS bf16* Bm = (q < 2) ? AT : (q == 2) ? BH : KH;
#pragma unroll
        for (int bi = 0; bi < 2; ++bi) { const int bm = 2 * (w & 1) + bi; const bf16x8 a0 = ldfrag(Am, 72, 16 * bm, 0, lane), a1 = ldfrag(Am, 72, 16 * bm, 32, lane);
#pragma unroll
            for (int bn = 0; bn < 4; ++bn) { f32x4 acc = (f32x4){0.f, 0.f, 0.f, 0.f};
                acc = MFMA16(a0, ldfrag(Bm, 72, 16 * bn, 0, lane), acc); acc = MFMA16(a1, ldfrag(Bm, 72, 16 * bn, 32, lane), acc);
#pragma unroll
                for (int r = 0; r < 4; ++r) { const int row = 16 * bm + 4 * g4 + r, col = 16 * bn + lc; const bool keep = (q < 2) ? (row < col) : (col <= row); const float v = keep ? acc[r] : 0.f;
                    if (q == 0) CUM[row * 68 + col] = v; else { LAS bf16* O = (q == 1) ? MAK : (q == 2) ? MRBT : MRKT; O[row * 72 + col] = (bf16)f2bf(v); } } } }
    }
    __syncthreads();
    {
        LAS bf16* Qn[2] = {BH, X1}; LAS bf16* Qt[2] = {KH, X2}; LAS bf16* Wn[2] = {AT, (LAS bf16*)CUM};
        const int bm = w >> 1; f32x4 wreg[2];
#pragma unroll
        for (int qn = 0; qn < 2; ++qn) { const int bn = (w & 1) * 2 + qn;
#pragma unroll
            for (int r = 0; r < 4; ++r) { const int row = 16 * bm + 4 * g4 + r, col = 16 * bn + lc; const float m = CUM[row * 68 + col]; wreg[qn][r] = m + ((row == col) ? 1.f : 0.f);
                const bf16 mb = (bf16)f2bf(m); Qn[0][row * 72 + col] = mb; Qt[0][col * 72 + row] = mb; Wn[0][row * 72 + col] = (bf16)f2bf(wreg[qn][r]); } }
        __syncthreads();
#pragma unroll
        for (int it = 0; it < 5; ++it) { const int cu = it & 1, nx = cu ^ 1;
            { const bf16x8 a0 = ldfrag(Qn[cu], 72, 16 * bm, 0, lane), a1 = ldfrag(Qn[cu], 72, 16 * bm, 32, lane);
#pragma unroll
              for (int qn = 0; qn < 2; ++qn) { const int bn = (w & 1) * 2 + qn; f32x4 acc = (f32x4){0.f, 0.f, 0.f, 0.f};
                  acc = MFMA16(a0, ldfrag(Qt[cu], 72, 16 * bn, 0, lane), acc); acc = MFMA16(a1, ldfrag(Qt[cu], 72, 16 * bn, 32, lane), acc);
#pragma unroll
                  for (int r = 0; r < 4; ++r) { const int row = 16 * bm + 4 * g4 + r, col = 16 * bn + lc; const bf16 v = (bf16)f2bf(acc[r]); Qn[nx][row * 72 + col] = v; Qt[nx][col * 72 + row] = v; } } }
            __syncthreads();
            { const bf16x8 a0 = ldfrag(Wn[cu], 72, 16 * bm, 0, lane), a1 = ldfrag(Wn[cu], 72, 16 * bm, 32, lane);
#pragma unroll
              for (int qn = 0; qn < 2; ++qn) { const int bn = (w & 1) * 2 + qn;
                  wreg[qn] = MFMA16(a0, ldfrag(Qt[nx], 72, 16 * bn, 0, lane), wreg[qn]); wreg[qn] = MFMA16(a1, ldfrag(Qt[nx], 72, 16 * bn, 32, lane), wreg[qn]); } }
            if (it < 4) {
#pragma unroll
                for (int qn = 0; qn < 2; ++qn) { const int bn = (w & 1) * 2 + qn;
#pragma unroll
                    for (int r = 0; r < 4; ++r) Wn[nx][(16 * bm + 4 * g4 + r) * 72 + 16 * bn + lc] = (bf16)f2bf(wreg[qn][r]); }
            }
        }
        __syncthreads();
#pragma unroll
        for (int qn = 0; qn < 2; ++qn) { const int bn = (w & 1) * 2 + qn;
#pragma unroll
            for (int r = 0; r < 4; ++r) WT[(16 * bn + lc) * 72 + 16 * bm + 4 * g4 + r] = (bf16)f2bf(wreg[qn][r]); }
    }
    __syncthreads();
    {
        const int q = w >> 2, bm = w & 3; const LAS bf16* Am = q ? MAK : AJ; LAS bf16* O = q ? G2 : G1;
        const bf16x8 a0 = ldfrag(Am, 72, 16 * bm, 0, lane), a1 = ldfrag(Am, 72, 16 * bm, 32, lane);
        f32x4 acc[4];
#pragma unroll
        for (int bn = 0; bn < 4; ++bn) { acc[bn] = (f32x4){0.f, 0.f, 0.f, 0.f};
            acc[bn] = MFMA16(a0, ldfrag(WT, 72, 16 * bn, 0, lane), acc[bn]); acc[bn] = MFMA16(a1, ldfrag(WT, 72, 16 * bn, 32, lane), acc[bn]); }
#pragma unroll
        for (int bn = 0; bn < 4; ++bn)
#pragma unroll
            for (int r = 0; r < 4; ++r) O[(16 * bm + 4 * g4 + r) * 72 + 16 * bn + lc] = (bf16)f2bf(acc[bn][r]);
    }
    __syncthreads();
    {
        const int q = w >> 1; const LAS bf16* Am = (q < 2) ? MRBT : BJ; const LAS bf16* Bm = (q & 1) ? G2 : G1;
        f32x4 acc[2][4];
#pragma unroll
        for (int bi = 0; bi < 2; ++bi) { const int bm = 2 * (w & 1) + bi; const bf16x8 a0 = ldfrag(Am, 72, 16 * bm, 0, lane), a1 = ldfrag(Am, 72, 16 * bm, 32, lane);
#pragma unroll
            for (int bn = 0; bn < 4; ++bn) { acc[bi][bn] = (f32x4){0.f, 0.f, 0.f, 0.f};
                acc[bi][bn] = MFMA16(a0, ldfrag(Bm, 72, 16 * bn, 0, lane), acc[bi][bn]); acc[bi][bn] = MFMA16(a1, ldfrag(Bm, 72, 16 * bn, 32, lane), acc[bi][bn]); } }
        LAS bf16* lout = (q == 0) ? AT : (q == 1) ? AJ : (q == 2) ? X1 : CST;
#pragma unroll
        for (int bi = 0; bi < 2; ++bi) { const int bm = 2 * (w & 1) + bi;
#pragma unroll
            for (int bn = 0; bn < 4; ++bn)
#pragma unroll
                for (int r = 0; r < 4; ++r) { const int row = 16 * bm + 4 * g4 + r, col = 16 * bn + lc; float v = acc[bi][bn][r];
                    if (q == 0) v += bf2f(RT[row * 72 + col]); else if (q == 1) v += bf2f(MRKT[row * 72 + col]); else if (q == 2) v += (row == col) ? PT[row] : 0.f; else v += bf2f(KJ[row * 72 + col]);
                    lout[row * 72 + col] = (bf16)f2bf(v); } }
    }
    __syncthreads();
    { const int row = tid >> 3, c8 = (tid & 7) * 8; const size_t go2 = (size_t)unit * 4096 + row * 64 + c8;
      *(GAS u32x4*)((bf16*)(ws + WS_QYT) + go2) = *(const LAS u32x4*)(AT + row * 72 + c8);
      *(GAS u32x4*)((bf16*)(ws + WS_CYT) + go2) = *(const LAS u32x4*)(AJ + row * 72 + c8);
      *(GAS u32x4*)((bf16*)(ws + WS_TST) + go2) = *(const LAS u32x4*)(X1 + row * 72 + c8); }
    {
        const int bm = w >> 1;
        const bf16x8 a0 = ldfrag(CST, 72, 16 * bm, 0, lane), a1 = ldfrag(CST, 72, 16 * bm, 32, lane);
#pragma unroll
        for (int qn = 0; qn < 2; ++qn) { const int bn = (w & 1) * 2 + qn; f32x4 acc = (f32x4){0.f, 0.f, 0.f, 0.f};
            acc = MFMA16(a0, ldfrag(VJ, 72, 16 * bn, 0, lane), acc); acc = MFMA16(a1, ldfrag(VJ, 72, 16 * bn, 32, lane), acc);
#pragma unroll
            for (int r = 0; r < 4; ++r) CUM[(16 * bm + 4 * g4 + r) * 68 + 16 * bn + lc] = acc[r]; }
    }
    __syncthreads();
    { float* nst = (float*)(ws + WS_NST) + (size_t)unit * 4096;
#pragma unroll
      for (int k = 0; k < 2; ++k) { const int p = tid + 512 * k, row = p >> 4, c4 = (p & 15) * 4; *(GAS f32x4*)(nst + row * 64 + c4) = *(const LAS f32x4*)(CUM + row * 68 + c4); } }
    __syncthreads();
}

DI void p_rwkv_scan2(Frame& F, int h) {
    unsigned char* ws = F.ws; const int lane = F.lane, w = F.wave, g4 = lane >> 4, lc = lane & 15;
    constexpr int SLOT_B = 9216 + 17408;
    const bf16* TST = (const bf16*)(ws + WS_TST) + (size_t)h * 4096; const float* NST = (const float*)(ws + WS_NST) + (size_t)h * 4096; bf16* S0 = (bf16*)(ws + WS_S0) + (size_t)h * 4096;
    if (w >= 4) {
        const int lt = (w - 4) * 64 + lane;
        u32x4 rt[8][2]; f32x4 rn[8][4];
#define SC_ISSUE(u, cc) { const size_t ub = (size_t)(cc) * 8 * 4096; \
            _Pragma("unroll") for (int i = 0; i < 2; ++i) { const int p = lt + 256 * i; rt[u][i] = *(const GAS u32x4*)(TST + ub + (size_t)p * 8); } \
            _Pragma("unroll") for (int i = 0; i < 4; ++i) { const int p = lt + 256 * i; rn[u][i] = *(const GAS f32x4*)(NST + ub + (size_t)p * 4); } }
#define SC_WRITE(u, cc) { LAS unsigned char* sl = F.lds + ((cc) & 1) * SLOT_B; \
            _Pragma("unroll") for (int i = 0; i < 2; ++i) { const int p = lt + 256 * i, r = p >> 3, c8 = p & 7; *(LAS u32x4*)(sl + (r * 72 + c8 * 8) * 2) = rt[u][i]; } \
            _Pragma("unroll") for (int i = 0; i < 4; ++i) { const int p = lt + 256 * i, r = p >> 4, c4 = p & 15; *(LAS f32x4*)(sl + 9216 + (r * 68 + c4 * 4) * 4) = rn[u][i]; } }
#pragma unroll
        for (int u = 0; u < 8; ++u) SC_ISSUE(u, u)
        for (int c0 = 0; c0 < NCH; c0 += 8) {
#pragma unroll
            for (int u = 0; u < 8; ++u) { const int c = c0 + u;
                SC_WRITE(u, c)
                SC_ISSUE(u, (c + 8 < NCH) ? c + 8 : NCH - 1)
                asm volatile("s_waitcnt lgkmcnt(0)" ::: "memory"); __builtin_amdgcn_s_barrier(); asm volatile("" ::: "memory");
            }
        }
#undef SC_ISSUE
#undef SC_WRITE
    } else {
        const int ib = w;
        f32x4 st[4];
#pragma unroll
        for (int jb = 0; jb < 4; ++jb) st[jb] = (f32x4){0.f, 0.f, 0.f, 0.f};
        for (int c = 0; c < NCH; ++c) {
            bf16* s0p = S0 + (size_t)c * 8 * 4096 + (size_t)(16 * ib + lc) * 64 + 4 * g4;
            bf16x8 bfr[2];
#pragma unroll
            for (int ks = 0; ks < 2; ++ks) { u32x4 p; p.x = pk2(st[2 * ks][0], st[2 * ks][1]); p.y = pk2(st[2 * ks][2], st[2 * ks][3]); p.z = pk2(st[2 * ks + 1][0], st[2 * ks + 1][1]); p.w = pk2(st[2 * ks + 1][2], st[2 * ks + 1][3]);
                bfr[ks] = __builtin_bit_cast(bf16x8, p);
                *(GAS u32x2*)(s0p + 32 * ks) = (u32x2){p.x, p.y}; *(GAS u32x2*)(s0p + 32 * ks + 16) = (u32x2){p.z, p.w}; }
            asm volatile("s_waitcnt lgkmcnt(0)" ::: "memory"); __builtin_amdgcn_s_barrier(); asm volatile("" ::: "memory");
            const LAS bf16* ts = (const LAS bf16*)(F.lds + (c & 1) * SLOT_B); const LAS float* ns = (const LAS float*)(F.lds + (c & 1) * SLOT_B + 9216);
#pragma unroll
            for (int jb = 0; jb < 4; ++jb) { f32x4 nw;
#pragma unroll
                for (int r = 0; r < 4; ++r) nw[r] = ns[(16 * jb + 4 * g4 + r) * 68 + 16 * ib + lc];
#pragma unroll
                for (int ks = 0; ks < 2; ++ks) { const LAS bf16* ap = ts + (16 * jb + lc) * 72 + 32 * ks + 4 * g4; const u32x2 a0 = *(const LAS u32x2*)ap, a1 = *(const LAS u32x2*)(ap + 16);
                    const u32x4 aw = (u32x4){a0.x, a0.y, a1.x, a1.y}; nw = MFMA16(__builtin_bit_cast(bf16x8, aw), bfr[ks], nw); }
                st[jb] = nw; }
        }
    }
}

DI void u_rwkv_r3(Frame& F, int l_, int c, int h) {
    int tid_ = F.tid; asm volatile("" : "+v"(tid_));
    unsigned char* ws = F.ws; const int tid = tid_, lane = tid_ & 63, w = F.wave, g4 = lane >> 4, lc = lane & 15, unit = c * 8 + h;
    LAS bf16* QY = (LAS bf16*)F.lds; LAS bf16* CY = QY + 4608; LAS bf16* S0s = CY + 4608; LAS bf16* VJ = S0s + 4608; LAS float* Ys = (LAS float*)(VJ + 4608);
    stage_nat(QY, 72, (const bf16*)(ws + WS_QYT) + (size_t)unit * 4096, 64, 64, 8, tid);
    stage_nat(CY, 72, (const bf16*)(ws + WS_CYT) + (size_t)unit * 4096, 64, 64, 8, tid);
    stage_nat(S0s, 72, (const bf16*)(ws + WS_S0) + (size_t)unit * 4096, 64, 64, 8, tid);
    const size_t gb = (size_t)(c * 64) * 512 + h * 64;
    { const int t = tid >> 3, j0 = (tid & 7) * 8; const u32x4 w4 = *(const GAS u32x4*)((const bf16*)(ws + WS_VV) + gb + (size_t)t * 512 + j0); LAS bf16* d = VJ + j0 * 72 + t;
      d[0] = (bf16)(w4.x & 0xffffu); d[72] = (bf16)(w4.x >> 16); d[144] = (bf16)(w4.y & 0xffffu); d[216] = (bf16)(w4.y >> 16); d[288] = (bf16)(w4.z & 0xffffu); d[360] = (bf16)(w4.z >> 16); d[432] = (bf16)(w4.w & 0xffffu); d[504] = (bf16)(w4.w >> 16); }
    __syncthreads();
    { const int bm = w >> 1;
#pragma unroll
      for (int qn = 0; qn < 2; ++qn) { const int bn = (w & 1) * 2 + qn; f32x4 acc = (f32x4){0.f, 0.f, 0.f, 0.f};
#pragma unroll
          for (int ks = 0; ks < 2; ++ks) { acc = MFMA16(ldfrag(QY, 72, 16 * bm, 32 * ks, lane), ldfrag(S0s, 72, 16 * bn, 32 * ks, lane), acc); acc = MFMA16(ldfrag(CY, 72, 16 * bm, 32 * ks, lane), ldfrag(VJ, 72, 16 * bn, 32 * ks, lane), acc); }
#pragma unroll
          for (int r = 0; r < 4; ++r) Ys[(16 * bm + 4 * g4 + r) * 68 + 16 * bn + lc] = acc[r]; } }
    __syncthreads();
    {
        const float* prm = (const float*)(ws + WS_PRM) + (size_t)l_ * PRM_STRIDE + h * 64; const int t = 8 * w + (lane >> 3), i0 = (lane & 7) * 8; const size_t o = gb + (size_t)t * 512 + i0;
        float r8[8], k8[8], v8[8], g8[8];
        unpack8(*(const GAS u32x4*)((const bf16*)(ws + WS_R32) + o), r8); unpack8(*(const GAS u32x4*)((const bf16*)(ws + WS_KP) + o), k8);
        unpack8(*(const GAS u32x4*)((const bf16*)(ws + WS_VV) + o), v8); unpack8(*(const GAS u32x4*)((const bf16*)(ws + WS_G32) + o), g8);
        const f32x4 y0 = *(const LAS f32x4*)(Ys + t * 68 + i0), y1 = *(const LAS f32x4*)(Ys + t * 68 + i0 + 4);
        const f32x4 lw0 = *(const GAS f32x4*)(prm + P_LNW + i0), lw1 = *(const GAS f32x4*)(prm + P_LNW + i0 + 4), lb0 = *(const GAS f32x4*)(prm + P_LNB + i0), lb1 = *(const GAS f32x4*)(prm + P_LNB + i0 + 4);
        const f32x4 rk0 = *(const GAS f32x4*)(prm + P_RK + i0), rk1 = *(const GAS f32x4*)(prm + P_RK + i0 + 4);
        const float mean = row_sum8((y0.x + y0.y) + (y0.z + y0.w) + (y1.x + y1.y) + (y1.z + y1.w)) * (1.f / 64.f);
        const f32x4 d0 = y0 - mean, d1 = y1 - mean;
        const float rstd = rsqrtf(row_sum8((d0.x * d0.x + d0.y * d0.y) + (d0.z * d0.z + d0.w * d0.w) + (d1.x * d1.x + d1.y * d1.y) + (d1.z * d1.z + d1.w * d1.w)) * (1.f / 64.f) + 64e-5f);
        float bsp = 0.f;
#pragma unroll
        for (int i = 0; i < 4; ++i) bsp += r8[i] * k8[i] * rk0[i] + r8[4 + i] * k8[4 + i] * rk1[i];
        const float bs = row_sum8(bsp);
        f32x4 o0, o1;
#pragma unroll
        for (int i = 0; i < 4; ++i) { o0[i] = (d0[i] * rstd * lw0[i] + lb0[i] + bs * v8[i]) * g8[i]; o1[i] = (d1[i] * rstd * lw1[i] + lb1[i] + bs * v8[4 + i]) * g8[4 + i]; }
        *(GAS u32x4*)((bf16*)(ws + WS_OB) + (size_t)(c * 64 + t) * D + 1536 + h * 64 + i0) = pack8(o0, o1);
    }
    __syncthreads();
}

constexpr int STEPS_PER_LAYER = 13, NSTEPS = 1 + DEPTH * STEPS_PER_LAYER;
constexpr int NSCAN_BLK = 8;

__global__ void __launch_bounds__(NTHR, 2) mk_fwd(Args args) {
    extern __shared__ __attribute__((aligned(16))) unsigned char lds_raw[];
    Frame F;
    F.lds = (LAS unsigned char*)lds_raw; F.MISC = (volatile LAS unsigned*)(F.lds + MISC_OFF);
    F.tid = threadIdx.x; F.lane = F.tid & 63; F.wave = __builtin_amdgcn_readfirstlane(F.tid >> 6);
    F.G = gridDim.x; F.bid = blockIdx.x; F.ws = args.ws; F.ctl = (gu32*)(args.ws + WS_CTL);
    for (int u = F.tid; u < (LDS_BYTES - LDSCTL_OFF) / 4; u += NTHR) ((LAS unsigned*)(F.lds + LDSCTL_OFF))[u] = 0u;
    __syncthreads();
    const int lo = args.st_lo, hi = args.st_hi;
    XcdBarrier bar; bar.bar = (unsigned*)(F.ctl + CW_BAR); bar.x = 0; bar.st = nullptr;
    if (hi - lo > 1) bar = xcd_barrier_post((unsigned*)(F.ctl + CW_BAR), F.MISC + 8);
#ifndef MK_MASK
#define MK_MASK 0xFBFEu
#endif
#define EN(k) (((MK_MASK) >> (k)) & 1u)
#ifndef MK_REP
#define MK_REP 0u
#endif
#define REP(k) (((MK_REP) >> (k)) & 1u)
#ifndef MK_DUP
#define MK_DUP 0u
#endif
#define DUP(k, stmt) do { stmt; if (((MK_DUP) >> (k)) & 1u) { stmt; } } while (0)
#define RUN(s) (lo <= (s) && (s) < hi)
#define SEAM(s) do { if ((s) + 1 < hi) xcd_barrier(bar); } while (0)

    if (EN(13) && RUN(0)) { _Pragma("unroll 1") for (int rp = 0; rp <= (int)REP(13); ++rp) { relaunder(F, args.ws, (LAS unsigned char*)lds_raw); p_prologue(F, args); } SEAM(0); }

    for (int l = 0; l < DEPTH; ++l) {
        const int sb = 1 + l * STEPS_PER_LAYER;
        const float* xin = (l == 0) ? args.in[0] : args.out;
        if (EN(0) && RUN(sb + 0)) { _Pragma("unroll 1") for (int rp = 0; rp <= (int)REP(0); ++rp) { relaunder(F, args.ws, (LAS unsigned char*)lds_raw); unsigned char* ws = F.ws; DUP(11, p_rmsnorm(F, xin, (const float*)(ws + WS_PRM) + (size_t)l * PRM_STRIDE + P_N1, (bf16*)(ws + WS_XN))); } SEAM(sb + 0); }
        if (EN(1) && RUN(sb + 1)) { _Pragma("unroll 1") for (int rp = 0; rp <= (int)REP(1); ++rp) { relaunder(F, args.ws, (LAS unsigned char*)lds_raw); unsigned char* ws = F.ws;
            pg8::Gemm g{(const bf16*)(ws + WS_XN), (const bf16*)(ws + WS_WIN) + (size_t)l * NINP * D, D, D, D};
            pg8::StaticOrder So; So.init(S, NINP - 256, F.G, F.bid); pg8::EpiIn E{ws, 0, (const LAS float*)(F.lds + RTAB_OFF)};
            pg8::fill_rstd((LAS float*)(F.lds + RTAB_OFF), (const float*)(ws + WS_RSSA), So, F.tid);
            DUP(6, (pg8::gemm_phase<pg8::EpiIn, pg8::StaticOrder, true>(F.lds, g, So, E, F.tid)));
            } SEAM(sb + 1);
        }
        if (EN(2) && RUN(sb + 2)) { _Pragma("unroll 1") for (int rp = 0; rp <= (int)REP(2); ++rp) { relaunder(F, args.ws, (LAS unsigned char*)lds_raw); unsigned char* ws = F.ws;
            if (F.bid >= F.G - 32) {
                pg8::Gemm g{(const bf16*)(ws + WS_XN), (const bf16*)(ws + WS_WIN) + ((size_t)l * NINP + (NINP - 256)) * D, D, D, D};
                pg8::StaticOrder So; So.init(S, 256, 32, F.bid - (F.G - 32)); pg8::EpiMisc E{ws, (const LAS float*)(F.lds + RTAB_OFF)};
                pg8::fill_rstd((LAS float*)(F.lds + RTAB_OFF), (const float*)(ws + WS_RSSA), So, F.tid);
                pg8::gemm_phase<pg8::EpiMisc, pg8::StaticOrder, true>(F.lds, g, So, E, F.tid);
            } else {
                const int Gs = F.G; F.G = Gs - 32;
                DUP(12, p_rwkv_prep(F, l));
                relaunder(F, args.ws, (LAS unsigned char*)lds_raw); F.G = Gs - 32; DUP(13, p_mamba_prep(F, l));
                __syncthreads(); relaunder(F, args.ws, (LAS unsigned char*)lds_raw); F.G = Gs - 32;
                for (int u = F.bid; u < 512; u += F.G) DUP(5, u_ret_kv(F, u >> 2, u & 3));
                F.G = Gs;
            }
            } SEAM(sb + 2);
        }
        if (EN(3) && RUN(sb + 3)) { _Pragma("unroll 1") for (int rp = 0; rp <= (int)REP(3); ++rp) { relaunder(F, args.ws, (LAS unsigned char*)lds_raw); unsigned char* ws = F.ws;
            { pg8::Gemm g{(const bf16*)(ws + WS_CQ), (const bf16*)(ws + WS_WQB) + (size_t)l * 1024 * 512, 512, 512, 512};
              pg8::StaticOrder So; So.init(S, 1024, F.G, F.bid); pg8::EpiQb E{ws, (const float*)(ws + WS_PRM) + (size_t)l * PRM_STRIDE + P_QNW};
              pg8::gemm_phase<pg8::EpiQb, pg8::StaticOrder, false>(F.lds, g, So, E, F.tid); __syncthreads(); }
            relaunder(F, args.ws, (LAS unsigned char*)lds_raw); ws = F.ws;
            { pg8::Gemm g{(const bf16*)(ws + WS_CKV), (const bf16*)(ws + WS_WKVB) + (size_t)l * 1024 * 256, 256, 256, 256};
              pg8::StaticOrder So; So.init(S, 1024, F.G, (F.bid + 128) % F.G); pg8::EpiKvb E{ws, (const float*)(ws + WS_PRM) + (size_t)l * PRM_STRIDE + P_KNW};
              pg8::gemm_phase<pg8::EpiKvb, pg8::StaticOrder, false>(F.lds, g, So, E, F.tid); __syncthreads(); }
            relaunder(F, args.ws, (LAS unsigned char*)lds_raw); ws = F.ws;
            if (l > 0) { pg8::Gemm g{(const bf16*)(ws + WS_VV), (const bf16*)(ws + WS_WV1) + (size_t)l * 256 * 512, 512, 512, 512};
              pg8::StaticOrder So; So.init(S, 256, F.G, (F.bid + 64) % F.G); pg8::EpiV1 E{ws};
              pg8::gemm_phase<pg8::EpiV1, pg8::StaticOrder, true>(F.lds, g, So, E, F.tid); __syncthreads(); }
            relaunder(F, args.ws, (LAS unsigned char*)lds_raw);
            for (int u = F.bid; u < 256; u += F.G) { u_mamba_dt(F, l, u >> 1); DUP(4, u_mamba_st(F, u >> 1, u & 1)); }
            } SEAM(sb + 3);
        }
        if (EN(4) && RUN(sb + 4)) { _Pragma("unroll 1") for (int rp = 0; rp <= (int)REP(4); ++rp) { relaunder(F, args.ws, (LAS unsigned char*)lds_raw); unsigned char* ws = F.ws;
            {
              pg8::Gemm g{(const bf16*)(ws + WS_ALORA), (const bf16*)(ws + WS_WLORA) + (size_t)l * 2048 * 512, 512, 512, 512};
              pg8::StaticOrder So; So.init(S, l > 0 ? 2048 : 1536, F.G, F.bid);
              const float* prm = (const float*)(ws + WS_PRM) + (size_t)l * PRM_STRIDE; pg8::EpiLora E{ws, prm + P_W0, prm + P_A0, prm + P_V0, prm + P_KA};
              DUP(9, (pg8::gemm_phase<pg8::EpiLora, pg8::StaticOrder, true>(F.lds, g, So, E, F.tid))); }
            } SEAM(sb + 4);
        }
        if (EN(5) && RUN(sb + 5)) { _Pragma("unroll 1") for (int rp = 0; rp <= (int)REP(5); ++rp) { relaunder(F, args.ws, (LAS unsigned char*)lds_raw); unsigned char* ws = F.ws; (void)ws;
            if (F.bid < 64) { p_scans(F, 64); relaunder(F, args.ws, (LAS unsigned char*)lds_raw);
                for (int u = F.bid * 2; u < F.bid * 2 + 2; ++u) u_rwkv_r1(F, u >> 3, u & 7); }
            else { for (int u = 128 + (F.bid - 64); u < 1024; u += F.G - 64) u_rwkv_r1(F, u >> 3, u & 7); }
            } SEAM(sb + 5);
        }
        if (EN(6) && RUN(sb + 6)) { _Pragma("unroll 1") for (int rp = 0; rp <= (int)REP(6); ++rp) { relaunder(F, args.ws, (LAS unsigned char*)lds_raw); unsigned char* ws = F.ws; (void)ws;
            if (F.bid < NSCAN_BLK) { p_rwkv_scan2(F, F.bid); }
            else {
                const int NB = F.G - NSCAN_BLK, b = F.bid - NSCAN_BLK;
                { const int* tab = (const int*)(ws + WS_ATAB);
                  for (int r = 0; r * NB < ATT_NSUB; ++r) { const int pos = (r & 1) ? NB - 1 - b : b; const int i = r * NB + pos;
                      if (i < ATT_NSUB) { const int e = tab[i]; DUP(0, u_attn2(F, e & 3, (e >> 2) & 31, (e >> 7) & 31, e >> 12)); } } }
            }
            } SEAM(sb + 6);
        }
        if (EN(7) && RUN(sb + 7)) { _Pragma("unroll 1") for (int rp = 0; rp <= (int)REP(7); ++rp) { relaunder(F, args.ws, (LAS unsigned char*)lds_raw); unsigned char* ws = F.ws; (void)ws;
            for (int u = F.bid; u < 1024; u += F.G) DUP(3, u_rwkv_r3(F, l, u >> 3, u & 7));
            for (int u = F.bid; u < 512; u += F.G) DUP(10, u_attn_comb(F, u >> 7, (u >> 2) & 31, u & 3));
            relaunder(F, args.ws, (LAS unsigned char*)lds_raw);
            for (int u = F.bid; u < 256; u += F.G) DUP(2, u_mamba_out(F, l, u >> 1, u & 1));
            relaunder(F, args.ws, (LAS unsigned char*)lds_raw);
            for (int u = F.bid; u < 512; u += F.G) DUP(1, u_ret_out(F, l, u >> 2, u & 3));
            } SEAM(sb + 7);
        }
        if (EN(8) && RUN(sb + 8)) { _Pragma("unroll 1") for (int rp = 0; rp <= (int)REP(8); ++rp) { relaunder(F, args.ws, (LAS unsigned char*)lds_raw); unsigned char* ws = F.ws;
            pg8::Gemm g{(const bf16*)(ws + WS_OB), (const bf16*)(ws + WS_WBR) + (size_t)l * 8192 * 512, 512, D, 512};
            pg8::BranchOrder So; So.init(F.G, F.bid); pg8::EpiBranch E{ws};
            DUP(8, (pg8::gemm_phase<pg8::EpiBranch, pg8::BranchOrder, true>(F.lds, g, So, E, F.tid)));
            } SEAM(sb + 8);
        }
        if (EN(9) && RUN(sb + 9)) { _Pragma("unroll 1") for (int rp = 0; rp <= (int)REP(9); ++rp) { relaunder(F, args.ws, (LAS unsigned char*)lds_raw); unsigned char* ws = F.ws;
            pg8::Gemm g{(const bf16*)(ws + WS_MERGED), (const bf16*)(ws + WS_WOUT) + (size_t)l * D * D, D, D, D};
            pg8::StaticOrder So; So.init(S, D, F.G, F.bid); pg8::EpiRes E{xin, args.out, (bf16*)(ws + WS_XN), (float*)(ws + WS_RSSB)};
            pg8::gemm_phase<pg8::EpiRes, pg8::StaticOrder, true>(F.lds, g, So, E, F.tid);
            } SEAM(sb + 9);
        }
        if (EN(10) && RUN(sb + 10)) { _Pragma("unroll 1") for (int rp = 0; rp <= (int)REP(10); ++rp) { relaunder(F, args.ws, (LAS unsigned char*)lds_raw); unsigned char* ws = F.ws; DUP(11, p_rmsnorm(F, args.out, (const float*)(ws + WS_PRM) + (size_t)l * PRM_STRIDE + P_N2, (bf16*)(ws + WS_XN))); } SEAM(sb + 10); }
        if (EN(11) && RUN(sb + 11)) { _Pragma("unroll 1") for (int rp = 0; rp <= (int)REP(11); ++rp) { relaunder(F, args.ws, (LAS unsigned char*)lds_raw); unsigned char* ws = F.ws;
            pg8::Gemm g{(const bf16*)(ws + WS_XN), (const bf16*)(ws + WS_WGU) + (size_t)l * 2 * DFF * D, D, D, D};
            pg8::StaticOrder So; So.init(S, 2 * DFF, F.G, F.bid); pg8::EpiGu E{ws, (const LAS float*)(F.lds + RTAB_OFF)};
            pg8::fill_rstd((LAS float*)(F.lds + RTAB_OFF), (const float*)(ws + WS_RSSB), So, F.tid);
            DUP(7, (pg8::gemm_phase<pg8::EpiGu, pg8::StaticOrder, true>(F.lds, g, So, E, F.tid)));
            } SEAM(sb + 11);
        }
        if (EN(12) && RUN(sb + 12)) { _Pragma("unroll 1") for (int rp = 0; rp <= (int)REP(12); ++rp) { relaunder(F, args.ws, (LAS unsigned char*)lds_raw); unsigned char* ws = F.ws;
            pg8::Gemm g{(const bf16*)(ws + WS_ACT), (const bf16*)(ws + WS_WDN) + (size_t)l * D * DFF, DFF, DFF, DFF};
            pg8::StaticOrder So; So.init(S, D, F.G, F.bid); pg8::EpiRes E{args.out, args.out, (bf16*)(ws + WS_XN), (l + 1 < DEPTH) ? (float*)(ws + WS_RSSA) : nullptr};
            pg8::gemm_phase<pg8::EpiRes, pg8::StaticOrder, true>(F.lds, g, So, E, F.tid);
            } SEAM(sb + 12);
        }
    }
#ifdef MK_PROBE
    { const int l = 3;
      if (RUN(200)) { relaunder(F, args.ws, (LAS unsigned char*)lds_raw); for (int u = F.bid; u < 1024; u += F.G) u_rwkv_r3(F, l, u >> 3, u & 7); }
      if (RUN(201)) { relaunder(F, args.ws, (LAS unsigned char*)lds_raw); for (int u = F.bid; u < 512; u += F.G) u_attn_comb(F, u >> 7, (u >> 2) & 31, u & 3); }
      if (RUN(202)) { relaunder(F, args.ws, (LAS unsigned char*)lds_raw); for (int u = F.bid; u < 256; u += F.G) u_mamba_out(F, l, u >> 1, u & 1); }
      if (RUN(203)) { relaunder(F, args.ws, (LAS unsigned char*)lds_raw); for (int u = F.bid; u < 512; u += F.G) u_ret_out(F, l, u >> 2, u & 3); }
      if (RUN(204)) { relaunder(F, args.ws, (LAS unsigned char*)lds_raw); if (F.bid < F.G - 32) { const int Gs = F.G; F.G = Gs - 32; p_rwkv_prep(F, l); F.G = Gs; } }
      if (RUN(205)) { relaunder(F, args.ws, (LAS unsigned char*)lds_raw); if (F.bid < F.G - 32) { const int Gs = F.G; F.G = Gs - 32; p_mamba_prep(F, l); F.G = Gs; } }
      if (RUN(206)) { relaunder(F, args.ws, (LAS unsigned char*)lds_raw); if (F.bid < F.G - 32) { const int Gs = F.G; F.G = Gs - 32; for (int u = F.bid; u < 512; u += F.G) u_ret_kv(F, u >> 2, u & 3); F.G = Gs; } }
      if (RUN(207)) { relaunder(F, args.ws, (LAS unsigned char*)lds_raw); if (F.bid < 64) p_scans(F, 64); }
      if (RUN(208)) { relaunder(F, args.ws, (LAS unsigned char*)lds_raw); if (F.bid >= 64) { for (int u = 128 + (F.bid - 64); u < 1024; u += F.G - 64) u_rwkv_r1(F, u >> 3, u & 7); } }
      if (RUN(210)) { relaunder(F, args.ws, (LAS unsigned char*)lds_raw); unsigned char* ws = F.ws; if (F.bid >= F.G - 32) {
                pg8::Gemm g{(const bf16*)(ws + WS_XN), (const bf16*)(ws + WS_WIN) + ((size_t)l * NINP + (NINP - 256)) * D, D, D, D};
                pg8::StaticOrder So; So.init(S, 256, 32, F.bid - (F.G - 32)); pg8::EpiMisc E{ws, (const LAS float*)(F.lds + RTAB_OFF)};
                pg8::fill_rstd((LAS float*)(F.lds + RTAB_OFF), (const float*)(ws + WS_RSSA), So, F.tid);
                pg8::gemm_phase<pg8::EpiMisc, pg8::StaticOrder, true>(F.lds, g, So, E, F.tid); } }
      if (RUN(211)) { relaunder(F, args.ws, (LAS unsigned char*)lds_raw); unsigned char* ws = F.ws; if (F.bid >= NSCAN_BLK) { const int NB = F.G - NSCAN_BLK, b = F.bid - NSCAN_BLK; const int* tab = (const int*)(ws + WS_ATAB);
                  for (int r = 0; r * NB < ATT_NSUB; ++r) { const int pos = (r & 1) ? NB - 1 - b : b; const int i = r * NB + pos;
                      if (i < ATT_NSUB) { const int e = tab[i]; u_attn2(F, e & 3, (e >> 2) & 31, (e >> 7) & 31, e >> 12); } } } }
      if (RUN(209)) { relaunder(F, args.ws, (LAS unsigned char*)lds_raw); if (F.bid < NSCAN_BLK) p_rwkv_scan2(F, F.bid); }
    }
#endif
#undef RUN
#undef SEAM
}

#ifndef MK_ONE_LAUNCH
#define MK_ONE_LAUNCH 1
#endif
extern "C" void kernel_launch(void* const* d_in, const int* in_sizes, int n_in, void* d_out, int out_size, void* d_ws, size_t ws_size, hipStream_t stream) {
    static int grid = 0;
    if (grid == 0) {
        if (n_in != 36 || in_sizes[0] != S * D || out_size != S * D || ws_size < WS_END3) { fprintf(stderr, "kernel_launch: bad shapes: n_in %d in0 %d out %d ws %zu (need %zu)\n", n_in, n_in > 0 ? in_sizes[0] : -1, out_size, ws_size, (size_t)WS_END3); grid = -1; return; }
        int dev = 0, cus = 0, per_cu = 0;
        if (hipGetDevice(&dev) != hipSuccess || hipDeviceGetAttribute(&cus, hipDeviceAttributeMultiprocessorCount, dev) != hipSuccess) { grid = -1; return; }
        if (hipFuncSetAttribute((const void*)mk_fwd, hipFuncAttributeMaxDynamicSharedMemorySize, LDS_BYTES) != hipSuccess) { fprintf(stderr, "kernel_launch: hipFuncSetAttribute failed\n"); grid = -1; return; }
        if (hipOccupancyMaxActiveBlocksPerMultiprocessor(&per_cu, (const void*)mk_fwd, NTHR, LDS_BYTES) != hipSuccess || per_cu < 1) fprintf(stderr, "kernel_launch: occupancy query says %d\n", per_cu);
        (void)hipGetLastError();
        grid = cus;
        if (grid != 256) fprintf(stderr, "kernel_launch: %d CUs (built for 256)\n", grid);
    }
    if (grid < 0) return;
    if (hipMemsetAsync((char*)d_ws + WS_CTL, 0, CTL_ZERO_BYTES, stream) != hipSuccess) return;
    Args a{};
    for (int i = 0; i < 36; ++i) a.in[i] = (const float*)d_in[i];
    a.out = (float*)d_out; a.ws = (unsigned char*)d_ws;
#if MK_ONE_LAUNCH
    a.st_lo = 0; a.st_hi = NSTEPS;
    hipLaunchKernelGGL(mk_fwd, dim3(grid), dim3(NTHR), LDS_BYTES, stream, a);
#ifndef MK_EXTRA_FLAGS
#define MK_EXTRA_FLAGS 0
#endif
#ifdef MK_EXTRA_STEPS
    { const int xs[] = {MK_EXTRA_STEPS};
      for (int r = 0; r < MK_EXTRA_N; ++r) for (unsigned i = 0; i < sizeof(xs) / sizeof(xs[0]); ++i) { a.st_lo = xs[i]; a.st_hi = xs[i] + 1; hipLaunchKernelGGL(mk_fwd, dim3(grid), dim3(NTHR), LDS_BYTES, stream, a); } }
#endif
#else
    for (int s = 0; s < NSTEPS; ++s) { a.st_lo = s; a.st_hi = s + 1; hipLaunchKernelGGL(mk_fwd, dim3(grid), dim3(NTHR), LDS_BYTES, stream, a); }
#endif
}
```

```cpp
#include <hip/hip_runtime.h>
#include <cstdio>
#include <cstdint>

#define GAS __attribute__((address_space(1)))
#define LAS __attribute__((address_space(3)))
typedef unsigned short bf16;
typedef short bf16x8 __attribute__((ext_vector_type(8)));
typedef short s16x4 __attribute__((ext_vector_type(4)));
typedef float f32x4 __attribute__((ext_vector_type(4)));
typedef float f32x2 __attribute__((ext_vector_type(2)));
typedef unsigned u32x4 __attribute__((ext_vector_type(4)));
typedef unsigned u32x2 __attribute__((ext_vector_type(2)));
typedef GAS unsigned gu32;
#define RLX_AGENT __ATOMIC_RELAXED, __HIP_MEMORY_SCOPE_AGENT
#define DI __device__ __forceinline__

constexpr int S = 8192, D = 2048, DEPTH = 4, NIN = 14408, NINP = 14592, DFF = 5632;
constexpr int NCH = 128;
constexpr float LOG2E = 1.4426950408889634f;

DI float bf2f(unsigned v) { return __uint_as_float(v << 16); }
typedef __bf16 bf16x2_t __attribute__((ext_vector_type(2)));
DI unsigned pk2(float lo, float hi) { const f32x2 v = {lo, hi}; const bf16x2_t b = __builtin_convertvector(v, bf16x2_t); return __builtin_bit_cast(unsigned, b); }
DI unsigned f2bf(float f) { const __bf16 b = (__bf16)f; return (unsigned)__builtin_bit_cast(unsigned short, b); }
DI float fexp_(float x) { return __builtin_amdgcn_exp2f(x * 1.4426950408889634f); }
DI float ftanh_(float x) { return 1.0f - 2.0f * __builtin_amdgcn_rcpf(1.0f + fexp_(2.0f * x)); }
DI float sigmoidf_(float x) { return __builtin_amdgcn_rcpf(1.0f + fexp_(-x)); }
DI float siluf_(float x) { return x * __builtin_amdgcn_rcpf(1.0f + fexp_(-x)); }
DI float softplusf_(float x) { return fmaxf(x, 0.f) + log1pf(fexp_(-fabsf(x))); }
DI u32x4 pack8(const f32x4 a, const f32x4 b) { u32x4 w; w.x = pk2(a[0], a[1]); w.y = pk2(a[2], a[3]); w.z = pk2(b[0], b[1]); w.w = pk2(b[2], b[3]); return w; }
DI void unpack8(const u32x4 w, float (&o)[8]) { o[0] = bf2f(w.x & 0xffffu); o[1] = bf2f(w.x >> 16); o[2] = bf2f(w.y & 0xffffu); o[3] = bf2f(w.y >> 16);
    o[4] = bf2f(w.z & 0xffffu); o[5] = bf2f(w.z >> 16); o[6] = bf2f(w.w & 0xffffu); o[7] = bf2f(w.w >> 16); }

namespace pg8 {
constexpr int BM = 256, BK = 64, HALF = 128, HTB = HALF * BK * 2, STAGE_BYTES = 8 * HTB, NXCD = 8, WGM = 8;
DI int lds_byte(int r, int c) { const int st = (r >> 4) * 2 + (c >> 5), rr = r & 15, cc = c & 31, ob = rr * 64 + cc * 2; return st * 1024 + (ob ^ (((ob >> 9) & 1) << 5)); }
DI void stage_rc(int b, int& R, int& C) { const int st = b / 1024, sb = b % 1024, swz = sb ^ (((sb >> 9) & 1) << 5); R = (st >> 1) * 16 + swz / 64; C = (st & 1) * 32 + (swz % 64) / 2; }
DI int perm32(int rho) { const int n = rho >> 4, i = rho & 15; return 8 * (i >> 2) + 4 * n + (i & 3); }

struct Unit { int pm, pn, ak, brow, sub, ord; };
struct Gemm { const bf16* A; const bf16* Bt; int K, lda, ldb; };

struct StaticOrder {
    int nM, nN, nwg, G, c;
    DI void init(int M, int N, int G_, int c_) { nM = M / BM; nN = N / BM; nwg = nM * nN; G = G_; c = c_; }
    DI bool next(int i, Unit& u) const {
        const long L = (long)i * G + c; if (L >= nwg) return false;
        int wgid = (int)L; { const int q = nwg / NXCD, r = nwg % NXCD, xcd = wgid % NXCD, off = wgid / NXCD; wgid = (xcd < r ? xcd * (q + 1) : r * (q + 1) + (xcd - r) * q) + off; }
        const int nig = WGM * nN, gid = wgid / nig, fm = gid * WGM, gsz = (nM - fm) < WGM ? (nM - fm) : WGM;
        u.pm = fm + ((wgid % nig) % gsz); u.pn = (wgid % nig) / gsz; u.ak = 0; u.brow = u.pn * BM; u.sub = 0; return true;
    }
};
struct LoraOrder {
    StaticOrder so;
    DI void init(int N, int G_, int c_) { so.init(S, N, G_, c_); }
    DI bool next(int i, Unit& u) const { if (!so.next(i, u)) return false; u.ak = (u.pn >= 4) ? 256 : 0; return true; }
};
struct BranchOrder {
    StaticOrder so;
    DI void init(int G_, int c_) { so.init(S, D, G_, c_); }
    DI bool next(int i, Unit& u) const { if (!so.next(i >> 2, u)) return false; u.sub = i & 3; u.ak = u.sub * 512; u.brow = u.sub * D + u.pn * BM; return true; }
};

typedef f32x4 Acc[2][2][4][2];

template <class Epi, class Sched, bool ALIGN_EPI>
DI void gemm_phase(LAS unsigned char* lds, const Gemm g, const Sched& Sc, const Epi& E, const int tid) {
    const int wid = __builtin_amdgcn_readfirstlane(tid >> 6), lane = tid & 63, wr = wid >> 2, wc = wid & 3, fr = lane & 15, fq = lane >> 4;
    const int K = g.K, nt = K / BK;
    unsigned voffA[2], voffB[2];
#pragma unroll
    for (int i = 0; i < 2; ++i) { int R, C; stage_rc(tid * 16 + i * 8192, R, C); const int Rb = (R & ~31) + perm32(R & 31);
        voffA[i] = (unsigned)(R * g.lda + C) * 2u; voffB[i] = (unsigned)(Rb * g.ldb + C) * 2u; }
    const size_t kstep = (size_t)(BK * 2);
    const size_t hA = (size_t)HALF * g.lda * 2, hB = (size_t)HALF * g.ldb * 2;
    const unsigned ldsw = (unsigned)wid * 1024u;
    const int aoff = lds_byte(wr * 64 + fr, fq * 8), boff = lds_byte(wc * 32 + fr, fq * 8);
#define PG8_SA(b, h) (((b) * 2 + (h)) * HTB)
#define PG8_SB(b, h) ((4 + (b) * 2 + (h)) * HTB)
#define PG8_STAGE(bufoff, gbase, voff) do { _Pragma("unroll") for (int _i = 0; _i < 2; ++_i) \
        __builtin_amdgcn_global_load_lds((const unsigned*)((const char*)(gbase) + (voff)[_i]), (LAS unsigned*)(lds + (bufoff) + ldsw + _i * 8192), 16, 0, 0); } while (0)
#define PG8_LDA(dst, b, h) do { _Pragma("unroll") for (int m = 0; m < 4; ++m) _Pragma("unroll") for (int k = 0; k < 2; ++k) dst[m][k] = *(const LAS bf16x8*)(lds + PG8_SA(b, h) + aoff + m * 2048 + k * 1024); } while (0)
#define PG8_LDB(dst, b, h) do { _Pragma("unroll") for (int n = 0; n < 2; ++n) _Pragma("unroll") for (int k = 0; k < 2; ++k) dst[n][k] = *(const LAS bf16x8*)(lds + PG8_SB(b, h) + boff + n * 2048 + k * 1024); } while (0)
#define PG8_MMA(ai, bj, At, Bt) do { __builtin_amdgcn_s_setprio(1); _Pragma("unroll") for (int m = 0; m < 4; ++m) _Pragma("unroll") for (int n = 0; n < 2; ++n) _Pragma("unroll") for (int k = 0; k < 2; ++k) \
        acc[ai][bj][m][n] = __builtin_amdgcn_mfma_f32_16x16x32_bf16(Bt[n][k], At[m][k], acc[ai][bj][m][n], 0, 0, 0); __builtin_amdgcn_s_setprio(0); } while (0)
#define PG8_WAIT_V(n) asm volatile("s_waitcnt vmcnt(" #n ")" ::: "memory")
#define PG8_WAIT_L(n) asm volatile("s_waitcnt lgkmcnt(" #n ")" ::: "memory")
#define PG8_BAR __builtin_amdgcn_s_barrier()
#define PG8_SCHED __builtin_amdgcn_sched_barrier(0)
    Unit cur, nxt; int ui = 0;
    if (!Sc.next(0, cur)) return;
    cur.ord = 0;
    Acc acc;
#pragma unroll
    for (int a = 0; a < 2; ++a)
#pragma unroll
        for (int b = 0; b < 2; ++b)
#pragma unroll
            for (int m = 0; m < 4; ++m)
#pragma unroll
                for (int n = 0; n < 2; ++n) acc[a][b][m][n] = (f32x4){0.f, 0.f, 0.f, 0.f};
    bf16x8 At[4][2], B0[2][2], B1[2][2];
    const char* cA = (const char*)g.A + ((size_t)cur.pm * BM * g.lda + cur.ak) * 2; const char* cB = (const char*)g.Bt + (size_t)cur.brow * g.ldb * 2;
    PG8_STAGE(PG8_SB(0, 0), cB, voffB); PG8_STAGE(PG8_SB(0, 1), cB + hB, voffB); PG8_STAGE(PG8_SA(0, 0), cA, voffA); PG8_STAGE(PG8_SA(0, 1), cA + hA, voffA);
    if (wr == 1) PG8_BAR;
    PG8_WAIT_V(2); PG8_BAR;
    PG8_STAGE(PG8_SB(1, 0), cB + kstep, voffB); PG8_STAGE(PG8_SA(1, 0), cA + kstep, voffA); PG8_STAGE(PG8_SB(1, 1), cB + hB + kstep, voffB);
    PG8_WAIT_V(6); PG8_BAR;
    for (;;) {
        const bool has_next = Sc.next(ui + 1, nxt); nxt.ord = ui + 1;
        const char* nA = has_next ? (const char*)g.A + ((size_t)nxt.pm * BM * g.lda + nxt.ak) * 2 : cA; const char* nB = has_next ? (const char*)g.Bt + (size_t)nxt.brow * g.ldb * 2 : cB;
        for (int t = 0; t < nt; t += 2) {
            const bool last = (t == nt - 2);
            const char* a1 = cA + (size_t)(t + 1) * kstep;
            const char* a2 = last ? nA : cA + (size_t)(t + 2) * kstep; const char* b2 = last ? nB : cB + (size_t)(t + 2) * kstep;
            const char* a3 = a2 + kstep; const char* b3 = b2 + kstep;
            PG8_LDB(B0, 0, 0); PG8_LDB(B1, 0, 1); PG8_SCHED; PG8_LDA(At, 0, 0); PG8_STAGE(PG8_SA(1, 1), a1 + hA, voffA);
            PG8_WAIT_V(8); PG8_WAIT_L(0); PG8_BAR; PG8_MMA(0, 0, At, B0); PG8_MMA(0, 1, At, B1); PG8_BAR; PG8_SCHED;
            PG8_LDA(At, 0, 1); PG8_STAGE(PG8_SB(0, 0), b2, voffB); PG8_STAGE(PG8_SB(0, 1), b2 + hB, voffB); PG8_STAGE(PG8_SA(0, 0), a2, voffA);
            PG8_WAIT_V(8); PG8_WAIT_L(0); PG8_BAR; PG8_MMA(1, 0, At, B0); PG8_MMA(1, 1, At, B1); PG8_BAR; PG8_SCHED;
            PG8_LDB(B0, 1, 0); PG8_LDB(B1, 1, 1); PG8_SCHED; PG8_LDA(At, 1, 0); PG8_STAGE(PG8_SA(0, 1), a2 + hA, voffA);
            PG8_WAIT_V(8); PG8_WAIT_L(0); PG8_BAR; PG8_MMA(0, 0, At, B0); PG8_MMA(0, 1, At, B1); PG8_BAR; PG8_SCHED;
            PG8_LDA(At, 1, 1); PG8_STAGE(PG8_SB(1, 0), b3, voffB); PG8_STAGE(PG8_SB(1, 1), b3 + hB, voffB); PG8_STAGE(PG8_SA(1, 0), a3, voffA);
            PG8_WAIT_V(8); PG8_WAIT_L(0); PG8_BAR; PG8_MMA(1, 0, At, B0); PG8_MMA(1, 1, At, B1); PG8_BAR; PG8_SCHED;
        }
        if constexpr (ALIGN_EPI) { if (wr == 0) PG8_BAR; }
        bool zero = true;
        if constexpr (!Epi::AFTER_DRAIN) { zero = E(acc, cur, wr, wc, fr, fq); }
        if (!has_next) break;
        if (zero) {
#pragma unroll
        for (int a = 0; a < 2; ++a)
#pragma unroll
            for (int b = 0; b < 2; ++b)
#pragma unroll
                for (int m = 0; m < 4; ++m)
#pragma unroll
                    for (int n = 0; n < 2; ++n) acc[a][b][m][n] = (f32x4){0.f, 0.f, 0.f, 0.f};
        }
        cur = nxt; cA = nA; cB = nB; ++ui;
        if constexpr (ALIGN_EPI) { if (wr == 1) PG8_BAR; }
    }
    PG8_WAIT_V(0);
    if constexpr (!ALIGN_EPI) { if (wr == 0) PG8_BAR; }
    PG8_BAR;
    if constexpr (Epi::AFTER_DRAIN) { E.fused(acc, cur, wr, wc, fr, fq, lds, wid, lane, tid); }
#undef PG8_SA
#undef PG8_SB
#undef PG8_STAGE
#undef PG8_LDA
#undef PG8_LDB
#undef PG8_MMA
#undef PG8_WAIT_V
#undef PG8_WAIT_L
#undef PG8_BAR
#undef PG8_SCHED
}
}

constexpr size_t MiB = 1u << 20;
constexpr size_t al256(size_t x) { return (x + 255) & ~(size_t)255; }
constexpr size_t WS_CTL = 0, CTL_ZERO_BYTES = 1 * MiB;
constexpr size_t WS_PRM = 1 * MiB;
constexpr int P_N1 = 0, P_N2 = 2048, P_GN = 4096, P_CW = 4608, P_CB = 8704, P_DTB = 9728, P_ALOG = 9736, P_SD = 9744, P_SNW = 9760, P_QNW = 10272, P_KNW = 10464, P_MU = 10656,
              P_W0 = 12448, P_A0 = 12960, P_V0 = 13472, P_KK = 13984, P_KA = 14496, P_RK = 15008, P_LNW = 15520, P_LNB = 16032, PRM_STRIDE = 16640;
constexpr size_t WS_COSR = 2 * MiB;
constexpr size_t WS_SINR = WS_COSR + (size_t)S * 64 * 4;
constexpr size_t WS_COSM = WS_SINR + (size_t)S * 64 * 4;
constexpr size_t WS_SINM = WS_COSM + (size_t)S * 32 * 4;
constexpr size_t WS_WIN  = WS_SINM + (size_t)S * 32 * 4;
constexpr size_t WS_WQB  = WS_WIN + (size_t)DEPTH * NINP * D * 2;
constexpr size_t WS_WKVB = WS_WQB + (size_t)DEPTH * 1024 * 512 * 2;
constexpr size_t WS_WV1  = WS_WKVB + (size_t)DEPTH * 1024 * 256 * 2;
constexpr size_t WS_WLORA = WS_WV1 + (size_t)DEPTH * 256 * 512 * 2;
constexpr size_t WS_WBR  = WS_WLORA + (size_t)DEPTH * 2048 * 512 * 2;
constexpr size_t WS_WOUT = WS_WBR + (size_t)DEPTH * 8192 * 512 * 2;
constexpr size_t WS_WGU  = WS_WOUT + (size_t)DEPTH * D * D * 2;
constexpr size_t WS_WDN  = WS_WGU + (size_t)DEPTH * 2 * DFF * D * 2;
constexpr size_t WS_ACT0 = WS_WDN + (size_t)DEPTH * D * DFF * 2;
constexpr size_t WS_XN   = WS_ACT0;
constexpr size_t WS_QR   = WS_XN + (size_t)S * D * 2;
constexpr size_t WS_KR   = WS_QR + (size_t)S * 512 * 2;
constexpr size_t WS_VR   = WS_KR + (size_t)S * 512 * 2;
constexpr size_t WS_GR   = WS_VR + (size_t)S * 512 * 2;
constexpr size_t WS_ZS   = WS_GR + (size_t)S * 512 * 2;
constexpr size_t WS_XBC  = WS_ZS + (size_t)S * 512 * 2;
constexpr size_t WS_XC   = WS_XBC + (size_t)S * 1024 * 2;
constexpr size_t WS_CQ   = WS_XC + (size_t)S * 1024 * 2;
constexpr size_t WS_CKV  = WS_CQ + (size_t)S * 512 * 2;
constexpr size_t WS_SSQ  = WS_CKV + (size_t)S * 256 * 2;
constexpr size_t WS_RW   = WS_SSQ + (size_t)S * 16 * 4;
constexpr size_t WS_GATE = WS_RW + (size_t)S * 1792 * 4;
constexpr size_t WS_MISC = WS_GATE + (size_t)S * 8192 * 2;
constexpr size_t WS_DTS  = WS_MISC + (size_t)S * 256 * 4;
constexpr size_t WS_ACS  = WS_DTS + (size_t)S * 8 * 4;
constexpr size_t WS_RKV  = WS_ACS + (size_t)S * 8 * 4;
constexpr size_t WS_MST  = WS_RKV + (size_t)NCH * 4 * 128 * 128 * 4;
constexpr size_t WS_QM   = WS_MST + (size_t)NCH * 8 * 64 * 128 * 4;
constexpr size_t WS_KM   = WS_QM + (size_t)S * 768 * 2;
constexpr size_t WS_VT   = WS_KM + (size_t)S * 768 * 2;
constexpr size_t WS_R32  = WS_VT + (size_t)512 * S * 2;
constexpr size_t SZ32    = (size_t)S * 512 * 4;
constexpr size_t WS_KKN  = WS_R32 + SZ32, WS_K32 = WS_KKN + SZ32, WS_VV = WS_K32 + SZ32, WS_VFIRST = WS_VV + SZ32, WS_DEC = WS_VFIRST + SZ32,
                 WS_KP = WS_DEC + SZ32, WS_BB = WS_KP + SZ32, WS_G32 = WS_BB + SZ32, WS_Y32 = WS_G32 + SZ32;
constexpr size_t WS_VB   = WS_Y32 + SZ32;
constexpr size_t WS_ALORA = WS_VB + (size_t)S * 512 * 2;
constexpr size_t WS_OB   = WS_ALORA + (size_t)S * 512 * 2;
constexpr size_t WS_MERGED = WS_OB + (size_t)S * D * 2;
constexpr size_t WS_ACT  = WS_MERGED + (size_t)S * D * 2;
constexpr size_t WS_END  = WS_ACT + (size_t)S * DFF * 2;

constexpr int CW_TMO = 0, CW_CODE = 1, CW_BAR = 4096;


constexpr int NWAVES = 8, NTHR = 512;
constexpr int RING_BYTES = 143360, LDSCTL_OFF = RING_BYTES, MISC_OFF = LDSCTL_OFF + 320, LDS_BYTES = 147456;
#define LDS_WAIT() asm volatile("s_waitcnt lgkmcnt(0)" ::: "memory")
#define VM_WAIT() asm volatile("s_waitcnt vmcnt(0)" ::: "memory")

#define XB_TMO      128
#define XB_XCNT(j)  (256  + 64 * (j))
#define XB_XSUB(j)  (1280 + 64 * (j))
#define XB_XGEN(j)  (2304 + 64 * (j))
#define XB_TOP      3328
#define XB_TOPGEN   3392
#define XCD_BAR_WORDS 3456
#define XB_SPIN_CAP (1u << 22)
DI unsigned xb_ld(unsigned* p)              { return __hip_atomic_load(p, __ATOMIC_RELAXED, __HIP_MEMORY_SCOPE_AGENT); }
DI unsigned xb_add(unsigned* p, unsigned v) { return __hip_atomic_fetch_add(p, v, __ATOMIC_RELAXED, __HIP_MEMORY_SCOPE_AGENT); }
DI unsigned xb_xcc_id() { return (unsigned)__builtin_amdgcn_s_getreg((3 << 11) | 20) & 0xFu; }
#define XB_SPIN(cond, bar) do { unsigned _sp = 0; while (cond) { __builtin_amdgcn_s_sleep(1); \
    if ((++_sp & 255u) == 0u) { if (xb_ld(&(bar)[XB_TMO])) break; if (_sp > XB_SPIN_CAP) { atomicAdd(&(bar)[XB_TMO], 1u); break; } } } } while (0)
struct XcdBarrier { unsigned* bar; unsigned x; volatile LAS unsigned* st; };
DI XcdBarrier xcd_barrier_post(unsigned* bar, volatile LAS unsigned* st) {
    XcdBarrier b; b.bar = bar; b.x = xb_xcc_id(); b.st = st;
    if (threadIdx.x == 0) (void)xb_add(&bar[XB_XCNT(b.x)], 1u);
    return b;
}
DI void xcd_barrier_complete(unsigned* bar, unsigned x, unsigned& nloc, unsigned& nx) {
    const unsigned G = gridDim.x * gridDim.y * gridDim.z;
    unsigned sum, cnt, mine, sp = 0u;
    for (;;) {
        sum = 0u; cnt = 0u; mine = 0u;
#pragma unroll
        for (unsigned j = 0; j < 16; ++j) { const unsigned c = xb_ld(&bar[XB_XCNT(j)]); sum += c; cnt += (c > 0u) ? 1u : 0u; mine = (j == x) ? c : mine; }
        if (sum == G) break;
        __builtin_amdgcn_s_sleep(1);
        if ((++sp & 255u) == 0u) { if (xb_ld(&bar[XB_TMO])) break; if (sp > XB_SPIN_CAP) { atomicAdd(&bar[XB_TMO], 1u); break; } }
    }
    nloc = mine > 0u ? mine : 1u; nx = cnt > 0u ? cnt : 1u;
}
DI void xcd_barrier(const XcdBarrier& b) {
    asm volatile("s_waitcnt vmcnt(0)" ::: "memory");
    __syncthreads();
    if (threadIdx.x == 0) {
        unsigned* bar = b.bar;
        __builtin_amdgcn_s_waitcnt(0);
        unsigned nloc = b.st[0], nx = b.st[1];
        if (nloc == 0u) { xcd_barrier_complete(bar, b.x, nloc, nx); b.st[0] = nloc; b.st[1] = nx; }
        const unsigned old = xb_add(&bar[XB_XSUB(b.x)], 1u);
        const unsigned gen = old / nloc;
        if (old + 1u == (gen + 1u) * nloc) {
            __builtin_amdgcn_fence(__ATOMIC_RELEASE, "agent");
            asm volatile("s_waitcnt vmcnt(0)" ::: "memory");
            const unsigned og = xb_add(&bar[XB_TOP], 1u);
            const unsigned tg = og / nx;
            if (og + 1u == (tg + 1u) * nx) xb_add(&bar[XB_TOPGEN], 1u);
            else XB_SPIN(xb_ld(&bar[XB_TOPGEN]) == tg, bar);
            __builtin_amdgcn_fence(__ATOMIC_ACQUIRE, "agent");
            xb_add(&bar[XB_XGEN(b.x)], 1u);
            asm volatile("s_waitcnt vmcnt(0)" ::: "memory");
        } else {
            XB_SPIN(xb_ld(&bar[XB_XGEN(b.x)]) == gen, bar);
            __builtin_amdgcn_fence(__ATOMIC_ACQUIRE, "agent");
            asm volatile("s_waitcnt vmcnt(0)" ::: "memory");
        }
    }
    __syncthreads();
}

struct Args { const float* in[36]; float* out; unsigned char* ws; int st_lo, st_hi; };
struct Frame {
    LAS unsigned char* lds; volatile LAS unsigned* MISC; gu32* ctl;
    int tid, lane, wave, G, bid;
    unsigned char* ws;
};
DI void relaunder(Frame& F, unsigned char* ws0, LAS unsigned char* lds0) {
    int t = threadIdx.x; asm volatile("" : "+v"(t)); F.tid = t; F.lane = t & 63; F.wave = __builtin_amdgcn_readfirstlane(t >> 6);
    unsigned long long w = (unsigned long long)ws0; asm volatile("" : "+s"(w)); F.ws = (unsigned char*)w; F.ctl = (gu32*)(F.ws + WS_CTL);
    unsigned lb = (unsigned)(unsigned long)lds0; asm volatile("" : "+s"(lb)); F.lds = (LAS unsigned char*)(unsigned long)lb; F.MISC = (volatile LAS unsigned*)(F.lds + MISC_OFF);
    int b = blockIdx.x; asm volatile("" : "+s"(b)); F.bid = b;
}
#define XR_SWAP(INS, a, b) asm volatile("s_nop 1\n\t" INS " %0, %1" : "+v"(a), "+v"(b))
DI float xr16_max(float x) { float a = x, b = x; XR_SWAP("v_permlane16_swap_b32", a, b); return fmaxf(a, b); }
DI float xr32_max(float x) { float a = x, b = x; XR_SWAP("v_permlane32_swap_b32", a, b); return fmaxf(a, b); }
DI float xr16_sum(float x) { float a = x, b = x; XR_SWAP("v_permlane16_swap_b32", a, b); return a + b; }
DI float xr32_sum(float x) { float a = x, b = x; XR_SWAP("v_permlane32_swap_b32", a, b); return a + b; }
template <int CTRL> DI float dpp_f(float v) { return __builtin_bit_cast(float, __builtin_amdgcn_update_dpp(0, __builtin_bit_cast(int, v), CTRL, 0xf, 0xf, true)); }
DI float row_sum8(float v) { v += dpp_f<0xB1>(v); v += dpp_f<0x4E>(v); v += dpp_f<0x141>(v); return v; }
DI float row_sum16(float v) { v += dpp_f<0xB1>(v); v += dpp_f<0x4E>(v); v += dpp_f<0x141>(v); v += dpp_f<0x140>(v); return v; }
DI float wave_sum(float v) { return xr32_sum(xr16_sum(row_sum16(v))); }
DI float wave_sum_dpp(float v) {
    const float t = row_sum16(v);
    const float s0 = __builtin_bit_cast(float, __builtin_amdgcn_readlane(__builtin_bit_cast(int, t), 0));
    const float s1 = __builtin_bit_cast(float, __builtin_amdgcn_readlane(__builtin_bit_cast(int, t), 16));
    const float s2 = __builtin_bit_cast(float, __builtin_amdgcn_readlane(__builtin_bit_cast(int, t), 32));
    const float s3 = __builtin_bit_cast(float, __builtin_amdgcn_readlane(__builtin_bit_cast(int, t), 48));
    return (s0 + s1) + (s2 + s3);
}
constexpr size_t WS_QYT = WS_END;
constexpr size_t WS_CYT = WS_QYT + (size_t)1024 * 4096 * 2;
constexpr size_t WS_TST = WS_CYT + (size_t)1024 * 4096 * 2;
constexpr size_t WS_NST = WS_TST + (size_t)1024 * 4096 * 2;
constexpr size_t WS_S0  = WS_NST + (size_t)1024 * 4096 * 4;
constexpr size_t WS_END2 = WS_S0 + (size_t)1024 * 4096 * 2;
constexpr int ATT_NSUB = 576, ATT_RUN = 16;
constexpr size_t WS_ATAB = WS_END2;
constexpr size_t WS_APO  = WS_ATAB + 8192;
constexpr size_t WS_APM  = WS_APO + (size_t)ATT_NSUB * 32768 * 4;
constexpr size_t WS_RSSA = WS_APM + (size_t)ATT_NSUB * 512 * 4;
constexpr size_t WS_RSSB = WS_RSSA + (size_t)S * 32 * 4;
constexpr size_t WS_END3 = WS_RSSB + (size_t)S * 32 * 4;
constexpr int RTAB_OFF = 131072;
DI int att_slot(int h, int qb, int s) { const int g = qb >> 2; return h * 144 + (g + 1) * (qb - 2 * g) + s; }

DI int map_in(int n) {
    const int T = n >> 8, c = n & 255;
    if (T < 4) { const int base = (T >> 1) * 512, tp = T & 1, half = c >> 7, hs = (c >> 6) & 1, j = c & 63; return base + (2 * tp + hs) * 128 + half * 64 + j; }
    if (T < 6) return 1024 + (T - 4) * 256 + c;
    if (T < 8) return 1536 + (T - 6) * 256 + c;
    if (T < 10) return 2048 + (T - 8) * 256 + c;
    if (T < 14) return 2560 + (T - 10) * 256 + c;
    if (T < 16) return 3592 + (T - 14) * 256 + c;
    if (T == 16) return 4104 + c;
    if (T < 24) return 4424 + (T - 17) * 256 + c;
    if (T < 56) {
        const int j = T - 24, bj = c >> 7, wc = (c >> 5) & 3, fq = (c >> 3) & 3, n = (c >> 2) & 1, i = c & 3; return 6216 + (2 * bj + n) * 2048 + 64 * j + wc * 16 + fq * 4 + i; }
    if (c < 8) return 3584 + c;
    if (c < 72) return 4360 + (c - 8);
    return -1;
}
DI int map_fn(int mapid, int n, int Nsrc) {
    if (mapid == 0) return n < Nsrc ? n : -1;
    if (mapid == 1) return map_in(n);
    if (mapid == 2) { const int T = n >> 8, c = n & 255; return c < 128 ? T * 128 + c : DFF + T * 128 + (c - 128); }
    if (mapid == 3) { const int h = n >> 8, c = n & 255; if (c < 96) return h * 192 + c; if (c < 128) return h * 192 + 128 + (c - 96); if (c < 160) return h * 192 + 96 + (c - 128); if (c < 224) return -1; return h * 192 + 160 + (c - 224); }
    return n < 32 ? n : -1;
}
DI void conv_item(const float* W, int K, int Nsrc, bf16* Wt, const float* kscale, int mapid, LAS bf16* tile, int item, int nblk, int lane) {
    const int kb = item / nblk, nb = item - kb * nblk, k0 = 64 * kb, n0 = 64 * nb;
    const int src = map_fn(mapid, n0 + lane, Nsrc);
    const float* wp = W + (size_t)k0 * Nsrc + (src >= 0 ? src : 0);
    float v[64];
#pragma unroll
    for (int i = 0; i < 64; ++i) v[i] = wp[(size_t)i * Nsrc];
    if (src < 0) {
#pragma unroll
        for (int i = 0; i < 64; ++i) v[i] = 0.f; }
    if (kscale) {
#pragma unroll
        for (int i = 0; i < 64; ++i) v[i] *= kscale[k0 + i]; }
#pragma unroll
    for (int q = 0; q < 8; ++q) { u32x4 o; o.x = pk2(v[8 * q], v[8 * q + 1]); o.y = pk2(v[8 * q + 2], v[8 * q + 3]); o.z = pk2(v[8 * q + 4], v[8 * q + 5]); o.w = pk2(v[8 * q + 6], v[8 * q + 7]);
        *(LAS u32x4*)(tile + lane * 72 + 8 * q) = o; }
    LDS_WAIT(); asm volatile("" ::: "memory");
#pragma unroll
    for (int i = 0; i < 8; ++i) { const int r = i * 8 + (lane >> 3), c8 = lane & 7;
        *(GAS u32x4*)(Wt + (size_t)(n0 + r) * K + k0 + 8 * c8) = *(const LAS u32x4*)(tile + r * 72 + 8 * c8); }
    LDS_WAIT(); asm volatile("" ::: "memory");
}
struct ConvJob { const float* W; bf16* Wt; const float* kscale; int K, Nsrc, Ndst, mapid; };
DI void conv_job(Frame& F, const ConvJob j, int& base) {
    const int nblk = j.Ndst / 64, nitems = (j.K / 64) * nblk, NGW = F.G * NWAVES, gw = F.bid * NWAVES + F.wave;
    int first = (gw - base % NGW + NGW) % NGW; LAS bf16* tile = (LAS bf16*)(F.lds + F.wave * 16384);
    for (int it = first; it < nitems; it += NGW) conv_item(j.W, j.K, j.Nsrc, j.Wt, j.kscale, j.mapid, tile, it, nblk, F.lane);
    base += nitems;
}
DI void p_prologue(Frame& F, const Args& a) {
    unsigned char* ws = F.ws;
    const int gt = F.bid * NTHR + F.tid, NGT = F.G * NTHR;
    if (F.bid == 0 && F.tid == 0) { int* tab = (int*)(ws + WS_ATAB); int n = 0;
        for (int pass = 16; pass >= 4; pass -= 4)
            for (int qb = 31; qb >= 0; --qb) { const int nt = 4 * (qb + 1), nfull = nt >> 4, rem = nt & 15;
                for (int h = 0; h < 4; ++h) {
                    if (pass == 16) { for (int s2 = 0; s2 < nfull; ++s2) tab[n++] = h | (qb << 2) | (s2 << 7) | (16 << 12); }
                    else if (rem == pass) tab[n++] = h | (qb << 2) | (nfull << 7) | (rem << 12); } }
        for (; n < 2048; ++n) tab[n] = 0; }
    { float* prm = (float*)(ws + WS_PRM);
#define CPV(IDX, N, OFF, SRC_L) for (int e = gt; e < (N); e += NGT) prm[(size_t)l * PRM_STRIDE + (OFF) + e] = a.in[IDX][(size_t)(SRC_L) * (N) + e];
      for (int l = 0; l < DEPTH; ++l) {
          CPV(2, 2048, P_N1, l) CPV(33, 2048, P_N2, l) CPV(4, 512, P_GN, l) CPV(5, 4096, P_CW, l) CPV(6, 1024, P_CB, l) CPV(7, 8, P_DTB, l) CPV(8, 8, P_ALOG, l) CPV(9, 8, P_SD, l)
          CPV(10, 512, P_SNW, l) CPV(15, 192, P_QNW, l) CPV(16, 192, P_KNW, l) CPV(17, 1792, P_MU, l) CPV(18, 512, P_W0, l) CPV(20, 512, P_A0, l)
          CPV(23, 512, P_V0, (l > 0 ? l - 1 : 0)) CPV(26, 512, P_KK, l) CPV(27, 512, P_KA, l) CPV(28, 512, P_RK, l) CPV(29, 512, P_LNW, l) CPV(30, 512, P_LNB, l)
      }
#undef CPV
    }
    const int* pos = (const int*)a.in[1];
    for (int e = gt; e < S * 64; e += NGT) { const int t = e >> 6, i = e & 63;
        const float inv = 1.0f / powf(10000.0f, (float)(2 * i) / 128.0f); const float ang = (float)pos[t] * inv;
        double rev = (double)ang * 0.15915494309189535; rev -= rint(rev); const float r = (float)(rev * 6.283185307179586);
        ((float*)(ws + WS_COSR))[e] = __cosf(r); ((float*)(ws + WS_SINR))[e] = __sinf(r); }
    for (int e = gt; e < S * 32; e += NGT) { const int t = e >> 5, i = e & 31;
        const float inv = 1.0f / powf(10000.0f, (float)(2 * i) / 64.0f); const float ang = (float)pos[t] * inv;
        double rev = (double)ang * 0.15915494309189535; rev -= rint(rev); const float r = (float)(rev * 6.283185307179586);
        ((float*)(ws + WS_COSM))[e] = __cosf(r); ((float*)(ws + WS_SINM))[e] = __sinf(r); }
    for (int l = 0; l < DEPTH; ++l) {
        const float* w2 = a.in[19] + (size_t)l * 64 * 512; const float* a2 = a.in[21] + (size_t)l * 64 * 512; const float* g2 = a.in[22] + (size_t)l * 128 * 512;
        const float* v2 = a.in[25] + (size_t)(l > 0 ? l - 1 : 0) * 32 * 512;
        bf16* Lt = (bf16*)(ws + WS_WLORA) + (size_t)l * 2048 * 512;
        for (int w = gt; w < 2048 * 64; w += NGT) { const int kg = w >> 11, n = w & 2047, seg = n >> 9, j = n & 511; float v[8];
#pragma unroll
            for (int i = 0; i < 8; ++i) { const int k = kg * 8 + i; float x = 0.f;
                if (seg == 0) { if (k < 64) x = w2[k * 512 + j]; }
                else if (seg == 1) { if (k >= 128 && k < 192) x = a2[(k - 128) * 512 + j]; }
                else if (seg == 2) { if (k >= 256 && k < 384) x = g2[(k - 256) * 512 + j]; }
                else { if (l > 0 && k >= 384 && k < 416) x = v2[(k - 384) * 512 + j]; }
                v[i] = x; }
            u32x4 o; o.x = pk2(v[0], v[1]); o.y = pk2(v[2], v[3]); o.z = pk2(v[4], v[5]); o.w = pk2(v[6], v[7]);
            *(GAS u32x4*)(Lt + (size_t)n * 512 + kg * 8) = o; }
    }
    { const int gw = F.bid * NWAVES + F.wave, NGW = F.G * NWAVES; float* rss = (float*)(ws + WS_RSSA);
      for (int m = gw; m < S; m += NGW) { const GAS f32x4* xr = (const GAS f32x4*)(a.in[0] + (size_t)m * D) + F.lane; GAS u32x2* o8 = (GAS u32x2*)((bf16*)(ws + WS_XN) + (size_t)m * D) + F.lane; float sq = 0.f;
#pragma unroll
          for (int j = 0; j < 8; ++j) { const f32x4 v = xr[64 * j]; sq += (v.x * v.x + v.y * v.y) + (v.z * v.z + v.w * v.w); u32x2 o; o.x = pk2(v.x, v.y); o.y = pk2(v.z, v.w); o8[64 * j] = o; }
          sq = wave_sum(sq); if (F.lane < 32) rss[(size_t)m * 32 + F.lane] = (F.lane == 0) ? sq : 0.f; } }
    int base = 0;
    for (int l = 0; l < DEPTH; ++l) {
        conv_job(F, ConvJob{a.in[3] + (size_t)l * D * NIN, (bf16*)(ws + WS_WIN) + (size_t)l * NINP * D, a.in[2] + (size_t)l * D, D, NIN, NINP, 1}, base);
        conv_job(F, ConvJob{a.in[34] + (size_t)l * D * 2 * DFF, (bf16*)(ws + WS_WGU) + (size_t)l * 2 * DFF * D, a.in[33] + (size_t)l * D, D, 2 * DFF, 2 * DFF, 2}, base);
        conv_job(F, ConvJob{a.in[35] + (size_t)l * DFF * D, (bf16*)(ws + WS_WDN) + (size_t)l * D * DFF, nullptr, DFF, D, D, 0}, base);
        conv_job(F, ConvJob{a.in[32] + (size_t)l * D * D, (bf16*)(ws + WS_WOUT) + (size_t)l * D * D, nullptr, D, D, D, 0}, base);
        for (int n = 0; n < 4; ++n)
            conv_job(F, ConvJob{a.in[31] + ((size_t)l * 4 + n) * 512 * D, (bf16*)(ws + WS_WBR) + ((size_t)l * 4 + n) * D * 512, nullptr, 512, D, D, 0}, base);
        conv_job(F, ConvJob{a.in[12] + (size_t)l * 512 * 768, (bf16*)(ws + WS_WQB) + (size_t)l * 1024 * 512, a.in[11] + (size_t)l * 512, 512, 768, 1024, 3}, base);
        conv_job(F, ConvJob{a.in[14] + (size_t)l * 256 * 1024, (bf16*)(ws + WS_WKVB) + (size_t)l * 1024 * 256, a.in[13] + (size_t)l * 256, 256, 1024, 1024, 0}, base);
        if (l > 0) conv_job(F, ConvJob{a.in[24] + (size_t)(l - 1) * 512 * 32, (bf16*)(ws + WS_WV1) + (size_t)l * 256 * 512, nullptr, 512, 32, 256, 4}, base);
    }
}

DI void p_rmsnorm(Frame& F, const float* x, const float* w, bf16* out) {
    const int gw = F.bid * NWAVES + F.wave, NGW = F.G * NWAVES;
    for (int m = gw; m < S; m += NGW) {
        const GAS f32x4* xr = (const GAS f32x4*)(x + (size_t)m * D) + F.lane; f32x4 v[8]; float s = 0.f;
#pragma unroll
        for (int j = 0; j < 8; ++j) { v[j] = xr[64 * j]; s += (v[j].x * v[j].x + v[j].y * v[j].y) + (v[j].z * v[j].z + v[j].w * v[j].w); }
        const float rstd = rsqrtf(wave_sum(s) * (1.f / D) + 1e-6f);
        const GAS f32x4* wr = (const GAS f32x4*)w + F.lane;
        GAS u32x2* o8 = (GAS u32x2*)(out + (size_t)m * D) + F.lane;
#pragma unroll
        for (int j = 0; j < 8; ++j) { const f32x4 ww = wr[64 * j]; u32x2 o; o.x = pk2(v[j].x * rstd * ww.x, v[j].y * rstd * ww.y); o.y = pk2(v[j].z * rstd * ww.z, v[j].w * rstd * ww.w); o8[64 * j] = o; }
    }
}

DI f32x4 bf4_(const u32x2 w) { return (f32x4){bf2f(w.x & 0xffffu), bf2f(w.x >> 16), bf2f(w.y & 0xffffu), bf2f(w.y >> 16)}; }
DI u32x2 pk4_(const f32x4 v) { u32x2 o; o.x = pk2(v.x, v.y); o.y = pk2(v.z, v.w); return o; }
DI void p_rwkv_prep(Frame& F, int l) {
    unsigned char* ws = F.ws;
    const bf16* RW = (const bf16*)(ws + WS_RW); const float* prm = (const float*)(ws + WS_PRM) + (size_t)l * PRM_STRIDE; const float* mu = prm + P_MU; const float* kk_w = prm + P_KK;
    const int gw = F.bid * NWAVES + F.wave, NGW = F.G * NWAVES, lane = F.lane;
    for (int t = gw; t < S; t += NGW) {
        const bf16* p = RW + (size_t)t * 1792 + 8 * lane; const bf16* pp = RW + (size_t)(t > 0 ? t - 1 : 0) * 1792 + 8 * lane;
        float pm[4][8];
#pragma unroll
        for (int jj = 0; jj < 4; ++jj) if (jj < 3 || lane < 32) { float c[8], pv[8]; unpack8(*(const GAS u32x4*)(p + 512 * jj), c); unpack8(*(const GAS u32x4*)(pp + 512 * jj), pv);
            const f32x4 m0 = *(const GAS f32x4*)(mu + 512 * jj + 8 * lane), m1 = *(const GAS f32x4*)(mu + 512 * jj + 8 * lane + 4);
#pragma unroll
            for (int i = 0; i < 8; ++i) { const float pvv = (t == 0) ? 0.f : pv[i]; pm[jj][i] = c[i] + (pvv - c[i]) * (i < 4 ? m0[i] : m1[i - 4]); } }
        const size_t ro = (size_t)t * 512 + 8 * lane;
        *(GAS u32x4*)((bf16*)(ws + WS_R32) + ro) = pack8((f32x4){pm[0][0], pm[0][1], pm[0][2], pm[0][3]}, (f32x4){pm[0][4], pm[0][5], pm[0][6], pm[0][7]});
        { const f32x4 kw0 = *(const GAS f32x4*)(kk_w + 8 * lane), kw1 = *(const GAS f32x4*)(kk_w + 8 * lane + 4); float kk[8]; float ss = 0.f;
#pragma unroll
          for (int i = 0; i < 8; ++i) { kk[i] = pm[1][i] * (i < 4 ? kw0[i] : kw1[i - 4]); ss += kk[i] * kk[i]; }
          ss = row_sum8(ss);
          const float inv = fminf(__builtin_amdgcn_rsqf(ss), 1e12f);
          *(GAS u32x4*)((bf16*)(ws + WS_K32) + ro) = pack8((f32x4){pm[1][0], pm[1][1], pm[1][2], pm[1][3]}, (f32x4){pm[1][4], pm[1][5], pm[1][6], pm[1][7]});
          *(GAS u32x4*)((bf16*)(ws + WS_KKN) + ro) = pack8((f32x4){kk[0], kk[1], kk[2], kk[3]} * inv, (f32x4){kk[4], kk[5], kk[6], kk[7]} * inv); }
        { const u32x4 vb = pack8((f32x4){pm[2][0], pm[2][1], pm[2][2], pm[2][3]}, (f32x4){pm[2][4], pm[2][5], pm[2][6], pm[2][7]});
          *(GAS u32x4*)((bf16*)(ws + WS_VV) + ro) = vb; if (l == 0) *(GAS u32x4*)((bf16*)(ws + WS_VFIRST) + ro) = vb; }
        { bf16* ar = (bf16*)(ws + WS_ALORA) + (size_t)t * 512;
          if (lane < 32) { float y[8]; int dst;
              if (lane < 8) { _Pragma("unroll") for (int i = 0; i < 8; ++i) y[i] = ftanh_(pm[3][i]); dst = 8 * lane; }
              else if (lane < 16) { _Pragma("unroll") for (int i = 0; i < 8; ++i) y[i] = pm[3][i]; dst = 128 + 8 * (lane - 8); }
              else { _Pragma("unroll") for (int i = 0; i < 8; ++i) y[i] = sigmoidf_(pm[3][i]); dst = 256 + 8 * (lane - 16); }
              *(GAS u32x4*)(ar + dst) = pack8((f32x4){y[0], y[1], y[2], y[3]}, (f32x4){y[4], y[5], y[6], y[7]}); }
          else { const int z = 8 * (lane - 32); const int zd = z < 64 ? 64 + z : (z < 128 ? 192 + (z - 64) : 384 + (z - 128));
              unsigned zz = 0u; asm volatile("" : "+v"(zz));
              *(GAS u32x4*)(ar + zd) = (u32x4){zz, zz, zz, zz}; } }
    }
}

DI void p_mamba_prep(Frame& F, int l) {
    unsigned char* ws = F.ws;
    const bf16* XBC = (const bf16*)(ws + WS_XBC); bf16* XC = (bf16*)(ws + WS_XC);
    const float* prm = (const float*)(ws + WS_PRM) + (size_t)l * PRM_STRIDE; const float* cw = prm + P_CW; const float* cb = prm + P_CB;
    for (int u = F.bid; u < 2 * NCH; u += F.G) {
        const int ch = 2 * F.tid, t0 = (u >> 1) * 64 + (u & 1) * 32;
        float w0[4], w1[4];
#pragma unroll
        for (int k = 0; k < 4; ++k) { const f32x2 wv = *(const GAS f32x2*)(cw + k * 1024 + ch); w0[k] = wv.x; w1[k] = wv.y; }
        const f32x2 bv = *(const GAS f32x2*)(cb + ch);
        float h0[3], h1[3];
#pragma unroll
        for (int k = 0; k < 3; ++k) { const int t = t0 - 3 + k; unsigned x = 0u; if (t >= 0) x = *(const GAS unsigned*)(XBC + (size_t)t * 1024 + ch); h0[k] = bf2f(x & 0xffffu); h1[k] = bf2f(x >> 16); }
        unsigned xin[32];
#pragma unroll
        for (int i = 0; i < 32; ++i) xin[i] = *(const GAS unsigned*)(XBC + (size_t)(t0 + i) * 1024 + ch);
#pragma unroll
        for (int i = 0; i < 32; ++i) { const float x0 = bf2f(xin[i] & 0xffffu), x1 = bf2f(xin[i] >> 16);
            const float y0 = bv.x + w0[0] * h0[0] + w0[1] * h0[1] + w0[2] * h0[2] + w0[3] * x0, y1 = bv.y + w1[0] * h1[0] + w1[1] * h1[1] + w1[2] * h1[2] + w1[3] * x1;
            h0[0] = h0[1]; h0[1] = h0[2]; h0[2] = x0; h1[0] = h1[1]; h1[1] = h1[2]; h1[2] = x1;
            *(GAS unsigned*)(XC + (size_t)(t0 + i) * 1024 + ch) = pk2(siluf_(y0), siluf_(y1)); }
    }
}
DI void u_mamba_dt(Frame& F, int l, int c) {
    unsigned char* ws = F.ws; LAS float* A = (LAS float*)F.lds;
    const float* prm = (const float*)(ws + WS_PRM) + (size_t)l * PRM_STRIDE; const int t = F.tid >> 3, h = F.tid & 7; const size_t row = (size_t)(c * 64 + t);
    const float dt = softplusf_(((const float*)(ws + WS_MISC))[row * 256 + h] + prm[P_DTB + h]);
    A[F.tid] = dt * -fexp_(prm[P_ALOG + h]);
    ((float*)(ws + WS_DTS))[row * 8 + h] = dt;
    __syncthreads();
    float cs = 0.f;
#pragma unroll 16
    for (int tt = 0; tt < 64; ++tt) { const float v = A[tt * 8 + h]; cs += (tt <= t) ? v : 0.f; }
    ((float*)(ws + WS_ACS))[row * 8 + h] = cs;
    __syncthreads();
}

DI void p_scans(Frame& F, int nblk) {
    unsigned char* ws = F.ws;
    const int gt = F.bid * NTHR + F.tid, NGT = nblk * NTHR;
    for (int q = gt; q < 32768; q += NGT) {
        const int e = q * 4; const bool ret = e < 65536; const int e2 = ret ? e : e - 65536, h = ret ? (e >> 14) : (e2 >> 13);
        float* p = (float*)(ws + (ret ? WS_RKV : WS_MST)) + e2; const float* acs = (const float*)(ws + WS_ACS);
        float mf = ret ? 0.f : 1.f; asm volatile("" : "+v"(mf));
        const float lr0 = ret ? log1pf(-exp2f(-5.0f - (float)h)) * 64.0f : 0.f;
        f32x4 st = (f32x4){0.f, 0.f, 0.f, 0.f};
#pragma unroll 1
        for (int c0 = 0; c0 < NCH; c0 += 16) { f32x4 v[16]; float dc[16];
#pragma unroll
            for (int i = 0; i < 16; ++i) v[i] = *(const GAS f32x4*)(p + (size_t)(c0 + i) * 65536);
#pragma unroll
            for (int i = 0; i < 16; ++i) { const float a_ = *(const GAS float*)(acs + (size_t)((c0 + i) * 64 + 63) * 8 + h); dc[i] = fexp_(a_ * mf + lr0); }
#pragma unroll
            for (int i = 0; i < 16; ++i) { *(GAS f32x4*)(p + (size_t)(c0 + i) * 65536) = st; st = st * dc[i] + v[i]; } }
    }
}


namespace pg8 {
DI unsigned char* lw(unsigned char* p) { unsigned long long w = (unsigned long long)p; asm volatile("" : "+s"(w)); return (unsigned char*)w; }
DI void st8bf(bf16* p, const f32x4 a, const f32x4 b) { *(GAS u32x4*)p = pack8(a, b); }
DI void st8f(float* p, const f32x4 a, const f32x4 b) { *(GAS f32x4*)p = a; *((GAS f32x4*)p + 1) = b; }
DI f32x4 map4(const f32x4 v, float (*f)(float)) { return (f32x4){f(v.x), f(v.y), f(v.z), f(v.w)}; }

DI void scale_rows(Acc& acc, const LAS float* rt, int rl0) {
#pragma unroll
    for (int ai = 0; ai < 2; ++ai)
#pragma unroll
        for (int m = 0; m < 4; ++m) { const float rs = rt[rl0 + ai * HALF + m * 16];
#pragma unroll
            for (int bj = 0; bj < 2; ++bj)
#pragma unroll
                for (int n = 0; n < 2; ++n) acc[ai][bj][m][n] = acc[ai][bj][m][n] * rs; }
}
template <class Sched> DI void fill_rstd(LAS float* rtab, const float* rss, const Sched& Sc, int tid) {
    pg8::Unit u; int ppm = -1; float pv = 0.f;
    for (int i = 0; Sc.next(i, u); ++i) if (tid < 256) {
        if (u.pm != ppm) { const float* p = rss + (size_t)(u.pm * BM + tid) * 32; f32x4 v[8];
#pragma unroll
            for (int q = 0; q < 8; ++q) v[q] = *(const GAS f32x4*)(p + 4 * q);
            float s = 0.f;
#pragma unroll
            for (int q = 0; q < 8; ++q) s += (v[q].x + v[q].y) + (v[q].z + v[q].w);
            pv = rsqrtf(s * (1.f / D) + 1e-6f); ppm = u.pm; }
        rtab[i * 256 + tid] = pv; }
    __syncthreads();
}
struct TileDesc { unsigned long long off; int ld, cb, kind, slot; };
constexpr TileDesc mk_tile(int T) {
    return T < 2 ? TileDesc{WS_QR, 512, 0, 0, 0} : T < 4 ? TileDesc{WS_KR, 512, 0, 1, 0}
         : T < 6 ? TileDesc{WS_VR, 512, (T - 4) * 256, 2, 0} : T < 8 ? TileDesc{WS_GR, 512, (T - 6) * 256, 3, 0} : T < 10 ? TileDesc{WS_ZS, 512, (T - 8) * 256, 3, 0}
         : T < 14 ? TileDesc{WS_XBC, 1024, (T - 10) * 256, 2, 0} : T < 16 ? TileDesc{WS_CQ, 512, (T - 14) * 256, 5, (T - 14) * 4} : T == 16 ? TileDesc{WS_CKV, 256, 0, 5, 8}
         : T < 24 ? TileDesc{WS_RW, 1792, (T - 17) * 256, 2, 0} : T < 56 ? TileDesc{WS_GATE, 8192, (T - 24) * 64, 7, 0} : TileDesc{WS_MISC, 256, 0, 6, 0};
}
struct TileTab { TileDesc d[57]; };
constexpr TileTab mk_tiletab() { TileTab t{}; for (int i = 0; i < 57; ++i) t.d[i] = mk_tile(i); return t; }
__constant__ TileTab g_tiletab = mk_tiletab();

struct EpiIn {
    static constexpr bool AFTER_DRAIN = false;
    unsigned char* ws_; int tile_off; const LAS float* rtab;
    DI bool operator()(Acc& acc, const Unit& u, int wr, int wc, int fr, int fq) const {
        unsigned char* ws = lw(ws_);
        const int T = u.pn + tile_off, row0 = u.pm * BM + wr * 64 + fr, c0 = wc * 32 + fq * 8;
        scale_rows(acc, rtab + u.ord * 256, wr * 64 + fr);
        const TileDesc d = g_tiletab.d[T]; const int kind = d.kind;
        if (kind < 2) {
            const int head = 2 * (T & 1) + (c0 >> 6), j0 = c0 & 63; const float sc = kind ? 0.08838834764831845f : 1.0f;
            bf16* dst = (bf16*)(ws + d.off); const float* cs = (const float*)(ws + WS_COSR); const float* sn = (const float*)(ws + WS_SINR);
#pragma unroll
            for (int ai = 0; ai < 2; ++ai)
#pragma unroll
                for (int m = 0; m < 4; ++m) { const int row = row0 + ai * HALF + m * 16;
                    const f32x4 ca = *(const GAS f32x4*)(cs + (size_t)row * 64 + j0), cb = *(const GAS f32x4*)(cs + (size_t)row * 64 + j0 + 4);
                    const f32x4 sa = *(const GAS f32x4*)(sn + (size_t)row * 64 + j0), sb = *(const GAS f32x4*)(sn + (size_t)row * 64 + j0 + 4);
                    const f32x4 x1a = acc[ai][0][m][0], x1b = acc[ai][0][m][1], x2a = acc[ai][1][m][0], x2b = acc[ai][1][m][1];
                    bf16* o = dst + (size_t)row * 512 + head * 128 + j0;
                    st8bf(o, (x1a * ca - x2a * sa) * sc, (x1b * cb - x2b * sb) * sc);
                    st8bf(o + 64, (x2a * ca + x1a * sa) * sc, (x2b * cb + x1b * sb) * sc); }
            return true;
        }
        if (kind == 7) {
            const int nb0 = (fq & 1) * 2; bf16* dst = (bf16*)(ws + d.off) + d.cb + wc * 16 + (fq & 2) * 4 + nb0 * 2048;
#pragma unroll
            for (int ai = 0; ai < 2; ++ai)
#pragma unroll
                for (int m = 0; m < 4; ++m) { const size_t ro = (size_t)(row0 + ai * HALF + m * 16) * 8192; f32x4 sv[4], gv[4];
#pragma unroll
                    for (int nb = 0; nb < 4; ++nb) { const f32x4 x = acc[ai][nb >> 1][m][nb & 1];
#pragma unroll
                        for (int i = 0; i < 4; ++i) { const float sk = 1.0f + fminf(fexp_(-x[i]), 1e30f); sv[nb][i] = sk; gv[nb][i] = __builtin_amdgcn_rcpf(sk); } }
                    u32x2 p0 = pk4_(gv[0] * sv[1]), p1 = pk4_(gv[1] * sv[2]), p2 = pk4_(gv[2] * sv[3]), p3 = pk4_(gv[3]);
                    XR_SWAP("v_permlane16_swap_b32", p0.x, p2.x); XR_SWAP("v_permlane16_swap_b32", p0.y, p2.y); XR_SWAP("v_permlane16_swap_b32", p1.x, p3.x); XR_SWAP("v_permlane16_swap_b32", p1.y, p3.y);
                    *(GAS u32x4*)(dst + ro) = (u32x4){p0.x, p0.y, p2.x, p2.y}; *(GAS u32x4*)(dst + ro + 2048) = (u32x4){p1.x, p1.y, p3.x, p3.y}; }
            return true;
        }
        if (kind == 6) {
            float* dst = (float*)(ws + d.off) + d.cb + c0;
#pragma unroll
            for (int ai = 0; ai < 2; ++ai)
#pragma unroll
                for (int m = 0; m < 4; ++m) { const int row = row0 + ai * HALF + m * 16;
#pragma unroll
                    for (int bj = 0; bj < 2; ++bj) st8f(dst + (size_t)row * d.ld + bj * HALF, acc[ai][bj][m][0], acc[ai][bj][m][1]); }
            return true;
        }
        {
            bf16* dst = (bf16*)(ws + d.off) + d.cb + c0; float* ssq = (float*)(ws + WS_SSQ) + d.slot + wc;
            const float am = (kind == 3 || kind == 4) ? 1.f : 0.f, xm = (kind == 4) ? 0.f : 1.f;
#pragma unroll
            for (int ai = 0; ai < 2; ++ai)
#pragma unroll
                for (int m = 0; m < 4; ++m) { const int row = row0 + ai * HALF + m * 16; float ss = 0.f;
#pragma unroll
                    for (int bj = 0; bj < 2; ++bj) { f32x4 a = acc[ai][bj][m][0], b = acc[ai][bj][m][1];
                        ss += (a.x * a.x + a.y * a.y) + (a.z * a.z + a.w * a.w) + (b.x * b.x + b.y * b.y) + (b.z * b.z + b.w * b.w);
                        if (am != 0.f) {
#pragma unroll
                            for (int i = 0; i < 4; ++i) { const float s0 = sigmoidf_(a[i]), s1 = sigmoidf_(b[i]); a[i] = (xm != 0.f) ? a[i] * s0 : s0; b[i] = (xm != 0.f) ? b[i] * s1 : s1; } }
                        st8bf(dst + (size_t)row * d.ld + bj * HALF, a, b); }
                    if (kind == 5) { ss = xr32_sum(xr16_sum(ss)); if (fq == 0) ssq[(size_t)row * 16] = ss; } }
        }
        return true;
    }
};

struct EpiMisc {
    static constexpr bool AFTER_DRAIN = false;
    unsigned char* ws_; const LAS float* rtab;
    DI bool operator()(Acc& acc, const Unit& u, int wr, int wc, int fr, int fq) const {
        float* dst = (float*)(lw(ws_) + WS_MISC) + wc * 32 + fq * 8; const int row0 = u.pm * BM + wr * 64 + fr;
        scale_rows(acc, rtab + u.ord * 256, wr * 64 + fr);
#pragma unroll
        for (int ai = 0; ai < 2; ++ai)
#pragma unroll
            for (int m = 0; m < 4; ++m) { const int row = row0 + ai * HALF + m * 16;
#pragma unroll
                for (int bj = 0; bj < 2; ++bj) st8f(dst + (size_t)row * 256 + bj * HALF, acc[ai][bj][m][0], acc[ai][bj][m][1]); }
        return true;
    }
};

struct EpiQb {
    static constexpr bool AFTER_DRAIN = true;
    unsigned char* ws; const float* qnw;
    DI bool operator()(Acc&, const Unit&, int, int, int, int) const { return true; }
    DI void fused(Acc& acc, const Unit& u, int wr, int wc, int fr, int fq, LAS unsigned char* lds, int wid, int lane, int tid) const {
        const int h = u.pn, row0 = u.pm * BM + wr * 64 + fr, c0 = wc * 32 + fq * 8;
        const float* ssq = (const float*)(ws + WS_SSQ); LAS float* P = (LAS float*)lds;
        const float QS = 0.07216878364870322f * LOG2E;
#pragma unroll
        for (int ai = 0; ai < 2; ++ai)
#pragma unroll
            for (int m = 0; m < 4; ++m) { const int row = row0 + ai * HALF + m * 16, rl = ai * HALF + wr * 64 + m * 16 + fr;
                const f32x4 s0 = *(const GAS f32x4*)(ssq + (size_t)row * 16), s1 = *(const GAS f32x4*)(ssq + (size_t)row * 16 + 4);
                const float rs = rsqrtf(((s0.x + s0.y) + (s0.z + s0.w) + (s1.x + s1.y) + (s1.z + s1.w)) * (1.f / 512.f) + 1e-6f);
                float ss = 0.f;
#pragma unroll
                for (int bj = 0; bj < 2; ++bj)
#pragma unroll
                    for (int n = 0; n < 2; ++n) { f32x4 a = acc[ai][bj][m][n] * rs; acc[ai][bj][m][n] = a; ss += (a.x * a.x + a.y * a.y) + (a.z * a.z + a.w * a.w); }
                ss = xr32_sum(xr16_sum(ss));
                if (fq == 0) P[rl * 4 + wc] = ss; }
        __syncthreads();
        bf16* QM = (bf16*)(ws + WS_QM); const float* cs = (const float*)(ws + WS_COSM); const float* sn = (const float*)(ws + WS_SINM);
#pragma unroll
        for (int ai = 0; ai < 2; ++ai)
#pragma unroll
            for (int m = 0; m < 4; ++m) { const int row = row0 + ai * HALF + m * 16, rl = ai * HALF + wr * 64 + m * 16 + fr;
                const f32x4 pp = *(const LAS f32x4*)(P + rl * 4); const float rq = rsqrtf(((pp.x + pp.y) + (pp.z + pp.w)) * (1.f / 192.f) + 1e-6f) * QS;
                bf16* o = QM + (size_t)row * 768 + h * 192;
                if (wc < 3) {
                    const f32x4 wa = *(const GAS f32x4*)(qnw + c0), wb = *(const GAS f32x4*)(qnw + c0 + 4);
                    st8bf(o + c0, acc[ai][0][m][0] * rq * wa, acc[ai][0][m][1] * rq * wb);
                    if (wc == 0) { const f32x4 wc4 = *(const GAS f32x4*)(qnw + 96 + c0), wd = *(const GAS f32x4*)(qnw + 100 + c0);
                        st8bf(o + 96 + c0, acc[ai][1][m][0] * rq * wc4, acc[ai][1][m][1] * rq * wd); }
                } else {
                    const int i0 = 8 * fq;
                    const f32x4 w1a = *(const GAS f32x4*)(qnw + 128 + i0), w1b = *(const GAS f32x4*)(qnw + 132 + i0), w2a = *(const GAS f32x4*)(qnw + 160 + i0), w2b = *(const GAS f32x4*)(qnw + 164 + i0);
                    const f32x4 ca = *(const GAS f32x4*)(cs + (size_t)row * 32 + i0), cb = *(const GAS f32x4*)(cs + (size_t)row * 32 + i0 + 4), sa = *(const GAS f32x4*)(sn + (size_t)row * 32 + i0), sb = *(const GAS f32x4*)(sn + (size_t)row * 32 + i0 + 4);
                    const f32x4 x1a = acc[ai][0][m][0] * rq * w1a, x1b = acc[ai][0][m][1] * rq * w1b, x2a = acc[ai][1][m][0] * rq * w2a, x2b = acc[ai][1][m][1] * rq * w2b;
                    st8bf(o + 128 + i0, x1a * ca - x2a * sa, x1b * cb - x2b * sb);
                    st8bf(o + 160 + i0, x2a * ca + x1a * sa, x2b * cb + x1b * sb);
                } }
        __syncthreads();
    }
};

struct EpiKvb {
    static constexpr bool AFTER_DRAIN = true;
    unsigned char* ws; const float* knw;
    DI bool operator()(Acc&, const Unit&, int, int, int, int) const { return true; }
    DI void fused(Acc& acc, const Unit& u, int wr, int wc, int fr, int fq, LAS unsigned char* lds, int wid, int lane, int tid) const {
        const int h = u.pn, row0 = u.pm * BM + wr * 64 + fr, c0 = wc * 32 + fq * 8;
        const float* ssq = (const float*)(ws + WS_SSQ); const float* misc = (const float*)(ws + WS_MISC);
        LAS float* P = (LAS float*)lds; LAS float* KRS = P + 1024; LAS float* RK = P + 1280;
        LAS bf16* VTs = (LAS bf16*)(lds + 8192);
        if (tid < 256) { const float* kr = misc + (size_t)(u.pm * BM + tid) * 256 + 8; float s = 0.f;
#pragma unroll
            for (int i = 0; i < 16; ++i) { const f32x4 v = *(const GAS f32x4*)(kr + 4 * i); s += (v.x * v.x + v.y * v.y) + (v.z * v.z + v.w * v.w); }
            KRS[tid] = s; }
#pragma unroll
        for (int ai = 0; ai < 2; ++ai)
#pragma unroll
            for (int m = 0; m < 4; ++m) { const int row = row0 + ai * HALF + m * 16, rl = ai * HALF + wr * 64 + m * 16 + fr;
                const f32x4 s0 = *(const GAS f32x4*)(ssq + (size_t)row * 16 + 8);
                const float rs = rsqrtf(((s0.x + s0.y) + (s0.z + s0.w)) * (1.f / 256.f) + 1e-6f);
                float ss = 0.f;
#pragma unroll
                for (int bj = 0; bj < 2; ++bj)
#pragma unroll
                    for (int n = 0; n < 2; ++n) { f32x4 a = acc[ai][bj][m][n] * rs; acc[ai][bj][m][n] = a; if (bj == 0) ss += (a.x * a.x + a.y * a.y) + (a.z * a.z + a.w * a.w); }
                ss = xr32_sum(xr16_sum(ss));
                if (fq == 0) P[rl * 4 + wc] = ss; }
        __syncthreads();
        if (tid < 256) { const f32x4 pp = *(const LAS f32x4*)(P + tid * 4); RK[tid] = rsqrtf(((pp.x + pp.y) + (pp.z + pp.w) + KRS[tid]) * (1.f / 192.f) + 1e-6f); }
        __syncthreads();
        bf16* KM = (bf16*)(ws + WS_KM); bf16* VT = (bf16*)(ws + WS_VT);
        const f32x4 wa = *(const GAS f32x4*)(knw + c0), wb = *(const GAS f32x4*)(knw + c0 + 4);
#pragma unroll
        for (int ai = 0; ai < 2; ++ai)
#pragma unroll
            for (int m = 0; m < 4; ++m) { const int row = row0 + ai * HALF + m * 16, rl = ai * HALF + wr * 64 + m * 16 + fr;
                const float rk = RK[rl];
                st8bf(KM + (size_t)row * 768 + h * 192 + c0, acc[ai][0][m][0] * rk * wa, acc[ai][0][m][1] * rk * wb);
#pragma unroll
                for (int n = 0; n < 2; ++n)
#pragma unroll
                    for (int i = 0; i < 4; ++i) VTs[(c0 + n * 4 + i) * 264 + rl] = (bf16)f2bf(acc[ai][1][m][n][i]); }
        {
            const int rl = tid >> 1, hf = tid & 1, row = u.pm * BM + rl, i0 = 16 * hf; const float rk = RK[rl];
            const float* kr = misc + (size_t)row * 256 + 8; const float* cs = (const float*)(ws + WS_COSM) + (size_t)row * 32; const float* sn = (const float*)(ws + WS_SINM) + (size_t)row * 32;
            bf16* o = KM + (size_t)row * 768 + h * 192 + 128;
#pragma unroll
            for (int q = 0; q < 2; ++q) { f32x4 o1[2], o2[2];
#pragma unroll
                for (int e = 0; e < 2; ++e) { const int i = i0 + 8 * q + 4 * e;
                    const f32x4 x1 = *(const GAS f32x4*)(kr + i) * *(const GAS f32x4*)(knw + 128 + i), x2 = *(const GAS f32x4*)(kr + 32 + i) * *(const GAS f32x4*)(knw + 160 + i);
                    const f32x4 c = *(const GAS f32x4*)(cs + i), s = *(const GAS f32x4*)(sn + i);
                    o1[e] = (x1 * c - x2 * s) * rk; o2[e] = (x2 * c + x1 * s) * rk; }
                st8bf(o + i0 + 8 * q, o1[0], o1[1]); st8bf(o + 32 + i0 + 8 * q, o2[0], o2[1]); }
        }
        __syncthreads();
#pragma unroll
        for (int k = 0; k < 8; ++k) { const int p = tid + 512 * k, dv = p >> 5, c8 = (p & 31) * 8; *(GAS u32x4*)(VT + (size_t)(h * 128 + dv) * S + u.pm * BM + c8) = *(const LAS u32x4*)(VTs + dv * 264 + c8); }
        __syncthreads();
    }
};

struct EpiV1 {
    static constexpr bool AFTER_DRAIN = false;
    unsigned char* ws_;
    DI bool operator()(Acc& acc, const Unit& u, int wr, int wc, int fr, int fq) const {
        if (wc != 0) return true;
        unsigned char* ws = lw(ws_);
        const int row0 = u.pm * BM + wr * 64 + fr; bf16* dst = (bf16*)(ws + WS_ALORA);
#pragma unroll
        for (int ai = 0; ai < 2; ++ai)
#pragma unroll
            for (int m = 0; m < 4; ++m) { const int row = row0 + ai * HALF + m * 16; st8bf(dst + (size_t)row * 512 + 384 + fq * 8, acc[ai][0][m][0], acc[ai][0][m][1]); }
        return true;
    }
};

struct EpiLora {
    static constexpr bool AFTER_DRAIN = false;
    unsigned char* ws_; const float* w0; const float* a0; const float* v0; const float* ka;
#define LORA_LOOP(BODY) _Pragma("unroll") for (int ai = 0; ai < 2; ++ai) _Pragma("unroll") for (int m = 0; m < 4; ++m) { const size_t ro = (size_t)(row0 + ai * HALF + m * 16) * 512; \
        _Pragma("unroll") for (int bj = 0; bj < 2; ++bj) _Pragma("unroll") for (int n = 0; n < 2; ++n) { const int j = jb + bj * HALF + n * 4; const size_t o = ro + j; const f32x4 x = acc[ai][bj][m][n]; BODY } }
#define LORA_LOOP8(BODY) _Pragma("unroll") for (int ai = 0; ai < 2; ++ai) _Pragma("unroll") for (int m = 0; m < 4; ++m) { const size_t ro = (size_t)(row0 + ai * HALF + m * 16) * 512; \
        _Pragma("unroll") for (int bj = 0; bj < 2; ++bj) { const int j = jb + bj * HALF; const size_t o = ro + j; const f32x4 x0 = acc[ai][bj][m][0]; const f32x4 x1 = acc[ai][bj][m][1]; BODY } }
#define LORA_LOOP8B(PA, PB, PRE, BODY) _Pragma("unroll") for (int ai = 0; ai < 2; ++ai) _Pragma("unroll") for (int bj = 0; bj < 2; ++bj) { const int j = jb + bj * HALF; u32x4 la_[4]; u32x4 lb_[4]; PRE \
        _Pragma("unroll") for (int m = 0; m < 4; ++m) { const size_t o = (size_t)(row0 + ai * HALF + m * 16) * 512 + j; la_[m] = *(const GAS u32x4*)((PA) + o); lb_[m] = *(const GAS u32x4*)((PB) + o); } \
        _Pragma("unroll") for (int m = 0; m < 4; ++m) { const size_t o = (size_t)(row0 + ai * HALF + m * 16) * 512 + j; const f32x4 x0 = acc[ai][bj][m][0]; const f32x4 x1 = acc[ai][bj][m][1]; const u32x4 LA = la_[m]; const u32x4 LB = lb_[m]; BODY } }
    DI bool operator()(Acc& acc, const Unit& u, int wr, int wc, int fr, int fq) const {
        unsigned char* ws = lw(ws_);
        const int seg = u.pn >> 1, row0 = u.pm * BM + wr * 64 + fr, jb = (u.pn & 1) * 256 + wc * 32 + fq * 8;
        if (seg == 0) { float* dec = (float*)(ws + WS_DEC);
            LORA_LOOP({ const f32x4 b = *(const GAS f32x4*)(w0 + j); f32x4 r;
                _Pragma("unroll") for (int i = 0; i < 4; ++i) { const float u_ = b[i] + x[i]; const float sp = fmaxf(-u_, 0.f) + __logf(1.0f + fexp_(-fabsf(u_))); r[i] = -fexp_(-sp - 0.5f); }
                *(GAS f32x4*)(dec + o) = r; })
        } else if (seg == 1) { const bf16* k32 = (const bf16*)(ws + WS_K32); const bf16* kkn_ = (const bf16*)(ws + WS_KKN); bf16* kp_ = (bf16*)(ws + WS_KP); bf16* bb_ = (bf16*)(ws + WS_BB);
            LORA_LOOP8B(k32, kkn_, const f32x4 b0 = *(const GAS f32x4*)(a0 + j); const f32x4 b1 = *(const GAS f32x4*)(a0 + j + 4); const f32x4 ka0 = *(const GAS f32x4*)(ka + j); const f32x4 ka1 = *(const GAS f32x4*)(ka + j + 4);,
                { float k[8]; float kkn[8]; unpack8(LA, k); unpack8(LB, kkn);
                f32x4 kp0; f32x4 kp1; f32x4 bb0; f32x4 bb1;
                _Pragma("unroll") for (int i = 0; i < 4; ++i) { const float av0 = sigmoidf_(b0[i] + x0[i]); const float av1 = sigmoidf_(b1[i] + x1[i]);
                    kp0[i] = k[i] * (1.0f + (av0 - 1.0f) * ka0[i]); kp1[i] = k[4 + i] * (1.0f + (av1 - 1.0f) * ka1[i]); bb0[i] = kkn[i] * av0; bb1[i] = kkn[4 + i] * av1; }
                *(GAS u32x4*)(kp_ + o) = pack8(kp0, kp1); *(GAS u32x4*)(bb_ + o) = pack8(bb0, bb1); })
        } else if (seg == 2) { bf16* g32 = (bf16*)(ws + WS_G32);
            LORA_LOOP8({ *(GAS u32x4*)(g32 + o) = pack8(x0, x1); })
        } else { bf16* vv = (bf16*)(ws + WS_VV); const bf16* vf_ = (const bf16*)(ws + WS_VFIRST);
            LORA_LOOP8B(vv, vf_, const f32x4 b0 = *(const GAS f32x4*)(v0 + j); const f32x4 b1 = *(const GAS f32x4*)(v0 + j + 4);,
                { float v[8]; float vf[8]; unpack8(LA, v); unpack8(LB, vf); f32x4 r0; f32x4 r1;
                _Pragma("unroll") for (int i = 0; i < 4; ++i) { r0[i] = v[i] + (vf[i] - v[i]) * sigmoidf_(b0[i] + x0[i]); r1[i] = v[4 + i] + (vf[4 + i] - v[4 + i]) * sigmoidf_(b1[i] + x1[i]); }
                *(GAS u32x4*)(vv + o) = pack8(r0, r1); })
        }
        return true;
    }
#undef LORA_LOOP
#undef LORA_LOOP8
#undef LORA_LOOP8B
};

struct EpiBranch {
    static constexpr bool AFTER_DRAIN = false;
    unsigned char* ws_;
    DI bool operator()(Acc& acc, const Unit& u, int wr, int wc, int fr, int fq) const {
        unsigned char* ws = lw(ws_);
        const int nb = u.sub, row0 = u.pm * BM + wr * 64 + fr, cb = u.pn * BM + wc * 32 + fq * 8;
        const bf16* G = (const bf16*)(ws + WS_GATE) + nb * D; bf16* M = (bf16*)(ws + WS_MERGED);
#pragma unroll
        for (int ai = 0; ai < 2; ++ai) { u32x4 gw[4][2];
#pragma unroll
            for (int m = 0; m < 4; ++m)
#pragma unroll
                for (int bj = 0; bj < 2; ++bj) gw[m][bj] = *(const GAS u32x4*)(G + (size_t)(row0 + ai * HALF + m * 16) * 8192 + cb + bj * HALF);
#pragma unroll
            for (int m = 0; m < 4; ++m) { const int row = row0 + ai * HALF + m * 16;
#pragma unroll
                for (int bj = 0; bj < 2; ++bj) { const int col = cb + bj * HALF;
                    float g[8]; unpack8(gw[m][bj], g);
                    const f32x4 a = acc[ai][bj][m][0] * (f32x4){g[0], g[1], g[2], g[3]}, b = acc[ai][bj][m][1] * (f32x4){g[4], g[5], g[6], g[7]};
                    if (nb < 3) { acc[ai][bj][m][0] = a; acc[ai][bj][m][1] = b; } else st8bf(M + (size_t)row * D + col, a, b); } } }
        return nb == 3;
    }
};

struct EpiRes {
    static constexpr bool AFTER_DRAIN = false; static constexpr int RES_MB = 4;
    const float* xin; float* out; bf16* xb; float* rss;
    DI bool operator()(Acc& acc, const Unit& u, int wr, int wc, int fr, int fq) const {
        const int row0 = u.pm * BM + wr * 64 + fr, cb = u.pn * BM + wc * 32 + fq * 8;
#pragma unroll
        for (int ai = 0; ai < 2; ++ai)
#pragma unroll
            for (int mh = 0; mh < 4; mh += RES_MB) { f32x4 xa_[RES_MB][2]; f32x4 xc_[RES_MB][2];
#pragma unroll
                for (int mm = 0; mm < RES_MB; ++mm)
#pragma unroll
                    for (int bj = 0; bj < 2; ++bj) { const size_t o = (size_t)(row0 + ai * HALF + (mh + mm) * 16) * D + cb + bj * HALF; xa_[mm][bj] = *(const GAS f32x4*)(xin + o); xc_[mm][bj] = *(const GAS f32x4*)(xin + o + 4); }
#pragma unroll
                for (int mm = 0; mm < RES_MB; ++mm) { const int m = mh + mm; const int row = row0 + ai * HALF + m * 16; float ss = 0.f;
#pragma unroll
                    for (int bj = 0; bj < 2; ++bj) { const size_t o = (size_t)row * D + cb + bj * HALF;
                        const f32x4 a = xa_[mm][bj] + acc[ai][bj][m][0], b = xc_[mm][bj] + acc[ai][bj][m][1];
                        st8f(out + o, a, b); st8bf(xb + o, a, b);
                        ss += (a.x * a.x + a.y * a.y) + (a.z * a.z + a.w * a.w) + (b.x * b.x + b.y * b.y) + (b.z * b.z + b.w * b.w); }
                    if (rss) { ss = xr32_sum(xr16_sum(ss)); if (fq == 0) rss[(size_t)row * 32 + u.pn * 4 + wc] = ss; } } }
        return true;
    }
};

struct EpiGu {
    static constexpr bool AFTER_DRAIN = false;
    unsigned char* ws_; const LAS float* rtab;
    DI bool operator()(Acc& acc, const Unit& u, int wr, int wc, int fr, int fq) const {
        unsigned char* ws = lw(ws_);
        scale_rows(acc, rtab + u.ord * 256, wr * 64 + fr);
        const int row0 = u.pm * BM + wr * 64 + fr, cb = u.pn * 128 + wc * 32 + fq * 8; bf16* A = (bf16*)(ws + WS_ACT);
#pragma unroll
        for (int ai = 0; ai < 2; ++ai)
#pragma unroll
            for (int m = 0; m < 4; ++m) { const int row = row0 + ai * HALF + m * 16;
                st8bf(A + (size_t)row * DFF + cb, map4(acc[ai][0][m][0], siluf_) * acc[ai][1][m][0], map4(acc[ai][0][m][1], siluf_) * acc[ai][1][m][1]); }
        return true;
    }
};
}

DI bf16x8 ldfrag(const LAS bf16* M, int ld, int r0, int k0, int lane) { return *(const LAS bf16x8*)(M + (r0 + (lane & 15)) * ld + k0 + 8 * (lane >> 4)); }
#define MFMA16(a, b, c) __builtin_amdgcn_mfma_f32_16x16x32_bf16((a), (b), (c), 0, 0, 0)
DI void stage_nat(LAS bf16* dst, int lp, const bf16* src, size_t gp, int rows, int cols8, int tid) {
    const int N = rows * cols8; u32x4 w[2];
#pragma unroll
    for (int k = 0; k < 2; ++k) if (k * NTHR < N) { const int p = tid + k * NTHR, r = p / cols8, c = p - r * cols8; w[k] = *(const GAS u32x4*)(src + (size_t)r * gp + c * 8); }
#pragma unroll
    for (int k = 0; k < 2; ++k) if (k * NTHR < N) { const int p = tid + k * NTHR, r = p / cols8, c = p - r * cols8; *(LAS u32x4*)(dst + r * lp + c * 8) = w[k]; }
}
DI void stage_tr(LAS bf16* dst, int lp, const bf16* src, size_t gp, int rows, int cols8, int tid) {
    const int N = rows * cols8; u32x4 wv[2];
#pragma unroll
    for (int k = 0; k < 2; ++k) if (k * NTHR < N) { const int p = tid + k * NTHR, r = p / cols8, c = p - r * cols8; wv[k] = *(const GAS u32x4*)(src + (size_t)r * gp + c * 8); }
#pragma unroll
    for (int k = 0; k < 2; ++k) if (k * NTHR < N) { const int p = tid + k * NTHR, r = p / cols8, c = p - r * cols8; const u32x4 w = wv[k];
        LAS bf16* d = dst + (c * 8) * lp + r;
        d[0] = (bf16)(w.x & 0xffffu); d[lp] = (bf16)(w.x >> 16); d[2 * lp] = (bf16)(w.y & 0xffffu); d[3 * lp] = (bf16)(w.y >> 16);
        d[4 * lp] = (bf16)(w.z & 0xffffu); d[5 * lp] = (bf16)(w.z >> 16); d[6 * lp] = (bf16)(w.w & 0xffffu); d[7 * lp] = (bf16)(w.w >> 16); }
}
struct StG { u32x4 w[2]; };
DI void stage_ld(StG& s, const bf16* src, size_t gp, int rows, int cols8, int tid) {
    const int N = rows * cols8;
#pragma unroll
    for (int k = 0; k < 2; ++k) if (k * NTHR < N) { const int p = tid + k * NTHR, r = p / cols8, c = p - r * cols8; s.w[k] = *(const GAS u32x4*)(src + (size_t)r * gp + c * 8); }
}
DI void stage_st_nat(const StG& s, LAS bf16* dst, int lp, int rows, int cols8, int tid) {
    const int N = rows * cols8;
#pragma unroll
    for (int k = 0; k < 2; ++k) if (k * NTHR < N) { const int p = tid + k * NTHR, r = p / cols8, c = p - r * cols8; *(LAS u32x4*)(dst + r * lp + c * 8) = s.w[k]; }
}
DI void stage_st_tr(const StG& s, LAS bf16* dst, int lp, int rows, int cols8, int tid) {
    const int N = rows * cols8;
#pragma unroll
    for (int k = 0; k < 2; ++k) if (k * NTHR < N) { const int p = tid + k * NTHR, r = p / cols8, c = p - r * cols8; const u32x4 w = s.w[k];
        LAS bf16* d = dst + (c * 8) * lp + r;
        d[0] = (bf16)(w.x & 0xffffu); d[lp] = (bf16)(w.x >> 16); d[2 * lp] = (bf16)(w.y & 0xffffu); d[3 * lp] = (bf16)(w.y >> 16);
        d[4 * lp] = (bf16)(w.z & 0xffffu); d[5 * lp] = (bf16)(w.z >> 16); d[6 * lp] = (bf16)(w.w & 0xffffu); d[7 * lp] = (bf16)(w.w >> 16); }
}
DI float ret_loggamma(int h) { return log1pf(-exp2f(-5.0f - (float)h)); }

DI void u_ret_kv(Frame& F, int c, int h) {
    int tid_ = F.tid; asm volatile("" : "+v"(tid_));
    unsigned char* ws = F.ws; const int tid = tid_, lane = tid_ & 63, w = F.wave;
    LAS bf16* Kt = (LAS bf16*)F.lds; LAS bf16* Vt = Kt + 128 * 72;
    const bf16* KR = (const bf16*)(ws + WS_KR) + (size_t)(c * 64) * 512 + h * 128; const bf16* VR = (const bf16*)(ws + WS_VR) + (size_t)(c * 64) * 512 + h * 128;
    const float lg = ret_loggamma(h);
    { u32x4 kw[2];
#pragma unroll
      for (int q = 0; q < 2; ++q) { const int p = tid + q * NTHR; kw[q] = *(const GAS u32x4*)(KR + (size_t)(p >> 4) * 512 + (p & 15) * 8); }
#pragma unroll
      for (int q = 0; q < 2; ++q) { const int p = tid + q * NTHR; const int m = p >> 4, d0 = (p & 15) * 8; float k[8]; unpack8(kw[q], k); const float sc = fexp_(lg * (float)(63 - m));
        LAS bf16* d = Kt + d0 * 72 + m;
#pragma unroll
        for (int i = 0; i < 8; ++i) d[i * 72] = (bf16)f2bf(k[i] * sc); } }
    stage_tr(Vt, 72, VR, 512, 64, 16, tid);
    __syncthreads();
    f32x4 acc[8];
#pragma unroll
    for (int bn = 0; bn < 8; ++bn) acc[bn] = (f32x4){0.f, 0.f, 0.f, 0.f};
#pragma unroll
    for (int ks = 0; ks < 2; ++ks) { const bf16x8 a = ldfrag(Kt, 72, 16 * w, 32 * ks, lane);
#pragma unroll
        for (int bn = 0; bn < 8; ++bn) acc[bn] = MFMA16(a, ldfrag(Vt, 72, 16 * bn, 32 * ks, lane), acc[bn]); }
    float* out = (float*)(ws + WS_RKV) + ((size_t)(c * 4 + h) * 128) * 128;
    __syncthreads();
    { LAS float* T = (LAS float*)F.lds;
#pragma unroll
      for (int bn = 0; bn < 8; ++bn)
#pragma unroll
          for (int r = 0; r < 4; ++r) T[(16 * w + 4 * (lane >> 4) + r) * 132 + 16 * bn + (lane & 15)] = acc[bn][r];
      __syncthreads();
#pragma unroll
      for (int k = 0; k < 8; ++k) { const int p = tid + 512 * k, row = p >> 5, c4 = (p & 31) * 4; *(GAS f32x4*)(out + (size_t)row * 128 + c4) = *(const LAS f32x4*)(T + row * 132 + c4); } }
    __syncthreads();
}

DI void u_ret_out(Frame& F, int l_, int c, int h) {
    int tid_ = F.tid; asm volatile("" : "+v"(tid_));
    unsigned char* ws = F.ws; const int tid = tid_, lane = tid_ & 63, w = F.wave;
    LAS bf16* Qs = (LAS bf16*)F.lds; LAS bf16* Ks = Qs + 64 * 136; LAS bf16* Vt = Ks + 64 * 136; LAS bf16* St = Vt + 128 * 72; LAS bf16* Ps = St + 128 * 136; LAS float* Os = (LAS float*)(Ps + 64 * 72);
    const size_t rowb = (size_t)(c * 64) * 512 + h * 128;
    { StG gq, gk, gv; stage_ld(gq, (const bf16*)(ws + WS_QR) + rowb, 512, 64, 16, tid); stage_ld(gk, (const bf16*)(ws + WS_KR) + rowb, 512, 64, 16, tid); stage_ld(gv, (const bf16*)(ws + WS_VR) + rowb, 512, 64, 16, tid);
      stage_st_nat(gq, Qs, 136, 64, 16, tid); stage_st_nat(gk, Ks, 136, 64, 16, tid); stage_st_tr(gv, Vt, 72, 64, 16, tid); }
    { const float* sp = (const float*)(ws + WS_RKV) + ((size_t)(c * 4 + h) * 128) * 128;
      for (int p = tid; p < 4096; p += NTHR) { const int d = p >> 5, e0 = (p & 31) * 4; const f32x4 v = *(const GAS f32x4*)(sp + (size_t)d * 128 + e0);
          LAS bf16* q = St + e0 * 136 + d; q[0] = (bf16)f2bf(v.x); q[136] = (bf16)f2bf(v.y); q[272] = (bf16)f2bf(v.z); q[408] = (bf16)f2bf(v.w); } }
    __syncthreads();
    const float lg = ret_loggamma(h); const int g4 = lane >> 4, lc = lane & 15;
    {
        const int bm = w >> 1;
#pragma unroll
        for (int q = 0; q < 2; ++q) { const int bn = (w & 1) * 2 + q; f32x4 acc = (f32x4){0.f, 0.f, 0.f, 0.f};
#pragma unroll
            for (int ks = 0; ks < 4; ++ks) acc = MFMA16(ldfrag(Qs, 136, 16 * bm, 32 * ks, lane), ldfrag(Ks, 136, 16 * bn, 32 * ks, lane), acc);
#pragma unroll
            for (int r = 0; r < 4; ++r) { const int l = 16 * bm + 4 * g4 + r, m = 16 * bn + lc; const int dd = l > m ? l - m : m - l; Ps[l * 72 + m] = (bf16)f2bf(acc[r] * fexp_(lg * (float)dd)); } }
    }
    __syncthreads();
    {
        const int bm = w >> 1;
#pragma unroll
        for (int q = 0; q < 4; ++q) { const int bn = (w & 1) * 4 + q; f32x4 a1 = (f32x4){0.f, 0.f, 0.f, 0.f}, a2 = (f32x4){0.f, 0.f, 0.f, 0.f};
#pragma unroll
            for (int ks = 0; ks < 2; ++ks) a1 = MFMA16(ldfrag(Ps, 72, 16 * bm, 32 * ks, lane), ldfrag(Vt, 72, 16 * bn, 32 * ks, lane), a1);
#pragma unroll
            for (int ks = 0; ks < 4; ++ks) a2 = MFMA16(ldfrag(Qs, 136, 16 * bm, 32 * ks, lane), ldfrag(St, 136, 16 * bn, 32 * ks, lane), a2);
#pragma unroll
            for (int r = 0; r < 4; ++r) { const int l = 16 * bm + 4 * g4 + r; Os[l * 132 + 16 * bn + lc] = a1[r] + fexp_(lg * (float)(l + 1)) * a2[r]; } }
    }
    __syncthreads();
    {
        const float* gw = (const float*)(ws + WS_PRM) + (size_t)l_ * PRM_STRIDE + P_GN + h * 128; const int l = 8 * w + (lane >> 3), e0 = (lane & 7) * 16; const size_t row = (size_t)(c * 64 + l);
        float x[16], gg[16];
#pragma unroll
        for (int q = 0; q < 4; ++q) { const f32x4 v = *(const LAS f32x4*)(Os + l * 132 + e0 + 4 * q); x[4 * q] = v.x; x[4 * q + 1] = v.y; x[4 * q + 2] = v.z; x[4 * q + 3] = v.w; }
        unpack8(*(const GAS u32x4*)((const bf16*)(ws + WS_GR) + row * 512 + h * 128 + e0), *(float(*)[8])&gg[0]); unpack8(*(const GAS u32x4*)((const bf16*)(ws + WS_GR) + row * 512 + h * 128 + e0 + 8), *(float(*)[8])&gg[8]);
        float sm = 0.f;
#pragma unroll
        for (int i = 0; i < 16; ++i) sm += x[i];
        const float mean = row_sum8(sm) * (1.f / 128.f); float sq = 0.f;
#pragma unroll
        for (int i = 0; i < 16; ++i) { x[i] -= mean; sq += x[i] * x[i]; }
        const float rstd = rsqrtf(row_sum8(sq) * (1.f / 128.f) + 1e-5f);
        float ov[16];
#pragma unroll
        for (int q = 0; q < 4; ++q) { const f32x4 wv = *(const GAS f32x4*)(gw + e0 + 4 * q);
#pragma unroll
            for (int i = 0; i < 4; ++i) ov[4 * q + i] = x[4 * q + i] * rstd * wv[i] * gg[4 * q + i]; }
        bf16* ob = (bf16*)(ws + WS_OB) + row * D + h * 128 + e0;
        *(GAS u32x4*)ob = pack8((f32x4){ov[0], ov[1], ov[2], ov[3]}, (f32x4){ov[4], ov[5], ov[6], ov[7]}); *(GAS u32x4*)(ob + 8) = pack8((f32x4){ov[8], ov[9], ov[10], ov[11]}, (f32x4){ov[12], ov[13], ov[14], ov[15]});
    }
    __syncthreads();
}

DI void u_mamba_st(Frame& F, int c, int g) {
    int tid_ = F.tid; asm volatile("" : "+v"(tid_));
    unsigned char* ws = F.ws; const int tid = tid_, lane = tid_ & 63, w = F.wave;
    LAS bf16* Xt = (LAS bf16*)F.lds; LAS bf16* Bt = Xt + 256 * 72;
    const bf16* XC = (const bf16*)(ws + WS_XC) + (size_t)(c * 64) * 1024; const float* dts = (const float*)(ws + WS_DTS) + (size_t)(c * 64) * 8; const float* acs = (const float*)(ws + WS_ACS) + (size_t)(c * 64) * 8;
    { u32x4 xw[4]; float dq[4]; float aq[4]; const int c0 = (tid & 31) * 8, h = g * 4 + (c0 >> 6); const float a63 = acs[63 * 8 + h];
#pragma unroll
      for (int q = 0; q < 4; ++q) { const int l = (tid + q * NTHR) >> 5; xw[q] = *(const GAS u32x4*)(XC + (size_t)l * 1024 + g * 256 + c0); dq[q] = dts[l * 8 + h]; aq[q] = acs[l * 8 + h]; }
#pragma unroll
      for (int q = 0; q < 4; ++q) { const int l = (tid + q * NTHR) >> 5; float x[8]; unpack8(xw[q], x);
        const float sc = dq[q] * fexp_(a63 - aq[q]); LAS bf16* d = Xt + c0 * 72 + l;
#pragma unroll
        for (int i = 0; i < 8; ++i) d[i * 72] = (bf16)f2bf(x[i] * sc); } }
    stage_tr(Bt, 72, XC + 512 + g * 128, 1024, 64, 16, tid);
    __syncthreads();
    f32x4 acc[2][8];
#pragma unroll
    for (int i = 0; i < 2; ++i)
#pragma unroll
        for (int bn = 0; bn < 8; ++bn) acc[i][bn] = (f32x4){0.f, 0.f, 0.f, 0.f};
#pragma unroll
    for (int ks = 0; ks < 2; ++ks) { const bf16x8 a0 = ldfrag(Xt, 72, 32 * w, 32 * ks, lane), a1 = ldfrag(Xt, 72, 32 * w + 16, 32 * ks, lane);
#pragma unroll
        for (int bn = 0; bn < 8; ++bn) { const bf16x8 b = ldfrag(Bt, 72, 16 * bn, 32 * ks, lane); acc[0][bn] = MFMA16(a0, b, acc[0][bn]); acc[1][bn] = MFMA16(a1, b, acc[1][bn]); } }
    float* out = (float*)(ws + WS_MST) + ((size_t)(c * 8 + g * 4) * 64) * 128;
    __syncthreads();
    { LAS float* T = (LAS float*)F.lds;
#pragma unroll
      for (int i = 0; i < 2; ++i)
#pragma unroll
          for (int bn = 0; bn < 8; ++bn)
#pragma unroll
              for (int r = 0; r < 4; ++r) T[(32 * w + 16 * i + 4 * (lane >> 4) + r) * 132 + 16 * bn + (lane & 15)] = acc[i][bn][r];
      __syncthreads();
#pragma unroll
      for (int k = 0; k < 16; ++k) { const int p = tid + 512 * k, row = p >> 5, c4 = (p & 31) * 4; *(GAS f32x4*)(out + (size_t)row * 128 + c4) = *(const LAS f32x4*)(T + row * 132 + c4); } }
    __syncthreads();
}

struct MambaLds { LAS bf16* Cs; LAS bf16* Bs; LAS float* CB; LAS bf16* Ph; LAS bf16* Xt; LAS bf16* Sh; LAS float* AC; LAS float* DT; LAS float* SSQ; };
DI void mamba_head(Frame& F, const MambaLds& L, const bf16* XC, const float* sp, int g, int hh, float dsk, const bf16* const (&zrow)[4], f32x4 (&y)[2]) {
    const int tid = F.tid, lane = F.lane, w = F.wave, g4 = lane >> 4, lc = lane & 15, bm = w >> 1;
    bf16 zv[2][4];
#pragma unroll
    for (int q = 0; q < 2; ++q)
#pragma unroll
        for (int r = 0; r < 4; ++r) zv[q][r] = zrow[r][hh * 64 + q * 16];
    __syncthreads();
    { const int l = tid >> 3, m0 = (tid & 7) * 8; const float al = L.AC[l * 4 + hh]; float pv[8];
#pragma unroll
      for (int i = 0; i < 8; ++i) { const int m = m0 + i; pv[i] = (m <= l) ? L.CB[l * 68 + m] * fexp_(al - L.AC[m * 4 + hh]) * L.DT[m * 4 + hh] : 0.f; }
      u32x4 o; o.x = pk2(pv[0], pv[1]); o.y = pk2(pv[2], pv[3]); o.z = pk2(pv[4], pv[5]); o.w = pk2(pv[6], pv[7]); *(LAS u32x4*)(L.Ph + l * 72 + m0) = o; }
    stage_tr(L.Xt, 72, XC + g * 256 + hh * 64, 1024, 64, 8, tid);
    { f32x4 sv[2][2];
#pragma unroll
      for (int k = 0; k < 2; ++k) { const int p = tid + k * NTHR, pr = p >> 4, n0 = (p & 15) * 8; sv[k][0] = *(const GAS f32x4*)(sp + (size_t)pr * 128 + n0); sv[k][1] = *(const GAS f32x4*)(sp + (size_t)pr * 128 + n0 + 4); }
#pragma unroll
      for (int k = 0; k < 2; ++k) { const int p = tid + k * NTHR, pr = p >> 4, n0 = (p & 15) * 8; *(LAS u32x4*)(L.Sh + pr * 136 + n0) = pack8(sv[k][0], sv[k][1]); } }
    __syncthreads();
#pragma unroll
    for (int q = 0; q < 2; ++q) { const int bn = (w & 1) * 2 + q; f32x4 yd = (f32x4){0.f, 0.f, 0.f, 0.f}, yo = (f32x4){0.f, 0.f, 0.f, 0.f};
#pragma unroll
        for (int ks = 0; ks < 2; ++ks) yd = MFMA16(ldfrag(L.Ph, 72, 16 * bm, 32 * ks, lane), ldfrag(L.Xt, 72, 16 * bn, 32 * ks, lane), yd);
#pragma unroll
        for (int ks = 0; ks < 4; ++ks) yo = MFMA16(ldfrag(L.Cs, 136, 16 * bm, 32 * ks, lane), ldfrag(L.Sh, 136, 16 * bn, 32 * ks, lane), yo);
#pragma unroll
        for (int r = 0; r < 4; ++r) { const int l = 16 * bm + 4 * g4 + r, p = 16 * bn + lc; const float x = bf2f(L.Xt[p * 72 + l]);
            const float z = bf2f(zv[q][r]);
            y[q][r] = (yd[r] + fexp_(L.AC[l * 4 + hh]) * yo[r] + x * dsk) * z; } }
}
DI void u_mamba_out(Frame& F, int l_, int c, int g) {
    int tid_ = F.tid; asm volatile("" : "+v"(tid_));
    unsigned char* ws = F.ws; const int tid = tid_, lane = tid_ & 63, w = F.wave, g4 = lane >> 4, lc = lane & 15;
    MambaLds L; L.Cs = (LAS bf16*)F.lds; L.Bs = L.Cs + 64 * 136; L.CB = (LAS float*)(L.Bs + 64 * 136); L.Ph = (LAS bf16*)(L.CB + 64 * 68); L.Xt = L.Ph + 64 * 72; L.Sh = L.Xt + 64 * 72;
    L.AC = (LAS float*)(L.Sh + 64 * 136); L.DT = L.AC + 256; L.SSQ = L.DT + 256;
    LAS bf16* Y = (LAS bf16*)(L.SSQ + 128);
    const bf16* XC = (const bf16*)(ws + WS_XC) + (size_t)(c * 64) * 1024;
    { StG gc, gb; float ac_ = 0.f, dt_ = 0.f; stage_ld(gc, XC + 768 + g * 128, 1024, 64, 16, tid); stage_ld(gb, XC + 512 + g * 128, 1024, 64, 16, tid);
      if (tid < 256) { const int l = tid >> 2, hh = tid & 3; ac_ = *(const GAS float*)((const float*)(ws + WS_ACS) + (size_t)(c * 64 + l) * 8 + g * 4 + hh); dt_ = *(const GAS float*)((const float*)(ws + WS_DTS) + (size_t)(c * 64 + l) * 8 + g * 4 + hh); }
      stage_st_nat(gc, L.Cs, 136, 64, 16, tid); stage_st_nat(gb, L.Bs, 136, 64, 16, tid);
      if (tid < 256) { L.AC[tid] = ac_; L.DT[tid] = dt_; } }
    __syncthreads();
    const int bm = w >> 1;
#pragma unroll
    for (int q = 0; q < 2; ++q) { const int bn = (w & 1) * 2 + q; f32x4 acc = (f32x4){0.f, 0.f, 0.f, 0.f};
#pragma unroll
        for (int ks = 0; ks < 4; ++ks) acc = MFMA16(ldfrag(L.Cs, 136, 16 * bm, 32 * ks, lane), ldfrag(L.Bs, 136, 16 * bn, 32 * ks, lane), acc);
#pragma unroll
        for (int r = 0; r < 4; ++r) L.CB[(16 * bm + 4 * g4 + r) * 68 + 16 * bn + lc] = acc[r]; }
    const int pcol = 16 * ((w & 1) * 2) + lc;
    const bf16* zrow[4];
#pragma unroll
    for (int r = 0; r < 4; ++r) { const size_t row = (size_t)(c * 64 + 16 * bm + 4 * g4 + r); zrow[r] = (const bf16*)(ws + WS_ZS) + row * 512 + g * 256 + pcol; }
    const float* mst = (const float*)(ws + WS_MST) + ((size_t)(c * 8 + g * 4) * 64) * 128; const float* prm = (const float*)(ws + WS_PRM) + (size_t)l_ * PRM_STRIDE; const float* dskp = prm + P_SD + g * 4;
    float ss[4] = {0.f, 0.f, 0.f, 0.f};
#pragma unroll 1
    for (int hh = 0; hh < 4; ++hh) { f32x4 y[2]; mamba_head(F, L, XC, mst + (size_t)hh * 64 * 128, g, hh, dskp[hh], zrow, y);
#pragma unroll
        for (int q = 0; q < 2; ++q)
#pragma unroll
            for (int r = 0; r < 4; ++r) { ss[r] += y[q][r] * y[q][r]; Y[(16 * bm + 4 * g4 + r) * 264 + hh * 64 + pcol + q * 16] = (bf16)f2bf(y[q][r]); } }
#pragma unroll
    for (int r = 0; r < 4; ++r) { float t = ss[r]; t = row_sum16(t);
        if (lc == 0) L.SSQ[(16 * bm + 4 * g4 + r) * 2 + (w & 1)] = t; }
    __syncthreads();
    {
        const int l = tid >> 3, c0 = (tid & 7) * 32; const float rstd = rsqrtf((L.SSQ[l * 2] + L.SSQ[l * 2 + 1]) * (1.f / 256.f) + 1e-6f);
        const float* nw = prm + P_SNW + g * 256 + c0; bf16* orow = (bf16*)(ws + WS_OB) + (size_t)(c * 64 + l) * D + 512 + g * 256 + c0;
        f32x4 wq[4][2];
#pragma unroll
        for (int q = 0; q < 4; ++q) { wq[q][0] = *(const GAS f32x4*)(nw + 8 * q); wq[q][1] = *(const GAS f32x4*)(nw + 8 * q + 4); }
#pragma unroll
        for (int q = 0; q < 4; ++q) { float v[8]; unpack8(*(const LAS u32x4*)(Y + l * 264 + c0 + 8 * q), v);
            const f32x4 w0 = wq[q][0], w1 = wq[q][1];
            *(GAS u32x4*)(orow + 8 * q) = pack8((f32x4){v[0], v[1], v[2], v[3]} * rstd * w0, (f32x4){v[4], v[5], v[6], v[7]} * rstd * w1); } }
    __syncthreads();
}

DI void u_attn2(Frame& F, int h, int qb, int sp, int ntile) {
    int tid_ = F.tid; asm volatile("" : "+v"(tid_));
    unsigned char* ws = F.ws; const int tid = tid_, lane = tid & 63, w = F.wave, g4 = lane >> 4, lc = lane & 15;
    LAS bf16* Ks = (LAS bf16*)F.lds; LAS bf16* Vs = Ks + 64 * 200;
    const bf16* QM = (const bf16*)(ws + WS_QM); const bf16* KM = (const bf16*)(ws + WS_KM) + h * 192; const bf16* VT = (const bf16*)(ws + WS_VT) + (size_t)(h * 128) * S;
    const int q0 = qb * 256 + w * 32, cw = 4 * qb + (w >> 1);
    bf16x8 qf[2][6];
#pragma unroll
    for (int qq = 0; qq < 2; ++qq)
#pragma unroll
        for (int ks = 0; ks < 6; ++ks) qf[qq][ks] = *(const GAS bf16x8*)(QM + (size_t)(q0 + qq * 16 + lc) * 768 + h * 192 + ks * 32 + g4 * 8);
    f32x4 o[8][2]; float mrun[2], lrun[2];
#pragma unroll
    for (int db = 0; db < 8; ++db)
#pragma unroll
        for (int qq = 0; qq < 2; ++qq) o[db][qq] = (f32x4){0.f, 0.f, 0.f, 0.f};
    mrun[0] = mrun[1] = -1e30f; lrun[0] = lrun[1] = 0.f;
    u32x4 kreg[3], vreg[2];
    const int kt0 = 16 * sp;
#define AT_LOAD(kt) { const int key0_ = (kt) * 64; \
        _Pragma("unroll") for (int i = 0; i < 3; ++i) { const int p = tid + 512 * i, r = p / 24, cc = p - r * 24; kreg[i] = *(const GAS u32x4*)(KM + (size_t)(key0_ + r) * 768 + cc * 8); } \
        _Pragma("unroll") for (int i = 0; i < 2; ++i) { const int p = tid + 512 * i, r = p >> 3, cc = p & 7; vreg[i] = *(const GAS u32x4*)(VT + (size_t)r * S + key0_ + cc * 8); } }
    AT_LOAD(kt0)
    for (int t = 0; t < ntile; ++t) {
        const int kt = kt0 + t;
        __syncthreads();
#pragma unroll
        for (int i = 0; i < 3; ++i) { const int p = tid + 512 * i, r = p / 24, cc = p - r * 24; *(LAS u32x4*)(Ks + r * 200 + cc * 8) = kreg[i]; }
#pragma unroll
        for (int i = 0; i < 2; ++i) { const int p = tid + 512 * i, r = p >> 3, cc = p & 7; *(LAS u32x4*)(Vs + r * 72 + cc * 8) = vreg[i]; }
        __syncthreads();
        if (t + 1 < ntile) AT_LOAD(kt + 1)
        if (kt <= cw) {
            f32x4 s[4][2];
#pragma unroll
            for (int kb = 0; kb < 4; ++kb)
#pragma unroll
                for (int qq = 0; qq < 2; ++qq) s[kb][qq] = (f32x4){0.f, 0.f, 0.f, 0.f};
            {
                bf16x8 kfr[2][4];
#pragma unroll
                for (int kb = 0; kb < 4; ++kb) kfr[0][kb] = ldfrag(Ks, 200, kb * 16, 0, lane);
#pragma unroll
                for (int ks = 0; ks < 6; ++ks) {
                    if (ks < 5) {
#pragma unroll
                        for (int kb = 0; kb < 4; ++kb) kfr[(ks + 1) & 1][kb] = ldfrag(Ks, 200, kb * 16, (ks + 1) * 32, lane); }
#pragma unroll
                    for (int kb = 0; kb < 4; ++kb)
#pragma unroll
                        for (int qq = 0; qq < 2; ++qq) s[kb][qq] = MFMA16(kfr[ks & 1][kb], qf[qq][ks], s[kb][qq]);
                }
            }
            bf16x8 pf[2][2];
#pragma unroll
            for (int qq = 0; qq < 2; ++qq) {
                float mx = -1e30f;
#pragma unroll
                for (int kb = 0; kb < 4; ++kb) mx = fmaxf(mx, fmaxf(fmaxf(s[kb][qq][0], s[kb][qq][1]), fmaxf(s[kb][qq][2], s[kb][qq][3])));
                mx = xr32_max(xr16_max(mx));
                const float mn = fmaxf(mrun[qq], mx), alpha = __builtin_amdgcn_exp2f(mrun[qq] - mn); mrun[qq] = mn;
                float ps = 0.f; float p[16];
#pragma unroll
                for (int kb = 0; kb < 4; ++kb)
#pragma unroll
                    for (int r = 0; r < 4; ++r) { p[kb * 4 + r] = __builtin_amdgcn_exp2f(s[kb][qq][r] - mn); ps += p[kb * 4 + r]; }
                ps = xr32_sum(xr16_sum(ps));
                lrun[qq] = lrun[qq] * alpha + ps;
if (__builtin_amdgcn_ballot_w64(alpha != 1.0f) != 0ull) {
#pragma unroll
                    for (int db = 0; db < 8; ++db) o[db][qq] = o[db][qq] * alpha; }
#pragma unroll
                for (int s2 = 0; s2 < 2; ++s2) { u32x4 pw; pw.x = pk2(p[8 * s2], p[8 * s2 + 1]); pw.y = pk2(p[8 * s2 + 2], p[8 * s2 + 3]); pw.z = pk2(p[8 * s2 + 4], p[8 * s2 + 5]); pw.w = pk2(p[8 * s2 + 6], p[8 * s2 + 7]); pf[qq][s2] = __builtin_bit_cast(bf16x8, pw); }
            }
            {
                bf16x8 vfr[2][2];
#define AT_VLD(dst, db_) { _Pragma("unroll") for (int s2 = 0; s2 < 2; ++s2) { const LAS bf16* vp = Vs + ((db_) * 16 + lc) * 72 + 32 * s2 + 4 * g4; \
                    const u32x2 v0 = *(const LAS u32x2*)vp, v1 = *(const LAS u32x2*)(vp + 16); const u32x4 vw = (u32x4){v0.x, v0.y, v1.x, v1.y}; dst[s2] = __builtin_bit_cast(bf16x8, vw); } }
                AT_VLD(vfr[0], 0)
#pragma unroll
                for (int db = 0; db < 8; ++db) {
                    if (db < 7) AT_VLD(vfr[(db + 1) & 1], db + 1)
#pragma unroll
                    for (int s2 = 0; s2 < 2; ++s2)
#pragma unroll
                        for (int qq = 0; qq < 2; ++qq) o[db][qq] = MFMA16(vfr[db & 1][s2], pf[qq][s2], o[db][qq]);
                }
#undef AT_VLD
            }
        }
    }
#undef AT_LOAD
    const int slot = att_slot(h, qb, sp);
    bf16* po = (bf16*)(ws + WS_APO) + (size_t)slot * 32768; float* pm = (float*)(ws + WS_APM) + (size_t)slot * 512;
#pragma unroll
    for (int db = 0; db < 8; ++db)
#pragma unroll
        for (int qq = 0; qq < 2; ++qq) *(GAS u32x2*)(po + (size_t)(w * 32 + qq * 16 + lc) * 128 + db * 16 + 4 * g4) = pk4_(o[db][qq]);
    if (g4 == 0) {
#pragma unroll
        for (int qq = 0; qq < 2; ++qq) { *(GAS f32x2*)(pm + (w * 32 + qq * 16 + lc) * 2) = (f32x2){mrun[qq], lrun[qq]}; } }
    __syncthreads();
}
DI void u_attn_comb(Frame& F, int h, int qb, int qq) {
    unsigned char* ws = F.ws; const int tid = F.tid, q = qq * 64 + (tid >> 3), dv0 = (tid & 7) * 16;
    const int ns = (qb + 4) >> 2, slot0 = att_slot(h, qb, 0);
    const float* pm = (const float*)(ws + WS_APM) + (size_t)slot0 * 512 + q * 2; const bf16* po = (const bf16*)(ws + WS_APO) + (size_t)slot0 * 32768 + (size_t)q * 128 + dv0;
    f32x2 ml[8];
#pragma unroll
    for (int s = 0; s < 8; ++s) { const int sc_ = s < ns ? s : ns - 1; ml[s] = *(const GAS f32x2*)(pm + (size_t)sc_ * 512); }
    float mstar = -1e30f;
#pragma unroll
    for (int s = 0; s < 8; ++s) mstar = fmaxf(mstar, ml[s].x);
    float lt = 0.f; float ov[16]; float wt[8];
#pragma unroll
    for (int i = 0; i < 16; ++i) ov[i] = 0.f;
#pragma unroll
    for (int s = 0; s < 8; ++s) { wt[s] = s < ns ? __builtin_amdgcn_exp2f(ml[s].x - mstar) : 0.f; lt += ml[s].y * wt[s]; }
#pragma unroll
    for (int sb = 0; sb < 8; sb += 4) {
        if (sb < ns) { u32x4 pa[4]; u32x4 pb[4];
#pragma unroll
            for (int k = 0; k < 4; ++k) { const int sc_ = (sb + k) < ns ? (sb + k) : ns - 1; pa[k] = *(const GAS u32x4*)(po + (size_t)sc_ * 32768); pb[k] = *(const GAS u32x4*)(po + (size_t)sc_ * 32768 + 8); }
#pragma unroll
            for (int k = 0; k < 4; ++k) { float v[16]; unpack8(pa[k], *(float(*)[8])&v[0]); unpack8(pb[k], *(float(*)[8])&v[8]); const float sc = wt[sb + k];
#pragma unroll
                for (int i = 0; i < 16; ++i) ov[i] += v[i] * sc; } } }
    const float inv = 1.0f / lt;
    bf16* ob = (bf16*)(ws + WS_OB) + (size_t)(qb * 256 + q) * D + 1024 + h * 128 + dv0;
    u32x4 o0, o1; o0.x = pk2(ov[0] * inv, ov[1] * inv); o0.y = pk2(ov[2] * inv, ov[3] * inv); o0.z = pk2(ov[4] * inv, ov[5] * inv); o0.w = pk2(ov[6] * inv, ov[7] * inv);
    o1.x = pk2(ov[8] * inv, ov[9] * inv); o1.y = pk2(ov[10] * inv, ov[11] * inv); o1.z = pk2(ov[12] * inv, ov[13] * inv); o1.w = pk2(ov[14] * inv, ov[15] * inv);
    *(GAS u32x4*)ob = o0; *(GAS u32x4*)(ob + 8) = o1;
}

DI void u_rwkv_r1(Frame& F, int c, int h) {
    int tid_ = F.tid; asm volatile("" : "+v"(tid_));
    unsigned char* ws = F.ws; const int tid = tid_, lane = tid_ & 63, w = F.wave, g4 = lane >> 4, lc = lane & 15;
    LAS float* CUM = (LAS float*)F.lds;
    LAS float* PT = CUM + 64 * 68;
    LAS bf16* AT = (LAS bf16*)(PT + 64); LAS bf16* BH = AT + 4608; LAS bf16* KH = BH + 4608; LAS bf16* RT = KH + 4608;
    LAS bf16* AJ = RT + 4608; LAS bf16* BJ = AJ + 4608; LAS bf16* KJ = BJ + 4608; LAS bf16* VJ = KJ + 4608;
    LAS bf16* MAK = VJ + 4608; LAS bf16* MRBT = MAK + 4608; LAS bf16* MRKT = MRBT + 4608; LAS bf16* X1 = MRKT + 4608; LAS bf16* X2 = X1 + 4608;
    LAS bf16* WT = AT; LAS bf16* G1 = BH; LAS bf16* G2 = KH; LAS bf16* CST = MAK;
    const size_t gb = (size_t)(c * 64) * 512 + h * 64; const int unit = c * 8 + h;
    const int t = tid >> 3, j0 = (tid & 7) * 8;
    const size_t go = gb + (size_t)t * 512 + j0;
    float lw[8];
    { const f32x4 x0 = *(const GAS f32x4*)((const float*)(ws + WS_DEC) + go), x1 = *(const GAS f32x4*)((const float*)(ws + WS_DEC) + go + 4);
#pragma unroll
      for (int i = 0; i < 4; ++i) { lw[i] = x0[i]; lw[4 + i] = x1[i]; }
#pragma unroll
      for (int i = 0; i < 8; ++i) CUM[t * 68 + j0 + i] = lw[i]; }
    __syncthreads();
    if (tid < 64) { float s = 0.f;
#pragma unroll 8
        for (int tt = 0; tt < 64; ++tt) { s += CUM[tt * 68 + tid]; CUM[tt * 68 + tid] = s; } }
    __syncthreads();
    {
        float cum[8], cT[8];
#pragma unroll
        for (int i = 0; i < 8; ++i) { cum[i] = CUM[t * 68 + j0 + i]; cT[i] = CUM[63 * 68 + j0 + i]; }
        if (t == 0) {
#pragma unroll
            for (int i = 0; i < 8; ++i) PT[j0 + i] = fexp_(cT[i]); }
        float av[8], bv[8], kv[8], rv[8], vv[8];
#define LD8(dst, OFF) { unpack8(*(const GAS u32x4*)((const bf16*)(ws + (OFF)) + go), dst); }
        LD8(av, WS_KKN) LD8(bv, WS_BB) LD8(kv, WS_KP) LD8(rv, WS_R32) LD8(vv, WS_VV)
#undef LD8
        float at[8], bh[8], kh[8], rt[8], bj[8], kj[8];
#pragma unroll
        for (int i = 0; i < 8; ++i) { const float pprev = fexp_(cum[i] - lw[i]), pinv = fexp_(-cum[i]), pt = fexp_(cum[i]), pend = fexp_(cT[i] - cum[i]);
            at[i] = -av[i] * pprev; bh[i] = bv[i] * pinv; kh[i] = kv[i] * pinv; rt[i] = rv[i] * pt; bj[i] = bv[i] * pend; kj[i] = kv[i] * pend; }
#define ST8(M, v) { u32x4 o; o.x = pk2(v[0], v[1]); o.y = pk2(v[2], v[3]); o.z = pk2(v[4], v[5]); o.w = pk2(v[6], v[7]); *(LAS u32x4*)(M + t * 72 + j0) = o; }
        ST8(AT, at) ST8(BH, bh) ST8(KH, kh) ST8(RT, rt)
#undef ST8
#pragma unroll
        for (int i = 0; i < 8; ++i) { const int o = (j0 + i) * 72 + t; AJ[o] = (bf16)f2bf(at[i]); BJ[o] = (bf16)f2bf(bj[i]); KJ[o] = (bf16)f2bf(kj[i]); VJ[o] = (bf16)f2bf(vv[i]); }
    }
    __syncthreads();
    {
        const int q = w >> 1; const LAS bf16* Am = (q == 0) ? BH : (q == 1) ? KH : RT; const LAS bf16* Bm = (q < 2) ? AT : (q == 2) ? BH : KH;
#pragma unroll
        for (int bi = 0; bi < 2; ++bi) { const int bm = 2 * (w & 1) + bi; const bf16x8 a0 = ldfrag(Am, 72, 16 * bm, 0, lane), a1 = ldfrag(Am, 72, 16 * bm, 32, lane);
#pragma unroll
            for (int bn = 0; bn < 4; ++bn) { f32x4 acc = (f32x4){0.f, 0.f, 0.f, 0.f};
                acc = MFMA16(a0, ldfrag(Bm, 72, 16 * bn, 0, lane), acc); acc = MFMA16(a1, ldfrag(Bm, 72, 16 * bn, 32, lane), acc);
#pragma unroll
                for (int r = 0; r < 4; ++r) { const int row = 16 * bm + 4 * g4 + r, col = 16 * bn + lc; const bool keep = (q < 2) ? (row < col) : (col <= row); const float v = keep ? acc[r] : 0.f;
                    if (q == 0) CUM[row * 68 + col] = v; else { LAS bf16* O = (q == 1) ? MAK : (q == 2) ? MRBT : MRKT; O[row * 72 + col] = (bf16)f2bf(v); } } } }
    }
    __syncthreads();
    {
        LAS bf16* Qn[2] = {BH, X1}; LAS bf16* Qt[2] = {KH, X2}; LAS bf16* Wn[2] = {AT, (LAS bf16*)CUM};
        const int bm = w >> 1; f32x4 wreg[2];
#pragma unroll
        for (int qn = 0; qn < 2; ++qn) { const int bn = (w & 1) * 2 + qn;
#pragma unroll
            for (int r = 0; r < 4; ++r) { const int row = 16 * bm + 4 * g4 + r, col = 16 * bn + lc; const float m = CUM[row * 68 + col]; wreg[qn][r] = m + ((row == col) ? 1.f : 0.f);
                const bf16 mb = (bf16)f2bf(m); Qn[0][row * 72 + col] = mb; Qt[0][col * 72 + row] = mb; Wn[0][row * 72 + col] = (bf16)f2bf(wreg[qn][r]); } }
        __syncthreads();
#pragma unroll
        for (int it = 0; it < 5; ++it) { const int cu = it & 1, nx = cu ^ 1;
            { const bf16x8 a0 = ldfrag(Qn[cu], 72, 16 * bm, 0, lane), a1 = ldfrag(Qn[cu], 72, 16 * bm, 32, lane);
#pragma unroll
              for (int qn = 0; qn < 2; ++qn) { const int bn = (w & 1) * 2 + qn; f32x4 acc = (f32x4){0.f, 0.f, 0.f, 0.f};
                  acc = MFMA16(a0, ldfrag(Qt[cu], 72, 16 * bn, 0, lane), acc); acc = MFMA16(a1, ldfrag(Qt[cu], 72, 16 * bn, 32, lane), acc);
#pragma unroll
                  for (int r = 0; r < 4; ++r) { const int row = 16 * bm + 4 * g4 + r, col = 16 * bn + lc; const bf16 v = (bf16)f2bf(acc[r]); Qn[nx][row * 72 + col] = v; Qt[nx][col * 72 + row] = v; } } }
            __syncthreads();
            { const bf16x8 a0 = ldfrag(Wn[cu], 72, 16 * bm, 0, lane), a1 = ldfrag(Wn[cu], 72, 16 * bm, 32, lane);
#pragma unroll
              for (int qn = 0; qn < 2; ++qn) { const int bn = (w & 1) * 2 + qn;
                  wreg[qn] = MFMA16(a0, ldfrag(Qt[nx], 72, 16 * bn, 0, lane), wreg[qn]); wreg[qn] = MFMA16(a1, ldfrag(Qt[nx], 72, 16 * bn, 32, lane), wreg[qn]); } }
            if (it < 4) {
#pragma unroll
                for (int qn = 0; qn < 2; ++qn) { const int bn = (w & 1) * 2 + qn;
#pragma unroll
                    for (int r = 0; r < 4; ++r) Wn[nx][(16 * bm + 4 * g4 + r) * 72 + 16 * bn + lc] = (bf16)f2bf(wreg[qn][r]); }
            }
        }
        __syncthreads();
#pragma unroll
        for (int qn = 0; qn < 2; ++qn) { const int bn = (w & 1) * 2 + qn;
#pragma unroll
            for (int r = 0; r < 4; ++r) WT[(16 * bn + lc) * 72 + 16 * bm + 4 * g4 + r] = (bf16)f2bf(wreg[qn][r]); }
    }
    __syncthreads();
    {
        const int q = w >> 2, bm = w & 3; const LAS bf16* Am = q ? MAK : AJ; LAS bf16* O = q ? G2 : G1;
        const bf16x8 a0 = ldfrag(Am, 72, 16 * bm, 0, lane), a1 = ldfrag(Am, 72, 16 * bm, 32, lane);
        f32x4 acc[4];
#pragma unroll
        for (int bn = 0; bn < 4; ++bn) { acc[bn] = (f32x4){0.f, 0.f, 0.f, 0.f};
            acc[bn] = MFMA16(a0, ldfrag(WT, 72, 16 * bn, 0, lane), acc[bn]); acc[bn] = MFMA16(a1, ldfrag(WT, 72, 16 * bn, 32, lane), acc[bn]); }
#pragma unroll
        for (int bn = 0; bn < 4; ++bn)
#pragma unroll
            for (int r = 0; r < 4; ++r) O[(16 * bm + 4 * g4 + r) * 72 + 16 * bn + lc] = (bf16)f2bf(acc[bn][r]);
    }
    __syncthreads();
    {
        const int q = w >> 1; const LAS bf16* Am = (q < 2) ? MRBT : BJ; const LAS bf16* Bm = (q & 1) ? G2 : G1;
        f32x4 acc[2][4];
#pragma unroll
        for (int bi = 0; bi < 2; ++bi) { const int bm = 2 * (w & 1) + bi; const bf16x8 a0 = ldfrag(Am, 72, 16 * bm, 0, lane), a1 = ldfrag(Am, 72, 16 * bm, 32, lane);
#pragma unroll
            for (int bn = 0; bn < 4; ++bn) { acc[bi][bn] = (f32x4){0.f, 0.f, 0.f, 0.f};
                acc[bi][bn] = MFMA16(a0, ldfrag(Bm, 72, 16 * bn, 0, lane), acc[bi][bn]); acc[bi][bn] = MFMA16(a1, ldfrag(Bm, 72, 16 * bn, 32, lane), acc[bi][bn]); } }
        LAS bf16* lout = (q == 0) ? AT : (q == 1) ? AJ : (q == 2) ? X1 : CST;
#pragma unroll
        for (int bi = 0; bi < 2; ++bi) { const int bm = 2 * (w & 1) + bi;
#pragma unroll
            for (int bn = 0; bn < 4; ++bn)
#pragma unroll
                for (int r = 0; r < 4; ++r) { const int row = 16 * bm + 4 * g4 + r, col = 16 * bn + lc; float v = acc[bi][bn][r];
                    if (q == 0) v += bf2f(RT[row * 72 + col]); else if (q == 1) v += bf2f(MRKT[row * 72 + col]); else if (q == 2) v += (row == col) ? PT[row] : 0.f; else v += bf2f(KJ[row * 72 + col]);
                    lout[row * 72 + col] = (bf16)f2bf(v); } }
    }
    __syncthreads();
    { const int row = tid >> 3, c8 = (tid & 7) * 8; const size_t go2 = (size_t)unit * 4096 + row * 64 + c8;
      *(GAS u32x4*)((bf16*)(ws + WS_QYT) + go2) = *(const LAS u32x4*)(AT + row * 72 + c8);
      *(GAS u32x4*)((bf16*)(ws + WS_CYT) + go2) = *(const LAS u32x4*)(AJ + row * 72 + c8);
      *(GAS u32x4*)((bf16*)(ws + WS_TST) + go2) = *(const LAS u32x4*)(X1 + row * 72 + c8); }
    {
        const int bm = w >> 1;
        const bf16x8 a0 = ldfrag(CST, 72, 16 * bm, 0, lane), a1 = ldfrag(CST, 72, 16 * bm, 32, lane);
#pragma unroll
        for (int qn = 0; qn < 2; ++qn) { const int bn = (w & 1) * 2 + qn; f32x4 acc = (f32x4){0.f, 0.f, 0.f, 0.f};
            acc = MFMA16(a0, ldfrag(VJ, 72, 16 * bn, 0, lane), acc); acc = MFMA16(a1, ldfrag(VJ, 72, 16 * bn, 32, lane), acc);
#pragma unroll
            for (int r = 0; r < 4; ++r) CUM[(16 * bm + 4 * g4 + r) * 68 + 16 * bn + lc] = acc[r]; }
    }
    __syncthreads();
    { float* nst = (float*)(ws + WS_NST) + (size_t)unit * 4096;
#pragma unroll
      for (int k = 0; k < 2; ++k) { const int p = tid + 512 * k, row = p >> 4, c4 = (p & 15) * 4; *(GAS f32x4*)(nst + row * 64 + c4) = *(const LAS f32x4*)(CUM + row * 68 + c4); } }
    __syncthreads();
}

DI void p_rwkv_scan2(Frame& F, int h) {
    unsigned char* ws = F.ws; const int lane = F.lane, w = F.wave, g4 = lane >> 4, lc = lane & 15;
    constexpr int SLOT_B = 9216 + 17408;
    const bf16* TST = (const bf16*)(ws + WS_TST) + (size_t)h * 4096; const float* NST = (const float*)(ws + WS_NST) + (size_t)h * 4096; bf16* S0 = (bf16*)(ws + WS_S0) + (size_t)h * 4096;
    if (w >= 4) {
        const int lt = (w - 4) * 64 + lane;
        u32x4 rt[8][2]; f32x4 rn[8][4];
#define SC_ISSUE(u, cc) { const size_t ub = (size_t)(cc) * 8 * 4096; \
            _Pragma("unroll") for (int i = 0; i < 2; ++i) { const int p = lt + 256 * i; rt[u][i] = *(const GAS u32x4*)(TST + ub + (size_t)p * 8); } \
            _Pragma("unroll") for (int i = 0; i < 4; ++i) { const int p = lt + 256 * i; rn[u][i] = *(const GAS f32x4*)(NST + ub + (size_t)p * 4); } }
#define SC_WRITE(u, cc) { LAS unsigned char* sl = F.lds + ((cc) & 1) * SLOT_B; \
            _Pragma("unroll") for (int i = 0; i < 2; ++i) { const int p = lt + 256 * i, r = p >> 3, c8 = p & 7; *(LAS u32x4*)(sl + (r * 72 + c8 * 8) * 2) = rt[u][i]; } \
            _Pragma("unroll") for (int i = 0; i < 4; ++i) { const int p = lt + 256 * i, r = p >> 4, c4 = p & 15; *(LAS f32x4*)(sl + 9216 + (r * 68 + c4 * 4) * 4) = rn[u][i]; } }
#pragma unroll
        for (int u = 0; u < 8; ++u) SC_ISSUE(u, u)
        for (int c0 = 0; c0 < NCH; c0 += 8) {
#pragma unroll
            for (int u = 0; u < 8; ++u) { const int c = c0 + u;
                SC_WRITE(u, c)
                SC_ISSUE(u, (c + 8 < NCH) ? c + 8 : NCH - 1)
                asm volatile("s_waitcnt lgkmcnt(0)" ::: "memory"); __builtin_amdgcn_s_barrier(); asm volatile("" ::: "memory");
            }
        }
#undef SC_ISSUE
#undef SC_WRITE
    } else {
        const int ib = w;
        f32x4 st[4];
#pragma unroll
        for (int jb = 0; jb < 4; ++jb) st[jb] = (f32x4){0.f, 0.f, 0.f, 0.f};
        for (int c = 0; c < NCH; ++c) {
            bf16* s0p = S0 + (size_t)c * 8 * 4096 + (size_t)(16 * ib + lc) * 64 + 4 * g4;
            bf16x8 bfr[2];
#pragma unroll
            for (int ks = 0; ks < 2; ++ks) { u32x4 p; p.x = pk2(st[2 * ks][0], st[2 * ks][1]); p.y = pk2(st[2 * ks][2], st[2 * ks][3]); p.z = pk2(st[2 * ks + 1][0], st[2 * ks + 1][1]); p.w = pk2(st[2 * ks + 1][2], st[2 * ks + 1][3]);
                bfr[ks] = __builtin_bit_cast(bf16x8, p);
                *(GAS u32x2*)(s0p + 32 * ks) = (u32x2){p.x, p.y}; *(GAS u32x2*)(s0p + 32 * ks + 16) = (u32x2){p.z, p.w}; }
            asm volatile("s_waitcnt lgkmcnt(0)" ::: "memory"); __builtin_amdgcn_s_barrier(); asm volatile("" ::: "memory");
            const LAS bf16* ts = (const LAS bf16*)(F.lds + (c & 1) * SLOT_B); const LAS float* ns = (const LAS float*)(F.lds + (c & 1) * SLOT_B + 9216);
#pragma unroll
            for (int jb = 0; jb < 4; ++jb) { f32x4 nw;
#pragma unroll
                for (int r = 0; r < 4; ++r) nw[r] = ns[(16 * jb + 4 * g4 + r) * 68 + 16 * ib + lc];
#pragma unroll
                for (int ks = 0; ks < 2; ++ks) { const LAS bf16* ap = ts + (16 * jb + lc) * 72 + 32 * ks + 4 * g4; const u32x2 a0 = *(const LAS u32x2*)ap, a1 = *(const LAS u32x2*)(ap + 16);
                    const u32x4 aw = (u32x4){a0.x, a0.y, a1.x, a1.y}; nw = MFMA16(__builtin_bit_cast(bf16x8, aw), bfr[ks], nw); }
                st[jb] = nw; }
        }
    }
}

DI void u_rwkv_r3(Frame& F, int l_, int c, int h) {
    int tid_ = F.tid; asm volatile("" : "+v"(tid_));
    unsigned char* ws = F.ws; const int tid = tid_, lane = tid_ & 63, w = F.wave, g4 = lane >> 4, lc = lane & 15, unit = c * 8 + h;
    LAS bf16* QY = (LAS bf16*)F.lds; LAS bf16* CY = QY + 4608; LAS bf16* S0s = CY + 4608; LAS bf16* VJ = S0s + 4608; LAS float* Ys = (LAS float*)(VJ + 4608);
    const size_t gb = (size_t)(c * 64) * 512 + h * 64;
    { StG g1, g2, g3; stage_ld(g1, (const bf16*)(ws + WS_QYT) + (size_t)unit * 4096, 64, 64, 8, tid); stage_ld(g2, (const bf16*)(ws + WS_CYT) + (size_t)unit * 4096, 64, 64, 8, tid); stage_ld(g3, (const bf16*)(ws + WS_S0) + (size_t)unit * 4096, 64, 64, 8, tid);
      const int t = tid >> 3, j0 = (tid & 7) * 8; const u32x4 w4 = *(const GAS u32x4*)((const bf16*)(ws + WS_VV) + gb + (size_t)t * 512 + j0); LAS bf16* d = VJ + j0 * 72 + t;
      stage_st_nat(g1, QY, 72, 64, 8, tid); stage_st_nat(g2, CY, 72, 64, 8, tid); stage_st_nat(g3, S0s, 72, 64, 8, tid);
      d[0] = (bf16)(w4.x & 0xffffu); d[72] = (bf16)(w4.x >> 16); d[144] = (bf16)(w4.y & 0xffffu); d[216] = (bf16)(w4.y >> 16); d[288] = (bf16)(w4.z & 0xffffu); d[360] = (bf16)(w4.z >> 16); d[432] = (bf16)(w4.w & 0xffffu); d[504] = (bf16)(w4.w >> 16); }
    __syncthreads();
    { const int bm = w >> 1;
#pragma unroll
      for (int qn = 0; qn < 2; ++qn) { const int bn = (w & 1) * 2 + qn; f32x4 acc = (f32x4){0.f, 0.f, 0.f, 0.f};
#pragma unroll
          for (int ks = 0; ks < 2; ++ks) { acc = MFMA16(ldfrag(QY, 72, 16 * bm, 32 * ks, lane), ldfrag(S0s, 72, 16 * bn, 32 * ks, lane), acc); acc = MFMA16(ldfrag(CY, 72, 16 * bm, 32 * ks, lane), ldfrag(VJ, 72, 16 * bn, 32 * ks, lane), acc); }
#pragma unroll
          for (int r = 0; r < 4; ++r) Ys[(16 * bm + 4 * g4 + r) * 68 + 16 * bn + lc] = acc[r]; } }
    __syncthreads();
    {
        const float* prm = (const float*)(ws + WS_PRM) + (size_t)l_ * PRM_STRIDE + h * 64; const int t = 8 * w + (lane >> 3), i0 = (lane & 7) * 8; const size_t o = gb + (size_t)t * 512 + i0;
        float r8[8], k8[8], v8[8], g8[8];
        unpack8(*(const GAS u32x4*)((const bf16*)(ws + WS_R32) + o), r8); unpack8(*(const GAS u32x4*)((const bf16*)(ws + WS_KP) + o), k8);
        unpack8(*(const GAS u32x4*)((const bf16*)(ws + WS_VV) + o), v8); unpack8(*(const GAS u32x4*)((const bf16*)(ws + WS_G32) + o), g8);
        const f32x4 y0 = *(const LAS f32x4*)(Ys + t * 68 + i0), y1 = *(const LAS f32x4*)(Ys + t * 68 + i0 + 4);
        const f32x4 lw0 = *(const GAS f32x4*)(prm + P_LNW + i0), lw1 = *(const GAS f32x4*)(prm + P_LNW + i0 + 4), lb0 = *(const GAS f32x4*)(prm + P_LNB + i0), lb1 = *(const GAS f32x4*)(prm + P_LNB + i0 + 4);
        const f32x4 rk0 = *(const GAS f32x4*)(prm + P_RK + i0), rk1 = *(const GAS f32x4*)(prm + P_RK + i0 + 4);
        const float mean = row_sum8((y0.x + y0.y) + (y0.z + y0.w) + (y1.x + y1.y) + (y1.z + y1.w)) * (1.f / 64.f);
        const f32x4 d0 = y0 - mean, d1 = y1 - mean;
        const float rstd = rsqrtf(row_sum8((d0.x * d0.x + d0.y * d0.y) + (d0.z * d0.z + d0.w * d0.w) + (d1.x * d1.x + d1.y * d1.y) + (d1.z * d1.z + d1.w * d1.w)) * (1.f / 64.f) + 64e-5f);
        float bsp = 0.f;
#pragma unroll
        for (int i = 0; i < 4; ++i) bsp += r8[i] * k8[i] * rk0[i] + r8[4 + i] * k8[4 + i] * rk1[i];
        const float bs = row_sum8(bsp);
        f32x4 o0, o1;
#pragma unroll
        for (int i = 0; i < 4; ++i) { o0[i] = (d0[i] * rstd * lw0[i] + lb0[i] + bs * v8[i]) * g8[i]; o1[i] = (d1[i] * rstd * lw1[i] + lb1[i] + bs * v8[4 + i]) * g8[4 + i]; }
        *(GAS u32x4*)((bf16*)(ws + WS_OB) + (size_t)(c * 64 + t) * D + 1536 + h * 64 + i0) = pack8(o0, o1);
    }
    __syncthreads();
}

constexpr int STEPS_PER_LAYER = 13, NSTEPS = 1 + DEPTH * STEPS_PER_LAYER;
constexpr int NSCAN_BLK = 8;

__global__ void __launch_bounds__(NTHR, 2) mk_fwd(Args args) {
    extern __shared__ __attribute__((aligned(16))) unsigned char lds_raw[];
    Frame F;
    F.lds = (LAS unsigned char*)lds_raw; F.MISC = (volatile LAS unsigned*)(F.lds + MISC_OFF);
    F.tid = threadIdx.x; F.lane = F.tid & 63; F.wave = __builtin_amdgcn_readfirstlane(F.tid >> 6);
    F.G = gridDim.x; F.bid = blockIdx.x; F.ws = args.ws; F.ctl = (gu32*)(args.ws + WS_CTL);
    for (int u = F.tid; u < (LDS_BYTES - LDSCTL_OFF) / 4; u += NTHR) ((LAS unsigned*)(F.lds + LDSCTL_OFF))[u] = 0u;
    __syncthreads();
    const int lo = args.st_lo, hi = args.st_hi;
    XcdBarrier bar; bar.bar = (unsigned*)(F.ctl + CW_BAR); bar.x = 0; bar.st = nullptr;
    if (hi - lo > 1) bar = xcd_barrier_post((unsigned*)(F.ctl + CW_BAR), F.MISC + 8);
#ifndef MK_MASK
#define MK_MASK 0xFBFEu
#endif
#define EN(k) (((MK_MASK) >> (k)) & 1u)
#ifndef MK_REP
#define MK_REP 0u
#endif
#define REP(k) (((MK_REP) >> (k)) & 1u)
#ifndef MK_DUP
#define MK_DUP 0u
#endif
#define DUP(k, stmt) do { stmt; if (((MK_DUP) >> (k)) & 1u) { stmt; } } while (0)
#define RUN(s) (lo <= (s) && (s) < hi)
#define SEAM(s) do { if ((s) + 1 < hi) xcd_barrier(bar); } while (0)

    if (EN(13) && RUN(0)) { _Pragma("unroll 1") for (int rp = 0; rp <= (int)REP(13); ++rp) { relaunder(F, args.ws, (LAS unsigned char*)lds_raw); p_prologue(F, args); } SEAM(0); }

    for (int l = 0; l < DEPTH; ++l) {
        const int sb = 1 + l * STEPS_PER_LAYER;
        const float* xin = (l == 0) ? args.in[0] : args.out;
        if (EN(0) && RUN(sb + 0)) { _Pragma("unroll 1") for (int rp = 0; rp <= (int)REP(0); ++rp) { relaunder(F, args.ws, (LAS unsigned char*)lds_raw); unsigned char* ws = F.ws; DUP(11, p_rmsnorm(F, xin, (const float*)(ws + WS_PRM) + (size_t)l * PRM_STRIDE + P_N1, (bf16*)(ws + WS_XN))); } SEAM(sb + 0); }
        if (EN(1) && RUN(sb + 1)) { _Pragma("unroll 1") for (int rp = 0; rp <= (int)REP(1); ++rp) { relaunder(F, args.ws, (LAS unsigned char*)lds_raw); unsigned char* ws = F.ws;
            pg8::Gemm g{(const bf16*)(ws + WS_XN), (const bf16*)(ws + WS_WIN) + (size_t)l * NINP * D, D, D, D};
            pg8::StaticOrder So; So.init(S, NINP - 256, F.G, F.bid); pg8::EpiIn E{ws, 0, (const LAS float*)(F.lds + RTAB_OFF)};
            pg8::fill_rstd((LAS float*)(F.lds + RTAB_OFF), (const float*)(ws + WS_RSSA), So, F.tid);
            DUP(6, (pg8::gemm_phase<pg8::EpiIn, pg8::StaticOrder, true>(F.lds, g, So, E, F.tid)));
            } SEAM(sb + 1);
        }
        if (EN(2) && RUN(sb + 2)) { _Pragma("unroll 1") for (int rp = 0; rp <= (int)REP(2); ++rp) { relaunder(F, args.ws, (LAS unsigned char*)lds_raw); unsigned char* ws = F.ws;
            if (F.bid >= F.G - 32) {
                pg8::Gemm g{(const bf16*)(ws + WS_XN), (const bf16*)(ws + WS_WIN) + ((size_t)l * NINP + (NINP - 256)) * D, D, D, D};
                pg8::StaticOrder So; So.init(S, 256, 32, F.bid - (F.G - 32)); pg8::EpiMisc E{ws, (const LAS float*)(F.lds + RTAB_OFF)};
                pg8::fill_rstd((LAS float*)(F.lds + RTAB_OFF), (const float*)(ws + WS_RSSA), So, F.tid);
                pg8::gemm_phase<pg8::EpiMisc, pg8::StaticOrder, true>(F.lds, g, So, E, F.tid);
            } else {
                const int Gs = F.G; F.G = Gs - 32;
                DUP(12, p_rwkv_prep(F, l));
                relaunder(F, args.ws, (LAS unsigned char*)lds_raw); F.G = Gs - 32; DUP(13, p_mamba_prep(F, l));
                __syncthreads(); relaunder(F, args.ws, (LAS unsigned char*)lds_raw); F.G = Gs - 32;
                for (int u = F.bid; u < 512; u += F.G) DUP(5, u_ret_kv(F, u >> 2, u & 3));
                F.G = Gs;
            }
            } SEAM(sb + 2);
        }
        if (EN(3) && RUN(sb + 3)) { _Pragma("unroll 1") for (int rp = 0; rp <= (int)REP(3); ++rp) { relaunder(F, args.ws, (LAS unsigned char*)lds_raw); unsigned char* ws = F.ws;
            { pg8::Gemm g{(const bf16*)(ws + WS_CQ), (const bf16*)(ws + WS_WQB) + (size_t)l * 1024 * 512, 512, 512, 512};
              pg8::StaticOrder So; So.init(S, 1024, F.G, F.bid); pg8::EpiQb E{ws, (const float*)(ws + WS_PRM) + (size_t)l * PRM_STRIDE + P_QNW};
              pg8::gemm_phase<pg8::EpiQb, pg8::StaticOrder, false>(F.lds, g, So, E, F.tid); __syncthreads(); }
            relaunder(F, args.ws, (LAS unsigned char*)lds_raw); ws = F.ws;
            { pg8::Gemm g{(const bf16*)(ws + WS_CKV), (const bf16*)(ws + WS_WKVB) + (size_t)l * 1024 * 256, 256, 256, 256};
              pg8::StaticOrder So; So.init(S, 1024, F.G, (F.bid + 128) % F.G); pg8::EpiKvb E{ws, (const float*)(ws + WS_PRM) + (size_t)l * PRM_STRIDE + P_KNW};
              pg8::gemm_phase<pg8::EpiKvb, pg8::StaticOrder, false>(F.lds, g, So, E, F.tid); __syncthreads(); }
            relaunder(F, args.ws, (LAS unsigned char*)lds_raw); ws = F.ws;
            if (l > 0) { pg8::Gemm g{(const bf16*)(ws + WS_VV), (const bf16*)(ws + WS_WV1) + (size_t)l * 256 * 512, 512, 512, 512};
              pg8::StaticOrder So; So.init(S, 256, F.G, (F.bid + 64) % F.G); pg8::EpiV1 E{ws};
              pg8::gemm_phase<pg8::EpiV1, pg8::StaticOrder, true>(F.lds, g, So, E, F.tid); __syncthreads(); }
            relaunder(F, args.ws, (LAS unsigned char*)lds_raw);
            for (int u = F.bid; u < 256; u += F.G) { u_mamba_dt(F, l, u >> 1); DUP(4, u_mamba_st(F, u >> 1, u & 1)); }
            } SEAM(sb + 3);
        }
        if (EN(4) && RUN(sb + 4)) { _Pragma("unroll 1") for (int rp = 0; rp <= (int)REP(4); ++rp) { relaunder(F, args.ws, (LAS unsigned char*)lds_raw); unsigned char* ws = F.ws;
            {
              pg8::Gemm g{(const bf16*)(ws + WS_ALORA), (const bf16*)(ws + WS_WLORA) + (size_t)l * 2048 * 512, 512, 512, 512};
              pg8::StaticOrder So; So.init(S, l > 0 ? 2048 : 1536, F.G, F.bid);
              const float* prm = (const float*)(ws + WS_PRM) + (size_t)l * PRM_STRIDE; pg8::EpiLora E{ws, prm + P_W0, prm + P_A0, prm + P_V0, prm + P_KA};
              DUP(9, (pg8::gemm_phase<pg8::EpiLora, pg8::StaticOrder, true>(F.lds, g, So, E, F.tid))); }
            } SEAM(sb + 4);
        }
        if (EN(5) && RUN(sb + 5)) { _Pragma("unroll 1") for (int rp = 0; rp <= (int)REP(5); ++rp) { relaunder(F, args.ws, (LAS unsigned char*)lds_raw); unsigned char* ws = F.ws; (void)ws;
            if (F.bid < 64) { p_scans(F, 64); relaunder(F, args.ws, (LAS unsigned char*)lds_raw);
                for (int u = F.bid * 2; u < F.bid * 2 + 2; ++u) u_rwkv_r1(F, u >> 3, u & 7); }
            else { for (int u = 128 + (F.bid - 64); u < 1024; u += F.G - 64) u_rwkv_r1(F, u >> 3, u & 7); }
            } SEAM(sb + 5);
        }
        if (EN(6) && RUN(sb + 6)) { _Pragma("unroll 1") for (int rp = 0; rp <= (int)REP(6); ++rp) { relaunder(F, args.ws, (LAS unsigned char*)lds_raw); unsigned char* ws = F.ws; (void)ws;
            if (F.bid < NSCAN_BLK) { p_rwkv_scan2(F, F.bid); }
            else {
                const int NB = F.G - NSCAN_BLK, b = F.bid - NSCAN_BLK;
                { const int* tab = (const int*)(ws + WS_ATAB);
                  for (int r = 0; r * NB < ATT_NSUB; ++r) { const int pos = (r & 1) ? NB - 1 - b : b; const int i = r * NB + pos;
                      if (i < ATT_NSUB) { const int e = tab[i]; DUP(0, u_attn2(F, e & 3, (e >> 2) & 31, (e >> 7) & 31, e >> 12)); } } }
            }
            } SEAM(sb + 6);
        }
        if (EN(7) && RUN(sb + 7)) { _Pragma("unroll 1") for (int rp = 0; rp <= (int)REP(7); ++rp) { relaunder(F, args.ws, (LAS unsigned char*)lds_raw); unsigned char* ws = F.ws; (void)ws;
            for (int u = F.bid; u < 1024; u += F.G) DUP(3, u_rwkv_r3(F, l, u >> 3, u & 7));
            for (int u = F.bid; u < 512; u += F.G) DUP(10, u_attn_comb(F, u >> 7, (u >> 2) & 31, u & 3));
            relaunder(F, args.ws, (LAS unsigned char*)lds_raw);
            for (int u = F.bid; u < 256; u += F.G) DUP(2, u_mamba_out(F, l, u >> 1, u & 1));
            relaunder(F, args.ws, (LAS unsigned char*)lds_raw);
            for (int u = F.bid; u < 512; u += F.G) DUP(1, u_ret_out(F, l, u >> 2, u & 3));
            } SEAM(sb + 7);
        }
        if (EN(8) && RUN(sb + 8)) { _Pragma("unroll 1") for (int rp = 0; rp <= (int)REP(8); ++rp) { relaunder(F, args.ws, (LAS unsigned char*)lds_raw); unsigned char* ws = F.ws;
            pg8::Gemm g{(const bf16*)(ws + WS_OB), (const bf16*)(ws + WS_WBR) + (size_t)l * 8192 * 512, 512, D, 512};
            pg8::BranchOrder So; So.init(F.G, F.bid); pg8::EpiBranch E{ws};
            DUP(8, (pg8::gemm_phase<pg8::EpiBranch, pg8::BranchOrder, true>(F.lds, g, So, E, F.tid)));
            } SEAM(sb + 8);
        }
        if (EN(9) && RUN(sb + 9)) { _Pragma("unroll 1") for (int rp = 0; rp <= (int)REP(9); ++rp) { relaunder(F, args.ws, (LAS unsigned char*)lds_raw); unsigned char* ws = F.ws;
            pg8::Gemm g{(const bf16*)(ws + WS_MERGED), (const bf16*)(ws + WS_WOUT) + (size_t)l * D * D, D, D, D};
            pg8::StaticOrder So; So.init(S, D, F.G, F.bid); pg8::EpiRes E{xin, args.out, (bf16*)(ws + WS_XN), (float*)(ws + WS_RSSB)};
            pg8::gemm_phase<pg8::EpiRes, pg8::StaticOrder, true>(F.lds, g, So, E, F.tid);
            } SEAM(sb + 9);
        }
        if (EN(10) && RUN(sb + 10)) { _Pragma("unroll 1") for (int rp = 0; rp <= (int)REP(10); ++rp) { relaunder(F, args.ws, (LAS unsigned char*)lds_raw); unsigned char* ws = F.ws; DUP(11, p_rmsnorm(F, args.out, (const float*)(ws + WS_PRM) + (size_t)l * PRM_STRIDE + P_N2, (bf16*)(ws + WS_XN))); } SEAM(sb + 10); }
        if (EN(11) && RUN(sb + 11)) { _Pragma("unroll 1") for (int rp = 0; rp <= (int)REP(11); ++rp) { relaunder(F, args.ws, (LAS unsigned char*)lds_raw); unsigned char* ws = F.ws;
            pg8::Gemm g{(const bf16*)(ws + WS_XN), (const bf16*)(ws + WS_WGU) + (size_t)l * 2 * DFF * D, D, D, D};
            pg8::StaticOrder So; So.init(S, 2 * DFF, F.G, F.bid); pg8::EpiGu E{ws, (const LAS float*)(F.lds + RTAB_OFF)};
            pg8::fill_rstd((LAS float*)(F.lds + RTAB_OFF), (const float*)(ws + WS_RSSB), So, F.tid);
            DUP(7, (pg8::gemm_phase<pg8::EpiGu, pg8::StaticOrder, true>(F.lds, g, So, E, F.tid)));
            } SEAM(sb + 11);
        }
        if (EN(12) && RUN(sb + 12)) { _Pragma("unroll 1") for (int rp = 0; rp <= (int)REP(12); ++rp) { relaunder(F, args.ws, (LAS unsigned char*)lds_raw); unsigned char* ws = F.ws;
            pg8::Gemm g{(const bf16*)(ws + WS_ACT), (const bf16*)(ws + WS_WDN) + (size_t)l * D * DFF, DFF, DFF, DFF};
            pg8::StaticOrder So; So.init(S, D, F.G, F.bid); pg8::EpiRes E{args.out, args.out, (bf16*)(ws + WS_XN), (l + 1 < DEPTH) ? (float*)(ws + WS_RSSA) : nullptr};
            pg8::gemm_phase<pg8::EpiRes, pg8::StaticOrder, true>(F.lds, g, So, E, F.tid);
            } SEAM(sb + 12);
        }
    }
#ifdef MK_PROBE
    { const int l = 3;
      if (RUN(200)) { relaunder(F, args.ws, (LAS unsigned char*)lds_raw); for (int u = F.bid; u < 1024; u += F.G) u_rwkv_r3(F, l, u >> 3, u & 7); }
      if (RUN(201)) { relaunder(F, args.ws, (LAS unsigned char*)lds_raw); for (int u = F.bid; u < 512; u += F.G) u_attn_comb(F, u >> 7, (u >> 2) & 31, u & 3); }
      if (RUN(202)) { relaunder(F, args.ws, (LAS unsigned char*)lds_raw); for (int u = F.bid; u < 256; u += F.G) u_mamba_out(F, l, u >> 1, u & 1); }
      if (RUN(203)) { relaunder(F, args.ws, (LAS unsigned char*)lds_raw); for (int u = F.bid; u < 512; u += F.G) u_ret_out(F, l, u >> 2, u & 3); }
      if (RUN(204)) { relaunder(F, args.ws, (LAS unsigned char*)lds_raw); if (F.bid < F.G - 32) { const int Gs = F.G; F.G = Gs - 32; p_rwkv_prep(F, l); F.G = Gs; } }
      if (RUN(205)) { relaunder(F, args.ws, (LAS unsigned char*)lds_raw); if (F.bid < F.G - 32) { const int Gs = F.G; F.G = Gs - 32; p_mamba_prep(F, l); F.G = Gs; } }
      if (RUN(206)) { relaunder(F, args.ws, (LAS unsigned char*)lds_raw); if (F.bid < F.G - 32) { const int Gs = F.G; F.G = Gs - 32; for (int u = F.bid; u < 512; u += F.G) u_ret_kv(F, u >> 2, u & 3); F.G = Gs; } }
      if (RUN(207)) { relaunder(F, args.ws, (LAS unsigned char*)lds_raw); if (F.bid < 64) p_scans(F, 64); }
      if (RUN(208)) { relaunder(F, args.ws, (LAS unsigned char*)lds_raw); if (F.bid >= 64) { for (int u = 128 + (F.bid - 64); u < 1024; u += F.G - 64) u_rwkv_r1(F, u >> 3, u & 7); } }
      if (RUN(210)) { relaunder(F, args.ws, (LAS unsigned char*)lds_raw); unsigned char* ws = F.ws; if (F.bid >= F.G - 32) {
                pg8::Gemm g{(const bf16*)(ws + WS_XN), (const bf16*)(ws + WS_WIN) + ((size_t)l * NINP + (NINP - 256)) * D, D, D, D};
                pg8::StaticOrder So; So.init(S, 256, 32, F.bid - (F.G - 32)); pg8::EpiMisc E{ws, (const LAS float*)(F.lds + RTAB_OFF)};
                pg8::fill_rstd((LAS float*)(F.lds + RTAB_OFF), (const float*)(ws + WS_RSSA), So, F.tid);
                pg8::gemm_phase<pg8::EpiMisc, pg8::StaticOrder, true>(F.lds, g, So, E, F.tid); } }
      if (RUN(211)) { relaunder(F, args.ws, (LAS unsigned char*)lds_raw); unsigned char* ws = F.ws; if (F.bid >= NSCAN_BLK) { const int NB = F.G - NSCAN_BLK, b = F.bid - NSCAN_BLK; const int* tab = (const int*)(ws + WS_ATAB);
                  for (int r = 0; r * NB < ATT_NSUB; ++r) { const int pos = (r & 1) ? NB - 1 - b : b; const int i = r * NB + pos;
                      if (i < ATT_NSUB) { const int e = tab[i]; u_attn2(F, e & 3, (e >> 2) & 31, (e >> 7) & 31, e >> 12); } } } }
      if (RUN(209)) { relaunder(F, args.ws, (LAS unsigned char*)lds_raw); if (F.bid < NSCAN_BLK) p_rwkv_scan2(F, F.bid); }
    }
#endif
#undef RUN
#undef SEAM
}

#ifndef MK_ONE_LAUNCH
#define MK_ONE_LAUNCH 1
#endif
extern "C" void kernel_launch(void* const* d_in, const int* in_sizes, int n_in, void* d_out, int out_size, void* d_ws, size_t ws_size, hipStream_t stream) {
    static int grid = 0;
    if (grid == 0) {
        if (n_in != 36 || in_sizes[0] != S * D || out_size != S * D || ws_size < WS_END3) { fprintf(stderr, "kernel_launch: bad shapes: n_in %d in0 %d out %d ws %zu (need %zu)\n", n_in, n_in > 0 ? in_sizes[0] : -1, out_size, ws_size, (size_t)WS_END3); grid = -1; return; }
        int dev = 0, cus = 0, per_cu = 0;
        if (hipGetDevice(&dev) != hipSuccess || hipDeviceGetAttribute(&cus, hipDeviceAttributeMultiprocessorCount, dev) != hipSuccess) { grid = -1; return; }
        if (hipFuncSetAttribute((const void*)mk_fwd, hipFuncAttributeMaxDynamicSharedMemorySize, LDS_BYTES) != hipSuccess) { fprintf(stderr, "kernel_launch: hipFuncSetAttribute failed\n"); grid = -1; return; }
        if (hipOccupancyMaxActiveBlocksPerMultiprocessor(&per_cu, (const void*)mk_fwd, NTHR, LDS_BYTES) != hipSuccess || per_cu < 1) fprintf(stderr, "kernel_launch: occupancy query says %d\n", per_cu);
        (void)hipGetLastError();
        grid = cus;
        if (grid != 256) fprintf(stderr, "kernel_launch: %d CUs (built for 256)\n", grid);
    }
    if (grid < 0) return;
    if (hipMemsetAsync((char*)d_ws + WS_CTL, 0, CTL_ZERO_BYTES, stream) != hipSuccess) return;
    Args a{};
    for (int i = 0; i < 36; ++i) a.in[i] = (const float*)d_in[i];
    a.out = (float*)d_out; a.ws = (unsigned char*)d_ws;
#if MK_ONE_LAUNCH
    a.st_lo = 0; a.st_hi = NSTEPS;
    hipLaunchKernelGGL(mk_fwd, dim3(grid), dim3(NTHR), LDS_BYTES, stream, a);
#ifndef MK_EXTRA_FLAGS
#define MK_EXTRA_FLAGS 0
#endif
#ifdef MK_EXTRA_STEPS
    { const int xs[] = {MK_EXTRA_STEPS};
      for (int r = 0; r < MK_EXTRA_N; ++r) for (unsigned i = 0; i < sizeof(xs) / sizeof(xs[0]); ++i) { a.st_lo = xs[i]; a.st_hi = xs[i] + 1; hipLaunchKernelGGL(mk_fwd, dim3(grid), dim3(NTHR), LDS_BYTES, stream, a); } }
#endif
#else
    for (int s = 0; s < NSTEPS; ++s) { a.st_lo = s; a.st_hi = s + 1; hipLaunchKernelGGL(mk_fwd, dim3(grid), dim3(NTHR), LDS_BYTES, stream, a); }
#endif
}
```
